# Optimizing an MI355X kernel written in HIP

```python
import math
import jax, jax.numpy as jnp
from jax import lax
import numpy as np

D_MODEL = 2048
BATCH = 4
SEQ = 2048
DEPTH = 1

N_META = 16
EPS = 1e-6
DA_HEADS = 4
DA_QK_DIM = 128
DA_V_DIM = 2 * DA_QK_DIM
DA_WIDTH = DA_HEADS * DA_V_DIM
DA_QK_COLS = DA_HEADS * 2 * DA_QK_DIM
Q_BLOCK = 128
ML_HEADS = 4
ML_QK_DIM = 128
ML_V_DIM = 256
ML_WIDTH = ML_HEADS * ML_V_DIM
ML_QK_COLS = ML_HEADS * ML_QK_DIM
ML_CONV = 4
ML_CHUNK = 64
NEG_BIG = -1e30
D_MIX = DA_WIDTH + ML_WIDTH
D_IN_PROJ = 2 * DA_QK_COLS + DA_WIDTH + 2 * ML_QK_COLS + 2 * ML_WIDTH + 2 * ML_HEADS
PEER_HEADS = 8
PEER_KEYS = 128
PEER_N = PEER_KEYS * PEER_KEYS
PEER_DKEY = 256
PEER_TOPK = 16
PEER_BLOCK = 64

kernel_name = "hymba_diffattn_mlstm_peer"


def rms_norm(x, g):
    xf = x.astype(jnp.float32)
    y = xf * lax.rsqrt(jnp.mean(xf * xf, axis=-1, keepdims=True) + EPS)
    return (y * g.astype(jnp.float32)).astype(x.dtype)


def alibi_slopes(n):
    start = 2.0 ** (-8.0 / n)
    return jnp.asarray([start ** (h + 1) for h in range(n)], dtype=jnp.float32)


def diff_attention(q, k, v, lam, lambda_init, qn_g, kn_g, subln_g):
    B, T, H, _, dk = q.shape
    dv = v.shape[-1]
    q = rms_norm(q, qn_g) * (dk ** -0.5)
    k = rms_norm(k, kn_g)
    n_blk = -(-T // Q_BLOCK)
    Tp = n_blk * Q_BLOCK
    qp = jnp.pad(q, ((0, 0), (0, Tp - T), (0, 0), (0, 0), (0, 0)))
    qb = jnp.moveaxis(qp.reshape(B, n_blk, Q_BLOCK, H, 2, dk), 1, 0)
    slopes = alibi_slopes(H)[None, :, None, None, None]
    kpos = jnp.arange(T)

    def block(args):
        qblk, start = args
        s = jnp.einsum('bqhmd,bkhmd->bhmqk', qblk, k,
                       preferred_element_type=jnp.float32)
        qpos = start + jnp.arange(Q_BLOCK)
        dist = (qpos[:, None] - kpos[None, :]).astype(jnp.float32)
        s = s - slopes * dist
        s = jnp.where(dist >= 0, s, -jnp.inf)
        p = jax.nn.softmax(s, axis=-1)
        a = p[:, :, 0] - lam * p[:, :, 1]
        return jnp.einsum('bhqk,bkhd->bqhd', a.astype(v.dtype), v)

    starts = jnp.arange(n_blk) * Q_BLOCK
    o = lax.map(block, (qb, starts))
    o = jnp.moveaxis(o, 0, 1).reshape(B, Tp, H, dv)[:, :T]
    o = rms_norm(o, subln_g) * (1.0 - lambda_init)
    return o.reshape(B, T, H * dv)


def causal_dwconv(x, w, b):
    C = x.shape[-1]
    y = lax.conv_general_dilated(
        x, w[:, None, :].astype(x.dtype), window_strides=(1,),
        padding=((ML_CONV - 1, 0),), dimension_numbers=('NWC', 'WIO', 'NWC'),
        feature_group_count=C)
    return y + b.astype(x.dtype)


def mlstm_chunkwise(q, k, v, li, lf):
    B, T, H, dk = q.shape
    dv = v.shape[-1]
    pad = ML_CHUNK - N_META

    def padf(a, val):
        return jnp.pad(a, ((0, 0), (pad, 0)) + ((0, 0),) * (a.ndim - 2), constant_values=val)

    q = padf(q, 0.0)
    k = padf(k, 0.0) * (dk ** -0.5)
    v = padf(v, 0.0)
    li = padf(li, NEG_BIG)
    lf = padf(lf, 0.0)
    Tp = T + pad
    nc = Tp // ML_CHUNK
    L = ML_CHUNK

    def chunks(a):
        a = a.reshape((B, nc, L) + a.shape[2:])
        return jnp.moveaxis(a, (1, 2), (0, 3))

    causal = jnp.tril(jnp.ones((L, L), dtype=bool))

    def step(carry, inp):
        C, n, m = carry
        qc, kc, vc, lic, lfc = inp
        b = jnp.cumsum(lfc, axis=-1)
        D = b[..., :, None] - b[..., None, :] + lic[..., None, :]
        D = jnp.where(causal, D, -jnp.inf)
        inter = b + m[..., None]
        m_t = jnp.maximum(inter, jnp.max(D, axis=-1))
        w_inter = jnp.exp(inter - m_t)
        S = jnp.einsum('bhtd,bhsd->bhts', qc, kc) * jnp.exp(D - m_t[..., None])
        num = (w_inter[..., None] * jnp.einsum('bhtd,bhde->bhte', qc, C)
               + jnp.einsum('bhts,bhse->bhte', S, vc))
        den = w_inter * jnp.einsum('bhtd,bhd->bht', qc, n) + jnp.sum(S, axis=-1)
        h = num / jnp.maximum(jnp.abs(den), jnp.exp(-m_t))[..., None]
        bL = b[..., -1]
        g = bL[..., None] - b + lic
        m_new = jnp.maximum(bL + m, jnp.max(g, axis=-1))
        decay = jnp.exp(bL + m - m_new)
        wg = jnp.exp(g - m_new[..., None])
        C = decay[..., None, None] * C + jnp.einsum('bhs,bhsd,bhse->bhde', wg, kc, vc)
        n = decay[..., None] * n + jnp.einsum('bhs,bhsd->bhd', wg, kc)
        return (C, n, m_new), h

    init = (jnp.zeros((B, H, dk, dv), jnp.float32),
            jnp.zeros((B, H, dk), jnp.float32),
            jnp.zeros((B, H), jnp.float32))
    _, hs = lax.scan(step, init, (chunks(q), chunks(k), chunks(v), chunks(li), chunks(lf)))
    hs = jnp.moveaxis(hs, (0, 3), (1, 2)).reshape(B, Tp, H, dv)
    return hs[:, pad:]


def token_mixer(xn, w_in, ml_conv_w, ml_conv_b, ml_igate_b, ml_fgate_b,
                da_lq1, da_lk1, da_lq2, da_lk2, da_qnorm_g, da_knorm_g, da_subln_g,
                ml_outnorm_g, w_out, lambda_init):
    B, T, _ = xn.shape
    proj = jnp.einsum('btd,de->bte', xn, w_in)
    sizes = [DA_QK_COLS, DA_QK_COLS, DA_WIDTH, 2 * ML_QK_COLS, ML_WIDTH, ML_WIDTH]
    da_q, da_k, da_v, ml_qk, ml_v, ml_o, ml_gates = jnp.split(
        proj, np.cumsum(sizes).tolist(), axis=-1)
    lam = (jnp.exp(jnp.sum(da_lq1.astype(jnp.float32) * da_lk1.astype(jnp.float32)))
           - jnp.exp(jnp.sum(da_lq2.astype(jnp.float32) * da_lk2.astype(jnp.float32)))
           + lambda_init)
    a_out = diff_attention(
        da_q.reshape(B, T, DA_HEADS, 2, DA_QK_DIM),
        da_k.reshape(B, T, DA_HEADS, 2, DA_QK_DIM),
        da_v.reshape(B, T, DA_HEADS, DA_V_DIM),
        lam, lambda_init, da_qnorm_g, da_knorm_g, da_subln_g)
    qk = jax.nn.silu(causal_dwconv(ml_qk, ml_conv_w, ml_conv_b))
    mq, mk = jnp.split(qk, 2, axis=-1)
    gates = ml_gates.astype(jnp.float32)
    li = gates[..., :ML_HEADS] + ml_igate_b.astype(jnp.float32)
    lf = jax.nn.log_sigmoid(gates[..., ML_HEADS:] + ml_fgate_b.astype(jnp.float32))
    hm = mlstm_chunkwise(
        mq.reshape(B, T, ML_HEADS, ML_QK_DIM).astype(jnp.float32),
        mk.reshape(B, T, ML_HEADS, ML_QK_DIM).astype(jnp.float32),
        ml_v.reshape(B, T, ML_HEADS, ML_V_DIM).astype(jnp.float32), li, lf)
    hm = rms_norm(hm, ml_outnorm_g).astype(xn.dtype).reshape(B, T, ML_WIDTH)
    m_out = jax.nn.sigmoid(ml_o) * hm
    return jnp.einsum('bte,ed->btd', jnp.concatenate([a_out, m_out], axis=-1), w_out)


def peer_ffn(xn, wq, subkeys, u, v):
    B, T, D = xn.shape
    half = PEER_DKEY // 2
    q = jnp.einsum('btd,de->bte', xn, wq).reshape(B, T, PEER_HEADS, 2, half)
    s = jnp.einsum('bthpc,hpkc->bthpk', q, subkeys,
                   preferred_element_type=jnp.float32)
    sv, si = lax.top_k(s, PEER_TOPK)
    cand = (sv[..., 0, :, None] + sv[..., 1, None, :]).reshape(B, T, PEER_HEADS, PEER_TOPK * PEER_TOPK)
    cidx = (si[..., 0, :, None] * PEER_KEYS + si[..., 1, None, :]).reshape(B, T, PEER_HEADS, PEER_TOPK * PEER_TOPK)
    top_v, top_pos = lax.top_k(cand, PEER_TOPK)
    idx = jnp.take_along_axis(cidx, top_pos, axis=-1)
    g = jax.nn.softmax(top_v, axis=-1)
    E = PEER_HEADS * PEER_TOPK
    n_tok = B * T
    nb = -(-n_tok // PEER_BLOCK)
    padn = nb * PEER_BLOCK - n_tok
    xf = jnp.pad(xn.reshape(n_tok, D), ((0, padn), (0, 0))).reshape(nb, PEER_BLOCK, D)
    idf = jnp.pad(idx.reshape(n_tok, E), ((0, padn), (0, 0))).reshape(nb, PEER_BLOCK, E)
    gf = jnp.pad(g.reshape(n_tok, E), ((0, padn), (0, 0))).reshape(nb, PEER_BLOCK, E)

    def block(args):
        xb, ib, gb = args
        act = jax.nn.gelu(jnp.einsum('nd,ned->ne', xb, u[ib]), approximate=False)
        return jnp.einsum('ne,ned->nd', (act.astype(jnp.float32) * gb).astype(xb.dtype), v[ib])

    y = lax.map(block, (xf, idf, gf)).reshape(nb * PEER_BLOCK, D)[:n_tok]
    return y.reshape(B, T, D)


def setup_inputs(seed: int = 0) -> dict:
    key = jax.random.key(seed)
    ks = jax.random.split(key, 24)
    f32 = jnp.float32
    nrm = lambda k, shape, scale: jax.random.normal(k, shape, f32) * scale
    return {
        "x": nrm(ks[0], (BATCH, SEQ, D_MODEL), 1.0),
        "meta_tokens": nrm(ks[1], (N_META, D_MODEL), 1.0),
        "norm1_g": 1.0 + nrm(ks[2], (DEPTH, D_MODEL), 0.01),
        "w_in": nrm(ks[3], (DEPTH, D_MODEL, D_IN_PROJ), D_MODEL ** -0.5),
        "ml_conv_w": nrm(ks[4], (DEPTH, ML_CONV, 2 * ML_QK_COLS), ML_CONV ** -0.5),
        "ml_conv_b": nrm(ks[5], (DEPTH, 2 * ML_QK_COLS), 0.01),
        "ml_igate_b": nrm(ks[6], (DEPTH, ML_HEADS), 0.1),
        "ml_fgate_b": jnp.linspace(3.0, 6.0, ML_HEADS, dtype=f32)[None, :] + nrm(ks[7], (DEPTH, ML_HEADS), 0.01),
        "da_lq1": nrm(ks[8], (DEPTH, DA_QK_DIM), 0.1),
        "da_lk1": nrm(ks[9], (DEPTH, DA_QK_DIM), 0.1),
        "da_lq2": nrm(ks[10], (DEPTH, DA_QK_DIM), 0.1),
        "da_lk2": nrm(ks[11], (DEPTH, DA_QK_DIM), 0.1),
        "da_qnorm_g": 1.0 + nrm(ks[12], (DEPTH, DA_QK_DIM), 0.01),
        "da_knorm_g": 1.0 + nrm(ks[13], (DEPTH, DA_QK_DIM), 0.01),
        "da_subln_g": 1.0 + nrm(ks[14], (DEPTH, DA_V_DIM), 0.01),
        "ml_outnorm_g": 1.0 + nrm(ks[15], (DEPTH, ML_HEADS, ML_V_DIM), 0.01),
        "w_out": nrm(ks[16], (DEPTH, D_MIX, D_MODEL), D_MIX ** -0.5),
        "norm2_g": 1.0 + nrm(ks[17], (DEPTH, D_MODEL), 0.01),
        "peer_wq": nrm(ks[18], (DEPTH, D_MODEL, PEER_HEADS * PEER_DKEY), D_MODEL ** -0.5),
        "peer_subkeys": nrm(ks[19], (DEPTH, PEER_HEADS, 2, PEER_KEYS, PEER_DKEY // 2), (PEER_DKEY // 2) ** -0.5),
        "peer_u": nrm(ks[20], (DEPTH, PEER_N, D_MODEL), D_MODEL ** -0.5),
        "peer_v": nrm(ks[21], (DEPTH, PEER_N, D_MODEL), 0.25),
    }


def reference(x, meta_tokens, norm1_g, w_in, ml_conv_w, ml_conv_b, ml_igate_b, ml_fgate_b,
              da_lq1, da_lk1, da_lq2, da_lk2, da_qnorm_g, da_knorm_g, da_subln_g,
              ml_outnorm_g, w_out, norm2_g, peer_wq, peer_subkeys, peer_u, peer_v):
    B = x.shape[0]
    meta = jnp.broadcast_to(meta_tokens[None].astype(x.dtype), (B, N_META, x.shape[-1]))
    h = jnp.concatenate([meta, x], axis=1)
    for l in range(DEPTH):
        lambda_init = 0.8 - 0.6 * math.exp(-0.3 * l)
        h = h + token_mixer(rms_norm(h, norm1_g[l]), w_in[l], ml_conv_w[l], ml_conv_b[l],
                            ml_igate_b[l], ml_fgate_b[l], da_lq1[l], da_lk1[l], da_lq2[l], da_lk2[l],
                            da_qnorm_g[l], da_knorm_g[l], da_subln_g[l], ml_outnorm_g[l],
                            w_out[l], lambda_init)
        h = h + peer_ffn(rms_norm(h, norm2_g[l]), peer_wq[l], peer_subkeys[l], peer_u[l], peer_v[l])
    return h[:, N_META:]
```

```cpp
#include <hip/hip_runtime.h>
#include <stdint.h>
#include <math.h>
#include <cstdio>

namespace nv {
constexpr int DM = 2048, NB = 4, SEQ = 2048, NMETA = 16, TT = SEQ + NMETA, NROW = NB * TT;
constexpr int DPROJ = 6152;
constexpr float EPS = 1e-6f;

using bf16x8 = __attribute__((ext_vector_type(8))) short;
using f32x4 = __attribute__((ext_vector_type(4))) float;

__device__ __forceinline__ unsigned short f2bf(float f) {
  unsigned u = __float_as_uint(f);
  u += 0x7fffu + ((u >> 16) & 1u);
  return (unsigned short)(u >> 16);
}
__device__ __forceinline__ float block_sum(float v, float* red) {
  for (int o = 32; o > 0; o >>= 1) v += __shfl_xor(v, o);
  __syncthreads();
  if ((threadIdx.x & 63) == 0) red[threadIdx.x >> 6] = v;
  __syncthreads();
  return red[0] + red[1] + red[2] + red[3];
}
__device__ __forceinline__ float block_max(float v, float* red) {
  for (int o = 32; o > 0; o >>= 1) v = fmaxf(v, __shfl_xor(v, o));
  __syncthreads();
  if ((threadIdx.x & 63) == 0) red[threadIdx.x >> 6] = v;
  __syncthreads();
  return fmaxf(fmaxf(red[0], red[1]), fmaxf(red[2], red[3]));
}

__global__ __launch_bounds__(256) void k_cat_norm(const float* __restrict__ x, const float* __restrict__ meta, const float* __restrict__ g,
                                                   float* __restrict__ h0, float* __restrict__ xn) {
  __shared__ float red[4];
  const int r = blockIdx.x, b = r / TT, t = r % TT, tid = threadIdx.x;
  const float* src = t < NMETA ? meta + (size_t)t * DM : x + ((size_t)b * SEQ + (t - NMETA)) * DM;
  float v[8]; float ss = 0.f;
#pragma unroll
  for (int i = 0; i < 8; ++i) { v[i] = src[tid + 256 * i]; ss += v[i] * v[i]; }
  ss = block_sum(ss, red);
  const float rs = rsqrtf(ss * (1.0f / DM) + EPS);
#pragma unroll
  for (int i = 0; i < 8; ++i) { const int c = tid + 256 * i; h0[(size_t)r * DM + c] = v[i]; xn[(size_t)r * DM + c] = v[i] * rs * g[c]; }
}
__global__ __launch_bounds__(256) void k_norm(const float* __restrict__ h, const float* __restrict__ g, float* __restrict__ xn) {
  __shared__ float red[4];
  const int r = blockIdx.x, tid = threadIdx.x;
  float v[8]; float ss = 0.f;
#pragma unroll
  for (int i = 0; i < 8; ++i) { v[i] = h[(size_t)r * DM + tid + 256 * i]; ss += v[i] * v[i]; }
  ss = block_sum(ss, red);
  const float rs = rsqrtf(ss * (1.0f / DM) + EPS);
#pragma unroll
  for (int i = 0; i < 8; ++i) { const int c = tid + 256 * i; xn[(size_t)r * DM + c] = v[i] * rs * g[c]; }
}

__global__ __launch_bounds__(256) void k_gemm(const float* __restrict__ A, int lda, const float* __restrict__ B, int ldb,
                                               float* C, int ldc, const float* R, int ldr, int M, int N, int K) {
  __shared__ __attribute__((aligned(16))) unsigned short As[128][40];
  __shared__ __attribute__((aligned(16))) unsigned short Bs[128][40];
  const int tid = threadIdx.x, wid = tid >> 6, lane = tid & 63, wr = wid >> 1, wc = wid & 1, fr = lane & 15, fq = lane >> 4;
  const int m0 = blockIdx.y * 128, n0 = blockIdx.x * 128;
  f32x4 acc[4][4];
#pragma unroll
  for (int i = 0; i < 4; ++i)
#pragma unroll
    for (int j = 0; j < 4; ++j) acc[i][j] = (f32x4){0.f, 0.f, 0.f, 0.f};
  const int arow = tid >> 1, akk = (tid & 1) * 16;
  const int bk = tid >> 3, bn0 = (tid & 7) * 16;
  for (int k0 = 0; k0 < K; k0 += 32) {
    {
      float4 a[4];
      const bool ok = (m0 + arow) < M;
#pragma unroll
      for (int i = 0; i < 4; ++i) a[i] = ok ? *(const float4*)(A + (size_t)(m0 + arow) * lda + k0 + akk + 4 * i) : make_float4(0.f, 0.f, 0.f, 0.f);
#pragma unroll
      for (int i = 0; i < 4; ++i) { As[arow][akk + 4 * i + 0] = f2bf(a[i].x); As[arow][akk + 4 * i + 1] = f2bf(a[i].y); As[arow][akk + 4 * i + 2] = f2bf(a[i].z); As[arow][akk + 4 * i + 3] = f2bf(a[i].w); }
      float4 bv[4];
#pragma unroll
      for (int i = 0; i < 4; ++i) { const int n = n0 + bn0 + 4 * i; bv[i] = (n < N) ? *(const float4*)(B + (size_t)(k0 + bk) * ldb + n) : make_float4(0.f, 0.f, 0.f, 0.f); }
#pragma unroll
      for (int i = 0; i < 4; ++i) { Bs[bn0 + 4 * i + 0][bk] = f2bf(bv[i].x); Bs[bn0 + 4 * i + 1][bk] = f2bf(bv[i].y); Bs[bn0 + 4 * i + 2][bk] = f2bf(bv[i].z); Bs[bn0 + 4 * i + 3][bk] = f2bf(bv[i].w); }
    }
    __syncthreads();
    bf16x8 af[4], bfr[4];
#pragma unroll
    for (int i = 0; i < 4; ++i) af[i] = *(const bf16x8*)&As[wr * 64 + i * 16 + fr][fq * 8];
#pragma unroll
    for (int j = 0; j < 4; ++j) bfr[j] = *(const bf16x8*)&Bs[wc * 64 + j * 16 + fr][fq * 8];
#pragma unroll
    for (int i = 0; i < 4; ++i)
#pragma unroll
      for (int j = 0; j < 4; ++j) acc[i][j] = __builtin_amdgcn_mfma_f32_16x16x32_bf16(af[i], bfr[j], acc[i][j], 0, 0, 0);
    __syncthreads();
  }
#pragma unroll
  for (int i = 0; i < 4; ++i)
#pragma unroll
    for (int j = 0; j < 4; ++j)
#pragma unroll
      for (int e = 0; e < 4; ++e) {
        const int row = m0 + wr * 64 + i * 16 + fq * 4 + e, col = n0 + wc * 64 + j * 16 + fr;
        if (row < M && col < N) { float v = acc[i][j][e]; if (R) v += R[(size_t)row * ldr + col]; C[(size_t)row * ldc + col] = v; }
      }
}

__global__ void k_lam(const float* lq1, const float* lk1, const float* lq2, const float* lk2, float* lam) {
  __shared__ float red[4];
  const int tid = threadIdx.x;
  float a = tid < 128 ? lq1[tid] * lk1[tid] : 0.f, b = tid < 128 ? lq2[tid] * lk2[tid] : 0.f;
  a = block_sum(a, red); b = block_sum(b, red);
  if (tid == 0) lam[0] = expf(a) - expf(b) + 0.2f;
}

__global__ __launch_bounds__(256) void k_qknorm(const float* __restrict__ proj, const float* __restrict__ qg, const float* __restrict__ kg,
                                                 float* __restrict__ qn, float* __restrict__ kn) {
  const int w = blockIdx.x * 4 + (threadIdx.x >> 6), lane = threadIdx.x & 63;
  const int r = w >> 4, grp = w & 15; if (r >= NROW) return;
  const bool isk = grp >= 8; const int g8 = grp & 7;
  const float* src = proj + (size_t)r * DPROJ + (isk ? 1024 : 0) + g8 * 128;
  float a = src[lane], b = src[lane + 64];
  float ss = a * a + b * b;
  for (int o = 32; o > 0; o >>= 1) ss += __shfl_xor(ss, o);
  const float rs = rsqrtf(ss * (1.0f / 128.f) + EPS);
  const float sc = isk ? 1.0f : 0.08838834764831845f;
  const float* gg = isk ? kg : qg;
  float* dst = (isk ? kn : qn) + (size_t)r * 1024 + g8 * 128;
  dst[lane] = a * rs * gg[lane] * sc; dst[lane + 64] = b * rs * gg[lane + 64] * sc;
}

__global__ __launch_bounds__(256) void k_attn(const float* __restrict__ qn, const float* __restrict__ kn, const float* __restrict__ proj,
                                               const float* __restrict__ lamp, const float* __restrict__ subg, float* __restrict__ ao) {
  __shared__ float sc[2][TT];
  __shared__ __attribute__((aligned(16))) float qs[256];
  __shared__ float red[4];
  const int t = blockIdx.x, h = blockIdx.y, b = blockIdx.z, tid = threadIdx.x;
  const size_t r = (size_t)b * TT + t;
  const float slope = exp2f(-2.0f * (h + 1));
  qs[tid] = qn[r * 1024 + h * 256 + tid];
  __syncthreads();
  float stat_m[2], stat_l[2];
  for (int m = 0; m < 2; ++m) {
    float mx = -INFINITY;
    for (int s = tid; s <= t; s += 256) {
      const float4* kp = (const float4*)(kn + ((size_t)b * TT + s) * 1024 + h * 256 + m * 128);
      const float4* qp = (const float4*)(qs + m * 128);
      float d = 0.f;
#pragma unroll 8
      for (int i = 0; i < 32; ++i) { const float4 kk = kp[i], qq = qp[i]; d += kk.x * qq.x + kk.y * qq.y + kk.z * qq.z + kk.w * qq.w; }
      d -= slope * (float)(t - s);
      sc[m][s] = d; mx = fmaxf(mx, d);
    }
    mx = block_max(mx, red);
    float sm = 0.f;
    for (int s = tid; s <= t; s += 256) { const float e = expf(sc[m][s] - mx); sc[m][s] = e; sm += e; }
    sm = block_sum(sm, red);
    stat_m[m] = mx; stat_l[m] = sm;
  }
  const float lam = lamp[0];
  const float i0 = 1.0f / stat_l[0], i1 = lam / stat_l[1];
  __syncthreads();
  for (int s = tid; s <= t; s += 256) sc[0][s] = sc[0][s] * i0 - sc[1][s] * i1;
  __syncthreads();
  float o = 0.f;
  const float* vp = proj + (size_t)b * TT * DPROJ + 2048 + h * 256 + tid;
  for (int s = 0; s <= t; ++s) o += sc[0][s] * vp[(size_t)s * DPROJ];
  float ss = block_sum(o * o, red);
  const float rs = rsqrtf(ss * (1.0f / 256.f) + EPS);
  ao[r * 1024 + h * 256 + tid] = o * rs * subg[tid] * 0.8f;
}

__global__ __launch_bounds__(256) void k_conv(const float* __restrict__ proj, const float* __restrict__ cw, const float* __restrict__ cb, float* __restrict__ mqk) {
  const size_t i = (size_t)blockIdx.x * 256 + threadIdx.x;
  const int c = (int)(i & 1023); const size_t r = i >> 10; if (r >= NROW) return;
  const int t = (int)(r % TT);
  float y = cb[c];
#pragma unroll
  for (int j = 0; j < 4; ++j) { const int tt = t - 3 + j; if (tt >= 0) y += cw[j * 1024 + c] * proj[(r - 3 + j) * DPROJ + 3072 + c]; }
  mqk[i] = y / (1.0f + expf(-y));
}

__global__ __launch_bounds__(512) void k_mlstm(const float* __restrict__ proj, const float* __restrict__ mqk, const float* __restrict__ igb, const float* __restrict__ fgb,
                                                float* __restrict__ hm) {
  __shared__ float qs[128], ks[128], ns[128], dens[1];
  const int b = blockIdx.x >> 2, h = blockIdx.x & 3, tid = threadIdx.x, e = tid >> 1, half = tid & 1;
  float C[64];
#pragma unroll
  for (int i = 0; i < 64; ++i) C[i] = 0.f;
  if (tid < 128) ns[tid] = 0.f;
  float m = 0.f;
  const float ib = igb[h], fb = fgb[h];
  for (int t = 0; t < TT; ++t) {
    const size_t r = (size_t)b * TT + t;
    __syncthreads();
    if (tid < 128) { qs[tid] = mqk[r * 1024 + h * 128 + tid]; ks[tid] = mqk[r * 1024 + 512 + h * 128 + tid] * 0.08838834764831845f; }
    const float li = proj[r * DPROJ + 6144 + h] + ib;
    const float fx = proj[r * DPROJ + 6148 + h] + fb;
    const float lf = fminf(fx, 0.f) - log1pf(expf(-fabsf(fx)));
    const float mn = fmaxf(lf + m, li);
    const float fp = expf(lf + m - mn), ip = expf(li - mn);
    m = mn;
    const float ve = proj[r * DPROJ + 4096 + h * 256 + e];
    __syncthreads();
    if (tid < 128) ns[tid] = fp * ns[tid] + ip * ks[tid];
    float num = 0.f; const float iv = ip * ve;
#pragma unroll
    for (int i = 0; i < 64; ++i) { C[i] = fp * C[i] + iv * ks[half * 64 + i]; num += qs[half * 64 + i] * C[i]; }
    num += __shfl_xor(num, 1);
    __syncthreads();
    if (tid < 64) { float d = qs[tid] * ns[tid] + qs[tid + 64] * ns[tid + 64]; for (int o = 32; o > 0; o >>= 1) d += __shfl_xor(d, o); if (tid == 0) dens[0] = d; }
    __syncthreads();
    const float den = dens[0];
    if (half == 0) hm[r * 1024 + h * 256 + e] = num / fmaxf(fabsf(den), expf(-m));
  }
}

__global__ __launch_bounds__(256) void k_mix(const float* __restrict__ ao, const float* __restrict__ hm, const float* __restrict__ proj, const float* __restrict__ og, float* __restrict__ A2) {
  __shared__ float red[4];
  const size_t r = blockIdx.x; const int tid = threadIdx.x;
  for (int h = 0; h < 4; ++h) {
    A2[r * DM + h * 256 + tid] = ao[r * 1024 + h * 256 + tid];
    const float v = hm[r * 1024 + h * 256 + tid];
    const float ss = block_sum(v * v, red);
    const float rs = rsqrtf(ss * (1.0f / 256.f) + EPS);
    const float o = proj[r * DPROJ + 5120 + h * 256 + tid];
    A2[r * DM + 1024 + h * 256 + tid] = v * rs * og[h * 256 + tid] / (1.0f + expf(-o));
  }
}

__global__ __launch_bounds__(256) void k_route(const float* __restrict__ pq, const float* __restrict__ subkeys, int* __restrict__ oidx, float* __restrict__ og) {
  __shared__ __attribute__((aligned(16))) float qv[2048];
  __shared__ float s[2][128];
  __shared__ float sv[2][16]; __shared__ int si[2][16];
  __shared__ float cand[256]; __shared__ int cidx[256];
  __shared__ float tv[16]; __shared__ int ti[16];
  const size_t r = blockIdx.x; const int tid = threadIdx.x, lane = tid & 63, wid = tid >> 6;
  for (int i = tid; i < 2048; i += 256) qv[i] = pq[r * 2048 + i];
  __syncthreads();
  for (int hh = 0; hh < 8; ++hh) {
    { const int p = tid >> 7, k = tid & 127;
      const float4* sk = (const float4*)(subkeys + ((size_t)((hh * 2 + p) * 128 + k)) * 128);
      const float4* qq = (const float4*)(qv + hh * 256 + p * 128);
      float d = 0.f;
#pragma unroll 8
      for (int c = 0; c < 32; ++c) { const float4 a = sk[c], q4 = qq[c]; d += a.x * q4.x + a.y * q4.y + a.z * q4.z + a.w * q4.w; }
      s[p][k] = d; }
    __syncthreads();
    if (wid < 2) {
      const int p = wid; float v0 = s[p][lane], v1 = s[p][lane + 64];
      for (int it = 0; it < 16; ++it) {
        float bv = v0; int bi = lane; if (v1 > bv) { bv = v1; bi = lane + 64; }
        for (int o = 32; o > 0; o >>= 1) { const float ov = __shfl_xor(bv, o); const int oi = __shfl_xor(bi, o); if (ov > bv || (ov == bv && oi < bi)) { bv = ov; bi = oi; } }
        if (lane == 0) { sv[p][it] = bv; si[p][it] = bi; }
        if (bi == lane) v0 = -INFINITY; if (bi == lane + 64) v1 = -INFINITY;
      }
    }
    __syncthreads();
    { const int i = tid >> 4, j = tid & 15; cand[tid] = sv[0][i] + sv[1][j]; cidx[tid] = si[0][i] * 128 + si[1][j]; }
    __syncthreads();
    if (wid == 0) {
      float v[4]; for (int q = 0; q < 4; ++q) v[q] = cand[lane + 64 * q];
      for (int it = 0; it < 16; ++it) {
        float bv = v[0]; int bi = lane;
        for (int q = 1; q < 4; ++q) if (v[q] > bv) { bv = v[q]; bi = lane + 64 * q; }
        for (int o = 32; o > 0; o >>= 1) { const float ov = __shfl_xor(bv, o); const int oi = __shfl_xor(bi, o); if (ov > bv || (ov == bv && oi < bi)) { bv = ov; bi = oi; } }
        if (lane == 0) { tv[it] = bv; ti[it] = cidx[bi]; }
        for (int q = 0; q < 4; ++q) if (bi == lane + 64 * q) v[q] = -INFINITY;
      }
      const float mx = tv[0];
      float e = lane < 16 ? expf(tv[lane] - mx) : 0.f; float sm = e;
      for (int o = 32; o > 0; o >>= 1) sm += __shfl_xor(sm, o);
      if (lane < 16) { oidx[r * 128 + hh * 16 + lane] = ti[lane]; og[r * 128 + hh * 16 + lane] = e / sm; }
    }
    __syncthreads();
  }
}

__global__ __launch_bounds__(256) void k_peer(const float* __restrict__ xn, const float* __restrict__ h1, const int* __restrict__ idx, const float* __restrict__ gg,
                                               const float* __restrict__ U, const float* __restrict__ V, float* __restrict__ out) {
  __shared__ __attribute__((aligned(16))) float xs[2048];
  __shared__ float act[128]; __shared__ int eid[128];
  const int tok = blockIdx.x, b = tok / SEQ, t = tok % SEQ, tid = threadIdx.x, lane = tid & 63, wid = tid >> 6;
  const size_t r = (size_t)b * TT + NMETA + t;
  for (int i = tid; i < 2048; i += 256) xs[i] = xn[r * 2048 + i];
  if (tid < 128) eid[tid] = idx[r * 128 + tid];
  __syncthreads();
  for (int q = 0; q < 32; ++q) {
    const int e = wid * 32 + q; const float4* up = (const float4*)(U + (size_t)eid[e] * 2048);
    float d = 0.f;
#pragma unroll
    for (int i = 0; i < 8; ++i) { const float4 a = up[i * 64 + lane], x4 = ((const float4*)xs)[i * 64 + lane]; d += a.x * x4.x + a.y * x4.y + a.z * x4.z + a.w * x4.w; }
    for (int o = 32; o > 0; o >>= 1) d += __shfl_xor(d, o);
    if (lane == 0) act[e] = 0.5f * d * (1.0f + erff(d * 0.7071067811865476f)) * gg[r * 128 + e];
  }
  __syncthreads();
  float4 y0 = make_float4(0.f, 0.f, 0.f, 0.f), y1 = y0;
  for (int e = 0; e < 128; ++e) {
    const float a = act[e]; const float4* vp = (const float4*)(V + (size_t)eid[e] * 2048);
    const float4 v0 = vp[tid], v1 = vp[256 + tid];
    y0.x += a * v0.x; y0.y += a * v0.y; y0.z += a * v0.z; y0.w += a * v0.w;
    y1.x += a * v1.x; y1.y += a * v1.y; y1.z += a * v1.z; y1.w += a * v1.w;
  }
  const float4* hp = (const float4*)(h1 + r * 2048); float4* op = (float4*)(out + (size_t)tok * 2048);
  float4 a0 = hp[tid], a1 = hp[256 + tid];
  a0.x += y0.x; a0.y += y0.y; a0.z += y0.z; a0.w += y0.w; a1.x += y1.x; a1.y += y1.y; a1.z += y1.z; a1.w += y1.w;
  op[tid] = a0; op[256 + tid] = a1;
}
}

extern "C" void kernel_launch(void* const* d_in, const int* in_sizes, int n_in, void* d_out, int out_size, void* d_ws, size_t ws_size, hipStream_t stream) {
  using namespace nv;
  const float* x = (const float*)d_in[0]; const float* meta = (const float*)d_in[1]; const float* norm1_g = (const float*)d_in[2];
  const float* w_in = (const float*)d_in[3]; const float* conv_w = (const float*)d_in[4]; const float* conv_b = (const float*)d_in[5];
  const float* igb = (const float*)d_in[6]; const float* fgb = (const float*)d_in[7];
  const float* lq1 = (const float*)d_in[8]; const float* lk1 = (const float*)d_in[9]; const float* lq2 = (const float*)d_in[10]; const float* lk2 = (const float*)d_in[11];
  const float* qng = (const float*)d_in[12]; const float* kng = (const float*)d_in[13]; const float* subg = (const float*)d_in[14]; const float* outg = (const float*)d_in[15];
  const float* w_out = (const float*)d_in[16]; const float* norm2_g = (const float*)d_in[17]; const float* wq = (const float*)d_in[18]; const float* subkeys = (const float*)d_in[19];
  const float* U = (const float*)d_in[20]; const float* V = (const float*)d_in[21];
  float* out = (float*)d_out;
  float* ws = (float*)d_ws;
  size_t off = 0;
  auto take = [&](size_t nfl) { float* p = ws + off; off += (nfl + 63) / 64 * 64; return p; };
  float* h0 = take((size_t)NROW * DM);
  float* xn = take((size_t)NROW * DM);
  float* proj = take((size_t)NROW * DPROJ);
  float* ao = take((size_t)NROW * 1024);
  float* mqk = take((size_t)NROW * 1024);
  float* hm = take((size_t)NROW * 1024);
  float* lam = take(64);
  int* ridx = (int*)take((size_t)NROW * 128);
  float* rg = take((size_t)NROW * 128);
  if (off * 4 > ws_size) { fprintf(stderr, "ws too small: need %zu have %zu\n", off * 4, ws_size); return; }
  float* qn = xn;
  float* kn = xn + (size_t)NROW * 1024;
  float* A2 = xn;
  float* pq = proj;
  k_cat_norm<<<NROW, 256, 0, stream>>>(x, meta, norm1_g, h0, xn);
  k_lam<<<1, 256, 0, stream>>>(lq1, lk1, lq2, lk2, lam);
  k_gemm<<<dim3((DPROJ + 127) / 128, (NROW + 127) / 128), 256, 0, stream>>>(xn, DM, w_in, DPROJ, proj, DPROJ, nullptr, 0, NROW, DPROJ, DM);
  k_qknorm<<<NROW * 4, 256, 0, stream>>>(proj, qng, kng, qn, kn);
  k_attn<<<dim3(TT, 4, NB), 256, 0, stream>>>(qn, kn, proj, lam, subg, ao);
  k_conv<<<NROW * 4, 256, 0, stream>>>(proj, conv_w, conv_b, mqk);
  k_mlstm<<<16, 512, 0, stream>>>(proj, mqk, igb, fgb, hm);
  k_mix<<<NROW, 256, 0, stream>>>(ao, hm, proj, outg, A2);
  k_gemm<<<dim3(DM / 128, (NROW + 127) / 128), 256, 0, stream>>>(A2, DM, w_out, DM, h0, DM, h0, DM, NROW, DM, DM);
  k_norm<<<NROW, 256, 0, stream>>>(h0, norm2_g, xn);
  k_gemm<<<dim3(DM / 128, (NROW + 127) / 128), 256, 0, stream>>>(xn, DM, wq, DM, pq, DM, nullptr, 0, NROW, DM, DM);
  k_route<<<NROW, 256, 0, stream>>>(pq, subkeys, ridx, rg);
  k_peer<<<NB * SEQ, 256, 0, stream>>>(xn, h0, ridx, rg, U, V, out);
}
```

```cpp
#include <hip/hip_runtime.h>
#include <cstdio>
#include <cstdint>
#include <math.h>
namespace pg8 {
#define PG8_LAS __attribute__((address_space(3)))
typedef unsigned short bf16_t;
typedef short bf16x8 __attribute__((ext_vector_type(8)));
typedef float f32x4 __attribute__((ext_vector_type(4)));
typedef unsigned u32x4 __attribute__((ext_vector_type(4)));
constexpr int BM = 256, BK = 64, HALF = 128, HTB = HALF * BK * 2  , STAGE_BYTES = 8 * HTB, NXCD = 8, WGM = 8;

__host__ __device__ __forceinline__ int lds_byte(int r, int c) { const int st = (r >> 4) * 2 + (c >> 5), rr = r & 15, cc = c & 31, ob = rr * 64 + cc * 2; return st * 1024 + (ob ^ (((ob >> 9) & 1) << 5)); }
__host__ __device__ __forceinline__ void stage_rc(int b, int& R, int& C) { const int st = b / 1024, sb = b % 1024, swz = sb ^ (((sb >> 9) & 1) << 5); R = (st >> 1) * 16 + swz / 64; C = (st & 1) * 32 + (swz % 64) / 2; }
__host__ __device__ __forceinline__ int perm32(int rho) { const int n = rho >> 4, i = rho & 15; return 8 * (i >> 2) + 4 * n + (i & 3); }

struct Unit { int pm, pn; };
struct Gemm { const bf16_t* A; const bf16_t* Bt; int M, N, K; };

struct StaticOrder {
    int nM, nN, nwg, G, c;
    __host__ __device__ void init(int M, int N, int G_, int c_) { nM = M / BM; nN = N / BM; nwg = nM * nN; G = G_; c = c_; }
    __host__ __device__ bool next(int i, Unit& u) const {
        const long L = (long)i * G + c; if (L >= nwg) return false;
        int wgid = (int)L; { const int q = nwg / NXCD, r = nwg % NXCD, xcd = wgid % NXCD, off = wgid / NXCD; wgid = (xcd < r ? xcd * (q + 1) : r * (q + 1) + (xcd - r) * q) + off; }
        const int nig = WGM * nN, gid = wgid / nig, fm = gid * WGM, gsz = (nM - fm) < WGM ? (nM - fm) : WGM;
        u.pm = fm + ((wgid % nig) % gsz); u.pn = (wgid % nig) / gsz; return true;
    }
    __device__ __forceinline__ void a_ready(const Unit&) const {}
    __device__ __forceinline__ void done(const Unit&) const {}
};

__device__ __forceinline__ unsigned cvt_pk_bf16(float lo, float hi) { unsigned r; asm volatile("v_cvt_pk_bf16_f32 %0, %1, %2" : "=v"(r) : "v"(lo), "v"(hi)); return r; }
typedef float f32x2 __attribute__((ext_vector_type(2)));
template <class Epi, class Sched, bool ALIGN_EPI = false, bool SP2 = false>
__device__ __forceinline__ void gemm_phase(PG8_LAS unsigned char* lds, const Gemm g, const Sched& S, const Epi& E) {
    const int tid = threadIdx.x, wid = __builtin_amdgcn_readfirstlane(tid >> 6), lane = tid & 63, wr = wid >> 2, wc = wid & 3, fr = lane & 15, fq = lane >> 4;
    const int K = g.K, nt = K / BK;
    unsigned voffA[2], voffB[2];
#pragma unroll
    for (int i = 0; i < 2; ++i) { int R, C; stage_rc(tid * 16 + i * 8192, R, C); const int Rb = Epi::PERM ? ((R & ~31) + perm32(R & 31)) : R;
        voffA[i] = (unsigned)(R * K + C) * 2u; voffB[i] = (unsigned)(Rb * K + C) * 2u; }
    const size_t kstep = (size_t)(BK * 2);
    const size_t hstep = (size_t)HALF * K * 2;
    const size_t tstep = 2 * hstep;
    const unsigned ldsw = (unsigned)wid * 1024u;
    const int aoff = lds_byte(wr * 64 + fr, fq * 8), boff = lds_byte(wc * 32 + fr, fq * 8);
#define PG8_SA(b, h) (((b) * 2 + (h)) * HTB)
#define PG8_SB(b, h) ((4 + (b) * 2 + (h)) * HTB)
#define PG8_STAGE(bufoff, gbase, voff) do { _Pragma("unroll") for (int _i = 0; _i < 2; ++_i) \
        __builtin_amdgcn_global_load_lds((const unsigned*)((const char*)(gbase) + (voff)[_i]), (PG8_LAS unsigned*)(lds + (bufoff) + ldsw + _i * 8192), 16, 0, 0); } while (0)
#define PG8_LDA(dst, b, h) do { _Pragma("unroll") for (int m = 0; m < 4; ++m) _Pragma("unroll") for (int k = 0; k < 2; ++k) dst[m][k] = *(const PG8_LAS bf16x8*)(lds + PG8_SA(b, h) + aoff + m * 2048 + k * 1024); } while (0)
#define PG8_LDB(dst, b, h) do { _Pragma("unroll") for (int n = 0; n < 2; ++n) _Pragma("unroll") for (int k = 0; k < 2; ++k) dst[n][k] = *(const PG8_LAS bf16x8*)(lds + PG8_SB(b, h) + boff + n * 2048 + k * 1024); } while (0)
#define PG8_MMA(ai, bj, At, Bt) do { __builtin_amdgcn_s_setprio(1); _Pragma("unroll") for (int m = 0; m < 4; ++m) _Pragma("unroll") for (int n = 0; n < 2; ++n) _Pragma("unroll") for (int k = 0; k < 2; ++k) \
        acc[ai][bj][m][n] = __builtin_amdgcn_mfma_f32_16x16x32_bf16(Bt[n][k], At[m][k], acc[ai][bj][m][n], 0, 0, 0); __builtin_amdgcn_s_setprio(0); } while (0)
#define PG8_WAIT_V(n) asm volatile("s_waitcnt vmcnt(" #n ")" ::: "memory")
#define PG8_WAIT_L(n) asm volatile("s_waitcnt lgkmcnt(" #n ")" ::: "memory")
#define PG8_BAR __builtin_amdgcn_s_barrier()
#define PG8_SCHED __builtin_amdgcn_sched_barrier(0)
    Unit cur, nxt; int ui = 0;
    if (!S.next(0, cur)) return;
    f32x4 acc[2][2][4][2];
#pragma unroll
    for (int a = 0; a < 2; ++a)
#pragma unroll
        for (int b = 0; b < 2; ++b)
#pragma unroll
            for (int m = 0; m < 4; ++m)
#pragma unroll
                for (int n = 0; n < 2; ++n) acc[a][b][m][n] = (f32x4){0.f, 0.f, 0.f, 0.f};
    bf16x8 At[4][2], B0[2][2], B1[2][2];
    const char* cA = (const char*)g.A + (size_t)cur.pm * tstep; const char* cB = (const char*)g.Bt + (size_t)cur.pn * tstep;
    S.a_ready(cur);
    if constexpr (SP2) {
        PG8_STAGE(PG8_SB(0, 0), cB, voffB); PG8_STAGE(PG8_SB(0, 1), cB + hstep, voffB); PG8_STAGE(PG8_SA(0, 0), cA, voffA); PG8_STAGE(PG8_SA(0, 1), cA + hstep, voffA);
        if (wr == 1) PG8_BAR;
        PG8_WAIT_V(2); PG8_BAR;
        PG8_STAGE(PG8_SB(1, 0), cB + kstep, voffB); PG8_STAGE(PG8_SA(1, 0), cA + kstep, voffA); PG8_STAGE(PG8_SB(1, 1), cB + hstep + kstep, voffB);
        PG8_WAIT_V(6); PG8_BAR;
    } else {
        PG8_STAGE(PG8_SB(0, 0), cB, voffB); PG8_STAGE(PG8_SA(0, 0), cA, voffA); PG8_STAGE(PG8_SB(0, 1), cB + hstep, voffB); PG8_STAGE(PG8_SA(0, 1), cA + hstep, voffA);
        if (wr == 1) PG8_BAR;
        PG8_WAIT_V(4); PG8_BAR;
        PG8_STAGE(PG8_SB(1, 0), cB + kstep, voffB); PG8_STAGE(PG8_SA(1, 0), cA + kstep, voffA); PG8_STAGE(PG8_SB(1, 1), cB + hstep + kstep, voffB);
        PG8_WAIT_V(6); PG8_BAR;
    }
    for (;;) {
        const bool has_next = S.next(ui + 1, nxt);
        const char* nA = has_next ? (const char*)g.A + (size_t)nxt.pm * tstep : cA; const char* nB = has_next ? (const char*)g.Bt + (size_t)nxt.pn * tstep : cB;
        for (int t = 0; t < nt; t += 2) {
            const bool last = (t == nt - 2);
            const char* a1 = cA + (size_t)(t + 1) * kstep;
            const char* a2 = last ? nA : cA + (size_t)(t + 2) * kstep; const char* b2 = last ? nB : cB + (size_t)(t + 2) * kstep;
            const char* a3 = a2 + kstep; const char* b3 = b2 + kstep;
            if (last && has_next) S.a_ready(nxt);
            if constexpr (SP2) {
            PG8_LDB(B0, 0, 0); PG8_LDB(B1, 0, 1); PG8_SCHED; PG8_LDA(At, 0, 0); PG8_STAGE(PG8_SA(1, 1), a1 + hstep, voffA);
            PG8_WAIT_V(8); PG8_WAIT_L(0); PG8_BAR; PG8_MMA(0, 0, At, B0); PG8_MMA(0, 1, At, B1); PG8_BAR; PG8_SCHED;
            PG8_LDA(At, 0, 1); PG8_STAGE(PG8_SB(0, 0), b2, voffB); PG8_STAGE(PG8_SB(0, 1), b2 + hstep, voffB); PG8_STAGE(PG8_SA(0, 0), a2, voffA);
            PG8_WAIT_V(8); PG8_WAIT_L(0); PG8_BAR; PG8_MMA(1, 0, At, B0); PG8_MMA(1, 1, At, B1); PG8_BAR; PG8_SCHED;
            PG8_LDB(B0, 1, 0); PG8_LDB(B1, 1, 1); PG8_SCHED; PG8_LDA(At, 1, 0); PG8_STAGE(PG8_SA(0, 1), a2 + hstep, voffA);
            PG8_WAIT_V(8); PG8_WAIT_L(0); PG8_BAR; PG8_MMA(0, 0, At, B0); PG8_MMA(0, 1, At, B1); PG8_BAR; PG8_SCHED;
            PG8_LDA(At, 1, 1); PG8_STAGE(PG8_SB(1, 0), b3, voffB); PG8_STAGE(PG8_SB(1, 1), b3 + hstep, voffB); PG8_STAGE(PG8_SA(1, 0), a3, voffA);
            PG8_WAIT_V(8); PG8_WAIT_L(0); PG8_BAR; PG8_MMA(1, 0, At, B0); PG8_MMA(1, 1, At, B1); PG8_BAR; PG8_SCHED;
            } else {
            PG8_LDB(B0, 0, 0); PG8_SCHED; PG8_LDA(At, 0, 0); PG8_STAGE(PG8_SA(1, 1), a1 + hstep, voffA);
            PG8_WAIT_L(8); PG8_BAR; PG8_WAIT_L(0); PG8_MMA(0, 0, At, B0); PG8_BAR; PG8_SCHED;
            PG8_LDB(B1, 0, 1); PG8_STAGE(PG8_SB(0, 0), b2, voffB);
            PG8_BAR; PG8_WAIT_L(0); PG8_MMA(0, 1, At, B1); PG8_BAR;
            PG8_LDA(At, 0, 1); PG8_STAGE(PG8_SA(0, 0), a2, voffA);
            PG8_BAR; PG8_WAIT_L(0); PG8_MMA(1, 0, At, B0); PG8_BAR; PG8_SCHED;
            PG8_STAGE(PG8_SB(0, 1), b2 + hstep, voffB);
            PG8_WAIT_V(6); PG8_BAR; PG8_MMA(1, 1, At, B1); PG8_BAR;
            PG8_LDB(B0, 1, 0); PG8_SCHED; PG8_LDA(At, 1, 0); PG8_STAGE(PG8_SA(0, 1), a2 + hstep, voffA);
            PG8_WAIT_L(8); PG8_BAR; PG8_WAIT_L(0); PG8_MMA(0, 0, At, B0); PG8_BAR; PG8_SCHED;
            PG8_LDB(B1, 1, 1); PG8_STAGE(PG8_SB(1, 0), b3, voffB);
            PG8_BAR; PG8_WAIT_L(0); PG8_MMA(0, 1, At, B1); PG8_BAR;
            PG8_LDA(At, 1, 1); PG8_STAGE(PG8_SA(1, 0), a3, voffA);
            PG8_BAR; PG8_WAIT_L(0); PG8_MMA(1, 0, At, B0); PG8_BAR; PG8_SCHED;
            PG8_STAGE(PG8_SB(1, 1), b3 + hstep, voffB);
            PG8_WAIT_V(6); PG8_BAR; PG8_MMA(1, 1, At, B1); PG8_BAR;
            }
        }
        if constexpr (ALIGN_EPI) { if (wr == 0) PG8_BAR; }
        if constexpr (!Epi::AFTER_DRAIN) { E(acc, cur, wr, wc, fr, fq); S.done(cur); }
        if (!has_next) break;
#pragma unroll
        for (int a = 0; a < 2; ++a)
#pragma unroll
            for (int b = 0; b < 2; ++b)
#pragma unroll
                for (int m = 0; m < 4; ++m)
#pragma unroll
                    for (int n = 0; n < 2; ++n) acc[a][b][m][n] = (f32x4){0.f, 0.f, 0.f, 0.f};
        cur = nxt; cA = nA; cB = nB; ++ui;
        if constexpr (ALIGN_EPI) { if (wr == 1) PG8_BAR; }
    }
    PG8_WAIT_V(0);
    if constexpr (!ALIGN_EPI) { if (wr == 0) PG8_BAR; }
    PG8_BAR;
    if constexpr (Epi::AFTER_DRAIN) { E.fused(acc, cur, wr, wc, fr, fq, lds, wid, lane); S.done(cur); }
#undef PG8_SA
#undef PG8_SB
#undef PG8_STAGE
#undef PG8_LDA
#undef PG8_LDB
#undef PG8_MMA
#undef PG8_WAIT_V
#undef PG8_WAIT_L
#undef PG8_BAR
#undef PG8_SCHED
}
}
#define GAS __attribute__((address_space(1)))
#define LAS __attribute__((address_space(3)))
typedef unsigned short bf16;
typedef unsigned v4u __attribute__((ext_vector_type(4)));
typedef unsigned v2u __attribute__((ext_vector_type(2)));
typedef float f32x4 __attribute__((ext_vector_type(4)));
typedef short bf16x8 __attribute__((ext_vector_type(8)));
#define LDS_WAIT() asm volatile("s_waitcnt lgkmcnt(0)" ::: "memory")
#define VM_WAIT() asm volatile("s_waitcnt vmcnt(0)" ::: "memory")

constexpr int DM = 2048, NB = 4, SEQ = 2048, NMETA = 16, MROWS = NB * SEQ, DPROJ = 6152, NPROJ = 6144;
constexpr int PADT = 2112, POS0 = 64, MPOS0 = 48;
constexpr float EPS = 1e-6f;
constexpr float LOG2E = 1.4426950408889634f;
constexpr float QSCALE = 0.08838834764831845f * LOG2E;
constexpr int NWAVES = 8, NTHR = 512;

constexpr size_t MiB = 1u << 20;
constexpr size_t WS_CTL = 0, CTL_ZERO_BYTES = 1 * MiB;
constexpr size_t WS_PM = 512 * 1024;
constexpr size_t WS_W1T = 2 * MiB, WS_W2T = 26 * MiB, WS_W3T = 34 * MiB, WS_XN = 42 * MiB;
constexpr size_t WS_Q = 74 * MiB, WS_KP = 90 * MiB, WS_VP = 107 * MiB, WS_MQ = 124 * MiB, WS_MK = 133 * MiB, WS_MV = 142 * MiB, WS_MO = 159 * MiB;
constexpr size_t WS_SMALL = 175 * MiB;
constexpr size_t WS_XM = WS_SMALL, WS_LI = WS_SMALL + 128 * 1024, WS_LF = WS_SMALL + 384 * 1024, WS_LAM = WS_SMALL + 640 * 1024;
constexpr int CW_BAR = 4096;

constexpr int RING_OFF = 0, RING_BYTES = 131072;
constexpr int XCH_OFF = 131072;
constexpr int MISC_OFF = XCH_OFF + 8192;
constexpr int LDS_BYTES = 147456;

__device__ __forceinline__ unsigned f2bf(float f) { unsigned u = __builtin_bit_cast(unsigned, f); return (u + 0x7fffu + ((u >> 16) & 1u)) >> 16; }
__device__ __forceinline__ unsigned pk2(float lo, float hi) { return f2bf(lo) | (f2bf(hi) << 16); }
__device__ __forceinline__ float bf2f(unsigned short u) { return __builtin_bit_cast(float, (unsigned)u << 16); }
__device__ __forceinline__ float bflo(unsigned w) { return __builtin_bit_cast(float, w << 16); }
__device__ __forceinline__ float bfhi(unsigned w) { return __builtin_bit_cast(float, w & 0xffff0000u); }
__device__ __forceinline__ float wave_sum(float v) {
#pragma unroll
  for (int o = 1; o < 64; o <<= 1) v += __shfl_xor(v, o);
  return v;
}
__device__ __forceinline__ float sigmoidf_(float x) { return 1.0f / (1.0f + __expf(-x)); }
struct Args { const float* in[22]; float* out; unsigned char* ws; int ph_lo, ph_hi; };
struct Frame {
  LAS unsigned char* lds; unsigned char* ws; int tid, lane, wave; const float* const* in;
};
#define IN_X 0
#define IN_META 1
#define IN_G1 2
#define IN_WIN 3
#define IN_CW 4
#define IN_CB 5
#define IN_IGB 6
#define IN_FGB 7
#define IN_LQ1 8
#define IN_LK1 9
#define IN_LQ2 10
#define IN_LK2 11
#define IN_QNG 12
#define IN_KNG 13
#define IN_SUBG 14
#define IN_OUTG 15
#define IN_WOUT 16
#define IN_G2 17
#define IN_WQ 18
#define IN_SUBK 19
#define IN_U 20
#define IN_V 21

__device__ __forceinline__ void p0_rows(const Frame& F, const Args& a) {
  const float* x = a.in[IN_X]; const float* meta = a.in[IN_META]; const float* g1 = a.in[IN_G1]; const float* w_in = a.in[IN_WIN];
  const float* igb = a.in[IN_IGB]; const float* fgb = a.in[IN_FGB];
  bf16* Xn = (bf16*)(F.ws + WS_XN); bf16* Xm = (bf16*)(F.ws + WS_XM); float* LI = (float*)(F.ws + WS_LI); float* LF = (float*)(F.ws + WS_LF);
  LAS f32x4* wgl = (LAS f32x4*)(F.lds);
  for (int e = F.tid; e < 4096; e += NTHR) {
    const int ln = e & 63, q = e >> 6, half = q & 1, j = (q >> 1) & 3, i = q >> 3;
    const int k = 4 * (i * 64 + ln) + j;
    wgl[e] = *(const f32x4*)(w_in + (size_t)k * DPROJ + NPROJ + 4 * half);
  }
  __syncthreads();
  const int gw = blockIdx.x * NWAVES + F.wave, NGW = gridDim.x * NWAVES, lane = F.lane;
  for (int task = gw; task < MROWS / 2 + NMETA / 2; task += NGW) {
    const bool ismeta = task >= MROWS / 2;
    const int r0 = ismeta ? (task - MROWS / 2) * 2 : task * 2;
    const float* src0 = (ismeta ? meta : x) + (size_t)r0 * DM;
    float rs[2];
    { float s0 = 0.f, s1 = 0.f;
#pragma unroll 2
      for (int i = 0; i < 8; ++i) { const f32x4 a0 = ((const f32x4*)src0)[i * 64 + lane], a1 = ((const f32x4*)(src0 + DM))[i * 64 + lane];
        s0 += (a0.x * a0.x + a0.y * a0.y) + (a0.z * a0.z + a0.w * a0.w); s1 += (a1.x * a1.x + a1.y * a1.y) + (a1.z * a1.z + a1.w * a1.w); }
      rs[0] = rsqrtf(wave_sum(s0) * (1.0f / DM) + EPS); rs[1] = rsqrtf(wave_sum(s1) * (1.0f / DM) + EPS); }
    float ga[2][8];
#pragma unroll
    for (int rr = 0; rr < 2; ++rr)
#pragma unroll
      for (int g = 0; g < 8; ++g) ga[rr][g] = 0.f;
    bf16* dst0 = (ismeta ? Xm : Xn) + (size_t)r0 * DM;
#pragma unroll 1
    for (int i = 0; i < 8; ++i) {
      const f32x4 g = ((const f32x4*)g1)[i * 64 + lane];
      f32x4 xn[2];
#pragma unroll
      for (int rr = 0; rr < 2; ++rr) { xn[rr] = ((const f32x4*)(src0 + (size_t)rr * DM))[i * 64 + lane] * g * rs[rr];
        v2u o; o.x = pk2(xn[rr].x, xn[rr].y); o.y = pk2(xn[rr].z, xn[rr].w); ((v2u*)(dst0 + (size_t)rr * DM))[i * 64 + lane] = o; }
#pragma unroll
      for (int j = 0; j < 4; ++j) {
        const f32x4 w0 = wgl[((i * 4 + j) * 2 + 0) * 64 + lane], w1 = wgl[((i * 4 + j) * 2 + 1) * 64 + lane];
#pragma unroll
        for (int rr = 0; rr < 2; ++rr) { const float xv = xn[rr][j];
          ga[rr][0] += xv * w0.x; ga[rr][1] += xv * w0.y; ga[rr][2] += xv * w0.z; ga[rr][3] += xv * w0.w;
          ga[rr][4] += xv * w1.x; ga[rr][5] += xv * w1.y; ga[rr][6] += xv * w1.z; ga[rr][7] += xv * w1.w; }
      }
    }
#pragma unroll
    for (int rr = 0; rr < 2; ++rr)
#pragma unroll
      for (int g = 0; g < 8; ++g) ga[rr][g] = wave_sum(ga[rr][g]);
    if (lane < 8) {
      const int rr = lane >> 2, h = lane & 3;
      float gi = 0.f, gf = 0.f;
#pragma unroll
      for (int q = 0; q < 2; ++q)
#pragma unroll
        for (int hh = 0; hh < 4; ++hh) if (q == rr && hh == h) { gi = ga[q][hh]; gf = ga[q][4 + hh]; }
      const float li = gi + igb[h]; const float fx = gf + fgb[h];
      const float lf = fminf(fx, 0.f) - log1pf(__expf(-fabsf(fx)));
      const int R = r0 + rr;
      if (!ismeta) { const int b = R >> 11, t = R & 2047; LI[(b * 4 + h) * PADT + POS0 + t] = li; LF[(b * 4 + h) * PADT + POS0 + t] = lf; }
      else { for (int b = 0; b < NB; ++b) { LI[(b * 4 + h) * PADT + MPOS0 + R] = li; LF[(b * 4 + h) * PADT + MPOS0 + R] = lf; } }
    }
  }
  __syncthreads();
}
__device__ __forceinline__ void p0_metaproj(const Frame& F, const Args& a) {
  const float* meta = a.in[IN_META]; const float* g1 = a.in[IN_G1]; const float* w_in = a.in[IN_WIN];
  float* PM = (float*)(F.ws + WS_PM);
  LAS float* xs = (LAS float*)(F.lds);
  for (int task = blockIdx.x; task < 12 * 16; task += gridDim.x) {
    const int nr = task % 12, kc = task / 12, n0 = nr * 512, k0 = kc * 128;
    __syncthreads();
#pragma unroll
    for (int i = 0; i < 4; ++i) { const int idx = F.tid + NTHR * i, kk = idx >> 4, m = idx & 15; xs[idx] = meta[(size_t)m * DM + k0 + kk] * g1[k0 + kk]; }
    __syncthreads();
    const int n = n0 + F.tid;
    float acc[16];
#pragma unroll
    for (int m = 0; m < 16; ++m) acc[m] = 0.f;
#pragma unroll 4
    for (int kk = 0; kk < 128; ++kk) {
      const float w = w_in[(size_t)(k0 + kk) * DPROJ + n];
      const LAS f32x4* xp = (const LAS f32x4*)(xs + kk * 16);
#pragma unroll
      for (int q = 0; q < 4; ++q) { const f32x4 xv = xp[q]; acc[4 * q + 0] += xv.x * w; acc[4 * q + 1] += xv.y * w; acc[4 * q + 2] += xv.z * w; acc[4 * q + 3] += xv.w * w; }
    }
#pragma unroll
    for (int m = 0; m < 16; ++m) atomicAdd(&PM[m * NPROJ + n], acc[m]);
  }
  __syncthreads();
}
__device__ __forceinline__ void p0_transpose(const Frame& F, const float* W, int ldw, int N, bf16* Wt) {
  LAS float* tl = (LAS float*)(F.lds);
  const int ntn = N / 64, ntask = ntn * 16;
  for (int task = blockIdx.x; task < ntask; task += gridDim.x) {
    const int nb = task % ntn, kb = task / ntn, n0 = nb * 64, k0 = kb * 128;
    __syncthreads();
#pragma unroll
    for (int i = 0; i < 4; ++i) { const int idx = F.tid + NTHR * i, kk = idx >> 4, c4 = idx & 15;
      const f32x4 w = *(const f32x4*)(W + (size_t)(k0 + kk) * ldw + n0 + 4 * c4);
      LAS float* d = tl + kk * 65 + 4 * c4; d[0] = w.x; d[1] = w.y; d[2] = w.z; d[3] = w.w; }
    __syncthreads();
    const int n = F.tid >> 3, kc = F.tid & 7;
    const LAS float* s = tl + (kc * 16) * 65 + n;
    v4u o0, o1;
    o0.x = pk2(s[0 * 65], s[1 * 65]); o0.y = pk2(s[2 * 65], s[3 * 65]); o0.z = pk2(s[4 * 65], s[5 * 65]); o0.w = pk2(s[6 * 65], s[7 * 65]);
    o1.x = pk2(s[8 * 65], s[9 * 65]); o1.y = pk2(s[10 * 65], s[11 * 65]); o1.z = pk2(s[12 * 65], s[13 * 65]); o1.w = pk2(s[14 * 65], s[15 * 65]);
    v4u* dp = (v4u*)(Wt + (size_t)(n0 + n) * DM + k0 + kc * 16);
    dp[0] = o0; dp[1] = o1;
  }
  __syncthreads();
}
__device__ __forceinline__ void p0_lam(const Frame& F, const Args& a) {
  if (blockIdx.x == 0 && F.wave == 0) {
    const int l = F.lane;
    float s1 = a.in[IN_LQ1][l] * a.in[IN_LK1][l] + a.in[IN_LQ1][l + 64] * a.in[IN_LK1][l + 64];
    float s2 = a.in[IN_LQ2][l] * a.in[IN_LK2][l] + a.in[IN_LQ2][l + 64] * a.in[IN_LK2][l + 64];
    s1 = wave_sum(s1); s2 = wave_sum(s2);
    if (l == 0) *(float*)(F.ws + WS_LAM) = __expf(s1) - __expf(s2) + 0.2f;
  }
}

struct EpiProj {
  static constexpr bool PERM = true, AFTER_DRAIN = false;
  bf16 *Qb, *Kp, *Vp, *MQ, *MK, *MV, *MO; const float *qg, *kg; LAS float* xch;
  __device__ __forceinline__ void operator()(const pg8::f32x4 (&acc)[2][2][4][2], const pg8::Unit& u, int wr, int wc, int fr, int fq) const {
    const int pn = u.pn, b = u.pm >> 3, tb = (u.pm & 7) * 256 + wr * 64 + fr, d0 = wc * 32 + fq * 8;
    if (pn < 8) {
      const bool isk = pn >= 4; const int h = pn & 3;
      float ssq[2][4][2];
#pragma unroll
      for (int ai = 0; ai < 2; ++ai)
#pragma unroll
        for (int m = 0; m < 4; ++m)
#pragma unroll
          for (int bj = 0; bj < 2; ++bj) { float s = 0.f;
#pragma unroll
            for (int n = 0; n < 2; ++n) { const pg8::f32x4 x = acc[ai][bj][m][n]; s += (x[0] * x[0] + x[1] * x[1]) + (x[2] * x[2] + x[3] * x[3]); }
            s += __shfl_xor(s, 16); s += __shfl_xor(s, 32); ssq[ai][m][bj] = s;
            if (fq == 0) xch[((ai * 128 + wr * 64 + m * 16 + fr) * 2 + bj) * 4 + wc] = s; }
      asm volatile("s_waitcnt lgkmcnt(0)" ::: "memory"); __builtin_amdgcn_s_barrier(); asm volatile("" ::: "memory");
      const float* gp = (isk ? kg : qg) + d0; const f32x4 g0 = *(const f32x4*)gp, g1v = *(const f32x4*)(gp + 4);
      const float sc = isk ? 1.0f : QSCALE;
#pragma unroll
      for (int ai = 0; ai < 2; ++ai)
#pragma unroll
        for (int m = 0; m < 4; ++m)
#pragma unroll
          for (int bj = 0; bj < 2; ++bj) {
            const f32x4 p = *(const LAS f32x4*)(xch + ((ai * 128 + wr * 64 + m * 16 + fr) * 2 + bj) * 4);
            const float rs = rsqrtf(((p.x + p.y) + (p.z + p.w)) * (1.0f / 128.f) + EPS) * sc;
            const pg8::f32x4 v0 = acc[ai][bj][m][0], v1 = acc[ai][bj][m][1];
            v4u w; w.x = pk2(v0[0] * rs * g0.x, v0[1] * rs * g0.y); w.y = pk2(v0[2] * rs * g0.z, v0[3] * rs * g0.w);
            w.z = pk2(v1[0] * rs * g1v.x, v1[1] * rs * g1v.y); w.w = pk2(v1[2] * rs * g1v.z, v1[3] * rs * g1v.w);
            const int t = tb + ai * 128 + m * 16;
            bf16* dst = isk ? Kp + ((size_t)((b * 4 + h) * 2 + bj) * PADT + POS0 + t) * 128 + d0
                            : Qb + ((size_t)((b * 4 + h) * 2 + bj) * SEQ + t) * 128 + d0;
            *(v4u*)dst = w; }
      return;
    }
#pragma unroll
    for (int ai = 0; ai < 2; ++ai)
#pragma unroll
      for (int m = 0; m < 4; ++m)
#pragma unroll
        for (int bj = 0; bj < 2; ++bj) {
          pg8::f32x4 v0 = acc[ai][bj][m][0], v1 = acc[ai][bj][m][1];
          const int t = tb + ai * 128 + m * 16;
          bf16* dst;
          if (pn < 12) { const int h = pn - 8; dst = Vp + ((size_t)(b * 4 + h) * PADT + POS0 + t) * 256 + bj * 128 + d0; }
          else if (pn < 16) { const int h = 2 * (pn & 1) + bj; dst = (pn >= 14 ? MK : MQ) + ((size_t)(b * 4 + h) * PADT + POS0 + t) * 128 + d0; }
          else if (pn < 20) { const int h = pn - 16; dst = MV + ((size_t)(b * 4 + h) * PADT + POS0 + t) * 256 + bj * 128 + d0; }
          else { dst = MO + (size_t)(b * SEQ + t) * 1024 + (pn - 20) * 256 + bj * 128 + d0;
#pragma unroll
            for (int j = 0; j < 4; ++j) { v0[j] = sigmoidf_(v0[j]); v1[j] = sigmoidf_(v1[j]); } }
          v4u w; w.x = pk2(v0[0], v0[1]); w.y = pk2(v0[2], v0[3]); w.z = pk2(v1[0], v1[1]); w.w = pk2(v1[2], v1[3]);
          *(v4u*)dst = w; }
  }
};
__device__ __forceinline__ void p1_meta_finalize(const Frame& F, const Args& a) {
  if (blockIdx.x >= NMETA) return;
  const int mrow = blockIdx.x, tid = F.tid, lane = F.lane, w = F.wave;
  const float* meta = a.in[IN_META] + (size_t)mrow * DM; const float* PM = (const float*)(F.ws + WS_PM) + (size_t)mrow * NPROJ;
  LAS float* red = (LAS float*)(F.lds + XCH_OFF);
  const f32x4 mv = ((const f32x4*)meta)[tid];
  float s = wave_sum((mv.x * mv.x + mv.y * mv.y) + (mv.z * mv.z + mv.w * mv.w));
  if (lane == 0) red[w] = s;
  __syncthreads();
  float tot = 0.f;
#pragma unroll
  for (int i = 0; i < 8; ++i) tot += red[i];
  const float rs = rsqrtf(tot * (1.0f / DM) + EPS);
  bf16* Kp = (bf16*)(F.ws + WS_KP); bf16* Vp = (bf16*)(F.ws + WS_VP); bf16* MQ = (bf16*)(F.ws + WS_MQ); bf16* MK = (bf16*)(F.ws + WS_MK); bf16* MV = (bf16*)(F.ws + WS_MV);
  const int pos = MPOS0 + mrow;
  {
    const float v0 = PM[1024 + w * 128 + lane] * rs, v1 = PM[1024 + w * 128 + lane + 64] * rs;
    const float rk = rsqrtf(wave_sum(v0 * v0 + v1 * v1) * (1.0f / 128.f) + EPS);
    const float* kg = a.in[IN_KNG];
    const unsigned short o0 = (unsigned short)f2bf(v0 * rk * kg[lane]), o1 = (unsigned short)f2bf(v1 * rk * kg[lane + 64]);
    for (int b = 0; b < NB; ++b) { bf16* d = Kp + ((size_t)((b * 4 + (w >> 1)) * 2 + (w & 1)) * PADT + pos) * 128; d[lane] = o0; d[lane + 64] = o1; }
  }
  { const int c = tid * 2;
    const unsigned o = pk2(PM[2048 + c] * rs, PM[2048 + c + 1] * rs); const int h = c >> 8, e = c & 255;
    for (int b = 0; b < NB; ++b) *(unsigned*)(Vp + ((size_t)(b * 4 + h) * PADT + pos) * 256 + e) = o;
    const unsigned o2 = pk2(PM[3072 + c] * rs, PM[3072 + c + 1] * rs); const bool isk = c >= 512; const int cc = c & 511, hq = cc >> 7, d = cc & 127;
    for (int b = 0; b < NB; ++b) *(unsigned*)((isk ? MK : MQ) + ((size_t)(b * 4 + hq) * PADT + pos) * 128 + d) = o2;
    const unsigned o3 = pk2(PM[4096 + c] * rs, PM[4096 + c + 1] * rs);
    for (int b = 0; b < NB; ++b) *(unsigned*)(MV + ((size_t)(b * 4 + h) * PADT + pos) * 256 + e) = o3;
  }
  __syncthreads();
}

__global__ void __launch_bounds__(NTHR, 2) mk_fwd(Args args) {
  extern __shared__ __attribute__((aligned(16))) unsigned char lds_raw[];
  Frame F; F.lds = (LAS unsigned char*)lds_raw; F.ws = args.ws; F.tid = threadIdx.x; F.lane = F.tid & 63; F.wave = __builtin_amdgcn_readfirstlane(F.tid >> 6);
  const int lo = args.ph_lo, hi = args.ph_hi;
#define IN(k) (lo <= (k) && (k) < hi)
  if (IN(0)) {
    p0_lam(F, args);
    p0_metaproj(F, args);
    p0_rows(F, args);
    p0_transpose(F, args.in[IN_WIN], DPROJ, NPROJ, (bf16*)(F.ws + WS_W1T));
  }
  if (IN(1)) {
    p1_meta_finalize(F, args);
    pg8::Gemm g{(const pg8::bf16_t*)(F.ws + WS_XN), (const pg8::bf16_t*)(F.ws + WS_W1T), MROWS, NPROJ, DM};
    pg8::StaticOrder S; S.init(MROWS, NPROJ, (int)gridDim.x, (int)blockIdx.x);
    EpiProj E{(bf16*)(F.ws + WS_Q), (bf16*)(F.ws + WS_KP), (bf16*)(F.ws + WS_VP), (bf16*)(F.ws + WS_MQ), (bf16*)(F.ws + WS_MK), (bf16*)(F.ws + WS_MV), (bf16*)(F.ws + WS_MO),
              args.in[IN_QNG], args.in[IN_KNG], (LAS float*)(F.lds + XCH_OFF)};
    pg8::gemm_phase<EpiProj, pg8::StaticOrder, true, true>(F.lds + RING_OFF, g, S, E);
  }
#undef IN
}
namespace nv {
constexpr int TT = 2064;

__device__ __forceinline__ float block_sum(float v, float* red) {
  for (int o = 32; o > 0; o >>= 1) v += __shfl_xor(v, o);
  __syncthreads();
  if ((threadIdx.x & 63) == 0) red[threadIdx.x >> 6] = v;
  __syncthreads();
  return red[0] + red[1] + red[2] + red[3];
}
__device__ __forceinline__ float block_max(float v, float* red) {
  for (int o = 32; o > 0; o >>= 1) v = fmaxf(v, __shfl_xor(v, o));
  __syncthreads();
  if ((threadIdx.x & 63) == 0) red[threadIdx.x >> 6] = v;
  __syncthreads();
  return fmaxf(fmaxf(red[0], red[1]), fmaxf(red[2], red[3]));
}

__global__ __launch_bounds__(256) void k_norm(const float* __restrict__ h, const float* __restrict__ g, float* __restrict__ xn) {
  __shared__ float red[4];
  const int r = blockIdx.x, tid = threadIdx.x;
  float v[8]; float ss = 0.f;
#pragma unroll
  for (int i = 0; i < 8; ++i) { v[i] = h[(size_t)r * DM + tid + 256 * i]; ss += v[i] * v[i]; }
  ss = block_sum(ss, red);
  const float rs = rsqrtf(ss * (1.0f / DM) + EPS);
#pragma unroll
  for (int i = 0; i < 8; ++i) { const int c = tid + 256 * i; xn[(size_t)r * DM + c] = v[i] * rs * g[c]; }
}

__global__ __launch_bounds__(256) void k_gemm(const float* __restrict__ A, int lda, const float* __restrict__ B, int ldb,
                                               float* C, int ldc, const float* R, int ldr, int M, int N, int K) {
  __shared__ __attribute__((aligned(16))) unsigned short As[128][40];
  __shared__ __attribute__((aligned(16))) unsigned short Bs[128][40];
  const int tid = threadIdx.x, wid = tid >> 6, lane = tid & 63, wr = wid >> 1, wc = wid & 1, fr = lane & 15, fq = lane >> 4;
  const int m0 = blockIdx.y * 128, n0 = blockIdx.x * 128;
  f32x4 acc[4][4];
#pragma unroll
  for (int i = 0; i < 4; ++i)
#pragma unroll
    for (int j = 0; j < 4; ++j) acc[i][j] = (f32x4){0.f, 0.f, 0.f, 0.f};
  const int arow = tid >> 1, akk = (tid & 1) * 16;
  const int bk = tid >> 3, bn0 = (tid & 7) * 16;
  for (int k0 = 0; k0 < K; k0 += 32) {
    {
      float4 a[4];
      const bool ok = (m0 + arow) < M;
#pragma unroll
      for (int i = 0; i < 4; ++i) a[i] = ok ? *(const float4*)(A + (size_t)(m0 + arow) * lda + k0 + akk + 4 * i) : make_float4(0.f, 0.f, 0.f, 0.f);
#pragma unroll
      for (int i = 0; i < 4; ++i) { As[arow][akk + 4 * i + 0] = (unsigned short)f2bf(a[i].x); As[arow][akk + 4 * i + 1] = (unsigned short)f2bf(a[i].y); As[arow][akk + 4 * i + 2] = (unsigned short)f2bf(a[i].z); As[arow][akk + 4 * i + 3] = (unsigned short)f2bf(a[i].w); }
      float4 bv[4];
#pragma unroll
      for (int i = 0; i < 4; ++i) { const int n = n0 + bn0 + 4 * i; bv[i] = (n < N) ? *(const float4*)(B + (size_t)(k0 + bk) * ldb + n) : make_float4(0.f, 0.f, 0.f, 0.f); }
#pragma unroll
      for (int i = 0; i < 4; ++i) { Bs[bn0 + 4 * i + 0][bk] = (unsigned short)f2bf(bv[i].x); Bs[bn0 + 4 * i + 1][bk] = (unsigned short)f2bf(bv[i].y); Bs[bn0 + 4 * i + 2][bk] = (unsigned short)f2bf(bv[i].z); Bs[bn0 + 4 * i + 3][bk] = (unsigned short)f2bf(bv[i].w); }
    }
    __syncthreads();
    bf16x8 af[4], bfr[4];
#pragma unroll
    for (int i = 0; i < 4; ++i) af[i] = *(const bf16x8*)&As[wr * 64 + i * 16 + fr][fq * 8];
#pragma unroll
    for (int j = 0; j < 4; ++j) bfr[j] = *(const bf16x8*)&Bs[wc * 64 + j * 16 + fr][fq * 8];
#pragma unroll
    for (int i = 0; i < 4; ++i)
#pragma unroll
      for (int j = 0; j < 4; ++j) acc[i][j] = __builtin_amdgcn_mfma_f32_16x16x32_bf16(af[i], bfr[j], acc[i][j], 0, 0, 0);
    __syncthreads();
  }
#pragma unroll
  for (int i = 0; i < 4; ++i)
#pragma unroll
    for (int j = 0; j < 4; ++j)
#pragma unroll
      for (int e = 0; e < 4; ++e) {
        const int row = m0 + wr * 64 + i * 16 + fq * 4 + e, col = n0 + wc * 64 + j * 16 + fr;
        if (row < M && col < N) { float v = acc[i][j][e]; if (R) v += R[(size_t)row * ldr + col]; C[(size_t)row * ldc + col] = v; }
      }
}

__global__ __launch_bounds__(256) void k_route(const float* __restrict__ pq, const float* __restrict__ subkeys, int* __restrict__ oidx, float* __restrict__ og) {
  __shared__ __attribute__((aligned(16))) float qv[2048];
  __shared__ float s[2][128];
  __shared__ float sv[2][16]; __shared__ int si[2][16];
  __shared__ float cand[256]; __shared__ int cidx[256];
  __shared__ float tv[16]; __shared__ int ti[16];
  const size_t r = blockIdx.x; const int tid = threadIdx.x, lane = tid & 63, wid = tid >> 6;
  for (int i = tid; i < 2048; i += 256) qv[i] = pq[r * 2048 + i];
  __syncthreads();
  for (int hh = 0; hh < 8; ++hh) {
    { const int p = tid >> 7, k = tid & 127;
      const float4* sk = (const float4*)(subkeys + ((size_t)((hh * 2 + p) * 128 + k)) * 128);
      const float4* qq = (const float4*)(qv + hh * 256 + p * 128);
      float d = 0.f;
#pragma unroll 8
      for (int c = 0; c < 32; ++c) { const float4 a = sk[c], q4 = qq[c]; d += a.x * q4.x + a.y * q4.y + a.z * q4.z + a.w * q4.w; }
      s[p][k] = d; }
    __syncthreads();
    if (wid < 2) {
      const int p = wid; float v0 = s[p][lane], v1 = s[p][lane + 64];
      for (int it = 0; it < 16; ++it) {
        float bv = v0; int bi = lane; if (v1 > bv) { bv = v1; bi = lane + 64; }
        for (int o = 32; o > 0; o >>= 1) { const float ov = __shfl_xor(bv, o); const int oi = __shfl_xor(bi, o); if (ov > bv || (ov == bv && oi < bi)) { bv = ov; bi = oi; } }
        if (lane == 0) { sv[p][it] = bv; si[p][it] = bi; }
        if (bi == lane) v0 = -INFINITY; if (bi == lane + 64) v1 = -INFINITY;
      }
    }
    __syncthreads();
    { const int i = tid >> 4, j = tid & 15; cand[tid] = sv[0][i] + sv[1][j]; cidx[tid] = si[0][i] * 128 + si[1][j]; }
    __syncthreads();
    if (wid == 0) {
      float v[4]; for (int q = 0; q < 4; ++q) v[q] = cand[lane + 64 * q];
      for (int it = 0; it < 16; ++it) {
        float bv = v[0]; int bi = lane;
        for (int q = 1; q < 4; ++q) if (v[q] > bv) { bv = v[q]; bi = lane + 64 * q; }
        for (int o = 32; o > 0; o >>= 1) { const float ov = __shfl_xor(bv, o); const int oi = __shfl_xor(bi, o); if (ov > bv || (ov == bv && oi < bi)) { bv = ov; bi = oi; } }
        if (lane == 0) { tv[it] = bv; ti[it] = cidx[bi]; }
        for (int q = 0; q < 4; ++q) if (bi == lane + 64 * q) v[q] = -INFINITY;
      }
      const float mx = tv[0];
      float e = lane < 16 ? expf(tv[lane] - mx) : 0.f; float sm = e;
      for (int o = 32; o > 0; o >>= 1) sm += __shfl_xor(sm, o);
      if (lane < 16) { oidx[r * 128 + hh * 16 + lane] = ti[lane]; og[r * 128 + hh * 16 + lane] = e / sm; }
    }
    __syncthreads();
  }
}

__global__ __launch_bounds__(256) void k_attn2(const bf16* __restrict__ Qb, const bf16* __restrict__ Kp, const bf16* __restrict__ Vp,
                                                const float* __restrict__ lamp, const float* __restrict__ subg, float* __restrict__ ao) {
  __shared__ float sc[2][TT];
  __shared__ float qs[256];
  __shared__ float red[4];
  const int t = blockIdx.x, h = blockIdx.y, b = blockIdx.z, tid = threadIdx.x;
  const int cnt = t + 17;
  const float slope2 = exp2f(-2.0f * (h + 1)) * LOG2E;
  qs[tid] = bf2f(Qb[((size_t)((b * 4 + h) * 2 + (tid >> 7)) * SEQ + t) * 128 + (tid & 127)]);
  __syncthreads();
  float stat_l[2];
  for (int m = 0; m < 2; ++m) {
    float mx = -INFINITY;
    for (int s = tid; s < cnt; s += 256) {
      const v4u* kp = (const v4u*)(Kp + ((size_t)((b * 4 + h) * 2 + m) * PADT + MPOS0 + s) * 128);
      float d = 0.f;
#pragma unroll 4
      for (int i = 0; i < 16; ++i) { const v4u kk = kp[i]; const float* q = qs + m * 128 + i * 8;
        d += bflo(kk.x) * q[0] + bfhi(kk.x) * q[1] + bflo(kk.y) * q[2] + bfhi(kk.y) * q[3] + bflo(kk.z) * q[4] + bfhi(kk.z) * q[5] + bflo(kk.w) * q[6] + bfhi(kk.w) * q[7]; }
      d -= slope2 * (float)(cnt - 1 - s);
      sc[m][s] = d; mx = fmaxf(mx, d);
    }
    mx = block_max(mx, red);
    float sm = 0.f;
    for (int s = tid; s < cnt; s += 256) { const float e = exp2f(sc[m][s] - mx); sc[m][s] = e; sm += e; }
    sm = block_sum(sm, red);
    stat_l[m] = sm;
  }
  const float lam = lamp[0];
  const float i0 = 1.0f / stat_l[0], i1 = lam / stat_l[1];
  __syncthreads();
  for (int s = tid; s < cnt; s += 256) sc[0][s] = sc[0][s] * i0 - sc[1][s] * i1;
  __syncthreads();
  float o = 0.f;
  const bf16* vp = Vp + ((size_t)(b * 4 + h) * PADT + MPOS0) * 256 + tid;
  for (int s = 0; s < cnt; ++s) o += sc[0][s] * bf2f(vp[(size_t)s * 256]);
  float ss = block_sum(o * o, red);
  const float rs = rsqrtf(ss * (1.0f / 256.f) + EPS);
  ao[((size_t)b * SEQ + t) * 1024 + h * 256 + tid] = o * rs * subg[tid] * 0.8f;
}
__global__ __launch_bounds__(256) void k_conv2(const bf16* __restrict__ MQ, const bf16* __restrict__ MK, const float* __restrict__ cw, const float* __restrict__ cb, float* __restrict__ mqk) {
  const size_t i = (size_t)blockIdx.x * 256 + threadIdx.x;
  const int c = (int)(i & 1023); const size_t rr = i >> 10; if (rr >= (size_t)NB * TT) return;
  const int b = (int)(rr / TT), sp = (int)(rr % TT);
  const bool isk = c >= 512; const int cc = c & 511, h = cc >> 7, d = cc & 127;
  const bf16* src = (isk ? MK : MQ) + ((size_t)(b * 4 + h) * PADT + MPOS0) * 128 + d;
  float y = cb[c];
#pragma unroll
  for (int j = 0; j < 4; ++j) { const int s2 = sp - 3 + j; if (s2 >= 0) y += cw[j * 1024 + c] * bf2f(src[(size_t)s2 * 128]); }
  mqk[i] = y / (1.0f + expf(-y));
}
__global__ __launch_bounds__(512) void k_mlstm2(const float* __restrict__ mqk, const bf16* __restrict__ MV, const float* __restrict__ LI, const float* __restrict__ LF, float* __restrict__ hm) {
  __shared__ float qs[128], ks[128], ns[128], dens[1];
  const int b = blockIdx.x >> 2, h = blockIdx.x & 3, tid = threadIdx.x, e = tid >> 1, half = tid & 1;
  float C[64];
#pragma unroll
  for (int i = 0; i < 64; ++i) C[i] = 0.f;
  if (tid < 128) ns[tid] = 0.f;
  float m = 0.f;
  for (int sp = 0; sp < TT; ++sp) {
    const size_t rr = (size_t)b * TT + sp;
    __syncthreads();
    if (tid < 128) { qs[tid] = mqk[rr * 1024 + h * 128 + tid]; ks[tid] = mqk[rr * 1024 + 512 + h * 128 + tid] * 0.08838834764831845f; }
    const float li = LI[(b * 4 + h) * PADT + MPOS0 + sp], lf = LF[(b * 4 + h) * PADT + MPOS0 + sp];
    const float mn = fmaxf(lf + m, li);
    const float fp = expf(lf + m - mn), ip = expf(li - mn);
    m = mn;
    const float ve = bf2f(MV[((size_t)(b * 4 + h) * PADT + MPOS0 + sp) * 256 + e]);
    __syncthreads();
    if (tid < 128) ns[tid] = fp * ns[tid] + ip * ks[tid];
    float num = 0.f; const float iv = ip * ve;
#pragma unroll
    for (int i = 0; i < 64; ++i) { C[i] = fp * C[i] + iv * ks[half * 64 + i]; num += qs[half * 64 + i] * C[i]; }
    num += __shfl_xor(num, 1);
    __syncthreads();
    if (tid < 64) { float d = qs[tid] * ns[tid] + qs[tid + 64] * ns[tid + 64]; for (int o = 32; o > 0; o >>= 1) d += __shfl_xor(d, o); if (tid == 0) dens[0] = d; }
    __syncthreads();
    const float den = dens[0];
    if (half == 0 && sp >= NMETA) hm[((size_t)b * SEQ + sp - NMETA) * 1024 + h * 256 + e] = num / fmaxf(fabsf(den), expf(-m));
  }
}
__global__ __launch_bounds__(256) void k_mix2(const float* __restrict__ ao, const float* __restrict__ hm, const bf16* __restrict__ MO, const float* __restrict__ og, float* __restrict__ A2) {
  __shared__ float red[4];
  const size_t r = blockIdx.x; const int tid = threadIdx.x;
  for (int h = 0; h < 4; ++h) {
    A2[r * DM + h * 256 + tid] = ao[r * 1024 + h * 256 + tid];
    const float v = hm[r * 1024 + h * 256 + tid];
    const float ss = block_sum(v * v, red);
    const float rs = rsqrtf(ss * (1.0f / 256.f) + EPS);
    A2[r * DM + 1024 + h * 256 + tid] = v * rs * og[h * 256 + tid] * bf2f(MO[r * 1024 + h * 256 + tid]);
  }
}
__global__ __launch_bounds__(256) void k_peer2(const float* __restrict__ xn, const int* __restrict__ idx, const float* __restrict__ gg,
                                                const float* __restrict__ U, const float* __restrict__ V, float* out) {
  __shared__ __attribute__((aligned(16))) float xs[2048];
  __shared__ float act[128]; __shared__ int eid[128];
  const int tid = threadIdx.x, lane = tid & 63, wid = tid >> 6;
  const size_t r = blockIdx.x;
  for (int i = tid; i < 2048; i += 256) xs[i] = xn[r * 2048 + i];
  if (tid < 128) eid[tid] = idx[r * 128 + tid];
  __syncthreads();
  for (int q = 0; q < 32; ++q) {
    const int e = wid * 32 + q; const float4* up = (const float4*)(U + (size_t)eid[e] * 2048);
    float d = 0.f;
#pragma unroll
    for (int i = 0; i < 8; ++i) { const float4 a = up[i * 64 + lane], x4 = ((const float4*)xs)[i * 64 + lane]; d += a.x * x4.x + a.y * x4.y + a.z * x4.z + a.w * x4.w; }
    for (int o = 32; o > 0; o >>= 1) d += __shfl_xor(d, o);
    if (lane == 0) act[e] = 0.5f * d * (1.0f + erff(d * 0.7071067811865476f)) * gg[r * 128 + e];
  }
  __syncthreads();
  float4 y0 = make_float4(0.f, 0.f, 0.f, 0.f), y1 = y0;
  for (int e = 0; e < 128; ++e) {
    const float a = act[e]; const float4* vp = (const float4*)(V + (size_t)eid[e] * 2048);
    const float4 v0 = vp[tid], v1 = vp[256 + tid];
    y0.x += a * v0.x; y0.y += a * v0.y; y0.z += a * v0.z; y0.w += a * v0.w;
    y1.x += a * v1.x; y1.y += a * v1.y; y1.z += a * v1.z; y1.w += a * v1.w;
  }
  float4* op = (float4*)(out + r * 2048);
  float4 a0 = op[tid], a1 = op[256 + tid];
  a0.x += y0.x; a0.y += y0.y; a0.z += y0.z; a0.w += y0.w; a1.x += y1.x; a1.y += y1.y; a1.z += y1.z; a1.w += y1.w;
  op[tid] = a0; op[256 + tid] = a1;
}
}
extern "C" void kernel_launch(void* const* d_in, const int* in_sizes, int n_in, void* d_out, int out_size, void* d_ws, size_t ws_size, hipStream_t stream) {
  static int grid = 0;
  if (grid == 0) {
    int dev = 0, cus = 0, per_cu = 0;
    if (hipGetDevice(&dev) != hipSuccess || hipDeviceGetAttribute(&cus, hipDeviceAttributeMultiprocessorCount, dev) != hipSuccess) { fprintf(stderr, "device query failed\n"); grid = -1; return; }
    if (hipFuncSetAttribute((const void*)mk_fwd, hipFuncAttributeMaxDynamicSharedMemorySize, LDS_BYTES) != hipSuccess) { fprintf(stderr, "hipFuncSetAttribute failed\n"); grid = -1; return; }
    if (hipOccupancyMaxActiveBlocksPerMultiprocessor(&per_cu, (const void*)mk_fwd, NTHR, LDS_BYTES) != hipSuccess || per_cu < 1) { fprintf(stderr, "occupancy query: %d\n", per_cu); per_cu = 1; }
    (void)hipGetLastError();
    grid = cus * 1;
    if (ws_size < (size_t)480 * MiB) { fprintf(stderr, "ws too small %zu\n", ws_size); grid = -1; return; }
  }
  if (grid < 0) return;
  unsigned char* ws = (unsigned char*)d_ws;
  hipMemsetAsync(ws + WS_CTL, 0, CTL_ZERO_BYTES, stream);
  Args a{};
  for (int i = 0; i < 22; ++i) a.in[i] = (const float*)d_in[i];
  a.out = (float*)d_out; a.ws = ws;
  a.ph_lo = 0; a.ph_hi = 1; hipLaunchKernelGGL(mk_fwd, dim3(grid), dim3(NTHR), LDS_BYTES, stream, a);
  a.ph_lo = 1; a.ph_hi = 2; hipLaunchKernelGGL(mk_fwd, dim3(grid), dim3(NTHR), LDS_BYTES, stream, a);
  using namespace nv;
  float* out = (float*)d_out;
  float* ao = (float*)(ws + 176 * MiB); float* mqk = (float*)(ws + 208 * MiB); float* hm = (float*)(ws + 241 * MiB);
  float* A2 = (float*)(ws + 273 * MiB); float* xn2 = (float*)(ws + 337 * MiB); float* pq = (float*)(ws + 401 * MiB);
  int* ridx = (int*)(ws + 465 * MiB); float* rg = (float*)(ws + 470 * MiB);
  const bf16* Qb = (const bf16*)(ws + WS_Q); const bf16* Kp = (const bf16*)(ws + WS_KP); const bf16* Vp = (const bf16*)(ws + WS_VP);
  const bf16* MQ = (const bf16*)(ws + WS_MQ); const bf16* MK = (const bf16*)(ws + WS_MK); const bf16* MV = (const bf16*)(ws + WS_MV); const bf16* MO = (const bf16*)(ws + WS_MO);
  const float* LI = (const float*)(ws + WS_LI); const float* LF = (const float*)(ws + WS_LF); const float* lam = (const float*)(ws + WS_LAM);
  k_attn2<<<dim3(SEQ, 4, NB), 256, 0, stream>>>(Qb, Kp, Vp, lam, a.in[IN_SUBG], ao);
  k_conv2<<<NB * TT * 4, 256, 0, stream>>>(MQ, MK, a.in[IN_CW], a.in[IN_CB], mqk);
  k_mlstm2<<<16, 512, 0, stream>>>(mqk, MV, LI, LF, hm);
  k_mix2<<<MROWS, 256, 0, stream>>>(ao, hm, MO, a.in[IN_OUTG], A2);
  k_gemm<<<dim3(DM / 128, MROWS / 128), 256, 0, stream>>>(A2, DM, a.in[IN_WOUT], DM, out, DM, a.in[IN_X], DM, MROWS, DM, DM);
  k_norm<<<MROWS, 256, 0, stream>>>(out, a.in[IN_G2], xn2);
  k_gemm<<<dim3(DM / 128, MROWS / 128), 256, 0, stream>>>(xn2, DM, a.in[IN_WQ], DM, pq, DM, nullptr, 0, MROWS, DM, DM);
  k_route<<<MROWS, 256, 0, stream>>>(pq, a.in[IN_SUBK], ridx, rg);
  k_peer2<<<MROWS, 256, 0, stream>>>(xn2, ridx, rg, a.in[IN_U], a.in[IN_V], out);
}
```

```cpp
#include <hip/hip_runtime.h>
#include <cstdio>
#include <cstdint>
#include <math.h>
namespace pg8 {
#define PG8_LAS __attribute__((address_space(3)))
typedef unsigned short bf16_t;
typedef short bf16x8 __attribute__((ext_vector_type(8)));
typedef float f32x4 __attribute__((ext_vector_type(4)));
typedef unsigned u32x4 __attribute__((ext_vector_type(4)));
constexpr int BM = 256, BK = 64, HALF = 128, HTB = HALF * BK * 2  , STAGE_BYTES = 8 * HTB, NXCD = 8, WGM = 8;

__host__ __device__ __forceinline__ int lds_byte(int r, int c) { const int st = (r >> 4) * 2 + (c >> 5), rr = r & 15, cc = c & 31, ob = rr * 64 + cc * 2; return st * 1024 + (ob ^ (((ob >> 9) & 1) << 5)); }
__host__ __device__ __forceinline__ void stage_rc(int b, int& R, int& C) { const int st = b / 1024, sb = b % 1024, swz = sb ^ (((sb >> 9) & 1) << 5); R = (st >> 1) * 16 + swz / 64; C = (st & 1) * 32 + (swz % 64) / 2; }
__host__ __device__ __forceinline__ int perm32(int rho) { const int n = rho >> 4, i = rho & 15; return 8 * (i >> 2) + 4 * n + (i & 3); }

struct Unit { int pm, pn; };
struct Gemm { const bf16_t* A; const bf16_t* Bt; int M, N, K; };

struct StaticOrder {
    int nM, nN, nwg, G, c;
    __host__ __device__ void init(int M, int N, int G_, int c_) { nM = M / BM; nN = N / BM; nwg = nM * nN; G = G_; c = c_; }
    __host__ __device__ bool next(int i, Unit& u) const {
        const long L = (long)i * G + c; if (L >= nwg) return false;
        int wgid = (int)L; { const int q = nwg / NXCD, r = nwg % NXCD, xcd = wgid % NXCD, off = wgid / NXCD; wgid = (xcd < r ? xcd * (q + 1) : r * (q + 1) + (xcd - r) * q) + off; }
        const int nig = WGM * nN, gid = wgid / nig, fm = gid * WGM, gsz = (nM - fm) < WGM ? (nM - fm) : WGM;
        u.pm = fm + ((wgid % nig) % gsz); u.pn = (wgid % nig) / gsz; return true;
    }
    __device__ __forceinline__ void a_ready(const Unit&) const {}
    __device__ __forceinline__ void done(const Unit&) const {}
};

__device__ __forceinline__ unsigned cvt_pk_bf16(float lo, float hi) { unsigned r; asm volatile("v_cvt_pk_bf16_f32 %0, %1, %2" : "=v"(r) : "v"(lo), "v"(hi)); return r; }
typedef float f32x2 __attribute__((ext_vector_type(2)));
template <class Epi, class Sched, bool ALIGN_EPI = false, bool SP2 = false>
__device__ __forceinline__ void gemm_phase(PG8_LAS unsigned char* lds, const Gemm g, const Sched& S, const Epi& E) {
    const int tid = threadIdx.x, wid = __builtin_amdgcn_readfirstlane(tid >> 6), lane = tid & 63, wr = wid >> 2, wc = wid & 3, fr = lane & 15, fq = lane >> 4;
    const int K = g.K, nt = K / BK;
    unsigned voffA[2], voffB[2];
#pragma unroll
    for (int i = 0; i < 2; ++i) { int R, C; stage_rc(tid * 16 + i * 8192, R, C); const int Rb = Epi::PERM ? ((R & ~31) + perm32(R & 31)) : R;
        voffA[i] = (unsigned)(R * K + C) * 2u; voffB[i] = (unsigned)(Rb * K + C) * 2u; }
    const size_t kstep = (size_t)(BK * 2);
    const size_t hstep = (size_t)HALF * K * 2;
    const size_t tstep = 2 * hstep;
    const unsigned ldsw = (unsigned)wid * 1024u;
    const int aoff = lds_byte(wr * 64 + fr, fq * 8), boff = lds_byte(wc * 32 + fr, fq * 8);
#define PG8_SA(b, h) (((b) * 2 + (h)) * HTB)
#define PG8_SB(b, h) ((4 + (b) * 2 + (h)) * HTB)
#define PG8_STAGE(bufoff, gbase, voff) do { _Pragma("unroll") for (int _i = 0; _i < 2; ++_i) \
        __builtin_amdgcn_global_load_lds((const unsigned*)((const char*)(gbase) + (voff)[_i]), (PG8_LAS unsigned*)(lds + (bufoff) + ldsw + _i * 8192), 16, 0, 0); } while (0)
#define PG8_LDA(dst, b, h) do { _Pragma("unroll") for (int m = 0; m < 4; ++m) _Pragma("unroll") for (int k = 0; k < 2; ++k) dst[m][k] = *(const PG8_LAS bf16x8*)(lds + PG8_SA(b, h) + aoff + m * 2048 + k * 1024); } while (0)
#define PG8_LDB(dst, b, h) do { _Pragma("unroll") for (int n = 0; n < 2; ++n) _Pragma("unroll") for (int k = 0; k < 2; ++k) dst[n][k] = *(const PG8_LAS bf16x8*)(lds + PG8_SB(b, h) + boff + n * 2048 + k * 1024); } while (0)
#define PG8_MMA(ai, bj, At, Bt) do { __builtin_amdgcn_s_setprio(1); _Pragma("unroll") for (int m = 0; m < 4; ++m) _Pragma("unroll") for (int n = 0; n < 2; ++n) _Pragma("unroll") for (int k = 0; k < 2; ++k) \
        acc[ai][bj][m][n] = __builtin_amdgcn_mfma_f32_16x16x32_bf16(Bt[n][k], At[m][k], acc[ai][bj][m][n], 0, 0, 0); __builtin_amdgcn_s_setprio(0); } while (0)
#define PG8_WAIT_V(n) asm volatile("s_waitcnt vmcnt(" #n ")" ::: "memory")
#define PG8_WAIT_L(n) asm volatile("s_waitcnt lgkmcnt(" #n ")" ::: "memory")
#define PG8_BAR __builtin_amdgcn_s_barrier()
#define PG8_SCHED __builtin_amdgcn_sched_barrier(0)
    Unit cur, nxt; int ui = 0;
    if (!S.next(0, cur)) return;
    f32x4 acc[2][2][4][2];
#pragma unroll
    for (int a = 0; a < 2; ++a)
#pragma unroll
        for (int b = 0; b < 2; ++b)
#pragma unroll
            for (int m = 0; m < 4; ++m)
#pragma unroll
                for (int n = 0; n < 2; ++n) acc[a][b][m][n] = (f32x4){0.f, 0.f, 0.f, 0.f};
    bf16x8 At[4][2], B0[2][2], B1[2][2];
    const char* cA = (const char*)g.A + (size_t)cur.pm * tstep; const char* cB = (const char*)g.Bt + (size_t)cur.pn * tstep;
    S.a_ready(cur);
    if constexpr (SP2) {
        PG8_STAGE(PG8_SB(0, 0), cB, voffB); PG8_STAGE(PG8_SB(0, 1), cB + hstep, voffB); PG8_STAGE(PG8_SA(0, 0), cA, voffA); PG8_STAGE(PG8_SA(0, 1), cA + hstep, voffA);
        if (wr == 1) PG8_BAR;
        PG8_WAIT_V(2); PG8_BAR;
        PG8_STAGE(PG8_SB(1, 0), cB + kstep, voffB); PG8_STAGE(PG8_SA(1, 0), cA + kstep, voffA); PG8_STAGE(PG8_SB(1, 1), cB + hstep + kstep, voffB);
        PG8_WAIT_V(6); PG8_BAR;
    } else {
        PG8_STAGE(PG8_SB(0, 0), cB, voffB); PG8_STAGE(PG8_SA(0, 0), cA, voffA); PG8_STAGE(PG8_SB(0, 1), cB + hstep, voffB); PG8_STAGE(PG8_SA(0, 1), cA + hstep, voffA);
        if (wr == 1) PG8_BAR;
        PG8_WAIT_V(4); PG8_BAR;
        PG8_STAGE(PG8_SB(1, 0), cB + kstep, voffB); PG8_STAGE(PG8_SA(1, 0), cA + kstep, voffA); PG8_STAGE(PG8_SB(1, 1), cB + hstep + kstep, voffB);
        PG8_WAIT_V(6); PG8_BAR;
    }
    for (;;) {
        const bool has_next = S.next(ui + 1, nxt);
        const char* nA = has_next ? (const char*)g.A + (size_t)nxt.pm * tstep : cA; const char* nB = has_next ? (const char*)g.Bt + (size_t)nxt.pn * tstep : cB;
        for (int t = 0; t < nt; t += 2) {
            const bool last = (t == nt - 2);
            const char* a1 = cA + (size_t)(t + 1) * kstep;
            const char* a2 = last ? nA : cA + (size_t)(t + 2) * kstep; const char* b2 = last ? nB : cB + (size_t)(t + 2) * kstep;
            const char* a3 = a2 + kstep; const char* b3 = b2 + kstep;
            if (last && has_next) S.a_ready(nxt);
            if constexpr (SP2) {
            PG8_LDB(B0, 0, 0); PG8_LDB(B1, 0, 1); PG8_SCHED; PG8_LDA(At, 0, 0); PG8_STAGE(PG8_SA(1, 1), a1 + hstep, voffA);
            PG8_WAIT_V(8); PG8_WAIT_L(0); PG8_BAR; PG8_MMA(0, 0, At, B0); PG8_MMA(0, 1, At, B1); PG8_BAR; PG8_SCHED;
            PG8_LDA(At, 0, 1); PG8_STAGE(PG8_SB(0, 0), b2, voffB); PG8_STAGE(PG8_SB(0, 1), b2 + hstep, voffB); PG8_STAGE(PG8_SA(0, 0), a2, voffA);
            PG8_WAIT_V(8); PG8_WAIT_L(0); PG8_BAR; PG8_MMA(1, 0, At, B0); PG8_MMA(1, 1, At, B1); PG8_BAR; PG8_SCHED;
            PG8_LDB(B0, 1, 0); PG8_LDB(B1, 1, 1); PG8_SCHED; PG8_LDA(At, 1, 0); PG8_STAGE(PG8_SA(0, 1), a2 + hstep, voffA);
            PG8_WAIT_V(8); PG8_WAIT_L(0); PG8_BAR; PG8_MMA(0, 0, At, B0); PG8_MMA(0, 1, At, B1); PG8_BAR; PG8_SCHED;
            PG8_LDA(At, 1, 1); PG8_STAGE(PG8_SB(1, 0), b3, voffB); PG8_STAGE(PG8_SB(1, 1), b3 + hstep, voffB); PG8_STAGE(PG8_SA(1, 0), a3, voffA);
            PG8_WAIT_V(8); PG8_WAIT_L(0); PG8_BAR; PG8_MMA(1, 0, At, B0); PG8_MMA(1, 1, At, B1); PG8_BAR; PG8_SCHED;
            } else {
            PG8_LDB(B0, 0, 0); PG8_SCHED; PG8_LDA(At, 0, 0); PG8_STAGE(PG8_SA(1, 1), a1 + hstep, voffA);
            PG8_WAIT_L(8); PG8_BAR; PG8_WAIT_L(0); PG8_MMA(0, 0, At, B0); PG8_BAR; PG8_SCHED;
            PG8_LDB(B1, 0, 1); PG8_STAGE(PG8_SB(0, 0), b2, voffB);
            PG8_BAR; PG8_WAIT_L(0); PG8_MMA(0, 1, At, B1); PG8_BAR;
            PG8_LDA(At, 0, 1); PG8_STAGE(PG8_SA(0, 0), a2, voffA);
            PG8_BAR; PG8_WAIT_L(0); PG8_MMA(1, 0, At, B0); PG8_BAR; PG8_SCHED;
            PG8_STAGE(PG8_SB(0, 1), b2 + hstep, voffB);
            PG8_WAIT_V(6); PG8_BAR; PG8_MMA(1, 1, At, B1); PG8_BAR;
            PG8_LDB(B0, 1, 0); PG8_SCHED; PG8_LDA(At, 1, 0); PG8_STAGE(PG8_SA(0, 1), a2 + hstep, voffA);
            PG8_WAIT_L(8); PG8_BAR; PG8_WAIT_L(0); PG8_MMA(0, 0, At, B0); PG8_BAR; PG8_SCHED;
            PG8_LDB(B1, 1, 1); PG8_STAGE(PG8_SB(1, 0), b3, voffB);
            PG8_BAR; PG8_WAIT_L(0); PG8_MMA(0, 1, At, B1); PG8_BAR;
            PG8_LDA(At, 1, 1); PG8_STAGE(PG8_SA(1, 0), a3, voffA);
            PG8_BAR; PG8_WAIT_L(0); PG8_MMA(1, 0, At, B0); PG8_BAR; PG8_SCHED;
            PG8_STAGE(PG8_SB(1, 1), b3 + hstep, voffB);
            PG8_WAIT_V(6); PG8_BAR; PG8_MMA(1, 1, At, B1); PG8_BAR;
            }
        }
        if constexpr (ALIGN_EPI) { if (wr == 0) PG8_BAR; }
        if constexpr (!Epi::AFTER_DRAIN) { E(acc, cur, wr, wc, fr, fq); S.done(cur); }
        if (!has_next) break;
#pragma unroll
        for (int a = 0; a < 2; ++a)
#pragma unroll
            for (int b = 0; b < 2; ++b)
#pragma unroll
                for (int m = 0; m < 4; ++m)
#pragma unroll
                    for (int n = 0; n < 2; ++n) acc[a][b][m][n] = (f32x4){0.f, 0.f, 0.f, 0.f};
        cur = nxt; cA = nA; cB = nB; ++ui;
        if constexpr (ALIGN_EPI) { if (wr == 1) PG8_BAR; }
    }
    PG8_WAIT_V(0);
    if constexpr (!ALIGN_EPI) { if (wr == 0) PG8_BAR; }
    PG8_BAR;
    if constexpr (Epi::AFTER_DRAIN) { E.fused(acc, cur, wr, wc, fr, fq, lds, wid, lane); S.done(cur); }
#undef PG8_SA
#undef PG8_SB
#undef PG8_STAGE
#undef PG8_LDA
#undef PG8_LDB
#undef PG8_MMA
#undef PG8_WAIT_V
#undef PG8_WAIT_L
#undef PG8_BAR
#undef PG8_SCHED
}
}
#define GAS __attribute__((address_space(1)))
#define LAS __attribute__((address_space(3)))
typedef unsigned short bf16;
typedef unsigned v4u __attribute__((ext_vector_type(4)));
typedef unsigned v2u __attribute__((ext_vector_type(2)));
typedef float f32x4 __attribute__((ext_vector_type(4)));
typedef short bf16x8 __attribute__((ext_vector_type(8)));
#define LDS_WAIT() asm volatile("s_waitcnt lgkmcnt(0)" ::: "memory")
#define VM_WAIT() asm volatile("s_waitcnt vmcnt(0)" ::: "memory")

constexpr int DM = 2048, NB = 4, SEQ = 2048, NMETA = 16, MROWS = NB * SEQ, DPROJ = 6152, NPROJ = 6144;
constexpr int PADT = 2112, POS0 = 64, MPOS0 = 48;
constexpr float EPS = 1e-6f;
constexpr float LOG2E = 1.4426950408889634f;
constexpr float QSCALE = 0.08838834764831845f * LOG2E;
constexpr int NWAVES = 8, NTHR = 512;

constexpr size_t MiB = 1u << 20;
constexpr size_t WS_CTL = 0, CTL_ZERO_BYTES = 1 * MiB;
constexpr size_t WS_PM = 512 * 1024;
constexpr size_t WS_W1T = 2 * MiB, WS_W2T = 26 * MiB, WS_W3T = 34 * MiB, WS_XN = 42 * MiB;
constexpr size_t WS_Q = 74 * MiB, WS_KP = 90 * MiB, WS_VP = 107 * MiB, WS_MQ = 124 * MiB, WS_MK = 133 * MiB, WS_MV = 142 * MiB, WS_MO = 159 * MiB;
constexpr size_t WS_SMALL = 175 * MiB;
constexpr size_t WS_XM = WS_SMALL, WS_LI = WS_SMALL + 128 * 1024, WS_LF = WS_SMALL + 384 * 1024, WS_LAM = WS_SMALL + 640 * 1024;
constexpr size_t WS_PO = 176 * MiB, WS_ML = 304 * MiB, WS_HM = 305 * MiB, WS_A2 = 337 * MiB, WS_H1B = 369 * MiB, WS_SSQ = 401 * MiB;
constexpr int CW_BAR = 4096;

constexpr int RING_OFF = 0, RING_BYTES = 131072;
constexpr int XCH_OFF = 131072;
constexpr int MISC_OFF = XCH_OFF + 8192;
constexpr int LDS_BYTES = 155648;

__device__ __forceinline__ unsigned f2bf(float f) { unsigned u = __builtin_bit_cast(unsigned, f); return (u + 0x7fffu + ((u >> 16) & 1u)) >> 16; }
__device__ __forceinline__ unsigned pk2(float lo, float hi) { return f2bf(lo) | (f2bf(hi) << 16); }
__device__ __forceinline__ float bf2f(unsigned short u) { return __builtin_bit_cast(float, (unsigned)u << 16); }
__device__ __forceinline__ float bflo(unsigned w) { return __builtin_bit_cast(float, w << 16); }
__device__ __forceinline__ float bfhi(unsigned w) { return __builtin_bit_cast(float, w & 0xffff0000u); }
__device__ __forceinline__ float wave_sum(float v) {
#pragma unroll
  for (int o = 1; o < 64; o <<= 1) v += __shfl_xor(v, o);
  return v;
}
__device__ __forceinline__ size_t kp_off(int bhm, int pos, int d) { const int j = pos >> 6, row = pos & 63, d0 = d >> 4, hi = (d >> 3) & 1;
  return ((size_t)(bhm * 33 + j) * 8 + d0) * 1024 + (size_t)((((row << 1) | hi) ^ ((row >> 3) & 1)) << 3) + (d & 7); }
__device__ __forceinline__ float sigmoidf_(float x) { return 1.0f / (1.0f + __expf(-x)); }
struct Args { const float* in[22]; float* out; unsigned char* ws; int ph_lo, ph_hi, na, pad; };
struct Frame {
  LAS unsigned char* lds; unsigned char* ws; int tid, lane, wave; const float* const* in;
};
#define IN_X 0
#define IN_META 1
#define IN_G1 2
#define IN_WIN 3
#define IN_CW 4
#define IN_CB 5
#define IN_IGB 6
#define IN_FGB 7
#define IN_LQ1 8
#define IN_LK1 9
#define IN_LQ2 10
#define IN_LK2 11
#define IN_QNG 12
#define IN_KNG 13
#define IN_SUBG 14
#define IN_OUTG 15
#define IN_WOUT 16
#define IN_G2 17
#define IN_WQ 18
#define IN_SUBK 19
#define IN_U 20
#define IN_V 21

__device__ __forceinline__ void p0_rows(const Frame& F, const Args& a) {
  const float* x = a.in[IN_X]; const float* meta = a.in[IN_META]; const float* g1 = a.in[IN_G1]; const float* w_in = a.in[IN_WIN];
  const float* igb = a.in[IN_IGB]; const float* fgb = a.in[IN_FGB];
  bf16* Xn = (bf16*)(F.ws + WS_XN); bf16* Xm = (bf16*)(F.ws + WS_XM); float* LI = (float*)(F.ws + WS_LI); float* LF = (float*)(F.ws + WS_LF);
  LAS f32x4* wgl = (LAS f32x4*)(F.lds);
  for (int e = F.tid; e < 4096; e += NTHR) {
    const int ln = e & 63, q = e >> 6, half = q & 1, j = (q >> 1) & 3, i = q >> 3;
    const int k = 4 * (i * 64 + ln) + j;
    wgl[e] = *(const f32x4*)(w_in + (size_t)k * DPROJ + NPROJ + 4 * half);
  }
  __syncthreads();
  const int gw = blockIdx.x * NWAVES + F.wave, NGW = gridDim.x * NWAVES, lane = F.lane;
  for (int task = gw; task < MROWS / 2 + NMETA / 2; task += NGW) {
    const bool ismeta = task >= MROWS / 2;
    const int r0 = ismeta ? (task - MROWS / 2) * 2 : task * 2;
    const float* src0 = (ismeta ? meta : x) + (size_t)r0 * DM;
    float rs[2];
    { float s0 = 0.f, s1 = 0.f;
#pragma unroll 2
      for (int i = 0; i < 8; ++i) { const f32x4 a0 = ((const f32x4*)src0)[i * 64 + lane], a1 = ((const f32x4*)(src0 + DM))[i * 64 + lane];
        s0 += (a0.x * a0.x + a0.y * a0.y) + (a0.z * a0.z + a0.w * a0.w); s1 += (a1.x * a1.x + a1.y * a1.y) + (a1.z * a1.z + a1.w * a1.w); }
      rs[0] = rsqrtf(wave_sum(s0) * (1.0f / DM) + EPS); rs[1] = rsqrtf(wave_sum(s1) * (1.0f / DM) + EPS); }
    float ga[2][8];
#pragma unroll
    for (int rr = 0; rr < 2; ++rr)
#pragma unroll
      for (int g = 0; g < 8; ++g) ga[rr][g] = 0.f;
    bf16* dst0 = (ismeta ? Xm : Xn) + (size_t)r0 * DM;
#pragma unroll 1
    for (int i = 0; i < 8; ++i) {
      const f32x4 g = ((const f32x4*)g1)[i * 64 + lane];
      f32x4 xn[2];
#pragma unroll
      for (int rr = 0; rr < 2; ++rr) { xn[rr] = ((const f32x4*)(src0 + (size_t)rr * DM))[i * 64 + lane] * g * rs[rr];
        v2u o; o.x = pk2(xn[rr].x, xn[rr].y); o.y = pk2(xn[rr].z, xn[rr].w); ((v2u*)(dst0 + (size_t)rr * DM))[i * 64 + lane] = o; }
#pragma unroll
      for (int j = 0; j < 4; ++j) {
        const f32x4 w0 = wgl[((i * 4 + j) * 2 + 0) * 64 + lane], w1 = wgl[((i * 4 + j) * 2 + 1) * 64 + lane];
#pragma unroll
        for (int rr = 0; rr < 2; ++rr) { const float xv = xn[rr][j];
          ga[rr][0] += xv * w0.x; ga[rr][1] += xv * w0.y; ga[rr][2] += xv * w0.z; ga[rr][3] += xv * w0.w;
          ga[rr][4] += xv * w1.x; ga[rr][5] += xv * w1.y; ga[rr][6] += xv * w1.z; ga[rr][7] += xv * w1.w; }
      }
    }
#pragma unroll
    for (int rr = 0; rr < 2; ++rr)
#pragma unroll
      for (int g = 0; g < 8; ++g) ga[rr][g] = wave_sum(ga[rr][g]);
    if (lane < 8) {
      const int rr = lane >> 2, h = lane & 3;
      float gi = 0.f, gf = 0.f;
#pragma unroll
      for (int q = 0; q < 2; ++q)
#pragma unroll
        for (int hh = 0; hh < 4; ++hh) if (q == rr && hh == h) { gi = ga[q][hh]; gf = ga[q][4 + hh]; }
      const float li = gi + igb[h]; const float fx = gf + fgb[h];
      const float lf = fminf(fx, 0.f) - log1pf(__expf(-fabsf(fx)));
      const int R = r0 + rr;
      if (!ismeta) { const int b = R >> 11, t = R & 2047; LI[(b * 4 + h) * PADT + POS0 + t] = li; LF[(b * 4 + h) * PADT + POS0 + t] = lf; }
      else { for (int b = 0; b < NB; ++b) { LI[(b * 4 + h) * PADT + MPOS0 + R] = li; LF[(b * 4 + h) * PADT + MPOS0 + R] = lf; } }
    }
  }
  __syncthreads();
}
__device__ __forceinline__ void p0_metaproj(const Frame& F, const Args& a) {
  const float* meta = a.in[IN_META]; const float* g1 = a.in[IN_G1]; const float* w_in = a.in[IN_WIN];
  float* PM = (float*)(F.ws + WS_PM);
  LAS float* xs = (LAS float*)(F.lds);
  LAS float* part = (LAS float*)(F.lds + 16384);
  const int q = F.tid >> 7, c = F.tid & 127;
  for (int task = blockIdx.x; task < NPROJ / 128; task += gridDim.x) {
    const int n = task * 128 + c;
    float acc[16];
#pragma unroll
    for (int m = 0; m < 16; ++m) acc[m] = 0.f;
#pragma unroll 1
    for (int kb = 0; kb < 8; ++kb) {
      __syncthreads();
#pragma unroll
      for (int i = 0; i < 8; ++i) { const int idx = F.tid + NTHR * i, qq = idx >> 10, kk = (idx >> 4) & 63, m = idx & 15; const int k = 512 * qq + 64 * kb + kk;
        xs[idx] = meta[(size_t)m * DM + k] * g1[k]; }
      __syncthreads();
#pragma unroll 4
      for (int kk = 0; kk < 64; ++kk) {
        const float w = w_in[(size_t)(512 * q + 64 * kb + kk) * DPROJ + n];
        const LAS f32x4* xp = (const LAS f32x4*)(xs + (q * 64 + kk) * 16);
#pragma unroll
        for (int t = 0; t < 4; ++t) { const f32x4 xv = xp[t]; acc[4 * t + 0] += xv.x * w; acc[4 * t + 1] += xv.y * w; acc[4 * t + 2] += xv.z * w; acc[4 * t + 3] += xv.w * w; }
      }
    }
#pragma unroll
    for (int m = 0; m < 16; ++m) part[(q * 16 + m) * 128 + c] = acc[m];
    __syncthreads();
    for (int e = F.tid; e < 16 * 128; e += NTHR) { const int m = e >> 7, cc = e & 127;
      PM[m * NPROJ + task * 128 + cc] = (part[(0 * 16 + m) * 128 + cc] + part[(1 * 16 + m) * 128 + cc]) + (part[(2 * 16 + m) * 128 + cc] + part[(3 * 16 + m) * 128 + cc]); }
  }
  __syncthreads();
}
__device__ __forceinline__ void p0_transpose(const Frame& F, const float* W, int ldw, int N, bf16* Wt) {
  LAS float* tl = (LAS float*)(F.lds);
  const int ntn = N / 64, ntask = ntn * 16;
  for (int task = blockIdx.x; task < ntask; task += gridDim.x) {
    const int nb = task % ntn, kb = task / ntn, n0 = nb * 64, k0 = kb * 128;
    __syncthreads();
#pragma unroll
    for (int i = 0; i < 4; ++i) { const int idx = F.tid + NTHR * i, kk = idx >> 4, c4 = idx & 15;
      const f32x4 w = *(const f32x4*)(W + (size_t)(k0 + kk) * ldw + n0 + 4 * c4);
      LAS float* d = tl + kk * 65 + 4 * c4; d[0] = w.x; d[1] = w.y; d[2] = w.z; d[3] = w.w; }
    __syncthreads();
    const int n = F.tid >> 3, kc = F.tid & 7;
    const LAS float* s = tl + (kc * 16) * 65 + n;
    v4u o0, o1;
    o0.x = pk2(s[0 * 65], s[1 * 65]); o0.y = pk2(s[2 * 65], s[3 * 65]); o0.z = pk2(s[4 * 65], s[5 * 65]); o0.w = pk2(s[6 * 65], s[7 * 65]);
    o1.x = pk2(s[8 * 65], s[9 * 65]); o1.y = pk2(s[10 * 65], s[11 * 65]); o1.z = pk2(s[12 * 65], s[13 * 65]); o1.w = pk2(s[14 * 65], s[15 * 65]);
    v4u* dp = (v4u*)(Wt + (size_t)(n0 + n) * DM + k0 + kc * 16);
    dp[0] = o0; dp[1] = o1;
  }
  __syncthreads();
}
__device__ __forceinline__ void p0_zero_vpad(const Frame& F) {
  bf16* Vp = (bf16*)(F.ws + WS_VP);
  const int per = MPOS0 * 256 / 8;
  for (int i = blockIdx.x * NTHR + F.tid; i < 16 * per; i += gridDim.x * NTHR) { const int bh = i / per, e = i % per;
    *(v4u*)(Vp + (size_t)bh * PADT * 256 + (size_t)e * 8) = (v4u){0u, 0u, 0u, 0u}; }
}
__device__ __forceinline__ void p0_lam(const Frame& F, const Args& a) {
  if (blockIdx.x == 0 && F.wave == 0) {
    const int l = F.lane;
    float s1 = a.in[IN_LQ1][l] * a.in[IN_LK1][l] + a.in[IN_LQ1][l + 64] * a.in[IN_LK1][l + 64];
    float s2 = a.in[IN_LQ2][l] * a.in[IN_LK2][l] + a.in[IN_LQ2][l + 64] * a.in[IN_LK2][l + 64];
    s1 = wave_sum(s1); s2 = wave_sum(s2);
    if (l == 0) *(float*)(F.ws + WS_LAM) = __expf(s1) - __expf(s2) + 0.2f;
  }
}

struct EpiProj {
  static constexpr bool PERM = true, AFTER_DRAIN = false;
  bf16 *Qb, *Kp, *Vp, *MQ, *MK, *MV, *MO; const float *qg, *kg; LAS float* xch;
  __device__ __forceinline__ void operator()(const pg8::f32x4 (&acc)[2][2][4][2], const pg8::Unit& u, int wr, int wc, int fr, int fq) const {
    const int pn = u.pn, b = u.pm >> 3, tb = (u.pm & 7) * 256 + wr * 64 + fr, d0 = wc * 32 + fq * 8;
    if (pn < 8) {
      const bool isk = pn >= 4; const int h = pn & 3;
      float ssq[2][4][2];
#pragma unroll
      for (int ai = 0; ai < 2; ++ai)
#pragma unroll
        for (int m = 0; m < 4; ++m)
#pragma unroll
          for (int bj = 0; bj < 2; ++bj) { float s = 0.f;
#pragma unroll
            for (int n = 0; n < 2; ++n) { const pg8::f32x4 x = acc[ai][bj][m][n]; s += (x[0] * x[0] + x[1] * x[1]) + (x[2] * x[2] + x[3] * x[3]); }
            s += __shfl_xor(s, 16); s += __shfl_xor(s, 32); ssq[ai][m][bj] = s;
            if (fq == 0) xch[((ai * 128 + wr * 64 + m * 16 + fr) * 2 + bj) * 4 + wc] = s; }
      asm volatile("s_waitcnt lgkmcnt(0)" ::: "memory"); __builtin_amdgcn_s_barrier(); asm volatile("" ::: "memory");
      const float* gp = (isk ? kg : qg) + d0; const f32x4 g0 = *(const f32x4*)gp, g1v = *(const f32x4*)(gp + 4);
      const float sc = isk ? 1.0f : QSCALE;
#pragma unroll
      for (int ai = 0; ai < 2; ++ai)
#pragma unroll
        for (int m = 0; m < 4; ++m)
#pragma unroll
          for (int bj = 0; bj < 2; ++bj) {
            const f32x4 p = *(const LAS f32x4*)(xch + ((ai * 128 + wr * 64 + m * 16 + fr) * 2 + bj) * 4);
            const float rs = rsqrtf(((p.x + p.y) + (p.z + p.w)) * (1.0f / 128.f) + EPS) * sc;
            const pg8::f32x4 v0 = acc[ai][bj][m][0], v1 = acc[ai][bj][m][1];
            v4u w; w.x = pk2(v0[0] * rs * g0.x, v0[1] * rs * g0.y); w.y = pk2(v0[2] * rs * g0.z, v0[3] * rs * g0.w);
            w.z = pk2(v1[0] * rs * g1v.x, v1[1] * rs * g1v.y); w.w = pk2(v1[2] * rs * g1v.z, v1[3] * rs * g1v.w);
            const int t = tb + ai * 128 + m * 16;
            bf16* dst = isk ? Kp + kp_off((b * 4 + h) * 2 + bj, POS0 + t, d0)
                            : Qb + ((size_t)((b * 4 + h) * 2 + bj) * SEQ + t) * 128 + d0;
            *(v4u*)dst = w; }
      return;
    }
#pragma unroll
    for (int ai = 0; ai < 2; ++ai)
#pragma unroll
      for (int m = 0; m < 4; ++m)
#pragma unroll
        for (int bj = 0; bj < 2; ++bj) {
          pg8::f32x4 v0 = acc[ai][bj][m][0], v1 = acc[ai][bj][m][1];
          const int t = tb + ai * 128 + m * 16;
          bf16* dst;
          if (pn < 12) { const int h = pn - 8; dst = Vp + ((size_t)(b * 4 + h) * PADT + POS0 + t) * 256 + bj * 128 + d0; }
          else if (pn < 16) { const int h = 2 * (pn & 1) + bj; dst = (pn >= 14 ? MK : MQ) + ((size_t)(b * 4 + h) * PADT + POS0 + t) * 128 + d0; }
          else if (pn < 20) { const int h = pn - 16; dst = MV + ((size_t)(b * 4 + h) * PADT + POS0 + t) * 256 + bj * 128 + d0; }
          else { dst = MO + (size_t)(b * SEQ + t) * 1024 + (pn - 20) * 256 + bj * 128 + d0;
#pragma unroll
            for (int j = 0; j < 4; ++j) { v0[j] = sigmoidf_(v0[j]); v1[j] = sigmoidf_(v1[j]); } }
          v4u w; w.x = pk2(v0[0], v0[1]); w.y = pk2(v0[2], v0[3]); w.z = pk2(v1[0], v1[1]); w.w = pk2(v1[2], v1[3]);
          *(v4u*)dst = w; }
  }
};
__device__ __forceinline__ void p1_meta_finalize(const Frame& F, const Args& a) {
  if (blockIdx.x >= NMETA) return;
  const int mrow = blockIdx.x, tid = F.tid, lane = F.lane, w = F.wave;
  const float* meta = a.in[IN_META] + (size_t)mrow * DM; const float* PM = (const float*)(F.ws + WS_PM) + (size_t)mrow * NPROJ;
  LAS float* red = (LAS float*)(F.lds + XCH_OFF);
  const f32x4 mv = ((const f32x4*)meta)[tid];
  float s = wave_sum((mv.x * mv.x + mv.y * mv.y) + (mv.z * mv.z + mv.w * mv.w));
  if (lane == 0) red[w] = s;
  __syncthreads();
  float tot = 0.f;
#pragma unroll
  for (int i = 0; i < 8; ++i) tot += red[i];
  const float rs = rsqrtf(tot * (1.0f / DM) + EPS);
  bf16* Kp = (bf16*)(F.ws + WS_KP); bf16* Vp = (bf16*)(F.ws + WS_VP); bf16* MQ = (bf16*)(F.ws + WS_MQ); bf16* MK = (bf16*)(F.ws + WS_MK); bf16* MV = (bf16*)(F.ws + WS_MV);
  const int pos = MPOS0 + mrow;
  {
    const float v0 = PM[1024 + w * 128 + lane] * rs, v1 = PM[1024 + w * 128 + lane + 64] * rs;
    const float rk = rsqrtf(wave_sum(v0 * v0 + v1 * v1) * (1.0f / 128.f) + EPS);
    const float* kg = a.in[IN_KNG];
    const unsigned short o0 = (unsigned short)f2bf(v0 * rk * kg[lane]), o1 = (unsigned short)f2bf(v1 * rk * kg[lane + 64]);
    for (int b = 0; b < NB; ++b) { const int bhm = (b * 4 + (w >> 1)) * 2 + (w & 1); Kp[kp_off(bhm, pos, lane)] = o0; Kp[kp_off(bhm, pos, lane + 64)] = o1; }
  }
  { const int c = tid * 2;
    const unsigned o = pk2(PM[2048 + c] * rs, PM[2048 + c + 1] * rs); const int h = c >> 8, e = c & 255;
    for (int b = 0; b < NB; ++b) *(unsigned*)(Vp + ((size_t)(b * 4 + h) * PADT + pos) * 256 + e) = o;
    const unsigned o2 = pk2(PM[3072 + c] * rs, PM[3072 + c + 1] * rs); const bool isk = c >= 512; const int cc = c & 511, hq = cc >> 7, d = cc & 127;
    for (int b = 0; b < NB; ++b) *(unsigned*)((isk ? MK : MQ) + ((size_t)(b * 4 + hq) * PADT + pos) * 128 + d) = o2;
    const unsigned o3 = pk2(PM[4096 + c] * rs, PM[4096 + c + 1] * rs);
    for (int b = 0; b < NB; ++b) *(unsigned*)(MV + ((size_t)(b * 4 + h) * PADT + pos) * 256 + e) = o3;
  }
  __syncthreads();
}

namespace att {
using f32x16 = __attribute__((ext_vector_type(16))) float;
using s16x4 = __attribute__((ext_vector_type(4))) short;
constexpr int STEPS_BHM = 152, NSTEPS = 32 * STEPS_BHM;
constexpr int SHM_V = 64 * 256 * 2, SHM_K = 64 * 128 * 2;
constexpr int LDS_V = 0, LDS_K = 2 * SHM_V, LDS_Q = LDS_K + SHM_K, LDS_WS = LDS_Q + 8 * 8192;
constexpr float THR2 = 8.0f;
#define KSWZ(row, colB) ((row) * 256 + ((colB) ^ (((row) & 7) << 4)))
#define SBAR() __builtin_amdgcn_sched_barrier(0)
__device__ __forceinline__ int crow(int r, int hi) { return (r & 3) + 8 * (r >> 2) + 4 * hi; }
__device__ __forceinline__ unsigned cvtpk(float lo, float hi) { unsigned r; asm volatile("v_cvt_pk_bf16_f32 %0, %1, %2" : "=v"(r) : "v"(lo), "v"(hi)); return r; }
__device__ __forceinline__ int qb_start(int qb) { return 2 * qb * qb + 3 * qb; }
__device__ __forceinline__ int chunk_of(int s, int NA) { return ((s + 1) * NA - 1) / NSTEPS; }

template <int OFF> __device__ __forceinline__ s16x4 tr_read(int vb) {
  s16x4 r; asm volatile("ds_read_b64_tr_b16 %0, %1 offset:%2" : "=&v"(r) : "v"(vb), "i"(OFF) : "memory"); return r;
}
constexpr int v_rd_off(int d0, int ks, int half) { return d0 * 512 + ks * 8192 + half * 4096; }
template <int D0> __device__ __forceinline__ void pv_one(f32x16& od, int vb, bf16x8 pa0, bf16x8 pa1, bf16x8 pa2, bf16x8 pa3) {
#define PK(L, H) (bf16x8){L[0], L[1], L[2], L[3], H[0], H[1], H[2], H[3]}
  { const s16x4 l0 = tr_read<v_rd_off(D0, 0, 0)>(vb), h0 = tr_read<v_rd_off(D0, 0, 1)>(vb), l1 = tr_read<v_rd_off(D0, 1, 0)>(vb), h1 = tr_read<v_rd_off(D0, 1, 1)>(vb);
    asm volatile("s_waitcnt lgkmcnt(0)" ::: "memory"); SBAR();
    od = __builtin_amdgcn_mfma_f32_32x32x16_bf16(pa0, PK(l0, h0), od, 0, 0, 0);
    od = __builtin_amdgcn_mfma_f32_32x32x16_bf16(pa1, PK(l1, h1), od, 0, 0, 0); }
  SBAR();
  { const s16x4 l2 = tr_read<v_rd_off(D0, 2, 0)>(vb), h2 = tr_read<v_rd_off(D0, 2, 1)>(vb), l3 = tr_read<v_rd_off(D0, 3, 0)>(vb), h3 = tr_read<v_rd_off(D0, 3, 1)>(vb);
    asm volatile("s_waitcnt lgkmcnt(0)" ::: "memory"); SBAR();
    od = __builtin_amdgcn_mfma_f32_32x32x16_bf16(pa2, PK(l2, h2), od, 0, 0, 0);
    od = __builtin_amdgcn_mfma_f32_32x32x16_bf16(pa3, PK(l3, h3), od, 0, 0, 0); }
#undef PK
}

__device__ __forceinline__ void segment(const Frame& F, int bhm, int qb, int j0, int j1, int slot) {
  const int tid = F.tid, wid = F.wave, lane = F.lane, r32 = lane & 31, hi = lane >> 5;
  const bf16* Qg = (const bf16*)(F.ws + WS_Q) + ((size_t)bhm * SEQ + qb * 256 + wid * 32 + r32) * 128 + hi * 8;
  const bf16* Kg = (const bf16*)(F.ws + WS_KP) + (size_t)bhm * 33 * 8192;
  const bf16* Vg = (const bf16*)(F.ws + WS_VP) + (size_t)(bhm >> 1) * PADT * 256;
  LAS unsigned char* lds = F.lds;
  LAS float* wsl = (LAS float*)(lds + LDS_WS) + wid * 64;
  const float slope2 = exp2f(-2.0f * (float)(((bhm >> 1) & 3) + 1)) * LOG2E;
  unsigned ksrc0, vsrc0;
  ksrc0 = (unsigned)tid * 16u;
  { const int a8 = tid >> 8, b = (tid >> 2) & 7, k = 8 * (b >> 2) + 4 * a8 + (b & 3), c = ((tid >> 5) & 7) * 32 + (tid & 3) * 8; vsrc0 = (unsigned)(k * 256 + c) * 2u; }
#define STAGE_K(j) do { const char* kt = (const char*)(Kg + (size_t)(j) * 8192); \
    _Pragma("unroll") for (int _i = 0; _i < 2; ++_i) __builtin_amdgcn_global_load_lds((const unsigned*)(kt + (ksrc0 + _i * 8192u)), (LAS unsigned*)(lds + LDS_K + _i * 8192 + wid * 1024), 16, 0, 0); } while (0)
#define STAGE_V(buf, j) do { const char* vt = (const char*)(Vg + (size_t)(j) * 64 * 256); \
    _Pragma("unroll") for (int _i = 0; _i < 4; ++_i) __builtin_amdgcn_global_load_lds((const unsigned*)(vt + (vsrc0 + _i * 8192u)), (LAS unsigned*)(lds + LDS_V + (buf) * SHM_V + _i * 8192 + wid * 1024), 16, 0, 0); } while (0)
  const int lt = (((r32 << 1) | hi) ^ ((r32 >> 3) & 1)) << 4;
  LAS unsigned char* Qs = lds + LDS_Q + wid * 8192;
#pragma unroll
  for (int d0 = 0; d0 < 8; ++d0) { const bf16x8 qv = *(const bf16x8*)(Qg + d0 * 16); *(LAS bf16x8*)(Qs + d0 * 1024 + lt) = qv; }
  const float hioff = slope2 * (float)(4 * hi);
  f32x16 o[8];
#pragma unroll
  for (int d = 0; d < 8; ++d)
#pragma unroll
    for (int r = 0; r < 16; ++r) o[d][r] = 0.f;
  float m_reg = -1e30f, l_reg = 0.f;
  const int vb0 = (int)(uintptr_t)(lds + LDS_V) + (((lane & 3) << 3) | (((lane >> 2) & 3) << 6) | (((lane >> 4) & 1) << 5) | (((lane >> 5) & 1) << 8));
  const int qrel = wid * 32 + r32;
  STAGE_K(j0); STAGE_V(0, j0);
  VM_WAIT(); __syncthreads();
  for (int j = j0; j < j1; ++j) {
    const int cur = (j - j0) & 1;
    if (j + 1 < j1) STAGE_V(cur ^ 1, j + 1);
    SBAR();
    f32x16 p0 = {}, p1 = {};
    { const LAS unsigned char* Ks = lds + LDS_K;
#pragma unroll
      for (int d0 = 0; d0 < 8; ++d0) {
        const bf16x8 b0 = *(const LAS bf16x8*)(Ks + d0 * 2048 + lt);
        const bf16x8 b1 = *(const LAS bf16x8*)(Ks + d0 * 2048 + 1024 + lt);
        const bf16x8 qf = *(const LAS bf16x8*)(Qs + d0 * 1024 + lt);
        p0 = __builtin_amdgcn_mfma_f32_32x32x16_bf16(b0, qf, p0, 0, 0, 0);
        p1 = __builtin_amdgcn_mfma_f32_32x32x16_bf16(b1, qf, p1, 0, 0, 0); } }
    asm volatile("s_waitcnt lgkmcnt(0)" ::: "memory"); __builtin_amdgcn_s_barrier(); asm volatile("" ::: "memory");
    if (j + 1 < j1) STAGE_K(j + 1);
    SBAR();
    if (j == 0) {
#pragma unroll
      for (int r = 0; r < 16; ++r) p0[r] = -INFINITY;
#pragma unroll
      for (int r = 0; r < 8; ++r) p1[r] = -INFINITY;
    }
    const int jb = j - (4 * qb + 1);
    if (jb >= 0) {
      const int kb = 64 * jb + 4 * hi;
#pragma unroll
      for (int r = 0; r < 16; ++r) { const int kv = kb + (r & 3) + 8 * (r >> 2); if (kv > qrel) p0[r] = -INFINITY; if (kv + 32 > qrel) p1[r] = -INFINITY; }
    }
    const float off0 = slope2 * (float)(64 * j) + hioff, off1 = off0 + 32.0f * slope2;
#pragma unroll
    for (int r = 0; r < 16; ++r) { const float sb = slope2 * (float)((r & 3) + 8 * (r >> 2)); p0[r] += sb; p1[r] += sb; }
    float pm0 = p0[0], pm1 = p1[0];
#pragma unroll
    for (int r = 1; r < 16; ++r) { pm0 = fmaxf(pm0, p0[r]); pm1 = fmaxf(pm1, p1[r]); }
    float pmax = fmaxf(pm0 + off0, pm1 + off1);
    { auto rr = __builtin_amdgcn_permlane32_swap(__float_as_uint(pmax), __float_as_uint(pmax), false, false);
      pmax = fmaxf(__uint_as_float(rr[0]), __uint_as_float(rr[1])); }
    float mn, alpha;
    if (__builtin_expect(__all(pmax - m_reg <= THR2), 1)) { mn = m_reg; alpha = 1.f; }
    else { mn = fmaxf(m_reg, pmax); alpha = __builtin_amdgcn_exp2f(m_reg - mn); m_reg = mn; }
    const float c0 = off0 - mn, c1 = off1 - mn;
    float ps = 0.f;
#pragma unroll
    for (int r = 0; r < 16; ++r) { p0[r] = __builtin_amdgcn_exp2f(p0[r] + c0); p1[r] = __builtin_amdgcn_exp2f(p1[r] + c1); ps += p0[r] + p1[r]; }
    { auto rr = __builtin_amdgcn_permlane32_swap(__float_as_uint(ps), __float_as_uint(ps), false, false);
      ps = __uint_as_float(rr[0]) + __uint_as_float(rr[1]); }
    l_reg = l_reg * alpha + ps;
    if (__any(alpha < 1.f)) { if (hi == 0) wsl[r32] = alpha; asm volatile("s_waitcnt lgkmcnt(0)" ::: "memory");
#pragma unroll
      for (int rg = 0; rg < 4; ++rg) { const f32x4 al = *(const LAS f32x4*)(wsl + 8 * rg + 4 * hi);
#pragma unroll
        for (int d = 0; d < 8; ++d) { o[d][4 * rg + 0] *= al.x; o[d][4 * rg + 1] *= al.y; o[d][4 * rg + 2] *= al.z; o[d][4 * rg + 3] *= al.w; }
        SBAR(); } }
    bf16x8 pa0, pa1, pa2, pa3;
#define PK4(P, BASE, OUT) do { unsigned a0 = cvtpk(P[BASE + 0], P[BASE + 1]), a1 = cvtpk(P[BASE + 2], P[BASE + 3]);   \
    unsigned b0 = cvtpk(P[BASE + 4], P[BASE + 5]), b1 = cvtpk(P[BASE + 6], P[BASE + 7]);                              \
    auto r0 = __builtin_amdgcn_permlane32_swap(a0, b0, false, false); auto r1 = __builtin_amdgcn_permlane32_swap(a1, b1, false, false); \
    v4u w = {r0[0], r1[0], r0[1], r1[1]}; OUT = *reinterpret_cast<bf16x8*>(&w); } while (0)
    PK4(p0, 0, pa0); PK4(p0, 8, pa1); PK4(p1, 0, pa2); PK4(p1, 8, pa3);
#undef PK4
    SBAR();
    { const int vb = vb0 + cur * SHM_V;
      pv_one<0>(o[0], vb, pa0, pa1, pa2, pa3); pv_one<1>(o[1], vb, pa0, pa1, pa2, pa3); pv_one<2>(o[2], vb, pa0, pa1, pa2, pa3); pv_one<3>(o[3], vb, pa0, pa1, pa2, pa3);
      pv_one<4>(o[4], vb, pa0, pa1, pa2, pa3); pv_one<5>(o[5], vb, pa0, pa1, pa2, pa3); pv_one<6>(o[6], vb, pa0, pa1, pa2, pa3); pv_one<7>(o[7], vb, pa0, pa1, pa2, pa3); }
    VM_WAIT(); __syncthreads();
  }
  { int lane2 = threadIdx.x & 63, slot2 = slot; asm volatile("" : "+v"(lane2), "+s"(slot2));
    const int r32e = lane2 & 31, hie = lane2 >> 5;
    float* PO = (float*)(F.ws + WS_PO) + (size_t)slot2 * 256 * 256; float* ML = (float*)(F.ws + WS_ML) + (size_t)slot2 * 512;
    LAS float* wse = (LAS float*)(F.lds + LDS_WS) + wid * 64;
    if (hie == 0) { wse[r32e] = l_reg; ML[(wid * 32 + r32e) * 2] = m_reg; ML[(wid * 32 + r32e) * 2 + 1] = l_reg; }
    asm volatile("s_waitcnt lgkmcnt(0)" ::: "memory");
    char* Ob = (char*)(PO + (size_t)(wid * 32) * 256);
    const unsigned lo = (unsigned)(4 * hie * 256 + r32e) * 4u;
#pragma unroll
    for (int r = 0; r < 16; ++r) { const int rowc = (r & 3) + 8 * (r >> 2); const float lv = wse[rowc + 4 * hie]; const float rl = lv > 0.f ? __builtin_amdgcn_rcpf(lv) : 0.f;
#pragma unroll
      for (int d0 = 0; d0 < 8; ++d0) *(float*)(Ob + (lo + (unsigned)(rowc * 256 + d0 * 32) * 4u)) = o[d0][r] * rl;
      SBAR(); } }
  __syncthreads();
#undef STAGE_K
#undef STAGE_V
}

__device__ __forceinline__ void phase(const Frame& F, int ca, int NA) {
  int s0 = (int)(((long)ca * NSTEPS) / NA); const int s1 = (int)(((long)(ca + 1) * NSTEPS) / NA);
  while (s0 < s1) {
    const int bhm = s0 / STEPS_BHM, rem = s0 - bhm * STEPS_BHM;
    int qb = 0;
#pragma unroll 1
    for (int q = 1; q < 8; ++q) if (rem >= qb_start(q)) qb = q;
    const int j0 = rem - qb_start(qb), nst = 4 * qb + 5;
    const int j1 = (j0 + (s1 - s0) < nst) ? j0 + (s1 - s0) : nst;
    const int slot = bhm * 16 + qb + chunk_of(s0, NA) - chunk_of(bhm * STEPS_BHM, NA);
    segment(F, bhm, qb, j0, j1, slot);
    s0 += j1 - j0;
  }
}
#undef KSWZ
#undef SBAR
}
__device__ __forceinline__ void p3_combine(const Frame& F, const Args& a, int NA) {
  const float* PO = (const float*)(F.ws + WS_PO); const float* ML = (const float*)(F.ws + WS_ML); const float* HM = (const float*)(F.ws + WS_HM);
  const bf16* MO = (const bf16*)(F.ws + WS_MO); bf16* A2 = (bf16*)(F.ws + WS_A2);
  const float lam = *(const float*)(F.ws + WS_LAM);
  const float* subg = a.in[IN_SUBG]; const float* og = a.in[IN_OUTG];
  const int gw = blockIdx.x * NWAVES + F.wave, NGW = gridDim.x * NWAVES, lane = F.lane;
  const f32x4 sg = ((const f32x4*)subg)[lane];
  for (int R = gw; R < MROWS; R += NGW) {
    const int b = R >> 11, t = R & 2047, qb = t >> 8, rq = t & 255;
#pragma unroll 1
    for (int h = 0; h < 4; ++h) {
      f32x4 om[2];
#pragma unroll
      for (int m = 0; m < 2; ++m) {
        const int bhm = (b * 4 + h) * 2 + m, first = bhm * att::STEPS_BHM + att::qb_start(qb), last = first + 4 * qb + 4;
        const int cf = att::chunk_of(first, NA), np = att::chunk_of(last, NA) - cf + 1, slot0 = bhm * 16 + qb + cf - att::chunk_of(bhm * att::STEPS_BHM, NA);
        float mp[3], lp[3]; f32x4 op[3];
#pragma unroll
        for (int p = 0; p < 3; ++p) { if (p < np) { const int slot = slot0 + p; mp[p] = ML[(size_t)slot * 512 + rq * 2]; lp[p] = ML[(size_t)slot * 512 + rq * 2 + 1];
            op[p] = ((const f32x4*)(PO + ((size_t)slot * 256 + rq) * 256))[lane]; } else { mp[p] = -1e30f; lp[p] = 0.f; op[p] = (f32x4){0.f, 0.f, 0.f, 0.f}; } }
        const float M = fmaxf(mp[0], fmaxf(mp[1], mp[2]));
        float wsum = 0.f; f32x4 acc = (f32x4){0.f, 0.f, 0.f, 0.f};
#pragma unroll
        for (int p = 0; p < 3; ++p) { const float w = lp[p] * exp2f(mp[p] - M); wsum += w; acc += op[p] * w; }
        om[m] = acc * (1.0f / wsum);
      }
      const f32x4 o = om[0] - om[1] * lam;
      const float rs = rsqrtf(wave_sum((o.x * o.x + o.y * o.y) + (o.z * o.z + o.w * o.w)) * (1.0f / 256.f) + EPS) * 0.8f;
      v2u w; w.x = pk2(o.x * rs * sg.x, o.y * rs * sg.y); w.y = pk2(o.z * rs * sg.z, o.w * rs * sg.w);
      ((v2u*)(A2 + (size_t)R * DM + h * 256))[lane] = w;
      const f32x4 hv = ((const f32x4*)(HM + (size_t)R * 1024 + h * 256))[lane];
      const float rh = rsqrtf(wave_sum((hv.x * hv.x + hv.y * hv.y) + (hv.z * hv.z + hv.w * hv.w)) * (1.0f / 256.f) + EPS);
      const f32x4 g = ((const f32x4*)(og + h * 256))[lane];
      const v2u mo = ((const v2u*)(MO + (size_t)R * 1024 + h * 256))[lane];
      v2u w2; w2.x = pk2(hv.x * rh * g.x * bflo(mo.x), hv.y * rh * g.y * bfhi(mo.x)); w2.y = pk2(hv.z * rh * g.z * bflo(mo.y), hv.w * rh * g.w * bfhi(mo.y));
      ((v2u*)(A2 + (size_t)R * DM + 1024 + h * 256))[lane] = w2;
    }
  }
}
struct EpiRes {
  static constexpr bool PERM = true, AFTER_DRAIN = false;
  const float* x; float* out; bf16* H1b; float* SSQ;
  __device__ __forceinline__ void operator()(const pg8::f32x4 (&acc)[2][2][4][2], const pg8::Unit& u, int wr, int wc, int fr, int fq) const {
    const int row0 = u.pm * 256 + wr * 64 + fr, col0 = u.pn * 256 + wc * 32 + 8 * fq;
#pragma unroll
    for (int ai = 0; ai < 2; ++ai)
#pragma unroll
      for (int m = 0; m < 4; ++m) { const size_t R = (size_t)(row0 + ai * 128 + m * 16); float s = 0.f;
#pragma unroll
        for (int bj = 0; bj < 2; ++bj) { const size_t off = R * DM + col0 + bj * 128;
          const f32x4 x0 = *(const f32x4*)(x + off), x1 = *(const f32x4*)(x + off + 4);
          const f32x4 v0 = acc[ai][bj][m][0] + x0, v1 = acc[ai][bj][m][1] + x1;
          *(f32x4*)(out + off) = v0; *(f32x4*)(out + off + 4) = v1;
          v4u w; w.x = pk2(v0.x, v0.y); w.y = pk2(v0.z, v0.w); w.z = pk2(v1.x, v1.y); w.w = pk2(v1.z, v1.w);
          *(v4u*)(H1b + off) = w;
          s += (v0.x * v0.x + v0.y * v0.y) + (v0.z * v0.z + v0.w * v0.w) + (v1.x * v1.x + v1.y * v1.y) + (v1.z * v1.z + v1.w * v1.w); }
        s += __shfl_xor(s, 16); s += __shfl_xor(s, 32);
        if (fq == 0) SSQ[R * 32 + u.pn * 4 + wc] = s; }
  }
};
__global__ void __launch_bounds__(NTHR, 2) mk_fwd(Args args) {
  extern __shared__ __attribute__((aligned(16))) unsigned char lds_raw[];
  Frame F; F.lds = (LAS unsigned char*)lds_raw; F.ws = args.ws; F.tid = threadIdx.x; F.lane = F.tid & 63; F.wave = __builtin_amdgcn_readfirstlane(F.tid >> 6);
  const int lo = args.ph_lo, hi = args.ph_hi;
#define IN(k) (lo <= (k) && (k) < hi)
  if (IN(0)) {
    p0_lam(F, args);
    p0_zero_vpad(F);
    p0_metaproj(F, args);
    p0_rows(F, args);
    p0_transpose(F, args.in[IN_WIN], DPROJ, NPROJ, (bf16*)(F.ws + WS_W1T));
    p0_transpose(F, args.in[IN_WOUT], DM, DM, (bf16*)(F.ws + WS_W2T));
  }
  if (IN(1)) {
    p1_meta_finalize(F, args);
    pg8::Gemm g{(const pg8::bf16_t*)(F.ws + WS_XN), (const pg8::bf16_t*)(F.ws + WS_W1T), MROWS, NPROJ, DM};
    pg8::StaticOrder S; S.init(MROWS, NPROJ, (int)gridDim.x, (int)blockIdx.x);
    EpiProj E{(bf16*)(F.ws + WS_Q), (bf16*)(F.ws + WS_KP), (bf16*)(F.ws + WS_VP), (bf16*)(F.ws + WS_MQ), (bf16*)(F.ws + WS_MK), (bf16*)(F.ws + WS_MV), (bf16*)(F.ws + WS_MO),
              args.in[IN_QNG], args.in[IN_KNG], (LAS float*)(F.lds + XCH_OFF)};
    pg8::gemm_phase<EpiProj, pg8::StaticOrder, true, true>(F.lds + RING_OFF, g, S, E);
  }
  if (IN(2)) {
    att::phase(F, (int)blockIdx.x, (int)gridDim.x);
  }
  if (IN(3)) {
    p3_combine(F, args, args.na);
  }
  if (IN(4)) {
    pg8::Gemm g{(const pg8::bf16_t*)(F.ws + WS_A2), (const pg8::bf16_t*)(F.ws + WS_W2T), MROWS, DM, DM};
    pg8::StaticOrder S; S.init(MROWS, DM, (int)gridDim.x, (int)blockIdx.x);
    EpiRes E{args.in[IN_X], args.out, (bf16*)(F.ws + WS_H1B), (float*)(F.ws + WS_SSQ)};
    pg8::gemm_phase<EpiRes, pg8::StaticOrder, true, true>(F.lds + RING_OFF, g, S, E);
  }
#undef IN
}
namespace nv {
constexpr int TT = 2064;

__device__ __forceinline__ float block_sum(float v, float* red) {
  for (int o = 32; o > 0; o >>= 1) v += __shfl_xor(v, o);
  __syncthreads();
  if ((threadIdx.x & 63) == 0) red[threadIdx.x >> 6] = v;
  __syncthreads();
  return red[0] + red[1] + red[2] + red[3];
}
__device__ __forceinline__ float block_max(float v, float* red) {
  for (int o = 32; o > 0; o >>= 1) v = fmaxf(v, __shfl_xor(v, o));
  __syncthreads();
  if ((threadIdx.x & 63) == 0) red[threadIdx.x >> 6] = v;
  __syncthreads();
  return fmaxf(fmaxf(red[0], red[1]), fmaxf(red[2], red[3]));
}

__global__ __launch_bounds__(256) void k_norm(const float* __restrict__ h, const float* __restrict__ g, float* __restrict__ xn) {
  __shared__ float red[4];
  const int r = blockIdx.x, tid = threadIdx.x;
  float v[8]; float ss = 0.f;
#pragma unroll
  for (int i = 0; i < 8; ++i) { v[i] = h[(size_t)r * DM + tid + 256 * i]; ss += v[i] * v[i]; }
  ss = block_sum(ss, red);
  const float rs = rsqrtf(ss * (1.0f / DM) + EPS);
#pragma unroll
  for (int i = 0; i < 8; ++i) { const int c = tid + 256 * i; xn[(size_t)r * DM + c] = v[i] * rs * g[c]; }
}

__global__ __launch_bounds__(256) void k_gemm(const float* __restrict__ A, int lda, const float* __restrict__ B, int ldb,
                                               float* C, int ldc, const float* R, int ldr, int M, int N, int K) {
  __shared__ __attribute__((aligned(16))) unsigned short As[128][40];
  __shared__ __attribute__((aligned(16))) unsigned short Bs[128][40];
  const int tid = threadIdx.x, wid = tid >> 6, lane = tid & 63, wr = wid >> 1, wc = wid & 1, fr = lane & 15, fq = lane >> 4;
  const int m0 = blockIdx.y * 128, n0 = blockIdx.x * 128;
  f32x4 acc[4][4];
#pragma unroll
  for (int i = 0; i < 4; ++i)
#pragma unroll
    for (int j = 0; j < 4; ++j) acc[i][j] = (f32x4){0.f, 0.f, 0.f, 0.f};
  const int arow = tid >> 1, akk = (tid & 1) * 16;
  const int bk = tid >> 3, bn0 = (tid & 7) * 16;
  for (int k0 = 0; k0 < K; k0 += 32) {
    {
      float4 a[4];
      const bool ok = (m0 + arow) < M;
#pragma unroll
      for (int i = 0; i < 4; ++i) a[i] = ok ? *(const float4*)(A + (size_t)(m0 + arow) * lda + k0 + akk + 4 * i) : make_float4(0.f, 0.f, 0.f, 0.f);
#pragma unroll
      for (int i = 0; i < 4; ++i) { As[arow][akk + 4 * i + 0] = (unsigned short)f2bf(a[i].x); As[arow][akk + 4 * i + 1] = (unsigned short)f2bf(a[i].y); As[arow][akk + 4 * i + 2] = (unsigned short)f2bf(a[i].z); As[arow][akk + 4 * i + 3] = (unsigned short)f2bf(a[i].w); }
      float4 bv[4];
#pragma unroll
      for (int i = 0; i < 4; ++i) { const int n = n0 + bn0 + 4 * i; bv[i] = (n < N) ? *(const float4*)(B + (size_t)(k0 + bk) * ldb + n) : make_float4(0.f, 0.f, 0.f, 0.f); }
#pragma unroll
      for (int i = 0; i < 4; ++i) { Bs[bn0 + 4 * i + 0][bk] = (unsigned short)f2bf(bv[i].x); Bs[bn0 + 4 * i + 1][bk] = (unsigned short)f2bf(bv[i].y); Bs[bn0 + 4 * i + 2][bk] = (unsigned short)f2bf(bv[i].z); Bs[bn0 + 4 * i + 3][bk] = (unsigned short)f2bf(bv[i].w); }
    }
    __syncthreads();
    bf16x8 af[4], bfr[4];
#pragma unroll
    for (int i = 0; i < 4; ++i) af[i] = *(const bf16x8*)&As[wr * 64 + i * 16 + fr][fq * 8];
#pragma unroll
    for (int j = 0; j < 4; ++j) bfr[j] = *(const bf16x8*)&Bs[wc * 64 + j * 16 + fr][fq * 8];
#pragma unroll
    for (int i = 0; i < 4; ++i)
#pragma unroll
      for (int j = 0; j < 4; ++j) acc[i][j] = __builtin_amdgcn_mfma_f32_16x16x32_bf16(af[i], bfr[j], acc[i][j], 0, 0, 0);
    __syncthreads();
  }
#pragma unroll
  for (int i = 0; i < 4; ++i)
#pragma unroll
    for (int j = 0; j < 4; ++j)
#pragma unroll
      for (int e = 0; e < 4; ++e) {
        const int row = m0 + wr * 64 + i * 16 + fq * 4 + e, col = n0 + wc * 64 + j * 16 + fr;
        if (row < M && col < N) { float v = acc[i][j][e]; if (R) v += R[(size_t)row * ldr + col]; C[(size_t)row * ldc + col] = v; }
      }
}

__global__ __launch_bounds__(256) void k_route(const float* __restrict__ pq, const float* __restrict__ subkeys, int* __restrict__ oidx, float* __restrict__ og) {
  __shared__ __attribute__((aligned(16))) float qv[2048];
  __shared__ float s[2][128];
  __shared__ float sv[2][16]; __shared__ int si[2][16];
  __shared__ float cand[256]; __shared__ int cidx[256];
  __shared__ float tv[16]; __shared__ int ti[16];
  const size_t r = blockIdx.x; const int tid = threadIdx.x, lane = tid & 63, wid = tid >> 6;
  for (int i = tid; i < 2048; i += 256) qv[i] = pq[r * 2048 + i];
  __syncthreads();
  for (int hh = 0; hh < 8; ++hh) {
    { const int p = tid >> 7, k = tid & 127;
      const float4* sk = (const float4*)(subkeys + ((size_t)((hh * 2 + p) * 128 + k)) * 128);
      const float4* qq = (const float4*)(qv + hh * 256 + p * 128);
      float d = 0.f;
#pragma unroll 8
      for (int c = 0; c < 32; ++c) { const float4 a = sk[c], q4 = qq[c]; d += a.x * q4.x + a.y * q4.y + a.z * q4.z + a.w * q4.w; }
      s[p][k] = d; }
    __syncthreads();
    if (wid < 2) {
      const int p = wid; float v0 = s[p][lane], v1 = s[p][lane + 64];
      for (int it = 0; it < 16; ++it) {
        float bv = v0; int bi = lane; if (v1 > bv) { bv = v1; bi = lane + 64; }
        for (int o = 32; o > 0; o >>= 1) { const float ov = __shfl_xor(bv, o); const int oi = __shfl_xor(bi, o); if (ov > bv || (ov == bv && oi < bi)) { bv = ov; bi = oi; } }
        if (lane == 0) { sv[p][it] = bv; si[p][it] = bi; }
        if (bi == lane) v0 = -INFINITY; if (bi == lane + 64) v1 = -INFINITY;
      }
    }
    __syncthreads();
    { const int i = tid >> 4, j = tid & 15; cand[tid] = sv[0][i] + sv[1][j]; cidx[tid] = si[0][i] * 128 + si[1][j]; }
    __syncthreads();
    if (wid == 0) {
      float v[4]; for (int q = 0; q < 4; ++q) v[q] = cand[lane + 64 * q];
      for (int it = 0; it < 16; ++it) {
        float bv = v[0]; int bi = lane;
        for (int q = 1; q < 4; ++q) if (v[q] > bv) { bv = v[q]; bi = lane + 64 * q; }
        for (int o = 32; o > 0; o >>= 1) { const float ov = __shfl_xor(bv, o); const int oi = __shfl_xor(bi, o); if (ov > bv || (ov == bv && oi < bi)) { bv = ov; bi = oi; } }
        if (lane == 0) { tv[it] = bv; ti[it] = cidx[bi]; }
        for (int q = 0; q < 4; ++q) if (bi == lane + 64 * q) v[q] = -INFINITY;
      }
      const float mx = tv[0];
      float e = lane < 16 ? expf(tv[lane] - mx) : 0.f; float sm = e;
      for (int o = 32; o > 0; o >>= 1) sm += __shfl_xor(sm, o);
      if (lane < 16) { oidx[r * 128 + hh * 16 + lane] = ti[lane]; og[r * 128 + hh * 16 + lane] = e / sm; }
    }
    __syncthreads();
  }
}

__global__ __launch_bounds__(256) void k_attn2(const bf16* __restrict__ Qb, const bf16* __restrict__ Kp, const bf16* __restrict__ Vp,
                                                const float* __restrict__ lamp, const float* __restrict__ subg, float* __restrict__ ao) {
  __shared__ float sc[2][TT];
  __shared__ float qs[256];
  __shared__ float red[4];
  const int t = blockIdx.x, h = blockIdx.y, b = blockIdx.z, tid = threadIdx.x;
  const int cnt = t + 17;
  const float slope2 = exp2f(-2.0f * (h + 1)) * LOG2E;
  qs[tid] = bf2f(Qb[((size_t)((b * 4 + h) * 2 + (tid >> 7)) * SEQ + t) * 128 + (tid & 127)]);
  __syncthreads();
  float stat_l[2];
  for (int m = 0; m < 2; ++m) {
    float mx = -INFINITY;
    for (int s = tid; s < cnt; s += 256) {
      float d = 0.f;
#pragma unroll 4
      for (int i = 0; i < 16; ++i) { const v4u kk = *(const v4u*)(Kp + kp_off((b * 4 + h) * 2 + m, MPOS0 + s, i * 8)); const float* q = qs + m * 128 + i * 8;
        d += bflo(kk.x) * q[0] + bfhi(kk.x) * q[1] + bflo(kk.y) * q[2] + bfhi(kk.y) * q[3] + bflo(kk.z) * q[4] + bfhi(kk.z) * q[5] + bflo(kk.w) * q[6] + bfhi(kk.w) * q[7]; }
      d -= slope2 * (float)(cnt - 1 - s);
      sc[m][s] = d; mx = fmaxf(mx, d);
    }
    mx = block_max(mx, red);
    float sm = 0.f;
    for (int s = tid; s < cnt; s += 256) { const float e = exp2f(sc[m][s] - mx); sc[m][s] = e; sm += e; }
    sm = block_sum(sm, red);
    stat_l[m] = sm;
  }
  const float lam = lamp[0];
  const float i0 = 1.0f / stat_l[0], i1 = lam / stat_l[1];
  __syncthreads();
  for (int s = tid; s < cnt; s += 256) sc[0][s] = sc[0][s] * i0 - sc[1][s] * i1;
  __syncthreads();
  float o = 0.f;
  const bf16* vp = Vp + ((size_t)(b * 4 + h) * PADT + MPOS0) * 256 + tid;
  for (int s = 0; s < cnt; ++s) o += sc[0][s] * bf2f(vp[(size_t)s * 256]);
  float ss = block_sum(o * o, red);
  const float rs = rsqrtf(ss * (1.0f / 256.f) + EPS);
  ao[((size_t)b * SEQ + t) * 1024 + h * 256 + tid] = o * rs * subg[tid] * 0.8f;
}
__global__ __launch_bounds__(256) void k_conv2(const bf16* __restrict__ MQ, const bf16* __restrict__ MK, const float* __restrict__ cw, const float* __restrict__ cb, float* __restrict__ mqk) {
  const size_t i = (size_t)blockIdx.x * 256 + threadIdx.x;
  const int c = (int)(i & 1023); const size_t rr = i >> 10; if (rr >= (size_t)NB * TT) return;
  const int b = (int)(rr / TT), sp = (int)(rr % TT);
  const bool isk = c >= 512; const int cc = c & 511, h = cc >> 7, d = cc & 127;
  const bf16* src = (isk ? MK : MQ) + ((size_t)(b * 4 + h) * PADT + MPOS0) * 128 + d;
  float y = cb[c];
#pragma unroll
  for (int j = 0; j < 4; ++j) { const int s2 = sp - 3 + j; if (s2 >= 0) y += cw[j * 1024 + c] * bf2f(src[(size_t)s2 * 128]); }
  mqk[i] = y / (1.0f + expf(-y));
}
__global__ __launch_bounds__(512) void k_mlstm2(const float* __restrict__ mqk, const bf16* __restrict__ MV, const float* __restrict__ LI, const float* __restrict__ LF, float* __restrict__ hm) {
  __shared__ float qs[128], ks[128], ns[128], dens[1];
  const int b = blockIdx.x >> 2, h = blockIdx.x & 3, tid = threadIdx.x, e = tid >> 1, half = tid & 1;
  float C[64];
#pragma unroll
  for (int i = 0; i < 64; ++i) C[i] = 0.f;
  if (tid < 128) ns[tid] = 0.f;
  float m = 0.f;
  for (int sp = 0; sp < TT; ++sp) {
    const size_t rr = (size_t)b * TT + sp;
    __syncthreads();
    if (tid < 128) { qs[tid] = mqk[rr * 1024 + h * 128 + tid]; ks[tid] = mqk[rr * 1024 + 512 + h * 128 + tid] * 0.08838834764831845f; }
    const float li = LI[(b * 4 + h) * PADT + MPOS0 + sp], lf = LF[(b * 4 + h) * PADT + MPOS0 + sp];
    const float mn = fmaxf(lf + m, li);
    const float fp = expf(lf + m - mn), ip = expf(li - mn);
    m = mn;
    const float ve = bf2f(MV[((size_t)(b * 4 + h) * PADT + MPOS0 + sp) * 256 + e]);
    __syncthreads();
    if (tid < 128) ns[tid] = fp * ns[tid] + ip * ks[tid];
    float num = 0.f; const float iv = ip * ve;
#pragma unroll
    for (int i = 0; i < 64; ++i) { C[i] = fp * C[i] + iv * ks[half * 64 + i]; num += qs[half * 64 + i] * C[i]; }
    num += __shfl_xor(num, 1);
    __syncthreads();
    if (tid < 64) { float d = qs[tid] * ns[tid] + qs[tid + 64] * ns[tid + 64]; for (int o = 32; o > 0; o >>= 1) d += __shfl_xor(d, o); if (tid == 0) dens[0] = d; }
    __syncthreads();
    const float den = dens[0];
    if (half == 0 && sp >= NMETA) hm[((size_t)b * SEQ + sp - NMETA) * 1024 + h * 256 + e] = num / fmaxf(fabsf(den), expf(-m));
  }
}
__global__ __launch_bounds__(256) void k_mix2(const float* __restrict__ ao, const float* __restrict__ hm, const bf16* __restrict__ MO, const float* __restrict__ og, float* __restrict__ A2) {
  __shared__ float red[4];
  const size_t r = blockIdx.x; const int tid = threadIdx.x;
  for (int h = 0; h < 4; ++h) {
    A2[r * DM + h * 256 + tid] = ao[r * 1024 + h * 256 + tid];
    const float v = hm[r * 1024 + h * 256 + tid];
    const float ss = block_sum(v * v, red);
    const float rs = rsqrtf(ss * (1.0f / 256.f) + EPS);
    A2[r * DM + 1024 + h * 256 + tid] = v * rs * og[h * 256 + tid] * bf2f(MO[r * 1024 + h * 256 + tid]);
  }
}
__global__ __launch_bounds__(256) void k_peer2(const float* __restrict__ xn, const int* __restrict__ idx, const float* __restrict__ gg,
                                                const float* __restrict__ U, const float* __restrict__ V, float* out) {
  __shared__ __attribute__((aligned(16))) float xs[2048];
  __shared__ float act[128]; __shared__ int eid[128];
  const int tid = threadIdx.x, lane = tid & 63, wid = tid >> 6;
  const size_t r = blockIdx.x;
  for (int i = tid; i < 2048; i += 256) xs[i] = xn[r * 2048 + i];
  if (tid < 128) eid[tid] = idx[r * 128 + tid];
  __syncthreads();
  for (int q = 0; q < 32; ++q) {
    const int e = wid * 32 + q; const float4* up = (const float4*)(U + (size_t)eid[e] * 2048);
    float d = 0.f;
#pragma unroll
    for (int i = 0; i < 8; ++i) { const float4 a = up[i * 64 + lane], x4 = ((const float4*)xs)[i * 64 + lane]; d += a.x * x4.x + a.y * x4.y + a.z * x4.z + a.w * x4.w; }
    for (int o = 32; o > 0; o >>= 1) d += __shfl_xor(d, o);
    if (lane == 0) act[e] = 0.5f * d * (1.0f + erff(d * 0.7071067811865476f)) * gg[r * 128 + e];
  }
  __syncthreads();
  float4 y0 = make_float4(0.f, 0.f, 0.f, 0.f), y1 = y0;
  for (int e = 0; e < 128; ++e) {
    const float a = act[e]; const float4* vp = (const float4*)(V + (size_t)eid[e] * 2048);
    const float4 v0 = vp[tid], v1 = vp[256 + tid];
    y0.x += a * v0.x; y0.y += a * v0.y; y0.z += a * v0.z; y0.w += a * v0.w;
    y1.x += a * v1.x; y1.y += a * v1.y; y1.z += a * v1.z; y1.w += a * v1.w;
  }
  float4* op = (float4*)(out + r * 2048);
  float4 a0 = op[tid], a1 = op[256 + tid];
  a0.x += y0.x; a0.y += y0.y; a0.z += y0.z; a0.w += y0.w; a1.x += y1.x; a1.y += y1.y; a1.z += y1.z; a1.w += y1.w;
  op[tid] = a0; op[256 + tid] = a1;
}
__global__ void k_bf2f(const bf16* __restrict__ in, float* __restrict__ out, size_t n) {
  for (size_t i = (size_t)blockIdx.x * 256 + threadIdx.x; i < n; i += (size_t)gridDim.x * 256) out[i] = bf2f(in[i]);
}
}
extern "C" void kernel_launch(void* const* d_in, const int* in_sizes, int n_in, void* d_out, int out_size, void* d_ws, size_t ws_size, hipStream_t stream) {
  static int grid = 0;
  if (grid == 0) {
    int dev = 0, cus = 0, per_cu = 0;
    if (hipGetDevice(&dev) != hipSuccess || hipDeviceGetAttribute(&cus, hipDeviceAttributeMultiprocessorCount, dev) != hipSuccess) { fprintf(stderr, "device query failed\n"); grid = -1; return; }
    if (hipFuncSetAttribute((const void*)mk_fwd, hipFuncAttributeMaxDynamicSharedMemorySize, LDS_BYTES) != hipSuccess) { fprintf(stderr, "hipFuncSetAttribute failed\n"); grid = -1; return; }
    if (hipOccupancyMaxActiveBlocksPerMultiprocessor(&per_cu, (const void*)mk_fwd, NTHR, LDS_BYTES) != hipSuccess || per_cu < 1) { fprintf(stderr, "occupancy query: %d\n", per_cu); per_cu = 1; }
    (void)hipGetLastError();
    grid = cus * 1;
    if (ws_size < (size_t)480 * MiB) { fprintf(stderr, "ws too small %zu\n", ws_size); grid = -1; return; }
  }
  if (grid < 0) return;
  unsigned char* ws = (unsigned char*)d_ws;
  hipMemsetAsync(ws + WS_CTL, 0, CTL_ZERO_BYTES, stream);
  Args a{};
  for (int i = 0; i < 22; ++i) a.in[i] = (const float*)d_in[i];
  a.out = (float*)d_out; a.ws = ws; a.na = grid;
  using namespace nv;
  float* out = (float*)d_out;
  float* hm = (float*)(ws + WS_HM); float* mqk = (float*)(ws + 402 * MiB);
  float* xn2 = (float*)(ws + 42 * MiB); float* pq = (float*)(ws + 107 * MiB);
  int* ridx = (int*)(ws + 435 * MiB); float* rg = (float*)(ws + 439 * MiB);
  const bf16* MQ = (const bf16*)(ws + WS_MQ); const bf16* MK = (const bf16*)(ws + WS_MK); const bf16* MV = (const bf16*)(ws + WS_MV);
  const float* LI = (const float*)(ws + WS_LI); const float* LF = (const float*)(ws + WS_LF);
#define PH(k) do { a.ph_lo = (k); a.ph_hi = (k) + 1; hipLaunchKernelGGL(mk_fwd, dim3(grid), dim3(NTHR), LDS_BYTES, stream, a); } while (0)
  PH(0); PH(1); PH(2);
  k_conv2<<<NB * TT * 4, 256, 0, stream>>>(MQ, MK, a.in[IN_CW], a.in[IN_CB], mqk);
  k_mlstm2<<<16, 512, 0, stream>>>(mqk, MV, LI, LF, hm);
  PH(3); PH(4);
  k_norm<<<MROWS, 256, 0, stream>>>(out, a.in[IN_G2], xn2);
  k_gemm<<<dim3(DM / 128, MROWS / 128), 256, 0, stream>>>(xn2, DM, a.in[IN_WQ], DM, pq, DM, nullptr, 0, MROWS, DM, DM);
  k_route<<<MROWS, 256, 0, stream>>>(pq, a.in[IN_SUBK], ridx, rg);
  k_peer2<<<MROWS, 256, 0, stream>>>(xn2, ridx, rg, a.in[IN_U], a.in[IN_V], out);
#undef PH
}
```

```cpp
#include <hip/hip_runtime.h>
#include <cstdio>
#include <cstdint>
#include <math.h>
namespace pg8 {
#define PG8_LAS __attribute__((address_space(3)))
typedef unsigned short bf16_t;
typedef short bf16x8 __attribute__((ext_vector_type(8)));
typedef float f32x4 __attribute__((ext_vector_type(4)));
typedef unsigned u32x4 __attribute__((ext_vector_type(4)));
constexpr int BM = 256, BK = 64, HALF = 128, HTB = HALF * BK * 2  , STAGE_BYTES = 8 * HTB, NXCD = 8, WGM = 8;

__host__ __device__ __forceinline__ int lds_byte(int r, int c) { const int st = (r >> 4) * 2 + (c >> 5), rr = r & 15, cc = c & 31, ob = rr * 64 + cc * 2; return st * 1024 + (ob ^ (((ob >> 9) & 1) << 5)); }
__host__ __device__ __forceinline__ void stage_rc(int b, int& R, int& C) { const int st = b / 1024, sb = b % 1024, swz = sb ^ (((sb >> 9) & 1) << 5); R = (st >> 1) * 16 + swz / 64; C = (st & 1) * 32 + (swz % 64) / 2; }
__host__ __device__ __forceinline__ int perm32(int rho) { const int n = rho >> 4, i = rho & 15; return 8 * (i >> 2) + 4 * n + (i & 3); }

struct Unit { int pm, pn; };
struct Gemm { const bf16_t* A; const bf16_t* Bt; int M, N, K; };

struct StaticOrder {
    int nM, nN, nwg, G, c;
    __host__ __device__ void init(int M, int N, int G_, int c_) { nM = M / BM; nN = N / BM; nwg = nM * nN; G = G_; c = c_; }
    __host__ __device__ bool next(int i, Unit& u) const {
        const long L = (long)i * G + c; if (L >= nwg) return false;
        int wgid = (int)L; { const int q = nwg / NXCD, r = nwg % NXCD, xcd = wgid % NXCD, off = wgid / NXCD; wgid = (xcd < r ? xcd * (q + 1) : r * (q + 1) + (xcd - r) * q) + off; }
        const int nig = WGM * nN, gid = wgid / nig, fm = gid * WGM, gsz = (nM - fm) < WGM ? (nM - fm) : WGM;
        u.pm = fm + ((wgid % nig) % gsz); u.pn = (wgid % nig) / gsz; return true;
    }
    __device__ __forceinline__ void a_ready(const Unit&) const {}
    __device__ __forceinline__ void done(const Unit&) const {}
};

__device__ __forceinline__ unsigned cvt_pk_bf16(float lo, float hi) { unsigned r; asm volatile("v_cvt_pk_bf16_f32 %0, %1, %2" : "=v"(r) : "v"(lo), "v"(hi)); return r; }
typedef float f32x2 __attribute__((ext_vector_type(2)));
template <class Epi, class Sched, bool ALIGN_EPI = false, bool SP2 = false>
__device__ __forceinline__ void gemm_phase(PG8_LAS unsigned char* lds, const Gemm g, const Sched& S, const Epi& E) {
    const int tid = threadIdx.x, wid = __builtin_amdgcn_readfirstlane(tid >> 6), lane = tid & 63, wr = wid >> 2, wc = wid & 3, fr = lane & 15, fq = lane >> 4;
    const int K = g.K, nt = K / BK;
    unsigned voffA[2], voffB[2];
#pragma unroll
    for (int i = 0; i < 2; ++i) { int R, C; stage_rc(tid * 16 + i * 8192, R, C); const int Rb = Epi::PERM ? ((R & ~31) + perm32(R & 31)) : R;
        voffA[i] = (unsigned)(R * K + C) * 2u; voffB[i] = (unsigned)(Rb * K + C) * 2u; }
    const size_t kstep = (size_t)(BK * 2);
    const size_t hstep = (size_t)HALF * K * 2;
    const size_t tstep = 2 * hstep;
    const unsigned ldsw = (unsigned)wid * 1024u;
    const int aoff = lds_byte(wr * 64 + fr, fq * 8), boff = lds_byte(wc * 32 + fr, fq * 8);
#define PG8_SA(b, h) (((b) * 2 + (h)) * HTB)
#define PG8_SB(b, h) ((4 + (b) * 2 + (h)) * HTB)
#define PG8_STAGE(bufoff, gbase, voff) do { _Pragma("unroll") for (int _i = 0; _i < 2; ++_i) \
        __builtin_amdgcn_global_load_lds((const unsigned*)((const char*)(gbase) + (voff)[_i]), (PG8_LAS unsigned*)(lds + (bufoff) + ldsw + _i * 8192), 16, 0, 0); } while (0)
#define PG8_LDA(dst, b, h) do { _Pragma("unroll") for (int m = 0; m < 4; ++m) _Pragma("unroll") for (int k = 0; k < 2; ++k) dst[m][k] = *(const PG8_LAS bf16x8*)(lds + PG8_SA(b, h) + aoff + m * 2048 + k * 1024); } while (0)
#define PG8_LDB(dst, b, h) do { _Pragma("unroll") for (int n = 0; n < 2; ++n) _Pragma("unroll") for (int k = 0; k < 2; ++k) dst[n][k] = *(const PG8_LAS bf16x8*)(lds + PG8_SB(b, h) + boff + n * 2048 + k * 1024); } while (0)
#define PG8_MMA(ai, bj, At, Bt) do { __builtin_amdgcn_s_setprio(1); _Pragma("unroll") for (int m = 0; m < 4; ++m) _Pragma("unroll") for (int n = 0; n < 2; ++n) _Pragma("unroll") for (int k = 0; k < 2; ++k) \
        acc[ai][bj][m][n] = __builtin_amdgcn_mfma_f32_16x16x32_bf16(Bt[n][k], At[m][k], acc[ai][bj][m][n], 0, 0, 0); __builtin_amdgcn_s_setprio(0); } while (0)
#define PG8_WAIT_V(n) asm volatile("s_waitcnt vmcnt(" #n ")" ::: "memory")
#define PG8_WAIT_L(n) asm volatile("s_waitcnt lgkmcnt(" #n ")" ::: "memory")
#define PG8_BAR __builtin_amdgcn_s_barrier()
#define PG8_SCHED __builtin_amdgcn_sched_barrier(0)
    Unit cur, nxt; int ui = 0;
    if (!S.next(0, cur)) return;
    f32x4 acc[2][2][4][2];
#pragma unroll
    for (int a = 0; a < 2; ++a)
#pragma unroll
        for (int b = 0; b < 2; ++b)
#pragma unroll
            for (int m = 0; m < 4; ++m)
#pragma unroll
                for (int n = 0; n < 2; ++n) acc[a][b][m][n] = (f32x4){0.f, 0.f, 0.f, 0.f};
    bf16x8 At[4][2], B0[2][2], B1[2][2];
    const char* cA = (const char*)g.A + (size_t)cur.pm * tstep; const char* cB = (const char*)g.Bt + (size_t)cur.pn * tstep;
    S.a_ready(cur);
    if constexpr (SP2) {
        PG8_STAGE(PG8_SB(0, 0), cB, voffB); PG8_STAGE(PG8_SB(0, 1), cB + hstep, voffB); PG8_STAGE(PG8_SA(0, 0), cA, voffA); PG8_STAGE(PG8_SA(0, 1), cA + hstep, voffA);
        if (wr == 1) PG8_BAR;
        PG8_WAIT_V(2); PG8_BAR;
        PG8_STAGE(PG8_SB(1, 0), cB + kstep, voffB); PG8_STAGE(PG8_SA(1, 0), cA + kstep, voffA); PG8_STAGE(PG8_SB(1, 1), cB + hstep + kstep, voffB);
        PG8_WAIT_V(6); PG8_BAR;
    } else {
        PG8_STAGE(PG8_SB(0, 0), cB, voffB); PG8_STAGE(PG8_SA(0, 0), cA, voffA); PG8_STAGE(PG8_SB(0, 1), cB + hstep, voffB); PG8_STAGE(PG8_SA(0, 1), cA + hstep, voffA);
        if (wr == 1) PG8_BAR;
        PG8_WAIT_V(4); PG8_BAR;
        PG8_STAGE(PG8_SB(1, 0), cB + kstep, voffB); PG8_STAGE(PG8_SA(1, 0), cA + kstep, voffA); PG8_STAGE(PG8_SB(1, 1), cB + hstep + kstep, voffB);
        PG8_WAIT_V(6); PG8_BAR;
    }
    for (;;) {
        const bool has_next = S.next(ui + 1, nxt);
        const char* nA = has_next ? (const char*)g.A + (size_t)nxt.pm * tstep : cA; const char* nB = has_next ? (const char*)g.Bt + (size_t)nxt.pn * tstep : cB;
        for (int t = 0; t < nt; t += 2) {
            const bool last = (t == nt - 2);
            const char* a1 = cA + (size_t)(t + 1) * kstep;
            const char* a2 = last ? nA : cA + (size_t)(t + 2) * kstep; const char* b2 = last ? nB : cB + (size_t)(t + 2) * kstep;
            const char* a3 = a2 + kstep; const char* b3 = b2 + kstep;
            if (last && has_next) S.a_ready(nxt);
            if constexpr (SP2) {
            PG8_LDB(B0, 0, 0); PG8_LDB(B1, 0, 1); PG8_SCHED; PG8_LDA(At, 0, 0); PG8_STAGE(PG8_SA(1, 1), a1 + hstep, voffA);
            PG8_WAIT_V(8); PG8_WAIT_L(0); PG8_BAR; PG8_MMA(0, 0, At, B0); PG8_MMA(0, 1, At, B1); PG8_BAR; PG8_SCHED;
            PG8_LDA(At, 0, 1); PG8_STAGE(PG8_SB(0, 0), b2, voffB); PG8_STAGE(PG8_SB(0, 1), b2 + hstep, voffB); PG8_STAGE(PG8_SA(0, 0), a2, voffA);
            PG8_WAIT_V(8); PG8_WAIT_L(0); PG8_BAR; PG8_MMA(1, 0, At, B0); PG8_MMA(1, 1, At, B1); PG8_BAR; PG8_SCHED;
            PG8_LDB(B0, 1, 0); PG8_LDB(B1, 1, 1); PG8_SCHED; PG8_LDA(At, 1, 0); PG8_STAGE(PG8_SA(0, 1), a2 + hstep, voffA);
            PG8_WAIT_V(8); PG8_WAIT_L(0); PG8_BAR; PG8_MMA(0, 0, At, B0); PG8_MMA(0, 1, At, B1); PG8_BAR; PG8_SCHED;
            PG8_LDA(At, 1, 1); PG8_STAGE(PG8_SB(1, 0), b3, voffB); PG8_STAGE(PG8_SB(1, 1), b3 + hstep, voffB); PG8_STAGE(PG8_SA(1, 0), a3, voffA);
            PG8_WAIT_V(8); PG8_WAIT_L(0); PG8_BAR; PG8_MMA(1, 0, At, B0); PG8_MMA(1, 1, At, B1); PG8_BAR; PG8_SCHED;
            } else {
            PG8_LDB(B0, 0, 0); PG8_SCHED; PG8_LDA(At, 0, 0); PG8_STAGE(PG8_SA(1, 1), a1 + hstep, voffA);
            PG8_WAIT_L(8); PG8_BAR; PG8_WAIT_L(0); PG8_MMA(0, 0, At, B0); PG8_BAR; PG8_SCHED;
            PG8_LDB(B1, 0, 1); PG8_STAGE(PG8_SB(0, 0), b2, voffB);
            PG8_BAR; PG8_WAIT_L(0); PG8_MMA(0, 1, At, B1); PG8_BAR;
            PG8_LDA(At, 0, 1); PG8_STAGE(PG8_SA(0, 0), a2, voffA);
            PG8_BAR; PG8_WAIT_L(0); PG8_MMA(1, 0, At, B0); PG8_BAR; PG8_SCHED;
            PG8_STAGE(PG8_SB(0, 1), b2 + hstep, voffB);
            PG8_WAIT_V(6); PG8_BAR; PG8_MMA(1, 1, At, B1); PG8_BAR;
            PG8_LDB(B0, 1, 0); PG8_SCHED; PG8_LDA(At, 1, 0); PG8_STAGE(PG8_SA(0, 1), a2 + hstep, voffA);
            PG8_WAIT_L(8); PG8_BAR; PG8_WAIT_L(0); PG8_MMA(0, 0, At, B0); PG8_BAR; PG8_SCHED;
            PG8_LDB(B1, 1, 1); PG8_STAGE(PG8_SB(1, 0), b3, voffB);
            PG8_BAR; PG8_WAIT_L(0); PG8_MMA(0, 1, At, B1); PG8_BAR;
            PG8_LDA(At, 1, 1); PG8_STAGE(PG8_SA(1, 0), a3, voffA);
            PG8_BAR; PG8_WAIT_L(0); PG8_MMA(1, 0, At, B0); PG8_BAR; PG8_SCHED;
            PG8_STAGE(PG8_SB(1, 1), b3 + hstep, voffB);
            PG8_WAIT_V(6); PG8_BAR; PG8_MMA(1, 1, At, B1); PG8_BAR;
            }
        }
        if constexpr (ALIGN_EPI) { if (wr == 0) PG8_BAR; }
        if constexpr (!Epi::AFTER_DRAIN) { E(acc, cur, wr, wc, fr, fq); S.done(cur); }
        if (!has_next) break;
#pragma unroll
        for (int a = 0; a < 2; ++a)
#pragma unroll
            for (int b = 0; b < 2; ++b)
#pragma unroll
                for (int m = 0; m < 4; ++m)
#pragma unroll
                    for (int n = 0; n < 2; ++n) acc[a][b][m][n] = (f32x4){0.f, 0.f, 0.f, 0.f};
        cur = nxt; cA = nA; cB = nB; ++ui;
        if constexpr (ALIGN_EPI) { if (wr == 1) PG8_BAR; }
    }
    PG8_WAIT_V(0);
    if constexpr (!ALIGN_EPI) { if (wr == 0) PG8_BAR; }
    PG8_BAR;
    if constexpr (Epi::AFTER_DRAIN) { E.fused(acc, cur, wr, wc, fr, fq, lds, wid, lane); S.done(cur); }
#undef PG8_SA
#undef PG8_SB
#undef PG8_STAGE
#undef PG8_LDA
#undef PG8_LDB
#undef PG8_MMA
#undef PG8_WAIT_V
#undef PG8_WAIT_L
#undef PG8_BAR
#undef PG8_SCHED
}
}
#define GAS __attribute__((address_space(1)))
#define LAS __attribute__((address_space(3)))
typedef unsigned short bf16;
typedef unsigned v4u __attribute__((ext_vector_type(4)));
typedef unsigned v2u __attribute__((ext_vector_type(2)));
typedef float f32x4 __attribute__((ext_vector_type(4)));
typedef short bf16x8 __attribute__((ext_vector_type(8)));
#define LDS_WAIT() asm volatile("s_waitcnt lgkmcnt(0)" ::: "memory")
#define VM_WAIT() asm volatile("s_waitcnt vmcnt(0)" ::: "memory")

constexpr int DM = 2048, NB = 4, SEQ = 2048, NMETA = 16, MROWS = NB * SEQ, DPROJ = 6152, NPROJ = 6144;
constexpr int PADT = 2112, POS0 = 64, MPOS0 = 48;
constexpr float EPS = 1e-6f;
constexpr float LOG2E = 1.4426950408889634f;
constexpr float QSCALE = 0.08838834764831845f * LOG2E;
constexpr int NWAVES = 8, NTHR = 512;

constexpr size_t MiB = 1u << 20;
constexpr size_t WS_CTL = 0, CTL_ZERO_BYTES = 1 * MiB;
constexpr size_t WS_PM = 512 * 1024;
constexpr size_t WS_W1T = 2 * MiB, WS_W2T = 26 * MiB, WS_W3T = 34 * MiB, WS_XN = 42 * MiB;
constexpr size_t WS_Q = 74 * MiB, WS_KP = 90 * MiB, WS_VP = 107 * MiB, WS_MQ = 124 * MiB, WS_MK = 133 * MiB, WS_MV = 142 * MiB, WS_MO = 159 * MiB;
constexpr size_t WS_SMALL = 175 * MiB;
constexpr size_t WS_XM = WS_SMALL, WS_LI = WS_SMALL + 128 * 1024, WS_LF = WS_SMALL + 384 * 1024, WS_LAM = WS_SMALL + 640 * 1024;
constexpr size_t WS_PO = 176 * MiB, WS_ML = 304 * MiB, WS_HM = 305 * MiB, WS_A2 = 42 * MiB, WS_H1B = 74 * MiB, WS_SSQ = 106 * MiB, WS_S = 176 * MiB, WS_UB = 384 * MiB, WS_VB = 448 * MiB;
constexpr int CW_BAR = 4096;

constexpr int RING_OFF = 0, RING_BYTES = 131072;
constexpr int XCH_OFF = 131072;
constexpr int MISC_OFF = XCH_OFF + 8192;
constexpr int LDS_BYTES = 155648;

__device__ __forceinline__ unsigned f2bf(float f) { unsigned u = __builtin_bit_cast(unsigned, f); return (u + 0x7fffu + ((u >> 16) & 1u)) >> 16; }
__device__ __forceinline__ unsigned pk2(float lo, float hi) { return f2bf(lo) | (f2bf(hi) << 16); }
__device__ __forceinline__ float bf2f(unsigned short u) { return __builtin_bit_cast(float, (unsigned)u << 16); }
__device__ __forceinline__ float bflo(unsigned w) { return __builtin_bit_cast(float, w << 16); }
__device__ __forceinline__ float bfhi(unsigned w) { return __builtin_bit_cast(float, w & 0xffff0000u); }
__device__ __forceinline__ float wave_sum(float v) {
#pragma unroll
  for (int o = 1; o < 64; o <<= 1) v += __shfl_xor(v, o);
  return v;
}
__device__ __forceinline__ size_t kp_off(int bhm, int pos, int d) { const int j = pos >> 6, row = pos & 63, d0 = d >> 4, hi = (d >> 3) & 1;
  return ((size_t)(bhm * 33 + j) * 8 + d0) * 1024 + (size_t)((((row << 1) | hi) ^ ((row >> 3) & 1)) << 3) + (d & 7); }
__device__ __forceinline__ float sigmoidf_(float x) { return 1.0f / (1.0f + __expf(-x)); }
struct Args { const float* in[22]; float* out; unsigned char* ws; int ph_lo, ph_hi, na, pad; };
struct Frame {
  LAS unsigned char* lds; unsigned char* ws; int tid, lane, wave; const float* const* in;
};
#define IN_X 0
#define IN_META 1
#define IN_G1 2
#define IN_WIN 3
#define IN_CW 4
#define IN_CB 5
#define IN_IGB 6
#define IN_FGB 7
#define IN_LQ1 8
#define IN_LK1 9
#define IN_LQ2 10
#define IN_LK2 11
#define IN_QNG 12
#define IN_KNG 13
#define IN_SUBG 14
#define IN_OUTG 15
#define IN_WOUT 16
#define IN_G2 17
#define IN_WQ 18
#define IN_SUBK 19
#define IN_U 20
#define IN_V 21

__device__ __forceinline__ void p0_rows(const Frame& F, const Args& a) {
  const float* x = a.in[IN_X]; const float* meta = a.in[IN_META]; const float* g1 = a.in[IN_G1]; const float* w_in = a.in[IN_WIN];
  const float* igb = a.in[IN_IGB]; const float* fgb = a.in[IN_FGB];
  bf16* Xn = (bf16*)(F.ws + WS_XN); bf16* Xm = (bf16*)(F.ws + WS_XM); float* LI = (float*)(F.ws + WS_LI); float* LF = (float*)(F.ws + WS_LF);
  LAS f32x4* wgl = (LAS f32x4*)(F.lds);
  for (int e = F.tid; e < 4096; e += NTHR) {
    const int ln = e & 63, q = e >> 6, half = q & 1, j = (q >> 1) & 3, i = q >> 3;
    const int k = 4 * (i * 64 + ln) + j;
    wgl[e] = *(const f32x4*)(w_in + (size_t)k * DPROJ + NPROJ + 4 * half);
  }
  __syncthreads();
  const int gw = blockIdx.x * NWAVES + F.wave, NGW = gridDim.x * NWAVES, lane = F.lane;
  for (int task = gw; task < MROWS / 2 + NMETA / 2; task += NGW) {
    const bool ismeta = task >= MROWS / 2;
    const int r0 = ismeta ? (task - MROWS / 2) * 2 : task * 2;
    const float* src0 = (ismeta ? meta : x) + (size_t)r0 * DM;
    float rs[2];
    { float s0 = 0.f, s1 = 0.f;
#pragma unroll 2
      for (int i = 0; i < 8; ++i) { const f32x4 a0 = ((const f32x4*)src0)[i * 64 + lane], a1 = ((const f32x4*)(src0 + DM))[i * 64 + lane];
        s0 += (a0.x * a0.x + a0.y * a0.y) + (a0.z * a0.z + a0.w * a0.w); s1 += (a1.x * a1.x + a1.y * a1.y) + (a1.z * a1.z + a1.w * a1.w); }
      rs[0] = rsqrtf(wave_sum(s0) * (1.0f / DM) + EPS); rs[1] = rsqrtf(wave_sum(s1) * (1.0f / DM) + EPS); }
    float ga[2][8];
#pragma unroll
    for (int rr = 0; rr < 2; ++rr)
#pragma unroll
      for (int g = 0; g < 8; ++g) ga[rr][g] = 0.f;
    bf16* dst0 = (ismeta ? Xm : Xn) + (size_t)r0 * DM;
#pragma unroll 1
    for (int i = 0; i < 8; ++i) {
      const f32x4 g = ((const f32x4*)g1)[i * 64 + lane];
      f32x4 xn[2];
#pragma unroll
      for (int rr = 0; rr < 2; ++rr) { xn[rr] = ((const f32x4*)(src0 + (size_t)rr * DM))[i * 64 + lane] * g * rs[rr];
        v2u o; o.x = pk2(xn[rr].x, xn[rr].y); o.y = pk2(xn[rr].z, xn[rr].w); ((v2u*)(dst0 + (size_t)rr * DM))[i * 64 + lane] = o; }
#pragma unroll
      for (int j = 0; j < 4; ++j) {
        const f32x4 w0 = wgl[((i * 4 + j) * 2 + 0) * 64 + lane], w1 = wgl[((i * 4 + j) * 2 + 1) * 64 + lane];
#pragma unroll
        for (int rr = 0; rr < 2; ++rr) { const float xv = xn[rr][j];
          ga[rr][0] += xv * w0.x; ga[rr][1] += xv * w0.y; ga[rr][2] += xv * w0.z; ga[rr][3] += xv * w0.w;
          ga[rr][4] += xv * w1.x; ga[rr][5] += xv * w1.y; ga[rr][6] += xv * w1.z; ga[rr][7] += xv * w1.w; }
      }
    }
#pragma unroll
    for (int rr = 0; rr < 2; ++rr)
#pragma unroll
      for (int g = 0; g < 8; ++g) ga[rr][g] = wave_sum(ga[rr][g]);
    if (lane < 8) {
      const int rr = lane >> 2, h = lane & 3;
      float gi = 0.f, gf = 0.f;
#pragma unroll
      for (int q = 0; q < 2; ++q)
#pragma unroll
        for (int hh = 0; hh < 4; ++hh) if (q == rr && hh == h) { gi = ga[q][hh]; gf = ga[q][4 + hh]; }
      const float li = gi + igb[h]; const float fx = gf + fgb[h];
      const float lf = fminf(fx, 0.f) - log1pf(__expf(-fabsf(fx)));
      const int R = r0 + rr;
      if (!ismeta) { const int b = R >> 11, t = R & 2047; LI[(b * 4 + h) * PADT + POS0 + t] = li; LF[(b * 4 + h) * PADT + POS0 + t] = lf; }
      else { for (int b = 0; b < NB; ++b) { LI[(b * 4 + h) * PADT + MPOS0 + R] = li; LF[(b * 4 + h) * PADT + MPOS0 + R] = lf; } }
    }
  }
  __syncthreads();
}
__device__ __forceinline__ void p0_metaproj(const Frame& F, const Args& a) {
  const float* meta = a.in[IN_META]; const float* g1 = a.in[IN_G1]; const float* w_in = a.in[IN_WIN];
  float* PM = (float*)(F.ws + WS_PM);
  LAS float* xs = (LAS float*)(F.lds);
  LAS float* part = (LAS float*)(F.lds + 16384);
  const int q = F.tid >> 7, c = F.tid & 127;
  for (int task = blockIdx.x; task < NPROJ / 128; task += gridDim.x) {
    const int n = task * 128 + c;
    float acc[16];
#pragma unroll
    for (int m = 0; m < 16; ++m) acc[m] = 0.f;
#pragma unroll 1
    for (int kb = 0; kb < 8; ++kb) {
      __syncthreads();
#pragma unroll
      for (int i = 0; i < 8; ++i) { const int idx = F.tid + NTHR * i, qq = idx >> 10, kk = (idx >> 4) & 63, m = idx & 15; const int k = 512 * qq + 64 * kb + kk;
        xs[idx] = meta[(size_t)m * DM + k] * g1[k]; }
      __syncthreads();
#pragma unroll 4
      for (int kk = 0; kk < 64; ++kk) {
        const float w = w_in[(size_t)(512 * q + 64 * kb + kk) * DPROJ + n];
        const LAS f32x4* xp = (const LAS f32x4*)(xs + (q * 64 + kk) * 16);
#pragma unroll
        for (int t = 0; t < 4; ++t) { const f32x4 xv = xp[t]; acc[4 * t + 0] += xv.x * w; acc[4 * t + 1] += xv.y * w; acc[4 * t + 2] += xv.z * w; acc[4 * t + 3] += xv.w * w; }
      }
    }
#pragma unroll
    for (int m = 0; m < 16; ++m) part[(q * 16 + m) * 128 + c] = acc[m];
    __syncthreads();
    for (int e = F.tid; e < 16 * 128; e += NTHR) { const int m = e >> 7, cc = e & 127;
      PM[m * NPROJ + task * 128 + cc] = (part[(0 * 16 + m) * 128 + cc] + part[(1 * 16 + m) * 128 + cc]) + (part[(2 * 16 + m) * 128 + cc] + part[(3 * 16 + m) * 128 + cc]); }
  }
  __syncthreads();
}
__device__ __forceinline__ void p0_transpose(const Frame& F, const float* W, int ldw, int N, bf16* Wt) {
  LAS float* tl = (LAS float*)(F.lds);
  const int ntn = N / 64, ntask = ntn * 16;
  for (int task = blockIdx.x; task < ntask; task += gridDim.x) {
    const int nb = task % ntn, kb = task / ntn, n0 = nb * 64, k0 = kb * 128;
    __syncthreads();
#pragma unroll
    for (int i = 0; i < 4; ++i) { const int idx = F.tid + NTHR * i, kk = idx >> 4, c4 = idx & 15;
      const f32x4 w = *(const f32x4*)(W + (size_t)(k0 + kk) * ldw + n0 + 4 * c4);
      LAS float* d = tl + kk * 65 + 4 * c4; d[0] = w.x; d[1] = w.y; d[2] = w.z; d[3] = w.w; }
    __syncthreads();
    const int n = F.tid >> 3, kc = F.tid & 7;
    const LAS float* s = tl + (kc * 16) * 65 + n;
    v4u o0, o1;
    o0.x = pk2(s[0 * 65], s[1 * 65]); o0.y = pk2(s[2 * 65], s[3 * 65]); o0.z = pk2(s[4 * 65], s[5 * 65]); o0.w = pk2(s[6 * 65], s[7 * 65]);
    o1.x = pk2(s[8 * 65], s[9 * 65]); o1.y = pk2(s[10 * 65], s[11 * 65]); o1.z = pk2(s[12 * 65], s[13 * 65]); o1.w = pk2(s[14 * 65], s[15 * 65]);
    v4u* dp = (v4u*)(Wt + (size_t)(n0 + n) * DM + k0 + kc * 16);
    dp[0] = o0; dp[1] = o1;
  }
  __syncthreads();
}
__device__ __forceinline__ void p0_zero_vpad(const Frame& F) {
  bf16* Vp = (bf16*)(F.ws + WS_VP);
  const int per = MPOS0 * 256 / 8;
  for (int i = blockIdx.x * NTHR + F.tid; i < 16 * per; i += gridDim.x * NTHR) { const int bh = i / per, e = i % per;
    *(v4u*)(Vp + (size_t)bh * PADT * 256 + (size_t)e * 8) = (v4u){0u, 0u, 0u, 0u}; }
}
__device__ __forceinline__ void p0_lam(const Frame& F, const Args& a) {
  if (blockIdx.x == 0 && F.wave == 0) {
    const int l = F.lane;
    float s1 = a.in[IN_LQ1][l] * a.in[IN_LK1][l] + a.in[IN_LQ1][l + 64] * a.in[IN_LK1][l + 64];
    float s2 = a.in[IN_LQ2][l] * a.in[IN_LK2][l] + a.in[IN_LQ2][l + 64] * a.in[IN_LK2][l + 64];
    s1 = wave_sum(s1); s2 = wave_sum(s2);
    if (l == 0) *(float*)(F.ws + WS_LAM) = __expf(s1) - __expf(s2) + 0.2f;
  }
}

struct EpiProj {
  static constexpr bool PERM = true, AFTER_DRAIN = false;
  bf16 *Qb, *Kp, *Vp, *MQ, *MK, *MV, *MO; const float *qg, *kg; LAS float* xch;
  __device__ __forceinline__ void operator()(const pg8::f32x4 (&acc)[2][2][4][2], const pg8::Unit& u, int wr, int wc, int fr, int fq) const {
    const int pn = u.pn, b = u.pm >> 3, tb = (u.pm & 7) * 256 + wr * 64 + fr, d0 = wc * 32 + fq * 8;
    if (pn < 8) {
      const bool isk = pn >= 4; const int h = pn & 3;
      float ssq[2][4][2];
#pragma unroll
      for (int ai = 0; ai < 2; ++ai)
#pragma unroll
        for (int m = 0; m < 4; ++m)
#pragma unroll
          for (int bj = 0; bj < 2; ++bj) { float s = 0.f;
#pragma unroll
            for (int n = 0; n < 2; ++n) { const pg8::f32x4 x = acc[ai][bj][m][n]; s += (x[0] * x[0] + x[1] * x[1]) + (x[2] * x[2] + x[3] * x[3]); }
            s += __shfl_xor(s, 16); s += __shfl_xor(s, 32); ssq[ai][m][bj] = s;
            if (fq == 0) xch[((ai * 128 + wr * 64 + m * 16 + fr) * 2 + bj) * 4 + wc] = s; }
      asm volatile("s_waitcnt lgkmcnt(0)" ::: "memory"); __builtin_amdgcn_s_barrier(); asm volatile("" ::: "memory");
      const float* gp = (isk ? kg : qg) + d0; const f32x4 g0 = *(const f32x4*)gp, g1v = *(const f32x4*)(gp + 4);
      const float sc = isk ? 1.0f : QSCALE;
#pragma unroll
      for (int ai = 0; ai < 2; ++ai)
#pragma unroll
        for (int m = 0; m < 4; ++m)
#pragma unroll
          for (int bj = 0; bj < 2; ++bj) {
            const f32x4 p = *(const LAS f32x4*)(xch + ((ai * 128 + wr * 64 + m * 16 + fr) * 2 + bj) * 4);
            const float rs = rsqrtf(((p.x + p.y) + (p.z + p.w)) * (1.0f / 128.f) + EPS) * sc;
            const pg8::f32x4 v0 = acc[ai][bj][m][0], v1 = acc[ai][bj][m][1];
            v4u w; w.x = pk2(v0[0] * rs * g0.x, v0[1] * rs * g0.y); w.y = pk2(v0[2] * rs * g0.z, v0[3] * rs * g0.w);
            w.z = pk2(v1[0] * rs * g1v.x, v1[1] * rs * g1v.y); w.w = pk2(v1[2] * rs * g1v.z, v1[3] * rs * g1v.w);
            const int t = tb + ai * 128 + m * 16;
            bf16* dst = isk ? Kp + kp_off((b * 4 + h) * 2 + bj, POS0 + t, d0)
                            : Qb + ((size_t)((b * 4 + h) * 2 + bj) * SEQ + t) * 128 + d0;
            *(v4u*)dst = w; }
      return;
    }
#pragma unroll
    for (int ai = 0; ai < 2; ++ai)
#pragma unroll
      for (int m = 0; m < 4; ++m)
#pragma unroll
        for (int bj = 0; bj < 2; ++bj) {
          pg8::f32x4 v0 = acc[ai][bj][m][0], v1 = acc[ai][bj][m][1];
          const int t = tb + ai * 128 + m * 16;
          bf16* dst;
          if (pn < 12) { const int h = pn - 8; dst = Vp + ((size_t)(b * 4 + h) * PADT + POS0 + t) * 256 + bj * 128 + d0; }
          else if (pn < 16) { const int h = 2 * (pn & 1) + bj; dst = (pn >= 14 ? MK : MQ) + ((size_t)(b * 4 + h) * PADT + POS0 + t) * 128 + d0; }
          else if (pn < 20) { const int h = pn - 16; dst = MV + ((size_t)(b * 4 + h) * PADT + POS0 + t) * 256 + bj * 128 + d0; }
          else { dst = MO + (size_t)(b * SEQ + t) * 1024 + (pn - 20) * 256 + bj * 128 + d0;
#pragma unroll
            for (int j = 0; j < 4; ++j) { v0[j] = sigmoidf_(v0[j]); v1[j] = sigmoidf_(v1[j]); } }
          v4u w; w.x = pk2(v0[0], v0[1]); w.y = pk2(v0[2], v0[3]); w.z = pk2(v1[0], v1[1]); w.w = pk2(v1[2], v1[3]);
          *(v4u*)dst = w; }
  }
};
__device__ __forceinline__ void p1_meta_finalize(const Frame& F, const Args& a) {
  if (blockIdx.x >= NMETA) return;
  const int mrow = blockIdx.x, tid = F.tid, lane = F.lane, w = F.wave;
  const float* meta = a.in[IN_META] + (size_t)mrow * DM; const float* PM = (const float*)(F.ws + WS_PM) + (size_t)mrow * NPROJ;
  LAS float* red = (LAS float*)(F.lds + XCH_OFF);
  const f32x4 mv = ((const f32x4*)meta)[tid];
  float s = wave_sum((mv.x * mv.x + mv.y * mv.y) + (mv.z * mv.z + mv.w * mv.w));
  if (lane == 0) red[w] = s;
  __syncthreads();
  float tot = 0.f;
#pragma unroll
  for (int i = 0; i < 8; ++i) tot += red[i];
  const float rs = rsqrtf(tot * (1.0f / DM) + EPS);
  bf16* Kp = (bf16*)(F.ws + WS_KP); bf16* Vp = (bf16*)(F.ws + WS_VP); bf16* MQ = (bf16*)(F.ws + WS_MQ); bf16* MK = (bf16*)(F.ws + WS_MK); bf16* MV = (bf16*)(F.ws + WS_MV);
  const int pos = MPOS0 + mrow;
  {
    const float v0 = PM[1024 + w * 128 + lane] * rs, v1 = PM[1024 + w * 128 + lane + 64] * rs;
    const float rk = rsqrtf(wave_sum(v0 * v0 + v1 * v1) * (1.0f / 128.f) + EPS);
    const float* kg = a.in[IN_KNG];
    const unsigned short o0 = (unsigned short)f2bf(v0 * rk * kg[lane]), o1 = (unsigned short)f2bf(v1 * rk * kg[lane + 64]);
    for (int b = 0; b < NB; ++b) { const int bhm = (b * 4 + (w >> 1)) * 2 + (w & 1); Kp[kp_off(bhm, pos, lane)] = o0; Kp[kp_off(bhm, pos, lane + 64)] = o1; }
  }
  { const int c = tid * 2;
    const unsigned o = pk2(PM[2048 + c] * rs, PM[2048 + c + 1] * rs); const int h = c >> 8, e = c & 255;
    for (int b = 0; b < NB; ++b) *(unsigned*)(Vp + ((size_t)(b * 4 + h) * PADT + pos) * 256 + e) = o;
    const unsigned o2 = pk2(PM[3072 + c] * rs, PM[3072 + c + 1] * rs); const bool isk = c >= 512; const int cc = c & 511, hq = cc >> 7, d = cc & 127;
    for (int b = 0; b < NB; ++b) *(unsigned*)((isk ? MK : MQ) + ((size_t)(b * 4 + hq) * PADT + pos) * 128 + d) = o2;
    const unsigned o3 = pk2(PM[4096 + c] * rs, PM[4096 + c + 1] * rs);
    for (int b = 0; b < NB; ++b) *(unsigned*)(MV + ((size_t)(b * 4 + h) * PADT + pos) * 256 + e) = o3;
  }
  __syncthreads();
}

namespace att {
using f32x16 = __attribute__((ext_vector_type(16))) float;
using s16x4 = __attribute__((ext_vector_type(4))) short;
constexpr int STEPS_BHM = 152, NSTEPS = 32 * STEPS_BHM;
constexpr int SHM_V = 64 * 256 * 2, SHM_K = 64 * 128 * 2;
constexpr int LDS_V = 0, LDS_K = 2 * SHM_V, LDS_Q = LDS_K + SHM_K, LDS_WS = LDS_Q + 8 * 8192;
constexpr float THR2 = 8.0f;
#define KSWZ(row, colB) ((row) * 256 + ((colB) ^ (((row) & 7) << 4)))
#define SBAR() __builtin_amdgcn_sched_barrier(0)
__device__ __forceinline__ int crow(int r, int hi) { return (r & 3) + 8 * (r >> 2) + 4 * hi; }
__device__ __forceinline__ unsigned cvtpk(float lo, float hi) { unsigned r; asm volatile("v_cvt_pk_bf16_f32 %0, %1, %2" : "=v"(r) : "v"(lo), "v"(hi)); return r; }
__device__ __forceinline__ int qb_start(int qb) { return 2 * qb * qb + 3 * qb; }
__device__ __forceinline__ int chunk_of(int s, int NA) { return ((s + 1) * NA - 1) / NSTEPS; }

template <int OFF> __device__ __forceinline__ s16x4 tr_read(int vb) {
  s16x4 r; asm volatile("ds_read_b64_tr_b16 %0, %1 offset:%2" : "=&v"(r) : "v"(vb), "i"(OFF) : "memory"); return r;
}
constexpr int v_rd_off(int d0, int ks, int half) { return d0 * 512 + ks * 8192 + half * 4096; }
template <int D0> __device__ __forceinline__ void pv_one(f32x16& od, int vb, bf16x8 pa0, bf16x8 pa1, bf16x8 pa2, bf16x8 pa3) {
#define PK(L, H) (bf16x8){L[0], L[1], L[2], L[3], H[0], H[1], H[2], H[3]}
  { const s16x4 l0 = tr_read<v_rd_off(D0, 0, 0)>(vb), h0 = tr_read<v_rd_off(D0, 0, 1)>(vb), l1 = tr_read<v_rd_off(D0, 1, 0)>(vb), h1 = tr_read<v_rd_off(D0, 1, 1)>(vb);
    asm volatile("s_waitcnt lgkmcnt(0)" ::: "memory"); SBAR();
    od = __builtin_amdgcn_mfma_f32_32x32x16_bf16(pa0, PK(l0, h0), od, 0, 0, 0);
    od = __builtin_amdgcn_mfma_f32_32x32x16_bf16(pa1, PK(l1, h1), od, 0, 0, 0); }
  SBAR();
  { const s16x4 l2 = tr_read<v_rd_off(D0, 2, 0)>(vb), h2 = tr_read<v_rd_off(D0, 2, 1)>(vb), l3 = tr_read<v_rd_off(D0, 3, 0)>(vb), h3 = tr_read<v_rd_off(D0, 3, 1)>(vb);
    asm volatile("s_waitcnt lgkmcnt(0)" ::: "memory"); SBAR();
    od = __builtin_amdgcn_mfma_f32_32x32x16_bf16(pa2, PK(l2, h2), od, 0, 0, 0);
    od = __builtin_amdgcn_mfma_f32_32x32x16_bf16(pa3, PK(l3, h3), od, 0, 0, 0); }
#undef PK
}

__device__ __forceinline__ void segment(const Frame& F, int bhm, int qb, int j0, int j1, int slot) {
  const int tid = F.tid, wid = F.wave, lane = F.lane, r32 = lane & 31, hi = lane >> 5;
  const bf16* Qg = (const bf16*)(F.ws + WS_Q) + ((size_t)bhm * SEQ + qb * 256 + wid * 32 + r32) * 128 + hi * 8;
  const bf16* Kg = (const bf16*)(F.ws + WS_KP) + (size_t)bhm * 33 * 8192;
  const bf16* Vg = (const bf16*)(F.ws + WS_VP) + (size_t)(bhm >> 1) * PADT * 256;
  LAS unsigned char* lds = F.lds;
  LAS float* wsl = (LAS float*)(lds + LDS_WS) + wid * 64;
  const float slope2 = exp2f(-2.0f * (float)(((bhm >> 1) & 3) + 1)) * LOG2E;
  unsigned ksrc0, vsrc0;
  ksrc0 = (unsigned)tid * 16u;
  { const int a8 = tid >> 8, b = (tid >> 2) & 7, k = 8 * (b >> 2) + 4 * a8 + (b & 3), c = ((tid >> 5) & 7) * 32 + (tid & 3) * 8; vsrc0 = (unsigned)(k * 256 + c) * 2u; }
#define STAGE_K(j) do { const char* kt = (const char*)(Kg + (size_t)(j) * 8192); \
    _Pragma("unroll") for (int _i = 0; _i < 2; ++_i) __builtin_amdgcn_global_load_lds((const unsigned*)(kt + (ksrc0 + _i * 8192u)), (LAS unsigned*)(lds + LDS_K + _i * 8192 + wid * 1024), 16, 0, 0); } while (0)
#define STAGE_V(buf, j) do { const char* vt = (const char*)(Vg + (size_t)(j) * 64 * 256); \
    _Pragma("unroll") for (int _i = 0; _i < 4; ++_i) __builtin_amdgcn_global_load_lds((const unsigned*)(vt + (vsrc0 + _i * 8192u)), (LAS unsigned*)(lds + LDS_V + (buf) * SHM_V + _i * 8192 + wid * 1024), 16, 0, 0); } while (0)
  const int lt = (((r32 << 1) | hi) ^ ((r32 >> 3) & 1)) << 4;
  LAS unsigned char* Qs = lds + LDS_Q + wid * 8192;
#pragma unroll
  for (int d0 = 0; d0 < 8; ++d0) { const bf16x8 qv = *(const bf16x8*)(Qg + d0 * 16); *(LAS bf16x8*)(Qs + d0 * 1024 + lt) = qv; }
  const float hioff = slope2 * (float)(4 * hi);
  f32x16 o[8];
#pragma unroll
  for (int d = 0; d < 8; ++d)
#pragma unroll
    for (int r = 0; r < 16; ++r) o[d][r] = 0.f;
  float m_reg = -1e30f, l_reg = 0.f;
  const int vb0 = (int)(uintptr_t)(lds + LDS_V) + (((lane & 3) << 3) | (((lane >> 2) & 3) << 6) | (((lane >> 4) & 1) << 5) | (((lane >> 5) & 1) << 8));
  const int qrel = wid * 32 + r32;
  STAGE_K(j0); STAGE_V(0, j0);
  VM_WAIT(); __syncthreads();
  for (int j = j0; j < j1; ++j) {
    const int cur = (j - j0) & 1;
    if (j + 1 < j1) STAGE_V(cur ^ 1, j + 1);
    SBAR();
    f32x16 p0 = {}, p1 = {};
    { const LAS unsigned char* Ks = lds + LDS_K;
#pragma unroll
      for (int d0 = 0; d0 < 8; ++d0) {
        const bf16x8 b0 = *(const LAS bf16x8*)(Ks + d0 * 2048 + lt);
        const bf16x8 b1 = *(const LAS bf16x8*)(Ks + d0 * 2048 + 1024 + lt);
        const bf16x8 qf = *(const LAS bf16x8*)(Qs + d0 * 1024 + lt);
        p0 = __builtin_amdgcn_mfma_f32_32x32x16_bf16(b0, qf, p0, 0, 0, 0);
        p1 = __builtin_amdgcn_mfma_f32_32x32x16_bf16(b1, qf, p1, 0, 0, 0); } }
    asm volatile("s_waitcnt lgkmcnt(0)" ::: "memory"); __builtin_amdgcn_s_barrier(); asm volatile("" ::: "memory");
    if (j + 1 < j1) STAGE_K(j + 1);
    SBAR();
    if (j == 0) {
#pragma unroll
      for (int r = 0; r < 16; ++r) p0[r] = -INFINITY;
#pragma unroll
      for (int r = 0; r < 8; ++r) p1[r] = -INFINITY;
    }
    const int jb = j - (4 * qb + 1);
    if (jb >= 0) {
      const int kb = 64 * jb + 4 * hi;
#pragma unroll
      for (int r = 0; r < 16; ++r) { const int kv = kb + (r & 3) + 8 * (r >> 2); if (kv > qrel) p0[r] = -INFINITY; if (kv + 32 > qrel) p1[r] = -INFINITY; }
    }
    const float off0 = slope2 * (float)(64 * j) + hioff, off1 = off0 + 32.0f * slope2;
#pragma unroll
    for (int r = 0; r < 16; ++r) { const float sb = slope2 * (float)((r & 3) + 8 * (r >> 2)); p0[r] += sb; p1[r] += sb; }
    float pm0 = p0[0], pm1 = p1[0];
#pragma unroll
    for (int r = 1; r < 16; ++r) { pm0 = fmaxf(pm0, p0[r]); pm1 = fmaxf(pm1, p1[r]); }
    float pmax = fmaxf(pm0 + off0, pm1 + off1);
    { auto rr = __builtin_amdgcn_permlane32_swap(__float_as_uint(pmax), __float_as_uint(pmax), false, false);
      pmax = fmaxf(__uint_as_float(rr[0]), __uint_as_float(rr[1])); }
    float mn, alpha;
    if (__builtin_expect(__all(pmax - m_reg <= THR2), 1)) { mn = m_reg; alpha = 1.f; }
    else { mn = fmaxf(m_reg, pmax); alpha = __builtin_amdgcn_exp2f(m_reg - mn); m_reg = mn; }
    const float c0 = off0 - mn, c1 = off1 - mn;
    float ps = 0.f;
#pragma unroll
    for (int r = 0; r < 16; ++r) { p0[r] = __builtin_amdgcn_exp2f(p0[r] + c0); p1[r] = __builtin_amdgcn_exp2f(p1[r] + c1); ps += p0[r] + p1[r]; }
    { auto rr = __builtin_amdgcn_permlane32_swap(__float_as_uint(ps), __float_as_uint(ps), false, false);
      ps = __uint_as_float(rr[0]) + __uint_as_float(rr[1]); }
    l_reg = l_reg * alpha + ps;
    if (__any(alpha < 1.f)) { if (hi == 0) wsl[r32] = alpha; asm volatile("s_waitcnt lgkmcnt(0)" ::: "memory");
#pragma unroll
      for (int rg = 0; rg < 4; ++rg) { const f32x4 al = *(const LAS f32x4*)(wsl + 8 * rg + 4 * hi);
#pragma unroll
        for (int d = 0; d < 8; ++d) { o[d][4 * rg + 0] *= al.x; o[d][4 * rg + 1] *= al.y; o[d][4 * rg + 2] *= al.z; o[d][4 * rg + 3] *= al.w; }
        SBAR(); } }
    bf16x8 pa0, pa1, pa2, pa3;
#define PK4(P, BASE, OUT) do { unsigned a0 = cvtpk(P[BASE + 0], P[BASE + 1]), a1 = cvtpk(P[BASE + 2], P[BASE + 3]);   \
    unsigned b0 = cvtpk(P[BASE + 4], P[BASE + 5]), b1 = cvtpk(P[BASE + 6], P[BASE + 7]);                              \
    auto r0 = __builtin_amdgcn_permlane32_swap(a0, b0, false, false); auto r1 = __builtin_amdgcn_permlane32_swap(a1, b1, false, false); \
    v4u w = {r0[0], r1[0], r0[1], r1[1]}; OUT = *reinterpret_cast<bf16x8*>(&w); } while (0)
    PK4(p0, 0, pa0); PK4(p0, 8, pa1); PK4(p1, 0, pa2); PK4(p1, 8, pa3);
#undef PK4
    SBAR();
    { const int vb = vb0 + cur * SHM_V;
      pv_one<0>(o[0], vb, pa0, pa1, pa2, pa3); pv_one<1>(o[1], vb, pa0, pa1, pa2, pa3); pv_one<2>(o[2], vb, pa0, pa1, pa2, pa3); pv_one<3>(o[3], vb, pa0, pa1, pa2, pa3);
      pv_one<4>(o[4], vb, pa0, pa1, pa2, pa3); pv_one<5>(o[5], vb, pa0, pa1, pa2, pa3); pv_one<6>(o[6], vb, pa0, pa1, pa2, pa3); pv_one<7>(o[7], vb, pa0, pa1, pa2, pa3); }
    VM_WAIT(); __syncthreads();
  }
  { int lane2 = threadIdx.x & 63, slot2 = slot; asm volatile("" : "+v"(lane2), "+s"(slot2));
    const int r32e = lane2 & 31, hie = lane2 >> 5;
    float* PO = (float*)(F.ws + WS_PO) + (size_t)slot2 * 256 * 256; float* ML = (float*)(F.ws + WS_ML) + (size_t)slot2 * 512;
    LAS float* wse = (LAS float*)(F.lds + LDS_WS) + wid * 64;
    if (hie == 0) { wse[r32e] = l_reg; ML[(wid * 32 + r32e) * 2] = m_reg; ML[(wid * 32 + r32e) * 2 + 1] = l_reg; }
    asm volatile("s_waitcnt lgkmcnt(0)" ::: "memory");
    char* Ob = (char*)(PO + (size_t)(wid * 32) * 256);
    const unsigned lo = (unsigned)(4 * hie * 256 + r32e) * 4u;
#pragma unroll
    for (int r = 0; r < 16; ++r) { const int rowc = (r & 3) + 8 * (r >> 2); const float lv = wse[rowc + 4 * hie]; const float rl = lv > 0.f ? __builtin_amdgcn_rcpf(lv) : 0.f;
#pragma unroll
      for (int d0 = 0; d0 < 8; ++d0) *(float*)(Ob + (lo + (unsigned)(rowc * 256 + d0 * 32) * 4u)) = o[d0][r] * rl;
      SBAR(); } }
  __syncthreads();
#undef STAGE_K
#undef STAGE_V
}

__device__ __forceinline__ void phase(const Frame& F, int ca, int NA) {
  int s0 = (int)(((long)ca * NSTEPS) / NA); const int s1 = (int)(((long)(ca + 1) * NSTEPS) / NA);
  while (s0 < s1) {
    const int bhm = s0 / STEPS_BHM, rem = s0 - bhm * STEPS_BHM;
    int qb = 0;
#pragma unroll 1
    for (int q = 1; q < 8; ++q) if (rem >= qb_start(q)) qb = q;
    const int j0 = rem - qb_start(qb), nst = 4 * qb + 5;
    const int j1 = (j0 + (s1 - s0) < nst) ? j0 + (s1 - s0) : nst;
    const int slot = bhm * 16 + qb + chunk_of(s0, NA) - chunk_of(bhm * STEPS_BHM, NA);
    segment(F, bhm, qb, j0, j1, slot);
    s0 += j1 - j0;
  }
}
#undef KSWZ
#undef SBAR
}
__device__ __forceinline__ void p3_combine(const Frame& F, const Args& a, int NA) {
  const float* PO = (const float*)(F.ws + WS_PO); const float* ML = (const float*)(F.ws + WS_ML); const float* HM = (const float*)(F.ws + WS_HM);
  const bf16* MO = (const bf16*)(F.ws + WS_MO); bf16* A2 = (bf16*)(F.ws + WS_A2);
  const float lam = *(const float*)(F.ws + WS_LAM);
  const float* subg = a.in[IN_SUBG]; const float* og = a.in[IN_OUTG];
  const int gw = blockIdx.x * NWAVES + F.wave, NGW = gridDim.x * NWAVES, lane = F.lane;
  const f32x4 sg = ((const f32x4*)subg)[lane];
  for (int R = gw; R < MROWS; R += NGW) {
    const int b = R >> 11, t = R & 2047, qb = t >> 8, rq = t & 255;
#pragma unroll 1
    for (int h = 0; h < 4; ++h) {
      f32x4 om[2];
#pragma unroll
      for (int m = 0; m < 2; ++m) {
        const int bhm = (b * 4 + h) * 2 + m, first = bhm * att::STEPS_BHM + att::qb_start(qb), last = first + 4 * qb + 4;
        const int cf = att::chunk_of(first, NA), np = att::chunk_of(last, NA) - cf + 1, slot0 = bhm * 16 + qb + cf - att::chunk_of(bhm * att::STEPS_BHM, NA);
        float mp[3], lp[3]; f32x4 op[3];
#pragma unroll
        for (int p = 0; p < 3; ++p) { if (p < np) { const int slot = slot0 + p; mp[p] = ML[(size_t)slot * 512 + rq * 2]; lp[p] = ML[(size_t)slot * 512 + rq * 2 + 1];
            op[p] = ((const f32x4*)(PO + ((size_t)slot * 256 + rq) * 256))[lane]; } else { mp[p] = -1e30f; lp[p] = 0.f; op[p] = (f32x4){0.f, 0.f, 0.f, 0.f}; } }
        const float M = fmaxf(mp[0], fmaxf(mp[1], mp[2]));
        float wsum = 0.f; f32x4 acc = (f32x4){0.f, 0.f, 0.f, 0.f};
#pragma unroll
        for (int p = 0; p < 3; ++p) { const float w = lp[p] * exp2f(mp[p] - M); wsum += w; acc += op[p] * w; }
        om[m] = acc * (1.0f / wsum);
      }
      const f32x4 o = om[0] - om[1] * lam;
      const float rs = rsqrtf(wave_sum((o.x * o.x + o.y * o.y) + (o.z * o.z + o.w * o.w)) * (1.0f / 256.f) + EPS) * 0.8f;
      v2u w; w.x = pk2(o.x * rs * sg.x, o.y * rs * sg.y); w.y = pk2(o.z * rs * sg.z, o.w * rs * sg.w);
      ((v2u*)(A2 + (size_t)R * DM + h * 256))[lane] = w;
      const f32x4 hv = ((const f32x4*)(HM + (size_t)R * 1024 + h * 256))[lane];
      const float rh = rsqrtf(wave_sum((hv.x * hv.x + hv.y * hv.y) + (hv.z * hv.z + hv.w * hv.w)) * (1.0f / 256.f) + EPS);
      const f32x4 g = ((const f32x4*)(og + h * 256))[lane];
      const v2u mo = ((const v2u*)(MO + (size_t)R * 1024 + h * 256))[lane];
      v2u w2; w2.x = pk2(hv.x * rh * g.x * bflo(mo.x), hv.y * rh * g.y * bfhi(mo.x)); w2.y = pk2(hv.z * rh * g.z * bflo(mo.y), hv.w * rh * g.w * bfhi(mo.y));
      ((v2u*)(A2 + (size_t)R * DM + 1024 + h * 256))[lane] = w2;
    }
  }
}
struct EpiRes {
  static constexpr bool PERM = true, AFTER_DRAIN = false;
  const float* x; float* out; bf16* H1b; float* SSQ;
  __device__ __forceinline__ void operator()(const pg8::f32x4 (&acc)[2][2][4][2], const pg8::Unit& u, int wr, int wc, int fr, int fq) const {
    const int row0 = u.pm * 256 + wr * 64 + fr, col0 = u.pn * 256 + wc * 32 + 8 * fq;
#pragma unroll
    for (int ai = 0; ai < 2; ++ai)
#pragma unroll
      for (int m = 0; m < 4; ++m) { const size_t R = (size_t)(row0 + ai * 128 + m * 16); float s = 0.f;
#pragma unroll
        for (int bj = 0; bj < 2; ++bj) { const size_t off = R * DM + col0 + bj * 128;
          const f32x4 x0 = *(const f32x4*)(x + off), x1 = *(const f32x4*)(x + off + 4);
          const f32x4 v0 = acc[ai][bj][m][0] + x0, v1 = acc[ai][bj][m][1] + x1;
          *(f32x4*)(out + off) = v0; *(f32x4*)(out + off + 4) = v1;
          v4u w; w.x = pk2(v0.x, v0.y); w.y = pk2(v0.z, v0.w); w.z = pk2(v1.x, v1.y); w.w = pk2(v1.z, v1.w);
          *(v4u*)(H1b + off) = w;
          s += (v0.x * v0.x + v0.y * v0.y) + (v0.z * v0.z + v0.w * v0.w) + (v1.x * v1.x + v1.y * v1.y) + (v1.z * v1.z + v1.w * v1.w); }
        s += __shfl_xor(s, 16); s += __shfl_xor(s, 32);
        if (fq == 0) SSQ[R * 32 + u.pn * 4 + wc] = s; }
  }
};
typedef __bf16 bfv2 __attribute__((ext_vector_type(2)));
__device__ __forceinline__ void split_hl(const f32x4 a, const f32x4 b, bf16x8& hi, bf16x8& lo) {
  float v[8] = {a.x, a.y, a.z, a.w, b.x, b.y, b.z, b.w}; unsigned h[8], l[8];
#pragma unroll
  for (int i = 0; i < 8; ++i) { h[i] = f2bf(v[i]); l[i] = f2bf(v[i] - __builtin_bit_cast(float, h[i] << 16)); }
  v4u hv = {h[0] | (h[1] << 16), h[2] | (h[3] << 16), h[4] | (h[5] << 16), h[6] | (h[7] << 16)};
  v4u lv = {l[0] | (l[1] << 16), l[2] | (l[3] << 16), l[4] | (l[5] << 16), l[6] | (l[7] << 16)};
  hi = __builtin_bit_cast(bf16x8, hv); lo = __builtin_bit_cast(bf16x8, lv);
}
__device__ __forceinline__ void p0_w3t(const Frame& F, const Args& a) {
  const float* wq = a.in[IN_WQ]; const float* sk = a.in[IN_SUBK]; const float* g2 = a.in[IN_G2];
  bf16* W3t = (bf16*)(F.ws + WS_W3T);
  const int gw = blockIdx.x * NWAVES + F.wave, NGW = gridDim.x * NWAVES, lane = F.lane, fr = lane & 15, fq = lane >> 4;
  for (int task = gw; task < 128 * 16; task += NGW) {
    const int kt = task >> 4, hh = task & 15;
    bf16x8 ahi[4], alo[4];
    const float* ap = wq + (size_t)(kt * 16 + fr) * DM + hh * 128 + fq * 8;
#pragma unroll
    for (int s = 0; s < 4; ++s) split_hl(*(const f32x4*)(ap + 32 * s), *(const f32x4*)(ap + 32 * s + 4), ahi[s], alo[s]);
    const f32x4 gk = *(const f32x4*)(g2 + kt * 16 + fq * 4);
#pragma unroll 1
    for (int t2 = 0; t2 < 8; ++t2) {
      const float* bp = sk + (size_t)(hh * 128 + t2 * 16 + fr) * 128 + fq * 8;
      f32x4 acc = {0.f, 0.f, 0.f, 0.f};
#pragma unroll
      for (int s = 0; s < 4; ++s) { bf16x8 bhi, blo; split_hl(*(const f32x4*)(bp + 32 * s), *(const f32x4*)(bp + 32 * s + 4), bhi, blo);
        acc = __builtin_amdgcn_mfma_f32_16x16x32_bf16(ahi[s], bhi, acc, 0, 0, 0);
        acc = __builtin_amdgcn_mfma_f32_16x16x32_bf16(ahi[s], blo, acc, 0, 0, 0);
        acc = __builtin_amdgcn_mfma_f32_16x16x32_bf16(alo[s], bhi, acc, 0, 0, 0); }
      v2u o; o.x = pk2(acc.x * gk.x, acc.y * gk.y); o.y = pk2(acc.z * gk.z, acc.w * gk.w);
      *(v2u*)(W3t + (size_t)(hh * 128 + t2 * 16 + fr) * DM + kt * 16 + fq * 4) = o;
    }
  }
}
__device__ __forceinline__ void p0_tables(const Frame& F, const Args& a) {
  const float* U = a.in[IN_U]; const float* V = a.in[IN_V]; const float* g2 = a.in[IN_G2];
  bf16* Ub = (bf16*)(F.ws + WS_UB); bf16* Vb = (bf16*)(F.ws + WS_VB);
  const size_t n8 = (size_t)16384 * DM / 8, stride = (size_t)gridDim.x * NTHR;
  for (size_t i = (size_t)blockIdx.x * NTHR + F.tid; i < n8; i += stride) {
    const int k8 = (int)(i & 255) * 8;
    const f32x4 g0 = *(const f32x4*)(g2 + k8), g1 = *(const f32x4*)(g2 + k8 + 4);
    const f32x4 u0 = *(const f32x4*)(U + i * 8), u1 = *(const f32x4*)(U + i * 8 + 4);
    const f32x4 v0 = *(const f32x4*)(V + i * 8), v1 = *(const f32x4*)(V + i * 8 + 4);
    v4u ou, ov;
    ou.x = pk2(u0.x * g0.x, u0.y * g0.y); ou.y = pk2(u0.z * g0.z, u0.w * g0.w); ou.z = pk2(u1.x * g1.x, u1.y * g1.y); ou.w = pk2(u1.z * g1.z, u1.w * g1.w);
    ov.x = pk2(v0.x, v0.y); ov.y = pk2(v0.z, v0.w); ov.z = pk2(v1.x, v1.y); ov.w = pk2(v1.z, v1.w);
    *(v4u*)(Ub + i * 8) = ou; *(v4u*)(Vb + i * 8) = ov;
  }
}
struct EpiScore {
  static constexpr bool PERM = true, AFTER_DRAIN = false;
  float* S; const LAS float* rs;
  __device__ __forceinline__ void operator()(const pg8::f32x4 (&acc)[2][2][4][2], const pg8::Unit& u, int wr, int wc, int fr, int fq) const {
    const int rl0 = wr * 64 + fr, col0 = u.pn * 256 + wc * 32 + 8 * fq;
#pragma unroll
    for (int ai = 0; ai < 2; ++ai)
#pragma unroll
      for (int m = 0; m < 4; ++m) { const int rl = rl0 + ai * 128 + m * 16; const float r = rs[rl]; const size_t R = (size_t)u.pm * 256 + rl;
#pragma unroll
        for (int bj = 0; bj < 2; ++bj) { float* d = S + R * DM + col0 + bj * 128;
          *(f32x4*)d = acc[ai][bj][m][0] * r; *(f32x4*)(d + 4) = acc[ai][bj][m][1] * r; } }
  }
};

__device__ __forceinline__ unsigned fkey(float f) { const unsigned b = __builtin_bit_cast(unsigned, f); return b ^ ((b >> 31) ? 0xFFFFFFFFu : 0x80000000u); }
template <int NV, int K> __device__ __forceinline__ void wave_topk(const unsigned (&u)[NV], bool (&sel)[NV], int lane) {
  unsigned prefix = 0u; int cge = NV * 64;
#pragma unroll 1
  for (int bit = 31; bit >= 0 && cge != K; --bit) {
    const unsigned cand = prefix | (1u << bit); int c = 0;
#pragma unroll
    for (int i = 0; i < NV; ++i) c += __builtin_popcountll(__ballot(u[i] >= cand));
    if (c >= K) { prefix = cand; cge = c; }
  }
  int cgt = 0;
#pragma unroll
  for (int i = 0; i < NV; ++i) cgt += __builtin_popcountll(__ballot(u[i] > prefix));
  int need = K - cgt;
  const unsigned long long lm = (1ull << lane) - 1ull;
#pragma unroll
  for (int i = 0; i < NV; ++i) { const unsigned long long eq = __ballot(u[i] == prefix); const int before = __builtin_popcountll(eq & lm);
    sel[i] = (u[i] > prefix) || (u[i] == prefix && before < need); const int ne = __builtin_popcountll(eq); need = need > ne ? need - ne : 0; }
}
__device__ __forceinline__ float gelu_erf(float x) { return 0.5f * x * (1.0f + erff(x * 0.70710678118654752f)); }

__device__ __forceinline__ void p6_peer(const Frame& F, const Args& a) {
  const float* S = (const float*)(F.ws + WS_S); const float* SSQ = (const float*)(F.ws + WS_SSQ); const bf16* H1b = (const bf16*)(F.ws + WS_H1B);
  const bf16* Ub = (const bf16*)(F.ws + WS_UB); const bf16* Vb = (const bf16*)(F.ws + WS_VB); float* out = a.out;
  const int lane = F.lane, gw = blockIdx.x * NWAVES + F.wave, NGW = gridDim.x * NWAVES;
  LAS float* wl = (LAS float*)(F.lds + F.wave * 2048);
  LAS int* wli = (LAS int*)wl;
  for (int tok = gw; tok < MROWS; tok += NGW) {
    const float rs = rsqrtf(wave_sum(lane < 32 ? SSQ[(size_t)tok * 32 + lane] : 0.f) * (1.0f / DM) + EPS);
    const float* srow = S + (size_t)tok * DM;
#ifdef PEER_IDS_FROM_GLOBAL
    { const int* gi = (const int*)(F.ws + (size_t)372 * MiB) + (size_t)tok * 128; const float* gg = (const float*)(F.ws + (size_t)376 * MiB) + (size_t)tok * 128;
      wli[128 + lane] = gi[lane]; wli[128 + 64 + lane] = gi[64 + lane]; wl[256 + lane] = gg[lane]; wl[256 + 64 + lane] = gg[64 + lane];
      asm volatile("s_waitcnt lgkmcnt(0)" ::: "memory"); }
#pragma unroll 1
    for (int h8 = 0; h8 < 0; ++h8) {
#else
#pragma unroll 1
    for (int h8 = 0; h8 < 8; ++h8) {
#endif
#pragma unroll
      for (int p = 0; p < 2; ++p) {
        const float2 sv = *(const float2*)(srow + (h8 * 2 + p) * 128 + 2 * lane);
        unsigned u[2] = {fkey(sv.x), fkey(sv.y)}; bool sel[2];
        wave_topk<2, 16>(u, sel, lane);
        const unsigned long long m0 = __ballot(sel[0]), m1 = __ballot(sel[1]); const unsigned long long lm = (1ull << lane) - 1ull;
        const int pos0 = __builtin_popcountll(m0 & lm), pos1 = __builtin_popcountll(m0) + __builtin_popcountll(m1 & lm);
        if (sel[0]) { wl[p * 16 + pos0] = sv.x; wli[64 + p * 16 + pos0] = 2 * lane; }
        if (sel[1]) { wl[p * 16 + pos1] = sv.y; wli[64 + p * 16 + pos1] = 2 * lane + 1; }
      }
      asm volatile("s_waitcnt lgkmcnt(0)" ::: "memory");
      const int ci = lane >> 2, cj = 4 * (lane & 3);
      const float s0 = wl[ci]; const f32x4 s1 = *(const LAS f32x4*)(wl + 16 + cj);
      float cv[4] = {s0 + s1.x, s0 + s1.y, s0 + s1.z, s0 + s1.w};
      unsigned cu[4] = {fkey(cv[0]), fkey(cv[1]), fkey(cv[2]), fkey(cv[3])}; bool csel[4];
      wave_topk<4, 16>(cu, csel, lane);
      float mx = -INFINITY;
#pragma unroll
      for (int q = 0; q < 4; ++q) if (csel[q]) mx = fmaxf(mx, cv[q]);
#pragma unroll
      for (int o = 1; o < 64; o <<= 1) mx = fmaxf(mx, __shfl_xor(mx, o));
      float ev[4], es = 0.f;
#pragma unroll
      for (int q = 0; q < 4; ++q) { ev[q] = csel[q] ? __expf(cv[q] - mx) : 0.f; es += ev[q]; }
      es = wave_sum(es); const float inv = 1.0f / es;
      const int ki = wli[64 + ci]; typedef int i32x4 __attribute__((ext_vector_type(4))); const i32x4 kj = *(const LAS i32x4*)(wli + 64 + 16 + cj);
      const int kjv[4] = {kj.x, kj.y, kj.z, kj.w};
      int base = 0; const unsigned long long lm = (1ull << lane) - 1ull;
#pragma unroll
      for (int q = 0; q < 4; ++q) { const unsigned long long mq = __ballot(csel[q]); const int pos = base + __builtin_popcountll(mq & lm);
        if (csel[q]) { wli[128 + h8 * 16 + pos] = ki * 128 + kjv[q]; wl[256 + h8 * 16 + pos] = ev[q] * inv; } base += __builtin_popcountll(mq); }
      asm volatile("s_waitcnt lgkmcnt(0)" ::: "memory");
    }
    v4u xr[4];
#pragma unroll
    for (int i = 0; i < 4; ++i) xr[i] = ((const v4u*)(H1b + (size_t)tok * DM))[i * 64 + lane];
    float y[32];
#pragma unroll
    for (int i = 0; i < 32; ++i) y[i] = 0.f;
#pragma unroll 1
    for (int e0 = 0; e0 < 128; e0 += 2) {
      const int id0 = __builtin_amdgcn_readfirstlane(wli[128 + e0]), id1 = __builtin_amdgcn_readfirstlane(wli[128 + e0 + 1]);
      const float g0 = wl[256 + e0], g1 = wl[256 + e0 + 1];
      v4u ur0[4], ur1[4], vr0[4], vr1[4];
#pragma unroll
      for (int i = 0; i < 4; ++i) { ur0[i] = ((const v4u*)(Ub + (size_t)id0 * DM))[i * 64 + lane]; ur1[i] = ((const v4u*)(Ub + (size_t)id1 * DM))[i * 64 + lane]; }
#pragma unroll
      for (int i = 0; i < 4; ++i) { vr0[i] = ((const v4u*)(Vb + (size_t)id0 * DM))[i * 64 + lane]; vr1[i] = ((const v4u*)(Vb + (size_t)id1 * DM))[i * 64 + lane]; }
      float d0 = 0.f, d1 = 0.f;
#pragma unroll
      for (int i = 0; i < 4; ++i)
#pragma unroll
        for (int c = 0; c < 4; ++c) { const unsigned xa = xr[i][c], ua = ur0[i][c], ub = ur1[i][c];
          d0 = __builtin_amdgcn_fdot2_f32_bf16(__builtin_bit_cast(bfv2, xa), __builtin_bit_cast(bfv2, ua), d0, false);
          d1 = __builtin_amdgcn_fdot2_f32_bf16(__builtin_bit_cast(bfv2, xa), __builtin_bit_cast(bfv2, ub), d1, false); }
      d0 = wave_sum(d0); d1 = wave_sum(d1);
      const float a0 = gelu_erf(d0 * rs) * g0, a1 = gelu_erf(d1 * rs) * g1;
#pragma unroll
      for (int i = 0; i < 4; ++i)
#pragma unroll
        for (int c = 0; c < 4; ++c) { y[i * 8 + 2 * c] += a0 * bflo(vr0[i][c]) + a1 * bflo(vr1[i][c]); y[i * 8 + 2 * c + 1] += a0 * bfhi(vr0[i][c]) + a1 * bfhi(vr1[i][c]); }
    }
    float* orow = out + (size_t)tok * DM;
#pragma unroll
    for (int i = 0; i < 4; ++i) { f32x4* p = (f32x4*)(orow + (size_t)(i * 64 + lane) * 8);
      f32x4 h0 = p[0], h1 = p[1];
      h0.x += y[i * 8 + 0]; h0.y += y[i * 8 + 1]; h0.z += y[i * 8 + 2]; h0.w += y[i * 8 + 3]; h1.x += y[i * 8 + 4]; h1.y += y[i * 8 + 5]; h1.z += y[i * 8 + 6]; h1.w += y[i * 8 + 7];
      p[0] = h0; p[1] = h1; }
  }
}
__global__ void __launch_bounds__(NTHR, 2) mk_fwd(Args args) {
  extern __shared__ __attribute__((aligned(16))) unsigned char lds_raw[];
  Frame F; F.lds = (LAS unsigned char*)lds_raw; F.ws = args.ws; F.tid = threadIdx.x; F.lane = F.tid & 63; F.wave = __builtin_amdgcn_readfirstlane(F.tid >> 6);
  const int lo = args.ph_lo, hi = args.ph_hi;
#define IN(k) (lo <= (k) && (k) < hi)
  if (IN(0)) {
    p0_lam(F, args);
    p0_zero_vpad(F);
    p0_metaproj(F, args);
    p0_rows(F, args);
    p0_transpose(F, args.in[IN_WIN], DPROJ, NPROJ, (bf16*)(F.ws + WS_W1T));
    p0_transpose(F, args.in[IN_WOUT], DM, DM, (bf16*)(F.ws + WS_W2T));
    p0_w3t(F, args);
    p0_tables(F, args);
  }
  if (IN(1)) {
    p1_meta_finalize(F, args);
    pg8::Gemm g{(const pg8::bf16_t*)(F.ws + WS_XN), (const pg8::bf16_t*)(F.ws + WS_W1T), MROWS, NPROJ, DM};
    pg8::StaticOrder S; S.init(MROWS, NPROJ, (int)gridDim.x, (int)blockIdx.x);
    EpiProj E{(bf16*)(F.ws + WS_Q), (bf16*)(F.ws + WS_KP), (bf16*)(F.ws + WS_VP), (bf16*)(F.ws + WS_MQ), (bf16*)(F.ws + WS_MK), (bf16*)(F.ws + WS_MV), (bf16*)(F.ws + WS_MO),
              args.in[IN_QNG], args.in[IN_KNG], (LAS float*)(F.lds + XCH_OFF)};
    pg8::gemm_phase<EpiProj, pg8::StaticOrder, true, true>(F.lds + RING_OFF, g, S, E);
  }
  if (IN(2)) {
    att::phase(F, (int)blockIdx.x, (int)gridDim.x);
  }
  if (IN(3)) {
    p3_combine(F, args, args.na);
  }
  if (IN(4)) {
    pg8::Gemm g{(const pg8::bf16_t*)(F.ws + WS_A2), (const pg8::bf16_t*)(F.ws + WS_W2T), MROWS, DM, DM};
    pg8::StaticOrder S; S.init(MROWS, DM, (int)gridDim.x, (int)blockIdx.x);
    EpiRes E{args.in[IN_X], args.out, (bf16*)(F.ws + WS_H1B), (float*)(F.ws + WS_SSQ)};
    pg8::gemm_phase<EpiRes, pg8::StaticOrder, true, true>(F.lds + RING_OFF, g, S, E);
  }
  if (IN(5)) {
    pg8::Gemm g{(const pg8::bf16_t*)(F.ws + WS_H1B), (const pg8::bf16_t*)(F.ws + WS_W3T), MROWS, DM, DM};
    pg8::StaticOrder S; S.init(MROWS, DM, (int)gridDim.x, (int)blockIdx.x);
    LAS float* rst = (LAS float*)(F.lds + XCH_OFF);
    { pg8::Unit u0; if (S.next(0, u0)) { if (F.tid < 256) { const float* sp = (const float*)(F.ws + WS_SSQ) + ((size_t)u0.pm * 256 + F.tid) * 32; float s = 0.f;
#pragma unroll
          for (int i = 0; i < 8; ++i) { const f32x4 v = ((const f32x4*)sp)[i]; s += (v.x + v.y) + (v.z + v.w); }
          rst[F.tid] = rsqrtf(s * (1.0f / DM) + EPS); } } }
    __syncthreads();
    EpiScore E{(float*)(F.ws + WS_S), rst};
    pg8::gemm_phase<EpiScore, pg8::StaticOrder, true, true>(F.lds + RING_OFF, g, S, E);
  }
  if (IN(6)) {
    p6_peer(F, args);
  }
#undef IN
}
namespace nv {
constexpr int TT = 2064;

__device__ __forceinline__ float block_sum(float v, float* red) {
  for (int o = 32; o > 0; o >>= 1) v += __shfl_xor(v, o);
  __syncthreads();
  if ((threadIdx.x & 63) == 0) red[threadIdx.x >> 6] = v;
  __syncthreads();
  return red[0] + red[1] + red[2] + red[3];
}
__device__ __forceinline__ float block_max(float v, float* red) {
  for (int o = 32; o > 0; o >>= 1) v = fmaxf(v, __shfl_xor(v, o));
  __syncthreads();
  if ((threadIdx.x & 63) == 0) red[threadIdx.x >> 6] = v;
  __syncthreads();
  return fmaxf(fmaxf(red[0], red[1]), fmaxf(red[2], red[3]));
}

__global__ __launch_bounds__(256) void k_norm(const float* __restrict__ h, const float* __restrict__ g, float* __restrict__ xn) {
  __shared__ float red[4];
  const int r = blockIdx.x, tid = threadIdx.x;
  float v[8]; float ss = 0.f;
#pragma unroll
  for (int i = 0; i < 8; ++i) { v[i] = h[(size_t)r * DM + tid + 256 * i]; ss += v[i] * v[i]; }
  ss = block_sum(ss, red);
  const float rs = rsqrtf(ss * (1.0f / DM) + EPS);
#pragma unroll
  for (int i = 0; i < 8; ++i) { const int c = tid + 256 * i; xn[(size_t)r * DM + c] = v[i] * rs * g[c]; }
}

__global__ __launch_bounds__(256) void k_gemm(const float* __restrict__ A, int lda, const float* __restrict__ B, int ldb,
                                               float* C, int ldc, const float* R, int ldr, int M, int N, int K) {
  __shared__ __attribute__((aligned(16))) unsigned short As[128][40];
  __shared__ __attribute__((aligned(16))) unsigned short Bs[128][40];
  const int tid = threadIdx.x, wid = tid >> 6, lane = tid & 63, wr = wid >> 1, wc = wid & 1, fr = lane & 15, fq = lane >> 4;
  const int m0 = blockIdx.y * 128, n0 = blockIdx.x * 128;
  f32x4 acc[4][4];
#pragma unroll
  for (int i = 0; i < 4; ++i)
#pragma unroll
    for (int j = 0; j < 4; ++j) acc[i][j] = (f32x4){0.f, 0.f, 0.f, 0.f};
  const int arow = tid >> 1, akk = (tid & 1) * 16;
  const int bk = tid >> 3, bn0 = (tid & 7) * 16;
  for (int k0 = 0; k0 < K; k0 += 32) {
    {
      float4 a[4];
      const bool ok = (m0 + arow) < M;
#pragma unroll
      for (int i = 0; i < 4; ++i) a[i] = ok ? *(const float4*)(A + (size_t)(m0 + arow) * lda + k0 + akk + 4 * i) : make_float4(0.f, 0.f, 0.f, 0.f);
#pragma unroll
      for (int i = 0; i < 4; ++i) { As[arow][akk + 4 * i + 0] = (unsigned short)f2bf(a[i].x); As[arow][akk + 4 * i + 1] = (unsigned short)f2bf(a[i].y); As[arow][akk + 4 * i + 2] = (unsigned short)f2bf(a[i].z); As[arow][akk + 4 * i + 3] = (unsigned short)f2bf(a[i].w); }
      float4 bv[4];
#pragma unroll
      for (int i = 0; i < 4; ++i) { const int n = n0 + bn0 + 4 * i; bv[i] = (n < N) ? *(const float4*)(B + (size_t)(k0 + bk) * ldb + n) : make_float4(0.f, 0.f, 0.f, 0.f); }
#pragma unroll
      for (int i = 0; i < 4; ++i) { Bs[bn0 + 4 * i + 0][bk] = (unsigned short)f2bf(bv[i].x); Bs[bn0 + 4 * i + 1][bk] = (unsigned short)f2bf(bv[i].y); Bs[bn0 + 4 * i + 2][bk] = (unsigned short)f2bf(bv[i].z); Bs[bn0 + 4 * i + 3][bk] = (unsigned short)f2bf(bv[i].w); }
    }
    __syncthreads();
    bf16x8 af[4], bfr[4];
#pragma unroll
    for (int i = 0; i < 4; ++i) af[i] = *(const bf16x8*)&As[wr * 64 + i * 16 + fr][fq * 8];
#pragma unroll
    for (int j = 0; j < 4; ++j) bfr[j] = *(const bf16x8*)&Bs[wc * 64 + j * 16 + fr][fq * 8];
#pragma unroll
    for (int i = 0; i < 4; ++i)
#pragma unroll
      for (int j = 0; j < 4; ++j) acc[i][j] = __builtin_amdgcn_mfma_f32_16x16x32_bf16(af[i], bfr[j], acc[i][j], 0, 0, 0);
    __syncthreads();
  }
#pragma unroll
  for (int i = 0; i < 4; ++i)
#pragma unroll
    for (int j = 0; j < 4; ++j)
#pragma unroll
      for (int e = 0; e < 4; ++e) {
        const int row = m0 + wr * 64 + i * 16 + fq * 4 + e, col = n0 + wc * 64 + j * 16 + fr;
        if (row < M && col < N) { float v = acc[i][j][e]; if (R) v += R[(size_t)row * ldr + col]; C[(size_t)row * ldc + col] = v; }
      }
}

__global__ __launch_bounds__(256) void k_route(const float* __restrict__ pq, const float* __restrict__ subkeys, int* __restrict__ oidx, float* __restrict__ og) {
  __shared__ __attribute__((aligned(16))) float qv[2048];
  __shared__ float s[2][128];
  __shared__ float sv[2][16]; __shared__ int si[2][16];
  __shared__ float cand[256]; __shared__ int cidx[256];
  __shared__ float tv[16]; __shared__ int ti[16];
  const size_t r = blockIdx.x; const int tid = threadIdx.x, lane = tid & 63, wid = tid >> 6;
  for (int i = tid; i < 2048; i += 256) qv[i] = pq[r * 2048 + i];
  __syncthreads();
  for (int hh = 0; hh < 8; ++hh) {
    { const int p = tid >> 7, k = tid & 127;
      const float4* sk = (const float4*)(subkeys + ((size_t)((hh * 2 + p) * 128 + k)) * 128);
      const float4* qq = (const float4*)(qv + hh * 256 + p * 128);
      float d = 0.f;
#pragma unroll 8
      for (int c = 0; c < 32; ++c) { const float4 a = sk[c], q4 = qq[c]; d += a.x * q4.x + a.y * q4.y + a.z * q4.z + a.w * q4.w; }
      s[p][k] = d; }
    __syncthreads();
    if (wid < 2) {
      const int p = wid; float v0 = s[p][lane], v1 = s[p][lane + 64];
      for (int it = 0; it < 16; ++it) {
        float bv = v0; int bi = lane; if (v1 > bv) { bv = v1; bi = lane + 64; }
        for (int o = 32; o > 0; o >>= 1) { const float ov = __shfl_xor(bv, o); const int oi = __shfl_xor(bi, o); if (ov > bv || (ov == bv && oi < bi)) { bv = ov; bi = oi; } }
        if (lane == 0) { sv[p][it] = bv; si[p][it] = bi; }
        if (bi == lane) v0 = -INFINITY; if (bi == lane + 64) v1 = -INFINITY;
      }
    }
    __syncthreads();
    { const int i = tid >> 4, j = tid & 15; cand[tid] = sv[0][i] + sv[1][j]; cidx[tid] = si[0][i] * 128 + si[1][j]; }
    __syncthreads();
    if (wid == 0) {
      float v[4]; for (int q = 0; q < 4; ++q) v[q] = cand[lane + 64 * q];
      for (int it = 0; it < 16; ++it) {
        float bv = v[0]; int bi = lane;
        for (int q = 1; q < 4; ++q) if (v[q] > bv) { bv = v[q]; bi = lane + 64 * q; }
        for (int o = 32; o > 0; o >>= 1) { const float ov = __shfl_xor(bv, o); const int oi = __shfl_xor(bi, o); if (ov > bv || (ov == bv && oi < bi)) { bv = ov; bi = oi; } }
        if (lane == 0) { tv[it] = bv; ti[it] = cidx[bi]; }
        for (int q = 0; q < 4; ++q) if (bi == lane + 64 * q) v[q] = -INFINITY;
      }
      const float mx = tv[0];
      float e = lane < 16 ? expf(tv[lane] - mx) : 0.f; float sm = e;
      for (int o = 32; o > 0; o >>= 1) sm += __shfl_xor(sm, o);
      if (lane < 16) { oidx[r * 128 + hh * 16 + lane] = ti[lane]; og[r * 128 + hh * 16 + lane] = e / sm; }
    }
    __syncthreads();
  }
}

__global__ __launch_bounds__(256) void k_attn2(const bf16* __restrict__ Qb, const bf16* __restrict__ Kp, const bf16* __restrict__ Vp,
                                                const float* __restrict__ lamp, const float* __restrict__ subg, float* __restrict__ ao) {
  __shared__ float sc[2][TT];
  __shared__ float qs[256];
  __shared__ float red[4];
  const int t = blockIdx.x, h = blockIdx.y, b = blockIdx.z, tid = threadIdx.x;
  const int cnt = t + 17;
  const float slope2 = exp2f(-2.0f * (h + 1)) * LOG2E;
  qs[tid] = bf2f(Qb[((size_t)((b * 4 + h) * 2 + (tid >> 7)) * SEQ + t) * 128 + (tid & 127)]);
  __syncthreads();
  float stat_l[2];
  for (int m = 0; m < 2; ++m) {
    float mx = -INFINITY;
    for (int s = tid; s < cnt; s += 256) {
      float d = 0.f;
#pragma unroll 4
      for (int i = 0; i < 16; ++i) { const v4u kk = *(const v4u*)(Kp + kp_off((b * 4 + h) * 2 + m, MPOS0 + s, i * 8)); const float* q = qs + m * 128 + i * 8;
        d += bflo(kk.x) * q[0] + bfhi(kk.x) * q[1] + bflo(kk.y) * q[2] + bfhi(kk.y) * q[3] + bflo(kk.z) * q[4] + bfhi(kk.z) * q[5] + bflo(kk.w) * q[6] + bfhi(kk.w) * q[7]; }
      d -= slope2 * (float)(cnt - 1 - s);
      sc[m][s] = d; mx = fmaxf(mx, d);
    }
    mx = block_max(mx, red);
    float sm = 0.f;
    for (int s = tid; s < cnt; s += 256) { const float e = exp2f(sc[m][s] - mx); sc[m][s] = e; sm += e; }
    sm = block_sum(sm, red);
    stat_l[m] = sm;
  }
  const float lam = lamp[0];
  const float i0 = 1.0f / stat_l[0], i1 = lam / stat_l[1];
  __syncthreads();
  for (int s = tid; s < cnt; s += 256) sc[0][s] = sc[0][s] * i0 - sc[1][s] * i1;
  __syncthreads();
  float o = 0.f;
  const bf16* vp = Vp + ((size_t)(b * 4 + h) * PADT + MPOS0) * 256 + tid;
  for (int s = 0; s < cnt; ++s) o += sc[0][s] * bf2f(vp[(size_t)s * 256]);
  float ss = block_sum(o * o, red);
  const float rs = rsqrtf(ss * (1.0f / 256.f) + EPS);
  ao[((size_t)b * SEQ + t) * 1024 + h * 256 + tid] = o * rs * subg[tid] * 0.8f;
}
__global__ __launch_bounds__(256) void k_conv2(const bf16* __restrict__ MQ, const bf16* __restrict__ MK, const float* __restrict__ cw, const float* __restrict__ cb, float* __restrict__ mqk) {
  const size_t i = (size_t)blockIdx.x * 256 + threadIdx.x;
  const int c = (int)(i & 1023); const size_t rr = i >> 10; if (rr >= (size_t)NB * TT) return;
  const int b = (int)(rr / TT), sp = (int)(rr % TT);
  const bool isk = c >= 512; const int cc = c & 511, h = cc >> 7, d = cc & 127;
  const bf16* src = (isk ? MK : MQ) + ((size_t)(b * 4 + h) * PADT + MPOS0) * 128 + d;
  float y = cb[c];
#pragma unroll
  for (int j = 0; j < 4; ++j) { const int s2 = sp - 3 + j; if (s2 >= 0) y += cw[j * 1024 + c] * bf2f(src[(size_t)s2 * 128]); }
  mqk[i] = y / (1.0f + expf(-y));
}
__global__ __launch_bounds__(512) void k_mlstm2(const float* __restrict__ mqk, const bf16* __restrict__ MV, const float* __restrict__ LI, const float* __restrict__ LF, float* __restrict__ hm) {
  __shared__ float qs[128], ks[128], ns[128], dens[1];
  const int b = blockIdx.x >> 2, h = blockIdx.x & 3, tid = threadIdx.x, e = tid >> 1, half = tid & 1;
  float C[64];
#pragma unroll
  for (int i = 0; i < 64; ++i) C[i] = 0.f;
  if (tid < 128) ns[tid] = 0.f;
  float m = 0.f;
  for (int sp = 0; sp < TT; ++sp) {
    const size_t rr = (size_t)b * TT + sp;
    __syncthreads();
    if (tid < 128) { qs[tid] = mqk[rr * 1024 + h * 128 + tid]; ks[tid] = mqk[rr * 1024 + 512 + h * 128 + tid] * 0.08838834764831845f; }
    const float li = LI[(b * 4 + h) * PADT + MPOS0 + sp], lf = LF[(b * 4 + h) * PADT + MPOS0 + sp];
    const float mn = fmaxf(lf + m, li);
    const float fp = expf(lf + m - mn), ip = expf(li - mn);
    m = mn;
    const float ve = bf2f(MV[((size_t)(b * 4 + h) * PADT + MPOS0 + sp) * 256 + e]);
    __syncthreads();
    if (tid < 128) ns[tid] = fp * ns[tid] + ip * ks[tid];
    float num = 0.f; const float iv = ip * ve;
#pragma unroll
    for (int i = 0; i < 64; ++i) { C[i] = fp * C[i] + iv * ks[half * 64 + i]; num += qs[half * 64 + i] * C[i]; }
    num += __shfl_xor(num, 1);
    __syncthreads();
    if (tid < 64) { float d = qs[tid] * ns[tid] + qs[tid + 64] * ns[tid + 64]; for (int o = 32; o > 0; o >>= 1) d += __shfl_xor(d, o); if (tid == 0) dens[0] = d; }
    __syncthreads();
    const float den = dens[0];
    if (half == 0 && sp >= NMETA) hm[((size_t)b * SEQ + sp - NMETA) * 1024 + h * 256 + e] = num / fmaxf(fabsf(den), expf(-m));
  }
}
__global__ __launch_bounds__(256) void k_mix2(const float* __restrict__ ao, const float* __restrict__ hm, const bf16* __restrict__ MO, const float* __restrict__ og, float* __restrict__ A2) {
  __shared__ float red[4];
  const size_t r = blockIdx.x; const int tid = threadIdx.x;
  for (int h = 0; h < 4; ++h) {
    A2[r * DM + h * 256 + tid] = ao[r * 1024 + h * 256 + tid];
    const float v = hm[r * 1024 + h * 256 + tid];
    const float ss = block_sum(v * v, red);
    const float rs = rsqrtf(ss * (1.0f / 256.f) + EPS);
    A2[r * DM + 1024 + h * 256 + tid] = v * rs * og[h * 256 + tid] * bf2f(MO[r * 1024 + h * 256 + tid]);
  }
}
__global__ __launch_bounds__(256) void k_peer2(const float* __restrict__ xn, const int* __restrict__ idx, const float* __restrict__ gg,
                                                const float* __restrict__ U, const float* __restrict__ V, float* out) {
  __shared__ __attribute__((aligned(16))) float xs[2048];
  __shared__ float act[128]; __shared__ int eid[128];
  const int tid = threadIdx.x, lane = tid & 63, wid = tid >> 6;
  const size_t r = blockIdx.x;
  for (int i = tid; i < 2048; i += 256) xs[i] = xn[r * 2048 + i];
  if (tid < 128) eid[tid] = idx[r * 128 + tid];
  __syncthreads();
  for (int q = 0; q < 32; ++q) {
    const int e = wid * 32 + q; const float4* up = (const float4*)(U + (size_t)eid[e] * 2048);
    float d = 0.f;
#pragma unroll
    for (int i = 0; i < 8; ++i) { const float4 a = up[i * 64 + lane], x4 = ((const float4*)xs)[i * 64 + lane]; d += a.x * x4.x + a.y * x4.y + a.z * x4.z + a.w * x4.w; }
    for (int o = 32; o > 0; o >>= 1) d += __shfl_xor(d, o);
    if (lane == 0) act[e] = 0.5f * d * (1.0f + erff(d * 0.7071067811865476f)) * gg[r * 128 + e];
  }
  __syncthreads();
  float4 y0 = make_float4(0.f, 0.f, 0.f, 0.f), y1 = y0;
  for (int e = 0; e < 128; ++e) {
    const float a = act[e]; const float4* vp = (const float4*)(V + (size_t)eid[e] * 2048);
    const float4 v0 = vp[tid], v1 = vp[256 + tid];
    y0.x += a * v0.x; y0.y += a * v0.y; y0.z += a * v0.z; y0.w += a * v0.w;
    y1.x += a * v1.x; y1.y += a * v1.y; y1.z += a * v1.z; y1.w += a * v1.w;
  }
  float4* op = (float4*)(out + r * 2048);
  float4 a0 = op[tid], a1 = op[256 + tid];
  a0.x += y0.x; a0.y += y0.y; a0.z += y0.z; a0.w += y0.w; a1.x += y1.x; a1.y += y1.y; a1.z += y1.z; a1.w += y1.w;
  op[tid] = a0; op[256 + tid] = a1;
}
__global__ void k_bf2f(const bf16* __restrict__ in, float* __restrict__ out, size_t n) {
  for (size_t i = (size_t)blockIdx.x * 256 + threadIdx.x; i < n; i += (size_t)gridDim.x * 256) out[i] = bf2f(in[i]);
}
}
extern "C" void kernel_launch(void* const* d_in, const int* in_sizes, int n_in, void* d_out, int out_size, void* d_ws, size_t ws_size, hipStream_t stream) {
  static int grid = 0;
  if (grid == 0) {
    int dev = 0, cus = 0, per_cu = 0;
    if (hipGetDevice(&dev) != hipSuccess || hipDeviceGetAttribute(&cus, hipDeviceAttributeMultiprocessorCount, dev) != hipSuccess) { fprintf(stderr, "device query failed\n"); grid = -1; return; }
    if (hipFuncSetAttribute((const void*)mk_fwd, hipFuncAttributeMaxDynamicSharedMemorySize, LDS_BYTES) != hipSuccess) { fprintf(stderr, "hipFuncSetAttribute failed\n"); grid = -1; return; }
    if (hipOccupancyMaxActiveBlocksPerMultiprocessor(&per_cu, (const void*)mk_fwd, NTHR, LDS_BYTES) != hipSuccess || per_cu < 1) { fprintf(stderr, "occupancy query: %d\n", per_cu); per_cu = 1; }
    (void)hipGetLastError();
    grid = cus * 1;
    if (ws_size < (size_t)512 * MiB) { fprintf(stderr, "ws too small %zu\n", ws_size); grid = -1; return; }
  }
  if (grid < 0) return;
  unsigned char* ws = (unsigned char*)d_ws;
  hipMemsetAsync(ws + WS_CTL, 0, CTL_ZERO_BYTES, stream);
  Args a{};
  for (int i = 0; i < 22; ++i) a.in[i] = (const float*)d_in[i];
  a.out = (float*)d_out; a.ws = ws; a.na = grid;
  using namespace nv;
  float* hm = (float*)(ws + WS_HM); float* mqk = (float*)(ws + 337 * MiB);
  const bf16* MQ = (const bf16*)(ws + WS_MQ); const bf16* MK = (const bf16*)(ws + WS_MK); const bf16* MV = (const bf16*)(ws + WS_MV);
  const float* LI = (const float*)(ws + WS_LI); const float* LF = (const float*)(ws + WS_LF);
#define PH(k) do { a.ph_lo = (k); a.ph_hi = (k) + 1; hipLaunchKernelGGL(mk_fwd, dim3(grid), dim3(NTHR), LDS_BYTES, stream, a); } while (0)
  PH(0); PH(1); PH(2);
  k_conv2<<<NB * TT * 4, 256, 0, stream>>>(MQ, MK, a.in[IN_CW], a.in[IN_CB], mqk);
  k_mlstm2<<<16, 512, 0, stream>>>(mqk, MV, LI, LF, hm);
  PH(3); PH(4); PH(5); PH(6);
#undef PH
}
```

```cpp
#include <hip/hip_runtime.h>
#include <cstdio>
#include <cstdint>
#include <math.h>
namespace pg8 {
#define PG8_LAS __attribute__((address_space(3)))
typedef unsigned short bf16_t;
typedef short bf16x8 __attribute__((ext_vector_type(8)));
typedef float f32x4 __attribute__((ext_vector_type(4)));
typedef unsigned u32x4 __attribute__((ext_vector_type(4)));
constexpr int BM = 256, BK = 64, HALF = 128, HTB = HALF * BK * 2  , STAGE_BYTES = 8 * HTB, NXCD = 8, WGM = 8;

__host__ __device__ __forceinline__ int lds_byte(int r, int c) { const int st = (r >> 4) * 2 + (c >> 5), rr = r & 15, cc = c & 31, ob = rr * 64 + cc * 2; return st * 1024 + (ob ^ (((ob >> 9) & 1) << 5)); }
__host__ __device__ __forceinline__ void stage_rc(int b, int& R, int& C) { const int st = b / 1024, sb = b % 1024, swz = sb ^ (((sb >> 9) & 1) << 5); R = (st >> 1) * 16 + swz / 64; C = (st & 1) * 32 + (swz % 64) / 2; }
__host__ __device__ __forceinline__ int perm32(int rho) { const int n = rho >> 4, i = rho & 15; return 8 * (i >> 2) + 4 * n + (i & 3); }

struct Unit { int pm, pn; };
struct Gemm { const bf16_t* A; const bf16_t* Bt; int M, N, K; };

struct StaticOrder {
    int nM, nN, nwg, G, c;
    __host__ __device__ void init(int M, int N, int G_, int c_) { nM = M / BM; nN = N / BM; nwg = nM * nN; G = G_; c = c_; }
    __host__ __device__ bool next(int i, Unit& u) const {
        const long L = (long)i * G + c; if (L >= nwg) return false;
        int wgid = (int)L; { const int q = nwg / NXCD, r = nwg % NXCD, xcd = wgid % NXCD, off = wgid / NXCD; wgid = (xcd < r ? xcd * (q + 1) : r * (q + 1) + (xcd - r) * q) + off; }
        const int nig = WGM * nN, gid = wgid / nig, fm = gid * WGM, gsz = (nM - fm) < WGM ? (nM - fm) : WGM;
        u.pm = fm + ((wgid % nig) % gsz); u.pn = (wgid % nig) / gsz; return true;
    }
    __device__ __forceinline__ void a_ready(const Unit&) const {}
    __device__ __forceinline__ void done(const Unit&) const {}
};

__device__ __forceinline__ unsigned cvt_pk_bf16(float lo, float hi) { unsigned r; asm volatile("v_cvt_pk_bf16_f32 %0, %1, %2" : "=v"(r) : "v"(lo), "v"(hi)); return r; }
typedef float f32x2 __attribute__((ext_vector_type(2)));
template <class Epi, class Sched, bool ALIGN_EPI = false, bool SP2 = false>
__device__ __forceinline__ void gemm_phase(PG8_LAS unsigned char* lds, const Gemm g, const Sched& S, const Epi& E) {
    const int tid = threadIdx.x, wid = __builtin_amdgcn_readfirstlane(tid >> 6), lane = tid & 63, wr = wid >> 2, wc = wid & 3, fr = lane & 15, fq = lane >> 4;
    const int K = g.K, nt = K / BK;
    unsigned voffA[2], voffB[2];
#pragma unroll
    for (int i = 0; i < 2; ++i) { int R, C; stage_rc(tid * 16 + i * 8192, R, C); const int Rb = Epi::PERM ? ((R & ~31) + perm32(R & 31)) : R;
        voffA[i] = (unsigned)(R * K + C) * 2u; voffB[i] = (unsigned)(Rb * K + C) * 2u; }
    const size_t kstep = (size_t)(BK * 2);
    const size_t hstep = (size_t)HALF * K * 2;
    const size_t tstep = 2 * hstep;
    const unsigned ldsw = (unsigned)wid * 1024u;
    const int aoff = lds_byte(wr * 64 + fr, fq * 8), boff = lds_byte(wc * 32 + fr, fq * 8);
#define PG8_SA(b, h) (((b) * 2 + (h)) * HTB)
#define PG8_SB(b, h) ((4 + (b) * 2 + (h)) * HTB)
#define PG8_STAGE(bufoff, gbase, voff) do { _Pragma("unroll") for (int _i = 0; _i < 2; ++_i) \
        __builtin_amdgcn_global_load_lds((const unsigned*)((const char*)(gbase) + (voff)[_i]), (PG8_LAS unsigned*)(lds + (bufoff) + ldsw + _i * 8192), 16, 0, 0); } while (0)
#define PG8_LDA(dst, b, h) do { _Pragma("unroll") for (int m = 0; m < 4; ++m) _Pragma("unroll") for (int k = 0; k < 2; ++k) dst[m][k] = *(const PG8_LAS bf16x8*)(lds + PG8_SA(b, h) + aoff + m * 2048 + k * 1024); } while (0)
#define PG8_LDB(dst, b, h) do { _Pragma("unroll") for (int n = 0; n < 2; ++n) _Pragma("unroll") for (int k = 0; k < 2; ++k) dst[n][k] = *(const PG8_LAS bf16x8*)(lds + PG8_SB(b, h) + boff + n * 2048 + k * 1024); } while (0)
#define PG8_MMA(ai, bj, At, Bt) do { __builtin_amdgcn_s_setprio(1); _Pragma("unroll") for (int m = 0; m < 4; ++m) _Pragma("unroll") for (int n = 0; n < 2; ++n) _Pragma("unroll") for (int k = 0; k < 2; ++k) \
        acc[ai][bj][m][n] = __builtin_amdgcn_mfma_f32_16x16x32_bf16(Bt[n][k], At[m][k], acc[ai][bj][m][n], 0, 0, 0); __builtin_amdgcn_s_setprio(0); } while (0)
#define PG8_WAIT_V(n) asm volatile("s_waitcnt vmcnt(" #n ")" ::: "memory")
#define PG8_WAIT_L(n) asm volatile("s_waitcnt lgkmcnt(" #n ")" ::: "memory")
#define PG8_BAR __builtin_amdgcn_s_barrier()
#define PG8_SCHED __builtin_amdgcn_sched_barrier(0)
    Unit cur, nxt; int ui = 0;
    if (!S.next(0, cur)) return;
    f32x4 acc[2][2][4][2];
#pragma unroll
    for (int a = 0; a < 2; ++a)
#pragma unroll
        for (int b = 0; b < 2; ++b)
#pragma unroll
            for (int m = 0; m < 4; ++m)
#pragma unroll
                for (int n = 0; n < 2; ++n) acc[a][b][m][n] = (f32x4){0.f, 0.f, 0.f, 0.f};
    bf16x8 At[4][2], B0[2][2], B1[2][2];
    const char* cA = (const char*)g.A + (size_t)cur.pm * tstep; const char* cB = (const char*)g.Bt + (size_t)cur.pn * tstep;
    S.a_ready(cur);
    if constexpr (SP2) {
        PG8_STAGE(PG8_SB(0, 0), cB, voffB); PG8_STAGE(PG8_SB(0, 1), cB + hstep, voffB); PG8_STAGE(PG8_SA(0, 0), cA, voffA); PG8_STAGE(PG8_SA(0, 1), cA + hstep, voffA);
        if (wr == 1) PG8_BAR;
        PG8_WAIT_V(2); PG8_BAR;
        PG8_STAGE(PG8_SB(1, 0), cB + kstep, voffB); PG8_STAGE(PG8_SA(1, 0), cA + kstep, voffA); PG8_STAGE(PG8_SB(1, 1), cB + hstep + kstep, voffB);
        PG8_WAIT_V(6); PG8_BAR;
    } else {
        PG8_STAGE(PG8_SB(0, 0), cB, voffB); PG8_STAGE(PG8_SA(0, 0), cA, voffA); PG8_STAGE(PG8_SB(0, 1), cB + hstep, voffB); PG8_STAGE(PG8_SA(0, 1), cA + hstep, voffA);
        if (wr == 1) PG8_BAR;
        PG8_WAIT_V(4); PG8_BAR;
        PG8_STAGE(PG8_SB(1, 0), cB + kstep, voffB); PG8_STAGE(PG8_SA(1, 0), cA + kstep, voffA); PG8_STAGE(PG8_SB(1, 1), cB + hstep + kstep, voffB);
        PG8_WAIT_V(6); PG8_BAR;
    }
    for (;;) {
        const bool has_next = S.next(ui + 1, nxt);
        const char* nA = has_next ? (const char*)g.A + (size_t)nxt.pm * tstep : cA; const char* nB = has_next ? (const char*)g.Bt + (size_t)nxt.pn * tstep : cB;
        for (int t = 0; t < nt; t += 2) {
            const bool last = (t == nt - 2);
            const char* a1 = cA + (size_t)(t + 1) * kstep;
            const char* a2 = last ? nA : cA + (size_t)(t + 2) * kstep; const char* b2 = last ? nB : cB + (size_t)(t + 2) * kstep;
            const char* a3 = a2 + kstep; const char* b3 = b2 + kstep;
            if (last && has_next) S.a_ready(nxt);
            if constexpr (SP2) {
            PG8_LDB(B0, 0, 0); PG8_LDB(B1, 0, 1); PG8_SCHED; PG8_LDA(At, 0, 0); PG8_STAGE(PG8_SA(1, 1), a1 + hstep, voffA);
            PG8_WAIT_V(8); PG8_WAIT_L(0); PG8_BAR; PG8_MMA(0, 0, At, B0); PG8_MMA(0, 1, At, B1); PG8_BAR; PG8_SCHED;
            PG8_LDA(At, 0, 1); PG8_STAGE(PG8_SB(0, 0), b2, voffB); PG8_STAGE(PG8_SB(0, 1), b2 + hstep, voffB); PG8_STAGE(PG8_SA(0, 0), a2, voffA);
            PG8_WAIT_V(8); PG8_WAIT_L(0); PG8_BAR; PG8_MMA(1, 0, At, B0); PG8_MMA(1, 1, At, B1); PG8_BAR; PG8_SCHED;
            PG8_LDB(B0, 1, 0); PG8_LDB(B1, 1, 1); PG8_SCHED; PG8_LDA(At, 1, 0); PG8_STAGE(PG8_SA(0, 1), a2 + hstep, voffA);
            PG8_WAIT_V(8); PG8_WAIT_L(0); PG8_BAR; PG8_MMA(0, 0, At, B0); PG8_MMA(0, 1, At, B1); PG8_BAR; PG8_SCHED;
            PG8_LDA(At, 1, 1); PG8_STAGE(PG8_SB(1, 0), b3, voffB); PG8_STAGE(PG8_SB(1, 1), b3 + hstep, voffB); PG8_STAGE(PG8_SA(1, 0), a3, voffA);
            PG8_WAIT_V(8); PG8_WAIT_L(0); PG8_BAR; PG8_MMA(1, 0, At, B0); PG8_MMA(1, 1, At, B1); PG8_BAR; PG8_SCHED;
            } else {
            PG8_LDB(B0, 0, 0); PG8_SCHED; PG8_LDA(At, 0, 0); PG8_STAGE(PG8_SA(1, 1), a1 + hstep, voffA);
            PG8_WAIT_L(8); PG8_BAR; PG8_WAIT_L(0); PG8_MMA(0, 0, At, B0); PG8_BAR; PG8_SCHED;
            PG8_LDB(B1, 0, 1); PG8_STAGE(PG8_SB(0, 0), b2, voffB);
            PG8_BAR; PG8_WAIT_L(0); PG8_MMA(0, 1, At, B1); PG8_BAR;
            PG8_LDA(At, 0, 1); PG8_STAGE(PG8_SA(0, 0), a2, voffA);
            PG8_BAR; PG8_WAIT_L(0); PG8_MMA(1, 0, At, B0); PG8_BAR; PG8_SCHED;
            PG8_STAGE(PG8_SB(0, 1), b2 + hstep, voffB);
            PG8_WAIT_V(6); PG8_BAR; PG8_MMA(1, 1, At, B1); PG8_BAR;
            PG8_LDB(B0, 1, 0); PG8_SCHED; PG8_LDA(At, 1, 0); PG8_STAGE(PG8_SA(0, 1), a2 + hstep, voffA);
            PG8_WAIT_L(8); PG8_BAR; PG8_WAIT_L(0); PG8_MMA(0, 0, At, B0); PG8_BAR; PG8_SCHED;
            PG8_LDB(B1, 1, 1); PG8_STAGE(PG8_SB(1, 0), b3, voffB);
            PG8_BAR; PG8_WAIT_L(0); PG8_MMA(0, 1, At, B1); PG8_BAR;
            PG8_LDA(At, 1, 1); PG8_STAGE(PG8_SA(1, 0), a3, voffA);
            PG8_BAR; PG8_WAIT_L(0); PG8_MMA(1, 0, At, B0); PG8_BAR; PG8_SCHED;
            PG8_STAGE(PG8_SB(1, 1), b3 + hstep, voffB);
            PG8_WAIT_V(6); PG8_BAR; PG8_MMA(1, 1, At, B1); PG8_BAR;
            }
        }
        if constexpr (ALIGN_EPI) { if (wr == 0) PG8_BAR; }
        if constexpr (!Epi::AFTER_DRAIN) { E(acc, cur, wr, wc, fr, fq); S.done(cur); }
        if (!has_next) break;
#pragma unroll
        for (int a = 0; a < 2; ++a)
#pragma unroll
            for (int b = 0; b < 2; ++b)
#pragma unroll
                for (int m = 0; m < 4; ++m)
#pragma unroll
                    for (int n = 0; n < 2; ++n) acc[a][b][m][n] = (f32x4){0.f, 0.f, 0.f, 0.f};
        cur = nxt; cA = nA; cB = nB; ++ui;
        if constexpr (ALIGN_EPI) { if (wr == 1) PG8_BAR; }
    }
    PG8_WAIT_V(0);
    if constexpr (!ALIGN_EPI) { if (wr == 0) PG8_BAR; }
    PG8_BAR;
    if constexpr (Epi::AFTER_DRAIN) { E.fused(acc, cur, wr, wc, fr, fq, lds, wid, lane); S.done(cur); }
#undef PG8_SA
#undef PG8_SB
#undef PG8_STAGE
#undef PG8_LDA
#undef PG8_LDB
#undef PG8_MMA
#undef PG8_WAIT_V
#undef PG8_WAIT_L
#undef PG8_BAR
#undef PG8_SCHED
}
}
#define GAS __attribute__((address_space(1)))
#define LAS __attribute__((address_space(3)))
typedef unsigned short bf16;
typedef unsigned v4u __attribute__((ext_vector_type(4)));
typedef unsigned v2u __attribute__((ext_vector_type(2)));
typedef float f32x4 __attribute__((ext_vector_type(4)));
typedef short bf16x8 __attribute__((ext_vector_type(8)));
#define LDS_WAIT() asm volatile("s_waitcnt lgkmcnt(0)" ::: "memory")
#define VM_WAIT() asm volatile("s_waitcnt vmcnt(0)" ::: "memory")

constexpr int DM = 2048, NB = 4, SEQ = 2048, NMETA = 16, MROWS = NB * SEQ, DPROJ = 6152, NPROJ = 6144;
constexpr int PADT = 2112, POS0 = 64, MPOS0 = 48;
constexpr float EPS = 1e-6f;
constexpr float LOG2E = 1.4426950408889634f;
constexpr float QSCALE = 0.08838834764831845f * LOG2E;
constexpr int NWAVES = 8, NTHR = 512;

constexpr size_t MiB = 1u << 20;
constexpr size_t WS_CTL = 0, CTL_ZERO_BYTES = 1 * MiB;
constexpr size_t WS_PM = 512 * 1024;
constexpr size_t WS_W1T = 2 * MiB, WS_W2T = 26 * MiB, WS_W3T = 34 * MiB, WS_XN = 42 * MiB;
constexpr size_t WS_Q = 74 * MiB, WS_KP = 90 * MiB, WS_VP = 107 * MiB, WS_MQ = 124 * MiB, WS_MK = 133 * MiB, WS_MV = 142 * MiB, WS_MO = 159 * MiB;
constexpr size_t WS_SMALL = 175 * MiB;
constexpr size_t WS_XM = WS_SMALL, WS_LI = WS_SMALL + 128 * 1024, WS_LF = WS_SMALL + 384 * 1024, WS_LAM = WS_SMALL + 640 * 1024;
constexpr size_t WS_PO = 176 * MiB, WS_ML = 304 * MiB, WS_HM = 305 * MiB, WS_A2 = 42 * MiB, WS_H1B = 74 * MiB, WS_SSQ = 106 * MiB, WS_S = 176 * MiB, WS_UB = 384 * MiB, WS_VB = 448 * MiB;
constexpr int CW_BAR = 4096;

constexpr int RING_OFF = 0, RING_BYTES = 131072;
constexpr int XCH_OFF = 131072;
constexpr int MISC_OFF = XCH_OFF + 8192;
constexpr int LDS_BYTES = 155648;

__device__ __forceinline__ unsigned f2bf(float f) { unsigned u = __builtin_bit_cast(unsigned, f); return (u + 0x7fffu + ((u >> 16) & 1u)) >> 16; }
__device__ __forceinline__ unsigned pk2(float lo, float hi) { return f2bf(lo) | (f2bf(hi) << 16); }
__device__ __forceinline__ float bf2f(unsigned short u) { return __builtin_bit_cast(float, (unsigned)u << 16); }
__device__ __forceinline__ float bflo(unsigned w) { return __builtin_bit_cast(float, w << 16); }
__device__ __forceinline__ float bfhi(unsigned w) { return __builtin_bit_cast(float, w & 0xffff0000u); }
__device__ __forceinline__ float wave_sum(float v) {
#pragma unroll
  for (int o = 1; o < 64; o <<= 1) v += __shfl_xor(v, o);
  return v;
}
__device__ __forceinline__ size_t kp_off(int bhm, int pos, int d) { const int j = pos >> 6, row = pos & 63, d0 = d >> 4, hi = (d >> 3) & 1;
  return ((size_t)(bhm * 33 + j) * 8 + d0) * 1024 + (size_t)((((row << 1) | hi) ^ ((row >> 3) & 1)) << 3) + (d & 7); }
__device__ __forceinline__ float sigmoidf_(float x) { return 1.0f / (1.0f + __expf(-x)); }
struct Args { const float* in[22]; float* out; unsigned char* ws; int ph_lo, ph_hi, na, pad; };
struct Frame {
  LAS unsigned char* lds; unsigned char* ws; int tid, lane, wave; const float* const* in;
};
#define IN_X 0
#define IN_META 1
#define IN_G1 2
#define IN_WIN 3
#define IN_CW 4
#define IN_CB 5
#define IN_IGB 6
#define IN_FGB 7
#define IN_LQ1 8
#define IN_LK1 9
#define IN_LQ2 10
#define IN_LK2 11
#define IN_QNG 12
#define IN_KNG 13
#define IN_SUBG 14
#define IN_OUTG 15
#define IN_WOUT 16
#define IN_G2 17
#define IN_WQ 18
#define IN_SUBK 19
#define IN_U 20
#define IN_V 21

__device__ __forceinline__ void p0_rows(const Frame& F, const Args& a) {
  const float* x = a.in[IN_X]; const float* meta = a.in[IN_META]; const float* g1 = a.in[IN_G1]; const float* w_in = a.in[IN_WIN];
  const float* igb = a.in[IN_IGB]; const float* fgb = a.in[IN_FGB];
  bf16* Xn = (bf16*)(F.ws + WS_XN); bf16* Xm = (bf16*)(F.ws + WS_XM); float* LI = (float*)(F.ws + WS_LI); float* LF = (float*)(F.ws + WS_LF);
  LAS f32x4* wgl = (LAS f32x4*)(F.lds);
  for (int e = F.tid; e < 4096; e += NTHR) {
    const int ln = e & 63, q = e >> 6, half = q & 1, j = (q >> 1) & 3, i = q >> 3;
    const int k = 4 * (i * 64 + ln) + j;
    wgl[e] = *(const f32x4*)(w_in + (size_t)k * DPROJ + NPROJ + 4 * half);
  }
  __syncthreads();
  const int gw = blockIdx.x * NWAVES + F.wave, NGW = gridDim.x * NWAVES, lane = F.lane;
  for (int task = gw; task < MROWS / 2 + NMETA / 2; task += NGW) {
    const bool ismeta = task >= MROWS / 2;
    const int r0 = ismeta ? (task - MROWS / 2) * 2 : task * 2;
    const float* src0 = (ismeta ? meta : x) + (size_t)r0 * DM;
    float rs[2];
    { float s0 = 0.f, s1 = 0.f;
#pragma unroll 2
      for (int i = 0; i < 8; ++i) { const f32x4 a0 = ((const f32x4*)src0)[i * 64 + lane], a1 = ((const f32x4*)(src0 + DM))[i * 64 + lane];
        s0 += (a0.x * a0.x + a0.y * a0.y) + (a0.z * a0.z + a0.w * a0.w); s1 += (a1.x * a1.x + a1.y * a1.y) + (a1.z * a1.z + a1.w * a1.w); }
      rs[0] = rsqrtf(wave_sum(s0) * (1.0f / DM) + EPS); rs[1] = rsqrtf(wave_sum(s1) * (1.0f / DM) + EPS); }
    float ga[2][8];
#pragma unroll
    for (int rr = 0; rr < 2; ++rr)
#pragma unroll
      for (int g = 0; g < 8; ++g) ga[rr][g] = 0.f;
    bf16* dst0 = (ismeta ? Xm : Xn) + (size_t)r0 * DM;
#pragma unroll 1
    for (int i = 0; i < 8; ++i) {
      const f32x4 g = ((const f32x4*)g1)[i * 64 + lane];
      f32x4 xn[2];
#pragma unroll
      for (int rr = 0; rr < 2; ++rr) { xn[rr] = ((const f32x4*)(src0 + (size_t)rr * DM))[i * 64 + lane] * g * rs[rr];
        v2u o; o.x = pk2(xn[rr].x, xn[rr].y); o.y = pk2(xn[rr].z, xn[rr].w); ((v2u*)(dst0 + (size_t)rr * DM))[i * 64 + lane] = o; }
#pragma unroll
      for (int j = 0; j < 4; ++j) {
        const f32x4 w0 = wgl[((i * 4 + j) * 2 + 0) * 64 + lane], w1 = wgl[((i * 4 + j) * 2 + 1) * 64 + lane];
#pragma unroll
        for (int rr = 0; rr < 2; ++rr) { const float xv = xn[rr][j];
          ga[rr][0] += xv * w0.x; ga[rr][1] += xv * w0.y; ga[rr][2] += xv * w0.z; ga[rr][3] += xv * w0.w;
          ga[rr][4] += xv * w1.x; ga[rr][5] += xv * w1.y; ga[rr][6] += xv * w1.z; ga[rr][7] += xv * w1.w; }
      }
    }
#pragma unroll
    for (int rr = 0; rr < 2; ++rr)
#pragma unroll
      for (int g = 0; g < 8; ++g) ga[rr][g] = wave_sum(ga[rr][g]);
    if (lane < 8) {
      const int rr = lane >> 2, h = lane & 3;
      float gi = 0.f, gf = 0.f;
#pragma unroll
      for (int q = 0; q < 2; ++q)
#pragma unroll
        for (int hh = 0; hh < 4; ++hh) if (q == rr && hh == h) { gi = ga[q][hh]; gf = ga[q][4 + hh]; }
      const float li = gi + igb[h]; const float fx = gf + fgb[h];
      const float lf = fminf(fx, 0.f) - log1pf(__expf(-fabsf(fx)));
      const int R = r0 + rr;
      if (!ismeta) { const int b = R >> 11, t = R & 2047; LI[(b * 4 + h) * PADT + POS0 + t] = li; LF[(b * 4 + h) * PADT + POS0 + t] = lf; }
      else { for (int b = 0; b < NB; ++b) { LI[(b * 4 + h) * PADT + MPOS0 + R] = li; LF[(b * 4 + h) * PADT + MPOS0 + R] = lf; } }
    }
  }
  __syncthreads();
}
__device__ __forceinline__ void p0_metaproj(const Frame& F, const Args& a) {
  const float* meta = a.in[IN_META]; const float* g1 = a.in[IN_G1]; const float* w_in = a.in[IN_WIN];
  float* PM = (float*)(F.ws + WS_PM);
  LAS float* xs = (LAS float*)(F.lds);
  LAS float* part = (LAS float*)(F.lds + 16384);
  const int q = F.tid >> 7, c = F.tid & 127;
  for (int task = blockIdx.x; task < NPROJ / 128; task += gridDim.x) {
    const int n = task * 128 + c;
    float acc[16];
#pragma unroll
    for (int m = 0; m < 16; ++m) acc[m] = 0.f;
#pragma unroll 1
    for (int kb = 0; kb < 8; ++kb) {
      __syncthreads();
#pragma unroll
      for (int i = 0; i < 8; ++i) { const int idx = F.tid + NTHR * i, qq = idx >> 10, kk = (idx >> 4) & 63, m = idx & 15; const int k = 512 * qq + 64 * kb + kk;
        xs[idx] = meta[(size_t)m * DM + k] * g1[k]; }
      __syncthreads();
#pragma unroll 4
      for (int kk = 0; kk < 64; ++kk) {
        const float w = w_in[(size_t)(512 * q + 64 * kb + kk) * DPROJ + n];
        const LAS f32x4* xp = (const LAS f32x4*)(xs + (q * 64 + kk) * 16);
#pragma unroll
        for (int t = 0; t < 4; ++t) { const f32x4 xv = xp[t]; acc[4 * t + 0] += xv.x * w; acc[4 * t + 1] += xv.y * w; acc[4 * t + 2] += xv.z * w; acc[4 * t + 3] += xv.w * w; }
      }
    }
#pragma unroll
    for (int m = 0; m < 16; ++m) part[(q * 16 + m) * 128 + c] = acc[m];
    __syncthreads();
    for (int e = F.tid; e < 16 * 128; e += NTHR) { const int m = e >> 7, cc = e & 127;
      PM[m * NPROJ + task * 128 + cc] = (part[(0 * 16 + m) * 128 + cc] + part[(1 * 16 + m) * 128 + cc]) + (part[(2 * 16 + m) * 128 + cc] + part[(3 * 16 + m) * 128 + cc]); }
  }
  __syncthreads();
}
__device__ __forceinline__ void p0_transpose(const Frame& F, const float* W, int ldw, int N, bf16* Wt) {
  LAS float* tl = (LAS float*)(F.lds);
  const int ntn = N / 64, ntask = ntn * 16;
  for (int task = blockIdx.x; task < ntask; task += gridDim.x) {
    const int nb = task % ntn, kb = task / ntn, n0 = nb * 64, k0 = kb * 128;
    __syncthreads();
#pragma unroll
    for (int i = 0; i < 4; ++i) { const int idx = F.tid + NTHR * i, kk = idx >> 4, c4 = idx & 15;
      const f32x4 w = *(const f32x4*)(W + (size_t)(k0 + kk) * ldw + n0 + 4 * c4);
      LAS float* d = tl + kk * 65 + 4 * c4; d[0] = w.x; d[1] = w.y; d[2] = w.z; d[3] = w.w; }
    __syncthreads();
    const int n = F.tid >> 3, kc = F.tid & 7;
    const LAS float* s = tl + (kc * 16) * 65 + n;
    v4u o0, o1;
    o0.x = pk2(s[0 * 65], s[1 * 65]); o0.y = pk2(s[2 * 65], s[3 * 65]); o0.z = pk2(s[4 * 65], s[5 * 65]); o0.w = pk2(s[6 * 65], s[7 * 65]);
    o1.x = pk2(s[8 * 65], s[9 * 65]); o1.y = pk2(s[10 * 65], s[11 * 65]); o1.z = pk2(s[12 * 65], s[13 * 65]); o1.w = pk2(s[14 * 65], s[15 * 65]);
    v4u* dp = (v4u*)(Wt + (size_t)(n0 + n) * DM + k0 + kc * 16);
    dp[0] = o0; dp[1] = o1;
  }
  __syncthreads();
}
__device__ __forceinline__ void p0_zero_vpad(const Frame& F) {
  bf16* Vp = (bf16*)(F.ws + WS_VP);
  const int per = MPOS0 * 256 / 8;
  for (int i = blockIdx.x * NTHR + F.tid; i < 16 * per; i += gridDim.x * NTHR) { const int bh = i / per, e = i % per;
    *(v4u*)(Vp + (size_t)bh * PADT * 256 + (size_t)e * 8) = (v4u){0u, 0u, 0u, 0u}; }
}
__device__ __forceinline__ void p0_lam(const Frame& F, const Args& a) {
  if (blockIdx.x == 0 && F.wave == 0) {
    const int l = F.lane;
    float s1 = a.in[IN_LQ1][l] * a.in[IN_LK1][l] + a.in[IN_LQ1][l + 64] * a.in[IN_LK1][l + 64];
    float s2 = a.in[IN_LQ2][l] * a.in[IN_LK2][l] + a.in[IN_LQ2][l + 64] * a.in[IN_LK2][l + 64];
    s1 = wave_sum(s1); s2 = wave_sum(s2);
    if (l == 0) *(float*)(F.ws + WS_LAM) = __expf(s1) - __expf(s2) + 0.2f;
  }
}

struct EpiProj {
  static constexpr bool PERM = true, AFTER_DRAIN = false;
  bf16 *Qb, *Kp, *Vp, *MQ, *MK, *MV, *MO; const float *qg, *kg; LAS float* xch;
  __device__ __forceinline__ void operator()(const pg8::f32x4 (&acc)[2][2][4][2], const pg8::Unit& u, int wr, int wc, int fr, int fq) const {
    const int pn = u.pn, b = u.pm >> 3, tb = (u.pm & 7) * 256 + wr * 64 + fr, d0 = wc * 32 + fq * 8;
    if (pn < 8) {
      const bool isk = pn >= 4; const int h = pn & 3;
      float ssq[2][4][2];
#pragma unroll
      for (int ai = 0; ai < 2; ++ai)
#pragma unroll
        for (int m = 0; m < 4; ++m)
#pragma unroll
          for (int bj = 0; bj < 2; ++bj) { float s = 0.f;
#pragma unroll
            for (int n = 0; n < 2; ++n) { const pg8::f32x4 x = acc[ai][bj][m][n]; s += (x[0] * x[0] + x[1] * x[1]) + (x[2] * x[2] + x[3] * x[3]); }
            s += __shfl_xor(s, 16); s += __shfl_xor(s, 32); ssq[ai][m][bj] = s;
            if (fq == 0) xch[((ai * 128 + wr * 64 + m * 16 + fr) * 2 + bj) * 4 + wc] = s; }
      asm volatile("s_waitcnt lgkmcnt(0)" ::: "memory"); __builtin_amdgcn_s_barrier(); asm volatile("" ::: "memory");
      const float* gp = (isk ? kg : qg) + d0; const f32x4 g0 = *(const f32x4*)gp, g1v = *(const f32x4*)(gp + 4);
      const float sc = isk ? 1.0f : QSCALE;
#pragma unroll
      for (int ai = 0; ai < 2; ++ai)
#pragma unroll
        for (int m = 0; m < 4; ++m)
#pragma unroll
          for (int bj = 0; bj < 2; ++bj) {
            const f32x4 p = *(const LAS f32x4*)(xch + ((ai * 128 + wr * 64 + m * 16 + fr) * 2 + bj) * 4);
            const float rs = rsqrtf(((p.x + p.y) + (p.z + p.w)) * (1.0f / 128.f) + EPS) * sc;
            const pg8::f32x4 v0 = acc[ai][bj][m][0], v1 = acc[ai][bj][m][1];
            v4u w; w.x = pk2(v0[0] * rs * g0.x, v0[1] * rs * g0.y); w.y = pk2(v0[2] * rs * g0.z, v0[3] * rs * g0.w);
            w.z = pk2(v1[0] * rs * g1v.x, v1[1] * rs * g1v.y); w.w = pk2(v1[2] * rs * g1v.z, v1[3] * rs * g1v.w);
            const int t = tb + ai * 128 + m * 16;
            bf16* dst = isk ? Kp + kp_off((b * 4 + h) * 2 + bj, POS0 + t, d0)
                            : Qb + ((size_t)((b * 4 + h) * 2 + bj) * SEQ + t) * 128 + d0;
            *(v4u*)dst = w; }
      return;
    }
#pragma unroll
    for (int ai = 0; ai < 2; ++ai)
#pragma unroll
      for (int m = 0; m < 4; ++m)
#pragma unroll
        for (int bj = 0; bj < 2; ++bj) {
          pg8::f32x4 v0 = acc[ai][bj][m][0], v1 = acc[ai][bj][m][1];
          const int t = tb + ai * 128 + m * 16;
          bf16* dst;
          if (pn < 12) { const int h = pn - 8; dst = Vp + ((size_t)(b * 4 + h) * PADT + POS0 + t) * 256 + bj * 128 + d0; }
          else if (pn < 16) { const int h = 2 * (pn & 1) + bj; dst = (pn >= 14 ? MK : MQ) + ((size_t)(b * 4 + h) * PADT + POS0 + t) * 128 + d0; }
          else if (pn < 20) { const int h = pn - 16; dst = MV + ((size_t)(b * 4 + h) * PADT + POS0 + t) * 256 + bj * 128 + d0; }
          else { dst = MO + (size_t)(b * SEQ + t) * 1024 + (pn - 20) * 256 + bj * 128 + d0;
#pragma unroll
            for (int j = 0; j < 4; ++j) { v0[j] = sigmoidf_(v0[j]); v1[j] = sigmoidf_(v1[j]); } }
          v4u w; w.x = pk2(v0[0], v0[1]); w.y = pk2(v0[2], v0[3]); w.z = pk2(v1[0], v1[1]); w.w = pk2(v1[2], v1[3]);
          *(v4u*)dst = w; }
  }
};
__device__ __forceinline__ void p1_meta_finalize(const Frame& F, const Args& a) {
  if (blockIdx.x >= NMETA) return;
  const int mrow = blockIdx.x, tid = F.tid, lane = F.lane, w = F.wave;
  const float* meta = a.in[IN_META] + (size_t)mrow * DM; const float* PM = (const float*)(F.ws + WS_PM) + (size_t)mrow * NPROJ;
  LAS float* red = (LAS float*)(F.lds + XCH_OFF);
  const f32x4 mv = ((const f32x4*)meta)[tid];
  float s = wave_sum((mv.x * mv.x + mv.y * mv.y) + (mv.z * mv.z + mv.w * mv.w));
  if (lane == 0) red[w] = s;
  __syncthreads();
  float tot = 0.f;
#pragma unroll
  for (int i = 0; i < 8; ++i) tot += red[i];
  const float rs = rsqrtf(tot * (1.0f / DM) + EPS);
  bf16* Kp = (bf16*)(F.ws + WS_KP); bf16* Vp = (bf16*)(F.ws + WS_VP); bf16* MQ = (bf16*)(F.ws + WS_MQ); bf16* MK = (bf16*)(F.ws + WS_MK); bf16* MV = (bf16*)(F.ws + WS_MV);
  const int pos = MPOS0 + mrow;
  {
    const float v0 = PM[1024 + w * 128 + lane] * rs, v1 = PM[1024 + w * 128 + lane + 64] * rs;
    const float rk = rsqrtf(wave_sum(v0 * v0 + v1 * v1) * (1.0f / 128.f) + EPS);
    const float* kg = a.in[IN_KNG];
    const unsigned short o0 = (unsigned short)f2bf(v0 * rk * kg[lane]), o1 = (unsigned short)f2bf(v1 * rk * kg[lane + 64]);
    for (int b = 0; b < NB; ++b) { const int bhm = (b * 4 + (w >> 1)) * 2 + (w & 1); Kp[kp_off(bhm, pos, lane)] = o0; Kp[kp_off(bhm, pos, lane + 64)] = o1; }
  }
  { const int c = tid * 2;
    const unsigned o = pk2(PM[2048 + c] * rs, PM[2048 + c + 1] * rs); const int h = c >> 8, e = c & 255;
    for (int b = 0; b < NB; ++b) *(unsigned*)(Vp + ((size_t)(b * 4 + h) * PADT + pos) * 256 + e) = o;
    const unsigned o2 = pk2(PM[3072 + c] * rs, PM[3072 + c + 1] * rs); const bool isk = c >= 512; const int cc = c & 511, hq = cc >> 7, d = cc & 127;
    for (int b = 0; b < NB; ++b) *(unsigned*)((isk ? MK : MQ) + ((size_t)(b * 4 + hq) * PADT + pos) * 128 + d) = o2;
    const unsigned o3 = pk2(PM[4096 + c] * rs, PM[4096 + c + 1] * rs);
    for (int b = 0; b < NB; ++b) *(unsigned*)(MV + ((size_t)(b * 4 + h) * PADT + pos) * 256 + e) = o3;
  }
  __syncthreads();
}

namespace att {
using f32x16 = __attribute__((ext_vector_type(16))) float;
using s16x4 = __attribute__((ext_vector_type(4))) short;
constexpr int STEPS_BHM = 152, NSTEPS = 32 * STEPS_BHM;
constexpr int SHM_V = 64 * 256 * 2, SHM_K = 64 * 128 * 2;
constexpr int LDS_V = 0, LDS_K = 2 * SHM_V, LDS_Q = LDS_K + SHM_K, LDS_WS = LDS_Q + 8 * 8192;
constexpr float THR2 = 8.0f;
#define KSWZ(row, colB) ((row) * 256 + ((colB) ^ (((row) & 7) << 4)))
#define SBAR() __builtin_amdgcn_sched_barrier(0)
__device__ __forceinline__ int crow(int r, int hi) { return (r & 3) + 8 * (r >> 2) + 4 * hi; }
__device__ __forceinline__ unsigned cvtpk(float lo, float hi) { unsigned r; asm volatile("v_cvt_pk_bf16_f32 %0, %1, %2" : "=v"(r) : "v"(lo), "v"(hi)); return r; }
__device__ __forceinline__ int qb_start(int qb) { return 2 * qb * qb + 3 * qb; }
__device__ __forceinline__ int chunk_of(int s, int NA) { return ((s + 1) * NA - 1) / NSTEPS; }

template <int OFF> __device__ __forceinline__ s16x4 tr_read(int vb) {
  s16x4 r; asm volatile("ds_read_b64_tr_b16 %0, %1 offset:%2" : "=&v"(r) : "v"(vb), "i"(OFF) : "memory"); return r;
}
constexpr int v_rd_off(int d0, int ks, int half) { return d0 * 512 + ks * 8192 + half * 4096; }
template <int D0> __device__ __forceinline__ void pv_one(f32x16& od, int vb, bf16x8 pa0, bf16x8 pa1, bf16x8 pa2, bf16x8 pa3) {
#define PK(L, H) (bf16x8){L[0], L[1], L[2], L[3], H[0], H[1], H[2], H[3]}
  { const s16x4 l0 = tr_read<v_rd_off(D0, 0, 0)>(vb), h0 = tr_read<v_rd_off(D0, 0, 1)>(vb), l1 = tr_read<v_rd_off(D0, 1, 0)>(vb), h1 = tr_read<v_rd_off(D0, 1, 1)>(vb);
    asm volatile("s_waitcnt lgkmcnt(0)" ::: "memory"); SBAR();
    od = __builtin_amdgcn_mfma_f32_32x32x16_bf16(pa0, PK(l0, h0), od, 0, 0, 0);
    od = __builtin_amdgcn_mfma_f32_32x32x16_bf16(pa1, PK(l1, h1), od, 0, 0, 0); }
  SBAR();
  { const s16x4 l2 = tr_read<v_rd_off(D0, 2, 0)>(vb), h2 = tr_read<v_rd_off(D0, 2, 1)>(vb), l3 = tr_read<v_rd_off(D0, 3, 0)>(vb), h3 = tr_read<v_rd_off(D0, 3, 1)>(vb);
    asm volatile("s_waitcnt lgkmcnt(0)" ::: "memory"); SBAR();
    od = __builtin_amdgcn_mfma_f32_32x32x16_bf16(pa2, PK(l2, h2), od, 0, 0, 0);
    od = __builtin_amdgcn_mfma_f32_32x32x16_bf16(pa3, PK(l3, h3), od, 0, 0, 0); }
#undef PK
}

__device__ __forceinline__ void segment(const Frame& F, int bhm, int qb, int j0, int j1, int slot) {
  const int tid = F.tid, wid = F.wave, lane = F.lane, r32 = lane & 31, hi = lane >> 5;
  const bf16* Qg = (const bf16*)(F.ws + WS_Q) + ((size_t)bhm * SEQ + qb * 256 + wid * 32 + r32) * 128 + hi * 8;
  const bf16* Kg = (const bf16*)(F.ws + WS_KP) + (size_t)bhm * 33 * 8192;
  const bf16* Vg = (const bf16*)(F.ws + WS_VP) + (size_t)(bhm >> 1) * PADT * 256;
  LAS unsigned char* lds = F.lds;
  LAS float* wsl = (LAS float*)(lds + LDS_WS) + wid * 64;
  const float slope2 = exp2f(-2.0f * (float)(((bhm >> 1) & 3) + 1)) * LOG2E;
  unsigned ksrc0, vsrc0;
  ksrc0 = (unsigned)tid * 16u;
  { const int a8 = tid >> 8, b = (tid >> 2) & 7, k = 8 * (b >> 2) + 4 * a8 + (b & 3), c = ((tid >> 5) & 7) * 32 + (tid & 3) * 8; vsrc0 = (unsigned)(k * 256 + c) * 2u; }
#define STAGE_K(j) do { const char* kt = (const char*)(Kg + (size_t)(j) * 8192); \
    _Pragma("unroll") for (int _i = 0; _i < 2; ++_i) __builtin_amdgcn_global_load_lds((const unsigned*)(kt + (ksrc0 + _i * 8192u)), (LAS unsigned*)(lds + LDS_K + _i * 8192 + wid * 1024), 16, 0, 0); } while (0)
#define STAGE_V(buf, j) do { const char* vt = (const char*)(Vg + (size_t)(j) * 64 * 256); \
    _Pragma("unroll") for (int _i = 0; _i < 4; ++_i) __builtin_amdgcn_global_load_lds((const unsigned*)(vt + (vsrc0 + _i * 8192u)), (LAS unsigned*)(lds + LDS_V + (buf) * SHM_V + _i * 8192 + wid * 1024), 16, 0, 0); } while (0)
  const int lt = (((r32 << 1) | hi) ^ ((r32 >> 3) & 1)) << 4;
  LAS unsigned char* Qs = lds + LDS_Q + wid * 8192;
#pragma unroll
  for (int d0 = 0; d0 < 8; ++d0) { const bf16x8 qv = *(const bf16x8*)(Qg + d0 * 16); *(LAS bf16x8*)(Qs + d0 * 1024 + lt) = qv; }
  const float hioff = slope2 * (float)(4 * hi);
  f32x16 o[8];
#pragma unroll
  for (int d = 0; d < 8; ++d)
#pragma unroll
    for (int r = 0; r < 16; ++r) o[d][r] = 0.f;
  float m_reg = -1e30f, l_reg = 0.f;
  const int vb0 = (int)(uintptr_t)(lds + LDS_V) + (((lane & 3) << 3) | (((lane >> 2) & 3) << 6) | (((lane >> 4) & 1) << 5) | (((lane >> 5) & 1) << 8));
  const int qrel = wid * 32 + r32;
  STAGE_K(j0); STAGE_V(0, j0);
  VM_WAIT(); __syncthreads();
  for (int j = j0; j < j1; ++j) {
    const int cur = (j - j0) & 1;
    if (j + 1 < j1) STAGE_V(cur ^ 1, j + 1);
    SBAR();
    f32x16 p0 = {}, p1 = {};
    { const LAS unsigned char* Ks = lds + LDS_K;
#pragma unroll
      for (int d0 = 0; d0 < 8; ++d0) {
        const bf16x8 b0 = *(const LAS bf16x8*)(Ks + d0 * 2048 + lt);
        const bf16x8 b1 = *(const LAS bf16x8*)(Ks + d0 * 2048 + 1024 + lt);
        const bf16x8 qf = *(const LAS bf16x8*)(Qs + d0 * 1024 + lt);
        p0 = __builtin_amdgcn_mfma_f32_32x32x16_bf16(b0, qf, p0, 0, 0, 0);
        p1 = __builtin_amdgcn_mfma_f32_32x32x16_bf16(b1, qf, p1, 0, 0, 0); } }
    asm volatile("s_waitcnt lgkmcnt(0)" ::: "memory"); __builtin_amdgcn_s_barrier(); asm volatile("" ::: "memory");
    if (j + 1 < j1) STAGE_K(j + 1);
    SBAR();
    if (j == 0) {
#pragma unroll
      for (int r = 0; r < 16; ++r) p0[r] = -INFINITY;
#pragma unroll
      for (int r = 0; r < 8; ++r) p1[r] = -INFINITY;
    }
    const int jb = j - (4 * qb + 1);
    if (jb >= 0) {
      const int kb = 64 * jb + 4 * hi;
#pragma unroll
      for (int r = 0; r < 16; ++r) { const int kv = kb + (r & 3) + 8 * (r >> 2); if (kv > qrel) p0[r] = -INFINITY; if (kv + 32 > qrel) p1[r] = -INFINITY; }
    }
    const float off0 = slope2 * (float)(64 * j) + hioff, off1 = off0 + 32.0f * slope2;
#pragma unroll
    for (int r = 0; r < 16; ++r) { const float sb = slope2 * (float)((r & 3) + 8 * (r >> 2)); p0[r] += sb; p1[r] += sb; }
    float pm0 = p0[0], pm1 = p1[0];
#pragma unroll
    for (int r = 1; r < 16; ++r) { pm0 = fmaxf(pm0, p0[r]); pm1 = fmaxf(pm1, p1[r]); }
    float pmax = fmaxf(pm0 + off0, pm1 + off1);
    { auto rr = __builtin_amdgcn_permlane32_swap(__float_as_uint(pmax), __float_as_uint(pmax), false, false);
      pmax = fmaxf(__uint_as_float(rr[0]), __uint_as_float(rr[1])); }
    float mn, alpha;
    if (__builtin_expect(__all(pmax - m_reg <= THR2), 1)) { mn = m_reg; alpha = 1.f; }
    else { mn = fmaxf(m_reg, pmax); alpha = __builtin_amdgcn_exp2f(m_reg - mn); m_reg = mn; }
    const float c0 = off0 - mn, c1 = off1 - mn;
    float ps = 0.f;
#pragma unroll
    for (int r = 0; r < 16; ++r) { p0[r] = __builtin_amdgcn_exp2f(p0[r] + c0); p1[r] = __builtin_amdgcn_exp2f(p1[r] + c1); ps += p0[r] + p1[r]; }
    { auto rr = __builtin_amdgcn_permlane32_swap(__float_as_uint(ps), __float_as_uint(ps), false, false);
      ps = __uint_as_float(rr[0]) + __uint_as_float(rr[1]); }
    l_reg = l_reg * alpha + ps;
    if (__any(alpha < 1.f)) { if (hi == 0) wsl[r32] = alpha; asm volatile("s_waitcnt lgkmcnt(0)" ::: "memory");
#pragma unroll
      for (int rg = 0; rg < 4; ++rg) { const f32x4 al = *(const LAS f32x4*)(wsl + 8 * rg + 4 * hi);
#pragma unroll
        for (int d = 0; d < 8; ++d) { o[d][4 * rg + 0] *= al.x; o[d][4 * rg + 1] *= al.y; o[d][4 * rg + 2] *= al.z; o[d][4 * rg + 3] *= al.w; }
        SBAR(); } }
    bf16x8 pa0, pa1, pa2, pa3;
#define PK4(P, BASE, OUT) do { unsigned a0 = cvtpk(P[BASE + 0], P[BASE + 1]), a1 = cvtpk(P[BASE + 2], P[BASE + 3]);   \
    unsigned b0 = cvtpk(P[BASE + 4], P[BASE + 5]), b1 = cvtpk(P[BASE + 6], P[BASE + 7]);                              \
    auto r0 = __builtin_amdgcn_permlane32_swap(a0, b0, false, false); auto r1 = __builtin_amdgcn_permlane32_swap(a1, b1, false, false); \
    v4u w = {r0[0], r1[0], r0[1], r1[1]}; OUT = *reinterpret_cast<bf16x8*>(&w); } while (0)
    PK4(p0, 0, pa0); PK4(p0, 8, pa1); PK4(p1, 0, pa2); PK4(p1, 8, pa3);
#undef PK4
    SBAR();
    { const int vb = vb0 + cur * SHM_V;
      pv_one<0>(o[0], vb, pa0, pa1, pa2, pa3); pv_one<1>(o[1], vb, pa0, pa1, pa2, pa3); pv_one<2>(o[2], vb, pa0, pa1, pa2, pa3); pv_one<3>(o[3], vb, pa0, pa1, pa2, pa3);
      pv_one<4>(o[4], vb, pa0, pa1, pa2, pa3); pv_one<5>(o[5], vb, pa0, pa1, pa2, pa3); pv_one<6>(o[6], vb, pa0, pa1, pa2, pa3); pv_one<7>(o[7], vb, pa0, pa1, pa2, pa3); }
    VM_WAIT(); __syncthreads();
  }
  { int lane2 = threadIdx.x & 63, slot2 = slot; asm volatile("" : "+v"(lane2), "+s"(slot2));
    const int r32e = lane2 & 31, hie = lane2 >> 5;
    float* PO = (float*)(F.ws + WS_PO) + (size_t)slot2 * 256 * 256; float* ML = (float*)(F.ws + WS_ML) + (size_t)slot2 * 512;
    LAS float* wse = (LAS float*)(F.lds + LDS_WS) + wid * 64;
    if (hie == 0) { wse[r32e] = l_reg; ML[(wid * 32 + r32e) * 2] = m_reg; ML[(wid * 32 + r32e) * 2 + 1] = l_reg; }
    asm volatile("s_waitcnt lgkmcnt(0)" ::: "memory");
    char* Ob = (char*)(PO + (size_t)(wid * 32) * 256);
    const unsigned lo = (unsigned)(4 * hie * 256 + r32e) * 4u;
#pragma unroll
    for (int r = 0; r < 16; ++r) { const int rowc = (r & 3) + 8 * (r >> 2); const float lv = wse[rowc + 4 * hie]; const float rl = lv > 0.f ? __builtin_amdgcn_rcpf(lv) : 0.f;
#pragma unroll
      for (int d0 = 0; d0 < 8; ++d0) *(float*)(Ob + (lo + (unsigned)(rowc * 256 + d0 * 32) * 4u)) = o[d0][r] * rl;
      SBAR(); } }
  __syncthreads();
#undef STAGE_K
#undef STAGE_V
}

__device__ __forceinline__ void phase(const Frame& F, int ca, int NA) {
  int s0 = (int)(((long)ca * NSTEPS) / NA); const int s1 = (int)(((long)(ca + 1) * NSTEPS) / NA);
  while (s0 < s1) {
    const int bhm = s0 / STEPS_BHM, rem = s0 - bhm * STEPS_BHM;
    int qb = 0;
#pragma unroll 1
    for (int q = 1; q < 8; ++q) if (rem >= qb_start(q)) qb = q;
    const int j0 = rem - qb_start(qb), nst = 4 * qb + 5;
    const int j1 = (j0 + (s1 - s0) < nst) ? j0 + (s1 - s0) : nst;
    const int slot = bhm * 16 + qb + chunk_of(s0, NA) - chunk_of(bhm * STEPS_BHM, NA);
    segment(F, bhm, qb, j0, j1, slot);
    s0 += j1 - j0;
  }
}
#undef KSWZ
#undef SBAR
}
namespace ml {
constexpr int QST = 136, TST = 72;
constexpr int L_RQ = 0, L_RK = 17152, L_QS = 34304, L_QW = 51712, L_KS = 69120, L_KWT = 86528, L_VT = 104960, L_SP = 123392, L_G = 132608, L_CW = 134656, L_N = 139776;
constexpr int G_A = 0, G_M = 64, G_WI = 128, G_EM = 192, G_DEN = 256, G_WG = 320, G_SC = 384;
__device__ __forceinline__ float shfl_up_f(float v, int d) { return __shfl_up(v, d); }

__device__ __forceinline__ void item(const Frame& F, const Args& a, int it) {
  const int b = it >> 3, h = (it >> 1) & 3, dvh = it & 1, tid = F.tid, w = F.wave, lane = F.lane, fr = lane & 15, kq = lane >> 4;
  LAS unsigned char* lds = F.lds;
  LAS float* G = (LAS float*)(lds + L_G); LAS float* CW = (LAS float*)(lds + L_CW);
  const bf16* MQg = (const bf16*)(F.ws + WS_MQ) + (size_t)(b * 4 + h) * PADT * 128;
  const bf16* MKg = (const bf16*)(F.ws + WS_MK) + (size_t)(b * 4 + h) * PADT * 128;
  const bf16* MVg = (const bf16*)(F.ws + WS_MV) + (size_t)(b * 4 + h) * PADT * 256 + dvh * 128;
  const float* LIg = (const float*)(F.ws + WS_LI) + (b * 4 + h) * PADT; const float* LFg = (const float*)(F.ws + WS_LF) + (b * 4 + h) * PADT;
  float* HMg = (float*)(F.ws + WS_HM) + (size_t)b * SEQ * 1024 + h * 256 + dvh * 128 + 16 * w + fr;
  for (int e = tid; e < 2 * 5 * 128; e += NTHR) { const int qk = e / 640, j = (e / 128) % 5, d = e & 127; const int ch = qk * 512 + h * 128 + d;
    CW[e] = j < 4 ? a.in[IN_CW][j * 1024 + ch] : a.in[IN_CB][ch]; }
  if (tid < 96) { const int qk = tid / 48, r = (tid % 48) >> 4, ch = tid & 15; *(LAS v4u*)(lds + (qk ? L_RK : L_RQ) + r * 256 + ch * 16) = (v4u){0u, 0u, 0u, 0u}; }
  f32x4 Cacc[8];
  LAS f32x4* NL = (LAS f32x4*)(lds + L_N);
#pragma unroll
  for (int i = 0; i < 8; ++i) { Cacc[i] = (f32x4){0.f, 0.f, 0.f, 0.f}; if (w == 0) NL[i * 64 + lane] = (f32x4){0.f, 0.f, 0.f, 0.f}; }
  float m = 0.f;
  const v4u onesv = fr == 0 ? (v4u){0x3F803F80u, 0x3F803F80u, 0x3F803F80u, 0x3F803F80u} : (v4u){0u, 0u, 0u, 0u};
  const bf16x8 ones = __builtin_bit_cast(bf16x8, onesv);
  v4u pv[2]; float pli = 0.f, plf = 0.f;
#define ML_LOAD(c) do { const int pos0 = 64 * (c); \
    _Pragma("unroll") for (int i = 0; i < 2; ++i) { \
      __builtin_amdgcn_global_load_lds((const unsigned*)((const char*)(MQg + (size_t)pos0 * 128) + i * 8192 + tid * 16), (LAS unsigned*)(lds + L_RQ + 768 + i * 8192 + w * 1024), 16, 0, 0); \
      __builtin_amdgcn_global_load_lds((const unsigned*)((const char*)(MKg + (size_t)pos0 * 128) + i * 8192 + tid * 16), (LAS unsigned*)(lds + L_RK + 768 + i * 8192 + w * 1024), 16, 0, 0); \
      const int p = tid + NTHR * i, row = p >> 4, ch = p & 15; pv[i] = *(const v4u*)(MVg + (size_t)(pos0 + row) * 256 + ch * 8); } \
    if (w == 0) { pli = LIg[pos0 + lane]; plf = LFg[pos0 + lane]; } } while (0)
  ML_LOAD(0);
  VM_WAIT(); __syncthreads();
#pragma unroll 1
  for (int c = 0; c < 33; ++c) {
#pragma unroll
    for (int i = 0; i < 2; ++i) { const int p = tid + NTHR * i, row = p >> 4, ch = p & 15; const bool dead = (c == 0) && (row < MPOS0);
      const v4u z = {0u, 0u, 0u, 0u}; const v4u v4 = dead ? z : pv[i];
      if (dead) { *(LAS v4u*)(lds + L_RQ + (3 + row) * 256 + ch * 16) = z; *(LAS v4u*)(lds + L_RK + (3 + row) * 256 + ch * 16) = z; }
      LAS bf16* vt = (LAS bf16*)(lds + L_VT) + (ch * 8) * TST + row;
      vt[0 * TST] = (bf16)(v4.x & 0xffff); vt[1 * TST] = (bf16)(v4.x >> 16); vt[2 * TST] = (bf16)(v4.y & 0xffff); vt[3 * TST] = (bf16)(v4.y >> 16);
      vt[4 * TST] = (bf16)(v4.z & 0xffff); vt[5 * TST] = (bf16)(v4.z >> 16); vt[6 * TST] = (bf16)(v4.w & 0xffff); vt[7 * TST] = (bf16)(v4.w >> 16); }
    if (w == 0) {
      const bool dead = (c == 0) && (lane < MPOS0);
      const float li = dead ? -1e30f : pli, lf = dead ? 0.f : plf;
      float bs = lf;
#pragma unroll
      for (int d = 1; d < 64; d <<= 1) { const float o = shfl_up_f(bs, d); if (lane >= d) bs += o; }
      const float av = li - bs; float cm = av;
#pragma unroll
      for (int d = 1; d < 64; d <<= 1) { const float o = shfl_up_f(cm, d); if (lane >= d) cm = fmaxf(cm, o); }
      const float Mt = fmaxf(m, cm);
      const float Mend = __shfl(Mt, 63), bL = __shfl(bs, 63);
      G[G_A + lane] = av; G[G_M + lane] = Mt; G[G_WI + lane] = __expf(m - Mt); G[G_EM + lane] = __expf(-(bs + Mt)); G[G_WG + lane] = __expf(av - Mend);
      if (lane == 0) { G[G_SC + 0] = __expf(m - Mend); G[G_SC + 1] = bL + Mend; }
    }
    __syncthreads();
    { const int t = tid >> 3, d0 = (tid & 7) * 16;
      const float wi = G[G_WI + t], wg = G[G_WG + t];
#pragma unroll
      for (int qk = 0; qk < 2; ++qk) {
        float y[16];
#pragma unroll
        for (int e = 0; e < 16; ++e) y[e] = CW[(qk * 5 + 4) * 128 + d0 + e];
#pragma unroll
        for (int j = 0; j < 4; ++j) { const LAS v4u* rp = (const LAS v4u*)(lds + (qk ? L_RK : L_RQ) + (t + j) * 256 + d0 * 2); const v4u r0 = rp[0], r1 = rp[1];
          const LAS float* cw = CW + (qk * 5 + j) * 128 + d0;
          y[0] += cw[0] * bflo(r0.x); y[1] += cw[1] * bfhi(r0.x); y[2] += cw[2] * bflo(r0.y); y[3] += cw[3] * bfhi(r0.y); y[4] += cw[4] * bflo(r0.z); y[5] += cw[5] * bfhi(r0.z); y[6] += cw[6] * bflo(r0.w); y[7] += cw[7] * bfhi(r0.w);
          y[8] += cw[8] * bflo(r1.x); y[9] += cw[9] * bfhi(r1.x); y[10] += cw[10] * bflo(r1.y); y[11] += cw[11] * bfhi(r1.y); y[12] += cw[12] * bflo(r1.z); y[13] += cw[13] * bfhi(r1.z); y[14] += cw[14] * bflo(r1.w); y[15] += cw[15] * bfhi(r1.w); }
#pragma unroll
        for (int e = 0; e < 16; ++e) y[e] = y[e] / (1.0f + __expf(-y[e]));
        if (qk == 0) {
          v4u o0, o1, w0, w1;
          o0.x = pk2(y[0], y[1]); o0.y = pk2(y[2], y[3]); o0.z = pk2(y[4], y[5]); o0.w = pk2(y[6], y[7]); o1.x = pk2(y[8], y[9]); o1.y = pk2(y[10], y[11]); o1.z = pk2(y[12], y[13]); o1.w = pk2(y[14], y[15]);
          w0.x = pk2(y[0] * wi, y[1] * wi); w0.y = pk2(y[2] * wi, y[3] * wi); w0.z = pk2(y[4] * wi, y[5] * wi); w0.w = pk2(y[6] * wi, y[7] * wi);
          w1.x = pk2(y[8] * wi, y[9] * wi); w1.y = pk2(y[10] * wi, y[11] * wi); w1.z = pk2(y[12] * wi, y[13] * wi); w1.w = pk2(y[14] * wi, y[15] * wi);
          LAS v4u* qs = (LAS v4u*)(lds + L_QS + (t * QST + d0) * 2); qs[0] = o0; qs[1] = o1;
          LAS v4u* qw = (LAS v4u*)(lds + L_QW + (t * QST + d0) * 2); qw[0] = w0; qw[1] = w1;
        } else {
          const float sc = 0.08838834764831845f;
          v4u o0, o1;
          o0.x = pk2(y[0] * sc, y[1] * sc); o0.y = pk2(y[2] * sc, y[3] * sc); o0.z = pk2(y[4] * sc, y[5] * sc); o0.w = pk2(y[6] * sc, y[7] * sc);
          o1.x = pk2(y[8] * sc, y[9] * sc); o1.y = pk2(y[10] * sc, y[11] * sc); o1.z = pk2(y[12] * sc, y[13] * sc); o1.w = pk2(y[14] * sc, y[15] * sc);
          LAS v4u* ks = (LAS v4u*)(lds + L_KS + (t * QST + d0) * 2); ks[0] = o0; ks[1] = o1;
          LAS bf16* kt = (LAS bf16*)(lds + L_KWT) + d0 * TST + t; const float sw = sc * wg;
#pragma unroll
          for (int e = 0; e < 16; ++e) kt[e * TST] = (bf16)f2bf(y[e] * sw);
        }
        __builtin_amdgcn_sched_barrier(0);
      }
    }
    __syncthreads();
    { const int si = w >> 1;
      const f32x4 as = *(const LAS f32x4*)(G + G_A + 16 * si + 4 * kq);
#pragma unroll
      for (int tt = 0; tt < 2; ++tt) { const int ti = 2 * (w & 1) + tt; f32x4 acc = {0.f, 0.f, 0.f, 0.f};
#pragma unroll
        for (int ks = 0; ks < 4; ++ks) { const bf16x8 af = *(const LAS bf16x8*)(lds + L_KS + ((16 * si + fr) * QST + 32 * ks + 8 * kq) * 2);
          const bf16x8 bfr = *(const LAS bf16x8*)(lds + L_QS + ((16 * ti + fr) * QST + 32 * ks + 8 * kq) * 2);
          acc = __builtin_amdgcn_mfma_f32_16x16x32_bf16(af, bfr, acc, 0, 0, 0); }
        const int t = 16 * ti + fr, s0 = 16 * si + 4 * kq; const float Mt = G[G_M + t];
        const float v0 = (s0 + 0 <= t) ? acc.x * __expf(as.x - Mt) : 0.f, v1 = (s0 + 1 <= t) ? acc.y * __expf(as.y - Mt) : 0.f;
        const float v2 = (s0 + 2 <= t) ? acc.z * __expf(as.z - Mt) : 0.f, v3 = (s0 + 3 <= t) ? acc.w * __expf(as.w - Mt) : 0.f;
        v2u o; o.x = pk2(v0, v1); o.y = pk2(v2, v3);
        *(LAS v2u*)(lds + L_SP + (t * TST + s0) * 2) = o; } }
    if (tid < 96) { const int qk = tid / 48, r = (tid % 48) >> 4, ch = tid & 15; LAS unsigned char* base = lds + (qk ? L_RK : L_RQ);
      const v4u hv = *(const LAS v4u*)(base + (64 + r) * 256 + ch * 16); *(LAS v4u*)(base + r * 256 + ch * 16) = hv; }
    __syncthreads();
    if (c + 1 < 33) ML_LOAD(c + 1);
    f32x4 acc[4], accn[4];
#pragma unroll
    for (int ti = 0; ti < 4; ++ti) { acc[ti] = (f32x4){0.f, 0.f, 0.f, 0.f}; accn[ti] = (f32x4){0.f, 0.f, 0.f, 0.f}; }
#pragma unroll
    for (int I = 0; I < 4; ++I) {
      v4u bc; bc.x = pk2(Cacc[2 * I][0], Cacc[2 * I][1]); bc.y = pk2(Cacc[2 * I][2], Cacc[2 * I][3]); bc.z = pk2(Cacc[2 * I + 1][0], Cacc[2 * I + 1][1]); bc.w = pk2(Cacc[2 * I + 1][2], Cacc[2 * I + 1][3]);
      v4u bn = {0u, 0u, 0u, 0u}; if (w == 0) { const f32x4 n0 = NL[(2 * I) * 64 + lane], n1 = NL[(2 * I + 1) * 64 + lane]; bn.x = pk2(n0.x, n0.y); bn.y = pk2(n0.z, n0.w); bn.z = pk2(n1.x, n1.y); bn.w = pk2(n1.z, n1.w); }
#pragma unroll
      for (int ti = 0; ti < 4; ++ti) { const LAS unsigned char* qp = lds + L_QW + ((16 * ti + fr) * QST + 32 * I + 4 * kq) * 2;
        const v2u a0 = *(const LAS v2u*)qp, a1 = *(const LAS v2u*)(qp + 32); const v4u av = {a0.x, a0.y, a1.x, a1.y};
        acc[ti] = __builtin_amdgcn_mfma_f32_16x16x32_bf16(__builtin_bit_cast(bf16x8, av), __builtin_bit_cast(bf16x8, bc), acc[ti], 0, 0, 0);
        if (w == 0) accn[ti] = __builtin_amdgcn_mfma_f32_16x16x32_bf16(__builtin_bit_cast(bf16x8, av), __builtin_bit_cast(bf16x8, bn), accn[ti], 0, 0, 0); }
      __builtin_amdgcn_sched_barrier(0);
    }
    bf16x8 bv[2];
#pragma unroll
    for (int ks = 0; ks < 2; ++ks) { bv[ks] = *(const LAS bf16x8*)(lds + L_VT + ((16 * w + fr) * TST + 32 * ks + 8 * kq) * 2);
#pragma unroll
      for (int ti = 0; ti < 4; ++ti) { const bf16x8 sf = *(const LAS bf16x8*)(lds + L_SP + ((16 * ti + fr) * TST + 32 * ks + 8 * kq) * 2);
        acc[ti] = __builtin_amdgcn_mfma_f32_16x16x32_bf16(sf, bv[ks], acc[ti], 0, 0, 0);
        if (w == 0) accn[ti] = __builtin_amdgcn_mfma_f32_16x16x32_bf16(sf, ones, accn[ti], 0, 0, 0); } }
    if (w == 0 && fr == 0) {
#pragma unroll
      for (int ti = 0; ti < 4; ++ti) *(LAS f32x4*)(G + G_DEN + 16 * ti + 4 * kq) = accn[ti]; }
    { const float decay = G[G_SC + 0];
#pragma unroll
      for (int i = 0; i < 8; ++i) { Cacc[i] = Cacc[i] * decay; f32x4 nn = {0.f, 0.f, 0.f, 0.f}; if (w == 0) nn = NL[i * 64 + lane] * decay;
#pragma unroll
        for (int ks = 0; ks < 2; ++ks) { const bf16x8 kf = *(const LAS bf16x8*)(lds + L_KWT + ((16 * i + fr) * TST + 32 * ks + 8 * kq) * 2);
          Cacc[i] = __builtin_amdgcn_mfma_f32_16x16x32_bf16(kf, bv[ks], Cacc[i], 0, 0, 0);
          if (w == 0) nn = __builtin_amdgcn_mfma_f32_16x16x32_bf16(kf, ones, nn, 0, 0, 0); }
        if (w == 0) NL[i * 64 + lane] = nn;
        if (i & 1) __builtin_amdgcn_sched_barrier(0); }
      m = G[G_SC + 1]; }
    __syncthreads();
    if (c >= 1) {
#pragma unroll
      for (int ti = 0; ti < 4; ++ti) { const f32x4 dn = *(const LAS f32x4*)(G + G_DEN + 16 * ti + 4 * kq), em = *(const LAS f32x4*)(G + G_EM + 16 * ti + 4 * kq);
        float* hp = HMg + (size_t)(64 * (c - 1) + 16 * ti + 4 * kq) * 1024;
        hp[0] = acc[ti].x / fmaxf(fabsf(dn.x), em.x); hp[1024] = acc[ti].y / fmaxf(fabsf(dn.y), em.y); hp[2048] = acc[ti].z / fmaxf(fabsf(dn.z), em.z); hp[3072] = acc[ti].w / fmaxf(fabsf(dn.w), em.w); }
    }
    VM_WAIT(); __syncthreads();
  }
#undef ML_LOAD
}
}
__device__ __forceinline__ void p3_combine(const Frame& F, const Args& a, int NA) {
  const float* PO = (const float*)(F.ws + WS_PO); const float* ML = (const float*)(F.ws + WS_ML); const float* HM = (const float*)(F.ws + WS_HM);
  const bf16* MO = (const bf16*)(F.ws + WS_MO); bf16* A2 = (bf16*)(F.ws + WS_A2);
  const float lam = *(const float*)(F.ws + WS_LAM);
  const float* subg = a.in[IN_SUBG]; const float* og = a.in[IN_OUTG];
  const int gw = blockIdx.x * NWAVES + F.wave, NGW = gridDim.x * NWAVES, lane = F.lane;
  const f32x4 sg = ((const f32x4*)subg)[lane];
  for (int R = gw; R < MROWS; R += NGW) {
    const int b = R >> 11, t = R & 2047, qb = t >> 8, rq = t & 255;
#pragma unroll 1
    for (int h = 0; h < 4; ++h) {
      f32x4 om[2];
#pragma unroll
      for (int m = 0; m < 2; ++m) {
        const int bhm = (b * 4 + h) * 2 + m, first = bhm * att::STEPS_BHM + att::qb_start(qb), last = first + 4 * qb + 4;
        const int cf = att::chunk_of(first, NA), np = att::chunk_of(last, NA) - cf + 1, slot0 = bhm * 16 + qb + cf - att::chunk_of(bhm * att::STEPS_BHM, NA);
        float mp[3], lp[3]; f32x4 op[3];
#pragma unroll
        for (int p = 0; p < 3; ++p) { if (p < np) { const int slot = slot0 + p; mp[p] = ML[(size_t)slot * 512 + rq * 2]; lp[p] = ML[(size_t)slot * 512 + rq * 2 + 1];
            op[p] = ((const f32x4*)(PO + ((size_t)slot * 256 + rq) * 256))[lane]; } else { mp[p] = -1e30f; lp[p] = 0.f; op[p] = (f32x4){0.f, 0.f, 0.f, 0.f}; } }
        const float M = fmaxf(mp[0], fmaxf(mp[1], mp[2]));
        float wsum = 0.f; f32x4 acc = (f32x4){0.f, 0.f, 0.f, 0.f};
#pragma unroll
        for (int p = 0; p < 3; ++p) { const float w = lp[p] * exp2f(mp[p] - M); wsum += w; acc += op[p] * w; }
        om[m] = acc * (1.0f / wsum);
      }
      const f32x4 o = om[0] - om[1] * lam;
      const float rs = rsqrtf(wave_sum((o.x * o.x + o.y * o.y) + (o.z * o.z + o.w * o.w)) * (1.0f / 256.f) + EPS) * 0.8f;
      v2u w; w.x = pk2(o.x * rs * sg.x, o.y * rs * sg.y); w.y = pk2(o.z * rs * sg.z, o.w * rs * sg.w);
      ((v2u*)(A2 + (size_t)R * DM + h * 256))[lane] = w;
      const f32x4 hv = ((const f32x4*)(HM + (size_t)R * 1024 + h * 256))[lane];
      const float rh = rsqrtf(wave_sum((hv.x * hv.x + hv.y * hv.y) + (hv.z * hv.z + hv.w * hv.w)) * (1.0f / 256.f) + EPS);
      const f32x4 g = ((const f32x4*)(og + h * 256))[lane];
      const v2u mo = ((const v2u*)(MO + (size_t)R * 1024 + h * 256))[lane];
      v2u w2; w2.x = pk2(hv.x * rh * g.x * bflo(mo.x), hv.y * rh * g.y * bfhi(mo.x)); w2.y = pk2(hv.z * rh * g.z * bflo(mo.y), hv.w * rh * g.w * bfhi(mo.y));
      ((v2u*)(A2 + (size_t)R * DM + 1024 + h * 256))[lane] = w2;
    }
  }
}
struct EpiRes {
  static constexpr bool PERM = true, AFTER_DRAIN = false;
  const float* x; float* out; bf16* H1b; float* SSQ;
  __device__ __forceinline__ void operator()(const pg8::f32x4 (&acc)[2][2][4][2], const pg8::Unit& u, int wr, int wc, int fr, int fq) const {
    const int row0 = u.pm * 256 + wr * 64 + fr, col0 = u.pn * 256 + wc * 32 + 8 * fq;
#pragma unroll
    for (int ai = 0; ai < 2; ++ai)
#pragma unroll
      for (int m = 0; m < 4; ++m) { const size_t R = (size_t)(row0 + ai * 128 + m * 16); float s = 0.f;
#pragma unroll
        for (int bj = 0; bj < 2; ++bj) { const size_t off = R * DM + col0 + bj * 128;
          const f32x4 x0 = *(const f32x4*)(x + off), x1 = *(const f32x4*)(x + off + 4);
          const f32x4 v0 = acc[ai][bj][m][0] + x0, v1 = acc[ai][bj][m][1] + x1;
          *(f32x4*)(out + off) = v0; *(f32x4*)(out + off + 4) = v1;
          v4u w; w.x = pk2(v0.x, v0.y); w.y = pk2(v0.z, v0.w); w.z = pk2(v1.x, v1.y); w.w = pk2(v1.z, v1.w);
          *(v4u*)(H1b + off) = w;
          s += (v0.x * v0.x + v0.y * v0.y) + (v0.z * v0.z + v0.w * v0.w) + (v1.x * v1.x + v1.y * v1.y) + (v1.z * v1.z + v1.w * v1.w); }
        s += __shfl_xor(s, 16); s += __shfl_xor(s, 32);
        if (fq == 0) SSQ[R * 32 + u.pn * 4 + wc] = s; }
  }
};
typedef __bf16 bfv2 __attribute__((ext_vector_type(2)));
__device__ __forceinline__ void split_hl(const f32x4 a, const f32x4 b, bf16x8& hi, bf16x8& lo) {
  float v[8] = {a.x, a.y, a.z, a.w, b.x, b.y, b.z, b.w}; unsigned h[8], l[8];
#pragma unroll
  for (int i = 0; i < 8; ++i) { h[i] = f2bf(v[i]); l[i] = f2bf(v[i] - __builtin_bit_cast(float, h[i] << 16)); }
  v4u hv = {h[0] | (h[1] << 16), h[2] | (h[3] << 16), h[4] | (h[5] << 16), h[6] | (h[7] << 16)};
  v4u lv = {l[0] | (l[1] << 16), l[2] | (l[3] << 16), l[4] | (l[5] << 16), l[6] | (l[7] << 16)};
  hi = __builtin_bit_cast(bf16x8, hv); lo = __builtin_bit_cast(bf16x8, lv);
}
__device__ __forceinline__ void p0_w3t(const Frame& F, const Args& a) {
  const float* wq = a.in[IN_WQ]; const float* sk = a.in[IN_SUBK]; const float* g2 = a.in[IN_G2];
  bf16* W3t = (bf16*)(F.ws + WS_W3T);
  const int gw = blockIdx.x * NWAVES + F.wave, NGW = gridDim.x * NWAVES, lane = F.lane, fr = lane & 15, fq = lane >> 4;
  for (int task = gw; task < 128 * 16; task += NGW) {
    const int kt = task >> 4, hh = task & 15;
    bf16x8 ahi[4], alo[4];
    const float* ap = wq + (size_t)(kt * 16 + fr) * DM + hh * 128 + fq * 8;
#pragma unroll
    for (int s = 0; s < 4; ++s) split_hl(*(const f32x4*)(ap + 32 * s), *(const f32x4*)(ap + 32 * s + 4), ahi[s], alo[s]);
    const f32x4 gk = *(const f32x4*)(g2 + kt * 16 + fq * 4);
#pragma unroll 1
    for (int t2 = 0; t2 < 8; ++t2) {
      const float* bp = sk + (size_t)(hh * 128 + t2 * 16 + fr) * 128 + fq * 8;
      f32x4 acc = {0.f, 0.f, 0.f, 0.f};
#pragma unroll
      for (int s = 0; s < 4; ++s) { bf16x8 bhi, blo; split_hl(*(const f32x4*)(bp + 32 * s), *(const f32x4*)(bp + 32 * s + 4), bhi, blo);
        acc = __builtin_amdgcn_mfma_f32_16x16x32_bf16(ahi[s], bhi, acc, 0, 0, 0);
        acc = __builtin_amdgcn_mfma_f32_16x16x32_bf16(ahi[s], blo, acc, 0, 0, 0);
        acc = __builtin_amdgcn_mfma_f32_16x16x32_bf16(alo[s], bhi, acc, 0, 0, 0); }
      v2u o; o.x = pk2(acc.x * gk.x, acc.y * gk.y); o.y = pk2(acc.z * gk.z, acc.w * gk.w);
      *(v2u*)(W3t + (size_t)(hh * 128 + t2 * 16 + fr) * DM + kt * 16 + fq * 4) = o;
    }
  }
}
__device__ __forceinline__ void p0_tables(const Frame& F, const Args& a) {
  const float* U = a.in[IN_U]; const float* V = a.in[IN_V]; const float* g2 = a.in[IN_G2];
  bf16* Ub = (bf16*)(F.ws + WS_UB); bf16* Vb = (bf16*)(F.ws + WS_VB);
  const size_t n8 = (size_t)16384 * DM / 8, stride = (size_t)gridDim.x * NTHR;
  for (size_t i = (size_t)blockIdx.x * NTHR + F.tid; i < n8; i += stride) {
    const int k8 = (int)(i & 255) * 8;
    const f32x4 g0 = *(const f32x4*)(g2 + k8), g1 = *(const f32x4*)(g2 + k8 + 4);
    const f32x4 u0 = *(const f32x4*)(U + i * 8), u1 = *(const f32x4*)(U + i * 8 + 4);
    const f32x4 v0 = *(const f32x4*)(V + i * 8), v1 = *(const f32x4*)(V + i * 8 + 4);
    v4u ou, ov;
    ou.x = pk2(u0.x * g0.x, u0.y * g0.y); ou.y = pk2(u0.z * g0.z, u0.w * g0.w); ou.z = pk2(u1.x * g1.x, u1.y * g1.y); ou.w = pk2(u1.z * g1.z, u1.w * g1.w);
    ov.x = pk2(v0.x, v0.y); ov.y = pk2(v0.z, v0.w); ov.z = pk2(v1.x, v1.y); ov.w = pk2(v1.z, v1.w);
    *(v4u*)(Ub + i * 8) = ou; *(v4u*)(Vb + i * 8) = ov;
  }
}
struct EpiScore {
  static constexpr bool PERM = true, AFTER_DRAIN = false;
  float* S; const LAS float* rs;
  __device__ __forceinline__ void operator()(const pg8::f32x4 (&acc)[2][2][4][2], const pg8::Unit& u, int wr, int wc, int fr, int fq) const {
    const int rl0 = wr * 64 + fr, col0 = u.pn * 256 + wc * 32 + 8 * fq;
#pragma unroll
    for (int ai = 0; ai < 2; ++ai)
#pragma unroll
      for (int m = 0; m < 4; ++m) { const int rl = rl0 + ai * 128 + m * 16; const float r = rs[rl]; const size_t R = (size_t)u.pm * 256 + rl;
#pragma unroll
        for (int bj = 0; bj < 2; ++bj) { float* d = S + R * DM + col0 + bj * 128;
          *(f32x4*)d = acc[ai][bj][m][0] * r; *(f32x4*)(d + 4) = acc[ai][bj][m][1] * r; } }
  }
};

__device__ __forceinline__ unsigned fkey(float f) { const unsigned b = __builtin_bit_cast(unsigned, f); return b ^ ((b >> 31) ? 0xFFFFFFFFu : 0x80000000u); }
template <int NV, int K> __device__ __forceinline__ void wave_topk(const unsigned (&u)[NV], bool (&sel)[NV], int lane) {
  unsigned prefix = 0u; int cge = NV * 64;
#pragma unroll 1
  for (int bit = 31; bit >= 0 && cge != K; --bit) {
    const unsigned cand = prefix | (1u << bit); int c = 0;
#pragma unroll
    for (int i = 0; i < NV; ++i) c += __builtin_popcountll(__ballot(u[i] >= cand));
    if (c >= K) { prefix = cand; cge = c; }
  }
  int cgt = 0;
#pragma unroll
  for (int i = 0; i < NV; ++i) cgt += __builtin_popcountll(__ballot(u[i] > prefix));
  int need = K - cgt;
  const unsigned long long lm = (1ull << lane) - 1ull;
#pragma unroll
  for (int i = 0; i < NV; ++i) { const unsigned long long eq = __ballot(u[i] == prefix); const int before = __builtin_popcountll(eq & lm);
    sel[i] = (u[i] > prefix) || (u[i] == prefix && before < need); const int ne = __builtin_popcountll(eq); need = need > ne ? need - ne : 0; }
}
__device__ __forceinline__ float gelu_erf(float x) { return 0.5f * x * (1.0f + erff(x * 0.70710678118654752f)); }

__device__ __forceinline__ void p6_peer(const Frame& F, const Args& a) {
  const float* S = (const float*)(F.ws + WS_S); const float* SSQ = (const float*)(F.ws + WS_SSQ); const bf16* H1b = (const bf16*)(F.ws + WS_H1B);
  const bf16* Ub = (const bf16*)(F.ws + WS_UB); const bf16* Vb = (const bf16*)(F.ws + WS_VB); float* out = a.out;
  const int lane = F.lane, gw = blockIdx.x * NWAVES + F.wave, NGW = gridDim.x * NWAVES;
  LAS float* wl = (LAS float*)(F.lds + F.wave * 2048);
  LAS int* wli = (LAS int*)wl;
  for (int tok = gw; tok < MROWS; tok += NGW) {
    const float rs = rsqrtf(wave_sum(lane < 32 ? SSQ[(size_t)tok * 32 + lane] : 0.f) * (1.0f / DM) + EPS);
    const float* srow = S + (size_t)tok * DM;
#ifdef PEER_IDS_FROM_GLOBAL
    { const int* gi = (const int*)(F.ws + (size_t)372 * MiB) + (size_t)tok * 128; const float* gg = (const float*)(F.ws + (size_t)376 * MiB) + (size_t)tok * 128;
      wli[128 + lane] = gi[lane]; wli[128 + 64 + lane] = gi[64 + lane]; wl[256 + lane] = gg[lane]; wl[256 + 64 + lane] = gg[64 + lane];
      asm volatile("s_waitcnt lgkmcnt(0)" ::: "memory"); }
#pragma unroll 1
    for (int h8 = 0; h8 < 0; ++h8) {
#else
#pragma unroll 1
    for (int h8 = 0; h8 < 8; ++h8) {
#endif
#pragma unroll
      for (int p = 0; p < 2; ++p) {
        const float2 sv = *(const float2*)(srow + (h8 * 2 + p) * 128 + 2 * lane);
        unsigned u[2] = {fkey(sv.x), fkey(sv.y)}; bool sel[2];
        wave_topk<2, 16>(u, sel, lane);
        const unsigned long long m0 = __ballot(sel[0]), m1 = __ballot(sel[1]); const unsigned long long lm = (1ull << lane) - 1ull;
        const int pos0 = __builtin_popcountll(m0 & lm), pos1 = __builtin_popcountll(m0) + __builtin_popcountll(m1 & lm);
        if (sel[0]) { wl[p * 16 + pos0] = sv.x; wli[64 + p * 16 + pos0] = 2 * lane; }
        if (sel[1]) { wl[p * 16 + pos1] = sv.y; wli[64 + p * 16 + pos1] = 2 * lane + 1; }
      }
      asm volatile("s_waitcnt lgkmcnt(0)" ::: "memory");
      const int ci = lane >> 2, cj = 4 * (lane & 3);
      const float s0 = wl[ci]; const f32x4 s1 = *(const LAS f32x4*)(wl + 16 + cj);
      float cv[4] = {s0 + s1.x, s0 + s1.y, s0 + s1.z, s0 + s1.w};
      unsigned cu[4] = {fkey(cv[0]), fkey(cv[1]), fkey(cv[2]), fkey(cv[3])}; bool csel[4];
      wave_topk<4, 16>(cu, csel, lane);
      float mx = -INFINITY;
#pragma unroll
      for (int q = 0; q < 4; ++q) if (csel[q]) mx = fmaxf(mx, cv[q]);
#pragma unroll
      for (int o = 1; o < 64; o <<= 1) mx = fmaxf(mx, __shfl_xor(mx, o));
      float ev[4], es = 0.f;
#pragma unroll
      for (int q = 0; q < 4; ++q) { ev[q] = csel[q] ? __expf(cv[q] - mx) : 0.f; es += ev[q]; }
      es = wave_sum(es); const float inv = 1.0f / es;
      const int ki = wli[64 + ci]; typedef int i32x4 __attribute__((ext_vector_type(4))); const i32x4 kj = *(const LAS i32x4*)(wli + 64 + 16 + cj);
      const int kjv[4] = {kj.x, kj.y, kj.z, kj.w};
      int base = 0; const unsigned long long lm = (1ull << lane) - 1ull;
#pragma unroll
      for (int q = 0; q < 4; ++q) { const unsigned long long mq = __ballot(csel[q]); const int pos = base + __builtin_popcountll(mq & lm);
        if (csel[q]) { wli[128 + h8 * 16 + pos] = ki * 128 + kjv[q]; wl[256 + h8 * 16 + pos] = ev[q] * inv; } base += __builtin_popcountll(mq); }
      asm volatile("s_waitcnt lgkmcnt(0)" ::: "memory");
    }
    v4u xr[4];
#pragma unroll
    for (int i = 0; i < 4; ++i) xr[i] = ((const v4u*)(H1b + (size_t)tok * DM))[i * 64 + lane];
    float y[32];
#pragma unroll
    for (int i = 0; i < 32; ++i) y[i] = 0.f;
#pragma unroll 1
    for (int e0 = 0; e0 < 128; e0 += 2) {
      const int id0 = __builtin_amdgcn_readfirstlane(wli[128 + e0]), id1 = __builtin_amdgcn_readfirstlane(wli[128 + e0 + 1]);
      const float g0 = wl[256 + e0], g1 = wl[256 + e0 + 1];
      v4u ur0[4], ur1[4], vr0[4], vr1[4];
#pragma unroll
      for (int i = 0; i < 4; ++i) { ur0[i] = ((const v4u*)(Ub + (size_t)id0 * DM))[i * 64 + lane]; ur1[i] = ((const v4u*)(Ub + (size_t)id1 * DM))[i * 64 + lane]; }
#pragma unroll
      for (int i = 0; i < 4; ++i) { vr0[i] = ((const v4u*)(Vb + (size_t)id0 * DM))[i * 64 + lane]; vr1[i] = ((const v4u*)(Vb + (size_t)id1 * DM))[i * 64 + lane]; }
      float d0 = 0.f, d1 = 0.f;
#pragma unroll
      for (int i = 0; i < 4; ++i)
#pragma unroll
        for (int c = 0; c < 4; ++c) { const unsigned xa = xr[i][c], ua = ur0[i][c], ub = ur1[i][c];
          d0 = __builtin_amdgcn_fdot2_f32_bf16(__builtin_bit_cast(bfv2, xa), __builtin_bit_cast(bfv2, ua), d0, false);
          d1 = __builtin_amdgcn_fdot2_f32_bf16(__builtin_bit_cast(bfv2, xa), __builtin_bit_cast(bfv2, ub), d1, false); }
      d0 = wave_sum(d0); d1 = wave_sum(d1);
      const float a0 = gelu_erf(d0 * rs) * g0, a1 = gelu_erf(d1 * rs) * g1;
#pragma unroll
      for (int i = 0; i < 4; ++i)
#pragma unroll
        for (int c = 0; c < 4; ++c) { y[i * 8 + 2 * c] += a0 * bflo(vr0[i][c]) + a1 * bflo(vr1[i][c]); y[i * 8 + 2 * c + 1] += a0 * bfhi(vr0[i][c]) + a1 * bfhi(vr1[i][c]); }
    }
    float* orow = out + (size_t)tok * DM;
#pragma unroll
    for (int i = 0; i < 4; ++i) { f32x4* p = (f32x4*)(orow + (size_t)(i * 64 + lane) * 8);
      f32x4 h0 = p[0], h1 = p[1];
      h0.x += y[i * 8 + 0]; h0.y += y[i * 8 + 1]; h0.z += y[i * 8 + 2]; h0.w += y[i * 8 + 3]; h1.x += y[i * 8 + 4]; h1.y += y[i * 8 + 5]; h1.z += y[i * 8 + 6]; h1.w += y[i * 8 + 7];
      p[0] = h0; p[1] = h1; }
  }
}
__global__ void __launch_bounds__(NTHR, 2) mk_fwd(Args args) {
  extern __shared__ __attribute__((aligned(16))) unsigned char lds_raw[];
  Frame F; F.lds = (LAS unsigned char*)lds_raw; F.ws = args.ws; F.tid = threadIdx.x; F.lane = F.tid & 63; F.wave = __builtin_amdgcn_readfirstlane(F.tid >> 6);
  const int lo = args.ph_lo, hi = args.ph_hi;
#define IN(k) (lo <= (k) && (k) < hi)
  if (IN(0)) {
    p0_lam(F, args);
    p0_zero_vpad(F);
    p0_metaproj(F, args);
    p0_rows(F, args);
    p0_transpose(F, args.in[IN_WIN], DPROJ, NPROJ, (bf16*)(F.ws + WS_W1T));
    p0_transpose(F, args.in[IN_WOUT], DM, DM, (bf16*)(F.ws + WS_W2T));
    p0_w3t(F, args);
    p0_tables(F, args);
  }
  if (IN(1)) {
    p1_meta_finalize(F, args);
    pg8::Gemm g{(const pg8::bf16_t*)(F.ws + WS_XN), (const pg8::bf16_t*)(F.ws + WS_W1T), MROWS, NPROJ, DM};
    pg8::StaticOrder S; S.init(MROWS, NPROJ, (int)gridDim.x, (int)blockIdx.x);
    EpiProj E{(bf16*)(F.ws + WS_Q), (bf16*)(F.ws + WS_KP), (bf16*)(F.ws + WS_VP), (bf16*)(F.ws + WS_MQ), (bf16*)(F.ws + WS_MK), (bf16*)(F.ws + WS_MV), (bf16*)(F.ws + WS_MO),
              args.in[IN_QNG], args.in[IN_KNG], (LAS float*)(F.lds + XCH_OFF)};
    pg8::gemm_phase<EpiProj, pg8::StaticOrder, true, true>(F.lds + RING_OFF, g, S, E);
  }
  if (IN(2)) {
    att::phase(F, (int)blockIdx.x, (int)gridDim.x);
  }
  if (IN(7)) {
    if (blockIdx.x < 32) ml::item(F, args, (int)blockIdx.x);
  }
  if (IN(3)) {
    p3_combine(F, args, args.na);
  }
  if (IN(4)) {
    pg8::Gemm g{(const pg8::bf16_t*)(F.ws + WS_A2), (const pg8::bf16_t*)(F.ws + WS_W2T), MROWS, DM, DM};
    pg8::StaticOrder S; S.init(MROWS, DM, (int)gridDim.x, (int)blockIdx.x);
    EpiRes E{args.in[IN_X], args.out, (bf16*)(F.ws + WS_H1B), (float*)(F.ws + WS_SSQ)};
    pg8::gemm_phase<EpiRes, pg8::StaticOrder, true, true>(F.lds + RING_OFF, g, S, E);
  }
  if (IN(5)) {
    pg8::Gemm g{(const pg8::bf16_t*)(F.ws + WS_H1B), (const pg8::bf16_t*)(F.ws + WS_W3T), MROWS, DM, DM};
    pg8::StaticOrder S; S.init(MROWS, DM, (int)gridDim.x, (int)blockIdx.x);
    LAS float* rst = (LAS float*)(F.lds + XCH_OFF);
    { pg8::Unit u0; if (S.next(0, u0)) { if (F.tid < 256) { const float* sp = (const float*)(F.ws + WS_SSQ) + ((size_t)u0.pm * 256 + F.tid) * 32; float s = 0.f;
#pragma unroll
          for (int i = 0; i < 8; ++i) { const f32x4 v = ((const f32x4*)sp)[i]; s += (v.x + v.y) + (v.z + v.w); }
          rst[F.tid] = rsqrtf(s * (1.0f / DM) + EPS); } } }
    __syncthreads();
    EpiScore E{(float*)(F.ws + WS_S), rst};
    pg8::gemm_phase<EpiScore, pg8::StaticOrder, true, true>(F.lds + RING_OFF, g, S, E);
  }
  if (IN(6)) {
    p6_peer(F, args);
  }
#undef IN
}
namespace nv {
constexpr int TT = 2064;

__device__ __forceinline__ float block_sum(float v, float* red) {
  for (int o = 32; o > 0; o >>= 1) v += __shfl_xor(v, o);
  __syncthreads();
  if ((threadIdx.x & 63) == 0) red[threadIdx.x >> 6] = v;
  __syncthreads();
  return red[0] + red[1] + red[2] + red[3];
}
__device__ __forceinline__ float block_max(float v, float* red) {
  for (int o = 32; o > 0; o >>= 1) v = fmaxf(v, __shfl_xor(v, o));
  __syncthreads();
  if ((threadIdx.x & 63) == 0) red[threadIdx.x >> 6] = v;
  __syncthreads();
  return fmaxf(fmaxf(red[0], red[1]), fmaxf(red[2], red[3]));
}

__global__ __launch_bounds__(256) void k_norm(const float* __restrict__ h, const float* __restrict__ g, float* __restrict__ xn) {
  __shared__ float red[4];
  const int r = blockIdx.x, tid = threadIdx.x;
  float v[8]; float ss = 0.f;
#pragma unroll
  for (int i = 0; i < 8; ++i) { v[i] = h[(size_t)r * DM + tid + 256 * i]; ss += v[i] * v[i]; }
  ss = block_sum(ss, red);
  const float rs = rsqrtf(ss * (1.0f / DM) + EPS);
#pragma unroll
  for (int i = 0; i < 8; ++i) { const int c = tid + 256 * i; xn[(size_t)r * DM + c] = v[i] * rs * g[c]; }
}

__global__ __launch_bounds__(256) void k_gemm(const float* __restrict__ A, int lda, const float* __restrict__ B, int ldb,
                                               float* C, int ldc, const float* R, int ldr, int M, int N, int K) {
  __shared__ __attribute__((aligned(16))) unsigned short As[128][40];
  __shared__ __attribute__((aligned(16))) unsigned short Bs[128][40];
  const int tid = threadIdx.x, wid = tid >> 6, lane = tid & 63, wr = wid >> 1, wc = wid & 1, fr = lane & 15, fq = lane >> 4;
  const int m0 = blockIdx.y * 128, n0 = blockIdx.x * 128;
  f32x4 acc[4][4];
#pragma unroll
  for (int i = 0; i < 4; ++i)
#pragma unroll
    for (int j = 0; j < 4; ++j) acc[i][j] = (f32x4){0.f, 0.f, 0.f, 0.f};
  const int arow = tid >> 1, akk = (tid & 1) * 16;
  const int bk = tid >> 3, bn0 = (tid & 7) * 16;
  for (int k0 = 0; k0 < K; k0 += 32) {
    {
      float4 a[4];
      const bool ok = (m0 + arow) < M;
#pragma unroll
      for (int i = 0; i < 4; ++i) a[i] = ok ? *(const float4*)(A + (size_t)(m0 + arow) * lda + k0 + akk + 4 * i) : make_float4(0.f, 0.f, 0.f, 0.f);
#pragma unroll
      for (int i = 0; i < 4; ++i) { As[arow][akk + 4 * i + 0] = (unsigned short)f2bf(a[i].x); As[arow][akk + 4 * i + 1] = (unsigned short)f2bf(a[i].y); As[arow][akk + 4 * i + 2] = (unsigned short)f2bf(a[i].z); As[arow][akk + 4 * i + 3] = (unsigned short)f2bf(a[i].w); }
      float4 bv[4];
#pragma unroll
      for (int i = 0; i < 4; ++i) { const int n = n0 + bn0 + 4 * i; bv[i] = (n < N) ? *(const float4*)(B + (size_t)(k0 + bk) * ldb + n) : make_float4(0.f, 0.f, 0.f, 0.f); }
#pragma unroll
      for (int i = 0; i < 4; ++i) { Bs[bn0 + 4 * i + 0][bk] = (unsigned short)f2bf(bv[i].x); Bs[bn0 + 4 * i + 1][bk] = (unsigned short)f2bf(bv[i].y); Bs[bn0 + 4 * i + 2][bk] = (unsigned short)f2bf(bv[i].z); Bs[bn0 + 4 * i + 3][bk] = (unsigned short)f2bf(bv[i].w); }
    }
    __syncthreads();
    bf16x8 af[4], bfr[4];
#pragma unroll
    for (int i = 0; i < 4; ++i) af[i] = *(const bf16x8*)&As[wr * 64 + i * 16 + fr][fq * 8];
#pragma unroll
    for (int j = 0; j < 4; ++j) bfr[j] = *(const bf16x8*)&Bs[wc * 64 + j * 16 + fr][fq * 8];
#pragma unroll
    for (int i = 0; i < 4; ++i)
#pragma unroll
      for (int j = 0; j < 4; ++j) acc[i][j] = __builtin_amdgcn_mfma_f32_16x16x32_bf16(af[i], bfr[j], acc[i][j], 0, 0, 0);
    __syncthreads();
  }
#pragma unroll
  for (int i = 0; i < 4; ++i)
#pragma unroll
    for (int j = 0; j < 4; ++j)
#pragma unroll
      for (int e = 0; e < 4; ++e) {
        const int row = m0 + wr * 64 + i * 16 + fq * 4 + e, col = n0 + wc * 64 + j * 16 + fr;
        if (row < M && col < N) { float v = acc[i][j][e]; if (R) v += R[(size_t)row * ldr + col]; C[(size_t)row * ldc + col] = v; }
      }
}

__global__ __launch_bounds__(256) void k_route(const float* __restrict__ pq, const float* __restrict__ subkeys, int* __restrict__ oidx, float* __restrict__ og) {
  __shared__ __attribute__((aligned(16))) float qv[2048];
  __shared__ float s[2][128];
  __shared__ float sv[2][16]; __shared__ int si[2][16];
  __shared__ float cand[256]; __shared__ int cidx[256];
  __shared__ float tv[16]; __shared__ int ti[16];
  const size_t r = blockIdx.x; const int tid = threadIdx.x, lane = tid & 63, wid = tid >> 6;
  for (int i = tid; i < 2048; i += 256) qv[i] = pq[r * 2048 + i];
  __syncthreads();
  for (int hh = 0; hh < 8; ++hh) {
    { const int p = tid >> 7, k = tid & 127;
      const float4* sk = (const float4*)(subkeys + ((size_t)((hh * 2 + p) * 128 + k)) * 128);
      const float4* qq = (const float4*)(qv + hh * 256 + p * 128);
      float d = 0.f;
#pragma unroll 8
      for (int c = 0; c < 32; ++c) { const float4 a = sk[c], q4 = qq[c]; d += a.x * q4.x + a.y * q4.y + a.z * q4.z + a.w * q4.w; }
      s[p][k] = d; }
    __syncthreads();
    if (wid < 2) {
      const int p = wid; float v0 = s[p][lane], v1 = s[p][lane + 64];
      for (int it = 0; it < 16; ++it) {
        float bv = v0; int bi = lane; if (v1 > bv) { bv = v1; bi = lane + 64; }
        for (int o = 32; o > 0; o >>= 1) { const float ov = __shfl_xor(bv, o); const int oi = __shfl_xor(bi, o); if (ov > bv || (ov == bv && oi < bi)) { bv = ov; bi = oi; } }
        if (lane == 0) { sv[p][it] = bv; si[p][it] = bi; }
        if (bi == lane) v0 = -INFINITY; if (bi == lane + 64) v1 = -INFINITY;
      }
    }
    __syncthreads();
    { const int i = tid >> 4, j = tid & 15; cand[tid] = sv[0][i] + sv[1][j]; cidx[tid] = si[0][i] * 128 + si[1][j]; }
    __syncthreads();
    if (wid == 0) {
      float v[4]; for (int q = 0; q < 4; ++q) v[q] = cand[lane + 64 * q];
      for (int it = 0; it < 16; ++it) {
        float bv = v[0]; int bi = lane;
        for (int q = 1; q < 4; ++q) if (v[q] > bv) { bv = v[q]; bi = lane + 64 * q; }
        for (int o = 32; o > 0; o >>= 1) { const float ov = __shfl_xor(bv, o); const int oi = __shfl_xor(bi, o); if (ov > bv || (ov == bv && oi < bi)) { bv = ov; bi = oi; } }
        if (lane == 0) { tv[it] = bv; ti[it] = cidx[bi]; }
        for (int q = 0; q < 4; ++q) if (bi == lane + 64 * q) v[q] = -INFINITY;
      }
      const float mx = tv[0];
      float e = lane < 16 ? expf(tv[lane] - mx) : 0.f; float sm = e;
      for (int o = 32; o > 0; o >>= 1) sm += __shfl_xor(sm, o);
      if (lane < 16) { oidx[r * 128 + hh * 16 + lane] = ti[lane]; og[r * 128 + hh * 16 + lane] = e / sm; }
    }
    __syncthreads();
  }
}

__global__ __launch_bounds__(256) void k_attn2(const bf16* __restrict__ Qb, const bf16* __restrict__ Kp, const bf16* __restrict__ Vp,
                                                const float* __restrict__ lamp, const float* __restrict__ subg, float* __restrict__ ao) {
  __shared__ float sc[2][TT];
  __shared__ float qs[256];
  __shared__ float red[4];
  const int t = blockIdx.x, h = blockIdx.y, b = blockIdx.z, tid = threadIdx.x;
  const int cnt = t + 17;
  const float slope2 = exp2f(-2.0f * (h + 1)) * LOG2E;
  qs[tid] = bf2f(Qb[((size_t)((b * 4 + h) * 2 + (tid >> 7)) * SEQ + t) * 128 + (tid & 127)]);
  __syncthreads();
  float stat_l[2];
  for (int m = 0; m < 2; ++m) {
    float mx = -INFINITY;
    for (int s = tid; s < cnt; s += 256) {
      float d = 0.f;
#pragma unroll 4
      for (int i = 0; i < 16; ++i) { const v4u kk = *(const v4u*)(Kp + kp_off((b * 4 + h) * 2 + m, MPOS0 + s, i * 8)); const float* q = qs + m * 128 + i * 8;
        d += bflo(kk.x) * q[0] + bfhi(kk.x) * q[1] + bflo(kk.y) * q[2] + bfhi(kk.y) * q[3] + bflo(kk.z) * q[4] + bfhi(kk.z) * q[5] + bflo(kk.w) * q[6] + bfhi(kk.w) * q[7]; }
      d -= slope2 * (float)(cnt - 1 - s);
      sc[m][s] = d; mx = fmaxf(mx, d);
    }
    mx = block_max(mx, red);
    float sm = 0.f;
    for (int s = tid; s < cnt; s += 256) { const float e = exp2f(sc[m][s] - mx); sc[m][s] = e; sm += e; }
    sm = block_sum(sm, red);
    stat_l[m] = sm;
  }
  const float lam = lamp[0];
  const float i0 = 1.0f / stat_l[0], i1 = lam / stat_l[1];
  __syncthreads();
  for (int s = tid; s < cnt; s += 256) sc[0][s] = sc[0][s] * i0 - sc[1][s] * i1;
  __syncthreads();
  float o = 0.f;
  const bf16* vp = Vp + ((size_t)(b * 4 + h) * PADT + MPOS0) * 256 + tid;
  for (int s = 0; s < cnt; ++s) o += sc[0][s] * bf2f(vp[(size_t)s * 256]);
  float ss = block_sum(o * o, red);
  const float rs = rsqrtf(ss * (1.0f / 256.f) + EPS);
  ao[((size_t)b * SEQ + t) * 1024 + h * 256 + tid] = o * rs * subg[tid] * 0.8f;
}
__global__ __launch_bounds__(256) void k_conv2(const bf16* __restrict__ MQ, const bf16* __restrict__ MK, const float* __restrict__ cw, const float* __restrict__ cb, float* __restrict__ mqk) {
  const size_t i = (size_t)blockIdx.x * 256 + threadIdx.x;
  const int c = (int)(i & 1023); const size_t rr = i >> 10; if (rr >= (size_t)NB * TT) return;
  const int b = (int)(rr / TT), sp = (int)(rr % TT);
  const bool isk = c >= 512; const int cc = c & 511, h = cc >> 7, d = cc & 127;
  const bf16* src = (isk ? MK : MQ) + ((size_t)(b * 4 + h) * PADT + MPOS0) * 128 + d;
  float y = cb[c];
#pragma unroll
  for (int j = 0; j < 4; ++j) { const int s2 = sp - 3 + j; if (s2 >= 0) y += cw[j * 1024 + c] * bf2f(src[(size_t)s2 * 128]); }
  mqk[i] = y / (1.0f + expf(-y));
}
__global__ __launch_bounds__(512) void k_mlstm2(const float* __restrict__ mqk, const bf16* __restrict__ MV, const float* __restrict__ LI, const float* __restrict__ LF, float* __restrict__ hm) {
  __shared__ float qs[128], ks[128], ns[128], dens[1];
  const int b = blockIdx.x >> 2, h = blockIdx.x & 3, tid = threadIdx.x, e = tid >> 1, half = tid & 1;
  float C[64];
#pragma unroll
  for (int i = 0; i < 64; ++i) C[i] = 0.f;
  if (tid < 128) ns[tid] = 0.f;
  float m = 0.f;
  for (int sp = 0; sp < TT; ++sp) {
    const size_t rr = (size_t)b * TT + sp;
    __syncthreads();
    if (tid < 128) { qs[tid] = mqk[rr * 1024 + h * 128 + tid]; ks[tid] = mqk[rr * 1024 + 512 + h * 128 + tid] * 0.08838834764831845f; }
    const float li = LI[(b * 4 + h) * PADT + MPOS0 + sp], lf = LF[(b * 4 + h) * PADT + MPOS0 + sp];
    const float mn = fmaxf(lf + m, li);
    const float fp = expf(lf + m - mn), ip = expf(li - mn);
    m = mn;
    const float ve = bf2f(MV[((size_t)(b * 4 + h) * PADT + MPOS0 + sp) * 256 + e]);
    __syncthreads();
    if (tid < 128) ns[tid] = fp * ns[tid] + ip * ks[tid];
    float num = 0.f; const float iv = ip * ve;
#pragma unroll
    for (int i = 0; i < 64; ++i) { C[i] = fp * C[i] + iv * ks[half * 64 + i]; num += qs[half * 64 + i] * C[i]; }
    num += __shfl_xor(num, 1);
    __syncthreads();
    if (tid < 64) { float d = qs[tid] * ns[tid] + qs[tid + 64] * ns[tid + 64]; for (int o = 32; o > 0; o >>= 1) d += __shfl_xor(d, o); if (tid == 0) dens[0] = d; }
    __syncthreads();
    const float den = dens[0];
    if (half == 0 && sp >= NMETA) hm[((size_t)b * SEQ + sp - NMETA) * 1024 + h * 256 + e] = num / fmaxf(fabsf(den), expf(-m));
  }
}
__global__ __launch_bounds__(256) void k_mix2(const float* __restrict__ ao, const float* __restrict__ hm, const bf16* __restrict__ MO, const float* __restrict__ og, float* __restrict__ A2) {
  __shared__ float red[4];
  const size_t r = blockIdx.x; const int tid = threadIdx.x;
  for (int h = 0; h < 4; ++h) {
    A2[r * DM + h * 256 + tid] = ao[r * 1024 + h * 256 + tid];
    const float v = hm[r * 1024 + h * 256 + tid];
    const float ss = block_sum(v * v, red);
    const float rs = rsqrtf(ss * (1.0f / 256.f) + EPS);
    A2[r * DM + 1024 + h * 256 + tid] = v * rs * og[h * 256 + tid] * bf2f(MO[r * 1024 + h * 256 + tid]);
  }
}
__global__ __launch_bounds__(256) void k_peer2(const float* __restrict__ xn, const int* __restrict__ idx, const float* __restrict__ gg,
                                                const float* __restrict__ U, const float* __restrict__ V, float* out) {
  __shared__ __attribute__((aligned(16))) float xs[2048];
  __shared__ float act[128]; __shared__ int eid[128];
  const int tid = threadIdx.x, lane = tid & 63, wid = tid >> 6;
  const size_t r = blockIdx.x;
  for (int i = tid; i < 2048; i += 256) xs[i] = xn[r * 2048 + i];
  if (tid < 128) eid[tid] = idx[r * 128 + tid];
  __syncthreads();
  for (int q = 0; q < 32; ++q) {
    const int e = wid * 32 + q; const float4* up = (const float4*)(U + (size_t)eid[e] * 2048);
    float d = 0.f;
#pragma unroll
    for (int i = 0; i < 8; ++i) { const float4 a = up[i * 64 + lane], x4 = ((const float4*)xs)[i * 64 + lane]; d += a.x * x4.x + a.y * x4.y + a.z * x4.z + a.w * x4.w; }
    for (int o = 32; o > 0; o >>= 1) d += __shfl_xor(d, o);
    if (lane == 0) act[e] = 0.5f * d * (1.0f + erff(d * 0.7071067811865476f)) * gg[r * 128 + e];
  }
  __syncthreads();
  float4 y0 = make_float4(0.f, 0.f, 0.f, 0.f), y1 = y0;
  for (int e = 0; e < 128; ++e) {
    const float a = act[e]; const float4* vp = (const float4*)(V + (size_t)eid[e] * 2048);
    const float4 v0 = vp[tid], v1 = vp[256 + tid];
    y0.x += a * v0.x; y0.y += a * v0.y; y0.z += a * v0.z; y0.w += a * v0.w;
    y1.x += a * v1.x; y1.y += a * v1.y; y1.z += a * v1.z; y1.w += a * v1.w;
  }
  float4* op = (float4*)(out + r * 2048);
  float4 a0 = op[tid], a1 = op[256 + tid];
  a0.x += y0.x; a0.y += y0.y; a0.z += y0.z; a0.w += y0.w; a1.x += y1.x; a1.y += y1.y; a1.z += y1.z; a1.w += y1.w;
  op[tid] = a0; op[256 + tid] = a1;
}
__global__ void k_bf2f(const bf16* __restrict__ in, float* __restrict__ out, size_t n) {
  for (size_t i = (size_t)blockIdx.x * 256 + threadIdx.x; i < n; i += (size_t)gridDim.x * 256) out[i] = bf2f(in[i]);
}
}
extern "C" void kernel_launch(void* const* d_in, const int* in_sizes, int n_in, void* d_out, int out_size, void* d_ws, size_t ws_size, hipStream_t stream) {
  static int grid = 0;
  if (grid == 0) {
    int dev = 0, cus = 0, per_cu = 0;
    if (hipGetDevice(&dev) != hipSuccess || hipDeviceGetAttribute(&cus, hipDeviceAttributeMultiprocessorCount, dev) != hipSuccess) { fprintf(stderr, "device query failed\n"); grid = -1; return; }
    if (hipFuncSetAttribute((const void*)mk_fwd, hipFuncAttributeMaxDynamicSharedMemorySize, LDS_BYTES) != hipSuccess) { fprintf(stderr, "hipFuncSetAttribute failed\n"); grid = -1; return; }
    if (hipOccupancyMaxActiveBlocksPerMultiprocessor(&per_cu, (const void*)mk_fwd, NTHR, LDS_BYTES) != hipSuccess || per_cu < 1) { fprintf(stderr, "occupancy query: %d\n", per_cu); per_cu = 1; }
    (void)hipGetLastError();
    grid = cus * 1;
    if (ws_size < (size_t)512 * MiB) { fprintf(stderr, "ws too small %zu\n", ws_size); grid = -1; return; }
  }
  if (grid < 0) return;
  unsigned char* ws = (unsigned char*)d_ws;
  hipMemsetAsync(ws + WS_CTL, 0, CTL_ZERO_BYTES, stream);
  Args a{};
  for (int i = 0; i < 22; ++i) a.in[i] = (const float*)d_in[i];
  a.out = (float*)d_out; a.ws = ws; a.na = grid;
  using namespace nv;
  float* hm = (float*)(ws + WS_HM); float* mqk = (float*)(ws + 337 * MiB);
  const bf16* MQ = (const bf16*)(ws + WS_MQ); const bf16* MK = (const bf16*)(ws + WS_MK); const bf16* MV = (const bf16*)(ws + WS_MV);
  const float* LI = (const float*)(ws + WS_LI); const float* LF = (const float*)(ws + WS_LF);
#define PH(k) do { a.ph_lo = (k); a.ph_hi = (k) + 1; hipLaunchKernelGGL(mk_fwd, dim3(grid), dim3(NTHR), LDS_BYTES, stream, a); } while (0)
  PH(0); PH(1); PH(2);
  PH(7);
  PH(3); PH(4); PH(5); PH(6);
#undef PH
}
```

```cpp
#include <hip/hip_runtime.h>
#include <cstdio>
#include <cstdint>
#include <math.h>
namespace pg8 {
#define PG8_LAS __attribute__((address_space(3)))
typedef unsigned short bf16_t;
typedef short bf16x8 __attribute__((ext_vector_type(8)));
typedef float f32x4 __attribute__((ext_vector_type(4)));
typedef unsigned u32x4 __attribute__((ext_vector_type(4)));
constexpr int BM = 256, BK = 64, HALF = 128, HTB = HALF * BK * 2  , STAGE_BYTES = 8 * HTB, NXCD = 8, WGM = 8;

__host__ __device__ __forceinline__ int lds_byte(int r, int c) { const int st = (r >> 4) * 2 + (c >> 5), rr = r & 15, cc = c & 31, ob = rr * 64 + cc * 2; return st * 1024 + (ob ^ (((ob >> 9) & 1) << 5)); }
__host__ __device__ __forceinline__ void stage_rc(int b, int& R, int& C) { const int st = b / 1024, sb = b % 1024, swz = sb ^ (((sb >> 9) & 1) << 5); R = (st >> 1) * 16 + swz / 64; C = (st & 1) * 32 + (swz % 64) / 2; }
__host__ __device__ __forceinline__ int perm32(int rho) { const int n = rho >> 4, i = rho & 15; return 8 * (i >> 2) + 4 * n + (i & 3); }

struct Unit { int pm, pn; };
struct Gemm { const bf16_t* A; const bf16_t* Bt; int M, N, K; };

struct StaticOrder {
    int nM, nN, nwg, G, c;
    __host__ __device__ void init(int M, int N, int G_, int c_) { nM = M / BM; nN = N / BM; nwg = nM * nN; G = G_; c = c_; }
    __host__ __device__ bool next(int i, Unit& u) const {
        const long L = (long)i * G + c; if (L >= nwg) return false;
        int wgid = (int)L; { const int q = nwg / NXCD, r = nwg % NXCD, xcd = wgid % NXCD, off = wgid / NXCD; wgid = (xcd < r ? xcd * (q + 1) : r * (q + 1) + (xcd - r) * q) + off; }
        const int nig = WGM * nN, gid = wgid / nig, fm = gid * WGM, gsz = (nM - fm) < WGM ? (nM - fm) : WGM;
        u.pm = fm + ((wgid % nig) % gsz); u.pn = (wgid % nig) / gsz; return true;
    }
    __device__ __forceinline__ void a_ready(const Unit&) const {}
    __device__ __forceinline__ void done(const Unit&) const {}
};

__device__ __forceinline__ unsigned cvt_pk_bf16(float lo, float hi) { unsigned r; asm volatile("v_cvt_pk_bf16_f32 %0, %1, %2" : "=v"(r) : "v"(lo), "v"(hi)); return r; }
typedef float f32x2 __attribute__((ext_vector_type(2)));
template <class Epi, class Sched, bool ALIGN_EPI = false, bool SP2 = false>
__device__ __forceinline__ void gemm_phase(PG8_LAS unsigned char* lds, const Gemm g, const Sched& S, const Epi& E) {
    const int tid = threadIdx.x, wid = __builtin_amdgcn_readfirstlane(tid >> 6), lane = tid & 63, wr = wid >> 2, wc = wid & 3, fr = lane & 15, fq = lane >> 4;
    const int K = g.K, nt = K / BK;
    unsigned voffA[2], voffB[2];
#pragma unroll
    for (int i = 0; i < 2; ++i) { int R, C; stage_rc(tid * 16 + i * 8192, R, C); const int Rb = Epi::PERM ? ((R & ~31) + perm32(R & 31)) : R;
        voffA[i] = (unsigned)(R * K + C) * 2u; voffB[i] = (unsigned)(Rb * K + C) * 2u; }
    const size_t kstep = (size_t)(BK * 2);
    const size_t hstep = (size_t)HALF * K * 2;
    const size_t tstep = 2 * hstep;
    const unsigned ldsw = (unsigned)wid * 1024u;
    const int aoff = lds_byte(wr * 64 + fr, fq * 8), boff = lds_byte(wc * 32 + fr, fq * 8);
#define PG8_SA(b, h) (((b) * 2 + (h)) * HTB)
#define PG8_SB(b, h) ((4 + (b) * 2 + (h)) * HTB)
#define PG8_STAGE(bufoff, gbase, voff) do { _Pragma("unroll") for (int _i = 0; _i < 2; ++_i) \
        __builtin_amdgcn_global_load_lds((const unsigned*)((const char*)(gbase) + (voff)[_i]), (PG8_LAS unsigned*)(lds + (bufoff) + ldsw + _i * 8192), 16, 0, 0); } while (0)
#define PG8_LDA(dst, b, h) do { _Pragma("unroll") for (int m = 0; m < 4; ++m) _Pragma("unroll") for (int k = 0; k < 2; ++k) dst[m][k] = *(const PG8_LAS bf16x8*)(lds + PG8_SA(b, h) + aoff + m * 2048 + k * 1024); } while (0)
#define PG8_LDB(dst, b, h) do { _Pragma("unroll") for (int n = 0; n < 2; ++n) _Pragma("unroll") for (int k = 0; k < 2; ++k) dst[n][k] = *(const PG8_LAS bf16x8*)(lds + PG8_SB(b, h) + boff + n * 2048 + k * 1024); } while (0)
#define PG8_MMA(ai, bj, At, Bt) do { __builtin_amdgcn_s_setprio(1); _Pragma("unroll") for (int m = 0; m < 4; ++m) _Pragma("unroll") for (int n = 0; n < 2; ++n) _Pragma("unroll") for (int k = 0; k < 2; ++k) \
        acc[ai][bj][m][n] = __builtin_amdgcn_mfma_f32_16x16x32_bf16(Bt[n][k], At[m][k], acc[ai][bj][m][n], 0, 0, 0); __builtin_amdgcn_s_setprio(0); } while (0)
#define PG8_WAIT_V(n) asm volatile("s_waitcnt vmcnt(" #n ")" ::: "memory")
#define PG8_WAIT_L(n) asm volatile("s_waitcnt lgkmcnt(" #n ")" ::: "memory")
#define PG8_BAR __builtin_amdgcn_s_barrier()
#define PG8_SCHED __builtin_amdgcn_sched_barrier(0)
    Unit cur, nxt; int ui = 0;
    if (!S.next(0, cur)) return;
    f32x4 acc[2][2][4][2];
#pragma unroll
    for (int a = 0; a < 2; ++a)
#pragma unroll
        for (int b = 0; b < 2; ++b)
#pragma unroll
            for (int m = 0; m < 4; ++m)
#pragma unroll
                for (int n = 0; n < 2; ++n) acc[a][b][m][n] = (f32x4){0.f, 0.f, 0.f, 0.f};
    bf16x8 At[4][2], B0[2][2], B1[2][2];
    const char* cA = (const char*)g.A + (size_t)cur.pm * tstep; const char* cB = (const char*)g.Bt + (size_t)cur.pn * tstep;
    S.a_ready(cur);
    if constexpr (SP2) {
        PG8_STAGE(PG8_SB(0, 0), cB, voffB); PG8_STAGE(PG8_SB(0, 1), cB + hstep, voffB); PG8_STAGE(PG8_SA(0, 0), cA, voffA); PG8_STAGE(PG8_SA(0, 1), cA + hstep, voffA);
        if (wr == 1) PG8_BAR;
        PG8_WAIT_V(2); PG8_BAR;
        PG8_STAGE(PG8_SB(1, 0), cB + kstep, voffB); PG8_STAGE(PG8_SA(1, 0), cA + kstep, voffA); PG8_STAGE(PG8_SB(1, 1), cB + hstep + kstep, voffB);
        PG8_WAIT_V(6); PG8_BAR;
    } else {
        PG8_STAGE(PG8_SB(0, 0), cB, voffB); PG8_STAGE(PG8_SA(0, 0), cA, voffA); PG8_STAGE(PG8_SB(0, 1), cB + hstep, voffB); PG8_STAGE(PG8_SA(0, 1), cA + hstep, voffA);
        if (wr == 1) PG8_BAR;
        PG8_WAIT_V(4); PG8_BAR;
        PG8_STAGE(PG8_SB(1, 0), cB + kstep, voffB); PG8_STAGE(PG8_SA(1, 0), cA + kstep, voffA); PG8_STAGE(PG8_SB(1, 1), cB + hstep + kstep, voffB);
        PG8_WAIT_V(6); PG8_BAR;
    }
    for (;;) {
        const bool has_next = S.next(ui + 1, nxt);
        const char* nA = has_next ? (const char*)g.A + (size_t)nxt.pm * tstep : cA; const char* nB = has_next ? (const char*)g.Bt + (size_t)nxt.pn * tstep : cB;
        for (int t = 0; t < nt; t += 2) {
            const bool last = (t == nt - 2);
            const char* a1 = cA + (size_t)(t + 1) * kstep;
            const char* a2 = last ? nA : cA + (size_t)(t + 2) * kstep; const char* b2 = last ? nB : cB + (size_t)(t + 2) * kstep;
            const char* a3 = a2 + kstep; const char* b3 = b2 + kstep;
            if (last && has_next) S.a_ready(nxt);
            if constexpr (SP2) {
            PG8_LDB(B0, 0, 0); PG8_LDB(B1, 0, 1); PG8_SCHED; PG8_LDA(At, 0, 0); PG8_STAGE(PG8_SA(1, 1), a1 + hstep, voffA);
            PG8_WAIT_V(8); PG8_WAIT_L(0); PG8_BAR; PG8_MMA(0, 0, At, B0); PG8_MMA(0, 1, At, B1); PG8_BAR; PG8_SCHED;
            PG8_LDA(At, 0, 1); PG8_STAGE(PG8_SB(0, 0), b2, voffB); PG8_STAGE(PG8_SB(0, 1), b2 + hstep, voffB); PG8_STAGE(PG8_SA(0, 0), a2, voffA);
            PG8_WAIT_V(8); PG8_WAIT_L(0); PG8_BAR; PG8_MMA(1, 0, At, B0); PG8_MMA(1, 1, At, B1); PG8_BAR; PG8_SCHED;
            PG8_LDB(B0, 1, 0); PG8_LDB(B1, 1, 1); PG8_SCHED; PG8_LDA(At, 1, 0); PG8_STAGE(PG8_SA(0, 1), a2 + hstep, voffA);
            PG8_WAIT_V(8); PG8_WAIT_L(0); PG8_BAR; PG8_MMA(0, 0, At, B0); PG8_MMA(0, 1, At, B1); PG8_BAR; PG8_SCHED;
            PG8_LDA(At, 1, 1); PG8_STAGE(PG8_SB(1, 0), b3, voffB); PG8_STAGE(PG8_SB(1, 1), b3 + hstep, voffB); PG8_STAGE(PG8_SA(1, 0), a3, voffA);
            PG8_WAIT_V(8); PG8_WAIT_L(0); PG8_BAR; PG8_MMA(1, 0, At, B0); PG8_MMA(1, 1, At, B1); PG8_BAR; PG8_SCHED;
            } else {
            PG8_LDB(B0, 0, 0); PG8_SCHED; PG8_LDA(At, 0, 0); PG8_STAGE(PG8_SA(1, 1), a1 + hstep, voffA);
            PG8_WAIT_L(8); PG8_BAR; PG8_WAIT_L(0); PG8_MMA(0, 0, At, B0); PG8_BAR; PG8_SCHED;
            PG8_LDB(B1, 0, 1); PG8_STAGE(PG8_SB(0, 0), b2, voffB);
            PG8_BAR; PG8_WAIT_L(0); PG8_MMA(0, 1, At, B1); PG8_BAR;
            PG8_LDA(At, 0, 1); PG8_STAGE(PG8_SA(0, 0), a2, voffA);
            PG8_BAR; PG8_WAIT_L(0); PG8_MMA(1, 0, At, B0); PG8_BAR; PG8_SCHED;
            PG8_STAGE(PG8_SB(0, 1), b2 + hstep, voffB);
            PG8_WAIT_V(6); PG8_BAR; PG8_MMA(1, 1, At, B1); PG8_BAR;
            PG8_LDB(B0, 1, 0); PG8_SCHED; PG8_LDA(At, 1, 0); PG8_STAGE(PG8_SA(0, 1), a2 + hstep, voffA);
            PG8_WAIT_L(8); PG8_BAR; PG8_WAIT_L(0); PG8_MMA(0, 0, At, B0); PG8_BAR; PG8_SCHED;
            PG8_LDB(B1, 1, 1); PG8_STAGE(PG8_SB(1, 0), b3, voffB);
            PG8_BAR; PG8_WAIT_L(0); PG8_MMA(0, 1, At, B1); PG8_BAR;
            PG8_LDA(At, 1, 1); PG8_STAGE(PG8_SA(1, 0), a3, voffA);
            PG8_BAR; PG8_WAIT_L(0); PG8_MMA(1, 0, At, B0); PG8_BAR; PG8_SCHED;
            PG8_STAGE(PG8_SB(1, 1), b3 + hstep, voffB);
            PG8_WAIT_V(6); PG8_BAR; PG8_MMA(1, 1, At, B1); PG8_BAR;
            }
        }
        if constexpr (ALIGN_EPI) { if (wr == 0) PG8_BAR; }
        if constexpr (!Epi::AFTER_DRAIN) { E(acc, cur, wr, wc, fr, fq); S.done(cur); }
        if (!has_next) break;
#pragma unroll
        for (int a = 0; a < 2; ++a)
#pragma unroll
            for (int b = 0; b < 2; ++b)
#pragma unroll
                for (int m = 0; m < 4; ++m)
#pragma unroll
                    for (int n = 0; n < 2; ++n) acc[a][b][m][n] = (f32x4){0.f, 0.f, 0.f, 0.f};
        cur = nxt; cA = nA; cB = nB; ++ui;
        if constexpr (ALIGN_EPI) { if (wr == 1) PG8_BAR; }
    }
    PG8_WAIT_V(0);
    if constexpr (!ALIGN_EPI) { if (wr == 0) PG8_BAR; }
    PG8_BAR;
    if constexpr (Epi::AFTER_DRAIN) { E.fused(acc, cur, wr, wc, fr, fq, lds, wid, lane); S.done(cur); }
#undef PG8_SA
#undef PG8_SB
#undef PG8_STAGE
#undef PG8_LDA
#undef PG8_LDB
#undef PG8_MMA
#undef PG8_WAIT_V
#undef PG8_WAIT_L
#undef PG8_BAR
#undef PG8_SCHED
}
}
#define GAS __attribute__((address_space(1)))
#define LAS __attribute__((address_space(3)))
typedef unsigned short bf16;
typedef unsigned v4u __attribute__((ext_vector_type(4)));
typedef unsigned v2u __attribute__((ext_vector_type(2)));
typedef float f32x4 __attribute__((ext_vector_type(4)));
typedef short bf16x8 __attribute__((ext_vector_type(8)));
#define LDS_WAIT() asm volatile("s_waitcnt lgkmcnt(0)" ::: "memory")
#define VM_WAIT() asm volatile("s_waitcnt vmcnt(0)" ::: "memory")

constexpr int DM = 2048, NB = 4, SEQ = 2048, NMETA = 16, MROWS = NB * SEQ, DPROJ = 6152, NPROJ = 6144;
constexpr int PADT = 2112, POS0 = 64, MPOS0 = 48;
constexpr float EPS = 1e-6f;
constexpr float LOG2E = 1.4426950408889634f;
constexpr float QSCALE = 0.08838834764831845f * LOG2E;
constexpr int NWAVES = 8, NTHR = 512;

constexpr size_t MiB = 1u << 20;
constexpr size_t WS_CTL = 0, CTL_ZERO_BYTES = 1 * MiB;
constexpr size_t WS_PM = 512 * 1024;
constexpr size_t WS_W1T = 2 * MiB, WS_W2T = 26 * MiB, WS_W3T = 34 * MiB, WS_XN = 42 * MiB;
constexpr size_t WS_Q = 74 * MiB, WS_KP = 90 * MiB, WS_VP = 107 * MiB, WS_MQ = 124 * MiB, WS_MK = 133 * MiB, WS_MV = 142 * MiB, WS_MO = 159 * MiB;
constexpr size_t WS_SMALL = 175 * MiB;
constexpr size_t WS_XM = WS_SMALL, WS_LI = WS_SMALL + 128 * 1024, WS_LF = WS_SMALL + 384 * 1024, WS_LAM = WS_SMALL + 640 * 1024;
constexpr size_t WS_PO = 176 * MiB, WS_ML = 304 * MiB, WS_HM = 305 * MiB, WS_A2 = 42 * MiB, WS_H1B = 74 * MiB, WS_SSQ = 106 * MiB, WS_S = 176 * MiB, WS_UB = 384 * MiB, WS_VB = 448 * MiB;
constexpr int CW_BAR = 4096;

constexpr int RING_OFF = 0, RING_BYTES = 131072;
constexpr int XCH_OFF = 131072;
constexpr int MISC_OFF = XCH_OFF + 8192;
constexpr int LDS_BYTES = 155648;

__device__ __forceinline__ unsigned f2bf(float f) { unsigned u = __builtin_bit_cast(unsigned, f); return (u + 0x7fffu + ((u >> 16) & 1u)) >> 16; }
__device__ __forceinline__ unsigned pk2(float lo, float hi) { return f2bf(lo) | (f2bf(hi) << 16); }
__device__ __forceinline__ float bf2f(unsigned short u) { return __builtin_bit_cast(float, (unsigned)u << 16); }
__device__ __forceinline__ float bflo(unsigned w) { return __builtin_bit_cast(float, w << 16); }
__device__ __forceinline__ float bfhi(unsigned w) { return __builtin_bit_cast(float, w & 0xffff0000u); }
__device__ __forceinline__ float wave_sum(float v) {
#pragma unroll
  for (int o = 1; o < 64; o <<= 1) v += __shfl_xor(v, o);
  return v;
}
__device__ __forceinline__ size_t kp_off(int bhm, int pos, int d) { const int j = pos >> 6, row = pos & 63, d0 = d >> 4, hi = (d >> 3) & 1;
  return ((size_t)(bhm * 33 + j) * 8 + d0) * 1024 + (size_t)((((row << 1) | hi) ^ ((row >> 3) & 1)) << 3) + (d & 7); }
__device__ __forceinline__ float sigmoidf_(float x) { return 1.0f / (1.0f + __expf(-x)); }
#define XB_TMO      128
#define XB_XCNT(j)  (256  + 64 * (j))
#define XB_XSUB(j)  (1280 + 64 * (j))
#define XB_XGEN(j)  (2304 + 64 * (j))
#define XB_TOP      3328
#define XB_TOPGEN   3392
#define XCD_BAR_WORDS 3456
#define XB_SPIN_CAP (1u << 18)

__device__ __forceinline__ unsigned xb_ld(unsigned* p)              { return __hip_atomic_load(p, __ATOMIC_RELAXED, __HIP_MEMORY_SCOPE_AGENT); }
__device__ __forceinline__ unsigned xb_add(unsigned* p, unsigned v) { return __hip_atomic_fetch_add(p, v, __ATOMIC_RELAXED, __HIP_MEMORY_SCOPE_AGENT); }
__device__ __forceinline__ unsigned xb_xcc_id() { return (unsigned)__builtin_amdgcn_s_getreg((3 << 11) | 20) & 0xFu; }
#define XB_SPIN(cond, bar) do { unsigned _sp = 0; while (cond) { __builtin_amdgcn_s_sleep(1); \
    if ((++_sp & 255u) == 0u) { if (xb_ld(&(bar)[XB_TMO])) break; if (_sp > XB_SPIN_CAP) { atomicAdd(&(bar)[XB_TMO], 1u); break; } } } } while (0)

struct XcdBarrier {
    unsigned* bar; unsigned x;
    volatile LAS unsigned* st;
};

__device__ __forceinline__ XcdBarrier xcd_barrier_post(unsigned* bar, volatile LAS unsigned* st) {
    XcdBarrier b; b.bar = bar; b.x = xb_xcc_id(); b.st = st;
    if (threadIdx.x == 0) (void)xb_add(&bar[XB_XCNT(b.x)], 1u);
    return b;
}
__device__ __forceinline__ void xcd_barrier_complete(unsigned* bar, unsigned x, unsigned& nloc, unsigned& nx) {
    const unsigned G = gridDim.x * gridDim.y * gridDim.z;
    unsigned sum, cnt, mine, sp = 0u;
    for (;;) {
        sum = 0u; cnt = 0u; mine = 0u;
#pragma unroll
        for (unsigned j = 0; j < 16; ++j) { const unsigned c = xb_ld(&bar[XB_XCNT(j)]); sum += c; cnt += (c > 0u) ? 1u : 0u; mine = (j == x) ? c : mine; }
        if (sum == G) break;
        __builtin_amdgcn_s_sleep(1);
        if ((++sp & 255u) == 0u) { if (xb_ld(&bar[XB_TMO])) break; if (sp > XB_SPIN_CAP) { atomicAdd(&bar[XB_TMO], 1u); break; } }
    }
    nloc = mine > 0u ? mine : 1u; nx = cnt > 0u ? cnt : 1u;
}

__device__ __forceinline__ void xcd_barrier(const XcdBarrier& b) {
    asm volatile("s_waitcnt vmcnt(0)" ::: "memory");
    __syncthreads();
    if (threadIdx.x == 0) {
        unsigned* bar = b.bar;
        __builtin_amdgcn_s_waitcnt(0);
        unsigned nloc = b.st[0], nx = b.st[1];
        if (nloc == 0u) { xcd_barrier_complete(bar, b.x, nloc, nx); b.st[0] = nloc; b.st[1] = nx; }
        const unsigned old = xb_add(&bar[XB_XSUB(b.x)], 1u);
        const unsigned gen = old / nloc;
        if (old + 1u == (gen + 1u) * nloc) {
            __builtin_amdgcn_fence(__ATOMIC_RELEASE, "agent");
            asm volatile("s_waitcnt vmcnt(0)" ::: "memory");
            const unsigned og = xb_add(&bar[XB_TOP], 1u);
            const unsigned tg = og / nx;
            if (og + 1u == (tg + 1u) * nx) xb_add(&bar[XB_TOPGEN], 1u);
            else XB_SPIN(xb_ld(&bar[XB_TOPGEN]) == tg, bar);
            __builtin_amdgcn_fence(__ATOMIC_ACQUIRE, "agent");
            xb_add(&bar[XB_XGEN(b.x)], 1u);
            asm volatile("s_waitcnt vmcnt(0)" ::: "memory");
        } else {
            XB_SPIN(xb_ld(&bar[XB_XGEN(b.x)]) == gen, bar);
            __builtin_amdgcn_fence(__ATOMIC_ACQUIRE, "agent");
            asm volatile("s_waitcnt vmcnt(0)" ::: "memory");
        }
    }
    __syncthreads();
}

struct Args { const float* in[22]; float* out; unsigned char* ws; int ph_lo, ph_hi, na, pad; };
struct Frame {
  LAS unsigned char* lds; unsigned char* ws; int tid, lane, wave; const float* const* in;
};
#define IN_X 0
#define IN_META 1
#define IN_G1 2
#define IN_WIN 3
#define IN_CW 4
#define IN_CB 5
#define IN_IGB 6
#define IN_FGB 7
#define IN_LQ1 8
#define IN_LK1 9
#define IN_LQ2 10
#define IN_LK2 11
#define IN_QNG 12
#define IN_KNG 13
#define IN_SUBG 14
#define IN_OUTG 15
#define IN_WOUT 16
#define IN_G2 17
#define IN_WQ 18
#define IN_SUBK 19
#define IN_U 20
#define IN_V 21

__device__ __forceinline__ void p0_rows(const Frame& F, const Args& a) {
  const float* x = a.in[IN_X]; const float* meta = a.in[IN_META]; const float* g1 = a.in[IN_G1]; const float* w_in = a.in[IN_WIN];
  const float* igb = a.in[IN_IGB]; const float* fgb = a.in[IN_FGB];
  bf16* Xn = (bf16*)(F.ws + WS_XN); bf16* Xm = (bf16*)(F.ws + WS_XM); float* LI = (float*)(F.ws + WS_LI); float* LF = (float*)(F.ws + WS_LF);
  LAS f32x4* wgl = (LAS f32x4*)(F.lds);
  for (int e = F.tid; e < 4096; e += NTHR) {
    const int ln = e & 63, q = e >> 6, half = q & 1, j = (q >> 1) & 3, i = q >> 3;
    const int k = 4 * (i * 64 + ln) + j;
    wgl[e] = *(const f32x4*)(w_in + (size_t)k * DPROJ + NPROJ + 4 * half);
  }
  __syncthreads();
  const int gw = blockIdx.x * NWAVES + F.wave, NGW = gridDim.x * NWAVES, lane = F.lane;
  for (int task = gw; task < MROWS / 2 + NMETA / 2; task += NGW) {
    const bool ismeta = task >= MROWS / 2;
    const int r0 = ismeta ? (task - MROWS / 2) * 2 : task * 2;
    const float* src0 = (ismeta ? meta : x) + (size_t)r0 * DM;
    float rs[2];
    { float s0 = 0.f, s1 = 0.f;
#pragma unroll 2
      for (int i = 0; i < 8; ++i) { const f32x4 a0 = ((const f32x4*)src0)[i * 64 + lane], a1 = ((const f32x4*)(src0 + DM))[i * 64 + lane];
        s0 += (a0.x * a0.x + a0.y * a0.y) + (a0.z * a0.z + a0.w * a0.w); s1 += (a1.x * a1.x + a1.y * a1.y) + (a1.z * a1.z + a1.w * a1.w); }
      rs[0] = rsqrtf(wave_sum(s0) * (1.0f / DM) + EPS); rs[1] = rsqrtf(wave_sum(s1) * (1.0f / DM) + EPS); }
    float ga[2][8];
#pragma unroll
    for (int rr = 0; rr < 2; ++rr)
#pragma unroll
      for (int g = 0; g < 8; ++g) ga[rr][g] = 0.f;
    bf16* dst0 = (ismeta ? Xm : Xn) + (size_t)r0 * DM;
#pragma unroll 1
    for (int i = 0; i < 8; ++i) {
      const f32x4 g = ((const f32x4*)g1)[i * 64 + lane];
      f32x4 xn[2];
#pragma unroll
      for (int rr = 0; rr < 2; ++rr) { xn[rr] = ((const f32x4*)(src0 + (size_t)rr * DM))[i * 64 + lane] * g * rs[rr];
        v2u o; o.x = pk2(xn[rr].x, xn[rr].y); o.y = pk2(xn[rr].z, xn[rr].w); ((v2u*)(dst0 + (size_t)rr * DM))[i * 64 + lane] = o; }
#pragma unroll
      for (int j = 0; j < 4; ++j) {
        const f32x4 w0 = wgl[((i * 4 + j) * 2 + 0) * 64 + lane], w1 = wgl[((i * 4 + j) * 2 + 1) * 64 + lane];
#pragma unroll
        for (int rr = 0; rr < 2; ++rr) { const float xv = xn[rr][j];
          ga[rr][0] += xv * w0.x; ga[rr][1] += xv * w0.y; ga[rr][2] += xv * w0.z; ga[rr][3] += xv * w0.w;
          ga[rr][4] += xv * w1.x; ga[rr][5] += xv * w1.y; ga[rr][6] += xv * w1.z; ga[rr][7] += xv * w1.w; }
      }
    }
#pragma unroll
    for (int rr = 0; rr < 2; ++rr)
#pragma unroll
      for (int g = 0; g < 8; ++g) ga[rr][g] = wave_sum(ga[rr][g]);
    if (lane < 8) {
      const int rr = lane >> 2, h = lane & 3;
      float gi = 0.f, gf = 0.f;
#pragma unroll
      for (int q = 0; q < 2; ++q)
#pragma unroll
        for (int hh = 0; hh < 4; ++hh) if (q == rr && hh == h) { gi = ga[q][hh]; gf = ga[q][4 + hh]; }
      const float li = gi + igb[h]; const float fx = gf + fgb[h];
      const float lf = fminf(fx, 0.f) - log1pf(__expf(-fabsf(fx)));
      const int R = r0 + rr;
      if (!ismeta) { const int b = R >> 11, t = R & 2047; LI[(b * 4 + h) * PADT + POS0 + t] = li; LF[(b * 4 + h) * PADT + POS0 + t] = lf; }
      else { for (int b = 0; b < NB; ++b) { LI[(b * 4 + h) * PADT + MPOS0 + R] = li; LF[(b * 4 + h) * PADT + MPOS0 + R] = lf; } }
    }
  }
  __syncthreads();
}
__device__ __forceinline__ void p0_metaproj(const Frame& F, const Args& a) {
  const float* meta = a.in[IN_META]; const float* g1 = a.in[IN_G1]; const float* w_in = a.in[IN_WIN];
  float* PM = (float*)(F.ws + WS_PM);
  LAS float* xs = (LAS float*)(F.lds);
  LAS float* part = (LAS float*)(F.lds + 16384);
  const int q = F.tid >> 7, c = F.tid & 127;
  for (int task = blockIdx.x; task < NPROJ / 128; task += gridDim.x) {
    const int n = task * 128 + c;
    float acc[16];
#pragma unroll
    for (int m = 0; m < 16; ++m) acc[m] = 0.f;
#pragma unroll 1
    for (int kb = 0; kb < 8; ++kb) {
      __syncthreads();
#pragma unroll
      for (int i = 0; i < 8; ++i) { const int idx = F.tid + NTHR * i, qq = idx >> 10, kk = (idx >> 4) & 63, m = idx & 15; const int k = 512 * qq + 64 * kb + kk;
        xs[idx] = meta[(size_t)m * DM + k] * g1[k]; }
      __syncthreads();
#pragma unroll 4
      for (int kk = 0; kk < 64; ++kk) {
        const float w = w_in[(size_t)(512 * q + 64 * kb + kk) * DPROJ + n];
        const LAS f32x4* xp = (const LAS f32x4*)(xs + (q * 64 + kk) * 16);
#pragma unroll
        for (int t = 0; t < 4; ++t) { const f32x4 xv = xp[t]; acc[4 * t + 0] += xv.x * w; acc[4 * t + 1] += xv.y * w; acc[4 * t + 2] += xv.z * w; acc[4 * t + 3] += xv.w * w; }
      }
    }
#pragma unroll
    for (int m = 0; m < 16; ++m) part[(q * 16 + m) * 128 + c] = acc[m];
    __syncthreads();
    for (int e = F.tid; e < 16 * 128; e += NTHR) { const int m = e >> 7, cc = e & 127;
      PM[m * NPROJ + task * 128 + cc] = (part[(0 * 16 + m) * 128 + cc] + part[(1 * 16 + m) * 128 + cc]) + (part[(2 * 16 + m) * 128 + cc] + part[(3 * 16 + m) * 128 + cc]); }
  }
  __syncthreads();
}
__device__ __forceinline__ void p0_transpose(const Frame& F, const float* W, int ldw, int N, bf16* Wt) {
  LAS float* tl = (LAS float*)(F.lds);
  const int ntn = N / 64, ntask = ntn * 16;
  for (int task = blockIdx.x; task < ntask; task += gridDim.x) {
    const int nb = task % ntn, kb = task / ntn, n0 = nb * 64, k0 = kb * 128;
    __syncthreads();
#pragma unroll
    for (int i = 0; i < 4; ++i) { const int idx = F.tid + NTHR * i, kk = idx >> 4, c4 = idx & 15;
      const f32x4 w = *(const f32x4*)(W + (size_t)(k0 + kk) * ldw + n0 + 4 * c4);
      LAS float* d = tl + kk * 65 + 4 * c4; d[0] = w.x; d[1] = w.y; d[2] = w.z; d[3] = w.w; }
    __syncthreads();
    const int n = F.tid >> 3, kc = F.tid & 7;
    const LAS float* s = tl + (kc * 16) * 65 + n;
    v4u o0, o1;
    o0.x = pk2(s[0 * 65], s[1 * 65]); o0.y = pk2(s[2 * 65], s[3 * 65]); o0.z = pk2(s[4 * 65], s[5 * 65]); o0.w = pk2(s[6 * 65], s[7 * 65]);
    o1.x = pk2(s[8 * 65], s[9 * 65]); o1.y = pk2(s[10 * 65], s[11 * 65]); o1.z = pk2(s[12 * 65], s[13 * 65]); o1.w = pk2(s[14 * 65], s[15 * 65]);
    v4u* dp = (v4u*)(Wt + (size_t)(n0 + n) * DM + k0 + kc * 16);
    dp[0] = o0; dp[1] = o1;
  }
  __syncthreads();
}
__device__ __forceinline__ void p0_zero_vpad(const Frame& F) {
  bf16* Vp = (bf16*)(F.ws + WS_VP);
  const int per = MPOS0 * 256 / 8;
  for (int i = blockIdx.x * NTHR + F.tid; i < 16 * per; i += gridDim.x * NTHR) { const int bh = i / per, e = i % per;
    *(v4u*)(Vp + (size_t)bh * PADT * 256 + (size_t)e * 8) = (v4u){0u, 0u, 0u, 0u}; }
}
__device__ __forceinline__ void p0_lam(const Frame& F, const Args& a) {
  if (blockIdx.x == 0 && F.wave == 0) {
    const int l = F.lane;
    float s1 = a.in[IN_LQ1][l] * a.in[IN_LK1][l] + a.in[IN_LQ1][l + 64] * a.in[IN_LK1][l + 64];
    float s2 = a.in[IN_LQ2][l] * a.in[IN_LK2][l] + a.in[IN_LQ2][l + 64] * a.in[IN_LK2][l + 64];
    s1 = wave_sum(s1); s2 = wave_sum(s2);
    if (l == 0) *(float*)(F.ws + WS_LAM) = __expf(s1) - __expf(s2) + 0.2f;
  }
}

struct EpiProj {
  static constexpr bool PERM = true, AFTER_DRAIN = false;
  bf16 *Qb, *Kp, *Vp, *MQ, *MK, *MV, *MO; const float *qg, *kg; LAS float* xch;
  __device__ __forceinline__ void operator()(const pg8::f32x4 (&acc)[2][2][4][2], const pg8::Unit& u, int wr, int wc, int fr, int fq) const {
    const int pn = u.pn, b = u.pm >> 3, tb = (u.pm & 7) * 256 + wr * 64 + fr, d0 = wc * 32 + fq * 8;
    if (pn < 8) {
      const bool isk = pn >= 4; const int h = pn & 3;
      float ssq[2][4][2];
#pragma unroll
      for (int ai = 0; ai < 2; ++ai)
#pragma unroll
        for (int m = 0; m < 4; ++m)
#pragma unroll
          for (int bj = 0; bj < 2; ++bj) { float s = 0.f;
#pragma unroll
            for (int n = 0; n < 2; ++n) { const pg8::f32x4 x = acc[ai][bj][m][n]; s += (x[0] * x[0] + x[1] * x[1]) + (x[2] * x[2] + x[3] * x[3]); }
            s += __shfl_xor(s, 16); s += __shfl_xor(s, 32); ssq[ai][m][bj] = s;
            if (fq == 0) xch[((ai * 128 + wr * 64 + m * 16 + fr) * 2 + bj) * 4 + wc] = s; }
      asm volatile("s_waitcnt lgkmcnt(0)" ::: "memory"); __builtin_amdgcn_s_barrier(); asm volatile("" ::: "memory");
      const float* gp = (isk ? kg : qg) + d0; const f32x4 g0 = *(const f32x4*)gp, g1v = *(const f32x4*)(gp + 4);
      const float sc = isk ? 1.0f : QSCALE;
#pragma unroll
      for (int ai = 0; ai < 2; ++ai)
#pragma unroll
        for (int m = 0; m < 4; ++m)
#pragma unroll
          for (int bj = 0; bj < 2; ++bj) {
            const f32x4 p = *(const LAS f32x4*)(xch + ((ai * 128 + wr * 64 + m * 16 + fr) * 2 + bj) * 4);
            const float rs = rsqrtf(((p.x + p.y) + (p.z + p.w)) * (1.0f / 128.f) + EPS) * sc;
            const pg8::f32x4 v0 = acc[ai][bj][m][0], v1 = acc[ai][bj][m][1];
            v4u w; w.x = pk2(v0[0] * rs * g0.x, v0[1] * rs * g0.y); w.y = pk2(v0[2] * rs * g0.z, v0[3] * rs * g0.w);
            w.z = pk2(v1[0] * rs * g1v.x, v1[1] * rs * g1v.y); w.w = pk2(v1[2] * rs * g1v.z, v1[3] * rs * g1v.w);
            const int t = tb + ai * 128 + m * 16;
            bf16* dst = isk ? Kp + kp_off((b * 4 + h) * 2 + bj, POS0 + t, d0)
                            : Qb + ((size_t)((b * 4 + h) * 2 + bj) * SEQ + t) * 128 + d0;
            *(v4u*)dst = w; }
      return;
    }
#pragma unroll
    for (int ai = 0; ai < 2; ++ai)
#pragma unroll
      for (int m = 0; m < 4; ++m)
#pragma unroll
        for (int bj = 0; bj < 2; ++bj) {
          pg8::f32x4 v0 = acc[ai][bj][m][0], v1 = acc[ai][bj][m][1];
          const int t = tb + ai * 128 + m * 16;
          bf16* dst;
          if (pn < 12) { const int h = pn - 8; dst = Vp + ((size_t)(b * 4 + h) * PADT + POS0 + t) * 256 + bj * 128 + d0; }
          else if (pn < 16) { const int h = 2 * (pn & 1) + bj; dst = (pn >= 14 ? MK : MQ) + ((size_t)(b * 4 + h) * PADT + POS0 + t) * 128 + d0; }
          else if (pn < 20) { const int h = pn - 16; dst = MV + ((size_t)(b * 4 + h) * PADT + POS0 + t) * 256 + bj * 128 + d0; }
          else { dst = MO + (size_t)(b * SEQ + t) * 1024 + (pn - 20) * 256 + bj * 128 + d0;
#pragma unroll
            for (int j = 0; j < 4; ++j) { v0[j] = sigmoidf_(v0[j]); v1[j] = sigmoidf_(v1[j]); } }
          v4u w; w.x = pk2(v0[0], v0[1]); w.y = pk2(v0[2], v0[3]); w.z = pk2(v1[0], v1[1]); w.w = pk2(v1[2], v1[3]);
          *(v4u*)dst = w; }
  }
};
__device__ __forceinline__ void p1_meta_finalize(const Frame& F, const Args& a) {
  if (blockIdx.x >= NMETA) return;
  const int mrow = blockIdx.x, tid = F.tid, lane = F.lane, w = F.wave;
  const float* meta = a.in[IN_META] + (size_t)mrow * DM; const float* PM = (const float*)(F.ws + WS_PM) + (size_t)mrow * NPROJ;
  LAS float* red = (LAS float*)(F.lds + XCH_OFF);
  const f32x4 mv = ((const f32x4*)meta)[tid];
  float s = wave_sum((mv.x * mv.x + mv.y * mv.y) + (mv.z * mv.z + mv.w * mv.w));
  if (lane == 0) red[w] = s;
  __syncthreads();
  float tot = 0.f;
#pragma unroll
  for (int i = 0; i < 8; ++i) tot += red[i];
  const float rs = rsqrtf(tot * (1.0f / DM) + EPS);
  bf16* Kp = (bf16*)(F.ws + WS_KP); bf16* Vp = (bf16*)(F.ws + WS_VP); bf16* MQ = (bf16*)(F.ws + WS_MQ); bf16* MK = (bf16*)(F.ws + WS_MK); bf16* MV = (bf16*)(F.ws + WS_MV);
  const int pos = MPOS0 + mrow;
  {
    const float v0 = PM[1024 + w * 128 + lane] * rs, v1 = PM[1024 + w * 128 + lane + 64] * rs;
    const float rk = rsqrtf(wave_sum(v0 * v0 + v1 * v1) * (1.0f / 128.f) + EPS);
    const float* kg = a.in[IN_KNG];
    const unsigned short o0 = (unsigned short)f2bf(v0 * rk * kg[lane]), o1 = (unsigned short)f2bf(v1 * rk * kg[lane + 64]);
    for (int b = 0; b < NB; ++b) { const int bhm = (b * 4 + (w >> 1)) * 2 + (w & 1); Kp[kp_off(bhm, pos, lane)] = o0; Kp[kp_off(bhm, pos, lane + 64)] = o1; }
  }
  { const int c = tid * 2;
    const unsigned o = pk2(PM[2048 + c] * rs, PM[2048 + c + 1] * rs); const int h = c >> 8, e = c & 255;
    for (int b = 0; b < NB; ++b) *(unsigned*)(Vp + ((size_t)(b * 4 + h) * PADT + pos) * 256 + e) = o;
    const unsigned o2 = pk2(PM[3072 + c] * rs, PM[3072 + c + 1] * rs); const bool isk = c >= 512; const int cc = c & 511, hq = cc >> 7, d = cc & 127;
    for (int b = 0; b < NB; ++b) *(unsigned*)((isk ? MK : MQ) + ((size_t)(b * 4 + hq) * PADT + pos) * 128 + d) = o2;
    const unsigned o3 = pk2(PM[4096 + c] * rs, PM[4096 + c + 1] * rs);
    for (int b = 0; b < NB; ++b) *(unsigned*)(MV + ((size_t)(b * 4 + h) * PADT + pos) * 256 + e) = o3;
  }
  __syncthreads();
}

namespace att {
using f32x16 = __attribute__((ext_vector_type(16))) float;
using s16x4 = __attribute__((ext_vector_type(4))) short;
constexpr int STEPS_BHM = 152, NSTEPS = 32 * STEPS_BHM;
constexpr int SHM_V = 64 * 256 * 2, SHM_K = 64 * 128 * 2;
constexpr int LDS_V = 0, LDS_K = 2 * SHM_V, LDS_Q = LDS_K + SHM_K, LDS_WS = LDS_Q + 8 * 8192;
constexpr float THR2 = 8.0f;
#define KSWZ(row, colB) ((row) * 256 + ((colB) ^ (((row) & 7) << 4)))
#define SBAR() __builtin_amdgcn_sched_barrier(0)
__device__ __forceinline__ int crow(int r, int hi) { return (r & 3) + 8 * (r >> 2) + 4 * hi; }
__device__ __forceinline__ unsigned cvtpk(float lo, float hi) { unsigned r; asm volatile("v_cvt_pk_bf16_f32 %0, %1, %2" : "=v"(r) : "v"(lo), "v"(hi)); return r; }
__device__ __forceinline__ int qb_start(int qb) { return 2 * qb * qb + 3 * qb; }
__device__ __forceinline__ int chunk_of(int s, int NA) { return ((s + 1) * NA - 1) / NSTEPS; }

template <int OFF> __device__ __forceinline__ s16x4 tr_read(int vb) {
  s16x4 r; asm volatile("ds_read_b64_tr_b16 %0, %1 offset:%2" : "=&v"(r) : "v"(vb), "i"(OFF) : "memory"); return r;
}
constexpr int v_rd_off(int d0, int ks, int half) { return d0 * 512 + ks * 8192 + half * 4096; }
template <int D0> __device__ __forceinline__ void pv_one(f32x16& od, int vb, bf16x8 pa0, bf16x8 pa1, bf16x8 pa2, bf16x8 pa3) {
#define PK(L, H) (bf16x8){L[0], L[1], L[2], L[3], H[0], H[1], H[2], H[3]}
  { const s16x4 l0 = tr_read<v_rd_off(D0, 0, 0)>(vb), h0 = tr_read<v_rd_off(D0, 0, 1)>(vb), l1 = tr_read<v_rd_off(D0, 1, 0)>(vb), h1 = tr_read<v_rd_off(D0, 1, 1)>(vb);
    asm volatile("s_waitcnt lgkmcnt(0)" ::: "memory"); SBAR();
    od = __builtin_amdgcn_mfma_f32_32x32x16_bf16(pa0, PK(l0, h0), od, 0, 0, 0);
    od = __builtin_amdgcn_mfma_f32_32x32x16_bf16(pa1, PK(l1, h1), od, 0, 0, 0); }
  SBAR();
  { const s16x4 l2 = tr_read<v_rd_off(D0, 2, 0)>(vb), h2 = tr_read<v_rd_off(D0, 2, 1)>(vb), l3 = tr_read<v_rd_off(D0, 3, 0)>(vb), h3 = tr_read<v_rd_off(D0, 3, 1)>(vb);
    asm volatile("s_waitcnt lgkmcnt(0)" ::: "memory"); SBAR();
    od = __builtin_amdgcn_mfma_f32_32x32x16_bf16(pa2, PK(l2, h2), od, 0, 0, 0);
    od = __builtin_amdgcn_mfma_f32_32x32x16_bf16(pa3, PK(l3, h3), od, 0, 0, 0); }
#undef PK
}

__device__ __forceinline__ void segment(const Frame& F, int bhm, int qb, int j0, int j1, int slot) {
  const int tid = F.tid, wid = F.wave, lane = F.lane, r32 = lane & 31, hi = lane >> 5;
  const bf16* Qg = (const bf16*)(F.ws + WS_Q) + ((size_t)bhm * SEQ + qb * 256 + wid * 32 + r32) * 128 + hi * 8;
  const bf16* Kg = (const bf16*)(F.ws + WS_KP) + (size_t)bhm * 33 * 8192;
  const bf16* Vg = (const bf16*)(F.ws + WS_VP) + (size_t)(bhm >> 1) * PADT * 256;
  LAS unsigned char* lds = F.lds;
  LAS float* wsl = (LAS float*)(lds + LDS_WS) + wid * 64;
  const float slope2 = exp2f(-2.0f * (float)(((bhm >> 1) & 3) + 1)) * LOG2E;
  unsigned ksrc0, vsrc0;
  ksrc0 = (unsigned)tid * 16u;
  { const int a8 = tid >> 8, b = (tid >> 2) & 7, k = 8 * (b >> 2) + 4 * a8 + (b & 3), c = ((tid >> 5) & 7) * 32 + (tid & 3) * 8; vsrc0 = (unsigned)(k * 256 + c) * 2u; }
#define STAGE_K(j) do { const char* kt = (const char*)(Kg + (size_t)(j) * 8192); \
    _Pragma("unroll") for (int _i = 0; _i < 2; ++_i) __builtin_amdgcn_global_load_lds((const unsigned*)(kt + (ksrc0 + _i * 8192u)), (LAS unsigned*)(lds + LDS_K + _i * 8192 + wid * 1024), 16, 0, 0); } while (0)
#define STAGE_V(buf, j) do { const char* vt = (const char*)(Vg + (size_t)(j) * 64 * 256); \
    _Pragma("unroll") for (int _i = 0; _i < 4; ++_i) __builtin_amdgcn_global_load_lds((const unsigned*)(vt + (vsrc0 + _i * 8192u)), (LAS unsigned*)(lds + LDS_V + (buf) * SHM_V + _i * 8192 + wid * 1024), 16, 0, 0); } while (0)
  const int lt = (((r32 << 1) | hi) ^ ((r32 >> 3) & 1)) << 4;
  LAS unsigned char* Qs = lds + LDS_Q + wid * 8192;
#pragma unroll
  for (int d0 = 0; d0 < 8; ++d0) { const bf16x8 qv = *(const bf16x8*)(Qg + d0 * 16); *(LAS bf16x8*)(Qs + d0 * 1024 + lt) = qv; }
  const float hioff = slope2 * (float)(4 * hi);
  f32x16 o[8];
#pragma unroll
  for (int d = 0; d < 8; ++d)
#pragma unroll
    for (int r = 0; r < 16; ++r) o[d][r] = 0.f;
  float m_reg = -1e30f, l_reg = 0.f;
  const int vb0 = (int)(uintptr_t)(lds + LDS_V) + (((lane & 3) << 3) | (((lane >> 2) & 3) << 6) | (((lane >> 4) & 1) << 5) | (((lane >> 5) & 1) << 8));
  const int qrel = wid * 32 + r32;
  STAGE_K(j0); STAGE_V(0, j0);
  VM_WAIT(); __syncthreads();
  for (int j = j0; j < j1; ++j) {
    const int cur = (j - j0) & 1;
    if (j + 1 < j1) STAGE_V(cur ^ 1, j + 1);
    SBAR();
    f32x16 p0 = {}, p1 = {};
    { const LAS unsigned char* Ks = lds + LDS_K;
#pragma unroll
      for (int d0 = 0; d0 < 8; ++d0) {
        const bf16x8 b0 = *(const LAS bf16x8*)(Ks + d0 * 2048 + lt);
        const bf16x8 b1 = *(const LAS bf16x8*)(Ks + d0 * 2048 + 1024 + lt);
        const bf16x8 qf = *(const LAS bf16x8*)(Qs + d0 * 1024 + lt);
        p0 = __builtin_amdgcn_mfma_f32_32x32x16_bf16(b0, qf, p0, 0, 0, 0);
        p1 = __builtin_amdgcn_mfma_f32_32x32x16_bf16(b1, qf, p1, 0, 0, 0); } }
    asm volatile("s_waitcnt lgkmcnt(0)" ::: "memory"); __builtin_amdgcn_s_barrier(); asm volatile("" ::: "memory");
    if (j + 1 < j1) STAGE_K(j + 1);
    SBAR();
    if (j == 0) {
#pragma unroll
      for (int r = 0; r < 16; ++r) p0[r] = -INFINITY;
#pragma unroll
      for (int r = 0; r < 8; ++r) p1[r] = -INFINITY;
    }
    const int jb = j - (4 * qb + 1);
    if (jb >= 0) {
      const int kb = 64 * jb + 4 * hi;
#pragma unroll
      for (int r = 0; r < 16; ++r) { const int kv = kb + (r & 3) + 8 * (r >> 2); if (kv > qrel) p0[r] = -INFINITY; if (kv + 32 > qrel) p1[r] = -INFINITY; }
    }
    const float off0 = slope2 * (float)(64 * j) + hioff, off1 = off0 + 32.0f * slope2;
#pragma unroll
    for (int r = 0; r < 16; ++r) { const float sb = slope2 * (float)((r & 3) + 8 * (r >> 2)); p0[r] += sb; p1[r] += sb; }
    float pm0 = p0[0], pm1 = p1[0];
#pragma unroll
    for (int r = 1; r < 16; ++r) { pm0 = fmaxf(pm0, p0[r]); pm1 = fmaxf(pm1, p1[r]); }
    float pmax = fmaxf(pm0 + off0, pm1 + off1);
    { auto rr = __builtin_amdgcn_permlane32_swap(__float_as_uint(pmax), __float_as_uint(pmax), false, false);
      pmax = fmaxf(__uint_as_float(rr[0]), __uint_as_float(rr[1])); }
    float mn, alpha;
    if (__builtin_expect(__all(pmax - m_reg <= THR2), 1)) { mn = m_reg; alpha = 1.f; }
    else { mn = fmaxf(m_reg, pmax); alpha = __builtin_amdgcn_exp2f(m_reg - mn); m_reg = mn; }
    const float c0 = off0 - mn, c1 = off1 - mn;
    float ps = 0.f;
#pragma unroll
    for (int r = 0; r < 16; ++r) { p0[r] = __builtin_amdgcn_exp2f(p0[r] + c0); p1[r] = __builtin_amdgcn_exp2f(p1[r] + c1); ps += p0[r] + p1[r]; }
    { auto rr = __builtin_amdgcn_permlane32_swap(__float_as_uint(ps), __float_as_uint(ps), false, false);
      ps = __uint_as_float(rr[0]) + __uint_as_float(rr[1]); }
    l_reg = l_reg * alpha + ps;
    if (__any(alpha < 1.f)) { if (hi == 0) wsl[r32] = alpha; asm volatile("s_waitcnt lgkmcnt(0)" ::: "memory");
#pragma unroll
      for (int rg = 0; rg < 4; ++rg) { const f32x4 al = *(const LAS f32x4*)(wsl + 8 * rg + 4 * hi);
#pragma unroll
        for (int d = 0; d < 8; ++d) { o[d][4 * rg + 0] *= al.x; o[d][4 * rg + 1] *= al.y; o[d][4 * rg + 2] *= al.z; o[d][4 * rg + 3] *= al.w; }
        SBAR(); } }
    bf16x8 pa0, pa1, pa2, pa3;
#define PK4(P, BASE, OUT) do { unsigned a0 = cvtpk(P[BASE + 0], P[BASE + 1]), a1 = cvtpk(P[BASE + 2], P[BASE + 3]);   \
    unsigned b0 = cvtpk(P[BASE + 4], P[BASE + 5]), b1 = cvtpk(P[BASE + 6], P[BASE + 7]);                              \
    auto r0 = __builtin_amdgcn_permlane32_swap(a0, b0, false, false); auto r1 = __builtin_amdgcn_permlane32_swap(a1, b1, false, false); \
    v4u w = {r0[0], r1[0], r0[1], r1[1]}; OUT = *reinterpret_cast<bf16x8*>(&w); } while (0)
    PK4(p0, 0, pa0); PK4(p0, 8, pa1); PK4(p1, 0, pa2); PK4(p1, 8, pa3);
#undef PK4
    SBAR();
    { const int vb = vb0 + cur * SHM_V;
      pv_one<0>(o[0], vb, pa0, pa1, pa2, pa3); pv_one<1>(o[1], vb, pa0, pa1, pa2, pa3); pv_one<2>(o[2], vb, pa0, pa1, pa2, pa3); pv_one<3>(o[3], vb, pa0, pa1, pa2, pa3);
      pv_one<4>(o[4], vb, pa0, pa1, pa2, pa3); pv_one<5>(o[5], vb, pa0, pa1, pa2, pa3); pv_one<6>(o[6], vb, pa0, pa1, pa2, pa3); pv_one<7>(o[7], vb, pa0, pa1, pa2, pa3); }
    VM_WAIT(); __syncthreads();
  }
  { int lane2 = threadIdx.x & 63, slot2 = slot; asm volatile("" : "+v"(lane2), "+s"(slot2));
    const int r32e = lane2 & 31, hie = lane2 >> 5;
    float* PO = (float*)(F.ws + WS_PO) + (size_t)slot2 * 256 * 256; float* ML = (float*)(F.ws + WS_ML) + (size_t)slot2 * 512;
    LAS float* wse = (LAS float*)(F.lds + LDS_WS) + wid * 64;
    if (hie == 0) { wse[r32e] = l_reg; ML[(wid * 32 + r32e) * 2] = m_reg; ML[(wid * 32 + r32e) * 2 + 1] = l_reg; }
    asm volatile("s_waitcnt lgkmcnt(0)" ::: "memory");
    char* Ob = (char*)(PO + (size_t)(wid * 32) * 256);
    const unsigned lo = (unsigned)(4 * hie * 256 + r32e) * 4u;
#pragma unroll
    for (int r = 0; r < 16; ++r) { const int rowc = (r & 3) + 8 * (r >> 2); const float lv = wse[rowc + 4 * hie]; const float rl = lv > 0.f ? __builtin_amdgcn_rcpf(lv) : 0.f;
#pragma unroll
      for (int d0 = 0; d0 < 8; ++d0) *(float*)(Ob + (lo + (unsigned)(rowc * 256 + d0 * 32) * 4u)) = o[d0][r] * rl;
      SBAR(); } }
  __syncthreads();
#undef STAGE_K
#undef STAGE_V
}

__device__ __forceinline__ void phase(const Frame& F, int ca, int NA) {
  int s0 = (int)(((long)ca * NSTEPS) / NA); const int s1 = (int)(((long)(ca + 1) * NSTEPS) / NA);
  while (s0 < s1) {
    const int bhm = s0 / STEPS_BHM, rem = s0 - bhm * STEPS_BHM;
    int qb = 0;
#pragma unroll 1
    for (int q = 1; q < 8; ++q) if (rem >= qb_start(q)) qb = q;
    const int j0 = rem - qb_start(qb), nst = 4 * qb + 5;
    const int j1 = (j0 + (s1 - s0) < nst) ? j0 + (s1 - s0) : nst;
    const int slot = bhm * 16 + qb + chunk_of(s0, NA) - chunk_of(bhm * STEPS_BHM, NA);
    segment(F, bhm, qb, j0, j1, slot);
    s0 += j1 - j0;
  }
}
#undef KSWZ
#undef SBAR
}
namespace ml {
constexpr int QST = 136, TST = 72;
constexpr int L_RQ = 0, L_RK = 17152, L_QS = 34304, L_QW = 51712, L_KS = 69120, L_KWT = 86528, L_VT = 104960, L_SP = 123392, L_G = 132608, L_CW = 134656, L_N = 139776;
constexpr int G_A = 0, G_M = 64, G_WI = 128, G_EM = 192, G_DEN = 256, G_WG = 320, G_SC = 384;
__device__ __forceinline__ float shfl_up_f(float v, int d) { return __shfl_up(v, d); }

__device__ __forceinline__ void item(const Frame& F, const Args& a, int it) {
  const int b = it >> 3, h = (it >> 1) & 3, dvh = it & 1, tid = F.tid, w = F.wave, lane = F.lane, fr = lane & 15, kq = lane >> 4;
  LAS unsigned char* lds = F.lds;
  LAS float* G = (LAS float*)(lds + L_G); LAS float* CW = (LAS float*)(lds + L_CW);
  const bf16* MQg = (const bf16*)(F.ws + WS_MQ) + (size_t)(b * 4 + h) * PADT * 128;
  const bf16* MKg = (const bf16*)(F.ws + WS_MK) + (size_t)(b * 4 + h) * PADT * 128;
  const bf16* MVg = (const bf16*)(F.ws + WS_MV) + (size_t)(b * 4 + h) * PADT * 256 + dvh * 128;
  const float* LIg = (const float*)(F.ws + WS_LI) + (b * 4 + h) * PADT; const float* LFg = (const float*)(F.ws + WS_LF) + (b * 4 + h) * PADT;
  float* HMg = (float*)(F.ws + WS_HM) + (size_t)b * SEQ * 1024 + h * 256 + dvh * 128 + 16 * w + fr;
  for (int e = tid; e < 2 * 5 * 128; e += NTHR) { const int qk = e / 640, j = (e / 128) % 5, d = e & 127; const int ch = qk * 512 + h * 128 + d;
    CW[e] = j < 4 ? a.in[IN_CW][j * 1024 + ch] : a.in[IN_CB][ch]; }
  if (tid < 96) { const int qk = tid / 48, r = (tid % 48) >> 4, ch = tid & 15; *(LAS v4u*)(lds + (qk ? L_RK : L_RQ) + r * 256 + ch * 16) = (v4u){0u, 0u, 0u, 0u}; }
  f32x4 Cacc[8];
  LAS f32x4* NL = (LAS f32x4*)(lds + L_N);
#pragma unroll
  for (int i = 0; i < 8; ++i) { Cacc[i] = (f32x4){0.f, 0.f, 0.f, 0.f}; if (w == 0) NL[i * 64 + lane] = (f32x4){0.f, 0.f, 0.f, 0.f}; }
  float m = 0.f;
  const v4u onesv = fr == 0 ? (v4u){0x3F803F80u, 0x3F803F80u, 0x3F803F80u, 0x3F803F80u} : (v4u){0u, 0u, 0u, 0u};
  const bf16x8 ones = __builtin_bit_cast(bf16x8, onesv);
  v4u pv[2]; float pli = 0.f, plf = 0.f;
#define ML_LOAD(c) do { const int pos0 = 64 * (c); \
    _Pragma("unroll") for (int i = 0; i < 2; ++i) { \
      __builtin_amdgcn_global_load_lds((const unsigned*)((const char*)(MQg + (size_t)pos0 * 128) + i * 8192 + tid * 16), (LAS unsigned*)(lds + L_RQ + 768 + i * 8192 + w * 1024), 16, 0, 0); \
      __builtin_amdgcn_global_load_lds((const unsigned*)((const char*)(MKg + (size_t)pos0 * 128) + i * 8192 + tid * 16), (LAS unsigned*)(lds + L_RK + 768 + i * 8192 + w * 1024), 16, 0, 0); \
      const int p = tid + NTHR * i, row = p >> 4, ch = p & 15; pv[i] = *(const v4u*)(MVg + (size_t)(pos0 + row) * 256 + ch * 8); } \
    if (w == 0) { pli = LIg[pos0 + lane]; plf = LFg[pos0 + lane]; } } while (0)
  ML_LOAD(0);
  VM_WAIT(); __syncthreads();
#pragma unroll 1
  for (int c = 0; c < 33; ++c) {
#pragma unroll
    for (int i = 0; i < 2; ++i) { const int p = tid + NTHR * i, row = p >> 4, ch = p & 15; const bool dead = (c == 0) && (row < MPOS0);
      const v4u z = {0u, 0u, 0u, 0u}; const v4u v4 = dead ? z : pv[i];
      if (dead) { *(LAS v4u*)(lds + L_RQ + (3 + row) * 256 + ch * 16) = z; *(LAS v4u*)(lds + L_RK + (3 + row) * 256 + ch * 16) = z; }
      LAS bf16* vt = (LAS bf16*)(lds + L_VT) + (ch * 8) * TST + row;
      vt[0 * TST] = (bf16)(v4.x & 0xffff); vt[1 * TST] = (bf16)(v4.x >> 16); vt[2 * TST] = (bf16)(v4.y & 0xffff); vt[3 * TST] = (bf16)(v4.y >> 16);
      vt[4 * TST] = (bf16)(v4.z & 0xffff); vt[5 * TST] = (bf16)(v4.z >> 16); vt[6 * TST] = (bf16)(v4.w & 0xffff); vt[7 * TST] = (bf16)(v4.w >> 16); }
    if (w == 0) {
      const bool dead = (c == 0) && (lane < MPOS0);
      const float li = dead ? -1e30f : pli, lf = dead ? 0.f : plf;
      float bs = lf;
#pragma unroll
      for (int d = 1; d < 64; d <<= 1) { const float o = shfl_up_f(bs, d); if (lane >= d) bs += o; }
      const float av = li - bs; float cm = av;
#pragma unroll
      for (int d = 1; d < 64; d <<= 1) { const float o = shfl_up_f(cm, d); if (lane >= d) cm = fmaxf(cm, o); }
      const float Mt = fmaxf(m, cm);
      const float Mend = __shfl(Mt, 63), bL = __shfl(bs, 63);
      G[G_A + lane] = av; G[G_M + lane] = Mt; G[G_WI + lane] = __expf(m - Mt); G[G_EM + lane] = __expf(-(bs + Mt)); G[G_WG + lane] = __expf(av - Mend);
      if (lane == 0) { G[G_SC + 0] = __expf(m - Mend); G[G_SC + 1] = bL + Mend; }
    }
    __syncthreads();
    { const int t = tid >> 3, d0 = (tid & 7) * 16;
      const float wi = G[G_WI + t], wg = G[G_WG + t];
#pragma unroll
      for (int qk = 0; qk < 2; ++qk) {
        float y[16];
#pragma unroll
        for (int e = 0; e < 16; ++e) y[e] = CW[(qk * 5 + 4) * 128 + d0 + e];
#pragma unroll
        for (int j = 0; j < 4; ++j) { const LAS v4u* rp = (const LAS v4u*)(lds + (qk ? L_RK : L_RQ) + (t + j) * 256 + d0 * 2); const v4u r0 = rp[0], r1 = rp[1];
          const LAS float* cw = CW + (qk * 5 + j) * 128 + d0;
          y[0] += cw[0] * bflo(r0.x); y[1] += cw[1] * bfhi(r0.x); y[2] += cw[2] * bflo(r0.y); y[3] += cw[3] * bfhi(r0.y); y[4] += cw[4] * bflo(r0.z); y[5] += cw[5] * bfhi(r0.z); y[6] += cw[6] * bflo(r0.w); y[7] += cw[7] * bfhi(r0.w);
          y[8] += cw[8] * bflo(r1.x); y[9] += cw[9] * bfhi(r1.x); y[10] += cw[10] * bflo(r1.y); y[11] += cw[11] * bfhi(r1.y); y[12] += cw[12] * bflo(r1.z); y[13] += cw[13] * bfhi(r1.z); y[14] += cw[14] * bflo(r1.w); y[15] += cw[15] * bfhi(r1.w); }
#pragma unroll
        for (int e = 0; e < 16; ++e) y[e] = y[e] / (1.0f + __expf(-y[e]));
        if (qk == 0) {
          v4u o0, o1, w0, w1;
          o0.x = pk2(y[0], y[1]); o0.y = pk2(y[2], y[3]); o0.z = pk2(y[4], y[5]); o0.w = pk2(y[6], y[7]); o1.x = pk2(y[8], y[9]); o1.y = pk2(y[10], y[11]); o1.z = pk2(y[12], y[13]); o1.w = pk2(y[14], y[15]);
          w0.x = pk2(y[0] * wi, y[1] * wi); w0.y = pk2(y[2] * wi, y[3] * wi); w0.z = pk2(y[4] * wi, y[5] * wi); w0.w = pk2(y[6] * wi, y[7] * wi);
          w1.x = pk2(y[8] * wi, y[9] * wi); w1.y = pk2(y[10] * wi, y[11] * wi); w1.z = pk2(y[12] * wi, y[13] * wi); w1.w = pk2(y[14] * wi, y[15] * wi);
          LAS v4u* qs = (LAS v4u*)(lds + L_QS + (t * QST + d0) * 2); qs[0] = o0; qs[1] = o1;
          LAS v4u* qw = (LAS v4u*)(lds + L_QW + (t * QST + d0) * 2); qw[0] = w0; qw[1] = w1;
        } else {
          const float sc = 0.08838834764831845f;
          v4u o0, o1;
          o0.x = pk2(y[0] * sc, y[1] * sc); o0.y = pk2(y[2] * sc, y[3] * sc); o0.z = pk2(y[4] * sc, y[5] * sc); o0.w = pk2(y[6] * sc, y[7] * sc);
          o1.x = pk2(y[8] * sc, y[9] * sc); o1.y = pk2(y[10] * sc, y[11] * sc); o1.z = pk2(y[12] * sc, y[13] * sc); o1.w = pk2(y[14] * sc, y[15] * sc);
          LAS v4u* ks = (LAS v4u*)(lds + L_KS + (t * QST + d0) * 2); ks[0] = o0; ks[1] = o1;
          LAS bf16* kt = (LAS bf16*)(lds + L_KWT) + d0 * TST + t; const float sw = sc * wg;
#pragma unroll
          for (int e = 0; e < 16; ++e) kt[e * TST] = (bf16)f2bf(y[e] * sw);
        }
        __builtin_amdgcn_sched_barrier(0);
      }
    }
    __syncthreads();
    { const int si = w >> 1;
      const f32x4 as = *(const LAS f32x4*)(G + G_A + 16 * si + 4 * kq);
#pragma unroll
      for (int tt = 0; tt < 2; ++tt) { const int ti = 2 * (w & 1) + tt; f32x4 acc = {0.f, 0.f, 0.f, 0.f};
#pragma unroll
        for (int ks = 0; ks < 4; ++ks) { const bf16x8 af = *(const LAS bf16x8*)(lds + L_KS + ((16 * si + fr) * QST + 32 * ks + 8 * kq) * 2);
          const bf16x8 bfr = *(const LAS bf16x8*)(lds + L_QS + ((16 * ti + fr) * QST + 32 * ks + 8 * kq) * 2);
          acc = __builtin_amdgcn_mfma_f32_16x16x32_bf16(af, bfr, acc, 0, 0, 0); }
        const int t = 16 * ti + fr, s0 = 16 * si + 4 * kq; const float Mt = G[G_M + t];
        const float v0 = (s0 + 0 <= t) ? acc.x * __expf(as.x - Mt) : 0.f, v1 = (s0 + 1 <= t) ? acc.y * __expf(as.y - Mt) : 0.f;
        const float v2 = (s0 + 2 <= t) ? acc.z * __expf(as.z - Mt) : 0.f, v3 = (s0 + 3 <= t) ? acc.w * __expf(as.w - Mt) : 0.f;
        v2u o; o.x = pk2(v0, v1); o.y = pk2(v2, v3);
        *(LAS v2u*)(lds + L_SP + (t * TST + s0) * 2) = o; } }
    if (tid < 96) { const int qk = tid / 48, r = (tid % 48) >> 4, ch = tid & 15; LAS unsigned char* base = lds + (qk ? L_RK : L_RQ);
      const v4u hv = *(const LAS v4u*)(base + (64 + r) * 256 + ch * 16); *(LAS v4u*)(base + r * 256 + ch * 16) = hv; }
    __syncthreads();
    if (c + 1 < 33) ML_LOAD(c + 1);
    f32x4 acc[4], accn[4];
#pragma unroll
    for (int ti = 0; ti < 4; ++ti) { acc[ti] = (f32x4){0.f, 0.f, 0.f, 0.f}; accn[ti] = (f32x4){0.f, 0.f, 0.f, 0.f}; }
#pragma unroll
    for (int I = 0; I < 4; ++I) {
      v4u bc; bc.x = pk2(Cacc[2 * I][0], Cacc[2 * I][1]); bc.y = pk2(Cacc[2 * I][2], Cacc[2 * I][3]); bc.z = pk2(Cacc[2 * I + 1][0], Cacc[2 * I + 1][1]); bc.w = pk2(Cacc[2 * I + 1][2], Cacc[2 * I + 1][3]);
      v4u bn = {0u, 0u, 0u, 0u}; if (w == 0) { const f32x4 n0 = NL[(2 * I) * 64 + lane], n1 = NL[(2 * I + 1) * 64 + lane]; bn.x = pk2(n0.x, n0.y); bn.y = pk2(n0.z, n0.w); bn.z = pk2(n1.x, n1.y); bn.w = pk2(n1.z, n1.w); }
#pragma unroll
      for (int ti = 0; ti < 4; ++ti) { const LAS unsigned char* qp = lds + L_QW + ((16 * ti + fr) * QST + 32 * I + 4 * kq) * 2;
        const v2u a0 = *(const LAS v2u*)qp, a1 = *(const LAS v2u*)(qp + 32); const v4u av = {a0.x, a0.y, a1.x, a1.y};
        acc[ti] = __builtin_amdgcn_mfma_f32_16x16x32_bf16(__builtin_bit_cast(bf16x8, av), __builtin_bit_cast(bf16x8, bc), acc[ti], 0, 0, 0);
        if (w == 0) accn[ti] = __builtin_amdgcn_mfma_f32_16x16x32_bf16(__builtin_bit_cast(bf16x8, av), __builtin_bit_cast(bf16x8, bn), accn[ti], 0, 0, 0); }
      __builtin_amdgcn_sched_barrier(0);
    }
    bf16x8 bv[2];
#pragma unroll
    for (int ks = 0; ks < 2; ++ks) { bv[ks] = *(const LAS bf16x8*)(lds + L_VT + ((16 * w + fr) * TST + 32 * ks + 8 * kq) * 2);
#pragma unroll
      for (int ti = 0; ti < 4; ++ti) { const bf16x8 sf = *(const LAS bf16x8*)(lds + L_SP + ((16 * ti + fr) * TST + 32 * ks + 8 * kq) * 2);
        acc[ti] = __builtin_amdgcn_mfma_f32_16x16x32_bf16(sf, bv[ks], acc[ti], 0, 0, 0);
        if (w == 0) accn[ti] = __builtin_amdgcn_mfma_f32_16x16x32_bf16(sf, ones, accn[ti], 0, 0, 0); } }
    if (w == 0 && fr == 0) {
#pragma unroll
      for (int ti = 0; ti < 4; ++ti) *(LAS f32x4*)(G + G_DEN + 16 * ti + 4 * kq) = accn[ti]; }
    { const float decay = G[G_SC + 0];
#pragma unroll
      for (int i = 0; i < 8; ++i) { Cacc[i] = Cacc[i] * decay; f32x4 nn = {0.f, 0.f, 0.f, 0.f}; if (w == 0) nn = NL[i * 64 + lane] * decay;
#pragma unroll
        for (int ks = 0; ks < 2; ++ks) { const bf16x8 kf = *(const LAS bf16x8*)(lds + L_KWT + ((16 * i + fr) * TST + 32 * ks + 8 * kq) * 2);
          Cacc[i] = __builtin_amdgcn_mfma_f32_16x16x32_bf16(kf, bv[ks], Cacc[i], 0, 0, 0);
          if (w == 0) nn = __builtin_amdgcn_mfma_f32_16x16x32_bf16(kf, ones, nn, 0, 0, 0); }
        if (w == 0) NL[i * 64 + lane] = nn;
        if (i & 1) __builtin_amdgcn_sched_barrier(0); }
      m = G[G_SC + 1]; }
    __syncthreads();
    if (c >= 1) {
#pragma unroll
      for (int ti = 0; ti < 4; ++ti) { const f32x4 dn = *(const LAS f32x4*)(G + G_DEN + 16 * ti + 4 * kq), em = *(const LAS f32x4*)(G + G_EM + 16 * ti + 4 * kq);
        float* hp = HMg + (size_t)(64 * (c - 1) + 16 * ti + 4 * kq) * 1024;
        hp[0] = acc[ti].x / fmaxf(fabsf(dn.x), em.x); hp[1024] = acc[ti].y / fmaxf(fabsf(dn.y), em.y); hp[2048] = acc[ti].z / fmaxf(fabsf(dn.z), em.z); hp[3072] = acc[ti].w / fmaxf(fabsf(dn.w), em.w); }
    }
    VM_WAIT(); __syncthreads();
  }
#undef ML_LOAD
}
}
__device__ __forceinline__ void p3_combine(const Frame& F, const Args& a, int NA) {
  const float* PO = (const float*)(F.ws + WS_PO); const float* ML = (const float*)(F.ws + WS_ML); const float* HM = (const float*)(F.ws + WS_HM);
  const bf16* MO = (const bf16*)(F.ws + WS_MO); bf16* A2 = (bf16*)(F.ws + WS_A2);
  const float lam = *(const float*)(F.ws + WS_LAM);
  const float* subg = a.in[IN_SUBG]; const float* og = a.in[IN_OUTG];
  const int gw = blockIdx.x * NWAVES + F.wave, NGW = gridDim.x * NWAVES, lane = F.lane;
  const f32x4 sg = ((const f32x4*)subg)[lane];
  for (int R = gw; R < MROWS; R += NGW) {
    const int b = R >> 11, t = R & 2047, qb = t >> 8, rq = t & 255;
#pragma unroll 1
    for (int h = 0; h < 4; ++h) {
      f32x4 om[2];
#pragma unroll
      for (int m = 0; m < 2; ++m) {
        const int bhm = (b * 4 + h) * 2 + m, first = bhm * att::STEPS_BHM + att::qb_start(qb), last = first + 4 * qb + 4;
        const int cf = att::chunk_of(first, NA), np = att::chunk_of(last, NA) - cf + 1, slot0 = bhm * 16 + qb + cf - att::chunk_of(bhm * att::STEPS_BHM, NA);
        float mp[3], lp[3]; f32x4 op[3];
#pragma unroll
        for (int p = 0; p < 3; ++p) { if (p < np) { const int slot = slot0 + p; mp[p] = ML[(size_t)slot * 512 + rq * 2]; lp[p] = ML[(size_t)slot * 512 + rq * 2 + 1];
            op[p] = ((const f32x4*)(PO + ((size_t)slot * 256 + rq) * 256))[lane]; } else { mp[p] = -1e30f; lp[p] = 0.f; op[p] = (f32x4){0.f, 0.f, 0.f, 0.f}; } }
        const float M = fmaxf(mp[0], fmaxf(mp[1], mp[2]));
        float wsum = 0.f; f32x4 acc = (f32x4){0.f, 0.f, 0.f, 0.f};
#pragma unroll
        for (int p = 0; p < 3; ++p) { const float w = lp[p] * exp2f(mp[p] - M); wsum += w; acc += op[p] * w; }
        om[m] = acc * (1.0f / wsum);
      }
      const f32x4 o = om[0] - om[1] * lam;
      const float rs = rsqrtf(wave_sum((o.x * o.x + o.y * o.y) + (o.z * o.z + o.w * o.w)) * (1.0f / 256.f) + EPS) * 0.8f;
      v2u w; w.x = pk2(o.x * rs * sg.x, o.y * rs * sg.y); w.y = pk2(o.z * rs * sg.z, o.w * rs * sg.w);
      ((v2u*)(A2 + (size_t)R * DM + h * 256))[lane] = w;
      const f32x4 hv = ((const f32x4*)(HM + (size_t)R * 1024 + h * 256))[lane];
      const float rh = rsqrtf(wave_sum((hv.x * hv.x + hv.y * hv.y) + (hv.z * hv.z + hv.w * hv.w)) * (1.0f / 256.f) + EPS);
      const f32x4 g = ((const f32x4*)(og + h * 256))[lane];
      const v2u mo = ((const v2u*)(MO + (size_t)R * 1024 + h * 256))[lane];
      v2u w2; w2.x = pk2(hv.x * rh * g.x * bflo(mo.x), hv.y * rh * g.y * bfhi(mo.x)); w2.y = pk2(hv.z * rh * g.z * bflo(mo.y), hv.w * rh * g.w * bfhi(mo.y));
      ((v2u*)(A2 + (size_t)R * DM + 1024 + h * 256))[lane] = w2;
    }
  }
}
struct EpiRes {
  static constexpr bool PERM = true, AFTER_DRAIN = false;
  const float* x; float* out; bf16* H1b; float* SSQ;
  __device__ __forceinline__ void operator()(const pg8::f32x4 (&acc)[2][2][4][2], const pg8::Unit& u, int wr, int wc, int fr, int fq) const {
    const int row0 = u.pm * 256 + wr * 64 + fr, col0 = u.pn * 256 + wc * 32 + 8 * fq;
#pragma unroll
    for (int ai = 0; ai < 2; ++ai)
#pragma unroll
      for (int m = 0; m < 4; ++m) { const size_t R = (size_t)(row0 + ai * 128 + m * 16); float s = 0.f;
#pragma unroll
        for (int bj = 0; bj < 2; ++bj) { const size_t off = R * DM + col0 + bj * 128;
          const f32x4 x0 = *(const f32x4*)(x + off), x1 = *(const f32x4*)(x + off + 4);
          const f32x4 v0 = acc[ai][bj][m][0] + x0, v1 = acc[ai][bj][m][1] + x1;
          *(f32x4*)(out + off) = v0; *(f32x4*)(out + off + 4) = v1;
          v4u w; w.x = pk2(v0.x, v0.y); w.y = pk2(v0.z, v0.w); w.z = pk2(v1.x, v1.y); w.w = pk2(v1.z, v1.w);
          *(v4u*)(H1b + off) = w;
          s += (v0.x * v0.x + v0.y * v0.y) + (v0.z * v0.z + v0.w * v0.w) + (v1.x * v1.x + v1.y * v1.y) + (v1.z * v1.z + v1.w * v1.w); }
        s += __shfl_xor(s, 16); s += __shfl_xor(s, 32);
        if (fq == 0) SSQ[R * 32 + u.pn * 4 + wc] = s; }
  }
};
typedef __bf16 bfv2 __attribute__((ext_vector_type(2)));
__device__ __forceinline__ void split_hl(const f32x4 a, const f32x4 b, bf16x8& hi, bf16x8& lo) {
  float v[8] = {a.x, a.y, a.z, a.w, b.x, b.y, b.z, b.w}; unsigned h[8], l[8];
#pragma unroll
  for (int i = 0; i < 8; ++i) { h[i] = f2bf(v[i]); l[i] = f2bf(v[i] - __builtin_bit_cast(float, h[i] << 16)); }
  v4u hv = {h[0] | (h[1] << 16), h[2] | (h[3] << 16), h[4] | (h[5] << 16), h[6] | (h[7] << 16)};
  v4u lv = {l[0] | (l[1] << 16), l[2] | (l[3] << 16), l[4] | (l[5] << 16), l[6] | (l[7] << 16)};
  hi = __builtin_bit_cast(bf16x8, hv); lo = __builtin_bit_cast(bf16x8, lv);
}
__device__ __forceinline__ void p0_w3t(const Frame& F, const Args& a) {
  const float* wq = a.in[IN_WQ]; const float* sk = a.in[IN_SUBK]; const float* g2 = a.in[IN_G2];
  bf16* W3t = (bf16*)(F.ws + WS_W3T);
  const int gw = blockIdx.x * NWAVES + F.wave, NGW = gridDim.x * NWAVES, lane = F.lane, fr = lane & 15, fq = lane >> 4;
  for (int task = gw; task < 128 * 16; task += NGW) {
    const int kt = task >> 4, hh = task & 15;
    bf16x8 ahi[4], alo[4];
    const float* ap = wq + (size_t)(kt * 16 + fr) * DM + hh * 128 + fq * 8;
#pragma unroll
    for (int s = 0; s < 4; ++s) split_hl(*(const f32x4*)(ap + 32 * s), *(const f32x4*)(ap + 32 * s + 4), ahi[s], alo[s]);
    const f32x4 gk = *(const f32x4*)(g2 + kt * 16 + fq * 4);
#pragma unroll 1
    for (int t2 = 0; t2 < 8; ++t2) {
      const float* bp = sk + (size_t)(hh * 128 + t2 * 16 + fr) * 128 + fq * 8;
      f32x4 acc = {0.f, 0.f, 0.f, 0.f};
#pragma unroll
      for (int s = 0; s < 4; ++s) { bf16x8 bhi, blo; split_hl(*(const f32x4*)(bp + 32 * s), *(const f32x4*)(bp + 32 * s + 4), bhi, blo);
        acc = __builtin_amdgcn_mfma_f32_16x16x32_bf16(ahi[s], bhi, acc, 0, 0, 0);
        acc = __builtin_amdgcn_mfma_f32_16x16x32_bf16(ahi[s], blo, acc, 0, 0, 0);
        acc = __builtin_amdgcn_mfma_f32_16x16x32_bf16(alo[s], bhi, acc, 0, 0, 0); }
      v2u o; o.x = pk2(acc.x * gk.x, acc.y * gk.y); o.y = pk2(acc.z * gk.z, acc.w * gk.w);
      *(v2u*)(W3t + (size_t)(hh * 128 + t2 * 16 + fr) * DM + kt * 16 + fq * 4) = o;
    }
  }
}
__device__ __forceinline__ void p0_tables(const Frame& F, const Args& a) {
  const float* U = a.in[IN_U]; const float* V = a.in[IN_V]; const float* g2 = a.in[IN_G2];
  bf16* Ub = (bf16*)(F.ws + WS_UB); bf16* Vb = (bf16*)(F.ws + WS_VB);
  const size_t n8 = (size_t)16384 * DM / 8, stride = (size_t)gridDim.x * NTHR;
  for (size_t i = (size_t)blockIdx.x * NTHR + F.tid; i < n8; i += stride) {
    const int k8 = (int)(i & 255) * 8;
    const f32x4 g0 = *(const f32x4*)(g2 + k8), g1 = *(const f32x4*)(g2 + k8 + 4);
    const f32x4 u0 = *(const f32x4*)(U + i * 8), u1 = *(const f32x4*)(U + i * 8 + 4);
    const f32x4 v0 = *(const f32x4*)(V + i * 8), v1 = *(const f32x4*)(V + i * 8 + 4);
    v4u ou, ov;
    ou.x = pk2(u0.x * g0.x, u0.y * g0.y); ou.y = pk2(u0.z * g0.z, u0.w * g0.w); ou.z = pk2(u1.x * g1.x, u1.y * g1.y); ou.w = pk2(u1.z * g1.z, u1.w * g1.w);
    ov.x = pk2(v0.x, v0.y); ov.y = pk2(v0.z, v0.w); ov.z = pk2(v1.x, v1.y); ov.w = pk2(v1.z, v1.w);
    *(v4u*)(Ub + i * 8) = ou; *(v4u*)(Vb + i * 8) = ov;
  }
}
struct EpiScore {
  static constexpr bool PERM = true, AFTER_DRAIN = false;
  float* S; const LAS float* rs;
  __device__ __forceinline__ void operator()(const pg8::f32x4 (&acc)[2][2][4][2], const pg8::Unit& u, int wr, int wc, int fr, int fq) const {
    const int rl0 = wr * 64 + fr, col0 = u.pn * 256 + wc * 32 + 8 * fq;
#pragma unroll
    for (int ai = 0; ai < 2; ++ai)
#pragma unroll
      for (int m = 0; m < 4; ++m) { const int rl = rl0 + ai * 128 + m * 16; const float r = rs[rl]; const size_t R = (size_t)u.pm * 256 + rl;
#pragma unroll
        for (int bj = 0; bj < 2; ++bj) { float* d = S + R * DM + col0 + bj * 128;
          *(f32x4*)d = acc[ai][bj][m][0] * r; *(f32x4*)(d + 4) = acc[ai][bj][m][1] * r; } }
  }
};

__device__ __forceinline__ unsigned fkey(float f) { const unsigned b = __builtin_bit_cast(unsigned, f); return b ^ ((b >> 31) ? 0xFFFFFFFFu : 0x80000000u); }
template <int NV, int K> __device__ __forceinline__ void wave_topk(const unsigned (&u)[NV], bool (&sel)[NV], int lane) {
  unsigned prefix = 0u; int cge = NV * 64;
#pragma unroll 1
  for (int bit = 31; bit >= 0 && cge != K; --bit) {
    const unsigned cand = prefix | (1u << bit); int c = 0;
#pragma unroll
    for (int i = 0; i < NV; ++i) c += __builtin_popcountll(__ballot(u[i] >= cand));
    if (c >= K) { prefix = cand; cge = c; }
  }
  int cgt = 0;
#pragma unroll
  for (int i = 0; i < NV; ++i) cgt += __builtin_popcountll(__ballot(u[i] > prefix));
  int need = K - cgt;
  const unsigned long long lm = (1ull << lane) - 1ull;
#pragma unroll
  for (int i = 0; i < NV; ++i) { const unsigned long long eq = __ballot(u[i] == prefix); const int before = __builtin_popcountll(eq & lm);
    sel[i] = (u[i] > prefix) || (u[i] == prefix && before < need); const int ne = __builtin_popcountll(eq); need = need > ne ? need - ne : 0; }
}
__device__ __forceinline__ float gelu_erf(float x) { return 0.5f * x * (1.0f + erff(x * 0.70710678118654752f)); }

__device__ __forceinline__ void p6_peer(const Frame& F, const Args& a) {
  const float* S = (const float*)(F.ws + WS_S); const float* SSQ = (const float*)(F.ws + WS_SSQ); const bf16* H1b = (const bf16*)(F.ws + WS_H1B);
  const bf16* Ub = (const bf16*)(F.ws + WS_UB); const bf16* Vb = (const bf16*)(F.ws + WS_VB); float* out = a.out;
  const int lane = F.lane, gw = blockIdx.x * NWAVES + F.wave, NGW = gridDim.x * NWAVES;
  LAS float* wl = (LAS float*)(F.lds + F.wave * 2048);
  LAS int* wli = (LAS int*)wl;
  for (int tok = gw; tok < MROWS; tok += NGW) {
    const float rs = rsqrtf(wave_sum(lane < 32 ? SSQ[(size_t)tok * 32 + lane] : 0.f) * (1.0f / DM) + EPS);
    const float* srow = S + (size_t)tok * DM;
#ifdef PEER_IDS_FROM_GLOBAL
    { const int* gi = (const int*)(F.ws + (size_t)372 * MiB) + (size_t)tok * 128; const float* gg = (const float*)(F.ws + (size_t)376 * MiB) + (size_t)tok * 128;
      wli[128 + lane] = gi[lane]; wli[128 + 64 + lane] = gi[64 + lane]; wl[256 + lane] = gg[lane]; wl[256 + 64 + lane] = gg[64 + lane];
      asm volatile("s_waitcnt lgkmcnt(0)" ::: "memory"); }
#pragma unroll 1
    for (int h8 = 0; h8 < 0; ++h8) {
#else
#pragma unroll 1
    for (int h8 = 0; h8 < 8; ++h8) {
#endif
#pragma unroll
      for (int p = 0; p < 2; ++p) {
        const float2 sv = *(const float2*)(srow + (h8 * 2 + p) * 128 + 2 * lane);
        unsigned u[2] = {fkey(sv.x), fkey(sv.y)}; bool sel[2];
        wave_topk<2, 16>(u, sel, lane);
        const unsigned long long m0 = __ballot(sel[0]), m1 = __ballot(sel[1]); const unsigned long long lm = (1ull << lane) - 1ull;
        const int pos0 = __builtin_popcountll(m0 & lm), pos1 = __builtin_popcountll(m0) + __builtin_popcountll(m1 & lm);
        if (sel[0]) { wl[p * 16 + pos0] = sv.x; wli[64 + p * 16 + pos0] = 2 * lane; }
        if (sel[1]) { wl[p * 16 + pos1] = sv.y; wli[64 + p * 16 + pos1] = 2 * lane + 1; }
      }
      asm volatile("s_waitcnt lgkmcnt(0)" ::: "memory");
      const int ci = lane >> 2, cj = 4 * (lane & 3);
      const float s0 = wl[ci]; const f32x4 s1 = *(const LAS f32x4*)(wl + 16 + cj);
      float cv[4] = {s0 + s1.x, s0 + s1.y, s0 + s1.z, s0 + s1.w};
      unsigned cu[4] = {fkey(cv[0]), fkey(cv[1]), fkey(cv[2]), fkey(cv[3])}; bool csel[4];
      wave_topk<4, 16>(cu, csel, lane);
      float mx = -INFINITY;
#pragma unroll
      for (int q = 0; q < 4; ++q) if (csel[q]) mx = fmaxf(mx, cv[q]);
#pragma unroll
      for (int o = 1; o < 64; o <<= 1) mx = fmaxf(mx, __shfl_xor(mx, o));
      float ev[4], es = 0.f;
#pragma unroll
      for (int q = 0; q < 4; ++q) { ev[q] = csel[q] ? __expf(cv[q] - mx) : 0.f; es += ev[q]; }
      es = wave_sum(es); const float inv = 1.0f / es;
      const int ki = wli[64 + ci]; typedef int i32x4 __attribute__((ext_vector_type(4))); const i32x4 kj = *(const LAS i32x4*)(wli + 64 + 16 + cj);
      const int kjv[4] = {kj.x, kj.y, kj.z, kj.w};
      int base = 0; const unsigned long long lm = (1ull << lane) - 1ull;
#pragma unroll
      for (int q = 0; q < 4; ++q) { const unsigned long long mq = __ballot(csel[q]); const int pos = base + __builtin_popcountll(mq & lm);
        if (csel[q]) { wli[128 + h8 * 16 + pos] = ki * 128 + kjv[q]; wl[256 + h8 * 16 + pos] = ev[q] * inv; } base += __builtin_popcountll(mq); }
      asm volatile("s_waitcnt lgkmcnt(0)" ::: "memory");
    }
    v4u xr[4];
#pragma unroll
    for (int i = 0; i < 4; ++i) xr[i] = ((const v4u*)(H1b + (size_t)tok * DM))[i * 64 + lane];
    float y[32];
#pragma unroll
    for (int i = 0; i < 32; ++i) y[i] = 0.f;
#pragma unroll 1
    for (int e0 = 0; e0 < 128; e0 += 2) {
      const int id0 = __builtin_amdgcn_readfirstlane(wli[128 + e0]), id1 = __builtin_amdgcn_readfirstlane(wli[128 + e0 + 1]);
      const float g0 = wl[256 + e0], g1 = wl[256 + e0 + 1];
      v4u ur0[4], ur1[4], vr0[4], vr1[4];
#pragma unroll
      for (int i = 0; i < 4; ++i) { ur0[i] = ((const v4u*)(Ub + (size_t)id0 * DM))[i * 64 + lane]; ur1[i] = ((const v4u*)(Ub + (size_t)id1 * DM))[i * 64 + lane]; }
#pragma unroll
      for (int i = 0; i < 4; ++i) { vr0[i] = ((const v4u*)(Vb + (size_t)id0 * DM))[i * 64 + lane]; vr1[i] = ((const v4u*)(Vb + (size_t)id1 * DM))[i * 64 + lane]; }
      float d0 = 0.f, d1 = 0.f;
#pragma unroll
      for (int i = 0; i < 4; ++i)
#pragma unroll
        for (int c = 0; c < 4; ++c) { const unsigned xa = xr[i][c], ua = ur0[i][c], ub = ur1[i][c];
          d0 = __builtin_amdgcn_fdot2_f32_bf16(__builtin_bit_cast(bfv2, xa), __builtin_bit_cast(bfv2, ua), d0, false);
          d1 = __builtin_amdgcn_fdot2_f32_bf16(__builtin_bit_cast(bfv2, xa), __builtin_bit_cast(bfv2, ub), d1, false); }
      d0 = wave_sum(d0); d1 = wave_sum(d1);
      const float a0 = gelu_erf(d0 * rs) * g0, a1 = gelu_erf(d1 * rs) * g1;
#pragma unroll
      for (int i = 0; i < 4; ++i)
#pragma unroll
        for (int c = 0; c < 4; ++c) { y[i * 8 + 2 * c] += a0 * bflo(vr0[i][c]) + a1 * bflo(vr1[i][c]); y[i * 8 + 2 * c + 1] += a0 * bfhi(vr0[i][c]) + a1 * bfhi(vr1[i][c]); }
    }
    float* orow = out + (size_t)tok * DM;
#pragma unroll
    for (int i = 0; i < 4; ++i) { f32x4* p = (f32x4*)(orow + (size_t)(i * 64 + lane) * 8);
      f32x4 h0 = p[0], h1 = p[1];
      h0.x += y[i * 8 + 0]; h0.y += y[i * 8 + 1]; h0.z += y[i * 8 + 2]; h0.w += y[i * 8 + 3]; h1.x += y[i * 8 + 4]; h1.y += y[i * 8 + 5]; h1.z += y[i * 8 + 6]; h1.w += y[i * 8 + 7];
      p[0] = h0; p[1] = h1; }
  }
}
constexpr int MISC_LDS = LDS_BYTES - 256;
__global__ void __launch_bounds__(NTHR, 2) mk_fwd(Args args) {
  extern __shared__ __attribute__((aligned(16))) unsigned char lds_raw[];
  Frame F; F.lds = (LAS unsigned char*)lds_raw; F.ws = args.ws; F.tid = threadIdx.x; F.lane = F.tid & 63; F.wave = __builtin_amdgcn_readfirstlane(F.tid >> 6);
  const int lo = args.ph_lo, hi = args.ph_hi, G = (int)gridDim.x, bx = (int)blockIdx.x;
  volatile LAS unsigned* misc = (volatile LAS unsigned*)(F.lds + MISC_LDS);
  if (F.tid < 16) misc[F.tid] = 0u;
  __syncthreads();
  XcdBarrier bar = xcd_barrier_post((unsigned*)(F.ws + WS_CTL) + CW_BAR, misc);
#define IN(k) (lo <= (k) && (k) < hi)
#define SEAM(k) do { if (IN(k) && IN((k) + 1)) xcd_barrier(bar); } while (0)
  const bool split = (G % 8 == 0) && (G >= 64);
  const int NA = split ? G - 32 : G;
  if (IN(0)) {
    p0_lam(F, args);
    p0_zero_vpad(F);
    p0_metaproj(F, args);
    p0_rows(F, args);
    p0_transpose(F, args.in[IN_WIN], DPROJ, NPROJ, (bf16*)(F.ws + WS_W1T));
    p0_transpose(F, args.in[IN_WOUT], DM, DM, (bf16*)(F.ws + WS_W2T));
    p0_w3t(F, args);
    p0_tables(F, args);
  }
  SEAM(0);
  if (IN(1)) {
    p1_meta_finalize(F, args);
    pg8::Gemm g{(const pg8::bf16_t*)(F.ws + WS_XN), (const pg8::bf16_t*)(F.ws + WS_W1T), MROWS, NPROJ, DM};
    pg8::StaticOrder S; S.init(MROWS, NPROJ, G, bx);
    EpiProj E{(bf16*)(F.ws + WS_Q), (bf16*)(F.ws + WS_KP), (bf16*)(F.ws + WS_VP), (bf16*)(F.ws + WS_MQ), (bf16*)(F.ws + WS_MK), (bf16*)(F.ws + WS_MV), (bf16*)(F.ws + WS_MO),
              args.in[IN_QNG], args.in[IN_KNG], (LAS float*)(F.lds + XCH_OFF)};
    pg8::gemm_phase<EpiProj, pg8::StaticOrder, true, true>(F.lds + RING_OFF, g, S, E);
  }
  SEAM(1);
  if (IN(2)) {
    if (split) {
      const int rowi = bx >> 3, xc = bx & 7, na8 = NA >> 3;
      if (rowi >= na8) ml::item(F, args, (rowi - na8) * 8 + xc);
      else att::phase(F, xc * na8 + rowi, NA);
    } else {
      att::phase(F, bx, NA);
      for (int it = bx; it < 32; it += G) ml::item(F, args, it);
    }
  }
  SEAM(2);
  if (IN(3)) p3_combine(F, args, NA);
  SEAM(3);
  if (IN(4)) {
    pg8::Gemm g{(const pg8::bf16_t*)(F.ws + WS_A2), (const pg8::bf16_t*)(F.ws + WS_W2T), MROWS, DM, DM};
    pg8::StaticOrder S; S.init(MROWS, DM, G, bx);
    EpiRes E{args.in[IN_X], args.out, (bf16*)(F.ws + WS_H1B), (float*)(F.ws + WS_SSQ)};
    pg8::gemm_phase<EpiRes, pg8::StaticOrder, true, true>(F.lds + RING_OFF, g, S, E);
  }
  SEAM(4);
  if (IN(5)) {
    pg8::Gemm g{(const pg8::bf16_t*)(F.ws + WS_H1B), (const pg8::bf16_t*)(F.ws + WS_W3T), MROWS, DM, DM};
    pg8::StaticOrder S; S.init(MROWS, DM, G, bx);
    LAS float* rst = (LAS float*)(F.lds + XCH_OFF);
    { pg8::Unit u0; if (S.next(0, u0)) { if (F.tid < 256) { const float* sp = (const float*)(F.ws + WS_SSQ) + ((size_t)u0.pm * 256 + F.tid) * 32; float s = 0.f;
#pragma unroll
          for (int i = 0; i < 8; ++i) { const f32x4 v = ((const f32x4*)sp)[i]; s += (v.x + v.y) + (v.z + v.w); }
          rst[F.tid] = rsqrtf(s * (1.0f / DM) + EPS); } } }
    __syncthreads();
    EpiScore E{(float*)(F.ws + WS_S), rst};
    pg8::gemm_phase<EpiScore, pg8::StaticOrder, true, true>(F.lds + RING_OFF, g, S, E);
  }
  SEAM(5);
  if (IN(6)) p6_peer(F, args);
#undef IN
#undef SEAM
}
extern "C" void kernel_launch(void* const* d_in, const int* in_sizes, int n_in, void* d_out, int out_size, void* d_ws, size_t ws_size, hipStream_t stream) {
  static int grid = 0;
  if (grid == 0) {
    int dev = 0, cus = 0, per_cu = 0;
    if (hipGetDevice(&dev) != hipSuccess || hipDeviceGetAttribute(&cus, hipDeviceAttributeMultiprocessorCount, dev) != hipSuccess) { fprintf(stderr, "device query failed\n"); grid = -1; return; }
    if (hipFuncSetAttribute((const void*)mk_fwd, hipFuncAttributeMaxDynamicSharedMemorySize, LDS_BYTES) != hipSuccess) { fprintf(stderr, "hipFuncSetAttribute failed\n"); grid = -1; return; }
    if (hipOccupancyMaxActiveBlocksPerMultiprocessor(&per_cu, (const void*)mk_fwd, NTHR, LDS_BYTES) != hipSuccess || per_cu < 1) { fprintf(stderr, "occupancy query says %d workgroups per CU: not launching\n", per_cu); (void)hipGetLastError(); grid = -1; return; }
    (void)hipGetLastError();
    grid = cus;
    if (n_in != 22 || ws_size < (size_t)512 * MiB || out_size != MROWS * DM) { fprintf(stderr, "unexpected shapes: n_in %d out %d ws %zu\n", n_in, out_size, ws_size); grid = -1; return; }
  }
  if (grid < 0) return;
  unsigned char* ws = (unsigned char*)d_ws;
  if (hipMemsetAsync(ws + WS_CTL, 0, CTL_ZERO_BYTES, stream) != hipSuccess) { fprintf(stderr, "memset failed\n"); return; }
  Args a{};
  for (int i = 0; i < 22; ++i) a.in[i] = (const float*)d_in[i];
  a.out = (float*)d_out; a.ws = ws; a.na = 0; a.pad = 0;
  a.ph_lo = 0; a.ph_hi = 7;
  hipLaunchKernelGGL(mk_fwd, dim3(grid), dim3(NTHR), LDS_BYTES, stream, a);
}
```

```cpp
#include <hip/hip_runtime.h>
#include <cstdio>
#include <cstdint>
#include <math.h>
namespace pg8 {
#define PG8_LAS __attribute__((address_space(3)))
typedef unsigned short bf16_t;
typedef short bf16x8 __attribute__((ext_vector_type(8)));
typedef float f32x4 __attribute__((ext_vector_type(4)));
typedef unsigned u32x4 __attribute__((ext_vector_type(4)));
constexpr int BM = 256, BK = 64, HALF = 128, HTB = HALF * BK * 2  , STAGE_BYTES = 8 * HTB, NXCD = 8, WGM = 8;

__host__ __device__ __forceinline__ int lds_byte(int r, int c) { const int st = (r >> 4) * 2 + (c >> 5), rr = r & 15, cc = c & 31, ob = rr * 64 + cc * 2; return st * 1024 + (ob ^ (((ob >> 9) & 1) << 5)); }
__host__ __device__ __forceinline__ void stage_rc(int b, int& R, int& C) { const int st = b / 1024, sb = b % 1024, swz = sb ^ (((sb >> 9) & 1) << 5); R = (st >> 1) * 16 + swz / 64; C = (st & 1) * 32 + (swz % 64) / 2; }
__host__ __device__ __forceinline__ int perm32(int rho) { const int n = rho >> 4, i = rho & 15; return 8 * (i >> 2) + 4 * n + (i & 3); }

struct Unit { int pm, pn; };
struct Gemm { const bf16_t* A; const bf16_t* Bt; int M, N, K; };

struct StaticOrder {
    int nM, nN, nwg, G, c;
    __host__ __device__ void init(int M, int N, int G_, int c_) { nM = M / BM; nN = N / BM; nwg = nM * nN; G = G_; c = c_; }
    __host__ __device__ bool next(int i, Unit& u) const {
        const long L = (long)i * G + c; if (L >= nwg) return false;
        int wgid = (int)L; { const int q = nwg / NXCD, r = nwg % NXCD, xcd = wgid % NXCD, off = wgid / NXCD; wgid = (xcd < r ? xcd * (q + 1) : r * (q + 1) + (xcd - r) * q) + off; }
        const int nig = WGM * nN, gid = wgid / nig, fm = gid * WGM, gsz = (nM - fm) < WGM ? (nM - fm) : WGM;
        u.pm = fm + ((wgid % nig) % gsz); u.pn = (wgid % nig) / gsz; return true;
    }
    __device__ __forceinline__ void a_ready(const Unit&) const {}
    __device__ __forceinline__ void done(const Unit&) const {}
};

__device__ __forceinline__ unsigned cvt_pk_bf16(float lo, float hi) { unsigned r; asm volatile("v_cvt_pk_bf16_f32 %0, %1, %2" : "=v"(r) : "v"(lo), "v"(hi)); return r; }
typedef float f32x2 __attribute__((ext_vector_type(2)));
template <class Epi, class Sched, bool ALIGN_EPI = false, bool SP2 = false>
__device__ __forceinline__ void gemm_phase(PG8_LAS unsigned char* lds, const Gemm g, const Sched& S, const Epi& E) {
    const int tid = threadIdx.x, wid = __builtin_amdgcn_readfirstlane(tid >> 6), lane = tid & 63, wr = wid >> 2, wc = wid & 3, fr = lane & 15, fq = lane >> 4;
    const int K = g.K, nt = K / BK;
    unsigned voffA[2], voffB[2];
#pragma unroll
    for (int i = 0; i < 2; ++i) { int R, C; stage_rc(tid * 16 + i * 8192, R, C); const int Rb = Epi::PERM ? ((R & ~31) + perm32(R & 31)) : R;
        voffA[i] = (unsigned)(R * K + C) * 2u; voffB[i] = (unsigned)(Rb * K + C) * 2u; }
    const size_t kstep = (size_t)(BK * 2);
    const size_t hstep = (size_t)HALF * K * 2;
    const size_t tstep = 2 * hstep;
    const unsigned ldsw = (unsigned)wid * 1024u;
    const int aoff = lds_byte(wr * 64 + fr, fq * 8), boff = lds_byte(wc * 32 + fr, fq * 8);
#define PG8_SA(b, h) (((b) * 2 + (h)) * HTB)
#define PG8_SB(b, h) ((4 + (b) * 2 + (h)) * HTB)
#define PG8_STAGE(bufoff, gbase, voff) do { _Pragma("unroll") for (int _i = 0; _i < 2; ++_i) \
        __builtin_amdgcn_global_load_lds((const unsigned*)((const char*)(gbase) + (voff)[_i]), (PG8_LAS unsigned*)(lds + (bufoff) + ldsw + _i * 8192), 16, 0, 0); } while (0)
#define PG8_LDA(dst, b, h) do { _Pragma("unroll") for (int m = 0; m < 4; ++m) _Pragma("unroll") for (int k = 0; k < 2; ++k) dst[m][k] = *(const PG8_LAS bf16x8*)(lds + PG8_SA(b, h) + aoff + m * 2048 + k * 1024); } while (0)
#define PG8_LDB(dst, b, h) do { _Pragma("unroll") for (int n = 0; n < 2; ++n) _Pragma("unroll") for (int k = 0; k < 2; ++k) dst[n][k] = *(const PG8_LAS bf16x8*)(lds + PG8_SB(b, h) + boff + n * 2048 + k * 1024); } while (0)
#define PG8_MMA(ai, bj, At, Bt) do { __builtin_amdgcn_s_setprio(1); _Pragma("unroll") for (int m = 0; m < 4; ++m) _Pragma("unroll") for (int n = 0; n < 2; ++n) _Pragma("unroll") for (int k = 0; k < 2; ++k) \
        acc[ai][bj][m][n] = __builtin_amdgcn_mfma_f32_16x16x32_bf16(Bt[n][k], At[m][k], acc[ai][bj][m][n], 0, 0, 0); __builtin_amdgcn_s_setprio(0); } while (0)
#define PG8_WAIT_V(n) asm volatile("s_waitcnt vmcnt(" #n ")" ::: "memory")
#define PG8_WAIT_L(n) asm volatile("s_waitcnt lgkmcnt(" #n ")" ::: "memory")
#define PG8_BAR __builtin_amdgcn_s_barrier()
#define PG8_SCHED __builtin_amdgcn_sched_barrier(0)
    Unit cur, nxt; int ui = 0;
    if (!S.next(0, cur)) return;
    f32x4 acc[2][2][4][2];
#pragma unroll
    for (int a = 0; a < 2; ++a)
#pragma unroll
        for (int b = 0; b < 2; ++b)
#pragma unroll
            for (int m = 0; m < 4; ++m)
#pragma unroll
                for (int n = 0; n < 2; ++n) acc[a][b][m][n] = (f32x4){0.f, 0.f, 0.f, 0.f};
    bf16x8 At[4][2], B0[2][2], B1[2][2];
    const char* cA = (const char*)g.A + (size_t)cur.pm * tstep; const char* cB = (const char*)g.Bt + (size_t)cur.pn * tstep;
    S.a_ready(cur);
    if constexpr (SP2) {
        PG8_STAGE(PG8_SB(0, 0), cB, voffB); PG8_STAGE(PG8_SB(0, 1), cB + hstep, voffB); PG8_STAGE(PG8_SA(0, 0), cA, voffA); PG8_STAGE(PG8_SA(0, 1), cA + hstep, voffA);
        if (wr == 1) PG8_BAR;
        PG8_WAIT_V(2); PG8_BAR;
        PG8_STAGE(PG8_SB(1, 0), cB + kstep, voffB); PG8_STAGE(PG8_SA(1, 0), cA + kstep, voffA); PG8_STAGE(PG8_SB(1, 1), cB + hstep + kstep, voffB);
        PG8_WAIT_V(6); PG8_BAR;
    } else {
        PG8_STAGE(PG8_SB(0, 0), cB, voffB); PG8_STAGE(PG8_SA(0, 0), cA, voffA); PG8_STAGE(PG8_SB(0, 1), cB + hstep, voffB); PG8_STAGE(PG8_SA(0, 1), cA + hstep, voffA);
        if (wr == 1) PG8_BAR;
        PG8_WAIT_V(4); PG8_BAR;
        PG8_STAGE(PG8_SB(1, 0), cB + kstep, voffB); PG8_STAGE(PG8_SA(1, 0), cA + kstep, voffA); PG8_STAGE(PG8_SB(1, 1), cB + hstep + kstep, voffB);
        PG8_WAIT_V(6); PG8_BAR;
    }
    for (;;) {
        const bool has_next = S.next(ui + 1, nxt);
        const char* nA = has_next ? (const char*)g.A + (size_t)nxt.pm * tstep : cA; const char* nB = has_next ? (const char*)g.Bt + (size_t)nxt.pn * tstep : cB;
        for (int t = 0; t < nt; t += 2) {
            const bool last = (t == nt - 2);
            const char* a1 = cA + (size_t)(t + 1) * kstep;
            const char* a2 = last ? nA : cA + (size_t)(t + 2) * kstep; const char* b2 = last ? nB : cB + (size_t)(t + 2) * kstep;
            const char* a3 = a2 + kstep; const char* b3 = b2 + kstep;
            if (last && has_next) S.a_ready(nxt);
            if constexpr (SP2) {
            PG8_LDB(B0, 0, 0); PG8_LDB(B1, 0, 1); PG8_SCHED; PG8_LDA(At, 0, 0); PG8_STAGE(PG8_SA(1, 1), a1 + hstep, voffA);
            PG8_WAIT_V(8); PG8_WAIT_L(0); PG8_BAR; PG8_MMA(0, 0, At, B0); PG8_MMA(0, 1, At, B1); PG8_BAR; PG8_SCHED;
            PG8_LDA(At, 0, 1); PG8_STAGE(PG8_SB(0, 0), b2, voffB); PG8_STAGE(PG8_SB(0, 1), b2 + hstep, voffB); PG8_STAGE(PG8_SA(0, 0), a2, voffA);
            PG8_WAIT_V(8); PG8_WAIT_L(0); PG8_BAR; PG8_MMA(1, 0, At, B0); PG8_MMA(1, 1, At, B1); PG8_BAR; PG8_SCHED;
            PG8_LDB(B0, 1, 0); PG8_LDB(B1, 1, 1); PG8_SCHED; PG8_LDA(At, 1, 0); PG8_STAGE(PG8_SA(0, 1), a2 + hstep, voffA);
            PG8_WAIT_V(8); PG8_WAIT_L(0); PG8_BAR; PG8_MMA(0, 0, At, B0); PG8_MMA(0, 1, At, B1); PG8_BAR; PG8_SCHED;
            PG8_LDA(At, 1, 1); PG8_STAGE(PG8_SB(1, 0), b3, voffB); PG8_STAGE(PG8_SB(1, 1), b3 + hstep, voffB); PG8_STAGE(PG8_SA(1, 0), a3, voffA);
            PG8_WAIT_V(8); PG8_WAIT_L(0); PG8_BAR; PG8_MMA(1, 0, At, B0); PG8_MMA(1, 1, At, B1); PG8_BAR; PG8_SCHED;
            } else {
            PG8_LDB(B0, 0, 0); PG8_SCHED; PG8_LDA(At, 0, 0); PG8_STAGE(PG8_SA(1, 1), a1 + hstep, voffA);
            PG8_WAIT_L(8); PG8_BAR; PG8_WAIT_L(0); PG8_MMA(0, 0, At, B0); PG8_BAR; PG8_SCHED;
            PG8_LDB(B1, 0, 1); PG8_STAGE(PG8_SB(0, 0), b2, voffB);
            PG8_BAR; PG8_WAIT_L(0); PG8_MMA(0, 1, At, B1); PG8_BAR;
            PG8_LDA(At, 0, 1); PG8_STAGE(PG8_SA(0, 0), a2, voffA);
            PG8_BAR; PG8_WAIT_L(0); PG8_MMA(1, 0, At, B0); PG8_BAR; PG8_SCHED;
            PG8_STAGE(PG8_SB(0, 1), b2 + hstep, voffB);
            PG8_WAIT_V(6); PG8_BAR; PG8_MMA(1, 1, At, B1); PG8_BAR;
            PG8_LDB(B0, 1, 0); PG8_SCHED; PG8_LDA(At, 1, 0); PG8_STAGE(PG8_SA(0, 1), a2 + hstep, voffA);
            PG8_WAIT_L(8); PG8_BAR; PG8_WAIT_L(0); PG8_MMA(0, 0, At, B0); PG8_BAR; PG8_SCHED;
            PG8_LDB(B1, 1, 1); PG8_STAGE(PG8_SB(1, 0), b3, voffB);
            PG8_BAR; PG8_WAIT_L(0); PG8_MMA(0, 1, At, B1); PG8_BAR;
            PG8_LDA(At, 1, 1); PG8_STAGE(PG8_SA(1, 0), a3, voffA);
            PG8_BAR; PG8_WAIT_L(0); PG8_MMA(1, 0, At, B0); PG8_BAR; PG8_SCHED;
            PG8_STAGE(PG8_SB(1, 1), b3 + hstep, voffB);
            PG8_WAIT_V(6); PG8_BAR; PG8_MMA(1, 1, At, B1); PG8_BAR;
            }
        }
        if constexpr (ALIGN_EPI) { if (wr == 0) PG8_BAR; }
        if constexpr (!Epi::AFTER_DRAIN) { E(acc, cur, wr, wc, fr, fq); S.done(cur); }
        if (!has_next) break;
#pragma unroll
        for (int a = 0; a < 2; ++a)
#pragma unroll
            for (int b = 0; b < 2; ++b)
#pragma unroll
                for (int m = 0; m < 4; ++m)
#pragma unroll
                    for (int n = 0; n < 2; ++n) acc[a][b][m][n] = (f32x4){0.f, 0.f, 0.f, 0.f};
        cur = nxt; cA = nA; cB = nB; ++ui;
        if constexpr (ALIGN_EPI) { if (wr == 1) PG8_BAR; }
    }
    PG8_WAIT_V(0);
    if constexpr (!ALIGN_EPI) { if (wr == 0) PG8_BAR; }
    PG8_BAR;
    if constexpr (Epi::AFTER_DRAIN) { E.fused(acc, cur, wr, wc, fr, fq, lds, wid, lane); S.done(cur); }
#undef PG8_SA
#undef PG8_SB
#undef PG8_STAGE
#undef PG8_LDA
#undef PG8_LDB
#undef PG8_MMA
#undef PG8_WAIT_V
#undef PG8_WAIT_L
#undef PG8_BAR
#undef PG8_SCHED
}
}
#define GAS __attribute__((address_space(1)))
#define LAS __attribute__((address_space(3)))
typedef unsigned short bf16;
typedef unsigned v4u __attribute__((ext_vector_type(4)));
typedef unsigned v2u __attribute__((ext_vector_type(2)));
typedef float f32x4 __attribute__((ext_vector_type(4)));
typedef short bf16x8 __attribute__((ext_vector_type(8)));
#define LDS_WAIT() asm volatile("s_waitcnt lgkmcnt(0)" ::: "memory")
#define VM_WAIT() asm volatile("s_waitcnt vmcnt(0)" ::: "memory")

constexpr int DM = 2048, NB = 4, SEQ = 2048, NMETA = 16, MROWS = NB * SEQ, DPROJ = 6152, NPROJ = 6144;
constexpr int PADT = 2112, POS0 = 64, MPOS0 = 48;
constexpr float EPS = 1e-6f;
constexpr float LOG2E = 1.4426950408889634f;
constexpr float QSCALE = 0.08838834764831845f * LOG2E;
constexpr int NWAVES = 8, NTHR = 512;

constexpr size_t MiB = 1u << 20;
constexpr size_t WS_CTL = 0, CTL_ZERO_BYTES = 1 * MiB;
constexpr size_t WS_PM = 512 * 1024;
constexpr size_t WS_W1T = 2 * MiB, WS_W2T = 26 * MiB, WS_W3T = 34 * MiB, WS_XN = 42 * MiB;
constexpr size_t WS_Q = 74 * MiB, WS_KP = 90 * MiB, WS_VP = 107 * MiB, WS_MQ = 124 * MiB, WS_MK = 133 * MiB, WS_MV = 142 * MiB, WS_MO = 159 * MiB;
constexpr size_t WS_SMALL = 175 * MiB;
constexpr size_t WS_XM = WS_SMALL, WS_LI = WS_SMALL + 128 * 1024, WS_LF = WS_SMALL + 384 * 1024, WS_LAM = WS_SMALL + 640 * 1024;
constexpr size_t WS_PO = 176 * MiB, WS_ML = 304 * MiB, WS_HM = 305 * MiB, WS_A2 = 42 * MiB, WS_H1B = 74 * MiB, WS_SSQ = 106 * MiB, WS_S = 176 * MiB, WS_UB = 384 * MiB, WS_VB = 448 * MiB;
constexpr size_t WS_SCL = WS_SMALL + 704 * 1024;
constexpr size_t WS_VB8 = WS_UB + 32 * MiB;
constexpr int CW_BAR = 4096;

constexpr int RING_OFF = 0, RING_BYTES = 131072;
constexpr int XCH_OFF = 131072;
constexpr int MISC_OFF = XCH_OFF + 8192;
constexpr int LDS_BYTES = 155648;

__device__ __forceinline__ unsigned f2bf(float f) { unsigned u = __builtin_bit_cast(unsigned, f); return (u + 0x7fffu + ((u >> 16) & 1u)) >> 16; }
__device__ __forceinline__ unsigned pk2(float lo, float hi) { return f2bf(lo) | (f2bf(hi) << 16); }
__device__ __forceinline__ float bf2f(unsigned short u) { return __builtin_bit_cast(float, (unsigned)u << 16); }
__device__ __forceinline__ float bflo(unsigned w) { return __builtin_bit_cast(float, w << 16); }
__device__ __forceinline__ float bfhi(unsigned w) { return __builtin_bit_cast(float, w & 0xffff0000u); }
__device__ __forceinline__ float wave_sum(float v) {
#pragma unroll
  for (int o = 1; o < 64; o <<= 1) v += __shfl_xor(v, o);
  return v;
}
__device__ __forceinline__ size_t kp_off(int bhm, int pos, int d) { const int j = pos >> 6, row = pos & 63, d0 = d >> 4, hi = (d >> 3) & 1;
  return ((size_t)(bhm * 33 + j) * 8 + d0) * 1024 + (size_t)((((row << 1) | hi) ^ ((row >> 3) & 1)) << 3) + (d & 7); }
__device__ __forceinline__ float sigmoidf_(float x) { return 1.0f / (1.0f + __expf(-x)); }
#define XB_TMO      128
#define XB_XCNT(j)  (256  + 64 * (j))
#define XB_XSUB(j)  (1280 + 64 * (j))
#define XB_XGEN(j)  (2304 + 64 * (j))
#define XB_TOP      3328
#define XB_TOPGEN   3392
#define XCD_BAR_WORDS 3456
#define XB_SPIN_CAP (1u << 18)

__device__ __forceinline__ unsigned xb_ld(unsigned* p)              { return __hip_atomic_load(p, __ATOMIC_RELAXED, __HIP_MEMORY_SCOPE_AGENT); }
__device__ __forceinline__ unsigned xb_add(unsigned* p, unsigned v) { return __hip_atomic_fetch_add(p, v, __ATOMIC_RELAXED, __HIP_MEMORY_SCOPE_AGENT); }
__device__ __forceinline__ unsigned xb_xcc_id() { return (unsigned)__builtin_amdgcn_s_getreg((3 << 11) | 20) & 0xFu; }
#define XB_SPIN(cond, bar) do { unsigned _sp = 0; while (cond) { __builtin_amdgcn_s_sleep(1); \
    if ((++_sp & 255u) == 0u) { if (xb_ld(&(bar)[XB_TMO])) break; if (_sp > XB_SPIN_CAP) { atomicAdd(&(bar)[XB_TMO], 1u); break; } } } } while (0)

struct XcdBarrier {
    unsigned* bar; unsigned x;
    volatile LAS unsigned* st;
};

__device__ __forceinline__ XcdBarrier xcd_barrier_post(unsigned* bar, volatile LAS unsigned* st) {
    XcdBarrier b; b.bar = bar; b.x = xb_xcc_id(); b.st = st;
    if (threadIdx.x == 0) (void)xb_add(&bar[XB_XCNT(b.x)], 1u);
    return b;
}
__device__ __forceinline__ void xcd_barrier_complete(unsigned* bar, unsigned x, unsigned& nloc, unsigned& nx) {
    const unsigned G = gridDim.x * gridDim.y * gridDim.z;
    unsigned sum, cnt, mine, sp = 0u;
    for (;;) {
        sum = 0u; cnt = 0u; mine = 0u;
#pragma unroll
        for (unsigned j = 0; j < 16; ++j) { const unsigned c = xb_ld(&bar[XB_XCNT(j)]); sum += c; cnt += (c > 0u) ? 1u : 0u; mine = (j == x) ? c : mine; }
        if (sum == G) break;
        __builtin_amdgcn_s_sleep(1);
        if ((++sp & 255u) == 0u) { if (xb_ld(&bar[XB_TMO])) break; if (sp > XB_SPIN_CAP) { atomicAdd(&bar[XB_TMO], 1u); break; } }
    }
    nloc = mine > 0u ? mine : 1u; nx = cnt > 0u ? cnt : 1u;
}

__device__ __forceinline__ void xcd_barrier(const XcdBarrier& b) {
    asm volatile("s_waitcnt vmcnt(0)" ::: "memory");
    __syncthreads();
    if (threadIdx.x == 0) {
        unsigned* bar = b.bar;
        __builtin_amdgcn_s_waitcnt(0);
        unsigned nloc = b.st[0], nx = b.st[1];
        if (nloc == 0u) { xcd_barrier_complete(bar, b.x, nloc, nx); b.st[0] = nloc; b.st[1] = nx; }
        const unsigned old = xb_add(&bar[XB_XSUB(b.x)], 1u);
        const unsigned gen = old / nloc;
        if (old + 1u == (gen + 1u) * nloc) {
            __builtin_amdgcn_fence(__ATOMIC_RELEASE, "agent");
            asm volatile("s_waitcnt vmcnt(0)" ::: "memory");
            const unsigned og = xb_add(&bar[XB_TOP], 1u);
            const unsigned tg = og / nx;
            if (og + 1u == (tg + 1u) * nx) xb_add(&bar[XB_TOPGEN], 1u);
            else XB_SPIN(xb_ld(&bar[XB_TOPGEN]) == tg, bar);
            __builtin_amdgcn_fence(__ATOMIC_ACQUIRE, "agent");
            xb_add(&bar[XB_XGEN(b.x)], 1u);
            asm volatile("s_waitcnt vmcnt(0)" ::: "memory");
        } else {
            XB_SPIN(xb_ld(&bar[XB_XGEN(b.x)]) == gen, bar);
            __builtin_amdgcn_fence(__ATOMIC_ACQUIRE, "agent");
            asm volatile("s_waitcnt vmcnt(0)" ::: "memory");
        }
    }
    __syncthreads();
}

struct Args { const float* in[22]; float* out; unsigned char* ws; int ph_lo, ph_hi, na, pad; };
struct Frame {
  LAS unsigned char* lds; unsigned char* ws; int tid, lane, wave; const float* const* in;
};
#define IN_X 0
#define IN_META 1
#define IN_G1 2
#define IN_WIN 3
#define IN_CW 4
#define IN_CB 5
#define IN_IGB 6
#define IN_FGB 7
#define IN_LQ1 8
#define IN_LK1 9
#define IN_LQ2 10
#define IN_LK2 11
#define IN_QNG 12
#define IN_KNG 13
#define IN_SUBG 14
#define IN_OUTG 15
#define IN_WOUT 16
#define IN_G2 17
#define IN_WQ 18
#define IN_SUBK 19
#define IN_U 20
#define IN_V 21

__device__ __forceinline__ void p0_rows(const Frame& F, const Args& a) {
  const float* x = a.in[IN_X]; const float* meta = a.in[IN_META]; const float* g1 = a.in[IN_G1]; const float* w_in = a.in[IN_WIN];
  const float* igb = a.in[IN_IGB]; const float* fgb = a.in[IN_FGB];
  bf16* Xn = (bf16*)(F.ws + WS_XN); bf16* Xm = (bf16*)(F.ws + WS_XM); float* LI = (float*)(F.ws + WS_LI); float* LF = (float*)(F.ws + WS_LF);
  LAS f32x4* wgl = (LAS f32x4*)(F.lds);
  for (int e = F.tid; e < 4096; e += NTHR) {
    const int ln = e & 63, q = e >> 6, half = q & 1, j = (q >> 1) & 3, i = q >> 3;
    const int k = 4 * (i * 64 + ln) + j;
    wgl[e] = *(const f32x4*)(w_in + (size_t)k * DPROJ + NPROJ + 4 * half);
  }
  __syncthreads();
  const int gw = blockIdx.x * NWAVES + F.wave, NGW = gridDim.x * NWAVES, lane = F.lane;
  for (int task = gw; task < MROWS / 2 + NMETA / 2; task += NGW) {
    const bool ismeta = task >= MROWS / 2;
    const int r0 = ismeta ? (task - MROWS / 2) * 2 : task * 2;
    const float* src0 = (ismeta ? meta : x) + (size_t)r0 * DM;
    float rs[2];
    { float s0 = 0.f, s1 = 0.f;
#pragma unroll 2
      for (int i = 0; i < 8; ++i) { const f32x4 a0 = ((const f32x4*)src0)[i * 64 + lane], a1 = ((const f32x4*)(src0 + DM))[i * 64 + lane];
        s0 += (a0.x * a0.x + a0.y * a0.y) + (a0.z * a0.z + a0.w * a0.w); s1 += (a1.x * a1.x + a1.y * a1.y) + (a1.z * a1.z + a1.w * a1.w); }
      rs[0] = rsqrtf(wave_sum(s0) * (1.0f / DM) + EPS); rs[1] = rsqrtf(wave_sum(s1) * (1.0f / DM) + EPS); }
    float ga[2][8];
#pragma unroll
    for (int rr = 0; rr < 2; ++rr)
#pragma unroll
      for (int g = 0; g < 8; ++g) ga[rr][g] = 0.f;
    bf16* dst0 = (ismeta ? Xm : Xn) + (size_t)r0 * DM;
#pragma unroll 1
    for (int i = 0; i < 8; ++i) {
      const f32x4 g = ((const f32x4*)g1)[i * 64 + lane];
      f32x4 xn[2];
#pragma unroll
      for (int rr = 0; rr < 2; ++rr) { xn[rr] = ((const f32x4*)(src0 + (size_t)rr * DM))[i * 64 + lane] * g * rs[rr];
        v2u o; o.x = pk2(xn[rr].x, xn[rr].y); o.y = pk2(xn[rr].z, xn[rr].w); ((v2u*)(dst0 + (size_t)rr * DM))[i * 64 + lane] = o; }
#pragma unroll
      for (int j = 0; j < 4; ++j) {
        const f32x4 w0 = wgl[((i * 4 + j) * 2 + 0) * 64 + lane], w1 = wgl[((i * 4 + j) * 2 + 1) * 64 + lane];
#pragma unroll
        for (int rr = 0; rr < 2; ++rr) { const float xv = xn[rr][j];
          ga[rr][0] += xv * w0.x; ga[rr][1] += xv * w0.y; ga[rr][2] += xv * w0.z; ga[rr][3] += xv * w0.w;
          ga[rr][4] += xv * w1.x; ga[rr][5] += xv * w1.y; ga[rr][6] += xv * w1.z; ga[rr][7] += xv * w1.w; }
      }
    }
#pragma unroll
    for (int rr = 0; rr < 2; ++rr)
#pragma unroll
      for (int g = 0; g < 8; ++g) ga[rr][g] = wave_sum(ga[rr][g]);
    if (lane < 8) {
      const int rr = lane >> 2, h = lane & 3;
      float gi = 0.f, gf = 0.f;
#pragma unroll
      for (int q = 0; q < 2; ++q)
#pragma unroll
        for (int hh = 0; hh < 4; ++hh) if (q == rr && hh == h) { gi = ga[q][hh]; gf = ga[q][4 + hh]; }
      const float li = gi + igb[h]; const float fx = gf + fgb[h];
      const float lf = fminf(fx, 0.f) - log1pf(__expf(-fabsf(fx)));
      const int R = r0 + rr;
      if (!ismeta) { const int b = R >> 11, t = R & 2047; LI[(b * 4 + h) * PADT + POS0 + t] = li; LF[(b * 4 + h) * PADT + POS0 + t] = lf; }
      else { for (int b = 0; b < NB; ++b) { LI[(b * 4 + h) * PADT + MPOS0 + R] = li; LF[(b * 4 + h) * PADT + MPOS0 + R] = lf; } }
    }
  }
  __syncthreads();
}
__device__ __forceinline__ void p0_metaproj(const Frame& F, const Args& a) {
  const float* meta = a.in[IN_META]; const float* g1 = a.in[IN_G1]; const float* w_in = a.in[IN_WIN];
  float* PM = (float*)(F.ws + WS_PM);
  LAS float* xs = (LAS float*)(F.lds);
  LAS float* part = (LAS float*)(F.lds + 16384);
  const int q = F.tid >> 7, c = F.tid & 127;
  for (int task = blockIdx.x; task < NPROJ / 128; task += gridDim.x) {
    const int n = task * 128 + c;
    float acc[16];
#pragma unroll
    for (int m = 0; m < 16; ++m) acc[m] = 0.f;
#pragma unroll 1
    for (int kb = 0; kb < 8; ++kb) {
      __syncthreads();
#pragma unroll
      for (int i = 0; i < 8; ++i) { const int idx = F.tid + NTHR * i, qq = idx >> 10, kk = (idx >> 4) & 63, m = idx & 15; const int k = 512 * qq + 64 * kb + kk;
        xs[idx] = meta[(size_t)m * DM + k] * g1[k]; }
      __syncthreads();
#pragma unroll 4
      for (int kk = 0; kk < 64; ++kk) {
        const float w = w_in[(size_t)(512 * q + 64 * kb + kk) * DPROJ + n];
        const LAS f32x4* xp = (const LAS f32x4*)(xs + (q * 64 + kk) * 16);
#pragma unroll
        for (int t = 0; t < 4; ++t) { const f32x4 xv = xp[t]; acc[4 * t + 0] += xv.x * w; acc[4 * t + 1] += xv.y * w; acc[4 * t + 2] += xv.z * w; acc[4 * t + 3] += xv.w * w; }
      }
    }
#pragma unroll
    for (int m = 0; m < 16; ++m) part[(q * 16 + m) * 128 + c] = acc[m];
    __syncthreads();
    for (int e = F.tid; e < 16 * 128; e += NTHR) { const int m = e >> 7, cc = e & 127;
      PM[m * NPROJ + task * 128 + cc] = (part[(0 * 16 + m) * 128 + cc] + part[(1 * 16 + m) * 128 + cc]) + (part[(2 * 16 + m) * 128 + cc] + part[(3 * 16 + m) * 128 + cc]); }
  }
  __syncthreads();
}
__device__ __forceinline__ void p0_transpose(const Frame& F, const float* W, int ldw, int N, bf16* Wt) {
  LAS float* tl = (LAS float*)(F.lds);
  const int ntn = N / 64, ntask = ntn * 16;
  for (int task = blockIdx.x; task < ntask; task += gridDim.x) {
    const int nb = task % ntn, kb = task / ntn, n0 = nb * 64, k0 = kb * 128;
    __syncthreads();
#pragma unroll
    for (int i = 0; i < 4; ++i) { const int idx = F.tid + NTHR * i, kk = idx >> 4, c4 = idx & 15;
      const f32x4 w = *(const f32x4*)(W + (size_t)(k0 + kk) * ldw + n0 + 4 * c4);
      LAS float* d = tl + kk * 65 + 4 * c4; d[0] = w.x; d[1] = w.y; d[2] = w.z; d[3] = w.w; }
    __syncthreads();
    const int n = F.tid >> 3, kc = F.tid & 7;
    const LAS float* s = tl + (kc * 16) * 65 + n;
    v4u o0, o1;
    o0.x = pk2(s[0 * 65], s[1 * 65]); o0.y = pk2(s[2 * 65], s[3 * 65]); o0.z = pk2(s[4 * 65], s[5 * 65]); o0.w = pk2(s[6 * 65], s[7 * 65]);
    o1.x = pk2(s[8 * 65], s[9 * 65]); o1.y = pk2(s[10 * 65], s[11 * 65]); o1.z = pk2(s[12 * 65], s[13 * 65]); o1.w = pk2(s[14 * 65], s[15 * 65]);
    v4u* dp = (v4u*)(Wt + (size_t)(n0 + n) * DM + k0 + kc * 16);
    dp[0] = o0; dp[1] = o1;
  }
  __syncthreads();
}
__device__ __forceinline__ void p0_zero_vpad(const Frame& F) {
  bf16* Vp = (bf16*)(F.ws + WS_VP);
  const int per = MPOS0 * 256 / 8;
  for (int i = blockIdx.x * NTHR + F.tid; i < 16 * per; i += gridDim.x * NTHR) { const int bh = i / per, e = i % per;
    *(v4u*)(Vp + (size_t)bh * PADT * 256 + (size_t)e * 8) = (v4u){0u, 0u, 0u, 0u}; }
}
__device__ __forceinline__ void p0_lam(const Frame& F, const Args& a) {
  if (blockIdx.x == 0 && F.wave == 0) {
    const int l = F.lane;
    float s1 = a.in[IN_LQ1][l] * a.in[IN_LK1][l] + a.in[IN_LQ1][l + 64] * a.in[IN_LK1][l + 64];
    float s2 = a.in[IN_LQ2][l] * a.in[IN_LK2][l] + a.in[IN_LQ2][l + 64] * a.in[IN_LK2][l + 64];
    s1 = wave_sum(s1); s2 = wave_sum(s2);
    if (l == 0) *(float*)(F.ws + WS_LAM) = __expf(s1) - __expf(s2) + 0.2f;
  }
}

struct EpiProj {
  static constexpr bool PERM = true, AFTER_DRAIN = false;
  bf16 *Qb, *Kp, *Vp, *MQ, *MK, *MV, *MO; const float *qg, *kg; LAS float* xch;
  __device__ __forceinline__ void operator()(const pg8::f32x4 (&acc)[2][2][4][2], const pg8::Unit& u, int wr, int wc, int fr, int fq) const {
    const int pn = u.pn, b = u.pm >> 3, tb = (u.pm & 7) * 256 + wr * 64 + fr, d0 = wc * 32 + fq * 8;
    if (pn < 8) {
      const bool isk = pn >= 4; const int h = pn & 3;
      float ssq[2][4][2];
#pragma unroll
      for (int ai = 0; ai < 2; ++ai)
#pragma unroll
        for (int m = 0; m < 4; ++m)
#pragma unroll
          for (int bj = 0; bj < 2; ++bj) { float s = 0.f;
#pragma unroll
            for (int n = 0; n < 2; ++n) { const pg8::f32x4 x = acc[ai][bj][m][n]; s += (x[0] * x[0] + x[1] * x[1]) + (x[2] * x[2] + x[3] * x[3]); }
            s += __shfl_xor(s, 16); s += __shfl_xor(s, 32); ssq[ai][m][bj] = s;
            if (fq == 0) xch[((ai * 128 + wr * 64 + m * 16 + fr) * 2 + bj) * 4 + wc] = s; }
      asm volatile("s_waitcnt lgkmcnt(0)" ::: "memory"); __builtin_amdgcn_s_barrier(); asm volatile("" ::: "memory");
      const float* gp = (isk ? kg : qg) + d0; const f32x4 g0 = *(const f32x4*)gp, g1v = *(const f32x4*)(gp + 4);
      const float sc = isk ? 1.0f : QSCALE;
#pragma unroll
      for (int ai = 0; ai < 2; ++ai)
#pragma unroll
        for (int m = 0; m < 4; ++m)
#pragma unroll
          for (int bj = 0; bj < 2; ++bj) {
            const f32x4 p = *(const LAS f32x4*)(xch + ((ai * 128 + wr * 64 + m * 16 + fr) * 2 + bj) * 4);
            const float rs = rsqrtf(((p.x + p.y) + (p.z + p.w)) * (1.0f / 128.f) + EPS) * sc;
            const pg8::f32x4 v0 = acc[ai][bj][m][0], v1 = acc[ai][bj][m][1];
            v4u w; w.x = pk2(v0[0] * rs * g0.x, v0[1] * rs * g0.y); w.y = pk2(v0[2] * rs * g0.z, v0[3] * rs * g0.w);
            w.z = pk2(v1[0] * rs * g1v.x, v1[1] * rs * g1v.y); w.w = pk2(v1[2] * rs * g1v.z, v1[3] * rs * g1v.w);
            const int t = tb + ai * 128 + m * 16;
            bf16* dst = isk ? Kp + kp_off((b * 4 + h) * 2 + bj, POS0 + t, d0)
                            : Qb + ((size_t)((b * 4 + h) * 2 + bj) * SEQ + t) * 128 + d0;
            *(v4u*)dst = w; }
      return;
    }
#pragma unroll
    for (int ai = 0; ai < 2; ++ai)
#pragma unroll
      for (int m = 0; m < 4; ++m)
#pragma unroll
        for (int bj = 0; bj < 2; ++bj) {
          pg8::f32x4 v0 = acc[ai][bj][m][0], v1 = acc[ai][bj][m][1];
          const int t = tb + ai * 128 + m * 16;
          bf16* dst;
          if (pn < 12) { const int h = pn - 8; dst = Vp + ((size_t)(b * 4 + h) * PADT + POS0 + t) * 256 + bj * 128 + d0; }
          else if (pn < 16) { const int h = 2 * (pn & 1) + bj; dst = (pn >= 14 ? MK : MQ) + ((size_t)(b * 4 + h) * PADT + POS0 + t) * 128 + d0; }
          else if (pn < 20) { const int h = pn - 16; dst = MV + ((size_t)(b * 4 + h) * PADT + POS0 + t) * 256 + bj * 128 + d0; }
          else { dst = MO + (size_t)(b * SEQ + t) * 1024 + (pn - 20) * 256 + bj * 128 + d0;
#pragma unroll
            for (int j = 0; j < 4; ++j) { v0[j] = sigmoidf_(v0[j]); v1[j] = sigmoidf_(v1[j]); } }
          v4u w; w.x = pk2(v0[0], v0[1]); w.y = pk2(v0[2], v0[3]); w.z = pk2(v1[0], v1[1]); w.w = pk2(v1[2], v1[3]);
          *(v4u*)dst = w; }
  }
};
__device__ __forceinline__ void p1_meta_finalize(const Frame& F, const Args& a) {
  if (blockIdx.x >= NMETA) return;
  const int mrow = blockIdx.x, tid = F.tid, lane = F.lane, w = F.wave;
  const float* meta = a.in[IN_META] + (size_t)mrow * DM; const float* PM = (const float*)(F.ws + WS_PM) + (size_t)mrow * NPROJ;
  LAS float* red = (LAS float*)(F.lds + XCH_OFF);
  const f32x4 mv = ((const f32x4*)meta)[tid];
  float s = wave_sum((mv.x * mv.x + mv.y * mv.y) + (mv.z * mv.z + mv.w * mv.w));
  if (lane == 0) red[w] = s;
  __syncthreads();
  float tot = 0.f;
#pragma unroll
  for (int i = 0; i < 8; ++i) tot += red[i];
  const float rs = rsqrtf(tot * (1.0f / DM) + EPS);
  bf16* Kp = (bf16*)(F.ws + WS_KP); bf16* Vp = (bf16*)(F.ws + WS_VP); bf16* MQ = (bf16*)(F.ws + WS_MQ); bf16* MK = (bf16*)(F.ws + WS_MK); bf16* MV = (bf16*)(F.ws + WS_MV);
  const int pos = MPOS0 + mrow;
  {
    const float v0 = PM[1024 + w * 128 + lane] * rs, v1 = PM[1024 + w * 128 + lane + 64] * rs;
    const float rk = rsqrtf(wave_sum(v0 * v0 + v1 * v1) * (1.0f / 128.f) + EPS);
    const float* kg = a.in[IN_KNG];
    const unsigned short o0 = (unsigned short)f2bf(v0 * rk * kg[lane]), o1 = (unsigned short)f2bf(v1 * rk * kg[lane + 64]);
    for (int b = 0; b < NB; ++b) { const int bhm = (b * 4 + (w >> 1)) * 2 + (w & 1); Kp[kp_off(bhm, pos, lane)] = o0; Kp[kp_off(bhm, pos, lane + 64)] = o1; }
  }
  { const int c = tid * 2;
    const unsigned o = pk2(PM[2048 + c] * rs, PM[2048 + c + 1] * rs); const int h = c >> 8, e = c & 255;
    for (int b = 0; b < NB; ++b) *(unsigned*)(Vp + ((size_t)(b * 4 + h) * PADT + pos) * 256 + e) = o;
    const unsigned o2 = pk2(PM[3072 + c] * rs, PM[3072 + c + 1] * rs); const bool isk = c >= 512; const int cc = c & 511, hq = cc >> 7, d = cc & 127;
    for (int b = 0; b < NB; ++b) *(unsigned*)((isk ? MK : MQ) + ((size_t)(b * 4 + hq) * PADT + pos) * 128 + d) = o2;
    const unsigned o3 = pk2(PM[4096 + c] * rs, PM[4096 + c + 1] * rs);
    for (int b = 0; b < NB; ++b) *(unsigned*)(MV + ((size_t)(b * 4 + h) * PADT + pos) * 256 + e) = o3;
  }
  __syncthreads();
}

namespace att {
using f32x16 = __attribute__((ext_vector_type(16))) float;
using s16x4 = __attribute__((ext_vector_type(4))) short;
constexpr int STEPS_BHM = 152, NSTEPS = 32 * STEPS_BHM;
constexpr int SHM_V = 64 * 256 * 2, SHM_K = 64 * 128 * 2;
constexpr int LDS_V = 0, LDS_K = 2 * SHM_V, LDS_Q = LDS_K + SHM_K, LDS_WS = LDS_Q + 8 * 8192;
constexpr float THR2 = 8.0f;
#define KSWZ(row, colB) ((row) * 256 + ((colB) ^ (((row) & 7) << 4)))
#define SBAR() __builtin_amdgcn_sched_barrier(0)
__device__ __forceinline__ int crow(int r, int hi) { return (r & 3) + 8 * (r >> 2) + 4 * hi; }
__device__ __forceinline__ unsigned cvtpk(float lo, float hi) { unsigned r; asm volatile("v_cvt_pk_bf16_f32 %0, %1, %2" : "=v"(r) : "v"(lo), "v"(hi)); return r; }
__device__ __forceinline__ int qb_start(int qb) { return 2 * qb * qb + 3 * qb; }
__device__ __forceinline__ int chunk_of(int s, int NA) { return ((s + 1) * NA - 1) / NSTEPS; }

template <int OFF> __device__ __forceinline__ s16x4 tr_read(int vb) {
  s16x4 r; asm volatile("ds_read_b64_tr_b16 %0, %1 offset:%2" : "=&v"(r) : "v"(vb), "i"(OFF) : "memory"); return r;
}
constexpr int v_rd_off(int d0, int ks, int half) { return d0 * 512 + ks * 8192 + half * 4096; }
template <int D0> __device__ __forceinline__ void pv_one(f32x16& od, int vb, bf16x8 pa0, bf16x8 pa1, bf16x8 pa2, bf16x8 pa3) {
#define PK(L, H) (bf16x8){L[0], L[1], L[2], L[3], H[0], H[1], H[2], H[3]}
  { const s16x4 l0 = tr_read<v_rd_off(D0, 0, 0)>(vb), h0 = tr_read<v_rd_off(D0, 0, 1)>(vb), l1 = tr_read<v_rd_off(D0, 1, 0)>(vb), h1 = tr_read<v_rd_off(D0, 1, 1)>(vb);
    asm volatile("s_waitcnt lgkmcnt(0)" ::: "memory"); SBAR();
    od = __builtin_amdgcn_mfma_f32_32x32x16_bf16(pa0, PK(l0, h0), od, 0, 0, 0);
    od = __builtin_amdgcn_mfma_f32_32x32x16_bf16(pa1, PK(l1, h1), od, 0, 0, 0); }
  SBAR();
  { const s16x4 l2 = tr_read<v_rd_off(D0, 2, 0)>(vb), h2 = tr_read<v_rd_off(D0, 2, 1)>(vb), l3 = tr_read<v_rd_off(D0, 3, 0)>(vb), h3 = tr_read<v_rd_off(D0, 3, 1)>(vb);
    asm volatile("s_waitcnt lgkmcnt(0)" ::: "memory"); SBAR();
    od = __builtin_amdgcn_mfma_f32_32x32x16_bf16(pa2, PK(l2, h2), od, 0, 0, 0);
    od = __builtin_amdgcn_mfma_f32_32x32x16_bf16(pa3, PK(l3, h3), od, 0, 0, 0); }
#undef PK
}

__device__ __forceinline__ void segment(const Frame& F, int bhm, int qb, int j0, int j1, int slot) {
  const int tid = F.tid, wid = F.wave, lane = F.lane, r32 = lane & 31, hi = lane >> 5;
  const bf16* Qg = (const bf16*)(F.ws + WS_Q) + ((size_t)bhm * SEQ + qb * 256 + wid * 32 + r32) * 128 + hi * 8;
  const bf16* Kg = (const bf16*)(F.ws + WS_KP) + (size_t)bhm * 33 * 8192;
  const bf16* Vg = (const bf16*)(F.ws + WS_VP) + (size_t)(bhm >> 1) * PADT * 256;
  LAS unsigned char* lds = F.lds;
  LAS float* wsl = (LAS float*)(lds + LDS_WS) + wid * 64;
  const float slope2 = exp2f(-2.0f * (float)(((bhm >> 1) & 3) + 1)) * LOG2E;
  unsigned ksrc0, vsrc0;
  ksrc0 = (unsigned)tid * 16u;
  { const int a8 = tid >> 8, b = (tid >> 2) & 7, k = 8 * (b >> 2) + 4 * a8 + (b & 3), c = ((tid >> 5) & 7) * 32 + (tid & 3) * 8; vsrc0 = (unsigned)(k * 256 + c) * 2u; }
#define STAGE_K(j) do { const char* kt = (const char*)(Kg + (size_t)(j) * 8192); \
    _Pragma("unroll") for (int _i = 0; _i < 2; ++_i) __builtin_amdgcn_global_load_lds((const unsigned*)(kt + (ksrc0 + _i * 8192u)), (LAS unsigned*)(lds + LDS_K + _i * 8192 + wid * 1024), 16, 0, 0); } while (0)
#define STAGE_V(buf, j) do { const char* vt = (const char*)(Vg + (size_t)(j) * 64 * 256); \
    _Pragma("unroll") for (int _i = 0; _i < 4; ++_i) __builtin_amdgcn_global_load_lds((const unsigned*)(vt + (vsrc0 + _i * 8192u)), (LAS unsigned*)(lds + LDS_V + (buf) * SHM_V + _i * 8192 + wid * 1024), 16, 0, 0); } while (0)
  const int lt = (((r32 << 1) | hi) ^ ((r32 >> 3) & 1)) << 4;
  LAS unsigned char* Qs = lds + LDS_Q + wid * 8192;
#pragma unroll
  for (int d0 = 0; d0 < 8; ++d0) { const bf16x8 qv = *(const bf16x8*)(Qg + d0 * 16); *(LAS bf16x8*)(Qs + d0 * 1024 + lt) = qv; }
  const float hioff = slope2 * (float)(4 * hi);
  f32x16 o[8];
#pragma unroll
  for (int d = 0; d < 8; ++d)
#pragma unroll
    for (int r = 0; r < 16; ++r) o[d][r] = 0.f;
  float m_reg = -1e30f, l_reg = 0.f;
  const int vb0 = (int)(uintptr_t)(lds + LDS_V) + (((lane & 3) << 3) | (((lane >> 2) & 3) << 6) | (((lane >> 4) & 1) << 5) | (((lane >> 5) & 1) << 8));
  const int qrel = wid * 32 + r32;
  STAGE_K(j0); STAGE_V(0, j0);
  VM_WAIT(); __syncthreads();
  for (int j = j0; j < j1; ++j) {
    const int cur = (j - j0) & 1;
    if (j + 1 < j1) STAGE_V(cur ^ 1, j + 1);
    SBAR();
    f32x16 p0 = {}, p1 = {};
    { const LAS unsigned char* Ks = lds + LDS_K;
#pragma unroll
      for (int d0 = 0; d0 < 8; ++d0) {
        const bf16x8 b0 = *(const LAS bf16x8*)(Ks + d0 * 2048 + lt);
        const bf16x8 b1 = *(const LAS bf16x8*)(Ks + d0 * 2048 + 1024 + lt);
        const bf16x8 qf = *(const LAS bf16x8*)(Qs + d0 * 1024 + lt);
        p0 = __builtin_amdgcn_mfma_f32_32x32x16_bf16(b0, qf, p0, 0, 0, 0);
        p1 = __builtin_amdgcn_mfma_f32_32x32x16_bf16(b1, qf, p1, 0, 0, 0); } }
    asm volatile("s_waitcnt lgkmcnt(0)" ::: "memory"); __builtin_amdgcn_s_barrier(); asm volatile("" ::: "memory");
    if (j + 1 < j1) STAGE_K(j + 1);
    SBAR();
    if (j == 0) {
#pragma unroll
      for (int r = 0; r < 16; ++r) p0[r] = -INFINITY;
#pragma unroll
      for (int r = 0; r < 8; ++r) p1[r] = -INFINITY;
    }
    const int jb = j - (4 * qb + 1);
    if (jb >= 0) {
      const int kb = 64 * jb + 4 * hi;
#pragma unroll
      for (int r = 0; r < 16; ++r) { const int kv = kb + (r & 3) + 8 * (r >> 2); if (kv > qrel) p0[r] = -INFINITY; if (kv + 32 > qrel) p1[r] = -INFINITY; }
    }
    const float off0 = slope2 * (float)(64 * j) + hioff, off1 = off0 + 32.0f * slope2;
#pragma unroll
    for (int r = 0; r < 16; ++r) { const float sb = slope2 * (float)((r & 3) + 8 * (r >> 2)); p0[r] += sb; p1[r] += sb; }
    float pm0 = p0[0], pm1 = p1[0];
#pragma unroll
    for (int r = 1; r < 16; ++r) { pm0 = fmaxf(pm0, p0[r]); pm1 = fmaxf(pm1, p1[r]); }
    float pmax = fmaxf(pm0 + off0, pm1 + off1);
    { auto rr = __builtin_amdgcn_permlane32_swap(__float_as_uint(pmax), __float_as_uint(pmax), false, false);
      pmax = fmaxf(__uint_as_float(rr[0]), __uint_as_float(rr[1])); }
    float mn, alpha;
    if (__builtin_expect(__all(pmax - m_reg <= THR2), 1)) { mn = m_reg; alpha = 1.f; }
    else { mn = fmaxf(m_reg, pmax); alpha = __builtin_amdgcn_exp2f(m_reg - mn); m_reg = mn; }
    const float c0 = off0 - mn, c1 = off1 - mn;
    float ps = 0.f;
#pragma unroll
    for (int r = 0; r < 16; ++r) { p0[r] = __builtin_amdgcn_exp2f(p0[r] + c0); p1[r] = __builtin_amdgcn_exp2f(p1[r] + c1); ps += p0[r] + p1[r]; }
    { auto rr = __builtin_amdgcn_permlane32_swap(__float_as_uint(ps), __float_as_uint(ps), false, false);
      ps = __uint_as_float(rr[0]) + __uint_as_float(rr[1]); }
    l_reg = l_reg * alpha + ps;
    if (__any(alpha < 1.f)) { if (hi == 0) wsl[r32] = alpha; asm volatile("s_waitcnt lgkmcnt(0)" ::: "memory");
#pragma unroll
      for (int rg = 0; rg < 4; ++rg) { const f32x4 al = *(const LAS f32x4*)(wsl + 8 * rg + 4 * hi);
#pragma unroll
        for (int d = 0; d < 8; ++d) { o[d][4 * rg + 0] *= al.x; o[d][4 * rg + 1] *= al.y; o[d][4 * rg + 2] *= al.z; o[d][4 * rg + 3] *= al.w; }
        SBAR(); } }
    bf16x8 pa0, pa1, pa2, pa3;
#define PK4(P, BASE, OUT) do { unsigned a0 = cvtpk(P[BASE + 0], P[BASE + 1]), a1 = cvtpk(P[BASE + 2], P[BASE + 3]);   \
    unsigned b0 = cvtpk(P[BASE + 4], P[BASE + 5]), b1 = cvtpk(P[BASE + 6], P[BASE + 7]);                              \
    auto r0 = __builtin_amdgcn_permlane32_swap(a0, b0, false, false); auto r1 = __builtin_amdgcn_permlane32_swap(a1, b1, false, false); \
    v4u w = {r0[0], r1[0], r0[1], r1[1]}; OUT = *reinterpret_cast<bf16x8*>(&w); } while (0)
    PK4(p0, 0, pa0); PK4(p0, 8, pa1); PK4(p1, 0, pa2); PK4(p1, 8, pa3);
#undef PK4
    SBAR();
    { const int vb = vb0 + cur * SHM_V;
      pv_one<0>(o[0], vb, pa0, pa1, pa2, pa3); pv_one<1>(o[1], vb, pa0, pa1, pa2, pa3); pv_one<2>(o[2], vb, pa0, pa1, pa2, pa3); pv_one<3>(o[3], vb, pa0, pa1, pa2, pa3);
      pv_one<4>(o[4], vb, pa0, pa1, pa2, pa3); pv_one<5>(o[5], vb, pa0, pa1, pa2, pa3); pv_one<6>(o[6], vb, pa0, pa1, pa2, pa3); pv_one<7>(o[7], vb, pa0, pa1, pa2, pa3); }
    VM_WAIT(); __syncthreads();
  }
  { int lane2 = threadIdx.x & 63, slot2 = slot; asm volatile("" : "+v"(lane2), "+s"(slot2));
    const int r32e = lane2 & 31, hie = lane2 >> 5;
    float* PO = (float*)(F.ws + WS_PO) + (size_t)slot2 * 256 * 256; float* ML = (float*)(F.ws + WS_ML) + (size_t)slot2 * 512;
    LAS float* wse = (LAS float*)(F.lds + LDS_WS) + wid * 64;
    if (hie == 0) { wse[r32e] = l_reg; ML[(wid * 32 + r32e) * 2] = m_reg; ML[(wid * 32 + r32e) * 2 + 1] = l_reg; }
    asm volatile("s_waitcnt lgkmcnt(0)" ::: "memory");
    char* Ob = (char*)(PO + (size_t)(wid * 32) * 256);
    const unsigned lo = (unsigned)(4 * hie * 256 + r32e) * 4u;
#pragma unroll
    for (int r = 0; r < 16; ++r) { const int rowc = (r & 3) + 8 * (r >> 2); const float lv = wse[rowc + 4 * hie]; const float rl = lv > 0.f ? __builtin_amdgcn_rcpf(lv) : 0.f;
#pragma unroll
      for (int d0 = 0; d0 < 8; ++d0) *(float*)(Ob + (lo + (unsigned)(rowc * 256 + d0 * 32) * 4u)) = o[d0][r] * rl;
      SBAR(); } }
  __syncthreads();
#undef STAGE_K
#undef STAGE_V
}

__device__ __forceinline__ void phase(const Frame& F, int ca, int NA) {
  int s0 = (int)(((long)ca * NSTEPS) / NA); const int s1 = (int)(((long)(ca + 1) * NSTEPS) / NA);
  while (s0 < s1) {
    const int bhm = s0 / STEPS_BHM, rem = s0 - bhm * STEPS_BHM;
    int qb = 0;
#pragma unroll 1
    for (int q = 1; q < 8; ++q) if (rem >= qb_start(q)) qb = q;
    const int j0 = rem - qb_start(qb), nst = 4 * qb + 5;
    const int j1 = (j0 + (s1 - s0) < nst) ? j0 + (s1 - s0) : nst;
    const int slot = bhm * 16 + qb + chunk_of(s0, NA) - chunk_of(bhm * STEPS_BHM, NA);
    segment(F, bhm, qb, j0, j1, slot);
    s0 += j1 - j0;
  }
}
#undef KSWZ
#undef SBAR
}
namespace ml {
constexpr int QST = 136, TST = 72;
constexpr int L_RQ = 0, L_RK = 17152, L_QS = 34304, L_QW = 51712, L_KS = 69120, L_KWT = 86528, L_VT = 104960, L_SP = 123392, L_G = 132608, L_CW = 134656, L_N = 139776;
constexpr int G_A = 0, G_M = 64, G_WI = 128, G_EM = 192, G_DEN = 256, G_WG = 320, G_SC = 384;
__device__ __forceinline__ float shfl_up_f(float v, int d) { return __shfl_up(v, d); }

__device__ __forceinline__ void item(const Frame& F, const Args& a, int it) {
  const int b = it >> 3, h = (it >> 1) & 3, dvh = it & 1, tid = F.tid, w = F.wave, lane = F.lane, fr = lane & 15, kq = lane >> 4;
  LAS unsigned char* lds = F.lds;
  LAS float* G = (LAS float*)(lds + L_G); LAS float* CW = (LAS float*)(lds + L_CW);
  const bf16* MQg = (const bf16*)(F.ws + WS_MQ) + (size_t)(b * 4 + h) * PADT * 128;
  const bf16* MKg = (const bf16*)(F.ws + WS_MK) + (size_t)(b * 4 + h) * PADT * 128;
  const bf16* MVg = (const bf16*)(F.ws + WS_MV) + (size_t)(b * 4 + h) * PADT * 256 + dvh * 128;
  const float* LIg = (const float*)(F.ws + WS_LI) + (b * 4 + h) * PADT; const float* LFg = (const float*)(F.ws + WS_LF) + (b * 4 + h) * PADT;
  float* HMg = (float*)(F.ws + WS_HM) + (size_t)b * SEQ * 1024 + h * 256 + dvh * 128 + 16 * w + fr;
  for (int e = tid; e < 2 * 5 * 128; e += NTHR) { const int qk = e / 640, j = (e / 128) % 5, d = e & 127; const int ch = qk * 512 + h * 128 + d;
    CW[e] = j < 4 ? a.in[IN_CW][j * 1024 + ch] : a.in[IN_CB][ch]; }
  if (tid < 96) { const int qk = tid / 48, r = (tid % 48) >> 4, ch = tid & 15; *(LAS v4u*)(lds + (qk ? L_RK : L_RQ) + r * 256 + ch * 16) = (v4u){0u, 0u, 0u, 0u}; }
  f32x4 Cacc[8];
  LAS f32x4* NL = (LAS f32x4*)(lds + L_N);
#pragma unroll
  for (int i = 0; i < 8; ++i) { Cacc[i] = (f32x4){0.f, 0.f, 0.f, 0.f}; if (w == 0) NL[i * 64 + lane] = (f32x4){0.f, 0.f, 0.f, 0.f}; }
  float m = 0.f;
  const v4u onesv = fr == 0 ? (v4u){0x3F803F80u, 0x3F803F80u, 0x3F803F80u, 0x3F803F80u} : (v4u){0u, 0u, 0u, 0u};
  const bf16x8 ones = __builtin_bit_cast(bf16x8, onesv);
  v4u pv[2]; float pli = 0.f, plf = 0.f;
#define ML_LOAD(c) do { const int pos0 = 64 * (c); \
    _Pragma("unroll") for (int i = 0; i < 2; ++i) { \
      __builtin_amdgcn_global_load_lds((const unsigned*)((const char*)(MQg + (size_t)pos0 * 128) + i * 8192 + tid * 16), (LAS unsigned*)(lds + L_RQ + 768 + i * 8192 + w * 1024), 16, 0, 0); \
      __builtin_amdgcn_global_load_lds((const unsigned*)((const char*)(MKg + (size_t)pos0 * 128) + i * 8192 + tid * 16), (LAS unsigned*)(lds + L_RK + 768 + i * 8192 + w * 1024), 16, 0, 0); \
      const int p = tid + NTHR * i, row = p >> 4, ch = p & 15; pv[i] = *(const v4u*)(MVg + (size_t)(pos0 + row) * 256 + ch * 8); } \
    if (w == 0) { pli = LIg[pos0 + lane]; plf = LFg[pos0 + lane]; } } while (0)
  ML_LOAD(0);
  VM_WAIT(); __syncthreads();
#pragma unroll 1
  for (int c = 0; c < 33; ++c) {
#pragma unroll
    for (int i = 0; i < 2; ++i) { const int p = tid + NTHR * i, row = p >> 4, ch = p & 15; const bool dead = (c == 0) && (row < MPOS0);
      const v4u z = {0u, 0u, 0u, 0u}; const v4u v4 = dead ? z : pv[i];
      if (dead) { *(LAS v4u*)(lds + L_RQ + (3 + row) * 256 + ch * 16) = z; *(LAS v4u*)(lds + L_RK + (3 + row) * 256 + ch * 16) = z; }
      LAS bf16* vt = (LAS bf16*)(lds + L_VT) + (ch * 8) * TST + row;
      vt[0 * TST] = (bf16)(v4.x & 0xffff); vt[1 * TST] = (bf16)(v4.x >> 16); vt[2 * TST] = (bf16)(v4.y & 0xffff); vt[3 * TST] = (bf16)(v4.y >> 16);
      vt[4 * TST] = (bf16)(v4.z & 0xffff); vt[5 * TST] = (bf16)(v4.z >> 16); vt[6 * TST] = (bf16)(v4.w & 0xffff); vt[7 * TST] = (bf16)(v4.w >> 16); }
    if (w == 0) {
      const bool dead = (c == 0) && (lane < MPOS0);
      const float li = dead ? -1e30f : pli, lf = dead ? 0.f : plf;
      float bs = lf;
#pragma unroll
      for (int d = 1; d < 64; d <<= 1) { const float o = shfl_up_f(bs, d); if (lane >= d) bs += o; }
      const float av = li - bs; float cm = av;
#pragma unroll
      for (int d = 1; d < 64; d <<= 1) { const float o = shfl_up_f(cm, d); if (lane >= d) cm = fmaxf(cm, o); }
      const float Mt = fmaxf(m, cm);
      const float Mend = __shfl(Mt, 63), bL = __shfl(bs, 63);
      G[G_A + lane] = av; G[G_M + lane] = Mt; G[G_WI + lane] = __expf(m - Mt); G[G_EM + lane] = __expf(-(bs + Mt)); G[G_WG + lane] = __expf(av - Mend);
      if (lane == 0) { G[G_SC + 0] = __expf(m - Mend); G[G_SC + 1] = bL + Mend; }
    }
    __syncthreads();
    { const int t = tid >> 3, d0 = (tid & 7) * 16;
      const float wi = G[G_WI + t], wg = G[G_WG + t];
#pragma unroll
      for (int qk = 0; qk < 2; ++qk) {
        float y[16];
#pragma unroll
        for (int e = 0; e < 16; ++e) y[e] = CW[(qk * 5 + 4) * 128 + d0 + e];
#pragma unroll
        for (int j = 0; j < 4; ++j) { const LAS v4u* rp = (const LAS v4u*)(lds + (qk ? L_RK : L_RQ) + (t + j) * 256 + d0 * 2); const v4u r0 = rp[0], r1 = rp[1];
          const LAS float* cw = CW + (qk * 5 + j) * 128 + d0;
          y[0] += cw[0] * bflo(r0.x); y[1] += cw[1] * bfhi(r0.x); y[2] += cw[2] * bflo(r0.y); y[3] += cw[3] * bfhi(r0.y); y[4] += cw[4] * bflo(r0.z); y[5] += cw[5] * bfhi(r0.z); y[6] += cw[6] * bflo(r0.w); y[7] += cw[7] * bfhi(r0.w);
          y[8] += cw[8] * bflo(r1.x); y[9] += cw[9] * bfhi(r1.x); y[10] += cw[10] * bflo(r1.y); y[11] += cw[11] * bfhi(r1.y); y[12] += cw[12] * bflo(r1.z); y[13] += cw[13] * bfhi(r1.z); y[14] += cw[14] * bflo(r1.w); y[15] += cw[15] * bfhi(r1.w); }
#pragma unroll
        for (int e = 0; e < 16; ++e) y[e] = y[e] / (1.0f + __expf(-y[e]));
        if (qk == 0) {
          v4u o0, o1, w0, w1;
          o0.x = pk2(y[0], y[1]); o0.y = pk2(y[2], y[3]); o0.z = pk2(y[4], y[5]); o0.w = pk2(y[6], y[7]); o1.x = pk2(y[8], y[9]); o1.y = pk2(y[10], y[11]); o1.z = pk2(y[12], y[13]); o1.w = pk2(y[14], y[15]);
          w0.x = pk2(y[0] * wi, y[1] * wi); w0.y = pk2(y[2] * wi, y[3] * wi); w0.z = pk2(y[4] * wi, y[5] * wi); w0.w = pk2(y[6] * wi, y[7] * wi);
          w1.x = pk2(y[8] * wi, y[9] * wi); w1.y = pk2(y[10] * wi, y[11] * wi); w1.z = pk2(y[12] * wi, y[13] * wi); w1.w = pk2(y[14] * wi, y[15] * wi);
          LAS v4u* qs = (LAS v4u*)(lds + L_QS + (t * QST + d0) * 2); qs[0] = o0; qs[1] = o1;
          LAS v4u* qw = (LAS v4u*)(lds + L_QW + (t * QST + d0) * 2); qw[0] = w0; qw[1] = w1;
        } else {
          const float sc = 0.08838834764831845f;
          v4u o0, o1;
          o0.x = pk2(y[0] * sc, y[1] * sc); o0.y = pk2(y[2] * sc, y[3] * sc); o0.z = pk2(y[4] * sc, y[5] * sc); o0.w = pk2(y[6] * sc, y[7] * sc);
          o1.x = pk2(y[8] * sc, y[9] * sc); o1.y = pk2(y[10] * sc, y[11] * sc); o1.z = pk2(y[12] * sc, y[13] * sc); o1.w = pk2(y[14] * sc, y[15] * sc);
          LAS v4u* ks = (LAS v4u*)(lds + L_KS + (t * QST + d0) * 2); ks[0] = o0; ks[1] = o1;
          LAS bf16* kt = (LAS bf16*)(lds + L_KWT) + d0 * TST + t; const float sw = sc * wg;
#pragma unroll
          for (int e = 0; e < 16; ++e) kt[e * TST] = (bf16)f2bf(y[e] * sw);
        }
        __builtin_amdgcn_sched_barrier(0);
      }
    }
    __syncthreads();
    { const int si = w >> 1;
      const f32x4 as = *(const LAS f32x4*)(G + G_A + 16 * si + 4 * kq);
#pragma unroll
      for (int tt = 0; tt < 2; ++tt) { const int ti = 2 * (w & 1) + tt; f32x4 acc = {0.f, 0.f, 0.f, 0.f};
#pragma unroll
        for (int ks = 0; ks < 4; ++ks) { const bf16x8 af = *(const LAS bf16x8*)(lds + L_KS + ((16 * si + fr) * QST + 32 * ks + 8 * kq) * 2);
          const bf16x8 bfr = *(const LAS bf16x8*)(lds + L_QS + ((16 * ti + fr) * QST + 32 * ks + 8 * kq) * 2);
          acc = __builtin_amdgcn_mfma_f32_16x16x32_bf16(af, bfr, acc, 0, 0, 0); }
        const int t = 16 * ti + fr, s0 = 16 * si + 4 * kq; const float Mt = G[G_M + t];
        const float v0 = (s0 + 0 <= t) ? acc.x * __expf(as.x - Mt) : 0.f, v1 = (s0 + 1 <= t) ? acc.y * __expf(as.y - Mt) : 0.f;
        const float v2 = (s0 + 2 <= t) ? acc.z * __expf(as.z - Mt) : 0.f, v3 = (s0 + 3 <= t) ? acc.w * __expf(as.w - Mt) : 0.f;
        v2u o; o.x = pk2(v0, v1); o.y = pk2(v2, v3);
        *(LAS v2u*)(lds + L_SP + (t * TST + s0) * 2) = o; } }
    if (tid < 96) { const int qk = tid / 48, r = (tid % 48) >> 4, ch = tid & 15; LAS unsigned char* base = lds + (qk ? L_RK : L_RQ);
      const v4u hv = *(const LAS v4u*)(base + (64 + r) * 256 + ch * 16); *(LAS v4u*)(base + r * 256 + ch * 16) = hv; }
    __syncthreads();
    if (c + 1 < 33) ML_LOAD(c + 1);
    f32x4 acc[4], accn[4];
#pragma unroll
    for (int ti = 0; ti < 4; ++ti) { acc[ti] = (f32x4){0.f, 0.f, 0.f, 0.f}; accn[ti] = (f32x4){0.f, 0.f, 0.f, 0.f}; }
#pragma unroll
    for (int I = 0; I < 4; ++I) {
      v4u bc; bc.x = pk2(Cacc[2 * I][0], Cacc[2 * I][1]); bc.y = pk2(Cacc[2 * I][2], Cacc[2 * I][3]); bc.z = pk2(Cacc[2 * I + 1][0], Cacc[2 * I + 1][1]); bc.w = pk2(Cacc[2 * I + 1][2], Cacc[2 * I + 1][3]);
      v4u bn = {0u, 0u, 0u, 0u}; if (w == 0) { const f32x4 n0 = NL[(2 * I) * 64 + lane], n1 = NL[(2 * I + 1) * 64 + lane]; bn.x = pk2(n0.x, n0.y); bn.y = pk2(n0.z, n0.w); bn.z = pk2(n1.x, n1.y); bn.w = pk2(n1.z, n1.w); }
#pragma unroll
      for (int ti = 0; ti < 4; ++ti) { const LAS unsigned char* qp = lds + L_QW + ((16 * ti + fr) * QST + 32 * I + 4 * kq) * 2;
        const v2u a0 = *(const LAS v2u*)qp, a1 = *(const LAS v2u*)(qp + 32); const v4u av = {a0.x, a0.y, a1.x, a1.y};
        acc[ti] = __builtin_amdgcn_mfma_f32_16x16x32_bf16(__builtin_bit_cast(bf16x8, av), __builtin_bit_cast(bf16x8, bc), acc[ti], 0, 0, 0);
        if (w == 0) accn[ti] = __builtin_amdgcn_mfma_f32_16x16x32_bf16(__builtin_bit_cast(bf16x8, av), __builtin_bit_cast(bf16x8, bn), accn[ti], 0, 0, 0); }
      __builtin_amdgcn_sched_barrier(0);
    }
    bf16x8 bv[2];
#pragma unroll
    for (int ks = 0; ks < 2; ++ks) { bv[ks] = *(const LAS bf16x8*)(lds + L_VT + ((16 * w + fr) * TST + 32 * ks + 8 * kq) * 2);
#pragma unroll
      for (int ti = 0; ti < 4; ++ti) { const bf16x8 sf = *(const LAS bf16x8*)(lds + L_SP + ((16 * ti + fr) * TST + 32 * ks + 8 * kq) * 2);
        acc[ti] = __builtin_amdgcn_mfma_f32_16x16x32_bf16(sf, bv[ks], acc[ti], 0, 0, 0);
        if (w == 0) accn[ti] = __builtin_amdgcn_mfma_f32_16x16x32_bf16(sf, ones, accn[ti], 0, 0, 0); } }
    if (w == 0 && fr == 0) {
#pragma unroll
      for (int ti = 0; ti < 4; ++ti) *(LAS f32x4*)(G + G_DEN + 16 * ti + 4 * kq) = accn[ti]; }
    { const float decay = G[G_SC + 0];
#pragma unroll
      for (int i = 0; i < 8; ++i) { Cacc[i] = Cacc[i] * decay; f32x4 nn = {0.f, 0.f, 0.f, 0.f}; if (w == 0) nn = NL[i * 64 + lane] * decay;
#pragma unroll
        for (int ks = 0; ks < 2; ++ks) { const bf16x8 kf = *(const LAS bf16x8*)(lds + L_KWT + ((16 * i + fr) * TST + 32 * ks + 8 * kq) * 2);
          Cacc[i] = __builtin_amdgcn_mfma_f32_16x16x32_bf16(kf, bv[ks], Cacc[i], 0, 0, 0);
          if (w == 0) nn = __builtin_amdgcn_mfma_f32_16x16x32_bf16(kf, ones, nn, 0, 0, 0); }
        if (w == 0) NL[i * 64 + lane] = nn;
        if (i & 1) __builtin_amdgcn_sched_barrier(0); }
      m = G[G_SC + 1]; }
    __syncthreads();
    if (c >= 1) {
#pragma unroll
      for (int ti = 0; ti < 4; ++ti) { const f32x4 dn = *(const LAS f32x4*)(G + G_DEN + 16 * ti + 4 * kq), em = *(const LAS f32x4*)(G + G_EM + 16 * ti + 4 * kq);
        float* hp = HMg + (size_t)(64 * (c - 1) + 16 * ti + 4 * kq) * 1024;
        hp[0] = acc[ti].x / fmaxf(fabsf(dn.x), em.x); hp[1024] = acc[ti].y / fmaxf(fabsf(dn.y), em.y); hp[2048] = acc[ti].z / fmaxf(fabsf(dn.z), em.z); hp[3072] = acc[ti].w / fmaxf(fabsf(dn.w), em.w); }
    }
    VM_WAIT(); __syncthreads();
  }
#undef ML_LOAD
}
}
__device__ __forceinline__ void p3_combine(const Frame& F, const Args& a, int NA) {
  const float* PO = (const float*)(F.ws + WS_PO); const float* ML = (const float*)(F.ws + WS_ML); const float* HM = (const float*)(F.ws + WS_HM);
  const bf16* MO = (const bf16*)(F.ws + WS_MO); bf16* A2 = (bf16*)(F.ws + WS_A2);
  const float lam = *(const float*)(F.ws + WS_LAM);
  const float* subg = a.in[IN_SUBG]; const float* og = a.in[IN_OUTG];
  const int gw = blockIdx.x * NWAVES + F.wave, NGW = gridDim.x * NWAVES, lane = F.lane;
  const f32x4 sg = ((const f32x4*)subg)[lane];
  for (int R = gw; R < MROWS; R += NGW) {
    const int b = R >> 11, t = R & 2047, qb = t >> 8, rq = t & 255;
#pragma unroll 1
    for (int h = 0; h < 4; ++h) {
      f32x4 om[2];
#pragma unroll
      for (int m = 0; m < 2; ++m) {
        const int bhm = (b * 4 + h) * 2 + m, first = bhm * att::STEPS_BHM + att::qb_start(qb), last = first + 4 * qb + 4;
        const int cf = att::chunk_of(first, NA), np = att::chunk_of(last, NA) - cf + 1, slot0 = bhm * 16 + qb + cf - att::chunk_of(bhm * att::STEPS_BHM, NA);
        float mp[3], lp[3]; f32x4 op[3];
#pragma unroll
        for (int p = 0; p < 3; ++p) { if (p < np) { const int slot = slot0 + p; mp[p] = ML[(size_t)slot * 512 + rq * 2]; lp[p] = ML[(size_t)slot * 512 + rq * 2 + 1];
            op[p] = ((const f32x4*)(PO + ((size_t)slot * 256 + rq) * 256))[lane]; } else { mp[p] = -1e30f; lp[p] = 0.f; op[p] = (f32x4){0.f, 0.f, 0.f, 0.f}; } }
        const float M = fmaxf(mp[0], fmaxf(mp[1], mp[2]));
        float wsum = 0.f; f32x4 acc = (f32x4){0.f, 0.f, 0.f, 0.f};
#pragma unroll
        for (int p = 0; p < 3; ++p) { const float w = lp[p] * exp2f(mp[p] - M); wsum += w; acc += op[p] * w; }
        om[m] = acc * (1.0f / wsum);
      }
      const f32x4 o = om[0] - om[1] * lam;
      const float rs = rsqrtf(wave_sum((o.x * o.x + o.y * o.y) + (o.z * o.z + o.w * o.w)) * (1.0f / 256.f) + EPS) * 0.8f;
      v2u w; w.x = pk2(o.x * rs * sg.x, o.y * rs * sg.y); w.y = pk2(o.z * rs * sg.z, o.w * rs * sg.w);
      ((v2u*)(A2 + (size_t)R * DM + h * 256))[lane] = w;
      const f32x4 hv = ((const f32x4*)(HM + (size_t)R * 1024 + h * 256))[lane];
      const float rh = rsqrtf(wave_sum((hv.x * hv.x + hv.y * hv.y) + (hv.z * hv.z + hv.w * hv.w)) * (1.0f / 256.f) + EPS);
      const f32x4 g = ((const f32x4*)(og + h * 256))[lane];
      const v2u mo = ((const v2u*)(MO + (size_t)R * 1024 + h * 256))[lane];
      v2u w2; w2.x = pk2(hv.x * rh * g.x * bflo(mo.x), hv.y * rh * g.y * bfhi(mo.x)); w2.y = pk2(hv.z * rh * g.z * bflo(mo.y), hv.w * rh * g.w * bfhi(mo.y));
      ((v2u*)(A2 + (size_t)R * DM + 1024 + h * 256))[lane] = w2;
    }
  }
}
struct EpiRes {
  static constexpr bool PERM = true, AFTER_DRAIN = false;
  const float* x; float* out; bf16* H1b; float* SSQ;
  __device__ __forceinline__ void operator()(const pg8::f32x4 (&acc)[2][2][4][2], const pg8::Unit& u, int wr, int wc, int fr, int fq) const {
    const int row0 = u.pm * 256 + wr * 64 + fr, col0 = u.pn * 256 + wc * 32 + 8 * fq;
#pragma unroll
    for (int ai = 0; ai < 2; ++ai)
#pragma unroll
      for (int m = 0; m < 4; ++m) { const size_t R = (size_t)(row0 + ai * 128 + m * 16); float s = 0.f;
#pragma unroll
        for (int bj = 0; bj < 2; ++bj) { const size_t off = R * DM + col0 + bj * 128;
          const f32x4 x0 = *(const f32x4*)(x + off), x1 = *(const f32x4*)(x + off + 4);
          const f32x4 v0 = acc[ai][bj][m][0] + x0, v1 = acc[ai][bj][m][1] + x1;
          *(f32x4*)(out + off) = v0; *(f32x4*)(out + off + 4) = v1;
          v4u w; w.x = pk2(v0.x, v0.y); w.y = pk2(v0.z, v0.w); w.z = pk2(v1.x, v1.y); w.w = pk2(v1.z, v1.w);
          *(v4u*)(H1b + off) = w;
          s += (v0.x * v0.x + v0.y * v0.y) + (v0.z * v0.z + v0.w * v0.w) + (v1.x * v1.x + v1.y * v1.y) + (v1.z * v1.z + v1.w * v1.w); }
        s += __shfl_xor(s, 16); s += __shfl_xor(s, 32);
        if (fq == 0) SSQ[R * 32 + u.pn * 4 + wc] = s; }
  }
};
typedef __bf16 bfv2 __attribute__((ext_vector_type(2)));
__device__ __forceinline__ void split_hl(const f32x4 a, const f32x4 b, bf16x8& hi, bf16x8& lo) {
  float v[8] = {a.x, a.y, a.z, a.w, b.x, b.y, b.z, b.w}; unsigned h[8], l[8];
#pragma unroll
  for (int i = 0; i < 8; ++i) { h[i] = f2bf(v[i]); l[i] = f2bf(v[i] - __builtin_bit_cast(float, h[i] << 16)); }
  v4u hv = {h[0] | (h[1] << 16), h[2] | (h[3] << 16), h[4] | (h[5] << 16), h[6] | (h[7] << 16)};
  v4u lv = {l[0] | (l[1] << 16), l[2] | (l[3] << 16), l[4] | (l[5] << 16), l[6] | (l[7] << 16)};
  hi = __builtin_bit_cast(bf16x8, hv); lo = __builtin_bit_cast(bf16x8, lv);
}
__device__ __forceinline__ void p0_w3t(const Frame& F, const Args& a) {
  const float* wq = a.in[IN_WQ]; const float* sk = a.in[IN_SUBK]; const float* g2 = a.in[IN_G2];
  bf16* W3t = (bf16*)(F.ws + WS_W3T);
  const int gw = blockIdx.x * NWAVES + F.wave, NGW = gridDim.x * NWAVES, lane = F.lane, fr = lane & 15, fq = lane >> 4;
  for (int task = gw; task < 128 * 16; task += NGW) {
    const int kt = task >> 4, hh = task & 15;
    bf16x8 ahi[4], alo[4];
    const float* ap = wq + (size_t)(kt * 16 + fr) * DM + hh * 128 + fq * 8;
#pragma unroll
    for (int s = 0; s < 4; ++s) split_hl(*(const f32x4*)(ap + 32 * s), *(const f32x4*)(ap + 32 * s + 4), ahi[s], alo[s]);
    const f32x4 gk = *(const f32x4*)(g2 + kt * 16 + fq * 4);
#pragma unroll 1
    for (int t2 = 0; t2 < 8; ++t2) {
      const float* bp = sk + (size_t)(hh * 128 + t2 * 16 + fr) * 128 + fq * 8;
      f32x4 acc = {0.f, 0.f, 0.f, 0.f};
#pragma unroll
      for (int s = 0; s < 4; ++s) { bf16x8 bhi, blo; split_hl(*(const f32x4*)(bp + 32 * s), *(const f32x4*)(bp + 32 * s + 4), bhi, blo);
        acc = __builtin_amdgcn_mfma_f32_16x16x32_bf16(ahi[s], bhi, acc, 0, 0, 0);
        acc = __builtin_amdgcn_mfma_f32_16x16x32_bf16(ahi[s], blo, acc, 0, 0, 0);
        acc = __builtin_amdgcn_mfma_f32_16x16x32_bf16(alo[s], bhi, acc, 0, 0, 0); }
      v2u o; o.x = pk2(acc.x * gk.x, acc.y * gk.y); o.y = pk2(acc.z * gk.z, acc.w * gk.w);
      *(v2u*)(W3t + (size_t)(hh * 128 + t2 * 16 + fr) * DM + kt * 16 + fq * 4) = o;
    }
  }
}
typedef float f32x2v __attribute__((ext_vector_type(2)));
__device__ __forceinline__ void p0_tables(const Frame& F, const Args& a) {
  const float* g2 = a.in[IN_G2];
  unsigned char* T8 = F.ws + WS_UB; float* SCL = (float*)(F.ws + WS_SCL);
  const int gw = blockIdx.x * NWAVES + F.wave, NGW = gridDim.x * NWAVES, lane = F.lane;
  for (int row = gw; row < 2 * 16384; row += NGW) {
    const bool isv = row >= 16384; const int e = row & 16383;
    const float* src = a.in[isv ? IN_V : IN_U] + (size_t)e * DM;
    f32x4 x[2][4]; float amax = 0.f;
#pragma unroll
    for (int i = 0; i < 2; ++i)
#pragma unroll
      for (int q = 0; q < 4; ++q) { const int k = (i * 64 + lane) * 16 + q * 4; f32x4 v = *(const f32x4*)(src + k);
        if (!isv) v = v * *(const f32x4*)(g2 + k);
        x[i][q] = v; amax = fmaxf(amax, fmaxf(fmaxf(fabsf(v.x), fabsf(v.y)), fmaxf(fabsf(v.z), fabsf(v.w)))); }
#pragma unroll
    for (int o = 1; o < 64; o <<= 1) amax = fmaxf(amax, __shfl_xor(amax, o));
    const float sc = amax > 0.f ? exp2f(floorf(log2f(224.0f / amax))) : 1.0f;
#pragma unroll
    for (int i = 0; i < 2; ++i) { v4u w;
#pragma unroll
      for (int q = 0; q < 4; ++q) { int pk = 0; pk = __builtin_amdgcn_cvt_pk_fp8_f32(x[i][q].x * sc, x[i][q].y * sc, pk, false); pk = __builtin_amdgcn_cvt_pk_fp8_f32(x[i][q].z * sc, x[i][q].w * sc, pk, true); w[q] = (unsigned)pk; }
      *(v4u*)(T8 + (size_t)row * DM + (size_t)(i * 64 + lane) * 16) = w; }
    if (lane == 0) SCL[row] = 1.0f / sc;
  }
}
struct EpiScore {
  static constexpr bool PERM = true, AFTER_DRAIN = false;
  float* S; const LAS float* rs;
  __device__ __forceinline__ void operator()(const pg8::f32x4 (&acc)[2][2][4][2], const pg8::Unit& u, int wr, int wc, int fr, int fq) const {
    const int rl0 = wr * 64 + fr, col0 = u.pn * 256 + wc * 32 + 8 * fq;
#pragma unroll
    for (int ai = 0; ai < 2; ++ai)
#pragma unroll
      for (int m = 0; m < 4; ++m) { const int rl = rl0 + ai * 128 + m * 16; const float r = rs[rl]; const size_t R = (size_t)u.pm * 256 + rl;
#pragma unroll
        for (int bj = 0; bj < 2; ++bj) { float* d = S + R * DM + col0 + bj * 128;
          *(f32x4*)d = acc[ai][bj][m][0] * r; *(f32x4*)(d + 4) = acc[ai][bj][m][1] * r; } }
  }
};

__device__ __forceinline__ unsigned fkey(float f) { const unsigned b = __builtin_bit_cast(unsigned, f); return b ^ ((b >> 31) ? 0xFFFFFFFFu : 0x80000000u); }
template <int NV, int K> __device__ __forceinline__ void wave_topk(const unsigned (&u)[NV], bool (&sel)[NV], int lane) {
  unsigned prefix = 0u; int cge = NV * 64;
#pragma unroll 1
  for (int bit = 31; bit >= 0 && cge != K; --bit) {
    const unsigned cand = prefix | (1u << bit); int c = 0;
#pragma unroll
    for (int i = 0; i < NV; ++i) c += __builtin_popcountll(__ballot(u[i] >= cand));
    if (c >= K) { prefix = cand; cge = c; }
  }
  int cgt = 0;
#pragma unroll
  for (int i = 0; i < NV; ++i) cgt += __builtin_popcountll(__ballot(u[i] > prefix));
  int need = K - cgt;
  const unsigned long long lm = (1ull << lane) - 1ull;
#pragma unroll
  for (int i = 0; i < NV; ++i) { const unsigned long long eq = __ballot(u[i] == prefix); const int before = __builtin_popcountll(eq & lm);
    sel[i] = (u[i] > prefix) || (u[i] == prefix && before < need); const int ne = __builtin_popcountll(eq); need = need > ne ? need - ne : 0; }
}
__device__ __forceinline__ float gelu_erf(float x) { return 0.5f * x * (1.0f + erff(x * 0.70710678118654752f)); }

__device__ __forceinline__ void p6_peer(const Frame& F, const Args& a, float* dst_base) {
  const float* S = (const float*)(F.ws + WS_S); const float* SSQ = (const float*)(F.ws + WS_SSQ); const bf16* H1b = (const bf16*)(F.ws + WS_H1B);
  float* out = a.out;
  const int lane = F.lane, gw = blockIdx.x * NWAVES + F.wave, NGW = gridDim.x * NWAVES;
  LAS float* wl = (LAS float*)(F.lds + F.wave * 2048);
  LAS int* wli = (LAS int*)wl;
  for (int tok = gw; tok < MROWS; tok += NGW) {
    const float rs = rsqrtf(wave_sum(lane < 32 ? SSQ[(size_t)tok * 32 + lane] : 0.f) * (1.0f / DM) + EPS);
    const float* srow = S + (size_t)tok * DM;
#ifdef PEER_IDS_FROM_GLOBAL
    { const int* gi = (const int*)(F.ws + (size_t)372 * MiB) + (size_t)tok * 128; const float* gg = (const float*)(F.ws + (size_t)376 * MiB) + (size_t)tok * 128;
      wli[128 + lane] = gi[lane]; wli[128 + 64 + lane] = gi[64 + lane]; wl[256 + lane] = gg[lane]; wl[256 + 64 + lane] = gg[64 + lane];
      asm volatile("s_waitcnt lgkmcnt(0)" ::: "memory"); }
#pragma unroll 1
    for (int h8 = 0; h8 < 0; ++h8) {
#else
#pragma unroll 1
    for (int h8 = 0; h8 < 8; ++h8) {
#endif
#pragma unroll
      for (int p = 0; p < 2; ++p) {
        const float2 sv = *(const float2*)(srow + (h8 * 2 + p) * 128 + 2 * lane);
        unsigned u[2] = {fkey(sv.x), fkey(sv.y)}; bool sel[2];
        wave_topk<2, 16>(u, sel, lane);
        const unsigned long long m0 = __ballot(sel[0]), m1 = __ballot(sel[1]); const unsigned long long lm = (1ull << lane) - 1ull;
        const int pos0 = __builtin_popcountll(m0 & lm), pos1 = __builtin_popcountll(m0) + __builtin_popcountll(m1 & lm);
        if (sel[0]) { wl[p * 16 + pos0] = sv.x; wli[64 + p * 16 + pos0] = 2 * lane; }
        if (sel[1]) { wl[p * 16 + pos1] = sv.y; wli[64 + p * 16 + pos1] = 2 * lane + 1; }
      }
      asm volatile("s_waitcnt lgkmcnt(0)" ::: "memory");
      const int ci = lane >> 2, cj = 4 * (lane & 3);
      const float s0 = wl[ci]; const f32x4 s1 = *(const LAS f32x4*)(wl + 16 + cj);
      float cv[4] = {s0 + s1.x, s0 + s1.y, s0 + s1.z, s0 + s1.w};
      unsigned cu[4] = {fkey(cv[0]), fkey(cv[1]), fkey(cv[2]), fkey(cv[3])}; bool csel[4];
      wave_topk<4, 16>(cu, csel, lane);
      float mx = -INFINITY;
#pragma unroll
      for (int q = 0; q < 4; ++q) if (csel[q]) mx = fmaxf(mx, cv[q]);
#pragma unroll
      for (int o = 1; o < 64; o <<= 1) mx = fmaxf(mx, __shfl_xor(mx, o));
      float ev[4], es = 0.f;
#pragma unroll
      for (int q = 0; q < 4; ++q) { ev[q] = csel[q] ? __expf(cv[q] - mx) : 0.f; es += ev[q]; }
      es = wave_sum(es); const float inv = 1.0f / es;
      const int ki = wli[64 + ci]; typedef int i32x4 __attribute__((ext_vector_type(4))); const i32x4 kj = *(const LAS i32x4*)(wli + 64 + 16 + cj);
      const int kjv[4] = {kj.x, kj.y, kj.z, kj.w};
      int base = 0; const unsigned long long lm = (1ull << lane) - 1ull;
#pragma unroll
      for (int q = 0; q < 4; ++q) { const unsigned long long mq = __ballot(csel[q]); const int pos = base + __builtin_popcountll(mq & lm);
        if (csel[q]) { wli[128 + h8 * 16 + pos] = ki * 128 + kjv[q]; wl[256 + h8 * 16 + pos] = ev[q] * inv; } base += __builtin_popcountll(mq); }
      asm volatile("s_waitcnt lgkmcnt(0)" ::: "memory");
    }
    float xs[32];
#pragma unroll
    for (int i = 0; i < 2; ++i) { const v4u* xp = (const v4u*)(H1b + (size_t)tok * DM + (size_t)(i * 64 + lane) * 16); const v4u x0 = xp[0], x1 = xp[1];
      xs[i * 16 + 0] = bflo(x0.x); xs[i * 16 + 1] = bfhi(x0.x); xs[i * 16 + 2] = bflo(x0.y); xs[i * 16 + 3] = bfhi(x0.y); xs[i * 16 + 4] = bflo(x0.z); xs[i * 16 + 5] = bfhi(x0.z); xs[i * 16 + 6] = bflo(x0.w); xs[i * 16 + 7] = bfhi(x0.w);
      xs[i * 16 + 8] = bflo(x1.x); xs[i * 16 + 9] = bfhi(x1.x); xs[i * 16 + 10] = bflo(x1.y); xs[i * 16 + 11] = bfhi(x1.y); xs[i * 16 + 12] = bflo(x1.z); xs[i * 16 + 13] = bfhi(x1.z); xs[i * 16 + 14] = bflo(x1.w); xs[i * 16 + 15] = bfhi(x1.w); }
    float y[32];
#pragma unroll
    for (int i = 0; i < 32; ++i) y[i] = 0.f;
    const unsigned char* U8 = F.ws + WS_UB; const unsigned char* V8 = F.ws + WS_VB8; const float* SCL = (const float*)(F.ws + WS_SCL);
#pragma unroll 1
    for (int e0 = 0; e0 < 128; e0 += 2) {
      const int id0 = __builtin_amdgcn_readfirstlane(wli[128 + e0]), id1 = __builtin_amdgcn_readfirstlane(wli[128 + e0 + 1]);
      const float g0 = wl[256 + e0], g1 = wl[256 + e0 + 1];
      v4u ur0[2], ur1[2], vr0[2], vr1[2];
#pragma unroll
      for (int i = 0; i < 2; ++i) { ur0[i] = ((const v4u*)(U8 + (size_t)id0 * DM))[i * 64 + lane]; ur1[i] = ((const v4u*)(U8 + (size_t)id1 * DM))[i * 64 + lane]; }
#pragma unroll
      for (int i = 0; i < 2; ++i) { vr0[i] = ((const v4u*)(V8 + (size_t)id0 * DM))[i * 64 + lane]; vr1[i] = ((const v4u*)(V8 + (size_t)id1 * DM))[i * 64 + lane]; }
      const float su0 = SCL[id0], su1 = SCL[id1], sv0 = SCL[16384 + id0], sv1 = SCL[16384 + id1];
      float d0 = 0.f, d1 = 0.f;
#pragma unroll
      for (int i = 0; i < 2; ++i)
#pragma unroll
        for (int c = 0; c < 4; ++c) { const int wa = (int)ur0[i][c], wb = (int)ur1[i][c];
          const f32x2v a0 = __builtin_amdgcn_cvt_pk_f32_fp8(wa, false), a1 = __builtin_amdgcn_cvt_pk_f32_fp8(wa, true);
          const f32x2v b0 = __builtin_amdgcn_cvt_pk_f32_fp8(wb, false), b1 = __builtin_amdgcn_cvt_pk_f32_fp8(wb, true);
          const float x0 = xs[i * 16 + 4 * c], x1 = xs[i * 16 + 4 * c + 1], x2 = xs[i * 16 + 4 * c + 2], x3 = xs[i * 16 + 4 * c + 3];
          d0 += x0 * a0.x + x1 * a0.y + x2 * a1.x + x3 * a1.y; d1 += x0 * b0.x + x1 * b0.y + x2 * b1.x + x3 * b1.y; }
      d0 = wave_sum(d0); d1 = wave_sum(d1);
      const float c0 = gelu_erf(d0 * (rs * su0)) * (g0 * sv0), c1 = gelu_erf(d1 * (rs * su1)) * (g1 * sv1);
#pragma unroll
      for (int i = 0; i < 2; ++i)
#pragma unroll
        for (int c = 0; c < 4; ++c) { const int wa = (int)vr0[i][c], wb = (int)vr1[i][c];
          const f32x2v a0 = __builtin_amdgcn_cvt_pk_f32_fp8(wa, false), a1 = __builtin_amdgcn_cvt_pk_f32_fp8(wa, true);
          const f32x2v b0 = __builtin_amdgcn_cvt_pk_f32_fp8(wb, false), b1 = __builtin_amdgcn_cvt_pk_f32_fp8(wb, true);
          y[i * 16 + 4 * c] += c0 * a0.x + c1 * b0.x; y[i * 16 + 4 * c + 1] += c0 * a0.y + c1 * b0.y; y[i * 16 + 4 * c + 2] += c0 * a1.x + c1 * b1.x; y[i * 16 + 4 * c + 3] += c0 * a1.y + c1 * b1.y; }
    }
    float* orow = out + (size_t)tok * DM; float* drow = dst_base + (size_t)tok * DM;
#pragma unroll
    for (int i = 0; i < 2; ++i)
#pragma unroll
      for (int q = 0; q < 4; ++q) { const size_t off = (size_t)(i * 64 + lane) * 16 + q * 4; f32x4 hv = *(const f32x4*)(orow + off);
        hv.x += y[i * 16 + 4 * q]; hv.y += y[i * 16 + 4 * q + 1]; hv.z += y[i * 16 + 4 * q + 2]; hv.w += y[i * 16 + 4 * q + 3]; *(f32x4*)(drow + off) = hv; }
  }
}
constexpr int MISC_LDS = LDS_BYTES - 256;
__global__ void __launch_bounds__(NTHR, 2) mk_fwd(Args args) {
  extern __shared__ __attribute__((aligned(16))) unsigned char lds_raw[];
  Frame F; F.lds = (LAS unsigned char*)lds_raw; F.ws = args.ws; F.tid = threadIdx.x; F.lane = F.tid & 63; F.wave = __builtin_amdgcn_readfirstlane(F.tid >> 6);
  const int lo = args.ph_lo, hi = args.ph_hi, G = (int)gridDim.x, bx = (int)blockIdx.x;
  volatile LAS unsigned* misc = (volatile LAS unsigned*)(F.lds + MISC_LDS);
  if (F.tid < 16) misc[F.tid] = 0u;
  __syncthreads();
  XcdBarrier bar = xcd_barrier_post((unsigned*)(F.ws + WS_CTL) + CW_BAR, misc);
#define IN(k) (lo <= (k) && (k) < hi)
#define SEAM(k) do { if (IN(k) && IN((k) + 1)) xcd_barrier(bar); } while (0)
  const bool split = (G % 8 == 0) && (G >= 64);
  const int NA = split ? G - 32 : G;
  if (IN(0)) {
    p0_lam(F, args);
    p0_zero_vpad(F);
    p0_metaproj(F, args);
    p0_rows(F, args);
    p0_transpose(F, args.in[IN_WIN], DPROJ, NPROJ, (bf16*)(F.ws + WS_W1T));
    p0_transpose(F, args.in[IN_WOUT], DM, DM, (bf16*)(F.ws + WS_W2T));
    p0_w3t(F, args);
    p0_tables(F, args);
  }
  SEAM(0);
  if (IN(1)) {
    p1_meta_finalize(F, args);
    pg8::Gemm g{(const pg8::bf16_t*)(F.ws + WS_XN), (const pg8::bf16_t*)(F.ws + WS_W1T), MROWS, NPROJ, DM};
    pg8::StaticOrder S; S.init(MROWS, NPROJ, G, bx);
    EpiProj E{(bf16*)(F.ws + WS_Q), (bf16*)(F.ws + WS_KP), (bf16*)(F.ws + WS_VP), (bf16*)(F.ws + WS_MQ), (bf16*)(F.ws + WS_MK), (bf16*)(F.ws + WS_MV), (bf16*)(F.ws + WS_MO),
              args.in[IN_QNG], args.in[IN_KNG], (LAS float*)(F.lds + XCH_OFF)};
    pg8::gemm_phase<EpiProj, pg8::StaticOrder, true, true>(F.lds + RING_OFF, g, S, E);
  }
  SEAM(1);
  if (IN(2)) {
    if (split) {
      const int rowi = bx >> 3, xc = bx & 7, na8 = NA >> 3;
      if (rowi >= na8) ml::item(F, args, (rowi - na8) * 8 + xc);
      else att::phase(F, xc * na8 + rowi, NA);
    } else {
      att::phase(F, bx, NA);
      for (int it = bx; it < 32; it += G) ml::item(F, args, it);
    }
  }
  SEAM(2);
  if (IN(3)) p3_combine(F, args, NA);
  SEAM(3);
  if (IN(4)) {
    pg8::Gemm g{(const pg8::bf16_t*)(F.ws + WS_A2), (const pg8::bf16_t*)(F.ws + WS_W2T), MROWS, DM, DM};
    pg8::StaticOrder S; S.init(MROWS, DM, G, bx);
    EpiRes E{args.in[IN_X], args.out, (bf16*)(F.ws + WS_H1B), (float*)(F.ws + WS_SSQ)};
    pg8::gemm_phase<EpiRes, pg8::StaticOrder, true, true>(F.lds + RING_OFF, g, S, E);
  }
  SEAM(4);
  if (IN(5)) {
    pg8::Gemm g{(const pg8::bf16_t*)(F.ws + WS_H1B), (const pg8::bf16_t*)(F.ws + WS_W3T), MROWS, DM, DM};
    pg8::StaticOrder S; S.init(MROWS, DM, G, bx);
    LAS float* rst = (LAS float*)(F.lds + XCH_OFF);
    { pg8::Unit u0; if (S.next(0, u0)) { if (F.tid < 256) { const float* sp = (const float*)(F.ws + WS_SSQ) + ((size_t)u0.pm * 256 + F.tid) * 32; float s = 0.f;
#pragma unroll
          for (int i = 0; i < 8; ++i) { const f32x4 v = ((const f32x4*)sp)[i]; s += (v.x + v.y) + (v.z + v.w); }
          rst[F.tid] = rsqrtf(s * (1.0f / DM) + EPS); } } }
    __syncthreads();
    EpiScore E{(float*)(F.ws + WS_S), rst};
    pg8::gemm_phase<EpiScore, pg8::StaticOrder, true, true>(F.lds + RING_OFF, g, S, E);
  }
  SEAM(5);
  if (IN(6)) p6_peer(F, args, args.out);
#undef IN
#undef SEAM
}
extern "C" void kernel_launch(void* const* d_in, const int* in_sizes, int n_in, void* d_out, int out_size, void* d_ws, size_t ws_size, hipStream_t stream) {
  static int grid = 0;
  if (grid == 0) {
    int dev = 0, cus = 0, per_cu = 0;
    if (hipGetDevice(&dev) != hipSuccess || hipDeviceGetAttribute(&cus, hipDeviceAttributeMultiprocessorCount, dev) != hipSuccess) { fprintf(stderr, "device query failed\n"); grid = -1; return; }
    if (hipFuncSetAttribute((const void*)mk_fwd, hipFuncAttributeMaxDynamicSharedMemorySize, LDS_BYTES) != hipSuccess) { fprintf(stderr, "hipFuncSetAttribute failed\n"); grid = -1; return; }
    if (hipOccupancyMaxActiveBlocksPerMultiprocessor(&per_cu, (const void*)mk_fwd, NTHR, LDS_BYTES) != hipSuccess || per_cu < 1) { fprintf(stderr, "occupancy query says %d workgroups per CU: not launching\n", per_cu); (void)hipGetLastError(); grid = -1; return; }
    (void)hipGetLastError();
    grid = cus;
    if (n_in != 22 || ws_size < (size_t)512 * MiB || out_size != MROWS * DM) { fprintf(stderr, "unexpected shapes: n_in %d out %d ws %zu\n", n_in, out_size, ws_size); grid = -1; return; }
  }
  if (grid < 0) return;
  unsigned char* ws = (unsigned char*)d_ws;
  if (hipMemsetAsync(ws + WS_CTL, 0, CTL_ZERO_BYTES, stream) != hipSuccess) { fprintf(stderr, "memset failed\n"); return; }
  Args a{};
  for (int i = 0; i < 22; ++i) a.in[i] = (const float*)d_in[i];
  a.out = (float*)d_out; a.ws = ws; a.na = 0; a.pad = 0;
  a.ph_lo = 0; a.ph_hi = 7;
  hipLaunchKernelGGL(mk_fwd, dim3(grid), dim3(NTHR), LDS_BYTES, stream, a);
}
```

```cpp
#include <hip/hip_runtime.h>
#include <cstdio>
#include <cstdint>
#include <math.h>
namespace pg8 {
#define PG8_LAS __attribute__((address_space(3)))
typedef unsigned short bf16_t;
typedef short bf16x8 __attribute__((ext_vector_type(8)));
typedef float f32x4 __attribute__((ext_vector_type(4)));
typedef unsigned u32x4 __attribute__((ext_vector_type(4)));
constexpr int BM = 256, BK = 64, HALF = 128, HTB = HALF * BK * 2  , STAGE_BYTES = 8 * HTB, NXCD = 8, WGM = 8;

__host__ __device__ __forceinline__ int lds_byte(int r, int c) { const int st = (r >> 4) * 2 + (c >> 5), rr = r & 15, cc = c & 31, ob = rr * 64 + cc * 2; return st * 1024 + (ob ^ (((ob >> 9) & 1) << 5)); }
__host__ __device__ __forceinline__ void stage_rc(int b, int& R, int& C) { const int st = b / 1024, sb = b % 1024, swz = sb ^ (((sb >> 9) & 1) << 5); R = (st >> 1) * 16 + swz / 64; C = (st & 1) * 32 + (swz % 64) / 2; }
__host__ __device__ __forceinline__ int perm32(int rho) { const int n = rho >> 4, i = rho & 15; return 8 * (i >> 2) + 4 * n + (i & 3); }

struct Unit { int pm, pn; };
struct Gemm { const bf16_t* A; const bf16_t* Bt; int M, N, K; };

struct StaticOrder {
    int nM, nN, nwg, G, c;
    __host__ __device__ void init(int M, int N, int G_, int c_) { nM = M / BM; nN = N / BM; nwg = nM * nN; G = G_; c = c_; }
    __host__ __device__ bool next(int i, Unit& u) const {
        const long L = (long)i * G + c; if (L >= nwg) return false;
        int wgid = (int)L; { const int q = nwg / NXCD, r = nwg % NXCD, xcd = wgid % NXCD, off = wgid / NXCD; wgid = (xcd < r ? xcd * (q + 1) : r * (q + 1) + (xcd - r) * q) + off; }
        const int nig = WGM * nN, gid = wgid / nig, fm = gid * WGM, gsz = (nM - fm) < WGM ? (nM - fm) : WGM;
        u.pm = fm + ((wgid % nig) % gsz); u.pn = (wgid % nig) / gsz; return true;
    }
    __device__ __forceinline__ void a_ready(const Unit&) const {}
    __device__ __forceinline__ void done(const Unit&) const {}
};

__device__ __forceinline__ unsigned cvt_pk_bf16(float lo, float hi) { unsigned r; asm volatile("v_cvt_pk_bf16_f32 %0, %1, %2" : "=v"(r) : "v"(lo), "v"(hi)); return r; }
typedef float f32x2 __attribute__((ext_vector_type(2)));
template <class Epi, class Sched, bool ALIGN_EPI = false, bool SP2 = false>
__device__ __forceinline__ void gemm_phase(PG8_LAS unsigned char* lds, const Gemm g, const Sched& S, const Epi& E) {
    const int tid = threadIdx.x, wid = __builtin_amdgcn_readfirstlane(tid >> 6), lane = tid & 63, wr = wid >> 2, wc = wid & 3, fr = lane & 15, fq = lane >> 4;
    const int K = g.K, nt = K / BK;
    unsigned voffA[2], voffB[2];
#pragma unroll
    for (int i = 0; i < 2; ++i) { int R, C; stage_rc(tid * 16 + i * 8192, R, C); const int Rb = Epi::PERM ? ((R & ~31) + perm32(R & 31)) : R;
        voffA[i] = (unsigned)(R * K + C) * 2u; voffB[i] = (unsigned)(Rb * K + C) * 2u; }
    const size_t kstep = (size_t)(BK * 2);
    const size_t hstep = (size_t)HALF * K * 2;
    const size_t tstep = 2 * hstep;
    const unsigned ldsw = (unsigned)wid * 1024u;
    const int aoff = lds_byte(wr * 64 + fr, fq * 8), boff = lds_byte(wc * 32 + fr, fq * 8);
#define PG8_SA(b, h) (((b) * 2 + (h)) * HTB)
#define PG8_SB(b, h) ((4 + (b) * 2 + (h)) * HTB)
#define PG8_STAGE(bufoff, gbase, voff) do { _Pragma("unroll") for (int _i = 0; _i < 2; ++_i) \
        __builtin_amdgcn_global_load_lds((const unsigned*)((const char*)(gbase) + (voff)[_i]), (PG8_LAS unsigned*)(lds + (bufoff) + ldsw + _i * 8192), 16, 0, 0); } while (0)
#define PG8_LDA(dst, b, h) do { _Pragma("unroll") for (int m = 0; m < 4; ++m) _Pragma("unroll") for (int k = 0; k < 2; ++k) dst[m][k] = *(const PG8_LAS bf16x8*)(lds + PG8_SA(b, h) + aoff + m * 2048 + k * 1024); } while (0)
#define PG8_LDB(dst, b, h) do { _Pragma("unroll") for (int n = 0; n < 2; ++n) _Pragma("unroll") for (int k = 0; k < 2; ++k) dst[n][k] = *(const PG8_LAS bf16x8*)(lds + PG8_SB(b, h) + boff + n * 2048 + k * 1024); } while (0)
#define PG8_MMA(ai, bj, At, Bt) do { __builtin_amdgcn_s_setprio(1); _Pragma("unroll") for (int m = 0; m < 4; ++m) _Pragma("unroll") for (int n = 0; n < 2; ++n) _Pragma("unroll") for (int k = 0; k < 2; ++k) \
        acc[ai][bj][m][n] = __builtin_amdgcn_mfma_f32_16x16x32_bf16(Bt[n][k], At[m][k], acc[ai][bj][m][n], 0, 0, 0); __builtin_amdgcn_s_setprio(0); } while (0)
#define PG8_WAIT_V(n) asm volatile("s_waitcnt vmcnt(" #n ")" ::: "memory")
#define PG8_WAIT_L(n) asm volatile("s_waitcnt lgkmcnt(" #n ")" ::: "memory")
#define PG8_BAR __builtin_amdgcn_s_barrier()
#define PG8_SCHED __builtin_amdgcn_sched_barrier(0)
    Unit cur, nxt; int ui = 0;
    if (!S.next(0, cur)) return;
    f32x4 acc[2][2][4][2];
#pragma unroll
    for (int a = 0; a < 2; ++a)
#pragma unroll
        for (int b = 0; b < 2; ++b)
#pragma unroll
            for (int m = 0; m < 4; ++m)
#pragma unroll
                for (int n = 0; n < 2; ++n) acc[a][b][m][n] = (f32x4){0.f, 0.f, 0.f, 0.f};
    bf16x8 At[4][2], B0[2][2], B1[2][2];
    const char* cA = (const char*)g.A + (size_t)cur.pm * tstep; const char* cB = (const char*)g.Bt + (size_t)cur.pn * tstep;
    S.a_ready(cur);
    if constexpr (SP2) {
        PG8_STAGE(PG8_SB(0, 0), cB, voffB); PG8_STAGE(PG8_SB(0, 1), cB + hstep, voffB); PG8_STAGE(PG8_SA(0, 0), cA, voffA); PG8_STAGE(PG8_SA(0, 1), cA + hstep, voffA);
        if (wr == 1) PG8_BAR;
        PG8_WAIT_V(2); PG8_BAR;
        PG8_STAGE(PG8_SB(1, 0), cB + kstep, voffB); PG8_STAGE(PG8_SA(1, 0), cA + kstep, voffA); PG8_STAGE(PG8_SB(1, 1), cB + hstep + kstep, voffB);
        PG8_WAIT_V(6); PG8_BAR;
    } else {
        PG8_STAGE(PG8_SB(0, 0), cB, voffB); PG8_STAGE(PG8_SA(0, 0), cA, voffA); PG8_STAGE(PG8_SB(0, 1), cB + hstep, voffB); PG8_STAGE(PG8_SA(0, 1), cA + hstep, voffA);
        if (wr == 1) PG8_BAR;
        PG8_WAIT_V(4); PG8_BAR;
        PG8_STAGE(PG8_SB(1, 0), cB + kstep, voffB); PG8_STAGE(PG8_SA(1, 0), cA + kstep, voffA); PG8_STAGE(PG8_SB(1, 1), cB + hstep + kstep, voffB);
        PG8_WAIT_V(6); PG8_BAR;
    }
    for (;;) {
        const bool has_next = S.next(ui + 1, nxt);
        const char* nA = has_next ? (const char*)g.A + (size_t)nxt.pm * tstep : cA; const char* nB = has_next ? (const char*)g.Bt + (size_t)nxt.pn * tstep : cB;
        for (int t = 0; t < nt; t += 2) {
            const bool last = (t == nt - 2);
            const char* a1 = cA + (size_t)(t + 1) * kstep;
            const char* a2 = last ? nA : cA + (size_t)(t + 2) * kstep; const char* b2 = last ? nB : cB + (size_t)(t + 2) * kstep;
            const char* a3 = a2 + kstep; const char* b3 = b2 + kstep;
            if (last && has_next) S.a_ready(nxt);
            if constexpr (SP2) {
            PG8_LDB(B0, 0, 0); PG8_LDB(B1, 0, 1); PG8_SCHED; PG8_LDA(At, 0, 0); PG8_STAGE(PG8_SA(1, 1), a1 + hstep, voffA);
            PG8_WAIT_V(8); PG8_WAIT_L(0); PG8_BAR; PG8_MMA(0, 0, At, B0); PG8_MMA(0, 1, At, B1); PG8_BAR; PG8_SCHED;
            PG8_LDA(At, 0, 1); PG8_STAGE(PG8_SB(0, 0), b2, voffB); PG8_STAGE(PG8_SB(0, 1), b2 + hstep, voffB); PG8_STAGE(PG8_SA(0, 0), a2, voffA);
            PG8_WAIT_V(8); PG8_WAIT_L(0); PG8_BAR; PG8_MMA(1, 0, At, B0); PG8_MMA(1, 1, At, B1); PG8_BAR; PG8_SCHED;
            PG8_LDB(B0, 1, 0); PG8_LDB(B1, 1, 1); PG8_SCHED; PG8_LDA(At, 1, 0); PG8_STAGE(PG8_SA(0, 1), a2 + hstep, voffA);
            PG8_WAIT_V(8); PG8_WAIT_L(0); PG8_BAR; PG8_MMA(0, 0, At, B0); PG8_MMA(0, 1, At, B1); PG8_BAR; PG8_SCHED;
            PG8_LDA(At, 1, 1); PG8_STAGE(PG8_SB(1, 0), b3, voffB); PG8_STAGE(PG8_SB(1, 1), b3 + hstep, voffB); PG8_STAGE(PG8_SA(1, 0), a3, voffA);
            PG8_WAIT_V(8); PG8_WAIT_L(0); PG8_BAR; PG8_MMA(1, 0, At, B0); PG8_MMA(1, 1, At, B1); PG8_BAR; PG8_SCHED;
            } else {
            PG8_LDB(B0, 0, 0); PG8_SCHED; PG8_LDA(At, 0, 0); PG8_STAGE(PG8_SA(1, 1), a1 + hstep, voffA);
            PG8_WAIT_L(8); PG8_BAR; PG8_WAIT_L(0); PG8_MMA(0, 0, At, B0); PG8_BAR; PG8_SCHED;
            PG8_LDB(B1, 0, 1); PG8_STAGE(PG8_SB(0, 0), b2, voffB);
            PG8_BAR; PG8_WAIT_L(0); PG8_MMA(0, 1, At, B1); PG8_BAR;
            PG8_LDA(At, 0, 1); PG8_STAGE(PG8_SA(0, 0), a2, voffA);
            PG8_BAR; PG8_WAIT_L(0); PG8_MMA(1, 0, At, B0); PG8_BAR; PG8_SCHED;
            PG8_STAGE(PG8_SB(0, 1), b2 + hstep, voffB);
            PG8_WAIT_V(6); PG8_BAR; PG8_MMA(1, 1, At, B1); PG8_BAR;
            PG8_LDB(B0, 1, 0); PG8_SCHED; PG8_LDA(At, 1, 0); PG8_STAGE(PG8_SA(0, 1), a2 + hstep, voffA);
            PG8_WAIT_L(8); PG8_BAR; PG8_WAIT_L(0); PG8_MMA(0, 0, At, B0); PG8_BAR; PG8_SCHED;
            PG8_LDB(B1, 1, 1); PG8_STAGE(PG8_SB(1, 0), b3, voffB);
            PG8_BAR; PG8_WAIT_L(0); PG8_MMA(0, 1, At, B1); PG8_BAR;
            PG8_LDA(At, 1, 1); PG8_STAGE(PG8_SA(1, 0), a3, voffA);
            PG8_BAR; PG8_WAIT_L(0); PG8_MMA(1, 0, At, B0); PG8_BAR; PG8_SCHED;
            PG8_STAGE(PG8_SB(1, 1), b3 + hstep, voffB);
            PG8_WAIT_V(6); PG8_BAR; PG8_MMA(1, 1, At, B1); PG8_BAR;
            }
        }
        if constexpr (ALIGN_EPI) { if (wr == 0) PG8_BAR; }
        if constexpr (!Epi::AFTER_DRAIN) { E(acc, cur, wr, wc, fr, fq); S.done(cur); }
        if (!has_next) break;
#pragma unroll
        for (int a = 0; a < 2; ++a)
#pragma unroll
            for (int b = 0; b < 2; ++b)
#pragma unroll
                for (int m = 0; m < 4; ++m)
#pragma unroll
                    for (int n = 0; n < 2; ++n) acc[a][b][m][n] = (f32x4){0.f, 0.f, 0.f, 0.f};
        cur = nxt; cA = nA; cB = nB; ++ui;
        if constexpr (ALIGN_EPI) { if (wr == 1) PG8_BAR; }
    }
    PG8_WAIT_V(0);
    if constexpr (!ALIGN_EPI) { if (wr == 0) PG8_BAR; }
    PG8_BAR;
    if constexpr (Epi::AFTER_DRAIN) { E.fused(acc, cur, wr, wc, fr, fq, lds, wid, lane); S.done(cur); }
#undef PG8_SA
#undef PG8_SB
#undef PG8_STAGE
#undef PG8_LDA
#undef PG8_LDB
#undef PG8_MMA
#undef PG8_WAIT_V
#undef PG8_WAIT_L
#undef PG8_BAR
#undef PG8_SCHED
}
}
#define GAS __attribute__((address_space(1)))
#define LAS __attribute__((address_space(3)))
typedef unsigned short bf16;
typedef unsigned v4u __attribute__((ext_vector_type(4)));
typedef unsigned v2u __attribute__((ext_vector_type(2)));
typedef float f32x4 __attribute__((ext_vector_type(4)));
typedef short bf16x8 __attribute__((ext_vector_type(8)));
#define LDS_WAIT() asm volatile("s_waitcnt lgkmcnt(0)" ::: "memory")
#define VM_WAIT() asm volatile("s_waitcnt vmcnt(0)" ::: "memory")

constexpr int DM = 2048, NB = 4, SEQ = 2048, NMETA = 16, MROWS = NB * SEQ, DPROJ = 6152, NPROJ = 6144;
constexpr int PADT = 2112, POS0 = 64, MPOS0 = 48;
constexpr float EPS = 1e-6f;
constexpr float LOG2E = 1.4426950408889634f;
constexpr float QSCALE = 0.08838834764831845f * LOG2E;
constexpr int NWAVES = 8, NTHR = 512;

constexpr size_t MiB = 1u << 20;
constexpr size_t WS_CTL = 0, CTL_ZERO_BYTES = 1 * MiB;
constexpr size_t WS_PM = 512 * 1024;
constexpr size_t WS_W1T = 2 * MiB, WS_W2T = 26 * MiB, WS_W3T = 34 * MiB, WS_XN = 42 * MiB;
constexpr size_t WS_Q = 74 * MiB, WS_KP = 90 * MiB, WS_VP = 107 * MiB, WS_MQ = 124 * MiB, WS_MK = 133 * MiB, WS_MV = 142 * MiB, WS_MO = 159 * MiB;
constexpr size_t WS_SMALL = 175 * MiB;
constexpr size_t WS_XM = WS_SMALL, WS_LI = WS_SMALL + 128 * 1024, WS_LF = WS_SMALL + 384 * 1024, WS_LAM = WS_SMALL + 640 * 1024;
constexpr size_t WS_PO = 176 * MiB, WS_ML = 304 * MiB, WS_HM = 305 * MiB, WS_A2 = 42 * MiB, WS_H1B = 74 * MiB, WS_SSQ = 106 * MiB, WS_S = 176 * MiB, WS_UB = 384 * MiB, WS_VB = 448 * MiB;
constexpr size_t WS_SCL = WS_SMALL + 704 * 1024;
constexpr size_t WS_VB8 = WS_UB + 32 * MiB;
constexpr size_t WS_DC = 305 * MiB, WS_CS = 448 * MiB, WS_DN = 482 * MiB, WS_NS = WS_DN + 512 * 1024, WS_GS = WS_DN + 1024 * 1024, WS_MS = WS_DN + 1152 * 1024;
constexpr int CW_BAR = 4096;

constexpr int RING_OFF = 0, RING_BYTES = 131072;
constexpr int XCH_OFF = 131072;
constexpr int MISC_OFF = XCH_OFF + 8192;
constexpr int LDS_BYTES = 155648;

__device__ __forceinline__ unsigned f2bf(float f) { unsigned u = __builtin_bit_cast(unsigned, f); return (u + 0x7fffu + ((u >> 16) & 1u)) >> 16; }
__device__ __forceinline__ unsigned pk2(float lo, float hi) { return f2bf(lo) | (f2bf(hi) << 16); }
__device__ __forceinline__ float bf2f(unsigned short u) { return __builtin_bit_cast(float, (unsigned)u << 16); }
__device__ __forceinline__ float bflo(unsigned w) { return __builtin_bit_cast(float, w << 16); }
__device__ __forceinline__ float bfhi(unsigned w) { return __builtin_bit_cast(float, w & 0xffff0000u); }
__device__ __forceinline__ float wave_sum(float v) {
#pragma unroll
  for (int o = 1; o < 64; o <<= 1) v += __shfl_xor(v, o);
  return v;
}
__device__ __forceinline__ size_t kp_off(int bhm, int pos, int d) { const int j = pos >> 6, row = pos & 63, d0 = d >> 4, hi = (d >> 3) & 1;
  return ((size_t)(bhm * 33 + j) * 8 + d0) * 1024 + (size_t)((((row << 1) | hi) ^ ((row >> 3) & 1)) << 3) + (d & 7); }
__device__ __forceinline__ float sigmoidf_(float x) { return 1.0f / (1.0f + __expf(-x)); }
#define XB_TMO      128
#define XB_XCNT(j)  (256  + 64 * (j))
#define XB_XSUB(j)  (1280 + 64 * (j))
#define XB_XGEN(j)  (2304 + 64 * (j))
#define XB_TOP      3328
#define XB_TOPGEN   3392
#define XCD_BAR_WORDS 3456
#define XB_SPIN_CAP (1u << 18)

__device__ __forceinline__ unsigned xb_ld(unsigned* p)              { return __hip_atomic_load(p, __ATOMIC_RELAXED, __HIP_MEMORY_SCOPE_AGENT); }
__device__ __forceinline__ unsigned xb_add(unsigned* p, unsigned v) { return __hip_atomic_fetch_add(p, v, __ATOMIC_RELAXED, __HIP_MEMORY_SCOPE_AGENT); }
__device__ __forceinline__ unsigned xb_xcc_id() { return (unsigned)__builtin_amdgcn_s_getreg((3 << 11) | 20) & 0xFu; }
#define XB_SPIN(cond, bar) do { unsigned _sp = 0; while (cond) { __builtin_amdgcn_s_sleep(1); \
    if ((++_sp & 255u) == 0u) { if (xb_ld(&(bar)[XB_TMO])) break; if (_sp > XB_SPIN_CAP) { atomicAdd(&(bar)[XB_TMO], 1u); break; } } } } while (0)

struct XcdBarrier {
    unsigned* bar; unsigned x;
    volatile LAS unsigned* st;
};

__device__ __forceinline__ XcdBarrier xcd_barrier_post(unsigned* bar, volatile LAS unsigned* st) {
    XcdBarrier b; b.bar = bar; b.x = xb_xcc_id(); b.st = st;
    if (threadIdx.x == 0) (void)xb_add(&bar[XB_XCNT(b.x)], 1u);
    return b;
}
__device__ __forceinline__ void xcd_barrier_complete(unsigned* bar, unsigned x, unsigned& nloc, unsigned& nx) {
    const unsigned G = gridDim.x * gridDim.y * gridDim.z;
    unsigned sum, cnt, mine, sp = 0u;
    for (;;) {
        sum = 0u; cnt = 0u; mine = 0u;
#pragma unroll
        for (unsigned j = 0; j < 16; ++j) { const unsigned c = xb_ld(&bar[XB_XCNT(j)]); sum += c; cnt += (c > 0u) ? 1u : 0u; mine = (j == x) ? c : mine; }
        if (sum == G) break;
        __builtin_amdgcn_s_sleep(1);
        if ((++sp & 255u) == 0u) { if (xb_ld(&bar[XB_TMO])) break; if (sp > XB_SPIN_CAP) { atomicAdd(&bar[XB_TMO], 1u); break; } }
    }
    nloc = mine > 0u ? mine : 1u; nx = cnt > 0u ? cnt : 1u;
}

__device__ __forceinline__ void xcd_barrier(const XcdBarrier& b) {
    asm volatile("s_waitcnt vmcnt(0)" ::: "memory");
    __syncthreads();
    if (threadIdx.x == 0) {
        unsigned* bar = b.bar;
        __builtin_amdgcn_s_waitcnt(0);
        unsigned nloc = b.st[0], nx = b.st[1];
        if (nloc == 0u) { xcd_barrier_complete(bar, b.x, nloc, nx); b.st[0] = nloc; b.st[1] = nx; }
        const unsigned old = xb_add(&bar[XB_XSUB(b.x)], 1u);
        const unsigned gen = old / nloc;
        if (old + 1u == (gen + 1u) * nloc) {
            __builtin_amdgcn_fence(__ATOMIC_RELEASE, "agent");
            asm volatile("s_waitcnt vmcnt(0)" ::: "memory");
            const unsigned og = xb_add(&bar[XB_TOP], 1u);
            const unsigned tg = og / nx;
            if (og + 1u == (tg + 1u) * nx) xb_add(&bar[XB_TOPGEN], 1u);
            else XB_SPIN(xb_ld(&bar[XB_TOPGEN]) == tg, bar);
            __builtin_amdgcn_fence(__ATOMIC_ACQUIRE, "agent");
            xb_add(&bar[XB_XGEN(b.x)], 1u);
            asm volatile("s_waitcnt vmcnt(0)" ::: "memory");
        } else {
            XB_SPIN(xb_ld(&bar[XB_XGEN(b.x)]) == gen, bar);
            __builtin_amdgcn_fence(__ATOMIC_ACQUIRE, "agent");
            asm volatile("s_waitcnt vmcnt(0)" ::: "memory");
        }
    }
    __syncthreads();
}

struct Args { const float* in[22]; float* out; unsigned char* ws; int ph_lo, ph_hi, na, pad; };
struct Frame {
  LAS unsigned char* lds; unsigned char* ws; int tid, lane, wave; const float* const* in;
};
#define IN_X 0
#define IN_META 1
#define IN_G1 2
#define IN_WIN 3
#define IN_CW 4
#define IN_CB 5
#define IN_IGB 6
#define IN_FGB 7
#define IN_LQ1 8
#define IN_LK1 9
#define IN_LQ2 10
#define IN_LK2 11
#define IN_QNG 12
#define IN_KNG 13
#define IN_SUBG 14
#define IN_OUTG 15
#define IN_WOUT 16
#define IN_G2 17
#define IN_WQ 18
#define IN_SUBK 19
#define IN_U 20
#define IN_V 21

__device__ __forceinline__ void p0_rows(const Frame& F, const Args& a) {
  const float* x = a.in[IN_X]; const float* meta = a.in[IN_META]; const float* g1 = a.in[IN_G1]; const float* w_in = a.in[IN_WIN];
  const float* igb = a.in[IN_IGB]; const float* fgb = a.in[IN_FGB];
  bf16* Xn = (bf16*)(F.ws + WS_XN); bf16* Xm = (bf16*)(F.ws + WS_XM); float* LI = (float*)(F.ws + WS_LI); float* LF = (float*)(F.ws + WS_LF);
  LAS f32x4* wgl = (LAS f32x4*)(F.lds);
  for (int e = F.tid; e < 4096; e += NTHR) {
    const int ln = e & 63, q = e >> 6, half = q & 1, j = (q >> 1) & 3, i = q >> 3;
    const int k = 4 * (i * 64 + ln) + j;
    wgl[e] = *(const f32x4*)(w_in + (size_t)k * DPROJ + NPROJ + 4 * half);
  }
  __syncthreads();
  const int gw = blockIdx.x * NWAVES + F.wave, NGW = gridDim.x * NWAVES, lane = F.lane;
  for (int task = gw; task < MROWS / 2 + NMETA / 2; task += NGW) {
    const bool ismeta = task >= MROWS / 2;
    const int r0 = ismeta ? (task - MROWS / 2) * 2 : task * 2;
    const float* src0 = (ismeta ? meta : x) + (size_t)r0 * DM;
    float rs[2];
    { float s0 = 0.f, s1 = 0.f;
#pragma unroll 2
      for (int i = 0; i < 8; ++i) { const f32x4 a0 = ((const f32x4*)src0)[i * 64 + lane], a1 = ((const f32x4*)(src0 + DM))[i * 64 + lane];
        s0 += (a0.x * a0.x + a0.y * a0.y) + (a0.z * a0.z + a0.w * a0.w); s1 += (a1.x * a1.x + a1.y * a1.y) + (a1.z * a1.z + a1.w * a1.w); }
      rs[0] = rsqrtf(wave_sum(s0) * (1.0f / DM) + EPS); rs[1] = rsqrtf(wave_sum(s1) * (1.0f / DM) + EPS); }
    float ga[2][8];
#pragma unroll
    for (int rr = 0; rr < 2; ++rr)
#pragma unroll
      for (int g = 0; g < 8; ++g) ga[rr][g] = 0.f;
    bf16* dst0 = (ismeta ? Xm : Xn) + (size_t)r0 * DM;
#pragma unroll 1
    for (int i = 0; i < 8; ++i) {
      const f32x4 g = ((const f32x4*)g1)[i * 64 + lane];
      f32x4 xn[2];
#pragma unroll
      for (int rr = 0; rr < 2; ++rr) { xn[rr] = ((const f32x4*)(src0 + (size_t)rr * DM))[i * 64 + lane] * g * rs[rr];
        v2u o; o.x = pk2(xn[rr].x, xn[rr].y); o.y = pk2(xn[rr].z, xn[rr].w); ((v2u*)(dst0 + (size_t)rr * DM))[i * 64 + lane] = o; }
#pragma unroll
      for (int j = 0; j < 4; ++j) {
        const f32x4 w0 = wgl[((i * 4 + j) * 2 + 0) * 64 + lane], w1 = wgl[((i * 4 + j) * 2 + 1) * 64 + lane];
#pragma unroll
        for (int rr = 0; rr < 2; ++rr) { const float xv = xn[rr][j];
          ga[rr][0] += xv * w0.x; ga[rr][1] += xv * w0.y; ga[rr][2] += xv * w0.z; ga[rr][3] += xv * w0.w;
          ga[rr][4] += xv * w1.x; ga[rr][5] += xv * w1.y; ga[rr][6] += xv * w1.z; ga[rr][7] += xv * w1.w; }
      }
    }
#pragma unroll
    for (int rr = 0; rr < 2; ++rr)
#pragma unroll
      for (int g = 0; g < 8; ++g) ga[rr][g] = wave_sum(ga[rr][g]);
    if (lane < 8) {
      const int rr = lane >> 2, h = lane & 3;
      float gi = 0.f, gf = 0.f;
#pragma unroll
      for (int q = 0; q < 2; ++q)
#pragma unroll
        for (int hh = 0; hh < 4; ++hh) if (q == rr && hh == h) { gi = ga[q][hh]; gf = ga[q][4 + hh]; }
      const float li = gi + igb[h]; const float fx = gf + fgb[h];
      const float lf = fminf(fx, 0.f) - log1pf(__expf(-fabsf(fx)));
      const int R = r0 + rr;
      if (!ismeta) { const int b = R >> 11, t = R & 2047; LI[(b * 4 + h) * PADT + POS0 + t] = li; LF[(b * 4 + h) * PADT + POS0 + t] = lf; }
      else { for (int b = 0; b < NB; ++b) { LI[(b * 4 + h) * PADT + MPOS0 + R] = li; LF[(b * 4 + h) * PADT + MPOS0 + R] = lf; } }
    }
  }
  __syncthreads();
}
__device__ __forceinline__ void p0_metaproj(const Frame& F, const Args& a) {
  const float* meta = a.in[IN_META]; const float* g1 = a.in[IN_G1]; const float* w_in = a.in[IN_WIN];
  float* PM = (float*)(F.ws + WS_PM);
  LAS float* xs = (LAS float*)(F.lds);
  LAS float* part = (LAS float*)(F.lds + 16384);
  const int q = F.tid >> 7, c = F.tid & 127;
  for (int task = blockIdx.x; task < NPROJ / 128; task += gridDim.x) {
    const int n = task * 128 + c;
    float acc[16];
#pragma unroll
    for (int m = 0; m < 16; ++m) acc[m] = 0.f;
#pragma unroll 1
    for (int kb = 0; kb < 8; ++kb) {
      __syncthreads();
#pragma unroll
      for (int i = 0; i < 8; ++i) { const int idx = F.tid + NTHR * i, qq = idx >> 10, kk = (idx >> 4) & 63, m = idx & 15; const int k = 512 * qq + 64 * kb + kk;
        xs[idx] = meta[(size_t)m * DM + k] * g1[k]; }
      __syncthreads();
#pragma unroll 4
      for (int kk = 0; kk < 64; ++kk) {
        const float w = w_in[(size_t)(512 * q + 64 * kb + kk) * DPROJ + n];
        const LAS f32x4* xp = (const LAS f32x4*)(xs + (q * 64 + kk) * 16);
#pragma unroll
        for (int t = 0; t < 4; ++t) { const f32x4 xv = xp[t]; acc[4 * t + 0] += xv.x * w; acc[4 * t + 1] += xv.y * w; acc[4 * t + 2] += xv.z * w; acc[4 * t + 3] += xv.w * w; }
      }
    }
#pragma unroll
    for (int m = 0; m < 16; ++m) part[(q * 16 + m) * 128 + c] = acc[m];
    __syncthreads();
    for (int e = F.tid; e < 16 * 128; e += NTHR) { const int m = e >> 7, cc = e & 127;
      PM[m * NPROJ + task * 128 + cc] = (part[(0 * 16 + m) * 128 + cc] + part[(1 * 16 + m) * 128 + cc]) + (part[(2 * 16 + m) * 128 + cc] + part[(3 * 16 + m) * 128 + cc]); }
  }
  __syncthreads();
}
__device__ __forceinline__ void p0_transpose(const Frame& F, const float* W, int ldw, int N, bf16* Wt) {
  LAS float* tl = (LAS float*)(F.lds);
  const int ntn = N / 64, ntask = ntn * 16;
  for (int task = blockIdx.x; task < ntask; task += gridDim.x) {
    const int nb = task % ntn, kb = task / ntn, n0 = nb * 64, k0 = kb * 128;
    __syncthreads();
#pragma unroll
    for (int i = 0; i < 4; ++i) { const int idx = F.tid + NTHR * i, kk = idx >> 4, c4 = idx & 15;
      const f32x4 w = *(const f32x4*)(W + (size_t)(k0 + kk) * ldw + n0 + 4 * c4);
      LAS float* d = tl + kk * 65 + 4 * c4; d[0] = w.x; d[1] = w.y; d[2] = w.z; d[3] = w.w; }
    __syncthreads();
    const int n = F.tid >> 3, kc = F.tid & 7;
    const LAS float* s = tl + (kc * 16) * 65 + n;
    v4u o0, o1;
    o0.x = pk2(s[0 * 65], s[1 * 65]); o0.y = pk2(s[2 * 65], s[3 * 65]); o0.z = pk2(s[4 * 65], s[5 * 65]); o0.w = pk2(s[6 * 65], s[7 * 65]);
    o1.x = pk2(s[8 * 65], s[9 * 65]); o1.y = pk2(s[10 * 65], s[11 * 65]); o1.z = pk2(s[12 * 65], s[13 * 65]); o1.w = pk2(s[14 * 65], s[15 * 65]);
    v4u* dp = (v4u*)(Wt + (size_t)(n0 + n) * DM + k0 + kc * 16);
    dp[0] = o0; dp[1] = o1;
  }
  __syncthreads();
}
__device__ __forceinline__ void p0_zero_vpad(const Frame& F) {
  bf16* Vp = (bf16*)(F.ws + WS_VP);
  const int per = MPOS0 * 256 / 8;
  for (int i = blockIdx.x * NTHR + F.tid; i < 16 * per; i += gridDim.x * NTHR) { const int bh = i / per, e = i % per;
    *(v4u*)(Vp + (size_t)bh * PADT * 256 + (size_t)e * 8) = (v4u){0u, 0u, 0u, 0u}; }
}
__device__ __forceinline__ void p0_lam(const Frame& F, const Args& a) {
  if (blockIdx.x == 0 && F.wave == 0) {
    const int l = F.lane;
    float s1 = a.in[IN_LQ1][l] * a.in[IN_LK1][l] + a.in[IN_LQ1][l + 64] * a.in[IN_LK1][l + 64];
    float s2 = a.in[IN_LQ2][l] * a.in[IN_LK2][l] + a.in[IN_LQ2][l + 64] * a.in[IN_LK2][l + 64];
    s1 = wave_sum(s1); s2 = wave_sum(s2);
    if (l == 0) *(float*)(F.ws + WS_LAM) = __expf(s1) - __expf(s2) + 0.2f;
  }
}

struct EpiProj {
  static constexpr bool PERM = true, AFTER_DRAIN = false;
  bf16 *Qb, *Kp, *Vp, *MQ, *MK, *MV, *MO; const float *qg, *kg; LAS float* xch;
  __device__ __forceinline__ void operator()(const pg8::f32x4 (&acc)[2][2][4][2], const pg8::Unit& u, int wr, int wc, int fr, int fq) const {
    const int pn = u.pn, b = u.pm >> 3, tb = (u.pm & 7) * 256 + wr * 64 + fr, d0 = wc * 32 + fq * 8;
    if (pn < 8) {
      const bool isk = pn >= 4; const int h = pn & 3;
      float ssq[2][4][2];
#pragma unroll
      for (int ai = 0; ai < 2; ++ai)
#pragma unroll
        for (int m = 0; m < 4; ++m)
#pragma unroll
          for (int bj = 0; bj < 2; ++bj) { float s = 0.f;
#pragma unroll
            for (int n = 0; n < 2; ++n) { const pg8::f32x4 x = acc[ai][bj][m][n]; s += (x[0] * x[0] + x[1] * x[1]) + (x[2] * x[2] + x[3] * x[3]); }
            s += __shfl_xor(s, 16); s += __shfl_xor(s, 32); ssq[ai][m][bj] = s;
            if (fq == 0) xch[((ai * 128 + wr * 64 + m * 16 + fr) * 2 + bj) * 4 + wc] = s; }
      asm volatile("s_waitcnt lgkmcnt(0)" ::: "memory"); __builtin_amdgcn_s_barrier(); asm volatile("" ::: "memory");
      const float* gp = (isk ? kg : qg) + d0; const f32x4 g0 = *(const f32x4*)gp, g1v = *(const f32x4*)(gp + 4);
      const float sc = isk ? 1.0f : QSCALE;
#pragma unroll
      for (int ai = 0; ai < 2; ++ai)
#pragma unroll
        for (int m = 0; m < 4; ++m)
#pragma unroll
          for (int bj = 0; bj < 2; ++bj) {
            const f32x4 p = *(const LAS f32x4*)(xch + ((ai * 128 + wr * 64 + m * 16 + fr) * 2 + bj) * 4);
            const float rs = rsqrtf(((p.x + p.y) + (p.z + p.w)) * (1.0f / 128.f) + EPS) * sc;
            const pg8::f32x4 v0 = acc[ai][bj][m][0], v1 = acc[ai][bj][m][1];
            v4u w; w.x = pk2(v0[0] * rs * g0.x, v0[1] * rs * g0.y); w.y = pk2(v0[2] * rs * g0.z, v0[3] * rs * g0.w);
            w.z = pk2(v1[0] * rs * g1v.x, v1[1] * rs * g1v.y); w.w = pk2(v1[2] * rs * g1v.z, v1[3] * rs * g1v.w);
            const int t = tb + ai * 128 + m * 16;
            bf16* dst = isk ? Kp + kp_off((b * 4 + h) * 2 + bj, POS0 + t, d0)
                            : Qb + ((size_t)((b * 4 + h) * 2 + bj) * SEQ + t) * 128 + d0;
            *(v4u*)dst = w; }
      return;
    }
#pragma unroll
    for (int ai = 0; ai < 2; ++ai)
#pragma unroll
      for (int m = 0; m < 4; ++m)
#pragma unroll
        for (int bj = 0; bj < 2; ++bj) {
          pg8::f32x4 v0 = acc[ai][bj][m][0], v1 = acc[ai][bj][m][1];
          const int t = tb + ai * 128 + m * 16;
          bf16* dst;
          if (pn < 12) { const int h = pn - 8; dst = Vp + ((size_t)(b * 4 + h) * PADT + POS0 + t) * 256 + bj * 128 + d0; }
          else if (pn < 16) { const int h = 2 * (pn & 1) + bj; dst = (pn >= 14 ? MK : MQ) + ((size_t)(b * 4 + h) * PADT + POS0 + t) * 128 + d0; }
          else if (pn < 20) { const int h = pn - 16; dst = MV + ((size_t)(b * 4 + h) * PADT + POS0 + t) * 256 + bj * 128 + d0; }
          else { dst = MO + (size_t)(b * SEQ + t) * 1024 + (pn - 20) * 256 + bj * 128 + d0;
#pragma unroll
            for (int j = 0; j < 4; ++j) { v0[j] = sigmoidf_(v0[j]); v1[j] = sigmoidf_(v1[j]); } }
          v4u w; w.x = pk2(v0[0], v0[1]); w.y = pk2(v0[2], v0[3]); w.z = pk2(v1[0], v1[1]); w.w = pk2(v1[2], v1[3]);
          *(v4u*)dst = w; }
  }
};
__device__ __forceinline__ void p1_meta_finalize(const Frame& F, const Args& a) {
  if (blockIdx.x >= NMETA) return;
  const int mrow = blockIdx.x, tid = F.tid, lane = F.lane, w = F.wave;
  const float* meta = a.in[IN_META] + (size_t)mrow * DM; const float* PM = (const float*)(F.ws + WS_PM) + (size_t)mrow * NPROJ;
  LAS float* red = (LAS float*)(F.lds + XCH_OFF);
  const f32x4 mv = ((const f32x4*)meta)[tid];
  float s = wave_sum((mv.x * mv.x + mv.y * mv.y) + (mv.z * mv.z + mv.w * mv.w));
  if (lane == 0) red[w] = s;
  __syncthreads();
  float tot = 0.f;
#pragma unroll
  for (int i = 0; i < 8; ++i) tot += red[i];
  const float rs = rsqrtf(tot * (1.0f / DM) + EPS);
  bf16* Kp = (bf16*)(F.ws + WS_KP); bf16* Vp = (bf16*)(F.ws + WS_VP); bf16* MQ = (bf16*)(F.ws + WS_MQ); bf16* MK = (bf16*)(F.ws + WS_MK); bf16* MV = (bf16*)(F.ws + WS_MV);
  const int pos = MPOS0 + mrow;
  {
    const float v0 = PM[1024 + w * 128 + lane] * rs, v1 = PM[1024 + w * 128 + lane + 64] * rs;
    const float rk = rsqrtf(wave_sum(v0 * v0 + v1 * v1) * (1.0f / 128.f) + EPS);
    const float* kg = a.in[IN_KNG];
    const unsigned short o0 = (unsigned short)f2bf(v0 * rk * kg[lane]), o1 = (unsigned short)f2bf(v1 * rk * kg[lane + 64]);
    for (int b = 0; b < NB; ++b) { const int bhm = (b * 4 + (w >> 1)) * 2 + (w & 1); Kp[kp_off(bhm, pos, lane)] = o0; Kp[kp_off(bhm, pos, lane + 64)] = o1; }
  }
  { const int c = tid * 2;
    const unsigned o = pk2(PM[2048 + c] * rs, PM[2048 + c + 1] * rs); const int h = c >> 8, e = c & 255;
    for (int b = 0; b < NB; ++b) *(unsigned*)(Vp + ((size_t)(b * 4 + h) * PADT + pos) * 256 + e) = o;
    const unsigned o2 = pk2(PM[3072 + c] * rs, PM[3072 + c + 1] * rs); const bool isk = c >= 512; const int cc = c & 511, hq = cc >> 7, d = cc & 127;
    for (int b = 0; b < NB; ++b) *(unsigned*)((isk ? MK : MQ) + ((size_t)(b * 4 + hq) * PADT + pos) * 128 + d) = o2;
    const unsigned o3 = pk2(PM[4096 + c] * rs, PM[4096 + c + 1] * rs);
    for (int b = 0; b < NB; ++b) *(unsigned*)(MV + ((size_t)(b * 4 + h) * PADT + pos) * 256 + e) = o3;
  }
  __syncthreads();
}

namespace att {
using f32x16 = __attribute__((ext_vector_type(16))) float;
using s16x4 = __attribute__((ext_vector_type(4))) short;
constexpr int STEPS_BHM = 152, NSTEPS = 32 * STEPS_BHM;
constexpr int SHM_V = 64 * 256 * 2, SHM_K = 64 * 128 * 2;
constexpr int LDS_V = 0, LDS_K = 2 * SHM_V, LDS_Q = LDS_K + SHM_K, LDS_WS = LDS_Q + 8 * 8192;
constexpr float THR2 = 8.0f;
#define KSWZ(row, colB) ((row) * 256 + ((colB) ^ (((row) & 7) << 4)))
#define SBAR() __builtin_amdgcn_sched_barrier(0)
__device__ __forceinline__ int crow(int r, int hi) { return (r & 3) + 8 * (r >> 2) + 4 * hi; }
__device__ __forceinline__ unsigned cvtpk(float lo, float hi) { unsigned r; asm volatile("v_cvt_pk_bf16_f32 %0, %1, %2" : "=v"(r) : "v"(lo), "v"(hi)); return r; }
__device__ __forceinline__ int qb_start(int qb) { return 2 * qb * qb + 3 * qb; }
__device__ __forceinline__ int chunk_of(int s, int NA) { return ((s + 1) * NA - 1) / NSTEPS; }

template <int OFF> __device__ __forceinline__ s16x4 tr_read(int vb) {
  s16x4 r; asm volatile("ds_read_b64_tr_b16 %0, %1 offset:%2" : "=&v"(r) : "v"(vb), "i"(OFF) : "memory"); return r;
}
constexpr int v_rd_off(int d0, int ks, int half) { return d0 * 512 + ks * 8192 + half * 4096; }
template <int D0> __device__ __forceinline__ void pv_one(f32x16& od, int vb, bf16x8 pa0, bf16x8 pa1, bf16x8 pa2, bf16x8 pa3) {
#define PK(L, H) (bf16x8){L[0], L[1], L[2], L[3], H[0], H[1], H[2], H[3]}
  { const s16x4 l0 = tr_read<v_rd_off(D0, 0, 0)>(vb), h0 = tr_read<v_rd_off(D0, 0, 1)>(vb), l1 = tr_read<v_rd_off(D0, 1, 0)>(vb), h1 = tr_read<v_rd_off(D0, 1, 1)>(vb);
    asm volatile("s_waitcnt lgkmcnt(0)" ::: "memory"); SBAR();
    od = __builtin_amdgcn_mfma_f32_32x32x16_bf16(pa0, PK(l0, h0), od, 0, 0, 0);
    od = __builtin_amdgcn_mfma_f32_32x32x16_bf16(pa1, PK(l1, h1), od, 0, 0, 0); }
  SBAR();
  { const s16x4 l2 = tr_read<v_rd_off(D0, 2, 0)>(vb), h2 = tr_read<v_rd_off(D0, 2, 1)>(vb), l3 = tr_read<v_rd_off(D0, 3, 0)>(vb), h3 = tr_read<v_rd_off(D0, 3, 1)>(vb);
    asm volatile("s_waitcnt lgkmcnt(0)" ::: "memory"); SBAR();
    od = __builtin_amdgcn_mfma_f32_32x32x16_bf16(pa2, PK(l2, h2), od, 0, 0, 0);
    od = __builtin_amdgcn_mfma_f32_32x32x16_bf16(pa3, PK(l3, h3), od, 0, 0, 0); }
#undef PK
}

__device__ __forceinline__ void segment(const Frame& F, int bhm, int qb, int j0, int j1, int slot) {
  const int tid = F.tid, wid = F.wave, lane = F.lane, r32 = lane & 31, hi = lane >> 5;
  const bf16* Qg = (const bf16*)(F.ws + WS_Q) + ((size_t)bhm * SEQ + qb * 256 + wid * 32 + r32) * 128 + hi * 8;
  const bf16* Kg = (const bf16*)(F.ws + WS_KP) + (size_t)bhm * 33 * 8192;
  const bf16* Vg = (const bf16*)(F.ws + WS_VP) + (size_t)(bhm >> 1) * PADT * 256;
  LAS unsigned char* lds = F.lds;
  LAS float* wsl = (LAS float*)(lds + LDS_WS) + wid * 64;
  const float slope2 = exp2f(-2.0f * (float)(((bhm >> 1) & 3) + 1)) * LOG2E;
  unsigned ksrc0, vsrc0;
  ksrc0 = (unsigned)tid * 16u;
  { const int a8 = tid >> 8, b = (tid >> 2) & 7, k = 8 * (b >> 2) + 4 * a8 + (b & 3), c = ((tid >> 5) & 7) * 32 + (tid & 3) * 8; vsrc0 = (unsigned)(k * 256 + c) * 2u; }
#define STAGE_K(j) do { const char* kt = (const char*)(Kg + (size_t)(j) * 8192); \
    _Pragma("unroll") for (int _i = 0; _i < 2; ++_i) __builtin_amdgcn_global_load_lds((const unsigned*)(kt + (ksrc0 + _i * 8192u)), (LAS unsigned*)(lds + LDS_K + _i * 8192 + wid * 1024), 16, 0, 0); } while (0)
#define STAGE_V(buf, j) do { const char* vt = (const char*)(Vg + (size_t)(j) * 64 * 256); \
    _Pragma("unroll") for (int _i = 0; _i < 4; ++_i) __builtin_amdgcn_global_load_lds((const unsigned*)(vt + (vsrc0 + _i * 8192u)), (LAS unsigned*)(lds + LDS_V + (buf) * SHM_V + _i * 8192 + wid * 1024), 16, 0, 0); } while (0)
  const int lt = (((r32 << 1) | hi) ^ ((r32 >> 3) & 1)) << 4;
  LAS unsigned char* Qs = lds + LDS_Q + wid * 8192;
#pragma unroll
  for (int d0 = 0; d0 < 8; ++d0) { const bf16x8 qv = *(const bf16x8*)(Qg + d0 * 16); *(LAS bf16x8*)(Qs + d0 * 1024 + lt) = qv; }
  const float hioff = slope2 * (float)(4 * hi);
  f32x16 o[8];
#pragma unroll
  for (int d = 0; d < 8; ++d)
#pragma unroll
    for (int r = 0; r < 16; ++r) o[d][r] = 0.f;
  float m_reg = -1e30f, l_reg = 0.f;
  const int vb0 = (int)(uintptr_t)(lds + LDS_V) + (((lane & 3) << 3) | (((lane >> 2) & 3) << 6) | (((lane >> 4) & 1) << 5) | (((lane >> 5) & 1) << 8));
  const int qrel = wid * 32 + r32;
  STAGE_K(j0); STAGE_V(0, j0);
  VM_WAIT(); __syncthreads();
  for (int j = j0; j < j1; ++j) {
    const int cur = (j - j0) & 1;
    if (j + 1 < j1) STAGE_V(cur ^ 1, j + 1);
    SBAR();
    f32x16 p0 = {}, p1 = {};
    { const LAS unsigned char* Ks = lds + LDS_K;
#pragma unroll
      for (int d0 = 0; d0 < 8; ++d0) {
        const bf16x8 b0 = *(const LAS bf16x8*)(Ks + d0 * 2048 + lt);
        const bf16x8 b1 = *(const LAS bf16x8*)(Ks + d0 * 2048 + 1024 + lt);
        const bf16x8 qf = *(const LAS bf16x8*)(Qs + d0 * 1024 + lt);
        p0 = __builtin_amdgcn_mfma_f32_32x32x16_bf16(b0, qf, p0, 0, 0, 0);
        p1 = __builtin_amdgcn_mfma_f32_32x32x16_bf16(b1, qf, p1, 0, 0, 0); } }
    asm volatile("s_waitcnt lgkmcnt(0)" ::: "memory"); __builtin_amdgcn_s_barrier(); asm volatile("" ::: "memory");
    if (j + 1 < j1) STAGE_K(j + 1);
    SBAR();
    if (j == 0) {
#pragma unroll
      for (int r = 0; r < 16; ++r) p0[r] = -INFINITY;
#pragma unroll
      for (int r = 0; r < 8; ++r) p1[r] = -INFINITY;
    }
    const int jb = j - (4 * qb + 1);
    if (jb >= 0) {
      const int kb = 64 * jb + 4 * hi;
#pragma unroll
      for (int r = 0; r < 16; ++r) { const int kv = kb + (r & 3) + 8 * (r >> 2); if (kv > qrel) p0[r] = -INFINITY; if (kv + 32 > qrel) p1[r] = -INFINITY; }
    }
    const float off0 = slope2 * (float)(64 * j) + hioff, off1 = off0 + 32.0f * slope2;
#pragma unroll
    for (int r = 0; r < 16; ++r) { const float sb = slope2 * (float)((r & 3) + 8 * (r >> 2)); p0[r] += sb; p1[r] += sb; }
    float pm0 = p0[0], pm1 = p1[0];
#pragma unroll
    for (int r = 1; r < 16; ++r) { pm0 = fmaxf(pm0, p0[r]); pm1 = fmaxf(pm1, p1[r]); }
    float pmax = fmaxf(pm0 + off0, pm1 + off1);
    { auto rr = __builtin_amdgcn_permlane32_swap(__float_as_uint(pmax), __float_as_uint(pmax), false, false);
      pmax = fmaxf(__uint_as_float(rr[0]), __uint_as_float(rr[1])); }
    float mn, alpha;
    if (__builtin_expect(__all(pmax - m_reg <= THR2), 1)) { mn = m_reg; alpha = 1.f; }
    else { mn = fmaxf(m_reg, pmax); alpha = __builtin_amdgcn_exp2f(m_reg - mn); m_reg = mn; }
    const float c0 = off0 - mn, c1 = off1 - mn;
    float ps = 0.f;
#pragma unroll
    for (int r = 0; r < 16; ++r) { p0[r] = __builtin_amdgcn_exp2f(p0[r] + c0); p1[r] = __builtin_amdgcn_exp2f(p1[r] + c1); ps += p0[r] + p1[r]; }
    { auto rr = __builtin_amdgcn_permlane32_swap(__float_as_uint(ps), __float_as_uint(ps), false, false);
      ps = __uint_as_float(rr[0]) + __uint_as_float(rr[1]); }
    l_reg = l_reg * alpha + ps;
    if (__any(alpha < 1.f)) { if (hi == 0) wsl[r32] = alpha; asm volatile("s_waitcnt lgkmcnt(0)" ::: "memory");
#pragma unroll
      for (int rg = 0; rg < 4; ++rg) { const f32x4 al = *(const LAS f32x4*)(wsl + 8 * rg + 4 * hi);
#pragma unroll
        for (int d = 0; d < 8; ++d) { o[d][4 * rg + 0] *= al.x; o[d][4 * rg + 1] *= al.y; o[d][4 * rg + 2] *= al.z; o[d][4 * rg + 3] *= al.w; }
        SBAR(); } }
    bf16x8 pa0, pa1, pa2, pa3;
#define PK4(P, BASE, OUT) do { unsigned a0 = cvtpk(P[BASE + 0], P[BASE + 1]), a1 = cvtpk(P[BASE + 2], P[BASE + 3]);   \
    unsigned b0 = cvtpk(P[BASE + 4], P[BASE + 5]), b1 = cvtpk(P[BASE + 6], P[BASE + 7]);                              \
    auto r0 = __builtin_amdgcn_permlane32_swap(a0, b0, false, false); auto r1 = __builtin_amdgcn_permlane32_swap(a1, b1, false, false); \
    v4u w = {r0[0], r1[0], r0[1], r1[1]}; OUT = *reinterpret_cast<bf16x8*>(&w); } while (0)
    PK4(p0, 0, pa0); PK4(p0, 8, pa1); PK4(p1, 0, pa2); PK4(p1, 8, pa3);
#undef PK4
    SBAR();
    { const int vb = vb0 + cur * SHM_V;
      pv_one<0>(o[0], vb, pa0, pa1, pa2, pa3); pv_one<1>(o[1], vb, pa0, pa1, pa2, pa3); pv_one<2>(o[2], vb, pa0, pa1, pa2, pa3); pv_one<3>(o[3], vb, pa0, pa1, pa2, pa3);
      pv_one<4>(o[4], vb, pa0, pa1, pa2, pa3); pv_one<5>(o[5], vb, pa0, pa1, pa2, pa3); pv_one<6>(o[6], vb, pa0, pa1, pa2, pa3); pv_one<7>(o[7], vb, pa0, pa1, pa2, pa3); }
    VM_WAIT(); __syncthreads();
  }
  { int lane2 = threadIdx.x & 63, slot2 = slot; asm volatile("" : "+v"(lane2), "+s"(slot2));
    const int r32e = lane2 & 31, hie = lane2 >> 5;
    float* PO = (float*)(F.ws + WS_PO) + (size_t)slot2 * 256 * 256; float* ML = (float*)(F.ws + WS_ML) + (size_t)slot2 * 512;
    LAS float* wse = (LAS float*)(F.lds + LDS_WS) + wid * 64;
    if (hie == 0) { wse[r32e] = l_reg; ML[(wid * 32 + r32e) * 2] = m_reg; ML[(wid * 32 + r32e) * 2 + 1] = l_reg; }
    asm volatile("s_waitcnt lgkmcnt(0)" ::: "memory");
    char* Ob = (char*)(PO + (size_t)(wid * 32) * 256);
    const unsigned lo = (unsigned)(4 * hie * 256 + r32e) * 4u;
#pragma unroll
    for (int r = 0; r < 16; ++r) { const int rowc = (r & 3) + 8 * (r >> 2); const float lv = wse[rowc + 4 * hie]; const float rl = lv > 0.f ? __builtin_amdgcn_rcpf(lv) : 0.f;
#pragma unroll
      for (int d0 = 0; d0 < 8; ++d0) *(float*)(Ob + (lo + (unsigned)(rowc * 256 + d0 * 32) * 4u)) = o[d0][r] * rl;
      SBAR(); } }
  __syncthreads();
#undef STAGE_K
#undef STAGE_V
}

__device__ __forceinline__ void phase(const Frame& F, int ca, int NA) {
  int s0 = (int)(((long)ca * NSTEPS) / NA); const int s1 = (int)(((long)(ca + 1) * NSTEPS) / NA);
  while (s0 < s1) {
    const int bhm = s0 / STEPS_BHM, rem = s0 - bhm * STEPS_BHM;
    int qb = 0;
#pragma unroll 1
    for (int q = 1; q < 8; ++q) if (rem >= qb_start(q)) qb = q;
    const int j0 = rem - qb_start(qb), nst = 4 * qb + 5;
    const int j1 = (j0 + (s1 - s0) < nst) ? j0 + (s1 - s0) : nst;
    const int slot = bhm * 16 + qb + chunk_of(s0, NA) - chunk_of(bhm * STEPS_BHM, NA);
    segment(F, bhm, qb, j0, j1, slot);
    s0 += j1 - j0;
  }
}
#undef KSWZ
#undef SBAR
}
namespace ml {
constexpr int QST = 136, TST = 72;
constexpr int L_RQ = 0, L_RK = 17152, L_QS = 34304, L_QW = 51712, L_KS = 69120, L_KWT = 86528, L_VT = 104960  , L_SP = 0  , L_G = 141824, L_CW = 143872;
constexpr int L_HT = 0;
constexpr int G_A = 0, G_M = 64, G_WI = 128, G_EM = 192, G_DEN = 256, G_WG = 320, G_SC = 384, G_N = 0;
constexpr int L_NV = L_CW + 5120;
constexpr int L_SSQ = L_KWT;
__device__ __forceinline__ float shfl_up_f(float v, int d) { return __shfl_up(v, d); }

__device__ __forceinline__ void load_cw(const Frame& F, const Args& a, int h) {
  LAS float* CW = (LAS float*)(F.lds + L_CW);
  for (int e = F.tid; e < 2 * 5 * 128; e += NTHR) { const int qk = e / 640, j = (e / 128) % 5, d = e & 127; const int ch = qk * 512 + h * 128 + d;
    CW[e] = j < 4 ? a.in[IN_CW][j * 1024 + ch] : a.in[IN_CB][ch]; }
}
__device__ __forceinline__ void load_raw(const Frame& F, const bf16* g, int pos0, int lds_off) {
  for (int p = F.tid; p < 67 * 16; p += NTHR) { const int row = p >> 4, ch = p & 15, pos = pos0 - 3 + row;
    v4u v = {0u, 0u, 0u, 0u}; if (pos >= MPOS0) v = *(const v4u*)(g + (size_t)pos * 128 + ch * 8);
    *(LAS v4u*)(F.lds + lds_off + row * 256 + ch * 16) = v; }
}
__device__ __forceinline__ void conv16(const Frame& F, int qk, int lds_off, int t, int d0, float (&y)[16]) {
  const LAS float* CW = (const LAS float*)(F.lds + L_CW);
#pragma unroll
  for (int e = 0; e < 16; ++e) y[e] = CW[(qk * 5 + 4) * 128 + d0 + e];
#pragma unroll
  for (int j = 0; j < 4; ++j) { const LAS v4u* rp = (const LAS v4u*)(F.lds + lds_off + (t + j) * 256 + d0 * 2); const v4u r0 = rp[0], r1 = rp[1];
    const LAS float* cw = CW + (qk * 5 + j) * 128 + d0;
    y[0] += cw[0] * bflo(r0.x); y[1] += cw[1] * bfhi(r0.x); y[2] += cw[2] * bflo(r0.y); y[3] += cw[3] * bfhi(r0.y); y[4] += cw[4] * bflo(r0.z); y[5] += cw[5] * bfhi(r0.z); y[6] += cw[6] * bflo(r0.w); y[7] += cw[7] * bfhi(r0.w);
    y[8] += cw[8] * bflo(r1.x); y[9] += cw[9] * bfhi(r1.x); y[10] += cw[10] * bflo(r1.y); y[11] += cw[11] * bfhi(r1.y); y[12] += cw[12] * bflo(r1.z); y[13] += cw[13] * bfhi(r1.z); y[14] += cw[14] * bflo(r1.w); y[15] += cw[15] * bfhi(r1.w); }
#pragma unroll
  for (int e = 0; e < 16; ++e) y[e] = y[e] / (1.0f + __expf(-y[e]));
}
__device__ __forceinline__ void load_vt(const Frame& F, const bf16* MVg, int pos0) {
#pragma unroll
  for (int i = 0; i < 4; ++i) { const int p = F.tid + NTHR * i, row = p >> 5, ch = p & 31; v4u v4 = {0u, 0u, 0u, 0u};
    if (pos0 + row >= MPOS0) v4 = *(const v4u*)(MVg + (size_t)(pos0 + row) * 256 + ch * 8);
    LAS bf16* vt = (LAS bf16*)(F.lds + L_VT) + (ch * 8) * TST + row;
    vt[0 * TST] = (bf16)(v4.x & 0xffff); vt[1 * TST] = (bf16)(v4.x >> 16); vt[2 * TST] = (bf16)(v4.y & 0xffff); vt[3 * TST] = (bf16)(v4.y >> 16);
    vt[4 * TST] = (bf16)(v4.z & 0xffff); vt[5 * TST] = (bf16)(v4.z >> 16); vt[6 * TST] = (bf16)(v4.w & 0xffff); vt[7 * TST] = (bf16)(v4.w >> 16); }
}

__device__ __forceinline__ void taskA(const Frame& F, const Args& a, int task) {
  const int bh = task >> 5, c = task & 31, h = bh & 3, tid = F.tid, w = F.wave, lane = F.lane, fr = lane & 15, kq = lane >> 4, pos0 = 64 * c;
  LAS unsigned char* lds = F.lds; LAS float* G = (LAS float*)(lds + L_G);
  const bf16* MKg = (const bf16*)(F.ws + WS_MK) + (size_t)bh * PADT * 128; const bf16* MVg = (const bf16*)(F.ws + WS_MV) + (size_t)bh * PADT * 256;
  __syncthreads();
  load_cw(F, a, h); load_raw(F, MKg, pos0, L_RK); load_vt(F, MVg, pos0);
  if (w == 0) {
    const bool dead = pos0 + lane < MPOS0;
    const float li = dead ? -1e30f : ((const float*)(F.ws + WS_LI))[bh * PADT + pos0 + lane], lf = dead ? 0.f : ((const float*)(F.ws + WS_LF))[bh * PADT + pos0 + lane];
    float bs = lf;
#pragma unroll
    for (int d = 1; d < 64; d <<= 1) { const float o = shfl_up_f(bs, d); if (lane >= d) bs += o; }
    const float av = li - bs; float mx = av;
#pragma unroll
    for (int o = 1; o < 64; o <<= 1) mx = fmaxf(mx, __shfl_xor(mx, o));
    G[G_WG + lane] = __expf(av - mx);
    if (lane == 63) { float* gs = (float*)(F.ws + WS_GS) + (size_t)(bh * 33 + c) * 2; gs[0] = bs; gs[1] = mx; }
  }
  __syncthreads();
  { const int t = tid >> 3, d0 = (tid & 7) * 16; float y[16]; conv16(F, 1, L_RK, t, d0, y);
    const float sw = 0.08838834764831845f * G[G_WG + t]; LAS bf16* kt = (LAS bf16*)(lds + L_KWT) + d0 * TST + t;
#pragma unroll
    for (int e = 0; e < 16; ++e) kt[e * TST] = (bf16)f2bf(y[e] * sw); }
  __syncthreads();
  f32x4* DCg = (f32x4*)(F.ws + WS_DC) + ((size_t)(bh * 32 + c) * 128) * 64;
#pragma unroll
  for (int jj = 0; jj < 2; ++jj) { const int j = 2 * w + jj;
    const bf16x8 bv0 = *(const LAS bf16x8*)(lds + L_VT + ((16 * j + fr) * TST + 8 * kq) * 2), bv1 = *(const LAS bf16x8*)(lds + L_VT + ((16 * j + fr) * TST + 32 + 8 * kq) * 2);
#pragma unroll
    for (int i = 0; i < 8; ++i) { f32x4 acc = {0.f, 0.f, 0.f, 0.f};
      const bf16x8 k0 = *(const LAS bf16x8*)(lds + L_KWT + ((16 * i + fr) * TST + 8 * kq) * 2), k1 = *(const LAS bf16x8*)(lds + L_KWT + ((16 * i + fr) * TST + 32 + 8 * kq) * 2);
      acc = __builtin_amdgcn_mfma_f32_16x16x32_bf16(k0, bv0, acc, 0, 0, 0); acc = __builtin_amdgcn_mfma_f32_16x16x32_bf16(k1, bv1, acc, 0, 0, 0);
      DCg[(size_t)(i * 16 + j) * 64 + lane] = acc; } }
  if (tid < 128) { const LAS v4u* kr = (const LAS v4u*)(lds + L_KWT + tid * TST * 2); float s = 0.f;
#pragma unroll
    for (int q = 0; q < 8; ++q) { const v4u x = kr[q]; s += (bflo(x.x) + bfhi(x.x)) + (bflo(x.y) + bfhi(x.y)) + (bflo(x.z) + bfhi(x.z)) + (bflo(x.w) + bfhi(x.w)); }
    ((float*)(F.ws + WS_DN))[(size_t)(bh * 32 + c) * 128 + tid] = s; }
}

__device__ __forceinline__ void scanB(const Frame& F) {
  const int gt = blockIdx.x * NTHR + F.tid, NT = gridDim.x * NTHR;
  const float* GS = (const float*)(F.ws + WS_GS);
  for (int g = gt; g < 16 * 8192; g += NT) { const int bh = g >> 13, r = g & 8191, i = r >> 10, j = (r >> 6) & 15, ln = r & 63;
    const f32x4* dc = (const f32x4*)(F.ws + WS_DC) + ((size_t)(bh * 32) * 128 + (i * 16 + j)) * 64 + ln;
    v2u* cs = (v2u*)(F.ws + WS_CS) + ((((size_t)bh * 33) * 4 + (i >> 1)) * 16 + j) * 64 * 2 + ln * 2 + (i & 1);
    f32x4 st = {0.f, 0.f, 0.f, 0.f}; float m = 0.f;
#pragma unroll 4
    for (int c = 0; c < 32; ++c) { const float bL = GS[(bh * 33 + c) * 2], ml = GS[(bh * 33 + c) * 2 + 1], me = fmaxf(m, ml);
      st = st * __expf(m - me) + dc[(size_t)c * 128 * 64] * __expf(ml - me); m = bL + me;
      v2u o; o.x = pk2(st.x, st.y); o.y = pk2(st.z, st.w); cs[(size_t)(c + 1) * 4 * 16 * 64 * 2] = o; } }
  for (int g = gt; g < 16 * 128; g += NT) { const int bh = g >> 7, d = g & 127; float n = 0.f, m = 0.f;
    for (int c = 0; c < 32; ++c) { const float bL = GS[(bh * 33 + c) * 2], ml = GS[(bh * 33 + c) * 2 + 1], me = fmaxf(m, ml);
      n = n * __expf(m - me) + ((const float*)(F.ws + WS_DN))[(size_t)(bh * 32 + c) * 128 + d] * __expf(ml - me); m = bL + me;
      ((float*)(F.ws + WS_NS))[(size_t)(bh * 33 + c + 1) * 128 + d] = n; if (d == 0) ((float*)(F.ws + WS_MS))[bh * 33 + c + 1] = m; } }
}

__device__ __forceinline__ void taskC(const Frame& F, const Args& a, int task) {
  const int bh = task >> 5, c = (task & 31) + 1, b = bh >> 2, h = bh & 3, tid = F.tid, w = F.wave, lane = F.lane, fr = lane & 15, kq = lane >> 4, pos0 = 64 * c;
  LAS unsigned char* lds = F.lds; LAS float* G = (LAS float*)(lds + L_G); LAS float* NV = (LAS float*)(lds + L_NV);
  const bf16* MQg = (const bf16*)(F.ws + WS_MQ) + (size_t)bh * PADT * 128; const bf16* MKg = (const bf16*)(F.ws + WS_MK) + (size_t)bh * PADT * 128;
  const bf16* MVg = (const bf16*)(F.ws + WS_MV) + (size_t)bh * PADT * 256;
  const float m = ((const float*)(F.ws + WS_MS))[bh * 33 + c];
  __syncthreads();
  load_cw(F, a, h); load_raw(F, MQg, pos0, L_RQ); load_raw(F, MKg, pos0, L_RK); load_vt(F, MVg, pos0);
  if (tid < 128) NV[tid] = ((const float*)(F.ws + WS_NS))[(size_t)(bh * 33 + c) * 128 + tid];
  if (w == 0) {
    const float li = ((const float*)(F.ws + WS_LI))[bh * PADT + pos0 + lane], lf = ((const float*)(F.ws + WS_LF))[bh * PADT + pos0 + lane];
    float bs = lf;
#pragma unroll
    for (int d = 1; d < 64; d <<= 1) { const float o = shfl_up_f(bs, d); if (lane >= d) bs += o; }
    const float av = li - bs; float cm = av;
#pragma unroll
    for (int d = 1; d < 64; d <<= 1) { const float o = shfl_up_f(cm, d); if (lane >= d) cm = fmaxf(cm, o); }
    const float Mt = fmaxf(m, cm);
    G[G_A + lane] = av; G[G_M + lane] = Mt; G[G_WI + lane] = __expf(m - Mt); G[G_EM + lane] = __expf(-(bs + Mt));
  }
  __syncthreads();
  { const int t = tid >> 3, d0 = (tid & 7) * 16; const float wi = G[G_WI + t]; float y[16];
    conv16(F, 0, L_RQ, t, d0, y);
    { v4u o0, o1, w0, w1;
      o0.x = pk2(y[0], y[1]); o0.y = pk2(y[2], y[3]); o0.z = pk2(y[4], y[5]); o0.w = pk2(y[6], y[7]); o1.x = pk2(y[8], y[9]); o1.y = pk2(y[10], y[11]); o1.z = pk2(y[12], y[13]); o1.w = pk2(y[14], y[15]);
      w0.x = pk2(y[0] * wi, y[1] * wi); w0.y = pk2(y[2] * wi, y[3] * wi); w0.z = pk2(y[4] * wi, y[5] * wi); w0.w = pk2(y[6] * wi, y[7] * wi);
      w1.x = pk2(y[8] * wi, y[9] * wi); w1.y = pk2(y[10] * wi, y[11] * wi); w1.z = pk2(y[12] * wi, y[13] * wi); w1.w = pk2(y[14] * wi, y[15] * wi);
      LAS v4u* qs = (LAS v4u*)(lds + L_QS + (t * QST + d0) * 2); qs[0] = o0; qs[1] = o1;
      LAS v4u* qw = (LAS v4u*)(lds + L_QW + (t * QST + d0) * 2); qw[0] = w0; qw[1] = w1; }
    __builtin_amdgcn_sched_barrier(0);
    conv16(F, 1, L_RK, t, d0, y);
    { const float sc = 0.08838834764831845f; v4u o0, o1;
      o0.x = pk2(y[0] * sc, y[1] * sc); o0.y = pk2(y[2] * sc, y[3] * sc); o0.z = pk2(y[4] * sc, y[5] * sc); o0.w = pk2(y[6] * sc, y[7] * sc);
      o1.x = pk2(y[8] * sc, y[9] * sc); o1.y = pk2(y[10] * sc, y[11] * sc); o1.z = pk2(y[12] * sc, y[13] * sc); o1.w = pk2(y[14] * sc, y[15] * sc);
      LAS v4u* ks = (LAS v4u*)(lds + L_KS + (t * QST + d0) * 2); ks[0] = o0; ks[1] = o1; } }
  __syncthreads();
  v4u cb[4][2];
  { const v4u* cs = (const v4u*)(F.ws + WS_CS) + (((size_t)bh * 33 + c) * 4 * 16) * 64;
#pragma unroll
    for (int I = 0; I < 4; ++I)
#pragma unroll
      for (int jj = 0; jj < 2; ++jj) cb[I][jj] = cs[(size_t)(I * 16 + 2 * w + jj) * 64 + lane]; }
  { const int si = w >> 1; const f32x4 as = *(const LAS f32x4*)(G + G_A + 16 * si + 4 * kq);
#pragma unroll
    for (int tt = 0; tt < 2; ++tt) { const int ti = 2 * (w & 1) + tt; f32x4 acc = {0.f, 0.f, 0.f, 0.f};
#pragma unroll
      for (int ks = 0; ks < 4; ++ks) { const bf16x8 af = *(const LAS bf16x8*)(lds + L_KS + ((16 * si + fr) * QST + 32 * ks + 8 * kq) * 2);
        const bf16x8 bfr = *(const LAS bf16x8*)(lds + L_QS + ((16 * ti + fr) * QST + 32 * ks + 8 * kq) * 2);
        acc = __builtin_amdgcn_mfma_f32_16x16x32_bf16(af, bfr, acc, 0, 0, 0); }
      const int t = 16 * ti + fr, s0 = 16 * si + 4 * kq; const float Mt = G[G_M + t];
      const float v0 = (s0 + 0 <= t) ? acc.x * __expf(as.x - Mt) : 0.f, v1 = (s0 + 1 <= t) ? acc.y * __expf(as.y - Mt) : 0.f;
      const float v2 = (s0 + 2 <= t) ? acc.z * __expf(as.z - Mt) : 0.f, v3 = (s0 + 3 <= t) ? acc.w * __expf(as.w - Mt) : 0.f;
      v2u o; o.x = pk2(v0, v1); o.y = pk2(v2, v3);
      *(LAS v2u*)(lds + L_SP + (t * TST + s0) * 2) = o; } }
  __syncthreads();
  if (w == 0) { const int t = lane; float qn = 0.f, rsum = 0.f;
#pragma unroll 4
    for (int q = 0; q < 16; ++q) { const v4u x = *(const LAS v4u*)(lds + L_QS + (t * QST + q * 8) * 2); const f32x4 n0 = *(const LAS f32x4*)(NV + q * 8), n1 = *(const LAS f32x4*)(NV + q * 8 + 4);
      qn += bflo(x.x) * n0.x + bfhi(x.x) * n0.y + bflo(x.y) * n0.z + bfhi(x.y) * n0.w + bflo(x.z) * n1.x + bfhi(x.z) * n1.y + bflo(x.w) * n1.z + bfhi(x.w) * n1.w; }
#pragma unroll
    for (int q = 0; q < 8; ++q) { const v4u x = *(const LAS v4u*)(lds + L_SP + (t * TST + q * 8) * 2); rsum += (bflo(x.x) + bfhi(x.x)) + (bflo(x.y) + bfhi(x.y)) + (bflo(x.z) + bfhi(x.z)) + (bflo(x.w) + bfhi(x.w)); }
    const float den = G[G_WI + t] * qn + rsum; G[G_DEN + t] = fmaxf(fabsf(den), G[G_EM + t]); }
  f32x4 acc[2][4];
#pragma unroll
  for (int jj = 0; jj < 2; ++jj)
#pragma unroll
    for (int ti = 0; ti < 4; ++ti) acc[jj][ti] = (f32x4){0.f, 0.f, 0.f, 0.f};
#pragma unroll
  for (int I = 0; I < 4; ++I) {
#pragma unroll
    for (int ti = 0; ti < 4; ++ti) { const LAS unsigned char* qp = lds + L_QW + ((16 * ti + fr) * QST + 32 * I + 4 * kq) * 2;
      const v2u a0 = *(const LAS v2u*)qp, a1 = *(const LAS v2u*)(qp + 32); const v4u av = {a0.x, a0.y, a1.x, a1.y};
      acc[0][ti] = __builtin_amdgcn_mfma_f32_16x16x32_bf16(__builtin_bit_cast(bf16x8, av), __builtin_bit_cast(bf16x8, cb[I][0]), acc[0][ti], 0, 0, 0);
      acc[1][ti] = __builtin_amdgcn_mfma_f32_16x16x32_bf16(__builtin_bit_cast(bf16x8, av), __builtin_bit_cast(bf16x8, cb[I][1]), acc[1][ti], 0, 0, 0); }
    __builtin_amdgcn_sched_barrier(0); }
#pragma unroll
  for (int ks = 0; ks < 2; ++ks) { const bf16x8 bv0 = *(const LAS bf16x8*)(lds + L_VT + ((32 * w + fr) * TST + 32 * ks + 8 * kq) * 2), bv1 = *(const LAS bf16x8*)(lds + L_VT + ((32 * w + 16 + fr) * TST + 32 * ks + 8 * kq) * 2);
#pragma unroll
    for (int ti = 0; ti < 4; ++ti) { const bf16x8 sf = *(const LAS bf16x8*)(lds + L_SP + ((16 * ti + fr) * TST + 32 * ks + 8 * kq) * 2);
      acc[0][ti] = __builtin_amdgcn_mfma_f32_16x16x32_bf16(sf, bv0, acc[0][ti], 0, 0, 0); acc[1][ti] = __builtin_amdgcn_mfma_f32_16x16x32_bf16(sf, bv1, acc[1][ti], 0, 0, 0); } }
  __syncthreads();
  LAS float* SSQ = (LAS float*)(lds + L_SSQ);
#pragma unroll
  for (int ti = 0; ti < 4; ++ti) { const f32x4 dn = *(const LAS f32x4*)(G + G_DEN + 16 * ti + 4 * kq);
    f32x4 s4;
#pragma unroll
    for (int r = 0; r < 4; ++r) { const float h0 = acc[0][ti][r] / dn[r], h1 = acc[1][ti][r] / dn[r]; acc[0][ti][r] = h0; acc[1][ti][r] = h1; s4[r] = h0 * h0 + h1 * h1; }
#pragma unroll
    for (int o = 1; o < 16; o <<= 1) { s4.x += __shfl_xor(s4.x, o); s4.y += __shfl_xor(s4.y, o); s4.z += __shfl_xor(s4.z, o); s4.w += __shfl_xor(s4.w, o); }
    if (fr == 0) { SSQ[(16 * ti + 4 * kq + 0) * 8 + w] = s4.x; SSQ[(16 * ti + 4 * kq + 1) * 8 + w] = s4.y; SSQ[(16 * ti + 4 * kq + 2) * 8 + w] = s4.z; SSQ[(16 * ti + 4 * kq + 3) * 8 + w] = s4.w; } }
  __syncthreads();
  LAS bf16* HT = (LAS bf16*)(lds + L_HT);
#pragma unroll
  for (int ti = 0; ti < 4; ++ti)
#pragma unroll
    for (int r = 0; r < 4; ++r) { const int t = 16 * ti + 4 * kq + r; const f32x4 p0 = *(const LAS f32x4*)(SSQ + t * 8), p1 = *(const LAS f32x4*)(SSQ + t * 8 + 4);
      const float rh = rsqrtf(((p0.x + p0.y) + (p0.z + p0.w) + (p1.x + p1.y) + (p1.z + p1.w)) * (1.0f / 256.f) + EPS);
      HT[t * 264 + 32 * w + fr] = (bf16)f2bf(acc[0][ti][r] * rh); HT[t * 264 + 32 * w + 16 + fr] = (bf16)f2bf(acc[1][ti][r] * rh); }
  __syncthreads();
  { const int t = tid >> 3, c0 = (tid & 7) * 32; const size_t R = (size_t)b * SEQ + 64 * (c - 1) + t;
    const bf16* mo = (const bf16*)(F.ws + WS_MO) + R * 1024 + h * 256 + c0; const float* og = a.in[IN_OUTG] + h * 256 + c0; bf16* A2 = (bf16*)(F.ws + WS_A2) + R * DM + 1024 + h * 256 + c0;
#pragma unroll
    for (int q = 0; q < 4; ++q) { const v4u hv = *(const LAS v4u*)(HT + t * 264 + c0 + q * 8); const v4u mv = *(const v4u*)(mo + q * 8); const f32x4 g0 = *(const f32x4*)(og + q * 8), g1 = *(const f32x4*)(og + q * 8 + 4);
      v4u o; o.x = pk2(bflo(hv.x) * g0.x * bflo(mv.x), bfhi(hv.x) * g0.y * bfhi(mv.x)); o.y = pk2(bflo(hv.y) * g0.z * bflo(mv.y), bfhi(hv.y) * g0.w * bfhi(mv.y));
      o.z = pk2(bflo(hv.z) * g1.x * bflo(mv.z), bfhi(hv.z) * g1.y * bfhi(mv.z)); o.w = pk2(bflo(hv.w) * g1.z * bflo(mv.w), bfhi(hv.w) * g1.w * bfhi(mv.w));
      *(v4u*)(A2 + q * 8) = o; } }
}
}
__device__ __forceinline__ void p3_combine(const Frame& F, const Args& a, int NA) {
  const float* PO = (const float*)(F.ws + WS_PO); const float* ML = (const float*)(F.ws + WS_ML);
  bf16* A2 = (bf16*)(F.ws + WS_A2);
  const float lam = *(const float*)(F.ws + WS_LAM);
  const float* subg = a.in[IN_SUBG];
  const int gw = blockIdx.x * NWAVES + F.wave, NGW = gridDim.x * NWAVES, lane = F.lane;
  const f32x4 sg = ((const f32x4*)subg)[lane];
  for (int R = gw; R < MROWS; R += NGW) {
    const int b = R >> 11, t = R & 2047, qb = t >> 8, rq = t & 255;
#pragma unroll 1
    for (int h = 0; h < 4; ++h) {
      f32x4 om[2];
#pragma unroll
      for (int m = 0; m < 2; ++m) {
        const int bhm = (b * 4 + h) * 2 + m, first = bhm * att::STEPS_BHM + att::qb_start(qb), last = first + 4 * qb + 4;
        const int cf = att::chunk_of(first, NA), np = att::chunk_of(last, NA) - cf + 1, slot0 = bhm * 16 + qb + cf - att::chunk_of(bhm * att::STEPS_BHM, NA);
        float mp[3], lp[3]; f32x4 op[3];
#pragma unroll
        for (int p = 0; p < 3; ++p) { if (p < np) { const int slot = slot0 + p; mp[p] = ML[(size_t)slot * 512 + rq * 2]; lp[p] = ML[(size_t)slot * 512 + rq * 2 + 1];
            op[p] = ((const f32x4*)(PO + ((size_t)slot * 256 + rq) * 256))[lane]; } else { mp[p] = -1e30f; lp[p] = 0.f; op[p] = (f32x4){0.f, 0.f, 0.f, 0.f}; } }
        const float M = fmaxf(mp[0], fmaxf(mp[1], mp[2]));
        float wsum = 0.f; f32x4 acc = (f32x4){0.f, 0.f, 0.f, 0.f};
#pragma unroll
        for (int p = 0; p < 3; ++p) { const float w = lp[p] * exp2f(mp[p] - M); wsum += w; acc += op[p] * w; }
        om[m] = acc * (1.0f / wsum);
      }
      const f32x4 o = om[0] - om[1] * lam;
      const float rs = rsqrtf(wave_sum((o.x * o.x + o.y * o.y) + (o.z * o.z + o.w * o.w)) * (1.0f / 256.f) + EPS) * 0.8f;
      v2u w; w.x = pk2(o.x * rs * sg.x, o.y * rs * sg.y); w.y = pk2(o.z * rs * sg.z, o.w * rs * sg.w);
      ((v2u*)(A2 + (size_t)R * DM + h * 256))[lane] = w;
    }
  }
}
struct EpiRes {
  static constexpr bool PERM = true, AFTER_DRAIN = false;
  const float* x; float* out; bf16* H1b; float* SSQ;
  __device__ __forceinline__ void operator()(const pg8::f32x4 (&acc)[2][2][4][2], const pg8::Unit& u, int wr, int wc, int fr, int fq) const {
    const int row0 = u.pm * 256 + wr * 64 + fr, col0 = u.pn * 256 + wc * 32 + 8 * fq;
#pragma unroll
    for (int ai = 0; ai < 2; ++ai)
#pragma unroll
      for (int m = 0; m < 4; ++m) { const size_t R = (size_t)(row0 + ai * 128 + m * 16); float s = 0.f;
#pragma unroll
        for (int bj = 0; bj < 2; ++bj) { const size_t off = R * DM + col0 + bj * 128;
          const f32x4 x0 = *(const f32x4*)(x + off), x1 = *(const f32x4*)(x + off + 4);
          const f32x4 v0 = acc[ai][bj][m][0] + x0, v1 = acc[ai][bj][m][1] + x1;
          *(f32x4*)(out + off) = v0; *(f32x4*)(out + off + 4) = v1;
          v4u w; w.x = pk2(v0.x, v0.y); w.y = pk2(v0.z, v0.w); w.z = pk2(v1.x, v1.y); w.w = pk2(v1.z, v1.w);
          *(v4u*)(H1b + off) = w;
          s += (v0.x * v0.x + v0.y * v0.y) + (v0.z * v0.z + v0.w * v0.w) + (v1.x * v1.x + v1.y * v1.y) + (v1.z * v1.z + v1.w * v1.w); }
        s += __shfl_xor(s, 16); s += __shfl_xor(s, 32);
        if (fq == 0) SSQ[R * 32 + u.pn * 4 + wc] = s; }
  }
};
typedef __bf16 bfv2 __attribute__((ext_vector_type(2)));
__device__ __forceinline__ void split_hl(const f32x4 a, const f32x4 b, bf16x8& hi, bf16x8& lo) {
  float v[8] = {a.x, a.y, a.z, a.w, b.x, b.y, b.z, b.w}; unsigned h[8], l[8];
#pragma unroll
  for (int i = 0; i < 8; ++i) { h[i] = f2bf(v[i]); l[i] = f2bf(v[i] - __builtin_bit_cast(float, h[i] << 16)); }
  v4u hv = {h[0] | (h[1] << 16), h[2] | (h[3] << 16), h[4] | (h[5] << 16), h[6] | (h[7] << 16)};
  v4u lv = {l[0] | (l[1] << 16), l[2] | (l[3] << 16), l[4] | (l[5] << 16), l[6] | (l[7] << 16)};
  hi = __builtin_bit_cast(bf16x8, hv); lo = __builtin_bit_cast(bf16x8, lv);
}
__device__ __forceinline__ void p0_w3t(const Frame& F, const Args& a) {
  const float* wq = a.in[IN_WQ]; const float* sk = a.in[IN_SUBK]; const float* g2 = a.in[IN_G2];
  bf16* W3t = (bf16*)(F.ws + WS_W3T);
  const int gw = blockIdx.x * NWAVES + F.wave, NGW = gridDim.x * NWAVES, lane = F.lane, fr = lane & 15, fq = lane >> 4;
  for (int task = gw; task < 128 * 16; task += NGW) {
    const int kt = task >> 4, hh = task & 15;
    bf16x8 ahi[4], alo[4];
    const float* ap = wq + (size_t)(kt * 16 + fr) * DM + hh * 128 + fq * 8;
#pragma unroll
    for (int s = 0; s < 4; ++s) split_hl(*(const f32x4*)(ap + 32 * s), *(const f32x4*)(ap + 32 * s + 4), ahi[s], alo[s]);
    const f32x4 gk = *(const f32x4*)(g2 + kt * 16 + fq * 4);
#pragma unroll 1
    for (int t2 = 0; t2 < 8; ++t2) {
      const float* bp = sk + (size_t)(hh * 128 + t2 * 16 + fr) * 128 + fq * 8;
      f32x4 acc = {0.f, 0.f, 0.f, 0.f};
#pragma unroll
      for (int s = 0; s < 4; ++s) { bf16x8 bhi, blo; split_hl(*(const f32x4*)(bp + 32 * s), *(const f32x4*)(bp + 32 * s + 4), bhi, blo);
        acc = __builtin_amdgcn_mfma_f32_16x16x32_bf16(ahi[s], bhi, acc, 0, 0, 0);
        acc = __builtin_amdgcn_mfma_f32_16x16x32_bf16(ahi[s], blo, acc, 0, 0, 0);
        acc = __builtin_amdgcn_mfma_f32_16x16x32_bf16(alo[s], bhi, acc, 0, 0, 0); }
      v2u o; o.x = pk2(acc.x * gk.x, acc.y * gk.y); o.y = pk2(acc.z * gk.z, acc.w * gk.w);
      *(v2u*)(W3t + (size_t)(hh * 128 + t2 * 16 + fr) * DM + kt * 16 + fq * 4) = o;
    }
  }
}
typedef float f32x2v __attribute__((ext_vector_type(2)));
__device__ __forceinline__ void p0_tables(const Frame& F, const Args& a) {
  const float* g2 = a.in[IN_G2];
  unsigned char* T8 = F.ws + WS_UB; float* SCL = (float*)(F.ws + WS_SCL);
  const int gw = blockIdx.x * NWAVES + F.wave, NGW = gridDim.x * NWAVES, lane = F.lane;
  for (int row = gw; row < 2 * 16384; row += NGW) {
    const bool isv = row >= 16384; const int e = row & 16383;
    const float* src = a.in[isv ? IN_V : IN_U] + (size_t)e * DM;
    f32x4 x[2][4]; float amax = 0.f;
#pragma unroll
    for (int i = 0; i < 2; ++i)
#pragma unroll
      for (int q = 0; q < 4; ++q) { const int k = (i * 64 + lane) * 16 + q * 4; f32x4 v = *(const f32x4*)(src + k);
        if (!isv) v = v * *(const f32x4*)(g2 + k);
        x[i][q] = v; amax = fmaxf(amax, fmaxf(fmaxf(fabsf(v.x), fabsf(v.y)), fmaxf(fabsf(v.z), fabsf(v.w)))); }
#pragma unroll
    for (int o = 1; o < 64; o <<= 1) amax = fmaxf(amax, __shfl_xor(amax, o));
    const float sc = amax > 0.f ? exp2f(floorf(log2f(224.0f / amax))) : 1.0f;
#pragma unroll
    for (int i = 0; i < 2; ++i) { v4u w;
#pragma unroll
      for (int q = 0; q < 4; ++q) { int pk = 0; pk = __builtin_amdgcn_cvt_pk_fp8_f32(x[i][q].x * sc, x[i][q].y * sc, pk, false); pk = __builtin_amdgcn_cvt_pk_fp8_f32(x[i][q].z * sc, x[i][q].w * sc, pk, true); w[q] = (unsigned)pk; }
      *(v4u*)(T8 + (size_t)row * DM + (size_t)(i * 64 + lane) * 16) = w; }
    if (lane == 0) SCL[row] = 1.0f / sc;
  }
}
struct EpiScore {
  static constexpr bool PERM = true, AFTER_DRAIN = false;
  float* S; const LAS float* rs;
  __device__ __forceinline__ void operator()(const pg8::f32x4 (&acc)[2][2][4][2], const pg8::Unit& u, int wr, int wc, int fr, int fq) const {
    const int rl0 = wr * 64 + fr, col0 = u.pn * 256 + wc * 32 + 8 * fq;
#pragma unroll
    for (int ai = 0; ai < 2; ++ai)
#pragma unroll
      for (int m = 0; m < 4; ++m) { const int rl = rl0 + ai * 128 + m * 16; const float r = rs[rl]; const size_t R = (size_t)u.pm * 256 + rl;
#pragma unroll
        for (int bj = 0; bj < 2; ++bj) { float* d = S + R * DM + col0 + bj * 128;
          *(f32x4*)d = acc[ai][bj][m][0] * r; *(f32x4*)(d + 4) = acc[ai][bj][m][1] * r; } }
  }
};

__device__ __forceinline__ unsigned fkey(float f) { const unsigned b = __builtin_bit_cast(unsigned, f); return b ^ ((b >> 31) ? 0xFFFFFFFFu : 0x80000000u); }
template <int NV, int K> __device__ __forceinline__ void wave_topk(const unsigned (&u)[NV], bool (&sel)[NV], int lane) {
  unsigned prefix = 0u; int cge = NV * 64;
#pragma unroll 1
  for (int bit = 31; bit >= 0 && cge != K; --bit) {
    const unsigned cand = prefix | (1u << bit); int c = 0;
#pragma unroll
    for (int i = 0; i < NV; ++i) c += __builtin_popcountll(__ballot(u[i] >= cand));
    if (c >= K) { prefix = cand; cge = c; }
  }
  int cgt = 0;
#pragma unroll
  for (int i = 0; i < NV; ++i) cgt += __builtin_popcountll(__ballot(u[i] > prefix));
  int need = K - cgt;
  const unsigned long long lm = (1ull << lane) - 1ull;
#pragma unroll
  for (int i = 0; i < NV; ++i) { const unsigned long long eq = __ballot(u[i] == prefix); const int before = __builtin_popcountll(eq & lm);
    sel[i] = (u[i] > prefix) || (u[i] == prefix && before < need); const int ne = __builtin_popcountll(eq); need = need > ne ? need - ne : 0; }
}
__device__ __forceinline__ float gelu_erf(float x) { return 0.5f * x * (1.0f + erff(x * 0.70710678118654752f)); }

__device__ __forceinline__ void p6_peer(const Frame& F, const Args& a, float* dst_base) {
  const float* S = (const float*)(F.ws + WS_S); const float* SSQ = (const float*)(F.ws + WS_SSQ); const bf16* H1b = (const bf16*)(F.ws + WS_H1B);
  float* out = a.out;
  const int lane = F.lane, gw = blockIdx.x * NWAVES + F.wave, NGW = gridDim.x * NWAVES;
  LAS float* wl = (LAS float*)(F.lds + F.wave * 2048);
  LAS int* wli = (LAS int*)wl;
  for (int tok = gw; tok < MROWS; tok += NGW) {
    const float rs = rsqrtf(wave_sum(lane < 32 ? SSQ[(size_t)tok * 32 + lane] : 0.f) * (1.0f / DM) + EPS);
    const float* srow = S + (size_t)tok * DM;
#ifdef PEER_IDS_FROM_GLOBAL
    { const int* gi = (const int*)(F.ws + (size_t)372 * MiB) + (size_t)tok * 128; const float* gg = (const float*)(F.ws + (size_t)376 * MiB) + (size_t)tok * 128;
      wli[128 + lane] = gi[lane]; wli[128 + 64 + lane] = gi[64 + lane]; wl[256 + lane] = gg[lane]; wl[256 + 64 + lane] = gg[64 + lane];
      asm volatile("s_waitcnt lgkmcnt(0)" ::: "memory"); }
#pragma unroll 1
    for (int h8 = 0; h8 < 0; ++h8) {
#else
#pragma unroll 1
    for (int h8 = 0; h8 < 8; ++h8) {
#endif
#pragma unroll
      for (int p = 0; p < 2; ++p) {
        const float2 sv = *(const float2*)(srow + (h8 * 2 + p) * 128 + 2 * lane);
        unsigned u[2] = {fkey(sv.x), fkey(sv.y)}; bool sel[2];
        wave_topk<2, 16>(u, sel, lane);
        const unsigned long long m0 = __ballot(sel[0]), m1 = __ballot(sel[1]); const unsigned long long lm = (1ull << lane) - 1ull;
        const int pos0 = __builtin_popcountll(m0 & lm), pos1 = __builtin_popcountll(m0) + __builtin_popcountll(m1 & lm);
        if (sel[0]) { wl[p * 16 + pos0] = sv.x; wli[64 + p * 16 + pos0] = 2 * lane; }
        if (sel[1]) { wl[p * 16 + pos1] = sv.y; wli[64 + p * 16 + pos1] = 2 * lane + 1; }
      }
      asm volatile("s_waitcnt lgkmcnt(0)" ::: "memory");
      const int ci = lane >> 2, cj = 4 * (lane & 3);
      const float s0 = wl[ci]; const f32x4 s1 = *(const LAS f32x4*)(wl + 16 + cj);
      float cv[4] = {s0 + s1.x, s0 + s1.y, s0 + s1.z, s0 + s1.w};
      unsigned cu[4] = {fkey(cv[0]), fkey(cv[1]), fkey(cv[2]), fkey(cv[3])}; bool csel[4];
      wave_topk<4, 16>(cu, csel, lane);
      float mx = -INFINITY;
#pragma unroll
      for (int q = 0; q < 4; ++q) if (csel[q]) mx = fmaxf(mx, cv[q]);
#pragma unroll
      for (int o = 1; o < 64; o <<= 1) mx = fmaxf(mx, __shfl_xor(mx, o));
      float ev[4], es = 0.f;
#pragma unroll
      for (int q = 0; q < 4; ++q) { ev[q] = csel[q] ? __expf(cv[q] - mx) : 0.f; es += ev[q]; }
      es = wave_sum(es); const float inv = 1.0f / es;
      const int ki = wli[64 + ci]; typedef int i32x4 __attribute__((ext_vector_type(4))); const i32x4 kj = *(const LAS i32x4*)(wli + 64 + 16 + cj);
      const int kjv[4] = {kj.x, kj.y, kj.z, kj.w};
      int base = 0; const unsigned long long lm = (1ull << lane) - 1ull;
#pragma unroll
      for (int q = 0; q < 4; ++q) { const unsigned long long mq = __ballot(csel[q]); const int pos = base + __builtin_popcountll(mq & lm);
        if (csel[q]) { wli[128 + h8 * 16 + pos] = ki * 128 + kjv[q]; wl[256 + h8 * 16 + pos] = ev[q] * inv; } base += __builtin_popcountll(mq); }
      asm volatile("s_waitcnt lgkmcnt(0)" ::: "memory");
    }
    float xs[32];
#pragma unroll
    for (int i = 0; i < 2; ++i) { const v4u* xp = (const v4u*)(H1b + (size_t)tok * DM + (size_t)(i * 64 + lane) * 16); const v4u x0 = xp[0], x1 = xp[1];
      xs[i * 16 + 0] = bflo(x0.x); xs[i * 16 + 1] = bfhi(x0.x); xs[i * 16 + 2] = bflo(x0.y); xs[i * 16 + 3] = bfhi(x0.y); xs[i * 16 + 4] = bflo(x0.z); xs[i * 16 + 5] = bfhi(x0.z); xs[i * 16 + 6] = bflo(x0.w); xs[i * 16 + 7] = bfhi(x0.w);
      xs[i * 16 + 8] = bflo(x1.x); xs[i * 16 + 9] = bfhi(x1.x); xs[i * 16 + 10] = bflo(x1.y); xs[i * 16 + 11] = bfhi(x1.y); xs[i * 16 + 12] = bflo(x1.z); xs[i * 16 + 13] = bfhi(x1.z); xs[i * 16 + 14] = bflo(x1.w); xs[i * 16 + 15] = bfhi(x1.w); }
    float y[32];
#pragma unroll
    for (int i = 0; i < 32; ++i) y[i] = 0.f;
    const unsigned char* U8 = F.ws + WS_UB; const unsigned char* V8 = F.ws + WS_VB8; const float* SCL = (const float*)(F.ws + WS_SCL);
#pragma unroll 1
    for (int e0 = 0; e0 < 128; e0 += 2) {
      const int id0 = __builtin_amdgcn_readfirstlane(wli[128 + e0]), id1 = __builtin_amdgcn_readfirstlane(wli[128 + e0 + 1]);
      const float g0 = wl[256 + e0], g1 = wl[256 + e0 + 1];
      v4u ur0[2], ur1[2], vr0[2], vr1[2];
#pragma unroll
      for (int i = 0; i < 2; ++i) { ur0[i] = ((const v4u*)(U8 + (size_t)id0 * DM))[i * 64 + lane]; ur1[i] = ((const v4u*)(U8 + (size_t)id1 * DM))[i * 64 + lane]; }
#pragma unroll
      for (int i = 0; i < 2; ++i) { vr0[i] = ((const v4u*)(V8 + (size_t)id0 * DM))[i * 64 + lane]; vr1[i] = ((const v4u*)(V8 + (size_t)id1 * DM))[i * 64 + lane]; }
      const float su0 = SCL[id0], su1 = SCL[id1], sv0 = SCL[16384 + id0], sv1 = SCL[16384 + id1];
      float d0 = 0.f, d1 = 0.f;
#pragma unroll
      for (int i = 0; i < 2; ++i)
#pragma unroll
        for (int c = 0; c < 4; ++c) { const int wa = (int)ur0[i][c], wb = (int)ur1[i][c];
          const f32x2v a0 = __builtin_amdgcn_cvt_pk_f32_fp8(wa, false), a1 = __builtin_amdgcn_cvt_pk_f32_fp8(wa, true);
          const f32x2v b0 = __builtin_amdgcn_cvt_pk_f32_fp8(wb, false), b1 = __builtin_amdgcn_cvt_pk_f32_fp8(wb, true);
          const float x0 = xs[i * 16 + 4 * c], x1 = xs[i * 16 + 4 * c + 1], x2 = xs[i * 16 + 4 * c + 2], x3 = xs[i * 16 + 4 * c + 3];
          d0 += x0 * a0.x + x1 * a0.y + x2 * a1.x + x3 * a1.y; d1 += x0 * b0.x + x1 * b0.y + x2 * b1.x + x3 * b1.y; }
      d0 = wave_sum(d0); d1 = wave_sum(d1);
      const float c0 = gelu_erf(d0 * (rs * su0)) * (g0 * sv0), c1 = gelu_erf(d1 * (rs * su1)) * (g1 * sv1);
#pragma unroll
      for (int i = 0; i < 2; ++i)
#pragma unroll
        for (int c = 0; c < 4; ++c) { const int wa = (int)vr0[i][c], wb = (int)vr1[i][c];
          const f32x2v a0 = __builtin_amdgcn_cvt_pk_f32_fp8(wa, false), a1 = __builtin_amdgcn_cvt_pk_f32_fp8(wa, true);
          const f32x2v b0 = __builtin_amdgcn_cvt_pk_f32_fp8(wb, false), b1 = __builtin_amdgcn_cvt_pk_f32_fp8(wb, true);
          y[i * 16 + 4 * c] += c0 * a0.x + c1 * b0.x; y[i * 16 + 4 * c + 1] += c0 * a0.y + c1 * b0.y; y[i * 16 + 4 * c + 2] += c0 * a1.x + c1 * b1.x; y[i * 16 + 4 * c + 3] += c0 * a1.y + c1 * b1.y; }
    }
    float* orow = out + (size_t)tok * DM; float* drow = dst_base + (size_t)tok * DM;
#pragma unroll
    for (int i = 0; i < 2; ++i)
#pragma unroll
      for (int q = 0; q < 4; ++q) { const size_t off = (size_t)(i * 64 + lane) * 16 + q * 4; f32x4 hv = *(const f32x4*)(orow + off);
        hv.x += y[i * 16 + 4 * q]; hv.y += y[i * 16 + 4 * q + 1]; hv.z += y[i * 16 + 4 * q + 2]; hv.w += y[i * 16 + 4 * q + 3]; *(f32x4*)(drow + off) = hv; }
  }
}
constexpr int MISC_LDS = LDS_BYTES - 256;
__global__ void __launch_bounds__(NTHR, 2) mk_fwd(Args args) {
  extern __shared__ __attribute__((aligned(16))) unsigned char lds_raw[];
  Frame F; F.lds = (LAS unsigned char*)lds_raw; F.ws = args.ws; F.tid = threadIdx.x; F.lane = F.tid & 63; F.wave = __builtin_amdgcn_readfirstlane(F.tid >> 6);
  const int lo = args.ph_lo, hi = args.ph_hi, G = (int)gridDim.x, bx = (int)blockIdx.x;
  volatile LAS unsigned* misc = (volatile LAS unsigned*)(F.lds + MISC_LDS);
  if (F.tid < 16) misc[F.tid] = 0u;
  __syncthreads();
  XcdBarrier bar = xcd_barrier_post((unsigned*)(F.ws + WS_CTL) + CW_BAR, misc);
#define IN(k) (lo <= (k) && (k) < hi)
#define SEAM(k) do { if (IN(k) && IN((k) + 1)) xcd_barrier(bar); } while (0)
  const int NA = G;
  if (IN(0)) {
    p0_lam(F, args);
    p0_zero_vpad(F);
    p0_metaproj(F, args);
    p0_rows(F, args);
    p0_transpose(F, args.in[IN_WIN], DPROJ, NPROJ, (bf16*)(F.ws + WS_W1T));
    p0_transpose(F, args.in[IN_WOUT], DM, DM, (bf16*)(F.ws + WS_W2T));
    p0_w3t(F, args);
    p0_tables(F, args);
  }
  SEAM(0);
  if (IN(1)) {
    p1_meta_finalize(F, args);
    pg8::Gemm g{(const pg8::bf16_t*)(F.ws + WS_XN), (const pg8::bf16_t*)(F.ws + WS_W1T), MROWS, NPROJ, DM};
    pg8::StaticOrder S; S.init(MROWS, NPROJ, G, bx);
    EpiProj E{(bf16*)(F.ws + WS_Q), (bf16*)(F.ws + WS_KP), (bf16*)(F.ws + WS_VP), (bf16*)(F.ws + WS_MQ), (bf16*)(F.ws + WS_MK), (bf16*)(F.ws + WS_MV), (bf16*)(F.ws + WS_MO),
              args.in[IN_QNG], args.in[IN_KNG], (LAS float*)(F.lds + XCH_OFF)};
    pg8::gemm_phase<EpiProj, pg8::StaticOrder, true, true>(F.lds + RING_OFF, g, S, E);
  }
  SEAM(1);
  if (IN(2)) {
    att::phase(F, (G % 8 == 0) ? (bx & 7) * (G >> 3) + (bx >> 3) : bx, NA);
    for (int task = bx; task < 512; task += G) ml::taskA(F, args, task);
  }
  SEAM(2);
  if (IN(3)) ml::scanB(F);
  SEAM(3);
  if (IN(4)) {
    for (int task = bx; task < 512; task += G) ml::taskC(F, args, task);
    p3_combine(F, args, NA);
  }
  SEAM(4);
  if (IN(5)) {
    pg8::Gemm g{(const pg8::bf16_t*)(F.ws + WS_A2), (const pg8::bf16_t*)(F.ws + WS_W2T), MROWS, DM, DM};
    pg8::StaticOrder S; S.init(MROWS, DM, G, bx);
    EpiRes E{args.in[IN_X], args.out, (bf16*)(F.ws + WS_H1B), (float*)(F.ws + WS_SSQ)};
    pg8::gemm_phase<EpiRes, pg8::StaticOrder, true, true>(F.lds + RING_OFF, g, S, E);
  }
  SEAM(5);
  if (IN(6)) {
    pg8::Gemm g{(const pg8::bf16_t*)(F.ws + WS_H1B), (const pg8::bf16_t*)(F.ws + WS_W3T), MROWS, DM, DM};
    pg8::StaticOrder S; S.init(MROWS, DM, G, bx);
    LAS float* rst = (LAS float*)(F.lds + XCH_OFF);
    { pg8::Unit u0; if (S.next(0, u0)) { if (F.tid < 256) { const float* sp = (const float*)(F.ws + WS_SSQ) + ((size_t)u0.pm * 256 + F.tid) * 32; float s = 0.f;
#pragma unroll
          for (int i = 0; i < 8; ++i) { const f32x4 v = ((const f32x4*)sp)[i]; s += (v.x + v.y) + (v.z + v.w); }
          rst[F.tid] = rsqrtf(s * (1.0f / DM) + EPS); } } }
    __syncthreads();
    EpiScore E{(float*)(F.ws + WS_S), rst};
    pg8::gemm_phase<EpiScore, pg8::StaticOrder, true, true>(F.lds + RING_OFF, g, S, E);
  }
  SEAM(6);
  if (IN(7)) p6_peer(F, args, args.out);
#undef IN
#undef SEAM
}
extern "C" void kernel_launch(void* const* d_in, const int* in_sizes, int n_in, void* d_out, int out_size, void* d_ws, size_t ws_size, hipStream_t stream) {
  static int grid = 0;
  if (grid == 0) {
    int dev = 0, cus = 0, per_cu = 0;
    if (hipGetDevice(&dev) != hipSuccess || hipDeviceGetAttribute(&cus, hipDeviceAttributeMultiprocessorCount, dev) != hipSuccess) { fprintf(stderr, "device query failed\n"); grid = -1; return; }
    if (hipFuncSetAttribute((const void*)mk_fwd, hipFuncAttributeMaxDynamicSharedMemorySize, LDS_BYTES) != hipSuccess) { fprintf(stderr, "hipFuncSetAttribute failed\n"); grid = -1; return; }
    if (hipOccupancyMaxActiveBlocksPerMultiprocessor(&per_cu, (const void*)mk_fwd, NTHR, LDS_BYTES) != hipSuccess || per_cu < 1) { fprintf(stderr, "occupancy query says %d workgroups per CU: not launching\n", per_cu); (void)hipGetLastError(); grid = -1; return; }
    (void)hipGetLastError();
    grid = cus;
    if (n_in != 22 || ws_size < (size_t)512 * MiB || out_size != MROWS * DM) { fprintf(stderr, "unexpected shapes: n_in %d out %d ws %zu\n", n_in, out_size, ws_size); grid = -1; return; }
  }
  if (grid < 0) return;
  unsigned char* ws = (unsigned char*)d_ws;
  if (hipMemsetAsync(ws + WS_CTL, 0, CTL_ZERO_BYTES, stream) != hipSuccess) { fprintf(stderr, "memset failed\n"); return; }
  Args a{};
  for (int i = 0; i < 22; ++i) a.in[i] = (const float*)d_in[i];
  a.out = (float*)d_out; a.ws = ws; a.na = 0; a.pad = 0;
  a.ph_lo = 0; a.ph_hi = 8;
  hipLaunchKernelGGL(mk_fwd, dim3(grid), dim3(NTHR), LDS_BYTES, stream, a);
}
```

```cpp
#include <hip/hip_runtime.h>
#include <cstdio>
#include <cstdint>
#include <math.h>
namespace pg8 {
#define PG8_LAS __attribute__((address_space(3)))
typedef unsigned short bf16_t;
typedef short bf16x8 __attribute__((ext_vector_type(8)));
typedef float f32x4 __attribute__((ext_vector_type(4)));
typedef unsigned u32x4 __attribute__((ext_vector_type(4)));
constexpr int BM = 256, BK = 64, HALF = 128, HTB = HALF * BK * 2  , STAGE_BYTES = 8 * HTB, NXCD = 8, WGM = 8;

__host__ __device__ __forceinline__ int lds_byte(int r, int c) { const int st = (r >> 4) * 2 + (c >> 5), rr = r & 15, cc = c & 31, ob = rr * 64 + cc * 2; return st * 1024 + (ob ^ (((ob >> 9) & 1) << 5)); }
__host__ __device__ __forceinline__ void stage_rc(int b, int& R, int& C) { const int st = b / 1024, sb = b % 1024, swz = sb ^ (((sb >> 9) & 1) << 5); R = (st >> 1) * 16 + swz / 64; C = (st & 1) * 32 + (swz % 64) / 2; }
__host__ __device__ __forceinline__ int perm32(int rho) { const int n = rho >> 4, i = rho & 15; return 8 * (i >> 2) + 4 * n + (i & 3); }

struct Unit { int pm, pn; };
struct Gemm { const bf16_t* A; const bf16_t* Bt; int M, N, K; };

struct StaticOrder {
    int nM, nN, nwg, G, c;
    __host__ __device__ void init(int M, int N, int G_, int c_) { nM = M / BM; nN = N / BM; nwg = nM * nN; G = G_; c = c_; }
    __host__ __device__ bool next(int i, Unit& u) const {
        const long L = (long)i * G + c; if (L >= nwg) return false;
        int wgid = (int)L; { const int q = nwg / NXCD, r = nwg % NXCD, xcd = wgid % NXCD, off = wgid / NXCD; wgid = (xcd < r ? xcd * (q + 1) : r * (q + 1) + (xcd - r) * q) + off; }
        const int nig = WGM * nN, gid = wgid / nig, fm = gid * WGM, gsz = (nM - fm) < WGM ? (nM - fm) : WGM;
        u.pm = fm + ((wgid % nig) % gsz); u.pn = (wgid % nig) / gsz; return true;
    }
    __device__ __forceinline__ void a_ready(const Unit&) const {}
    __device__ __forceinline__ void done(const Unit&) const {}
};

__device__ __forceinline__ unsigned cvt_pk_bf16(float lo, float hi) { unsigned r; asm volatile("v_cvt_pk_bf16_f32 %0, %1, %2" : "=v"(r) : "v"(lo), "v"(hi)); return r; }
typedef float f32x2 __attribute__((ext_vector_type(2)));
template <class Epi, class Sched, bool ALIGN_EPI = false, bool SP2 = false>
__device__ __forceinline__ void gemm_phase(PG8_LAS unsigned char* lds, const Gemm g, const Sched& S, const Epi& E) {
    const int tid = threadIdx.x, wid = __builtin_amdgcn_readfirstlane(tid >> 6), lane = tid & 63, wr = wid >> 2, wc = wid & 3, fr = lane & 15, fq = lane >> 4;
    const int K = g.K, nt = K / BK;
    unsigned voffA[2], voffB[2];
#pragma unroll
    for (int i = 0; i < 2; ++i) { int R, C; stage_rc(tid * 16 + i * 8192, R, C); const int Rb = Epi::PERM ? ((R & ~31) + perm32(R & 31)) : R;
        voffA[i] = (unsigned)(R * K + C) * 2u; voffB[i] = (unsigned)(Rb * K + C) * 2u; }
    const size_t kstep = (size_t)(BK * 2);
    const size_t hstep = (size_t)HALF * K * 2;
    const size_t tstep = 2 * hstep;
    const unsigned ldsw = (unsigned)wid * 1024u;
    const int aoff = lds_byte(wr * 64 + fr, fq * 8), boff = lds_byte(wc * 32 + fr, fq * 8);
#define PG8_SA(b, h) (((b) * 2 + (h)) * HTB)
#define PG8_SB(b, h) ((4 + (b) * 2 + (h)) * HTB)
#define PG8_STAGE(bufoff, gbase, voff) do { _Pragma("unroll") for (int _i = 0; _i < 2; ++_i) \
        __builtin_amdgcn_global_load_lds((const unsigned*)((const char*)(gbase) + (voff)[_i]), (PG8_LAS unsigned*)(lds + (bufoff) + ldsw + _i * 8192), 16, 0, 0); } while (0)
#define PG8_LDA(dst, b, h) do { _Pragma("unroll") for (int m = 0; m < 4; ++m) _Pragma("unroll") for (int k = 0; k < 2; ++k) dst[m][k] = *(const PG8_LAS bf16x8*)(lds + PG8_SA(b, h) + aoff + m * 2048 + k * 1024); } while (0)
#define PG8_LDB(dst, b, h) do { _Pragma("unroll") for (int n = 0; n < 2; ++n) _Pragma("unroll") for (int k = 0; k < 2; ++k) dst[n][k] = *(const PG8_LAS bf16x8*)(lds + PG8_SB(b, h) + boff + n * 2048 + k * 1024); } while (0)
#define PG8_MMA(ai, bj, At, Bt) do { __builtin_amdgcn_s_setprio(1); _Pragma("unroll") for (int m = 0; m < 4; ++m) _Pragma("unroll") for (int n = 0; n < 2; ++n) _Pragma("unroll") for (int k = 0; k < 2; ++k) \
        acc[ai][bj][m][n] = __builtin_amdgcn_mfma_f32_16x16x32_bf16(Bt[n][k], At[m][k], acc[ai][bj][m][n], 0, 0, 0); __builtin_amdgcn_s_setprio(0); } while (0)
#define PG8_WAIT_V(n) asm volatile("s_waitcnt vmcnt(" #n ")" ::: "memory")
#define PG8_WAIT_L(n) asm volatile("s_waitcnt lgkmcnt(" #n ")" ::: "memory")
#define PG8_BAR __builtin_amdgcn_s_barrier()
#define PG8_SCHED __builtin_amdgcn_sched_barrier(0)
    Unit cur, nxt; int ui = 0;
    if (!S.next(0, cur)) return;
    f32x4 acc[2][2][4][2];
#pragma unroll
    for (int a = 0; a < 2; ++a)
#pragma unroll
        for (int b = 0; b < 2; ++b)
#pragma unroll
            for (int m = 0; m < 4; ++m)
#pragma unroll
                for (int n = 0; n < 2; ++n) acc[a][b][m][n] = (f32x4){0.f, 0.f, 0.f, 0.f};
    bf16x8 At[4][2], B0[2][2], B1[2][2];
    const char* cA = (const char*)g.A + (size_t)cur.pm * tstep; const char* cB = (const char*)g.Bt + (size_t)cur.pn * tstep;
    S.a_ready(cur);
    if constexpr (SP2) {
        PG8_STAGE(PG8_SB(0, 0), cB, voffB); PG8_STAGE(PG8_SB(0, 1), cB + hstep, voffB); PG8_STAGE(PG8_SA(0, 0), cA, voffA); PG8_STAGE(PG8_SA(0, 1), cA + hstep, voffA);
        if (wr == 1) PG8_BAR;
        PG8_WAIT_V(2); PG8_BAR;
        PG8_STAGE(PG8_SB(1, 0), cB + kstep, voffB); PG8_STAGE(PG8_SA(1, 0), cA + kstep, voffA); PG8_STAGE(PG8_SB(1, 1), cB + hstep + kstep, voffB);
        PG8_WAIT_V(6); PG8_BAR;
    } else {
        PG8_STAGE(PG8_SB(0, 0), cB, voffB); PG8_STAGE(PG8_SA(0, 0), cA, voffA); PG8_STAGE(PG8_SB(0, 1), cB + hstep, voffB); PG8_STAGE(PG8_SA(0, 1), cA + hstep, voffA);
        if (wr == 1) PG8_BAR;
        PG8_WAIT_V(4); PG8_BAR;
        PG8_STAGE(PG8_SB(1, 0), cB + kstep, voffB); PG8_STAGE(PG8_SA(1, 0), cA + kstep, voffA); PG8_STAGE(PG8_SB(1, 1), cB + hstep + kstep, voffB);
        PG8_WAIT_V(6); PG8_BAR;
    }
    for (;;) {
        const bool has_next = S.next(ui + 1, nxt);
        const char* nA = has_next ? (const char*)g.A + (size_t)nxt.pm * tstep : cA; const char* nB = has_next ? (const char*)g.Bt + (size_t)nxt.pn * tstep : cB;
        for (int t = 0; t < nt; t += 2) {
            const bool last = (t == nt - 2);
            const char* a1 = cA + (size_t)(t + 1) * kstep;
            const char* a2 = last ? nA : cA + (size_t)(t + 2) * kstep; const char* b2 = last ? nB : cB + (size_t)(t + 2) * kstep;
            const char* a3 = a2 + kstep; const char* b3 = b2 + kstep;
            if (last && has_next) S.a_ready(nxt);
            if constexpr (SP2) {
            PG8_LDB(B0, 0, 0); PG8_LDB(B1, 0, 1); PG8_SCHED; PG8_LDA(At, 0, 0); PG8_STAGE(PG8_SA(1, 1), a1 + hstep, voffA);
            PG8_WAIT_V(8); PG8_WAIT_L(0); PG8_BAR; PG8_MMA(0, 0, At, B0); PG8_MMA(0, 1, At, B1); PG8_BAR; PG8_SCHED;
            PG8_LDA(At, 0, 1); PG8_STAGE(PG8_SB(0, 0), b2, voffB); PG8_STAGE(PG8_SB(0, 1), b2 + hstep, voffB); PG8_STAGE(PG8_SA(0, 0), a2, voffA);
            PG8_WAIT_V(8); PG8_WAIT_L(0); PG8_BAR; PG8_MMA(1, 0, At, B0); PG8_MMA(1, 1, At, B1); PG8_BAR; PG8_SCHED;
            PG8_LDB(B0, 1, 0); PG8_LDB(B1, 1, 1); PG8_SCHED; PG8_LDA(At, 1, 0); PG8_STAGE(PG8_SA(0, 1), a2 + hstep, voffA);
            PG8_WAIT_V(8); PG8_WAIT_L(0); PG8_BAR; PG8_MMA(0, 0, At, B0); PG8_MMA(0, 1, At, B1); PG8_BAR; PG8_SCHED;
            PG8_LDA(At, 1, 1); PG8_STAGE(PG8_SB(1, 0), b3, voffB); PG8_STAGE(PG8_SB(1, 1), b3 + hstep, voffB); PG8_STAGE(PG8_SA(1, 0), a3, voffA);
            PG8_WAIT_V(8); PG8_WAIT_L(0); PG8_BAR; PG8_MMA(1, 0, At, B0); PG8_MMA(1, 1, At, B1); PG8_BAR; PG8_SCHED;
            } else {
            PG8_LDB(B0, 0, 0); PG8_SCHED; PG8_LDA(At, 0, 0); PG8_STAGE(PG8_SA(1, 1), a1 + hstep, voffA);
            PG8_WAIT_L(8); PG8_BAR; PG8_WAIT_L(0); PG8_MMA(0, 0, At, B0); PG8_BAR; PG8_SCHED;
            PG8_LDB(B1, 0, 1); PG8_STAGE(PG8_SB(0, 0), b2, voffB);
            PG8_BAR; PG8_WAIT_L(0); PG8_MMA(0, 1, At, B1); PG8_BAR;
            PG8_LDA(At, 0, 1); PG8_STAGE(PG8_SA(0, 0), a2, voffA);
            PG8_BAR; PG8_WAIT_L(0); PG8_MMA(1, 0, At, B0); PG8_BAR; PG8_SCHED;
            PG8_STAGE(PG8_SB(0, 1), b2 + hstep, voffB);
            PG8_WAIT_V(6); PG8_BAR; PG8_MMA(1, 1, At, B1); PG8_BAR;
            PG8_LDB(B0, 1, 0); PG8_SCHED; PG8_LDA(At, 1, 0); PG8_STAGE(PG8_SA(0, 1), a2 + hstep, voffA);
            PG8_WAIT_L(8); PG8_BAR; PG8_WAIT_L(0); PG8_MMA(0, 0, At, B0); PG8_BAR; PG8_SCHED;
            PG8_LDB(B1, 1, 1); PG8_STAGE(PG8_SB(1, 0), b3, voffB);
            PG8_BAR; PG8_WAIT_L(0); PG8_MMA(0, 1, At, B1); PG8_BAR;
            PG8_LDA(At, 1, 1); PG8_STAGE(PG8_SA(1, 0), a3, voffA);
            PG8_BAR; PG8_WAIT_L(0); PG8_MMA(1, 0, At, B0); PG8_BAR; PG8_SCHED;
            PG8_STAGE(PG8_SB(1, 1), b3 + hstep, voffB);
            PG8_WAIT_V(6); PG8_BAR; PG8_MMA(1, 1, At, B1); PG8_BAR;
            }
        }
        if constexpr (ALIGN_EPI) { if (wr == 0) PG8_BAR; }
        if constexpr (!Epi::AFTER_DRAIN) { E(acc, cur, wr, wc, fr, fq); S.done(cur); }
        if (!has_next) break;
#pragma unroll
        for (int a = 0; a < 2; ++a)
#pragma unroll
            for (int b = 0; b < 2; ++b)
#pragma unroll
                for (int m = 0; m < 4; ++m)
#pragma unroll
                    for (int n = 0; n < 2; ++n) acc[a][b][m][n] = (f32x4){0.f, 0.f, 0.f, 0.f};
        cur = nxt; cA = nA; cB = nB; ++ui;
        if constexpr (ALIGN_EPI) { if (wr == 1) PG8_BAR; }
    }
    PG8_WAIT_V(0);
    if constexpr (!ALIGN_EPI) { if (wr == 0) PG8_BAR; }
    PG8_BAR;
    if constexpr (Epi::AFTER_DRAIN) { E.fused(acc, cur, wr, wc, fr, fq, lds, wid, lane); S.done(cur); }
#undef PG8_SA
#undef PG8_SB
#undef PG8_STAGE
#undef PG8_LDA
#undef PG8_LDB
#undef PG8_MMA
#undef PG8_WAIT_V
#undef PG8_WAIT_L
#undef PG8_BAR
#undef PG8_SCHED
}
}
#define GAS __attribute__((address_space(1)))
#define LAS __attribute__((address_space(3)))
typedef unsigned short bf16;
typedef unsigned v4u __attribute__((ext_vector_type(4)));
typedef unsigned v2u __attribute__((ext_vector_type(2)));
typedef float f32x4 __attribute__((ext_vector_type(4)));
typedef short bf16x8 __attribute__((ext_vector_type(8)));
#define LDS_WAIT() asm volatile("s_waitcnt lgkmcnt(0)" ::: "memory")
#define VM_WAIT() asm volatile("s_waitcnt vmcnt(0)" ::: "memory")

constexpr int DM = 2048, NB = 4, SEQ = 2048, NMETA = 16, MROWS = NB * SEQ, DPROJ = 6152, NPROJ = 6144;
constexpr int PADT = 2112, POS0 = 64, MPOS0 = 48;
constexpr float EPS = 1e-6f;
constexpr float LOG2E = 1.4426950408889634f;
constexpr float QSCALE = 0.08838834764831845f * LOG2E;
constexpr int NWAVES = 8, NTHR = 512;

constexpr size_t MiB = 1u << 20;
constexpr size_t WS_CTL = 0, CTL_ZERO_BYTES = 1 * MiB;
constexpr size_t WS_PM = 512 * 1024;
constexpr size_t WS_W1T = 2 * MiB, WS_W2T = 26 * MiB, WS_W3T = 34 * MiB, WS_XN = 42 * MiB;
constexpr size_t WS_Q = 74 * MiB, WS_KP = 90 * MiB, WS_VP = 107 * MiB, WS_MQ = 124 * MiB, WS_MK = 133 * MiB, WS_MV = 142 * MiB, WS_MO = 159 * MiB;
constexpr size_t WS_SMALL = 175 * MiB;
constexpr size_t WS_XM = WS_SMALL, WS_LI = WS_SMALL + 128 * 1024, WS_LF = WS_SMALL + 384 * 1024, WS_LAM = WS_SMALL + 640 * 1024;
constexpr size_t WS_PO = 176 * MiB, WS_ML = 304 * MiB, WS_HM = 305 * MiB, WS_A2 = 42 * MiB, WS_H1B = 74 * MiB, WS_SSQ = 106 * MiB, WS_S = 176 * MiB, WS_UB = 384 * MiB, WS_VB = 448 * MiB;
constexpr size_t WS_SCL = WS_SMALL + 704 * 1024;
constexpr size_t WS_VB8 = WS_UB + 32 * MiB;
constexpr size_t WS_DC = 305 * MiB, WS_CS = 448 * MiB, WS_DN = 482 * MiB, WS_NS = WS_DN + 512 * 1024, WS_GS = WS_DN + 1024 * 1024, WS_MS = WS_DN + 1152 * 1024;
constexpr int CW_BAR = 4096;

constexpr int RING_OFF = 0, RING_BYTES = 131072;
constexpr int XCH_OFF = 131072;
constexpr int MISC_OFF = XCH_OFF + 8192;
constexpr int LDS_BYTES = 155648;

__device__ __forceinline__ unsigned f2bf(float f) { unsigned u = __builtin_bit_cast(unsigned, f); return (u + 0x7fffu + ((u >> 16) & 1u)) >> 16; }
__device__ __forceinline__ unsigned pk2(float lo, float hi) { return f2bf(lo) | (f2bf(hi) << 16); }
__device__ __forceinline__ float bf2f(unsigned short u) { return __builtin_bit_cast(float, (unsigned)u << 16); }
__device__ __forceinline__ float bflo(unsigned w) { return __builtin_bit_cast(float, w << 16); }
__device__ __forceinline__ float bfhi(unsigned w) { return __builtin_bit_cast(float, w & 0xffff0000u); }
__device__ __forceinline__ float wave_sum(float v) {
#pragma unroll
  for (int o = 1; o < 64; o <<= 1) v += __shfl_xor(v, o);
  return v;
}
__device__ __forceinline__ size_t kp_off(int bhm, int pos, int d) { const int j = pos >> 6, row = pos & 63, d0 = d >> 4, hi = (d >> 3) & 1;
  return ((size_t)(bhm * 33 + j) * 8 + d0) * 1024 + (size_t)((((row << 1) | hi) ^ ((row >> 3) & 1)) << 3) + (d & 7); }
__device__ __forceinline__ float sigmoidf_(float x) { return 1.0f / (1.0f + __expf(-x)); }
#define XB_TMO      128
#define XB_XCNT(j)  (256  + 64 * (j))
#define XB_XSUB(j)  (1280 + 64 * (j))
#define XB_XGEN(j)  (2304 + 64 * (j))
#define XB_TOP      3328
#define XB_TOPGEN   3392
#define XCD_BAR_WORDS 3456
#define XB_SPIN_CAP (1u << 18)

__device__ __forceinline__ unsigned xb_ld(unsigned* p)              { return __hip_atomic_load(p, __ATOMIC_RELAXED, __HIP_MEMORY_SCOPE_AGENT); }
__device__ __forceinline__ unsigned xb_add(unsigned* p, unsigned v) { return __hip_atomic_fetch_add(p, v, __ATOMIC_RELAXED, __HIP_MEMORY_SCOPE_AGENT); }
__device__ __forceinline__ unsigned xb_xcc_id() { return (unsigned)__builtin_amdgcn_s_getreg((3 << 11) | 20) & 0xFu; }
#define XB_SPIN(cond, bar) do { unsigned _sp = 0; while (cond) { __builtin_amdgcn_s_sleep(1); \
    if ((++_sp & 255u) == 0u) { if (xb_ld(&(bar)[XB_TMO])) break; if (_sp > XB_SPIN_CAP) { atomicAdd(&(bar)[XB_TMO], 1u); break; } } } } while (0)

struct XcdBarrier {
    unsigned* bar; unsigned x;
    volatile LAS unsigned* st;
};

__device__ __forceinline__ XcdBarrier xcd_barrier_post(unsigned* bar, volatile LAS unsigned* st) {
    XcdBarrier b; b.bar = bar; b.x = xb_xcc_id(); b.st = st;
    if (threadIdx.x == 0) (void)xb_add(&bar[XB_XCNT(b.x)], 1u);
    return b;
}
__device__ __forceinline__ void xcd_barrier_complete(unsigned* bar, unsigned x, unsigned& nloc, unsigned& nx) {
    const unsigned G = gridDim.x * gridDim.y * gridDim.z;
    unsigned sum, cnt, mine, sp = 0u;
    for (;;) {
        sum = 0u; cnt = 0u; mine = 0u;
#pragma unroll
        for (unsigned j = 0; j < 16; ++j) { const unsigned c = xb_ld(&bar[XB_XCNT(j)]); sum += c; cnt += (c > 0u) ? 1u : 0u; mine = (j == x) ? c : mine; }
        if (sum == G) break;
        __builtin_amdgcn_s_sleep(1);
        if ((++sp & 255u) == 0u) { if (xb_ld(&bar[XB_TMO])) break; if (sp > XB_SPIN_CAP) { atomicAdd(&bar[XB_TMO], 1u); break; } }
    }
    nloc = mine > 0u ? mine : 1u; nx = cnt > 0u ? cnt : 1u;
}

__device__ __forceinline__ void xcd_barrier(const XcdBarrier& b) {
    asm volatile("s_waitcnt vmcnt(0)" ::: "memory");
    __syncthreads();
    if (threadIdx.x == 0) {
        unsigned* bar = b.bar;
        __builtin_amdgcn_s_waitcnt(0);
        unsigned nloc = b.st[0], nx = b.st[1];
        if (nloc == 0u) { xcd_barrier_complete(bar, b.x, nloc, nx); b.st[0] = nloc; b.st[1] = nx; }
        const unsigned old = xb_add(&bar[XB_XSUB(b.x)], 1u);
        const unsigned gen = old / nloc;
        if (old + 1u == (gen + 1u) * nloc) {
            __builtin_amdgcn_fence(__ATOMIC_RELEASE, "agent");
            asm volatile("s_waitcnt vmcnt(0)" ::: "memory");
            const unsigned og = xb_add(&bar[XB_TOP], 1u);
            const unsigned tg = og / nx;
            if (og + 1u == (tg + 1u) * nx) xb_add(&bar[XB_TOPGEN], 1u);
            else XB_SPIN(xb_ld(&bar[XB_TOPGEN]) == tg, bar);
            __builtin_amdgcn_fence(__ATOMIC_ACQUIRE, "agent");
            xb_add(&bar[XB_XGEN(b.x)], 1u);
            asm volatile("s_waitcnt vmcnt(0)" ::: "memory");
        } else {
            XB_SPIN(xb_ld(&bar[XB_XGEN(b.x)]) == gen, bar);
            __builtin_amdgcn_fence(__ATOMIC_ACQUIRE, "agent");
            asm volatile("s_waitcnt vmcnt(0)" ::: "memory");
        }
    }
    __syncthreads();
}

struct Args { const float* in[22]; float* out; unsigned char* ws; int ph_lo, ph_hi, na, pad; };
struct Frame {
  LAS unsigned char* lds; unsigned char* ws; int tid, lane, wave; const float* const* in;
};
#define IN_X 0
#define IN_META 1
#define IN_G1 2
#define IN_WIN 3
#define IN_CW 4
#define IN_CB 5
#define IN_IGB 6
#define IN_FGB 7
#define IN_LQ1 8
#define IN_LK1 9
#define IN_LQ2 10
#define IN_LK2 11
#define IN_QNG 12
#define IN_KNG 13
#define IN_SUBG 14
#define IN_OUTG 15
#define IN_WOUT 16
#define IN_G2 17
#define IN_WQ 18
#define IN_SUBK 19
#define IN_U 20
#define IN_V 21

__device__ __forceinline__ void p0_rows(const Frame& F, const Args& a) {
  const float* x = a.in[IN_X]; const float* meta = a.in[IN_META]; const float* g1 = a.in[IN_G1]; const float* w_in = a.in[IN_WIN];
  const float* igb = a.in[IN_IGB]; const float* fgb = a.in[IN_FGB];
  bf16* Xn = (bf16*)(F.ws + WS_XN); bf16* Xm = (bf16*)(F.ws + WS_XM); float* LI = (float*)(F.ws + WS_LI); float* LF = (float*)(F.ws + WS_LF);
  LAS f32x4* wgl = (LAS f32x4*)(F.lds);
  for (int e = F.tid; e < 4096; e += NTHR) {
    const int ln = e & 63, q = e >> 6, half = q & 1, j = (q >> 1) & 3, i = q >> 3;
    const int k = 4 * (i * 64 + ln) + j;
    wgl[e] = *(const f32x4*)(w_in + (size_t)k * DPROJ + NPROJ + 4 * half);
  }
  __syncthreads();
  const int gw = blockIdx.x * NWAVES + F.wave, NGW = gridDim.x * NWAVES, lane = F.lane;
  for (int task = gw; task < MROWS / 2 + NMETA / 2; task += NGW) {
    const bool ismeta = task >= MROWS / 2;
    const int r0 = ismeta ? (task - MROWS / 2) * 2 : task * 2;
    const float* src0 = (ismeta ? meta : x) + (size_t)r0 * DM;
    float rs[2];
    { float s0 = 0.f, s1 = 0.f;
#pragma unroll 2
      for (int i = 0; i < 8; ++i) { const f32x4 a0 = ((const f32x4*)src0)[i * 64 + lane], a1 = ((const f32x4*)(src0 + DM))[i * 64 + lane];
        s0 += (a0.x * a0.x + a0.y * a0.y) + (a0.z * a0.z + a0.w * a0.w); s1 += (a1.x * a1.x + a1.y * a1.y) + (a1.z * a1.z + a1.w * a1.w); }
      rs[0] = rsqrtf(wave_sum(s0) * (1.0f / DM) + EPS); rs[1] = rsqrtf(wave_sum(s1) * (1.0f / DM) + EPS); }
    float ga[2][8];
#pragma unroll
    for (int rr = 0; rr < 2; ++rr)
#pragma unroll
      for (int g = 0; g < 8; ++g) ga[rr][g] = 0.f;
    bf16* dst0 = (ismeta ? Xm : Xn) + (size_t)r0 * DM;
#pragma unroll 1
    for (int i = 0; i < 8; ++i) {
      const f32x4 g = ((const f32x4*)g1)[i * 64 + lane];
      f32x4 xn[2];
#pragma unroll
      for (int rr = 0; rr < 2; ++rr) { xn[rr] = ((const f32x4*)(src0 + (size_t)rr * DM))[i * 64 + lane] * g * rs[rr];
        v2u o; o.x = pk2(xn[rr].x, xn[rr].y); o.y = pk2(xn[rr].z, xn[rr].w); ((v2u*)(dst0 + (size_t)rr * DM))[i * 64 + lane] = o; }
#pragma unroll
      for (int j = 0; j < 4; ++j) {
        const f32x4 w0 = wgl[((i * 4 + j) * 2 + 0) * 64 + lane], w1 = wgl[((i * 4 + j) * 2 + 1) * 64 + lane];
#pragma unroll
        for (int rr = 0; rr < 2; ++rr) { const float xv = xn[rr][j];
          ga[rr][0] += xv * w0.x; ga[rr][1] += xv * w0.y; ga[rr][2] += xv * w0.z; ga[rr][3] += xv * w0.w;
          ga[rr][4] += xv * w1.x; ga[rr][5] += xv * w1.y; ga[rr][6] += xv * w1.z; ga[rr][7] += xv * w1.w; }
      }
    }
#pragma unroll
    for (int rr = 0; rr < 2; ++rr)
#pragma unroll
      for (int g = 0; g < 8; ++g) ga[rr][g] = wave_sum(ga[rr][g]);
    if (lane < 8) {
      const int rr = lane >> 2, h = lane & 3;
      float gi = 0.f, gf = 0.f;
#pragma unroll
      for (int q = 0; q < 2; ++q)
#pragma unroll
        for (int hh = 0; hh < 4; ++hh) if (q == rr && hh == h) { gi = ga[q][hh]; gf = ga[q][4 + hh]; }
      const float li = gi + igb[h]; const float fx = gf + fgb[h];
      const float lf = fminf(fx, 0.f) - log1pf(__expf(-fabsf(fx)));
      const int R = r0 + rr;
      if (!ismeta) { const int b = R >> 11, t = R & 2047; LI[(b * 4 + h) * PADT + POS0 + t] = li; LF[(b * 4 + h) * PADT + POS0 + t] = lf; }
      else { for (int b = 0; b < NB; ++b) { LI[(b * 4 + h) * PADT + MPOS0 + R] = li; LF[(b * 4 + h) * PADT + MPOS0 + R] = lf; } }
    }
  }
  __syncthreads();
}
__device__ __forceinline__ void p0_metaproj(const Frame& F, const Args& a) {
  const float* meta = a.in[IN_META]; const float* g1 = a.in[IN_G1]; const float* w_in = a.in[IN_WIN];
  float* PM = (float*)(F.ws + WS_PM);
  LAS float* xs = (LAS float*)(F.lds);
  LAS float* part = (LAS float*)(F.lds + 16384);
  const int q = F.tid >> 7, c = F.tid & 127;
  for (int task = blockIdx.x; task < NPROJ / 128; task += gridDim.x) {
    const int n = task * 128 + c;
    float acc[16];
#pragma unroll
    for (int m = 0; m < 16; ++m) acc[m] = 0.f;
#pragma unroll 1
    for (int kb = 0; kb < 8; ++kb) {
      __syncthreads();
#pragma unroll
      for (int i = 0; i < 8; ++i) { const int idx = F.tid + NTHR * i, qq = idx >> 10, kk = (idx >> 4) & 63, m = idx & 15; const int k = 512 * qq + 64 * kb + kk;
        xs[idx] = meta[(size_t)m * DM + k] * g1[k]; }
      __syncthreads();
#pragma unroll 4
      for (int kk = 0; kk < 64; ++kk) {
        const float w = w_in[(size_t)(512 * q + 64 * kb + kk) * DPROJ + n];
        const LAS f32x4* xp = (const LAS f32x4*)(xs + (q * 64 + kk) * 16);
#pragma unroll
        for (int t = 0; t < 4; ++t) { const f32x4 xv = xp[t]; acc[4 * t + 0] += xv.x * w; acc[4 * t + 1] += xv.y * w; acc[4 * t + 2] += xv.z * w; acc[4 * t + 3] += xv.w * w; }
      }
    }
#pragma unroll
    for (int m = 0; m < 16; ++m) part[(q * 16 + m) * 128 + c] = acc[m];
    __syncthreads();
    for (int e = F.tid; e < 16 * 128; e += NTHR) { const int m = e >> 7, cc = e & 127;
      PM[m * NPROJ + task * 128 + cc] = (part[(0 * 16 + m) * 128 + cc] + part[(1 * 16 + m) * 128 + cc]) + (part[(2 * 16 + m) * 128 + cc] + part[(3 * 16 + m) * 128 + cc]); }
  }
  __syncthreads();
}
__device__ __forceinline__ void p0_transpose(const Frame& F, const float* W, int ldw, int N, bf16* Wt) {
  LAS float* tl = (LAS float*)(F.lds);
  const int ntn = N / 64, ntask = ntn * 16;
  for (int task = blockIdx.x; task < ntask; task += gridDim.x) {
    const int nb = task % ntn, kb = task / ntn, n0 = nb * 64, k0 = kb * 128;
    __syncthreads();
#pragma unroll
    for (int i = 0; i < 4; ++i) { const int idx = F.tid + NTHR * i, kk = idx >> 4, c4 = idx & 15;
      const f32x4 w = *(const f32x4*)(W + (size_t)(k0 + kk) * ldw + n0 + 4 * c4);
      LAS float* d = tl + kk * 65 + 4 * c4; d[0] = w.x; d[1] = w.y; d[2] = w.z; d[3] = w.w; }
    __syncthreads();
    const int n = F.tid >> 3, kc = F.tid & 7;
    const LAS float* s = tl + (kc * 16) * 65 + n;
    v4u o0, o1;
    o0.x = pk2(s[0 * 65], s[1 * 65]); o0.y = pk2(s[2 * 65], s[3 * 65]); o0.z = pk2(s[4 * 65], s[5 * 65]); o0.w = pk2(s[6 * 65], s[7 * 65]);
    o1.x = pk2(s[8 * 65], s[9 * 65]); o1.y = pk2(s[10 * 65], s[11 * 65]); o1.z = pk2(s[12 * 65], s[13 * 65]); o1.w = pk2(s[14 * 65], s[15 * 65]);
    v4u* dp = (v4u*)(Wt + (size_t)(n0 + n) * DM + k0 + kc * 16);
    dp[0] = o0; dp[1] = o1;
  }
  __syncthreads();
}
__device__ __forceinline__ void p0_zero_vpad(const Frame& F) {
  bf16* Vp = (bf16*)(F.ws + WS_VP);
  const int per = MPOS0 * 256 / 8;
  for (int i = blockIdx.x * NTHR + F.tid; i < 16 * per; i += gridDim.x * NTHR) { const int bh = i / per, e = i % per;
    *(v4u*)(Vp + (size_t)bh * PADT * 256 + (size_t)e * 8) = (v4u){0u, 0u, 0u, 0u}; }
}
__device__ __forceinline__ void p0_lam(const Frame& F, const Args& a) {
  if (blockIdx.x == 0 && F.wave == 0) {
    const int l = F.lane;
    float s1 = a.in[IN_LQ1][l] * a.in[IN_LK1][l] + a.in[IN_LQ1][l + 64] * a.in[IN_LK1][l + 64];
    float s2 = a.in[IN_LQ2][l] * a.in[IN_LK2][l] + a.in[IN_LQ2][l + 64] * a.in[IN_LK2][l + 64];
    s1 = wave_sum(s1); s2 = wave_sum(s2);
    if (l == 0) *(float*)(F.ws + WS_LAM) = __expf(s1) - __expf(s2) + 0.2f;
  }
}

struct EpiProj {
  static constexpr bool PERM = true, AFTER_DRAIN = false;
  bf16 *Qb, *Kp, *Vp, *MQ, *MK, *MV, *MO; const float *qg, *kg; LAS float* xch;
  __device__ __forceinline__ void operator()(const pg8::f32x4 (&acc)[2][2][4][2], const pg8::Unit& u, int wr, int wc, int fr, int fq) const {
    const int pn = u.pn, b = u.pm >> 3, tb = (u.pm & 7) * 256 + wr * 64 + fr, d0 = wc * 32 + fq * 8;
    if (pn < 8) {
      const bool isk = pn >= 4; const int h = pn & 3;
      float ssq[2][4][2];
#pragma unroll
      for (int ai = 0; ai < 2; ++ai)
#pragma unroll
        for (int m = 0; m < 4; ++m)
#pragma unroll
          for (int bj = 0; bj < 2; ++bj) { float s = 0.f;
#pragma unroll
            for (int n = 0; n < 2; ++n) { const pg8::f32x4 x = acc[ai][bj][m][n]; s += (x[0] * x[0] + x[1] * x[1]) + (x[2] * x[2] + x[3] * x[3]); }
            s += __shfl_xor(s, 16); s += __shfl_xor(s, 32); ssq[ai][m][bj] = s;
            if (fq == 0) xch[((ai * 128 + wr * 64 + m * 16 + fr) * 2 + bj) * 4 + wc] = s; }
      asm volatile("s_waitcnt lgkmcnt(0)" ::: "memory"); __builtin_amdgcn_s_barrier(); asm volatile("" ::: "memory");
      const float* gp = (isk ? kg : qg) + d0; const f32x4 g0 = *(const f32x4*)gp, g1v = *(const f32x4*)(gp + 4);
      const float sc = isk ? 1.0f : QSCALE;
#pragma unroll
      for (int ai = 0; ai < 2; ++ai)
#pragma unroll
        for (int m = 0; m < 4; ++m)
#pragma unroll
          for (int bj = 0; bj < 2; ++bj) {
            const f32x4 p = *(const LAS f32x4*)(xch + ((ai * 128 + wr * 64 + m * 16 + fr) * 2 + bj) * 4);
            const float rs = rsqrtf(((p.x + p.y) + (p.z + p.w)) * (1.0f / 128.f) + EPS) * sc;
            const pg8::f32x4 v0 = acc[ai][bj][m][0], v1 = acc[ai][bj][m][1];
            v4u w; w.x = pk2(v0[0] * rs * g0.x, v0[1] * rs * g0.y); w.y = pk2(v0[2] * rs * g0.z, v0[3] * rs * g0.w);
            w.z = pk2(v1[0] * rs * g1v.x, v1[1] * rs * g1v.y); w.w = pk2(v1[2] * rs * g1v.z, v1[3] * rs * g1v.w);
            const int t = tb + ai * 128 + m * 16;
            bf16* dst = isk ? Kp + kp_off((b * 4 + h) * 2 + bj, POS0 + t, d0)
                            : Qb + ((size_t)((b * 4 + h) * 2 + bj) * SEQ + t) * 128 + d0;
            *(v4u*)dst = w; }
      return;
    }
#pragma unroll
    for (int ai = 0; ai < 2; ++ai)
#pragma unroll
      for (int m = 0; m < 4; ++m)
#pragma unroll
        for (int bj = 0; bj < 2; ++bj) {
          pg8::f32x4 v0 = acc[ai][bj][m][0], v1 = acc[ai][bj][m][1];
          const int t = tb + ai * 128 + m * 16;
          bf16* dst;
          if (pn < 12) { const int h = pn - 8; dst = Vp + ((size_t)(b * 4 + h) * PADT + POS0 + t) * 256 + bj * 128 + d0; }
          else if (pn < 16) { const int h = 2 * (pn & 1) + bj; dst = (pn >= 14 ? MK : MQ) + ((size_t)(b * 4 + h) * PADT + POS0 + t) * 128 + d0; }
          else if (pn < 20) { const int h = pn - 16; dst = MV + ((size_t)(b * 4 + h) * PADT + POS0 + t) * 256 + bj * 128 + d0; }
          else { dst = MO + (size_t)(b * SEQ + t) * 1024 + (pn - 20) * 256 + bj * 128 + d0;
#pragma unroll
            for (int j = 0; j < 4; ++j) { v0[j] = sigmoidf_(v0[j]); v1[j] = sigmoidf_(v1[j]); } }
          v4u w; w.x = pk2(v0[0], v0[1]); w.y = pk2(v0[2], v0[3]); w.z = pk2(v1[0], v1[1]); w.w = pk2(v1[2], v1[3]);
          *(v4u*)dst = w; }
  }
};
__device__ __forceinline__ void p1_meta_finalize(const Frame& F, const Args& a) {
  if (blockIdx.x >= NMETA) return;
  const int mrow = blockIdx.x, tid = F.tid, lane = F.lane, w = F.wave;
  const float* meta = a.in[IN_META] + (size_t)mrow * DM; const float* PM = (const float*)(F.ws + WS_PM) + (size_t)mrow * NPROJ;
  LAS float* red = (LAS float*)(F.lds + XCH_OFF);
  const f32x4 mv = ((const f32x4*)meta)[tid];
  float s = wave_sum((mv.x * mv.x + mv.y * mv.y) + (mv.z * mv.z + mv.w * mv.w));
  if (lane == 0) red[w] = s;
  __syncthreads();
  float tot = 0.f;
#pragma unroll
  for (int i = 0; i < 8; ++i) tot += red[i];
  const float rs = rsqrtf(tot * (1.0f / DM) + EPS);
  bf16* Kp = (bf16*)(F.ws + WS_KP); bf16* Vp = (bf16*)(F.ws + WS_VP); bf16* MQ = (bf16*)(F.ws + WS_MQ); bf16* MK = (bf16*)(F.ws + WS_MK); bf16* MV = (bf16*)(F.ws + WS_MV);
  const int pos = MPOS0 + mrow;
  {
    const float v0 = PM[1024 + w * 128 + lane] * rs, v1 = PM[1024 + w * 128 + lane + 64] * rs;
    const float rk = rsqrtf(wave_sum(v0 * v0 + v1 * v1) * (1.0f / 128.f) + EPS);
    const float* kg = a.in[IN_KNG];
    const unsigned short o0 = (unsigned short)f2bf(v0 * rk * kg[lane]), o1 = (unsigned short)f2bf(v1 * rk * kg[lane + 64]);
    for (int b = 0; b < NB; ++b) { const int bhm = (b * 4 + (w >> 1)) * 2 + (w & 1); Kp[kp_off(bhm, pos, lane)] = o0; Kp[kp_off(bhm, pos, lane + 64)] = o1; }
  }
  { const int c = tid * 2;
    const unsigned o = pk2(PM[2048 + c] * rs, PM[2048 + c + 1] * rs); const int h = c >> 8, e = c & 255;
    for (int b = 0; b < NB; ++b) *(unsigned*)(Vp + ((size_t)(b * 4 + h) * PADT + pos) * 256 + e) = o;
    const unsigned o2 = pk2(PM[3072 + c] * rs, PM[3072 + c + 1] * rs); const bool isk = c >= 512; const int cc = c & 511, hq = cc >> 7, d = cc & 127;
    for (int b = 0; b < NB; ++b) *(unsigned*)((isk ? MK : MQ) + ((size_t)(b * 4 + hq) * PADT + pos) * 128 + d) = o2;
    const unsigned o3 = pk2(PM[4096 + c] * rs, PM[4096 + c + 1] * rs);
    for (int b = 0; b < NB; ++b) *(unsigned*)(MV + ((size_t)(b * 4 + h) * PADT + pos) * 256 + e) = o3;
  }
  __syncthreads();
}

namespace att {
using f32x16 = __attribute__((ext_vector_type(16))) float;
using s16x4 = __attribute__((ext_vector_type(4))) short;
constexpr int STEPS_BHM = 152, NSTEPS = 32 * STEPS_BHM;
constexpr int SHM_V = 64 * 256 * 2, SHM_K = 64 * 128 * 2;
constexpr int LDS_V = 0, LDS_K = 2 * SHM_V, LDS_Q = LDS_K + SHM_K, LDS_WS = LDS_Q + 8 * 8192;
constexpr float THR2 = 8.0f;
#define KSWZ(row, colB) ((row) * 256 + ((colB) ^ (((row) & 7) << 4)))
#define SBAR() __builtin_amdgcn_sched_barrier(0)
__device__ __forceinline__ int crow(int r, int hi) { return (r & 3) + 8 * (r >> 2) + 4 * hi; }
__device__ __forceinline__ unsigned cvtpk(float lo, float hi) { unsigned r; asm volatile("v_cvt_pk_bf16_f32 %0, %1, %2" : "=v"(r) : "v"(lo), "v"(hi)); return r; }
__device__ __forceinline__ int qb_start(int qb) { return 2 * qb * qb + 3 * qb; }
__device__ __forceinline__ int chunk_of(int s, int NA) { return ((s + 1) * NA - 1) / NSTEPS; }

template <int OFF> __device__ __forceinline__ s16x4 tr_read(int vb) {
  s16x4 r; asm volatile("ds_read_b64_tr_b16 %0, %1 offset:%2" : "=&v"(r) : "v"(vb), "i"(OFF) : "memory"); return r;
}
constexpr int v_rd_off(int d0, int ks, int half) { return d0 * 512 + ks * 8192 + half * 4096; }
template <int D0> __device__ __forceinline__ void pv_one(f32x16& od, int vb, bf16x8 pa0, bf16x8 pa1, bf16x8 pa2, bf16x8 pa3) {
#define PK(L, H) (bf16x8){L[0], L[1], L[2], L[3], H[0], H[1], H[2], H[3]}
  { const s16x4 l0 = tr_read<v_rd_off(D0, 0, 0)>(vb), h0 = tr_read<v_rd_off(D0, 0, 1)>(vb), l1 = tr_read<v_rd_off(D0, 1, 0)>(vb), h1 = tr_read<v_rd_off(D0, 1, 1)>(vb);
    asm volatile("s_waitcnt lgkmcnt(0)" ::: "memory"); SBAR();
    od = __builtin_amdgcn_mfma_f32_32x32x16_bf16(pa0, PK(l0, h0), od, 0, 0, 0);
    od = __builtin_amdgcn_mfma_f32_32x32x16_bf16(pa1, PK(l1, h1), od, 0, 0, 0); }
  SBAR();
  { const s16x4 l2 = tr_read<v_rd_off(D0, 2, 0)>(vb), h2 = tr_read<v_rd_off(D0, 2, 1)>(vb), l3 = tr_read<v_rd_off(D0, 3, 0)>(vb), h3 = tr_read<v_rd_off(D0, 3, 1)>(vb);
    asm volatile("s_waitcnt lgkmcnt(0)" ::: "memory"); SBAR();
    od = __builtin_amdgcn_mfma_f32_32x32x16_bf16(pa2, PK(l2, h2), od, 0, 0, 0);
    od = __builtin_amdgcn_mfma_f32_32x32x16_bf16(pa3, PK(l3, h3), od, 0, 0, 0); }
#undef PK
}

__device__ __forceinline__ void segment(const Frame& F, int bhm, int qb, int j0, int j1, int slot) {
  const int tid = F.tid, wid = F.wave, lane = F.lane, r32 = lane & 31, hi = lane >> 5;
  const bf16* Qg = (const bf16*)(F.ws + WS_Q) + ((size_t)bhm * SEQ + qb * 256 + wid * 32 + r32) * 128 + hi * 8;
  const bf16* Kg = (const bf16*)(F.ws + WS_KP) + (size_t)bhm * 33 * 8192;
  const bf16* Vg = (const bf16*)(F.ws + WS_VP) + (size_t)(bhm >> 1) * PADT * 256;
  LAS unsigned char* lds = F.lds;
  LAS float* wsl = (LAS float*)(lds + LDS_WS) + wid * 64;
  const float slope2 = exp2f(-2.0f * (float)(((bhm >> 1) & 3) + 1)) * LOG2E;
  unsigned ksrc0, vsrc0;
  ksrc0 = (unsigned)tid * 16u;
  { const int a8 = tid >> 8, b = (tid >> 2) & 7, k = 8 * (b >> 2) + 4 * a8 + (b & 3), c = ((tid >> 5) & 7) * 32 + (tid & 3) * 8; vsrc0 = (unsigned)(k * 256 + c) * 2u; }
#define STAGE_K(j) do { const char* kt = (const char*)(Kg + (size_t)(j) * 8192); \
    _Pragma("unroll") for (int _i = 0; _i < 2; ++_i) __builtin_amdgcn_global_load_lds((const unsigned*)(kt + (ksrc0 + _i * 8192u)), (LAS unsigned*)(lds + LDS_K + _i * 8192 + wid * 1024), 16, 0, 0); } while (0)
#define STAGE_V(buf, j) do { const char* vt = (const char*)(Vg + (size_t)(j) * 64 * 256); \
    _Pragma("unroll") for (int _i = 0; _i < 4; ++_i) __builtin_amdgcn_global_load_lds((const unsigned*)(vt + (vsrc0 + _i * 8192u)), (LAS unsigned*)(lds + LDS_V + (buf) * SHM_V + _i * 8192 + wid * 1024), 16, 0, 0); } while (0)
  const int lt = (((r32 << 1) | hi) ^ ((r32 >> 3) & 1)) << 4;
  LAS unsigned char* Qs = lds + LDS_Q + wid * 8192;
#pragma unroll
  for (int d0 = 0; d0 < 8; ++d0) { const bf16x8 qv = *(const bf16x8*)(Qg + d0 * 16); *(LAS bf16x8*)(Qs + d0 * 1024 + lt) = qv; }
  const float hioff = slope2 * (float)(4 * hi);
  f32x16 o[8];
#pragma unroll
  for (int d = 0; d < 8; ++d)
#pragma unroll
    for (int r = 0; r < 16; ++r) o[d][r] = 0.f;
  float m_reg = -1e30f, l_reg = 0.f;
  const int vb0 = (int)(uintptr_t)(lds + LDS_V) + (((lane & 3) << 3) | (((lane >> 2) & 3) << 6) | (((lane >> 4) & 1) << 5) | (((lane >> 5) & 1) << 8));
  const int qrel = wid * 32 + r32;
  STAGE_K(j0); STAGE_V(0, j0);
  VM_WAIT(); __syncthreads();
  for (int j = j0; j < j1; ++j) {
    const int cur = (j - j0) & 1;
    if (j + 1 < j1) STAGE_V(cur ^ 1, j + 1);
    SBAR();
    f32x16 p0 = {}, p1 = {};
    { const LAS unsigned char* Ks = lds + LDS_K;
#pragma unroll
      for (int d0 = 0; d0 < 8; ++d0) {
        const bf16x8 b0 = *(const LAS bf16x8*)(Ks + d0 * 2048 + lt);
        const bf16x8 b1 = *(const LAS bf16x8*)(Ks + d0 * 2048 + 1024 + lt);
        const bf16x8 qf = *(const LAS bf16x8*)(Qs + d0 * 1024 + lt);
        p0 = __builtin_amdgcn_mfma_f32_32x32x16_bf16(b0, qf, p0, 0, 0, 0);
        p1 = __builtin_amdgcn_mfma_f32_32x32x16_bf16(b1, qf, p1, 0, 0, 0); } }
    asm volatile("s_waitcnt lgkmcnt(0)" ::: "memory"); __builtin_amdgcn_s_barrier(); asm volatile("" ::: "memory");
    if (j + 1 < j1) STAGE_K(j + 1);
    SBAR();
    if (j == 0) {
#pragma unroll
      for (int r = 0; r < 16; ++r) p0[r] = -INFINITY;
#pragma unroll
      for (int r = 0; r < 8; ++r) p1[r] = -INFINITY;
    }
    const int jb = j - (4 * qb + 1);
    if (jb >= 0) {
      const int kb = 64 * jb + 4 * hi;
#pragma unroll
      for (int r = 0; r < 16; ++r) { const int kv = kb + (r & 3) + 8 * (r >> 2); if (kv > qrel) p0[r] = -INFINITY; if (kv + 32 > qrel) p1[r] = -INFINITY; }
    }
    const float off0 = slope2 * (float)(64 * j) + hioff, off1 = off0 + 32.0f * slope2;
#pragma unroll
    for (int r = 0; r < 16; ++r) { const float sb = slope2 * (float)((r & 3) + 8 * (r >> 2)); p0[r] += sb; p1[r] += sb; }
    float pm0 = p0[0], pm1 = p1[0];
#pragma unroll
    for (int r = 1; r < 16; ++r) { pm0 = fmaxf(pm0, p0[r]); pm1 = fmaxf(pm1, p1[r]); }
    float pmax = fmaxf(pm0 + off0, pm1 + off1);
    { auto rr = __builtin_amdgcn_permlane32_swap(__float_as_uint(pmax), __float_as_uint(pmax), false, false);
      pmax = fmaxf(__uint_as_float(rr[0]), __uint_as_float(rr[1])); }
    float mn, alpha;
    if (__builtin_expect(__all(pmax - m_reg <= THR2), 1)) { mn = m_reg; alpha = 1.f; }
    else { mn = fmaxf(m_reg, pmax); alpha = __builtin_amdgcn_exp2f(m_reg - mn); m_reg = mn; }
    const float c0 = off0 - mn, c1 = off1 - mn;
    float ps = 0.f;
#pragma unroll
    for (int r = 0; r < 16; ++r) { p0[r] = __builtin_amdgcn_exp2f(p0[r] + c0); p1[r] = __builtin_amdgcn_exp2f(p1[r] + c1); ps += p0[r] + p1[r]; }
    { auto rr = __builtin_amdgcn_permlane32_swap(__float_as_uint(ps), __float_as_uint(ps), false, false);
      ps = __uint_as_float(rr[0]) + __uint_as_float(rr[1]); }
    l_reg = l_reg * alpha + ps;
    if (__any(alpha < 1.f)) { if (hi == 0) wsl[r32] = alpha; asm volatile("s_waitcnt lgkmcnt(0)" ::: "memory");
#pragma unroll
      for (int rg = 0; rg < 4; ++rg) { const f32x4 al = *(const LAS f32x4*)(wsl + 8 * rg + 4 * hi);
#pragma unroll
        for (int d = 0; d < 8; ++d) { o[d][4 * rg + 0] *= al.x; o[d][4 * rg + 1] *= al.y; o[d][4 * rg + 2] *= al.z; o[d][4 * rg + 3] *= al.w; }
        SBAR(); } }
    bf16x8 pa0, pa1, pa2, pa3;
#define PK4(P, BASE, OUT) do { unsigned a0 = cvtpk(P[BASE + 0], P[BASE + 1]), a1 = cvtpk(P[BASE + 2], P[BASE + 3]);   \
    unsigned b0 = cvtpk(P[BASE + 4], P[BASE + 5]), b1 = cvtpk(P[BASE + 6], P[BASE + 7]);                              \
    auto r0 = __builtin_amdgcn_permlane32_swap(a0, b0, false, false); auto r1 = __builtin_amdgcn_permlane32_swap(a1, b1, false, false); \
    v4u w = {r0[0], r1[0], r0[1], r1[1]}; OUT = *reinterpret_cast<bf16x8*>(&w); } while (0)
    PK4(p0, 0, pa0); PK4(p0, 8, pa1); PK4(p1, 0, pa2); PK4(p1, 8, pa3);
#undef PK4
    SBAR();
    { const int vb = vb0 + cur * SHM_V;
      pv_one<0>(o[0], vb, pa0, pa1, pa2, pa3); pv_one<1>(o[1], vb, pa0, pa1, pa2, pa3); pv_one<2>(o[2], vb, pa0, pa1, pa2, pa3); pv_one<3>(o[3], vb, pa0, pa1, pa2, pa3);
      pv_one<4>(o[4], vb, pa0, pa1, pa2, pa3); pv_one<5>(o[5], vb, pa0, pa1, pa2, pa3); pv_one<6>(o[6], vb, pa0, pa1, pa2, pa3); pv_one<7>(o[7], vb, pa0, pa1, pa2, pa3); }
    VM_WAIT(); __syncthreads();
  }
  { int lane2 = threadIdx.x & 63, slot2 = slot; asm volatile("" : "+v"(lane2), "+s"(slot2));
    const int r32e = lane2 & 31, hie = lane2 >> 5;
    float* PO = (float*)(F.ws + WS_PO) + (size_t)slot2 * 256 * 256; float* ML = (float*)(F.ws + WS_ML) + (size_t)slot2 * 512;
    LAS float* wse = (LAS float*)(F.lds + LDS_WS) + wid * 64;
    if (hie == 0) { wse[r32e] = l_reg; ML[(wid * 32 + r32e) * 2] = m_reg; ML[(wid * 32 + r32e) * 2 + 1] = l_reg; }
    asm volatile("s_waitcnt lgkmcnt(0)" ::: "memory");
    char* Ob = (char*)(PO + (size_t)(wid * 32) * 256);
    const unsigned lo = (unsigned)(4 * hie * 256 + r32e) * 4u;
#pragma unroll
    for (int r = 0; r < 16; ++r) { const int rowc = (r & 3) + 8 * (r >> 2); const float lv = wse[rowc + 4 * hie]; const float rl = lv > 0.f ? __builtin_amdgcn_rcpf(lv) : 0.f;
#pragma unroll
      for (int d0 = 0; d0 < 8; ++d0) *(float*)(Ob + (lo + (unsigned)(rowc * 256 + d0 * 32) * 4u)) = o[d0][r] * rl;
      SBAR(); } }
  __syncthreads();
#undef STAGE_K
#undef STAGE_V
}

__device__ __forceinline__ void phase(const Frame& F, int ca, int NA) {
  int s0 = (int)(((long)ca * NSTEPS) / NA); const int s1 = (int)(((long)(ca + 1) * NSTEPS) / NA);
  while (s0 < s1) {
    const int bhm = s0 / STEPS_BHM, rem = s0 - bhm * STEPS_BHM;
    int qb = 0;
#pragma unroll 1
    for (int q = 1; q < 8; ++q) if (rem >= qb_start(q)) qb = q;
    const int j0 = rem - qb_start(qb), nst = 4 * qb + 5;
    const int j1 = (j0 + (s1 - s0) < nst) ? j0 + (s1 - s0) : nst;
    const int slot = bhm * 16 + qb + chunk_of(s0, NA) - chunk_of(bhm * STEPS_BHM, NA);
    segment(F, bhm, qb, j0, j1, slot);
    s0 += j1 - j0;
  }
}
#undef KSWZ
#undef SBAR
}
namespace ml {
constexpr int QST = 136, TST = 72;
constexpr int L_RQ = 0, L_RK = 17152, L_QS = 34304, L_QW = 51712, L_KS = 69120, L_KWT = 86528, L_VT = 104960  , L_SP = 0  , L_G = 141824, L_CW = 143872;
constexpr int L_HT = 0;
constexpr int G_A = 0, G_M = 64, G_WI = 128, G_EM = 192, G_DEN = 256, G_WG = 320, G_SC = 384, G_N = 0;
constexpr int L_NV = L_CW + 5120;
constexpr int L_SSQ = L_KWT;
__device__ __forceinline__ float shfl_up_f(float v, int d) { return __shfl_up(v, d); }

__device__ __forceinline__ void load_cw(const Frame& F, const Args& a, int h) {
  LAS float* CW = (LAS float*)(F.lds + L_CW);
  for (int e = F.tid; e < 2 * 5 * 128; e += NTHR) { const int qk = e / 640, j = (e / 128) % 5, d = e & 127; const int ch = qk * 512 + h * 128 + d;
    CW[e] = j < 4 ? a.in[IN_CW][j * 1024 + ch] : a.in[IN_CB][ch]; }
}
__device__ __forceinline__ void load_raw(const Frame& F, const bf16* g, int pos0, int lds_off) {
  for (int p = F.tid; p < 67 * 16; p += NTHR) { const int row = p >> 4, ch = p & 15, pos = pos0 - 3 + row;
    v4u v = {0u, 0u, 0u, 0u}; if (pos >= MPOS0) v = *(const v4u*)(g + (size_t)pos * 128 + ch * 8);
    *(LAS v4u*)(F.lds + lds_off + row * 256 + ch * 16) = v; }
}
__device__ __forceinline__ void conv16(const Frame& F, int qk, int lds_off, int t, int d0, float (&y)[16]) {
  const LAS float* CW = (const LAS float*)(F.lds + L_CW);
#pragma unroll
  for (int e = 0; e < 16; ++e) y[e] = CW[(qk * 5 + 4) * 128 + d0 + e];
#pragma unroll
  for (int j = 0; j < 4; ++j) { const LAS v4u* rp = (const LAS v4u*)(F.lds + lds_off + (t + j) * 256 + d0 * 2); const v4u r0 = rp[0], r1 = rp[1];
    const LAS float* cw = CW + (qk * 5 + j) * 128 + d0;
    y[0] += cw[0] * bflo(r0.x); y[1] += cw[1] * bfhi(r0.x); y[2] += cw[2] * bflo(r0.y); y[3] += cw[3] * bfhi(r0.y); y[4] += cw[4] * bflo(r0.z); y[5] += cw[5] * bfhi(r0.z); y[6] += cw[6] * bflo(r0.w); y[7] += cw[7] * bfhi(r0.w);
    y[8] += cw[8] * bflo(r1.x); y[9] += cw[9] * bfhi(r1.x); y[10] += cw[10] * bflo(r1.y); y[11] += cw[11] * bfhi(r1.y); y[12] += cw[12] * bflo(r1.z); y[13] += cw[13] * bfhi(r1.z); y[14] += cw[14] * bflo(r1.w); y[15] += cw[15] * bfhi(r1.w); }
#pragma unroll
  for (int e = 0; e < 16; ++e) y[e] = y[e] / (1.0f + __expf(-y[e]));
}
__device__ __forceinline__ void load_vt(const Frame& F, const bf16* MVg, int pos0) {
#pragma unroll
  for (int i = 0; i < 4; ++i) { const int p = F.tid + NTHR * i, row = p >> 5, ch = p & 31; v4u v4 = {0u, 0u, 0u, 0u};
    if (pos0 + row >= MPOS0) v4 = *(const v4u*)(MVg + (size_t)(pos0 + row) * 256 + ch * 8);
    LAS bf16* vt = (LAS bf16*)(F.lds + L_VT) + (ch * 8) * TST + row;
    vt[0 * TST] = (bf16)(v4.x & 0xffff); vt[1 * TST] = (bf16)(v4.x >> 16); vt[2 * TST] = (bf16)(v4.y & 0xffff); vt[3 * TST] = (bf16)(v4.y >> 16);
    vt[4 * TST] = (bf16)(v4.z & 0xffff); vt[5 * TST] = (bf16)(v4.z >> 16); vt[6 * TST] = (bf16)(v4.w & 0xffff); vt[7 * TST] = (bf16)(v4.w >> 16); }
}

__device__ __forceinline__ void taskA(const Frame& F, const Args& a, int task) {
  const int bh = task >> 5, c = task & 31, h = bh & 3, tid = F.tid, w = F.wave, lane = F.lane, fr = lane & 15, kq = lane >> 4, pos0 = 64 * c;
  LAS unsigned char* lds = F.lds; LAS float* G = (LAS float*)(lds + L_G);
  const bf16* MKg = (const bf16*)(F.ws + WS_MK) + (size_t)bh * PADT * 128; const bf16* MVg = (const bf16*)(F.ws + WS_MV) + (size_t)bh * PADT * 256;
  __syncthreads();
  load_cw(F, a, h); load_raw(F, MKg, pos0, L_RK); load_vt(F, MVg, pos0);
  if (w == 0) {
    const bool dead = pos0 + lane < MPOS0;
    const float li = dead ? -1e30f : ((const float*)(F.ws + WS_LI))[bh * PADT + pos0 + lane], lf = dead ? 0.f : ((const float*)(F.ws + WS_LF))[bh * PADT + pos0 + lane];
    float bs = lf;
#pragma unroll
    for (int d = 1; d < 64; d <<= 1) { const float o = shfl_up_f(bs, d); if (lane >= d) bs += o; }
    const float av = li - bs; float mx = av;
#pragma unroll
    for (int o = 1; o < 64; o <<= 1) mx = fmaxf(mx, __shfl_xor(mx, o));
    G[G_WG + lane] = __expf(av - mx);
    if (lane == 63) { float* gs = (float*)(F.ws + WS_GS) + (size_t)(bh * 33 + c) * 2; gs[0] = bs; gs[1] = mx; }
  }
  __syncthreads();
  { const int t = tid >> 3, d0 = (tid & 7) * 16; float y[16]; conv16(F, 1, L_RK, t, d0, y);
    const float sw = 0.08838834764831845f * G[G_WG + t]; LAS bf16* kt = (LAS bf16*)(lds + L_KWT) + d0 * TST + t;
#pragma unroll
    for (int e = 0; e < 16; ++e) kt[e * TST] = (bf16)f2bf(y[e] * sw); }
  __syncthreads();
  f32x4* DCg = (f32x4*)(F.ws + WS_DC) + ((size_t)(bh * 32 + c) * 128) * 64;
#pragma unroll
  for (int jj = 0; jj < 2; ++jj) { const int j = 2 * w + jj;
    const bf16x8 bv0 = *(const LAS bf16x8*)(lds + L_VT + ((16 * j + fr) * TST + 8 * kq) * 2), bv1 = *(const LAS bf16x8*)(lds + L_VT + ((16 * j + fr) * TST + 32 + 8 * kq) * 2);
#pragma unroll
    for (int i = 0; i < 8; ++i) { f32x4 acc = {0.f, 0.f, 0.f, 0.f};
      const bf16x8 k0 = *(const LAS bf16x8*)(lds + L_KWT + ((16 * i + fr) * TST + 8 * kq) * 2), k1 = *(const LAS bf16x8*)(lds + L_KWT + ((16 * i + fr) * TST + 32 + 8 * kq) * 2);
      acc = __builtin_amdgcn_mfma_f32_16x16x32_bf16(k0, bv0, acc, 0, 0, 0); acc = __builtin_amdgcn_mfma_f32_16x16x32_bf16(k1, bv1, acc, 0, 0, 0);
      DCg[(size_t)(i * 16 + j) * 64 + lane] = acc; } }
  if (tid < 128) { const LAS v4u* kr = (const LAS v4u*)(lds + L_KWT + tid * TST * 2); float s = 0.f;
#pragma unroll
    for (int q = 0; q < 8; ++q) { const v4u x = kr[q]; s += (bflo(x.x) + bfhi(x.x)) + (bflo(x.y) + bfhi(x.y)) + (bflo(x.z) + bfhi(x.z)) + (bflo(x.w) + bfhi(x.w)); }
    ((float*)(F.ws + WS_DN))[(size_t)(bh * 32 + c) * 128 + tid] = s; }
}

__device__ __forceinline__ void scanB(const Frame& F) {
  const int gt = blockIdx.x * NTHR + F.tid, NT = gridDim.x * NTHR;
  const float* GS = (const float*)(F.ws + WS_GS);
  for (int g = gt; g < 16 * 8192; g += NT) { const int bh = g >> 13, r = g & 8191, i = r >> 10, j = (r >> 6) & 15, ln = r & 63;
    const f32x4* dc = (const f32x4*)(F.ws + WS_DC) + ((size_t)(bh * 32) * 128 + (i * 16 + j)) * 64 + ln;
    v2u* cs = (v2u*)(F.ws + WS_CS) + ((((size_t)bh * 33) * 4 + (i >> 1)) * 16 + j) * 64 * 2 + ln * 2 + (i & 1);
    f32x4 st = {0.f, 0.f, 0.f, 0.f}; float m = 0.f;
#pragma unroll 4
    for (int c = 0; c < 32; ++c) { const float bL = GS[(bh * 33 + c) * 2], ml = GS[(bh * 33 + c) * 2 + 1], me = fmaxf(m, ml);
      st = st * __expf(m - me) + dc[(size_t)c * 128 * 64] * __expf(ml - me); m = bL + me;
      v2u o; o.x = pk2(st.x, st.y); o.y = pk2(st.z, st.w); cs[(size_t)(c + 1) * 4 * 16 * 64 * 2] = o; } }
  for (int g = gt; g < 16 * 128; g += NT) { const int bh = g >> 7, d = g & 127; float n = 0.f, m = 0.f;
    for (int c = 0; c < 32; ++c) { const float bL = GS[(bh * 33 + c) * 2], ml = GS[(bh * 33 + c) * 2 + 1], me = fmaxf(m, ml);
      n = n * __expf(m - me) + ((const float*)(F.ws + WS_DN))[(size_t)(bh * 32 + c) * 128 + d] * __expf(ml - me); m = bL + me;
      ((float*)(F.ws + WS_NS))[(size_t)(bh * 33 + c + 1) * 128 + d] = n; if (d == 0) ((float*)(F.ws + WS_MS))[bh * 33 + c + 1] = m; } }
}

__device__ __forceinline__ void taskC(const Frame& F, const Args& a, int task) {
  const int bh = task >> 5, c = (task & 31) + 1, b = bh >> 2, h = bh & 3, tid = F.tid, w = F.wave, lane = F.lane, fr = lane & 15, kq = lane >> 4, pos0 = 64 * c;
  LAS unsigned char* lds = F.lds; LAS float* G = (LAS float*)(lds + L_G); LAS float* NV = (LAS float*)(lds + L_NV);
  const bf16* MQg = (const bf16*)(F.ws + WS_MQ) + (size_t)bh * PADT * 128; const bf16* MKg = (const bf16*)(F.ws + WS_MK) + (size_t)bh * PADT * 128;
  const bf16* MVg = (const bf16*)(F.ws + WS_MV) + (size_t)bh * PADT * 256;
  const float m = ((const float*)(F.ws + WS_MS))[bh * 33 + c];
  __syncthreads();
  load_cw(F, a, h); load_raw(F, MQg, pos0, L_RQ); load_raw(F, MKg, pos0, L_RK); load_vt(F, MVg, pos0);
  if (tid < 128) NV[tid] = ((const float*)(F.ws + WS_NS))[(size_t)(bh * 33 + c) * 128 + tid];
  if (w == 0) {
    const float li = ((const float*)(F.ws + WS_LI))[bh * PADT + pos0 + lane], lf = ((const float*)(F.ws + WS_LF))[bh * PADT + pos0 + lane];
    float bs = lf;
#pragma unroll
    for (int d = 1; d < 64; d <<= 1) { const float o = shfl_up_f(bs, d); if (lane >= d) bs += o; }
    const float av = li - bs; float cm = av;
#pragma unroll
    for (int d = 1; d < 64; d <<= 1) { const float o = shfl_up_f(cm, d); if (lane >= d) cm = fmaxf(cm, o); }
    const float Mt = fmaxf(m, cm);
    G[G_A + lane] = av; G[G_M + lane] = Mt; G[G_WI + lane] = __expf(m - Mt); G[G_EM + lane] = __expf(-(bs + Mt));
  }
  __syncthreads();
  { const int t = tid >> 3, d0 = (tid & 7) * 16; const float wi = G[G_WI + t]; float y[16];
    conv16(F, 0, L_RQ, t, d0, y);
    { v4u o0, o1, w0, w1;
      o0.x = pk2(y[0], y[1]); o0.y = pk2(y[2], y[3]); o0.z = pk2(y[4], y[5]); o0.w = pk2(y[6], y[7]); o1.x = pk2(y[8], y[9]); o1.y = pk2(y[10], y[11]); o1.z = pk2(y[12], y[13]); o1.w = pk2(y[14], y[15]);
      w0.x = pk2(y[0] * wi, y[1] * wi); w0.y = pk2(y[2] * wi, y[3] * wi); w0.z = pk2(y[4] * wi, y[5] * wi); w0.w = pk2(y[6] * wi, y[7] * wi);
      w1.x = pk2(y[8] * wi, y[9] * wi); w1.y = pk2(y[10] * wi, y[11] * wi); w1.z = pk2(y[12] * wi, y[13] * wi); w1.w = pk2(y[14] * wi, y[15] * wi);
      LAS v4u* qs = (LAS v4u*)(lds + L_QS + (t * QST + d0) * 2); qs[0] = o0; qs[1] = o1;
      LAS v4u* qw = (LAS v4u*)(lds + L_QW + (t * QST + d0) * 2); qw[0] = w0; qw[1] = w1; }
    __builtin_amdgcn_sched_barrier(0);
    conv16(F, 1, L_RK, t, d0, y);
    { const float sc = 0.08838834764831845f; v4u o0, o1;
      o0.x = pk2(y[0] * sc, y[1] * sc); o0.y = pk2(y[2] * sc, y[3] * sc); o0.z = pk2(y[4] * sc, y[5] * sc); o0.w = pk2(y[6] * sc, y[7] * sc);
      o1.x = pk2(y[8] * sc, y[9] * sc); o1.y = pk2(y[10] * sc, y[11] * sc); o1.z = pk2(y[12] * sc, y[13] * sc); o1.w = pk2(y[14] * sc, y[15] * sc);
      LAS v4u* ks = (LAS v4u*)(lds + L_KS + (t * QST + d0) * 2); ks[0] = o0; ks[1] = o1; } }
  __syncthreads();
  v4u cb[4][2];
  { const v4u* cs = (const v4u*)(F.ws + WS_CS) + (((size_t)bh * 33 + c) * 4 * 16) * 64;
#pragma unroll
    for (int I = 0; I < 4; ++I)
#pragma unroll
      for (int jj = 0; jj < 2; ++jj) cb[I][jj] = cs[(size_t)(I * 16 + 2 * w + jj) * 64 + lane]; }
  { const int si = w >> 1; const f32x4 as = *(const LAS f32x4*)(G + G_A + 16 * si + 4 * kq);
#pragma unroll
    for (int tt = 0; tt < 2; ++tt) { const int ti = 2 * (w & 1) + tt; f32x4 acc = {0.f, 0.f, 0.f, 0.f};
#pragma unroll
      for (int ks = 0; ks < 4; ++ks) { const bf16x8 af = *(const LAS bf16x8*)(lds + L_KS + ((16 * si + fr) * QST + 32 * ks + 8 * kq) * 2);
        const bf16x8 bfr = *(const LAS bf16x8*)(lds + L_QS + ((16 * ti + fr) * QST + 32 * ks + 8 * kq) * 2);
        acc = __builtin_amdgcn_mfma_f32_16x16x32_bf16(af, bfr, acc, 0, 0, 0); }
      const int t = 16 * ti + fr, s0 = 16 * si + 4 * kq; const float Mt = G[G_M + t];
      const float v0 = (s0 + 0 <= t) ? acc.x * __expf(as.x - Mt) : 0.f, v1 = (s0 + 1 <= t) ? acc.y * __expf(as.y - Mt) : 0.f;
      const float v2 = (s0 + 2 <= t) ? acc.z * __expf(as.z - Mt) : 0.f, v3 = (s0 + 3 <= t) ? acc.w * __expf(as.w - Mt) : 0.f;
      v2u o; o.x = pk2(v0, v1); o.y = pk2(v2, v3);
      *(LAS v2u*)(lds + L_SP + (t * TST + s0) * 2) = o; } }
  __syncthreads();
  if (w == 0) { const int t = lane; float qn = 0.f, rsum = 0.f;
#pragma unroll 4
    for (int q = 0; q < 16; ++q) { const v4u x = *(const LAS v4u*)(lds + L_QS + (t * QST + q * 8) * 2); const f32x4 n0 = *(const LAS f32x4*)(NV + q * 8), n1 = *(const LAS f32x4*)(NV + q * 8 + 4);
      qn += bflo(x.x) * n0.x + bfhi(x.x) * n0.y + bflo(x.y) * n0.z + bfhi(x.y) * n0.w + bflo(x.z) * n1.x + bfhi(x.z) * n1.y + bflo(x.w) * n1.z + bfhi(x.w) * n1.w; }
#pragma unroll
    for (int q = 0; q < 8; ++q) { const v4u x = *(const LAS v4u*)(lds + L_SP + (t * TST + q * 8) * 2); rsum += (bflo(x.x) + bfhi(x.x)) + (bflo(x.y) + bfhi(x.y)) + (bflo(x.z) + bfhi(x.z)) + (bflo(x.w) + bfhi(x.w)); }
    const float den = G[G_WI + t] * qn + rsum; G[G_DEN + t] = fmaxf(fabsf(den), G[G_EM + t]); }
  f32x4 acc[2][4];
#pragma unroll
  for (int jj = 0; jj < 2; ++jj)
#pragma unroll
    for (int ti = 0; ti < 4; ++ti) acc[jj][ti] = (f32x4){0.f, 0.f, 0.f, 0.f};
#pragma unroll
  for (int I = 0; I < 4; ++I) {
#pragma unroll
    for (int ti = 0; ti < 4; ++ti) { const LAS unsigned char* qp = lds + L_QW + ((16 * ti + fr) * QST + 32 * I + 4 * kq) * 2;
      const v2u a0 = *(const LAS v2u*)qp, a1 = *(const LAS v2u*)(qp + 32); const v4u av = {a0.x, a0.y, a1.x, a1.y};
      acc[0][ti] = __builtin_amdgcn_mfma_f32_16x16x32_bf16(__builtin_bit_cast(bf16x8, av), __builtin_bit_cast(bf16x8, cb[I][0]), acc[0][ti], 0, 0, 0);
      acc[1][ti] = __builtin_amdgcn_mfma_f32_16x16x32_bf16(__builtin_bit_cast(bf16x8, av), __builtin_bit_cast(bf16x8, cb[I][1]), acc[1][ti], 0, 0, 0); }
    __builtin_amdgcn_sched_barrier(0); }
#pragma unroll
  for (int ks = 0; ks < 2; ++ks) { const bf16x8 bv0 = *(const LAS bf16x8*)(lds + L_VT + ((32 * w + fr) * TST + 32 * ks + 8 * kq) * 2), bv1 = *(const LAS bf16x8*)(lds + L_VT + ((32 * w + 16 + fr) * TST + 32 * ks + 8 * kq) * 2);
#pragma unroll
    for (int ti = 0; ti < 4; ++ti) { const bf16x8 sf = *(const LAS bf16x8*)(lds + L_SP + ((16 * ti + fr) * TST + 32 * ks + 8 * kq) * 2);
      acc[0][ti] = __builtin_amdgcn_mfma_f32_16x16x32_bf16(sf, bv0, acc[0][ti], 0, 0, 0); acc[1][ti] = __builtin_amdgcn_mfma_f32_16x16x32_bf16(sf, bv1, acc[1][ti], 0, 0, 0); } }
  __syncthreads();
  LAS float* SSQ = (LAS float*)(lds + L_SSQ);
#pragma unroll
  for (int ti = 0; ti < 4; ++ti) { const f32x4 dn = *(const LAS f32x4*)(G + G_DEN + 16 * ti + 4 * kq);
    f32x4 s4;
#pragma unroll
    for (int r = 0; r < 4; ++r) { const float h0 = acc[0][ti][r] / dn[r], h1 = acc[1][ti][r] / dn[r]; acc[0][ti][r] = h0; acc[1][ti][r] = h1; s4[r] = h0 * h0 + h1 * h1; }
#pragma unroll
    for (int o = 1; o < 16; o <<= 1) { s4.x += __shfl_xor(s4.x, o); s4.y += __shfl_xor(s4.y, o); s4.z += __shfl_xor(s4.z, o); s4.w += __shfl_xor(s4.w, o); }
    if (fr == 0) { SSQ[(16 * ti + 4 * kq + 0) * 8 + w] = s4.x; SSQ[(16 * ti + 4 * kq + 1) * 8 + w] = s4.y; SSQ[(16 * ti + 4 * kq + 2) * 8 + w] = s4.z; SSQ[(16 * ti + 4 * kq + 3) * 8 + w] = s4.w; } }
  __syncthreads();
  LAS bf16* HT = (LAS bf16*)(lds + L_HT);
#pragma unroll
  for (int ti = 0; ti < 4; ++ti)
#pragma unroll
    for (int r = 0; r < 4; ++r) { const int t = 16 * ti + 4 * kq + r; const f32x4 p0 = *(const LAS f32x4*)(SSQ + t * 8), p1 = *(const LAS f32x4*)(SSQ + t * 8 + 4);
      const float rh = rsqrtf(((p0.x + p0.y) + (p0.z + p0.w) + (p1.x + p1.y) + (p1.z + p1.w)) * (1.0f / 256.f) + EPS);
      HT[t * 264 + 32 * w + fr] = (bf16)f2bf(acc[0][ti][r] * rh); HT[t * 264 + 32 * w + 16 + fr] = (bf16)f2bf(acc[1][ti][r] * rh); }
  __syncthreads();
  { const int t = tid >> 3, c0 = (tid & 7) * 32; const size_t R = (size_t)b * SEQ + 64 * (c - 1) + t;
    const bf16* mo = (const bf16*)(F.ws + WS_MO) + R * 1024 + h * 256 + c0; const float* og = a.in[IN_OUTG] + h * 256 + c0; bf16* A2 = (bf16*)(F.ws + WS_A2) + R * DM + 1024 + h * 256 + c0;
#pragma unroll
    for (int q = 0; q < 4; ++q) { const v4u hv = *(const LAS v4u*)(HT + t * 264 + c0 + q * 8); const v4u mv = *(const v4u*)(mo + q * 8); const f32x4 g0 = *(const f32x4*)(og + q * 8), g1 = *(const f32x4*)(og + q * 8 + 4);
      v4u o; o.x = pk2(bflo(hv.x) * g0.x * bflo(mv.x), bfhi(hv.x) * g0.y * bfhi(mv.x)); o.y = pk2(bflo(hv.y) * g0.z * bflo(mv.y), bfhi(hv.y) * g0.w * bfhi(mv.y));
      o.z = pk2(bflo(hv.z) * g1.x * bflo(mv.z), bfhi(hv.z) * g1.y * bfhi(mv.z)); o.w = pk2(bflo(hv.w) * g1.z * bflo(mv.w), bfhi(hv.w) * g1.w * bfhi(mv.w));
      *(v4u*)(A2 + q * 8) = o; } }
}
}
__device__ __forceinline__ void p3_combine(const Frame& F, const Args& a, int NA) {
  const float* PO = (const float*)(F.ws + WS_PO); const float* ML = (const float*)(F.ws + WS_ML);
  bf16* A2 = (bf16*)(F.ws + WS_A2);
  const float lam = *(const float*)(F.ws + WS_LAM);
  const float* subg = a.in[IN_SUBG];
  const int gw = blockIdx.x * NWAVES + F.wave, NGW = gridDim.x * NWAVES, lane = F.lane;
  const f32x4 sg = ((const f32x4*)subg)[lane];
  for (int R = gw; R < MROWS; R += NGW) {
    const int b = R >> 11, t = R & 2047, qb = t >> 8, rq = t & 255;
#pragma unroll 1
    for (int h = 0; h < 4; ++h) {
      f32x4 om[2];
#pragma unroll
      for (int m = 0; m < 2; ++m) {
        const int bhm = (b * 4 + h) * 2 + m, first = bhm * att::STEPS_BHM + att::qb_start(qb), last = first + 4 * qb + 4;
        const int cf = att::chunk_of(first, NA), np = att::chunk_of(last, NA) - cf + 1, slot0 = bhm * 16 + qb + cf - att::chunk_of(bhm * att::STEPS_BHM, NA);
        float mp[3], lp[3]; f32x4 op[3];
#pragma unroll
        for (int p = 0; p < 3; ++p) { if (p < np) { const int slot = slot0 + p; mp[p] = ML[(size_t)slot * 512 + rq * 2]; lp[p] = ML[(size_t)slot * 512 + rq * 2 + 1];
            op[p] = ((const f32x4*)(PO + ((size_t)slot * 256 + rq) * 256))[lane]; } else { mp[p] = -1e30f; lp[p] = 0.f; op[p] = (f32x4){0.f, 0.f, 0.f, 0.f}; } }
        const float M = fmaxf(mp[0], fmaxf(mp[1], mp[2]));
        float wsum = 0.f; f32x4 acc = (f32x4){0.f, 0.f, 0.f, 0.f};
#pragma unroll
        for (int p = 0; p < 3; ++p) { const float w = lp[p] * exp2f(mp[p] - M); wsum += w; acc += op[p] * w; }
        om[m] = acc * (1.0f / wsum);
      }
      const f32x4 o = om[0] - om[1] * lam;
      const float rs = rsqrtf(wave_sum((o.x * o.x + o.y * o.y) + (o.z * o.z + o.w * o.w)) * (1.0f / 256.f) + EPS) * 0.8f;
      v2u w; w.x = pk2(o.x * rs * sg.x, o.y * rs * sg.y); w.y = pk2(o.z * rs * sg.z, o.w * rs * sg.w);
      ((v2u*)(A2 + (size_t)R * DM + h * 256))[lane] = w;
    }
  }
}
struct EpiRes {
  static constexpr bool PERM = true, AFTER_DRAIN = false;
  const float* x; float* out; bf16* H1b; float* SSQ;
  __device__ __forceinline__ void operator()(const pg8::f32x4 (&acc)[2][2][4][2], const pg8::Unit& u, int wr, int wc, int fr, int fq) const {
    const int row0 = u.pm * 256 + wr * 64 + fr, col0 = u.pn * 256 + wc * 32 + 8 * fq;
#pragma unroll
    for (int ai = 0; ai < 2; ++ai)
#pragma unroll
      for (int m = 0; m < 4; ++m) { const size_t R = (size_t)(row0 + ai * 128 + m * 16); float s = 0.f;
#pragma unroll
        for (int bj = 0; bj < 2; ++bj) { const size_t off = R * DM + col0 + bj * 128;
          const f32x4 x0 = *(const f32x4*)(x + off), x1 = *(const f32x4*)(x + off + 4);
          const f32x4 v0 = acc[ai][bj][m][0] + x0, v1 = acc[ai][bj][m][1] + x1;
          *(f32x4*)(out + off) = v0; *(f32x4*)(out + off + 4) = v1;
          v4u w; w.x = pk2(v0.x, v0.y); w.y = pk2(v0.z, v0.w); w.z = pk2(v1.x, v1.y); w.w = pk2(v1.z, v1.w);
          *(v4u*)(H1b + off) = w;
          s += (v0.x * v0.x + v0.y * v0.y) + (v0.z * v0.z + v0.w * v0.w) + (v1.x * v1.x + v1.y * v1.y) + (v1.z * v1.z + v1.w * v1.w); }
        s += __shfl_xor(s, 16); s += __shfl_xor(s, 32);
        if (fq == 0) SSQ[R * 32 + u.pn * 4 + wc] = s; }
  }
};
typedef __bf16 bfv2 __attribute__((ext_vector_type(2)));
__device__ __forceinline__ void split_hl(const f32x4 a, const f32x4 b, bf16x8& hi, bf16x8& lo) {
  float v[8] = {a.x, a.y, a.z, a.w, b.x, b.y, b.z, b.w}; unsigned h[8], l[8];
#pragma unroll
  for (int i = 0; i < 8; ++i) { h[i] = f2bf(v[i]); l[i] = f2bf(v[i] - __builtin_bit_cast(float, h[i] << 16)); }
  v4u hv = {h[0] | (h[1] << 16), h[2] | (h[3] << 16), h[4] | (h[5] << 16), h[6] | (h[7] << 16)};
  v4u lv = {l[0] | (l[1] << 16), l[2] | (l[3] << 16), l[4] | (l[5] << 16), l[6] | (l[7] << 16)};
  hi = __builtin_bit_cast(bf16x8, hv); lo = __builtin_bit_cast(bf16x8, lv);
}
__device__ __forceinline__ void p0_w3t(const Frame& F, const Args& a) {
  const float* wq = a.in[IN_WQ]; const float* sk = a.in[IN_SUBK]; const float* g2 = a.in[IN_G2];
  bf16* W3t = (bf16*)(F.ws + WS_W3T);
  const int gw = blockIdx.x * NWAVES + F.wave, NGW = gridDim.x * NWAVES, lane = F.lane, fr = lane & 15, fq = lane >> 4;
  for (int task = gw; task < 128 * 16; task += NGW) {
    const int kt = task >> 4, hh = task & 15;
    bf16x8 ahi[4], alo[4];
    const float* ap = wq + (size_t)(kt * 16 + fr) * DM + hh * 128 + fq * 8;
#pragma unroll
    for (int s = 0; s < 4; ++s) split_hl(*(const f32x4*)(ap + 32 * s), *(const f32x4*)(ap + 32 * s + 4), ahi[s], alo[s]);
    const f32x4 gk = *(const f32x4*)(g2 + kt * 16 + fq * 4);
#pragma unroll 1
    for (int t2 = 0; t2 < 8; ++t2) {
      const float* bp = sk + (size_t)(hh * 128 + t2 * 16 + fr) * 128 + fq * 8;
      f32x4 acc = {0.f, 0.f, 0.f, 0.f};
#pragma unroll
      for (int s = 0; s < 4; ++s) { bf16x8 bhi, blo; split_hl(*(const f32x4*)(bp + 32 * s), *(const f32x4*)(bp + 32 * s + 4), bhi, blo);
        acc = __builtin_amdgcn_mfma_f32_16x16x32_bf16(ahi[s], bhi, acc, 0, 0, 0);
        acc = __builtin_amdgcn_mfma_f32_16x16x32_bf16(ahi[s], blo, acc, 0, 0, 0);
        acc = __builtin_amdgcn_mfma_f32_16x16x32_bf16(alo[s], bhi, acc, 0, 0, 0); }
      v2u o; o.x = pk2(acc.x * gk.x, acc.y * gk.y); o.y = pk2(acc.z * gk.z, acc.w * gk.w);
      *(v2u*)(W3t + (size_t)(hh * 128 + t2 * 16 + fr) * DM + kt * 16 + fq * 4) = o;
    }
  }
}
typedef float f32x2v __attribute__((ext_vector_type(2)));
__device__ __forceinline__ void p0_tables(const Frame& F, const Args& a) {
  const float* g2 = a.in[IN_G2];
  unsigned char* T8 = F.ws + WS_UB; float* SCL = (float*)(F.ws + WS_SCL);
  const int gw = blockIdx.x * NWAVES + F.wave, NGW = gridDim.x * NWAVES, lane = F.lane;
  for (int row = gw; row < 2 * 16384; row += NGW) {
    const bool isv = row >= 16384; const int e = row & 16383;
    if (!isv) {
      const float* src = a.in[IN_U] + (size_t)e * DM;
      f32x4 x[2][4]; float amax = 0.f;
#pragma unroll
      for (int i = 0; i < 2; ++i)
#pragma unroll
        for (int q = 0; q < 4; ++q) { const int k = (i * 64 + lane) * 16 + q * 4; f32x4 v = *(const f32x4*)(src + k) * *(const f32x4*)(g2 + k);
          x[i][q] = v; amax = fmaxf(amax, fmaxf(fmaxf(fabsf(v.x), fabsf(v.y)), fmaxf(fabsf(v.z), fabsf(v.w)))); }
#pragma unroll
      for (int o = 1; o < 64; o <<= 1) amax = fmaxf(amax, __shfl_xor(amax, o));
      const float sc = amax > 0.f ? exp2f(floorf(log2f(224.0f / amax))) : 1.0f;
#pragma unroll
      for (int i = 0; i < 2; ++i) { v4u w;
#pragma unroll
        for (int q = 0; q < 4; ++q) { int pk = 0; pk = __builtin_amdgcn_cvt_pk_fp8_f32(x[i][q].x * sc, x[i][q].y * sc, pk, false); pk = __builtin_amdgcn_cvt_pk_fp8_f32(x[i][q].z * sc, x[i][q].w * sc, pk, true); w[q] = (unsigned)pk; }
        *(v4u*)(T8 + (size_t)e * DM + (size_t)(i * 64 + lane) * 16) = w; }
      if (lane == 0) SCL[row] = 1.0f / sc;
    } else {
      const float* src = a.in[IN_V] + (size_t)e * DM + lane * 32;
      f32x4 x[8]; float amax = 0.f;
#pragma unroll
      for (int q = 0; q < 8; ++q) { x[q] = *(const f32x4*)(src + q * 4); amax = fmaxf(amax, fmaxf(fmaxf(fabsf(x[q].x), fabsf(x[q].y)), fmaxf(fabsf(x[q].z), fabsf(x[q].w)))); }
#pragma unroll
      for (int o = 1; o < 64; o <<= 1) amax = fmaxf(amax, __shfl_xor(amax, o));
      const float sc = amax > 0.f ? 6.0f / amax : 1.0f;
      v4u w;
#pragma unroll
      for (int d = 0; d < 4; ++d) { unsigned pk = 0u;
        pk = __builtin_amdgcn_cvt_scalef32_pk_fp4_f32(pk, x[2 * d].x * sc, x[2 * d].y * sc, 1.0f, 0); pk = __builtin_amdgcn_cvt_scalef32_pk_fp4_f32(pk, x[2 * d].z * sc, x[2 * d].w * sc, 1.0f, 1);
        pk = __builtin_amdgcn_cvt_scalef32_pk_fp4_f32(pk, x[2 * d + 1].x * sc, x[2 * d + 1].y * sc, 1.0f, 2); pk = __builtin_amdgcn_cvt_scalef32_pk_fp4_f32(pk, x[2 * d + 1].z * sc, x[2 * d + 1].w * sc, 1.0f, 3);
        w[d] = pk; }
      *(v4u*)(F.ws + WS_VB8 + (size_t)e * 1024 + lane * 16) = w;
      if (lane == 0) SCL[row] = 1.0f / sc;
    }
  }
}
struct EpiScore {
  static constexpr bool PERM = true, AFTER_DRAIN = false;
  float* S; const LAS float* rs;
  __device__ __forceinline__ void operator()(const pg8::f32x4 (&acc)[2][2][4][2], const pg8::Unit& u, int wr, int wc, int fr, int fq) const {
    const int rl0 = wr * 64 + fr, col0 = u.pn * 256 + wc * 32 + 8 * fq;
#pragma unroll
    for (int ai = 0; ai < 2; ++ai)
#pragma unroll
      for (int m = 0; m < 4; ++m) { const int rl = rl0 + ai * 128 + m * 16; const float r = rs[rl]; const size_t R = (size_t)u.pm * 256 + rl;
#pragma unroll
        for (int bj = 0; bj < 2; ++bj) { float* d = S + R * DM + col0 + bj * 128;
          *(f32x4*)d = acc[ai][bj][m][0] * r; *(f32x4*)(d + 4) = acc[ai][bj][m][1] * r; } }
  }
};

__device__ __forceinline__ unsigned fkey(float f) { const unsigned b = __builtin_bit_cast(unsigned, f); return b ^ ((b >> 31) ? 0xFFFFFFFFu : 0x80000000u); }
template <int NV, int K> __device__ __forceinline__ void wave_topk(const unsigned (&u)[NV], bool (&sel)[NV], int lane) {
  unsigned prefix = 0u; int cge = NV * 64;
#pragma unroll 1
  for (int bit = 31; bit >= 0 && cge != K; --bit) {
    const unsigned cand = prefix | (1u << bit); int c = 0;
#pragma unroll
    for (int i = 0; i < NV; ++i) c += __builtin_popcountll(__ballot(u[i] >= cand));
    if (c >= K) { prefix = cand; cge = c; }
  }
  int cgt = 0;
#pragma unroll
  for (int i = 0; i < NV; ++i) cgt += __builtin_popcountll(__ballot(u[i] > prefix));
  int need = K - cgt;
  const unsigned long long lm = (1ull << lane) - 1ull;
#pragma unroll
  for (int i = 0; i < NV; ++i) { const unsigned long long eq = __ballot(u[i] == prefix); const int before = __builtin_popcountll(eq & lm);
    sel[i] = (u[i] > prefix) || (u[i] == prefix && before < need); const int ne = __builtin_popcountll(eq); need = need > ne ? need - ne : 0; }
}
template <int NG, int NV, int K> __device__ __forceinline__ void wave_topk_multi(const unsigned (&u)[NG][NV], bool (&sel)[NG][NV], int lane) {
  unsigned prefix[NG]; int cge[NG];
#pragma unroll
  for (int g = 0; g < NG; ++g) { prefix[g] = 0u; cge[g] = NV * 64; }
#pragma unroll 1
  for (int bit = 31; bit >= 0; --bit) {
    bool done = true;
#pragma unroll
    for (int g = 0; g < NG; ++g) done = done && (cge[g] == K);
    if (done) break;
#pragma unroll
    for (int g = 0; g < NG; ++g) { const unsigned cand = prefix[g] | (1u << bit); int c = 0;
#pragma unroll
      for (int i = 0; i < NV; ++i) c += __builtin_popcountll(__ballot(u[g][i] >= cand));
      if (cge[g] != K && c >= K) { prefix[g] = cand; cge[g] = c; } }
  }
  const unsigned long long lm = (1ull << lane) - 1ull;
#pragma unroll
  for (int g = 0; g < NG; ++g) { int cgt = 0;
#pragma unroll
    for (int i = 0; i < NV; ++i) cgt += __builtin_popcountll(__ballot(u[g][i] > prefix[g]));
    int need = K - cgt;
#pragma unroll
    for (int i = 0; i < NV; ++i) { const unsigned long long eq = __ballot(u[g][i] == prefix[g]); const int before = __builtin_popcountll(eq & lm);
      sel[g][i] = (u[g][i] > prefix[g]) || (u[g][i] == prefix[g] && before < need); const int ne = __builtin_popcountll(eq); need = need > ne ? need - ne : 0; } }
}
__device__ __forceinline__ float gelu_erf(float x) { return 0.5f * x * (1.0f + erff(x * 0.70710678118654752f)); }

#ifndef ROUTE_REPS
#define ROUTE_REPS 1
#endif
__device__ __forceinline__ void p6_peer(const Frame& F, const Args& a, float* dst_base) {
  const float* S = (const float*)(F.ws + WS_S); const float* SSQ = (const float*)(F.ws + WS_SSQ); const bf16* H1b = (const bf16*)(F.ws + WS_H1B);
  float* out = a.out;
  const int lane = F.lane, gw = blockIdx.x * NWAVES + F.wave, NGW = gridDim.x * NWAVES;
  LAS float* wl = (LAS float*)(F.lds + F.wave * 4096);
  LAS int* wli = (LAS int*)wl;
  for (int tok = gw; tok < MROWS; tok += NGW) {
    const float rs = rsqrtf(wave_sum(lane < 32 ? SSQ[(size_t)tok * 32 + lane] : 0.f) * (1.0f / DM) + EPS);
    const float* srow = S + (size_t)tok * DM;
    const unsigned long long lmk = (1ull << lane) - 1ull;
#pragma unroll 1
    for (int gb = 0; gb < 4 * ROUTE_REPS; ++gb) {
      const int g0 = (gb & 3) * 4;
      float2 sv[4]; unsigned u[4][2]; bool sel[4][2];
#pragma unroll
      for (int q = 0; q < 4; ++q) { sv[q] = *(const float2*)(srow + (g0 + q) * 128 + 2 * lane); u[q][0] = fkey(sv[q].x); u[q][1] = fkey(sv[q].y); }
      wave_topk_multi<4, 2, 16>(u, sel, lane);
#pragma unroll
      for (int q = 0; q < 4; ++q) { const unsigned long long m0 = __ballot(sel[q][0]), m1 = __ballot(sel[q][1]);
        const int pos0 = __builtin_popcountll(m0 & lmk), pos1 = __builtin_popcountll(m0) + __builtin_popcountll(m1 & lmk);
        if (sel[q][0]) { wl[(g0 + q) * 16 + pos0] = sv[q].x; wli[256 + (g0 + q) * 16 + pos0] = 2 * lane; }
        if (sel[q][1]) { wl[(g0 + q) * 16 + pos1] = sv[q].y; wli[256 + (g0 + q) * 16 + pos1] = 2 * lane + 1; } }
    }
    asm volatile("s_waitcnt lgkmcnt(0)" ::: "memory");
    const int ci = lane >> 2, cj = 4 * (lane & 3);
#pragma unroll 1
    for (int hb = 0; hb < 2 * ROUTE_REPS; ++hb) {
      const int h0 = (hb & 1) * 4;
      float cv[4][4]; unsigned cu[4][4]; bool csel[4][4];
#pragma unroll
      for (int hq = 0; hq < 4; ++hq) { const int h8 = h0 + hq; const float s0 = wl[(2 * h8) * 16 + ci]; const f32x4 s1 = *(const LAS f32x4*)(wl + (2 * h8 + 1) * 16 + cj);
        cv[hq][0] = s0 + s1.x; cv[hq][1] = s0 + s1.y; cv[hq][2] = s0 + s1.z; cv[hq][3] = s0 + s1.w;
#pragma unroll
        for (int q = 0; q < 4; ++q) cu[hq][q] = fkey(cv[hq][q]); }
      wave_topk_multi<4, 4, 16>(cu, csel, lane);
#pragma unroll
      for (int hq = 0; hq < 4; ++hq) { const int h8 = h0 + hq;
        float mx = -INFINITY;
#pragma unroll
        for (int q = 0; q < 4; ++q) if (csel[hq][q]) mx = fmaxf(mx, cv[hq][q]);
#pragma unroll
        for (int o = 1; o < 64; o <<= 1) mx = fmaxf(mx, __shfl_xor(mx, o));
        float ev[4], es = 0.f;
#pragma unroll
        for (int q = 0; q < 4; ++q) { ev[q] = csel[hq][q] ? __expf(cv[hq][q] - mx) : 0.f; es += ev[q]; }
        es = wave_sum(es); const float inv = 1.0f / es;
        typedef int i32x4 __attribute__((ext_vector_type(4)));
        const int ki = wli[256 + (2 * h8) * 16 + ci]; const i32x4 kj = *(const LAS i32x4*)(wli + 256 + (2 * h8 + 1) * 16 + cj);
        const int kjv[4] = {kj.x, kj.y, kj.z, kj.w};
        int base = 0;
#pragma unroll
        for (int q = 0; q < 4; ++q) { const unsigned long long mq = __ballot(csel[hq][q]); const int pos = base + __builtin_popcountll(mq & lmk);
          if (csel[hq][q]) { wli[512 + h8 * 16 + pos] = ki * 128 + kjv[q]; wl[640 + h8 * 16 + pos] = ev[q] * inv; } base += __builtin_popcountll(mq); } }
    }
    asm volatile("s_waitcnt lgkmcnt(0)" ::: "memory");
    float xs[32];
#pragma unroll
    for (int i = 0; i < 2; ++i) { const v4u* xp = (const v4u*)(H1b + (size_t)tok * DM + (size_t)(i * 64 + lane) * 16); const v4u x0 = xp[0], x1 = xp[1];
      xs[i * 16 + 0] = bflo(x0.x); xs[i * 16 + 1] = bfhi(x0.x); xs[i * 16 + 2] = bflo(x0.y); xs[i * 16 + 3] = bfhi(x0.y); xs[i * 16 + 4] = bflo(x0.z); xs[i * 16 + 5] = bfhi(x0.z); xs[i * 16 + 6] = bflo(x0.w); xs[i * 16 + 7] = bfhi(x0.w);
      xs[i * 16 + 8] = bflo(x1.x); xs[i * 16 + 9] = bfhi(x1.x); xs[i * 16 + 10] = bflo(x1.y); xs[i * 16 + 11] = bfhi(x1.y); xs[i * 16 + 12] = bflo(x1.z); xs[i * 16 + 13] = bfhi(x1.z); xs[i * 16 + 14] = bflo(x1.w); xs[i * 16 + 15] = bfhi(x1.w); }
    float y[32];
#pragma unroll
    for (int i = 0; i < 32; ++i) y[i] = 0.f;
    const unsigned char* U8 = F.ws + WS_UB; const unsigned char* V8 = F.ws + WS_VB8; const float* SCL = (const float*)(F.ws + WS_SCL);
#pragma unroll 1
    for (int e0 = 0; e0 < 128; e0 += 4) {
      int id[4]; float gt[4];
#pragma unroll
      for (int q = 0; q < 4; ++q) { id[q] = __builtin_amdgcn_readfirstlane(wli[512 + e0 + q]); gt[q] = wl[640 + e0 + q]; }
      v4u ur[4][2], vr[4];
#pragma unroll
      for (int q = 0; q < 4; ++q)
#pragma unroll
        for (int i = 0; i < 2; ++i) ur[q][i] = ((const v4u*)(U8 + (size_t)id[q] * DM))[i * 64 + lane];
#pragma unroll
      for (int q = 0; q < 4; ++q) vr[q] = ((const v4u*)(V8 + (size_t)id[q] * 1024))[lane];
      float su[4], sv[4];
#pragma unroll
      for (int q = 0; q < 4; ++q) { su[q] = SCL[id[q]]; sv[q] = SCL[16384 + id[q]]; }
      float d[4] = {0.f, 0.f, 0.f, 0.f};
#pragma unroll
      for (int q = 0; q < 4; ++q)
#pragma unroll
        for (int i = 0; i < 2; ++i)
#pragma unroll
          for (int c = 0; c < 4; ++c) { const int wa = (int)ur[q][i][c];
            const f32x2v a0 = __builtin_amdgcn_cvt_pk_f32_fp8(wa, false), a1 = __builtin_amdgcn_cvt_pk_f32_fp8(wa, true);
            d[q] += xs[i * 16 + 4 * c] * a0.x + xs[i * 16 + 4 * c + 1] * a0.y + xs[i * 16 + 4 * c + 2] * a1.x + xs[i * 16 + 4 * c + 3] * a1.y; }
      float cf[4];
#pragma unroll
      for (int q = 0; q < 4; ++q) { d[q] = wave_sum(d[q]); cf[q] = gelu_erf(d[q] * (rs * su[q])) * (gt[q] * sv[q]); }
#pragma unroll
      for (int q = 0; q < 4; ++q)
#pragma unroll
        for (int d = 0; d < 4; ++d) { const unsigned wa = vr[q][d];
          { const f32x2v v2 = __builtin_amdgcn_cvt_scalef32_pk_f32_fp4(wa, 1.0f, 0); y[8 * d + 0] += cf[q] * v2.x; y[8 * d + 1] += cf[q] * v2.y; }
          { const f32x2v v2 = __builtin_amdgcn_cvt_scalef32_pk_f32_fp4(wa, 1.0f, 1); y[8 * d + 2] += cf[q] * v2.x; y[8 * d + 3] += cf[q] * v2.y; }
          { const f32x2v v2 = __builtin_amdgcn_cvt_scalef32_pk_f32_fp4(wa, 1.0f, 2); y[8 * d + 4] += cf[q] * v2.x; y[8 * d + 5] += cf[q] * v2.y; }
          { const f32x2v v2 = __builtin_amdgcn_cvt_scalef32_pk_f32_fp4(wa, 1.0f, 3); y[8 * d + 6] += cf[q] * v2.x; y[8 * d + 7] += cf[q] * v2.y; } }
    }
    float* orow = out + (size_t)tok * DM; float* drow = dst_base + (size_t)tok * DM;
#pragma unroll
    for (int q = 0; q < 8; ++q) { const size_t off = (size_t)lane * 32 + q * 4; f32x4 hv = *(const f32x4*)(orow + off);
      hv.x += y[4 * q]; hv.y += y[4 * q + 1]; hv.z += y[4 * q + 2]; hv.w += y[4 * q + 3]; *(f32x4*)(drow + off) = hv; }
  }
}
constexpr int MISC_LDS = LDS_BYTES - 256;
__global__ void __launch_bounds__(NTHR, 2) mk_fwd(Args args) {
  extern __shared__ __attribute__((aligned(16))) unsigned char lds_raw[];
  Frame F; F.lds = (LAS unsigned char*)lds_raw; F.ws = args.ws; F.tid = threadIdx.x; F.lane = F.tid & 63; F.wave = __builtin_amdgcn_readfirstlane(F.tid >> 6);
  const int lo = args.ph_lo, hi = args.ph_hi, G = (int)gridDim.x, bx = (int)blockIdx.x;
  volatile LAS unsigned* misc = (volatile LAS unsigned*)(F.lds + MISC_LDS);
  if (F.tid < 16) misc[F.tid] = 0u;
  __syncthreads();
  XcdBarrier bar = xcd_barrier_post((unsigned*)(F.ws + WS_CTL) + CW_BAR, misc);
#define IN(k) (lo <= (k) && (k) < hi)
#define SEAM(k) do { if (IN(k) && IN((k) + 1)) xcd_barrier(bar); } while (0)
  const int NA = G;
  if (IN(0)) {
    p0_lam(F, args);
    p0_zero_vpad(F);
    p0_metaproj(F, args);
    p0_rows(F, args);
    p0_transpose(F, args.in[IN_WIN], DPROJ, NPROJ, (bf16*)(F.ws + WS_W1T));
    p0_transpose(F, args.in[IN_WOUT], DM, DM, (bf16*)(F.ws + WS_W2T));
    p0_w3t(F, args);
    p0_tables(F, args);
  }
  SEAM(0);
  if (IN(1)) {
    p1_meta_finalize(F, args);
    pg8::Gemm g{(const pg8::bf16_t*)(F.ws + WS_XN), (const pg8::bf16_t*)(F.ws + WS_W1T), MROWS, NPROJ, DM};
    pg8::StaticOrder S; S.init(MROWS, NPROJ, G, bx);
    EpiProj E{(bf16*)(F.ws + WS_Q), (bf16*)(F.ws + WS_KP), (bf16*)(F.ws + WS_VP), (bf16*)(F.ws + WS_MQ), (bf16*)(F.ws + WS_MK), (bf16*)(F.ws + WS_MV), (bf16*)(F.ws + WS_MO),
              args.in[IN_QNG], args.in[IN_KNG], (LAS float*)(F.lds + XCH_OFF)};
    pg8::gemm_phase<EpiProj, pg8::StaticOrder, true, true>(F.lds + RING_OFF, g, S, E);
  }
  SEAM(1);
  if (IN(2)) {
    att::phase(F, (G % 8 == 0) ? (bx & 7) * (G >> 3) + (bx >> 3) : bx, NA);
    for (int task = bx; task < 512; task += G) ml::taskA(F, args, task);
  }
  SEAM(2);
  if (IN(3)) ml::scanB(F);
  SEAM(3);
  if (IN(4)) {
    for (int task = bx; task < 512; task += G) ml::taskC(F, args, task);
    p3_combine(F, args, NA);
  }
  SEAM(4);
  if (IN(5)) {
    pg8::Gemm g{(const pg8::bf16_t*)(F.ws + WS_A2), (const pg8::bf16_t*)(F.ws + WS_W2T), MROWS, DM, DM};
    pg8::StaticOrder S; S.init(MROWS, DM, G, bx);
    EpiRes E{args.in[IN_X], args.out, (bf16*)(F.ws + WS_H1B), (float*)(F.ws + WS_SSQ)};
    pg8::gemm_phase<EpiRes, pg8::StaticOrder, true, true>(F.lds + RING_OFF, g, S, E);
  }
  SEAM(5);
  if (IN(6)) {
    pg8::Gemm g{(const pg8::bf16_t*)(F.ws + WS_H1B), (const pg8::bf16_t*)(F.ws + WS_W3T), MROWS, DM, DM};
    pg8::StaticOrder S; S.init(MROWS, DM, G, bx);
    LAS float* rst = (LAS float*)(F.lds + XCH_OFF);
    { pg8::Unit u0; if (S.next(0, u0)) { if (F.tid < 256) { const float* sp = (const float*)(F.ws + WS_SSQ) + ((size_t)u0.pm * 256 + F.tid) * 32; float s = 0.f;
#pragma unroll
          for (int i = 0; i < 8; ++i) { const f32x4 v = ((const f32x4*)sp)[i]; s += (v.x + v.y) + (v.z + v.w); }
          rst[F.tid] = rsqrtf(s * (1.0f / DM) + EPS); } } }
    __syncthreads();
    EpiScore E{(float*)(F.ws + WS_S), rst};
    pg8::gemm_phase<EpiScore, pg8::StaticOrder, true, true>(F.lds + RING_OFF, g, S, E);
  }
  SEAM(6);
  if (IN(7)) p6_peer(F, args, args.out);
#undef IN
#undef SEAM
}
extern "C" void kernel_launch(void* const* d_in, const int* in_sizes, int n_in, void* d_out, int out_size, void* d_ws, size_t ws_size, hipStream_t stream) {
  static int grid = 0;
  if (grid == 0) {
    int dev = 0, cus = 0, per_cu = 0;
    if (hipGetDevice(&dev) != hipSuccess || hipDeviceGetAttribute(&cus, hipDeviceAttributeMultiprocessorCount, dev) != hipSuccess) { fprintf(stderr, "device query failed\n"); grid = -1; return; }
    if (hipFuncSetAttribute((const void*)mk_fwd, hipFuncAttributeMaxDynamicSharedMemorySize, LDS_BYTES) != hipSuccess) { fprintf(stderr, "hipFuncSetAttribute failed\n"); grid = -1; return; }
    if (hipOccupancyMaxActiveBlocksPerMultiprocessor(&per_cu, (const void*)mk_fwd, NTHR, LDS_BYTES) != hipSuccess || per_cu < 1) { fprintf(stderr, "occupancy query says %d workgroups per CU: not launching\n", per_cu); (void)hipGetLastError(); grid = -1; return; }
    (void)hipGetLastError();
    grid = cus;
    if (n_in != 22 || ws_size < (size_t)512 * MiB || out_size != MROWS * DM) { fprintf(stderr, "unexpected shapes: n_in %d out %d ws %zu\n", n_in, out_size, ws_size); grid = -1; return; }
  }
  if (grid < 0) return;
  unsigned char* ws = (unsigned char*)d_ws;
  if (hipMemsetAsync(ws + WS_CTL, 0, CTL_ZERO_BYTES, stream) != hipSuccess) { fprintf(stderr, "memset failed\n"); return; }
  Args a{};
  for (int i = 0; i < 22; ++i) a.in[i] = (const float*)d_in[i];
  a.out = (float*)d_out; a.ws = ws; a.na = 0; a.pad = 0;
  a.ph_lo = 0; a.ph_hi = 8;
  hipLaunchKernelGGL(mk_fwd, dim3(grid), dim3(NTHR), LDS_BYTES, stream, a);
}
```

```cpp
#include <hip/hip_runtime.h>
#include <cstdio>
#include <cstdint>
#include <math.h>
namespace pg8 {
#define PG8_LAS __attribute__((address_space(3)))
typedef unsigned short bf16_t;
typedef short bf16x8 __attribute__((ext_vector_type(8)));
typedef float f32x4 __attribute__((ext_vector_type(4)));
typedef unsigned u32x4 __attribute__((ext_vector_type(4)));
constexpr int BM = 256, BK = 64, HALF = 128, HTB = HALF * BK * 2  , STAGE_BYTES = 8 * HTB, NXCD = 8, WGM = 8;

__host__ __device__ __forceinline__ int lds_byte(int r, int c) { const int st = (r >> 4) * 2 + (c >> 5), rr = r & 15, cc = c & 31, ob = rr * 64 + cc * 2; return st * 1024 + (ob ^ (((ob >> 9) & 1) << 5)); }
__host__ __device__ __forceinline__ void stage_rc(int b, int& R, int& C) { const int st = b / 1024, sb = b % 1024, swz = sb ^ (((sb >> 9) & 1) << 5); R = (st >> 1) * 16 + swz / 64; C = (st & 1) * 32 + (swz % 64) / 2; }
__host__ __device__ __forceinline__ int perm32(int rho) { const int n = rho >> 4, i = rho & 15; return 8 * (i >> 2) + 4 * n + (i & 3); }

struct Unit { int pm, pn; };
struct Gemm { const bf16_t* A; const bf16_t* Bt; int M, N, K; };

struct StaticOrder {
    int nM, nN, nwg, G, c;
    __host__ __device__ void init(int M, int N, int G_, int c_) { nM = M / BM; nN = N / BM; nwg = nM * nN; G = G_; c = c_; }
    __host__ __device__ bool next(int i, Unit& u) const {
        const long L = (long)i * G + c; if (L >= nwg) return false;
        int wgid = (int)L; { const int q = nwg / NXCD, r = nwg % NXCD, xcd = wgid % NXCD, off = wgid / NXCD; wgid = (xcd < r ? xcd * (q + 1) : r * (q + 1) + (xcd - r) * q) + off; }
        const int nig = WGM * nN, gid = wgid / nig, fm = gid * WGM, gsz = (nM - fm) < WGM ? (nM - fm) : WGM;
        u.pm = fm + ((wgid % nig) % gsz); u.pn = (wgid % nig) / gsz; return true;
    }
    __device__ __forceinline__ void a_ready(const Unit&) const {}
    __device__ __forceinline__ void done(const Unit&) const {}
};

__device__ __forceinline__ unsigned cvt_pk_bf16(float lo, float hi) { unsigned r; asm volatile("v_cvt_pk_bf16_f32 %0, %1, %2" : "=v"(r) : "v"(lo), "v"(hi)); return r; }
typedef float f32x2 __attribute__((ext_vector_type(2)));
template <class Epi, class Sched, bool ALIGN_EPI = false, bool SP2 = false>
__device__ __forceinline__ void gemm_phase(PG8_LAS unsigned char* lds, const Gemm g, const Sched& S, const Epi& E) {
    int tid_ = threadIdx.x; asm volatile("" : "+v"(tid_));
    const int tid = tid_, wid = __builtin_amdgcn_readfirstlane(tid >> 6), lane = tid & 63, wr = wid >> 2, wc = wid & 3, fr = lane & 15, fq = lane >> 4;
    const int K = g.K, nt = K / BK;
    unsigned voffA[2], voffB[2];
#pragma unroll
    for (int i = 0; i < 2; ++i) { int R, C; stage_rc(tid * 16 + i * 8192, R, C); const int Rb = Epi::PERM ? ((R & ~31) + perm32(R & 31)) : R;
        voffA[i] = (unsigned)(R * K + C) * 2u; voffB[i] = (unsigned)(Rb * K + C) * 2u; }
    const size_t kstep = (size_t)(BK * 2);
    const size_t hstep = (size_t)HALF * K * 2;
    const size_t tstep = 2 * hstep;
    const unsigned ldsw = (unsigned)wid * 1024u;
    const int aoff = lds_byte(wr * 64 + fr, fq * 8), boff = lds_byte(wc * 32 + fr, fq * 8);
#define PG8_SA(b, h) (((b) * 2 + (h)) * HTB)
#define PG8_SB(b, h) ((4 + (b) * 2 + (h)) * HTB)
#define PG8_STAGE(bufoff, gbase, voff) do { _Pragma("unroll") for (int _i = 0; _i < 2; ++_i) \
        __builtin_amdgcn_global_load_lds((const unsigned*)((const char*)(gbase) + (voff)[_i]), (PG8_LAS unsigned*)(lds + (bufoff) + ldsw + _i * 8192), 16, 0, 0); } while (0)
#define PG8_LDA(dst, b, h) do { _Pragma("unroll") for (int m = 0; m < 4; ++m) _Pragma("unroll") for (int k = 0; k < 2; ++k) dst[m][k] = *(const PG8_LAS bf16x8*)(lds + PG8_SA(b, h) + aoff + m * 2048 + k * 1024); } while (0)
#define PG8_LDB(dst, b, h) do { _Pragma("unroll") for (int n = 0; n < 2; ++n) _Pragma("unroll") for (int k = 0; k < 2; ++k) dst[n][k] = *(const PG8_LAS bf16x8*)(lds + PG8_SB(b, h) + boff + n * 2048 + k * 1024); } while (0)
#define PG8_MMA(ai, bj, At, Bt) do { __builtin_amdgcn_s_setprio(1); _Pragma("unroll") for (int m = 0; m < 4; ++m) _Pragma("unroll") for (int n = 0; n < 2; ++n) _Pragma("unroll") for (int k = 0; k < 2; ++k) \
        acc[ai][bj][m][n] = __builtin_amdgcn_mfma_f32_16x16x32_bf16(Bt[n][k], At[m][k], acc[ai][bj][m][n], 0, 0, 0); __builtin_amdgcn_s_setprio(0); } while (0)
#define PG8_WAIT_V(n) asm volatile("s_waitcnt vmcnt(" #n ")" ::: "memory")
#define PG8_WAIT_L(n) asm volatile("s_waitcnt lgkmcnt(" #n ")" ::: "memory")
#define PG8_BAR __builtin_amdgcn_s_barrier()
#define PG8_SCHED __builtin_amdgcn_sched_barrier(0)
    Unit cur, nxt; int ui = 0;
    if (!S.next(0, cur)) return;
    f32x4 acc[2][2][4][2];
#pragma unroll
    for (int a = 0; a < 2; ++a)
#pragma unroll
        for (int b = 0; b < 2; ++b)
#pragma unroll
            for (int m = 0; m < 4; ++m)
#pragma unroll
                for (int n = 0; n < 2; ++n) acc[a][b][m][n] = (f32x4){0.f, 0.f, 0.f, 0.f};
    bf16x8 At[4][2], B0[2][2], B1[2][2];
    const char* cA = (const char*)g.A + (size_t)cur.pm * tstep; const char* cB = (const char*)g.Bt + (size_t)cur.pn * tstep;
    S.a_ready(cur);
    if constexpr (SP2) {
        PG8_STAGE(PG8_SB(0, 0), cB, voffB); PG8_STAGE(PG8_SB(0, 1), cB + hstep, voffB); PG8_STAGE(PG8_SA(0, 0), cA, voffA); PG8_STAGE(PG8_SA(0, 1), cA + hstep, voffA);
        if (wr == 1) PG8_BAR;
        PG8_WAIT_V(2); PG8_BAR;
        PG8_STAGE(PG8_SB(1, 0), cB + kstep, voffB); PG8_STAGE(PG8_SA(1, 0), cA + kstep, voffA); PG8_STAGE(PG8_SB(1, 1), cB + hstep + kstep, voffB);
        PG8_WAIT_V(6); PG8_BAR;
    } else {
        PG8_STAGE(PG8_SB(0, 0), cB, voffB); PG8_STAGE(PG8_SA(0, 0), cA, voffA); PG8_STAGE(PG8_SB(0, 1), cB + hstep, voffB); PG8_STAGE(PG8_SA(0, 1), cA + hstep, voffA);
        if (wr == 1) PG8_BAR;
        PG8_WAIT_V(4); PG8_BAR;
        PG8_STAGE(PG8_SB(1, 0), cB + kstep, voffB); PG8_STAGE(PG8_SA(1, 0), cA + kstep, voffA); PG8_STAGE(PG8_SB(1, 1), cB + hstep + kstep, voffB);
        PG8_WAIT_V(6); PG8_BAR;
    }
    for (;;) {
        const bool has_next = S.next(ui + 1, nxt);
        const char* nA = has_next ? (const char*)g.A + (size_t)nxt.pm * tstep : cA; const char* nB = has_next ? (const char*)g.Bt + (size_t)nxt.pn * tstep : cB;
        for (int t = 0; t < nt; t += 2) {
            const bool last = (t == nt - 2);
            const char* a1 = cA + (size_t)(t + 1) * kstep;
            const char* a2 = last ? nA : cA + (size_t)(t + 2) * kstep; const char* b2 = last ? nB : cB + (size_t)(t + 2) * kstep;
            const char* a3 = a2 + kstep; const char* b3 = b2 + kstep;
            if (last && has_next) S.a_ready(nxt);
            if constexpr (SP2) {
            PG8_LDB(B0, 0, 0); PG8_LDB(B1, 0, 1); PG8_SCHED; PG8_LDA(At, 0, 0); PG8_STAGE(PG8_SA(1, 1), a1 + hstep, voffA);
            PG8_WAIT_V(8); PG8_WAIT_L(0); PG8_BAR; PG8_MMA(0, 0, At, B0); PG8_MMA(0, 1, At, B1); PG8_BAR; PG8_SCHED;
            PG8_LDA(At, 0, 1); PG8_STAGE(PG8_SB(0, 0), b2, voffB); PG8_STAGE(PG8_SB(0, 1), b2 + hstep, voffB); PG8_STAGE(PG8_SA(0, 0), a2, voffA);
            PG8_WAIT_V(8); PG8_WAIT_L(0); PG8_BAR; PG8_MMA(1, 0, At, B0); PG8_MMA(1, 1, At, B1); PG8_BAR; PG8_SCHED;
            PG8_LDB(B0, 1, 0); PG8_LDB(B1, 1, 1); PG8_SCHED; PG8_LDA(At, 1, 0); PG8_STAGE(PG8_SA(0, 1), a2 + hstep, voffA);
            PG8_WAIT_V(8); PG8_WAIT_L(0); PG8_BAR; PG8_MMA(0, 0, At, B0); PG8_MMA(0, 1, At, B1); PG8_BAR; PG8_SCHED;
            PG8_LDA(At, 1, 1); PG8_STAGE(PG8_SB(1, 0), b3, voffB); PG8_STAGE(PG8_SB(1, 1), b3 + hstep, voffB); PG8_STAGE(PG8_SA(1, 0), a3, voffA);
            PG8_WAIT_V(8); PG8_WAIT_L(0); PG8_BAR; PG8_MMA(1, 0, At, B0); PG8_MMA(1, 1, At, B1); PG8_BAR; PG8_SCHED;
            } else {
            PG8_LDB(B0, 0, 0); PG8_SCHED; PG8_LDA(At, 0, 0); PG8_STAGE(PG8_SA(1, 1), a1 + hstep, voffA);
            PG8_WAIT_L(8); PG8_BAR; PG8_WAIT_L(0); PG8_MMA(0, 0, At, B0); PG8_BAR; PG8_SCHED;
            PG8_LDB(B1, 0, 1); PG8_STAGE(PG8_SB(0, 0), b2, voffB);
            PG8_BAR; PG8_WAIT_L(0); PG8_MMA(0, 1, At, B1); PG8_BAR;
            PG8_LDA(At, 0, 1); PG8_STAGE(PG8_SA(0, 0), a2, voffA);
            PG8_BAR; PG8_WAIT_L(0); PG8_MMA(1, 0, At, B0); PG8_BAR; PG8_SCHED;
            PG8_STAGE(PG8_SB(0, 1), b2 + hstep, voffB);
            PG8_WAIT_V(6); PG8_BAR; PG8_MMA(1, 1, At, B1); PG8_BAR;
            PG8_LDB(B0, 1, 0); PG8_SCHED; PG8_LDA(At, 1, 0); PG8_STAGE(PG8_SA(0, 1), a2 + hstep, voffA);
            PG8_WAIT_L(8); PG8_BAR; PG8_WAIT_L(0); PG8_MMA(0, 0, At, B0); PG8_BAR; PG8_SCHED;
            PG8_LDB(B1, 1, 1); PG8_STAGE(PG8_SB(1, 0), b3, voffB);
            PG8_BAR; PG8_WAIT_L(0); PG8_MMA(0, 1, At, B1); PG8_BAR;
            PG8_LDA(At, 1, 1); PG8_STAGE(PG8_SA(1, 0), a3, voffA);
            PG8_BAR; PG8_WAIT_L(0); PG8_MMA(1, 0, At, B0); PG8_BAR; PG8_SCHED;
            PG8_STAGE(PG8_SB(1, 1), b3 + hstep, voffB);
            PG8_WAIT_V(6); PG8_BAR; PG8_MMA(1, 1, At, B1); PG8_BAR;
            }
        }
        if constexpr (ALIGN_EPI) { if (wr == 0) PG8_BAR; }
        if constexpr (!Epi::AFTER_DRAIN) { E(acc, cur, wr, wc, fr, fq); S.done(cur); }
        if (!has_next) break;
#pragma unroll
        for (int a = 0; a < 2; ++a)
#pragma unroll
            for (int b = 0; b < 2; ++b)
#pragma unroll
                for (int m = 0; m < 4; ++m)
#pragma unroll
                    for (int n = 0; n < 2; ++n) acc[a][b][m][n] = (f32x4){0.f, 0.f, 0.f, 0.f};
        cur = nxt; cA = nA; cB = nB; ++ui;
        if constexpr (ALIGN_EPI) { if (wr == 1) PG8_BAR; }
    }
    PG8_WAIT_V(0);
    if constexpr (!ALIGN_EPI) { if (wr == 0) PG8_BAR; }
    PG8_BAR;
    if constexpr (Epi::AFTER_DRAIN) { E.fused(acc, cur, wr, wc, fr, fq, lds, wid, lane); S.done(cur); }
#undef PG8_SA
#undef PG8_SB
#undef PG8_STAGE
#undef PG8_LDA
#undef PG8_LDB
#undef PG8_MMA
#undef PG8_WAIT_V
#undef PG8_WAIT_L
#undef PG8_BAR
#undef PG8_SCHED
}
}
#define GAS __attribute__((address_space(1)))
#define LAS __attribute__((address_space(3)))
typedef unsigned short bf16;
typedef unsigned v4u __attribute__((ext_vector_type(4)));
typedef unsigned v2u __attribute__((ext_vector_type(2)));
typedef float f32x4 __attribute__((ext_vector_type(4)));
typedef short bf16x8 __attribute__((ext_vector_type(8)));
#define LDS_WAIT() asm volatile("s_waitcnt lgkmcnt(0)" ::: "memory")
#define VM_WAIT() asm volatile("s_waitcnt vmcnt(0)" ::: "memory")

constexpr int DM = 2048, NB = 4, SEQ = 2048, NMETA = 16, MROWS = NB * SEQ, DPROJ = 6152, NPROJ = 6144;
constexpr int PADT = 2112, POS0 = 64, MPOS0 = 48;
constexpr float EPS = 1e-6f;
constexpr float LOG2E = 1.4426950408889634f;
constexpr float QSCALE = 0.08838834764831845f * LOG2E;
constexpr int NWAVES = 8, NTHR = 512;

constexpr size_t MiB = 1u << 20;
constexpr size_t WS_CTL = 0, CTL_ZERO_BYTES = 1 * MiB;
constexpr size_t WS_PM = 512 * 1024;
constexpr size_t WS_W1T = 2 * MiB, WS_W2T = 26 * MiB, WS_W3T = 34 * MiB, WS_XN = 42 * MiB;
constexpr size_t WS_Q = 74 * MiB, WS_KP = 90 * MiB, WS_VP = 107 * MiB, WS_MQ = 124 * MiB, WS_MK = 133 * MiB, WS_MV = 142 * MiB, WS_MO = 159 * MiB;
constexpr size_t WS_SMALL = 175 * MiB;
constexpr size_t WS_XM = WS_SMALL, WS_LI = WS_SMALL + 128 * 1024, WS_LF = WS_SMALL + 384 * 1024, WS_LAM = WS_SMALL + 640 * 1024;
constexpr size_t WS_PO = 176 * MiB, WS_ML = 304 * MiB, WS_HM = 305 * MiB, WS_A2 = 42 * MiB, WS_H1B = 74 * MiB, WS_SSQ = 106 * MiB, WS_S = 176 * MiB, WS_UB = 384 * MiB, WS_VB = 448 * MiB;
constexpr size_t WS_SCL = WS_SMALL + 704 * 1024;
constexpr size_t WS_VB8 = WS_UB + 32 * MiB;
constexpr size_t WS_DC = 305 * MiB, WS_CS = 448 * MiB, WS_DN = 482 * MiB, WS_NS = WS_DN + 512 * 1024, WS_GS = WS_DN + 1024 * 1024, WS_MS = WS_DN + 1152 * 1024;
constexpr int CW_BAR = 4096;

constexpr int RING_OFF = 0, RING_BYTES = 131072;
constexpr int XCH_OFF = 131072;
constexpr int MISC_OFF = XCH_OFF + 8192;
constexpr int LDS_BYTES = 155648;

__device__ __forceinline__ unsigned f2bf(float f) { unsigned u = __builtin_bit_cast(unsigned, f); return (u + 0x7fffu + ((u >> 16) & 1u)) >> 16; }
__device__ __forceinline__ unsigned pk2(float lo, float hi) { return f2bf(lo) | (f2bf(hi) << 16); }
__device__ __forceinline__ float bf2f(unsigned short u) { return __builtin_bit_cast(float, (unsigned)u << 16); }
__device__ __forceinline__ float bflo(unsigned w) { return __builtin_bit_cast(float, w << 16); }
__device__ __forceinline__ float bfhi(unsigned w) { return __builtin_bit_cast(float, w & 0xffff0000u); }
__device__ __forceinline__ float wave_sum(float v) {
#pragma unroll
  for (int o = 1; o < 64; o <<= 1) v += __shfl_xor(v, o);
  return v;
}
__device__ __forceinline__ size_t kp_off(int bhm, int pos, int d) { const int j = pos >> 6, row = pos & 63, d0 = d >> 4, hi = (d >> 3) & 1;
  return ((size_t)(bhm * 33 + j) * 8 + d0) * 1024 + (size_t)((((row << 1) | hi) ^ ((row >> 3) & 1)) << 3) + (d & 7); }
__device__ __forceinline__ float sigmoidf_(float x) { return 1.0f / (1.0f + __expf(-x)); }
#define XB_TMO      128
#define XB_XCNT(j)  (256  + 64 * (j))
#define XB_XSUB(j)  (1280 + 64 * (j))
#define XB_XGEN(j)  (2304 + 64 * (j))
#define XB_TOP      3328
#define XB_TOPGEN   3392
#define XCD_BAR_WORDS 3456
#define XB_SPIN_CAP (1u << 18)

__device__ __forceinline__ unsigned xb_ld(unsigned* p)              { return __hip_atomic_load(p, __ATOMIC_RELAXED, __HIP_MEMORY_SCOPE_AGENT); }
__device__ __forceinline__ unsigned xb_add(unsigned* p, unsigned v) { return __hip_atomic_fetch_add(p, v, __ATOMIC_RELAXED, __HIP_MEMORY_SCOPE_AGENT); }
__device__ __forceinline__ unsigned xb_xcc_id() { return (unsigned)__builtin_amdgcn_s_getreg((3 << 11) | 20) & 0xFu; }
#define XB_SPIN(cond, bar) do { unsigned _sp = 0; while (cond) { __builtin_amdgcn_s_sleep(1); \
    if ((++_sp & 255u) == 0u) { if (xb_ld(&(bar)[XB_TMO])) break; if (_sp > XB_SPIN_CAP) { atomicAdd(&(bar)[XB_TMO], 1u); break; } } } } while (0)

struct XcdBarrier {
    unsigned* bar; unsigned x;
    volatile LAS unsigned* st;
};

__device__ __forceinline__ XcdBarrier xcd_barrier_post(unsigned* bar, volatile LAS unsigned* st) {
    XcdBarrier b; b.bar = bar; b.x = xb_xcc_id(); b.st = st;
    if (threadIdx.x == 0) (void)xb_add(&bar[XB_XCNT(b.x)], 1u);
    return b;
}
__device__ __forceinline__ void xcd_barrier_complete(unsigned* bar, unsigned x, unsigned& nloc, unsigned& nx) {
    const unsigned G = gridDim.x * gridDim.y * gridDim.z;
    unsigned sum, cnt, mine, sp = 0u;
    for (;;) {
        sum = 0u; cnt = 0u; mine = 0u;
#pragma unroll
        for (unsigned j = 0; j < 16; ++j) { const unsigned c = xb_ld(&bar[XB_XCNT(j)]); sum += c; cnt += (c > 0u) ? 1u : 0u; mine = (j == x) ? c : mine; }
        if (sum == G) break;
        __builtin_amdgcn_s_sleep(1);
        if ((++sp & 255u) == 0u) { if (xb_ld(&bar[XB_TMO])) break; if (sp > XB_SPIN_CAP) { atomicAdd(&bar[XB_TMO], 1u); break; } }
    }
    nloc = mine > 0u ? mine : 1u; nx = cnt > 0u ? cnt : 1u;
}

__device__ __forceinline__ void xcd_barrier(const XcdBarrier& b) {
    asm volatile("s_waitcnt vmcnt(0)" ::: "memory");
    __syncthreads();
    if (threadIdx.x == 0) {
        unsigned* bar = b.bar;
        __builtin_amdgcn_s_waitcnt(0);
        unsigned nloc = b.st[0], nx = b.st[1];
        if (nloc == 0u) { xcd_barrier_complete(bar, b.x, nloc, nx); b.st[0] = nloc; b.st[1] = nx; }
        const unsigned old = xb_add(&bar[XB_XSUB(b.x)], 1u);
        const unsigned gen = old / nloc;
        if (old + 1u == (gen + 1u) * nloc) {
            __builtin_amdgcn_fence(__ATOMIC_RELEASE, "agent");
            asm volatile("s_waitcnt vmcnt(0)" ::: "memory");
            const unsigned og = xb_add(&bar[XB_TOP], 1u);
            const unsigned tg = og / nx;
            if (og + 1u == (tg + 1u) * nx) xb_add(&bar[XB_TOPGEN], 1u);
            else XB_SPIN(xb_ld(&bar[XB_TOPGEN]) == tg, bar);
            __builtin_amdgcn_fence(__ATOMIC_ACQUIRE, "agent");
            xb_add(&bar[XB_XGEN(b.x)], 1u);
            asm volatile("s_waitcnt vmcnt(0)" ::: "memory");
        } else {
            XB_SPIN(xb_ld(&bar[XB_XGEN(b.x)]) == gen, bar);
            __builtin_amdgcn_fence(__ATOMIC_ACQUIRE, "agent");
            asm volatile("s_waitcnt vmcnt(0)" ::: "memory");
        }
    }
    __syncthreads();
}

struct Args { const float* in[22]; float* out; unsigned char* ws; int ph_lo, ph_hi, na, pad; };
struct Frame {
  LAS unsigned char* lds; unsigned char* ws; int tid, lane, wave; const float* const* in;
};
#define IN_X 0
#define IN_META 1
#define IN_G1 2
#define IN_WIN 3
#define IN_CW 4
#define IN_CB 5
#define IN_IGB 6
#define IN_FGB 7
#define IN_LQ1 8
#define IN_LK1 9
#define IN_LQ2 10
#define IN_LK2 11
#define IN_QNG 12
#define IN_KNG 13
#define IN_SUBG 14
#define IN_OUTG 15
#define IN_WOUT 16
#define IN_G2 17
#define IN_WQ 18
#define IN_SUBK 19
#define IN_U 20
#define IN_V 21

__device__ __forceinline__ void p0_rows(const Frame& F, const Args& a) {
  const float* x = a.in[IN_X]; const float* meta = a.in[IN_META]; const float* g1 = a.in[IN_G1]; const float* w_in = a.in[IN_WIN];
  const float* igb = a.in[IN_IGB]; const float* fgb = a.in[IN_FGB];
  bf16* Xn = (bf16*)(F.ws + WS_XN); bf16* Xm = (bf16*)(F.ws + WS_XM); float* LI = (float*)(F.ws + WS_LI); float* LF = (float*)(F.ws + WS_LF);
  LAS f32x4* wgl = (LAS f32x4*)(F.lds);
  for (int e = F.tid; e < 4096; e += NTHR) {
    const int ln = e & 63, q = e >> 6, half = q & 1, j = (q >> 1) & 3, i = q >> 3;
    const int k = 4 * (i * 64 + ln) + j;
    wgl[e] = *(const f32x4*)(w_in + (size_t)k * DPROJ + NPROJ + 4 * half);
  }
  __syncthreads();
  const int gw = blockIdx.x * NWAVES + F.wave, NGW = gridDim.x * NWAVES, lane = F.lane;
  for (int task = gw; task < MROWS / 2 + NMETA / 2; task += NGW) {
    const bool ismeta = task >= MROWS / 2;
    const int r0 = ismeta ? (task - MROWS / 2) * 2 : task * 2;
    const float* src0 = (ismeta ? meta : x) + (size_t)r0 * DM;
    float rs[2];
    { float s0 = 0.f, s1 = 0.f;
#pragma unroll 2
      for (int i = 0; i < 8; ++i) { const f32x4 a0 = ((const f32x4*)src0)[i * 64 + lane], a1 = ((const f32x4*)(src0 + DM))[i * 64 + lane];
        s0 += (a0.x * a0.x + a0.y * a0.y) + (a0.z * a0.z + a0.w * a0.w); s1 += (a1.x * a1.x + a1.y * a1.y) + (a1.z * a1.z + a1.w * a1.w); }
      rs[0] = rsqrtf(wave_sum(s0) * (1.0f / DM) + EPS); rs[1] = rsqrtf(wave_sum(s1) * (1.0f / DM) + EPS); }
    float ga[2][8];
#pragma unroll
    for (int rr = 0; rr < 2; ++rr)
#pragma unroll
      for (int g = 0; g < 8; ++g) ga[rr][g] = 0.f;
    bf16* dst0 = (ismeta ? Xm : Xn) + (size_t)r0 * DM;
#pragma unroll 1
    for (int i = 0; i < 8; ++i) {
      const f32x4 g = ((const f32x4*)g1)[i * 64 + lane];
      f32x4 xn[2];
#pragma unroll
      for (int rr = 0; rr < 2; ++rr) { xn[rr] = ((const f32x4*)(src0 + (size_t)rr * DM))[i * 64 + lane] * g * rs[rr];
        v2u o; o.x = pk2(xn[rr].x, xn[rr].y); o.y = pk2(xn[rr].z, xn[rr].w); ((v2u*)(dst0 + (size_t)rr * DM))[i * 64 + lane] = o; }
#pragma unroll
      for (int j = 0; j < 4; ++j) {
        const f32x4 w0 = wgl[((i * 4 + j) * 2 + 0) * 64 + lane], w1 = wgl[((i * 4 + j) * 2 + 1) * 64 + lane];
#pragma unroll
        for (int rr = 0; rr < 2; ++rr) { const float xv = xn[rr][j];
          ga[rr][0] += xv * w0.x; ga[rr][1] += xv * w0.y; ga[rr][2] += xv * w0.z; ga[rr][3] += xv * w0.w;
          ga[rr][4] += xv * w1.x; ga[rr][5] += xv * w1.y; ga[rr][6] += xv * w1.z; ga[rr][7] += xv * w1.w; }
      }
    }
#pragma unroll
    for (int rr = 0; rr < 2; ++rr)
#pragma unroll
      for (int g = 0; g < 8; ++g) ga[rr][g] = wave_sum(ga[rr][g]);
    if (lane < 8) {
      const int rr = lane >> 2, h = lane & 3;
      float gi = 0.f, gf = 0.f;
#pragma unroll
      for (int q = 0; q < 2; ++q)
#pragma unroll
        for (int hh = 0; hh < 4; ++hh) if (q == rr && hh == h) { gi = ga[q][hh]; gf = ga[q][4 + hh]; }
      const float li = gi + igb[h]; const float fx = gf + fgb[h];
      const float lf = fminf(fx, 0.f) - log1pf(__expf(-fabsf(fx)));
      const int R = r0 + rr;
      if (!ismeta) { const int b = R >> 11, t = R & 2047; LI[(b * 4 + h) * PADT + POS0 + t] = li; LF[(b * 4 + h) * PADT + POS0 + t] = lf; }
      else { for (int b = 0; b < NB; ++b) { LI[(b * 4 + h) * PADT + MPOS0 + R] = li; LF[(b * 4 + h) * PADT + MPOS0 + R] = lf; } }
    }
  }
  __syncthreads();
}
__device__ __forceinline__ void p0_metaproj(const Frame& F, const Args& a) {
  const float* meta = a.in[IN_META]; const float* g1 = a.in[IN_G1]; const float* w_in = a.in[IN_WIN];
  float* PM = (float*)(F.ws + WS_PM);
  LAS float* xs = (LAS float*)(F.lds);
  LAS float* part = (LAS float*)(F.lds + 16384);
  const int q = F.tid >> 7, c = F.tid & 127;
  for (int task = blockIdx.x; task < NPROJ / 128; task += gridDim.x) {
    const int n = task * 128 + c;
    float acc[16];
#pragma unroll
    for (int m = 0; m < 16; ++m) acc[m] = 0.f;
#pragma unroll 1
    for (int kb = 0; kb < 8; ++kb) {
      __syncthreads();
#pragma unroll
      for (int i = 0; i < 8; ++i) { const int idx = F.tid + NTHR * i, qq = idx >> 10, kk = (idx >> 4) & 63, m = idx & 15; const int k = 512 * qq + 64 * kb + kk;
        xs[idx] = meta[(size_t)m * DM + k] * g1[k]; }
      __syncthreads();
#pragma unroll 4
      for (int kk = 0; kk < 64; ++kk) {
        const float w = w_in[(size_t)(512 * q + 64 * kb + kk) * DPROJ + n];
        const LAS f32x4* xp = (const LAS f32x4*)(xs + (q * 64 + kk) * 16);
#pragma unroll
        for (int t = 0; t < 4; ++t) { const f32x4 xv = xp[t]; acc[4 * t + 0] += xv.x * w; acc[4 * t + 1] += xv.y * w; acc[4 * t + 2] += xv.z * w; acc[4 * t + 3] += xv.w * w; }
      }
    }
#pragma unroll
    for (int m = 0; m < 16; ++m) part[(q * 16 + m) * 128 + c] = acc[m];
    __syncthreads();
    for (int e = F.tid; e < 16 * 128; e += NTHR) { const int m = e >> 7, cc = e & 127;
      PM[m * NPROJ + task * 128 + cc] = (part[(0 * 16 + m) * 128 + cc] + part[(1 * 16 + m) * 128 + cc]) + (part[(2 * 16 + m) * 128 + cc] + part[(3 * 16 + m) * 128 + cc]); }
  }
  __syncthreads();
}
__device__ __forceinline__ void p0_transpose(const Frame& F, const float* W, int ldw, int N, bf16* Wt) {
  LAS float* tl = (LAS float*)(F.lds);
  const int ntn = N / 64, ntask = ntn * 16;
  for (int task = blockIdx.x; task < ntask; task += gridDim.x) {
    const int nb = task % ntn, kb = task / ntn, n0 = nb * 64, k0 = kb * 128;
    __syncthreads();
#pragma unroll
    for (int i = 0; i < 4; ++i) { const int idx = F.tid + NTHR * i, kk = idx >> 4, c4 = idx & 15;
      const f32x4 w = *(const f32x4*)(W + (size_t)(k0 + kk) * ldw + n0 + 4 * c4);
      LAS float* d = tl + kk * 65 + 4 * c4; d[0] = w.x; d[1] = w.y; d[2] = w.z; d[3] = w.w; }
    __syncthreads();
    const int n = F.tid >> 3, kc = F.tid & 7;
    const LAS float* s = tl + (kc * 16) * 65 + n;
    v4u o0, o1;
    o0.x = pk2(s[0 * 65], s[1 * 65]); o0.y = pk2(s[2 * 65], s[3 * 65]); o0.z = pk2(s[4 * 65], s[5 * 65]); o0.w = pk2(s[6 * 65], s[7 * 65]);
    o1.x = pk2(s[8 * 65], s[9 * 65]); o1.y = pk2(s[10 * 65], s[11 * 65]); o1.z = pk2(s[12 * 65], s[13 * 65]); o1.w = pk2(s[14 * 65], s[15 * 65]);
    v4u* dp = (v4u*)(Wt + (size_t)(n0 + n) * DM + k0 + kc * 16);
    dp[0] = o0; dp[1] = o1;
  }
  __syncthreads();
}
__device__ __forceinline__ void p0_zero_vpad(const Frame& F) {
  bf16* Vp = (bf16*)(F.ws + WS_VP);
  const int per = MPOS0 * 256 / 8;
  for (int i = blockIdx.x * NTHR + F.tid; i < 16 * per; i += gridDim.x * NTHR) { const int bh = i / per, e = i % per;
    *(v4u*)(Vp + (size_t)bh * PADT * 256 + (size_t)e * 8) = (v4u){0u, 0u, 0u, 0u}; }
}
__device__ __forceinline__ void p0_lam(const Frame& F, const Args& a) {
  if (blockIdx.x == 0 && F.wave == 0) {
    const int l = F.lane;
    float s1 = a.in[IN_LQ1][l] * a.in[IN_LK1][l] + a.in[IN_LQ1][l + 64] * a.in[IN_LK1][l + 64];
    float s2 = a.in[IN_LQ2][l] * a.in[IN_LK2][l] + a.in[IN_LQ2][l + 64] * a.in[IN_LK2][l + 64];
    s1 = wave_sum(s1); s2 = wave_sum(s2);
    if (l == 0) *(float*)(F.ws + WS_LAM) = __expf(s1) - __expf(s2) + 0.2f;
  }
}

struct EpiProj {
  static constexpr bool PERM = true, AFTER_DRAIN = false;
  bf16 *Qb, *Kp, *Vp, *MQ, *MK, *MV, *MO; const float *qg, *kg; LAS float* xch;
  __device__ __forceinline__ void operator()(const pg8::f32x4 (&acc)[2][2][4][2], const pg8::Unit& u, int wr, int wc, int fr, int fq) const {
    const int pn = u.pn, b = u.pm >> 3, tb = (u.pm & 7) * 256 + wr * 64 + fr, d0 = wc * 32 + fq * 8;
    if (pn < 8) {
      const bool isk = pn >= 4; const int h = pn & 3;
      float ssq[2][4][2];
#pragma unroll
      for (int ai = 0; ai < 2; ++ai)
#pragma unroll
        for (int m = 0; m < 4; ++m)
#pragma unroll
          for (int bj = 0; bj < 2; ++bj) { float s = 0.f;
#pragma unroll
            for (int n = 0; n < 2; ++n) { const pg8::f32x4 x = acc[ai][bj][m][n]; s += (x[0] * x[0] + x[1] * x[1]) + (x[2] * x[2] + x[3] * x[3]); }
            s += __shfl_xor(s, 16); s += __shfl_xor(s, 32); ssq[ai][m][bj] = s;
            if (fq == 0) xch[((ai * 128 + wr * 64 + m * 16 + fr) * 2 + bj) * 4 + wc] = s; }
      asm volatile("s_waitcnt lgkmcnt(0)" ::: "memory"); __builtin_amdgcn_s_barrier(); asm volatile("" ::: "memory");
      const float* gp = (isk ? kg : qg) + d0; const f32x4 g0 = *(const f32x4*)gp, g1v = *(const f32x4*)(gp + 4);
      const float sc = isk ? 1.0f : QSCALE;
#pragma unroll
      for (int ai = 0; ai < 2; ++ai)
#pragma unroll
        for (int m = 0; m < 4; ++m)
#pragma unroll
          for (int bj = 0; bj < 2; ++bj) {
            const f32x4 p = *(const LAS f32x4*)(xch + ((ai * 128 + wr * 64 + m * 16 + fr) * 2 + bj) * 4);
            const float rs = rsqrtf(((p.x + p.y) + (p.z + p.w)) * (1.0f / 128.f) + EPS) * sc;
            const pg8::f32x4 v0 = acc[ai][bj][m][0], v1 = acc[ai][bj][m][1];
            v4u w; w.x = pk2(v0[0] * rs * g0.x, v0[1] * rs * g0.y); w.y = pk2(v0[2] * rs * g0.z, v0[3] * rs * g0.w);
            w.z = pk2(v1[0] * rs * g1v.x, v1[1] * rs * g1v.y); w.w = pk2(v1[2] * rs * g1v.z, v1[3] * rs * g1v.w);
            const int t = tb + ai * 128 + m * 16;
            bf16* dst = isk ? Kp + kp_off((b * 4 + h) * 2 + bj, POS0 + t, d0)
                            : Qb + ((size_t)((b * 4 + h) * 2 + bj) * SEQ + t) * 128 + d0;
            *(v4u*)dst = w; }
      return;
    }
#pragma unroll
    for (int ai = 0; ai < 2; ++ai)
#pragma unroll
      for (int m = 0; m < 4; ++m)
#pragma unroll
        for (int bj = 0; bj < 2; ++bj) {
          pg8::f32x4 v0 = acc[ai][bj][m][0], v1 = acc[ai][bj][m][1];
          const int t = tb + ai * 128 + m * 16;
          bf16* dst;
          if (pn < 12) { const int h = pn - 8; dst = Vp + ((size_t)(b * 4 + h) * PADT + POS0 + t) * 256 + bj * 128 + d0; }
          else if (pn < 16) { const int h = 2 * (pn & 1) + bj; dst = (pn >= 14 ? MK : MQ) + ((size_t)(b * 4 + h) * PADT + POS0 + t) * 128 + d0; }
          else if (pn < 20) { const int h = pn - 16; dst = MV + ((size_t)(b * 4 + h) * PADT + POS0 + t) * 256 + bj * 128 + d0; }
          else { dst = MO + (size_t)(b * SEQ + t) * 1024 + (pn - 20) * 256 + bj * 128 + d0;
#pragma unroll
            for (int j = 0; j < 4; ++j) { v0[j] = sigmoidf_(v0[j]); v1[j] = sigmoidf_(v1[j]); } }
          v4u w; w.x = pk2(v0[0], v0[1]); w.y = pk2(v0[2], v0[3]); w.z = pk2(v1[0], v1[1]); w.w = pk2(v1[2], v1[3]);
          *(v4u*)dst = w; }
  }
};
__device__ __forceinline__ void p1_meta_finalize(const Frame& F, const Args& a) {
  if (blockIdx.x >= NMETA) return;
  const int mrow = blockIdx.x, tid = F.tid, lane = F.lane, w = F.wave;
  const float* meta = a.in[IN_META] + (size_t)mrow * DM; const float* PM = (const float*)(F.ws + WS_PM) + (size_t)mrow * NPROJ;
  LAS float* red = (LAS float*)(F.lds + XCH_OFF);
  const f32x4 mv = ((const f32x4*)meta)[tid];
  float s = wave_sum((mv.x * mv.x + mv.y * mv.y) + (mv.z * mv.z + mv.w * mv.w));
  if (lane == 0) red[w] = s;
  __syncthreads();
  float tot = 0.f;
#pragma unroll
  for (int i = 0; i < 8; ++i) tot += red[i];
  const float rs = rsqrtf(tot * (1.0f / DM) + EPS);
  bf16* Kp = (bf16*)(F.ws + WS_KP); bf16* Vp = (bf16*)(F.ws + WS_VP); bf16* MQ = (bf16*)(F.ws + WS_MQ); bf16* MK = (bf16*)(F.ws + WS_MK); bf16* MV = (bf16*)(F.ws + WS_MV);
  const int pos = MPOS0 + mrow;
  {
    const float v0 = PM[1024 + w * 128 + lane] * rs, v1 = PM[1024 + w * 128 + lane + 64] * rs;
    const float rk = rsqrtf(wave_sum(v0 * v0 + v1 * v1) * (1.0f / 128.f) + EPS);
    const float* kg = a.in[IN_KNG];
    const unsigned short o0 = (unsigned short)f2bf(v0 * rk * kg[lane]), o1 = (unsigned short)f2bf(v1 * rk * kg[lane + 64]);
    for (int b = 0; b < NB; ++b) { const int bhm = (b * 4 + (w >> 1)) * 2 + (w & 1); Kp[kp_off(bhm, pos, lane)] = o0; Kp[kp_off(bhm, pos, lane + 64)] = o1; }
  }
  { const int c = tid * 2;
    const unsigned o = pk2(PM[2048 + c] * rs, PM[2048 + c + 1] * rs); const int h = c >> 8, e = c & 255;
    for (int b = 0; b < NB; ++b) *(unsigned*)(Vp + ((size_t)(b * 4 + h) * PADT + pos) * 256 + e) = o;
    const unsigned o2 = pk2(PM[3072 + c] * rs, PM[3072 + c + 1] * rs); const bool isk = c >= 512; const int cc = c & 511, hq = cc >> 7, d = cc & 127;
    for (int b = 0; b < NB; ++b) *(unsigned*)((isk ? MK : MQ) + ((size_t)(b * 4 + hq) * PADT + pos) * 128 + d) = o2;
    const unsigned o3 = pk2(PM[4096 + c] * rs, PM[4096 + c + 1] * rs);
    for (int b = 0; b < NB; ++b) *(unsigned*)(MV + ((size_t)(b * 4 + h) * PADT + pos) * 256 + e) = o3;
  }
  __syncthreads();
}

namespace att {
using f32x16 = __attribute__((ext_vector_type(16))) float;
using s16x4 = __attribute__((ext_vector_type(4))) short;
constexpr int STEPS_BHM = 152, NSTEPS = 32 * STEPS_BHM;
constexpr int SHM_V = 64 * 256 * 2, SHM_K = 64 * 128 * 2;
constexpr int LDS_V = 0, LDS_K = 2 * SHM_V, LDS_Q = LDS_K + SHM_K, LDS_WS = LDS_Q + 8 * 8192;
constexpr float THR2 = 8.0f;
#define KSWZ(row, colB) ((row) * 256 + ((colB) ^ (((row) & 7) << 4)))
#define SBAR() __builtin_amdgcn_sched_barrier(0)
__device__ __forceinline__ int crow(int r, int hi) { return (r & 3) + 8 * (r >> 2) + 4 * hi; }
__device__ __forceinline__ unsigned cvtpk(float lo, float hi) { unsigned r; asm volatile("v_cvt_pk_bf16_f32 %0, %1, %2" : "=v"(r) : "v"(lo), "v"(hi)); return r; }
__device__ __forceinline__ int qb_start(int qb) { return 2 * qb * qb + 3 * qb; }
__device__ __forceinline__ int chunk_of(int s, int NA) { return ((s + 1) * NA - 1) / NSTEPS; }

template <int OFF> __device__ __forceinline__ s16x4 tr_read(int vb) {
  s16x4 r; asm volatile("ds_read_b64_tr_b16 %0, %1 offset:%2" : "=&v"(r) : "v"(vb), "i"(OFF) : "memory"); return r;
}
constexpr int v_rd_off(int d0, int ks, int half) { return d0 * 512 + ks * 8192 + half * 4096; }
template <int D0> __device__ __forceinline__ void pv_one(f32x16& od, int vb, bf16x8 pa0, bf16x8 pa1, bf16x8 pa2, bf16x8 pa3) {
#define PK(L, H) (bf16x8){L[0], L[1], L[2], L[3], H[0], H[1], H[2], H[3]}
  { const s16x4 l0 = tr_read<v_rd_off(D0, 0, 0)>(vb), h0 = tr_read<v_rd_off(D0, 0, 1)>(vb), l1 = tr_read<v_rd_off(D0, 1, 0)>(vb), h1 = tr_read<v_rd_off(D0, 1, 1)>(vb);
    asm volatile("s_waitcnt lgkmcnt(0)" ::: "memory"); SBAR();
    od = __builtin_amdgcn_mfma_f32_32x32x16_bf16(pa0, PK(l0, h0), od, 0, 0, 0);
    od = __builtin_amdgcn_mfma_f32_32x32x16_bf16(pa1, PK(l1, h1), od, 0, 0, 0); }
  SBAR();
  { const s16x4 l2 = tr_read<v_rd_off(D0, 2, 0)>(vb), h2 = tr_read<v_rd_off(D0, 2, 1)>(vb), l3 = tr_read<v_rd_off(D0, 3, 0)>(vb), h3 = tr_read<v_rd_off(D0, 3, 1)>(vb);
    asm volatile("s_waitcnt lgkmcnt(0)" ::: "memory"); SBAR();
    od = __builtin_amdgcn_mfma_f32_32x32x16_bf16(pa2, PK(l2, h2), od, 0, 0, 0);
    od = __builtin_amdgcn_mfma_f32_32x32x16_bf16(pa3, PK(l3, h3), od, 0, 0, 0); }
#undef PK
}

__device__ __forceinline__ void segment(const Frame& F, int bhm, int qb, int j0, int j1, int slot) {
  const int tid = F.tid, wid = F.wave, lane = F.lane, r32 = lane & 31, hi = lane >> 5;
  const bf16* Qg = (const bf16*)(F.ws + WS_Q) + ((size_t)bhm * SEQ + qb * 256 + wid * 32 + r32) * 128 + hi * 8;
  const bf16* Kg = (const bf16*)(F.ws + WS_KP) + (size_t)bhm * 33 * 8192;
  const bf16* Vg = (const bf16*)(F.ws + WS_VP) + (size_t)(bhm >> 1) * PADT * 256;
  LAS unsigned char* lds = F.lds;
  LAS float* wsl = (LAS float*)(lds + LDS_WS) + wid * 64;
  const float slope2 = exp2f(-2.0f * (float)(((bhm >> 1) & 3) + 1)) * LOG2E;
  unsigned ksrc0, vsrc0;
  ksrc0 = (unsigned)tid * 16u;
  { const int a8 = tid >> 8, b = (tid >> 2) & 7, k = 8 * (b >> 2) + 4 * a8 + (b & 3), c = ((tid >> 5) & 7) * 32 + (tid & 3) * 8; vsrc0 = (unsigned)(k * 256 + c) * 2u; }
#define STAGE_K(j) do { const char* kt = (const char*)(Kg + (size_t)(j) * 8192); \
    _Pragma("unroll") for (int _i = 0; _i < 2; ++_i) __builtin_amdgcn_global_load_lds((const unsigned*)(kt + (ksrc0 + _i * 8192u)), (LAS unsigned*)(lds + LDS_K + _i * 8192 + wid * 1024), 16, 0, 0); } while (0)
#define STAGE_V(buf, j) do { const char* vt = (const char*)(Vg + (size_t)(j) * 64 * 256); \
    _Pragma("unroll") for (int _i = 0; _i < 4; ++_i) __builtin_amdgcn_global_load_lds((const unsigned*)(vt + (vsrc0 + _i * 8192u)), (LAS unsigned*)(lds + LDS_V + (buf) * SHM_V + _i * 8192 + wid * 1024), 16, 0, 0); } while (0)
  const int lt = (((r32 << 1) | hi) ^ ((r32 >> 3) & 1)) << 4;
  LAS unsigned char* Qs = lds + LDS_Q + wid * 8192;
#pragma unroll
  for (int d0 = 0; d0 < 8; ++d0) { const bf16x8 qv = *(const bf16x8*)(Qg + d0 * 16); *(LAS bf16x8*)(Qs + d0 * 1024 + lt) = qv; }
  const float hioff = slope2 * (float)(4 * hi);
  f32x16 o[8];
#pragma unroll
  for (int d = 0; d < 8; ++d)
#pragma unroll
    for (int r = 0; r < 16; ++r) o[d][r] = 0.f;
  float m_reg = -1e30f, l_reg = 0.f;
  const int vb0 = (int)(uintptr_t)(lds + LDS_V) + (((lane & 3) << 3) | (((lane >> 2) & 3) << 6) | (((lane >> 4) & 1) << 5) | (((lane >> 5) & 1) << 8));
  const int qrel = wid * 32 + r32;
  STAGE_K(j0); STAGE_V(0, j0);
  VM_WAIT(); __syncthreads();
  for (int j = j0; j < j1; ++j) {
    const int cur = (j - j0) & 1;
    if (j + 1 < j1) STAGE_V(cur ^ 1, j + 1);
    SBAR();
    f32x16 p0 = {}, p1 = {};
    { const LAS unsigned char* Ks = lds + LDS_K;
#pragma unroll
      for (int d0 = 0; d0 < 8; ++d0) {
        const bf16x8 b0 = *(const LAS bf16x8*)(Ks + d0 * 2048 + lt);
        const bf16x8 b1 = *(const LAS bf16x8*)(Ks + d0 * 2048 + 1024 + lt);
        const bf16x8 qf = *(const LAS bf16x8*)(Qs + d0 * 1024 + lt);
        p0 = __builtin_amdgcn_mfma_f32_32x32x16_bf16(b0, qf, p0, 0, 0, 0);
        p1 = __builtin_amdgcn_mfma_f32_32x32x16_bf16(b1, qf, p1, 0, 0, 0); } }
    asm volatile("s_waitcnt lgkmcnt(0)" ::: "memory"); __builtin_amdgcn_s_barrier(); asm volatile("" ::: "memory");
    if (j + 1 < j1) STAGE_K(j + 1);
    SBAR();
    if (j == 0) {
#pragma unroll
      for (int r = 0; r < 16; ++r) p0[r] = -INFINITY;
#pragma unroll
      for (int r = 0; r < 8; ++r) p1[r] = -INFINITY;
    }
    const int jb = j - (4 * qb + 1);
    if (jb >= 0) {
      const int kb = 64 * jb + 4 * hi;
#pragma unroll
      for (int r = 0; r < 16; ++r) { const int kv = kb + (r & 3) + 8 * (r >> 2); if (kv > qrel) p0[r] = -INFINITY; if (kv + 32 > qrel) p1[r] = -INFINITY; }
    }
    const float off0 = slope2 * (float)(64 * j) + hioff, off1 = off0 + 32.0f * slope2;
#pragma unroll
    for (int r = 0; r < 16; ++r) { const float sb = slope2 * (float)((r & 3) + 8 * (r >> 2)); p0[r] += sb; p1[r] += sb; }
    float pm0 = p0[0], pm1 = p1[0];
#pragma unroll
    for (int r = 1; r < 16; ++r) { pm0 = fmaxf(pm0, p0[r]); pm1 = fmaxf(pm1, p1[r]); }
    float pmax = fmaxf(pm0 + off0, pm1 + off1);
    { auto rr = __builtin_amdgcn_permlane32_swap(__float_as_uint(pmax), __float_as_uint(pmax), false, false);
      pmax = fmaxf(__uint_as_float(rr[0]), __uint_as_float(rr[1])); }
    float mn, alpha;
    if (__builtin_expect(__all(pmax - m_reg <= THR2), 1)) { mn = m_reg; alpha = 1.f; }
    else { mn = fmaxf(m_reg, pmax); alpha = __builtin_amdgcn_exp2f(m_reg - mn); m_reg = mn; }
    const float c0 = off0 - mn, c1 = off1 - mn;
    float ps = 0.f;
#pragma unroll
    for (int r = 0; r < 16; ++r) { p0[r] = __builtin_amdgcn_exp2f(p0[r] + c0); p1[r] = __builtin_amdgcn_exp2f(p1[r] + c1); ps += p0[r] + p1[r]; }
    { auto rr = __builtin_amdgcn_permlane32_swap(__float_as_uint(ps), __float_as_uint(ps), false, false);
      ps = __uint_as_float(rr[0]) + __uint_as_float(rr[1]); }
    l_reg = l_reg * alpha + ps;
    if (__any(alpha < 1.f)) { if (hi == 0) wsl[r32] = alpha; asm volatile("s_waitcnt lgkmcnt(0)" ::: "memory");
#pragma unroll
      for (int rg = 0; rg < 4; ++rg) { const f32x4 al = *(const LAS f32x4*)(wsl + 8 * rg + 4 * hi);
#pragma unroll
        for (int d = 0; d < 8; ++d) { o[d][4 * rg + 0] *= al.x; o[d][4 * rg + 1] *= al.y; o[d][4 * rg + 2] *= al.z; o[d][4 * rg + 3] *= al.w; }
        SBAR(); } }
    bf16x8 pa0, pa1, pa2, pa3;
#define PK4(P, BASE, OUT) do { unsigned a0 = cvtpk(P[BASE + 0], P[BASE + 1]), a1 = cvtpk(P[BASE + 2], P[BASE + 3]);   \
    unsigned b0 = cvtpk(P[BASE + 4], P[BASE + 5]), b1 = cvtpk(P[BASE + 6], P[BASE + 7]);                              \
    auto r0 = __builtin_amdgcn_permlane32_swap(a0, b0, false, false); auto r1 = __builtin_amdgcn_permlane32_swap(a1, b1, false, false); \
    v4u w = {r0[0], r1[0], r0[1], r1[1]}; OUT = *reinterpret_cast<bf16x8*>(&w); } while (0)
    PK4(p0, 0, pa0); PK4(p0, 8, pa1); PK4(p1, 0, pa2); PK4(p1, 8, pa3);
#undef PK4
    SBAR();
    { const int vb = vb0 + cur * SHM_V;
      pv_one<0>(o[0], vb, pa0, pa1, pa2, pa3); pv_one<1>(o[1], vb, pa0, pa1, pa2, pa3); pv_one<2>(o[2], vb, pa0, pa1, pa2, pa3); pv_one<3>(o[3], vb, pa0, pa1, pa2, pa3);
      pv_one<4>(o[4], vb, pa0, pa1, pa2, pa3); pv_one<5>(o[5], vb, pa0, pa1, pa2, pa3); pv_one<6>(o[6], vb, pa0, pa1, pa2, pa3); pv_one<7>(o[7], vb, pa0, pa1, pa2, pa3); }
    VM_WAIT(); __syncthreads();
  }
  { int lane2 = threadIdx.x & 63, slot2 = slot; asm volatile("" : "+v"(lane2), "+s"(slot2));
    const int r32e = lane2 & 31, hie = lane2 >> 5;
    float* PO = (float*)(F.ws + WS_PO) + (size_t)slot2 * 256 * 256; float* ML = (float*)(F.ws + WS_ML) + (size_t)slot2 * 512;
    LAS float* wse = (LAS float*)(F.lds + LDS_WS) + wid * 64;
    if (hie == 0) { wse[r32e] = l_reg; ML[(wid * 32 + r32e) * 2] = m_reg; ML[(wid * 32 + r32e) * 2 + 1] = l_reg; }
    asm volatile("s_waitcnt lgkmcnt(0)" ::: "memory");
    char* Ob = (char*)(PO + (size_t)(wid * 32) * 256);
    const unsigned lo = (unsigned)(4 * hie * 256 + r32e) * 4u;
#pragma unroll
    for (int r = 0; r < 16; ++r) { const int rowc = (r & 3) + 8 * (r >> 2); const float lv = wse[rowc + 4 * hie]; const float rl = lv > 0.f ? __builtin_amdgcn_rcpf(lv) : 0.f;
#pragma unroll
      for (int d0 = 0; d0 < 8; ++d0) *(float*)(Ob + (lo + (unsigned)(rowc * 256 + d0 * 32) * 4u)) = o[d0][r] * rl;
      SBAR(); } }
  __syncthreads();
#undef STAGE_K
#undef STAGE_V
}

__device__ __forceinline__ void phase(const Frame& F, int ca, int NA) {
  int s0 = (int)(((long)ca * NSTEPS) / NA); const int s1 = (int)(((long)(ca + 1) * NSTEPS) / NA);
  while (s0 < s1) {
    const int bhm = s0 / STEPS_BHM, rem = s0 - bhm * STEPS_BHM;
    int qb = 0;
#pragma unroll 1
    for (int q = 1; q < 8; ++q) if (rem >= qb_start(q)) qb = q;
    const int j0 = rem - qb_start(qb), nst = 4 * qb + 5;
    const int j1 = (j0 + (s1 - s0) < nst) ? j0 + (s1 - s0) : nst;
    const int slot = bhm * 16 + qb + chunk_of(s0, NA) - chunk_of(bhm * STEPS_BHM, NA);
    segment(F, bhm, qb, j0, j1, slot);
    s0 += j1 - j0;
  }
}
#undef KSWZ
#undef SBAR
}
namespace ml {
constexpr int QST = 136, TST = 72;
constexpr int L_RQ = 0, L_RK = 17152, L_QS = 34304, L_QW = 51712, L_KS = 69120, L_KWT = 86528, L_VT = 104960  , L_SP = 0  , L_G = 141824, L_CW = 143872;
constexpr int L_HT = 0;
constexpr int G_A = 0, G_M = 64, G_WI = 128, G_EM = 192, G_DEN = 256, G_WG = 320, G_SC = 384, G_N = 0;
constexpr int L_NV = L_CW + 5120;
constexpr int L_SSQ = L_KWT;
__device__ __forceinline__ float shfl_up_f(float v, int d) { return __shfl_up(v, d); }

__device__ __forceinline__ void load_cw(const Frame& F, const Args& a, int h) {
  LAS float* CW = (LAS float*)(F.lds + L_CW);
  for (int e = F.tid; e < 2 * 5 * 128; e += NTHR) { const int qk = e / 640, j = (e / 128) % 5, d = e & 127; const int ch = qk * 512 + h * 128 + d;
    CW[e] = j < 4 ? a.in[IN_CW][j * 1024 + ch] : a.in[IN_CB][ch]; }
}
__device__ __forceinline__ void load_raw(const Frame& F, const bf16* g, int pos0, int lds_off) {
  for (int p = F.tid; p < 67 * 16; p += NTHR) { const int row = p >> 4, ch = p & 15, pos = pos0 - 3 + row;
    v4u v = {0u, 0u, 0u, 0u}; if (pos >= MPOS0) v = *(const v4u*)(g + (size_t)pos * 128 + ch * 8);
    *(LAS v4u*)(F.lds + lds_off + row * 256 + ch * 16) = v; }
}
__device__ __forceinline__ void conv16(const Frame& F, int qk, int lds_off, int t, int d0, float (&y)[16]) {
  const LAS float* CW = (const LAS float*)(F.lds + L_CW);
#pragma unroll
  for (int e = 0; e < 16; ++e) y[e] = CW[(qk * 5 + 4) * 128 + d0 + e];
#pragma unroll
  for (int j = 0; j < 4; ++j) { const LAS v4u* rp = (const LAS v4u*)(F.lds + lds_off + (t + j) * 256 + d0 * 2); const v4u r0 = rp[0], r1 = rp[1];
    const LAS float* cw = CW + (qk * 5 + j) * 128 + d0;
    y[0] += cw[0] * bflo(r0.x); y[1] += cw[1] * bfhi(r0.x); y[2] += cw[2] * bflo(r0.y); y[3] += cw[3] * bfhi(r0.y); y[4] += cw[4] * bflo(r0.z); y[5] += cw[5] * bfhi(r0.z); y[6] += cw[6] * bflo(r0.w); y[7] += cw[7] * bfhi(r0.w);
    y[8] += cw[8] * bflo(r1.x); y[9] += cw[9] * bfhi(r1.x); y[10] += cw[10] * bflo(r1.y); y[11] += cw[11] * bfhi(r1.y); y[12] += cw[12] * bflo(r1.z); y[13] += cw[13] * bfhi(r1.z); y[14] += cw[14] * bflo(r1.w); y[15] += cw[15] * bfhi(r1.w); }
#pragma unroll
  for (int e = 0; e < 16; ++e) y[e] = y[e] / (1.0f + __expf(-y[e]));
}
__device__ __forceinline__ void load_vt(const Frame& F, const bf16* MVg, int pos0) {
#pragma unroll
  for (int i = 0; i < 4; ++i) { const int p = F.tid + NTHR * i, row = p >> 5, ch = p & 31; v4u v4 = {0u, 0u, 0u, 0u};
    if (pos0 + row >= MPOS0) v4 = *(const v4u*)(MVg + (size_t)(pos0 + row) * 256 + ch * 8);
    LAS bf16* vt = (LAS bf16*)(F.lds + L_VT) + (ch * 8) * TST + row;
    vt[0 * TST] = (bf16)(v4.x & 0xffff); vt[1 * TST] = (bf16)(v4.x >> 16); vt[2 * TST] = (bf16)(v4.y & 0xffff); vt[3 * TST] = (bf16)(v4.y >> 16);
    vt[4 * TST] = (bf16)(v4.z & 0xffff); vt[5 * TST] = (bf16)(v4.z >> 16); vt[6 * TST] = (bf16)(v4.w & 0xffff); vt[7 * TST] = (bf16)(v4.w >> 16); }
}

__device__ __forceinline__ void taskA(const Frame& F, const Args& a, int task) {
  const int bh = task >> 5, c = task & 31, h = bh & 3, tid = F.tid, w = F.wave, lane = F.lane, fr = lane & 15, kq = lane >> 4, pos0 = 64 * c;
  LAS unsigned char* lds = F.lds; LAS float* G = (LAS float*)(lds + L_G);
  const bf16* MKg = (const bf16*)(F.ws + WS_MK) + (size_t)bh * PADT * 128; const bf16* MVg = (const bf16*)(F.ws + WS_MV) + (size_t)bh * PADT * 256;
  __syncthreads();
  load_cw(F, a, h); load_raw(F, MKg, pos0, L_RK); load_vt(F, MVg, pos0);
  if (w == 0) {
    const bool dead = pos0 + lane < MPOS0;
    const float li = dead ? -1e30f : ((const float*)(F.ws + WS_LI))[bh * PADT + pos0 + lane], lf = dead ? 0.f : ((const float*)(F.ws + WS_LF))[bh * PADT + pos0 + lane];
    float bs = lf;
#pragma unroll
    for (int d = 1; d < 64; d <<= 1) { const float o = shfl_up_f(bs, d); if (lane >= d) bs += o; }
    const float av = li - bs; float mx = av;
#pragma unroll
    for (int o = 1; o < 64; o <<= 1) mx = fmaxf(mx, __shfl_xor(mx, o));
    G[G_WG + lane] = __expf(av - mx);
    if (lane == 63) { float* gs = (float*)(F.ws + WS_GS) + (size_t)(bh * 33 + c) * 2; gs[0] = bs; gs[1] = mx; }
  }
  __syncthreads();
  { const int t = tid >> 3, d0 = (tid & 7) * 16; float y[16]; conv16(F, 1, L_RK, t, d0, y);
    const float sw = 0.08838834764831845f * G[G_WG + t]; LAS bf16* kt = (LAS bf16*)(lds + L_KWT) + d0 * TST + t;
#pragma unroll
    for (int e = 0; e < 16; ++e) kt[e * TST] = (bf16)f2bf(y[e] * sw); }
  __syncthreads();
  f32x4* DCg = (f32x4*)(F.ws + WS_DC) + ((size_t)(bh * 32 + c) * 128) * 64;
#pragma unroll
  for (int jj = 0; jj < 2; ++jj) { const int j = 2 * w + jj;
    const bf16x8 bv0 = *(const LAS bf16x8*)(lds + L_VT + ((16 * j + fr) * TST + 8 * kq) * 2), bv1 = *(const LAS bf16x8*)(lds + L_VT + ((16 * j + fr) * TST + 32 + 8 * kq) * 2);
#pragma unroll
    for (int i = 0; i < 8; ++i) { f32x4 acc = {0.f, 0.f, 0.f, 0.f};
      const bf16x8 k0 = *(const LAS bf16x8*)(lds + L_KWT + ((16 * i + fr) * TST + 8 * kq) * 2), k1 = *(const LAS bf16x8*)(lds + L_KWT + ((16 * i + fr) * TST + 32 + 8 * kq) * 2);
      acc = __builtin_amdgcn_mfma_f32_16x16x32_bf16(k0, bv0, acc, 0, 0, 0); acc = __builtin_amdgcn_mfma_f32_16x16x32_bf16(k1, bv1, acc, 0, 0, 0);
      DCg[(size_t)(i * 16 + j) * 64 + lane] = acc; } }
  if (tid < 128) { const LAS v4u* kr = (const LAS v4u*)(lds + L_KWT + tid * TST * 2); float s = 0.f;
#pragma unroll
    for (int q = 0; q < 8; ++q) { const v4u x = kr[q]; s += (bflo(x.x) + bfhi(x.x)) + (bflo(x.y) + bfhi(x.y)) + (bflo(x.z) + bfhi(x.z)) + (bflo(x.w) + bfhi(x.w)); }
    ((float*)(F.ws + WS_DN))[(size_t)(bh * 32 + c) * 128 + tid] = s; }
}

__device__ __forceinline__ void scanB(const Frame& F) {
  const int gt = blockIdx.x * NTHR + F.tid, NT = gridDim.x * NTHR;
  const float* GS = (const float*)(F.ws + WS_GS);
  for (int g = gt; g < 16 * 8192; g += NT) { const int bh = g >> 13, r = g & 8191, i = r >> 10, j = (r >> 6) & 15, ln = r & 63;
    const f32x4* dc = (const f32x4*)(F.ws + WS_DC) + ((size_t)(bh * 32) * 128 + (i * 16 + j)) * 64 + ln;
    v2u* cs = (v2u*)(F.ws + WS_CS) + ((((size_t)bh * 33) * 4 + (i >> 1)) * 16 + j) * 64 * 2 + ln * 2 + (i & 1);
    f32x4 st = {0.f, 0.f, 0.f, 0.f}; float m = 0.f;
#pragma unroll 4
    for (int c = 0; c < 32; ++c) { const float bL = GS[(bh * 33 + c) * 2], ml = GS[(bh * 33 + c) * 2 + 1], me = fmaxf(m, ml);
      st = st * __expf(m - me) + dc[(size_t)c * 128 * 64] * __expf(ml - me); m = bL + me;
      v2u o; o.x = pk2(st.x, st.y); o.y = pk2(st.z, st.w); cs[(size_t)(c + 1) * 4 * 16 * 64 * 2] = o; } }
  for (int g = gt; g < 16 * 128; g += NT) { const int bh = g >> 7, d = g & 127; float n = 0.f, m = 0.f;
    for (int c = 0; c < 32; ++c) { const float bL = GS[(bh * 33 + c) * 2], ml = GS[(bh * 33 + c) * 2 + 1], me = fmaxf(m, ml);
      n = n * __expf(m - me) + ((const float*)(F.ws + WS_DN))[(size_t)(bh * 32 + c) * 128 + d] * __expf(ml - me); m = bL + me;
      ((float*)(F.ws + WS_NS))[(size_t)(bh * 33 + c + 1) * 128 + d] = n; if (d == 0) ((float*)(F.ws + WS_MS))[bh * 33 + c + 1] = m; } }
}

__device__ __forceinline__ void taskC(const Frame& F, const Args& a, int task) {
  const int bh = task >> 5, c = (task & 31) + 1, b = bh >> 2, h = bh & 3, tid = F.tid, w = F.wave, lane = F.lane, fr = lane & 15, kq = lane >> 4, pos0 = 64 * c;
  LAS unsigned char* lds = F.lds; LAS float* G = (LAS float*)(lds + L_G); LAS float* NV = (LAS float*)(lds + L_NV);
  const bf16* MQg = (const bf16*)(F.ws + WS_MQ) + (size_t)bh * PADT * 128; const bf16* MKg = (const bf16*)(F.ws + WS_MK) + (size_t)bh * PADT * 128;
  const bf16* MVg = (const bf16*)(F.ws + WS_MV) + (size_t)bh * PADT * 256;
  const float m = ((const float*)(F.ws + WS_MS))[bh * 33 + c];
  __syncthreads();
  load_cw(F, a, h); load_raw(F, MQg, pos0, L_RQ); load_raw(F, MKg, pos0, L_RK); load_vt(F, MVg, pos0);
  if (tid < 128) NV[tid] = ((const float*)(F.ws + WS_NS))[(size_t)(bh * 33 + c) * 128 + tid];
  if (w == 0) {
    const float li = ((const float*)(F.ws + WS_LI))[bh * PADT + pos0 + lane], lf = ((const float*)(F.ws + WS_LF))[bh * PADT + pos0 + lane];
    float bs = lf;
#pragma unroll
    for (int d = 1; d < 64; d <<= 1) { const float o = shfl_up_f(bs, d); if (lane >= d) bs += o; }
    const float av = li - bs; float cm = av;
#pragma unroll
    for (int d = 1; d < 64; d <<= 1) { const float o = shfl_up_f(cm, d); if (lane >= d) cm = fmaxf(cm, o); }
    const float Mt = fmaxf(m, cm);
    G[G_A + lane] = av; G[G_M + lane] = Mt; G[G_WI + lane] = __expf(m - Mt); G[G_EM + lane] = __expf(-(bs + Mt));
  }
  __syncthreads();
  { const int t = tid >> 3, d0 = (tid & 7) * 16; const float wi = G[G_WI + t]; float y[16];
    conv16(F, 0, L_RQ, t, d0, y);
    { v4u o0, o1, w0, w1;
      o0.x = pk2(y[0], y[1]); o0.y = pk2(y[2], y[3]); o0.z = pk2(y[4], y[5]); o0.w = pk2(y[6], y[7]); o1.x = pk2(y[8], y[9]); o1.y = pk2(y[10], y[11]); o1.z = pk2(y[12], y[13]); o1.w = pk2(y[14], y[15]);
      w0.x = pk2(y[0] * wi, y[1] * wi); w0.y = pk2(y[2] * wi, y[3] * wi); w0.z = pk2(y[4] * wi, y[5] * wi); w0.w = pk2(y[6] * wi, y[7] * wi);
      w1.x = pk2(y[8] * wi, y[9] * wi); w1.y = pk2(y[10] * wi, y[11] * wi); w1.z = pk2(y[12] * wi, y[13] * wi); w1.w = pk2(y[14] * wi, y[15] * wi);
      LAS v4u* qs = (LAS v4u*)(lds + L_QS + (t * QST + d0) * 2); qs[0] = o0; qs[1] = o1;
      LAS v4u* qw = (LAS v4u*)(lds + L_QW + (t * QST + d0) * 2); qw[0] = w0; qw[1] = w1; }
    __builtin_amdgcn_sched_barrier(0);
    conv16(F, 1, L_RK, t, d0, y);
    { const float sc = 0.08838834764831845f; v4u o0, o1;
      o0.x = pk2(y[0] * sc, y[1] * sc); o0.y = pk2(y[2] * sc, y[3] * sc); o0.z = pk2(y[4] * sc, y[5] * sc); o0.w = pk2(y[6] * sc, y[7] * sc);
      o1.x = pk2(y[8] * sc, y[9] * sc); o1.y = pk2(y[10] * sc, y[11] * sc); o1.z = pk2(y[12] * sc, y[13] * sc); o1.w = pk2(y[14] * sc, y[15] * sc);
      LAS v4u* ks = (LAS v4u*)(lds + L_KS + (t * QST + d0) * 2); ks[0] = o0; ks[1] = o1; } }
  __syncthreads();
  v4u cb[4][2];
  { const v4u* cs = (const v4u*)(F.ws + WS_CS) + (((size_t)bh * 33 + c) * 4 * 16) * 64;
#pragma unroll
    for (int I = 0; I < 4; ++I)
#pragma unroll
      for (int jj = 0; jj < 2; ++jj) cb[I][jj] = cs[(size_t)(I * 16 + 2 * w + jj) * 64 + lane]; }
  { const int si = w >> 1; const f32x4 as = *(const LAS f32x4*)(G + G_A + 16 * si + 4 * kq);
#pragma unroll
    for (int tt = 0; tt < 2; ++tt) { const int ti = 2 * (w & 1) + tt; f32x4 acc = {0.f, 0.f, 0.f, 0.f};
#pragma unroll
      for (int ks = 0; ks < 4; ++ks) { const bf16x8 af = *(const LAS bf16x8*)(lds + L_KS + ((16 * si + fr) * QST + 32 * ks + 8 * kq) * 2);
        const bf16x8 bfr = *(const LAS bf16x8*)(lds + L_QS + ((16 * ti + fr) * QST + 32 * ks + 8 * kq) * 2);
        acc = __builtin_amdgcn_mfma_f32_16x16x32_bf16(af, bfr, acc, 0, 0, 0); }
      const int t = 16 * ti + fr, s0 = 16 * si + 4 * kq; const float Mt = G[G_M + t];
      const float v0 = (s0 + 0 <= t) ? acc.x * __expf(as.x - Mt) : 0.f, v1 = (s0 + 1 <= t) ? acc.y * __expf(as.y - Mt) : 0.f;
      const float v2 = (s0 + 2 <= t) ? acc.z * __expf(as.z - Mt) : 0.f, v3 = (s0 + 3 <= t) ? acc.w * __expf(as.w - Mt) : 0.f;
      v2u o; o.x = pk2(v0, v1); o.y = pk2(v2, v3);
      *(LAS v2u*)(lds + L_SP + (t * TST + s0) * 2) = o; } }
  __syncthreads();
  if (w == 0) { const int t = lane; float qn = 0.f, rsum = 0.f;
#pragma unroll 4
    for (int q = 0; q < 16; ++q) { const v4u x = *(const LAS v4u*)(lds + L_QS + (t * QST + q * 8) * 2); const f32x4 n0 = *(const LAS f32x4*)(NV + q * 8), n1 = *(const LAS f32x4*)(NV + q * 8 + 4);
      qn += bflo(x.x) * n0.x + bfhi(x.x) * n0.y + bflo(x.y) * n0.z + bfhi(x.y) * n0.w + bflo(x.z) * n1.x + bfhi(x.z) * n1.y + bflo(x.w) * n1.z + bfhi(x.w) * n1.w; }
#pragma unroll
    for (int q = 0; q < 8; ++q) { const v4u x = *(const LAS v4u*)(lds + L_SP + (t * TST + q * 8) * 2); rsum += (bflo(x.x) + bfhi(x.x)) + (bflo(x.y) + bfhi(x.y)) + (bflo(x.z) + bfhi(x.z)) + (bflo(x.w) + bfhi(x.w)); }
    const float den = G[G_WI + t] * qn + rsum; G[G_DEN + t] = fmaxf(fabsf(den), G[G_EM + t]); }
  f32x4 acc[2][4];
#pragma unroll
  for (int jj = 0; jj < 2; ++jj)
#pragma unroll
    for (int ti = 0; ti < 4; ++ti) acc[jj][ti] = (f32x4){0.f, 0.f, 0.f, 0.f};
#pragma unroll
  for (int I = 0; I < 4; ++I) {
#pragma unroll
    for (int ti = 0; ti < 4; ++ti) { const LAS unsigned char* qp = lds + L_QW + ((16 * ti + fr) * QST + 32 * I + 4 * kq) * 2;
      const v2u a0 = *(const LAS v2u*)qp, a1 = *(const LAS v2u*)(qp + 32); const v4u av = {a0.x, a0.y, a1.x, a1.y};
      acc[0][ti] = __builtin_amdgcn_mfma_f32_16x16x32_bf16(__builtin_bit_cast(bf16x8, av), __builtin_bit_cast(bf16x8, cb[I][0]), acc[0][ti], 0, 0, 0);
      acc[1][ti] = __builtin_amdgcn_mfma_f32_16x16x32_bf16(__builtin_bit_cast(bf16x8, av), __builtin_bit_cast(bf16x8, cb[I][1]), acc[1][ti], 0, 0, 0); }
    __builtin_amdgcn_sched_barrier(0); }
#pragma unroll
  for (int ks = 0; ks < 2; ++ks) { const bf16x8 bv0 = *(const LAS bf16x8*)(lds + L_VT + ((32 * w + fr) * TST + 32 * ks + 8 * kq) * 2), bv1 = *(const LAS bf16x8*)(lds + L_VT + ((32 * w + 16 + fr) * TST + 32 * ks + 8 * kq) * 2);
#pragma unroll
    for (int ti = 0; ti < 4; ++ti) { const bf16x8 sf = *(const LAS bf16x8*)(lds + L_SP + ((16 * ti + fr) * TST + 32 * ks + 8 * kq) * 2);
      acc[0][ti] = __builtin_amdgcn_mfma_f32_16x16x32_bf16(sf, bv0, acc[0][ti], 0, 0, 0); acc[1][ti] = __builtin_amdgcn_mfma_f32_16x16x32_bf16(sf, bv1, acc[1][ti], 0, 0, 0); } }
  __syncthreads();
  LAS float* SSQ = (LAS float*)(lds + L_SSQ);
#pragma unroll
  for (int ti = 0; ti < 4; ++ti) { const f32x4 dn = *(const LAS f32x4*)(G + G_DEN + 16 * ti + 4 * kq);
    f32x4 s4;
#pragma unroll
    for (int r = 0; r < 4; ++r) { const float h0 = acc[0][ti][r] / dn[r], h1 = acc[1][ti][r] / dn[r]; acc[0][ti][r] = h0; acc[1][ti][r] = h1; s4[r] = h0 * h0 + h1 * h1; }
#pragma unroll
    for (int o = 1; o < 16; o <<= 1) { s4.x += __shfl_xor(s4.x, o); s4.y += __shfl_xor(s4.y, o); s4.z += __shfl_xor(s4.z, o); s4.w += __shfl_xor(s4.w, o); }
    if (fr == 0) { SSQ[(16 * ti + 4 * kq + 0) * 8 + w] = s4.x; SSQ[(16 * ti + 4 * kq + 1) * 8 + w] = s4.y; SSQ[(16 * ti + 4 * kq + 2) * 8 + w] = s4.z; SSQ[(16 * ti + 4 * kq + 3) * 8 + w] = s4.w; } }
  __syncthreads();
  LAS bf16* HT = (LAS bf16*)(lds + L_HT);
#pragma unroll
  for (int ti = 0; ti < 4; ++ti)
#pragma unroll
    for (int r = 0; r < 4; ++r) { const int t = 16 * ti + 4 * kq + r; const f32x4 p0 = *(const LAS f32x4*)(SSQ + t * 8), p1 = *(const LAS f32x4*)(SSQ + t * 8 + 4);
      const float rh = rsqrtf(((p0.x + p0.y) + (p0.z + p0.w) + (p1.x + p1.y) + (p1.z + p1.w)) * (1.0f / 256.f) + EPS);
      HT[t * 264 + 32 * w + fr] = (bf16)f2bf(acc[0][ti][r] * rh); HT[t * 264 + 32 * w + 16 + fr] = (bf16)f2bf(acc[1][ti][r] * rh); }
  __syncthreads();
  { const int t = tid >> 3, c0 = (tid & 7) * 32; const size_t R = (size_t)b * SEQ + 64 * (c - 1) + t;
    const bf16* mo = (const bf16*)(F.ws + WS_MO) + R * 1024 + h * 256 + c0; const float* og = a.in[IN_OUTG] + h * 256 + c0; bf16* A2 = (bf16*)(F.ws + WS_A2) + R * DM + 1024 + h * 256 + c0;
#pragma unroll
    for (int q = 0; q < 4; ++q) { const v4u hv = *(const LAS v4u*)(HT + t * 264 + c0 + q * 8); const v4u mv = *(const v4u*)(mo + q * 8); const f32x4 g0 = *(const f32x4*)(og + q * 8), g1 = *(const f32x4*)(og + q * 8 + 4);
      v4u o; o.x = pk2(bflo(hv.x) * g0.x * bflo(mv.x), bfhi(hv.x) * g0.y * bfhi(mv.x)); o.y = pk2(bflo(hv.y) * g0.z * bflo(mv.y), bfhi(hv.y) * g0.w * bfhi(mv.y));
      o.z = pk2(bflo(hv.z) * g1.x * bflo(mv.z), bfhi(hv.z) * g1.y * bfhi(mv.z)); o.w = pk2(bflo(hv.w) * g1.z * bflo(mv.w), bfhi(hv.w) * g1.w * bfhi(mv.w));
      *(v4u*)(A2 + q * 8) = o; } }
}
}
__device__ __forceinline__ void p3_combine(const Frame& F, const Args& a, int NA) {
  const float* PO = (const float*)(F.ws + WS_PO); const float* ML = (const float*)(F.ws + WS_ML);
  bf16* A2 = (bf16*)(F.ws + WS_A2);
  const float lam = *(const float*)(F.ws + WS_LAM);
  const float* subg = a.in[IN_SUBG];
  const int gw = blockIdx.x * NWAVES + F.wave, NGW = gridDim.x * NWAVES, lane = F.lane;
  const f32x4 sg = ((const f32x4*)subg)[lane];
  for (int R = gw; R < MROWS; R += NGW) {
    const int b = R >> 11, t = R & 2047, qb = t >> 8, rq = t & 255;
#pragma unroll 1
    for (int h = 0; h < 4; ++h) {
      f32x4 om[2];
#pragma unroll
      for (int m = 0; m < 2; ++m) {
        const int bhm = (b * 4 + h) * 2 + m, first = bhm * att::STEPS_BHM + att::qb_start(qb), last = first + 4 * qb + 4;
        const int cf = att::chunk_of(first, NA), np = att::chunk_of(last, NA) - cf + 1, slot0 = bhm * 16 + qb + cf - att::chunk_of(bhm * att::STEPS_BHM, NA);
        float mp[3], lp[3]; f32x4 op[3];
#pragma unroll
        for (int p = 0; p < 3; ++p) { if (p < np) { const int slot = slot0 + p; mp[p] = ML[(size_t)slot * 512 + rq * 2]; lp[p] = ML[(size_t)slot * 512 + rq * 2 + 1];
            op[p] = ((const f32x4*)(PO + ((size_t)slot * 256 + rq) * 256))[lane]; } else { mp[p] = -1e30f; lp[p] = 0.f; op[p] = (f32x4){0.f, 0.f, 0.f, 0.f}; } }
        const float M = fmaxf(mp[0], fmaxf(mp[1], mp[2]));
        float wsum = 0.f; f32x4 acc = (f32x4){0.f, 0.f, 0.f, 0.f};
#pragma unroll
        for (int p = 0; p < 3; ++p) { const float w = lp[p] * exp2f(mp[p] - M); wsum += w; acc += op[p] * w; }
        om[m] = acc * (1.0f / wsum);
      }
      const f32x4 o = om[0] - om[1] * lam;
      const float rs = rsqrtf(wave_sum((o.x * o.x + o.y * o.y) + (o.z * o.z + o.w * o.w)) * (1.0f / 256.f) + EPS) * 0.8f;
      v2u w; w.x = pk2(o.x * rs * sg.x, o.y * rs * sg.y); w.y = pk2(o.z * rs * sg.z, o.w * rs * sg.w);
      ((v2u*)(A2 + (size_t)R * DM + h * 256))[lane] = w;
    }
  }
}
struct EpiRes {
  static constexpr bool PERM = true, AFTER_DRAIN = false;
  const float* x; float* out; bf16* H1b; float* SSQ;
  __device__ __forceinline__ void operator()(const pg8::f32x4 (&acc)[2][2][4][2], const pg8::Unit& u, int wr, int wc, int fr, int fq) const {
    const int row0 = u.pm * 256 + wr * 64 + fr, col0 = u.pn * 256 + wc * 32 + 8 * fq;
#pragma unroll
    for (int ai = 0; ai < 2; ++ai)
#pragma unroll
      for (int m = 0; m < 4; ++m) { const size_t R = (size_t)(row0 + ai * 128 + m * 16); float s = 0.f;
#pragma unroll
        for (int bj = 0; bj < 2; ++bj) { const size_t off = R * DM + col0 + bj * 128;
          const f32x4 x0 = *(const f32x4*)(x + off), x1 = *(const f32x4*)(x + off + 4);
          const f32x4 v0 = acc[ai][bj][m][0] + x0, v1 = acc[ai][bj][m][1] + x1;
          *(f32x4*)(out + off) = v0; *(f32x4*)(out + off + 4) = v1;
          v4u w; w.x = pk2(v0.x, v0.y); w.y = pk2(v0.z, v0.w); w.z = pk2(v1.x, v1.y); w.w = pk2(v1.z, v1.w);
          *(v4u*)(H1b + off) = w;
          s += (v0.x * v0.x + v0.y * v0.y) + (v0.z * v0.z + v0.w * v0.w) + (v1.x * v1.x + v1.y * v1.y) + (v1.z * v1.z + v1.w * v1.w); }
        s += __shfl_xor(s, 16); s += __shfl_xor(s, 32);
        if (fq == 0) SSQ[R * 32 + u.pn * 4 + wc] = s; }
  }
};
#ifndef PEER_U_FP8
#define PEER_U_FP8 0
#endif
typedef __bf16 bfv2 __attribute__((ext_vector_type(2)));
__device__ __forceinline__ void split_hl(const f32x4 a, const f32x4 b, bf16x8& hi, bf16x8& lo) {
  float v[8] = {a.x, a.y, a.z, a.w, b.x, b.y, b.z, b.w}; unsigned h[8], l[8];
#pragma unroll
  for (int i = 0; i < 8; ++i) { h[i] = f2bf(v[i]); l[i] = f2bf(v[i] - __builtin_bit_cast(float, h[i] << 16)); }
  v4u hv = {h[0] | (h[1] << 16), h[2] | (h[3] << 16), h[4] | (h[5] << 16), h[6] | (h[7] << 16)};
  v4u lv = {l[0] | (l[1] << 16), l[2] | (l[3] << 16), l[4] | (l[5] << 16), l[6] | (l[7] << 16)};
  hi = __builtin_bit_cast(bf16x8, hv); lo = __builtin_bit_cast(bf16x8, lv);
}
__device__ __forceinline__ void p0_w3t(const Frame& F, const Args& a) {
  const float* wq = a.in[IN_WQ]; const float* sk = a.in[IN_SUBK]; const float* g2 = a.in[IN_G2];
  bf16* W3t = (bf16*)(F.ws + WS_W3T);
  const int gw = blockIdx.x * NWAVES + F.wave, NGW = gridDim.x * NWAVES, lane = F.lane, fr = lane & 15, fq = lane >> 4;
  for (int task = gw; task < 128 * 16; task += NGW) {
    const int kt = task >> 4, hh = task & 15;
    bf16x8 ahi[4], alo[4];
    const float* ap = wq + (size_t)(kt * 16 + fr) * DM + hh * 128 + fq * 8;
#pragma unroll
    for (int s = 0; s < 4; ++s) split_hl(*(const f32x4*)(ap + 32 * s), *(const f32x4*)(ap + 32 * s + 4), ahi[s], alo[s]);
    const f32x4 gk = *(const f32x4*)(g2 + kt * 16 + fq * 4);
#pragma unroll 1
    for (int t2 = 0; t2 < 8; ++t2) {
      const float* bp = sk + (size_t)(hh * 128 + t2 * 16 + fr) * 128 + fq * 8;
      f32x4 acc = {0.f, 0.f, 0.f, 0.f};
#pragma unroll
      for (int s = 0; s < 4; ++s) { bf16x8 bhi, blo; split_hl(*(const f32x4*)(bp + 32 * s), *(const f32x4*)(bp + 32 * s + 4), bhi, blo);
        acc = __builtin_amdgcn_mfma_f32_16x16x32_bf16(ahi[s], bhi, acc, 0, 0, 0);
        acc = __builtin_amdgcn_mfma_f32_16x16x32_bf16(ahi[s], blo, acc, 0, 0, 0);
        acc = __builtin_amdgcn_mfma_f32_16x16x32_bf16(alo[s], bhi, acc, 0, 0, 0); }
      v2u o; o.x = pk2(acc.x * gk.x, acc.y * gk.y); o.y = pk2(acc.z * gk.z, acc.w * gk.w);
      *(v2u*)(W3t + (size_t)(hh * 128 + t2 * 16 + fr) * DM + kt * 16 + fq * 4) = o;
    }
  }
}
typedef float f32x2v __attribute__((ext_vector_type(2)));
__device__ __forceinline__ void p0_tables(const Frame& F, const Args& a) {
  const float* g2 = a.in[IN_G2];
  unsigned char* T8 = F.ws + WS_UB; float* SCL = (float*)(F.ws + WS_SCL);
  const int gw = blockIdx.x * NWAVES + F.wave, NGW = gridDim.x * NWAVES, lane = F.lane;
  for (int row = gw; row < 2 * 16384; row += NGW) {
    const bool isv = row >= 16384; const int e = row & 16383;
    {
      const float* src = a.in[isv ? IN_V : IN_U] + (size_t)e * DM + lane * 32;
      f32x4 x[8]; float amax = 0.f;
#pragma unroll
      for (int q = 0; q < 8; ++q) { x[q] = *(const f32x4*)(src + q * 4); if (!isv) x[q] = x[q] * *(const f32x4*)(g2 + lane * 32 + q * 4); amax = fmaxf(amax, fmaxf(fmaxf(fabsf(x[q].x), fabsf(x[q].y)), fmaxf(fabsf(x[q].z), fabsf(x[q].w)))); }
#pragma unroll
      for (int o = 1; o < 64; o <<= 1) amax = fmaxf(amax, __shfl_xor(amax, o));
      const float sc = amax > 0.f ? 6.0f / amax : 1.0f;
      v4u w;
#pragma unroll
      for (int d = 0; d < 4; ++d) { unsigned pk = 0u;
        pk = __builtin_amdgcn_cvt_scalef32_pk_fp4_f32(pk, x[2 * d].x * sc, x[2 * d].y * sc, 1.0f, 0); pk = __builtin_amdgcn_cvt_scalef32_pk_fp4_f32(pk, x[2 * d].z * sc, x[2 * d].w * sc, 1.0f, 1);
        pk = __builtin_amdgcn_cvt_scalef32_pk_fp4_f32(pk, x[2 * d + 1].x * sc, x[2 * d + 1].y * sc, 1.0f, 2); pk = __builtin_amdgcn_cvt_scalef32_pk_fp4_f32(pk, x[2 * d + 1].z * sc, x[2 * d + 1].w * sc, 1.0f, 3);
        w[d] = pk; }
      if (PEER_U_FP8 && !isv) {
        const float s8 = amax > 0.f ? exp2f(floorf(log2f(224.0f / amax))) : 1.0f; v4u w0, w1;
#pragma unroll
        for (int q = 0; q < 4; ++q) { int pk = 0; pk = __builtin_amdgcn_cvt_pk_fp8_f32(x[q].x * s8, x[q].y * s8, pk, false); pk = __builtin_amdgcn_cvt_pk_fp8_f32(x[q].z * s8, x[q].w * s8, pk, true); w0[q] = (unsigned)pk; }
#pragma unroll
        for (int q = 0; q < 4; ++q) { int pk = 0; pk = __builtin_amdgcn_cvt_pk_fp8_f32(x[4 + q].x * s8, x[4 + q].y * s8, pk, false); pk = __builtin_amdgcn_cvt_pk_fp8_f32(x[4 + q].z * s8, x[4 + q].w * s8, pk, true); w1[q] = (unsigned)pk; }
        v4u* dp = (v4u*)(F.ws + WS_UB + (size_t)e * 2048 + lane * 32); dp[0] = w0; dp[1] = w1;
        if (lane == 0) SCL[row] = 1.0f / s8;
        continue;
      }
      *(v4u*)(F.ws + (isv ? WS_VB8 : WS_UB) + (size_t)e * 1024 + lane * 16) = w;
      if (lane == 0) SCL[row] = 1.0f / sc;
    }
  }
}
struct EpiScore {
  static constexpr bool PERM = true, AFTER_DRAIN = false;
  float* S; const LAS float* rs;
  __device__ __forceinline__ void operator()(const pg8::f32x4 (&acc)[2][2][4][2], const pg8::Unit& u, int wr, int wc, int fr, int fq) const {
    const int rl0 = wr * 64 + fr, col0 = u.pn * 256 + wc * 32 + 8 * fq;
#pragma unroll
    for (int ai = 0; ai < 2; ++ai)
#pragma unroll
      for (int m = 0; m < 4; ++m) { const int rl = rl0 + ai * 128 + m * 16; const float r = rs[rl]; const size_t R = (size_t)u.pm * 256 + rl;
#pragma unroll
        for (int bj = 0; bj < 2; ++bj) { float* d = S + R * DM + col0 + bj * 128;
          *(f32x4*)d = acc[ai][bj][m][0] * r; *(f32x4*)(d + 4) = acc[ai][bj][m][1] * r; } }
  }
};

__device__ __forceinline__ unsigned fkey(float f) { const unsigned b = __builtin_bit_cast(unsigned, f); return b ^ ((b >> 31) ? 0xFFFFFFFFu : 0x80000000u); }
template <int NV, int K> __device__ __forceinline__ void wave_topk(const unsigned (&u)[NV], bool (&sel)[NV], int lane) {
  unsigned prefix = 0u; int cge = NV * 64;
#pragma unroll 1
  for (int bit = 31; bit >= 0 && cge != K; --bit) {
    const unsigned cand = prefix | (1u << bit); int c = 0;
#pragma unroll
    for (int i = 0; i < NV; ++i) c += __builtin_popcountll(__ballot(u[i] >= cand));
    if (c >= K) { prefix = cand; cge = c; }
  }
  int cgt = 0;
#pragma unroll
  for (int i = 0; i < NV; ++i) cgt += __builtin_popcountll(__ballot(u[i] > prefix));
  int need = K - cgt;
  const unsigned long long lm = (1ull << lane) - 1ull;
#pragma unroll
  for (int i = 0; i < NV; ++i) { const unsigned long long eq = __ballot(u[i] == prefix); const int before = __builtin_popcountll(eq & lm);
    sel[i] = (u[i] > prefix) || (u[i] == prefix && before < need); const int ne = __builtin_popcountll(eq); need = need > ne ? need - ne : 0; }
}
template <int NG, int NV, int K> __device__ __forceinline__ void wave_topk_multi(const unsigned (&u)[NG][NV], bool (&sel)[NG][NV], int lane) {
  unsigned prefix[NG]; int cge[NG];
#pragma unroll
  for (int g = 0; g < NG; ++g) { prefix[g] = 0u; cge[g] = NV * 64; }
#pragma unroll 1
  for (int bit = 31; bit >= 0; --bit) {
    bool done = true;
#pragma unroll
    for (int g = 0; g < NG; ++g) done = done && (cge[g] == K);
    if (done) break;
#pragma unroll
    for (int g = 0; g < NG; ++g) { const unsigned cand = prefix[g] | (1u << bit); int c = 0;
#pragma unroll
      for (int i = 0; i < NV; ++i) c += __builtin_popcountll(__ballot(u[g][i] >= cand));
      if (cge[g] != K && c >= K) { prefix[g] = cand; cge[g] = c; } }
  }
  const unsigned long long lm = (1ull << lane) - 1ull;
#pragma unroll
  for (int g = 0; g < NG; ++g) { int cgt = 0;
#pragma unroll
    for (int i = 0; i < NV; ++i) cgt += __builtin_popcountll(__ballot(u[g][i] > prefix[g]));
    int need = K - cgt;
#pragma unroll
    for (int i = 0; i < NV; ++i) { const unsigned long long eq = __ballot(u[g][i] == prefix[g]); const int before = __builtin_popcountll(eq & lm);
      sel[g][i] = (u[g][i] > prefix[g]) || (u[g][i] == prefix[g] && before < need); const int ne = __builtin_popcountll(eq); need = need > ne ? need - ne : 0; } }
}
__device__ __forceinline__ float gelu_erf(float v) {
  const float av = fabsf(v), t = __builtin_amdgcn_rcpf(1.0f + 0.2316418882f * av);
  float q = t * 0.5307027145f - 0.7265760135f; q = q * t + 0.7107068705f; q = q * t - 0.142248368f; q = q * t + 0.127414796f; q = q * t;
  const float tail = q * __builtin_amdgcn_exp2f(v * v * -0.72134752044f);
  return v < 0.f ? v * tail : v - v * tail;
}
__device__ __forceinline__ float wave_sum_dpp(float v) {
  v += __builtin_bit_cast(float, __builtin_amdgcn_update_dpp(0, __builtin_bit_cast(int, v), 0xB1, 0xF, 0xF, true));
  v += __builtin_bit_cast(float, __builtin_amdgcn_update_dpp(0, __builtin_bit_cast(int, v), 0x4E, 0xF, 0xF, true));
  v += __builtin_bit_cast(float, __builtin_amdgcn_update_dpp(0, __builtin_bit_cast(int, v), 0x141, 0xF, 0xF, true));
  v += __builtin_bit_cast(float, __builtin_amdgcn_update_dpp(0, __builtin_bit_cast(int, v), 0x140, 0xF, 0xF, true));
  const float r0 = __builtin_bit_cast(float, __builtin_amdgcn_readlane(__builtin_bit_cast(int, v), 0)), r1 = __builtin_bit_cast(float, __builtin_amdgcn_readlane(__builtin_bit_cast(int, v), 16));
  const float r2 = __builtin_bit_cast(float, __builtin_amdgcn_readlane(__builtin_bit_cast(int, v), 32)), r3 = __builtin_bit_cast(float, __builtin_amdgcn_readlane(__builtin_bit_cast(int, v), 48));
  return (r0 + r1) + (r2 + r3);
}

#ifndef ROUTE_REPS
#define ROUTE_REPS 1
#endif
__device__ __forceinline__ void p6_peer(const Frame& F, const Args& a, float* dst_base) {
  const float* S = (const float*)(F.ws + WS_S); const float* SSQ = (const float*)(F.ws + WS_SSQ); const bf16* H1b = (const bf16*)(F.ws + WS_H1B);
  float* out = a.out;
  int lane = F.lane, wv = F.wave; asm volatile("" : "+v"(lane), "+s"(wv));
  const int gw = blockIdx.x * NWAVES + wv, NGW = gridDim.x * NWAVES;
  LAS unsigned char* RB = F.lds + 12288 + wv * 16384;
  LAS float* wl = (LAS float*)RB;
  LAS int* wli = (LAS int*)wl;
  LAS int* eid = (LAS int*)(F.lds + wv * 1536); LAS float* egt = (LAS float*)(eid + 128); LAS float* esu = (LAS float*)(eid + 256);
  for (int tok = gw; tok < MROWS; tok += NGW) {
    const float rs = rsqrtf(wave_sum(lane < 32 ? SSQ[(size_t)tok * 32 + lane] : 0.f) * (1.0f / DM) + EPS);
    const float* srow = S + (size_t)tok * DM;
    const unsigned long long lmk = (1ull << lane) - 1ull;
#pragma unroll 1
    for (int gb = 0; gb < 4 * ROUTE_REPS; ++gb) {
      const int g0 = (gb & 3) * 4;
      float2 sv[4]; unsigned u[4][2]; bool sel[4][2];
#pragma unroll
      for (int q = 0; q < 4; ++q) { sv[q] = *(const float2*)(srow + (g0 + q) * 128 + 2 * lane); u[q][0] = fkey(sv[q].x); u[q][1] = fkey(sv[q].y); }
      wave_topk_multi<4, 2, 16>(u, sel, lane);
#pragma unroll
      for (int q = 0; q < 4; ++q) { const unsigned long long m0 = __ballot(sel[q][0]), m1 = __ballot(sel[q][1]);
        const int pos0 = __builtin_popcountll(m0 & lmk), pos1 = __builtin_popcountll(m0) + __builtin_popcountll(m1 & lmk);
        if (sel[q][0]) { wl[(g0 + q) * 16 + pos0] = sv[q].x; wli[256 + (g0 + q) * 16 + pos0] = 2 * lane; }
        if (sel[q][1]) { wl[(g0 + q) * 16 + pos1] = sv[q].y; wli[256 + (g0 + q) * 16 + pos1] = 2 * lane + 1; } }
    }
    asm volatile("s_waitcnt lgkmcnt(0)" ::: "memory");
    const int ci = lane >> 2, cj = 4 * (lane & 3);
#pragma unroll 1
    for (int hb = 0; hb < 2 * ROUTE_REPS; ++hb) {
      const int h0 = (hb & 1) * 4;
      float cv[4][4]; unsigned cu[4][4]; bool csel[4][4];
#pragma unroll
      for (int hq = 0; hq < 4; ++hq) { const int h8 = h0 + hq; const float s0 = wl[(2 * h8) * 16 + ci]; const f32x4 s1 = *(const LAS f32x4*)(wl + (2 * h8 + 1) * 16 + cj);
        cv[hq][0] = s0 + s1.x; cv[hq][1] = s0 + s1.y; cv[hq][2] = s0 + s1.z; cv[hq][3] = s0 + s1.w;
#pragma unroll
        for (int q = 0; q < 4; ++q) cu[hq][q] = fkey(cv[hq][q]); }
      wave_topk_multi<4, 4, 16>(cu, csel, lane);
#pragma unroll
      for (int hq = 0; hq < 4; ++hq) { const int h8 = h0 + hq;
        float mx = -INFINITY;
#pragma unroll
        for (int q = 0; q < 4; ++q) if (csel[hq][q]) mx = fmaxf(mx, cv[hq][q]);
#pragma unroll
        for (int o = 1; o < 64; o <<= 1) mx = fmaxf(mx, __shfl_xor(mx, o));
        float ev[4], es = 0.f;
#pragma unroll
        for (int q = 0; q < 4; ++q) { ev[q] = csel[hq][q] ? __expf(cv[hq][q] - mx) : 0.f; es += ev[q]; }
        es = wave_sum(es); const float inv = 1.0f / es;
        typedef int i32x4 __attribute__((ext_vector_type(4)));
        const int ki = wli[256 + (2 * h8) * 16 + ci]; const i32x4 kj = *(const LAS i32x4*)(wli + 256 + (2 * h8 + 1) * 16 + cj);
        const int kjv[4] = {kj.x, kj.y, kj.z, kj.w};
        int base = 0;
#pragma unroll
        for (int q = 0; q < 4; ++q) { const unsigned long long mq = __ballot(csel[hq][q]); const int pos = base + __builtin_popcountll(mq & lmk);
          if (csel[hq][q]) { eid[h8 * 16 + pos] = ki * 128 + kjv[q]; egt[h8 * 16 + pos] = ev[q] * inv; } base += __builtin_popcountll(mq); } }
    }
    asm volatile("s_waitcnt lgkmcnt(0)" ::: "memory");
    { const float* SCL = (const float*)(F.ws + WS_SCL);
#pragma unroll
      for (int i = 0; i < 2; ++i) { const int e = lane + 64 * i, idq = eid[e]; esu[e] = SCL[idq]; egt[e] *= SCL[16384 + idq]; } }
    unsigned xw[16];
    { const v4u* xp = (const v4u*)(H1b + (size_t)tok * DM + (size_t)lane * 32);
#pragma unroll
      for (int q = 0; q < 4; ++q) { const v4u x0 = xp[q]; xw[4 * q] = x0.x; xw[4 * q + 1] = x0.y; xw[4 * q + 2] = x0.z; xw[4 * q + 3] = x0.w; } }
    float y[32];
#pragma unroll
    for (int i = 0; i < 32; ++i) y[i] = 0.f;
    asm volatile("s_waitcnt vmcnt(0) lgkmcnt(0)" ::: "memory");
    const unsigned char* U8 = F.ws + WS_UB; const unsigned char* V8 = F.ws + WS_VB8;
#define PG_ISSUE(E) do { const int idq_ = __builtin_amdgcn_readfirstlane(eid[(E)]); LAS unsigned char* sl_ = RB + ((E) & 7) * 2048; \
      __builtin_amdgcn_global_load_lds((const unsigned*)(U8 + (size_t)idq_ * 1024 + lane * 16), (LAS unsigned*)sl_, 16, 0, 0); \
      __builtin_amdgcn_global_load_lds((const unsigned*)(V8 + (size_t)idq_ * 1024 + lane * 16), (LAS unsigned*)(sl_ + 1024), 16, 0, 0); } while (0)
#define PG_DOT(UW, DACC) do { float da_ = 0.f, db_ = 0.f; _Pragma("unroll") for (int dd = 0; dd < 4; ++dd) { const unsigned wa = UW[dd]; \
          da_ = __builtin_amdgcn_fdot2_f32_bf16(__builtin_bit_cast(bfv2, xw[4 * dd + 0]), __builtin_amdgcn_cvt_scalef32_pk_bf16_fp4(wa, 1.0f, 0), da_, false); \
          db_ = __builtin_amdgcn_fdot2_f32_bf16(__builtin_bit_cast(bfv2, xw[4 * dd + 1]), __builtin_amdgcn_cvt_scalef32_pk_bf16_fp4(wa, 1.0f, 1), db_, false); \
          da_ = __builtin_amdgcn_fdot2_f32_bf16(__builtin_bit_cast(bfv2, xw[4 * dd + 2]), __builtin_amdgcn_cvt_scalef32_pk_bf16_fp4(wa, 1.0f, 2), da_, false); \
          db_ = __builtin_amdgcn_fdot2_f32_bf16(__builtin_bit_cast(bfv2, xw[4 * dd + 3]), __builtin_amdgcn_cvt_scalef32_pk_bf16_fp4(wa, 1.0f, 3), db_, false); } DACC = da_ + db_; } while (0)
#define PG_AXPY(VW, CF) do { _Pragma("unroll") for (int dd = 0; dd < 4; ++dd) { const unsigned wa = VW[dd]; \
          { const f32x2v v2 = __builtin_amdgcn_cvt_scalef32_pk_f32_fp4(wa, 1.0f, 0); y[8 * dd + 0] += CF * v2.x; y[8 * dd + 1] += CF * v2.y; } \
          { const f32x2v v2 = __builtin_amdgcn_cvt_scalef32_pk_f32_fp4(wa, 1.0f, 1); y[8 * dd + 2] += CF * v2.x; y[8 * dd + 3] += CF * v2.y; } \
          { const f32x2v v2 = __builtin_amdgcn_cvt_scalef32_pk_f32_fp4(wa, 1.0f, 2); y[8 * dd + 4] += CF * v2.x; y[8 * dd + 5] += CF * v2.y; } \
          { const f32x2v v2 = __builtin_amdgcn_cvt_scalef32_pk_f32_fp4(wa, 1.0f, 3); y[8 * dd + 6] += CF * v2.x; y[8 * dd + 7] += CF * v2.y; } } } while (0)
#define PG_CONSUME(E) do { const LAS unsigned char* s0_ = RB + ((E) & 7) * 2048 + lane * 16; \
      const v4u u0 = *(const LAS v4u*)s0_, v0 = *(const LAS v4u*)(s0_ + 1024); \
      float d0 = 0.f; PG_DOT(u0, d0); d0 = wave_sum_dpp(d0); \
      const float c0 = gelu_erf(d0 * (rs * esu[(E)])) * egt[(E)]; \
      PG_AXPY(v0, c0); } while (0)
#pragma unroll
    for (int e = 0; e < 7; ++e) PG_ISSUE(e);
#pragma unroll 1
    for (int e = 0; e < 121; ++e) {
      PG_ISSUE(e + 7);
      asm volatile("s_waitcnt vmcnt(14)" ::: "memory");
      PG_CONSUME(e);
      asm volatile("" ::: "memory");
    }
    asm volatile("s_waitcnt vmcnt(0)" ::: "memory");
#pragma unroll 1
    for (int e = 121; e < 128; ++e) PG_CONSUME(e);
    asm volatile("s_waitcnt lgkmcnt(0)" ::: "memory");
#undef PG_ISSUE
#undef PG_DOT
#undef PG_AXPY
#undef PG_CONSUME
    float* orow = out + (size_t)tok * DM; float* drow = dst_base + (size_t)tok * DM;
#pragma unroll
    for (int q = 0; q < 8; ++q) { const size_t off = (size_t)lane * 32 + q * 4; f32x4 hv = *(const f32x4*)(orow + off);
      hv.x += y[4 * q]; hv.y += y[4 * q + 1]; hv.z += y[4 * q + 2]; hv.w += y[4 * q + 3]; *(f32x4*)(drow + off) = hv; }
  }
}
constexpr int MISC_LDS = LDS_BYTES - 256;
__global__ void __launch_bounds__(NTHR, 2) mk_fwd(Args args) {
  extern __shared__ __attribute__((aligned(16))) unsigned char lds_raw[];
  Frame F; F.lds = (LAS unsigned char*)lds_raw; F.ws = args.ws; F.tid = threadIdx.x; F.lane = F.tid & 63; F.wave = __builtin_amdgcn_readfirstlane(F.tid >> 6);
  const int lo = args.ph_lo, hi = args.ph_hi, G = (int)gridDim.x, bx = (int)blockIdx.x;
  volatile LAS unsigned* misc = (volatile LAS unsigned*)(F.lds + MISC_LDS);
  if (F.tid < 16) misc[F.tid] = 0u;
  __syncthreads();
  XcdBarrier bar = xcd_barrier_post((unsigned*)(F.ws + WS_CTL) + CW_BAR, misc);
#define IN(k) (lo <= (k) && (k) < hi)
#define SEAM(k) do { if (IN(k) && IN((k) + 1)) xcd_barrier(bar); } while (0)
#define PHASE_FRAME(Fp) Frame Fp = F; asm volatile("" : "+v"(Fp.tid), "+v"(Fp.lane))
  const int NA = G;
  if (IN(0)) { PHASE_FRAME(F0);
    p0_lam(F0, args);
    p0_zero_vpad(F0);
    p0_metaproj(F0, args);
    p0_rows(F0, args);
    p0_transpose(F0, args.in[IN_WIN], DPROJ, NPROJ, (bf16*)(F.ws + WS_W1T));
    p0_transpose(F0, args.in[IN_WOUT], DM, DM, (bf16*)(F.ws + WS_W2T));
    p0_w3t(F0, args);
    p0_tables(F0, args);
  }
  SEAM(0);
  if (IN(1)) { PHASE_FRAME(F1);
    p1_meta_finalize(F1, args);
    pg8::Gemm g{(const pg8::bf16_t*)(F.ws + WS_XN), (const pg8::bf16_t*)(F.ws + WS_W1T), MROWS, NPROJ, DM};
    pg8::StaticOrder S; S.init(MROWS, NPROJ, G, bx);
    EpiProj E{(bf16*)(F.ws + WS_Q), (bf16*)(F.ws + WS_KP), (bf16*)(F.ws + WS_VP), (bf16*)(F.ws + WS_MQ), (bf16*)(F.ws + WS_MK), (bf16*)(F.ws + WS_MV), (bf16*)(F.ws + WS_MO),
              args.in[IN_QNG], args.in[IN_KNG], (LAS float*)(F.lds + XCH_OFF)};
    pg8::gemm_phase<EpiProj, pg8::StaticOrder, true, true>(F.lds + RING_OFF, g, S, E);
  }
  SEAM(1);
  if (IN(2)) {
    PHASE_FRAME(F2);
    att::phase(F2, (G % 8 == 0) ? (bx & 7) * (G >> 3) + (bx >> 3) : bx, NA);
    for (int task = bx; task < 512; task += G) ml::taskA(F2, args, task);
  }
  SEAM(2);
  if (IN(3)) { PHASE_FRAME(F3); ml::scanB(F3); }
  SEAM(3);
  if (IN(4)) {
    PHASE_FRAME(F4);
    for (int task = bx; task < 512; task += G) ml::taskC(F4, args, task);
    p3_combine(F4, args, NA);
  }
  SEAM(4);
  if (IN(5)) {
    pg8::Gemm g{(const pg8::bf16_t*)(F.ws + WS_A2), (const pg8::bf16_t*)(F.ws + WS_W2T), MROWS, DM, DM};
    pg8::StaticOrder S; S.init(MROWS, DM, G, bx);
    EpiRes E{args.in[IN_X], args.out, (bf16*)(F.ws + WS_H1B), (float*)(F.ws + WS_SSQ)};
    pg8::gemm_phase<EpiRes, pg8::StaticOrder, true, true>(F.lds + RING_OFF, g, S, E);
  }
  SEAM(5);
  if (IN(6)) {
    pg8::Gemm g{(const pg8::bf16_t*)(F.ws + WS_H1B), (const pg8::bf16_t*)(F.ws + WS_W3T), MROWS, DM, DM};
    pg8::StaticOrder S; S.init(MROWS, DM, G, bx);
    LAS float* rst = (LAS float*)(F.lds + XCH_OFF);
    { pg8::Unit u0; if (S.next(0, u0)) { if (F.tid < 256) { const float* sp = (const float*)(F.ws + WS_SSQ) + ((size_t)u0.pm * 256 + F.tid) * 32; float s = 0.f;
#pragma unroll
          for (int i = 0; i < 8; ++i) { const f32x4 v = ((const f32x4*)sp)[i]; s += (v.x + v.y) + (v.z + v.w); }
          rst[F.tid] = rsqrtf(s * (1.0f / DM) + EPS); } } }
    __syncthreads();
    EpiScore E{(float*)(F.ws + WS_S), rst};
    pg8::gemm_phase<EpiScore, pg8::StaticOrder, true, true>(F.lds + RING_OFF, g, S, E);
  }
  SEAM(6);
  if (IN(7)) { PHASE_FRAME(F7); p6_peer(F7, args, args.out); }
#undef IN
#undef SEAM
}
extern "C" void kernel_launch(void* const* d_in, const int* in_sizes, int n_in, void* d_out, int out_size, void* d_ws, size_t ws_size, hipStream_t stream) {
  static int grid = 0;
  if (grid == 0) {
    int dev = 0, cus = 0, per_cu = 0;
    if (hipGetDevice(&dev) != hipSuccess || hipDeviceGetAttribute(&cus, hipDeviceAttributeMultiprocessorCount, dev) != hipSuccess) { fprintf(stderr, "device query failed\n"); grid = -1; return; }
    if (hipFuncSetAttribute((const void*)mk_fwd, hipFuncAttributeMaxDynamicSharedMemorySize, LDS_BYTES) != hipSuccess) { fprintf(stderr, "hipFuncSetAttribute failed\n"); grid = -1; return; }
    if (hipOccupancyMaxActiveBlocksPerMultiprocessor(&per_cu, (const void*)mk_fwd, NTHR, LDS_BYTES) != hipSuccess || per_cu < 1) { fprintf(stderr, "occupancy query says %d workgroups per CU: not launching\n", per_cu); (void)hipGetLastError(); grid = -1; return; }
    (void)hipGetLastError();
    grid = cus;
    if (n_in != 22 || ws_size < (size_t)512 * MiB || out_size != MROWS * DM) { fprintf(stderr, "unexpected shapes: n_in %d out %d ws %zu\n", n_in, out_size, ws_size); grid = -1; return; }
  }
  if (grid < 0) return;
  unsigned char* ws = (unsigned char*)d_ws;
  if (hipMemsetAsync(ws + WS_CTL, 0, CTL_ZERO_BYTES, stream) != hipSuccess) { fprintf(stderr, "memset failed\n"); return; }
  Args a{};
  for (int i = 0; i < 22; ++i) a.in[i] = (const float*)d_in[i];
  a.out = (float*)d_out; a.ws = ws; a.na = 0; a.pad = 0;
  a.ph_lo = 0; a.ph_hi = 8;
  hipLaunchKernelGGL(mk_fwd, dim3(grid), dim3(NTHR), LDS_BYTES, stream, a);
}
```

```cpp
#include <hip/hip_runtime.h>
#include <cstdio>
#include <cstdint>
#include <math.h>
namespace pg8 {
#define PG8_LAS __attribute__((address_space(3)))
typedef unsigned short bf16_t;
typedef short bf16x8 __attribute__((ext_vector_type(8)));
typedef float f32x4 __attribute__((ext_vector_type(4)));
typedef unsigned u32x4 __attribute__((ext_vector_type(4)));
constexpr int BM = 256, BK = 64, HALF = 128, HTB = HALF * BK * 2  , STAGE_BYTES = 8 * HTB, NXCD = 8, WGM = 8;

__host__ __device__ __forceinline__ int lds_byte(int r, int c) { const int st = (r >> 4) * 2 + (c >> 5), rr = r & 15, cc = c & 31, ob = rr * 64 + cc * 2; return st * 1024 + (ob ^ (((ob >> 9) & 1) << 5)); }
__host__ __device__ __forceinline__ void stage_rc(int b, int& R, int& C) { const int st = b / 1024, sb = b % 1024, swz = sb ^ (((sb >> 9) & 1) << 5); R = (st >> 1) * 16 + swz / 64; C = (st & 1) * 32 + (swz % 64) / 2; }
__host__ __device__ __forceinline__ int perm32(int rho) { const int n = rho >> 4, i = rho & 15; return 8 * (i >> 2) + 4 * n + (i & 3); }

struct Unit { int pm, pn; };
struct Gemm { const bf16_t* A; const bf16_t* Bt; int M, N, K; };

struct StaticOrder {
    int nM, nN, nwg, G, c;
    __host__ __device__ void init(int M, int N, int G_, int c_) { nM = M / BM; nN = N / BM; nwg = nM * nN; G = G_; c = c_; }
    __host__ __device__ bool next(int i, Unit& u) const {
        const long L = (long)i * G + c; if (L >= nwg) return false;
        int wgid = (int)L; { const int q = nwg / NXCD, r = nwg % NXCD, xcd = wgid % NXCD, off = wgid / NXCD; wgid = (xcd < r ? xcd * (q + 1) : r * (q + 1) + (xcd - r) * q) + off; }
        const int nig = WGM * nN, gid = wgid / nig, fm = gid * WGM, gsz = (nM - fm) < WGM ? (nM - fm) : WGM;
        u.pm = fm + ((wgid % nig) % gsz); u.pn = (wgid % nig) / gsz; return true;
    }
    __device__ __forceinline__ void a_ready(const Unit&) const {}
    __device__ __forceinline__ void done(const Unit&) const {}
};

__device__ __forceinline__ unsigned cvt_pk_bf16(float lo, float hi) { unsigned r; asm volatile("v_cvt_pk_bf16_f32 %0, %1, %2" : "=v"(r) : "v"(lo), "v"(hi)); return r; }
typedef float f32x2 __attribute__((ext_vector_type(2)));
template <class Epi, class Sched, bool ALIGN_EPI = false, bool SP2 = false>
__device__ __forceinline__ void gemm_phase(PG8_LAS unsigned char* lds, const Gemm g, const Sched& S, const Epi& E) {
    int tid_ = threadIdx.x; asm volatile("" : "+v"(tid_));
    const int tid = tid_, wid = __builtin_amdgcn_readfirstlane(tid >> 6), lane = tid & 63, wr = wid >> 2, wc = wid & 3, fr = lane & 15, fq = lane >> 4;
    const int K = g.K, nt = K / BK;
    unsigned voffA[2], voffB[2];
#pragma unroll
    for (int i = 0; i < 2; ++i) { int R, C; stage_rc(tid * 16 + i * 8192, R, C); const int Rb = Epi::PERM ? ((R & ~31) + perm32(R & 31)) : R;
        voffA[i] = (unsigned)(R * K + C) * 2u; voffB[i] = (unsigned)(Rb * K + C) * 2u; }
    const size_t kstep = (size_t)(BK * 2);
    const size_t hstep = (size_t)HALF * K * 2;
    const size_t tstep = 2 * hstep;
    const unsigned ldsw = (unsigned)wid * 1024u;
    const int aoff = lds_byte(wr * 64 + fr, fq * 8), boff = lds_byte(wc * 32 + fr, fq * 8);
#define PG8_SA(b, h) (((b) * 2 + (h)) * HTB)
#define PG8_SB(b, h) ((4 + (b) * 2 + (h)) * HTB)
#define PG8_STAGE(bufoff, gbase, voff) do { _Pragma("unroll") for (int _i = 0; _i < 2; ++_i) \
        __builtin_amdgcn_global_load_lds((const unsigned*)((const char*)(gbase) + (voff)[_i]), (PG8_LAS unsigned*)(lds + (bufoff) + ldsw + _i * 8192), 16, 0, 0); } while (0)
#define PG8_LDA(dst, b, h) do { _Pragma("unroll") for (int m = 0; m < 4; ++m) _Pragma("unroll") for (int k = 0; k < 2; ++k) dst[m][k] = *(const PG8_LAS bf16x8*)(lds + PG8_SA(b, h) + aoff + m * 2048 + k * 1024); } while (0)
#define PG8_LDB(dst, b, h) do { _Pragma("unroll") for (int n = 0; n < 2; ++n) _Pragma("unroll") for (int k = 0; k < 2; ++k) dst[n][k] = *(const PG8_LAS bf16x8*)(lds + PG8_SB(b, h) + boff + n * 2048 + k * 1024); } while (0)
#define PG8_MMA(ai, bj, At, Bt) do { __builtin_amdgcn_s_setprio(1); _Pragma("unroll") for (int m = 0; m < 4; ++m) _Pragma("unroll") for (int n = 0; n < 2; ++n) _Pragma("unroll") for (int k = 0; k < 2; ++k) \
        acc[ai][bj][m][n] = __builtin_amdgcn_mfma_f32_16x16x32_bf16(Bt[n][k], At[m][k], acc[ai][bj][m][n], 0, 0, 0); __builtin_amdgcn_s_setprio(0); } while (0)
#define PG8_WAIT_V(n) asm volatile("s_waitcnt vmcnt(" #n ")" ::: "memory")
#define PG8_WAIT_L(n) asm volatile("s_waitcnt lgkmcnt(" #n ")" ::: "memory")
#define PG8_BAR __builtin_amdgcn_s_barrier()
#define PG8_SCHED __builtin_amdgcn_sched_barrier(0)
    Unit cur, nxt; int ui = 0;
    if (!S.next(0, cur)) return;
    f32x4 acc[2][2][4][2];
#pragma unroll
    for (int a = 0; a < 2; ++a)
#pragma unroll
        for (int b = 0; b < 2; ++b)
#pragma unroll
            for (int m = 0; m < 4; ++m)
#pragma unroll
                for (int n = 0; n < 2; ++n) acc[a][b][m][n] = (f32x4){0.f, 0.f, 0.f, 0.f};
    bf16x8 At[4][2], B0[2][2], B1[2][2];
    const char* cA = (const char*)g.A + (size_t)cur.pm * tstep; const char* cB = (const char*)g.Bt + (size_t)cur.pn * tstep;
    S.a_ready(cur);
    if constexpr (SP2) {
        PG8_STAGE(PG8_SB(0, 0), cB, voffB); PG8_STAGE(PG8_SB(0, 1), cB + hstep, voffB); PG8_STAGE(PG8_SA(0, 0), cA, voffA); PG8_STAGE(PG8_SA(0, 1), cA + hstep, voffA);
        if (wr == 1) PG8_BAR;
        PG8_WAIT_V(2); PG8_BAR;
        PG8_STAGE(PG8_SB(1, 0), cB + kstep, voffB); PG8_STAGE(PG8_SA(1, 0), cA + kstep, voffA); PG8_STAGE(PG8_SB(1, 1), cB + hstep + kstep, voffB);
        PG8_WAIT_V(6); PG8_BAR;
    } else {
        PG8_STAGE(PG8_SB(0, 0), cB, voffB); PG8_STAGE(PG8_SA(0, 0), cA, voffA); PG8_STAGE(PG8_SB(0, 1), cB + hstep, voffB); PG8_STAGE(PG8_SA(0, 1), cA + hstep, voffA);
        if (wr == 1) PG8_BAR;
        PG8_WAIT_V(4); PG8_BAR;
        PG8_STAGE(PG8_SB(1, 0), cB + kstep, voffB); PG8_STAGE(PG8_SA(1, 0), cA + kstep, voffA); PG8_STAGE(PG8_SB(1, 1), cB + hstep + kstep, voffB);
        PG8_WAIT_V(6); PG8_BAR;
    }
    for (;;) {
        const bool has_next = S.next(ui + 1, nxt);
        const char* nA = has_next ? (const char*)g.A + (size_t)nxt.pm * tstep : cA; const char* nB = has_next ? (const char*)g.Bt + (size_t)nxt.pn * tstep : cB;
        for (int t = 0; t < nt; t += 2) {
            const bool last = (t == nt - 2);
            const char* a1 = cA + (size_t)(t + 1) * kstep;
            const char* a2 = last ? nA : cA + (size_t)(t + 2) * kstep; const char* b2 = last ? nB : cB + (size_t)(t + 2) * kstep;
            const char* a3 = a2 + kstep; const char* b3 = b2 + kstep;
            if (last && has_next) S.a_ready(nxt);
            if constexpr (SP2) {
            PG8_LDB(B0, 0, 0); PG8_LDB(B1, 0, 1); PG8_SCHED; PG8_LDA(At, 0, 0); PG8_STAGE(PG8_SA(1, 1), a1 + hstep, voffA);
            PG8_WAIT_V(8); PG8_WAIT_L(0); PG8_BAR; PG8_MMA(0, 0, At, B0); PG8_MMA(0, 1, At, B1); PG8_BAR; PG8_SCHED;
            PG8_LDA(At, 0, 1); PG8_STAGE(PG8_SB(0, 0), b2, voffB); PG8_STAGE(PG8_SB(0, 1), b2 + hstep, voffB); PG8_STAGE(PG8_SA(0, 0), a2, voffA);
            PG8_WAIT_V(8); PG8_WAIT_L(0); PG8_BAR; PG8_MMA(1, 0, At, B0); PG8_MMA(1, 1, At, B1); PG8_BAR; PG8_SCHED;
            PG8_LDB(B0, 1, 0); PG8_LDB(B1, 1, 1); PG8_SCHED; PG8_LDA(At, 1, 0); PG8_STAGE(PG8_SA(0, 1), a2 + hstep, voffA);
            PG8_WAIT_V(8); PG8_WAIT_L(0); PG8_BAR; PG8_MMA(0, 0, At, B0); PG8_MMA(0, 1, At, B1); PG8_BAR; PG8_SCHED;
            PG8_LDA(At, 1, 1); PG8_STAGE(PG8_SB(1, 0), b3, voffB); PG8_STAGE(PG8_SB(1, 1), b3 + hstep, voffB); PG8_STAGE(PG8_SA(1, 0), a3, voffA);
            PG8_WAIT_V(8); PG8_WAIT_L(0); PG8_BAR; PG8_MMA(1, 0, At, B0); PG8_MMA(1, 1, At, B1); PG8_BAR; PG8_SCHED;
            } else {
            PG8_LDB(B0, 0, 0); PG8_SCHED; PG8_LDA(At, 0, 0); PG8_STAGE(PG8_SA(1, 1), a1 + hstep, voffA);
            PG8_WAIT_L(8); PG8_BAR; PG8_WAIT_L(0); PG8_MMA(0, 0, At, B0); PG8_BAR; PG8_SCHED;
            PG8_LDB(B1, 0, 1); PG8_STAGE(PG8_SB(0, 0), b2, voffB);
            PG8_BAR; PG8_WAIT_L(0); PG8_MMA(0, 1, At, B1); PG8_BAR;
            PG8_LDA(At, 0, 1); PG8_STAGE(PG8_SA(0, 0), a2, voffA);
            PG8_BAR; PG8_WAIT_L(0); PG8_MMA(1, 0, At, B0); PG8_BAR; PG8_SCHED;
            PG8_STAGE(PG8_SB(0, 1), b2 + hstep, voffB);
            PG8_WAIT_V(6); PG8_BAR; PG8_MMA(1, 1, At, B1); PG8_BAR;
            PG8_LDB(B0, 1, 0); PG8_SCHED; PG8_LDA(At, 1, 0); PG8_STAGE(PG8_SA(0, 1), a2 + hstep, voffA);
            PG8_WAIT_L(8); PG8_BAR; PG8_WAIT_L(0); PG8_MMA(0, 0, At, B0); PG8_BAR; PG8_SCHED;
            PG8_LDB(B1, 1, 1); PG8_STAGE(PG8_SB(1, 0), b3, voffB);
            PG8_BAR; PG8_WAIT_L(0); PG8_MMA(0, 1, At, B1); PG8_BAR;
            PG8_LDA(At, 1, 1); PG8_STAGE(PG8_SA(1, 0), a3, voffA);
            PG8_BAR; PG8_WAIT_L(0); PG8_MMA(1, 0, At, B0); PG8_BAR; PG8_SCHED;
            PG8_STAGE(PG8_SB(1, 1), b3 + hstep, voffB);
            PG8_WAIT_V(6); PG8_BAR; PG8_MMA(1, 1, At, B1); PG8_BAR;
            }
        }
        if constexpr (ALIGN_EPI) { if (wr == 0) PG8_BAR; }
        if constexpr (!Epi::AFTER_DRAIN) { E(acc, cur, wr, wc, fr, fq); S.done(cur); }
        if (!has_next) break;
#pragma unroll
        for (int a = 0; a < 2; ++a)
#pragma unroll
            for (int b = 0; b < 2; ++b)
#pragma unroll
                for (int m = 0; m < 4; ++m)
#pragma unroll
                    for (int n = 0; n < 2; ++n) acc[a][b][m][n] = (f32x4){0.f, 0.f, 0.f, 0.f};
        cur = nxt; cA = nA; cB = nB; ++ui;
        if constexpr (ALIGN_EPI) { if (wr == 1) PG8_BAR; }
    }
    PG8_WAIT_V(0);
    if constexpr (!ALIGN_EPI) { if (wr == 0) PG8_BAR; }
    PG8_BAR;
    if constexpr (Epi::AFTER_DRAIN) { E.fused(acc, cur, wr, wc, fr, fq, lds, wid, lane); S.done(cur); }
#undef PG8_SA
#undef PG8_SB
#undef PG8_STAGE
#undef PG8_LDA
#undef PG8_LDB
#undef PG8_MMA
#undef PG8_WAIT_V
#undef PG8_WAIT_L
#undef PG8_BAR
#undef PG8_SCHED
}
}
#define GAS __attribute__((address_space(1)))
#define LAS __attribute__((address_space(3)))
typedef unsigned short bf16;
typedef unsigned v4u __attribute__((ext_vector_type(4)));
typedef unsigned v2u __attribute__((ext_vector_type(2)));
typedef float f32x4 __attribute__((ext_vector_type(4)));
typedef short bf16x8 __attribute__((ext_vector_type(8)));
#define LDS_WAIT() asm volatile("s_waitcnt lgkmcnt(0)" ::: "memory")
#define VM_WAIT() asm volatile("s_waitcnt vmcnt(0)" ::: "memory")

constexpr int DM = 2048, NB = 4, SEQ = 2048, NMETA = 16, MROWS = NB * SEQ, DPROJ = 6152, NPROJ = 6144;
constexpr int PADT = 2112, POS0 = 64, MPOS0 = 48;
constexpr float EPS = 1e-6f;
constexpr float LOG2E = 1.4426950408889634f;
constexpr float QSCALE = 0.08838834764831845f * LOG2E;
constexpr int NWAVES = 8, NTHR = 512;

constexpr size_t MiB = 1u << 20;
constexpr size_t WS_CTL = 0, CTL_ZERO_BYTES = 1 * MiB;
constexpr size_t WS_PM = 484 * MiB;
constexpr size_t WS_W1T = 2 * MiB, WS_W2T = 26 * MiB, WS_W3T = 34 * MiB, WS_XN = 42 * MiB;
constexpr size_t WS_Q = 74 * MiB, WS_KP = 90 * MiB, WS_VP = 107 * MiB, WS_MQ = 124 * MiB, WS_MK = 133 * MiB, WS_MV = 142 * MiB, WS_MO = 159 * MiB;
constexpr size_t WS_SMALL = 175 * MiB;
constexpr size_t WS_XM = WS_SMALL, WS_LI = WS_SMALL + 128 * 1024, WS_LF = WS_SMALL + 384 * 1024, WS_LAM = WS_SMALL + 640 * 1024;
constexpr size_t WS_PO = 176 * MiB, WS_ML = 304 * MiB, WS_HM = 305 * MiB, WS_A2 = 42 * MiB, WS_H1B = 74 * MiB, WS_SSQ = 106 * MiB, WS_S = 176 * MiB, WS_UB = 384 * MiB, WS_VB = 448 * MiB;
constexpr size_t WS_SCL = WS_SMALL + 704 * 1024;
constexpr size_t WS_VB8 = WS_UB + 32 * MiB;
constexpr size_t WS_DC = 305 * MiB, WS_CS = 448 * MiB, WS_DN = 482 * MiB, WS_NS = WS_DN + 512 * 1024, WS_GS = WS_DN + 1024 * 1024, WS_MS = WS_DN + 1152 * 1024;
constexpr int CW_BAR = 4096;

constexpr int RING_OFF = 0, RING_BYTES = 131072;
constexpr int XCH_OFF = 131072;
constexpr int MISC_OFF = XCH_OFF + 8192;
constexpr int LDS_BYTES = 155648;

__device__ __forceinline__ unsigned f2bf(float f) { unsigned u = __builtin_bit_cast(unsigned, f); return (u + 0x7fffu + ((u >> 16) & 1u)) >> 16; }
__device__ __forceinline__ unsigned pk2(float lo, float hi) { return f2bf(lo) | (f2bf(hi) << 16); }
__device__ __forceinline__ float bf2f(unsigned short u) { return __builtin_bit_cast(float, (unsigned)u << 16); }
__device__ __forceinline__ float bflo(unsigned w) { return __builtin_bit_cast(float, w << 16); }
__device__ __forceinline__ float bfhi(unsigned w) { return __builtin_bit_cast(float, w & 0xffff0000u); }
__device__ __forceinline__ float wave_sum(float v) {
#pragma unroll
  for (int o = 1; o < 64; o <<= 1) v += __shfl_xor(v, o);
  return v;
}
__device__ __forceinline__ size_t kp_off(int bhm, int pos, int d) { const int j = pos >> 6, row = pos & 63, d0 = d >> 4, hi = (d >> 3) & 1;
  return ((size_t)(bhm * 33 + j) * 8 + d0) * 1024 + (size_t)((((row << 1) | hi) ^ ((row >> 3) & 1)) << 3) + (d & 7); }
__device__ __forceinline__ float wave_sum_dpp(float v) {
  v += __builtin_bit_cast(float, __builtin_amdgcn_update_dpp(0, __builtin_bit_cast(int, v), 0xB1, 0xF, 0xF, true));
  v += __builtin_bit_cast(float, __builtin_amdgcn_update_dpp(0, __builtin_bit_cast(int, v), 0x4E, 0xF, 0xF, true));
  v += __builtin_bit_cast(float, __builtin_amdgcn_update_dpp(0, __builtin_bit_cast(int, v), 0x141, 0xF, 0xF, true));
  v += __builtin_bit_cast(float, __builtin_amdgcn_update_dpp(0, __builtin_bit_cast(int, v), 0x140, 0xF, 0xF, true));
  const float r0 = __builtin_bit_cast(float, __builtin_amdgcn_readlane(__builtin_bit_cast(int, v), 0)), r1 = __builtin_bit_cast(float, __builtin_amdgcn_readlane(__builtin_bit_cast(int, v), 16));
  const float r2 = __builtin_bit_cast(float, __builtin_amdgcn_readlane(__builtin_bit_cast(int, v), 32)), r3 = __builtin_bit_cast(float, __builtin_amdgcn_readlane(__builtin_bit_cast(int, v), 48));
  return (r0 + r1) + (r2 + r3);
}
__device__ __forceinline__ float sigmoidf_(float x) { return 1.0f / (1.0f + __expf(-x)); }
#define XB_TMO      128
#define XB_XCNT(j)  (256  + 64 * (j))
#define XB_XSUB(j)  (1280 + 64 * (j))
#define XB_XGEN(j)  (2304 + 64 * (j))
#define XB_TOP      3328
#define XB_TOPGEN   3392
#define XCD_BAR_WORDS 3456
#define XB_SPIN_CAP (1u << 18)

__device__ __forceinline__ unsigned xb_ld(unsigned* p)              { return __hip_atomic_load(p, __ATOMIC_RELAXED, __HIP_MEMORY_SCOPE_AGENT); }
__device__ __forceinline__ unsigned xb_add(unsigned* p, unsigned v) { return __hip_atomic_fetch_add(p, v, __ATOMIC_RELAXED, __HIP_MEMORY_SCOPE_AGENT); }
__device__ __forceinline__ unsigned xb_xcc_id() { return (unsigned)__builtin_amdgcn_s_getreg((3 << 11) | 20) & 0xFu; }
#define XB_SPIN(cond, bar) do { unsigned _sp = 0; while (cond) { __builtin_amdgcn_s_sleep(1); \
    if ((++_sp & 255u) == 0u) { if (xb_ld(&(bar)[XB_TMO])) break; if (_sp > XB_SPIN_CAP) { atomicAdd(&(bar)[XB_TMO], 1u); break; } } } } while (0)

struct XcdBarrier {
    unsigned* bar; unsigned x;
    volatile LAS unsigned* st;
};

__device__ __forceinline__ XcdBarrier xcd_barrier_post(unsigned* bar, volatile LAS unsigned* st) {
    XcdBarrier b; b.bar = bar; b.x = xb_xcc_id(); b.st = st;
    if (threadIdx.x == 0) (void)xb_add(&bar[XB_XCNT(b.x)], 1u);
    return b;
}
__device__ __forceinline__ void xcd_barrier_complete(unsigned* bar, unsigned x, unsigned& nloc, unsigned& nx) {
    const unsigned G = gridDim.x * gridDim.y * gridDim.z;
    unsigned sum, cnt, mine, sp = 0u;
    for (;;) {
        sum = 0u; cnt = 0u; mine = 0u;
#pragma unroll
        for (unsigned j = 0; j < 16; ++j) { const unsigned c = xb_ld(&bar[XB_XCNT(j)]); sum += c; cnt += (c > 0u) ? 1u : 0u; mine = (j == x) ? c : mine; }
        if (sum == G) break;
        __builtin_amdgcn_s_sleep(1);
        if ((++sp & 255u) == 0u) { if (xb_ld(&bar[XB_TMO])) break; if (sp > XB_SPIN_CAP) { atomicAdd(&bar[XB_TMO], 1u); break; } }
    }
    nloc = mine > 0u ? mine : 1u; nx = cnt > 0u ? cnt : 1u;
}

__device__ __forceinline__ void xcd_barrier(const XcdBarrier& b) {
    asm volatile("s_waitcnt vmcnt(0)" ::: "memory");
    __syncthreads();
    if (threadIdx.x == 0) {
        unsigned* bar = b.bar;
        __builtin_amdgcn_s_waitcnt(0);
        unsigned nloc = b.st[0], nx = b.st[1];
        if (nloc == 0u) { xcd_barrier_complete(bar, b.x, nloc, nx); b.st[0] = nloc; b.st[1] = nx; }
        const unsigned old = xb_add(&bar[XB_XSUB(b.x)], 1u);
        const unsigned gen = old / nloc;
        if (old + 1u == (gen + 1u) * nloc) {
            __builtin_amdgcn_fence(__ATOMIC_RELEASE, "agent");
            asm volatile("s_waitcnt vmcnt(0)" ::: "memory");
            const unsigned og = xb_add(&bar[XB_TOP], 1u);
            const unsigned tg = og / nx;
            if (og + 1u == (tg + 1u) * nx) xb_add(&bar[XB_TOPGEN], 1u);
            else XB_SPIN(xb_ld(&bar[XB_TOPGEN]) == tg, bar);
            __builtin_amdgcn_fence(__ATOMIC_ACQUIRE, "agent");
            xb_add(&bar[XB_XGEN(b.x)], 1u);
            asm volatile("s_waitcnt vmcnt(0)" ::: "memory");
        } else {
            XB_SPIN(xb_ld(&bar[XB_XGEN(b.x)]) == gen, bar);
            __builtin_amdgcn_fence(__ATOMIC_ACQUIRE, "agent");
            asm volatile("s_waitcnt vmcnt(0)" ::: "memory");
        }
    }
    __syncthreads();
}

struct Args { const float* in[22]; float* out; unsigned char* ws; int ph_lo, ph_hi, na, pad; };
struct Frame {
  LAS unsigned char* lds; unsigned char* ws; int tid, lane, wave; const float* const* in;
};
#define IN_X 0
#define IN_META 1
#define IN_G1 2
#define IN_WIN 3
#define IN_CW 4
#define IN_CB 5
#define IN_IGB 6
#define IN_FGB 7
#define IN_LQ1 8
#define IN_LK1 9
#define IN_LQ2 10
#define IN_LK2 11
#define IN_QNG 12
#define IN_KNG 13
#define IN_SUBG 14
#define IN_OUTG 15
#define IN_WOUT 16
#define IN_G2 17
#define IN_WQ 18
#define IN_SUBK 19
#define IN_U 20
#define IN_V 21

__device__ __forceinline__ void p0_rows(const Frame& F, const Args& a) {
  const float* x = a.in[IN_X]; const float* meta = a.in[IN_META]; const float* g1 = a.in[IN_G1]; const float* w_in = a.in[IN_WIN];
  const float* igb = a.in[IN_IGB]; const float* fgb = a.in[IN_FGB];
  bf16* Xn = (bf16*)(F.ws + WS_XN); bf16* Xm = (bf16*)(F.ws + WS_XM); float* LI = (float*)(F.ws + WS_LI); float* LF = (float*)(F.ws + WS_LF);
  LAS f32x4* wgl = (LAS f32x4*)(F.lds);
  for (int e = F.tid; e < 4096; e += NTHR) {
    const int ln = e & 63, q = e >> 6, half = q & 1, j = (q >> 1) & 3, i = q >> 3;
    const int k = 4 * (i * 64 + ln) + j;
    wgl[e] = *(const f32x4*)(w_in + (size_t)k * DPROJ + NPROJ + 4 * half);
  }
  __syncthreads();
  const int gw = blockIdx.x * NWAVES + F.wave, NGW = gridDim.x * NWAVES, lane = F.lane;
  for (int task = gw; task < MROWS / 2 + NMETA / 2; task += NGW) {
    const bool ismeta = task >= MROWS / 2;
    const int r0 = ismeta ? (task - MROWS / 2) * 2 : task * 2;
    const float* src0 = (ismeta ? meta : x) + (size_t)r0 * DM;
    f32x4 xv[2][8]; float rs[2];
    { float s0 = 0.f, s1 = 0.f;
#pragma unroll
      for (int i = 0; i < 8; ++i) { xv[0][i] = ((const f32x4*)src0)[i * 64 + lane]; xv[1][i] = ((const f32x4*)(src0 + DM))[i * 64 + lane]; }
#pragma unroll
      for (int i = 0; i < 8; ++i) { const f32x4 a0 = xv[0][i], a1 = xv[1][i];
        s0 += (a0.x * a0.x + a0.y * a0.y) + (a0.z * a0.z + a0.w * a0.w); s1 += (a1.x * a1.x + a1.y * a1.y) + (a1.z * a1.z + a1.w * a1.w); }
      rs[0] = rsqrtf(wave_sum_dpp(s0) * (1.0f / DM) + EPS); rs[1] = rsqrtf(wave_sum_dpp(s1) * (1.0f / DM) + EPS); }
    float ga[2][8];
#pragma unroll
    for (int rr = 0; rr < 2; ++rr)
#pragma unroll
      for (int g = 0; g < 8; ++g) ga[rr][g] = 0.f;
    bf16* dst0 = (ismeta ? Xm : Xn) + (size_t)r0 * DM;
#pragma unroll
    for (int i = 0; i < 8; ++i) {
      const f32x4 g = ((const f32x4*)g1)[i * 64 + lane];
      f32x4 xn[2];
#pragma unroll
      for (int rr = 0; rr < 2; ++rr) { xn[rr] = xv[rr][i] * g * rs[rr];
        v2u o; o.x = pk2(xn[rr].x, xn[rr].y); o.y = pk2(xn[rr].z, xn[rr].w); ((v2u*)(dst0 + (size_t)rr * DM))[i * 64 + lane] = o; }
#pragma unroll
      for (int j = 0; j < 4; ++j) {
        const f32x4 w0 = wgl[((i * 4 + j) * 2 + 0) * 64 + lane], w1 = wgl[((i * 4 + j) * 2 + 1) * 64 + lane];
#pragma unroll
        for (int rr = 0; rr < 2; ++rr) { const float xs_ = xn[rr][j];
          ga[rr][0] += xs_ * w0.x; ga[rr][1] += xs_ * w0.y; ga[rr][2] += xs_ * w0.z; ga[rr][3] += xs_ * w0.w;
          ga[rr][4] += xs_ * w1.x; ga[rr][5] += xs_ * w1.y; ga[rr][6] += xs_ * w1.z; ga[rr][7] += xs_ * w1.w; }
      }
      __builtin_amdgcn_sched_barrier(0);
    }
#pragma unroll
    for (int rr = 0; rr < 2; ++rr)
#pragma unroll
      for (int g = 0; g < 8; ++g) ga[rr][g] = wave_sum_dpp(ga[rr][g]);
    if (lane < 8) {
      const int rr = lane >> 2, h = lane & 3;
      float gi = 0.f, gf = 0.f;
#pragma unroll
      for (int q = 0; q < 2; ++q)
#pragma unroll
        for (int hh = 0; hh < 4; ++hh) if (q == rr && hh == h) { gi = ga[q][hh]; gf = ga[q][4 + hh]; }
      const float li = gi + igb[h]; const float fx = gf + fgb[h];
      const float lf = fminf(fx, 0.f) - log1pf(__expf(-fabsf(fx)));
      const int R = r0 + rr;
      if (!ismeta) { const int b = R >> 11, t = R & 2047; LI[(b * 4 + h) * PADT + POS0 + t] = li; LF[(b * 4 + h) * PADT + POS0 + t] = lf; }
      else { for (int b = 0; b < NB; ++b) { LI[(b * 4 + h) * PADT + MPOS0 + R] = li; LF[(b * 4 + h) * PADT + MPOS0 + R] = lf; } }
    }
  }
  __syncthreads();
}
__device__ __forceinline__ void p0_metaproj(const Frame& F, const Args& a) {
  const float* meta = a.in[IN_META]; const float* g1 = a.in[IN_G1]; const float* w_in = a.in[IN_WIN];
  float* PM = (float*)(F.ws + WS_PM);
  LAS float* xs = (LAS float*)(F.lds);
  LAS float* part = (LAS float*)(F.lds + 16384);
  const int q = F.tid >> 7, c = F.tid & 127;
  for (int task = blockIdx.x; task < (NPROJ / 128) * 4; task += gridDim.x) {
    const int nb = task >> 2, kp = task & 3, n = nb * 128 + c;
    float acc[16];
#pragma unroll
    for (int m = 0; m < 16; ++m) acc[m] = 0.f;
#pragma unroll 1
    for (int kb = 0; kb < 2; ++kb) {
      __syncthreads();
#pragma unroll
      for (int i = 0; i < 8; ++i) { const int idx = F.tid + NTHR * i, qq = idx >> 10, kk = (idx >> 4) & 63, m = idx & 15; const int k = 512 * kp + 128 * qq + 64 * kb + kk;
        xs[idx] = meta[(size_t)m * DM + k] * g1[k]; }
      __syncthreads();
#pragma unroll 8
      for (int kk = 0; kk < 64; ++kk) {
        const float w = w_in[(size_t)(512 * kp + 128 * q + 64 * kb + kk) * DPROJ + n];
        const LAS f32x4* xp = (const LAS f32x4*)(xs + (q * 64 + kk) * 16);
#pragma unroll
        for (int t = 0; t < 4; ++t) { const f32x4 xv = xp[t]; acc[4 * t + 0] += xv.x * w; acc[4 * t + 1] += xv.y * w; acc[4 * t + 2] += xv.z * w; acc[4 * t + 3] += xv.w * w; }
      }
    }
#pragma unroll
    for (int m = 0; m < 16; ++m) part[(q * 16 + m) * 128 + c] = acc[m];
    __syncthreads();
    for (int e = F.tid; e < 16 * 128; e += NTHR) { const int m = e >> 7, cc = e & 127;
      PM[((size_t)kp * 16 + m) * NPROJ + nb * 128 + cc] = (part[(0 * 16 + m) * 128 + cc] + part[(1 * 16 + m) * 128 + cc]) + (part[(2 * 16 + m) * 128 + cc] + part[(3 * 16 + m) * 128 + cc]); }
  }
  __syncthreads();
}
__device__ __forceinline__ void p0_transpose(const Frame& F, const float* W, int ldw, int N, bf16* Wt) {
  LAS float* tl = (LAS float*)(F.lds);
  const int ntn = N / 64, ntask = ntn * 16;
  for (int task = blockIdx.x; task < ntask; task += gridDim.x) {
    const int nb = task % ntn, kb = task / ntn, n0 = nb * 64, k0 = kb * 128;
    __syncthreads();
#pragma unroll
    for (int i = 0; i < 4; ++i) { const int idx = F.tid + NTHR * i, kk = idx >> 4, c4 = idx & 15;
      const f32x4 w = *(const f32x4*)(W + (size_t)(k0 + kk) * ldw + n0 + 4 * c4);
      LAS float* d = tl + kk * 65 + 4 * c4; d[0] = w.x; d[1] = w.y; d[2] = w.z; d[3] = w.w; }
    __syncthreads();
    const int n = F.tid >> 3, kc = F.tid & 7;
    const LAS float* s = tl + (kc * 16) * 65 + n;
    v4u o0, o1;
    o0.x = pk2(s[0 * 65], s[1 * 65]); o0.y = pk2(s[2 * 65], s[3 * 65]); o0.z = pk2(s[4 * 65], s[5 * 65]); o0.w = pk2(s[6 * 65], s[7 * 65]);
    o1.x = pk2(s[8 * 65], s[9 * 65]); o1.y = pk2(s[10 * 65], s[11 * 65]); o1.z = pk2(s[12 * 65], s[13 * 65]); o1.w = pk2(s[14 * 65], s[15 * 65]);
    v4u* dp = (v4u*)(Wt + (size_t)(n0 + n) * DM + k0 + kc * 16);
    dp[0] = o0; dp[1] = o1;
  }
  __syncthreads();
}
__device__ __forceinline__ void p0_zero_vpad(const Frame& F) {
  bf16* Vp = (bf16*)(F.ws + WS_VP);
  const int per = MPOS0 * 256 / 8;
  for (int i = blockIdx.x * NTHR + F.tid; i < 16 * per; i += gridDim.x * NTHR) { const int bh = i / per, e = i % per;
    *(v4u*)(Vp + (size_t)bh * PADT * 256 + (size_t)e * 8) = (v4u){0u, 0u, 0u, 0u}; }
}
__device__ __forceinline__ void p0_lam(const Frame& F, const Args& a) {
  if (blockIdx.x == 0 && F.wave == 0) {
    const int l = F.lane;
    float s1 = a.in[IN_LQ1][l] * a.in[IN_LK1][l] + a.in[IN_LQ1][l + 64] * a.in[IN_LK1][l + 64];
    float s2 = a.in[IN_LQ2][l] * a.in[IN_LK2][l] + a.in[IN_LQ2][l + 64] * a.in[IN_LK2][l + 64];
    s1 = wave_sum(s1); s2 = wave_sum(s2);
    if (l == 0) *(float*)(F.ws + WS_LAM) = __expf(s1) - __expf(s2) + 0.2f;
  }
}

struct EpiProj {
  static constexpr bool PERM = true, AFTER_DRAIN = false;
  bf16 *Qb, *Kp, *Vp, *MQ, *MK, *MV, *MO; const float *qg, *kg; LAS float* xch;
  __device__ __forceinline__ void operator()(const pg8::f32x4 (&acc)[2][2][4][2], const pg8::Unit& u, int wr, int wc, int fr, int fq) const {
    const int pn = u.pn, b = u.pm >> 3, tb = (u.pm & 7) * 256 + wr * 64 + fr, d0 = wc * 32 + fq * 8;
    if (pn < 8) {
      const bool isk = pn >= 4; const int h = pn & 3;
      float ssq[2][4][2];
#pragma unroll
      for (int ai = 0; ai < 2; ++ai)
#pragma unroll
        for (int m = 0; m < 4; ++m)
#pragma unroll
          for (int bj = 0; bj < 2; ++bj) { float s = 0.f;
#pragma unroll
            for (int n = 0; n < 2; ++n) { const pg8::f32x4 x = acc[ai][bj][m][n]; s += (x[0] * x[0] + x[1] * x[1]) + (x[2] * x[2] + x[3] * x[3]); }
            s += __shfl_xor(s, 16); s += __shfl_xor(s, 32); ssq[ai][m][bj] = s;
            if (fq == 0) xch[((ai * 128 + wr * 64 + m * 16 + fr) * 2 + bj) * 4 + wc] = s; }
      asm volatile("s_waitcnt lgkmcnt(0)" ::: "memory"); __builtin_amdgcn_s_barrier(); asm volatile("" ::: "memory");
      const float* gp = (isk ? kg : qg) + d0; const f32x4 g0 = *(const f32x4*)gp, g1v = *(const f32x4*)(gp + 4);
      const float sc = isk ? 1.0f : QSCALE;
#pragma unroll
      for (int ai = 0; ai < 2; ++ai)
#pragma unroll
        for (int m = 0; m < 4; ++m)
#pragma unroll
          for (int bj = 0; bj < 2; ++bj) {
            const f32x4 p = *(const LAS f32x4*)(xch + ((ai * 128 + wr * 64 + m * 16 + fr) * 2 + bj) * 4);
            const float rs = rsqrtf(((p.x + p.y) + (p.z + p.w)) * (1.0f / 128.f) + EPS) * sc;
            const pg8::f32x4 v0 = acc[ai][bj][m][0], v1 = acc[ai][bj][m][1];
            v4u w; w.x = pk2(v0[0] * rs * g0.x, v0[1] * rs * g0.y); w.y = pk2(v0[2] * rs * g0.z, v0[3] * rs * g0.w);
            w.z = pk2(v1[0] * rs * g1v.x, v1[1] * rs * g1v.y); w.w = pk2(v1[2] * rs * g1v.z, v1[3] * rs * g1v.w);
            const int t = tb + ai * 128 + m * 16;
            bf16* dst = isk ? Kp + kp_off((b * 4 + h) * 2 + bj, POS0 + t, d0)
                            : Qb + ((size_t)((b * 4 + h) * 2 + bj) * SEQ + t) * 128 + d0;
            *(v4u*)dst = w; }
      return;
    }
#pragma unroll
    for (int ai = 0; ai < 2; ++ai)
#pragma unroll
      for (int m = 0; m < 4; ++m)
#pragma unroll
        for (int bj = 0; bj < 2; ++bj) {
          pg8::f32x4 v0 = acc[ai][bj][m][0], v1 = acc[ai][bj][m][1];
          const int t = tb + ai * 128 + m * 16;
          bf16* dst;
          if (pn < 12) { const int h = pn - 8; dst = Vp + ((size_t)(b * 4 + h) * PADT + POS0 + t) * 256 + bj * 128 + d0; }
          else if (pn < 16) { const int h = 2 * (pn & 1) + bj; dst = (pn >= 14 ? MK : MQ) + ((size_t)(b * 4 + h) * PADT + POS0 + t) * 128 + d0; }
          else if (pn < 20) { const int h = pn - 16; dst = MV + ((size_t)(b * 4 + h) * PADT + POS0 + t) * 256 + bj * 128 + d0; }
          else { dst = MO + (size_t)(b * SEQ + t) * 1024 + (pn - 20) * 256 + bj * 128 + d0;
#pragma unroll
            for (int j = 0; j < 4; ++j) { v0[j] = sigmoidf_(v0[j]); v1[j] = sigmoidf_(v1[j]); } }
          v4u w; w.x = pk2(v0[0], v0[1]); w.y = pk2(v0[2], v0[3]); w.z = pk2(v1[0], v1[1]); w.w = pk2(v1[2], v1[3]);
          *(v4u*)dst = w; }
  }
};
__device__ __forceinline__ void p1_meta_finalize(const Frame& F, const Args& a) {
  if (blockIdx.x >= NMETA) return;
  const int mrow = blockIdx.x, tid = F.tid, lane = F.lane, w = F.wave;
  const float* meta = a.in[IN_META] + (size_t)mrow * DM; const float* PM0 = (const float*)(F.ws + WS_PM) + (size_t)mrow * NPROJ;
#define PM_AT(i) ((PM0[(i)] + PM0[(size_t)16 * NPROJ + (i)]) + (PM0[(size_t)32 * NPROJ + (i)] + PM0[(size_t)48 * NPROJ + (i)]))
  LAS float* red = (LAS float*)(F.lds + XCH_OFF);
  const f32x4 mv = ((const f32x4*)meta)[tid];
  float s = wave_sum((mv.x * mv.x + mv.y * mv.y) + (mv.z * mv.z + mv.w * mv.w));
  if (lane == 0) red[w] = s;
  __syncthreads();
  float tot = 0.f;
#pragma unroll
  for (int i = 0; i < 8; ++i) tot += red[i];
  const float rs = rsqrtf(tot * (1.0f / DM) + EPS);
  bf16* Kp = (bf16*)(F.ws + WS_KP); bf16* Vp = (bf16*)(F.ws + WS_VP); bf16* MQ = (bf16*)(F.ws + WS_MQ); bf16* MK = (bf16*)(F.ws + WS_MK); bf16* MV = (bf16*)(F.ws + WS_MV);
  const int pos = MPOS0 + mrow;
  {
    const float v0 = PM_AT(1024 + w * 128 + lane) * rs, v1 = PM_AT(1024 + w * 128 + lane + 64) * rs;
    const float rk = rsqrtf(wave_sum(v0 * v0 + v1 * v1) * (1.0f / 128.f) + EPS);
    const float* kg = a.in[IN_KNG];
    const unsigned short o0 = (unsigned short)f2bf(v0 * rk * kg[lane]), o1 = (unsigned short)f2bf(v1 * rk * kg[lane + 64]);
    for (int b = 0; b < NB; ++b) { const int bhm = (b * 4 + (w >> 1)) * 2 + (w & 1); Kp[kp_off(bhm, pos, lane)] = o0; Kp[kp_off(bhm, pos, lane + 64)] = o1; }
  }
  { const int c = tid * 2;
    const unsigned o = pk2(PM_AT(2048 + c) * rs, PM_AT(2048 + c + 1) * rs); const int h = c >> 8, e = c & 255;
    for (int b = 0; b < NB; ++b) *(unsigned*)(Vp + ((size_t)(b * 4 + h) * PADT + pos) * 256 + e) = o;
    const unsigned o2 = pk2(PM_AT(3072 + c) * rs, PM_AT(3072 + c + 1) * rs); const bool isk = c >= 512; const int cc = c & 511, hq = cc >> 7, d = cc & 127;
    for (int b = 0; b < NB; ++b) *(unsigned*)((isk ? MK : MQ) + ((size_t)(b * 4 + hq) * PADT + pos) * 128 + d) = o2;
    const unsigned o3 = pk2(PM_AT(4096 + c) * rs, PM_AT(4096 + c + 1) * rs);
    for (int b = 0; b < NB; ++b) *(unsigned*)(MV + ((size_t)(b * 4 + h) * PADT + pos) * 256 + e) = o3;
  }
  __syncthreads();
}
#undef PM_AT

namespace att {
using f32x16 = __attribute__((ext_vector_type(16))) float;
using s16x4 = __attribute__((ext_vector_type(4))) short;
constexpr int STEPS_BHM = 152, NSTEPS = 32 * STEPS_BHM;
constexpr int SHM_V = 64 * 256 * 2, SHM_K = 64 * 128 * 2;
constexpr int LDS_V = 0, LDS_K = 2 * SHM_V, LDS_Q = LDS_K + SHM_K, LDS_WS = LDS_Q + 8 * 8192;
constexpr float THR2 = 8.0f;
#define KSWZ(row, colB) ((row) * 256 + ((colB) ^ (((row) & 7) << 4)))
#define SBAR() __builtin_amdgcn_sched_barrier(0)
__device__ __forceinline__ int crow(int r, int hi) { return (r & 3) + 8 * (r >> 2) + 4 * hi; }
__device__ __forceinline__ unsigned cvtpk(float lo, float hi) { unsigned r; asm volatile("v_cvt_pk_bf16_f32 %0, %1, %2" : "=v"(r) : "v"(lo), "v"(hi)); return r; }
__device__ __forceinline__ int qb_start(int qb) { return 2 * qb * qb + 3 * qb; }
__device__ __forceinline__ int chunk_of(int s, int NA) { return ((s + 1) * NA - 1) / NSTEPS; }

template <int OFF> __device__ __forceinline__ s16x4 tr_read(int vb) {
  s16x4 r; asm volatile("ds_read_b64_tr_b16 %0, %1 offset:%2" : "=&v"(r) : "v"(vb), "i"(OFF) : "memory"); return r;
}
constexpr int v_rd_off(int d0, int ks, int half) { return d0 * 512 + ks * 8192 + half * 4096; }
template <int D0> __device__ __forceinline__ void pv_one(f32x16& od, int vb, bf16x8 pa0, bf16x8 pa1, bf16x8 pa2, bf16x8 pa3) {
#define PK(L, H) (bf16x8){L[0], L[1], L[2], L[3], H[0], H[1], H[2], H[3]}
  { const s16x4 l0 = tr_read<v_rd_off(D0, 0, 0)>(vb), h0 = tr_read<v_rd_off(D0, 0, 1)>(vb), l1 = tr_read<v_rd_off(D0, 1, 0)>(vb), h1 = tr_read<v_rd_off(D0, 1, 1)>(vb);
    asm volatile("s_waitcnt lgkmcnt(0)" ::: "memory"); SBAR();
    od = __builtin_amdgcn_mfma_f32_32x32x16_bf16(pa0, PK(l0, h0), od, 0, 0, 0);
    od = __builtin_amdgcn_mfma_f32_32x32x16_bf16(pa1, PK(l1, h1), od, 0, 0, 0); }
  SBAR();
  { const s16x4 l2 = tr_read<v_rd_off(D0, 2, 0)>(vb), h2 = tr_read<v_rd_off(D0, 2, 1)>(vb), l3 = tr_read<v_rd_off(D0, 3, 0)>(vb), h3 = tr_read<v_rd_off(D0, 3, 1)>(vb);
    asm volatile("s_waitcnt lgkmcnt(0)" ::: "memory"); SBAR();
    od = __builtin_amdgcn_mfma_f32_32x32x16_bf16(pa2, PK(l2, h2), od, 0, 0, 0);
    od = __builtin_amdgcn_mfma_f32_32x32x16_bf16(pa3, PK(l3, h3), od, 0, 0, 0); }
#undef PK
}

__device__ __forceinline__ void segment(const Frame& F, int bhm, int qb, int j0, int j1, int slot) {
  const int tid = F.tid, wid = F.wave, lane = F.lane, r32 = lane & 31, hi = lane >> 5;
  const bf16* Qg = (const bf16*)(F.ws + WS_Q) + ((size_t)bhm * SEQ + qb * 256 + wid * 32 + r32) * 128 + hi * 8;
  const bf16* Kg = (const bf16*)(F.ws + WS_KP) + (size_t)bhm * 33 * 8192;
  const bf16* Vg = (const bf16*)(F.ws + WS_VP) + (size_t)(bhm >> 1) * PADT * 256;
  LAS unsigned char* lds = F.lds;
  LAS float* wsl = (LAS float*)(lds + LDS_WS) + wid * 64;
  const float slope2 = exp2f(-2.0f * (float)(((bhm >> 1) & 3) + 1)) * LOG2E;
  unsigned ksrc0, vsrc0;
  ksrc0 = (unsigned)tid * 16u;
  { const int a8 = tid >> 8, b = (tid >> 2) & 7, k = 8 * (b >> 2) + 4 * a8 + (b & 3), c = ((tid >> 5) & 7) * 32 + (tid & 3) * 8; vsrc0 = (unsigned)(k * 256 + c) * 2u; }
#define STAGE_K(j) do { const char* kt = (const char*)(Kg + (size_t)(j) * 8192); \
    _Pragma("unroll") for (int _i = 0; _i < 2; ++_i) __builtin_amdgcn_global_load_lds((const unsigned*)(kt + (ksrc0 + _i * 8192u)), (LAS unsigned*)(lds + LDS_K + _i * 8192 + wid * 1024), 16, 0, 0); } while (0)
#define STAGE_V(buf, j) do { const char* vt = (const char*)(Vg + (size_t)(j) * 64 * 256); \
    _Pragma("unroll") for (int _i = 0; _i < 4; ++_i) __builtin_amdgcn_global_load_lds((const unsigned*)(vt + (vsrc0 + _i * 8192u)), (LAS unsigned*)(lds + LDS_V + (buf) * SHM_V + _i * 8192 + wid * 1024), 16, 0, 0); } while (0)
  const int lt = (((r32 << 1) | hi) ^ ((r32 >> 3) & 1)) << 4;
  LAS unsigned char* Qs = lds + LDS_Q + wid * 8192;
#pragma unroll
  for (int d0 = 0; d0 < 8; ++d0) { const bf16x8 qv = *(const bf16x8*)(Qg + d0 * 16); *(LAS bf16x8*)(Qs + d0 * 1024 + lt) = qv; }
  const float hioff = slope2 * (float)(4 * hi);
  f32x16 o[8];
#pragma unroll
  for (int d = 0; d < 8; ++d)
#pragma unroll
    for (int r = 0; r < 16; ++r) o[d][r] = 0.f;
  float m_reg = -1e30f, l_reg = 0.f;
  const int vb0 = (int)(uintptr_t)(lds + LDS_V) + (((lane & 3) << 3) | (((lane >> 2) & 3) << 6) | (((lane >> 4) & 1) << 5) | (((lane >> 5) & 1) << 8));
  const int qrel = wid * 32 + r32;
  STAGE_K(j0); STAGE_V(0, j0);
  VM_WAIT(); __syncthreads();
  for (int j = j0; j < j1; ++j) {
    const int cur = (j - j0) & 1;
    if (j + 1 < j1) STAGE_V(cur ^ 1, j + 1);
    SBAR();
    f32x16 p0 = {}, p1 = {};
    { const LAS unsigned char* Ks = lds + LDS_K;
#pragma unroll
      for (int d0 = 0; d0 < 8; ++d0) {
        const bf16x8 b0 = *(const LAS bf16x8*)(Ks + d0 * 2048 + lt);
        const bf16x8 b1 = *(const LAS bf16x8*)(Ks + d0 * 2048 + 1024 + lt);
        const bf16x8 qf = *(const LAS bf16x8*)(Qs + d0 * 1024 + lt);
        p0 = __builtin_amdgcn_mfma_f32_32x32x16_bf16(b0, qf, p0, 0, 0, 0);
        p1 = __builtin_amdgcn_mfma_f32_32x32x16_bf16(b1, qf, p1, 0, 0, 0); } }
    asm volatile("s_waitcnt lgkmcnt(0)" ::: "memory"); __builtin_amdgcn_s_barrier(); asm volatile("" ::: "memory");
    if (j + 1 < j1) STAGE_K(j + 1);
    SBAR();
    if (j == 0) {
#pragma unroll
      for (int r = 0; r < 16; ++r) p0[r] = -INFINITY;
#pragma unroll
      for (int r = 0; r < 8; ++r) p1[r] = -INFINITY;
    }
    const int jb = j - (4 * qb + 1);
    if (jb >= 0) {
      const int kb = 64 * jb + 4 * hi;
#pragma unroll
      for (int r = 0; r < 16; ++r) { const int kv = kb + (r & 3) + 8 * (r >> 2); if (kv > qrel) p0[r] = -INFINITY; if (kv + 32 > qrel) p1[r] = -INFINITY; }
    }
    const float off0 = slope2 * (float)(64 * j) + hioff, off1 = off0 + 32.0f * slope2;
#pragma unroll
    for (int r = 0; r < 16; ++r) { const float sb = slope2 * (float)((r & 3) + 8 * (r >> 2)); p0[r] += sb; p1[r] += sb; }
    float pm0 = p0[0], pm1 = p1[0];
#pragma unroll
    for (int r = 1; r < 16; ++r) { pm0 = fmaxf(pm0, p0[r]); pm1 = fmaxf(pm1, p1[r]); }
    float pmax = fmaxf(pm0 + off0, pm1 + off1);
    { auto rr = __builtin_amdgcn_permlane32_swap(__float_as_uint(pmax), __float_as_uint(pmax), false, false);
      pmax = fmaxf(__uint_as_float(rr[0]), __uint_as_float(rr[1])); }
    float mn, alpha;
    if (__builtin_expect(__all(pmax - m_reg <= THR2), 1)) { mn = m_reg; alpha = 1.f; }
    else { mn = fmaxf(m_reg, pmax); alpha = __builtin_amdgcn_exp2f(m_reg - mn); m_reg = mn; }
    const float c0 = off0 - mn, c1 = off1 - mn;
    float ps = 0.f;
#pragma unroll
    for (int r = 0; r < 16; ++r) { p0[r] = __builtin_amdgcn_exp2f(p0[r] + c0); p1[r] = __builtin_amdgcn_exp2f(p1[r] + c1); ps += p0[r] + p1[r]; }
    { auto rr = __builtin_amdgcn_permlane32_swap(__float_as_uint(ps), __float_as_uint(ps), false, false);
      ps = __uint_as_float(rr[0]) + __uint_as_float(rr[1]); }
    l_reg = l_reg * alpha + ps;
    if (__any(alpha < 1.f)) { if (hi == 0) wsl[r32] = alpha; asm volatile("s_waitcnt lgkmcnt(0)" ::: "memory");
#pragma unroll
      for (int rg = 0; rg < 4; ++rg) { const f32x4 al = *(const LAS f32x4*)(wsl + 8 * rg + 4 * hi);
#pragma unroll
        for (int d = 0; d < 8; ++d) { o[d][4 * rg + 0] *= al.x; o[d][4 * rg + 1] *= al.y; o[d][4 * rg + 2] *= al.z; o[d][4 * rg + 3] *= al.w; }
        SBAR(); } }
    bf16x8 pa0, pa1, pa2, pa3;
#define PK4(P, BASE, OUT) do { unsigned a0 = cvtpk(P[BASE + 0], P[BASE + 1]), a1 = cvtpk(P[BASE + 2], P[BASE + 3]);   \
    unsigned b0 = cvtpk(P[BASE + 4], P[BASE + 5]), b1 = cvtpk(P[BASE + 6], P[BASE + 7]);                              \
    auto r0 = __builtin_amdgcn_permlane32_swap(a0, b0, false, false); auto r1 = __builtin_amdgcn_permlane32_swap(a1, b1, false, false); \
    v4u w = {r0[0], r1[0], r0[1], r1[1]}; OUT = *reinterpret_cast<bf16x8*>(&w); } while (0)
    PK4(p0, 0, pa0); PK4(p0, 8, pa1); PK4(p1, 0, pa2); PK4(p1, 8, pa3);
#undef PK4
    SBAR();
    { const int vb = vb0 + cur * SHM_V;
      pv_one<0>(o[0], vb, pa0, pa1, pa2, pa3); pv_one<1>(o[1], vb, pa0, pa1, pa2, pa3); pv_one<2>(o[2], vb, pa0, pa1, pa2, pa3); pv_one<3>(o[3], vb, pa0, pa1, pa2, pa3);
      pv_one<4>(o[4], vb, pa0, pa1, pa2, pa3); pv_one<5>(o[5], vb, pa0, pa1, pa2, pa3); pv_one<6>(o[6], vb, pa0, pa1, pa2, pa3); pv_one<7>(o[7], vb, pa0, pa1, pa2, pa3); }
    VM_WAIT(); __syncthreads();
  }
  { int lane2 = threadIdx.x & 63, slot2 = slot; asm volatile("" : "+v"(lane2), "+s"(slot2));
    const int r32e = lane2 & 31, hie = lane2 >> 5;
    float* PO = (float*)(F.ws + WS_PO) + (size_t)slot2 * 256 * 256; float* ML = (float*)(F.ws + WS_ML) + (size_t)slot2 * 512;
    LAS float* wse = (LAS float*)(F.lds + LDS_WS) + wid * 64;
    if (hie == 0) { wse[r32e] = l_reg; ML[(wid * 32 + r32e) * 2] = m_reg; ML[(wid * 32 + r32e) * 2 + 1] = l_reg; }
    asm volatile("s_waitcnt lgkmcnt(0)" ::: "memory");
    char* Ob = (char*)(PO + (size_t)(wid * 32) * 256);
    const unsigned lo = (unsigned)(4 * hie * 256 + r32e) * 4u;
#pragma unroll
    for (int r = 0; r < 16; ++r) { const int rowc = (r & 3) + 8 * (r >> 2); const float lv = wse[rowc + 4 * hie]; const float rl = lv > 0.f ? __builtin_amdgcn_rcpf(lv) : 0.f;
#pragma unroll
      for (int d0 = 0; d0 < 8; ++d0) *(float*)(Ob + (lo + (unsigned)(rowc * 256 + d0 * 32) * 4u)) = o[d0][r] * rl;
      SBAR(); } }
  __syncthreads();
#undef STAGE_K
#undef STAGE_V
}

__device__ __forceinline__ void phase(const Frame& F, int ca, int NA) {
  int s0 = (int)(((long)ca * NSTEPS) / NA); const int s1 = (int)(((long)(ca + 1) * NSTEPS) / NA);
  while (s0 < s1) {
    const int bhm = s0 / STEPS_BHM, rem = s0 - bhm * STEPS_BHM;
    int qb = 0;
#pragma unroll 1
    for (int q = 1; q < 8; ++q) if (rem >= qb_start(q)) qb = q;
    const int j0 = rem - qb_start(qb), nst = 4 * qb + 5;
    const int j1 = (j0 + (s1 - s0) < nst) ? j0 + (s1 - s0) : nst;
    const int slot = bhm * 16 + qb + chunk_of(s0, NA) - chunk_of(bhm * STEPS_BHM, NA);
    segment(F, bhm, qb, j0, j1, slot);
    s0 += j1 - j0;
  }
}
#undef KSWZ
#undef SBAR
}
namespace ml {
constexpr int QST = 136, TST = 72;
constexpr int L_RQ = 0, L_RK = 17152, L_QS = 34304, L_QW = 51712, L_KS = 69120, L_KWT = 86528, L_VT = 104960  , L_SP = 0  , L_G = 141824, L_CW = 143872;
constexpr int L_HT = 0;
constexpr int G_A = 0, G_M = 64, G_WI = 128, G_EM = 192, G_DEN = 256, G_WG = 320, G_SC = 384, G_N = 0;
constexpr int L_NV = L_CW + 5120;
constexpr int L_SSQ = L_KWT;
__device__ __forceinline__ float shfl_up_f(float v, int d) { return __shfl_up(v, d); }

__device__ __forceinline__ void load_cw(const Frame& F, const Args& a, int h) {
  LAS float* CW = (LAS float*)(F.lds + L_CW);
  for (int e = F.tid; e < 2 * 5 * 128; e += NTHR) { const int qk = e / 640, j = (e / 128) % 5, d = e & 127; const int ch = qk * 512 + h * 128 + d;
    CW[e] = j < 4 ? a.in[IN_CW][j * 1024 + ch] : a.in[IN_CB][ch]; }
}
__device__ __forceinline__ void load_raw(const Frame& F, const bf16* g, int pos0, int lds_off) {
  for (int p = F.tid; p < 67 * 16; p += NTHR) { const int row = p >> 4, ch = p & 15, pos = pos0 - 3 + row;
    v4u v = {0u, 0u, 0u, 0u}; if (pos >= MPOS0) v = *(const v4u*)(g + (size_t)pos * 128 + ch * 8);
    *(LAS v4u*)(F.lds + lds_off + row * 256 + ch * 16) = v; }
}
__device__ __forceinline__ void conv16(const Frame& F, int qk, int lds_off, int t, int d0, float (&y)[16]) {
  const LAS float* CW = (const LAS float*)(F.lds + L_CW);
#pragma unroll
  for (int e = 0; e < 16; ++e) y[e] = CW[(qk * 5 + 4) * 128 + d0 + e];
#pragma unroll
  for (int j = 0; j < 4; ++j) { const LAS v4u* rp = (const LAS v4u*)(F.lds + lds_off + (t + j) * 256 + d0 * 2); const v4u r0 = rp[0], r1 = rp[1];
    const LAS float* cw = CW + (qk * 5 + j) * 128 + d0;
    y[0] += cw[0] * bflo(r0.x); y[1] += cw[1] * bfhi(r0.x); y[2] += cw[2] * bflo(r0.y); y[3] += cw[3] * bfhi(r0.y); y[4] += cw[4] * bflo(r0.z); y[5] += cw[5] * bfhi(r0.z); y[6] += cw[6] * bflo(r0.w); y[7] += cw[7] * bfhi(r0.w);
    y[8] += cw[8] * bflo(r1.x); y[9] += cw[9] * bfhi(r1.x); y[10] += cw[10] * bflo(r1.y); y[11] += cw[11] * bfhi(r1.y); y[12] += cw[12] * bflo(r1.z); y[13] += cw[13] * bfhi(r1.z); y[14] += cw[14] * bflo(r1.w); y[15] += cw[15] * bfhi(r1.w); }
#pragma unroll
  for (int e = 0; e < 16; ++e) y[e] = y[e] / (1.0f + __expf(-y[e]));
}
__device__ __forceinline__ void load_vt(const Frame& F, const bf16* MVg, int pos0) {
#pragma unroll
  for (int i = 0; i < 4; ++i) { const int p = F.tid + NTHR * i, row = p >> 5, ch = p & 31; v4u v4 = {0u, 0u, 0u, 0u};
    if (pos0 + row >= MPOS0) v4 = *(const v4u*)(MVg + (size_t)(pos0 + row) * 256 + ch * 8);
    LAS bf16* vt = (LAS bf16*)(F.lds + L_VT) + (ch * 8) * TST + row;
    vt[0 * TST] = (bf16)(v4.x & 0xffff); vt[1 * TST] = (bf16)(v4.x >> 16); vt[2 * TST] = (bf16)(v4.y & 0xffff); vt[3 * TST] = (bf16)(v4.y >> 16);
    vt[4 * TST] = (bf16)(v4.z & 0xffff); vt[5 * TST] = (bf16)(v4.z >> 16); vt[6 * TST] = (bf16)(v4.w & 0xffff); vt[7 * TST] = (bf16)(v4.w >> 16); }
}

__device__ __forceinline__ void taskA(const Frame& F, const Args& a, int task) {
  const int bh = task >> 5, c = task & 31, h = bh & 3, tid = F.tid, w = F.wave, lane = F.lane, fr = lane & 15, kq = lane >> 4, pos0 = 64 * c;
  LAS unsigned char* lds = F.lds; LAS float* G = (LAS float*)(lds + L_G);
  const bf16* MKg = (const bf16*)(F.ws + WS_MK) + (size_t)bh * PADT * 128; const bf16* MVg = (const bf16*)(F.ws + WS_MV) + (size_t)bh * PADT * 256;
  __syncthreads();
  load_cw(F, a, h); load_raw(F, MKg, pos0, L_RK); load_vt(F, MVg, pos0);
  if (w == 0) {
    const bool dead = pos0 + lane < MPOS0;
    const float li = dead ? -1e30f : ((const float*)(F.ws + WS_LI))[bh * PADT + pos0 + lane], lf = dead ? 0.f : ((const float*)(F.ws + WS_LF))[bh * PADT + pos0 + lane];
    float bs = lf;
#pragma unroll
    for (int d = 1; d < 64; d <<= 1) { const float o = shfl_up_f(bs, d); if (lane >= d) bs += o; }
    const float av = li - bs; float mx = av;
#pragma unroll
    for (int o = 1; o < 64; o <<= 1) mx = fmaxf(mx, __shfl_xor(mx, o));
    G[G_WG + lane] = __expf(av - mx);
    if (lane == 63) { float* gs = (float*)(F.ws + WS_GS) + (size_t)(bh * 33 + c) * 2; gs[0] = bs; gs[1] = mx; }
  }
  __syncthreads();
  { const int t = tid >> 3, d0 = (tid & 7) * 16; float y[16]; conv16(F, 1, L_RK, t, d0, y);
    const float sw = 0.08838834764831845f * G[G_WG + t]; LAS bf16* kt = (LAS bf16*)(lds + L_KWT) + d0 * TST + t;
#pragma unroll
    for (int e = 0; e < 16; ++e) kt[e * TST] = (bf16)f2bf(y[e] * sw); }
  __syncthreads();
  f32x4* DCg = (f32x4*)(F.ws + WS_DC) + ((size_t)(bh * 32 + c) * 128) * 64;
#pragma unroll
  for (int jj = 0; jj < 2; ++jj) { const int j = 2 * w + jj;
    const bf16x8 bv0 = *(const LAS bf16x8*)(lds + L_VT + ((16 * j + fr) * TST + 8 * kq) * 2), bv1 = *(const LAS bf16x8*)(lds + L_VT + ((16 * j + fr) * TST + 32 + 8 * kq) * 2);
#pragma unroll
    for (int i = 0; i < 8; ++i) { f32x4 acc = {0.f, 0.f, 0.f, 0.f};
      const bf16x8 k0 = *(const LAS bf16x8*)(lds + L_KWT + ((16 * i + fr) * TST + 8 * kq) * 2), k1 = *(const LAS bf16x8*)(lds + L_KWT + ((16 * i + fr) * TST + 32 + 8 * kq) * 2);
      acc = __builtin_amdgcn_mfma_f32_16x16x32_bf16(k0, bv0, acc, 0, 0, 0); acc = __builtin_amdgcn_mfma_f32_16x16x32_bf16(k1, bv1, acc, 0, 0, 0);
      DCg[(size_t)(i * 16 + j) * 64 + lane] = acc; } }
  if (tid < 128) { const LAS v4u* kr = (const LAS v4u*)(lds + L_KWT + tid * TST * 2); float s = 0.f;
#pragma unroll
    for (int q = 0; q < 8; ++q) { const v4u x = kr[q]; s += (bflo(x.x) + bfhi(x.x)) + (bflo(x.y) + bfhi(x.y)) + (bflo(x.z) + bfhi(x.z)) + (bflo(x.w) + bfhi(x.w)); }
    ((float*)(F.ws + WS_DN))[(size_t)(bh * 32 + c) * 128 + tid] = s; }
}

__device__ __forceinline__ void scanB(const Frame& F) {
  const float* GS = (const float*)(F.ws + WS_GS);
  LAS float* cf = (LAS float*)F.lds;
  for (int blk = blockIdx.x; blk < 16 * 16; blk += gridDim.x) { const int bh = blk >> 4, r = (blk & 15) * NTHR + F.tid, i = r >> 10, j = (r >> 6) & 15, ln = r & 63;
    __syncthreads();
    if (F.tid == 0) { float m = 0.f; for (int c = 0; c < 32; ++c) { const float bL = GS[(bh * 33 + c) * 2], ml = GS[(bh * 33 + c) * 2 + 1], me = fmaxf(m, ml);
        cf[2 * c] = __expf(m - me); cf[2 * c + 1] = __expf(ml - me); m = bL + me; } }
    __syncthreads();
    const f32x4* dc = (const f32x4*)(F.ws + WS_DC) + ((size_t)(bh * 32) * 128 + (i * 16 + j)) * 64 + ln;
    v2u* cs = (v2u*)(F.ws + WS_CS) + ((((size_t)bh * 33) * 4 + (i >> 1)) * 16 + j) * 64 * 2 + ln * 2 + (i & 1);
    f32x4 st = {0.f, 0.f, 0.f, 0.f};
#pragma unroll 8
    for (int c = 0; c < 32; ++c) { st = st * cf[2 * c] + dc[(size_t)c * 128 * 64] * cf[2 * c + 1];
      v2u o; o.x = pk2(st.x, st.y); o.y = pk2(st.z, st.w); cs[(size_t)(c + 1) * 4 * 16 * 64 * 2] = o; } }
  const int gt = blockIdx.x * NTHR + F.tid, NT = gridDim.x * NTHR;
  for (int g = gt; g < 16 * 128; g += NT) { const int bh = g >> 7, d = g & 127; float n = 0.f, m = 0.f;
    for (int c = 0; c < 32; ++c) { const float bL = GS[(bh * 33 + c) * 2], ml = GS[(bh * 33 + c) * 2 + 1], me = fmaxf(m, ml);
      n = n * __expf(m - me) + ((const float*)(F.ws + WS_DN))[(size_t)(bh * 32 + c) * 128 + d] * __expf(ml - me); m = bL + me;
      ((float*)(F.ws + WS_NS))[(size_t)(bh * 33 + c + 1) * 128 + d] = n; if (d == 0) ((float*)(F.ws + WS_MS))[bh * 33 + c + 1] = m; } }
}

__device__ __forceinline__ void taskC(const Frame& F, const Args& a, int task) {
  const int bh = task >> 5, c = (task & 31) + 1, b = bh >> 2, h = bh & 3, tid = F.tid, w = F.wave, lane = F.lane, fr = lane & 15, kq = lane >> 4, pos0 = 64 * c;
  LAS unsigned char* lds = F.lds; LAS float* G = (LAS float*)(lds + L_G); LAS float* NV = (LAS float*)(lds + L_NV);
  const bf16* MQg = (const bf16*)(F.ws + WS_MQ) + (size_t)bh * PADT * 128; const bf16* MKg = (const bf16*)(F.ws + WS_MK) + (size_t)bh * PADT * 128;
  const bf16* MVg = (const bf16*)(F.ws + WS_MV) + (size_t)bh * PADT * 256;
  const float m = ((const float*)(F.ws + WS_MS))[bh * 33 + c];
  __syncthreads();
  load_cw(F, a, h); load_raw(F, MQg, pos0, L_RQ); load_raw(F, MKg, pos0, L_RK); load_vt(F, MVg, pos0);
  if (tid < 128) NV[tid] = ((const float*)(F.ws + WS_NS))[(size_t)(bh * 33 + c) * 128 + tid];
  if (w == 0) {
    const float li = ((const float*)(F.ws + WS_LI))[bh * PADT + pos0 + lane], lf = ((const float*)(F.ws + WS_LF))[bh * PADT + pos0 + lane];
    float bs = lf;
#pragma unroll
    for (int d = 1; d < 64; d <<= 1) { const float o = shfl_up_f(bs, d); if (lane >= d) bs += o; }
    const float av = li - bs; float cm = av;
#pragma unroll
    for (int d = 1; d < 64; d <<= 1) { const float o = shfl_up_f(cm, d); if (lane >= d) cm = fmaxf(cm, o); }
    const float Mt = fmaxf(m, cm);
    G[G_A + lane] = av; G[G_M + lane] = Mt; G[G_WI + lane] = __expf(m - Mt); G[G_EM + lane] = __expf(-(bs + Mt));
  }
  __syncthreads();
  { const int t = tid >> 3, d0 = (tid & 7) * 16; const float wi = G[G_WI + t]; float y[16];
    conv16(F, 0, L_RQ, t, d0, y);
    { v4u o0, o1, w0, w1;
      o0.x = pk2(y[0], y[1]); o0.y = pk2(y[2], y[3]); o0.z = pk2(y[4], y[5]); o0.w = pk2(y[6], y[7]); o1.x = pk2(y[8], y[9]); o1.y = pk2(y[10], y[11]); o1.z = pk2(y[12], y[13]); o1.w = pk2(y[14], y[15]);
      w0.x = pk2(y[0] * wi, y[1] * wi); w0.y = pk2(y[2] * wi, y[3] * wi); w0.z = pk2(y[4] * wi, y[5] * wi); w0.w = pk2(y[6] * wi, y[7] * wi);
      w1.x = pk2(y[8] * wi, y[9] * wi); w1.y = pk2(y[10] * wi, y[11] * wi); w1.z = pk2(y[12] * wi, y[13] * wi); w1.w = pk2(y[14] * wi, y[15] * wi);
      LAS v4u* qs = (LAS v4u*)(lds + L_QS + (t * QST + d0) * 2); qs[0] = o0; qs[1] = o1;
      LAS v4u* qw = (LAS v4u*)(lds + L_QW + (t * QST + d0) * 2); qw[0] = w0; qw[1] = w1; }
    __builtin_amdgcn_sched_barrier(0);
    conv16(F, 1, L_RK, t, d0, y);
    { const float sc = 0.08838834764831845f; v4u o0, o1;
      o0.x = pk2(y[0] * sc, y[1] * sc); o0.y = pk2(y[2] * sc, y[3] * sc); o0.z = pk2(y[4] * sc, y[5] * sc); o0.w = pk2(y[6] * sc, y[7] * sc);
      o1.x = pk2(y[8] * sc, y[9] * sc); o1.y = pk2(y[10] * sc, y[11] * sc); o1.z = pk2(y[12] * sc, y[13] * sc); o1.w = pk2(y[14] * sc, y[15] * sc);
      LAS v4u* ks = (LAS v4u*)(lds + L_KS + (t * QST + d0) * 2); ks[0] = o0; ks[1] = o1; } }
  __syncthreads();
  v4u cb[4][2];
  { const v4u* cs = (const v4u*)(F.ws + WS_CS) + (((size_t)bh * 33 + c) * 4 * 16) * 64;
#pragma unroll
    for (int I = 0; I < 4; ++I)
#pragma unroll
      for (int jj = 0; jj < 2; ++jj) cb[I][jj] = cs[(size_t)(I * 16 + 2 * w + jj) * 64 + lane]; }
  { const int si = w >> 1; const f32x4 as = *(const LAS f32x4*)(G + G_A + 16 * si + 4 * kq);
#pragma unroll
    for (int tt = 0; tt < 2; ++tt) { const int ti = 2 * (w & 1) + tt; f32x4 acc = {0.f, 0.f, 0.f, 0.f};
#pragma unroll
      for (int ks = 0; ks < 4; ++ks) { const bf16x8 af = *(const LAS bf16x8*)(lds + L_KS + ((16 * si + fr) * QST + 32 * ks + 8 * kq) * 2);
        const bf16x8 bfr = *(const LAS bf16x8*)(lds + L_QS + ((16 * ti + fr) * QST + 32 * ks + 8 * kq) * 2);
        acc = __builtin_amdgcn_mfma_f32_16x16x32_bf16(af, bfr, acc, 0, 0, 0); }
      const int t = 16 * ti + fr, s0 = 16 * si + 4 * kq; const float Mt = G[G_M + t];
      const float v0 = (s0 + 0 <= t) ? acc.x * __expf(as.x - Mt) : 0.f, v1 = (s0 + 1 <= t) ? acc.y * __expf(as.y - Mt) : 0.f;
      const float v2 = (s0 + 2 <= t) ? acc.z * __expf(as.z - Mt) : 0.f, v3 = (s0 + 3 <= t) ? acc.w * __expf(as.w - Mt) : 0.f;
      v2u o; o.x = pk2(v0, v1); o.y = pk2(v2, v3);
      *(LAS v2u*)(lds + L_SP + (t * TST + s0) * 2) = o; } }
  __syncthreads();
  if (w == 0) { const int t = lane; float qn = 0.f, rsum = 0.f;
#pragma unroll 4
    for (int q = 0; q < 16; ++q) { const v4u x = *(const LAS v4u*)(lds + L_QS + (t * QST + q * 8) * 2); const f32x4 n0 = *(const LAS f32x4*)(NV + q * 8), n1 = *(const LAS f32x4*)(NV + q * 8 + 4);
      qn += bflo(x.x) * n0.x + bfhi(x.x) * n0.y + bflo(x.y) * n0.z + bfhi(x.y) * n0.w + bflo(x.z) * n1.x + bfhi(x.z) * n1.y + bflo(x.w) * n1.z + bfhi(x.w) * n1.w; }
#pragma unroll
    for (int q = 0; q < 8; ++q) { const v4u x = *(const LAS v4u*)(lds + L_SP + (t * TST + q * 8) * 2); rsum += (bflo(x.x) + bfhi(x.x)) + (bflo(x.y) + bfhi(x.y)) + (bflo(x.z) + bfhi(x.z)) + (bflo(x.w) + bfhi(x.w)); }
    const float den = G[G_WI + t] * qn + rsum; G[G_DEN + t] = fmaxf(fabsf(den), G[G_EM + t]); }
  f32x4 acc[2][4];
#pragma unroll
  for (int jj = 0; jj < 2; ++jj)
#pragma unroll
    for (int ti = 0; ti < 4; ++ti) acc[jj][ti] = (f32x4){0.f, 0.f, 0.f, 0.f};
#pragma unroll
  for (int I = 0; I < 4; ++I) {
#pragma unroll
    for (int ti = 0; ti < 4; ++ti) { const LAS unsigned char* qp = lds + L_QW + ((16 * ti + fr) * QST + 32 * I + 4 * kq) * 2;
      const v2u a0 = *(const LAS v2u*)qp, a1 = *(const LAS v2u*)(qp + 32); const v4u av = {a0.x, a0.y, a1.x, a1.y};
      acc[0][ti] = __builtin_amdgcn_mfma_f32_16x16x32_bf16(__builtin_bit_cast(bf16x8, av), __builtin_bit_cast(bf16x8, cb[I][0]), acc[0][ti], 0, 0, 0);
      acc[1][ti] = __builtin_amdgcn_mfma_f32_16x16x32_bf16(__builtin_bit_cast(bf16x8, av), __builtin_bit_cast(bf16x8, cb[I][1]), acc[1][ti], 0, 0, 0); }
    __builtin_amdgcn_sched_barrier(0); }
#pragma unroll
  for (int ks = 0; ks < 2; ++ks) { const bf16x8 bv0 = *(const LAS bf16x8*)(lds + L_VT + ((32 * w + fr) * TST + 32 * ks + 8 * kq) * 2), bv1 = *(const LAS bf16x8*)(lds + L_VT + ((32 * w + 16 + fr) * TST + 32 * ks + 8 * kq) * 2);
#pragma unroll
    for (int ti = 0; ti < 4; ++ti) { const bf16x8 sf = *(const LAS bf16x8*)(lds + L_SP + ((16 * ti + fr) * TST + 32 * ks + 8 * kq) * 2);
      acc[0][ti] = __builtin_amdgcn_mfma_f32_16x16x32_bf16(sf, bv0, acc[0][ti], 0, 0, 0); acc[1][ti] = __builtin_amdgcn_mfma_f32_16x16x32_bf16(sf, bv1, acc[1][ti], 0, 0, 0); } }
  __syncthreads();
  LAS float* SSQ = (LAS float*)(lds + L_SSQ);
#pragma unroll
  for (int ti = 0; ti < 4; ++ti) { const f32x4 dn = *(const LAS f32x4*)(G + G_DEN + 16 * ti + 4 * kq);
    f32x4 s4;
#pragma unroll
    for (int r = 0; r < 4; ++r) { const float h0 = acc[0][ti][r] / dn[r], h1 = acc[1][ti][r] / dn[r]; acc[0][ti][r] = h0; acc[1][ti][r] = h1; s4[r] = h0 * h0 + h1 * h1; }
#pragma unroll
    for (int o = 1; o < 16; o <<= 1) { s4.x += __shfl_xor(s4.x, o); s4.y += __shfl_xor(s4.y, o); s4.z += __shfl_xor(s4.z, o); s4.w += __shfl_xor(s4.w, o); }
    if (fr == 0) { SSQ[(16 * ti + 4 * kq + 0) * 8 + w] = s4.x; SSQ[(16 * ti + 4 * kq + 1) * 8 + w] = s4.y; SSQ[(16 * ti + 4 * kq + 2) * 8 + w] = s4.z; SSQ[(16 * ti + 4 * kq + 3) * 8 + w] = s4.w; } }
  __syncthreads();
  LAS bf16* HT = (LAS bf16*)(lds + L_HT);
#pragma unroll
  for (int ti = 0; ti < 4; ++ti)
#pragma unroll
    for (int r = 0; r < 4; ++r) { const int t = 16 * ti + 4 * kq + r; const f32x4 p0 = *(const LAS f32x4*)(SSQ + t * 8), p1 = *(const LAS f32x4*)(SSQ + t * 8 + 4);
      const float rh = rsqrtf(((p0.x + p0.y) + (p0.z + p0.w) + (p1.x + p1.y) + (p1.z + p1.w)) * (1.0f / 256.f) + EPS);
      HT[t * 264 + 32 * w + fr] = (bf16)f2bf(acc[0][ti][r] * rh); HT[t * 264 + 32 * w + 16 + fr] = (bf16)f2bf(acc[1][ti][r] * rh); }
  __syncthreads();
  { const int t = tid >> 3, c0 = (tid & 7) * 32; const size_t R = (size_t)b * SEQ + 64 * (c - 1) + t;
    const bf16* mo = (const bf16*)(F.ws + WS_MO) + R * 1024 + h * 256 + c0; const float* og = a.in[IN_OUTG] + h * 256 + c0; bf16* A2 = (bf16*)(F.ws + WS_A2) + R * DM + 1024 + h * 256 + c0;
#pragma unroll
    for (int q = 0; q < 4; ++q) { const v4u hv = *(const LAS v4u*)(HT + t * 264 + c0 + q * 8); const v4u mv = *(const v4u*)(mo + q * 8); const f32x4 g0 = *(const f32x4*)(og + q * 8), g1 = *(const f32x4*)(og + q * 8 + 4);
      v4u o; o.x = pk2(bflo(hv.x) * g0.x * bflo(mv.x), bfhi(hv.x) * g0.y * bfhi(mv.x)); o.y = pk2(bflo(hv.y) * g0.z * bflo(mv.y), bfhi(hv.y) * g0.w * bfhi(mv.y));
      o.z = pk2(bflo(hv.z) * g1.x * bflo(mv.z), bfhi(hv.z) * g1.y * bfhi(mv.z)); o.w = pk2(bflo(hv.w) * g1.z * bflo(mv.w), bfhi(hv.w) * g1.w * bfhi(mv.w));
      *(v4u*)(A2 + q * 8) = o; } }
}
}
__device__ __forceinline__ void p3_combine(const Frame& F, const Args& a, int NA) {
  const float* PO = (const float*)(F.ws + WS_PO); const float* ML = (const float*)(F.ws + WS_ML);
  bf16* A2 = (bf16*)(F.ws + WS_A2);
  const float lam = *(const float*)(F.ws + WS_LAM);
  const float* subg = a.in[IN_SUBG];
  const int gw = blockIdx.x * NWAVES + F.wave, NGW = gridDim.x * NWAVES, lane = F.lane;
  const f32x4 sg = ((const f32x4*)subg)[lane];
  for (int R = gw; R < MROWS; R += NGW) {
    const int b = R >> 11, t = R & 2047, qb = t >> 8, rq = t & 255;
#pragma unroll 2
    for (int h = 0; h < 4; ++h) {
      f32x4 om[2];
#pragma unroll
      for (int m = 0; m < 2; ++m) {
        const int bhm = (b * 4 + h) * 2 + m, first = bhm * att::STEPS_BHM + att::qb_start(qb), last = first + 4 * qb + 4;
        const int cf = att::chunk_of(first, NA), np = att::chunk_of(last, NA) - cf + 1, slot0 = bhm * 16 + qb + cf - att::chunk_of(bhm * att::STEPS_BHM, NA);
        float mp[3], lp[3]; f32x4 op[3];
#pragma unroll
        for (int p = 0; p < 3; ++p) { if (p < np) { const int slot = slot0 + p; mp[p] = ML[(size_t)slot * 512 + rq * 2]; lp[p] = ML[(size_t)slot * 512 + rq * 2 + 1];
            op[p] = ((const f32x4*)(PO + ((size_t)slot * 256 + rq) * 256))[lane]; } else { mp[p] = -1e30f; lp[p] = 0.f; op[p] = (f32x4){0.f, 0.f, 0.f, 0.f}; } }
        const float M = fmaxf(mp[0], fmaxf(mp[1], mp[2]));
        float wsum = 0.f; f32x4 acc = (f32x4){0.f, 0.f, 0.f, 0.f};
#pragma unroll
        for (int p = 0; p < 3; ++p) { const float w = lp[p] * exp2f(mp[p] - M); wsum += w; acc += op[p] * w; }
        om[m] = acc * (1.0f / wsum);
      }
      const f32x4 o = om[0] - om[1] * lam;
      const float rs = rsqrtf(wave_sum((o.x * o.x + o.y * o.y) + (o.z * o.z + o.w * o.w)) * (1.0f / 256.f) + EPS) * 0.8f;
      v2u w; w.x = pk2(o.x * rs * sg.x, o.y * rs * sg.y); w.y = pk2(o.z * rs * sg.z, o.w * rs * sg.w);
      ((v2u*)(A2 + (size_t)R * DM + h * 256))[lane] = w;
    }
  }
}
struct EpiRes {
  static constexpr bool PERM = true, AFTER_DRAIN = false;
  const float* x; float* out; bf16* H1b; float* SSQ;
  __device__ __forceinline__ void operator()(const pg8::f32x4 (&acc)[2][2][4][2], const pg8::Unit& u, int wr, int wc, int fr, int fq) const {
    const int row0 = u.pm * 256 + wr * 64 + fr, col0 = u.pn * 256 + wc * 32 + 8 * fq;
#pragma unroll
    for (int ai = 0; ai < 2; ++ai)
#pragma unroll
      for (int m = 0; m < 4; ++m) { const size_t R = (size_t)(row0 + ai * 128 + m * 16); float s = 0.f;
#pragma unroll
        for (int bj = 0; bj < 2; ++bj) { const size_t off = R * DM + col0 + bj * 128;
          const f32x4 x0 = *(const f32x4*)(x + off), x1 = *(const f32x4*)(x + off + 4);
          const f32x4 v0 = acc[ai][bj][m][0] + x0, v1 = acc[ai][bj][m][1] + x1;
          v4u w; w.x = pk2(v0.x, v0.y); w.y = pk2(v0.z, v0.w); w.z = pk2(v1.x, v1.y); w.w = pk2(v1.z, v1.w);
          *(v4u*)(H1b + off) = w;
          s += (v0.x * v0.x + v0.y * v0.y) + (v0.z * v0.z + v0.w * v0.w) + (v1.x * v1.x + v1.y * v1.y) + (v1.z * v1.z + v1.w * v1.w); }
        s += __shfl_xor(s, 16); s += __shfl_xor(s, 32);
        if (fq == 0) SSQ[R * 32 + u.pn * 4 + wc] = s; }
  }
};
#ifndef PEER_U_FP8
#define PEER_U_FP8 0
#endif
typedef __bf16 bfv2 __attribute__((ext_vector_type(2)));
__device__ __forceinline__ void split_hl(const f32x4 a, const f32x4 b, bf16x8& hi, bf16x8& lo) {
  float v[8] = {a.x, a.y, a.z, a.w, b.x, b.y, b.z, b.w}; unsigned h[8], l[8];
#pragma unroll
  for (int i = 0; i < 8; ++i) { h[i] = f2bf(v[i]); l[i] = f2bf(v[i] - __builtin_bit_cast(float, h[i] << 16)); }
  v4u hv = {h[0] | (h[1] << 16), h[2] | (h[3] << 16), h[4] | (h[5] << 16), h[6] | (h[7] << 16)};
  v4u lv = {l[0] | (l[1] << 16), l[2] | (l[3] << 16), l[4] | (l[5] << 16), l[6] | (l[7] << 16)};
  hi = __builtin_bit_cast(bf16x8, hv); lo = __builtin_bit_cast(bf16x8, lv);
}
__device__ __forceinline__ void p0_w3t(const Frame& F, const Args& a) {
  const float* wq = a.in[IN_WQ]; const float* sk = a.in[IN_SUBK]; const float* g2 = a.in[IN_G2];
  bf16* W3t = (bf16*)(F.ws + WS_W3T);
  const int gw = blockIdx.x * NWAVES + F.wave, NGW = gridDim.x * NWAVES, lane = F.lane, fr = lane & 15, fq = lane >> 4;
  for (int task = gw; task < 128 * 16; task += NGW) {
    const int kt = task >> 4, hh = task & 15;
    bf16x8 ahi[4], alo[4];
    const float* ap = wq + (size_t)(kt * 16 + fr) * DM + hh * 128 + fq * 8;
#pragma unroll
    for (int s = 0; s < 4; ++s) split_hl(*(const f32x4*)(ap + 32 * s), *(const f32x4*)(ap + 32 * s + 4), ahi[s], alo[s]);
    const f32x4 gk = *(const f32x4*)(g2 + kt * 16 + fq * 4);
#pragma unroll 1
    for (int t2 = 0; t2 < 8; ++t2) {
      const float* bp = sk + (size_t)(hh * 128 + t2 * 16 + fr) * 128 + fq * 8;
      f32x4 acc = {0.f, 0.f, 0.f, 0.f};
#pragma unroll
      for (int s = 0; s < 4; ++s) { bf16x8 bhi, blo; split_hl(*(const f32x4*)(bp + 32 * s), *(const f32x4*)(bp + 32 * s + 4), bhi, blo);
        acc = __builtin_amdgcn_mfma_f32_16x16x32_bf16(ahi[s], bhi, acc, 0, 0, 0);
        acc = __builtin_amdgcn_mfma_f32_16x16x32_bf16(ahi[s], blo, acc, 0, 0, 0);
        acc = __builtin_amdgcn_mfma_f32_16x16x32_bf16(alo[s], bhi, acc, 0, 0, 0); }
      v2u o; o.x = pk2(acc.x * gk.x, acc.y * gk.y); o.y = pk2(acc.z * gk.z, acc.w * gk.w);
      *(v2u*)(W3t + (size_t)(hh * 128 + t2 * 16 + fr) * DM + kt * 16 + fq * 4) = o;
    }
  }
}
typedef float f32x2v __attribute__((ext_vector_type(2)));
__device__ __forceinline__ void p0_tables(const Frame& F, const Args& a) {
  const float* g2 = a.in[IN_G2];
  float* SCL = (float*)(F.ws + WS_SCL);
  const int gw = blockIdx.x * NWAVES + F.wave, NGW = gridDim.x * NWAVES, lane = F.lane;
  f32x4 gl[8];
#pragma unroll
  for (int q = 0; q < 8; ++q) gl[q] = *(const f32x4*)(g2 + lane * 32 + q * 4);
  f32x4 xn[8];
  { const int row = gw; if (row < 2 * 16384) { const float* src = a.in[row >= 16384 ? IN_V : IN_U] + (size_t)(row & 16383) * DM + lane * 32;
#pragma unroll
      for (int q = 0; q < 8; ++q) xn[q] = *(const f32x4*)(src + q * 4); } }
  for (int row = gw; row < 2 * 16384; row += NGW) {
    const bool isv = row >= 16384; const int e = row & 16383;
    f32x4 x[8];
#pragma unroll
    for (int q = 0; q < 8; ++q) x[q] = xn[q];
    { const int rn = row + NGW; if (rn < 2 * 16384) { const float* src = a.in[rn >= 16384 ? IN_V : IN_U] + (size_t)(rn & 16383) * DM + lane * 32;
#pragma unroll
        for (int q = 0; q < 8; ++q) xn[q] = *(const f32x4*)(src + q * 4); } }
    float amax = 0.f;
#pragma unroll
    for (int q = 0; q < 8; ++q) { if (!isv) x[q] = x[q] * gl[q]; amax = fmaxf(amax, fmaxf(fmaxf(fabsf(x[q].x), fabsf(x[q].y)), fmaxf(fabsf(x[q].z), fabsf(x[q].w)))); }
#pragma unroll
    for (int o = 1; o < 64; o <<= 1) amax = fmaxf(amax, __shfl_xor(amax, o));
    const float sc = amax > 0.f ? 6.0f / amax : 1.0f;
    v4u w;
#pragma unroll
    for (int d = 0; d < 4; ++d) { unsigned pk = 0u;
      pk = __builtin_amdgcn_cvt_scalef32_pk_fp4_f32(pk, x[2 * d].x * sc, x[2 * d].y * sc, 1.0f, 0); pk = __builtin_amdgcn_cvt_scalef32_pk_fp4_f32(pk, x[2 * d].z * sc, x[2 * d].w * sc, 1.0f, 1);
      pk = __builtin_amdgcn_cvt_scalef32_pk_fp4_f32(pk, x[2 * d + 1].x * sc, x[2 * d + 1].y * sc, 1.0f, 2); pk = __builtin_amdgcn_cvt_scalef32_pk_fp4_f32(pk, x[2 * d + 1].z * sc, x[2 * d + 1].w * sc, 1.0f, 3);
      w[d] = pk; }
    *(v4u*)(F.ws + (isv ? WS_VB8 : WS_UB) + (size_t)e * 1024 + lane * 16) = w;
    if (lane == 0) SCL[row] = 1.0f / sc;
  }
}
struct EpiScore {
  static constexpr bool PERM = true, AFTER_DRAIN = false;
  float* S; const LAS float* rs;
  __device__ __forceinline__ void operator()(const pg8::f32x4 (&acc)[2][2][4][2], const pg8::Unit& u, int wr, int wc, int fr, int fq) const {
    const int rl0 = wr * 64 + fr, col0 = u.pn * 256 + wc * 32 + 8 * fq;
#pragma unroll
    for (int ai = 0; ai < 2; ++ai)
#pragma unroll
      for (int m = 0; m < 4; ++m) { const int rl = rl0 + ai * 128 + m * 16; const float r = rs[rl]; const size_t R = (size_t)u.pm * 256 + rl;
#pragma unroll
        for (int bj = 0; bj < 2; ++bj) { float* d = S + R * DM + col0 + bj * 128;
          *(f32x4*)d = acc[ai][bj][m][0] * r; *(f32x4*)(d + 4) = acc[ai][bj][m][1] * r; } }
  }
};

__device__ __forceinline__ unsigned fkey(float f) { const unsigned b = __builtin_bit_cast(unsigned, f); return b ^ ((b >> 31) ? 0xFFFFFFFFu : 0x80000000u); }
template <int NV, int K> __device__ __forceinline__ void wave_topk(const unsigned (&u)[NV], bool (&sel)[NV], int lane) {
  unsigned prefix = 0u; int cge = NV * 64;
#pragma unroll 1
  for (int bit = 31; bit >= 0 && cge != K; --bit) {
    const unsigned cand = prefix | (1u << bit); int c = 0;
#pragma unroll
    for (int i = 0; i < NV; ++i) c += __builtin_popcountll(__ballot(u[i] >= cand));
    if (c >= K) { prefix = cand; cge = c; }
  }
  int cgt = 0;
#pragma unroll
  for (int i = 0; i < NV; ++i) cgt += __builtin_popcountll(__ballot(u[i] > prefix));
  int need = K - cgt;
  const unsigned long long lm = (1ull << lane) - 1ull;
#pragma unroll
  for (int i = 0; i < NV; ++i) { const unsigned long long eq = __ballot(u[i] == prefix); const int before = __builtin_popcountll(eq & lm);
    sel[i] = (u[i] > prefix) || (u[i] == prefix && before < need); const int ne = __builtin_popcountll(eq); need = need > ne ? need - ne : 0; }
}
template <int NG, int NV, int K> __device__ __forceinline__ void wave_topk_multi(const unsigned (&u)[NG][NV], bool (&sel)[NG][NV], int lane) {
  unsigned prefix[NG]; int cge[NG];
#pragma unroll
  for (int g = 0; g < NG; ++g) { prefix[g] = 0u; cge[g] = NV * 64; }
#pragma unroll 1
  for (int bit = 31; bit >= 0; --bit) {
    bool done = true;
#pragma unroll
    for (int g = 0; g < NG; ++g) done = done && (cge[g] == K);
    if (done) break;
#pragma unroll
    for (int g = 0; g < NG; ++g) { const unsigned cand = prefix[g] | (1u << bit); int c = 0;
#pragma unroll
      for (int i = 0; i < NV; ++i) c += __builtin_popcountll(__ballot(u[g][i] >= cand));
      if (cge[g] != K && c >= K) { prefix[g] = cand; cge[g] = c; } }
  }
  const unsigned long long lm = (1ull << lane) - 1ull;
#pragma unroll
  for (int g = 0; g < NG; ++g) { int cgt = 0;
#pragma unroll
    for (int i = 0; i < NV; ++i) cgt += __builtin_popcountll(__ballot(u[g][i] > prefix[g]));
    int need = K - cgt;
#pragma unroll
    for (int i = 0; i < NV; ++i) { const unsigned long long eq = __ballot(u[g][i] == prefix[g]); const int before = __builtin_popcountll(eq & lm);
      sel[g][i] = (u[g][i] > prefix[g]) || (u[g][i] == prefix[g] && before < need); const int ne = __builtin_popcountll(eq); need = need > ne ? need - ne : 0; } }
}
__device__ __forceinline__ float gelu_erf(float v) {
  const float av = fabsf(v), t = __builtin_amdgcn_rcpf(1.0f + 0.2316418882f * av);
  float q = t * 0.5307027145f - 0.7265760135f; q = q * t + 0.7107068705f; q = q * t - 0.142248368f; q = q * t + 0.127414796f; q = q * t;
  const float tail = q * __builtin_amdgcn_exp2f(v * v * -0.72134752044f);
  return v < 0.f ? v * tail : v - v * tail;
}

#ifndef ROUTE_REPS
#define ROUTE_REPS 1
#endif
__device__ __forceinline__ void p6_peer(const Frame& F, const Args& a, float* dst_base) {
  const float* S = (const float*)(F.ws + WS_S); const float* SSQ = (const float*)(F.ws + WS_SSQ); const bf16* H1b = (const bf16*)(F.ws + WS_H1B);
  int lane = F.lane, wv = F.wave; asm volatile("" : "+v"(lane), "+s"(wv));
  const int gw = blockIdx.x * NWAVES + wv, NGW = gridDim.x * NWAVES;
  LAS unsigned char* RB = F.lds + 12288 + wv * 16384;
  LAS float* wl = (LAS float*)RB;
  LAS int* wli = (LAS int*)wl;
  LAS int* eid = (LAS int*)(F.lds + wv * 1536); LAS float* egt = (LAS float*)(eid + 128); LAS float* esu = (LAS float*)(eid + 256);
  for (int tok = gw; tok < MROWS; tok += NGW) {
    const float rs = rsqrtf(wave_sum(lane < 32 ? SSQ[(size_t)tok * 32 + lane] : 0.f) * (1.0f / DM) + EPS);
    const float* srow = S + (size_t)tok * DM;
    const unsigned long long lmk = (1ull << lane) - 1ull;
#pragma unroll 1
    for (int gb = 0; gb < 4 * ROUTE_REPS; ++gb) {
      const int g0 = (gb & 3) * 4;
      float2 sv[4]; unsigned u[4][2]; bool sel[4][2];
#pragma unroll
      for (int q = 0; q < 4; ++q) { sv[q] = *(const float2*)(srow + (g0 + q) * 128 + 2 * lane); u[q][0] = fkey(sv[q].x); u[q][1] = fkey(sv[q].y); }
      wave_topk_multi<4, 2, 16>(u, sel, lane);
#pragma unroll
      for (int q = 0; q < 4; ++q) { const unsigned long long m0 = __ballot(sel[q][0]), m1 = __ballot(sel[q][1]);
        const int pos0 = __builtin_popcountll(m0 & lmk), pos1 = __builtin_popcountll(m0) + __builtin_popcountll(m1 & lmk);
        if (sel[q][0]) { wl[(g0 + q) * 16 + pos0] = sv[q].x; wli[256 + (g0 + q) * 16 + pos0] = 2 * lane; }
        if (sel[q][1]) { wl[(g0 + q) * 16 + pos1] = sv[q].y; wli[256 + (g0 + q) * 16 + pos1] = 2 * lane + 1; } }
    }
    asm volatile("s_waitcnt lgkmcnt(0)" ::: "memory");
    const int ci = lane >> 2, cj = 4 * (lane & 3);
#pragma unroll 1
    for (int hb = 0; hb < 2 * ROUTE_REPS; ++hb) {
      const int h0 = (hb & 1) * 4;
      float cv[4][4]; unsigned cu[4][4]; bool csel[4][4];
#pragma unroll
      for (int hq = 0; hq < 4; ++hq) { const int h8 = h0 + hq; const float s0 = wl[(2 * h8) * 16 + ci]; const f32x4 s1 = *(const LAS f32x4*)(wl + (2 * h8 + 1) * 16 + cj);
        cv[hq][0] = s0 + s1.x; cv[hq][1] = s0 + s1.y; cv[hq][2] = s0 + s1.z; cv[hq][3] = s0 + s1.w;
#pragma unroll
        for (int q = 0; q < 4; ++q) cu[hq][q] = fkey(cv[hq][q]); }
      wave_topk_multi<4, 4, 16>(cu, csel, lane);
#pragma unroll
      for (int hq = 0; hq < 4; ++hq) { const int h8 = h0 + hq;
        float mx = -INFINITY;
#pragma unroll
        for (int q = 0; q < 4; ++q) if (csel[hq][q]) mx = fmaxf(mx, cv[hq][q]);
#pragma unroll
        for (int o = 1; o < 64; o <<= 1) mx = fmaxf(mx, __shfl_xor(mx, o));
        float ev[4], es = 0.f;
#pragma unroll
        for (int q = 0; q < 4; ++q) { ev[q] = csel[hq][q] ? __expf(cv[hq][q] - mx) : 0.f; es += ev[q]; }
        es = wave_sum(es); const float inv = 1.0f / es;
        typedef int i32x4 __attribute__((ext_vector_type(4)));
        const int ki = wli[256 + (2 * h8) * 16 + ci]; const i32x4 kj = *(const LAS i32x4*)(wli + 256 + (2 * h8 + 1) * 16 + cj);
        const int kjv[4] = {kj.x, kj.y, kj.z, kj.w};
        int base = 0;
#pragma unroll
        for (int q = 0; q < 4; ++q) { const unsigned long long mq = __ballot(csel[hq][q]); const int pos = base + __builtin_popcountll(mq & lmk);
          if (csel[hq][q]) { eid[h8 * 16 + pos] = ki * 128 + kjv[q]; egt[h8 * 16 + pos] = ev[q] * inv; } base += __builtin_popcountll(mq); } }
    }
    asm volatile("s_waitcnt lgkmcnt(0)" ::: "memory");
    { const float* SCL = (const float*)(F.ws + WS_SCL);
#pragma unroll
      for (int i = 0; i < 2; ++i) { const int e = lane + 64 * i, idq = eid[e]; esu[e] = SCL[idq]; egt[e] *= SCL[16384 + idq]; } }
    unsigned xw[16];
    { const v4u* xp = (const v4u*)(H1b + (size_t)tok * DM + (size_t)lane * 32);
#pragma unroll
      for (int q = 0; q < 4; ++q) { const v4u x0 = xp[q]; xw[4 * q] = x0.x; xw[4 * q + 1] = x0.y; xw[4 * q + 2] = x0.z; xw[4 * q + 3] = x0.w; } }
    float y[32];
#pragma unroll
    for (int i = 0; i < 32; ++i) y[i] = 0.f;
    asm volatile("s_waitcnt vmcnt(0) lgkmcnt(0)" ::: "memory");
    const unsigned char* U8 = F.ws + WS_UB; const unsigned char* V8 = F.ws + WS_VB8;
#define PG_ISSUE(E) do { const int idq_ = __builtin_amdgcn_readfirstlane(eid[(E)]); LAS unsigned char* sl_ = RB + ((E) & 7) * 2048; \
      __builtin_amdgcn_global_load_lds((const unsigned*)(U8 + (size_t)idq_ * 1024 + lane * 16), (LAS unsigned*)sl_, 16, 0, 0); \
      __builtin_amdgcn_global_load_lds((const unsigned*)(V8 + (size_t)idq_ * 1024 + lane * 16), (LAS unsigned*)(sl_ + 1024), 16, 0, 0); } while (0)
#define PG_DOT(UW, DACC) do { float da_ = 0.f, db_ = 0.f; _Pragma("unroll") for (int dd = 0; dd < 4; ++dd) { const unsigned wa = UW[dd]; \
          da_ = __builtin_amdgcn_fdot2_f32_bf16(__builtin_bit_cast(bfv2, xw[4 * dd + 0]), __builtin_amdgcn_cvt_scalef32_pk_bf16_fp4(wa, 1.0f, 0), da_, false); \
          db_ = __builtin_amdgcn_fdot2_f32_bf16(__builtin_bit_cast(bfv2, xw[4 * dd + 1]), __builtin_amdgcn_cvt_scalef32_pk_bf16_fp4(wa, 1.0f, 1), db_, false); \
          da_ = __builtin_amdgcn_fdot2_f32_bf16(__builtin_bit_cast(bfv2, xw[4 * dd + 2]), __builtin_amdgcn_cvt_scalef32_pk_bf16_fp4(wa, 1.0f, 2), da_, false); \
          db_ = __builtin_amdgcn_fdot2_f32_bf16(__builtin_bit_cast(bfv2, xw[4 * dd + 3]), __builtin_amdgcn_cvt_scalef32_pk_bf16_fp4(wa, 1.0f, 3), db_, false); } DACC = da_ + db_; } while (0)
#define PG_AXPY(VW, CF) do { _Pragma("unroll") for (int dd = 0; dd < 4; ++dd) { const unsigned wa = VW[dd]; \
          { const f32x2v v2 = __builtin_amdgcn_cvt_scalef32_pk_f32_fp4(wa, 1.0f, 0); y[8 * dd + 0] += CF * v2.x; y[8 * dd + 1] += CF * v2.y; } \
          { const f32x2v v2 = __builtin_amdgcn_cvt_scalef32_pk_f32_fp4(wa, 1.0f, 1); y[8 * dd + 2] += CF * v2.x; y[8 * dd + 3] += CF * v2.y; } \
          { const f32x2v v2 = __builtin_amdgcn_cvt_scalef32_pk_f32_fp4(wa, 1.0f, 2); y[8 * dd + 4] += CF * v2.x; y[8 * dd + 5] += CF * v2.y; } \
          { const f32x2v v2 = __builtin_amdgcn_cvt_scalef32_pk_f32_fp4(wa, 1.0f, 3); y[8 * dd + 6] += CF * v2.x; y[8 * dd + 7] += CF * v2.y; } } } while (0)
#define PG_CONSUME(E) do { const LAS unsigned char* s0_ = RB + ((E) & 7) * 2048 + lane * 16; \
      const v4u u0 = *(const LAS v4u*)s0_, v0 = *(const LAS v4u*)(s0_ + 1024); \
      float d0 = 0.f; PG_DOT(u0, d0); d0 = wave_sum_dpp(d0); \
      const float c0 = gelu_erf(d0 * (rs * esu[(E)])) * egt[(E)]; \
      PG_AXPY(v0, c0); } while (0)
#pragma unroll
    for (int e = 0; e < 7; ++e) PG_ISSUE(e);
#pragma unroll 1
    for (int e = 0; e < 121; ++e) {
      PG_ISSUE(e + 7);
      asm volatile("s_waitcnt vmcnt(14)" ::: "memory");
      PG_CONSUME(e);
      asm volatile("" ::: "memory");
    }
    asm volatile("s_waitcnt vmcnt(0)" ::: "memory");
#pragma unroll 1
    for (int e = 121; e < 128; ++e) PG_CONSUME(e);
    asm volatile("s_waitcnt lgkmcnt(0)" ::: "memory");
#undef PG_ISSUE
#undef PG_DOT
#undef PG_AXPY
#undef PG_CONSUME
    float* drow = dst_base + (size_t)tok * DM;
#pragma unroll
    for (int q = 0; q < 8; ++q) { const size_t off = (size_t)lane * 32 + q * 4; f32x4 hv;
      hv.x = bflo(xw[2 * q]) + y[4 * q]; hv.y = bfhi(xw[2 * q]) + y[4 * q + 1]; hv.z = bflo(xw[2 * q + 1]) + y[4 * q + 2]; hv.w = bfhi(xw[2 * q + 1]) + y[4 * q + 3]; *(f32x4*)(drow + off) = hv; }
  }
}
constexpr int MISC_LDS = LDS_BYTES - 256;
__global__ void __launch_bounds__(NTHR, 2) mk_fwd(Args args) {
  extern __shared__ __attribute__((aligned(16))) unsigned char lds_raw[];
  Frame F; F.lds = (LAS unsigned char*)lds_raw; F.ws = args.ws; F.tid = threadIdx.x; F.lane = F.tid & 63; F.wave = __builtin_amdgcn_readfirstlane(F.tid >> 6);
  const int lo = args.ph_lo, hi = args.ph_hi, G = (int)gridDim.x, bx = (int)blockIdx.x;
  volatile LAS unsigned* misc = (volatile LAS unsigned*)(F.lds + MISC_LDS);
  if (F.tid < 16) misc[F.tid] = 0u;
  __syncthreads();
  XcdBarrier bar = xcd_barrier_post((unsigned*)(F.ws + WS_CTL) + CW_BAR, misc);
#define IN(k) (lo <= (k) && (k) < hi)
#define SEAM(k) do { if (IN(k) && IN((k) + 1)) xcd_barrier(bar); } while (0)
#define PHASE_FRAME(Fp) Frame Fp = F; asm volatile("" : "+v"(Fp.tid), "+v"(Fp.lane))
  const int NA = G;
  if (IN(0)) { PHASE_FRAME(F0);
    p0_lam(F0, args);
    p0_zero_vpad(F0);
    p0_metaproj(F0, args);
    p0_rows(F0, args);
    p0_transpose(F0, args.in[IN_WIN], DPROJ, NPROJ, (bf16*)(F.ws + WS_W1T));
    p0_transpose(F0, args.in[IN_WOUT], DM, DM, (bf16*)(F.ws + WS_W2T));
    p0_w3t(F0, args);
    p0_tables(F0, args);
  }
  SEAM(0);
  if (IN(1)) { PHASE_FRAME(F1);
    p1_meta_finalize(F1, args);
    pg8::Gemm g{(const pg8::bf16_t*)(F.ws + WS_XN), (const pg8::bf16_t*)(F.ws + WS_W1T), MROWS, NPROJ, DM};
    pg8::StaticOrder S; S.init(MROWS, NPROJ, G, bx);
    EpiProj E{(bf16*)(F.ws + WS_Q), (bf16*)(F.ws + WS_KP), (bf16*)(F.ws + WS_VP), (bf16*)(F.ws + WS_MQ), (bf16*)(F.ws + WS_MK), (bf16*)(F.ws + WS_MV), (bf16*)(F.ws + WS_MO),
              args.in[IN_QNG], args.in[IN_KNG], (LAS float*)(F.lds + XCH_OFF)};
    pg8::gemm_phase<EpiProj, pg8::StaticOrder, true, true>(F.lds + RING_OFF, g, S, E);
  }
  SEAM(1);
  if (IN(2)) {
    att::phase(F, (G % 8 == 0) ? (bx & 7) * (G >> 3) + (bx >> 3) : bx, NA);
    for (int task = bx; task < 512; task += G) ml::taskA(F, args, task);
  }
  SEAM(2);
  if (IN(3)) { PHASE_FRAME(F3); ml::scanB(F3); }
  SEAM(3);
  if (IN(4)) {
    PHASE_FRAME(F4);
    for (int task = bx; task < 512; task += G) ml::taskC(F4, args, task);
    p3_combine(F4, args, NA);
  }
  SEAM(4);
  if (IN(5)) {
    pg8::Gemm g{(const pg8::bf16_t*)(F.ws + WS_A2), (const pg8::bf16_t*)(F.ws + WS_W2T), MROWS, DM, DM};
    pg8::StaticOrder S; S.init(MROWS, DM, G, bx);
    EpiRes E{args.in[IN_X], args.out, (bf16*)(F.ws + WS_H1B), (float*)(F.ws + WS_SSQ)};
    pg8::gemm_phase<EpiRes, pg8::StaticOrder, true, true>(F.lds + RING_OFF, g, S, E);
  }
  SEAM(5);
  if (IN(6)) {
    pg8::Gemm g{(const pg8::bf16_t*)(F.ws + WS_H1B), (const pg8::bf16_t*)(F.ws + WS_W3T), MROWS, DM, DM};
    pg8::StaticOrder S; S.init(MROWS, DM, G, bx);
    LAS float* rst = (LAS float*)(F.lds + XCH_OFF);
    { pg8::Unit u0; if (S.next(0, u0)) { if (F.tid < 256) { const float* sp = (const float*)(F.ws + WS_SSQ) + ((size_t)u0.pm * 256 + F.tid) * 32; float s = 0.f;
#pragma unroll
          for (int i = 0; i < 8; ++i) { const f32x4 v = ((const f32x4*)sp)[i]; s += (v.x + v.y) + (v.z + v.w); }
          rst[F.tid] = rsqrtf(s * (1.0f / DM) + EPS); } } }
    __syncthreads();
    EpiScore E{(float*)(F.ws + WS_S), rst};
    pg8::gemm_phase<EpiScore, pg8::StaticOrder, true, true>(F.lds + RING_OFF, g, S, E);
  }
  SEAM(6);
  if (IN(7)) { PHASE_FRAME(F7); p6_peer(F7, args, args.out); }
#undef IN
#undef SEAM
}
extern "C" void kernel_launch(void* const* d_in, const int* in_sizes, int n_in, void* d_out, int out_size, void* d_ws, size_t ws_size, hipStream_t stream) {
  static int grid = 0;
  if (grid == 0) {
    int dev = 0, cus = 0, per_cu = 0;
    if (hipGetDevice(&dev) != hipSuccess || hipDeviceGetAttribute(&cus, hipDeviceAttributeMultiprocessorCount, dev) != hipSuccess) { fprintf(stderr, "device query failed\n"); grid = -1; return; }
    if (hipFuncSetAttribute((const void*)mk_fwd, hipFuncAttributeMaxDynamicSharedMemorySize, LDS_BYTES) != hipSuccess) { fprintf(stderr, "hipFuncSetAttribute failed\n"); grid = -1; return; }
    if (hipOccupancyMaxActiveBlocksPerMultiprocessor(&per_cu, (const void*)mk_fwd, NTHR, LDS_BYTES) != hipSuccess || per_cu < 1) { fprintf(stderr, "occupancy query says %d workgroups per CU: not launching\n", per_cu); (void)hipGetLastError(); grid = -1; return; }
    (void)hipGetLastError();
    grid = cus;
    if (n_in != 22 || ws_size < (size_t)512 * MiB || out_size != MROWS * DM) { fprintf(stderr, "unexpected shapes: n_in %d out %d ws %zu\n", n_in, out_size, ws_size); grid = -1; return; }
  }
  if (grid < 0) return;
  unsigned char* ws = (unsigned char*)d_ws;
  if (hipMemsetAsync(ws + WS_CTL, 0, CTL_ZERO_BYTES, stream) != hipSuccess) { fprintf(stderr, "memset failed\n"); return; }
  Args a{};
  for (int i = 0; i < 22; ++i) a.in[i] = (const float*)d_in[i];
  a.out = (float*)d_out; a.ws = ws; a.na = 0; a.pad = 0;
  a.ph_lo = 0; a.ph_hi = 8;
  hipLaunchKernelGGL(mk_fwd, dim3(grid), dim3(NTHR), LDS_BYTES, stream, a);
}
```

```cpp
#include <hip/hip_runtime.h>
#include <cstdio>
#include <cstdint>
#include <math.h>
namespace pg8 {
#define PG8_LAS __attribute__((address_space(3)))
typedef unsigned short bf16_t;
typedef short bf16x8 __attribute__((ext_vector_type(8)));
typedef float f32x4 __attribute__((ext_vector_type(4)));
typedef unsigned u32x4 __attribute__((ext_vector_type(4)));
constexpr int BM = 256, BK = 64, HALF = 128, HTB = HALF * BK * 2  , STAGE_BYTES = 8 * HTB, NXCD = 8, WGM = 8;

__host__ __device__ __forceinline__ int lds_byte(int r, int c) { const int st = (r >> 4) * 2 + (c >> 5), rr = r & 15, cc = c & 31, ob = rr * 64 + cc * 2; return st * 1024 + (ob ^ (((ob >> 9) & 1) << 5)); }
__host__ __device__ __forceinline__ void stage_rc(int b, int& R, int& C) { const int st = b / 1024, sb = b % 1024, swz = sb ^ (((sb >> 9) & 1) << 5); R = (st >> 1) * 16 + swz / 64; C = (st & 1) * 32 + (swz % 64) / 2; }
__host__ __device__ __forceinline__ int perm32(int rho) { const int n = rho >> 4, i = rho & 15; return 8 * (i >> 2) + 4 * n + (i & 3); }

struct Unit { int pm, pn; };
struct Gemm { const bf16_t* A; const bf16_t* Bt; int M, N, K; };

struct StaticOrder {
    int nM, nN, nwg, G, c;
    __host__ __device__ void init(int M, int N, int G_, int c_) { nM = M / BM; nN = N / BM; nwg = nM * nN; G = G_; c = c_; }
    __host__ __device__ bool next(int i, Unit& u) const {
        const long L = (long)i * G + c; if (L >= nwg) return false;
        int wgid = (int)L; { const int q = nwg / NXCD, r = nwg % NXCD, xcd = wgid % NXCD, off = wgid / NXCD; wgid = (xcd < r ? xcd * (q + 1) : r * (q + 1) + (xcd - r) * q) + off; }
        const int nig = WGM * nN, gid = wgid / nig, fm = gid * WGM, gsz = (nM - fm) < WGM ? (nM - fm) : WGM;
        u.pm = fm + ((wgid % nig) % gsz); u.pn = (wgid % nig) / gsz; return true;
    }
    __device__ __forceinline__ void a_ready(const Unit&) const {}
    __device__ __forceinline__ void done(const Unit&) const {}
};

__device__ __forceinline__ unsigned cvt_pk_bf16(float lo, float hi) { unsigned r; asm volatile("v_cvt_pk_bf16_f32 %0, %1, %2" : "=v"(r) : "v"(lo), "v"(hi)); return r; }
typedef float f32x2 __attribute__((ext_vector_type(2)));
template <class Epi, class Sched, bool ALIGN_EPI = false, bool SP2 = false>
__device__ __forceinline__ void gemm_phase(PG8_LAS unsigned char* lds, const Gemm g, const Sched& S, const Epi& E) {
    int tid_ = threadIdx.x; asm volatile("" : "+v"(tid_));
    const int tid = tid_, wid = __builtin_amdgcn_readfirstlane(tid >> 6), lane = tid & 63, wr = wid >> 2, wc = wid & 3, fr = lane & 15, fq = lane >> 4;
    const int K = g.K, nt = K / BK;
    unsigned voffA[2], voffB[2];
#pragma unroll
    for (int i = 0; i < 2; ++i) { int R, C; stage_rc(tid * 16 + i * 8192, R, C); const int Rb = Epi::PERM ? ((R & ~31) + perm32(R & 31)) : R;
        voffA[i] = (unsigned)(R * K + C) * 2u; voffB[i] = (unsigned)(Rb * K + C) * 2u; }
    const size_t kstep = (size_t)(BK * 2);
    const size_t hstep = (size_t)HALF * K * 2;
    const size_t tstep = 2 * hstep;
    const unsigned ldsw = (unsigned)wid * 1024u;
    const int aoff = lds_byte(wr * 64 + fr, fq * 8), boff = lds_byte(wc * 32 + fr, fq * 8);
#define PG8_SA(b, h) (((b) * 2 + (h)) * HTB)
#define PG8_SB(b, h) ((4 + (b) * 2 + (h)) * HTB)
#define PG8_STAGE(bufoff, gbase, voff) do { _Pragma("unroll") for (int _i = 0; _i < 2; ++_i) \
        __builtin_amdgcn_global_load_lds((const unsigned*)((const char*)(gbase) + (voff)[_i]), (PG8_LAS unsigned*)(lds + (bufoff) + ldsw + _i * 8192), 16, 0, 0); } while (0)
#define PG8_LDA(dst, b, h) do { _Pragma("unroll") for (int m = 0; m < 4; ++m) _Pragma("unroll") for (int k = 0; k < 2; ++k) dst[m][k] = *(const PG8_LAS bf16x8*)(lds + PG8_SA(b, h) + aoff + m * 2048 + k * 1024); } while (0)
#define PG8_LDB(dst, b, h) do { _Pragma("unroll") for (int n = 0; n < 2; ++n) _Pragma("unroll") for (int k = 0; k < 2; ++k) dst[n][k] = *(const PG8_LAS bf16x8*)(lds + PG8_SB(b, h) + boff + n * 2048 + k * 1024); } while (0)
#define PG8_MMA(ai, bj, At, Bt) do { __builtin_amdgcn_s_setprio(1); _Pragma("unroll") for (int m = 0; m < 4; ++m) _Pragma("unroll") for (int n = 0; n < 2; ++n) _Pragma("unroll") for (int k = 0; k < 2; ++k) \
        acc[ai][bj][m][n] = __builtin_amdgcn_mfma_f32_16x16x32_bf16(Bt[n][k], At[m][k], acc[ai][bj][m][n], 0, 0, 0); __builtin_amdgcn_s_setprio(0); } while (0)
#define PG8_WAIT_V(n) asm volatile("s_waitcnt vmcnt(" #n ")" ::: "memory")
#define PG8_WAIT_L(n) asm volatile("s_waitcnt lgkmcnt(" #n ")" ::: "memory")
#define PG8_BAR __builtin_amdgcn_s_barrier()
#define PG8_SCHED __builtin_amdgcn_sched_barrier(0)
    Unit cur, nxt; int ui = 0;
    if (!S.next(0, cur)) return;
    f32x4 acc[2][2][4][2];
#pragma unroll
    for (int a = 0; a < 2; ++a)
#pragma unroll
        for (int b = 0; b < 2; ++b)
#pragma unroll
            for (int m = 0; m < 4; ++m)
#pragma unroll
                for (int n = 0; n < 2; ++n) acc[a][b][m][n] = (f32x4){0.f, 0.f, 0.f, 0.f};
    bf16x8 At[4][2], B0[2][2], B1[2][2];
    const char* cA = (const char*)g.A + (size_t)cur.pm * tstep; const char* cB = (const char*)g.Bt + (size_t)cur.pn * tstep;
    S.a_ready(cur);
    if constexpr (SP2) {
        PG8_STAGE(PG8_SB(0, 0), cB, voffB); PG8_STAGE(PG8_SB(0, 1), cB + hstep, voffB); PG8_STAGE(PG8_SA(0, 0), cA, voffA); PG8_STAGE(PG8_SA(0, 1), cA + hstep, voffA);
        if (wr == 1) PG8_BAR;
        PG8_WAIT_V(2); PG8_BAR;
        PG8_STAGE(PG8_SB(1, 0), cB + kstep, voffB); PG8_STAGE(PG8_SA(1, 0), cA + kstep, voffA); PG8_STAGE(PG8_SB(1, 1), cB + hstep + kstep, voffB);
        PG8_WAIT_V(6); PG8_BAR;
    } else {
        PG8_STAGE(PG8_SB(0, 0), cB, voffB); PG8_STAGE(PG8_SA(0, 0), cA, voffA); PG8_STAGE(PG8_SB(0, 1), cB + hstep, voffB); PG8_STAGE(PG8_SA(0, 1), cA + hstep, voffA);
        if (wr == 1) PG8_BAR;
        PG8_WAIT_V(4); PG8_BAR;
        PG8_STAGE(PG8_SB(1, 0), cB + kstep, voffB); PG8_STAGE(PG8_SA(1, 0), cA + kstep, voffA); PG8_STAGE(PG8_SB(1, 1), cB + hstep + kstep, voffB);
        PG8_WAIT_V(6); PG8_BAR;
    }
    for (;;) {
        const bool has_next = S.next(ui + 1, nxt);
        const char* nA = has_next ? (const char*)g.A + (size_t)nxt.pm * tstep : cA; const char* nB = has_next ? (const char*)g.Bt + (size_t)nxt.pn * tstep : cB;
        for (int t = 0; t < nt; t += 2) {
            const bool last = (t == nt - 2);
            const char* a1 = cA + (size_t)(t + 1) * kstep;
            const char* a2 = last ? nA : cA + (size_t)(t + 2) * kstep; const char* b2 = last ? nB : cB + (size_t)(t + 2) * kstep;
            const char* a3 = a2 + kstep; const char* b3 = b2 + kstep;
            if (last && has_next) S.a_ready(nxt);
            if constexpr (SP2) {
            PG8_LDB(B0, 0, 0); PG8_LDB(B1, 0, 1); PG8_SCHED; PG8_LDA(At, 0, 0); PG8_STAGE(PG8_SA(1, 1), a1 + hstep, voffA);
            PG8_WAIT_V(8); PG8_WAIT_L(0); PG8_BAR; PG8_MMA(0, 0, At, B0); PG8_MMA(0, 1, At, B1); PG8_BAR; PG8_SCHED;
            PG8_LDA(At, 0, 1); PG8_STAGE(PG8_SB(0, 0), b2, voffB); PG8_STAGE(PG8_SB(0, 1), b2 + hstep, voffB); PG8_STAGE(PG8_SA(0, 0), a2, voffA);
            PG8_WAIT_V(8); PG8_WAIT_L(0); PG8_BAR; PG8_MMA(1, 0, At, B0); PG8_MMA(1, 1, At, B1); PG8_BAR; PG8_SCHED;
            PG8_LDB(B0, 1, 0); PG8_LDB(B1, 1, 1); PG8_SCHED; PG8_LDA(At, 1, 0); PG8_STAGE(PG8_SA(0, 1), a2 + hstep, voffA);
            PG8_WAIT_V(8); PG8_WAIT_L(0); PG8_BAR; PG8_MMA(0, 0, At, B0); PG8_MMA(0, 1, At, B1); PG8_BAR; PG8_SCHED;
            PG8_LDA(At, 1, 1); PG8_STAGE(PG8_SB(1, 0), b3, voffB); PG8_STAGE(PG8_SB(1, 1), b3 + hstep, voffB); PG8_STAGE(PG8_SA(1, 0), a3, voffA);
            PG8_WAIT_V(8); PG8_WAIT_L(0); PG8_BAR; PG8_MMA(1, 0, At, B0); PG8_MMA(1, 1, At, B1); PG8_BAR; PG8_SCHED;
            } else {
            PG8_LDB(B0, 0, 0); PG8_SCHED; PG8_LDA(At, 0, 0); PG8_STAGE(PG8_SA(1, 1), a1 + hstep, voffA);
            PG8_WAIT_L(8); PG8_BAR; PG8_WAIT_L(0); PG8_MMA(0, 0, At, B0); PG8_BAR; PG8_SCHED;
            PG8_LDB(B1, 0, 1); PG8_STAGE(PG8_SB(0, 0), b2, voffB);
            PG8_BAR; PG8_WAIT_L(0); PG8_MMA(0, 1, At, B1); PG8_BAR;
            PG8_LDA(At, 0, 1); PG8_STAGE(PG8_SA(0, 0), a2, voffA);
            PG8_BAR; PG8_WAIT_L(0); PG8_MMA(1, 0, At, B0); PG8_BAR; PG8_SCHED;
            PG8_STAGE(PG8_SB(0, 1), b2 + hstep, voffB);
            PG8_WAIT_V(6); PG8_BAR; PG8_MMA(1, 1, At, B1); PG8_BAR;
            PG8_LDB(B0, 1, 0); PG8_SCHED; PG8_LDA(At, 1, 0); PG8_STAGE(PG8_SA(0, 1), a2 + hstep, voffA);
            PG8_WAIT_L(8); PG8_BAR; PG8_WAIT_L(0); PG8_MMA(0, 0, At, B0); PG8_BAR; PG8_SCHED;
            PG8_LDB(B1, 1, 1); PG8_STAGE(PG8_SB(1, 0), b3, voffB);
            PG8_BAR; PG8_WAIT_L(0); PG8_MMA(0, 1, At, B1); PG8_BAR;
            PG8_LDA(At, 1, 1); PG8_STAGE(PG8_SA(1, 0), a3, voffA);
            PG8_BAR; PG8_WAIT_L(0); PG8_MMA(1, 0, At, B0); PG8_BAR; PG8_SCHED;
            PG8_STAGE(PG8_SB(1, 1), b3 + hstep, voffB);
            PG8_WAIT_V(6); PG8_BAR; PG8_MMA(1, 1, At, B1); PG8_BAR;
            }
        }
        if constexpr (ALIGN_EPI) { if (wr == 0) PG8_BAR; }
        if constexpr (!Epi::AFTER_DRAIN) { E(acc, cur, wr, wc, fr, fq); S.done(cur); }
        if (!has_next) break;
#pragma unroll
        for (int a = 0; a < 2; ++a)
#pragma unroll
            for (int b = 0; b < 2; ++b)
#pragma unroll
                for (int m = 0; m < 4; ++m)
#pragma unroll
                    for (int n = 0; n < 2; ++n) acc[a][b][m][n] = (f32x4){0.f, 0.f, 0.f, 0.f};
        cur = nxt; cA = nA; cB = nB; ++ui;
        if constexpr (ALIGN_EPI) { if (wr == 1) PG8_BAR; }
    }
    PG8_WAIT_V(0);
    if constexpr (!ALIGN_EPI) { if (wr == 0) PG8_BAR; }
    PG8_BAR;
    if constexpr (Epi::AFTER_DRAIN) { E.fused(acc, cur, wr, wc, fr, fq, lds, wid, lane); S.done(cur); }
#undef PG8_SA
#undef PG8_SB
#undef PG8_STAGE
#undef PG8_LDA
#undef PG8_LDB
#undef PG8_MMA
#undef PG8_WAIT_V
#undef PG8_WAIT_L
#undef PG8_BAR
#undef PG8_SCHED
}
}
#define GAS __attribute__((address_space(1)))
#define LAS __attribute__((address_space(3)))
typedef unsigned short bf16;
typedef unsigned v4u __attribute__((ext_vector_type(4)));
typedef unsigned v2u __attribute__((ext_vector_type(2)));
typedef float f32x4 __attribute__((ext_vector_type(4)));
typedef short bf16x8 __attribute__((ext_vector_type(8)));
#define LDS_WAIT() asm volatile("s_waitcnt lgkmcnt(0)" ::: "memory")
#define VM_WAIT() asm volatile("s_waitcnt vmcnt(0)" ::: "memory")

constexpr int DM = 2048, NB = 4, SEQ = 2048, NMETA = 16, MROWS = NB * SEQ, DPROJ = 6152, NPROJ = 6144;
constexpr int PADT = 2112, POS0 = 64, MPOS0 = 48;
constexpr float EPS = 1e-6f;
constexpr float LOG2E = 1.4426950408889634f;
constexpr float QSCALE = 0.08838834764831845f * LOG2E;
constexpr int NWAVES = 8, NTHR = 512;

constexpr size_t MiB = 1u << 20;
constexpr size_t WS_CTL = 0, CTL_ZERO_BYTES = 1 * MiB;
constexpr size_t WS_PM = 484 * MiB;
constexpr size_t WS_W1T = 2 * MiB, WS_W2T = 26 * MiB, WS_W3T = 34 * MiB, WS_XN = 42 * MiB;
constexpr size_t WS_Q = 74 * MiB, WS_KP = 90 * MiB, WS_VP = 107 * MiB, WS_MQ = 124 * MiB, WS_MK = 133 * MiB, WS_MV = 142 * MiB, WS_MO = 159 * MiB;
constexpr size_t WS_SMALL = 175 * MiB;
constexpr size_t WS_XM = WS_SMALL, WS_LI = WS_SMALL + 128 * 1024, WS_LF = WS_SMALL + 384 * 1024, WS_LAM = WS_SMALL + 640 * 1024;
constexpr size_t WS_PO = 176 * MiB, WS_ML = 304 * MiB, WS_HM = 305 * MiB, WS_A2 = 42 * MiB, WS_H1B = 74 * MiB, WS_SSQ = 106 * MiB, WS_S = 176 * MiB, WS_UB = 384 * MiB, WS_VB = 448 * MiB;
constexpr size_t WS_SCL = WS_SMALL + 704 * 1024;
constexpr size_t WS_VB8 = WS_UB + 32 * MiB;
constexpr size_t WS_DC = 305 * MiB, WS_CS = 448 * MiB, WS_DN = 482 * MiB, WS_NS = WS_DN + 512 * 1024, WS_GS = WS_DN + 1024 * 1024, WS_MS = WS_DN + 1152 * 1024;
constexpr int CW_BAR = 4096;

constexpr int RING_OFF = 0, RING_BYTES = 131072;
constexpr int XCH_OFF = 131072;
constexpr int MISC_OFF = XCH_OFF + 8192;
constexpr int LDS_BYTES = 155648;

__device__ __forceinline__ unsigned f2bf(float f) { unsigned u = __builtin_bit_cast(unsigned, f); return (u + 0x7fffu + ((u >> 16) & 1u)) >> 16; }
__device__ __forceinline__ unsigned pk2(float lo, float hi) { return f2bf(lo) | (f2bf(hi) << 16); }
__device__ __forceinline__ float bf2f(unsigned short u) { return __builtin_bit_cast(float, (unsigned)u << 16); }
__device__ __forceinline__ float bflo(unsigned w) { return __builtin_bit_cast(float, w << 16); }
__device__ __forceinline__ float bfhi(unsigned w) { return __builtin_bit_cast(float, w & 0xffff0000u); }
__device__ __forceinline__ float wave_sum(float v) {
#pragma unroll
  for (int o = 1; o < 64; o <<= 1) v += __shfl_xor(v, o);
  return v;
}
__device__ __forceinline__ size_t kp_off(int bhm, int pos, int d) { const int j = pos >> 6, row = pos & 63, d0 = d >> 4, hi = (d >> 3) & 1;
  return ((size_t)(bhm * 33 + j) * 8 + d0) * 1024 + (size_t)((((row << 1) | hi) ^ ((row >> 3) & 1)) << 3) + (d & 7); }
__device__ __forceinline__ float wave_sum_dpp(float v) {
  v += __builtin_bit_cast(float, __builtin_amdgcn_update_dpp(0, __builtin_bit_cast(int, v), 0xB1, 0xF, 0xF, true));
  v += __builtin_bit_cast(float, __builtin_amdgcn_update_dpp(0, __builtin_bit_cast(int, v), 0x4E, 0xF, 0xF, true));
  v += __builtin_bit_cast(float, __builtin_amdgcn_update_dpp(0, __builtin_bit_cast(int, v), 0x141, 0xF, 0xF, true));
  v += __builtin_bit_cast(float, __builtin_amdgcn_update_dpp(0, __builtin_bit_cast(int, v), 0x140, 0xF, 0xF, true));
  const float r0 = __builtin_bit_cast(float, __builtin_amdgcn_readlane(__builtin_bit_cast(int, v), 0)), r1 = __builtin_bit_cast(float, __builtin_amdgcn_readlane(__builtin_bit_cast(int, v), 16));
  const float r2 = __builtin_bit_cast(float, __builtin_amdgcn_readlane(__builtin_bit_cast(int, v), 32)), r3 = __builtin_bit_cast(float, __builtin_amdgcn_readlane(__builtin_bit_cast(int, v), 48));
  return (r0 + r1) + (r2 + r3);
}
__device__ __forceinline__ float sigmoidf_(float x) { return 1.0f / (1.0f + __expf(-x)); }
#define XB_TMO      128
#define XB_XCNT(j)  (256  + 64 * (j))
#define XB_XSUB(j)  (1280 + 64 * (j))
#define XB_XGEN(j)  (2304 + 64 * (j))
#define XB_TOP      3328
#define XB_TOPGEN   3392
#define XCD_BAR_WORDS 3456
#define XB_SPIN_CAP (1u << 18)

__device__ __forceinline__ unsigned xb_ld(unsigned* p)              { return __hip_atomic_load(p, __ATOMIC_RELAXED, __HIP_MEMORY_SCOPE_AGENT); }
__device__ __forceinline__ unsigned xb_add(unsigned* p, unsigned v) { return __hip_atomic_fetch_add(p, v, __ATOMIC_RELAXED, __HIP_MEMORY_SCOPE_AGENT); }
__device__ __forceinline__ unsigned xb_xcc_id() { return (unsigned)__builtin_amdgcn_s_getreg((3 << 11) | 20) & 0xFu; }
#define XB_SPIN(cond, bar) do { unsigned _sp = 0; while (cond) { __builtin_amdgcn_s_sleep(1); \
    if ((++_sp & 255u) == 0u) { if (xb_ld(&(bar)[XB_TMO])) break; if (_sp > XB_SPIN_CAP) { atomicAdd(&(bar)[XB_TMO], 1u); break; } } } } while (0)

struct XcdBarrier {
    unsigned* bar; unsigned x;
    volatile LAS unsigned* st;
};

__device__ __forceinline__ XcdBarrier xcd_barrier_post(unsigned* bar, volatile LAS unsigned* st) {
    XcdBarrier b; b.bar = bar; b.x = xb_xcc_id(); b.st = st;
    if (threadIdx.x == 0) (void)xb_add(&bar[XB_XCNT(b.x)], 1u);
    return b;
}
__device__ __forceinline__ void xcd_barrier_complete(unsigned* bar, unsigned x, unsigned& nloc, unsigned& nx) {
    const unsigned G = gridDim.x * gridDim.y * gridDim.z;
    unsigned sum, cnt, mine, sp = 0u;
    for (;;) {
        sum = 0u; cnt = 0u; mine = 0u;
#pragma unroll
        for (unsigned j = 0; j < 16; ++j) { const unsigned c = xb_ld(&bar[XB_XCNT(j)]); sum += c; cnt += (c > 0u) ? 1u : 0u; mine = (j == x) ? c : mine; }
        if (sum == G) break;
        __builtin_amdgcn_s_sleep(1);
        if ((++sp & 255u) == 0u) { if (xb_ld(&bar[XB_TMO])) break; if (sp > XB_SPIN_CAP) { atomicAdd(&bar[XB_TMO], 1u); break; } }
    }
    nloc = mine > 0u ? mine : 1u; nx = cnt > 0u ? cnt : 1u;
}

__device__ __forceinline__ void xcd_barrier(const XcdBarrier& b) {
    asm volatile("s_waitcnt vmcnt(0)" ::: "memory");
    __syncthreads();
    if (threadIdx.x == 0) {
        unsigned* bar = b.bar;
        __builtin_amdgcn_s_waitcnt(0);
        unsigned nloc = b.st[0], nx = b.st[1];
        if (nloc == 0u) { xcd_barrier_complete(bar, b.x, nloc, nx); b.st[0] = nloc; b.st[1] = nx; }
        const unsigned old = xb_add(&bar[XB_XSUB(b.x)], 1u);
        const unsigned gen = old / nloc;
        if (old + 1u == (gen + 1u) * nloc) {
            __builtin_amdgcn_fence(__ATOMIC_RELEASE, "agent");
            asm volatile("s_waitcnt vmcnt(0)" ::: "memory");
            const unsigned og = xb_add(&bar[XB_TOP], 1u);
            const unsigned tg = og / nx;
            if (og + 1u == (tg + 1u) * nx) xb_add(&bar[XB_TOPGEN], 1u);
            else XB_SPIN(xb_ld(&bar[XB_TOPGEN]) == tg, bar);
            __builtin_amdgcn_fence(__ATOMIC_ACQUIRE, "agent");
            xb_add(&bar[XB_XGEN(b.x)], 1u);
            asm volatile("s_waitcnt vmcnt(0)" ::: "memory");
        } else {
            XB_SPIN(xb_ld(&bar[XB_XGEN(b.x)]) == gen, bar);
            __builtin_amdgcn_fence(__ATOMIC_ACQUIRE, "agent");
            asm volatile("s_waitcnt vmcnt(0)" ::: "memory");
        }
    }
    __syncthreads();
}

struct Args { const float* in[22]; float* out; unsigned char* ws; int ph_lo, ph_hi, na, pad; };
struct Frame {
  LAS unsigned char* lds; unsigned char* ws; int tid, lane, wave; const float* const* in;
};
#define IN_X 0
#define IN_META 1
#define IN_G1 2
#define IN_WIN 3
#define IN_CW 4
#define IN_CB 5
#define IN_IGB 6
#define IN_FGB 7
#define IN_LQ1 8
#define IN_LK1 9
#define IN_LQ2 10
#define IN_LK2 11
#define IN_QNG 12
#define IN_KNG 13
#define IN_SUBG 14
#define IN_OUTG 15
#define IN_WOUT 16
#define IN_G2 17
#define IN_WQ 18
#define IN_SUBK 19
#define IN_U 20
#define IN_V 21

__device__ __forceinline__ void p0_rows(const Frame& F, const Args& a) {
  const float* x = a.in[IN_X]; const float* meta = a.in[IN_META]; const float* g1 = a.in[IN_G1]; const float* w_in = a.in[IN_WIN];
  const float* igb = a.in[IN_IGB]; const float* fgb = a.in[IN_FGB];
  bf16* Xn = (bf16*)(F.ws + WS_XN); bf16* Xm = (bf16*)(F.ws + WS_XM); float* LI = (float*)(F.ws + WS_LI); float* LF = (float*)(F.ws + WS_LF);
  LAS f32x4* wgl = (LAS f32x4*)(F.lds);
  for (int e = F.tid; e < 4096; e += NTHR) {
    const int ln = e & 63, q = e >> 6, half = q & 1, j = (q >> 1) & 3, i = q >> 3;
    const int k = 4 * (i * 64 + ln) + j;
    wgl[e] = *(const f32x4*)(w_in + (size_t)k * DPROJ + NPROJ + 4 * half);
  }
  __syncthreads();
  const int gw = blockIdx.x * NWAVES + F.wave, NGW = gridDim.x * NWAVES, lane = F.lane;
  for (int task = gw; task < MROWS / 2 + NMETA / 2; task += NGW) {
    const bool ismeta = task >= MROWS / 2;
    const int r0 = ismeta ? (task - MROWS / 2) * 2 : task * 2;
    const float* src0 = (ismeta ? meta : x) + (size_t)r0 * DM;
    f32x4 xv[2][8]; float rs[2];
    { float s0 = 0.f, s1 = 0.f;
#pragma unroll
      for (int i = 0; i < 8; ++i) { xv[0][i] = ((const f32x4*)src0)[i * 64 + lane]; xv[1][i] = ((const f32x4*)(src0 + DM))[i * 64 + lane]; }
#pragma unroll
      for (int i = 0; i < 8; ++i) { const f32x4 a0 = xv[0][i], a1 = xv[1][i];
        s0 += (a0.x * a0.x + a0.y * a0.y) + (a0.z * a0.z + a0.w * a0.w); s1 += (a1.x * a1.x + a1.y * a1.y) + (a1.z * a1.z + a1.w * a1.w); }
      rs[0] = rsqrtf(wave_sum_dpp(s0) * (1.0f / DM) + EPS); rs[1] = rsqrtf(wave_sum_dpp(s1) * (1.0f / DM) + EPS); }
    float ga[2][8];
#pragma unroll
    for (int rr = 0; rr < 2; ++rr)
#pragma unroll
      for (int g = 0; g < 8; ++g) ga[rr][g] = 0.f;
    bf16* dst0 = (ismeta ? Xm : Xn) + (size_t)r0 * DM;
#pragma unroll
    for (int i = 0; i < 8; ++i) {
      const f32x4 g = ((const f32x4*)g1)[i * 64 + lane];
      f32x4 xn[2];
#pragma unroll
      for (int rr = 0; rr < 2; ++rr) { xn[rr] = xv[rr][i] * g * rs[rr];
        v2u o; o.x = pk2(xn[rr].x, xn[rr].y); o.y = pk2(xn[rr].z, xn[rr].w); ((v2u*)(dst0 + (size_t)rr * DM))[i * 64 + lane] = o; }
#pragma unroll
      for (int j = 0; j < 4; ++j) {
        const f32x4 w0 = wgl[((i * 4 + j) * 2 + 0) * 64 + lane], w1 = wgl[((i * 4 + j) * 2 + 1) * 64 + lane];
#pragma unroll
        for (int rr = 0; rr < 2; ++rr) { const float xs_ = xn[rr][j];
          ga[rr][0] += xs_ * w0.x; ga[rr][1] += xs_ * w0.y; ga[rr][2] += xs_ * w0.z; ga[rr][3] += xs_ * w0.w;
          ga[rr][4] += xs_ * w1.x; ga[rr][5] += xs_ * w1.y; ga[rr][6] += xs_ * w1.z; ga[rr][7] += xs_ * w1.w; }
      }
      __builtin_amdgcn_sched_barrier(0);
    }
#pragma unroll
    for (int rr = 0; rr < 2; ++rr)
#pragma unroll
      for (int g = 0; g < 8; ++g) ga[rr][g] = wave_sum_dpp(ga[rr][g]);
    if (lane < 8) {
      const int rr = lane >> 2, h = lane & 3;
      float gi = 0.f, gf = 0.f;
#pragma unroll
      for (int q = 0; q < 2; ++q)
#pragma unroll
        for (int hh = 0; hh < 4; ++hh) if (q == rr && hh == h) { gi = ga[q][hh]; gf = ga[q][4 + hh]; }
      const float li = gi + igb[h]; const float fx = gf + fgb[h];
      const float lf = fminf(fx, 0.f) - log1pf(__expf(-fabsf(fx)));
      const int R = r0 + rr;
      if (!ismeta) { const int b = R >> 11, t = R & 2047; LI[(b * 4 + h) * PADT + POS0 + t] = li; LF[(b * 4 + h) * PADT + POS0 + t] = lf; }
      else { for (int b = 0; b < NB; ++b) { LI[(b * 4 + h) * PADT + MPOS0 + R] = li; LF[(b * 4 + h) * PADT + MPOS0 + R] = lf; } }
    }
  }
  __syncthreads();
}
__device__ __forceinline__ void p0_metaproj(const Frame& F, const Args& a) {
  const float* meta = a.in[IN_META]; const float* g1 = a.in[IN_G1]; const float* w_in = a.in[IN_WIN];
  float* PM = (float*)(F.ws + WS_PM);
  LAS float* xs = (LAS float*)(F.lds);
  LAS float* part = (LAS float*)(F.lds + 16384);
  const int q = F.tid >> 7, c = F.tid & 127;
  for (int task = blockIdx.x; task < (NPROJ / 128) * 4; task += gridDim.x) {
    const int nb = task >> 2, kp = task & 3, n = nb * 128 + c;
    float acc[16];
#pragma unroll
    for (int m = 0; m < 16; ++m) acc[m] = 0.f;
#pragma unroll 1
    for (int kb = 0; kb < 2; ++kb) {
      __syncthreads();
#pragma unroll
      for (int i = 0; i < 8; ++i) { const int idx = F.tid + NTHR * i, qq = idx >> 10, kk = (idx >> 4) & 63, m = idx & 15; const int k = 512 * kp + 128 * qq + 64 * kb + kk;
        xs[idx] = meta[(size_t)m * DM + k] * g1[k]; }
      __syncthreads();
#pragma unroll 8
      for (int kk = 0; kk < 64; ++kk) {
        const float w = w_in[(size_t)(512 * kp + 128 * q + 64 * kb + kk) * DPROJ + n];
        const LAS f32x4* xp = (const LAS f32x4*)(xs + (q * 64 + kk) * 16);
#pragma unroll
        for (int t = 0; t < 4; ++t) { const f32x4 xv = xp[t]; acc[4 * t + 0] += xv.x * w; acc[4 * t + 1] += xv.y * w; acc[4 * t + 2] += xv.z * w; acc[4 * t + 3] += xv.w * w; }
      }
    }
#pragma unroll
    for (int m = 0; m < 16; ++m) part[(q * 16 + m) * 128 + c] = acc[m];
    __syncthreads();
    for (int e = F.tid; e < 16 * 128; e += NTHR) { const int m = e >> 7, cc = e & 127;
      PM[((size_t)kp * 16 + m) * NPROJ + nb * 128 + cc] = (part[(0 * 16 + m) * 128 + cc] + part[(1 * 16 + m) * 128 + cc]) + (part[(2 * 16 + m) * 128 + cc] + part[(3 * 16 + m) * 128 + cc]); }
  }
  __syncthreads();
}
__device__ __forceinline__ void p0_transpose(const Frame& F, const float* W, int ldw, int N, bf16* Wt) {
  LAS float* tl = (LAS float*)(F.lds);
  const int ntn = N / 64, ntask = ntn * 16;
  for (int task = blockIdx.x; task < ntask; task += gridDim.x) {
    const int nb = task % ntn, kb = task / ntn, n0 = nb * 64, k0 = kb * 128;
    __syncthreads();
#pragma unroll
    for (int i = 0; i < 4; ++i) { const int idx = F.tid + NTHR * i, kk = idx >> 4, c4 = idx & 15;
      const f32x4 w = *(const f32x4*)(W + (size_t)(k0 + kk) * ldw + n0 + 4 * c4);
      LAS float* d = tl + kk * 65 + 4 * c4; d[0] = w.x; d[1] = w.y; d[2] = w.z; d[3] = w.w; }
    __syncthreads();
    const int n = F.tid >> 3, kc = F.tid & 7;
    const LAS float* s = tl + (kc * 16) * 65 + n;
    v4u o0, o1;
    o0.x = pk2(s[0 * 65], s[1 * 65]); o0.y = pk2(s[2 * 65], s[3 * 65]); o0.z = pk2(s[4 * 65], s[5 * 65]); o0.w = pk2(s[6 * 65], s[7 * 65]);
    o1.x = pk2(s[8 * 65], s[9 * 65]); o1.y = pk2(s[10 * 65], s[11 * 65]); o1.z = pk2(s[12 * 65], s[13 * 65]); o1.w = pk2(s[14 * 65], s[15 * 65]);
    v4u* dp = (v4u*)(Wt + (size_t)(n0 + n) * DM + k0 + kc * 16);
    dp[0] = o0; dp[1] = o1;
  }
  __syncthreads();
}
__device__ __forceinline__ void p0_zero_vpad(const Frame& F) {
  bf16* Vp = (bf16*)(F.ws + WS_VP);
  const int per = MPOS0 * 256 / 8;
  for (int i = blockIdx.x * NTHR + F.tid; i < 16 * per; i += gridDim.x * NTHR) { const int bh = i / per, e = i % per;
    *(v4u*)(Vp + (size_t)bh * PADT * 256 + (size_t)e * 8) = (v4u){0u, 0u, 0u, 0u}; }
}
__device__ __forceinline__ void p0_lam(const Frame& F, const Args& a) {
  if (blockIdx.x == 0 && F.wave == 0) {
    const int l = F.lane;
    float s1 = a.in[IN_LQ1][l] * a.in[IN_LK1][l] + a.in[IN_LQ1][l + 64] * a.in[IN_LK1][l + 64];
    float s2 = a.in[IN_LQ2][l] * a.in[IN_LK2][l] + a.in[IN_LQ2][l + 64] * a.in[IN_LK2][l + 64];
    s1 = wave_sum(s1); s2 = wave_sum(s2);
    if (l == 0) *(float*)(F.ws + WS_LAM) = __expf(s1) - __expf(s2) + 0.2f;
  }
}

struct EpiProj {
  static constexpr bool PERM = true, AFTER_DRAIN = false;
  bf16 *Qb, *Kp, *Vp, *MQ, *MK, *MV, *MO; const float *qg, *kg; LAS float* xch;
  __device__ __forceinline__ void operator()(const pg8::f32x4 (&acc)[2][2][4][2], const pg8::Unit& u, int wr, int wc, int fr, int fq) const {
    const int pn = u.pn, b = u.pm >> 3, tb = (u.pm & 7) * 256 + wr * 64 + fr, d0 = wc * 32 + fq * 8;
    if (pn < 8) {
      const bool isk = pn >= 4; const int h = pn & 3;
      float ssq[2][4][2];
#pragma unroll
      for (int ai = 0; ai < 2; ++ai)
#pragma unroll
        for (int m = 0; m < 4; ++m)
#pragma unroll
          for (int bj = 0; bj < 2; ++bj) { float s = 0.f;
#pragma unroll
            for (int n = 0; n < 2; ++n) { const pg8::f32x4 x = acc[ai][bj][m][n]; s += (x[0] * x[0] + x[1] * x[1]) + (x[2] * x[2] + x[3] * x[3]); }
            s += __shfl_xor(s, 16); s += __shfl_xor(s, 32); ssq[ai][m][bj] = s;
            if (fq == 0) xch[((ai * 128 + wr * 64 + m * 16 + fr) * 2 + bj) * 4 + wc] = s; }
      asm volatile("s_waitcnt lgkmcnt(0)" ::: "memory"); __builtin_amdgcn_s_barrier(); asm volatile("" ::: "memory");
      const float* gp = (isk ? kg : qg) + d0; const f32x4 g0 = *(const f32x4*)gp, g1v = *(const f32x4*)(gp + 4);
      const float sc = isk ? 1.0f : QSCALE;
#pragma unroll
      for (int ai = 0; ai < 2; ++ai)
#pragma unroll
        for (int m = 0; m < 4; ++m)
#pragma unroll
          for (int bj = 0; bj < 2; ++bj) {
            const f32x4 p = *(const LAS f32x4*)(xch + ((ai * 128 + wr * 64 + m * 16 + fr) * 2 + bj) * 4);
            const float rs = rsqrtf(((p.x + p.y) + (p.z + p.w)) * (1.0f / 128.f) + EPS) * sc;
            const pg8::f32x4 v0 = acc[ai][bj][m][0], v1 = acc[ai][bj][m][1];
            v4u w; w.x = pk2(v0[0] * rs * g0.x, v0[1] * rs * g0.y); w.y = pk2(v0[2] * rs * g0.z, v0[3] * rs * g0.w);
            w.z = pk2(v1[0] * rs * g1v.x, v1[1] * rs * g1v.y); w.w = pk2(v1[2] * rs * g1v.z, v1[3] * rs * g1v.w);
            const int t = tb + ai * 128 + m * 16;
            bf16* dst = isk ? Kp + kp_off((b * 4 + h) * 2 + bj, POS0 + t, d0)
                            : Qb + ((size_t)((b * 4 + h) * 2 + bj) * SEQ + t) * 128 + d0;
            *(v4u*)dst = w; }
      return;
    }
#pragma unroll
    for (int ai = 0; ai < 2; ++ai)
#pragma unroll
      for (int m = 0; m < 4; ++m)
#pragma unroll
        for (int bj = 0; bj < 2; ++bj) {
          pg8::f32x4 v0 = acc[ai][bj][m][0], v1 = acc[ai][bj][m][1];
          const int t = tb + ai * 128 + m * 16;
          bf16* dst;
          if (pn < 12) { const int h = pn - 8; dst = Vp + ((size_t)(b * 4 + h) * PADT + POS0 + t) * 256 + bj * 128 + d0; }
          else if (pn < 16) { const int h = 2 * (pn & 1) + bj; dst = (pn >= 14 ? MK : MQ) + ((size_t)(b * 4 + h) * PADT + POS0 + t) * 128 + d0; }
          else if (pn < 20) { const int h = pn - 16; dst = MV + ((size_t)(b * 4 + h) * PADT + POS0 + t) * 256 + bj * 128 + d0; }
          else { dst = MO + (size_t)(b * SEQ + t) * 1024 + (pn - 20) * 256 + bj * 128 + d0;
#pragma unroll
            for (int j = 0; j < 4; ++j) { v0[j] = sigmoidf_(v0[j]); v1[j] = sigmoidf_(v1[j]); } }
          v4u w; w.x = pk2(v0[0], v0[1]); w.y = pk2(v0[2], v0[3]); w.z = pk2(v1[0], v1[1]); w.w = pk2(v1[2], v1[3]);
          *(v4u*)dst = w; }
  }
};
__device__ __forceinline__ void p1_meta_finalize(const Frame& F, const Args& a) {
  if (blockIdx.x >= NMETA) return;
  const int mrow = blockIdx.x, tid = F.tid, lane = F.lane, w = F.wave;
  const float* meta = a.in[IN_META] + (size_t)mrow * DM; const float* PM0 = (const float*)(F.ws + WS_PM) + (size_t)mrow * NPROJ;
#define PM_AT(i) ((PM0[(i)] + PM0[(size_t)16 * NPROJ + (i)]) + (PM0[(size_t)32 * NPROJ + (i)] + PM0[(size_t)48 * NPROJ + (i)]))
  LAS float* red = (LAS float*)(F.lds + XCH_OFF);
  const f32x4 mv = ((const f32x4*)meta)[tid];
  float s = wave_sum((mv.x * mv.x + mv.y * mv.y) + (mv.z * mv.z + mv.w * mv.w));
  if (lane == 0) red[w] = s;
  __syncthreads();
  float tot = 0.f;
#pragma unroll
  for (int i = 0; i < 8; ++i) tot += red[i];
  const float rs = rsqrtf(tot * (1.0f / DM) + EPS);
  bf16* Kp = (bf16*)(F.ws + WS_KP); bf16* Vp = (bf16*)(F.ws + WS_VP); bf16* MQ = (bf16*)(F.ws + WS_MQ); bf16* MK = (bf16*)(F.ws + WS_MK); bf16* MV = (bf16*)(F.ws + WS_MV);
  const int pos = MPOS0 + mrow;
  {
    const float v0 = PM_AT(1024 + w * 128 + lane) * rs, v1 = PM_AT(1024 + w * 128 + lane + 64) * rs;
    const float rk = rsqrtf(wave_sum(v0 * v0 + v1 * v1) * (1.0f / 128.f) + EPS);
    const float* kg = a.in[IN_KNG];
    const unsigned short o0 = (unsigned short)f2bf(v0 * rk * kg[lane]), o1 = (unsigned short)f2bf(v1 * rk * kg[lane + 64]);
    for (int b = 0; b < NB; ++b) { const int bhm = (b * 4 + (w >> 1)) * 2 + (w & 1); Kp[kp_off(bhm, pos, lane)] = o0; Kp[kp_off(bhm, pos, lane + 64)] = o1; }
  }
  { const int c = tid * 2;
    const unsigned o = pk2(PM_AT(2048 + c) * rs, PM_AT(2048 + c + 1) * rs); const int h = c >> 8, e = c & 255;
    for (int b = 0; b < NB; ++b) *(unsigned*)(Vp + ((size_t)(b * 4 + h) * PADT + pos) * 256 + e) = o;
    const unsigned o2 = pk2(PM_AT(3072 + c) * rs, PM_AT(3072 + c + 1) * rs); const bool isk = c >= 512; const int cc = c & 511, hq = cc >> 7, d = cc & 127;
    for (int b = 0; b < NB; ++b) *(unsigned*)((isk ? MK : MQ) + ((size_t)(b * 4 + hq) * PADT + pos) * 128 + d) = o2;
    const unsigned o3 = pk2(PM_AT(4096 + c) * rs, PM_AT(4096 + c + 1) * rs);
    for (int b = 0; b < NB; ++b) *(unsigned*)(MV + ((size_t)(b * 4 + h) * PADT + pos) * 256 + e) = o3;
  }
  __syncthreads();
}
#undef PM_AT

namespace att {
using f32x16 = __attribute__((ext_vector_type(16))) float;
using s16x4 = __attribute__((ext_vector_type(4))) short;
constexpr int STEPS_BHM = 152, NSTEPS = 32 * STEPS_BHM;
constexpr int SHM_V = 64 * 256 * 2, SHM_K = 64 * 128 * 2;
constexpr int LDS_V = 0, LDS_K = 2 * SHM_V, LDS_Q = LDS_K + SHM_K, LDS_WS = LDS_Q + 8 * 8192;
constexpr float THR2 = 8.0f;
#define KSWZ(row, colB) ((row) * 256 + ((colB) ^ (((row) & 7) << 4)))
#define SBAR() __builtin_amdgcn_sched_barrier(0)
__device__ __forceinline__ int crow(int r, int hi) { return (r & 3) + 8 * (r >> 2) + 4 * hi; }
__device__ __forceinline__ unsigned cvtpk(float lo, float hi) { unsigned r; asm volatile("v_cvt_pk_bf16_f32 %0, %1, %2" : "=v"(r) : "v"(lo), "v"(hi)); return r; }
__device__ __forceinline__ int qb_start(int qb) { return 2 * qb * qb + 3 * qb; }
__device__ __forceinline__ int chunk_of(int s, int NA) { return ((s + 1) * NA - 1) / NSTEPS; }

template <int OFF> __device__ __forceinline__ s16x4 tr_read(int vb) {
  s16x4 r; asm volatile("ds_read_b64_tr_b16 %0, %1 offset:%2" : "=&v"(r) : "v"(vb), "i"(OFF) : "memory"); return r;
}
constexpr int v_rd_off(int d0, int ks, int half) { return d0 * 512 + ks * 8192 + half * 4096; }
template <int D0> __device__ __forceinline__ void pv_one(f32x16& od, int vb, bf16x8 pa0, bf16x8 pa1, bf16x8 pa2, bf16x8 pa3) {
#define PK(L, H) (bf16x8){L[0], L[1], L[2], L[3], H[0], H[1], H[2], H[3]}
  { const s16x4 l0 = tr_read<v_rd_off(D0, 0, 0)>(vb), h0 = tr_read<v_rd_off(D0, 0, 1)>(vb), l1 = tr_read<v_rd_off(D0, 1, 0)>(vb), h1 = tr_read<v_rd_off(D0, 1, 1)>(vb);
    asm volatile("s_waitcnt lgkmcnt(0)" ::: "memory"); SBAR();
    od = __builtin_amdgcn_mfma_f32_32x32x16_bf16(pa0, PK(l0, h0), od, 0, 0, 0);
    od = __builtin_amdgcn_mfma_f32_32x32x16_bf16(pa1, PK(l1, h1), od, 0, 0, 0); }
  SBAR();
  { const s16x4 l2 = tr_read<v_rd_off(D0, 2, 0)>(vb), h2 = tr_read<v_rd_off(D0, 2, 1)>(vb), l3 = tr_read<v_rd_off(D0, 3, 0)>(vb), h3 = tr_read<v_rd_off(D0, 3, 1)>(vb);
    asm volatile("s_waitcnt lgkmcnt(0)" ::: "memory"); SBAR();
    od = __builtin_amdgcn_mfma_f32_32x32x16_bf16(pa2, PK(l2, h2), od, 0, 0, 0);
    od = __builtin_amdgcn_mfma_f32_32x32x16_bf16(pa3, PK(l3, h3), od, 0, 0, 0); }
#undef PK
}

__device__ __forceinline__ void segment(const Frame& F, int bhm, int qb, int j0, int j1, int slot) {
  const int tid = F.tid, wid = F.wave, lane = F.lane, r32 = lane & 31, hi = lane >> 5;
  const bf16* Qg = (const bf16*)(F.ws + WS_Q) + ((size_t)bhm * SEQ + qb * 256 + wid * 32 + r32) * 128 + hi * 8;
  const bf16* Kg = (const bf16*)(F.ws + WS_KP) + (size_t)bhm * 33 * 8192;
  const bf16* Vg = (const bf16*)(F.ws + WS_VP) + (size_t)(bhm >> 1) * PADT * 256;
  LAS unsigned char* lds = F.lds;
  LAS float* wsl = (LAS float*)(lds + LDS_WS) + wid * 64;
  const float slope2 = exp2f(-2.0f * (float)(((bhm >> 1) & 3) + 1)) * LOG2E;
  unsigned ksrc0, vsrc0;
  ksrc0 = (unsigned)tid * 16u;
  { const int a8 = tid >> 8, b = (tid >> 2) & 7, k = 8 * (b >> 2) + 4 * a8 + (b & 3), c = ((tid >> 5) & 7) * 32 + (tid & 3) * 8; vsrc0 = (unsigned)(k * 256 + c) * 2u; }
#define STAGE_K(j) do { const char* kt = (const char*)(Kg + (size_t)(j) * 8192); \
    _Pragma("unroll") for (int _i = 0; _i < 2; ++_i) __builtin_amdgcn_global_load_lds((const unsigned*)(kt + (ksrc0 + _i * 8192u)), (LAS unsigned*)(lds + LDS_K + _i * 8192 + wid * 1024), 16, 0, 0); } while (0)
#define STAGE_V(buf, j) do { const char* vt = (const char*)(Vg + (size_t)(j) * 64 * 256); \
    _Pragma("unroll") for (int _i = 0; _i < 4; ++_i) __builtin_amdgcn_global_load_lds((const unsigned*)(vt + (vsrc0 + _i * 8192u)), (LAS unsigned*)(lds + LDS_V + (buf) * SHM_V + _i * 8192 + wid * 1024), 16, 0, 0); } while (0)
  const int lt = (((r32 << 1) | hi) ^ ((r32 >> 3) & 1)) << 4;
  LAS unsigned char* Qs = lds + LDS_Q + wid * 8192;
#pragma unroll
  for (int d0 = 0; d0 < 8; ++d0) { const bf16x8 qv = *(const bf16x8*)(Qg + d0 * 16); *(LAS bf16x8*)(Qs + d0 * 1024 + lt) = qv; }
  const float hioff = slope2 * (float)(4 * hi);
  f32x16 o[8];
#pragma unroll
  for (int d = 0; d < 8; ++d)
#pragma unroll
    for (int r = 0; r < 16; ++r) o[d][r] = 0.f;
  float m_reg = -1e30f, l_reg = 0.f;
  const int vb0 = (int)(uintptr_t)(lds + LDS_V) + (((lane & 3) << 3) | (((lane >> 2) & 3) << 6) | (((lane >> 4) & 1) << 5) | (((lane >> 5) & 1) << 8));
  const int qrel = wid * 32 + r32;
  STAGE_K(j0); STAGE_V(0, j0);
  VM_WAIT(); __syncthreads();
  for (int j = j0; j < j1; ++j) {
    const int cur = (j - j0) & 1;
    if (j + 1 < j1) STAGE_V(cur ^ 1, j + 1);
    SBAR();
    f32x16 p0 = {}, p1 = {};
    { const LAS unsigned char* Ks = lds + LDS_K;
#pragma unroll
      for (int d0 = 0; d0 < 8; ++d0) {
        const bf16x8 b0 = *(const LAS bf16x8*)(Ks + d0 * 2048 + lt);
        const bf16x8 b1 = *(const LAS bf16x8*)(Ks + d0 * 2048 + 1024 + lt);
        const bf16x8 qf = *(const LAS bf16x8*)(Qs + d0 * 1024 + lt);
        p0 = __builtin_amdgcn_mfma_f32_32x32x16_bf16(b0, qf, p0, 0, 0, 0);
        p1 = __builtin_amdgcn_mfma_f32_32x32x16_bf16(b1, qf, p1, 0, 0, 0); } }
    asm volatile("s_waitcnt lgkmcnt(0)" ::: "memory"); __builtin_amdgcn_s_barrier(); asm volatile("" ::: "memory");
    if (j + 1 < j1) STAGE_K(j + 1);
    SBAR();
    if (j == 0) {
#pragma unroll
      for (int r = 0; r < 16; ++r) p0[r] = -INFINITY;
#pragma unroll
      for (int r = 0; r < 8; ++r) p1[r] = -INFINITY;
    }
    const int jb = j - (4 * qb + 1);
    if (jb >= 0) {
      const int kb = 64 * jb + 4 * hi;
#pragma unroll
      for (int r = 0; r < 16; ++r) { const int kv = kb + (r & 3) + 8 * (r >> 2); if (kv > qrel) p0[r] = -INFINITY; if (kv + 32 > qrel) p1[r] = -INFINITY; }
    }
    const float off0 = slope2 * (float)(64 * j) + hioff, off1 = off0 + 32.0f * slope2;
#pragma unroll
    for (int r = 0; r < 16; ++r) { const float sb = slope2 * (float)((r & 3) + 8 * (r >> 2)); p0[r] += sb; p1[r] += sb; }
    float pm0 = p0[0], pm1 = p1[0];
#pragma unroll
    for (int r = 1; r < 16; ++r) { pm0 = fmaxf(pm0, p0[r]); pm1 = fmaxf(pm1, p1[r]); }
    float pmax = fmaxf(pm0 + off0, pm1 + off1);
    { auto rr = __builtin_amdgcn_permlane32_swap(__float_as_uint(pmax), __float_as_uint(pmax), false, false);
      pmax = fmaxf(__uint_as_float(rr[0]), __uint_as_float(rr[1])); }
    float mn, alpha;
    if (__builtin_expect(__all(pmax - m_reg <= THR2), 1)) { mn = m_reg; alpha = 1.f; }
    else { mn = fmaxf(m_reg, pmax); alpha = __builtin_amdgcn_exp2f(m_reg - mn); m_reg = mn; }
    const float c0 = off0 - mn, c1 = off1 - mn;
    float ps = 0.f;
#pragma unroll
    for (int r = 0; r < 16; ++r) { p0[r] = __builtin_amdgcn_exp2f(p0[r] + c0); p1[r] = __builtin_amdgcn_exp2f(p1[r] + c1); ps += p0[r] + p1[r]; }
    { auto rr = __builtin_amdgcn_permlane32_swap(__float_as_uint(ps), __float_as_uint(ps), false, false);
      ps = __uint_as_float(rr[0]) + __uint_as_float(rr[1]); }
    l_reg = l_reg * alpha + ps;
    if (__any(alpha < 1.f)) { if (hi == 0) wsl[r32] = alpha; asm volatile("s_waitcnt lgkmcnt(0)" ::: "memory");
#pragma unroll
      for (int rg = 0; rg < 4; ++rg) { const f32x4 al = *(const LAS f32x4*)(wsl + 8 * rg + 4 * hi);
#pragma unroll
        for (int d = 0; d < 8; ++d) { o[d][4 * rg + 0] *= al.x; o[d][4 * rg + 1] *= al.y; o[d][4 * rg + 2] *= al.z; o[d][4 * rg + 3] *= al.w; }
        SBAR(); } }
    bf16x8 pa0, pa1, pa2, pa3;
#define PK4(P, BASE, OUT) do { unsigned a0 = cvtpk(P[BASE + 0], P[BASE + 1]), a1 = cvtpk(P[BASE + 2], P[BASE + 3]);   \
    unsigned b0 = cvtpk(P[BASE + 4], P[BASE + 5]), b1 = cvtpk(P[BASE + 6], P[BASE + 7]);                              \
    auto r0 = __builtin_amdgcn_permlane32_swap(a0, b0, false, false); auto r1 = __builtin_amdgcn_permlane32_swap(a1, b1, false, false); \
    v4u w = {r0[0], r1[0], r0[1], r1[1]}; OUT = *reinterpret_cast<bf16x8*>(&w); } while (0)
    PK4(p0, 0, pa0); PK4(p0, 8, pa1); PK4(p1, 0, pa2); PK4(p1, 8, pa3);
#undef PK4
    SBAR();
    { const int vb = vb0 + cur * SHM_V;
      pv_one<0>(o[0], vb, pa0, pa1, pa2, pa3); pv_one<1>(o[1], vb, pa0, pa1, pa2, pa3); pv_one<2>(o[2], vb, pa0, pa1, pa2, pa3); pv_one<3>(o[3], vb, pa0, pa1, pa2, pa3);
      pv_one<4>(o[4], vb, pa0, pa1, pa2, pa3); pv_one<5>(o[5], vb, pa0, pa1, pa2, pa3); pv_one<6>(o[6], vb, pa0, pa1, pa2, pa3); pv_one<7>(o[7], vb, pa0, pa1, pa2, pa3); }
    VM_WAIT(); __syncthreads();
  }
  { int lane2 = threadIdx.x & 63, slot2 = slot; asm volatile("" : "+v"(lane2), "+s"(slot2));
    const int r32e = lane2 & 31, hie = lane2 >> 5;
    float* PO = (float*)(F.ws + WS_PO) + (size_t)slot2 * 256 * 256; float* ML = (float*)(F.ws + WS_ML) + (size_t)slot2 * 512;
    LAS float* wse = (LAS float*)(F.lds + LDS_WS) + wid * 64;
    if (hie == 0) { wse[r32e] = l_reg; ML[(wid * 32 + r32e) * 2] = m_reg; ML[(wid * 32 + r32e) * 2 + 1] = l_reg; }
    asm volatile("s_waitcnt lgkmcnt(0)" ::: "memory");
    char* Ob = (char*)(PO + (size_t)(wid * 32) * 256);
    const unsigned lo = (unsigned)(4 * hie * 256 + r32e) * 4u;
#pragma unroll
    for (int r = 0; r < 16; ++r) { const int rowc = (r & 3) + 8 * (r >> 2); const float lv = wse[rowc + 4 * hie]; const float rl = lv > 0.f ? __builtin_amdgcn_rcpf(lv) : 0.f;
#pragma unroll
      for (int d0 = 0; d0 < 8; ++d0) *(float*)(Ob + (lo + (unsigned)(rowc * 256 + d0 * 32) * 4u)) = o[d0][r] * rl;
      SBAR(); } }
  __syncthreads();
#undef STAGE_K
#undef STAGE_V
}

__device__ __forceinline__ void phase(const Frame& F, int ca, int NA) {
  int s0 = (int)(((long)ca * NSTEPS) / NA); const int s1 = (int)(((long)(ca + 1) * NSTEPS) / NA);
  while (s0 < s1) {
    const int bhm = s0 / STEPS_BHM, rem = s0 - bhm * STEPS_BHM;
    int qb = 0;
#pragma unroll 1
    for (int q = 1; q < 8; ++q) if (rem >= qb_start(q)) qb = q;
    const int j0 = rem - qb_start(qb), nst = 4 * qb + 5;
    const int j1 = (j0 + (s1 - s0) < nst) ? j0 + (s1 - s0) : nst;
    const int slot = bhm * 16 + qb + chunk_of(s0, NA) - chunk_of(bhm * STEPS_BHM, NA);
    segment(F, bhm, qb, j0, j1, slot);
    s0 += j1 - j0;
  }
}
#undef KSWZ
#undef SBAR
}
namespace ml {
constexpr int QST = 136, TST = 72;
constexpr int L_RQ = 0, L_RK = 17152, L_QS = 34304, L_QW = 51712, L_KS = 69120, L_KWT = 86528, L_VT = 104960  , L_SP = 0  , L_G = 141824, L_CW = 143872;
constexpr int L_HT = 0;
constexpr int G_A = 0, G_M = 64, G_WI = 128, G_EM = 192, G_DEN = 256, G_WG = 320, G_SC = 384, G_N = 0;
constexpr int L_NV = L_CW + 5120;
constexpr int L_SSQ = L_KWT;
__device__ __forceinline__ float shfl_up_f(float v, int d) { return __shfl_up(v, d); }

__device__ __forceinline__ void load_cw(const Frame& F, const Args& a, int h) {
  LAS float* CW = (LAS float*)(F.lds + L_CW);
  for (int e = F.tid; e < 2 * 5 * 128; e += NTHR) { const int qk = e / 640, j = (e / 128) % 5, d = e & 127; const int ch = qk * 512 + h * 128 + d;
    CW[e] = j < 4 ? a.in[IN_CW][j * 1024 + ch] : a.in[IN_CB][ch]; }
}
__device__ __forceinline__ void load_raw(const Frame& F, const bf16* g, int pos0, int lds_off) {
  for (int p = F.tid; p < 67 * 16; p += NTHR) { const int row = p >> 4, ch = p & 15, pos = pos0 - 3 + row;
    v4u v = {0u, 0u, 0u, 0u}; if (pos >= MPOS0) v = *(const v4u*)(g + (size_t)pos * 128 + ch * 8);
    *(LAS v4u*)(F.lds + lds_off + row * 256 + ch * 16) = v; }
}
__device__ __forceinline__ void conv16(const Frame& F, int qk, int lds_off, int t, int d0, float (&y)[16]) {
  const LAS float* CW = (const LAS float*)(F.lds + L_CW);
#pragma unroll
  for (int e = 0; e < 16; ++e) y[e] = CW[(qk * 5 + 4) * 128 + d0 + e];
#pragma unroll
  for (int j = 0; j < 4; ++j) { const LAS v4u* rp = (const LAS v4u*)(F.lds + lds_off + (t + j) * 256 + d0 * 2); const v4u r0 = rp[0], r1 = rp[1];
    const LAS float* cw = CW + (qk * 5 + j) * 128 + d0;
    y[0] += cw[0] * bflo(r0.x); y[1] += cw[1] * bfhi(r0.x); y[2] += cw[2] * bflo(r0.y); y[3] += cw[3] * bfhi(r0.y); y[4] += cw[4] * bflo(r0.z); y[5] += cw[5] * bfhi(r0.z); y[6] += cw[6] * bflo(r0.w); y[7] += cw[7] * bfhi(r0.w);
    y[8] += cw[8] * bflo(r1.x); y[9] += cw[9] * bfhi(r1.x); y[10] += cw[10] * bflo(r1.y); y[11] += cw[11] * bfhi(r1.y); y[12] += cw[12] * bflo(r1.z); y[13] += cw[13] * bfhi(r1.z); y[14] += cw[14] * bflo(r1.w); y[15] += cw[15] * bfhi(r1.w); }
#pragma unroll
  for (int e = 0; e < 16; ++e) y[e] = y[e] / (1.0f + __expf(-y[e]));
}
__device__ __forceinline__ void load_vt(const Frame& F, const bf16* MVg, int pos0) {
#pragma unroll
  for (int i = 0; i < 4; ++i) { const int p = F.tid + NTHR * i, row = p >> 5, ch = p & 31; v4u v4 = {0u, 0u, 0u, 0u};
    if (pos0 + row >= MPOS0) v4 = *(const v4u*)(MVg + (size_t)(pos0 + row) * 256 + ch * 8);
    LAS bf16* vt = (LAS bf16*)(F.lds + L_VT) + (ch * 8) * TST + row;
    vt[0 * TST] = (bf16)(v4.x & 0xffff); vt[1 * TST] = (bf16)(v4.x >> 16); vt[2 * TST] = (bf16)(v4.y & 0xffff); vt[3 * TST] = (bf16)(v4.y >> 16);
    vt[4 * TST] = (bf16)(v4.z & 0xffff); vt[5 * TST] = (bf16)(v4.z >> 16); vt[6 * TST] = (bf16)(v4.w & 0xffff); vt[7 * TST] = (bf16)(v4.w >> 16); }
}

__device__ __forceinline__ void taskA(const Frame& F, const Args& a, int task) {
  const int bh = task >> 5, c = task & 31, h = bh & 3, tid = F.tid, w = F.wave, lane = F.lane, fr = lane & 15, kq = lane >> 4, pos0 = 64 * c;
  LAS unsigned char* lds = F.lds; LAS float* G = (LAS float*)(lds + L_G);
  const bf16* MKg = (const bf16*)(F.ws + WS_MK) + (size_t)bh * PADT * 128; const bf16* MVg = (const bf16*)(F.ws + WS_MV) + (size_t)bh * PADT * 256;
  __syncthreads();
  load_cw(F, a, h); load_raw(F, MKg, pos0, L_RK); load_vt(F, MVg, pos0);
  if (w == 0) {
    const bool dead = pos0 + lane < MPOS0;
    const float li = dead ? -1e30f : ((const float*)(F.ws + WS_LI))[bh * PADT + pos0 + lane], lf = dead ? 0.f : ((const float*)(F.ws + WS_LF))[bh * PADT + pos0 + lane];
    float bs = lf;
#pragma unroll
    for (int d = 1; d < 64; d <<= 1) { const float o = shfl_up_f(bs, d); if (lane >= d) bs += o; }
    const float av = li - bs; float mx = av;
#pragma unroll
    for (int o = 1; o < 64; o <<= 1) mx = fmaxf(mx, __shfl_xor(mx, o));
    G[G_WG + lane] = __expf(av - mx);
    if (lane == 63) { float* gs = (float*)(F.ws + WS_GS) + (size_t)(bh * 33 + c) * 2; gs[0] = bs; gs[1] = mx; }
  }
  __syncthreads();
  { const int t = tid >> 3, d0 = (tid & 7) * 16; float y[16]; conv16(F, 1, L_RK, t, d0, y);
    const float sw = 0.08838834764831845f * G[G_WG + t]; LAS bf16* kt = (LAS bf16*)(lds + L_KWT) + d0 * TST + t;
#pragma unroll
    for (int e = 0; e < 16; ++e) kt[e * TST] = (bf16)f2bf(y[e] * sw); }
  __syncthreads();
  f32x4* DCg = (f32x4*)(F.ws + WS_DC) + ((size_t)(bh * 32 + c) * 128) * 64;
#pragma unroll
  for (int jj = 0; jj < 2; ++jj) { const int j = 2 * w + jj;
    const bf16x8 bv0 = *(const LAS bf16x8*)(lds + L_VT + ((16 * j + fr) * TST + 8 * kq) * 2), bv1 = *(const LAS bf16x8*)(lds + L_VT + ((16 * j + fr) * TST + 32 + 8 * kq) * 2);
#pragma unroll
    for (int i = 0; i < 8; ++i) { f32x4 acc = {0.f, 0.f, 0.f, 0.f};
      const bf16x8 k0 = *(const LAS bf16x8*)(lds + L_KWT + ((16 * i + fr) * TST + 8 * kq) * 2), k1 = *(const LAS bf16x8*)(lds + L_KWT + ((16 * i + fr) * TST + 32 + 8 * kq) * 2);
      acc = __builtin_amdgcn_mfma_f32_16x16x32_bf16(k0, bv0, acc, 0, 0, 0); acc = __builtin_amdgcn_mfma_f32_16x16x32_bf16(k1, bv1, acc, 0, 0, 0);
      DCg[(size_t)(i * 16 + j) * 64 + lane] = acc; } }
  if (tid < 128) { const LAS v4u* kr = (const LAS v4u*)(lds + L_KWT + tid * TST * 2); float s = 0.f;
#pragma unroll
    for (int q = 0; q < 8; ++q) { const v4u x = kr[q]; s += (bflo(x.x) + bfhi(x.x)) + (bflo(x.y) + bfhi(x.y)) + (bflo(x.z) + bfhi(x.z)) + (bflo(x.w) + bfhi(x.w)); }
    ((float*)(F.ws + WS_DN))[(size_t)(bh * 32 + c) * 128 + tid] = s; }
}

__device__ __forceinline__ void scanB(const Frame& F) {
  const float* GS = (const float*)(F.ws + WS_GS);
  LAS float* cf = (LAS float*)F.lds;
  for (int blk = blockIdx.x; blk < 16 * 16; blk += gridDim.x) { const int bh = blk >> 4, r = (blk & 15) * NTHR + F.tid, i = r >> 10, j = (r >> 6) & 15, ln = r & 63;
    __syncthreads();
    if (F.tid == 0) { float m = 0.f; for (int c = 0; c < 32; ++c) { const float bL = GS[(bh * 33 + c) * 2], ml = GS[(bh * 33 + c) * 2 + 1], me = fmaxf(m, ml);
        cf[2 * c] = __expf(m - me); cf[2 * c + 1] = __expf(ml - me); m = bL + me; } }
    __syncthreads();
    const f32x4* dc = (const f32x4*)(F.ws + WS_DC) + ((size_t)(bh * 32) * 128 + (i * 16 + j)) * 64 + ln;
    v2u* cs = (v2u*)(F.ws + WS_CS) + ((((size_t)bh * 33) * 4 + (i >> 1)) * 16 + j) * 64 * 2 + ln * 2 + (i & 1);
    f32x4 st = {0.f, 0.f, 0.f, 0.f};
#pragma unroll 8
    for (int c = 0; c < 32; ++c) { st = st * cf[2 * c] + dc[(size_t)c * 128 * 64] * cf[2 * c + 1];
      v2u o; o.x = pk2(st.x, st.y); o.y = pk2(st.z, st.w); cs[(size_t)(c + 1) * 4 * 16 * 64 * 2] = o; } }
  const int gt = blockIdx.x * NTHR + F.tid, NT = gridDim.x * NTHR;
  for (int g = gt; g < 16 * 128; g += NT) { const int bh = g >> 7, d = g & 127; float n = 0.f, m = 0.f;
    for (int c = 0; c < 32; ++c) { const float bL = GS[(bh * 33 + c) * 2], ml = GS[(bh * 33 + c) * 2 + 1], me = fmaxf(m, ml);
      n = n * __expf(m - me) + ((const float*)(F.ws + WS_DN))[(size_t)(bh * 32 + c) * 128 + d] * __expf(ml - me); m = bL + me;
      ((float*)(F.ws + WS_NS))[(size_t)(bh * 33 + c + 1) * 128 + d] = n; if (d == 0) ((float*)(F.ws + WS_MS))[bh * 33 + c + 1] = m; } }
}

__device__ __forceinline__ void taskC(const Frame& F, const Args& a, int task) {
  const int bh = task >> 5, c = (task & 31) + 1, b = bh >> 2, h = bh & 3, tid = F.tid, w = F.wave, lane = F.lane, fr = lane & 15, kq = lane >> 4, pos0 = 64 * c;
  LAS unsigned char* lds = F.lds; LAS float* G = (LAS float*)(lds + L_G); LAS float* NV = (LAS float*)(lds + L_NV);
  const bf16* MQg = (const bf16*)(F.ws + WS_MQ) + (size_t)bh * PADT * 128; const bf16* MKg = (const bf16*)(F.ws + WS_MK) + (size_t)bh * PADT * 128;
  const bf16* MVg = (const bf16*)(F.ws + WS_MV) + (size_t)bh * PADT * 256;
  const float m = ((const float*)(F.ws + WS_MS))[bh * 33 + c];
  __syncthreads();
  load_cw(F, a, h); load_raw(F, MQg, pos0, L_RQ); load_raw(F, MKg, pos0, L_RK); load_vt(F, MVg, pos0);
  if (tid < 128) NV[tid] = ((const float*)(F.ws + WS_NS))[(size_t)(bh * 33 + c) * 128 + tid];
  if (w == 0) {
    const float li = ((const float*)(F.ws + WS_LI))[bh * PADT + pos0 + lane], lf = ((const float*)(F.ws + WS_LF))[bh * PADT + pos0 + lane];
    float bs = lf;
#pragma unroll
    for (int d = 1; d < 64; d <<= 1) { const float o = shfl_up_f(bs, d); if (lane >= d) bs += o; }
    const float av = li - bs; float cm = av;
#pragma unroll
    for (int d = 1; d < 64; d <<= 1) { const float o = shfl_up_f(cm, d); if (lane >= d) cm = fmaxf(cm, o); }
    const float Mt = fmaxf(m, cm);
    G[G_A + lane] = av; G[G_M + lane] = Mt; G[G_WI + lane] = __expf(m - Mt); G[G_EM + lane] = __expf(-(bs + Mt));
  }
  __syncthreads();
  { const int t = tid >> 3, d0 = (tid & 7) * 16; const float wi = G[G_WI + t]; float y[16];
    conv16(F, 0, L_RQ, t, d0, y);
    { v4u o0, o1, w0, w1;
      o0.x = pk2(y[0], y[1]); o0.y = pk2(y[2], y[3]); o0.z = pk2(y[4], y[5]); o0.w = pk2(y[6], y[7]); o1.x = pk2(y[8], y[9]); o1.y = pk2(y[10], y[11]); o1.z = pk2(y[12], y[13]); o1.w = pk2(y[14], y[15]);
      w0.x = pk2(y[0] * wi, y[1] * wi); w0.y = pk2(y[2] * wi, y[3] * wi); w0.z = pk2(y[4] * wi, y[5] * wi); w0.w = pk2(y[6] * wi, y[7] * wi);
      w1.x = pk2(y[8] * wi, y[9] * wi); w1.y = pk2(y[10] * wi, y[11] * wi); w1.z = pk2(y[12] * wi, y[13] * wi); w1.w = pk2(y[14] * wi, y[15] * wi);
      LAS v4u* qs = (LAS v4u*)(lds + L_QS + (t * QST + d0) * 2); qs[0] = o0; qs[1] = o1;
      LAS v4u* qw = (LAS v4u*)(lds + L_QW + (t * QST + d0) * 2); qw[0] = w0; qw[1] = w1; }
    __builtin_amdgcn_sched_barrier(0);
    conv16(F, 1, L_RK, t, d0, y);
    { const float sc = 0.08838834764831845f; v4u o0, o1;
      o0.x = pk2(y[0] * sc, y[1] * sc); o0.y = pk2(y[2] * sc, y[3] * sc); o0.z = pk2(y[4] * sc, y[5] * sc); o0.w = pk2(y[6] * sc, y[7] * sc);
      o1.x = pk2(y[8] * sc, y[9] * sc); o1.y = pk2(y[10] * sc, y[11] * sc); o1.z = pk2(y[12] * sc, y[13] * sc); o1.w = pk2(y[14] * sc, y[15] * sc);
      LAS v4u* ks = (LAS v4u*)(lds + L_KS + (t * QST + d0) * 2); ks[0] = o0; ks[1] = o1; } }
  __syncthreads();
  v4u cb[4][2];
  { const v4u* cs = (const v4u*)(F.ws + WS_CS) + (((size_t)bh * 33 + c) * 4 * 16) * 64;
#pragma unroll
    for (int I = 0; I < 4; ++I)
#pragma unroll
      for (int jj = 0; jj < 2; ++jj) cb[I][jj] = cs[(size_t)(I * 16 + 2 * w + jj) * 64 + lane]; }
  { const int si = w >> 1; const f32x4 as = *(const LAS f32x4*)(G + G_A + 16 * si + 4 * kq);
#pragma unroll
    for (int tt = 0; tt < 2; ++tt) { const int ti = 2 * (w & 1) + tt; f32x4 acc = {0.f, 0.f, 0.f, 0.f};
#pragma unroll
      for (int ks = 0; ks < 4; ++ks) { const bf16x8 af = *(const LAS bf16x8*)(lds + L_KS + ((16 * si + fr) * QST + 32 * ks + 8 * kq) * 2);
        const bf16x8 bfr = *(const LAS bf16x8*)(lds + L_QS + ((16 * ti + fr) * QST + 32 * ks + 8 * kq) * 2);
        acc = __builtin_amdgcn_mfma_f32_16x16x32_bf16(af, bfr, acc, 0, 0, 0); }
      const int t = 16 * ti + fr, s0 = 16 * si + 4 * kq; const float Mt = G[G_M + t];
      const float v0 = (s0 + 0 <= t) ? acc.x * __expf(as.x - Mt) : 0.f, v1 = (s0 + 1 <= t) ? acc.y * __expf(as.y - Mt) : 0.f;
      const float v2 = (s0 + 2 <= t) ? acc.z * __expf(as.z - Mt) : 0.f, v3 = (s0 + 3 <= t) ? acc.w * __expf(as.w - Mt) : 0.f;
      v2u o; o.x = pk2(v0, v1); o.y = pk2(v2, v3);
      *(LAS v2u*)(lds + L_SP + (t * TST + s0) * 2) = o; } }
  __syncthreads();
  if (w == 0) { const int t = lane; float qn = 0.f, rsum = 0.f;
#pragma unroll 4
    for (int q = 0; q < 16; ++q) { const v4u x = *(const LAS v4u*)(lds + L_QS + (t * QST + q * 8) * 2); const f32x4 n0 = *(const LAS f32x4*)(NV + q * 8), n1 = *(const LAS f32x4*)(NV + q * 8 + 4);
      qn += bflo(x.x) * n0.x + bfhi(x.x) * n0.y + bflo(x.y) * n0.z + bfhi(x.y) * n0.w + bflo(x.z) * n1.x + bfhi(x.z) * n1.y + bflo(x.w) * n1.z + bfhi(x.w) * n1.w; }
#pragma unroll
    for (int q = 0; q < 8; ++q) { const v4u x = *(const LAS v4u*)(lds + L_SP + (t * TST + q * 8) * 2); rsum += (bflo(x.x) + bfhi(x.x)) + (bflo(x.y) + bfhi(x.y)) + (bflo(x.z) + bfhi(x.z)) + (bflo(x.w) + bfhi(x.w)); }
    const float den = G[G_WI + t] * qn + rsum; G[G_DEN + t] = fmaxf(fabsf(den), G[G_EM + t]); }
  f32x4 acc[2][4];
#pragma unroll
  for (int jj = 0; jj < 2; ++jj)
#pragma unroll
    for (int ti = 0; ti < 4; ++ti) acc[jj][ti] = (f32x4){0.f, 0.f, 0.f, 0.f};
#pragma unroll
  for (int I = 0; I < 4; ++I) {
#pragma unroll
    for (int ti = 0; ti < 4; ++ti) { const LAS unsigned char* qp = lds + L_QW + ((16 * ti + fr) * QST + 32 * I + 4 * kq) * 2;
      const v2u a0 = *(const LAS v2u*)qp, a1 = *(const LAS v2u*)(qp + 32); const v4u av = {a0.x, a0.y, a1.x, a1.y};
      acc[0][ti] = __builtin_amdgcn_mfma_f32_16x16x32_bf16(__builtin_bit_cast(bf16x8, av), __builtin_bit_cast(bf16x8, cb[I][0]), acc[0][ti], 0, 0, 0);
      acc[1][ti] = __builtin_amdgcn_mfma_f32_16x16x32_bf16(__builtin_bit_cast(bf16x8, av), __builtin_bit_cast(bf16x8, cb[I][1]), acc[1][ti], 0, 0, 0); }
    __builtin_amdgcn_sched_barrier(0); }
#pragma unroll
  for (int ks = 0; ks < 2; ++ks) { const bf16x8 bv0 = *(const LAS bf16x8*)(lds + L_VT + ((32 * w + fr) * TST + 32 * ks + 8 * kq) * 2), bv1 = *(const LAS bf16x8*)(lds + L_VT + ((32 * w + 16 + fr) * TST + 32 * ks + 8 * kq) * 2);
#pragma unroll
    for (int ti = 0; ti < 4; ++ti) { const bf16x8 sf = *(const LAS bf16x8*)(lds + L_SP + ((16 * ti + fr) * TST + 32 * ks + 8 * kq) * 2);
      acc[0][ti] = __builtin_amdgcn_mfma_f32_16x16x32_bf16(sf, bv0, acc[0][ti], 0, 0, 0); acc[1][ti] = __builtin_amdgcn_mfma_f32_16x16x32_bf16(sf, bv1, acc[1][ti], 0, 0, 0); } }
  __syncthreads();
  LAS float* SSQ = (LAS float*)(lds + L_SSQ);
#pragma unroll
  for (int ti = 0; ti < 4; ++ti) { const f32x4 dn = *(const LAS f32x4*)(G + G_DEN + 16 * ti + 4 * kq);
    f32x4 s4;
#pragma unroll
    for (int r = 0; r < 4; ++r) { const float h0 = acc[0][ti][r] / dn[r], h1 = acc[1][ti][r] / dn[r]; acc[0][ti][r] = h0; acc[1][ti][r] = h1; s4[r] = h0 * h0 + h1 * h1; }
#pragma unroll
    for (int o = 1; o < 16; o <<= 1) { s4.x += __shfl_xor(s4.x, o); s4.y += __shfl_xor(s4.y, o); s4.z += __shfl_xor(s4.z, o); s4.w += __shfl_xor(s4.w, o); }
    if (fr == 0) { SSQ[(16 * ti + 4 * kq + 0) * 8 + w] = s4.x; SSQ[(16 * ti + 4 * kq + 1) * 8 + w] = s4.y; SSQ[(16 * ti + 4 * kq + 2) * 8 + w] = s4.z; SSQ[(16 * ti + 4 * kq + 3) * 8 + w] = s4.w; } }
  __syncthreads();
  LAS bf16* HT = (LAS bf16*)(lds + L_HT);
#pragma unroll
  for (int ti = 0; ti < 4; ++ti)
#pragma unroll
    for (int r = 0; r < 4; ++r) { const int t = 16 * ti + 4 * kq + r; const f32x4 p0 = *(const LAS f32x4*)(SSQ + t * 8), p1 = *(const LAS f32x4*)(SSQ + t * 8 + 4);
      const float rh = rsqrtf(((p0.x + p0.y) + (p0.z + p0.w) + (p1.x + p1.y) + (p1.z + p1.w)) * (1.0f / 256.f) + EPS);
      HT[t * 264 + 32 * w + fr] = (bf16)f2bf(acc[0][ti][r] * rh); HT[t * 264 + 32 * w + 16 + fr] = (bf16)f2bf(acc[1][ti][r] * rh); }
  __syncthreads();
  { const int t = tid >> 3, c0 = (tid & 7) * 32; const size_t R = (size_t)b * SEQ + 64 * (c - 1) + t;
    const bf16* mo = (const bf16*)(F.ws + WS_MO) + R * 1024 + h * 256 + c0; const float* og = a.in[IN_OUTG] + h * 256 + c0; bf16* A2 = (bf16*)(F.ws + WS_A2) + R * DM + 1024 + h * 256 + c0;
#pragma unroll
    for (int q = 0; q < 4; ++q) { const v4u hv = *(const LAS v4u*)(HT + t * 264 + c0 + q * 8); const v4u mv = *(const v4u*)(mo + q * 8); const f32x4 g0 = *(const f32x4*)(og + q * 8), g1 = *(const f32x4*)(og + q * 8 + 4);
      v4u o; o.x = pk2(bflo(hv.x) * g0.x * bflo(mv.x), bfhi(hv.x) * g0.y * bfhi(mv.x)); o.y = pk2(bflo(hv.y) * g0.z * bflo(mv.y), bfhi(hv.y) * g0.w * bfhi(mv.y));
      o.z = pk2(bflo(hv.z) * g1.x * bflo(mv.z), bfhi(hv.z) * g1.y * bfhi(mv.z)); o.w = pk2(bflo(hv.w) * g1.z * bflo(mv.w), bfhi(hv.w) * g1.w * bfhi(mv.w));
      *(v4u*)(A2 + q * 8) = o; } }
}
}
__device__ __forceinline__ void p3_combine(const Frame& F, const Args& a, int NA) {
  const float* PO = (const float*)(F.ws + WS_PO); const float* ML = (const float*)(F.ws + WS_ML);
  bf16* A2 = (bf16*)(F.ws + WS_A2);
  const float lam = *(const float*)(F.ws + WS_LAM);
  const float* subg = a.in[IN_SUBG];
  const int gw = blockIdx.x * NWAVES + F.wave, NGW = gridDim.x * NWAVES, lane = F.lane;
  const f32x4 sg = ((const f32x4*)subg)[lane];
  for (int R = gw; R < MROWS; R += NGW) {
    const int b = R >> 11, t = R & 2047, qb = t >> 8, rq = t & 255;
#pragma unroll 2
    for (int h = 0; h < 4; ++h) {
      f32x4 om[2];
#pragma unroll
      for (int m = 0; m < 2; ++m) {
        const int bhm = (b * 4 + h) * 2 + m, first = bhm * att::STEPS_BHM + att::qb_start(qb), last = first + 4 * qb + 4;
        const int cf = att::chunk_of(first, NA), np = att::chunk_of(last, NA) - cf + 1, slot0 = bhm * 16 + qb + cf - att::chunk_of(bhm * att::STEPS_BHM, NA);
        float mp[3], lp[3]; f32x4 op[3];
#pragma unroll
        for (int p = 0; p < 3; ++p) { if (p < np) { const int slot = slot0 + p; mp[p] = ML[(size_t)slot * 512 + rq * 2]; lp[p] = ML[(size_t)slot * 512 + rq * 2 + 1];
            op[p] = ((const f32x4*)(PO + ((size_t)slot * 256 + rq) * 256))[lane]; } else { mp[p] = -1e30f; lp[p] = 0.f; op[p] = (f32x4){0.f, 0.f, 0.f, 0.f}; } }
        const float M = fmaxf(mp[0], fmaxf(mp[1], mp[2]));
        float wsum = 0.f; f32x4 acc = (f32x4){0.f, 0.f, 0.f, 0.f};
#pragma unroll
        for (int p = 0; p < 3; ++p) { const float w = lp[p] * exp2f(mp[p] - M); wsum += w; acc += op[p] * w; }
        om[m] = acc * (1.0f / wsum);
      }
      const f32x4 o = om[0] - om[1] * lam;
      const float rs = rsqrtf(wave_sum((o.x * o.x + o.y * o.y) + (o.z * o.z + o.w * o.w)) * (1.0f / 256.f) + EPS) * 0.8f;
      v2u w; w.x = pk2(o.x * rs * sg.x, o.y * rs * sg.y); w.y = pk2(o.z * rs * sg.z, o.w * rs * sg.w);
      ((v2u*)(A2 + (size_t)R * DM + h * 256))[lane] = w;
    }
  }
}
struct EpiRes {
  static constexpr bool PERM = true, AFTER_DRAIN = false;
  const float* x; float* out; bf16* H1b; float* SSQ;
  __device__ __forceinline__ void operator()(const pg8::f32x4 (&acc)[2][2][4][2], const pg8::Unit& u, int wr, int wc, int fr, int fq) const {
    const int row0 = u.pm * 256 + wr * 64 + fr, col0 = u.pn * 256 + wc * 32 + 8 * fq;
#pragma unroll
    for (int ai = 0; ai < 2; ++ai)
#pragma unroll
      for (int m = 0; m < 4; ++m) { const size_t R = (size_t)(row0 + ai * 128 + m * 16); float s = 0.f;
#pragma unroll
        for (int bj = 0; bj < 2; ++bj) { const size_t off = R * DM + col0 + bj * 128;
          const f32x4 x0 = *(const f32x4*)(x + off), x1 = *(const f32x4*)(x + off + 4);
          const f32x4 v0 = acc[ai][bj][m][0] + x0, v1 = acc[ai][bj][m][1] + x1;
          v4u w; w.x = pk2(v0.x, v0.y); w.y = pk2(v0.z, v0.w); w.z = pk2(v1.x, v1.y); w.w = pk2(v1.z, v1.w);
          *(v4u*)(H1b + off) = w;
          s += (v0.x * v0.x + v0.y * v0.y) + (v0.z * v0.z + v0.w * v0.w) + (v1.x * v1.x + v1.y * v1.y) + (v1.z * v1.z + v1.w * v1.w); }
        s += __shfl_xor(s, 16); s += __shfl_xor(s, 32);
        if (fq == 0) SSQ[R * 32 + u.pn * 4 + wc] = s; }
  }
};
#ifndef PEER_U_FP8
#define PEER_U_FP8 0
#endif
typedef __bf16 bfv2 __attribute__((ext_vector_type(2)));
__device__ __forceinline__ void split_hl(const f32x4 a, const f32x4 b, bf16x8& hi, bf16x8& lo) {
  float v[8] = {a.x, a.y, a.z, a.w, b.x, b.y, b.z, b.w}; unsigned h[8], l[8];
#pragma unroll
  for (int i = 0; i < 8; ++i) { h[i] = f2bf(v[i]); l[i] = f2bf(v[i] - __builtin_bit_cast(float, h[i] << 16)); }
  v4u hv = {h[0] | (h[1] << 16), h[2] | (h[3] << 16), h[4] | (h[5] << 16), h[6] | (h[7] << 16)};
  v4u lv = {l[0] | (l[1] << 16), l[2] | (l[3] << 16), l[4] | (l[5] << 16), l[6] | (l[7] << 16)};
  hi = __builtin_bit_cast(bf16x8, hv); lo = __builtin_bit_cast(bf16x8, lv);
}
__device__ __forceinline__ void p0_w3t(const Frame& F, const Args& a) {
  const float* wq = a.in[IN_WQ]; const float* sk = a.in[IN_SUBK]; const float* g2 = a.in[IN_G2];
  bf16* W3t = (bf16*)(F.ws + WS_W3T);
  const int gw = blockIdx.x * NWAVES + F.wave, NGW = gridDim.x * NWAVES, lane = F.lane, fr = lane & 15, fq = lane >> 4;
  for (int task = gw; task < 128 * 16; task += NGW) {
    const int kt = task >> 4, hh = task & 15;
    bf16x8 ahi[4], alo[4];
    const float* ap = wq + (size_t)(kt * 16 + fr) * DM + hh * 128 + fq * 8;
#pragma unroll
    for (int s = 0; s < 4; ++s) split_hl(*(const f32x4*)(ap + 32 * s), *(const f32x4*)(ap + 32 * s + 4), ahi[s], alo[s]);
    const f32x4 gk = *(const f32x4*)(g2 + kt * 16 + fq * 4);
#pragma unroll 1
    for (int t2 = 0; t2 < 8; ++t2) {
      const float* bp = sk + (size_t)(hh * 128 + t2 * 16 + fr) * 128 + fq * 8;
      f32x4 acc = {0.f, 0.f, 0.f, 0.f};
#pragma unroll
      for (int s = 0; s < 4; ++s) { bf16x8 bhi, blo; split_hl(*(const f32x4*)(bp + 32 * s), *(const f32x4*)(bp + 32 * s + 4), bhi, blo);
        acc = __builtin_amdgcn_mfma_f32_16x16x32_bf16(ahi[s], bhi, acc, 0, 0, 0);
        acc = __builtin_amdgcn_mfma_f32_16x16x32_bf16(ahi[s], blo, acc, 0, 0, 0);
        acc = __builtin_amdgcn_mfma_f32_16x16x32_bf16(alo[s], bhi, acc, 0, 0, 0); }
      v2u o; o.x = pk2(acc.x * gk.x, acc.y * gk.y); o.y = pk2(acc.z * gk.z, acc.w * gk.w);
      *(v2u*)(W3t + (size_t)(hh * 128 + t2 * 16 + fr) * DM + kt * 16 + fq * 4) = o;
    }
  }
}
typedef float f32x2v __attribute__((ext_vector_type(2)));
__device__ __forceinline__ void p0_tables(const Frame& F, const Args& a) {
  const float* g2 = a.in[IN_G2];
  float* SCL = (float*)(F.ws + WS_SCL);
  const int gw = blockIdx.x * NWAVES + F.wave, NGW = gridDim.x * NWAVES, lane = F.lane;
  f32x4 gl[8];
#pragma unroll
  for (int q = 0; q < 8; ++q) gl[q] = *(const f32x4*)(g2 + lane * 32 + q * 4);
  f32x4 xn[8];
  { const int row = gw; if (row < 2 * 16384) { const float* src = a.in[row >= 16384 ? IN_V : IN_U] + (size_t)(row & 16383) * DM + lane * 32;
#pragma unroll
      for (int q = 0; q < 8; ++q) xn[q] = *(const f32x4*)(src + q * 4); } }
  for (int row = gw; row < 2 * 16384; row += NGW) {
    const bool isv = row >= 16384; const int e = row & 16383;
    f32x4 x[8];
#pragma unroll
    for (int q = 0; q < 8; ++q) x[q] = xn[q];
    { const int rn = row + NGW; if (rn < 2 * 16384) { const float* src = a.in[rn >= 16384 ? IN_V : IN_U] + (size_t)(rn & 16383) * DM + lane * 32;
#pragma unroll
        for (int q = 0; q < 8; ++q) xn[q] = *(const f32x4*)(src + q * 4); } }
    float amax = 0.f;
#pragma unroll
    for (int q = 0; q < 8; ++q) { if (!isv) x[q] = x[q] * gl[q]; amax = fmaxf(amax, fmaxf(fmaxf(fabsf(x[q].x), fabsf(x[q].y)), fmaxf(fabsf(x[q].z), fabsf(x[q].w)))); }
#pragma unroll
    for (int o = 1; o < 64; o <<= 1) amax = fmaxf(amax, __shfl_xor(amax, o));
    const float sc = amax > 0.f ? 6.0f / amax : 1.0f;
    v4u w;
#pragma unroll
    for (int d = 0; d < 4; ++d) { unsigned pk = 0u;
      pk = __builtin_amdgcn_cvt_scalef32_pk_fp4_f32(pk, x[2 * d].x * sc, x[2 * d].y * sc, 1.0f, 0); pk = __builtin_amdgcn_cvt_scalef32_pk_fp4_f32(pk, x[2 * d].z * sc, x[2 * d].w * sc, 1.0f, 1);
      pk = __builtin_amdgcn_cvt_scalef32_pk_fp4_f32(pk, x[2 * d + 1].x * sc, x[2 * d + 1].y * sc, 1.0f, 2); pk = __builtin_amdgcn_cvt_scalef32_pk_fp4_f32(pk, x[2 * d + 1].z * sc, x[2 * d + 1].w * sc, 1.0f, 3);
      w[d] = pk; }
    *(v4u*)(F.ws + (isv ? WS_VB8 : WS_UB) + (size_t)e * 1024 + lane * 16) = w;
    if (lane == 0) SCL[row] = 1.0f / sc;
  }
}
struct EpiScore {
  static constexpr bool PERM = true, AFTER_DRAIN = false;
  float* S; const LAS float* rs;
  __device__ __forceinline__ void operator()(const pg8::f32x4 (&acc)[2][2][4][2], const pg8::Unit& u, int wr, int wc, int fr, int fq) const {
    const int rl0 = wr * 64 + fr, keyb = wc * 32 + 8 * fq;
#pragma unroll
    for (int ai = 0; ai < 2; ++ai)
#pragma unroll
      for (int m = 0; m < 4; ++m) { const int rl = rl0 + ai * 128 + m * 16; const float r = rs[rl]; const int row = u.pm * 256 + rl;
#pragma unroll
        for (int bj = 0; bj < 2; ++bj) { float* d = S + ((size_t)((row >> 5) * 16 + u.pn * 2 + bj) * 128 + keyb) * 32 + (row & 31);
          const pg8::f32x4 v0 = acc[ai][bj][m][0] * r, v1 = acc[ai][bj][m][1] * r;
          d[0] = v0[0]; d[32] = v0[1]; d[64] = v0[2]; d[96] = v0[3]; d[128] = v1[0]; d[160] = v1[1]; d[192] = v1[2]; d[224] = v1[3]; } }
  }
};

__device__ __forceinline__ unsigned fkey(float f) { const unsigned b = __builtin_bit_cast(unsigned, f); return b ^ ((b >> 31) ? 0xFFFFFFFFu : 0x80000000u); }
template <int NV, int K> __device__ __forceinline__ void wave_topk(const unsigned (&u)[NV], bool (&sel)[NV], int lane) {
  unsigned prefix = 0u; int cge = NV * 64;
#pragma unroll 1
  for (int bit = 31; bit >= 0 && cge != K; --bit) {
    const unsigned cand = prefix | (1u << bit); int c = 0;
#pragma unroll
    for (int i = 0; i < NV; ++i) c += __builtin_popcountll(__ballot(u[i] >= cand));
    if (c >= K) { prefix = cand; cge = c; }
  }
  int cgt = 0;
#pragma unroll
  for (int i = 0; i < NV; ++i) cgt += __builtin_popcountll(__ballot(u[i] > prefix));
  int need = K - cgt;
  const unsigned long long lm = (1ull << lane) - 1ull;
#pragma unroll
  for (int i = 0; i < NV; ++i) { const unsigned long long eq = __ballot(u[i] == prefix); const int before = __builtin_popcountll(eq & lm);
    sel[i] = (u[i] > prefix) || (u[i] == prefix && before < need); const int ne = __builtin_popcountll(eq); need = need > ne ? need - ne : 0; }
}
template <int NG, int NV, int K> __device__ __forceinline__ void wave_topk_multi(const unsigned (&u)[NG][NV], bool (&sel)[NG][NV], int lane) {
  unsigned prefix[NG]; int cge[NG];
#pragma unroll
  for (int g = 0; g < NG; ++g) { prefix[g] = 0u; cge[g] = NV * 64; }
#pragma unroll 1
  for (int bit = 31; bit >= 0; --bit) {
    bool done = true;
#pragma unroll
    for (int g = 0; g < NG; ++g) done = done && (cge[g] == K);
    if (done) break;
#pragma unroll
    for (int g = 0; g < NG; ++g) { const unsigned cand = prefix[g] | (1u << bit); int c = 0;
#pragma unroll
      for (int i = 0; i < NV; ++i) c += __builtin_popcountll(__ballot(u[g][i] >= cand));
      if (cge[g] != K && c >= K) { prefix[g] = cand; cge[g] = c; } }
  }
  const unsigned long long lm = (1ull << lane) - 1ull;
#pragma unroll
  for (int g = 0; g < NG; ++g) { int cgt = 0;
#pragma unroll
    for (int i = 0; i < NV; ++i) cgt += __builtin_popcountll(__ballot(u[g][i] > prefix[g]));
    int need = K - cgt;
#pragma unroll
    for (int i = 0; i < NV; ++i) { const unsigned long long eq = __ballot(u[g][i] == prefix[g]); const int before = __builtin_popcountll(eq & lm);
      sel[g][i] = (u[g][i] > prefix[g]) || (u[g][i] == prefix[g] && before < need); const int ne = __builtin_popcountll(eq); need = need > ne ? need - ne : 0; } }
}
__device__ __forceinline__ float gelu_erf(float v) {
  const float av = fabsf(v), t = __builtin_amdgcn_rcpf(1.0f + 0.2316418882f * av);
  float q = t * 0.5307027145f - 0.7265760135f; q = q * t + 0.7107068705f; q = q * t - 0.142248368f; q = q * t + 0.127414796f; q = q * t;
  const float tail = q * __builtin_amdgcn_exp2f(v * v * -0.72134752044f);
  return v < 0.f ? v * tail : v - v * tail;
}

#ifndef ROUTE_REPS
#define ROUTE_REPS 1
#endif
__device__ __forceinline__ void ins16(float (&t)[16], float x) {
#pragma unroll
  for (int i = 15; i >= 1; --i) t[i] = __builtin_amdgcn_fmed3f(t[i - 1], t[i], x);
  t[0] = fmaxf(t[0], x);
}
__device__ __forceinline__ void p6_peer(const Frame& F, const Args& a, float* dst_base) {
  const float* S2 = (const float*)(F.ws + WS_S); const float* SSQ = (const float*)(F.ws + WS_SSQ); const bf16* H1b = (const bf16*)(F.ws + WS_H1B);
  int lane = F.lane, wv = F.wave, tid = F.tid; asm volatile("" : "+v"(lane), "+s"(wv), "+v"(tid));
  LAS unsigned short* EID = (LAS unsigned short*)F.lds; LAS float* EGT = (LAS float*)(F.lds + 8192);
  LAS int* eid = (LAS int*)(F.lds + 24576 + wv * 1536); LAS float* egt = (LAS float*)(eid + 128); LAS float* esu = (LAS float*)(eid + 256);
  LAS unsigned char* RB = F.lds + 36864 + wv * 14336;
  LAS float* L1 = (LAS float*)(F.lds + 36864);
  for (int tb = blockIdx.x; tb < MROWS / 32; tb += gridDim.x) {
    __syncthreads();
    {
      const int g = tid >> 5, tl = tid & 31; const float* src = S2 + ((size_t)(tb * 16 + g) * 128) * 32 + tl;
      float t[16];
#pragma unroll
      for (int i = 0; i < 16; ++i) t[i] = -INFINITY;
#pragma unroll 8
      for (int k = 0; k < 128; ++k) { const float x = src[k * 32]; ins16(t, __builtin_bit_cast(float, (__builtin_bit_cast(unsigned, x) & ~0x7Fu) | (unsigned)(127 - k))); }
#pragma unroll
      for (int i = 0; i < 16; ++i) L1[(g * 16 + i) * 32 + tl] = t[i];
    }
    __syncthreads();
    if (tid < 256) {
      const int h8 = tid >> 5, tl = tid & 31; const LAS float* LA = L1 + ((2 * h8) * 16) * 32 + tl; const LAS float* LB = L1 + ((2 * h8 + 1) * 16) * 32 + tl;
      float A[16], B[16], t[16];
#pragma unroll
      for (int i = 0; i < 16; ++i) { A[i] = LA[i * 32]; B[i] = LB[i * 32]; t[i] = -INFINITY; }
#pragma unroll
      for (int i = 0; i < 16; ++i)
#pragma unroll
        for (int j = 0; j < 16; ++j) if ((i + 1) * (j + 1) <= 16) { const float c = A[i] + B[j];
            ins16(t, __builtin_bit_cast(float, (__builtin_bit_cast(unsigned, c) & ~0xFFu) | (unsigned)(255 - (i * 16 + j)))); }
      float ev[16], es = 0.f;
#pragma unroll
      for (int r = 0; r < 16; ++r) { ev[r] = __expf(t[r] - t[0]); es += ev[r]; }
      const float inv = 1.0f / es;
#pragma unroll
      for (int r = 0; r < 16; ++r) { const unsigned flat = 255u - (__builtin_bit_cast(unsigned, t[r]) & 0xFFu), ii = flat >> 4, jj = flat & 15u;
        const unsigned ka = 127u - (__builtin_bit_cast(unsigned, LA[ii * 32]) & 0x7Fu), kb = 127u - (__builtin_bit_cast(unsigned, LB[jj * 32]) & 0x7Fu);
        EID[tl * 128 + h8 * 16 + r] = (unsigned short)(ka * 128u + kb); EGT[tl * 128 + h8 * 16 + r] = ev[r] * inv; }
    }
    __syncthreads();
#pragma unroll 1
    for (int tt = 0; tt < 4; ++tt) {
    const int tl = wv * 4 + tt, tok = tb * 32 + tl;
    const float rs = rsqrtf(wave_sum_dpp(lane < 32 ? SSQ[(size_t)tok * 32 + lane] : 0.f) * (1.0f / DM) + EPS);
    { const float* SCL = (const float*)(F.ws + WS_SCL);
#pragma unroll
      for (int i = 0; i < 2; ++i) { const int e = lane + 64 * i, idq = EID[tl * 128 + e]; eid[e] = idq; esu[e] = SCL[idq]; egt[e] = EGT[tl * 128 + e] * SCL[16384 + idq]; } }
    unsigned xw[16];
    { const v4u* xp = (const v4u*)(H1b + (size_t)tok * DM + (size_t)lane * 32);
#pragma unroll
      for (int q = 0; q < 4; ++q) { const v4u x0 = xp[q]; xw[4 * q] = x0.x; xw[4 * q + 1] = x0.y; xw[4 * q + 2] = x0.z; xw[4 * q + 3] = x0.w; } }
    float y[32];
#pragma unroll
    for (int i = 0; i < 32; ++i) y[i] = 0.f;
    asm volatile("s_waitcnt vmcnt(0) lgkmcnt(0)" ::: "memory");
    const unsigned char* U8 = F.ws + WS_UB; const unsigned char* V8 = F.ws + WS_VB8;
#define PG_ISSUE(E) do { const int idq_ = __builtin_amdgcn_readfirstlane(eid[(E)]); LAS unsigned char* sl_ = RB + ((E) % 7) * 2048; \
      __builtin_amdgcn_global_load_lds((const unsigned*)(U8 + (size_t)idq_ * 1024 + lane * 16), (LAS unsigned*)sl_, 16, 0, 0); \
      __builtin_amdgcn_global_load_lds((const unsigned*)(V8 + (size_t)idq_ * 1024 + lane * 16), (LAS unsigned*)(sl_ + 1024), 16, 0, 0); } while (0)
#define PG_DOT(UW, DACC) do { float da_ = 0.f, db_ = 0.f; _Pragma("unroll") for (int dd = 0; dd < 4; ++dd) { const unsigned wa = UW[dd]; \
          da_ = __builtin_amdgcn_fdot2_f32_bf16(__builtin_bit_cast(bfv2, xw[4 * dd + 0]), __builtin_amdgcn_cvt_scalef32_pk_bf16_fp4(wa, 1.0f, 0), da_, false); \
          db_ = __builtin_amdgcn_fdot2_f32_bf16(__builtin_bit_cast(bfv2, xw[4 * dd + 1]), __builtin_amdgcn_cvt_scalef32_pk_bf16_fp4(wa, 1.0f, 1), db_, false); \
          da_ = __builtin_amdgcn_fdot2_f32_bf16(__builtin_bit_cast(bfv2, xw[4 * dd + 2]), __builtin_amdgcn_cvt_scalef32_pk_bf16_fp4(wa, 1.0f, 2), da_, false); \
          db_ = __builtin_amdgcn_fdot2_f32_bf16(__builtin_bit_cast(bfv2, xw[4 * dd + 3]), __builtin_amdgcn_cvt_scalef32_pk_bf16_fp4(wa, 1.0f, 3), db_, false); } DACC = da_ + db_; } while (0)
#define PG_AXPY(VW, CF) do { _Pragma("unroll") for (int dd = 0; dd < 4; ++dd) { const unsigned wa = VW[dd]; \
          { const f32x2v v2 = __builtin_amdgcn_cvt_scalef32_pk_f32_fp4(wa, 1.0f, 0); y[8 * dd + 0] += CF * v2.x; y[8 * dd + 1] += CF * v2.y; } \
          { const f32x2v v2 = __builtin_amdgcn_cvt_scalef32_pk_f32_fp4(wa, 1.0f, 1); y[8 * dd + 2] += CF * v2.x; y[8 * dd + 3] += CF * v2.y; } \
          { const f32x2v v2 = __builtin_amdgcn_cvt_scalef32_pk_f32_fp4(wa, 1.0f, 2); y[8 * dd + 4] += CF * v2.x; y[8 * dd + 5] += CF * v2.y; } \
          { const f32x2v v2 = __builtin_amdgcn_cvt_scalef32_pk_f32_fp4(wa, 1.0f, 3); y[8 * dd + 6] += CF * v2.x; y[8 * dd + 7] += CF * v2.y; } } } while (0)
#define PG_CONSUME(E) do { const LAS unsigned char* s0_ = RB + ((E) % 7) * 2048 + lane * 16; \
      const v4u u0 = *(const LAS v4u*)s0_, v0 = *(const LAS v4u*)(s0_ + 1024); \
      float d0 = 0.f; PG_DOT(u0, d0); d0 = wave_sum_dpp(d0); \
      const float c0 = gelu_erf(d0 * (rs * esu[(E)])) * egt[(E)]; \
      PG_AXPY(v0, c0); } while (0)
#pragma unroll
    for (int e = 0; e < 6; ++e) PG_ISSUE(e);
#pragma unroll 1
    for (int e = 0; e < 122; ++e) {
      PG_ISSUE(e + 6);
      asm volatile("s_waitcnt vmcnt(12)" ::: "memory");
      PG_CONSUME(e);
      asm volatile("" ::: "memory");
    }
    asm volatile("s_waitcnt vmcnt(0)" ::: "memory");
#pragma unroll 1
    for (int e = 122; e < 128; ++e) PG_CONSUME(e);
    asm volatile("s_waitcnt lgkmcnt(0)" ::: "memory");
#undef PG_ISSUE
#undef PG_DOT
#undef PG_AXPY
#undef PG_CONSUME
    float* drow = dst_base + (size_t)tok * DM;
#pragma unroll
    for (int q = 0; q < 8; ++q) { const size_t off = (size_t)lane * 32 + q * 4; f32x4 hv;
      hv.x = bflo(xw[2 * q]) + y[4 * q]; hv.y = bfhi(xw[2 * q]) + y[4 * q + 1]; hv.z = bflo(xw[2 * q + 1]) + y[4 * q + 2]; hv.w = bfhi(xw[2 * q + 1]) + y[4 * q + 3]; *(f32x4*)(drow + off) = hv; }
    }
  }
}
constexpr int MISC_LDS = LDS_BYTES - 256;
__global__ void __launch_bounds__(NTHR, 2) mk_fwd(Args args) {
  extern __shared__ __attribute__((aligned(16))) unsigned char lds_raw[];
  Frame F; F.lds = (LAS unsigned char*)lds_raw; F.ws = args.ws; F.tid = threadIdx.x; F.lane = F.tid & 63; F.wave = __builtin_amdgcn_readfirstlane(F.tid >> 6);
  const int lo = args.ph_lo, hi = args.ph_hi, G = (int)gridDim.x, bx = (int)blockIdx.x;
  volatile LAS unsigned* misc = (volatile LAS unsigned*)(F.lds + MISC_LDS);
  if (F.tid < 16) misc[F.tid] = 0u;
  __syncthreads();
  XcdBarrier bar = xcd_barrier_post((unsigned*)(F.ws + WS_CTL) + CW_BAR, misc);
#define IN(k) (lo <= (k) && (k) < hi)
#define SEAM(k) do { if (IN(k) && IN((k) + 1)) xcd_barrier(bar); } while (0)
#define PHASE_FRAME(Fp) Frame Fp = F; asm volatile("" : "+v"(Fp.tid), "+v"(Fp.lane))
  const int NA = G;
  if (IN(0)) { PHASE_FRAME(F0);
    p0_lam(F0, args);
    p0_zero_vpad(F0);
    p0_metaproj(F0, args);
    p0_rows(F0, args);
    p0_transpose(F0, args.in[IN_WIN], DPROJ, NPROJ, (bf16*)(F.ws + WS_W1T));
    p0_transpose(F0, args.in[IN_WOUT], DM, DM, (bf16*)(F.ws + WS_W2T));
    p0_w3t(F0, args);
    p0_tables(F0, args);
  }
  SEAM(0);
  if (IN(1)) { PHASE_FRAME(F1);
    p1_meta_finalize(F1, args);
    pg8::Gemm g{(const pg8::bf16_t*)(F.ws + WS_XN), (const pg8::bf16_t*)(F.ws + WS_W1T), MROWS, NPROJ, DM};
    pg8::StaticOrder S; S.init(MROWS, NPROJ, G, bx);
    EpiProj E{(bf16*)(F.ws + WS_Q), (bf16*)(F.ws + WS_KP), (bf16*)(F.ws + WS_VP), (bf16*)(F.ws + WS_MQ), (bf16*)(F.ws + WS_MK), (bf16*)(F.ws + WS_MV), (bf16*)(F.ws + WS_MO),
              args.in[IN_QNG], args.in[IN_KNG], (LAS float*)(F.lds + XCH_OFF)};
    pg8::gemm_phase<EpiProj, pg8::StaticOrder, true, true>(F.lds + RING_OFF, g, S, E);
  }
  SEAM(1);
  if (IN(2)) {
    att::phase(F, (G % 8 == 0) ? (bx & 7) * (G >> 3) + (bx >> 3) : bx, NA);
    for (int task = bx; task < 512; task += G) ml::taskA(F, args, task);
  }
  SEAM(2);
  if (IN(3)) { PHASE_FRAME(F3); ml::scanB(F3); }
  SEAM(3);
  if (IN(4)) {
    PHASE_FRAME(F4);
    for (int task = bx; task < 512; task += G) ml::taskC(F4, args, task);
    p3_combine(F4, args, NA);
  }
  SEAM(4);
  if (IN(5)) {
    pg8::Gemm g{(const pg8::bf16_t*)(F.ws + WS_A2), (const pg8::bf16_t*)(F.ws + WS_W2T), MROWS, DM, DM};
    pg8::StaticOrder S; S.init(MROWS, DM, G, bx);
    EpiRes E{args.in[IN_X], args.out, (bf16*)(F.ws + WS_H1B), (float*)(F.ws + WS_SSQ)};
    pg8::gemm_phase<EpiRes, pg8::StaticOrder, true, true>(F.lds + RING_OFF, g, S, E);
  }
  SEAM(5);
  if (IN(6)) {
    pg8::Gemm g{(const pg8::bf16_t*)(F.ws + WS_H1B), (const pg8::bf16_t*)(F.ws + WS_W3T), MROWS, DM, DM};
    pg8::StaticOrder S; S.init(MROWS, DM, G, bx);
    LAS float* rst = (LAS float*)(F.lds + XCH_OFF);
    { pg8::Unit u0; if (S.next(0, u0)) { if (F.tid < 256) { const float* sp = (const float*)(F.ws + WS_SSQ) + ((size_t)u0.pm * 256 + F.tid) * 32; float s = 0.f;
#pragma unroll
          for (int i = 0; i < 8; ++i) { const f32x4 v = ((const f32x4*)sp)[i]; s += (v.x + v.y) + (v.z + v.w); }
          rst[F.tid] = rsqrtf(s * (1.0f / DM) + EPS); } } }
    __syncthreads();
    EpiScore E{(float*)(F.ws + WS_S), rst};
    pg8::gemm_phase<EpiScore, pg8::StaticOrder, true, true>(F.lds + RING_OFF, g, S, E);
  }
  SEAM(6);
  if (IN(7)) { PHASE_FRAME(F7); p6_peer(F7, args, args.out); }
#undef IN
#undef SEAM
}
extern "C" void kernel_launch(void* const* d_in, const int* in_sizes, int n_in, void* d_out, int out_size, void* d_ws, size_t ws_size, hipStream_t stream) {
  static int grid = 0;
  if (grid == 0) {
    int dev = 0, cus = 0, per_cu = 0;
    if (hipGetDevice(&dev) != hipSuccess || hipDeviceGetAttribute(&cus, hipDeviceAttributeMultiprocessorCount, dev) != hipSuccess) { fprintf(stderr, "device query failed\n"); grid = -1; return; }
    if (hipFuncSetAttribute((const void*)mk_fwd, hipFuncAttributeMaxDynamicSharedMemorySize, LDS_BYTES) != hipSuccess) { fprintf(stderr, "hipFuncSetAttribute failed\n"); grid = -1; return; }
    if (hipOccupancyMaxActiveBlocksPerMultiprocessor(&per_cu, (const void*)mk_fwd, NTHR, LDS_BYTES) != hipSuccess || per_cu < 1) { fprintf(stderr, "occupancy query says %d workgroups per CU: not launching\n", per_cu); (void)hipGetLastError(); grid = -1; return; }
    (void)hipGetLastError();
    grid = cus;
    if (n_in != 22 || ws_size < (size_t)512 * MiB || out_size != MROWS * DM) { fprintf(stderr, "unexpected shapes: n_in %d out %d ws %zu\n", n_in, out_size, ws_size); grid = -1; return; }
  }
  if (grid < 0) return;
  unsigned char* ws = (unsigned char*)d_ws;
  if (hipMemsetAsync(ws + WS_CTL, 0, CTL_ZERO_BYTES, stream) != hipSuccess) { fprintf(stderr, "memset failed\n"); return; }
  Args a{};
  for (int i = 0; i < 22; ++i) a.in[i] = (const float*)d_in[i];
  a.out = (float*)d_out; a.ws = ws; a.na = 0; a.pad = 0;
  a.ph_lo = 0; a.ph_hi = 8;
  hipLaunchKernelGGL(mk_fwd, dim3(grid), dim3(NTHR), LDS_BYTES, stream, a);
}
```

```cpp
#include <hip/hip_runtime.h>
#include <cstdio>
#include <cstdint>
#include <math.h>
namespace pg8 {
#define PG8_LAS __attribute__((address_space(3)))
typedef unsigned short bf16_t;
typedef short bf16x8 __attribute__((ext_vector_type(8)));
typedef float f32x4 __attribute__((ext_vector_type(4)));
typedef unsigned u32x4 __attribute__((ext_vector_type(4)));
constexpr int BM = 256, BK = 64, HALF = 128, HTB = HALF * BK * 2  , STAGE_BYTES = 8 * HTB, NXCD = 8, WGM = 8;

__host__ __device__ __forceinline__ int lds_byte(int r, int c) { const int st = (r >> 4) * 2 + (c >> 5), rr = r & 15, cc = c & 31, ob = rr * 64 + cc * 2; return st * 1024 + (ob ^ (((ob >> 9) & 1) << 5)); }
__host__ __device__ __forceinline__ void stage_rc(int b, int& R, int& C) { const int st = b / 1024, sb = b % 1024, swz = sb ^ (((sb >> 9) & 1) << 5); R = (st >> 1) * 16 + swz / 64; C = (st & 1) * 32 + (swz % 64) / 2; }
__host__ __device__ __forceinline__ int perm32(int rho) { const int n = rho >> 4, i = rho & 15; return 8 * (i >> 2) + 4 * n + (i & 3); }

struct Unit { int pm, pn; };
struct Gemm { const bf16_t* A; const bf16_t* Bt; int M, N, K; };

struct StaticOrder {
    int nM, nN, nwg, G, c;
    __host__ __device__ void init(int M, int N, int G_, int c_) { nM = M / BM; nN = N / BM; nwg = nM * nN; G = G_; c = c_; }
    __host__ __device__ bool next(int i, Unit& u) const {
        const long L = (long)i * G + c; if (L >= nwg) return false;
        int wgid = (int)L; { const int q = nwg / NXCD, r = nwg % NXCD, xcd = wgid % NXCD, off = wgid / NXCD; wgid = (xcd < r ? xcd * (q + 1) : r * (q + 1) + (xcd - r) * q) + off; }
        const int nig = WGM * nN, gid = wgid / nig, fm = gid * WGM, gsz = (nM - fm) < WGM ? (nM - fm) : WGM;
        u.pm = fm + ((wgid % nig) % gsz); u.pn = (wgid % nig) / gsz; return true;
    }
    __device__ __forceinline__ void a_ready(const Unit&) const {}
    __device__ __forceinline__ void done(const Unit&) const {}
};

__device__ __forceinline__ unsigned cvt_pk_bf16(float lo, float hi) { unsigned r; asm volatile("v_cvt_pk_bf16_f32 %0, %1, %2" : "=v"(r) : "v"(lo), "v"(hi)); return r; }
typedef float f32x2 __attribute__((ext_vector_type(2)));
template <class Epi, class Sched, bool ALIGN_EPI = false, bool SP2 = false>
__device__ __forceinline__ void gemm_phase(PG8_LAS unsigned char* lds, const Gemm g, const Sched& S, const Epi& E) {
    int tid_ = threadIdx.x; asm volatile("" : "+v"(tid_));
    const int tid = tid_, wid = __builtin_amdgcn_readfirstlane(tid >> 6), lane = tid & 63, wr = wid >> 2, wc = wid & 3, fr = lane & 15, fq = lane >> 4;
    const int K = g.K, nt = K / BK;
    unsigned voffA[2], voffB[2];
#pragma unroll
    for (int i = 0; i < 2; ++i) { int R, C; stage_rc(tid * 16 + i * 8192, R, C); const int Rb = Epi::PERM ? ((R & ~31) + perm32(R & 31)) : R;
        voffA[i] = (unsigned)(R * K + C) * 2u; voffB[i] = (unsigned)(Rb * K + C) * 2u; }
    const size_t kstep = (size_t)(BK * 2);
    const size_t hstep = (size_t)HALF * K * 2;
    const size_t tstep = 2 * hstep;
    const unsigned ldsw = (unsigned)wid * 1024u;
    const int aoff = lds_byte(wr * 64 + fr, fq * 8), boff = lds_byte(wc * 32 + fr, fq * 8);
#define PG8_SA(b, h) (((b) * 2 + (h)) * HTB)
#define PG8_SB(b, h) ((4 + (b) * 2 + (h)) * HTB)
#define PG8_STAGE(bufoff, gbase, voff) do { _Pragma("unroll") for (int _i = 0; _i < 2; ++_i) \
        __builtin_amdgcn_global_load_lds((const unsigned*)((const char*)(gbase) + (voff)[_i]), (PG8_LAS unsigned*)(lds + (bufoff) + ldsw + _i * 8192), 16, 0, 0); } while (0)
#define PG8_LDA(dst, b, h) do { _Pragma("unroll") for (int m = 0; m < 4; ++m) _Pragma("unroll") for (int k = 0; k < 2; ++k) dst[m][k] = *(const PG8_LAS bf16x8*)(lds + PG8_SA(b, h) + aoff + m * 2048 + k * 1024); } while (0)
#define PG8_LDB(dst, b, h) do { _Pragma("unroll") for (int n = 0; n < 2; ++n) _Pragma("unroll") for (int k = 0; k < 2; ++k) dst[n][k] = *(const PG8_LAS bf16x8*)(lds + PG8_SB(b, h) + boff + n * 2048 + k * 1024); } while (0)
#define PG8_MMA(ai, bj, At, Bt) do { __builtin_amdgcn_s_setprio(1); _Pragma("unroll") for (int m = 0; m < 4; ++m) _Pragma("unroll") for (int n = 0; n < 2; ++n) _Pragma("unroll") for (int k = 0; k < 2; ++k) \
        acc[ai][bj][m][n] = __builtin_amdgcn_mfma_f32_16x16x32_bf16(Bt[n][k], At[m][k], acc[ai][bj][m][n], 0, 0, 0); __builtin_amdgcn_s_setprio(0); } while (0)
#define PG8_WAIT_V(n) asm volatile("s_waitcnt vmcnt(" #n ")" ::: "memory")
#define PG8_WAIT_L(n) asm volatile("s_waitcnt lgkmcnt(" #n ")" ::: "memory")
#define PG8_BAR __builtin_amdgcn_s_barrier()
#define PG8_SCHED __builtin_amdgcn_sched_barrier(0)
    Unit cur, nxt; int ui = 0;
    if (!S.next(0, cur)) return;
    f32x4 acc[2][2][4][2];
#pragma unroll
    for (int a = 0; a < 2; ++a)
#pragma unroll
        for (int b = 0; b < 2; ++b)
#pragma unroll
            for (int m = 0; m < 4; ++m)
#pragma unroll
                for (int n = 0; n < 2; ++n) acc[a][b][m][n] = (f32x4){0.f, 0.f, 0.f, 0.f};
    bf16x8 At[4][2], B0[2][2], B1[2][2];
    const char* cA = (const char*)g.A + (size_t)cur.pm * tstep; const char* cB = (const char*)g.Bt + (size_t)cur.pn * tstep;
    S.a_ready(cur);
    if constexpr (SP2) {
        PG8_STAGE(PG8_SB(0, 0), cB, voffB); PG8_STAGE(PG8_SB(0, 1), cB + hstep, voffB); PG8_STAGE(PG8_SA(0, 0), cA, voffA); PG8_STAGE(PG8_SA(0, 1), cA + hstep, voffA);
        if (wr == 1) PG8_BAR;
        PG8_WAIT_V(2); PG8_BAR;
        PG8_STAGE(PG8_SB(1, 0), cB + kstep, voffB); PG8_STAGE(PG8_SA(1, 0), cA + kstep, voffA); PG8_STAGE(PG8_SB(1, 1), cB + hstep + kstep, voffB);
        PG8_WAIT_V(6); PG8_BAR;
    } else {
        PG8_STAGE(PG8_SB(0, 0), cB, voffB); PG8_STAGE(PG8_SA(0, 0), cA, voffA); PG8_STAGE(PG8_SB(0, 1), cB + hstep, voffB); PG8_STAGE(PG8_SA(0, 1), cA + hstep, voffA);
        if (wr == 1) PG8_BAR;
        PG8_WAIT_V(4); PG8_BAR;
        PG8_STAGE(PG8_SB(1, 0), cB + kstep, voffB); PG8_STAGE(PG8_SA(1, 0), cA + kstep, voffA); PG8_STAGE(PG8_SB(1, 1), cB + hstep + kstep, voffB);
        PG8_WAIT_V(6); PG8_BAR;
    }
    for (;;) {
        const bool has_next = S.next(ui + 1, nxt);
        const char* nA = has_next ? (const char*)g.A + (size_t)nxt.pm * tstep : cA; const char* nB = has_next ? (const char*)g.Bt + (size_t)nxt.pn * tstep : cB;
        for (int t = 0; t < nt; t += 2) {
            const bool last = (t == nt - 2);
            const char* a1 = cA + (size_t)(t + 1) * kstep;
            const char* a2 = last ? nA : cA + (size_t)(t + 2) * kstep; const char* b2 = last ? nB : cB + (size_t)(t + 2) * kstep;
            const char* a3 = a2 + kstep; const char* b3 = b2 + kstep;
            if (last && has_next) S.a_ready(nxt);
            if constexpr (SP2) {
            PG8_LDB(B0, 0, 0); PG8_LDB(B1, 0, 1); PG8_SCHED; PG8_LDA(At, 0, 0); PG8_STAGE(PG8_SA(1, 1), a1 + hstep, voffA);
            PG8_WAIT_V(8); PG8_WAIT_L(0); PG8_BAR; PG8_MMA(0, 0, At, B0); PG8_MMA(0, 1, At, B1); PG8_BAR; PG8_SCHED;
            PG8_LDA(At, 0, 1); PG8_STAGE(PG8_SB(0, 0), b2, voffB); PG8_STAGE(PG8_SB(0, 1), b2 + hstep, voffB); PG8_STAGE(PG8_SA(0, 0), a2, voffA);
            PG8_WAIT_V(8); PG8_WAIT_L(0); PG8_BAR; PG8_MMA(1, 0, At, B0); PG8_MMA(1, 1, At, B1); PG8_BAR; PG8_SCHED;
            PG8_LDB(B0, 1, 0); PG8_LDB(B1, 1, 1); PG8_SCHED; PG8_LDA(At, 1, 0); PG8_STAGE(PG8_SA(0, 1), a2 + hstep, voffA);
            PG8_WAIT_V(8); PG8_WAIT_L(0); PG8_BAR; PG8_MMA(0, 0, At, B0); PG8_MMA(0, 1, At, B1); PG8_BAR; PG8_SCHED;
            PG8_LDA(At, 1, 1); PG8_STAGE(PG8_SB(1, 0), b3, voffB); PG8_STAGE(PG8_SB(1, 1), b3 + hstep, voffB); PG8_STAGE(PG8_SA(1, 0), a3, voffA);
            PG8_WAIT_V(8); PG8_WAIT_L(0); PG8_BAR; PG8_MMA(1, 0, At, B0); PG8_MMA(1, 1, At, B1); PG8_BAR; PG8_SCHED;
            } else {
            PG8_LDB(B0, 0, 0); PG8_SCHED; PG8_LDA(At, 0, 0); PG8_STAGE(PG8_SA(1, 1), a1 + hstep, voffA);
            PG8_WAIT_L(8); PG8_BAR; PG8_WAIT_L(0); PG8_MMA(0, 0, At, B0); PG8_BAR; PG8_SCHED;
            PG8_LDB(B1, 0, 1); PG8_STAGE(PG8_SB(0, 0), b2, voffB);
            PG8_BAR; PG8_WAIT_L(0); PG8_MMA(0, 1, At, B1); PG8_BAR;
            PG8_LDA(At, 0, 1); PG8_STAGE(PG8_SA(0, 0), a2, voffA);
            PG8_BAR; PG8_WAIT_L(0); PG8_MMA(1, 0, At, B0); PG8_BAR; PG8_SCHED;
            PG8_STAGE(PG8_SB(0, 1), b2 + hstep, voffB);
            PG8_WAIT_V(6); PG8_BAR; PG8_MMA(1, 1, At, B1); PG8_BAR;
            PG8_LDB(B0, 1, 0); PG8_SCHED; PG8_LDA(At, 1, 0); PG8_STAGE(PG8_SA(0, 1), a2 + hstep, voffA);
            PG8_WAIT_L(8); PG8_BAR; PG8_WAIT_L(0); PG8_MMA(0, 0, At, B0); PG8_BAR; PG8_SCHED;
            PG8_LDB(B1, 1, 1); PG8_STAGE(PG8_SB(1, 0), b3, voffB);
            PG8_BAR; PG8_WAIT_L(0); PG8_MMA(0, 1, At, B1); PG8_BAR;
            PG8_LDA(At, 1, 1); PG8_STAGE(PG8_SA(1, 0), a3, voffA);
            PG8_BAR; PG8_WAIT_L(0); PG8_MMA(1, 0, At, B0); PG8_BAR; PG8_SCHED;
            PG8_STAGE(PG8_SB(1, 1), b3 + hstep, voffB);
            PG8_WAIT_V(6); PG8_BAR; PG8_MMA(1, 1, At, B1); PG8_BAR;
            }
        }
        if constexpr (ALIGN_EPI) { if (wr == 0) PG8_BAR; }
        if constexpr (!Epi::AFTER_DRAIN) { E(acc, cur, wr, wc, fr, fq); S.done(cur); }
        if (!has_next) break;
#pragma unroll
        for (int a = 0; a < 2; ++a)
#pragma unroll
            for (int b = 0; b < 2; ++b)
#pragma unroll
                for (int m = 0; m < 4; ++m)
#pragma unroll
                    for (int n = 0; n < 2; ++n) acc[a][b][m][n] = (f32x4){0.f, 0.f, 0.f, 0.f};
        cur = nxt; cA = nA; cB = nB; ++ui;
        if constexpr (ALIGN_EPI) { if (wr == 1) PG8_BAR; }
    }
    PG8_WAIT_V(0);
    if constexpr (!ALIGN_EPI) { if (wr == 0) PG8_BAR; }
    PG8_BAR;
    if constexpr (Epi::AFTER_DRAIN) { E.fused(acc, cur, wr, wc, fr, fq, lds, wid, lane); S.done(cur); }
#undef PG8_SA
#undef PG8_SB
#undef PG8_STAGE
#undef PG8_LDA
#undef PG8_LDB
#undef PG8_MMA
#undef PG8_WAIT_V
#undef PG8_WAIT_L
#undef PG8_BAR
#undef PG8_SCHED
}
}
#define GAS __attribute__((address_space(1)))
#define LAS __attribute__((address_space(3)))
typedef unsigned short bf16;
typedef unsigned v4u __attribute__((ext_vector_type(4)));
typedef unsigned v2u __attribute__((ext_vector_type(2)));
typedef float f32x4 __attribute__((ext_vector_type(4)));
typedef short bf16x8 __attribute__((ext_vector_type(8)));
#define LDS_WAIT() asm volatile("s_waitcnt lgkmcnt(0)" ::: "memory")
#define VM_WAIT() asm volatile("s_waitcnt vmcnt(0)" ::: "memory")

constexpr int DM = 2048, NB = 4, SEQ = 2048, NMETA = 16, MROWS = NB * SEQ, DPROJ = 6152, NPROJ = 6144;
constexpr int PADT = 2112, POS0 = 64, MPOS0 = 48;
constexpr float EPS = 1e-6f;
constexpr float LOG2E = 1.4426950408889634f;
constexpr float QSCALE = 0.08838834764831845f * LOG2E;
constexpr int NWAVES = 8, NTHR = 512;

constexpr size_t MiB = 1u << 20;
constexpr size_t WS_CTL = 0, CTL_ZERO_BYTES = 1 * MiB;
constexpr size_t WS_PM = 484 * MiB;
constexpr size_t WS_W1T = 2 * MiB, WS_W2T = 26 * MiB, WS_W3T = 34 * MiB, WS_XN = 42 * MiB;
constexpr size_t WS_Q = 74 * MiB, WS_KP = 90 * MiB, WS_VP = 107 * MiB, WS_MQ = 124 * MiB, WS_MK = 133 * MiB, WS_MV = 142 * MiB, WS_MO = 159 * MiB;
constexpr size_t WS_SMALL = 175 * MiB;
constexpr size_t WS_XM = WS_SMALL, WS_LI = WS_SMALL + 128 * 1024, WS_LF = WS_SMALL + 384 * 1024, WS_LAM = WS_SMALL + 640 * 1024;
constexpr size_t WS_PO = 176 * MiB, WS_ML = 304 * MiB, WS_HM = 305 * MiB, WS_A2 = 42 * MiB, WS_H1B = 74 * MiB, WS_SSQ = 106 * MiB, WS_S = 176 * MiB, WS_UB = 384 * MiB, WS_VB = 448 * MiB;
constexpr size_t WS_SCL = WS_SMALL + 704 * 1024;
constexpr size_t WS_VB8 = WS_UB + 32 * MiB;
constexpr size_t WS_DC = 305 * MiB, WS_CS = 448 * MiB, WS_DN = 482 * MiB, WS_NS = WS_DN + 512 * 1024, WS_GS = WS_DN + 1024 * 1024, WS_MS = WS_DN + 1152 * 1024;
constexpr int CW_BAR = 4096;

constexpr int RING_OFF = 0, RING_BYTES = 131072;
constexpr int XCH_OFF = 131072;
constexpr int MISC_OFF = XCH_OFF + 8192;
constexpr int LDS_BYTES = 155648;

__device__ __forceinline__ unsigned f2bf(float f) { unsigned u = __builtin_bit_cast(unsigned, f); return (u + 0x7fffu + ((u >> 16) & 1u)) >> 16; }
__device__ __forceinline__ unsigned pk2(float lo, float hi) { return f2bf(lo) | (f2bf(hi) << 16); }
__device__ __forceinline__ float bf2f(unsigned short u) { return __builtin_bit_cast(float, (unsigned)u << 16); }
__device__ __forceinline__ float bflo(unsigned w) { return __builtin_bit_cast(float, w << 16); }
__device__ __forceinline__ float bfhi(unsigned w) { return __builtin_bit_cast(float, w & 0xffff0000u); }
__device__ __forceinline__ float wave_sum(float v) {
#pragma unroll
  for (int o = 1; o < 64; o <<= 1) v += __shfl_xor(v, o);
  return v;
}
__device__ __forceinline__ size_t kp_off(int bhm, int pos, int d) { const int j = pos >> 6, row = pos & 63, d0 = d >> 4, hi = (d >> 3) & 1;
  return ((size_t)(bhm * 33 + j) * 8 + d0) * 1024 + (size_t)((((row << 1) | hi) ^ ((row >> 3) & 1)) << 3) + (d & 7); }
__device__ __forceinline__ float wave_sum_dpp(float v) {
  v += __builtin_bit_cast(float, __builtin_amdgcn_update_dpp(0, __builtin_bit_cast(int, v), 0xB1, 0xF, 0xF, true));
  v += __builtin_bit_cast(float, __builtin_amdgcn_update_dpp(0, __builtin_bit_cast(int, v), 0x4E, 0xF, 0xF, true));
  v += __builtin_bit_cast(float, __builtin_amdgcn_update_dpp(0, __builtin_bit_cast(int, v), 0x141, 0xF, 0xF, true));
  v += __builtin_bit_cast(float, __builtin_amdgcn_update_dpp(0, __builtin_bit_cast(int, v), 0x140, 0xF, 0xF, true));
  const float r0 = __builtin_bit_cast(float, __builtin_amdgcn_readlane(__builtin_bit_cast(int, v), 0)), r1 = __builtin_bit_cast(float, __builtin_amdgcn_readlane(__builtin_bit_cast(int, v), 16));
  const float r2 = __builtin_bit_cast(float, __builtin_amdgcn_readlane(__builtin_bit_cast(int, v), 32)), r3 = __builtin_bit_cast(float, __builtin_amdgcn_readlane(__builtin_bit_cast(int, v), 48));
  return (r0 + r1) + (r2 + r3);
}
__device__ __forceinline__ float sigmoidf_(float x) { return 1.0f / (1.0f + __expf(-x)); }
#define XB_TMO      128
#define XB_XCNT(j)  (256  + 64 * (j))
#define XB_XSUB(j)  (1280 + 64 * (j))
#define XB_XGEN(j)  (2304 + 64 * (j))
#define XB_TOP      3328
#define XB_TOPGEN   3392
#define XCD_BAR_WORDS 3456
#define XB_SPIN_CAP (1u << 18)

__device__ __forceinline__ unsigned xb_ld(unsigned* p)              { return __hip_atomic_load(p, __ATOMIC_RELAXED, __HIP_MEMORY_SCOPE_AGENT); }
__device__ __forceinline__ unsigned xb_add(unsigned* p, unsigned v) { return __hip_atomic_fetch_add(p, v, __ATOMIC_RELAXED, __HIP_MEMORY_SCOPE_AGENT); }
__device__ __forceinline__ unsigned xb_xcc_id() { return (unsigned)__builtin_amdgcn_s_getreg((3 << 11) | 20) & 0xFu; }
#define XB_SPIN(cond, bar) do { unsigned _sp = 0; while (cond) { __builtin_amdgcn_s_sleep(1); \
    if ((++_sp & 255u) == 0u) { if (xb_ld(&(bar)[XB_TMO])) break; if (_sp > XB_SPIN_CAP) { atomicAdd(&(bar)[XB_TMO], 1u); break; } } } } while (0)

struct XcdBarrier {
    unsigned* bar; unsigned x;
    volatile LAS unsigned* st;
};

__device__ __forceinline__ XcdBarrier xcd_barrier_post(unsigned* bar, volatile LAS unsigned* st) {
    XcdBarrier b; b.bar = bar; b.x = xb_xcc_id(); b.st = st;
    if (threadIdx.x == 0) (void)xb_add(&bar[XB_XCNT(b.x)], 1u);
    return b;
}
__device__ __forceinline__ void xcd_barrier_complete(unsigned* bar, unsigned x, unsigned& nloc, unsigned& nx) {
    const unsigned G = gridDim.x * gridDim.y * gridDim.z;
    unsigned sum, cnt, mine, sp = 0u;
    for (;;) {
        sum = 0u; cnt = 0u; mine = 0u;
#pragma unroll
        for (unsigned j = 0; j < 16; ++j) { const unsigned c = xb_ld(&bar[XB_XCNT(j)]); sum += c; cnt += (c > 0u) ? 1u : 0u; mine = (j == x) ? c : mine; }
        if (sum == G) break;
        __builtin_amdgcn_s_sleep(1);
        if ((++sp & 255u) == 0u) { if (xb_ld(&bar[XB_TMO])) break; if (sp > XB_SPIN_CAP) { atomicAdd(&bar[XB_TMO], 1u); break; } }
    }
    nloc = mine > 0u ? mine : 1u; nx = cnt > 0u ? cnt : 1u;
}

__device__ __forceinline__ void xcd_barrier(const XcdBarrier& b) {
    asm volatile("s_waitcnt vmcnt(0)" ::: "memory");
    __syncthreads();
    if (threadIdx.x == 0) {
        unsigned* bar = b.bar;
        __builtin_amdgcn_s_waitcnt(0);
        unsigned nloc = b.st[0], nx = b.st[1];
        if (nloc == 0u) { xcd_barrier_complete(bar, b.x, nloc, nx); b.st[0] = nloc; b.st[1] = nx; }
        const unsigned old = xb_add(&bar[XB_XSUB(b.x)], 1u);
        const unsigned gen = old / nloc;
        if (old + 1u == (gen + 1u) * nloc) {
            __builtin_amdgcn_fence(__ATOMIC_RELEASE, "agent");
            asm volatile("s_waitcnt vmcnt(0)" ::: "memory");
            const unsigned og = xb_add(&bar[XB_TOP], 1u);
            const unsigned tg = og / nx;
            if (og + 1u == (tg + 1u) * nx) xb_add(&bar[XB_TOPGEN], 1u);
            else XB_SPIN(xb_ld(&bar[XB_TOPGEN]) == tg, bar);
            __builtin_amdgcn_fence(__ATOMIC_ACQUIRE, "agent");
            xb_add(&bar[XB_XGEN(b.x)], 1u);
            asm volatile("s_waitcnt vmcnt(0)" ::: "memory");
        } else {
            XB_SPIN(xb_ld(&bar[XB_XGEN(b.x)]) == gen, bar);
            __builtin_amdgcn_fence(__ATOMIC_ACQUIRE, "agent");
            asm volatile("s_waitcnt vmcnt(0)" ::: "memory");
        }
    }
    __syncthreads();
}

struct Args { const float* in[22]; float* out; unsigned char* ws; int ph_lo, ph_hi, na, pad; };
struct Frame {
  LAS unsigned char* lds; unsigned char* ws; int tid, lane, wave; const float* const* in;
};
#define IN_X 0
#define IN_META 1
#define IN_G1 2
#define IN_WIN 3
#define IN_CW 4
#define IN_CB 5
#define IN_IGB 6
#define IN_FGB 7
#define IN_LQ1 8
#define IN_LK1 9
#define IN_LQ2 10
#define IN_LK2 11
#define IN_QNG 12
#define IN_KNG 13
#define IN_SUBG 14
#define IN_OUTG 15
#define IN_WOUT 16
#define IN_G2 17
#define IN_WQ 18
#define IN_SUBK 19
#define IN_U 20
#define IN_V 21

__device__ __forceinline__ void p0_rows(const Frame& F, const Args& a) {
  const float* x = a.in[IN_X]; const float* meta = a.in[IN_META]; const float* g1 = a.in[IN_G1]; const float* w_in = a.in[IN_WIN];
  const float* igb = a.in[IN_IGB]; const float* fgb = a.in[IN_FGB];
  bf16* Xn = (bf16*)(F.ws + WS_XN); bf16* Xm = (bf16*)(F.ws + WS_XM); float* LI = (float*)(F.ws + WS_LI); float* LF = (float*)(F.ws + WS_LF);
  LAS f32x4* wgl = (LAS f32x4*)(F.lds);
  for (int e = F.tid; e < 4096; e += NTHR) {
    const int ln = e & 63, q = e >> 6, half = q & 1, j = (q >> 1) & 3, i = q >> 3;
    const int k = 4 * (i * 64 + ln) + j;
    wgl[e] = *(const f32x4*)(w_in + (size_t)k * DPROJ + NPROJ + 4 * half);
  }
  __syncthreads();
  const int gw = blockIdx.x * NWAVES + F.wave, NGW = gridDim.x * NWAVES, lane = F.lane;
  for (int task = gw; task < MROWS / 2 + NMETA / 2; task += NGW) {
    const bool ismeta = task >= MROWS / 2;
    const int r0 = ismeta ? (task - MROWS / 2) * 2 : task * 2;
    const float* src0 = (ismeta ? meta : x) + (size_t)r0 * DM;
    f32x4 xv[2][8]; float rs[2];
    { float s0 = 0.f, s1 = 0.f;
#pragma unroll
      for (int i = 0; i < 8; ++i) { xv[0][i] = ((const f32x4*)src0)[i * 64 + lane]; xv[1][i] = ((const f32x4*)(src0 + DM))[i * 64 + lane]; }
#pragma unroll
      for (int i = 0; i < 8; ++i) { const f32x4 a0 = xv[0][i], a1 = xv[1][i];
        s0 += (a0.x * a0.x + a0.y * a0.y) + (a0.z * a0.z + a0.w * a0.w); s1 += (a1.x * a1.x + a1.y * a1.y) + (a1.z * a1.z + a1.w * a1.w); }
      rs[0] = rsqrtf(wave_sum_dpp(s0) * (1.0f / DM) + EPS); rs[1] = rsqrtf(wave_sum_dpp(s1) * (1.0f / DM) + EPS); }
    float ga[2][8];
#pragma unroll
    for (int rr = 0; rr < 2; ++rr)
#pragma unroll
      for (int g = 0; g < 8; ++g) ga[rr][g] = 0.f;
    bf16* dst0 = (ismeta ? Xm : Xn) + (size_t)r0 * DM;
#pragma unroll
    for (int i = 0; i < 8; ++i) {
      const f32x4 g = ((const f32x4*)g1)[i * 64 + lane];
      f32x4 xn[2];
#pragma unroll
      for (int rr = 0; rr < 2; ++rr) { xn[rr] = xv[rr][i] * g * rs[rr];
        v2u o; o.x = pk2(xn[rr].x, xn[rr].y); o.y = pk2(xn[rr].z, xn[rr].w); ((v2u*)(dst0 + (size_t)rr * DM))[i * 64 + lane] = o; }
#pragma unroll
      for (int j = 0; j < 4; ++j) {
        const f32x4 w0 = wgl[((i * 4 + j) * 2 + 0) * 64 + lane], w1 = wgl[((i * 4 + j) * 2 + 1) * 64 + lane];
#pragma unroll
        for (int rr = 0; rr < 2; ++rr) { const float xs_ = xn[rr][j];
          ga[rr][0] += xs_ * w0.x; ga[rr][1] += xs_ * w0.y; ga[rr][2] += xs_ * w0.z; ga[rr][3] += xs_ * w0.w;
          ga[rr][4] += xs_ * w1.x; ga[rr][5] += xs_ * w1.y; ga[rr][6] += xs_ * w1.z; ga[rr][7] += xs_ * w1.w; }
      }
      __builtin_amdgcn_sched_barrier(0);
    }
#pragma unroll
    for (int rr = 0; rr < 2; ++rr)
#pragma unroll
      for (int g = 0; g < 8; ++g) ga[rr][g] = wave_sum_dpp(ga[rr][g]);
    if (lane < 8) {
      const int rr = lane >> 2, h = lane & 3;
      float gi = 0.f, gf = 0.f;
#pragma unroll
      for (int q = 0; q < 2; ++q)
#pragma unroll
        for (int hh = 0; hh < 4; ++hh) if (q == rr && hh == h) { gi = ga[q][hh]; gf = ga[q][4 + hh]; }
      const float li = gi + igb[h]; const float fx = gf + fgb[h];
      const float lf = fminf(fx, 0.f) - log1pf(__expf(-fabsf(fx)));
      const int R = r0 + rr;
      if (!ismeta) { const int b = R >> 11, t = R & 2047; LI[(b * 4 + h) * PADT + POS0 + t] = li; LF[(b * 4 + h) * PADT + POS0 + t] = lf; }
      else { for (int b = 0; b < NB; ++b) { LI[(b * 4 + h) * PADT + MPOS0 + R] = li; LF[(b * 4 + h) * PADT + MPOS0 + R] = lf; } }
    }
  }
  __syncthreads();
}
__device__ __forceinline__ void p0_metaproj(const Frame& F, const Args& a) {
  const float* meta = a.in[IN_META]; const float* g1 = a.in[IN_G1]; const float* w_in = a.in[IN_WIN];
  float* PM = (float*)(F.ws + WS_PM);
  LAS float* xs = (LAS float*)(F.lds);
  LAS float* part = (LAS float*)(F.lds + 16384);
  const int q = F.tid >> 7, c = F.tid & 127;
  for (int task = blockIdx.x; task < (NPROJ / 128) * 4; task += gridDim.x) {
    const int nb = task >> 2, kp = task & 3, n = nb * 128 + c;
    float acc[16];
#pragma unroll
    for (int m = 0; m < 16; ++m) acc[m] = 0.f;
#pragma unroll 1
    for (int kb = 0; kb < 2; ++kb) {
      __syncthreads();
#pragma unroll
      for (int i = 0; i < 8; ++i) { const int idx = F.tid + NTHR * i, qq = idx >> 10, kk = (idx >> 4) & 63, m = idx & 15; const int k = 512 * kp + 128 * qq + 64 * kb + kk;
        xs[idx] = meta[(size_t)m * DM + k] * g1[k]; }
      __syncthreads();
#pragma unroll 8
      for (int kk = 0; kk < 64; ++kk) {
        const float w = w_in[(size_t)(512 * kp + 128 * q + 64 * kb + kk) * DPROJ + n];
        const LAS f32x4* xp = (const LAS f32x4*)(xs + (q * 64 + kk) * 16);
#pragma unroll
        for (int t = 0; t < 4; ++t) { const f32x4 xv = xp[t]; acc[4 * t + 0] += xv.x * w; acc[4 * t + 1] += xv.y * w; acc[4 * t + 2] += xv.z * w; acc[4 * t + 3] += xv.w * w; }
      }
    }
#pragma unroll
    for (int m = 0; m < 16; ++m) part[(q * 16 + m) * 128 + c] = acc[m];
    __syncthreads();
    for (int e = F.tid; e < 16 * 128; e += NTHR) { const int m = e >> 7, cc = e & 127;
      PM[((size_t)kp * 16 + m) * NPROJ + nb * 128 + cc] = (part[(0 * 16 + m) * 128 + cc] + part[(1 * 16 + m) * 128 + cc]) + (part[(2 * 16 + m) * 128 + cc] + part[(3 * 16 + m) * 128 + cc]); }
  }
  __syncthreads();
}
__device__ __forceinline__ void p0_transpose(const Frame& F, const float* W, int ldw, int N, bf16* Wt) {
  LAS float* tl = (LAS float*)(F.lds);
  const int ntn = N / 64, ntask = ntn * 16;
  for (int task = blockIdx.x; task < ntask; task += gridDim.x) {
    const int nb = task % ntn, kb = task / ntn, n0 = nb * 64, k0 = kb * 128;
    __syncthreads();
#pragma unroll
    for (int i = 0; i < 4; ++i) { const int idx = F.tid + NTHR * i, kk = idx >> 4, c4 = idx & 15;
      const f32x4 w = *(const f32x4*)(W + (size_t)(k0 + kk) * ldw + n0 + 4 * c4);
      LAS float* d = tl + kk * 65 + 4 * c4; d[0] = w.x; d[1] = w.y; d[2] = w.z; d[3] = w.w; }
    __syncthreads();
    const int n = F.tid >> 3, kc = F.tid & 7;
    const LAS float* s = tl + (kc * 16) * 65 + n;
    v4u o0, o1;
    o0.x = pk2(s[0 * 65], s[1 * 65]); o0.y = pk2(s[2 * 65], s[3 * 65]); o0.z = pk2(s[4 * 65], s[5 * 65]); o0.w = pk2(s[6 * 65], s[7 * 65]);
    o1.x = pk2(s[8 * 65], s[9 * 65]); o1.y = pk2(s[10 * 65], s[11 * 65]); o1.z = pk2(s[12 * 65], s[13 * 65]); o1.w = pk2(s[14 * 65], s[15 * 65]);
    v4u* dp = (v4u*)(Wt + (size_t)(n0 + n) * DM + k0 + kc * 16);
    dp[0] = o0; dp[1] = o1;
  }
  __syncthreads();
}
__device__ __forceinline__ void p0_zero_vpad(const Frame& F) {
  bf16* Vp = (bf16*)(F.ws + WS_VP);
  const int per = MPOS0 * 256 / 8;
  for (int i = blockIdx.x * NTHR + F.tid; i < 16 * per; i += gridDim.x * NTHR) { const int bh = i / per, e = i % per;
    *(v4u*)(Vp + (size_t)bh * PADT * 256 + (size_t)e * 8) = (v4u){0u, 0u, 0u, 0u}; }
}
__device__ __forceinline__ void p0_lam(const Frame& F, const Args& a) {
  if (blockIdx.x == 0 && F.wave == 0) {
    const int l = F.lane;
    float s1 = a.in[IN_LQ1][l] * a.in[IN_LK1][l] + a.in[IN_LQ1][l + 64] * a.in[IN_LK1][l + 64];
    float s2 = a.in[IN_LQ2][l] * a.in[IN_LK2][l] + a.in[IN_LQ2][l + 64] * a.in[IN_LK2][l + 64];
    s1 = wave_sum(s1); s2 = wave_sum(s2);
    if (l == 0) *(float*)(F.ws + WS_LAM) = __expf(s1) - __expf(s2) + 0.2f;
  }
}

struct EpiProj {
  static constexpr bool PERM = true, AFTER_DRAIN = false;
  bf16 *Qb, *Kp, *Vp, *MQ, *MK, *MV, *MO; const float *qg, *kg; LAS float* xch;
  __device__ __forceinline__ void operator()(const pg8::f32x4 (&acc)[2][2][4][2], const pg8::Unit& u, int wr, int wc, int fr, int fq) const {
    const int pn = u.pn, b = u.pm >> 3, tb = (u.pm & 7) * 256 + wr * 64 + fr, d0 = wc * 32 + fq * 8;
    if (pn < 8) {
      const bool isk = pn >= 4; const int h = pn & 3;
      float ssq[2][4][2];
#pragma unroll
      for (int ai = 0; ai < 2; ++ai)
#pragma unroll
        for (int m = 0; m < 4; ++m)
#pragma unroll
          for (int bj = 0; bj < 2; ++bj) { float s = 0.f;
#pragma unroll
            for (int n = 0; n < 2; ++n) { const pg8::f32x4 x = acc[ai][bj][m][n]; s += (x[0] * x[0] + x[1] * x[1]) + (x[2] * x[2] + x[3] * x[3]); }
            s += __shfl_xor(s, 16); s += __shfl_xor(s, 32); ssq[ai][m][bj] = s;
            if (fq == 0) xch[((ai * 128 + wr * 64 + m * 16 + fr) * 2 + bj) * 4 + wc] = s; }
      asm volatile("s_waitcnt lgkmcnt(0)" ::: "memory"); __builtin_amdgcn_s_barrier(); asm volatile("" ::: "memory");
      const float* gp = (isk ? kg : qg) + d0; const f32x4 g0 = *(const f32x4*)gp, g1v = *(const f32x4*)(gp + 4);
      const float sc = isk ? 1.0f : QSCALE;
#pragma unroll
      for (int ai = 0; ai < 2; ++ai)
#pragma unroll
        for (int m = 0; m < 4; ++m)
#pragma unroll
          for (int bj = 0; bj < 2; ++bj) {
            const f32x4 p = *(const LAS f32x4*)(xch + ((ai * 128 + wr * 64 + m * 16 + fr) * 2 + bj) * 4);
            const float rs = rsqrtf(((p.x + p.y) + (p.z + p.w)) * (1.0f / 128.f) + EPS) * sc;
            const pg8::f32x4 v0 = acc[ai][bj][m][0], v1 = acc[ai][bj][m][1];
            v4u w; w.x = pk2(v0[0] * rs * g0.x, v0[1] * rs * g0.y); w.y = pk2(v0[2] * rs * g0.z, v0[3] * rs * g0.w);
            w.z = pk2(v1[0] * rs * g1v.x, v1[1] * rs * g1v.y); w.w = pk2(v1[2] * rs * g1v.z, v1[3] * rs * g1v.w);
            const int t = tb + ai * 128 + m * 16;
            bf16* dst = isk ? Kp + kp_off((b * 4 + h) * 2 + bj, POS0 + t, d0)
                            : Qb + ((size_t)((b * 4 + h) * 2 + bj) * SEQ + t) * 128 + d0;
            *(v4u*)dst = w; }
      return;
    }
#pragma unroll
    for (int ai = 0; ai < 2; ++ai)
#pragma unroll
      for (int m = 0; m < 4; ++m)
#pragma unroll
        for (int bj = 0; bj < 2; ++bj) {
          pg8::f32x4 v0 = acc[ai][bj][m][0], v1 = acc[ai][bj][m][1];
          const int t = tb + ai * 128 + m * 16;
          bf16* dst;
          if (pn < 12) { const int h = pn - 8; dst = Vp + ((size_t)(b * 4 + h) * PADT + POS0 + t) * 256 + bj * 128 + d0; }
          else if (pn < 16) { const int h = 2 * (pn & 1) + bj; dst = (pn >= 14 ? MK : MQ) + ((size_t)(b * 4 + h) * PADT + POS0 + t) * 128 + d0; }
          else if (pn < 20) { const int h = pn - 16; dst = MV + ((size_t)(b * 4 + h) * PADT + POS0 + t) * 256 + bj * 128 + d0; }
          else { dst = MO + (size_t)(b * SEQ + t) * 1024 + (pn - 20) * 256 + bj * 128 + d0;
#pragma unroll
            for (int j = 0; j < 4; ++j) { v0[j] = sigmoidf_(v0[j]); v1[j] = sigmoidf_(v1[j]); } }
          v4u w; w.x = pk2(v0[0], v0[1]); w.y = pk2(v0[2], v0[3]); w.z = pk2(v1[0], v1[1]); w.w = pk2(v1[2], v1[3]);
          *(v4u*)dst = w; }
  }
};
__device__ __forceinline__ void p1_meta_finalize(const Frame& F, const Args& a) {
  if (blockIdx.x >= NMETA) return;
  const int mrow = blockIdx.x, tid = F.tid, lane = F.lane, w = F.wave;
  const float* meta = a.in[IN_META] + (size_t)mrow * DM; const float* PM0 = (const float*)(F.ws + WS_PM) + (size_t)mrow * NPROJ;
#define PM_AT(i) ((PM0[(i)] + PM0[(size_t)16 * NPROJ + (i)]) + (PM0[(size_t)32 * NPROJ + (i)] + PM0[(size_t)48 * NPROJ + (i)]))
  LAS float* red = (LAS float*)(F.lds + XCH_OFF);
  const f32x4 mv = ((const f32x4*)meta)[tid];
  float s = wave_sum((mv.x * mv.x + mv.y * mv.y) + (mv.z * mv.z + mv.w * mv.w));
  if (lane == 0) red[w] = s;
  __syncthreads();
  float tot = 0.f;
#pragma unroll
  for (int i = 0; i < 8; ++i) tot += red[i];
  const float rs = rsqrtf(tot * (1.0f / DM) + EPS);
  bf16* Kp = (bf16*)(F.ws + WS_KP); bf16* Vp = (bf16*)(F.ws + WS_VP); bf16* MQ = (bf16*)(F.ws + WS_MQ); bf16* MK = (bf16*)(F.ws + WS_MK); bf16* MV = (bf16*)(F.ws + WS_MV);
  const int pos = MPOS0 + mrow;
  {
    const float v0 = PM_AT(1024 + w * 128 + lane) * rs, v1 = PM_AT(1024 + w * 128 + lane + 64) * rs;
    const float rk = rsqrtf(wave_sum(v0 * v0 + v1 * v1) * (1.0f / 128.f) + EPS);
    const float* kg = a.in[IN_KNG];
    const unsigned short o0 = (unsigned short)f2bf(v0 * rk * kg[lane]), o1 = (unsigned short)f2bf(v1 * rk * kg[lane + 64]);
    for (int b = 0; b < NB; ++b) { const int bhm = (b * 4 + (w >> 1)) * 2 + (w & 1); Kp[kp_off(bhm, pos, lane)] = o0; Kp[kp_off(bhm, pos, lane + 64)] = o1; }
  }
  { const int c = tid * 2;
    const unsigned o = pk2(PM_AT(2048 + c) * rs, PM_AT(2048 + c + 1) * rs); const int h = c >> 8, e = c & 255;
    for (int b = 0; b < NB; ++b) *(unsigned*)(Vp + ((size_t)(b * 4 + h) * PADT + pos) * 256 + e) = o;
    const unsigned o2 = pk2(PM_AT(3072 + c) * rs, PM_AT(3072 + c + 1) * rs); const bool isk = c >= 512; const int cc = c & 511, hq = cc >> 7, d = cc & 127;
    for (int b = 0; b < NB; ++b) *(unsigned*)((isk ? MK : MQ) + ((size_t)(b * 4 + hq) * PADT + pos) * 128 + d) = o2;
    const unsigned o3 = pk2(PM_AT(4096 + c) * rs, PM_AT(4096 + c + 1) * rs);
    for (int b = 0; b < NB; ++b) *(unsigned*)(MV + ((size_t)(b * 4 + h) * PADT + pos) * 256 + e) = o3;
  }
  __syncthreads();
}
#undef PM_AT

namespace att {
using f32x16 = __attribute__((ext_vector_type(16))) float;
using s16x4 = __attribute__((ext_vector_type(4))) short;
constexpr int STEPS_BHM = 152, NSTEPS = 32 * STEPS_BHM;
constexpr int SHM_V = 64 * 256 * 2, SHM_K = 64 * 128 * 2;
constexpr int LDS_V = 0, LDS_K = 2 * SHM_V, LDS_Q = LDS_K + SHM_K, LDS_WS = LDS_Q + 8 * 8192;
constexpr float THR2 = 8.0f;
#define KSWZ(row, colB) ((row) * 256 + ((colB) ^ (((row) & 7) << 4)))
#define SBAR() __builtin_amdgcn_sched_barrier(0)
__device__ __forceinline__ int crow(int r, int hi) { return (r & 3) + 8 * (r >> 2) + 4 * hi; }
__device__ __forceinline__ unsigned cvtpk(float lo, float hi) { unsigned r; asm volatile("v_cvt_pk_bf16_f32 %0, %1, %2" : "=v"(r) : "v"(lo), "v"(hi)); return r; }
__device__ __forceinline__ int qb_start(int qb) { return 2 * qb * qb + 3 * qb; }
__device__ __forceinline__ int chunk_of(int s, int NA) { return ((s + 1) * NA - 1) / NSTEPS; }

template <int OFF> __device__ __forceinline__ s16x4 tr_read(int vb) {
  s16x4 r; asm volatile("ds_read_b64_tr_b16 %0, %1 offset:%2" : "=&v"(r) : "v"(vb), "i"(OFF) : "memory"); return r;
}
constexpr int v_rd_off(int d0, int ks, int half) { return d0 * 512 + ks * 8192 + half * 4096; }
template <int D0> __device__ __forceinline__ void pv_one(f32x16& od, int vb, bf16x8 pa0, bf16x8 pa1, bf16x8 pa2, bf16x8 pa3) {
#define PK(L, H) (bf16x8){L[0], L[1], L[2], L[3], H[0], H[1], H[2], H[3]}
  { const s16x4 l0 = tr_read<v_rd_off(D0, 0, 0)>(vb), h0 = tr_read<v_rd_off(D0, 0, 1)>(vb), l1 = tr_read<v_rd_off(D0, 1, 0)>(vb), h1 = tr_read<v_rd_off(D0, 1, 1)>(vb);
    asm volatile("s_waitcnt lgkmcnt(0)" ::: "memory"); SBAR();
    od = __builtin_amdgcn_mfma_f32_32x32x16_bf16(pa0, PK(l0, h0), od, 0, 0, 0);
    od = __builtin_amdgcn_mfma_f32_32x32x16_bf16(pa1, PK(l1, h1), od, 0, 0, 0); }
  SBAR();
  { const s16x4 l2 = tr_read<v_rd_off(D0, 2, 0)>(vb), h2 = tr_read<v_rd_off(D0, 2, 1)>(vb), l3 = tr_read<v_rd_off(D0, 3, 0)>(vb), h3 = tr_read<v_rd_off(D0, 3, 1)>(vb);
    asm volatile("s_waitcnt lgkmcnt(0)" ::: "memory"); SBAR();
    od = __builtin_amdgcn_mfma_f32_32x32x16_bf16(pa2, PK(l2, h2), od, 0, 0, 0);
    od = __builtin_amdgcn_mfma_f32_32x32x16_bf16(pa3, PK(l3, h3), od, 0, 0, 0); }
#undef PK
}

__device__ __forceinline__ void segment(const Frame& F, int bhm, int qb, int j0, int j1, int slot) {
  const int tid = F.tid, wid = F.wave, lane = F.lane, r32 = lane & 31, hi = lane >> 5;
  const bf16* Qg = (const bf16*)(F.ws + WS_Q) + ((size_t)bhm * SEQ + qb * 256 + wid * 32 + r32) * 128 + hi * 8;
  const bf16* Kg = (const bf16*)(F.ws + WS_KP) + (size_t)bhm * 33 * 8192;
  const bf16* Vg = (const bf16*)(F.ws + WS_VP) + (size_t)(bhm >> 1) * PADT * 256;
  LAS unsigned char* lds = F.lds;
  LAS float* wsl = (LAS float*)(lds + LDS_WS) + wid * 64;
  const float slope2 = exp2f(-2.0f * (float)(((bhm >> 1) & 3) + 1)) * LOG2E;
  unsigned ksrc0, vsrc0;
  ksrc0 = (unsigned)tid * 16u;
  { const int a8 = tid >> 8, b = (tid >> 2) & 7, k = 8 * (b >> 2) + 4 * a8 + (b & 3), c = ((tid >> 5) & 7) * 32 + (tid & 3) * 8; vsrc0 = (unsigned)(k * 256 + c) * 2u; }
#define STAGE_K(j) do { const char* kt = (const char*)(Kg + (size_t)(j) * 8192); \
    _Pragma("unroll") for (int _i = 0; _i < 2; ++_i) __builtin_amdgcn_global_load_lds((const unsigned*)(kt + (ksrc0 + _i * 8192u)), (LAS unsigned*)(lds + LDS_K + _i * 8192 + wid * 1024), 16, 0, 0); } while (0)
#define STAGE_V(buf, j) do { const char* vt = (const char*)(Vg + (size_t)(j) * 64 * 256); \
    _Pragma("unroll") for (int _i = 0; _i < 4; ++_i) __builtin_amdgcn_global_load_lds((const unsigned*)(vt + (vsrc0 + _i * 8192u)), (LAS unsigned*)(lds + LDS_V + (buf) * SHM_V + _i * 8192 + wid * 1024), 16, 0, 0); } while (0)
  const int lt = (((r32 << 1) | hi) ^ ((r32 >> 3) & 1)) << 4;
  LAS unsigned char* Qs = lds + LDS_Q + wid * 8192;
#pragma unroll
  for (int d0 = 0; d0 < 8; ++d0) { const bf16x8 qv = *(const bf16x8*)(Qg + d0 * 16); *(LAS bf16x8*)(Qs + d0 * 1024 + lt) = qv; }
  const float hioff = slope2 * (float)(4 * hi);
  f32x16 o[8];
#pragma unroll
  for (int d = 0; d < 8; ++d)
#pragma unroll
    for (int r = 0; r < 16; ++r) o[d][r] = 0.f;
  float m_reg = -1e30f, l_reg = 0.f;
  const int vb0 = (int)(uintptr_t)(lds + LDS_V) + (((lane & 3) << 3) | (((lane >> 2) & 3) << 6) | (((lane >> 4) & 1) << 5) | (((lane >> 5) & 1) << 8));
  const int qrel = wid * 32 + r32;
  STAGE_K(j0); STAGE_V(0, j0);
  VM_WAIT(); __syncthreads();
  for (int j = j0; j < j1; ++j) {
    const int cur = (j - j0) & 1;
    if (j + 1 < j1) STAGE_V(cur ^ 1, j + 1);
    SBAR();
    f32x16 p0 = {}, p1 = {};
    { const LAS unsigned char* Ks = lds + LDS_K;
#pragma unroll
      for (int d0 = 0; d0 < 8; ++d0) {
        const bf16x8 b0 = *(const LAS bf16x8*)(Ks + d0 * 2048 + lt);
        const bf16x8 b1 = *(const LAS bf16x8*)(Ks + d0 * 2048 + 1024 + lt);
        const bf16x8 qf = *(const LAS bf16x8*)(Qs + d0 * 1024 + lt);
        p0 = __builtin_amdgcn_mfma_f32_32x32x16_bf16(b0, qf, p0, 0, 0, 0);
        p1 = __builtin_amdgcn_mfma_f32_32x32x16_bf16(b1, qf, p1, 0, 0, 0); } }
    asm volatile("s_waitcnt lgkmcnt(0)" ::: "memory"); __builtin_amdgcn_s_barrier(); asm volatile("" ::: "memory");
    if (j + 1 < j1) STAGE_K(j + 1);
    SBAR();
    if (j == 0) {
#pragma unroll
      for (int r = 0; r < 16; ++r) p0[r] = -INFINITY;
#pragma unroll
      for (int r = 0; r < 8; ++r) p1[r] = -INFINITY;
    }
    const int jb = j - (4 * qb + 1);
    if (jb >= 0) {
      const int kb = 64 * jb + 4 * hi;
#pragma unroll
      for (int r = 0; r < 16; ++r) { const int kv = kb + (r & 3) + 8 * (r >> 2); if (kv > qrel) p0[r] = -INFINITY; if (kv + 32 > qrel) p1[r] = -INFINITY; }
    }
    const float off0 = slope2 * (float)(64 * j) + hioff, off1 = off0 + 32.0f * slope2;
#pragma unroll
    for (int r = 0; r < 16; ++r) { const float sb = slope2 * (float)((r & 3) + 8 * (r >> 2)); p0[r] += sb; p1[r] += sb; }
    float pm0 = p0[0], pm1 = p1[0];
#pragma unroll
    for (int r = 1; r < 16; ++r) { pm0 = fmaxf(pm0, p0[r]); pm1 = fmaxf(pm1, p1[r]); }
    float pmax = fmaxf(pm0 + off0, pm1 + off1);
    { auto rr = __builtin_amdgcn_permlane32_swap(__float_as_uint(pmax), __float_as_uint(pmax), false, false);
      pmax = fmaxf(__uint_as_float(rr[0]), __uint_as_float(rr[1])); }
    float mn, alpha;
    if (__builtin_expect(__all(pmax - m_reg <= THR2), 1)) { mn = m_reg; alpha = 1.f; }
    else { mn = fmaxf(m_reg, pmax); alpha = __builtin_amdgcn_exp2f(m_reg - mn); m_reg = mn; }
    const float c0 = off0 - mn, c1 = off1 - mn;
    float ps = 0.f;
#pragma unroll
    for (int r = 0; r < 16; ++r) { p0[r] = __builtin_amdgcn_exp2f(p0[r] + c0); p1[r] = __builtin_amdgcn_exp2f(p1[r] + c1); ps += p0[r] + p1[r]; }
    { auto rr = __builtin_amdgcn_permlane32_swap(__float_as_uint(ps), __float_as_uint(ps), false, false);
      ps = __uint_as_float(rr[0]) + __uint_as_float(rr[1]); }
    l_reg = l_reg * alpha + ps;
    if (__any(alpha < 1.f)) { if (hi == 0) wsl[r32] = alpha; asm volatile("s_waitcnt lgkmcnt(0)" ::: "memory");
#pragma unroll
      for (int rg = 0; rg < 4; ++rg) { const f32x4 al = *(const LAS f32x4*)(wsl + 8 * rg + 4 * hi);
#pragma unroll
        for (int d = 0; d < 8; ++d) { o[d][4 * rg + 0] *= al.x; o[d][4 * rg + 1] *= al.y; o[d][4 * rg + 2] *= al.z; o[d][4 * rg + 3] *= al.w; }
        SBAR(); } }
    bf16x8 pa0, pa1, pa2, pa3;
#define PK4(P, BASE, OUT) do { unsigned a0 = cvtpk(P[BASE + 0], P[BASE + 1]), a1 = cvtpk(P[BASE + 2], P[BASE + 3]);   \
    unsigned b0 = cvtpk(P[BASE + 4], P[BASE + 5]), b1 = cvtpk(P[BASE + 6], P[BASE + 7]);                              \
    auto r0 = __builtin_amdgcn_permlane32_swap(a0, b0, false, false); auto r1 = __builtin_amdgcn_permlane32_swap(a1, b1, false, false); \
    v4u w = {r0[0], r1[0], r0[1], r1[1]}; OUT = *reinterpret_cast<bf16x8*>(&w); } while (0)
    PK4(p0, 0, pa0); PK4(p0, 8, pa1); PK4(p1, 0, pa2); PK4(p1, 8, pa3);
#undef PK4
    SBAR();
    { const int vb = vb0 + cur * SHM_V;
      pv_one<0>(o[0], vb, pa0, pa1, pa2, pa3); pv_one<1>(o[1], vb, pa0, pa1, pa2, pa3); pv_one<2>(o[2], vb, pa0, pa1, pa2, pa3); pv_one<3>(o[3], vb, pa0, pa1, pa2, pa3);
      pv_one<4>(o[4], vb, pa0, pa1, pa2, pa3); pv_one<5>(o[5], vb, pa0, pa1, pa2, pa3); pv_one<6>(o[6], vb, pa0, pa1, pa2, pa3); pv_one<7>(o[7], vb, pa0, pa1, pa2, pa3); }
    VM_WAIT(); __syncthreads();
  }
  { int lane2 = threadIdx.x & 63, slot2 = slot; asm volatile("" : "+v"(lane2), "+s"(slot2));
    const int r32e = lane2 & 31, hie = lane2 >> 5;
    float* PO = (float*)(F.ws + WS_PO) + (size_t)slot2 * 256 * 256; float* ML = (float*)(F.ws + WS_ML) + (size_t)slot2 * 512;
    LAS float* wse = (LAS float*)(F.lds + LDS_WS) + wid * 64;
    if (hie == 0) { wse[r32e] = l_reg; ML[(wid * 32 + r32e) * 2] = m_reg; ML[(wid * 32 + r32e) * 2 + 1] = l_reg; }
    asm volatile("s_waitcnt lgkmcnt(0)" ::: "memory");
    char* Ob = (char*)(PO + (size_t)(wid * 32) * 256);
    const unsigned lo = (unsigned)(4 * hie * 256 + r32e) * 4u;
#pragma unroll
    for (int r = 0; r < 16; ++r) { const int rowc = (r & 3) + 8 * (r >> 2); const float lv = wse[rowc + 4 * hie]; const float rl = lv > 0.f ? __builtin_amdgcn_rcpf(lv) : 0.f;
#pragma unroll
      for (int d0 = 0; d0 < 8; ++d0) *(float*)(Ob + (lo + (unsigned)(rowc * 256 + d0 * 32) * 4u)) = o[d0][r] * rl;
      SBAR(); } }
  __syncthreads();
#undef STAGE_K
#undef STAGE_V
}

__device__ __forceinline__ void phase(const Frame& F, int ca, int NA) {
  int s0 = (int)(((long)ca * NSTEPS) / NA); const int s1 = (int)(((long)(ca + 1) * NSTEPS) / NA);
  while (s0 < s1) {
    const int bhm = s0 / STEPS_BHM, rem = s0 - bhm * STEPS_BHM;
    int qb = 0;
#pragma unroll 1
    for (int q = 1; q < 8; ++q) if (rem >= qb_start(q)) qb = q;
    const int j0 = rem - qb_start(qb), nst = 4 * qb + 5;
    const int j1 = (j0 + (s1 - s0) < nst) ? j0 + (s1 - s0) : nst;
    const int slot = bhm * 16 + qb + chunk_of(s0, NA) - chunk_of(bhm * STEPS_BHM, NA);
    segment(F, bhm, qb, j0, j1, slot);
    s0 += j1 - j0;
  }
}
#undef KSWZ
#undef SBAR
}
namespace ml {
constexpr int QST = 136, TST = 72;
constexpr int L_RQ = 0, L_RK = 17152, L_QS = 34304, L_QW = 51712, L_KS = 69120, L_KWT = 86528, L_VT = 104960  , L_SP = 0  , L_G = 141824, L_CW = 143872;
constexpr int L_HT = 0;
constexpr int G_A = 0, G_M = 64, G_WI = 128, G_EM = 192, G_DEN = 256, G_WG = 320, G_SC = 384, G_N = 0;
constexpr int L_NV = L_CW + 5120;
constexpr int L_SSQ = L_KWT;
__device__ __forceinline__ float shfl_up_f(float v, int d) { return __shfl_up(v, d); }

__device__ __forceinline__ void load_cw(const Frame& F, const Args& a, int h) {
  LAS float* CW = (LAS float*)(F.lds + L_CW);
  for (int e = F.tid; e < 2 * 5 * 128; e += NTHR) { const int qk = e / 640, j = (e / 128) % 5, d = e & 127; const int ch = qk * 512 + h * 128 + d;
    CW[e] = j < 4 ? a.in[IN_CW][j * 1024 + ch] : a.in[IN_CB][ch]; }
}
__device__ __forceinline__ void load_raw(const Frame& F, const bf16* g, int pos0, int lds_off) {
  for (int p = F.tid; p < 67 * 16; p += NTHR) { const int row = p >> 4, ch = p & 15, pos = pos0 - 3 + row;
    v4u v = {0u, 0u, 0u, 0u}; if (pos >= MPOS0) v = *(const v4u*)(g + (size_t)pos * 128 + ch * 8);
    *(LAS v4u*)(F.lds + lds_off + row * 256 + ch * 16) = v; }
}
__device__ __forceinline__ void conv16(const Frame& F, int qk, int lds_off, int t, int d0, float (&y)[16]) {
  const LAS float* CW = (const LAS float*)(F.lds + L_CW);
#pragma unroll
  for (int e = 0; e < 16; ++e) y[e] = CW[(qk * 5 + 4) * 128 + d0 + e];
#pragma unroll
  for (int j = 0; j < 4; ++j) { const LAS v4u* rp = (const LAS v4u*)(F.lds + lds_off + (t + j) * 256 + d0 * 2); const v4u r0 = rp[0], r1 = rp[1];
    const LAS float* cw = CW + (qk * 5 + j) * 128 + d0;
    y[0] += cw[0] * bflo(r0.x); y[1] += cw[1] * bfhi(r0.x); y[2] += cw[2] * bflo(r0.y); y[3] += cw[3] * bfhi(r0.y); y[4] += cw[4] * bflo(r0.z); y[5] += cw[5] * bfhi(r0.z); y[6] += cw[6] * bflo(r0.w); y[7] += cw[7] * bfhi(r0.w);
    y[8] += cw[8] * bflo(r1.x); y[9] += cw[9] * bfhi(r1.x); y[10] += cw[10] * bflo(r1.y); y[11] += cw[11] * bfhi(r1.y); y[12] += cw[12] * bflo(r1.z); y[13] += cw[13] * bfhi(r1.z); y[14] += cw[14] * bflo(r1.w); y[15] += cw[15] * bfhi(r1.w); }
#pragma unroll
  for (int e = 0; e < 16; ++e) y[e] = y[e] / (1.0f + __expf(-y[e]));
}
__device__ __forceinline__ void load_vt(const Frame& F, const bf16* MVg, int pos0) {
#pragma unroll
  for (int i = 0; i < 4; ++i) { const int p = F.tid + NTHR * i, row = p >> 5, ch = p & 31; v4u v4 = {0u, 0u, 0u, 0u};
    if (pos0 + row >= MPOS0) v4 = *(const v4u*)(MVg + (size_t)(pos0 + row) * 256 + ch * 8);
    LAS bf16* vt = (LAS bf16*)(F.lds + L_VT) + (ch * 8) * TST + row;
    vt[0 * TST] = (bf16)(v4.x & 0xffff); vt[1 * TST] = (bf16)(v4.x >> 16); vt[2 * TST] = (bf16)(v4.y & 0xffff); vt[3 * TST] = (bf16)(v4.y >> 16);
    vt[4 * TST] = (bf16)(v4.z & 0xffff); vt[5 * TST] = (bf16)(v4.z >> 16); vt[6 * TST] = (bf16)(v4.w & 0xffff); vt[7 * TST] = (bf16)(v4.w >> 16); }
}

__device__ __forceinline__ void taskA(const Frame& F, const Args& a, int task) {
  const int bh = task >> 5, c = task & 31, h = bh & 3, tid = F.tid, w = F.wave, lane = F.lane, fr = lane & 15, kq = lane >> 4, pos0 = 64 * c;
  LAS unsigned char* lds = F.lds; LAS float* G = (LAS float*)(lds + L_G);
  const bf16* MKg = (const bf16*)(F.ws + WS_MK) + (size_t)bh * PADT * 128; const bf16* MVg = (const bf16*)(F.ws + WS_MV) + (size_t)bh * PADT * 256;
  __syncthreads();
  load_cw(F, a, h); load_raw(F, MKg, pos0, L_RK); load_vt(F, MVg, pos0);
  if (w == 0) {
    const bool dead = pos0 + lane < MPOS0;
    const float li = dead ? -1e30f : ((const float*)(F.ws + WS_LI))[bh * PADT + pos0 + lane], lf = dead ? 0.f : ((const float*)(F.ws + WS_LF))[bh * PADT + pos0 + lane];
    float bs = lf;
#pragma unroll
    for (int d = 1; d < 64; d <<= 1) { const float o = shfl_up_f(bs, d); if (lane >= d) bs += o; }
    const float av = li - bs; float mx = av;
#pragma unroll
    for (int o = 1; o < 64; o <<= 1) mx = fmaxf(mx, __shfl_xor(mx, o));
    G[G_WG + lane] = __expf(av - mx);
    if (lane == 63) { float* gs = (float*)(F.ws + WS_GS) + (size_t)(bh * 33 + c) * 2; gs[0] = bs; gs[1] = mx; }
  }
  __syncthreads();
  { const int t = tid >> 3, d0 = (tid & 7) * 16; float y[16]; conv16(F, 1, L_RK, t, d0, y);
    const float sw = 0.08838834764831845f * G[G_WG + t]; LAS bf16* kt = (LAS bf16*)(lds + L_KWT) + d0 * TST + t;
#pragma unroll
    for (int e = 0; e < 16; ++e) kt[e * TST] = (bf16)f2bf(y[e] * sw); }
  __syncthreads();
  f32x4* DCg = (f32x4*)(F.ws + WS_DC) + ((size_t)(bh * 32 + c) * 128) * 64;
#pragma unroll
  for (int jj = 0; jj < 2; ++jj) { const int j = 2 * w + jj;
    const bf16x8 bv0 = *(const LAS bf16x8*)(lds + L_VT + ((16 * j + fr) * TST + 8 * kq) * 2), bv1 = *(const LAS bf16x8*)(lds + L_VT + ((16 * j + fr) * TST + 32 + 8 * kq) * 2);
#pragma unroll
    for (int i = 0; i < 8; ++i) { f32x4 acc = {0.f, 0.f, 0.f, 0.f};
      const bf16x8 k0 = *(const LAS bf16x8*)(lds + L_KWT + ((16 * i + fr) * TST + 8 * kq) * 2), k1 = *(const LAS bf16x8*)(lds + L_KWT + ((16 * i + fr) * TST + 32 + 8 * kq) * 2);
      acc = __builtin_amdgcn_mfma_f32_16x16x32_bf16(k0, bv0, acc, 0, 0, 0); acc = __builtin_amdgcn_mfma_f32_16x16x32_bf16(k1, bv1, acc, 0, 0, 0);
      DCg[(size_t)(i * 16 + j) * 64 + lane] = acc; } }
  if (tid < 128) { const LAS v4u* kr = (const LAS v4u*)(lds + L_KWT + tid * TST * 2); float s = 0.f;
#pragma unroll
    for (int q = 0; q < 8; ++q) { const v4u x = kr[q]; s += (bflo(x.x) + bfhi(x.x)) + (bflo(x.y) + bfhi(x.y)) + (bflo(x.z) + bfhi(x.z)) + (bflo(x.w) + bfhi(x.w)); }
    ((float*)(F.ws + WS_DN))[(size_t)(bh * 32 + c) * 128 + tid] = s; }
}

__device__ __forceinline__ void scanB(const Frame& F) {
  const float* GS = (const float*)(F.ws + WS_GS);
  LAS float* cf = (LAS float*)F.lds;
  for (int blk = blockIdx.x; blk < 16 * 16; blk += gridDim.x) { const int bh = blk >> 4, r = (blk & 15) * NTHR + F.tid, i = r >> 10, j = (r >> 6) & 15, ln = r & 63;
    __syncthreads();
    if (F.tid == 0) { float m = 0.f; for (int c = 0; c < 32; ++c) { const float bL = GS[(bh * 33 + c) * 2], ml = GS[(bh * 33 + c) * 2 + 1], me = fmaxf(m, ml);
        cf[2 * c] = __expf(m - me); cf[2 * c + 1] = __expf(ml - me); m = bL + me; } }
    __syncthreads();
    const f32x4* dc = (const f32x4*)(F.ws + WS_DC) + ((size_t)(bh * 32) * 128 + (i * 16 + j)) * 64 + ln;
    v2u* cs = (v2u*)(F.ws + WS_CS) + ((((size_t)bh * 33) * 4 + (i >> 1)) * 16 + j) * 64 * 2 + ln * 2 + (i & 1);
    f32x4 st = {0.f, 0.f, 0.f, 0.f};
#pragma unroll 8
    for (int c = 0; c < 32; ++c) { st = st * cf[2 * c] + dc[(size_t)c * 128 * 64] * cf[2 * c + 1];
      v2u o; o.x = pk2(st.x, st.y); o.y = pk2(st.z, st.w); cs[(size_t)(c + 1) * 4 * 16 * 64 * 2] = o; } }
  const int gt = blockIdx.x * NTHR + F.tid, NT = gridDim.x * NTHR;
  for (int g = gt; g < 16 * 128; g += NT) { const int bh = g >> 7, d = g & 127; float n = 0.f, m = 0.f;
    for (int c = 0; c < 32; ++c) { const float bL = GS[(bh * 33 + c) * 2], ml = GS[(bh * 33 + c) * 2 + 1], me = fmaxf(m, ml);
      n = n * __expf(m - me) + ((const float*)(F.ws + WS_DN))[(size_t)(bh * 32 + c) * 128 + d] * __expf(ml - me); m = bL + me;
      ((float*)(F.ws + WS_NS))[(size_t)(bh * 33 + c + 1) * 128 + d] = n; if (d == 0) ((float*)(F.ws + WS_MS))[bh * 33 + c + 1] = m; } }
}

__device__ __forceinline__ void taskC(const Frame& F, const Args& a, int task) {
  const int bh = task >> 5, c = (task & 31) + 1, b = bh >> 2, h = bh & 3, tid = F.tid, w = F.wave, lane = F.lane, fr = lane & 15, kq = lane >> 4, pos0 = 64 * c;
  LAS unsigned char* lds = F.lds; LAS float* G = (LAS float*)(lds + L_G); LAS float* NV = (LAS float*)(lds + L_NV);
  const bf16* MQg = (const bf16*)(F.ws + WS_MQ) + (size_t)bh * PADT * 128; const bf16* MKg = (const bf16*)(F.ws + WS_MK) + (size_t)bh * PADT * 128;
  const bf16* MVg = (const bf16*)(F.ws + WS_MV) + (size_t)bh * PADT * 256;
  const float m = ((const float*)(F.ws + WS_MS))[bh * 33 + c];
  __syncthreads();
  load_cw(F, a, h); load_raw(F, MQg, pos0, L_RQ); load_raw(F, MKg, pos0, L_RK); load_vt(F, MVg, pos0);
  if (tid < 128) NV[tid] = ((const float*)(F.ws + WS_NS))[(size_t)(bh * 33 + c) * 128 + tid];
  if (w == 0) {
    const float li = ((const float*)(F.ws + WS_LI))[bh * PADT + pos0 + lane], lf = ((const float*)(F.ws + WS_LF))[bh * PADT + pos0 + lane];
    float bs = lf;
#pragma unroll
    for (int d = 1; d < 64; d <<= 1) { const float o = shfl_up_f(bs, d); if (lane >= d) bs += o; }
    const float av = li - bs; float cm = av;
#pragma unroll
    for (int d = 1; d < 64; d <<= 1) { const float o = shfl_up_f(cm, d); if (lane >= d) cm = fmaxf(cm, o); }
    const float Mt = fmaxf(m, cm);
    G[G_A + lane] = av; G[G_M + lane] = Mt; G[G_WI + lane] = __expf(m - Mt); G[G_EM + lane] = __expf(-(bs + Mt));
  }
  __syncthreads();
  { const int t = tid >> 3, d0 = (tid & 7) * 16; const float wi = G[G_WI + t]; float y[16];
    conv16(F, 0, L_RQ, t, d0, y);
    { v4u o0, o1, w0, w1;
      o0.x = pk2(y[0], y[1]); o0.y = pk2(y[2], y[3]); o0.z = pk2(y[4], y[5]); o0.w = pk2(y[6], y[7]); o1.x = pk2(y[8], y[9]); o1.y = pk2(y[10], y[11]); o1.z = pk2(y[12], y[13]); o1.w = pk2(y[14], y[15]);
      w0.x = pk2(y[0] * wi, y[1] * wi); w0.y = pk2(y[2] * wi, y[3] * wi); w0.z = pk2(y[4] * wi, y[5] * wi); w0.w = pk2(y[6] * wi, y[7] * wi);
      w1.x = pk2(y[8] * wi, y[9] * wi); w1.y = pk2(y[10] * wi, y[11] * wi); w1.z = pk2(y[12] * wi, y[13] * wi); w1.w = pk2(y[14] * wi, y[15] * wi);
      LAS v4u* qs = (LAS v4u*)(lds + L_QS + (t * QST + d0) * 2); qs[0] = o0; qs[1] = o1;
      LAS v4u* qw = (LAS v4u*)(lds + L_QW + (t * QST + d0) * 2); qw[0] = w0; qw[1] = w1; }
    __builtin_amdgcn_sched_barrier(0);
    conv16(F, 1, L_RK, t, d0, y);
    { const float sc = 0.08838834764831845f; v4u o0, o1;
      o0.x = pk2(y[0] * sc, y[1] * sc); o0.y = pk2(y[2] * sc, y[3] * sc); o0.z = pk2(y[4] * sc, y[5] * sc); o0.w = pk2(y[6] * sc, y[7] * sc);
      o1.x = pk2(y[8] * sc, y[9] * sc); o1.y = pk2(y[10] * sc, y[11] * sc); o1.z = pk2(y[12] * sc, y[13] * sc); o1.w = pk2(y[14] * sc, y[15] * sc);
      LAS v4u* ks = (LAS v4u*)(lds + L_KS + (t * QST + d0) * 2); ks[0] = o0; ks[1] = o1; } }
  __syncthreads();
  v4u cb[4][2];
  { const v4u* cs = (const v4u*)(F.ws + WS_CS) + (((size_t)bh * 33 + c) * 4 * 16) * 64;
#pragma unroll
    for (int I = 0; I < 4; ++I)
#pragma unroll
      for (int jj = 0; jj < 2; ++jj) cb[I][jj] = cs[(size_t)(I * 16 + 2 * w + jj) * 64 + lane]; }
  { const int si = w >> 1; const f32x4 as = *(const LAS f32x4*)(G + G_A + 16 * si + 4 * kq);
#pragma unroll
    for (int tt = 0; tt < 2; ++tt) { const int ti = 2 * (w & 1) + tt; f32x4 acc = {0.f, 0.f, 0.f, 0.f};
#pragma unroll
      for (int ks = 0; ks < 4; ++ks) { const bf16x8 af = *(const LAS bf16x8*)(lds + L_KS + ((16 * si + fr) * QST + 32 * ks + 8 * kq) * 2);
        const bf16x8 bfr = *(const LAS bf16x8*)(lds + L_QS + ((16 * ti + fr) * QST + 32 * ks + 8 * kq) * 2);
        acc = __builtin_amdgcn_mfma_f32_16x16x32_bf16(af, bfr, acc, 0, 0, 0); }
      const int t = 16 * ti + fr, s0 = 16 * si + 4 * kq; const float Mt = G[G_M + t];
      const float v0 = (s0 + 0 <= t) ? acc.x * __expf(as.x - Mt) : 0.f, v1 = (s0 + 1 <= t) ? acc.y * __expf(as.y - Mt) : 0.f;
      const float v2 = (s0 + 2 <= t) ? acc.z * __expf(as.z - Mt) : 0.f, v3 = (s0 + 3 <= t) ? acc.w * __expf(as.w - Mt) : 0.f;
      v2u o; o.x = pk2(v0, v1); o.y = pk2(v2, v3);
      *(LAS v2u*)(lds + L_SP + (t * TST + s0) * 2) = o; } }
  __syncthreads();
  if (w == 0) { const int t = lane; float qn = 0.f, rsum = 0.f;
#pragma unroll 4
    for (int q = 0; q < 16; ++q) { const v4u x = *(const LAS v4u*)(lds + L_QS + (t * QST + q * 8) * 2); const f32x4 n0 = *(const LAS f32x4*)(NV + q * 8), n1 = *(const LAS f32x4*)(NV + q * 8 + 4);
      qn += bflo(x.x) * n0.x + bfhi(x.x) * n0.y + bflo(x.y) * n0.z + bfhi(x.y) * n0.w + bflo(x.z) * n1.x + bfhi(x.z) * n1.y + bflo(x.w) * n1.z + bfhi(x.w) * n1.w; }
#pragma unroll
    for (int q = 0; q < 8; ++q) { const v4u x = *(const LAS v4u*)(lds + L_SP + (t * TST + q * 8) * 2); rsum += (bflo(x.x) + bfhi(x.x)) + (bflo(x.y) + bfhi(x.y)) + (bflo(x.z) + bfhi(x.z)) + (bflo(x.w) + bfhi(x.w)); }
    const float den = G[G_WI + t] * qn + rsum; G[G_DEN + t] = fmaxf(fabsf(den), G[G_EM + t]); }
  f32x4 acc[2][4];
#pragma unroll
  for (int jj = 0; jj < 2; ++jj)
#pragma unroll
    for (int ti = 0; ti < 4; ++ti) acc[jj][ti] = (f32x4){0.f, 0.f, 0.f, 0.f};
#pragma unroll
  for (int I = 0; I < 4; ++I) {
#pragma unroll
    for (int ti = 0; ti < 4; ++ti) { const LAS unsigned char* qp = lds + L_QW + ((16 * ti + fr) * QST + 32 * I + 4 * kq) * 2;
      const v2u a0 = *(const LAS v2u*)qp, a1 = *(const LAS v2u*)(qp + 32); const v4u av = {a0.x, a0.y, a1.x, a1.y};
      acc[0][ti] = __builtin_amdgcn_mfma_f32_16x16x32_bf16(__builtin_bit_cast(bf16x8, av), __builtin_bit_cast(bf16x8, cb[I][0]), acc[0][ti], 0, 0, 0);
      acc[1][ti] = __builtin_amdgcn_mfma_f32_16x16x32_bf16(__builtin_bit_cast(bf16x8, av), __builtin_bit_cast(bf16x8, cb[I][1]), acc[1][ti], 0, 0, 0); }
    __builtin_amdgcn_sched_barrier(0); }
#pragma unroll
  for (int ks = 0; ks < 2; ++ks) { const bf16x8 bv0 = *(const LAS bf16x8*)(lds + L_VT + ((32 * w + fr) * TST + 32 * ks + 8 * kq) * 2), bv1 = *(const LAS bf16x8*)(lds + L_VT + ((32 * w + 16 + fr) * TST + 32 * ks + 8 * kq) * 2);
#pragma unroll
    for (int ti = 0; ti < 4; ++ti) { const bf16x8 sf = *(const LAS bf16x8*)(lds + L_SP + ((16 * ti + fr) * TST + 32 * ks + 8 * kq) * 2);
      acc[0][ti] = __builtin_amdgcn_mfma_f32_16x16x32_bf16(sf, bv0, acc[0][ti], 0, 0, 0); acc[1][ti] = __builtin_amdgcn_mfma_f32_16x16x32_bf16(sf, bv1, acc[1][ti], 0, 0, 0); } }
  __syncthreads();
  LAS float* SSQ = (LAS float*)(lds + L_SSQ);
#pragma unroll
  for (int ti = 0; ti < 4; ++ti) { const f32x4 dn = *(const LAS f32x4*)(G + G_DEN + 16 * ti + 4 * kq);
    f32x4 s4;
#pragma unroll
    for (int r = 0; r < 4; ++r) { const float h0 = acc[0][ti][r] / dn[r], h1 = acc[1][ti][r] / dn[r]; acc[0][ti][r] = h0; acc[1][ti][r] = h1; s4[r] = h0 * h0 + h1 * h1; }
#pragma unroll
    for (int o = 1; o < 16; o <<= 1) { s4.x += __shfl_xor(s4.x, o); s4.y += __shfl_xor(s4.y, o); s4.z += __shfl_xor(s4.z, o); s4.w += __shfl_xor(s4.w, o); }
    if (fr == 0) { SSQ[(16 * ti + 4 * kq + 0) * 8 + w] = s4.x; SSQ[(16 * ti + 4 * kq + 1) * 8 + w] = s4.y; SSQ[(16 * ti + 4 * kq + 2) * 8 + w] = s4.z; SSQ[(16 * ti + 4 * kq + 3) * 8 + w] = s4.w; } }
  __syncthreads();
  LAS bf16* HT = (LAS bf16*)(lds + L_HT);
#pragma unroll
  for (int ti = 0; ti < 4; ++ti)
#pragma unroll
    for (int r = 0; r < 4; ++r) { const int t = 16 * ti + 4 * kq + r; const f32x4 p0 = *(const LAS f32x4*)(SSQ + t * 8), p1 = *(const LAS f32x4*)(SSQ + t * 8 + 4);
      const float rh = rsqrtf(((p0.x + p0.y) + (p0.z + p0.w) + (p1.x + p1.y) + (p1.z + p1.w)) * (1.0f / 256.f) + EPS);
      HT[t * 264 + 32 * w + fr] = (bf16)f2bf(acc[0][ti][r] * rh); HT[t * 264 + 32 * w + 16 + fr] = (bf16)f2bf(acc[1][ti][r] * rh); }
  __syncthreads();
  { const int t = tid >> 3, c0 = (tid & 7) * 32; const size_t R = (size_t)b * SEQ + 64 * (c - 1) + t;
    const bf16* mo = (const bf16*)(F.ws + WS_MO) + R * 1024 + h * 256 + c0; const float* og = a.in[IN_OUTG] + h * 256 + c0; bf16* A2 = (bf16*)(F.ws + WS_A2) + R * DM + 1024 + h * 256 + c0;
#pragma unroll
    for (int q = 0; q < 4; ++q) { const v4u hv = *(const LAS v4u*)(HT + t * 264 + c0 + q * 8); const v4u mv = *(const v4u*)(mo + q * 8); const f32x4 g0 = *(const f32x4*)(og + q * 8), g1 = *(const f32x4*)(og + q * 8 + 4);
      v4u o; o.x = pk2(bflo(hv.x) * g0.x * bflo(mv.x), bfhi(hv.x) * g0.y * bfhi(mv.x)); o.y = pk2(bflo(hv.y) * g0.z * bflo(mv.y), bfhi(hv.y) * g0.w * bfhi(mv.y));
      o.z = pk2(bflo(hv.z) * g1.x * bflo(mv.z), bfhi(hv.z) * g1.y * bfhi(mv.z)); o.w = pk2(bflo(hv.w) * g1.z * bflo(mv.w), bfhi(hv.w) * g1.w * bfhi(mv.w));
      *(v4u*)(A2 + q * 8) = o; } }
}
}
__device__ __forceinline__ void p3_combine(const Frame& F, const Args& a, int NA) {
  const float* PO = (const float*)(F.ws + WS_PO); const float* ML = (const float*)(F.ws + WS_ML);
  bf16* A2 = (bf16*)(F.ws + WS_A2);
  const float lam = *(const float*)(F.ws + WS_LAM);
  const float* subg = a.in[IN_SUBG];
  const int gw = blockIdx.x * NWAVES + F.wave, NGW = gridDim.x * NWAVES, lane = F.lane;
  const f32x4 sg = ((const f32x4*)subg)[lane];
  for (int R = gw; R < MROWS; R += NGW) {
    const int b = R >> 11, t = R & 2047, qb = t >> 8, rq = t & 255;
#pragma unroll 2
    for (int h = 0; h < 4; ++h) {
      f32x4 om[2];
#pragma unroll
      for (int m = 0; m < 2; ++m) {
        const int bhm = (b * 4 + h) * 2 + m, first = bhm * att::STEPS_BHM + att::qb_start(qb), last = first + 4 * qb + 4;
        const int cf = att::chunk_of(first, NA), np = att::chunk_of(last, NA) - cf + 1, slot0 = bhm * 16 + qb + cf - att::chunk_of(bhm * att::STEPS_BHM, NA);
        float mp[3], lp[3]; f32x4 op[3];
#pragma unroll
        for (int p = 0; p < 3; ++p) { if (p < np) { const int slot = slot0 + p; mp[p] = ML[(size_t)slot * 512 + rq * 2]; lp[p] = ML[(size_t)slot * 512 + rq * 2 + 1];
            op[p] = ((const f32x4*)(PO + ((size_t)slot * 256 + rq) * 256))[lane]; } else { mp[p] = -1e30f; lp[p] = 0.f; op[p] = (f32x4){0.f, 0.f, 0.f, 0.f}; } }
        const float M = fmaxf(mp[0], fmaxf(mp[1], mp[2]));
        float wsum = 0.f; f32x4 acc = (f32x4){0.f, 0.f, 0.f, 0.f};
#pragma unroll
        for (int p = 0; p < 3; ++p) { const float w = lp[p] * exp2f(mp[p] - M); wsum += w; acc += op[p] * w; }
        om[m] = acc * (1.0f / wsum);
      }
      const f32x4 o = om[0] - om[1] * lam;
      const float rs = rsqrtf(wave_sum((o.x * o.x + o.y * o.y) + (o.z * o.z + o.w * o.w)) * (1.0f / 256.f) + EPS) * 0.8f;
      v2u w; w.x = pk2(o.x * rs * sg.x, o.y * rs * sg.y); w.y = pk2(o.z * rs * sg.z, o.w * rs * sg.w);
      ((v2u*)(A2 + (size_t)R * DM + h * 256))[lane] = w;
    }
  }
}
struct EpiRes {
  static constexpr bool PERM = true, AFTER_DRAIN = false;
  const float* x; float* out; bf16* H1b; float* SSQ;
  __device__ __forceinline__ void operator()(const pg8::f32x4 (&acc)[2][2][4][2], const pg8::Unit& u, int wr, int wc, int fr, int fq) const {
    const int row0 = u.pm * 256 + wr * 64 + fr, col0 = u.pn * 256 + wc * 32 + 8 * fq;
#pragma unroll
    for (int ai = 0; ai < 2; ++ai)
#pragma unroll
      for (int m = 0; m < 4; ++m) { const size_t R = (size_t)(row0 + ai * 128 + m * 16); float s = 0.f;
#pragma unroll
        for (int bj = 0; bj < 2; ++bj) { const size_t off = R * DM + col0 + bj * 128;
          const f32x4 x0 = *(const f32x4*)(x + off), x1 = *(const f32x4*)(x + off + 4);
          const f32x4 v0 = acc[ai][bj][m][0] + x0, v1 = acc[ai][bj][m][1] + x1;
          v4u w; w.x = pk2(v0.x, v0.y); w.y = pk2(v0.z, v0.w); w.z = pk2(v1.x, v1.y); w.w = pk2(v1.z, v1.w);
          *(v4u*)(H1b + off) = w;
          s += (v0.x * v0.x + v0.y * v0.y) + (v0.z * v0.z + v0.w * v0.w) + (v1.x * v1.x + v1.y * v1.y) + (v1.z * v1.z + v1.w * v1.w); }
        s += __shfl_xor(s, 16); s += __shfl_xor(s, 32);
        if (fq == 0) SSQ[R * 32 + u.pn * 4 + wc] = s; }
  }
};
#ifndef PEER_U_FP8
#define PEER_U_FP8 0
#endif
typedef __bf16 bfv2 __attribute__((ext_vector_type(2)));
__device__ __forceinline__ void split_hl(const f32x4 a, const f32x4 b, bf16x8& hi, bf16x8& lo) {
  float v[8] = {a.x, a.y, a.z, a.w, b.x, b.y, b.z, b.w}; unsigned h[8], l[8];
#pragma unroll
  for (int i = 0; i < 8; ++i) { h[i] = f2bf(v[i]); l[i] = f2bf(v[i] - __builtin_bit_cast(float, h[i] << 16)); }
  v4u hv = {h[0] | (h[1] << 16), h[2] | (h[3] << 16), h[4] | (h[5] << 16), h[6] | (h[7] << 16)};
  v4u lv = {l[0] | (l[1] << 16), l[2] | (l[3] << 16), l[4] | (l[5] << 16), l[6] | (l[7] << 16)};
  hi = __builtin_bit_cast(bf16x8, hv); lo = __builtin_bit_cast(bf16x8, lv);
}
__device__ __forceinline__ void p0_w3t(const Frame& F, const Args& a) {
  const float* wq = a.in[IN_WQ]; const float* sk = a.in[IN_SUBK]; const float* g2 = a.in[IN_G2];
  bf16* W3t = (bf16*)(F.ws + WS_W3T);
  const int gw = blockIdx.x * NWAVES + F.wave, NGW = gridDim.x * NWAVES, lane = F.lane, fr = lane & 15, fq = lane >> 4;
  for (int task = gw; task < 128 * 16; task += NGW) {
    const int kt = task >> 4, hh = task & 15;
    bf16x8 ahi[4], alo[4];
    const float* ap = wq + (size_t)(kt * 16 + fr) * DM + hh * 128 + fq * 8;
#pragma unroll
    for (int s = 0; s < 4; ++s) split_hl(*(const f32x4*)(ap + 32 * s), *(const f32x4*)(ap + 32 * s + 4), ahi[s], alo[s]);
    const f32x4 gk = *(const f32x4*)(g2 + kt * 16 + fq * 4);
#pragma unroll 1
    for (int t2 = 0; t2 < 8; ++t2) {
      const float* bp = sk + (size_t)(hh * 128 + t2 * 16 + fr) * 128 + fq * 8;
      f32x4 acc = {0.f, 0.f, 0.f, 0.f};
#pragma unroll
      for (int s = 0; s < 4; ++s) { bf16x8 bhi, blo; split_hl(*(const f32x4*)(bp + 32 * s), *(const f32x4*)(bp + 32 * s + 4), bhi, blo);
        acc = __builtin_amdgcn_mfma_f32_16x16x32_bf16(ahi[s], bhi, acc, 0, 0, 0);
        acc = __builtin_amdgcn_mfma_f32_16x16x32_bf16(ahi[s], blo, acc, 0, 0, 0);
        acc = __builtin_amdgcn_mfma_f32_16x16x32_bf16(alo[s], bhi, acc, 0, 0, 0); }
      v2u o; o.x = pk2(acc.x * gk.x, acc.y * gk.y); o.y = pk2(acc.z * gk.z, acc.w * gk.w);
      *(v2u*)(W3t + (size_t)(hh * 128 + t2 * 16 + fr) * DM + kt * 16 + fq * 4) = o;
    }
  }
}
typedef float f32x2v __attribute__((ext_vector_type(2)));
__device__ __forceinline__ void p0_tables(const Frame& F, const Args& a) {
  const float* g2 = a.in[IN_G2];
  float* SCL = (float*)(F.ws + WS_SCL);
  const int gw = blockIdx.x * NWAVES + F.wave, NGW = gridDim.x * NWAVES, lane = F.lane;
  f32x4 gl[8];
#pragma unroll
  for (int q = 0; q < 8; ++q) gl[q] = *(const f32x4*)(g2 + lane * 32 + q * 4);
  f32x4 xn[8];
  { const int row = gw; if (row < 2 * 16384) { const float* src = a.in[row >= 16384 ? IN_V : IN_U] + (size_t)(row & 16383) * DM + lane * 32;
#pragma unroll
      for (int q = 0; q < 8; ++q) xn[q] = *(const f32x4*)(src + q * 4); } }
  for (int row = gw; row < 2 * 16384; row += NGW) {
    const bool isv = row >= 16384; const int e = row & 16383;
    f32x4 x[8];
#pragma unroll
    for (int q = 0; q < 8; ++q) x[q] = xn[q];
    { const int rn = row + NGW; if (rn < 2 * 16384) { const float* src = a.in[rn >= 16384 ? IN_V : IN_U] + (size_t)(rn & 16383) * DM + lane * 32;
#pragma unroll
        for (int q = 0; q < 8; ++q) xn[q] = *(const f32x4*)(src + q * 4); } }
    float amax = 0.f;
#pragma unroll
    for (int q = 0; q < 8; ++q) { if (!isv) x[q] = x[q] * gl[q]; amax = fmaxf(amax, fmaxf(fmaxf(fabsf(x[q].x), fabsf(x[q].y)), fmaxf(fabsf(x[q].z), fabsf(x[q].w)))); }
#pragma unroll
    for (int o = 1; o < 64; o <<= 1) amax = fmaxf(amax, __shfl_xor(amax, o));
    const float sc = amax > 0.f ? 6.0f / amax : 1.0f;
    v4u w;
#pragma unroll
    for (int d = 0; d < 4; ++d) { unsigned pk = 0u;
      pk = __builtin_amdgcn_cvt_scalef32_pk_fp4_f32(pk, x[2 * d].x * sc, x[2 * d].y * sc, 1.0f, 0); pk = __builtin_amdgcn_cvt_scalef32_pk_fp4_f32(pk, x[2 * d].z * sc, x[2 * d].w * sc, 1.0f, 1);
      pk = __builtin_amdgcn_cvt_scalef32_pk_fp4_f32(pk, x[2 * d + 1].x * sc, x[2 * d + 1].y * sc, 1.0f, 2); pk = __builtin_amdgcn_cvt_scalef32_pk_fp4_f32(pk, x[2 * d + 1].z * sc, x[2 * d + 1].w * sc, 1.0f, 3);
      w[d] = pk; }
    *(v4u*)(F.ws + (isv ? WS_VB8 : WS_UB) + (size_t)e * 1024 + lane * 16) = w;
    if (lane == 0) SCL[row] = 1.0f / sc;
  }
}
struct EpiScore {
  static constexpr bool PERM = true, AFTER_DRAIN = false;
  float* S; const LAS float* rs;
  __device__ __forceinline__ void operator()(const pg8::f32x4 (&acc)[2][2][4][2], const pg8::Unit& u, int wr, int wc, int fr, int fq) const {
    const int rl0 = wr * 64 + fr, keyb = wc * 32 + 8 * fq;
#pragma unroll
    for (int ai = 0; ai < 2; ++ai)
#pragma unroll
      for (int m = 0; m < 4; ++m) { const int rl = rl0 + ai * 128 + m * 16; const float r = rs[rl]; const int row = u.pm * 256 + rl;
#pragma unroll
        for (int bj = 0; bj < 2; ++bj) { float* d = S + ((size_t)((row >> 5) * 16 + u.pn * 2 + bj) * 128 + keyb) * 32 + (row & 31);
          const pg8::f32x4 v0 = acc[ai][bj][m][0] * r, v1 = acc[ai][bj][m][1] * r;
          d[0] = v0[0]; d[32] = v0[1]; d[64] = v0[2]; d[96] = v0[3]; d[128] = v1[0]; d[160] = v1[1]; d[192] = v1[2]; d[224] = v1[3]; } }
  }
};

__device__ __forceinline__ unsigned fkey(float f) { const unsigned b = __builtin_bit_cast(unsigned, f); return b ^ ((b >> 31) ? 0xFFFFFFFFu : 0x80000000u); }
template <int NV, int K> __device__ __forceinline__ void wave_topk(const unsigned (&u)[NV], bool (&sel)[NV], int lane) {
  unsigned prefix = 0u; int cge = NV * 64;
#pragma unroll 1
  for (int bit = 31; bit >= 0 && cge != K; --bit) {
    const unsigned cand = prefix | (1u << bit); int c = 0;
#pragma unroll
    for (int i = 0; i < NV; ++i) c += __builtin_popcountll(__ballot(u[i] >= cand));
    if (c >= K) { prefix = cand; cge = c; }
  }
  int cgt = 0;
#pragma unroll
  for (int i = 0; i < NV; ++i) cgt += __builtin_popcountll(__ballot(u[i] > prefix));
  int need = K - cgt;
  const unsigned long long lm = (1ull << lane) - 1ull;
#pragma unroll
  for (int i = 0; i < NV; ++i) { const unsigned long long eq = __ballot(u[i] == prefix); const int before = __builtin_popcountll(eq & lm);
    sel[i] = (u[i] > prefix) || (u[i] == prefix && before < need); const int ne = __builtin_popcountll(eq); need = need > ne ? need - ne : 0; }
}
template <int NG, int NV, int K> __device__ __forceinline__ void wave_topk_multi(const unsigned (&u)[NG][NV], bool (&sel)[NG][NV], int lane) {
  unsigned prefix[NG]; int cge[NG];
#pragma unroll
  for (int g = 0; g < NG; ++g) { prefix[g] = 0u; cge[g] = NV * 64; }
#pragma unroll 1
  for (int bit = 31; bit >= 0; --bit) {
    bool done = true;
#pragma unroll
    for (int g = 0; g < NG; ++g) done = done && (cge[g] == K);
    if (done) break;
#pragma unroll
    for (int g = 0; g < NG; ++g) { const unsigned cand = prefix[g] | (1u << bit); int c = 0;
#pragma unroll
      for (int i = 0; i < NV; ++i) c += __builtin_popcountll(__ballot(u[g][i] >= cand));
      if (cge[g] != K && c >= K) { prefix[g] = cand; cge[g] = c; } }
  }
  const unsigned long long lm = (1ull << lane) - 1ull;
#pragma unroll
  for (int g = 0; g < NG; ++g) { int cgt = 0;
#pragma unroll
    for (int i = 0; i < NV; ++i) cgt += __builtin_popcountll(__ballot(u[g][i] > prefix[g]));
    int need = K - cgt;
#pragma unroll
    for (int i = 0; i < NV; ++i) { const unsigned long long eq = __ballot(u[g][i] == prefix[g]); const int before = __builtin_popcountll(eq & lm);
      sel[g][i] = (u[g][i] > prefix[g]) || (u[g][i] == prefix[g] && before < need); const int ne = __builtin_popcountll(eq); need = need > ne ? need - ne : 0; } }
}
__device__ __forceinline__ float gelu_erf(float v) {
  const float av = fabsf(v), t = __builtin_amdgcn_rcpf(1.0f + 0.2316418882f * av);
  float q = t * 0.5307027145f - 0.7265760135f; q = q * t + 0.7107068705f; q = q * t - 0.142248368f; q = q * t + 0.127414796f; q = q * t;
  const float tail = q * __builtin_amdgcn_exp2f(v * v * -0.72134752044f);
  return v < 0.f ? v * tail : v - v * tail;
}

#ifndef ROUTE_REPS
#define ROUTE_REPS 1
#endif
__device__ __forceinline__ void ins16(float (&t)[16], float x) {
#pragma unroll
  for (int i = 15; i >= 1; --i) t[i] = __builtin_amdgcn_fmed3f(t[i - 1], t[i], x);
  t[0] = fmaxf(t[0], x);
}
__device__ __forceinline__ void p6_peer(const Frame& F, const Args& a, float* dst_base) {
  const float* S2 = (const float*)(F.ws + WS_S); const float* SSQ = (const float*)(F.ws + WS_SSQ); const bf16* H1b = (const bf16*)(F.ws + WS_H1B);
  int lane = F.lane, wv = F.wave, tid = F.tid; asm volatile("" : "+v"(lane), "+s"(wv), "+v"(tid));
  LAS unsigned short* EID = (LAS unsigned short*)F.lds; LAS float* EGT = (LAS float*)(F.lds + 8192);
  LAS int* eid = (LAS int*)(F.lds + 24576 + wv * 1536); LAS float* egt = (LAS float*)(eid + 128); LAS float* esu = (LAS float*)(eid + 256);
  LAS unsigned char* RB = F.lds + 36864 + wv * 14336;
  LAS float* L1 = (LAS float*)(F.lds + 36864);
  for (int tb = blockIdx.x; tb < MROWS / 32; tb += gridDim.x) {
    __syncthreads();
    {
      const int g = tid >> 5, tl = tid & 31; const float* src = S2 + ((size_t)(tb * 16 + g) * 128) * 32 + tl;
      float t[16];
#pragma unroll
      for (int i = 0; i < 16; ++i) t[i] = -INFINITY;
#pragma unroll 32
      for (int k = 0; k < 128; ++k) { const float x = src[k * 32]; ins16(t, __builtin_bit_cast(float, (__builtin_bit_cast(unsigned, x) & ~0x7Fu) | (unsigned)(127 - k))); }
#pragma unroll
      for (int i = 0; i < 16; ++i) L1[(g * 16 + i) * 32 + tl] = t[i];
    }
    __syncthreads();
    if (tid < 256) {
      const int h8 = tid >> 5, tl = tid & 31; const LAS float* LA = L1 + ((2 * h8) * 16) * 32 + tl; const LAS float* LB = L1 + ((2 * h8 + 1) * 16) * 32 + tl;
      float A[16], B[16], t[16];
#pragma unroll
      for (int i = 0; i < 16; ++i) { A[i] = LA[i * 32]; B[i] = LB[i * 32]; t[i] = -INFINITY; }
#pragma unroll
      for (int i = 0; i < 16; ++i)
#pragma unroll
        for (int j = 0; j < 16; ++j) if ((i + 1) * (j + 1) <= 16) { const float c = A[i] + B[j];
            ins16(t, __builtin_bit_cast(float, (__builtin_bit_cast(unsigned, c) & ~0xFFu) | (unsigned)(255 - (i * 16 + j)))); }
      float ev[16], es = 0.f;
#pragma unroll
      for (int r = 0; r < 16; ++r) { ev[r] = __expf(t[r] - t[0]); es += ev[r]; }
      const float inv = 1.0f / es;
#pragma unroll
      for (int r = 0; r < 16; ++r) { const unsigned flat = 255u - (__builtin_bit_cast(unsigned, t[r]) & 0xFFu), ii = flat >> 4, jj = flat & 15u;
        const unsigned ka = 127u - (__builtin_bit_cast(unsigned, LA[ii * 32]) & 0x7Fu), kb = 127u - (__builtin_bit_cast(unsigned, LB[jj * 32]) & 0x7Fu);
        EID[tl * 128 + h8 * 16 + r] = (unsigned short)(ka * 128u + kb); EGT[tl * 128 + h8 * 16 + r] = ev[r] * inv; }
    }
    __syncthreads();
#pragma unroll 1
    for (int tt = 0; tt < 4; ++tt) {
    const int tl = wv * 4 + tt, tok = tb * 32 + tl;
    const float rs = rsqrtf(wave_sum_dpp(lane < 32 ? SSQ[(size_t)tok * 32 + lane] : 0.f) * (1.0f / DM) + EPS);
    { const float* SCL = (const float*)(F.ws + WS_SCL);
#pragma unroll
      for (int i = 0; i < 2; ++i) { const int e = lane + 64 * i, idq = EID[tl * 128 + e]; eid[e] = idq; esu[e] = SCL[idq]; egt[e] = EGT[tl * 128 + e] * SCL[16384 + idq]; } }
    unsigned xw[16];
    { const v4u* xp = (const v4u*)(H1b + (size_t)tok * DM + (size_t)lane * 32);
#pragma unroll
      for (int q = 0; q < 4; ++q) { const v4u x0 = xp[q]; xw[4 * q] = x0.x; xw[4 * q + 1] = x0.y; xw[4 * q + 2] = x0.z; xw[4 * q + 3] = x0.w; } }
    float y[32];
#pragma unroll
    for (int i = 0; i < 32; ++i) y[i] = 0.f;
    asm volatile("s_waitcnt vmcnt(0) lgkmcnt(0)" ::: "memory");
    const unsigned char* U8 = F.ws + WS_UB; const unsigned char* V8 = F.ws + WS_VB8;
#define PG_ISSUE(E) do { const int idq_ = __builtin_amdgcn_readfirstlane(eid[(E)]); LAS unsigned char* sl_ = RB + ((E) % 7) * 2048; \
      __builtin_amdgcn_global_load_lds((const unsigned*)(U8 + (size_t)idq_ * 1024 + lane * 16), (LAS unsigned*)sl_, 16, 0, 0); \
      __builtin_amdgcn_global_load_lds((const unsigned*)(V8 + (size_t)idq_ * 1024 + lane * 16), (LAS unsigned*)(sl_ + 1024), 16, 0, 0); } while (0)
#define PG_DOT(UW, DACC) do { float da_ = 0.f, db_ = 0.f; _Pragma("unroll") for (int dd = 0; dd < 4; ++dd) { const unsigned wa = UW[dd]; \
          da_ = __builtin_amdgcn_fdot2_f32_bf16(__builtin_bit_cast(bfv2, xw[4 * dd + 0]), __builtin_amdgcn_cvt_scalef32_pk_bf16_fp4(wa, 1.0f, 0), da_, false); \
          db_ = __builtin_amdgcn_fdot2_f32_bf16(__builtin_bit_cast(bfv2, xw[4 * dd + 1]), __builtin_amdgcn_cvt_scalef32_pk_bf16_fp4(wa, 1.0f, 1), db_, false); \
          da_ = __builtin_amdgcn_fdot2_f32_bf16(__builtin_bit_cast(bfv2, xw[4 * dd + 2]), __builtin_amdgcn_cvt_scalef32_pk_bf16_fp4(wa, 1.0f, 2), da_, false); \
          db_ = __builtin_amdgcn_fdot2_f32_bf16(__builtin_bit_cast(bfv2, xw[4 * dd + 3]), __builtin_amdgcn_cvt_scalef32_pk_bf16_fp4(wa, 1.0f, 3), db_, false); } DACC = da_ + db_; } while (0)
#define PG_AXPY(VW, CF) do { _Pragma("unroll") for (int dd = 0; dd < 4; ++dd) { const unsigned wa = VW[dd]; \
          { const f32x2v v2 = __builtin_amdgcn_cvt_scalef32_pk_f32_fp4(wa, 1.0f, 0); y[8 * dd + 0] += CF * v2.x; y[8 * dd + 1] += CF * v2.y; } \
          { const f32x2v v2 = __builtin_amdgcn_cvt_scalef32_pk_f32_fp4(wa, 1.0f, 1); y[8 * dd + 2] += CF * v2.x; y[8 * dd + 3] += CF * v2.y; } \
          { const f32x2v v2 = __builtin_amdgcn_cvt_scalef32_pk_f32_fp4(wa, 1.0f, 2); y[8 * dd + 4] += CF * v2.x; y[8 * dd + 5] += CF * v2.y; } \
          { const f32x2v v2 = __builtin_amdgcn_cvt_scalef32_pk_f32_fp4(wa, 1.0f, 3); y[8 * dd + 6] += CF * v2.x; y[8 * dd + 7] += CF * v2.y; } } } while (0)
#define PG_STAGE1(E, CFV, VROW) do { const LAS unsigned char* s0_ = RB + ((E) % 7) * 2048 + lane * 16; \
      const v4u u0 = *(const LAS v4u*)s0_; VROW = *(const LAS v4u*)(s0_ + 1024); \
      float d0 = 0.f; PG_DOT(u0, d0); d0 = wave_sum_dpp(d0); \
      CFV = gelu_erf(d0 * (rs * esu[(E)])) * egt[(E)]; } while (0)
#pragma unroll
    for (int e = 0; e < 6; ++e) PG_ISSUE(e);
    float cfa; v4u vra;
    asm volatile("s_waitcnt vmcnt(10)" ::: "memory");
    PG_STAGE1(0, cfa, vra);
#pragma unroll 1
    for (int e = 0; e < 122; ++e) {
      PG_ISSUE(e + 6);
      asm volatile("s_waitcnt vmcnt(10)" ::: "memory");
      float cfb; v4u vrb;
      PG_STAGE1(e + 1, cfb, vrb);
      PG_AXPY(vra, cfa);
      cfa = cfb; vra = vrb;
      asm volatile("" ::: "memory");
    }
    asm volatile("s_waitcnt vmcnt(0)" ::: "memory");
#pragma unroll 1
    for (int e = 122; e < 127; ++e) { float cfb; v4u vrb; PG_STAGE1(e + 1, cfb, vrb); PG_AXPY(vra, cfa); cfa = cfb; vra = vrb; }
    PG_AXPY(vra, cfa);
    asm volatile("s_waitcnt lgkmcnt(0)" ::: "memory");
#undef PG_STAGE1
#undef PG_ISSUE
#undef PG_DOT
#undef PG_AXPY
    float* drow = dst_base + (size_t)tok * DM;
#pragma unroll
    for (int q = 0; q < 8; ++q) { const size_t off = (size_t)lane * 32 + q * 4; f32x4 hv;
      hv.x = bflo(xw[2 * q]) + y[4 * q]; hv.y = bfhi(xw[2 * q]) + y[4 * q + 1]; hv.z = bflo(xw[2 * q + 1]) + y[4 * q + 2]; hv.w = bfhi(xw[2 * q + 1]) + y[4 * q + 3]; *(f32x4*)(drow + off) = hv; }
    }
  }
}
constexpr int MISC_LDS = LDS_BYTES - 256;
__global__ void __launch_bounds__(NTHR, 2) mk_fwd(Args args) {
  extern __shared__ __attribute__((aligned(16))) unsigned char lds_raw[];
  Frame F; F.lds = (LAS unsigned char*)lds_raw; F.ws = args.ws; F.tid = threadIdx.x; F.lane = F.tid & 63; F.wave = __builtin_amdgcn_readfirstlane(F.tid >> 6);
  const int lo = args.ph_lo, hi = args.ph_hi, G = (int)gridDim.x, bx = (int)blockIdx.x;
  volatile LAS unsigned* misc = (volatile LAS unsigned*)(F.lds + MISC_LDS);
  if (F.tid < 16) misc[F.tid] = 0u;
  __syncthreads();
  XcdBarrier bar = xcd_barrier_post((unsigned*)(F.ws + WS_CTL) + CW_BAR, misc);
#define IN(k) (lo <= (k) && (k) < hi)
#define SEAM(k) do { if (IN(k) && IN((k) + 1)) xcd_barrier(bar); } while (0)
#define PHASE_FRAME(Fp) Frame Fp = F; asm volatile("" : "+v"(Fp.tid), "+v"(Fp.lane))
  const int NA = G;
  if (IN(0)) { PHASE_FRAME(F0);
    p0_lam(F0, args);
    p0_zero_vpad(F0);
    p0_metaproj(F0, args);
    p0_rows(F0, args);
    p0_transpose(F0, args.in[IN_WIN], DPROJ, NPROJ, (bf16*)(F.ws + WS_W1T));
    p0_transpose(F0, args.in[IN_WOUT], DM, DM, (bf16*)(F.ws + WS_W2T));
    p0_w3t(F0, args);
    p0_tables(F0, args);
  }
  SEAM(0);
  if (IN(1)) { PHASE_FRAME(F1);
    p1_meta_finalize(F1, args);
    pg8::Gemm g{(const pg8::bf16_t*)(F.ws + WS_XN), (const pg8::bf16_t*)(F.ws + WS_W1T), MROWS, NPROJ, DM};
    pg8::StaticOrder S; S.init(MROWS, NPROJ, G, bx);
    EpiProj E{(bf16*)(F.ws + WS_Q), (bf16*)(F.ws + WS_KP), (bf16*)(F.ws + WS_VP), (bf16*)(F.ws + WS_MQ), (bf16*)(F.ws + WS_MK), (bf16*)(F.ws + WS_MV), (bf16*)(F.ws + WS_MO),
              args.in[IN_QNG], args.in[IN_KNG], (LAS float*)(F.lds + XCH_OFF)};
    pg8::gemm_phase<EpiProj, pg8::StaticOrder, true, true>(F.lds + RING_OFF, g, S, E);
  }
  SEAM(1);
  if (IN(2)) {
    att::phase(F, (G % 8 == 0) ? (bx & 7) * (G >> 3) + (bx >> 3) : bx, NA);
    for (int task = bx; task < 512; task += G) ml::taskA(F, args, task);
  }
  SEAM(2);
  if (IN(3)) { PHASE_FRAME(F3); ml::scanB(F3); p3_combine(F3, args, NA); }
  SEAM(3);
  if (IN(4)) {
    PHASE_FRAME(F4);
    for (int task = bx; task < 512; task += G) ml::taskC(F4, args, task);
  }
  SEAM(4);
  if (IN(5)) {
    pg8::Gemm g{(const pg8::bf16_t*)(F.ws + WS_A2), (const pg8::bf16_t*)(F.ws + WS_W2T), MROWS, DM, DM};
    pg8::StaticOrder S; S.init(MROWS, DM, G, bx);
    EpiRes E{args.in[IN_X], args.out, (bf16*)(F.ws + WS_H1B), (float*)(F.ws + WS_SSQ)};
    pg8::gemm_phase<EpiRes, pg8::StaticOrder, true, true>(F.lds + RING_OFF, g, S, E);
  }
  SEAM(5);
  if (IN(6)) {
    pg8::Gemm g{(const pg8::bf16_t*)(F.ws + WS_H1B), (const pg8::bf16_t*)(F.ws + WS_W3T), MROWS, DM, DM};
    pg8::StaticOrder S; S.init(MROWS, DM, G, bx);
    LAS float* rst = (LAS float*)(F.lds + XCH_OFF);
    { pg8::Unit u0; if (S.next(0, u0)) { if (F.tid < 256) { const float* sp = (const float*)(F.ws + WS_SSQ) + ((size_t)u0.pm * 256 + F.tid) * 32; float s = 0.f;
#pragma unroll
          for (int i = 0; i < 8; ++i) { const f32x4 v = ((const f32x4*)sp)[i]; s += (v.x + v.y) + (v.z + v.w); }
          rst[F.tid] = rsqrtf(s * (1.0f / DM) + EPS); } } }
    __syncthreads();
    EpiScore E{(float*)(F.ws + WS_S), rst};
    pg8::gemm_phase<EpiScore, pg8::StaticOrder, true, true>(F.lds + RING_OFF, g, S, E);
  }
  SEAM(6);
  if (IN(7)) { PHASE_FRAME(F7); p6_peer(F7, args, args.out); }
#undef IN
#undef SEAM
}
extern "C" void kernel_launch(void* const* d_in, const int* in_sizes, int n_in, void* d_out, int out_size, void* d_ws, size_t ws_size, hipStream_t stream) {
  static int grid = 0;
  if (grid == 0) {
    int dev = 0, cus = 0, per_cu = 0;
    if (hipGetDevice(&dev) != hipSuccess || hipDeviceGetAttribute(&cus, hipDeviceAttributeMultiprocessorCount, dev) != hipSuccess) { fprintf(stderr, "device query failed\n"); grid = -1; return; }
    if (hipFuncSetAttribute((const void*)mk_fwd, hipFuncAttributeMaxDynamicSharedMemorySize, LDS_BYTES) != hipSuccess) { fprintf(stderr, "hipFuncSetAttribute failed\n"); grid = -1; return; }
    if (hipOccupancyMaxActiveBlocksPerMultiprocessor(&per_cu, (const void*)mk_fwd, NTHR, LDS_BYTES) != hipSuccess || per_cu < 1) { fprintf(stderr, "occupancy query says %d workgroups per CU: not launching\n", per_cu); (void)hipGetLastError(); grid = -1; return; }
    (void)hipGetLastError();
    grid = cus;
    if (n_in != 22 || ws_size < (size_t)512 * MiB || out_size != MROWS * DM) { fprintf(stderr, "unexpected shapes: n_in %d out %d ws %zu\n", n_in, out_size, ws_size); grid = -1; return; }
  }
  if (grid < 0) return;
  unsigned char* ws = (unsigned char*)d_ws;
  if (hipMemsetAsync(ws + WS_CTL, 0, CTL_ZERO_BYTES, stream) != hipSuccess) { fprintf(stderr, "memset failed\n"); return; }
  Args a{};
  for (int i = 0; i < 22; ++i) a.in[i] = (const float*)d_in[i];
  a.out = (float*)d_out; a.ws = ws; a.na = 0; a.pad = 0;
  a.ph_lo = 0; a.ph_hi = 8;
  hipLaunchKernelGGL(mk_fwd, dim3(grid), dim3(NTHR), LDS_BYTES, stream, a);
}
```

```cpp
#include <hip/hip_runtime.h>
#include <cstdio>
#include <cstdint>
#include <math.h>
namespace pg8 {
#define PG8_LAS __attribute__((address_space(3)))
typedef unsigned short bf16_t;
typedef short bf16x8 __attribute__((ext_vector_type(8)));
typedef float f32x4 __attribute__((ext_vector_type(4)));
typedef unsigned u32x4 __attribute__((ext_vector_type(4)));
constexpr int BM = 256, BK = 64, HALF = 128, HTB = HALF * BK * 2  , STAGE_BYTES = 8 * HTB, NXCD = 8, WGM = 8;

__host__ __device__ __forceinline__ int lds_byte(int r, int c) { const int st = (r >> 4) * 2 + (c >> 5), rr = r & 15, cc = c & 31, ob = rr * 64 + cc * 2; return st * 1024 + (ob ^ (((ob >> 9) & 1) << 5)); }
__host__ __device__ __forceinline__ void stage_rc(int b, int& R, int& C) { const int st = b / 1024, sb = b % 1024, swz = sb ^ (((sb >> 9) & 1) << 5); R = (st >> 1) * 16 + swz / 64; C = (st & 1) * 32 + (swz % 64) / 2; }
__host__ __device__ __forceinline__ int perm32(int rho) { const int n = rho >> 4, i = rho & 15; return 8 * (i >> 2) + 4 * n + (i & 3); }

struct Unit { int pm, pn; };
struct Gemm { const bf16_t* A; const bf16_t* Bt; int M, N, K; };

struct StaticOrder {
    int nM, nN, nwg, G, c;
    __host__ __device__ void init(int M, int N, int G_, int c_) { nM = M / BM; nN = N / BM; nwg = nM * nN; G = G_; c = c_; }
    __host__ __device__ bool next(int i, Unit& u) const {
        const long L = (long)i * G + c; if (L >= nwg) return false;
        int wgid = (int)L; { const int q = nwg / NXCD, r = nwg % NXCD, xcd = wgid % NXCD, off = wgid / NXCD; wgid = (xcd < r ? xcd * (q + 1) : r * (q + 1) + (xcd - r) * q) + off; }
        const int nig = WGM * nN, gid = wgid / nig, fm = gid * WGM, gsz = (nM - fm) < WGM ? (nM - fm) : WGM;
        u.pm = fm + ((wgid % nig) % gsz); u.pn = (wgid % nig) / gsz; return true;
    }
    __device__ __forceinline__ void a_ready(const Unit&) const {}
    __device__ __forceinline__ void done(const Unit&) const {}
};

__device__ __forceinline__ unsigned cvt_pk_bf16(float lo, float hi) { unsigned r; asm volatile("v_cvt_pk_bf16_f32 %0, %1, %2" : "=v"(r) : "v"(lo), "v"(hi)); return r; }
typedef float f32x2 __attribute__((ext_vector_type(2)));
template <class Epi, class Sched, bool ALIGN_EPI = false, bool SP2 = false>
__device__ __forceinline__ void gemm_phase(PG8_LAS unsigned char* lds, const Gemm g, const Sched& S, const Epi& E) {
    int tid_ = threadIdx.x; asm volatile("" : "+v"(tid_));
    const int tid = tid_, wid = __builtin_amdgcn_readfirstlane(tid >> 6), lane = tid & 63, wr = wid >> 2, wc = wid & 3, fr = lane & 15, fq = lane >> 4;
    const int K = g.K, nt = K / BK;
    unsigned voffA[2], voffB[2];
#pragma unroll
    for (int i = 0; i < 2; ++i) { int R, C; stage_rc(tid * 16 + i * 8192, R, C); const int Rb = Epi::PERM ? ((R & ~31) + perm32(R & 31)) : R;
        voffA[i] = (unsigned)(R * K + C) * 2u; voffB[i] = (unsigned)(Rb * K + C) * 2u; }
    const size_t kstep = (size_t)(BK * 2);
    const size_t hstep = (size_t)HALF * K * 2;
    const size_t tstep = 2 * hstep;
    const unsigned ldsw = (unsigned)wid * 1024u;
    const int aoff = lds_byte(wr * 64 + fr, fq * 8), boff = lds_byte(wc * 32 + fr, fq * 8);
#define PG8_SA(b, h) (((b) * 2 + (h)) * HTB)
#define PG8_SB(b, h) ((4 + (b) * 2 + (h)) * HTB)
#define PG8_STAGE(bufoff, gbase, voff) do { _Pragma("unroll") for (int _i = 0; _i < 2; ++_i) \
        __builtin_amdgcn_global_load_lds((const unsigned*)((const char*)(gbase) + (voff)[_i]), (PG8_LAS unsigned*)(lds + (bufoff) + ldsw + _i * 8192), 16, 0, 0); } while (0)
#define PG8_LDA(dst, b, h) do { _Pragma("unroll") for (int m = 0; m < 4; ++m) _Pragma("unroll") for (int k = 0; k < 2; ++k) dst[m][k] = *(const PG8_LAS bf16x8*)(lds + PG8_SA(b, h) + aoff + m * 2048 + k * 1024); } while (0)
#define PG8_LDB(dst, b, h) do { _Pragma("unroll") for (int n = 0; n < 2; ++n) _Pragma("unroll") for (int k = 0; k < 2; ++k) dst[n][k] = *(const PG8_LAS bf16x8*)(lds + PG8_SB(b, h) + boff + n * 2048 + k * 1024); } while (0)
#define PG8_MMA(ai, bj, At, Bt) do { __builtin_amdgcn_s_setprio(1); _Pragma("unroll") for (int m = 0; m < 4; ++m) _Pragma("unroll") for (int n = 0; n < 2; ++n) _Pragma("unroll") for (int k = 0; k < 2; ++k) \
        acc[ai][bj][m][n] = __builtin_amdgcn_mfma_f32_16x16x32_bf16(Bt[n][k], At[m][k], acc[ai][bj][m][n], 0, 0, 0); __builtin_amdgcn_s_setprio(0); } while (0)
#define PG8_WAIT_V(n) asm volatile("s_waitcnt vmcnt(" #n ")" ::: "memory")
#define PG8_WAIT_L(n) asm volatile("s_waitcnt lgkmcnt(" #n ")" ::: "memory")
#define PG8_BAR __builtin_amdgcn_s_barrier()
#define PG8_SCHED __builtin_amdgcn_sched_barrier(0)
    Unit cur, nxt; int ui = 0;
    if (!S.next(0, cur)) return;
    f32x4 acc[2][2][4][2];
#pragma unroll
    for (int a = 0; a < 2; ++a)
#pragma unroll
        for (int b = 0; b < 2; ++b)
#pragma unroll
            for (int m = 0; m < 4; ++m)
#pragma unroll
                for (int n = 0; n < 2; ++n) acc[a][b][m][n] = (f32x4){0.f, 0.f, 0.f, 0.f};
    bf16x8 At[4][2], B0[2][2], B1[2][2];
    const char* cA = (const char*)g.A + (size_t)cur.pm * tstep; const char* cB = (const char*)g.Bt + (size_t)cur.pn * tstep;
    S.a_ready(cur);
    if constexpr (SP2) {
        PG8_STAGE(PG8_SB(0, 0), cB, voffB); PG8_STAGE(PG8_SB(0, 1), cB + hstep, voffB); PG8_STAGE(PG8_SA(0, 0), cA, voffA); PG8_STAGE(PG8_SA(0, 1), cA + hstep, voffA);
        if (wr == 1) PG8_BAR;
        PG8_WAIT_V(2); PG8_BAR;
        PG8_STAGE(PG8_SB(1, 0), cB + kstep, voffB); PG8_STAGE(PG8_SA(1, 0), cA + kstep, voffA); PG8_STAGE(PG8_SB(1, 1), cB + hstep + kstep, voffB);
        PG8_WAIT_V(6); PG8_BAR;
    } else {
        PG8_STAGE(PG8_SB(0, 0), cB, voffB); PG8_STAGE(PG8_SA(0, 0), cA, voffA); PG8_STAGE(PG8_SB(0, 1), cB + hstep, voffB); PG8_STAGE(PG8_SA(0, 1), cA + hstep, voffA);
        if (wr == 1) PG8_BAR;
        PG8_WAIT_V(4); PG8_BAR;
        PG8_STAGE(PG8_SB(1, 0), cB + kstep, voffB); PG8_STAGE(PG8_SA(1, 0), cA + kstep, voffA); PG8_STAGE(PG8_SB(1, 1), cB + hstep + kstep, voffB);
        PG8_WAIT_V(6); PG8_BAR;
    }
    for (;;) {
        const bool has_next = S.next(ui + 1, nxt);
        const char* nA = has_next ? (const char*)g.A + (size_t)nxt.pm * tstep : cA; const char* nB = has_next ? (const char*)g.Bt + (size_t)nxt.pn * tstep : cB;
        for (int t = 0; t < nt; t += 2) {
            const bool last = (t == nt - 2);
            const char* a1 = cA + (size_t)(t + 1) * kstep;
            const char* a2 = last ? nA : cA + (size_t)(t + 2) * kstep; const char* b2 = last ? nB : cB + (size_t)(t + 2) * kstep;
            const char* a3 = a2 + kstep; const char* b3 = b2 + kstep;
            if (last && has_next) S.a_ready(nxt);
            if constexpr (SP2) {
            PG8_LDB(B0, 0, 0); PG8_LDB(B1, 0, 1); PG8_SCHED; PG8_LDA(At, 0, 0); PG8_STAGE(PG8_SA(1, 1), a1 + hstep, voffA);
            PG8_WAIT_V(8); PG8_WAIT_L(0); PG8_BAR; PG8_MMA(0, 0, At, B0); PG8_MMA(0, 1, At, B1); PG8_BAR; PG8_SCHED;
            PG8_LDA(At, 0, 1); PG8_STAGE(PG8_SB(0, 0), b2, voffB); PG8_STAGE(PG8_SB(0, 1), b2 + hstep, voffB); PG8_STAGE(PG8_SA(0, 0), a2, voffA);
            PG8_WAIT_V(8); PG8_WAIT_L(0); PG8_BAR; PG8_MMA(1, 0, At, B0); PG8_MMA(1, 1, At, B1); PG8_BAR; PG8_SCHED;
            PG8_LDB(B0, 1, 0); PG8_LDB(B1, 1, 1); PG8_SCHED; PG8_LDA(At, 1, 0); PG8_STAGE(PG8_SA(0, 1), a2 + hstep, voffA);
            PG8_WAIT_V(8); PG8_WAIT_L(0); PG8_BAR; PG8_MMA(0, 0, At, B0); PG8_MMA(0, 1, At, B1); PG8_BAR; PG8_SCHED;
            PG8_LDA(At, 1, 1); PG8_STAGE(PG8_SB(1, 0), b3, voffB); PG8_STAGE(PG8_SB(1, 1), b3 + hstep, voffB); PG8_STAGE(PG8_SA(1, 0), a3, voffA);
            PG8_WAIT_V(8); PG8_WAIT_L(0); PG8_BAR; PG8_MMA(1, 0, At, B0); PG8_MMA(1, 1, At, B1); PG8_BAR; PG8_SCHED;
            } else {
            PG8_LDB(B0, 0, 0); PG8_SCHED; PG8_LDA(At, 0, 0); PG8_STAGE(PG8_SA(1, 1), a1 + hstep, voffA);
            PG8_WAIT_L(8); PG8_BAR; PG8_WAIT_L(0); PG8_MMA(0, 0, At, B0); PG8_BAR; PG8_SCHED;
            PG8_LDB(B1, 0, 1); PG8_STAGE(PG8_SB(0, 0), b2, voffB);
            PG8_BAR; PG8_WAIT_L(0); PG8_MMA(0, 1, At, B1); PG8_BAR;
            PG8_LDA(At, 0, 1); PG8_STAGE(PG8_SA(0, 0), a2, voffA);
            PG8_BAR; PG8_WAIT_L(0); PG8_MMA(1, 0, At, B0); PG8_BAR; PG8_SCHED;
            PG8_STAGE(PG8_SB(0, 1), b2 + hstep, voffB);
            PG8_WAIT_V(6); PG8_BAR; PG8_MMA(1, 1, At, B1); PG8_BAR;
            PG8_LDB(B0, 1, 0); PG8_SCHED; PG8_LDA(At, 1, 0); PG8_STAGE(PG8_SA(0, 1), a2 + hstep, voffA);
            PG8_WAIT_L(8); PG8_BAR; PG8_WAIT_L(0); PG8_MMA(0, 0, At, B0); PG8_BAR; PG8_SCHED;
            PG8_LDB(B1, 1, 1); PG8_STAGE(PG8_SB(1, 0), b3, voffB);
            PG8_BAR; PG8_WAIT_L(0); PG8_MMA(0, 1, At, B1); PG8_BAR;
            PG8_LDA(At, 1, 1); PG8_STAGE(PG8_SA(1, 0), a3, voffA);
            PG8_BAR; PG8_WAIT_L(0); PG8_MMA(1, 0, At, B0); PG8_BAR; PG8_SCHED;
            PG8_STAGE(PG8_SB(1, 1), b3 + hstep, voffB);
            PG8_WAIT_V(6); PG8_BAR; PG8_MMA(1, 1, At, B1); PG8_BAR;
            }
        }
        if constexpr (ALIGN_EPI) { if (wr == 0) PG8_BAR; }
        if constexpr (!Epi::AFTER_DRAIN) { E(acc, cur, wr, wc, fr, fq); S.done(cur); }
        if (!has_next) break;
#pragma unroll
        for (int a = 0; a < 2; ++a)
#pragma unroll
            for (int b = 0; b < 2; ++b)
#pragma unroll
                for (int m = 0; m < 4; ++m)
#pragma unroll
                    for (int n = 0; n < 2; ++n) acc[a][b][m][n] = (f32x4){0.f, 0.f, 0.f, 0.f};
        cur = nxt; cA = nA; cB = nB; ++ui;
        if constexpr (ALIGN_EPI) { if (wr == 1) PG8_BAR; }
    }
    PG8_WAIT_V(0);
    if constexpr (!ALIGN_EPI) { if (wr == 0) PG8_BAR; }
    PG8_BAR;
    if constexpr (Epi::AFTER_DRAIN) { E.fused(acc, cur, wr, wc, fr, fq, lds, wid, lane); S.done(cur); }
#undef PG8_SA
#undef PG8_SB
#undef PG8_STAGE
#undef PG8_LDA
#undef PG8_LDB
#undef PG8_MMA
#undef PG8_WAIT_V
#undef PG8_WAIT_L
#undef PG8_BAR
#undef PG8_SCHED
}
}
#define GAS __attribute__((address_space(1)))
#define LAS __attribute__((address_space(3)))
typedef unsigned short bf16;
typedef unsigned v4u __attribute__((ext_vector_type(4)));
typedef unsigned v2u __attribute__((ext_vector_type(2)));
typedef float f32x4 __attribute__((ext_vector_type(4)));
typedef short bf16x8 __attribute__((ext_vector_type(8)));
#define LDS_WAIT() asm volatile("s_waitcnt lgkmcnt(0)" ::: "memory")
#define VM_WAIT() asm volatile("s_waitcnt vmcnt(0)" ::: "memory")

constexpr int DM = 2048, NB = 4, SEQ = 2048, NMETA = 16, MROWS = NB * SEQ, DPROJ = 6152, NPROJ = 6144;
constexpr int PADT = 2112, POS0 = 64, MPOS0 = 48;
constexpr float EPS = 1e-6f;
constexpr float LOG2E = 1.4426950408889634f;
constexpr float QSCALE = 0.08838834764831845f * LOG2E;
constexpr int NWAVES = 8, NTHR = 512;

constexpr size_t MiB = 1u << 20;
constexpr size_t WS_CTL = 0, CTL_ZERO_BYTES = 32 * 1024;
constexpr size_t WS_PM = 484 * MiB;
constexpr size_t WS_W1T = 2 * MiB, WS_W2T = 26 * MiB, WS_W3T = 34 * MiB, WS_XN = 42 * MiB;
constexpr size_t WS_Q = 74 * MiB, WS_KP = 90 * MiB, WS_VP = 107 * MiB, WS_MQ = 124 * MiB, WS_MK = 133 * MiB, WS_MV = 142 * MiB, WS_MO = 159 * MiB;
constexpr size_t WS_SMALL = 175 * MiB;
constexpr size_t WS_XM = WS_SMALL, WS_LI = WS_SMALL + 128 * 1024, WS_LF = WS_SMALL + 384 * 1024, WS_LAM = WS_SMALL + 640 * 1024;
constexpr size_t WS_PO = 176 * MiB, WS_ML = 304 * MiB, WS_HM = 305 * MiB, WS_A2 = 42 * MiB, WS_H1B = 74 * MiB, WS_SSQ = 106 * MiB, WS_S = 176 * MiB, WS_UB = 384 * MiB, WS_VB = 448 * MiB;
constexpr size_t WS_SCL = WS_SMALL + 704 * 1024;
constexpr size_t WS_VB8 = WS_UB + 32 * MiB;
constexpr size_t WS_DC = 305 * MiB, WS_CS = 448 * MiB, WS_DN = 482 * MiB, WS_NS = WS_DN + 512 * 1024, WS_GS = WS_DN + 1024 * 1024, WS_MS = WS_DN + 1152 * 1024;
constexpr size_t WS_EID = 240 * MiB, WS_EGT = 244 * MiB;
constexpr int CW_BAR = 4096;

constexpr int RING_OFF = 0, RING_BYTES = 131072;
constexpr int XCH_OFF = 131072;
constexpr int MISC_OFF = XCH_OFF + 8192;
constexpr int LDS_BYTES = 155648;

__device__ __forceinline__ unsigned f2bf(float f) { unsigned u = __builtin_bit_cast(unsigned, f); return (u + 0x7fffu + ((u >> 16) & 1u)) >> 16; }
__device__ __forceinline__ unsigned pk2(float lo, float hi) { return f2bf(lo) | (f2bf(hi) << 16); }
__device__ __forceinline__ float bf2f(unsigned short u) { return __builtin_bit_cast(float, (unsigned)u << 16); }
__device__ __forceinline__ float bflo(unsigned w) { return __builtin_bit_cast(float, w << 16); }
__device__ __forceinline__ float bfhi(unsigned w) { return __builtin_bit_cast(float, w & 0xffff0000u); }
__device__ __forceinline__ float wave_sum(float v) {
#pragma unroll
  for (int o = 1; o < 64; o <<= 1) v += __shfl_xor(v, o);
  return v;
}
__device__ __forceinline__ size_t kp_off(int bhm, int pos, int d) { const int j = pos >> 6, row = pos & 63, d0 = d >> 4, hi = (d >> 3) & 1;
  return ((size_t)(bhm * 33 + j) * 8 + d0) * 1024 + (size_t)((((row << 1) | hi) ^ ((row >> 3) & 1)) << 3) + (d & 7); }
__device__ __forceinline__ float wave_sum_dpp(float v) {
  v += __builtin_bit_cast(float, __builtin_amdgcn_update_dpp(0, __builtin_bit_cast(int, v), 0xB1, 0xF, 0xF, true));
  v += __builtin_bit_cast(float, __builtin_amdgcn_update_dpp(0, __builtin_bit_cast(int, v), 0x4E, 0xF, 0xF, true));
  v += __builtin_bit_cast(float, __builtin_amdgcn_update_dpp(0, __builtin_bit_cast(int, v), 0x141, 0xF, 0xF, true));
  v += __builtin_bit_cast(float, __builtin_amdgcn_update_dpp(0, __builtin_bit_cast(int, v), 0x140, 0xF, 0xF, true));
  const float r0 = __builtin_bit_cast(float, __builtin_amdgcn_readlane(__builtin_bit_cast(int, v), 0)), r1 = __builtin_bit_cast(float, __builtin_amdgcn_readlane(__builtin_bit_cast(int, v), 16));
  const float r2 = __builtin_bit_cast(float, __builtin_amdgcn_readlane(__builtin_bit_cast(int, v), 32)), r3 = __builtin_bit_cast(float, __builtin_amdgcn_readlane(__builtin_bit_cast(int, v), 48));
  return (r0 + r1) + (r2 + r3);
}
__device__ __forceinline__ float sigmoidf_(float x) { return 1.0f / (1.0f + __expf(-x)); }
#define XB_TMO      128
#define XB_XCNT(j)  (256  + 64 * (j))
#define XB_XSUB(j)  (1280 + 64 * (j))
#define XB_XGEN(j)  (2304 + 64 * (j))
#define XB_TOP      3328
#define XB_TOPGEN   3392
#define XCD_BAR_WORDS 3456
#define XB_SPIN_CAP (1u << 18)

__device__ __forceinline__ unsigned xb_ld(unsigned* p)              { return __hip_atomic_load(p, __ATOMIC_RELAXED, __HIP_MEMORY_SCOPE_AGENT); }
__device__ __forceinline__ unsigned xb_add(unsigned* p, unsigned v) { return __hip_atomic_fetch_add(p, v, __ATOMIC_RELAXED, __HIP_MEMORY_SCOPE_AGENT); }
__device__ __forceinline__ unsigned xb_xcc_id() { return (unsigned)__builtin_amdgcn_s_getreg((3 << 11) | 20) & 0xFu; }
#define XB_SPIN(cond, bar) do { unsigned _sp = 0; while (cond) { __builtin_amdgcn_s_sleep(1); \
    if ((++_sp & 255u) == 0u) { if (xb_ld(&(bar)[XB_TMO])) break; if (_sp > XB_SPIN_CAP) { atomicAdd(&(bar)[XB_TMO], 1u); break; } } } } while (0)

struct XcdBarrier {
    unsigned* bar; unsigned x;
    volatile LAS unsigned* st;
};

__device__ __forceinline__ XcdBarrier xcd_barrier_post(unsigned* bar, volatile LAS unsigned* st) {
    XcdBarrier b; b.bar = bar; b.x = xb_xcc_id(); b.st = st;
    if (threadIdx.x == 0) (void)xb_add(&bar[XB_XCNT(b.x)], 1u);
    return b;
}
__device__ __forceinline__ void xcd_barrier_complete(unsigned* bar, unsigned x, unsigned& nloc, unsigned& nx) {
    const unsigned G = gridDim.x * gridDim.y * gridDim.z;
    unsigned sum, cnt, mine, sp = 0u;
    for (;;) {
        sum = 0u; cnt = 0u; mine = 0u;
#pragma unroll
        for (unsigned j = 0; j < 16; ++j) { const unsigned c = xb_ld(&bar[XB_XCNT(j)]); sum += c; cnt += (c > 0u) ? 1u : 0u; mine = (j == x) ? c : mine; }
        if (sum == G) break;
        __builtin_amdgcn_s_sleep(1);
        if ((++sp & 255u) == 0u) { if (xb_ld(&bar[XB_TMO])) break; if (sp > XB_SPIN_CAP) { atomicAdd(&bar[XB_TMO], 1u); break; } }
    }
    nloc = mine > 0u ? mine : 1u; nx = cnt > 0u ? cnt : 1u;
}

__device__ __forceinline__ void xcd_barrier(const XcdBarrier& b) {
    asm volatile("s_waitcnt vmcnt(0)" ::: "memory");
    __syncthreads();
    if (threadIdx.x == 0) {
        unsigned* bar = b.bar;
        __builtin_amdgcn_s_waitcnt(0);
        unsigned nloc = b.st[0], nx = b.st[1];
        if (nloc == 0u) { xcd_barrier_complete(bar, b.x, nloc, nx); b.st[0] = nloc; b.st[1] = nx; }
        const unsigned old = xb_add(&bar[XB_XSUB(b.x)], 1u);
        const unsigned gen = old / nloc;
        if (old + 1u == (gen + 1u) * nloc) {
            __builtin_amdgcn_fence(__ATOMIC_RELEASE, "agent");
            asm volatile("s_waitcnt vmcnt(0)" ::: "memory");
            const unsigned og = xb_add(&bar[XB_TOP], 1u);
            const unsigned tg = og / nx;
            if (og + 1u == (tg + 1u) * nx) xb_add(&bar[XB_TOPGEN], 1u);
            else XB_SPIN(xb_ld(&bar[XB_TOPGEN]) == tg, bar);
            __builtin_amdgcn_fence(__ATOMIC_ACQUIRE, "agent");
            xb_add(&bar[XB_XGEN(b.x)], 1u);
            asm volatile("s_waitcnt vmcnt(0)" ::: "memory");
        } else {
            XB_SPIN(xb_ld(&bar[XB_XGEN(b.x)]) == gen, bar);
            __builtin_amdgcn_fence(__ATOMIC_ACQUIRE, "agent");
            asm volatile("s_waitcnt vmcnt(0)" ::: "memory");
        }
    }
    __syncthreads();
}

struct Args { const float* in[22]; float* out; unsigned char* ws; int ph_lo, ph_hi, na, pad; };
struct Frame {
  LAS unsigned char* lds; unsigned char* ws; int tid, lane, wave; const float* const* in;
};
#define IN_X 0
#define IN_META 1
#define IN_G1 2
#define IN_WIN 3
#define IN_CW 4
#define IN_CB 5
#define IN_IGB 6
#define IN_FGB 7
#define IN_LQ1 8
#define IN_LK1 9
#define IN_LQ2 10
#define IN_LK2 11
#define IN_QNG 12
#define IN_KNG 13
#define IN_SUBG 14
#define IN_OUTG 15
#define IN_WOUT 16
#define IN_G2 17
#define IN_WQ 18
#define IN_SUBK 19
#define IN_U 20
#define IN_V 21

__device__ __forceinline__ void p0_rows(const Frame& F, const Args& a) {
  const float* x = a.in[IN_X]; const float* meta = a.in[IN_META]; const float* g1 = a.in[IN_G1]; const float* w_in = a.in[IN_WIN];
  const float* igb = a.in[IN_IGB]; const float* fgb = a.in[IN_FGB];
  bf16* Xn = (bf16*)(F.ws + WS_XN); bf16* Xm = (bf16*)(F.ws + WS_XM); float* LI = (float*)(F.ws + WS_LI); float* LF = (float*)(F.ws + WS_LF);
  LAS f32x4* wgl = (LAS f32x4*)(F.lds);
  for (int e = F.tid; e < 4096; e += NTHR) {
    const int ln = e & 63, q = e >> 6, half = q & 1, j = (q >> 1) & 3, i = q >> 3;
    const int k = 4 * (i * 64 + ln) + j;
    wgl[e] = *(const f32x4*)(w_in + (size_t)k * DPROJ + NPROJ + 4 * half);
  }
  __syncthreads();
  const int gw = blockIdx.x * NWAVES + F.wave, NGW = gridDim.x * NWAVES, lane = F.lane;
  for (int task = gw; task < MROWS / 2 + NMETA / 2; task += NGW) {
    const bool ismeta = task >= MROWS / 2;
    const int r0 = ismeta ? (task - MROWS / 2) * 2 : task * 2;
    const float* src0 = (ismeta ? meta : x) + (size_t)r0 * DM;
    f32x4 xv[2][8]; float rs[2];
    { float s0 = 0.f, s1 = 0.f;
#pragma unroll
      for (int i = 0; i < 8; ++i) { xv[0][i] = ((const f32x4*)src0)[i * 64 + lane]; xv[1][i] = ((const f32x4*)(src0 + DM))[i * 64 + lane]; }
#pragma unroll
      for (int i = 0; i < 8; ++i) { const f32x4 a0 = xv[0][i], a1 = xv[1][i];
        s0 += (a0.x * a0.x + a0.y * a0.y) + (a0.z * a0.z + a0.w * a0.w); s1 += (a1.x * a1.x + a1.y * a1.y) + (a1.z * a1.z + a1.w * a1.w); }
      rs[0] = rsqrtf(wave_sum_dpp(s0) * (1.0f / DM) + EPS); rs[1] = rsqrtf(wave_sum_dpp(s1) * (1.0f / DM) + EPS); }
    float ga[2][8];
#pragma unroll
    for (int rr = 0; rr < 2; ++rr)
#pragma unroll
      for (int g = 0; g < 8; ++g) ga[rr][g] = 0.f;
    bf16* dst0 = (ismeta ? Xm : Xn) + (size_t)r0 * DM;
#pragma unroll
    for (int i = 0; i < 8; ++i) {
      const f32x4 g = ((const f32x4*)g1)[i * 64 + lane];
      f32x4 xn[2];
#pragma unroll
      for (int rr = 0; rr < 2; ++rr) { xn[rr] = xv[rr][i] * g * rs[rr];
        v2u o; o.x = pk2(xn[rr].x, xn[rr].y); o.y = pk2(xn[rr].z, xn[rr].w); ((v2u*)(dst0 + (size_t)rr * DM))[i * 64 + lane] = o; }
#pragma unroll
      for (int j = 0; j < 4; ++j) {
        const f32x4 w0 = wgl[((i * 4 + j) * 2 + 0) * 64 + lane], w1 = wgl[((i * 4 + j) * 2 + 1) * 64 + lane];
#pragma unroll
        for (int rr = 0; rr < 2; ++rr) { const float xs_ = xn[rr][j];
          ga[rr][0] += xs_ * w0.x; ga[rr][1] += xs_ * w0.y; ga[rr][2] += xs_ * w0.z; ga[rr][3] += xs_ * w0.w;
          ga[rr][4] += xs_ * w1.x; ga[rr][5] += xs_ * w1.y; ga[rr][6] += xs_ * w1.z; ga[rr][7] += xs_ * w1.w; }
      }
      __builtin_amdgcn_sched_barrier(0);
    }
#pragma unroll
    for (int rr = 0; rr < 2; ++rr)
#pragma unroll
      for (int g = 0; g < 8; ++g) ga[rr][g] = wave_sum_dpp(ga[rr][g]);
    if (lane < 8) {
      const int rr = lane >> 2, h = lane & 3;
      float gi = 0.f, gf = 0.f;
#pragma unroll
      for (int q = 0; q < 2; ++q)
#pragma unroll
        for (int hh = 0; hh < 4; ++hh) if (q == rr && hh == h) { gi = ga[q][hh]; gf = ga[q][4 + hh]; }
      const float li = gi + igb[h]; const float fx = gf + fgb[h];
      const float lf = fminf(fx, 0.f) - log1pf(__expf(-fabsf(fx)));
      const int R = r0 + rr;
      if (!ismeta) { const int b = R >> 11, t = R & 2047; LI[(b * 4 + h) * PADT + POS0 + t] = li; LF[(b * 4 + h) * PADT + POS0 + t] = lf; }
      else { for (int b = 0; b < NB; ++b) { LI[(b * 4 + h) * PADT + MPOS0 + R] = li; LF[(b * 4 + h) * PADT + MPOS0 + R] = lf; } }
    }
  }
  __syncthreads();
}
__device__ __forceinline__ void p0_metaproj(const Frame& F, const Args& a) {
  const float* meta = a.in[IN_META]; const float* g1 = a.in[IN_G1]; const float* w_in = a.in[IN_WIN];
  float* PM = (float*)(F.ws + WS_PM);
  LAS float* xs = (LAS float*)(F.lds);
  LAS float* part = (LAS float*)(F.lds + 16384);
  const int q = F.tid >> 7, c = F.tid & 127;
  for (int task = blockIdx.x; task < (NPROJ / 128) * 4; task += gridDim.x) {
    const int nb = task >> 2, kp = task & 3, n = nb * 128 + c;
    float acc[16];
#pragma unroll
    for (int m = 0; m < 16; ++m) acc[m] = 0.f;
#pragma unroll 1
    for (int kb = 0; kb < 2; ++kb) {
      __syncthreads();
#pragma unroll
      for (int i = 0; i < 8; ++i) { const int idx = F.tid + NTHR * i, qq = idx >> 10, kk = (idx >> 4) & 63, m = idx & 15; const int k = 512 * kp + 128 * qq + 64 * kb + kk;
        xs[idx] = meta[(size_t)m * DM + k] * g1[k]; }
      __syncthreads();
#pragma unroll 8
      for (int kk = 0; kk < 64; ++kk) {
        const float w = w_in[(size_t)(512 * kp + 128 * q + 64 * kb + kk) * DPROJ + n];
        const LAS f32x4* xp = (const LAS f32x4*)(xs + (q * 64 + kk) * 16);
#pragma unroll
        for (int t = 0; t < 4; ++t) { const f32x4 xv = xp[t]; acc[4 * t + 0] += xv.x * w; acc[4 * t + 1] += xv.y * w; acc[4 * t + 2] += xv.z * w; acc[4 * t + 3] += xv.w * w; }
      }
    }
#pragma unroll
    for (int m = 0; m < 16; ++m) part[(q * 16 + m) * 128 + c] = acc[m];
    __syncthreads();
    for (int e = F.tid; e < 16 * 128; e += NTHR) { const int m = e >> 7, cc = e & 127;
      PM[((size_t)kp * 16 + m) * NPROJ + nb * 128 + cc] = (part[(0 * 16 + m) * 128 + cc] + part[(1 * 16 + m) * 128 + cc]) + (part[(2 * 16 + m) * 128 + cc] + part[(3 * 16 + m) * 128 + cc]); }
  }
  __syncthreads();
}
__device__ __forceinline__ void p0_transpose(const Frame& F, const float* W, int ldw, int N, bf16* Wt) {
  LAS float* tl = (LAS float*)(F.lds);
  const int ntn = N / 64, ntask = ntn * 16;
  for (int task = blockIdx.x; task < ntask; task += gridDim.x) {
    const int nb = task % ntn, kb = task / ntn, n0 = nb * 64, k0 = kb * 128;
    __syncthreads();
#pragma unroll
    for (int i = 0; i < 4; ++i) { const int idx = F.tid + NTHR * i, kk = idx >> 4, c4 = idx & 15;
      const f32x4 w = *(const f32x4*)(W + (size_t)(k0 + kk) * ldw + n0 + 4 * c4);
      LAS float* d = tl + kk * 65 + 4 * c4; d[0] = w.x; d[1] = w.y; d[2] = w.z; d[3] = w.w; }
    __syncthreads();
    const int n = F.tid >> 3, kc = F.tid & 7;
    const LAS float* s = tl + (kc * 16) * 65 + n;
    v4u o0, o1;
    o0.x = pk2(s[0 * 65], s[1 * 65]); o0.y = pk2(s[2 * 65], s[3 * 65]); o0.z = pk2(s[4 * 65], s[5 * 65]); o0.w = pk2(s[6 * 65], s[7 * 65]);
    o1.x = pk2(s[8 * 65], s[9 * 65]); o1.y = pk2(s[10 * 65], s[11 * 65]); o1.z = pk2(s[12 * 65], s[13 * 65]); o1.w = pk2(s[14 * 65], s[15 * 65]);
    v4u* dp = (v4u*)(Wt + (size_t)(n0 + n) * DM + k0 + kc * 16);
    dp[0] = o0; dp[1] = o1;
  }
  __syncthreads();
}
__device__ __forceinline__ void p0_zero_vpad(const Frame& F) {
  bf16* Vp = (bf16*)(F.ws + WS_VP);
  const int per = MPOS0 * 256 / 8;
  for (int i = blockIdx.x * NTHR + F.tid; i < 16 * per; i += gridDim.x * NTHR) { const int bh = i / per, e = i % per;
    *(v4u*)(Vp + (size_t)bh * PADT * 256 + (size_t)e * 8) = (v4u){0u, 0u, 0u, 0u}; }
}
__device__ __forceinline__ void p0_lam(const Frame& F, const Args& a) {
  if (blockIdx.x == 0 && F.wave == 0) {
    const int l = F.lane;
    float s1 = a.in[IN_LQ1][l] * a.in[IN_LK1][l] + a.in[IN_LQ1][l + 64] * a.in[IN_LK1][l + 64];
    float s2 = a.in[IN_LQ2][l] * a.in[IN_LK2][l] + a.in[IN_LQ2][l + 64] * a.in[IN_LK2][l + 64];
    s1 = wave_sum(s1); s2 = wave_sum(s2);
    if (l == 0) *(float*)(F.ws + WS_LAM) = __expf(s1) - __expf(s2) + 0.2f;
  }
}

struct EpiProj {
  static constexpr bool PERM = true, AFTER_DRAIN = false;
  bf16 *Qb, *Kp, *Vp, *MQ, *MK, *MV, *MO; const float *qg, *kg; LAS float* xch;
  __device__ __forceinline__ void operator()(const pg8::f32x4 (&acc)[2][2][4][2], const pg8::Unit& u, int wr, int wc, int fr, int fq) const {
    const int pn = u.pn, b = u.pm >> 3, tb = (u.pm & 7) * 256 + wr * 64 + fr, d0 = wc * 32 + fq * 8;
    if (pn < 8) {
      const bool isk = pn >= 4; const int h = pn & 3;
      float ssq[2][4][2];
#pragma unroll
      for (int ai = 0; ai < 2; ++ai)
#pragma unroll
        for (int m = 0; m < 4; ++m)
#pragma unroll
          for (int bj = 0; bj < 2; ++bj) { float s = 0.f;
#pragma unroll
            for (int n = 0; n < 2; ++n) { const pg8::f32x4 x = acc[ai][bj][m][n]; s += (x[0] * x[0] + x[1] * x[1]) + (x[2] * x[2] + x[3] * x[3]); }
            s += __shfl_xor(s, 16); s += __shfl_xor(s, 32); ssq[ai][m][bj] = s;
            if (fq == 0) xch[((ai * 128 + wr * 64 + m * 16 + fr) * 2 + bj) * 4 + wc] = s; }
      asm volatile("s_waitcnt lgkmcnt(0)" ::: "memory"); __builtin_amdgcn_s_barrier(); asm volatile("" ::: "memory");
      const float* gp = (isk ? kg : qg) + d0; const f32x4 g0 = *(const f32x4*)gp, g1v = *(const f32x4*)(gp + 4);
      const float sc = isk ? 1.0f : QSCALE;
#pragma unroll
      for (int ai = 0; ai < 2; ++ai)
#pragma unroll
        for (int m = 0; m < 4; ++m)
#pragma unroll
          for (int bj = 0; bj < 2; ++bj) {
            const f32x4 p = *(const LAS f32x4*)(xch + ((ai * 128 + wr * 64 + m * 16 + fr) * 2 + bj) * 4);
            const float rs = rsqrtf(((p.x + p.y) + (p.z + p.w)) * (1.0f / 128.f) + EPS) * sc;
            const pg8::f32x4 v0 = acc[ai][bj][m][0], v1 = acc[ai][bj][m][1];
            v4u w; w.x = pk2(v0[0] * rs * g0.x, v0[1] * rs * g0.y); w.y = pk2(v0[2] * rs * g0.z, v0[3] * rs * g0.w);
            w.z = pk2(v1[0] * rs * g1v.x, v1[1] * rs * g1v.y); w.w = pk2(v1[2] * rs * g1v.z, v1[3] * rs * g1v.w);
            const int t = tb + ai * 128 + m * 16;
            bf16* dst = isk ? Kp + kp_off((b * 4 + h) * 2 + bj, POS0 + t, d0)
                            : Qb + ((size_t)((b * 4 + h) * 2 + bj) * SEQ + t) * 128 + d0;
            *(v4u*)dst = w; }
      return;
    }
#pragma unroll
    for (int ai = 0; ai < 2; ++ai)
#pragma unroll
      for (int m = 0; m < 4; ++m)
#pragma unroll
        for (int bj = 0; bj < 2; ++bj) {
          pg8::f32x4 v0 = acc[ai][bj][m][0], v1 = acc[ai][bj][m][1];
          const int t = tb + ai * 128 + m * 16;
          bf16* dst;
          if (pn < 12) { const int h = pn - 8; dst = Vp + ((size_t)(b * 4 + h) * PADT + POS0 + t) * 256 + bj * 128 + d0; }
          else if (pn < 16) { const int h = 2 * (pn & 1) + bj; dst = (pn >= 14 ? MK : MQ) + ((size_t)(b * 4 + h) * PADT + POS0 + t) * 128 + d0; }
          else if (pn < 20) { const int h = pn - 16; dst = MV + ((size_t)(b * 4 + h) * PADT + POS0 + t) * 256 + bj * 128 + d0; }
          else { dst = MO + (size_t)(b * SEQ + t) * 1024 + (pn - 20) * 256 + bj * 128 + d0;
#pragma unroll
            for (int j = 0; j < 4; ++j) { v0[j] = sigmoidf_(v0[j]); v1[j] = sigmoidf_(v1[j]); } }
          v4u w; w.x = pk2(v0[0], v0[1]); w.y = pk2(v0[2], v0[3]); w.z = pk2(v1[0], v1[1]); w.w = pk2(v1[2], v1[3]);
          *(v4u*)dst = w; }
  }
};
__device__ __forceinline__ void p1_meta_finalize(const Frame& F, const Args& a) {
  if (blockIdx.x >= NMETA) return;
  const int mrow = blockIdx.x, tid = F.tid, lane = F.lane, w = F.wave;
  const float* meta = a.in[IN_META] + (size_t)mrow * DM; const float* PM0 = (const float*)(F.ws + WS_PM) + (size_t)mrow * NPROJ;
#define PM_AT(i) ((PM0[(i)] + PM0[(size_t)16 * NPROJ + (i)]) + (PM0[(size_t)32 * NPROJ + (i)] + PM0[(size_t)48 * NPROJ + (i)]))
  LAS float* red = (LAS float*)(F.lds + XCH_OFF);
  const f32x4 mv = ((const f32x4*)meta)[tid];
  float s = wave_sum((mv.x * mv.x + mv.y * mv.y) + (mv.z * mv.z + mv.w * mv.w));
  if (lane == 0) red[w] = s;
  __syncthreads();
  float tot = 0.f;
#pragma unroll
  for (int i = 0; i < 8; ++i) tot += red[i];
  const float rs = rsqrtf(tot * (1.0f / DM) + EPS);
  bf16* Kp = (bf16*)(F.ws + WS_KP); bf16* Vp = (bf16*)(F.ws + WS_VP); bf16* MQ = (bf16*)(F.ws + WS_MQ); bf16* MK = (bf16*)(F.ws + WS_MK); bf16* MV = (bf16*)(F.ws + WS_MV);
  const int pos = MPOS0 + mrow;
  {
    const float v0 = PM_AT(1024 + w * 128 + lane) * rs, v1 = PM_AT(1024 + w * 128 + lane + 64) * rs;
    const float rk = rsqrtf(wave_sum(v0 * v0 + v1 * v1) * (1.0f / 128.f) + EPS);
    const float* kg = a.in[IN_KNG];
    const unsigned short o0 = (unsigned short)f2bf(v0 * rk * kg[lane]), o1 = (unsigned short)f2bf(v1 * rk * kg[lane + 64]);
    for (int b = 0; b < NB; ++b) { const int bhm = (b * 4 + (w >> 1)) * 2 + (w & 1); Kp[kp_off(bhm, pos, lane)] = o0; Kp[kp_off(bhm, pos, lane + 64)] = o1; }
  }
  { const int c = tid * 2;
    const unsigned o = pk2(PM_AT(2048 + c) * rs, PM_AT(2048 + c + 1) * rs); const int h = c >> 8, e = c & 255;
    for (int b = 0; b < NB; ++b) *(unsigned*)(Vp + ((size_t)(b * 4 + h) * PADT + pos) * 256 + e) = o;
    const unsigned o2 = pk2(PM_AT(3072 + c) * rs, PM_AT(3072 + c + 1) * rs); const bool isk = c >= 512; const int cc = c & 511, hq = cc >> 7, d = cc & 127;
    for (int b = 0; b < NB; ++b) *(unsigned*)((isk ? MK : MQ) + ((size_t)(b * 4 + hq) * PADT + pos) * 128 + d) = o2;
    const unsigned o3 = pk2(PM_AT(4096 + c) * rs, PM_AT(4096 + c + 1) * rs);
    for (int b = 0; b < NB; ++b) *(unsigned*)(MV + ((size_t)(b * 4 + h) * PADT + pos) * 256 + e) = o3;
  }
  __syncthreads();
}
#undef PM_AT

namespace att {
using f32x16 = __attribute__((ext_vector_type(16))) float;
using s16x4 = __attribute__((ext_vector_type(4))) short;
constexpr int STEPS_BHM = 152, NSTEPS = 32 * STEPS_BHM;
constexpr int SHM_V = 64 * 256 * 2, SHM_K = 64 * 128 * 2;
constexpr int LDS_V = 0, LDS_K = 2 * SHM_V, LDS_Q = LDS_K + SHM_K, LDS_WS = LDS_Q + 8 * 8192;
constexpr float THR2 = 8.0f;
#define KSWZ(row, colB) ((row) * 256 + ((colB) ^ (((row) & 7) << 4)))
#define SBAR() __builtin_amdgcn_sched_barrier(0)
__device__ __forceinline__ int crow(int r, int hi) { return (r & 3) + 8 * (r >> 2) + 4 * hi; }
__device__ __forceinline__ unsigned cvtpk(float lo, float hi) { unsigned r; asm volatile("v_cvt_pk_bf16_f32 %0, %1, %2" : "=v"(r) : "v"(lo), "v"(hi)); return r; }
__device__ __forceinline__ int qb_start(int qb) { return 2 * qb * qb + 3 * qb; }
__device__ __forceinline__ int chunk_of(int s, int NA) { return ((s + 1) * NA - 1) / NSTEPS; }

template <int OFF> __device__ __forceinline__ s16x4 tr_read(int vb) {
  s16x4 r; asm volatile("ds_read_b64_tr_b16 %0, %1 offset:%2" : "=&v"(r) : "v"(vb), "i"(OFF) : "memory"); return r;
}
constexpr int v_rd_off(int d0, int ks, int half) { return d0 * 512 + ks * 8192 + half * 4096; }
template <int D0> __device__ __forceinline__ void pv_one(f32x16& od, int vb, bf16x8 pa0, bf16x8 pa1, bf16x8 pa2, bf16x8 pa3) {
#define PK(L, H) (bf16x8){L[0], L[1], L[2], L[3], H[0], H[1], H[2], H[3]}
  { const s16x4 l0 = tr_read<v_rd_off(D0, 0, 0)>(vb), h0 = tr_read<v_rd_off(D0, 0, 1)>(vb), l1 = tr_read<v_rd_off(D0, 1, 0)>(vb), h1 = tr_read<v_rd_off(D0, 1, 1)>(vb);
    asm volatile("s_waitcnt lgkmcnt(0)" ::: "memory"); SBAR();
    od = __builtin_amdgcn_mfma_f32_32x32x16_bf16(pa0, PK(l0, h0), od, 0, 0, 0);
    od = __builtin_amdgcn_mfma_f32_32x32x16_bf16(pa1, PK(l1, h1), od, 0, 0, 0); }
  SBAR();
  { const s16x4 l2 = tr_read<v_rd_off(D0, 2, 0)>(vb), h2 = tr_read<v_rd_off(D0, 2, 1)>(vb), l3 = tr_read<v_rd_off(D0, 3, 0)>(vb), h3 = tr_read<v_rd_off(D0, 3, 1)>(vb);
    asm volatile("s_waitcnt lgkmcnt(0)" ::: "memory"); SBAR();
    od = __builtin_amdgcn_mfma_f32_32x32x16_bf16(pa2, PK(l2, h2), od, 0, 0, 0);
    od = __builtin_amdgcn_mfma_f32_32x32x16_bf16(pa3, PK(l3, h3), od, 0, 0, 0); }
#undef PK
}

__device__ __forceinline__ void segment(const Frame& F, int bhm, int qb, int j0, int j1, int slot) {
  const int tid = F.tid, wid = F.wave, lane = F.lane, r32 = lane & 31, hi = lane >> 5;
  const bf16* Qg = (const bf16*)(F.ws + WS_Q) + ((size_t)bhm * SEQ + qb * 256 + wid * 32 + r32) * 128 + hi * 8;
  const bf16* Kg = (const bf16*)(F.ws + WS_KP) + (size_t)bhm * 33 * 8192;
  const bf16* Vg = (const bf16*)(F.ws + WS_VP) + (size_t)(bhm >> 1) * PADT * 256;
  LAS unsigned char* lds = F.lds;
  LAS float* wsl = (LAS float*)(lds + LDS_WS) + wid * 64;
  const float slope2 = exp2f(-2.0f * (float)(((bhm >> 1) & 3) + 1)) * LOG2E;
  unsigned ksrc0, vsrc0;
  ksrc0 = (unsigned)tid * 16u;
  { const int a8 = tid >> 8, b = (tid >> 2) & 7, k = 8 * (b >> 2) + 4 * a8 + (b & 3), c = ((tid >> 5) & 7) * 32 + (tid & 3) * 8; vsrc0 = (unsigned)(k * 256 + c) * 2u; }
#define STAGE_K(j) do { const char* kt = (const char*)(Kg + (size_t)(j) * 8192); \
    _Pragma("unroll") for (int _i = 0; _i < 2; ++_i) __builtin_amdgcn_global_load_lds((const unsigned*)(kt + (ksrc0 + _i * 8192u)), (LAS unsigned*)(lds + LDS_K + _i * 8192 + wid * 1024), 16, 0, 0); } while (0)
#define STAGE_V(buf, j) do { const char* vt = (const char*)(Vg + (size_t)(j) * 64 * 256); \
    _Pragma("unroll") for (int _i = 0; _i < 4; ++_i) __builtin_amdgcn_global_load_lds((const unsigned*)(vt + (vsrc0 + _i * 8192u)), (LAS unsigned*)(lds + LDS_V + (buf) * SHM_V + _i * 8192 + wid * 1024), 16, 0, 0); } while (0)
  const int lt = (((r32 << 1) | hi) ^ ((r32 >> 3) & 1)) << 4;
  LAS unsigned char* Qs = lds + LDS_Q + wid * 8192;
#pragma unroll
  for (int d0 = 0; d0 < 8; ++d0) { const bf16x8 qv = *(const bf16x8*)(Qg + d0 * 16); *(LAS bf16x8*)(Qs + d0 * 1024 + lt) = qv; }
  f32x16 o[8];
#pragma unroll
  for (int d = 0; d < 8; ++d)
#pragma unroll
    for (int r = 0; r < 16; ++r) o[d][r] = 0.f;
  float m_reg = -1e30f, l_reg = 0.f;
  const int vb0 = (int)(uintptr_t)(lds + LDS_V) + (((lane & 3) << 3) | (((lane >> 2) & 3) << 6) | (((lane >> 4) & 1) << 5) | (((lane >> 5) & 1) << 8));
  STAGE_K(j0); STAGE_V(0, j0);
  VM_WAIT(); __syncthreads();
  for (int j = j0; j < j1; ++j) {
    const int cur = (j - j0) & 1;
    if (j + 1 < j1) STAGE_V(cur ^ 1, j + 1);
    SBAR();
    f32x16 p0 = {}, p1 = {};
    { const LAS unsigned char* Ks = lds + LDS_K;
#pragma unroll
      for (int d0 = 0; d0 < 8; ++d0) {
        const bf16x8 b0 = *(const LAS bf16x8*)(Ks + d0 * 2048 + lt);
        const bf16x8 b1 = *(const LAS bf16x8*)(Ks + d0 * 2048 + 1024 + lt);
        const bf16x8 qf = *(const LAS bf16x8*)(Qs + d0 * 1024 + lt);
        p0 = __builtin_amdgcn_mfma_f32_32x32x16_bf16(b0, qf, p0, 0, 0, 0);
        p1 = __builtin_amdgcn_mfma_f32_32x32x16_bf16(b1, qf, p1, 0, 0, 0); } }
    asm volatile("s_waitcnt lgkmcnt(0)" ::: "memory"); __builtin_amdgcn_s_barrier(); asm volatile("" ::: "memory");
    if (j + 1 < j1) STAGE_K(j + 1);
    SBAR();
    if (j == 0) {
#pragma unroll
      for (int r = 0; r < 16; ++r) p0[r] = -INFINITY;
#pragma unroll
      for (int r = 0; r < 8; ++r) p1[r] = -INFINITY;
    }
    int ln2 = threadIdx.x & 63; asm volatile("" : "+v"(ln2));
    const int hi2 = ln2 >> 5;
    const int jb = j - (4 * qb + 1);
    if (jb >= 0) {
      const int kb = 64 * jb + 4 * hi2, qrel = wid * 32 + (ln2 & 31);
#pragma unroll
      for (int r = 0; r < 16; ++r) { const int kv = kb + (r & 3) + 8 * (r >> 2); if (kv > qrel) p0[r] = -INFINITY; if (kv + 32 > qrel) p1[r] = -INFINITY; }
    }
    const float off0 = slope2 * (float)(64 * j + 4 * hi2), off1 = off0 + 32.0f * slope2;
#pragma unroll
    for (int r = 0; r < 16; ++r) { const float sb = slope2 * (float)((r & 3) + 8 * (r >> 2)); p0[r] += sb; p1[r] += sb; }
    float pm0 = p0[0], pm1 = p1[0];
#pragma unroll
    for (int r = 1; r < 16; ++r) { pm0 = fmaxf(pm0, p0[r]); pm1 = fmaxf(pm1, p1[r]); }
    float pmax = fmaxf(pm0 + off0, pm1 + off1);
    { auto rr = __builtin_amdgcn_permlane32_swap(__float_as_uint(pmax), __float_as_uint(pmax), false, false);
      pmax = fmaxf(__uint_as_float(rr[0]), __uint_as_float(rr[1])); }
    float mn, alpha;
    if (__builtin_expect(__all(pmax - m_reg <= THR2), 1)) { mn = m_reg; alpha = 1.f; }
    else { mn = fmaxf(m_reg, pmax); alpha = __builtin_amdgcn_exp2f(m_reg - mn); m_reg = mn; }
    const float c0 = off0 - mn, c1 = off1 - mn;
    float ps = 0.f;
#pragma unroll
    for (int r = 0; r < 16; ++r) { p0[r] = __builtin_amdgcn_exp2f(p0[r] + c0); p1[r] = __builtin_amdgcn_exp2f(p1[r] + c1); ps += p0[r] + p1[r]; }
    { auto rr = __builtin_amdgcn_permlane32_swap(__float_as_uint(ps), __float_as_uint(ps), false, false);
      ps = __uint_as_float(rr[0]) + __uint_as_float(rr[1]); }
    l_reg = l_reg * alpha + ps;
    if (__any(alpha < 1.f)) { if (hi == 0) wsl[r32] = alpha; asm volatile("s_waitcnt lgkmcnt(0)" ::: "memory");
#pragma unroll
      for (int rg = 0; rg < 4; ++rg) { const f32x4 al = *(const LAS f32x4*)(wsl + 8 * rg + 4 * hi);
#pragma unroll
        for (int d = 0; d < 8; ++d) { o[d][4 * rg + 0] *= al.x; o[d][4 * rg + 1] *= al.y; o[d][4 * rg + 2] *= al.z; o[d][4 * rg + 3] *= al.w; }
        SBAR(); } }
    bf16x8 pa0, pa1, pa2, pa3;
#define PK4(P, BASE, OUT) do { unsigned a0 = cvtpk(P[BASE + 0], P[BASE + 1]), a1 = cvtpk(P[BASE + 2], P[BASE + 3]);   \
    unsigned b0 = cvtpk(P[BASE + 4], P[BASE + 5]), b1 = cvtpk(P[BASE + 6], P[BASE + 7]);                              \
    auto r0 = __builtin_amdgcn_permlane32_swap(a0, b0, false, false); auto r1 = __builtin_amdgcn_permlane32_swap(a1, b1, false, false); \
    v4u w = {r0[0], r1[0], r0[1], r1[1]}; OUT = *reinterpret_cast<bf16x8*>(&w); } while (0)
    PK4(p0, 0, pa0); PK4(p0, 8, pa1); PK4(p1, 0, pa2); PK4(p1, 8, pa3);
#undef PK4
    SBAR();
    { const int vb = vb0 + cur * SHM_V;
      pv_one<0>(o[0], vb, pa0, pa1, pa2, pa3); pv_one<1>(o[1], vb, pa0, pa1, pa2, pa3); pv_one<2>(o[2], vb, pa0, pa1, pa2, pa3); pv_one<3>(o[3], vb, pa0, pa1, pa2, pa3);
      pv_one<4>(o[4], vb, pa0, pa1, pa2, pa3); pv_one<5>(o[5], vb, pa0, pa1, pa2, pa3); pv_one<6>(o[6], vb, pa0, pa1, pa2, pa3); pv_one<7>(o[7], vb, pa0, pa1, pa2, pa3); }
    VM_WAIT(); __syncthreads();
  }
  { int lane2 = threadIdx.x & 63, slot2 = slot; asm volatile("" : "+v"(lane2), "+s"(slot2));
    const int r32e = lane2 & 31, hie = lane2 >> 5;
    float* PO = (float*)(F.ws + WS_PO) + (size_t)slot2 * 256 * 256; float* ML = (float*)(F.ws + WS_ML) + (size_t)slot2 * 512;
    LAS float* wse = (LAS float*)(F.lds + LDS_WS) + wid * 64;
    if (hie == 0) { wse[r32e] = l_reg; ML[(wid * 32 + r32e) * 2] = m_reg; ML[(wid * 32 + r32e) * 2 + 1] = l_reg; }
    asm volatile("s_waitcnt lgkmcnt(0)" ::: "memory");
    char* Ob = (char*)(PO + (size_t)(wid * 32) * 256);
    const unsigned lo = (unsigned)(4 * hie * 256 + r32e) * 4u;
#pragma unroll
    for (int r = 0; r < 16; ++r) { const int rowc = (r & 3) + 8 * (r >> 2); const float lv = wse[rowc + 4 * hie]; const float rl = lv > 0.f ? __builtin_amdgcn_rcpf(lv) : 0.f;
#pragma unroll
      for (int d0 = 0; d0 < 8; ++d0) *(float*)(Ob + (lo + (unsigned)(rowc * 256 + d0 * 32) * 4u)) = o[d0][r] * rl;
      SBAR(); } }
  __syncthreads();
#undef STAGE_K
#undef STAGE_V
}

__device__ __forceinline__ void phase(const Frame& F, int ca, int NA) {
  int s0 = (int)(((long)ca * NSTEPS) / NA); const int s1 = (int)(((long)(ca + 1) * NSTEPS) / NA);
  while (s0 < s1) {
    const int bhm = s0 / STEPS_BHM, rem = s0 - bhm * STEPS_BHM;
    int qb = 0;
#pragma unroll 1
    for (int q = 1; q < 8; ++q) if (rem >= qb_start(q)) qb = q;
    const int j0 = rem - qb_start(qb), nst = 4 * qb + 5;
    const int j1 = (j0 + (s1 - s0) < nst) ? j0 + (s1 - s0) : nst;
    const int slot = bhm * 16 + qb + chunk_of(s0, NA) - chunk_of(bhm * STEPS_BHM, NA);
    segment(F, bhm, qb, j0, j1, slot);
    s0 += j1 - j0;
  }
}
#undef KSWZ
#undef SBAR
}
namespace ml {
constexpr int QST = 136, TST = 72;
constexpr int L_RQ = 0, L_RK = 17152, L_QS = 34304, L_QW = 51712, L_KS = 69120, L_KWT = 86528, L_VT = 104960  , L_SP = 0  , L_G = 141824, L_CW = 143872;
constexpr int L_HT = 0;
constexpr int G_A = 0, G_M = 64, G_WI = 128, G_EM = 192, G_DEN = 256, G_WG = 320, G_SC = 384, G_N = 0;
constexpr int L_NV = L_CW + 5120;
constexpr int L_SSQ = L_KWT;
__device__ __forceinline__ float shfl_up_f(float v, int d) { return __shfl_up(v, d); }

__device__ __forceinline__ void load_cw(const Frame& F, const Args& a, int h) {
  LAS float* CW = (LAS float*)(F.lds + L_CW);
  for (int e = F.tid; e < 2 * 5 * 128; e += NTHR) { const int qk = e / 640, j = (e / 128) % 5, d = e & 127; const int ch = qk * 512 + h * 128 + d;
    CW[e] = j < 4 ? a.in[IN_CW][j * 1024 + ch] : a.in[IN_CB][ch]; }
}
__device__ __forceinline__ void load_raw(const Frame& F, const bf16* g, int pos0, int lds_off) {
  for (int p = F.tid; p < 67 * 16; p += NTHR) { const int row = p >> 4, ch = p & 15, pos = pos0 - 3 + row;
    v4u v = {0u, 0u, 0u, 0u}; if (pos >= MPOS0) v = *(const v4u*)(g + (size_t)pos * 128 + ch * 8);
    *(LAS v4u*)(F.lds + lds_off + row * 256 + ch * 16) = v; }
}
__device__ __forceinline__ void conv16(const Frame& F, int qk, int lds_off, int t, int d0, float (&y)[16]) {
  const LAS float* CW = (const LAS float*)(F.lds + L_CW);
#pragma unroll
  for (int e = 0; e < 16; ++e) y[e] = CW[(qk * 5 + 4) * 128 + d0 + e];
#pragma unroll
  for (int j = 0; j < 4; ++j) { const LAS v4u* rp = (const LAS v4u*)(F.lds + lds_off + (t + j) * 256 + d0 * 2); const v4u r0 = rp[0], r1 = rp[1];
    const LAS float* cw = CW + (qk * 5 + j) * 128 + d0;
    y[0] += cw[0] * bflo(r0.x); y[1] += cw[1] * bfhi(r0.x); y[2] += cw[2] * bflo(r0.y); y[3] += cw[3] * bfhi(r0.y); y[4] += cw[4] * bflo(r0.z); y[5] += cw[5] * bfhi(r0.z); y[6] += cw[6] * bflo(r0.w); y[7] += cw[7] * bfhi(r0.w);
    y[8] += cw[8] * bflo(r1.x); y[9] += cw[9] * bfhi(r1.x); y[10] += cw[10] * bflo(r1.y); y[11] += cw[11] * bfhi(r1.y); y[12] += cw[12] * bflo(r1.z); y[13] += cw[13] * bfhi(r1.z); y[14] += cw[14] * bflo(r1.w); y[15] += cw[15] * bfhi(r1.w); }
#pragma unroll
  for (int e = 0; e < 16; ++e) y[e] = y[e] / (1.0f + __expf(-y[e]));
}
__device__ __forceinline__ void load_vt(const Frame& F, const bf16* MVg, int pos0) {
#pragma unroll
  for (int i = 0; i < 4; ++i) { const int p = F.tid + NTHR * i, row = p >> 5, ch = p & 31; v4u v4 = {0u, 0u, 0u, 0u};
    if (pos0 + row >= MPOS0) v4 = *(const v4u*)(MVg + (size_t)(pos0 + row) * 256 + ch * 8);
    LAS bf16* vt = (LAS bf16*)(F.lds + L_VT) + (ch * 8) * TST + row;
    vt[0 * TST] = (bf16)(v4.x & 0xffff); vt[1 * TST] = (bf16)(v4.x >> 16); vt[2 * TST] = (bf16)(v4.y & 0xffff); vt[3 * TST] = (bf16)(v4.y >> 16);
    vt[4 * TST] = (bf16)(v4.z & 0xffff); vt[5 * TST] = (bf16)(v4.z >> 16); vt[6 * TST] = (bf16)(v4.w & 0xffff); vt[7 * TST] = (bf16)(v4.w >> 16); }
}

__device__ __forceinline__ void taskA(const Frame& F, const Args& a, int task) {
  const int bh = task >> 5, c = task & 31, h = bh & 3, tid = F.tid, w = F.wave, lane = F.lane, fr = lane & 15, kq = lane >> 4, pos0 = 64 * c;
  LAS unsigned char* lds = F.lds; LAS float* G = (LAS float*)(lds + L_G);
  const bf16* MKg = (const bf16*)(F.ws + WS_MK) + (size_t)bh * PADT * 128; const bf16* MVg = (const bf16*)(F.ws + WS_MV) + (size_t)bh * PADT * 256;
  __syncthreads();
  load_cw(F, a, h); load_raw(F, MKg, pos0, L_RK); load_vt(F, MVg, pos0);
  if (w == 0) {
    const bool dead = pos0 + lane < MPOS0;
    const float li = dead ? -1e30f : ((const float*)(F.ws + WS_LI))[bh * PADT + pos0 + lane], lf = dead ? 0.f : ((const float*)(F.ws + WS_LF))[bh * PADT + pos0 + lane];
    float bs = lf;
#pragma unroll
    for (int d = 1; d < 64; d <<= 1) { const float o = shfl_up_f(bs, d); if (lane >= d) bs += o; }
    const float av = li - bs; float mx = av;
#pragma unroll
    for (int o = 1; o < 64; o <<= 1) mx = fmaxf(mx, __shfl_xor(mx, o));
    G[G_WG + lane] = __expf(av - mx);
    if (lane == 63) { float* gs = (float*)(F.ws + WS_GS) + (size_t)(bh * 33 + c) * 2; gs[0] = bs; gs[1] = mx; }
  }
  __syncthreads();
  { const int t = tid >> 3, d0 = (tid & 7) * 16; float y[16]; conv16(F, 1, L_RK, t, d0, y);
    const float sw = 0.08838834764831845f * G[G_WG + t]; LAS bf16* kt = (LAS bf16*)(lds + L_KWT) + d0 * TST + t;
#pragma unroll
    for (int e = 0; e < 16; ++e) kt[e * TST] = (bf16)f2bf(y[e] * sw); }
  __syncthreads();
  f32x4* DCg = (f32x4*)(F.ws + WS_DC) + ((size_t)(bh * 32 + c) * 128) * 64;
#pragma unroll
  for (int jj = 0; jj < 2; ++jj) { const int j = 2 * w + jj;
    const bf16x8 bv0 = *(const LAS bf16x8*)(lds + L_VT + ((16 * j + fr) * TST + 8 * kq) * 2), bv1 = *(const LAS bf16x8*)(lds + L_VT + ((16 * j + fr) * TST + 32 + 8 * kq) * 2);
#pragma unroll
    for (int i = 0; i < 8; ++i) { f32x4 acc = {0.f, 0.f, 0.f, 0.f};
      const bf16x8 k0 = *(const LAS bf16x8*)(lds + L_KWT + ((16 * i + fr) * TST + 8 * kq) * 2), k1 = *(const LAS bf16x8*)(lds + L_KWT + ((16 * i + fr) * TST + 32 + 8 * kq) * 2);
      acc = __builtin_amdgcn_mfma_f32_16x16x32_bf16(k0, bv0, acc, 0, 0, 0); acc = __builtin_amdgcn_mfma_f32_16x16x32_bf16(k1, bv1, acc, 0, 0, 0);
      DCg[(size_t)(i * 16 + j) * 64 + lane] = acc; } }
  if (tid < 128) { const LAS v4u* kr = (const LAS v4u*)(lds + L_KWT + tid * TST * 2); float s = 0.f;
#pragma unroll
    for (int q = 0; q < 8; ++q) { const v4u x = kr[q]; s += (bflo(x.x) + bfhi(x.x)) + (bflo(x.y) + bfhi(x.y)) + (bflo(x.z) + bfhi(x.z)) + (bflo(x.w) + bfhi(x.w)); }
    ((float*)(F.ws + WS_DN))[(size_t)(bh * 32 + c) * 128 + tid] = s; }
}

__device__ __forceinline__ void scanB(const Frame& F) {
  const float* GS = (const float*)(F.ws + WS_GS);
  LAS float* cf = (LAS float*)F.lds;
  for (int blk = blockIdx.x; blk < 16 * 16; blk += gridDim.x) { const int bh = blk >> 4, r = (blk & 15) * NTHR + F.tid, i = r >> 10, j = (r >> 6) & 15, ln = r & 63;
    __syncthreads();
    if (F.tid == 0) { float m = 0.f; for (int c = 0; c < 32; ++c) { const float bL = GS[(bh * 33 + c) * 2], ml = GS[(bh * 33 + c) * 2 + 1], me = fmaxf(m, ml);
        cf[2 * c] = __expf(m - me); cf[2 * c + 1] = __expf(ml - me); m = bL + me; } }
    __syncthreads();
    const f32x4* dc = (const f32x4*)(F.ws + WS_DC) + ((size_t)(bh * 32) * 128 + (i * 16 + j)) * 64 + ln;
    v2u* cs = (v2u*)(F.ws + WS_CS) + ((((size_t)bh * 33) * 4 + (i >> 1)) * 16 + j) * 64 * 2 + ln * 2 + (i & 1);
    f32x4 st = {0.f, 0.f, 0.f, 0.f};
#pragma unroll 8
    for (int c = 0; c < 32; ++c) { st = st * cf[2 * c] + dc[(size_t)c * 128 * 64] * cf[2 * c + 1];
      v2u o; o.x = pk2(st.x, st.y); o.y = pk2(st.z, st.w); cs[(size_t)(c + 1) * 4 * 16 * 64 * 2] = o; } }
  const int gt = blockIdx.x * NTHR + F.tid, NT = gridDim.x * NTHR;
  for (int g = gt; g < 16 * 128; g += NT) { const int bh = g >> 7, d = g & 127; float n = 0.f, m = 0.f;
    for (int c = 0; c < 32; ++c) { const float bL = GS[(bh * 33 + c) * 2], ml = GS[(bh * 33 + c) * 2 + 1], me = fmaxf(m, ml);
      n = n * __expf(m - me) + ((const float*)(F.ws + WS_DN))[(size_t)(bh * 32 + c) * 128 + d] * __expf(ml - me); m = bL + me;
      ((float*)(F.ws + WS_NS))[(size_t)(bh * 33 + c + 1) * 128 + d] = n; if (d == 0) ((float*)(F.ws + WS_MS))[bh * 33 + c + 1] = m; } }
}

__device__ __forceinline__ void taskC(const Frame& F, const Args& a, int task) {
  const int bh = task >> 5, c = (task & 31) + 1, b = bh >> 2, h = bh & 3, tid = F.tid, w = F.wave, lane = F.lane, fr = lane & 15, kq = lane >> 4, pos0 = 64 * c;
  LAS unsigned char* lds = F.lds; LAS float* G = (LAS float*)(lds + L_G); LAS float* NV = (LAS float*)(lds + L_NV);
  const bf16* MQg = (const bf16*)(F.ws + WS_MQ) + (size_t)bh * PADT * 128; const bf16* MKg = (const bf16*)(F.ws + WS_MK) + (size_t)bh * PADT * 128;
  const bf16* MVg = (const bf16*)(F.ws + WS_MV) + (size_t)bh * PADT * 256;
  const float m = ((const float*)(F.ws + WS_MS))[bh * 33 + c];
  __syncthreads();
  load_cw(F, a, h); load_raw(F, MQg, pos0, L_RQ); load_raw(F, MKg, pos0, L_RK); load_vt(F, MVg, pos0);
  if (tid < 128) NV[tid] = ((const float*)(F.ws + WS_NS))[(size_t)(bh * 33 + c) * 128 + tid];
  if (w == 0) {
    const float li = ((const float*)(F.ws + WS_LI))[bh * PADT + pos0 + lane], lf = ((const float*)(F.ws + WS_LF))[bh * PADT + pos0 + lane];
    float bs = lf;
#pragma unroll
    for (int d = 1; d < 64; d <<= 1) { const float o = shfl_up_f(bs, d); if (lane >= d) bs += o; }
    const float av = li - bs; float cm = av;
#pragma unroll
    for (int d = 1; d < 64; d <<= 1) { const float o = shfl_up_f(cm, d); if (lane >= d) cm = fmaxf(cm, o); }
    const float Mt = fmaxf(m, cm);
    G[G_A + lane] = av; G[G_M + lane] = Mt; G[G_WI + lane] = __expf(m - Mt); G[G_EM + lane] = __expf(-(bs + Mt));
  }
  __syncthreads();
  { const int t = tid >> 3, d0 = (tid & 7) * 16; const float wi = G[G_WI + t]; float y[16];
    conv16(F, 0, L_RQ, t, d0, y);
    { v4u o0, o1, w0, w1;
      o0.x = pk2(y[0], y[1]); o0.y = pk2(y[2], y[3]); o0.z = pk2(y[4], y[5]); o0.w = pk2(y[6], y[7]); o1.x = pk2(y[8], y[9]); o1.y = pk2(y[10], y[11]); o1.z = pk2(y[12], y[13]); o1.w = pk2(y[14], y[15]);
      w0.x = pk2(y[0] * wi, y[1] * wi); w0.y = pk2(y[2] * wi, y[3] * wi); w0.z = pk2(y[4] * wi, y[5] * wi); w0.w = pk2(y[6] * wi, y[7] * wi);
      w1.x = pk2(y[8] * wi, y[9] * wi); w1.y = pk2(y[10] * wi, y[11] * wi); w1.z = pk2(y[12] * wi, y[13] * wi); w1.w = pk2(y[14] * wi, y[15] * wi);
      LAS v4u* qs = (LAS v4u*)(lds + L_QS + (t * QST + d0) * 2); qs[0] = o0; qs[1] = o1;
      LAS v4u* qw = (LAS v4u*)(lds + L_QW + (t * QST + d0) * 2); qw[0] = w0; qw[1] = w1; }
    __builtin_amdgcn_sched_barrier(0);
    conv16(F, 1, L_RK, t, d0, y);
    { const float sc = 0.08838834764831845f; v4u o0, o1;
      o0.x = pk2(y[0] * sc, y[1] * sc); o0.y = pk2(y[2] * sc, y[3] * sc); o0.z = pk2(y[4] * sc, y[5] * sc); o0.w = pk2(y[6] * sc, y[7] * sc);
      o1.x = pk2(y[8] * sc, y[9] * sc); o1.y = pk2(y[10] * sc, y[11] * sc); o1.z = pk2(y[12] * sc, y[13] * sc); o1.w = pk2(y[14] * sc, y[15] * sc);
      LAS v4u* ks = (LAS v4u*)(lds + L_KS + (t * QST + d0) * 2); ks[0] = o0; ks[1] = o1; } }
  __syncthreads();
  v4u cb[4][2];
  { const v4u* cs = (const v4u*)(F.ws + WS_CS) + (((size_t)bh * 33 + c) * 4 * 16) * 64;
#pragma unroll
    for (int I = 0; I < 4; ++I)
#pragma unroll
      for (int jj = 0; jj < 2; ++jj) cb[I][jj] = cs[(size_t)(I * 16 + 2 * w + jj) * 64 + lane]; }
  { const int si = w >> 1; const f32x4 as = *(const LAS f32x4*)(G + G_A + 16 * si + 4 * kq);
#pragma unroll
    for (int tt = 0; tt < 2; ++tt) { const int ti = 2 * (w & 1) + tt; f32x4 acc = {0.f, 0.f, 0.f, 0.f};
#pragma unroll
      for (int ks = 0; ks < 4; ++ks) { const bf16x8 af = *(const LAS bf16x8*)(lds + L_KS + ((16 * si + fr) * QST + 32 * ks + 8 * kq) * 2);
        const bf16x8 bfr = *(const LAS bf16x8*)(lds + L_QS + ((16 * ti + fr) * QST + 32 * ks + 8 * kq) * 2);
        acc = __builtin_amdgcn_mfma_f32_16x16x32_bf16(af, bfr, acc, 0, 0, 0); }
      const int t = 16 * ti + fr, s0 = 16 * si + 4 * kq; const float Mt = G[G_M + t];
      const float v0 = (s0 + 0 <= t) ? acc.x * __expf(as.x - Mt) : 0.f, v1 = (s0 + 1 <= t) ? acc.y * __expf(as.y - Mt) : 0.f;
      const float v2 = (s0 + 2 <= t) ? acc.z * __expf(as.z - Mt) : 0.f, v3 = (s0 + 3 <= t) ? acc.w * __expf(as.w - Mt) : 0.f;
      v2u o; o.x = pk2(v0, v1); o.y = pk2(v2, v3);
      *(LAS v2u*)(lds + L_SP + (t * TST + s0) * 2) = o; } }
  __syncthreads();
  if (w == 0) { const int t = lane; float qn = 0.f, rsum = 0.f;
#pragma unroll 4
    for (int q = 0; q < 16; ++q) { const v4u x = *(const LAS v4u*)(lds + L_QS + (t * QST + q * 8) * 2); const f32x4 n0 = *(const LAS f32x4*)(NV + q * 8), n1 = *(const LAS f32x4*)(NV + q * 8 + 4);
      qn += bflo(x.x) * n0.x + bfhi(x.x) * n0.y + bflo(x.y) * n0.z + bfhi(x.y) * n0.w + bflo(x.z) * n1.x + bfhi(x.z) * n1.y + bflo(x.w) * n1.z + bfhi(x.w) * n1.w; }
#pragma unroll
    for (int q = 0; q < 8; ++q) { const v4u x = *(const LAS v4u*)(lds + L_SP + (t * TST + q * 8) * 2); rsum += (bflo(x.x) + bfhi(x.x)) + (bflo(x.y) + bfhi(x.y)) + (bflo(x.z) + bfhi(x.z)) + (bflo(x.w) + bfhi(x.w)); }
    const float den = G[G_WI + t] * qn + rsum; G[G_DEN + t] = fmaxf(fabsf(den), G[G_EM + t]); }
  f32x4 acc[2][4];
#pragma unroll
  for (int jj = 0; jj < 2; ++jj)
#pragma unroll
    for (int ti = 0; ti < 4; ++ti) acc[jj][ti] = (f32x4){0.f, 0.f, 0.f, 0.f};
#pragma unroll
  for (int I = 0; I < 4; ++I) {
#pragma unroll
    for (int ti = 0; ti < 4; ++ti) { const LAS unsigned char* qp = lds + L_QW + ((16 * ti + fr) * QST + 32 * I + 4 * kq) * 2;
      const v2u a0 = *(const LAS v2u*)qp, a1 = *(const LAS v2u*)(qp + 32); const v4u av = {a0.x, a0.y, a1.x, a1.y};
      acc[0][ti] = __builtin_amdgcn_mfma_f32_16x16x32_bf16(__builtin_bit_cast(bf16x8, av), __builtin_bit_cast(bf16x8, cb[I][0]), acc[0][ti], 0, 0, 0);
      acc[1][ti] = __builtin_amdgcn_mfma_f32_16x16x32_bf16(__builtin_bit_cast(bf16x8, av), __builtin_bit_cast(bf16x8, cb[I][1]), acc[1][ti], 0, 0, 0); }
    __builtin_amdgcn_sched_barrier(0); }
#pragma unroll
  for (int ks = 0; ks < 2; ++ks) { const bf16x8 bv0 = *(const LAS bf16x8*)(lds + L_VT + ((32 * w + fr) * TST + 32 * ks + 8 * kq) * 2), bv1 = *(const LAS bf16x8*)(lds + L_VT + ((32 * w + 16 + fr) * TST + 32 * ks + 8 * kq) * 2);
#pragma unroll
    for (int ti = 0; ti < 4; ++ti) { const bf16x8 sf = *(const LAS bf16x8*)(lds + L_SP + ((16 * ti + fr) * TST + 32 * ks + 8 * kq) * 2);
      acc[0][ti] = __builtin_amdgcn_mfma_f32_16x16x32_bf16(sf, bv0, acc[0][ti], 0, 0, 0); acc[1][ti] = __builtin_amdgcn_mfma_f32_16x16x32_bf16(sf, bv1, acc[1][ti], 0, 0, 0); } }
  __syncthreads();
  LAS float* SSQ = (LAS float*)(lds + L_SSQ);
#pragma unroll
  for (int ti = 0; ti < 4; ++ti) { const f32x4 dn = *(const LAS f32x4*)(G + G_DEN + 16 * ti + 4 * kq);
    f32x4 s4;
#pragma unroll
    for (int r = 0; r < 4; ++r) { const float h0 = acc[0][ti][r] / dn[r], h1 = acc[1][ti][r] / dn[r]; acc[0][ti][r] = h0; acc[1][ti][r] = h1; s4[r] = h0 * h0 + h1 * h1; }
#pragma unroll
    for (int o = 1; o < 16; o <<= 1) { s4.x += __shfl_xor(s4.x, o); s4.y += __shfl_xor(s4.y, o); s4.z += __shfl_xor(s4.z, o); s4.w += __shfl_xor(s4.w, o); }
    if (fr == 0) { SSQ[(16 * ti + 4 * kq + 0) * 8 + w] = s4.x; SSQ[(16 * ti + 4 * kq + 1) * 8 + w] = s4.y; SSQ[(16 * ti + 4 * kq + 2) * 8 + w] = s4.z; SSQ[(16 * ti + 4 * kq + 3) * 8 + w] = s4.w; } }
  __syncthreads();
  LAS bf16* HT = (LAS bf16*)(lds + L_HT);
#pragma unroll
  for (int ti = 0; ti < 4; ++ti)
#pragma unroll
    for (int r = 0; r < 4; ++r) { const int t = 16 * ti + 4 * kq + r; const f32x4 p0 = *(const LAS f32x4*)(SSQ + t * 8), p1 = *(const LAS f32x4*)(SSQ + t * 8 + 4);
      const float rh = rsqrtf(((p0.x + p0.y) + (p0.z + p0.w) + (p1.x + p1.y) + (p1.z + p1.w)) * (1.0f / 256.f) + EPS);
      HT[t * 264 + 32 * w + fr] = (bf16)f2bf(acc[0][ti][r] * rh); HT[t * 264 + 32 * w + 16 + fr] = (bf16)f2bf(acc[1][ti][r] * rh); }
  __syncthreads();
  { const int t = tid >> 3, c0 = (tid & 7) * 32; const size_t R = (size_t)b * SEQ + 64 * (c - 1) + t;
    const bf16* mo = (const bf16*)(F.ws + WS_MO) + R * 1024 + h * 256 + c0; const float* og = a.in[IN_OUTG] + h * 256 + c0; bf16* A2 = (bf16*)(F.ws + WS_A2) + R * DM + 1024 + h * 256 + c0;
#pragma unroll
    for (int q = 0; q < 4; ++q) { const v4u hv = *(const LAS v4u*)(HT + t * 264 + c0 + q * 8); const v4u mv = *(const v4u*)(mo + q * 8); const f32x4 g0 = *(const f32x4*)(og + q * 8), g1 = *(const f32x4*)(og + q * 8 + 4);
      v4u o; o.x = pk2(bflo(hv.x) * g0.x * bflo(mv.x), bfhi(hv.x) * g0.y * bfhi(mv.x)); o.y = pk2(bflo(hv.y) * g0.z * bflo(mv.y), bfhi(hv.y) * g0.w * bfhi(mv.y));
      o.z = pk2(bflo(hv.z) * g1.x * bflo(mv.z), bfhi(hv.z) * g1.y * bfhi(mv.z)); o.w = pk2(bflo(hv.w) * g1.z * bflo(mv.w), bfhi(hv.w) * g1.w * bfhi(mv.w));
      *(v4u*)(A2 + q * 8) = o; } }
}
}
__device__ __forceinline__ void p3_combine(const Frame& F, const Args& a, int NA) {
  const float* PO = (const float*)(F.ws + WS_PO); const float* ML = (const float*)(F.ws + WS_ML);
  bf16* A2 = (bf16*)(F.ws + WS_A2);
  const float lam = *(const float*)(F.ws + WS_LAM);
  const float* subg = a.in[IN_SUBG];
  const int gw = blockIdx.x * NWAVES + F.wave, NGW = gridDim.x * NWAVES, lane = F.lane;
  const f32x4 sg = ((const f32x4*)subg)[lane];
  for (int R = gw; R < MROWS; R += NGW) {
    const int b = R >> 11, t = R & 2047, qb = t >> 8, rq = t & 255;
#pragma unroll 2
    for (int h = 0; h < 4; ++h) {
      f32x4 om[2];
#pragma unroll
      for (int m = 0; m < 2; ++m) {
        const int bhm = (b * 4 + h) * 2 + m, first = bhm * att::STEPS_BHM + att::qb_start(qb), last = first + 4 * qb + 4;
        const int cf = att::chunk_of(first, NA), np = att::chunk_of(last, NA) - cf + 1, slot0 = bhm * 16 + qb + cf - att::chunk_of(bhm * att::STEPS_BHM, NA);
        float mp[3], lp[3]; f32x4 op[3];
#pragma unroll
        for (int p = 0; p < 3; ++p) { if (p < np) { const int slot = slot0 + p; mp[p] = ML[(size_t)slot * 512 + rq * 2]; lp[p] = ML[(size_t)slot * 512 + rq * 2 + 1];
            op[p] = ((const f32x4*)(PO + ((size_t)slot * 256 + rq) * 256))[lane]; } else { mp[p] = -1e30f; lp[p] = 0.f; op[p] = (f32x4){0.f, 0.f, 0.f, 0.f}; } }
        const float M = fmaxf(mp[0], fmaxf(mp[1], mp[2]));
        float wsum = 0.f; f32x4 acc = (f32x4){0.f, 0.f, 0.f, 0.f};
#pragma unroll
        for (int p = 0; p < 3; ++p) { const float w = lp[p] * exp2f(mp[p] - M); wsum += w; acc += op[p] * w; }
        om[m] = acc * (1.0f / wsum);
      }
      const f32x4 o = om[0] - om[1] * lam;
      const float rs = rsqrtf(wave_sum((o.x * o.x + o.y * o.y) + (o.z * o.z + o.w * o.w)) * (1.0f / 256.f) + EPS) * 0.8f;
      v2u w; w.x = pk2(o.x * rs * sg.x, o.y * rs * sg.y); w.y = pk2(o.z * rs * sg.z, o.w * rs * sg.w);
      ((v2u*)(A2 + (size_t)R * DM + h * 256))[lane] = w;
    }
  }
}
struct EpiRes {
  static constexpr bool PERM = true, AFTER_DRAIN = false;
  const float* x; float* out; bf16* H1b; float* SSQ;
  __device__ __forceinline__ void operator()(const pg8::f32x4 (&acc)[2][2][4][2], const pg8::Unit& u, int wr, int wc, int fr, int fq) const {
    const int row0 = u.pm * 256 + wr * 64 + fr, col0 = u.pn * 256 + wc * 32 + 8 * fq;
#pragma unroll
    for (int ai = 0; ai < 2; ++ai)
#pragma unroll
      for (int m = 0; m < 4; ++m) { const size_t R = (size_t)(row0 + ai * 128 + m * 16); float s = 0.f;
#pragma unroll
        for (int bj = 0; bj < 2; ++bj) { const size_t off = R * DM + col0 + bj * 128;
          const f32x4 x0 = *(const f32x4*)(x + off), x1 = *(const f32x4*)(x + off + 4);
          const f32x4 v0 = acc[ai][bj][m][0] + x0, v1 = acc[ai][bj][m][1] + x1;
          v4u w; w.x = pk2(v0.x, v0.y); w.y = pk2(v0.z, v0.w); w.z = pk2(v1.x, v1.y); w.w = pk2(v1.z, v1.w);
          *(v4u*)(H1b + off) = w;
          s += (v0.x * v0.x + v0.y * v0.y) + (v0.z * v0.z + v0.w * v0.w) + (v1.x * v1.x + v1.y * v1.y) + (v1.z * v1.z + v1.w * v1.w); }
        s += __shfl_xor(s, 16); s += __shfl_xor(s, 32);
        if (fq == 0) SSQ[R * 32 + u.pn * 4 + wc] = s; }
  }
};
#ifndef PEER_U_FP8
#define PEER_U_FP8 0
#endif
typedef __bf16 bfv2 __attribute__((ext_vector_type(2)));
__device__ __forceinline__ void split_hl(const f32x4 a, const f32x4 b, bf16x8& hi, bf16x8& lo) {
  float v[8] = {a.x, a.y, a.z, a.w, b.x, b.y, b.z, b.w}; unsigned h[8], l[8];
#pragma unroll
  for (int i = 0; i < 8; ++i) { h[i] = f2bf(v[i]); l[i] = f2bf(v[i] - __builtin_bit_cast(float, h[i] << 16)); }
  v4u hv = {h[0] | (h[1] << 16), h[2] | (h[3] << 16), h[4] | (h[5] << 16), h[6] | (h[7] << 16)};
  v4u lv = {l[0] | (l[1] << 16), l[2] | (l[3] << 16), l[4] | (l[5] << 16), l[6] | (l[7] << 16)};
  hi = __builtin_bit_cast(bf16x8, hv); lo = __builtin_bit_cast(bf16x8, lv);
}
__device__ __forceinline__ void p0_w3t(const Frame& F, const Args& a) {
  const float* wq = a.in[IN_WQ]; const float* sk = a.in[IN_SUBK]; const float* g2 = a.in[IN_G2];
  bf16* W3t = (bf16*)(F.ws + WS_W3T);
  const int gw = blockIdx.x * NWAVES + F.wave, NGW = gridDim.x * NWAVES, lane = F.lane, fr = lane & 15, fq = lane >> 4;
  for (int task = gw; task < 128 * 16; task += NGW) {
    const int kt = task >> 4, hh = task & 15;
    bf16x8 ahi[4], alo[4];
    const float* ap = wq + (size_t)(kt * 16 + fr) * DM + hh * 128 + fq * 8;
#pragma unroll
    for (int s = 0; s < 4; ++s) split_hl(*(const f32x4*)(ap + 32 * s), *(const f32x4*)(ap + 32 * s + 4), ahi[s], alo[s]);
    const f32x4 gk = *(const f32x4*)(g2 + kt * 16 + fq * 4);
#pragma unroll 1
    for (int t2 = 0; t2 < 8; ++t2) {
      const float* bp = sk + (size_t)(hh * 128 + t2 * 16 + fr) * 128 + fq * 8;
      f32x4 acc = {0.f, 0.f, 0.f, 0.f};
#pragma unroll
      for (int s = 0; s < 4; ++s) { bf16x8 bhi, blo; split_hl(*(const f32x4*)(bp + 32 * s), *(const f32x4*)(bp + 32 * s + 4), bhi, blo);
        acc = __builtin_amdgcn_mfma_f32_16x16x32_bf16(ahi[s], bhi, acc, 0, 0, 0);
        acc = __builtin_amdgcn_mfma_f32_16x16x32_bf16(ahi[s], blo, acc, 0, 0, 0);
        acc = __builtin_amdgcn_mfma_f32_16x16x32_bf16(alo[s], bhi, acc, 0, 0, 0); }
      v2u o; o.x = pk2(acc.x * gk.x, acc.y * gk.y); o.y = pk2(acc.z * gk.z, acc.w * gk.w);
      *(v2u*)(W3t + (size_t)(hh * 128 + t2 * 16 + fr) * DM + kt * 16 + fq * 4) = o;
    }
  }
}
typedef float f32x2v __attribute__((ext_vector_type(2)));
__device__ __forceinline__ void p0_tables(const Frame& F, const Args& a) {
  const float* g2 = a.in[IN_G2];
  float* SCL = (float*)(F.ws + WS_SCL);
  const int gw = blockIdx.x * NWAVES + F.wave, NGW = gridDim.x * NWAVES, lane = F.lane;
  f32x4 gl[8];
#pragma unroll
  for (int q = 0; q < 8; ++q) gl[q] = *(const f32x4*)(g2 + lane * 32 + q * 4);
  f32x4 xn[8];
  { const int row = gw; if (row < 2 * 16384) { const float* src = a.in[row >= 16384 ? IN_V : IN_U] + (size_t)(row & 16383) * DM + lane * 32;
#pragma unroll
      for (int q = 0; q < 8; ++q) xn[q] = *(const f32x4*)(src + q * 4); } }
  for (int row = gw; row < 2 * 16384; row += NGW) {
    const bool isv = row >= 16384; const int e = row & 16383;
    f32x4 x[8];
#pragma unroll
    for (int q = 0; q < 8; ++q) x[q] = xn[q];
    { const int rn = row + NGW; if (rn < 2 * 16384) { const float* src = a.in[rn >= 16384 ? IN_V : IN_U] + (size_t)(rn & 16383) * DM + lane * 32;
#pragma unroll
        for (int q = 0; q < 8; ++q) xn[q] = *(const f32x4*)(src + q * 4); } }
    float amax = 0.f;
#pragma unroll
    for (int q = 0; q < 8; ++q) { if (!isv) x[q] = x[q] * gl[q]; amax = fmaxf(amax, fmaxf(fmaxf(fabsf(x[q].x), fabsf(x[q].y)), fmaxf(fabsf(x[q].z), fabsf(x[q].w)))); }
#pragma unroll
    for (int o = 1; o < 64; o <<= 1) amax = fmaxf(amax, __shfl_xor(amax, o));
    const float sc = amax > 0.f ? 6.0f / amax : 1.0f;
    v4u w;
#pragma unroll
    for (int d = 0; d < 4; ++d) { unsigned pk = 0u;
      pk = __builtin_amdgcn_cvt_scalef32_pk_fp4_f32(pk, x[2 * d].x * sc, x[2 * d].y * sc, 1.0f, 0); pk = __builtin_amdgcn_cvt_scalef32_pk_fp4_f32(pk, x[2 * d].z * sc, x[2 * d].w * sc, 1.0f, 1);
      pk = __builtin_amdgcn_cvt_scalef32_pk_fp4_f32(pk, x[2 * d + 1].x * sc, x[2 * d + 1].y * sc, 1.0f, 2); pk = __builtin_amdgcn_cvt_scalef32_pk_fp4_f32(pk, x[2 * d + 1].z * sc, x[2 * d + 1].w * sc, 1.0f, 3);
      w[d] = pk; }
    *(v4u*)(F.ws + (isv ? WS_VB8 : WS_UB) + (size_t)e * 1024 + lane * 16) = w;
    if (lane == 0) SCL[row] = 1.0f / sc;
  }
}
struct EpiScore {
  static constexpr bool PERM = true, AFTER_DRAIN = false;
  float* S; const LAS float* rs;
  __device__ __forceinline__ void operator()(const pg8::f32x4 (&acc)[2][2][4][2], const pg8::Unit& u, int wr, int wc, int fr, int fq) const {
    const int rl0 = wr * 64 + fr, keyb = wc * 32 + 8 * fq;
#pragma unroll
    for (int ai = 0; ai < 2; ++ai)
#pragma unroll
      for (int m = 0; m < 4; ++m) { const int rl = rl0 + ai * 128 + m * 16; const float r = rs[rl]; const int row = u.pm * 256 + rl;
#pragma unroll
        for (int bj = 0; bj < 2; ++bj) { float* d = S + ((size_t)((row >> 5) * 16 + u.pn * 2 + bj) * 128 + keyb) * 32 + (row & 31);
          const pg8::f32x4 v0 = acc[ai][bj][m][0] * r, v1 = acc[ai][bj][m][1] * r;
          d[0] = v0[0]; d[32] = v0[1]; d[64] = v0[2]; d[96] = v0[3]; d[128] = v1[0]; d[160] = v1[1]; d[192] = v1[2]; d[224] = v1[3]; } }
  }
};

__device__ __forceinline__ unsigned fkey(float f) { const unsigned b = __builtin_bit_cast(unsigned, f); return b ^ ((b >> 31) ? 0xFFFFFFFFu : 0x80000000u); }
template <int NV, int K> __device__ __forceinline__ void wave_topk(const unsigned (&u)[NV], bool (&sel)[NV], int lane) {
  unsigned prefix = 0u; int cge = NV * 64;
#pragma unroll 1
  for (int bit = 31; bit >= 0 && cge != K; --bit) {
    const unsigned cand = prefix | (1u << bit); int c = 0;
#pragma unroll
    for (int i = 0; i < NV; ++i) c += __builtin_popcountll(__ballot(u[i] >= cand));
    if (c >= K) { prefix = cand; cge = c; }
  }
  int cgt = 0;
#pragma unroll
  for (int i = 0; i < NV; ++i) cgt += __builtin_popcountll(__ballot(u[i] > prefix));
  int need = K - cgt;
  const unsigned long long lm = (1ull << lane) - 1ull;
#pragma unroll
  for (int i = 0; i < NV; ++i) { const unsigned long long eq = __ballot(u[i] == prefix); const int before = __builtin_popcountll(eq & lm);
    sel[i] = (u[i] > prefix) || (u[i] == prefix && before < need); const int ne = __builtin_popcountll(eq); need = need > ne ? need - ne : 0; }
}
template <int NG, int NV, int K> __device__ __forceinline__ void wave_topk_multi(const unsigned (&u)[NG][NV], bool (&sel)[NG][NV], int lane) {
  unsigned prefix[NG]; int cge[NG];
#pragma unroll
  for (int g = 0; g < NG; ++g) { prefix[g] = 0u; cge[g] = NV * 64; }
#pragma unroll 1
  for (int bit = 31; bit >= 0; --bit) {
    bool done = true;
#pragma unroll
    for (int g = 0; g < NG; ++g) done = done && (cge[g] == K);
    if (done) break;
#pragma unroll
    for (int g = 0; g < NG; ++g) { const unsigned cand = prefix[g] | (1u << bit); int c = 0;
#pragma unroll
      for (int i = 0; i < NV; ++i) c += __builtin_popcountll(__ballot(u[g][i] >= cand));
      if (cge[g] != K && c >= K) { prefix[g] = cand; cge[g] = c; } }
  }
  const unsigned long long lm = (1ull << lane) - 1ull;
#pragma unroll
  for (int g = 0; g < NG; ++g) { int cgt = 0;
#pragma unroll
    for (int i = 0; i < NV; ++i) cgt += __builtin_popcountll(__ballot(u[g][i] > prefix[g]));
    int need = K - cgt;
#pragma unroll
    for (int i = 0; i < NV; ++i) { const unsigned long long eq = __ballot(u[g][i] == prefix[g]); const int before = __builtin_popcountll(eq & lm);
      sel[g][i] = (u[g][i] > prefix[g]) || (u[g][i] == prefix[g] && before < need); const int ne = __builtin_popcountll(eq); need = need > ne ? need - ne : 0; } }
}
__device__ __forceinline__ float gelu_erf(float v) {
  const float av = fabsf(v), t = __builtin_amdgcn_rcpf(1.0f + 0.2316418882f * av);
  float q = t * 0.5307027145f - 0.7265760135f; q = q * t + 0.7107068705f; q = q * t - 0.142248368f; q = q * t + 0.127414796f; q = q * t;
  const float tail = q * __builtin_amdgcn_exp2f(v * v * -0.72134752044f);
  return v < 0.f ? v * tail : v - v * tail;
}

#ifndef ROUTE_REPS
#define ROUTE_REPS 1
#endif
__device__ __forceinline__ void ins16(float (&t)[16], float x) {
#pragma unroll
  for (int i = 15; i >= 1; --i) t[i] = __builtin_amdgcn_fmed3f(t[i - 1], t[i], x);
  t[0] = fmaxf(t[0], x);
}
__device__ __forceinline__ void p6_peer(const Frame& F, const Args& a, float* dst_base) {
  const float* S2 = (const float*)(F.ws + WS_S); const float* SSQ = (const float*)(F.ws + WS_SSQ); const bf16* H1b = (const bf16*)(F.ws + WS_H1B);
  int lane = F.lane, wv = F.wave, tid = F.tid; asm volatile("" : "+v"(lane), "+s"(wv), "+v"(tid));
  int* EIDg = (int*)(F.ws + WS_EID); float* EGTg = (float*)(F.ws + WS_EGT);
  LAS int* eid = (LAS int*)(F.lds + wv * 1536); LAS float* egt = (LAS float*)(eid + 128); LAS float* esu = (LAS float*)(eid + 256);
  LAS unsigned char* RB = F.lds + 12288 + wv * 16384;
  LAS float* L1 = (LAS float*)(F.lds + 12288);
  for (int tb = blockIdx.x; tb < MROWS / 32; tb += gridDim.x) {
    __syncthreads();
    {
      const int g = tid >> 5, tl = tid & 31; const float* src = S2 + ((size_t)(tb * 16 + g) * 128) * 32 + tl;
      float t[16];
#pragma unroll
      for (int i = 0; i < 16; ++i) t[i] = -INFINITY;
#pragma unroll 32
      for (int k = 0; k < 128; ++k) { const float x = src[k * 32]; ins16(t, __builtin_bit_cast(float, (__builtin_bit_cast(unsigned, x) & ~0x7Fu) | (unsigned)(127 - k))); }
#pragma unroll
      for (int i = 0; i < 16; ++i) L1[(g * 16 + i) * 32 + tl] = t[i];
    }
    __syncthreads();
    if (tid < 256) {
      const int h8 = tid >> 5, tl = tid & 31; const LAS float* LA = L1 + ((2 * h8) * 16) * 32 + tl; const LAS float* LB = L1 + ((2 * h8 + 1) * 16) * 32 + tl;
      float A[16], B[16], t[16];
#pragma unroll
      for (int i = 0; i < 16; ++i) { A[i] = LA[i * 32]; B[i] = LB[i * 32]; t[i] = -INFINITY; }
#pragma unroll
      for (int i = 0; i < 16; ++i)
#pragma unroll
        for (int j = 0; j < 16; ++j) if ((i + 1) * (j + 1) <= 16) { const float c = A[i] + B[j];
            ins16(t, __builtin_bit_cast(float, (__builtin_bit_cast(unsigned, c) & ~0xFFu) | (unsigned)(255 - (i * 16 + j)))); }
      float ev[16], es = 0.f;
#pragma unroll
      for (int r = 0; r < 16; ++r) { ev[r] = __expf(t[r] - t[0]); es += ev[r]; }
      const float inv = 1.0f / es;
#pragma unroll
      for (int r = 0; r < 16; ++r) { const unsigned flat = 255u - (__builtin_bit_cast(unsigned, t[r]) & 0xFFu), ii = flat >> 4, jj = flat & 15u;
        const unsigned ka = 127u - (__builtin_bit_cast(unsigned, LA[ii * 32]) & 0x7Fu), kb = 127u - (__builtin_bit_cast(unsigned, LB[jj * 32]) & 0x7Fu);
        EIDg[(size_t)(tb * 32 + tl) * 128 + h8 * 16 + r] = (int)(ka * 128u + kb); EGTg[(size_t)(tb * 32 + tl) * 128 + h8 * 16 + r] = ev[r] * inv; }
    }
    asm volatile("s_waitcnt vmcnt(0)" ::: "memory"); __syncthreads();
#pragma unroll 1
    for (int tt = 0; tt < 4; ++tt) {
    const int tl = wv * 4 + tt, tok = tb * 32 + tl;
    const float rs = rsqrtf(wave_sum_dpp(lane < 32 ? SSQ[(size_t)tok * 32 + lane] : 0.f) * (1.0f / DM) + EPS);
    { const float* SCL = (const float*)(F.ws + WS_SCL);
#pragma unroll
      for (int i = 0; i < 2; ++i) { const int e = lane + 64 * i, idq = __builtin_nontemporal_load(EIDg + (size_t)tok * 128 + e); eid[e] = idq; esu[e] = SCL[idq]; egt[e] = __builtin_nontemporal_load(EGTg + (size_t)tok * 128 + e) * SCL[16384 + idq]; } }
    unsigned xw[16];
    { const v4u* xp = (const v4u*)(H1b + (size_t)tok * DM + (size_t)lane * 32);
#pragma unroll
      for (int q = 0; q < 4; ++q) { const v4u x0 = xp[q]; xw[4 * q] = x0.x; xw[4 * q + 1] = x0.y; xw[4 * q + 2] = x0.z; xw[4 * q + 3] = x0.w; } }
    float y[32];
#pragma unroll
    for (int i = 0; i < 32; ++i) y[i] = 0.f;
    asm volatile("s_waitcnt vmcnt(0) lgkmcnt(0)" ::: "memory");
    const unsigned char* U8 = F.ws + WS_UB; const unsigned char* V8 = F.ws + WS_VB8;
#define PG_ISSUE(E) do { const int idq_ = __builtin_amdgcn_readfirstlane(eid[(E)]); LAS unsigned char* sl_ = RB + ((E) & 7) * 2048; \
      __builtin_amdgcn_global_load_lds((const unsigned*)(U8 + (size_t)idq_ * 1024 + lane * 16), (LAS unsigned*)sl_, 16, 0, 0); \
      __builtin_amdgcn_global_load_lds((const unsigned*)(V8 + (size_t)idq_ * 1024 + lane * 16), (LAS unsigned*)(sl_ + 1024), 16, 0, 0); } while (0)
#define PG_DOT(UW, DACC) do { float da_ = 0.f, db_ = 0.f; _Pragma("unroll") for (int dd = 0; dd < 4; ++dd) { const unsigned wa = UW[dd]; \
          da_ = __builtin_amdgcn_fdot2_f32_bf16(__builtin_bit_cast(bfv2, xw[4 * dd + 0]), __builtin_amdgcn_cvt_scalef32_pk_bf16_fp4(wa, 1.0f, 0), da_, false); \
          db_ = __builtin_amdgcn_fdot2_f32_bf16(__builtin_bit_cast(bfv2, xw[4 * dd + 1]), __builtin_amdgcn_cvt_scalef32_pk_bf16_fp4(wa, 1.0f, 1), db_, false); \
          da_ = __builtin_amdgcn_fdot2_f32_bf16(__builtin_bit_cast(bfv2, xw[4 * dd + 2]), __builtin_amdgcn_cvt_scalef32_pk_bf16_fp4(wa, 1.0f, 2), da_, false); \
          db_ = __builtin_amdgcn_fdot2_f32_bf16(__builtin_bit_cast(bfv2, xw[4 * dd + 3]), __builtin_amdgcn_cvt_scalef32_pk_bf16_fp4(wa, 1.0f, 3), db_, false); } DACC = da_ + db_; } while (0)
#define PG_AXPY(VW, CF) do { _Pragma("unroll") for (int dd = 0; dd < 4; ++dd) { const unsigned wa = VW[dd]; \
          { const f32x2v v2 = __builtin_amdgcn_cvt_scalef32_pk_f32_fp4(wa, 1.0f, 0); y[8 * dd + 0] += CF * v2.x; y[8 * dd + 1] += CF * v2.y; } \
          { const f32x2v v2 = __builtin_amdgcn_cvt_scalef32_pk_f32_fp4(wa, 1.0f, 1); y[8 * dd + 2] += CF * v2.x; y[8 * dd + 3] += CF * v2.y; } \
          { const f32x2v v2 = __builtin_amdgcn_cvt_scalef32_pk_f32_fp4(wa, 1.0f, 2); y[8 * dd + 4] += CF * v2.x; y[8 * dd + 5] += CF * v2.y; } \
          { const f32x2v v2 = __builtin_amdgcn_cvt_scalef32_pk_f32_fp4(wa, 1.0f, 3); y[8 * dd + 6] += CF * v2.x; y[8 * dd + 7] += CF * v2.y; } } } while (0)
#define PG_BATCH(E0, DOISSUE) do { v4u ub[NBT], vb[NBT]; float su_[NBT], gt_[NBT]; \
      _Pragma("unroll") for (int q = 0; q < NBT; ++q) { const LAS unsigned char* s0_ = RB + (((E0) + q) & 7) * 2048 + lane * 16; ub[q] = *(const LAS v4u*)s0_; vb[q] = *(const LAS v4u*)(s0_ + 1024); su_[q] = esu[(E0) + q]; gt_[q] = egt[(E0) + q]; } \
      asm volatile("s_waitcnt lgkmcnt(0)" ::: "memory"); \
      if (DOISSUE) { _Pragma("unroll") for (int q = 0; q < NBT; ++q) PG_ISSUE((E0) + 8 + q); } \
      float d_[NBT]; _Pragma("unroll") for (int q = 0; q < NBT; ++q) { d_[q] = 0.f; PG_DOT(ub[q], d_[q]); } \
      _Pragma("unroll") for (int q = 0; q < NBT; ++q) d_[q] = wave_sum_dpp(d_[q]); \
      _Pragma("unroll") for (int q = 0; q < NBT; ++q) { const float c_ = gelu_erf(d_[q] * (rs * su_[q])) * gt_[q]; PG_AXPY(vb[q], c_); __builtin_amdgcn_sched_barrier(0); } } while (0)
    constexpr int NBT = 2;
#pragma unroll
    for (int e = 0; e < 8; ++e) PG_ISSUE(e);
#pragma unroll 1
    for (int e = 0; e < 120; e += NBT) {
      asm volatile("s_waitcnt vmcnt(12)" ::: "memory");
      PG_BATCH(e, true);
      asm volatile("" ::: "memory");
    }
    asm volatile("s_waitcnt vmcnt(0)" ::: "memory");
#pragma unroll 1
    for (int e = 120; e < 128; e += NBT) PG_BATCH(e, false);
    asm volatile("s_waitcnt lgkmcnt(0)" ::: "memory");
#undef PG_ISSUE
#undef PG_DOT
#undef PG_AXPY
#undef PG_BATCH
    float* drow = dst_base + (size_t)tok * DM;
#pragma unroll
    for (int q = 0; q < 8; ++q) { const size_t off = (size_t)lane * 32 + q * 4; f32x4 hv;
      hv.x = bflo(xw[2 * q]) + y[4 * q]; hv.y = bfhi(xw[2 * q]) + y[4 * q + 1]; hv.z = bflo(xw[2 * q + 1]) + y[4 * q + 2]; hv.w = bfhi(xw[2 * q + 1]) + y[4 * q + 3]; *(f32x4*)(drow + off) = hv; }
    }
  }
}
constexpr int MISC_LDS = LDS_BYTES - 256;
__global__ void __launch_bounds__(NTHR, 2) mk_fwd(Args args) {
  extern __shared__ __attribute__((aligned(16))) unsigned char lds_raw[];
  Frame F; F.lds = (LAS unsigned char*)lds_raw; F.ws = args.ws; F.tid = threadIdx.x; F.lane = F.tid & 63; F.wave = __builtin_amdgcn_readfirstlane(F.tid >> 6);
  const int lo = args.ph_lo, hi = args.ph_hi, G = (int)gridDim.x, bx = (int)blockIdx.x;
  volatile LAS unsigned* misc = (volatile LAS unsigned*)(F.lds + MISC_LDS);
  if (F.tid < 16) misc[F.tid] = 0u;
  __syncthreads();
  XcdBarrier bar = xcd_barrier_post((unsigned*)(F.ws + WS_CTL) + CW_BAR, misc);
#define IN(k) (lo <= (k) && (k) < hi)
#define SEAM(k) do { if (IN(k) && IN((k) + 1)) xcd_barrier(bar); } while (0)
#define PHASE_FRAME(Fp) Frame Fp = F; asm volatile("" : "+v"(Fp.tid), "+v"(Fp.lane))
  const int NA = G;
  if (IN(0)) { PHASE_FRAME(F0);
    p0_lam(F0, args);
    p0_zero_vpad(F0);
    p0_metaproj(F0, args);
    p0_rows(F0, args);
    p0_transpose(F0, args.in[IN_WIN], DPROJ, NPROJ, (bf16*)(F.ws + WS_W1T));
    p0_transpose(F0, args.in[IN_WOUT], DM, DM, (bf16*)(F.ws + WS_W2T));
    p0_w3t(F0, args);
    p0_tables(F0, args);
  }
  SEAM(0);
  if (IN(1)) { PHASE_FRAME(F1);
    p1_meta_finalize(F1, args);
    pg8::Gemm g{(const pg8::bf16_t*)(F.ws + WS_XN), (const pg8::bf16_t*)(F.ws + WS_W1T), MROWS, NPROJ, DM};
    pg8::StaticOrder S; S.init(MROWS, NPROJ, G, bx);
    EpiProj E{(bf16*)(F.ws + WS_Q), (bf16*)(F.ws + WS_KP), (bf16*)(F.ws + WS_VP), (bf16*)(F.ws + WS_MQ), (bf16*)(F.ws + WS_MK), (bf16*)(F.ws + WS_MV), (bf16*)(F.ws + WS_MO),
              args.in[IN_QNG], args.in[IN_KNG], (LAS float*)(F.lds + XCH_OFF)};
    pg8::gemm_phase<EpiProj, pg8::StaticOrder, true, true>(F.lds + RING_OFF, g, S, E);
  }
  SEAM(1);
  if (IN(2)) {
    PHASE_FRAME(F2);
    att::phase(F2, (G % 8 == 0) ? (bx & 7) * (G >> 3) + (bx >> 3) : bx, NA);
    for (int task = bx; task < 512; task += G) ml::taskA(F2, args, task);
  }
  SEAM(2);
  if (IN(3)) { PHASE_FRAME(F3); ml::scanB(F3); p3_combine(F3, args, NA); }
  SEAM(3);
  if (IN(4)) {
    PHASE_FRAME(F4);
    for (int task = bx; task < 512; task += G) ml::taskC(F4, args, task);
  }
  SEAM(4);
  if (IN(5)) {
    pg8::Gemm g{(const pg8::bf16_t*)(F.ws + WS_A2), (const pg8::bf16_t*)(F.ws + WS_W2T), MROWS, DM, DM};
    pg8::StaticOrder S; S.init(MROWS, DM, G, bx);
    EpiRes E{args.in[IN_X], args.out, (bf16*)(F.ws + WS_H1B), (float*)(F.ws + WS_SSQ)};
    pg8::gemm_phase<EpiRes, pg8::StaticOrder, true, true>(F.lds + RING_OFF, g, S, E);
  }
  SEAM(5);
  if (IN(6)) {
    pg8::Gemm g{(const pg8::bf16_t*)(F.ws + WS_H1B), (const pg8::bf16_t*)(F.ws + WS_W3T), MROWS, DM, DM};
    pg8::StaticOrder S; S.init(MROWS, DM, G, bx);
    LAS float* rst = (LAS float*)(F.lds + XCH_OFF);
    { pg8::Unit u0; if (S.next(0, u0)) { if (F.tid < 256) { const float* sp = (const float*)(F.ws + WS_SSQ) + ((size_t)u0.pm * 256 + F.tid) * 32; float s = 0.f;
#pragma unroll
          for (int i = 0; i < 8; ++i) { const f32x4 v = ((const f32x4*)sp)[i]; s += (v.x + v.y) + (v.z + v.w); }
          rst[F.tid] = rsqrtf(s * (1.0f / DM) + EPS); } } }
    __syncthreads();
    EpiScore E{(float*)(F.ws + WS_S), rst};
    pg8::gemm_phase<EpiScore, pg8::StaticOrder, true, true>(F.lds + RING_OFF, g, S, E);
  }
  SEAM(6);
  if (IN(7)) { PHASE_FRAME(F7); p6_peer(F7, args, args.out); }
#undef IN
#undef SEAM
}
extern "C" void kernel_launch(void* const* d_in, const int* in_sizes, int n_in, void* d_out, int out_size, void* d_ws, size_t ws_size, hipStream_t stream) {
  static int grid = 0;
  if (grid == 0) {
    int dev = 0, cus = 0, per_cu = 0;
    if (hipGetDevice(&dev) != hipSuccess || hipDeviceGetAttribute(&cus, hipDeviceAttributeMultiprocessorCount, dev) != hipSuccess) { fprintf(stderr, "device query failed\n"); grid = -1; return; }
    if (hipFuncSetAttribute((const void*)mk_fwd, hipFuncAttributeMaxDynamicSharedMemorySize, LDS_BYTES) != hipSuccess) { fprintf(stderr, "hipFuncSetAttribute failed\n"); grid = -1; return; }
    if (hipOccupancyMaxActiveBlocksPerMultiprocessor(&per_cu, (const void*)mk_fwd, NTHR, LDS_BYTES) != hipSuccess || per_cu < 1) { fprintf(stderr, "occupancy query says %d workgroups per CU: not launching\n", per_cu); (void)hipGetLastError(); grid = -1; return; }
    (void)hipGetLastError();
    grid = cus;
    if (n_in != 22 || ws_size < (size_t)512 * MiB || out_size != MROWS * DM) { fprintf(stderr, "unexpected shapes: n_in %d out %d ws %zu\n", n_in, out_size, ws_size); grid = -1; return; }
  }
  if (grid < 0) return;
  unsigned char* ws = (unsigned char*)d_ws;
  if (hipMemsetAsync(ws + WS_CTL, 0, CTL_ZERO_BYTES, stream) != hipSuccess) { fprintf(stderr, "memset failed\n"); return; }
  Args a{};
  for (int i = 0; i < 22; ++i) a.in[i] = (const float*)d_in[i];
  a.out = (float*)d_out; a.ws = ws; a.na = 0; a.pad = 0;
  a.ph_lo = 0; a.ph_hi = 8;
  hipLaunchKernelGGL(mk_fwd, dim3(grid), dim3(NTHR), LDS_BYTES, stream, a);
}
```

```cpp
#include <hip/hip_runtime.h>
#include <cstdio>
#include <cstdint>
#include <math.h>
namespace pg8 {
#define PG8_LAS __attribute__((address_space(3)))
typedef unsigned short bf16_t;
typedef short bf16x8 __attribute__((ext_vector_type(8)));
typedef float f32x4 __attribute__((ext_vector_type(4)));
typedef unsigned u32x4 __attribute__((ext_vector_type(4)));
constexpr int BM = 256, BK = 64, HALF = 128, HTB = HALF * BK * 2  , STAGE_BYTES = 8 * HTB, NXCD = 8, WGM = 8;

__host__ __device__ __forceinline__ int lds_byte(int r, int c) { const int st = (r >> 4) * 2 + (c >> 5), rr = r & 15, cc = c & 31, ob = rr * 64 + cc * 2; return st * 1024 + (ob ^ (((ob >> 9) & 1) << 5)); }
__host__ __device__ __forceinline__ void stage_rc(int b, int& R, int& C) { const int st = b / 1024, sb = b % 1024, swz = sb ^ (((sb >> 9) & 1) << 5); R = (st >> 1) * 16 + swz / 64; C = (st & 1) * 32 + (swz % 64) / 2; }
__host__ __device__ __forceinline__ int perm32(int rho) { const int n = rho >> 4, i = rho & 15; return 8 * (i >> 2) + 4 * n + (i & 3); }

struct Unit { int pm, pn; };
struct Gemm { const bf16_t* A; const bf16_t* Bt; int M, N, K; };

struct StaticOrder {
    int nM, nN, nwg, G, c;
    __host__ __device__ void init(int M, int N, int G_, int c_) { nM = M / BM; nN = N / BM; nwg = nM * nN; G = G_; c = c_; }
    __host__ __device__ bool next(int i, Unit& u) const {
        const long L = (long)i * G + c; if (L >= nwg) return false;
        int wgid = (int)L; { const int q = nwg / NXCD, r = nwg % NXCD, xcd = wgid % NXCD, off = wgid / NXCD; wgid = (xcd < r ? xcd * (q + 1) : r * (q + 1) + (xcd - r) * q) + off; }
        const int nig = WGM * nN, gid = wgid / nig, fm = gid * WGM, gsz = (nM - fm) < WGM ? (nM - fm) : WGM;
        u.pm = fm + ((wgid % nig) % gsz); u.pn = (wgid % nig) / gsz; return true;
    }
    __device__ __forceinline__ void a_ready(const Unit&) const {}
    __device__ __forceinline__ void done(const Unit&) const {}
};

__device__ __forceinline__ unsigned cvt_pk_bf16(float lo, float hi) { unsigned r; asm volatile("v_cvt_pk_bf16_f32 %0, %1, %2" : "=v"(r) : "v"(lo), "v"(hi)); return r; }
typedef float f32x2 __attribute__((ext_vector_type(2)));
template <class Epi, class Sched, bool ALIGN_EPI = false, bool SP2 = false>
__device__ __forceinline__ void gemm_phase(PG8_LAS unsigned char* lds, const Gemm g, const Sched& S, const Epi& E) {
    int tid_ = threadIdx.x; asm volatile("" : "+v"(tid_));
    const int tid = tid_, wid = __builtin_amdgcn_readfirstlane(tid >> 6), lane = tid & 63, wr = wid >> 2, wc = wid & 3, fr = lane & 15, fq = lane >> 4;
    const int K = g.K, nt = K / BK;
    unsigned voffA[2], voffB[2];
#pragma unroll
    for (int i = 0; i < 2; ++i) { int R, C; stage_rc(tid * 16 + i * 8192, R, C); const int Rb = Epi::PERM ? ((R & ~31) + perm32(R & 31)) : R;
        voffA[i] = (unsigned)(R * K + C) * 2u; voffB[i] = (unsigned)(Rb * K + C) * 2u; }
    const size_t kstep = (size_t)(BK * 2);
    const size_t hstep = (size_t)HALF * K * 2;
    const size_t tstep = 2 * hstep;
    const unsigned ldsw = (unsigned)wid * 1024u;
    const int aoff = lds_byte(wr * 64 + fr, fq * 8), boff = lds_byte(wc * 32 + fr, fq * 8);
#define PG8_SA(b, h) (((b) * 2 + (h)) * HTB)
#define PG8_SB(b, h) ((4 + (b) * 2 + (h)) * HTB)
#define PG8_STAGE(bufoff, gbase, voff) do { _Pragma("unroll") for (int _i = 0; _i < 2; ++_i) \
        __builtin_amdgcn_global_load_lds((const unsigned*)((const char*)(gbase) + (voff)[_i]), (PG8_LAS unsigned*)(lds + (bufoff) + ldsw + _i * 8192), 16, 0, 0); } while (0)
#define PG8_LDA(dst, b, h) do { _Pragma("unroll") for (int m = 0; m < 4; ++m) _Pragma("unroll") for (int k = 0; k < 2; ++k) dst[m][k] = *(const PG8_LAS bf16x8*)(lds + PG8_SA(b, h) + aoff + m * 2048 + k * 1024); } while (0)
#define PG8_LDB(dst, b, h) do { _Pragma("unroll") for (int n = 0; n < 2; ++n) _Pragma("unroll") for (int k = 0; k < 2; ++k) dst[n][k] = *(const PG8_LAS bf16x8*)(lds + PG8_SB(b, h) + boff + n * 2048 + k * 1024); } while (0)
#define PG8_MMA(ai, bj, At, Bt) do { __builtin_amdgcn_s_setprio(1); _Pragma("unroll") for (int m = 0; m < 4; ++m) _Pragma("unroll") for (int n = 0; n < 2; ++n) _Pragma("unroll") for (int k = 0; k < 2; ++k) \
        acc[ai][bj][m][n] = __builtin_amdgcn_mfma_f32_16x16x32_bf16(Bt[n][k], At[m][k], acc[ai][bj][m][n], 0, 0, 0); __builtin_amdgcn_s_setprio(0); } while (0)
#define PG8_WAIT_V(n) asm volatile("s_waitcnt vmcnt(" #n ")" ::: "memory")
#define PG8_WAIT_L(n) asm volatile("s_waitcnt lgkmcnt(" #n ")" ::: "memory")
#define PG8_BAR __builtin_amdgcn_s_barrier()
#define PG8_SCHED __builtin_amdgcn_sched_barrier(0)
    Unit cur, nxt; int ui = 0;
    if (!S.next(0, cur)) return;
    f32x4 acc[2][2][4][2];
#pragma unroll
    for (int a = 0; a < 2; ++a)
#pragma unroll
        for (int b = 0; b < 2; ++b)
#pragma unroll
            for (int m = 0; m < 4; ++m)
#pragma unroll
                for (int n = 0; n < 2; ++n) acc[a][b][m][n] = (f32x4){0.f, 0.f, 0.f, 0.f};
    bf16x8 At[4][2], B0[2][2], B1[2][2];
    const char* cA = (const char*)g.A + (size_t)cur.pm * tstep; const char* cB = (const char*)g.Bt + (size_t)cur.pn * tstep;
    S.a_ready(cur);
    if constexpr (SP2) {
        PG8_STAGE(PG8_SB(0, 0), cB, voffB); PG8_STAGE(PG8_SB(0, 1), cB + hstep, voffB); PG8_STAGE(PG8_SA(0, 0), cA, voffA); PG8_STAGE(PG8_SA(0, 1), cA + hstep, voffA);
        if (wr == 1) PG8_BAR;
        PG8_WAIT_V(2); PG8_BAR;
        PG8_STAGE(PG8_SB(1, 0), cB + kstep, voffB); PG8_STAGE(PG8_SA(1, 0), cA + kstep, voffA); PG8_STAGE(PG8_SB(1, 1), cB + hstep + kstep, voffB);
        PG8_WAIT_V(6); PG8_BAR;
    } else {
        PG8_STAGE(PG8_SB(0, 0), cB, voffB); PG8_STAGE(PG8_SA(0, 0), cA, voffA); PG8_STAGE(PG8_SB(0, 1), cB + hstep, voffB); PG8_STAGE(PG8_SA(0, 1), cA + hstep, voffA);
        if (wr == 1) PG8_BAR;
        PG8_WAIT_V(4); PG8_BAR;
        PG8_STAGE(PG8_SB(1, 0), cB + kstep, voffB); PG8_STAGE(PG8_SA(1, 0), cA + kstep, voffA); PG8_STAGE(PG8_SB(1, 1), cB + hstep + kstep, voffB);
        PG8_WAIT_V(6); PG8_BAR;
    }
    for (;;) {
        const bool has_next = S.next(ui + 1, nxt);
        const char* nA = has_next ? (const char*)g.A + (size_t)nxt.pm * tstep : cA; const char* nB = has_next ? (const char*)g.Bt + (size_t)nxt.pn * tstep : cB;
        for (int t = 0; t < nt; t += 2) {
            const bool last = (t == nt - 2);
            const char* a1 = cA + (size_t)(t + 1) * kstep;
            const char* a2 = last ? nA : cA + (size_t)(t + 2) * kstep; const char* b2 = last ? nB : cB + (size_t)(t + 2) * kstep;
            const char* a3 = a2 + kstep; const char* b3 = b2 + kstep;
            if (last && has_next) S.a_ready(nxt);
            if constexpr (SP2) {
            PG8_LDB(B0, 0, 0); PG8_LDB(B1, 0, 1); PG8_SCHED; PG8_LDA(At, 0, 0); PG8_STAGE(PG8_SA(1, 1), a1 + hstep, voffA);
            PG8_WAIT_V(8); PG8_WAIT_L(0); PG8_BAR; PG8_MMA(0, 0, At, B0); PG8_MMA(0, 1, At, B1); PG8_BAR; PG8_SCHED;
            PG8_LDA(At, 0, 1); PG8_STAGE(PG8_SB(0, 0), b2, voffB); PG8_STAGE(PG8_SB(0, 1), b2 + hstep, voffB); PG8_STAGE(PG8_SA(0, 0), a2, voffA);
            PG8_WAIT_V(8); PG8_WAIT_L(0); PG8_BAR; PG8_MMA(1, 0, At, B0); PG8_MMA(1, 1, At, B1); PG8_BAR; PG8_SCHED;
            PG8_LDB(B0, 1, 0); PG8_LDB(B1, 1, 1); PG8_SCHED; PG8_LDA(At, 1, 0); PG8_STAGE(PG8_SA(0, 1), a2 + hstep, voffA);
            PG8_WAIT_V(8); PG8_WAIT_L(0); PG8_BAR; PG8_MMA(0, 0, At, B0); PG8_MMA(0, 1, At, B1); PG8_BAR; PG8_SCHED;
            PG8_LDA(At, 1, 1); PG8_STAGE(PG8_SB(1, 0), b3, voffB); PG8_STAGE(PG8_SB(1, 1), b3 + hstep, voffB); PG8_STAGE(PG8_SA(1, 0), a3, voffA);
            PG8_WAIT_V(8); PG8_WAIT_L(0); PG8_BAR; PG8_MMA(1, 0, At, B0); PG8_MMA(1, 1, At, B1); PG8_BAR; PG8_SCHED;
            } else {
            PG8_LDB(B0, 0, 0); PG8_SCHED; PG8_LDA(At, 0, 0); PG8_STAGE(PG8_SA(1, 1), a1 + hstep, voffA);
            PG8_WAIT_L(8); PG8_BAR; PG8_WAIT_L(0); PG8_MMA(0, 0, At, B0); PG8_BAR; PG8_SCHED;
            PG8_LDB(B1, 0, 1); PG8_STAGE(PG8_SB(0, 0), b2, voffB);
            PG8_BAR; PG8_WAIT_L(0); PG8_MMA(0, 1, At, B1); PG8_BAR;
            PG8_LDA(At, 0, 1); PG8_STAGE(PG8_SA(0, 0), a2, voffA);
            PG8_BAR; PG8_WAIT_L(0); PG8_MMA(1, 0, At, B0); PG8_BAR; PG8_SCHED;
            PG8_STAGE(PG8_SB(0, 1), b2 + hstep, voffB);
            PG8_WAIT_V(6); PG8_BAR; PG8_MMA(1, 1, At, B1); PG8_BAR;
            PG8_LDB(B0, 1, 0); PG8_SCHED; PG8_LDA(At, 1, 0); PG8_STAGE(PG8_SA(0, 1), a2 + hstep, voffA);
            PG8_WAIT_L(8); PG8_BAR; PG8_WAIT_L(0); PG8_MMA(0, 0, At, B0); PG8_BAR; PG8_SCHED;
            PG8_LDB(B1, 1, 1); PG8_STAGE(PG8_SB(1, 0), b3, voffB);
            PG8_BAR; PG8_WAIT_L(0); PG8_MMA(0, 1, At, B1); PG8_BAR;
            PG8_LDA(At, 1, 1); PG8_STAGE(PG8_SA(1, 0), a3, voffA);
            PG8_BAR; PG8_WAIT_L(0); PG8_MMA(1, 0, At, B0); PG8_BAR; PG8_SCHED;
            PG8_STAGE(PG8_SB(1, 1), b3 + hstep, voffB);
            PG8_WAIT_V(6); PG8_BAR; PG8_MMA(1, 1, At, B1); PG8_BAR;
            }
        }
        if constexpr (ALIGN_EPI) { if (wr == 0) PG8_BAR; }
        if constexpr (!Epi::AFTER_DRAIN) { E(acc, cur, wr, wc, fr, fq); S.done(cur); }
        if (!has_next) break;
#pragma unroll
        for (int a = 0; a < 2; ++a)
#pragma unroll
            for (int b = 0; b < 2; ++b)
#pragma unroll
                for (int m = 0; m < 4; ++m)
#pragma unroll
                    for (int n = 0; n < 2; ++n) acc[a][b][m][n] = (f32x4){0.f, 0.f, 0.f, 0.f};
        cur = nxt; cA = nA; cB = nB; ++ui;
        if constexpr (ALIGN_EPI) { if (wr == 1) PG8_BAR; }
    }
    PG8_WAIT_V(0);
    if constexpr (!ALIGN_EPI) { if (wr == 0) PG8_BAR; }
    PG8_BAR;
    if constexpr (Epi::AFTER_DRAIN) { E.fused(acc, cur, wr, wc, fr, fq, lds, wid, lane); S.done(cur); }
#undef PG8_SA
#undef PG8_SB
#undef PG8_STAGE
#undef PG8_LDA
#undef PG8_LDB
#undef PG8_MMA
#undef PG8_WAIT_V
#undef PG8_WAIT_L
#undef PG8_BAR
#undef PG8_SCHED
}
}
#define GAS __attribute__((address_space(1)))
#define LAS __attribute__((address_space(3)))
typedef unsigned short bf16;
typedef unsigned v4u __attribute__((ext_vector_type(4)));
typedef unsigned v2u __attribute__((ext_vector_type(2)));
typedef float f32x4 __attribute__((ext_vector_type(4)));
typedef short bf16x8 __attribute__((ext_vector_type(8)));
#define LDS_WAIT() asm volatile("s_waitcnt lgkmcnt(0)" ::: "memory")
#define VM_WAIT() asm volatile("s_waitcnt vmcnt(0)" ::: "memory")

constexpr int DM = 2048, NB = 4, SEQ = 2048, NMETA = 16, MROWS = NB * SEQ, DPROJ = 6152, NPROJ = 6144;
constexpr int PADT = 2112, POS0 = 64, MPOS0 = 48;
constexpr float EPS = 1e-6f;
constexpr float LOG2E = 1.4426950408889634f;
constexpr float QSCALE = 0.08838834764831845f * LOG2E;
constexpr int NWAVES = 8, NTHR = 512;

constexpr size_t MiB = 1u << 20;
constexpr size_t WS_CTL = 0, CTL_ZERO_BYTES = 32 * 1024;
constexpr size_t WS_PM = 484 * MiB;
constexpr size_t WS_W1T = 2 * MiB, WS_W2T = 26 * MiB, WS_W3T = 34 * MiB, WS_XN = 42 * MiB;
constexpr size_t WS_Q = 74 * MiB, WS_KP = 90 * MiB, WS_VP = 107 * MiB, WS_MQ = 124 * MiB, WS_MK = 133 * MiB, WS_MV = 142 * MiB, WS_MO = 159 * MiB;
constexpr size_t WS_SMALL = 175 * MiB;
constexpr size_t WS_XM = WS_SMALL, WS_LI = WS_SMALL + 128 * 1024, WS_LF = WS_SMALL + 384 * 1024, WS_LAM = WS_SMALL + 640 * 1024;
constexpr size_t WS_PO = 176 * MiB, WS_ML = 304 * MiB, WS_HM = 305 * MiB, WS_A2 = 42 * MiB, WS_H1B = 74 * MiB, WS_SSQ = 106 * MiB, WS_S = 176 * MiB, WS_UB = 384 * MiB, WS_VB = 448 * MiB;
constexpr size_t WS_SCL = WS_SMALL + 704 * 1024;
constexpr size_t WS_VB8 = WS_UB + 32 * MiB;
constexpr size_t WS_DC = 305 * MiB, WS_CS = 448 * MiB, WS_DN = 482 * MiB, WS_NS = WS_DN + 512 * 1024, WS_GS = WS_DN + 1024 * 1024, WS_MS = WS_DN + 1152 * 1024;
constexpr size_t WS_EID = 240 * MiB, WS_EGT = 244 * MiB;
constexpr int CW_BAR = 4096;

constexpr int RING_OFF = 0, RING_BYTES = 131072;
constexpr int XCH_OFF = 131072;
constexpr int MISC_OFF = XCH_OFF + 8192;
constexpr int LDS_BYTES = 155648;

__device__ __forceinline__ unsigned f2bf(float f) { unsigned u = __builtin_bit_cast(unsigned, f); return (u + 0x7fffu + ((u >> 16) & 1u)) >> 16; }
__device__ __forceinline__ unsigned pk2(float lo, float hi) { return f2bf(lo) | (f2bf(hi) << 16); }
__device__ __forceinline__ float bf2f(unsigned short u) { return __builtin_bit_cast(float, (unsigned)u << 16); }
__device__ __forceinline__ float bflo(unsigned w) { return __builtin_bit_cast(float, w << 16); }
__device__ __forceinline__ float bfhi(unsigned w) { return __builtin_bit_cast(float, w & 0xffff0000u); }
__device__ __forceinline__ float wave_sum(float v) {
#pragma unroll
  for (int o = 1; o < 64; o <<= 1) v += __shfl_xor(v, o);
  return v;
}
__device__ __forceinline__ size_t kp_off(int bhm, int pos, int d) { const int j = pos >> 6, row = pos & 63, d0 = d >> 4, hi = (d >> 3) & 1;
  return ((size_t)(bhm * 33 + j) * 8 + d0) * 1024 + (size_t)((((row << 1) | hi) ^ ((row >> 3) & 1)) << 3) + (d & 7); }
__device__ __forceinline__ float wave_sum_dpp(float v) {
  v += __builtin_bit_cast(float, __builtin_amdgcn_update_dpp(0, __builtin_bit_cast(int, v), 0xB1, 0xF, 0xF, true));
  v += __builtin_bit_cast(float, __builtin_amdgcn_update_dpp(0, __builtin_bit_cast(int, v), 0x4E, 0xF, 0xF, true));
  v += __builtin_bit_cast(float, __builtin_amdgcn_update_dpp(0, __builtin_bit_cast(int, v), 0x141, 0xF, 0xF, true));
  v += __builtin_bit_cast(float, __builtin_amdgcn_update_dpp(0, __builtin_bit_cast(int, v), 0x140, 0xF, 0xF, true));
  const float r0 = __builtin_bit_cast(float, __builtin_amdgcn_readlane(__builtin_bit_cast(int, v), 0)), r1 = __builtin_bit_cast(float, __builtin_amdgcn_readlane(__builtin_bit_cast(int, v), 16));
  const float r2 = __builtin_bit_cast(float, __builtin_amdgcn_readlane(__builtin_bit_cast(int, v), 32)), r3 = __builtin_bit_cast(float, __builtin_amdgcn_readlane(__builtin_bit_cast(int, v), 48));
  return (r0 + r1) + (r2 + r3);
}
__device__ __forceinline__ float sigmoidf_(float x) { return 1.0f / (1.0f + __expf(-x)); }
#define XB_TMO      128
#define XB_XCNT(j)  (256  + 64 * (j))
#define XB_XSUB(j)  (1280 + 64 * (j))
#define XB_XGEN(j)  (2304 + 64 * (j))
#define XB_TOP      3328
#define XB_TOPGEN   3392
#define XCD_BAR_WORDS 3456
#define XB_SPIN_CAP (1u << 18)

__device__ __forceinline__ unsigned xb_ld(unsigned* p)              { return __hip_atomic_load(p, __ATOMIC_RELAXED, __HIP_MEMORY_SCOPE_AGENT); }
__device__ __forceinline__ unsigned xb_add(unsigned* p, unsigned v) { return __hip_atomic_fetch_add(p, v, __ATOMIC_RELAXED, __HIP_MEMORY_SCOPE_AGENT); }
__device__ __forceinline__ unsigned xb_xcc_id() { return (unsigned)__builtin_amdgcn_s_getreg((3 << 11) | 20) & 0xFu; }
#define XB_SPIN(cond, bar) do { unsigned _sp = 0; while (cond) { __builtin_amdgcn_s_sleep(1); \
    if ((++_sp & 255u) == 0u) { if (xb_ld(&(bar)[XB_TMO])) break; if (_sp > XB_SPIN_CAP) { atomicAdd(&(bar)[XB_TMO], 1u); break; } } } } while (0)

struct XcdBarrier {
    unsigned* bar; unsigned x;
    volatile LAS unsigned* st;
};

__device__ __forceinline__ XcdBarrier xcd_barrier_post(unsigned* bar, volatile LAS unsigned* st) {
    XcdBarrier b; b.bar = bar; b.x = xb_xcc_id(); b.st = st;
    if (threadIdx.x == 0) (void)xb_add(&bar[XB_XCNT(b.x)], 1u);
    return b;
}
__device__ __forceinline__ void xcd_barrier_complete(unsigned* bar, unsigned x, unsigned& nloc, unsigned& nx) {
    const unsigned G = gridDim.x * gridDim.y * gridDim.z;
    unsigned sum, cnt, mine, sp = 0u;
    for (;;) {
        sum = 0u; cnt = 0u; mine = 0u;
#pragma unroll
        for (unsigned j = 0; j < 16; ++j) { const unsigned c = xb_ld(&bar[XB_XCNT(j)]); sum += c; cnt += (c > 0u) ? 1u : 0u; mine = (j == x) ? c : mine; }
        if (sum == G) break;
        __builtin_amdgcn_s_sleep(1);
        if ((++sp & 255u) == 0u) { if (xb_ld(&bar[XB_TMO])) break; if (sp > XB_SPIN_CAP) { atomicAdd(&bar[XB_TMO], 1u); break; } }
    }
    nloc = mine > 0u ? mine : 1u; nx = cnt > 0u ? cnt : 1u;
}

__device__ __forceinline__ void xcd_barrier(const XcdBarrier& b) {
    asm volatile("s_waitcnt vmcnt(0)" ::: "memory");
    __syncthreads();
    if (threadIdx.x == 0) {
        unsigned* bar = b.bar;
        __builtin_amdgcn_s_waitcnt(0);
        unsigned nloc = b.st[0], nx = b.st[1];
        if (nloc == 0u) { xcd_barrier_complete(bar, b.x, nloc, nx); b.st[0] = nloc; b.st[1] = nx; }
        const unsigned old = xb_add(&bar[XB_XSUB(b.x)], 1u);
        const unsigned gen = old / nloc;
        if (old + 1u == (gen + 1u) * nloc) {
            __builtin_amdgcn_fence(__ATOMIC_RELEASE, "agent");
            asm volatile("s_waitcnt vmcnt(0)" ::: "memory");
            const unsigned og = xb_add(&bar[XB_TOP], 1u);
            const unsigned tg = og / nx;
            if (og + 1u == (tg + 1u) * nx) xb_add(&bar[XB_TOPGEN], 1u);
            else XB_SPIN(xb_ld(&bar[XB_TOPGEN]) == tg, bar);
            __builtin_amdgcn_fence(__ATOMIC_ACQUIRE, "agent");
            xb_add(&bar[XB_XGEN(b.x)], 1u);
            asm volatile("s_waitcnt vmcnt(0)" ::: "memory");
        } else {
            XB_SPIN(xb_ld(&bar[XB_XGEN(b.x)]) == gen, bar);
            __builtin_amdgcn_fence(__ATOMIC_ACQUIRE, "agent");
            asm volatile("s_waitcnt vmcnt(0)" ::: "memory");
        }
    }
    __syncthreads();
}

struct Args { const float* in[22]; float* out; unsigned char* ws; int ph_lo, ph_hi, na, pad; };
struct Frame {
  LAS unsigned char* lds; unsigned char* ws; int tid, lane, wave; const float* const* in;
};
#define IN_X 0
#define IN_META 1
#define IN_G1 2
#define IN_WIN 3
#define IN_CW 4
#define IN_CB 5
#define IN_IGB 6
#define IN_FGB 7
#define IN_LQ1 8
#define IN_LK1 9
#define IN_LQ2 10
#define IN_LK2 11
#define IN_QNG 12
#define IN_KNG 13
#define IN_SUBG 14
#define IN_OUTG 15
#define IN_WOUT 16
#define IN_G2 17
#define IN_WQ 18
#define IN_SUBK 19
#define IN_U 20
#define IN_V 21

__device__ __forceinline__ void p0_rows(const Frame& F, const Args& a) {
  const float* x = a.in[IN_X]; const float* meta = a.in[IN_META]; const float* g1 = a.in[IN_G1]; const float* w_in = a.in[IN_WIN];
  const float* igb = a.in[IN_IGB]; const float* fgb = a.in[IN_FGB];
  bf16* Xn = (bf16*)(F.ws + WS_XN); bf16* Xm = (bf16*)(F.ws + WS_XM); float* LI = (float*)(F.ws + WS_LI); float* LF = (float*)(F.ws + WS_LF);
  LAS f32x4* wgl = (LAS f32x4*)(F.lds);
  for (int e = F.tid; e < 4096; e += NTHR) {
    const int ln = e & 63, q = e >> 6, half = q & 1, j = (q >> 1) & 3, i = q >> 3;
    const int k = 4 * (i * 64 + ln) + j;
    wgl[e] = *(const f32x4*)(w_in + (size_t)k * DPROJ + NPROJ + 4 * half);
  }
  __syncthreads();
  const int gw = blockIdx.x * NWAVES + F.wave, NGW = gridDim.x * NWAVES, lane = F.lane;
  constexpr int NTASK = MROWS / 2 + NMETA / 2;
  f32x4 xnx[2][8];
  if (gw < NTASK) { const float* sn = (gw >= MROWS / 2 ? meta + (size_t)(gw - MROWS / 2) * 2 * DM : x + (size_t)gw * 2 * DM);
#pragma unroll
    for (int i = 0; i < 8; ++i) { xnx[0][i] = ((const f32x4*)sn)[i * 64 + lane]; xnx[1][i] = ((const f32x4*)(sn + DM))[i * 64 + lane]; } }
  for (int task = gw; task < NTASK; task += NGW) {
    const bool ismeta = task >= MROWS / 2;
    const int r0 = ismeta ? (task - MROWS / 2) * 2 : task * 2;
    f32x4 xv[2][8]; float rs[2];
    { float s0 = 0.f, s1 = 0.f;
#pragma unroll
      for (int i = 0; i < 8; ++i) { xv[0][i] = xnx[0][i]; xv[1][i] = xnx[1][i]; }
      { const int tn = task + NGW; if (tn < NTASK) { const float* sn = (tn >= MROWS / 2 ? meta + (size_t)(tn - MROWS / 2) * 2 * DM : x + (size_t)tn * 2 * DM);
#pragma unroll
          for (int i = 0; i < 8; ++i) { xnx[0][i] = ((const f32x4*)sn)[i * 64 + lane]; xnx[1][i] = ((const f32x4*)(sn + DM))[i * 64 + lane]; } } }
#pragma unroll
      for (int i = 0; i < 8; ++i) { const f32x4 a0 = xv[0][i], a1 = xv[1][i];
        s0 += (a0.x * a0.x + a0.y * a0.y) + (a0.z * a0.z + a0.w * a0.w); s1 += (a1.x * a1.x + a1.y * a1.y) + (a1.z * a1.z + a1.w * a1.w); }
      rs[0] = rsqrtf(wave_sum_dpp(s0) * (1.0f / DM) + EPS); rs[1] = rsqrtf(wave_sum_dpp(s1) * (1.0f / DM) + EPS); }
    float ga[2][8];
#pragma unroll
    for (int rr = 0; rr < 2; ++rr)
#pragma unroll
      for (int g = 0; g < 8; ++g) ga[rr][g] = 0.f;
    bf16* dst0 = (ismeta ? Xm : Xn) + (size_t)r0 * DM;
#pragma unroll
    for (int i = 0; i < 8; ++i) {
      const f32x4 g = ((const f32x4*)g1)[i * 64 + lane];
      f32x4 xn[2];
#pragma unroll
      for (int rr = 0; rr < 2; ++rr) { xn[rr] = xv[rr][i] * g * rs[rr];
        v2u o; o.x = pk2(xn[rr].x, xn[rr].y); o.y = pk2(xn[rr].z, xn[rr].w); ((v2u*)(dst0 + (size_t)rr * DM))[i * 64 + lane] = o; }
#pragma unroll
      for (int j = 0; j < 4; ++j) {
        const f32x4 w0 = wgl[((i * 4 + j) * 2 + 0) * 64 + lane], w1 = wgl[((i * 4 + j) * 2 + 1) * 64 + lane];
#pragma unroll
        for (int rr = 0; rr < 2; ++rr) { const float xs_ = xn[rr][j];
          ga[rr][0] += xs_ * w0.x; ga[rr][1] += xs_ * w0.y; ga[rr][2] += xs_ * w0.z; ga[rr][3] += xs_ * w0.w;
          ga[rr][4] += xs_ * w1.x; ga[rr][5] += xs_ * w1.y; ga[rr][6] += xs_ * w1.z; ga[rr][7] += xs_ * w1.w; }
      }
      __builtin_amdgcn_sched_barrier(0);
    }
#pragma unroll
    for (int rr = 0; rr < 2; ++rr)
#pragma unroll
      for (int g = 0; g < 8; ++g) ga[rr][g] = wave_sum_dpp(ga[rr][g]);
    if (lane < 8) {
      const int rr = lane >> 2, h = lane & 3;
      float gi = 0.f, gf = 0.f;
#pragma unroll
      for (int q = 0; q < 2; ++q)
#pragma unroll
        for (int hh = 0; hh < 4; ++hh) if (q == rr && hh == h) { gi = ga[q][hh]; gf = ga[q][4 + hh]; }
      const float li = gi + igb[h]; const float fx = gf + fgb[h];
      const float lf = fminf(fx, 0.f) - log1pf(__expf(-fabsf(fx)));
      const int R = r0 + rr;
      if (!ismeta) { const int b = R >> 11, t = R & 2047; LI[(b * 4 + h) * PADT + POS0 + t] = li; LF[(b * 4 + h) * PADT + POS0 + t] = lf; }
      else { for (int b = 0; b < NB; ++b) { LI[(b * 4 + h) * PADT + MPOS0 + R] = li; LF[(b * 4 + h) * PADT + MPOS0 + R] = lf; } }
    }
  }
  __syncthreads();
}
__device__ __forceinline__ void p0_metaproj(const Frame& F, const Args& a) {
  const float* meta = a.in[IN_META]; const float* g1 = a.in[IN_G1]; const float* w_in = a.in[IN_WIN];
  float* PM = (float*)(F.ws + WS_PM);
  LAS float* xs = (LAS float*)(F.lds);
  LAS float* part = (LAS float*)(F.lds + 16384);
  const int q = F.tid >> 7, c = F.tid & 127;
  for (int task = blockIdx.x; task < (NPROJ / 128) * 4; task += gridDim.x) {
    const int nb = task >> 2, kp = task & 3, n = nb * 128 + c;
    float acc[16];
#pragma unroll
    for (int m = 0; m < 16; ++m) acc[m] = 0.f;
#pragma unroll 1
    for (int kb = 0; kb < 2; ++kb) {
      __syncthreads();
#pragma unroll
      for (int i = 0; i < 8; ++i) { const int idx = F.tid + NTHR * i, qq = idx >> 10, kk = (idx >> 4) & 63, m = idx & 15; const int k = 512 * kp + 128 * qq + 64 * kb + kk;
        xs[idx] = meta[(size_t)m * DM + k] * g1[k]; }
      __syncthreads();
#pragma unroll 8
      for (int kk = 0; kk < 64; ++kk) {
        const float w = w_in[(size_t)(512 * kp + 128 * q + 64 * kb + kk) * DPROJ + n];
        const LAS f32x4* xp = (const LAS f32x4*)(xs + (q * 64 + kk) * 16);
#pragma unroll
        for (int t = 0; t < 4; ++t) { const f32x4 xv = xp[t]; acc[4 * t + 0] += xv.x * w; acc[4 * t + 1] += xv.y * w; acc[4 * t + 2] += xv.z * w; acc[4 * t + 3] += xv.w * w; }
      }
    }
#pragma unroll
    for (int m = 0; m < 16; ++m) part[(q * 16 + m) * 128 + c] = acc[m];
    __syncthreads();
    for (int e = F.tid; e < 16 * 128; e += NTHR) { const int m = e >> 7, cc = e & 127;
      PM[((size_t)kp * 16 + m) * NPROJ + nb * 128 + cc] = (part[(0 * 16 + m) * 128 + cc] + part[(1 * 16 + m) * 128 + cc]) + (part[(2 * 16 + m) * 128 + cc] + part[(3 * 16 + m) * 128 + cc]); }
  }
  __syncthreads();
}
__device__ __forceinline__ void p0_transpose(const Frame& F, const float* W, int ldw, int N, bf16* Wt) {
  LAS float* tl = (LAS float*)(F.lds);
  const int ntn = N / 64, ntask = ntn * 16;
  f32x4 wn[4];
  if ((int)blockIdx.x < ntask) { const int nb = blockIdx.x % ntn, kb = blockIdx.x / ntn;
#pragma unroll
    for (int i = 0; i < 4; ++i) { const int idx = F.tid + NTHR * i, kk = idx >> 4, c4 = idx & 15; wn[i] = *(const f32x4*)(W + (size_t)(kb * 128 + kk) * ldw + nb * 64 + 4 * c4); } }
  for (int task = blockIdx.x; task < ntask; task += gridDim.x) {
    const int nb = task % ntn, kb = task / ntn, n0 = nb * 64, k0 = kb * 128;
    __syncthreads();
#pragma unroll
    for (int i = 0; i < 4; ++i) { const int idx = F.tid + NTHR * i, kk = idx >> 4, c4 = idx & 15; const f32x4 w = wn[i];
      LAS float* d = tl + kk * 65 + 4 * c4; d[0] = w.x; d[1] = w.y; d[2] = w.z; d[3] = w.w; }
    { const int tn = task + gridDim.x; if (tn < ntask) { const int nb2 = tn % ntn, kb2 = tn / ntn;
#pragma unroll
        for (int i = 0; i < 4; ++i) { const int idx = F.tid + NTHR * i, kk = idx >> 4, c4 = idx & 15; wn[i] = *(const f32x4*)(W + (size_t)(kb2 * 128 + kk) * ldw + nb2 * 64 + 4 * c4); } } }
    __syncthreads();
    const int n = F.tid >> 3, kc = F.tid & 7;
    const LAS float* s = tl + (kc * 16) * 65 + n;
    v4u o0, o1;
    o0.x = pk2(s[0 * 65], s[1 * 65]); o0.y = pk2(s[2 * 65], s[3 * 65]); o0.z = pk2(s[4 * 65], s[5 * 65]); o0.w = pk2(s[6 * 65], s[7 * 65]);
    o1.x = pk2(s[8 * 65], s[9 * 65]); o1.y = pk2(s[10 * 65], s[11 * 65]); o1.z = pk2(s[12 * 65], s[13 * 65]); o1.w = pk2(s[14 * 65], s[15 * 65]);
    v4u* dp = (v4u*)(Wt + (size_t)(n0 + n) * DM + k0 + kc * 16);
    dp[0] = o0; dp[1] = o1;
  }
  __syncthreads();
}
__device__ __forceinline__ void p0_zero_vpad(const Frame& F) {
  bf16* Vp = (bf16*)(F.ws + WS_VP);
  const int per = MPOS0 * 256 / 8;
  for (int i = blockIdx.x * NTHR + F.tid; i < 16 * per; i += gridDim.x * NTHR) { const int bh = i / per, e = i % per;
    *(v4u*)(Vp + (size_t)bh * PADT * 256 + (size_t)e * 8) = (v4u){0u, 0u, 0u, 0u}; }
}
__device__ __forceinline__ void p0_lam(const Frame& F, const Args& a) {
  if (blockIdx.x == 0 && F.wave == 0) {
    const int l = F.lane;
    float s1 = a.in[IN_LQ1][l] * a.in[IN_LK1][l] + a.in[IN_LQ1][l + 64] * a.in[IN_LK1][l + 64];
    float s2 = a.in[IN_LQ2][l] * a.in[IN_LK2][l] + a.in[IN_LQ2][l + 64] * a.in[IN_LK2][l + 64];
    s1 = wave_sum(s1); s2 = wave_sum(s2);
    if (l == 0) *(float*)(F.ws + WS_LAM) = __expf(s1) - __expf(s2) + 0.2f;
  }
}

struct EpiProj {
  static constexpr bool PERM = true, AFTER_DRAIN = false;
  bf16 *Qb, *Kp, *Vp, *MQ, *MK, *MV, *MO; const float *qg, *kg; LAS float* xch;
  __device__ __forceinline__ void operator()(const pg8::f32x4 (&acc)[2][2][4][2], const pg8::Unit& u, int wr, int wc, int fr, int fq) const {
    const int pn = u.pn, b = u.pm >> 3, tb = (u.pm & 7) * 256 + wr * 64 + fr, d0 = wc * 32 + fq * 8;
    if (pn < 8) {
      const bool isk = pn >= 4; const int h = pn & 3;
      float ssq[2][4][2];
#pragma unroll
      for (int ai = 0; ai < 2; ++ai)
#pragma unroll
        for (int m = 0; m < 4; ++m)
#pragma unroll
          for (int bj = 0; bj < 2; ++bj) { float s = 0.f;
#pragma unroll
            for (int n = 0; n < 2; ++n) { const pg8::f32x4 x = acc[ai][bj][m][n]; s += (x[0] * x[0] + x[1] * x[1]) + (x[2] * x[2] + x[3] * x[3]); }
            s += __shfl_xor(s, 16); s += __shfl_xor(s, 32); ssq[ai][m][bj] = s;
            if (fq == 0) xch[((ai * 128 + wr * 64 + m * 16 + fr) * 2 + bj) * 4 + wc] = s; }
      asm volatile("s_waitcnt lgkmcnt(0)" ::: "memory"); __builtin_amdgcn_s_barrier(); asm volatile("" ::: "memory");
      const float* gp = (isk ? kg : qg) + d0; const f32x4 g0 = *(const f32x4*)gp, g1v = *(const f32x4*)(gp + 4);
      const float sc = isk ? 1.0f : QSCALE;
#pragma unroll
      for (int ai = 0; ai < 2; ++ai)
#pragma unroll
        for (int m = 0; m < 4; ++m)
#pragma unroll
          for (int bj = 0; bj < 2; ++bj) {
            const f32x4 p = *(const LAS f32x4*)(xch + ((ai * 128 + wr * 64 + m * 16 + fr) * 2 + bj) * 4);
            const float rs = rsqrtf(((p.x + p.y) + (p.z + p.w)) * (1.0f / 128.f) + EPS) * sc;
            const pg8::f32x4 v0 = acc[ai][bj][m][0], v1 = acc[ai][bj][m][1];
            v4u w; w.x = pk2(v0[0] * rs * g0.x, v0[1] * rs * g0.y); w.y = pk2(v0[2] * rs * g0.z, v0[3] * rs * g0.w);
            w.z = pk2(v1[0] * rs * g1v.x, v1[1] * rs * g1v.y); w.w = pk2(v1[2] * rs * g1v.z, v1[3] * rs * g1v.w);
            const int t = tb + ai * 128 + m * 16;
            bf16* dst = isk ? Kp + kp_off((b * 4 + h) * 2 + bj, POS0 + t, d0)
                            : Qb + ((size_t)((b * 4 + h) * 2 + bj) * SEQ + t) * 128 + d0;
            *(v4u*)dst = w; }
      return;
    }
#pragma unroll
    for (int ai = 0; ai < 2; ++ai)
#pragma unroll
      for (int m = 0; m < 4; ++m)
#pragma unroll
        for (int bj = 0; bj < 2; ++bj) {
          pg8::f32x4 v0 = acc[ai][bj][m][0], v1 = acc[ai][bj][m][1];
          const int t = tb + ai * 128 + m * 16;
          bf16* dst;
          if (pn < 12) { const int h = pn - 8; dst = Vp + ((size_t)(b * 4 + h) * PADT + POS0 + t) * 256 + bj * 128 + d0; }
          else if (pn < 16) { const int h = 2 * (pn & 1) + bj; dst = (pn >= 14 ? MK : MQ) + ((size_t)(b * 4 + h) * PADT + POS0 + t) * 128 + d0; }
          else if (pn < 20) { const int h = pn - 16; dst = MV + ((size_t)(b * 4 + h) * PADT + POS0 + t) * 256 + bj * 128 + d0; }
          else { dst = MO + (size_t)(b * SEQ + t) * 1024 + (pn - 20) * 256 + bj * 128 + d0;
#pragma unroll
            for (int j = 0; j < 4; ++j) { v0[j] = sigmoidf_(v0[j]); v1[j] = sigmoidf_(v1[j]); } }
          v4u w; w.x = pk2(v0[0], v0[1]); w.y = pk2(v0[2], v0[3]); w.z = pk2(v1[0], v1[1]); w.w = pk2(v1[2], v1[3]);
          *(v4u*)dst = w; }
  }
};
__device__ __forceinline__ void p1_meta_finalize(const Frame& F, const Args& a) {
  if (blockIdx.x >= NMETA) return;
  const int mrow = blockIdx.x, tid = F.tid, lane = F.lane, w = F.wave;
  const float* meta = a.in[IN_META] + (size_t)mrow * DM; const float* PM0 = (const float*)(F.ws + WS_PM) + (size_t)mrow * NPROJ;
#define PM_AT(i) ((PM0[(i)] + PM0[(size_t)16 * NPROJ + (i)]) + (PM0[(size_t)32 * NPROJ + (i)] + PM0[(size_t)48 * NPROJ + (i)]))
  LAS float* red = (LAS float*)(F.lds + XCH_OFF);
  const f32x4 mv = ((const f32x4*)meta)[tid];
  float s = wave_sum((mv.x * mv.x + mv.y * mv.y) + (mv.z * mv.z + mv.w * mv.w));
  if (lane == 0) red[w] = s;
  __syncthreads();
  float tot = 0.f;
#pragma unroll
  for (int i = 0; i < 8; ++i) tot += red[i];
  const float rs = rsqrtf(tot * (1.0f / DM) + EPS);
  bf16* Kp = (bf16*)(F.ws + WS_KP); bf16* Vp = (bf16*)(F.ws + WS_VP); bf16* MQ = (bf16*)(F.ws + WS_MQ); bf16* MK = (bf16*)(F.ws + WS_MK); bf16* MV = (bf16*)(F.ws + WS_MV);
  const int pos = MPOS0 + mrow;
  {
    const float v0 = PM_AT(1024 + w * 128 + lane) * rs, v1 = PM_AT(1024 + w * 128 + lane + 64) * rs;
    const float rk = rsqrtf(wave_sum(v0 * v0 + v1 * v1) * (1.0f / 128.f) + EPS);
    const float* kg = a.in[IN_KNG];
    const unsigned short o0 = (unsigned short)f2bf(v0 * rk * kg[lane]), o1 = (unsigned short)f2bf(v1 * rk * kg[lane + 64]);
    for (int b = 0; b < NB; ++b) { const int bhm = (b * 4 + (w >> 1)) * 2 + (w & 1); Kp[kp_off(bhm, pos, lane)] = o0; Kp[kp_off(bhm, pos, lane + 64)] = o1; }
  }
  { const int c = tid * 2;
    const unsigned o = pk2(PM_AT(2048 + c) * rs, PM_AT(2048 + c + 1) * rs); const int h = c >> 8, e = c & 255;
    for (int b = 0; b < NB; ++b) *(unsigned*)(Vp + ((size_t)(b * 4 + h) * PADT + pos) * 256 + e) = o;
    const unsigned o2 = pk2(PM_AT(3072 + c) * rs, PM_AT(3072 + c + 1) * rs); const bool isk = c >= 512; const int cc = c & 511, hq = cc >> 7, d = cc & 127;
    for (int b = 0; b < NB; ++b) *(unsigned*)((isk ? MK : MQ) + ((size_t)(b * 4 + hq) * PADT + pos) * 128 + d) = o2;
    const unsigned o3 = pk2(PM_AT(4096 + c) * rs, PM_AT(4096 + c + 1) * rs);
    for (int b = 0; b < NB; ++b) *(unsigned*)(MV + ((size_t)(b * 4 + h) * PADT + pos) * 256 + e) = o3;
  }
  __syncthreads();
}
#undef PM_AT

namespace att {
using f32x16 = __attribute__((ext_vector_type(16))) float;
using s16x4 = __attribute__((ext_vector_type(4))) short;
constexpr int STEPS_BHM = 152, NSTEPS = 32 * STEPS_BHM;
constexpr int SHM_V = 64 * 256 * 2, SHM_K = 64 * 128 * 2;
constexpr int LDS_V = 0, LDS_K = 2 * SHM_V, LDS_Q = LDS_K + SHM_K, LDS_WS = LDS_Q + 8 * 8192;
constexpr float THR2 = 8.0f;
#define KSWZ(row, colB) ((row) * 256 + ((colB) ^ (((row) & 7) << 4)))
#define SBAR() __builtin_amdgcn_sched_barrier(0)
__device__ __forceinline__ int crow(int r, int hi) { return (r & 3) + 8 * (r >> 2) + 4 * hi; }
__device__ __forceinline__ unsigned cvtpk(float lo, float hi) { unsigned r; asm volatile("v_cvt_pk_bf16_f32 %0, %1, %2" : "=v"(r) : "v"(lo), "v"(hi)); return r; }
__device__ __forceinline__ int qb_start(int qb) { return 2 * qb * qb + 3 * qb; }
__device__ __forceinline__ int chunk_of(int s, int NA) { return ((s + 1) * NA - 1) / NSTEPS; }

template <int OFF> __device__ __forceinline__ s16x4 tr_read(int vb) {
  s16x4 r; asm volatile("ds_read_b64_tr_b16 %0, %1 offset:%2" : "=&v"(r) : "v"(vb), "i"(OFF) : "memory"); return r;
}
constexpr int v_rd_off(int d0, int ks, int half) { return d0 * 512 + ks * 8192 + half * 4096; }
template <int D0> __device__ __forceinline__ void pv_one(f32x16& od, int vb, bf16x8 pa0, bf16x8 pa1, bf16x8 pa2, bf16x8 pa3) {
#define PK(L, H) (bf16x8){L[0], L[1], L[2], L[3], H[0], H[1], H[2], H[3]}
  { const s16x4 l0 = tr_read<v_rd_off(D0, 0, 0)>(vb), h0 = tr_read<v_rd_off(D0, 0, 1)>(vb), l1 = tr_read<v_rd_off(D0, 1, 0)>(vb), h1 = tr_read<v_rd_off(D0, 1, 1)>(vb);
    asm volatile("s_waitcnt lgkmcnt(0)" ::: "memory"); SBAR();
    od = __builtin_amdgcn_mfma_f32_32x32x16_bf16(pa0, PK(l0, h0), od, 0, 0, 0);
    od = __builtin_amdgcn_mfma_f32_32x32x16_bf16(pa1, PK(l1, h1), od, 0, 0, 0); }
  SBAR();
  { const s16x4 l2 = tr_read<v_rd_off(D0, 2, 0)>(vb), h2 = tr_read<v_rd_off(D0, 2, 1)>(vb), l3 = tr_read<v_rd_off(D0, 3, 0)>(vb), h3 = tr_read<v_rd_off(D0, 3, 1)>(vb);
    asm volatile("s_waitcnt lgkmcnt(0)" ::: "memory"); SBAR();
    od = __builtin_amdgcn_mfma_f32_32x32x16_bf16(pa2, PK(l2, h2), od, 0, 0, 0);
    od = __builtin_amdgcn_mfma_f32_32x32x16_bf16(pa3, PK(l3, h3), od, 0, 0, 0); }
#undef PK
}

__device__ __forceinline__ void segment(const Frame& F, int bhm, int qb, int j0, int j1, int slot) {
  const int tid = F.tid, wid = F.wave, lane = F.lane, r32 = lane & 31, hi = lane >> 5;
  const bf16* Qg = (const bf16*)(F.ws + WS_Q) + ((size_t)bhm * SEQ + qb * 256 + wid * 32 + r32) * 128 + hi * 8;
  const bf16* Kg = (const bf16*)(F.ws + WS_KP) + (size_t)bhm * 33 * 8192;
  const bf16* Vg = (const bf16*)(F.ws + WS_VP) + (size_t)(bhm >> 1) * PADT * 256;
  LAS unsigned char* lds = F.lds;
  LAS float* wsl = (LAS float*)(lds + LDS_WS) + wid * 64;
  const float slope2 = exp2f(-2.0f * (float)(((bhm >> 1) & 3) + 1)) * LOG2E;
  unsigned ksrc0, vsrc0;
  ksrc0 = (unsigned)tid * 16u;
  { const int a8 = tid >> 8, b = (tid >> 2) & 7, k = 8 * (b >> 2) + 4 * a8 + (b & 3), c = ((tid >> 5) & 7) * 32 + (tid & 3) * 8; vsrc0 = (unsigned)(k * 256 + c) * 2u; }
#define STAGE_K(j) do { const char* kt = (const char*)(Kg + (size_t)(j) * 8192); \
    _Pragma("unroll") for (int _i = 0; _i < 2; ++_i) __builtin_amdgcn_global_load_lds((const unsigned*)(kt + (ksrc0 + _i * 8192u)), (LAS unsigned*)(lds + LDS_K + _i * 8192 + wid * 1024), 16, 0, 0); } while (0)
#define STAGE_V(buf, j) do { const char* vt = (const char*)(Vg + (size_t)(j) * 64 * 256); \
    _Pragma("unroll") for (int _i = 0; _i < 4; ++_i) __builtin_amdgcn_global_load_lds((const unsigned*)(vt + (vsrc0 + _i * 8192u)), (LAS unsigned*)(lds + LDS_V + (buf) * SHM_V + _i * 8192 + wid * 1024), 16, 0, 0); } while (0)
  const int lt = (((r32 << 1) | hi) ^ ((r32 >> 3) & 1)) << 4;
  LAS unsigned char* Qs = lds + LDS_Q + wid * 8192;
#pragma unroll
  for (int d0 = 0; d0 < 8; ++d0) { const bf16x8 qv = *(const bf16x8*)(Qg + d0 * 16); *(LAS bf16x8*)(Qs + d0 * 1024 + lt) = qv; }
  f32x16 o[8];
#pragma unroll
  for (int d = 0; d < 8; ++d)
#pragma unroll
    for (int r = 0; r < 16; ++r) o[d][r] = 0.f;
  float m_reg = -1e30f, l_reg = 0.f;
  const int vb0 = (int)(uintptr_t)(lds + LDS_V) + (((lane & 3) << 3) | (((lane >> 2) & 3) << 6) | (((lane >> 4) & 1) << 5) | (((lane >> 5) & 1) << 8));
  STAGE_K(j0); STAGE_V(0, j0);
  VM_WAIT(); __syncthreads();
  for (int j = j0; j < j1; ++j) {
    const int cur = (j - j0) & 1;
    if (j + 1 < j1) STAGE_V(cur ^ 1, j + 1);
    SBAR();
    f32x16 p0 = {}, p1 = {};
    { const LAS unsigned char* Ks = lds + LDS_K;
#pragma unroll
      for (int d0 = 0; d0 < 8; ++d0) {
        const bf16x8 b0 = *(const LAS bf16x8*)(Ks + d0 * 2048 + lt);
        const bf16x8 b1 = *(const LAS bf16x8*)(Ks + d0 * 2048 + 1024 + lt);
        const bf16x8 qf = *(const LAS bf16x8*)(Qs + d0 * 1024 + lt);
        p0 = __builtin_amdgcn_mfma_f32_32x32x16_bf16(b0, qf, p0, 0, 0, 0);
        p1 = __builtin_amdgcn_mfma_f32_32x32x16_bf16(b1, qf, p1, 0, 0, 0); } }
    asm volatile("s_waitcnt lgkmcnt(0)" ::: "memory"); __builtin_amdgcn_s_barrier(); asm volatile("" ::: "memory");
    if (j + 1 < j1) STAGE_K(j + 1);
    SBAR();
    if (j == 0) {
#pragma unroll
      for (int r = 0; r < 16; ++r) p0[r] = -INFINITY;
#pragma unroll
      for (int r = 0; r < 8; ++r) p1[r] = -INFINITY;
    }
    int ln2 = threadIdx.x & 63; asm volatile("" : "+v"(ln2));
    const int hi2 = ln2 >> 5;
    const int jb = j - (4 * qb + 1);
    if (jb >= 0) {
      const int kb = 64 * jb + 4 * hi2, qrel = wid * 32 + (ln2 & 31);
#pragma unroll
      for (int r = 0; r < 16; ++r) { const int kv = kb + (r & 3) + 8 * (r >> 2); if (kv > qrel) p0[r] = -INFINITY; if (kv + 32 > qrel) p1[r] = -INFINITY; }
    }
    const float off0 = slope2 * (float)(64 * j + 4 * hi2), off1 = off0 + 32.0f * slope2;
#pragma unroll
    for (int r = 0; r < 16; ++r) { const float sb = slope2 * (float)((r & 3) + 8 * (r >> 2)); p0[r] += sb; p1[r] += sb; }
    float pm0 = p0[0], pm1 = p1[0];
#pragma unroll
    for (int r = 1; r < 16; ++r) { pm0 = fmaxf(pm0, p0[r]); pm1 = fmaxf(pm1, p1[r]); }
    float pmax = fmaxf(pm0 + off0, pm1 + off1);
    { auto rr = __builtin_amdgcn_permlane32_swap(__float_as_uint(pmax), __float_as_uint(pmax), false, false);
      pmax = fmaxf(__uint_as_float(rr[0]), __uint_as_float(rr[1])); }
    float mn, alpha;
    if (__builtin_expect(__all(pmax - m_reg <= THR2), 1)) { mn = m_reg; alpha = 1.f; }
    else { mn = fmaxf(m_reg, pmax); alpha = __builtin_amdgcn_exp2f(m_reg - mn); m_reg = mn; }
    const float c0 = off0 - mn, c1 = off1 - mn;
    float ps = 0.f;
#pragma unroll
    for (int r = 0; r < 16; ++r) { p0[r] = __builtin_amdgcn_exp2f(p0[r] + c0); p1[r] = __builtin_amdgcn_exp2f(p1[r] + c1); ps += p0[r] + p1[r]; }
    { auto rr = __builtin_amdgcn_permlane32_swap(__float_as_uint(ps), __float_as_uint(ps), false, false);
      ps = __uint_as_float(rr[0]) + __uint_as_float(rr[1]); }
    l_reg = l_reg * alpha + ps;
    if (__any(alpha < 1.f)) { if (hi == 0) wsl[r32] = alpha; asm volatile("s_waitcnt lgkmcnt(0)" ::: "memory");
#pragma unroll
      for (int rg = 0; rg < 4; ++rg) { const f32x4 al = *(const LAS f32x4*)(wsl + 8 * rg + 4 * hi);
#pragma unroll
        for (int d = 0; d < 8; ++d) { o[d][4 * rg + 0] *= al.x; o[d][4 * rg + 1] *= al.y; o[d][4 * rg + 2] *= al.z; o[d][4 * rg + 3] *= al.w; }
        SBAR(); } }
    bf16x8 pa0, pa1, pa2, pa3;
#define PK4(P, BASE, OUT) do { unsigned a0 = cvtpk(P[BASE + 0], P[BASE + 1]), a1 = cvtpk(P[BASE + 2], P[BASE + 3]);   \
    unsigned b0 = cvtpk(P[BASE + 4], P[BASE + 5]), b1 = cvtpk(P[BASE + 6], P[BASE + 7]);                              \
    auto r0 = __builtin_amdgcn_permlane32_swap(a0, b0, false, false); auto r1 = __builtin_amdgcn_permlane32_swap(a1, b1, false, false); \
    v4u w = {r0[0], r1[0], r0[1], r1[1]}; OUT = *reinterpret_cast<bf16x8*>(&w); } while (0)
    PK4(p0, 0, pa0); PK4(p0, 8, pa1); PK4(p1, 0, pa2); PK4(p1, 8, pa3);
#undef PK4
    SBAR();
    { const int vb = vb0 + cur * SHM_V;
      pv_one<0>(o[0], vb, pa0, pa1, pa2, pa3); pv_one<1>(o[1], vb, pa0, pa1, pa2, pa3); pv_one<2>(o[2], vb, pa0, pa1, pa2, pa3); pv_one<3>(o[3], vb, pa0, pa1, pa2, pa3);
      pv_one<4>(o[4], vb, pa0, pa1, pa2, pa3); pv_one<5>(o[5], vb, pa0, pa1, pa2, pa3); pv_one<6>(o[6], vb, pa0, pa1, pa2, pa3); pv_one<7>(o[7], vb, pa0, pa1, pa2, pa3); }
    VM_WAIT(); __syncthreads();
  }
  { int lane2 = threadIdx.x & 63, slot2 = slot; asm volatile("" : "+v"(lane2), "+s"(slot2));
    const int r32e = lane2 & 31, hie = lane2 >> 5;
    float* PO = (float*)(F.ws + WS_PO) + (size_t)slot2 * 256 * 256; float* ML = (float*)(F.ws + WS_ML) + (size_t)slot2 * 512;
    LAS float* wse = (LAS float*)(F.lds + LDS_WS) + wid * 64;
    if (hie == 0) { wse[r32e] = l_reg; ML[(wid * 32 + r32e) * 2] = m_reg; ML[(wid * 32 + r32e) * 2 + 1] = l_reg; }
    asm volatile("s_waitcnt lgkmcnt(0)" ::: "memory");
    char* Ob = (char*)(PO + (size_t)(wid * 32) * 256);
    const unsigned lo = (unsigned)(4 * hie * 256 + r32e) * 4u;
#pragma unroll
    for (int r = 0; r < 16; ++r) { const int rowc = (r & 3) + 8 * (r >> 2); const float lv = wse[rowc + 4 * hie]; const float rl = lv > 0.f ? __builtin_amdgcn_rcpf(lv) : 0.f;
#pragma unroll
      for (int d0 = 0; d0 < 8; ++d0) *(float*)(Ob + (lo + (unsigned)(rowc * 256 + d0 * 32) * 4u)) = o[d0][r] * rl;
      SBAR(); } }
  __syncthreads();
#undef STAGE_K
#undef STAGE_V
}

__device__ __forceinline__ void phase(const Frame& F, int ca, int NA) {
  int s0 = (int)(((long)ca * NSTEPS) / NA); const int s1 = (int)(((long)(ca + 1) * NSTEPS) / NA);
  while (s0 < s1) {
    const int bhm = s0 / STEPS_BHM, rem = s0 - bhm * STEPS_BHM;
    int qb = 0;
#pragma unroll 1
    for (int q = 1; q < 8; ++q) if (rem >= qb_start(q)) qb = q;
    const int j0 = rem - qb_start(qb), nst = 4 * qb + 5;
    const int j1 = (j0 + (s1 - s0) < nst) ? j0 + (s1 - s0) : nst;
    const int slot = bhm * 16 + qb + chunk_of(s0, NA) - chunk_of(bhm * STEPS_BHM, NA);
    segment(F, bhm, qb, j0, j1, slot);
    s0 += j1 - j0;
  }
}
#undef KSWZ
#undef SBAR
}
namespace ml {
constexpr int QST = 136, TST = 72;
constexpr int L_RQ = 0, L_RK = 17152, L_QS = 34304, L_QW = 51712, L_KS = 69120, L_KWT = 86528, L_VT = 104960  , L_SP = 0  , L_G = 141824, L_CW = 143872;
constexpr int L_HT = 0;
constexpr int G_A = 0, G_M = 64, G_WI = 128, G_EM = 192, G_DEN = 256, G_WG = 320, G_SC = 384, G_N = 0;
constexpr int L_NV = L_CW + 5120;
constexpr int L_SSQ = L_KWT;
__device__ __forceinline__ float shfl_up_f(float v, int d) { return __shfl_up(v, d); }

__device__ __forceinline__ void load_cw(const Frame& F, const Args& a, int h) {
  LAS float* CW = (LAS float*)(F.lds + L_CW);
  for (int e = F.tid; e < 2 * 5 * 128; e += NTHR) { const int qk = e / 640, j = (e / 128) % 5, d = e & 127; const int ch = qk * 512 + h * 128 + d;
    CW[e] = j < 4 ? a.in[IN_CW][j * 1024 + ch] : a.in[IN_CB][ch]; }
}
__device__ __forceinline__ void load_raw(const Frame& F, const bf16* g, int pos0, int lds_off) {
  for (int p = F.tid; p < 67 * 16; p += NTHR) { const int row = p >> 4, ch = p & 15, pos = pos0 - 3 + row;
    v4u v = {0u, 0u, 0u, 0u}; if (pos >= MPOS0) v = *(const v4u*)(g + (size_t)pos * 128 + ch * 8);
    *(LAS v4u*)(F.lds + lds_off + row * 256 + ch * 16) = v; }
}
__device__ __forceinline__ void conv16(const Frame& F, int qk, int lds_off, int t, int d0, float (&y)[16]) {
  const LAS float* CW = (const LAS float*)(F.lds + L_CW);
#pragma unroll
  for (int e = 0; e < 16; ++e) y[e] = CW[(qk * 5 + 4) * 128 + d0 + e];
#pragma unroll
  for (int j = 0; j < 4; ++j) { const LAS v4u* rp = (const LAS v4u*)(F.lds + lds_off + (t + j) * 256 + d0 * 2); const v4u r0 = rp[0], r1 = rp[1];
    const LAS float* cw = CW + (qk * 5 + j) * 128 + d0;
    y[0] += cw[0] * bflo(r0.x); y[1] += cw[1] * bfhi(r0.x); y[2] += cw[2] * bflo(r0.y); y[3] += cw[3] * bfhi(r0.y); y[4] += cw[4] * bflo(r0.z); y[5] += cw[5] * bfhi(r0.z); y[6] += cw[6] * bflo(r0.w); y[7] += cw[7] * bfhi(r0.w);
    y[8] += cw[8] * bflo(r1.x); y[9] += cw[9] * bfhi(r1.x); y[10] += cw[10] * bflo(r1.y); y[11] += cw[11] * bfhi(r1.y); y[12] += cw[12] * bflo(r1.z); y[13] += cw[13] * bfhi(r1.z); y[14] += cw[14] * bflo(r1.w); y[15] += cw[15] * bfhi(r1.w); }
#pragma unroll
  for (int e = 0; e < 16; ++e) y[e] = y[e] / (1.0f + __expf(-y[e]));
}
__device__ __forceinline__ void load_vt(const Frame& F, const bf16* MVg, int pos0) {
#pragma unroll
  for (int i = 0; i < 4; ++i) { const int p = F.tid + NTHR * i, row = p >> 5, ch = p & 31; v4u v4 = {0u, 0u, 0u, 0u};
    if (pos0 + row >= MPOS0) v4 = *(const v4u*)(MVg + (size_t)(pos0 + row) * 256 + ch * 8);
    LAS bf16* vt = (LAS bf16*)(F.lds + L_VT) + (ch * 8) * TST + row;
    vt[0 * TST] = (bf16)(v4.x & 0xffff); vt[1 * TST] = (bf16)(v4.x >> 16); vt[2 * TST] = (bf16)(v4.y & 0xffff); vt[3 * TST] = (bf16)(v4.y >> 16);
    vt[4 * TST] = (bf16)(v4.z & 0xffff); vt[5 * TST] = (bf16)(v4.z >> 16); vt[6 * TST] = (bf16)(v4.w & 0xffff); vt[7 * TST] = (bf16)(v4.w >> 16); }
}

__device__ __forceinline__ void taskA(const Frame& F, const Args& a, int task) {
  const int bh = task >> 5, c = task & 31, h = bh & 3, tid = F.tid, w = F.wave, lane = F.lane, fr = lane & 15, kq = lane >> 4, pos0 = 64 * c;
  LAS unsigned char* lds = F.lds; LAS float* G = (LAS float*)(lds + L_G);
  const bf16* MKg = (const bf16*)(F.ws + WS_MK) + (size_t)bh * PADT * 128; const bf16* MVg = (const bf16*)(F.ws + WS_MV) + (size_t)bh * PADT * 256;
  __syncthreads();
  load_cw(F, a, h); load_raw(F, MKg, pos0, L_RK); load_vt(F, MVg, pos0);
  if (w == 0) {
    const bool dead = pos0 + lane < MPOS0;
    const float li = dead ? -1e30f : ((const float*)(F.ws + WS_LI))[bh * PADT + pos0 + lane], lf = dead ? 0.f : ((const float*)(F.ws + WS_LF))[bh * PADT + pos0 + lane];
    float bs = lf;
#pragma unroll
    for (int d = 1; d < 64; d <<= 1) { const float o = shfl_up_f(bs, d); if (lane >= d) bs += o; }
    const float av = li - bs; float mx = av;
#pragma unroll
    for (int o = 1; o < 64; o <<= 1) mx = fmaxf(mx, __shfl_xor(mx, o));
    G[G_WG + lane] = __expf(av - mx);
    if (lane == 63) { float* gs = (float*)(F.ws + WS_GS) + (size_t)(bh * 33 + c) * 2; gs[0] = bs; gs[1] = mx; }
  }
  __syncthreads();
  { const int t = tid >> 3, d0 = (tid & 7) * 16; float y[16]; conv16(F, 1, L_RK, t, d0, y);
    const float sw = 0.08838834764831845f * G[G_WG + t]; LAS bf16* kt = (LAS bf16*)(lds + L_KWT) + d0 * TST + t;
#pragma unroll
    for (int e = 0; e < 16; ++e) kt[e * TST] = (bf16)f2bf(y[e] * sw); }
  __syncthreads();
  f32x4* DCg = (f32x4*)(F.ws + WS_DC) + ((size_t)(bh * 32 + c) * 128) * 64;
#pragma unroll
  for (int jj = 0; jj < 2; ++jj) { const int j = 2 * w + jj;
    const bf16x8 bv0 = *(const LAS bf16x8*)(lds + L_VT + ((16 * j + fr) * TST + 8 * kq) * 2), bv1 = *(const LAS bf16x8*)(lds + L_VT + ((16 * j + fr) * TST + 32 + 8 * kq) * 2);
#pragma unroll
    for (int i = 0; i < 8; ++i) { f32x4 acc = {0.f, 0.f, 0.f, 0.f};
      const bf16x8 k0 = *(const LAS bf16x8*)(lds + L_KWT + ((16 * i + fr) * TST + 8 * kq) * 2), k1 = *(const LAS bf16x8*)(lds + L_KWT + ((16 * i + fr) * TST + 32 + 8 * kq) * 2);
      acc = __builtin_amdgcn_mfma_f32_16x16x32_bf16(k0, bv0, acc, 0, 0, 0); acc = __builtin_amdgcn_mfma_f32_16x16x32_bf16(k1, bv1, acc, 0, 0, 0);
      DCg[(size_t)(i * 16 + j) * 64 + lane] = acc; } }
  if (tid < 128) { const LAS v4u* kr = (const LAS v4u*)(lds + L_KWT + tid * TST * 2); float s = 0.f;
#pragma unroll
    for (int q = 0; q < 8; ++q) { const v4u x = kr[q]; s += (bflo(x.x) + bfhi(x.x)) + (bflo(x.y) + bfhi(x.y)) + (bflo(x.z) + bfhi(x.z)) + (bflo(x.w) + bfhi(x.w)); }
    ((float*)(F.ws + WS_DN))[(size_t)(bh * 32 + c) * 128 + tid] = s; }
}

__device__ __forceinline__ void scanB(const Frame& F) {
  const float* GS = (const float*)(F.ws + WS_GS);
  LAS float* cf = (LAS float*)F.lds;
  for (int blk = blockIdx.x; blk < 16 * 8; blk += gridDim.x) { const int bh = blk >> 3, r = (blk & 7) * NTHR + F.tid, I = r >> 10, j = (r >> 6) & 15, ln = r & 63;
    __syncthreads();
    if (F.tid == 0) { float m = 0.f; for (int c = 0; c < 32; ++c) { const float bL = GS[(bh * 33 + c) * 2], ml = GS[(bh * 33 + c) * 2 + 1], me = fmaxf(m, ml);
        cf[2 * c] = __expf(m - me); cf[2 * c + 1] = __expf(ml - me); m = bL + me; } }
    __syncthreads();
    const f32x4* dc0 = (const f32x4*)(F.ws + WS_DC) + ((size_t)(bh * 32) * 128 + ((2 * I) * 16 + j)) * 64 + ln;
    const f32x4* dc1 = dc0 + 16 * 64;
    v4u* cs = (v4u*)(F.ws + WS_CS) + ((((size_t)bh * 33) * 4 + I) * 16 + j) * 64 + ln;
    f32x4 s0 = {0.f, 0.f, 0.f, 0.f}, s1 = {0.f, 0.f, 0.f, 0.f};
#pragma unroll 8
    for (int c = 0; c < 32; ++c) { const float fa = cf[2 * c], fb = cf[2 * c + 1];
      s0 = s0 * fa + dc0[(size_t)c * 128 * 64] * fb; s1 = s1 * fa + dc1[(size_t)c * 128 * 64] * fb;
      v4u o; o.x = pk2(s0.x, s0.y); o.y = pk2(s0.z, s0.w); o.z = pk2(s1.x, s1.y); o.w = pk2(s1.z, s1.w); cs[(size_t)(c + 1) * 4 * 16 * 64] = o; } }
  const int gt = blockIdx.x * NTHR + F.tid, NT = gridDim.x * NTHR;
  for (int g = gt; g < 16 * 128; g += NT) { const int bh = g >> 7, d = g & 127; float n = 0.f, m = 0.f;
    for (int c = 0; c < 32; ++c) { const float bL = GS[(bh * 33 + c) * 2], ml = GS[(bh * 33 + c) * 2 + 1], me = fmaxf(m, ml);
      n = n * __expf(m - me) + ((const float*)(F.ws + WS_DN))[(size_t)(bh * 32 + c) * 128 + d] * __expf(ml - me); m = bL + me;
      ((float*)(F.ws + WS_NS))[(size_t)(bh * 33 + c + 1) * 128 + d] = n; if (d == 0) ((float*)(F.ws + WS_MS))[bh * 33 + c + 1] = m; } }
}

__device__ __forceinline__ void taskC(const Frame& F, const Args& a, int task) {
  const int bh = task >> 5, c = (task & 31) + 1, b = bh >> 2, h = bh & 3, tid = F.tid, w = F.wave, lane = F.lane, fr = lane & 15, kq = lane >> 4, pos0 = 64 * c;
  LAS unsigned char* lds = F.lds; LAS float* G = (LAS float*)(lds + L_G); LAS float* NV = (LAS float*)(lds + L_NV);
  const bf16* MQg = (const bf16*)(F.ws + WS_MQ) + (size_t)bh * PADT * 128; const bf16* MKg = (const bf16*)(F.ws + WS_MK) + (size_t)bh * PADT * 128;
  const bf16* MVg = (const bf16*)(F.ws + WS_MV) + (size_t)bh * PADT * 256;
  const float m = ((const float*)(F.ws + WS_MS))[bh * 33 + c];
  __syncthreads();
  load_cw(F, a, h); load_raw(F, MQg, pos0, L_RQ); load_raw(F, MKg, pos0, L_RK); load_vt(F, MVg, pos0);
  if (tid < 128) NV[tid] = ((const float*)(F.ws + WS_NS))[(size_t)(bh * 33 + c) * 128 + tid];
  if (w == 0) {
    const float li = ((const float*)(F.ws + WS_LI))[bh * PADT + pos0 + lane], lf = ((const float*)(F.ws + WS_LF))[bh * PADT + pos0 + lane];
    float bs = lf;
#pragma unroll
    for (int d = 1; d < 64; d <<= 1) { const float o = shfl_up_f(bs, d); if (lane >= d) bs += o; }
    const float av = li - bs; float cm = av;
#pragma unroll
    for (int d = 1; d < 64; d <<= 1) { const float o = shfl_up_f(cm, d); if (lane >= d) cm = fmaxf(cm, o); }
    const float Mt = fmaxf(m, cm);
    G[G_A + lane] = av; G[G_M + lane] = Mt; G[G_WI + lane] = __expf(m - Mt); G[G_EM + lane] = __expf(-(bs + Mt));
  }
  __syncthreads();
  { const int t = tid >> 3, d0 = (tid & 7) * 16; const float wi = G[G_WI + t]; float y[16];
    conv16(F, 0, L_RQ, t, d0, y);
    { v4u o0, o1, w0, w1;
      o0.x = pk2(y[0], y[1]); o0.y = pk2(y[2], y[3]); o0.z = pk2(y[4], y[5]); o0.w = pk2(y[6], y[7]); o1.x = pk2(y[8], y[9]); o1.y = pk2(y[10], y[11]); o1.z = pk2(y[12], y[13]); o1.w = pk2(y[14], y[15]);
      w0.x = pk2(y[0] * wi, y[1] * wi); w0.y = pk2(y[2] * wi, y[3] * wi); w0.z = pk2(y[4] * wi, y[5] * wi); w0.w = pk2(y[6] * wi, y[7] * wi);
      w1.x = pk2(y[8] * wi, y[9] * wi); w1.y = pk2(y[10] * wi, y[11] * wi); w1.z = pk2(y[12] * wi, y[13] * wi); w1.w = pk2(y[14] * wi, y[15] * wi);
      LAS v4u* qs = (LAS v4u*)(lds + L_QS + (t * QST + d0) * 2); qs[0] = o0; qs[1] = o1;
      LAS v4u* qw = (LAS v4u*)(lds + L_QW + (t * QST + d0) * 2); qw[0] = w0; qw[1] = w1; }
    __builtin_amdgcn_sched_barrier(0);
    conv16(F, 1, L_RK, t, d0, y);
    { const float sc = 0.08838834764831845f; v4u o0, o1;
      o0.x = pk2(y[0] * sc, y[1] * sc); o0.y = pk2(y[2] * sc, y[3] * sc); o0.z = pk2(y[4] * sc, y[5] * sc); o0.w = pk2(y[6] * sc, y[7] * sc);
      o1.x = pk2(y[8] * sc, y[9] * sc); o1.y = pk2(y[10] * sc, y[11] * sc); o1.z = pk2(y[12] * sc, y[13] * sc); o1.w = pk2(y[14] * sc, y[15] * sc);
      LAS v4u* ks = (LAS v4u*)(lds + L_KS + (t * QST + d0) * 2); ks[0] = o0; ks[1] = o1; } }
  __syncthreads();
  v4u cb[4][2];
  { const v4u* cs = (const v4u*)(F.ws + WS_CS) + (((size_t)bh * 33 + c) * 4 * 16) * 64;
#pragma unroll
    for (int I = 0; I < 4; ++I)
#pragma unroll
      for (int jj = 0; jj < 2; ++jj) cb[I][jj] = cs[(size_t)(I * 16 + 2 * w + jj) * 64 + lane]; }
  { const int si = w >> 1; const f32x4 as = *(const LAS f32x4*)(G + G_A + 16 * si + 4 * kq);
#pragma unroll
    for (int tt = 0; tt < 2; ++tt) { const int ti = 2 * (w & 1) + tt; f32x4 acc = {0.f, 0.f, 0.f, 0.f};
#pragma unroll
      for (int ks = 0; ks < 4; ++ks) { const bf16x8 af = *(const LAS bf16x8*)(lds + L_KS + ((16 * si + fr) * QST + 32 * ks + 8 * kq) * 2);
        const bf16x8 bfr = *(const LAS bf16x8*)(lds + L_QS + ((16 * ti + fr) * QST + 32 * ks + 8 * kq) * 2);
        acc = __builtin_amdgcn_mfma_f32_16x16x32_bf16(af, bfr, acc, 0, 0, 0); }
      const int t = 16 * ti + fr, s0 = 16 * si + 4 * kq; const float Mt = G[G_M + t];
      const float v0 = (s0 + 0 <= t) ? acc.x * __expf(as.x - Mt) : 0.f, v1 = (s0 + 1 <= t) ? acc.y * __expf(as.y - Mt) : 0.f;
      const float v2 = (s0 + 2 <= t) ? acc.z * __expf(as.z - Mt) : 0.f, v3 = (s0 + 3 <= t) ? acc.w * __expf(as.w - Mt) : 0.f;
      v2u o; o.x = pk2(v0, v1); o.y = pk2(v2, v3);
      *(LAS v2u*)(lds + L_SP + (t * TST + s0) * 2) = o; } }
  __syncthreads();
  if (w == 0) { const int t = lane; float qn = 0.f, rsum = 0.f;
#pragma unroll 4
    for (int q = 0; q < 16; ++q) { const v4u x = *(const LAS v4u*)(lds + L_QS + (t * QST + q * 8) * 2); const f32x4 n0 = *(const LAS f32x4*)(NV + q * 8), n1 = *(const LAS f32x4*)(NV + q * 8 + 4);
      qn += bflo(x.x) * n0.x + bfhi(x.x) * n0.y + bflo(x.y) * n0.z + bfhi(x.y) * n0.w + bflo(x.z) * n1.x + bfhi(x.z) * n1.y + bflo(x.w) * n1.z + bfhi(x.w) * n1.w; }
#pragma unroll
    for (int q = 0; q < 8; ++q) { const v4u x = *(const LAS v4u*)(lds + L_SP + (t * TST + q * 8) * 2); rsum += (bflo(x.x) + bfhi(x.x)) + (bflo(x.y) + bfhi(x.y)) + (bflo(x.z) + bfhi(x.z)) + (bflo(x.w) + bfhi(x.w)); }
    const float den = G[G_WI + t] * qn + rsum; G[G_DEN + t] = fmaxf(fabsf(den), G[G_EM + t]); }
  f32x4 acc[2][4];
#pragma unroll
  for (int jj = 0; jj < 2; ++jj)
#pragma unroll
    for (int ti = 0; ti < 4; ++ti) acc[jj][ti] = (f32x4){0.f, 0.f, 0.f, 0.f};
#pragma unroll
  for (int I = 0; I < 4; ++I) {
#pragma unroll
    for (int ti = 0; ti < 4; ++ti) { const LAS unsigned char* qp = lds + L_QW + ((16 * ti + fr) * QST + 32 * I + 4 * kq) * 2;
      const v2u a0 = *(const LAS v2u*)qp, a1 = *(const LAS v2u*)(qp + 32); const v4u av = {a0.x, a0.y, a1.x, a1.y};
      acc[0][ti] = __builtin_amdgcn_mfma_f32_16x16x32_bf16(__builtin_bit_cast(bf16x8, av), __builtin_bit_cast(bf16x8, cb[I][0]), acc[0][ti], 0, 0, 0);
      acc[1][ti] = __builtin_amdgcn_mfma_f32_16x16x32_bf16(__builtin_bit_cast(bf16x8, av), __builtin_bit_cast(bf16x8, cb[I][1]), acc[1][ti], 0, 0, 0); }
    __builtin_amdgcn_sched_barrier(0); }
#pragma unroll
  for (int ks = 0; ks < 2; ++ks) { const bf16x8 bv0 = *(const LAS bf16x8*)(lds + L_VT + ((32 * w + fr) * TST + 32 * ks + 8 * kq) * 2), bv1 = *(const LAS bf16x8*)(lds + L_VT + ((32 * w + 16 + fr) * TST + 32 * ks + 8 * kq) * 2);
#pragma unroll
    for (int ti = 0; ti < 4; ++ti) { const bf16x8 sf = *(const LAS bf16x8*)(lds + L_SP + ((16 * ti + fr) * TST + 32 * ks + 8 * kq) * 2);
      acc[0][ti] = __builtin_amdgcn_mfma_f32_16x16x32_bf16(sf, bv0, acc[0][ti], 0, 0, 0); acc[1][ti] = __builtin_amdgcn_mfma_f32_16x16x32_bf16(sf, bv1, acc[1][ti], 0, 0, 0); } }
  __syncthreads();
  LAS float* SSQ = (LAS float*)(lds + L_SSQ);
#pragma unroll
  for (int ti = 0; ti < 4; ++ti) { const f32x4 dn = *(const LAS f32x4*)(G + G_DEN + 16 * ti + 4 * kq);
    f32x4 s4;
#pragma unroll
    for (int r = 0; r < 4; ++r) { const float h0 = acc[0][ti][r] / dn[r], h1 = acc[1][ti][r] / dn[r]; acc[0][ti][r] = h0; acc[1][ti][r] = h1; s4[r] = h0 * h0 + h1 * h1; }
#pragma unroll
    for (int o = 1; o < 16; o <<= 1) { s4.x += __shfl_xor(s4.x, o); s4.y += __shfl_xor(s4.y, o); s4.z += __shfl_xor(s4.z, o); s4.w += __shfl_xor(s4.w, o); }
    if (fr == 0) { SSQ[(16 * ti + 4 * kq + 0) * 8 + w] = s4.x; SSQ[(16 * ti + 4 * kq + 1) * 8 + w] = s4.y; SSQ[(16 * ti + 4 * kq + 2) * 8 + w] = s4.z; SSQ[(16 * ti + 4 * kq + 3) * 8 + w] = s4.w; } }
  __syncthreads();
  LAS bf16* HT = (LAS bf16*)(lds + L_HT);
#pragma unroll
  for (int ti = 0; ti < 4; ++ti)
#pragma unroll
    for (int r = 0; r < 4; ++r) { const int t = 16 * ti + 4 * kq + r; const f32x4 p0 = *(const LAS f32x4*)(SSQ + t * 8), p1 = *(const LAS f32x4*)(SSQ + t * 8 + 4);
      const float rh = rsqrtf(((p0.x + p0.y) + (p0.z + p0.w) + (p1.x + p1.y) + (p1.z + p1.w)) * (1.0f / 256.f) + EPS);
      HT[t * 264 + 32 * w + fr] = (bf16)f2bf(acc[0][ti][r] * rh); HT[t * 264 + 32 * w + 16 + fr] = (bf16)f2bf(acc[1][ti][r] * rh); }
  __syncthreads();
  { const int t = tid >> 3, c0 = (tid & 7) * 32; const size_t R = (size_t)b * SEQ + 64 * (c - 1) + t;
    const bf16* mo = (const bf16*)(F.ws + WS_MO) + R * 1024 + h * 256 + c0; const float* og = a.in[IN_OUTG] + h * 256 + c0; bf16* A2 = (bf16*)(F.ws + WS_A2) + R * DM + 1024 + h * 256 + c0;
#pragma unroll
    for (int q = 0; q < 4; ++q) { const v4u hv = *(const LAS v4u*)(HT + t * 264 + c0 + q * 8); const v4u mv = *(const v4u*)(mo + q * 8); const f32x4 g0 = *(const f32x4*)(og + q * 8), g1 = *(const f32x4*)(og + q * 8 + 4);
      v4u o; o.x = pk2(bflo(hv.x) * g0.x * bflo(mv.x), bfhi(hv.x) * g0.y * bfhi(mv.x)); o.y = pk2(bflo(hv.y) * g0.z * bflo(mv.y), bfhi(hv.y) * g0.w * bfhi(mv.y));
      o.z = pk2(bflo(hv.z) * g1.x * bflo(mv.z), bfhi(hv.z) * g1.y * bfhi(mv.z)); o.w = pk2(bflo(hv.w) * g1.z * bflo(mv.w), bfhi(hv.w) * g1.w * bfhi(mv.w));
      *(v4u*)(A2 + q * 8) = o; } }
}
}
__device__ __forceinline__ void p3_combine(const Frame& F, const Args& a, int NA) {
  const float* PO = (const float*)(F.ws + WS_PO); const float* ML = (const float*)(F.ws + WS_ML);
  bf16* A2 = (bf16*)(F.ws + WS_A2);
  const float lam = *(const float*)(F.ws + WS_LAM);
  const float* subg = a.in[IN_SUBG];
  const int gw = blockIdx.x * NWAVES + F.wave, NGW = gridDim.x * NWAVES, lane = F.lane;
  const f32x4 sg = ((const f32x4*)subg)[lane];
  for (int R = gw; R < MROWS; R += NGW) {
    const int b = R >> 11, t = R & 2047, qb = t >> 8, rq = t & 255;
#pragma unroll 2
    for (int h = 0; h < 4; ++h) {
      f32x4 om[2];
#pragma unroll
      for (int m = 0; m < 2; ++m) {
        const int bhm = (b * 4 + h) * 2 + m, first = bhm * att::STEPS_BHM + att::qb_start(qb), last = first + 4 * qb + 4;
        const int cf = att::chunk_of(first, NA), np = att::chunk_of(last, NA) - cf + 1, slot0 = bhm * 16 + qb + cf - att::chunk_of(bhm * att::STEPS_BHM, NA);
        float mp[3], lp[3]; f32x4 op[3];
#pragma unroll
        for (int p = 0; p < 3; ++p) { if (p < np) { const int slot = slot0 + p; mp[p] = ML[(size_t)slot * 512 + rq * 2]; lp[p] = ML[(size_t)slot * 512 + rq * 2 + 1];
            op[p] = ((const f32x4*)(PO + ((size_t)slot * 256 + rq) * 256))[lane]; } else { mp[p] = -1e30f; lp[p] = 0.f; op[p] = (f32x4){0.f, 0.f, 0.f, 0.f}; } }
        const float M = fmaxf(mp[0], fmaxf(mp[1], mp[2]));
        float wsum = 0.f; f32x4 acc = (f32x4){0.f, 0.f, 0.f, 0.f};
#pragma unroll
        for (int p = 0; p < 3; ++p) { const float w = lp[p] * exp2f(mp[p] - M); wsum += w; acc += op[p] * w; }
        om[m] = acc * (1.0f / wsum);
      }
      const f32x4 o = om[0] - om[1] * lam;
      const float rs = rsqrtf(wave_sum((o.x * o.x + o.y * o.y) + (o.z * o.z + o.w * o.w)) * (1.0f / 256.f) + EPS) * 0.8f;
      v2u w; w.x = pk2(o.x * rs * sg.x, o.y * rs * sg.y); w.y = pk2(o.z * rs * sg.z, o.w * rs * sg.w);
      ((v2u*)(A2 + (size_t)R * DM + h * 256))[lane] = w;
    }
  }
}
struct EpiRes {
  static constexpr bool PERM = true, AFTER_DRAIN = false;
  const float* x; float* out; bf16* H1b; float* SSQ;
  __device__ __forceinline__ void operator()(const pg8::f32x4 (&acc)[2][2][4][2], const pg8::Unit& u, int wr, int wc, int fr, int fq) const {
    const int row0 = u.pm * 256 + wr * 64 + fr, col0 = u.pn * 256 + wc * 32 + 8 * fq;
#pragma unroll
    for (int ai = 0; ai < 2; ++ai)
#pragma unroll
      for (int m = 0; m < 4; ++m) { const size_t R = (size_t)(row0 + ai * 128 + m * 16); float s = 0.f;
#pragma unroll
        for (int bj = 0; bj < 2; ++bj) { const size_t off = R * DM + col0 + bj * 128;
          const f32x4 x0 = *(const f32x4*)(x + off), x1 = *(const f32x4*)(x + off + 4);
          const f32x4 v0 = acc[ai][bj][m][0] + x0, v1 = acc[ai][bj][m][1] + x1;
          v4u w; w.x = pk2(v0.x, v0.y); w.y = pk2(v0.z, v0.w); w.z = pk2(v1.x, v1.y); w.w = pk2(v1.z, v1.w);
          *(v4u*)(H1b + off) = w;
          s += (v0.x * v0.x + v0.y * v0.y) + (v0.z * v0.z + v0.w * v0.w) + (v1.x * v1.x + v1.y * v1.y) + (v1.z * v1.z + v1.w * v1.w); }
        s += __shfl_xor(s, 16); s += __shfl_xor(s, 32);
        if (fq == 0) SSQ[R * 32 + u.pn * 4 + wc] = s; }
  }
};
#ifndef PEER_U_FP8
#define PEER_U_FP8 0
#endif
typedef __bf16 bfv2 __attribute__((ext_vector_type(2)));
__device__ __forceinline__ void split_hl(const f32x4 a, const f32x4 b, bf16x8& hi, bf16x8& lo) {
  float v[8] = {a.x, a.y, a.z, a.w, b.x, b.y, b.z, b.w}; unsigned h[8], l[8];
#pragma unroll
  for (int i = 0; i < 8; ++i) { h[i] = f2bf(v[i]); l[i] = f2bf(v[i] - __builtin_bit_cast(float, h[i] << 16)); }
  v4u hv = {h[0] | (h[1] << 16), h[2] | (h[3] << 16), h[4] | (h[5] << 16), h[6] | (h[7] << 16)};
  v4u lv = {l[0] | (l[1] << 16), l[2] | (l[3] << 16), l[4] | (l[5] << 16), l[6] | (l[7] << 16)};
  hi = __builtin_bit_cast(bf16x8, hv); lo = __builtin_bit_cast(bf16x8, lv);
}
__device__ __forceinline__ void p0_w3t(const Frame& F, const Args& a) {
  const float* wq = a.in[IN_WQ]; const float* sk = a.in[IN_SUBK]; const float* g2 = a.in[IN_G2];
  bf16* W3t = (bf16*)(F.ws + WS_W3T);
  const int gw = blockIdx.x * NWAVES + F.wave, NGW = gridDim.x * NWAVES, lane = F.lane, fr = lane & 15, fq = lane >> 4;
  for (int task = gw; task < 128 * 16; task += NGW) {
    const int kt = task >> 4, hh = task & 15;
    bf16x8 ahi[4], alo[4];
    const float* ap = wq + (size_t)(kt * 16 + fr) * DM + hh * 128 + fq * 8;
#pragma unroll
    for (int s = 0; s < 4; ++s) split_hl(*(const f32x4*)(ap + 32 * s), *(const f32x4*)(ap + 32 * s + 4), ahi[s], alo[s]);
    const f32x4 gk = *(const f32x4*)(g2 + kt * 16 + fq * 4);
#pragma unroll 1
    for (int t2 = 0; t2 < 8; ++t2) {
      const float* bp = sk + (size_t)(hh * 128 + t2 * 16 + fr) * 128 + fq * 8;
      f32x4 acc = {0.f, 0.f, 0.f, 0.f};
#pragma unroll
      for (int s = 0; s < 4; ++s) { bf16x8 bhi, blo; split_hl(*(const f32x4*)(bp + 32 * s), *(const f32x4*)(bp + 32 * s + 4), bhi, blo);
        acc = __builtin_amdgcn_mfma_f32_16x16x32_bf16(ahi[s], bhi, acc, 0, 0, 0);
        acc = __builtin_amdgcn_mfma_f32_16x16x32_bf16(ahi[s], blo, acc, 0, 0, 0);
        acc = __builtin_amdgcn_mfma_f32_16x16x32_bf16(alo[s], bhi, acc, 0, 0, 0); }
      v2u o; o.x = pk2(acc.x * gk.x, acc.y * gk.y); o.y = pk2(acc.z * gk.z, acc.w * gk.w);
      *(v2u*)(W3t + (size_t)(hh * 128 + t2 * 16 + fr) * DM + kt * 16 + fq * 4) = o;
    }
  }
}
typedef float f32x2v __attribute__((ext_vector_type(2)));
__device__ __forceinline__ void p0_tables(const Frame& F, const Args& a) {
  const float* g2 = a.in[IN_G2];
  float* SCL = (float*)(F.ws + WS_SCL);
  const int gw = blockIdx.x * NWAVES + F.wave, NGW = gridDim.x * NWAVES, lane = F.lane;
  f32x4 gl[8];
#pragma unroll
  for (int q = 0; q < 8; ++q) gl[q] = *(const f32x4*)(g2 + lane * 32 + q * 4);
  f32x4 xn[8];
  { const int row = gw; if (row < 2 * 16384) { const float* src = a.in[row >= 16384 ? IN_V : IN_U] + (size_t)(row & 16383) * DM + lane * 32;
#pragma unroll
      for (int q = 0; q < 8; ++q) xn[q] = *(const f32x4*)(src + q * 4); } }
  for (int row = gw; row < 2 * 16384; row += NGW) {
    const bool isv = row >= 16384; const int e = row & 16383;
    f32x4 x[8];
#pragma unroll
    for (int q = 0; q < 8; ++q) x[q] = xn[q];
    { const int rn = row + NGW; if (rn < 2 * 16384) { const float* src = a.in[rn >= 16384 ? IN_V : IN_U] + (size_t)(rn & 16383) * DM + lane * 32;
#pragma unroll
        for (int q = 0; q < 8; ++q) xn[q] = *(const f32x4*)(src + q * 4); } }
    float amax = 0.f;
#pragma unroll
    for (int q = 0; q < 8; ++q) { if (!isv) x[q] = x[q] * gl[q]; amax = fmaxf(amax, fmaxf(fmaxf(fabsf(x[q].x), fabsf(x[q].y)), fmaxf(fabsf(x[q].z), fabsf(x[q].w)))); }
#pragma unroll
    for (int o = 1; o < 64; o <<= 1) amax = fmaxf(amax, __shfl_xor(amax, o));
    const float sc = amax > 0.f ? 6.0f / amax : 1.0f;
    v4u w;
#pragma unroll
    for (int d = 0; d < 4; ++d) { unsigned pk = 0u;
      pk = __builtin_amdgcn_cvt_scalef32_pk_fp4_f32(pk, x[2 * d].x * sc, x[2 * d].y * sc, 1.0f, 0); pk = __builtin_amdgcn_cvt_scalef32_pk_fp4_f32(pk, x[2 * d].z * sc, x[2 * d].w * sc, 1.0f, 1);
      pk = __builtin_amdgcn_cvt_scalef32_pk_fp4_f32(pk, x[2 * d + 1].x * sc, x[2 * d + 1].y * sc, 1.0f, 2); pk = __builtin_amdgcn_cvt_scalef32_pk_fp4_f32(pk, x[2 * d + 1].z * sc, x[2 * d + 1].w * sc, 1.0f, 3);
      w[d] = pk; }
    *(v4u*)(F.ws + (isv ? WS_VB8 : WS_UB) + (size_t)e * 1024 + lane * 16) = w;
    if (lane == 0) SCL[row] = 1.0f / sc;
  }
}
struct EpiScore {
  static constexpr bool PERM = true, AFTER_DRAIN = false;
  float* S; const LAS float* rs;
  __device__ __forceinline__ void operator()(const pg8::f32x4 (&acc)[2][2][4][2], const pg8::Unit& u, int wr, int wc, int fr, int fq) const {
    const int rl0 = wr * 64 + fr, keyb = wc * 32 + 8 * fq;
#pragma unroll
    for (int ai = 0; ai < 2; ++ai)
#pragma unroll
      for (int m = 0; m < 4; ++m) { const int rl = rl0 + ai * 128 + m * 16; const float r = rs[rl]; const int row = u.pm * 256 + rl;
#pragma unroll
        for (int bj = 0; bj < 2; ++bj) { float* d = S + ((size_t)((row >> 5) * 16 + u.pn * 2 + bj) * 128 + keyb) * 32 + (row & 31);
          const pg8::f32x4 v0 = acc[ai][bj][m][0] * r, v1 = acc[ai][bj][m][1] * r;
          d[0] = v0[0]; d[32] = v0[1]; d[64] = v0[2]; d[96] = v0[3]; d[128] = v1[0]; d[160] = v1[1]; d[192] = v1[2]; d[224] = v1[3]; } }
  }
};

__device__ __forceinline__ unsigned fkey(float f) { const unsigned b = __builtin_bit_cast(unsigned, f); return b ^ ((b >> 31) ? 0xFFFFFFFFu : 0x80000000u); }
template <int NV, int K> __device__ __forceinline__ void wave_topk(const unsigned (&u)[NV], bool (&sel)[NV], int lane) {
  unsigned prefix = 0u; int cge = NV * 64;
#pragma unroll 1
  for (int bit = 31; bit >= 0 && cge != K; --bit) {
    const unsigned cand = prefix | (1u << bit); int c = 0;
#pragma unroll
    for (int i = 0; i < NV; ++i) c += __builtin_popcountll(__ballot(u[i] >= cand));
    if (c >= K) { prefix = cand; cge = c; }
  }
  int cgt = 0;
#pragma unroll
  for (int i = 0; i < NV; ++i) cgt += __builtin_popcountll(__ballot(u[i] > prefix));
  int need = K - cgt;
  const unsigned long long lm = (1ull << lane) - 1ull;
#pragma unroll
  for (int i = 0; i < NV; ++i) { const unsigned long long eq = __ballot(u[i] == prefix); const int before = __builtin_popcountll(eq & lm);
    sel[i] = (u[i] > prefix) || (u[i] == prefix && before < need); const int ne = __builtin_popcountll(eq); need = need > ne ? need - ne : 0; }
}
template <int NG, int NV, int K> __device__ __forceinline__ void wave_topk_multi(const unsigned (&u)[NG][NV], bool (&sel)[NG][NV], int lane) {
  unsigned prefix[NG]; int cge[NG];
#pragma unroll
  for (int g = 0; g < NG; ++g) { prefix[g] = 0u; cge[g] = NV * 64; }
#pragma unroll 1
  for (int bit = 31; bit >= 0; --bit) {
    bool done = true;
#pragma unroll
    for (int g = 0; g < NG; ++g) done = done && (cge[g] == K);
    if (done) break;
#pragma unroll
    for (int g = 0; g < NG; ++g) { const unsigned cand = prefix[g] | (1u << bit); int c = 0;
#pragma unroll
      for (int i = 0; i < NV; ++i) c += __builtin_popcountll(__ballot(u[g][i] >= cand));
      if (cge[g] != K && c >= K) { prefix[g] = cand; cge[g] = c; } }
  }
  const unsigned long long lm = (1ull << lane) - 1ull;
#pragma unroll
  for (int g = 0; g < NG; ++g) { int cgt = 0;
#pragma unroll
    for (int i = 0; i < NV; ++i) cgt += __builtin_popcountll(__ballot(u[g][i] > prefix[g]));
    int need = K - cgt;
#pragma unroll
    for (int i = 0; i < NV; ++i) { const unsigned long long eq = __ballot(u[g][i] == prefix[g]); const int before = __builtin_popcountll(eq & lm);
      sel[g][i] = (u[g][i] > prefix[g]) || (u[g][i] == prefix[g] && before < need); const int ne = __builtin_popcountll(eq); need = need > ne ? need - ne : 0; } }
}
__device__ __forceinline__ float gelu_erf(float v) {
  const float av = fabsf(v), t = __builtin_amdgcn_rcpf(1.0f + 0.2316418882f * av);
  float q = t * 0.5307027145f - 0.7265760135f; q = q * t + 0.7107068705f; q = q * t - 0.142248368f; q = q * t + 0.127414796f; q = q * t;
  const float tail = q * __builtin_amdgcn_exp2f(v * v * -0.72134752044f);
  return v < 0.f ? v * tail : v - v * tail;
}

#ifndef ROUTE_REPS
#define ROUTE_REPS 1
#endif
__device__ __forceinline__ void ins16(float (&t)[16], float x) {
#pragma unroll
  for (int i = 15; i >= 1; --i) t[i] = __builtin_amdgcn_fmed3f(t[i - 1], t[i], x);
  t[0] = fmaxf(t[0], x);
}
__device__ __forceinline__ void p6_peer(const Frame& F, const Args& a, float* dst_base) {
  const float* S2 = (const float*)(F.ws + WS_S); const float* SSQ = (const float*)(F.ws + WS_SSQ); const bf16* H1b = (const bf16*)(F.ws + WS_H1B);
  int lane = F.lane, wv = F.wave, tid = F.tid; asm volatile("" : "+v"(lane), "+s"(wv), "+v"(tid));
  int* EIDg = (int*)(F.ws + WS_EID); float* EGTg = (float*)(F.ws + WS_EGT);
  LAS int* eid = (LAS int*)(F.lds + wv * 1536); LAS float* egt = (LAS float*)(eid + 128); LAS float* esu = (LAS float*)(eid + 256);
  LAS unsigned char* RB = F.lds + 12288 + wv * 16384;
  LAS float* L1 = (LAS float*)(F.lds + 12288);
  for (int tb = blockIdx.x; tb < MROWS / 32; tb += gridDim.x) {
    __syncthreads();
    {
      const int g = tid >> 5, tl = tid & 31; const float* src = S2 + ((size_t)(tb * 16 + g) * 128) * 32 + tl;
      float t[16];
#pragma unroll
      for (int i = 0; i < 16; ++i) t[i] = -INFINITY;
#pragma unroll 32
      for (int k = 0; k < 128; ++k) { const float x = src[k * 32]; ins16(t, __builtin_bit_cast(float, (__builtin_bit_cast(unsigned, x) & ~0x7Fu) | (unsigned)(127 - k))); }
#pragma unroll
      for (int i = 0; i < 16; ++i) L1[(g * 16 + i) * 32 + tl] = t[i];
    }
    __syncthreads();
    if (tid < 256) {
      const int h8 = tid >> 5, tl = tid & 31; const LAS float* LA = L1 + ((2 * h8) * 16) * 32 + tl; const LAS float* LB = L1 + ((2 * h8 + 1) * 16) * 32 + tl;
      float A[16], B[16], t[16];
#pragma unroll
      for (int i = 0; i < 16; ++i) { A[i] = LA[i * 32]; B[i] = LB[i * 32]; t[i] = -INFINITY; }
#pragma unroll
      for (int i = 0; i < 16; ++i)
#pragma unroll
        for (int j = 0; j < 16; ++j) if ((i + 1) * (j + 1) <= 16) { const float c = A[i] + B[j];
            ins16(t, __builtin_bit_cast(float, (__builtin_bit_cast(unsigned, c) & ~0xFFu) | (unsigned)(255 - (i * 16 + j)))); }
      float ev[16], es = 0.f;
#pragma unroll
      for (int r = 0; r < 16; ++r) { ev[r] = __expf(t[r] - t[0]); es += ev[r]; }
      const float inv = 1.0f / es;
#pragma unroll
      for (int r = 0; r < 16; ++r) { const unsigned flat = 255u - (__builtin_bit_cast(unsigned, t[r]) & 0xFFu), ii = flat >> 4, jj = flat & 15u;
        const unsigned ka = 127u - (__builtin_bit_cast(unsigned, LA[ii * 32]) & 0x7Fu), kb = 127u - (__builtin_bit_cast(unsigned, LB[jj * 32]) & 0x7Fu);
        EIDg[(size_t)(tb * 32 + tl) * 128 + h8 * 16 + r] = (int)(ka * 128u + kb); EGTg[(size_t)(tb * 32 + tl) * 128 + h8 * 16 + r] = ev[r] * inv; }
    }
    asm volatile("s_waitcnt vmcnt(0)" ::: "memory"); __syncthreads();
#pragma unroll 1
    for (int tt = 0; tt < 4; ++tt) {
    const int tl = wv * 4 + tt, tok = tb * 32 + tl;
    const float rs = rsqrtf(wave_sum_dpp(lane < 32 ? SSQ[(size_t)tok * 32 + lane] : 0.f) * (1.0f / DM) + EPS);
    { const float* SCL = (const float*)(F.ws + WS_SCL);
#pragma unroll
      for (int i = 0; i < 2; ++i) { const int e = lane + 64 * i, idq = __builtin_nontemporal_load(EIDg + (size_t)tok * 128 + e); eid[e] = idq; esu[e] = SCL[idq]; egt[e] = __builtin_nontemporal_load(EGTg + (size_t)tok * 128 + e) * SCL[16384 + idq]; } }
    unsigned xw[16];
    { const v4u* xp = (const v4u*)(H1b + (size_t)tok * DM + (size_t)lane * 32);
#pragma unroll
      for (int q = 0; q < 4; ++q) { const v4u x0 = xp[q]; xw[4 * q] = x0.x; xw[4 * q + 1] = x0.y; xw[4 * q + 2] = x0.z; xw[4 * q + 3] = x0.w; } }
    float y[32];
#pragma unroll
    for (int i = 0; i < 32; ++i) y[i] = 0.f;
    asm volatile("s_waitcnt vmcnt(0) lgkmcnt(0)" ::: "memory");
    const unsigned char* U8 = F.ws + WS_UB; const unsigned char* V8 = F.ws + WS_VB8;
#define PG_ISSUE(E) do { const int idq_ = __builtin_amdgcn_readfirstlane(eid[(E)]); LAS unsigned char* sl_ = RB + ((E) & 7) * 2048; \
      __builtin_amdgcn_global_load_lds((const unsigned*)(U8 + (size_t)idq_ * 1024 + lane * 16), (LAS unsigned*)sl_, 16, 0, 0); \
      __builtin_amdgcn_global_load_lds((const unsigned*)(V8 + (size_t)idq_ * 1024 + lane * 16), (LAS unsigned*)(sl_ + 1024), 16, 0, 0); } while (0)
#define PG_DOT(UW, DACC) do { float da_ = 0.f, db_ = 0.f; _Pragma("unroll") for (int dd = 0; dd < 4; ++dd) { const unsigned wa = UW[dd]; \
          da_ = __builtin_amdgcn_fdot2_f32_bf16(__builtin_bit_cast(bfv2, xw[4 * dd + 0]), __builtin_amdgcn_cvt_scalef32_pk_bf16_fp4(wa, 1.0f, 0), da_, false); \
          db_ = __builtin_amdgcn_fdot2_f32_bf16(__builtin_bit_cast(bfv2, xw[4 * dd + 1]), __builtin_amdgcn_cvt_scalef32_pk_bf16_fp4(wa, 1.0f, 1), db_, false); \
          da_ = __builtin_amdgcn_fdot2_f32_bf16(__builtin_bit_cast(bfv2, xw[4 * dd + 2]), __builtin_amdgcn_cvt_scalef32_pk_bf16_fp4(wa, 1.0f, 2), da_, false); \
          db_ = __builtin_amdgcn_fdot2_f32_bf16(__builtin_bit_cast(bfv2, xw[4 * dd + 3]), __builtin_amdgcn_cvt_scalef32_pk_bf16_fp4(wa, 1.0f, 3), db_, false); } DACC = da_ + db_; } while (0)
#define PG_AXPY(VW, CF) do { _Pragma("unroll") for (int dd = 0; dd < 4; ++dd) { const unsigned wa = VW[dd]; \
          { const f32x2v v2 = __builtin_amdgcn_cvt_scalef32_pk_f32_fp4(wa, 1.0f, 0); y[8 * dd + 0] += CF * v2.x; y[8 * dd + 1] += CF * v2.y; } \
          { const f32x2v v2 = __builtin_amdgcn_cvt_scalef32_pk_f32_fp4(wa, 1.0f, 1); y[8 * dd + 2] += CF * v2.x; y[8 * dd + 3] += CF * v2.y; } \
          { const f32x2v v2 = __builtin_amdgcn_cvt_scalef32_pk_f32_fp4(wa, 1.0f, 2); y[8 * dd + 4] += CF * v2.x; y[8 * dd + 5] += CF * v2.y; } \
          { const f32x2v v2 = __builtin_amdgcn_cvt_scalef32_pk_f32_fp4(wa, 1.0f, 3); y[8 * dd + 6] += CF * v2.x; y[8 * dd + 7] += CF * v2.y; } } } while (0)
#define PG_BATCH(E0, DOISSUE) do { v4u ub[NBT], vb[NBT]; float su_[NBT], gt_[NBT]; \
      _Pragma("unroll") for (int q = 0; q < NBT; ++q) { const LAS unsigned char* s0_ = RB + (((E0) + q) & 7) * 2048 + lane * 16; ub[q] = *(const LAS v4u*)s0_; vb[q] = *(const LAS v4u*)(s0_ + 1024); su_[q] = esu[(E0) + q]; gt_[q] = egt[(E0) + q]; } \
      asm volatile("s_waitcnt lgkmcnt(0)" ::: "memory"); \
      if (DOISSUE) { _Pragma("unroll") for (int q = 0; q < NBT; ++q) PG_ISSUE((E0) + 8 + q); } \
      float d_[NBT]; _Pragma("unroll") for (int q = 0; q < NBT; ++q) { d_[q] = 0.f; PG_DOT(ub[q], d_[q]); } \
      _Pragma("unroll") for (int q = 0; q < NBT; ++q) d_[q] = wave_sum_dpp(d_[q]); \
      _Pragma("unroll") for (int q = 0; q < NBT; ++q) { const float c_ = gelu_erf(d_[q] * (rs * su_[q])) * gt_[q]; PG_AXPY(vb[q], c_); __builtin_amdgcn_sched_barrier(0); } } while (0)
    constexpr int NBT = 2;
#pragma unroll
    for (int e = 0; e < 8; ++e) PG_ISSUE(e);
#pragma unroll 1
    for (int e = 0; e < 120; e += NBT) {
      asm volatile("s_waitcnt vmcnt(12)" ::: "memory");
      PG_BATCH(e, true);
      asm volatile("" ::: "memory");
    }
    asm volatile("s_waitcnt vmcnt(0)" ::: "memory");
#pragma unroll 1
    for (int e = 120; e < 128; e += NBT) PG_BATCH(e, false);
    asm volatile("s_waitcnt lgkmcnt(0)" ::: "memory");
#undef PG_ISSUE
#undef PG_DOT
#undef PG_AXPY
#undef PG_BATCH
    float* drow = dst_base + (size_t)tok * DM;
#pragma unroll
    for (int q = 0; q < 8; ++q) { const size_t off = (size_t)lane * 32 + q * 4; f32x4 hv;
      hv.x = bflo(xw[2 * q]) + y[4 * q]; hv.y = bfhi(xw[2 * q]) + y[4 * q + 1]; hv.z = bflo(xw[2 * q + 1]) + y[4 * q + 2]; hv.w = bfhi(xw[2 * q + 1]) + y[4 * q + 3]; *(f32x4*)(drow + off) = hv; }
    }
  }
}
constexpr int MISC_LDS = LDS_BYTES - 256;
__global__ void __launch_bounds__(NTHR, 2) mk_fwd(Args args) {
  extern __shared__ __attribute__((aligned(16))) unsigned char lds_raw[];
  Frame F; F.lds = (LAS unsigned char*)lds_raw; F.ws = args.ws; F.tid = threadIdx.x; F.lane = F.tid & 63; F.wave = __builtin_amdgcn_readfirstlane(F.tid >> 6);
  const int lo = args.ph_lo, hi = args.ph_hi, G = (int)gridDim.x, bx = (int)blockIdx.x;
  volatile LAS unsigned* misc = (volatile LAS unsigned*)(F.lds + MISC_LDS);
  if (F.tid < 16) misc[F.tid] = 0u;
  __syncthreads();
  XcdBarrier bar = xcd_barrier_post((unsigned*)(F.ws + WS_CTL) + CW_BAR, misc);
#define IN(k) (lo <= (k) && (k) < hi)
#define SEAM(k) do { if (IN(k) && IN((k) + 1)) xcd_barrier(bar); } while (0)
#define PHASE_FRAME(Fp) Frame Fp = F; asm volatile("" : "+v"(Fp.tid), "+v"(Fp.lane))
  const int NA = G;
  if (IN(0)) { PHASE_FRAME(F0);
    p0_lam(F0, args);
    p0_zero_vpad(F0);
    p0_metaproj(F0, args);
    p0_rows(F0, args);
    p0_transpose(F0, args.in[IN_WIN], DPROJ, NPROJ, (bf16*)(F.ws + WS_W1T));
    p0_transpose(F0, args.in[IN_WOUT], DM, DM, (bf16*)(F.ws + WS_W2T));
    p0_w3t(F0, args);
    p0_tables(F0, args);
  }
  SEAM(0);
  if (IN(1)) { PHASE_FRAME(F1);
    p1_meta_finalize(F1, args);
    pg8::Gemm g{(const pg8::bf16_t*)(F.ws + WS_XN), (const pg8::bf16_t*)(F.ws + WS_W1T), MROWS, NPROJ, DM};
    pg8::StaticOrder S; S.init(MROWS, NPROJ, G, bx);
    EpiProj E{(bf16*)(F.ws + WS_Q), (bf16*)(F.ws + WS_KP), (bf16*)(F.ws + WS_VP), (bf16*)(F.ws + WS_MQ), (bf16*)(F.ws + WS_MK), (bf16*)(F.ws + WS_MV), (bf16*)(F.ws + WS_MO),
              args.in[IN_QNG], args.in[IN_KNG], (LAS float*)(F.lds + XCH_OFF)};
    pg8::gemm_phase<EpiProj, pg8::StaticOrder, true, true>(F.lds + RING_OFF, g, S, E);
  }
  SEAM(1);
  if (IN(2)) {
    PHASE_FRAME(F2);
    att::phase(F2, (G % 8 == 0) ? (bx & 7) * (G >> 3) + (bx >> 3) : bx, NA);
    for (int task = bx; task < 512; task += G) ml::taskA(F2, args, task);
  }
  SEAM(2);
  if (IN(3)) { PHASE_FRAME(F3); ml::scanB(F3); p3_combine(F3, args, NA); }
  SEAM(3);
  if (IN(4)) {
    PHASE_FRAME(F4);
    for (int task = bx; task < 512; task += G) ml::taskC(F4, args, task);
  }
  SEAM(4);
  if (IN(5)) {
    pg8::Gemm g{(const pg8::bf16_t*)(F.ws + WS_A2), (const pg8::bf16_t*)(F.ws + WS_W2T), MROWS, DM, DM};
    pg8::StaticOrder S; S.init(MROWS, DM, G, bx);
    EpiRes E{args.in[IN_X], args.out, (bf16*)(F.ws + WS_H1B), (float*)(F.ws + WS_SSQ)};
    pg8::gemm_phase<EpiRes, pg8::StaticOrder, true, true>(F.lds + RING_OFF, g, S, E);
  }
  SEAM(5);
  if (IN(6)) {
    pg8::Gemm g{(const pg8::bf16_t*)(F.ws + WS_H1B), (const pg8::bf16_t*)(F.ws + WS_W3T), MROWS, DM, DM};
    pg8::StaticOrder S; S.init(MROWS, DM, G, bx);
    LAS float* rst = (LAS float*)(F.lds + XCH_OFF);
    { pg8::Unit u0; if (S.next(0, u0)) { if (F.tid < 256) { const float* sp = (const float*)(F.ws + WS_SSQ) + ((size_t)u0.pm * 256 + F.tid) * 32; float s = 0.f;
#pragma unroll
          for (int i = 0; i < 8; ++i) { const f32x4 v = ((const f32x4*)sp)[i]; s += (v.x + v.y) + (v.z + v.w); }
          rst[F.tid] = rsqrtf(s * (1.0f / DM) + EPS); } } }
    __syncthreads();
    EpiScore E{(float*)(F.ws + WS_S), rst};
    pg8::gemm_phase<EpiScore, pg8::StaticOrder, true, true>(F.lds + RING_OFF, g, S, E);
  }
  SEAM(6);
  if (IN(7)) { PHASE_FRAME(F7); p6_peer(F7, args, args.out); }
#undef IN
#undef SEAM
}
extern "C" void kernel_launch(void* const* d_in, const int* in_sizes, int n_in, void* d_out, int out_size, void* d_ws, size_t ws_size, hipStream_t stream) {
  static int grid = 0;
  if (grid == 0) {
    int dev = 0, cus = 0, per_cu = 0;
    if (hipGetDevice(&dev) != hipSuccess || hipDeviceGetAttribute(&cus, hipDeviceAttributeMultiprocessorCount, dev) != hipSuccess) { fprintf(stderr, "device query failed\n"); grid = -1; return; }
    if (hipFuncSetAttribute((const void*)mk_fwd, hipFuncAttributeMaxDynamicSharedMemorySize, LDS_BYTES) != hipSuccess) { fprintf(stderr, "hipFuncSetAttribute failed\n"); grid = -1; return; }
    if (hipOccupancyMaxActiveBlocksPerMultiprocessor(&per_cu, (const void*)mk_fwd, NTHR, LDS_BYTES) != hipSuccess || per_cu < 1) { fprintf(stderr, "occupancy query says %d workgroups per CU: not launching\n", per_cu); (void)hipGetLastError(); grid = -1; return; }
    (void)hipGetLastError();
    grid = cus;
    if (n_in != 22 || ws_size < (size_t)512 * MiB || out_size != MROWS * DM) { fprintf(stderr, "unexpected shapes: n_in %d out %d ws %zu\n", n_in, out_size, ws_size); grid = -1; return; }
  }
  if (grid < 0) return;
  unsigned char* ws = (unsigned char*)d_ws;
  if (hipMemsetAsync(ws + WS_CTL, 0, CTL_ZERO_BYTES, stream) != hipSuccess) { fprintf(stderr, "memset failed\n"); return; }
  Args a{};
  for (int i = 0; i < 22; ++i) a.in[i] = (const float*)d_in[i];
  a.out = (float*)d_out; a.ws = ws; a.na = 0; a.pad = 0;
  a.ph_lo = 0; a.ph_hi = 8;
  hipLaunchKernelGGL(mk_fwd, dim3(grid), dim3(NTHR), LDS_BYTES, stream, a);
}
```

```cpp
#include <hip/hip_runtime.h>
#include <cstdio>
#include <cstdint>
#include <math.h>
namespace pg8 {
#define PG8_LAS __attribute__((address_space(3)))
typedef unsigned short bf16_t;
typedef short bf16x8 __attribute__((ext_vector_type(8)));
typedef float f32x4 __attribute__((ext_vector_type(4)));
typedef unsigned u32x4 __attribute__((ext_vector_type(4)));
constexpr int BM = 256, BK = 64, HALF = 128, HTB = HALF * BK * 2  , STAGE_BYTES = 8 * HTB, NXCD = 8, WGM = 8;

__host__ __device__ __forceinline__ int lds_byte(int r, int c) { const int st = (r >> 4) * 2 + (c >> 5), rr = r & 15, cc = c & 31, ob = rr * 64 + cc * 2; return st * 1024 + (ob ^ (((ob >> 9) & 1) << 5)); }
__host__ __device__ __forceinline__ void stage_rc(int b, int& R, int& C) { const int st = b / 1024, sb = b % 1024, swz = sb ^ (((sb >> 9) & 1) << 5); R = (st >> 1) * 16 + swz / 64; C = (st & 1) * 32 + (swz % 64) / 2; }
__host__ __device__ __forceinline__ int perm32(int rho) { const int n = rho >> 4, i = rho & 15; return 8 * (i >> 2) + 4 * n + (i & 3); }

struct Unit { int pm, pn; };
struct Gemm { const bf16_t* A; const bf16_t* Bt; int M, N, K; };

struct StaticOrder {
    int nM, nN, nwg, G, c;
    __host__ __device__ void init(int M, int N, int G_, int c_) { nM = M / BM; nN = N / BM; nwg = nM * nN; G = G_; c = c_; }
    __host__ __device__ bool next(int i, Unit& u) const {
        const long L = (long)i * G + c; if (L >= nwg) return false;
        int wgid = (int)L; { const int q = nwg / NXCD, r = nwg % NXCD, xcd = wgid % NXCD, off = wgid / NXCD; wgid = (xcd < r ? xcd * (q + 1) : r * (q + 1) + (xcd - r) * q) + off; }
        const int nig = WGM * nN, gid = wgid / nig, fm = gid * WGM, gsz = (nM - fm) < WGM ? (nM - fm) : WGM;
        u.pm = fm + ((wgid % nig) % gsz); u.pn = (wgid % nig) / gsz; return true;
    }
    __device__ __forceinline__ void a_ready(const Unit&) const {}
    __device__ __forceinline__ void done(const Unit&) const {}
};

__device__ __forceinline__ unsigned cvt_pk_bf16(float lo, float hi) { unsigned r; asm volatile("v_cvt_pk_bf16_f32 %0, %1, %2" : "=v"(r) : "v"(lo), "v"(hi)); return r; }
typedef float f32x2 __attribute__((ext_vector_type(2)));
template <class Epi, class Sched, bool ALIGN_EPI = false, bool SP2 = false>
__device__ __forceinline__ void gemm_phase(PG8_LAS unsigned char* lds, const Gemm g, const Sched& S, const Epi& E) {
    int tid_ = threadIdx.x; asm volatile("" : "+v"(tid_));
    const int tid = tid_, wid = __builtin_amdgcn_readfirstlane(tid >> 6), lane = tid & 63, wr = wid >> 2, wc = wid & 3, fr = lane & 15, fq = lane >> 4;
    const int K = g.K, nt = K / BK;
    unsigned voffA[2], voffB[2];
#pragma unroll
    for (int i = 0; i < 2; ++i) { int R, C; stage_rc(tid * 16 + i * 8192, R, C); const int Rb = Epi::PERM ? ((R & ~31) + perm32(R & 31)) : R;
        voffA[i] = (unsigned)(R * K + C) * 2u; voffB[i] = (unsigned)(Rb * K + C) * 2u; }
    const size_t kstep = (size_t)(BK * 2);
    const size_t hstep = (size_t)HALF * K * 2;
    const size_t tstep = 2 * hstep;
    const unsigned ldsw = (unsigned)wid * 1024u;
    const int aoff = lds_byte(wr * 64 + fr, fq * 8), boff = lds_byte(wc * 32 + fr, fq * 8);
#define PG8_SA(b, h) (((b) * 2 + (h)) * HTB)
#define PG8_SB(b, h) ((4 + (b) * 2 + (h)) * HTB)
#define PG8_STAGE(bufoff, gbase, voff) do { _Pragma("unroll") for (int _i = 0; _i < 2; ++_i) \
        __builtin_amdgcn_global_load_lds((const unsigned*)((const char*)(gbase) + (voff)[_i]), (PG8_LAS unsigned*)(lds + (bufoff) + ldsw + _i * 8192), 16, 0, 0); } while (0)
#define PG8_LDA(dst, b, h) do { _Pragma("unroll") for (int m = 0; m < 4; ++m) _Pragma("unroll") for (int k = 0; k < 2; ++k) dst[m][k] = *(const PG8_LAS bf16x8*)(lds + PG8_SA(b, h) + aoff + m * 2048 + k * 1024); } while (0)
#define PG8_LDB(dst, b, h) do { _Pragma("unroll") for (int n = 0; n < 2; ++n) _Pragma("unroll") for (int k = 0; k < 2; ++k) dst[n][k] = *(const PG8_LAS bf16x8*)(lds + PG8_SB(b, h) + boff + n * 2048 + k * 1024); } while (0)
#define PG8_MMA(ai, bj, At, Bt) do { __builtin_amdgcn_s_setprio(1); _Pragma("unroll") for (int m = 0; m < 4; ++m) _Pragma("unroll") for (int n = 0; n < 2; ++n) _Pragma("unroll") for (int k = 0; k < 2; ++k) \
        acc[ai][bj][m][n] = __builtin_amdgcn_mfma_f32_16x16x32_bf16(Bt[n][k], At[m][k], acc[ai][bj][m][n], 0, 0, 0); __builtin_amdgcn_s_setprio(0); } while (0)
#define PG8_WAIT_V(n) asm volatile("s_waitcnt vmcnt(" #n ")" ::: "memory")
#define PG8_WAIT_L(n) asm volatile("s_waitcnt lgkmcnt(" #n ")" ::: "memory")
#define PG8_BAR __builtin_amdgcn_s_barrier()
#define PG8_SCHED __builtin_amdgcn_sched_barrier(0)
    Unit cur, nxt; int ui = 0;
    if (!S.next(0, cur)) return;
    f32x4 acc[2][2][4][2];
#pragma unroll
    for (int a = 0; a < 2; ++a)
#pragma unroll
        for (int b = 0; b < 2; ++b)
#pragma unroll
            for (int m = 0; m < 4; ++m)
#pragma unroll
                for (int n = 0; n < 2; ++n) acc[a][b][m][n] = (f32x4){0.f, 0.f, 0.f, 0.f};
    bf16x8 At[4][2], B0[2][2], B1[2][2];
    const char* cA = (const char*)g.A + (size_t)cur.pm * tstep; const char* cB = (const char*)g.Bt + (size_t)cur.pn * tstep;
    S.a_ready(cur);
    if constexpr (SP2) {
        PG8_STAGE(PG8_SB(0, 0), cB, voffB); PG8_STAGE(PG8_SB(0, 1), cB + hstep, voffB); PG8_STAGE(PG8_SA(0, 0), cA, voffA); PG8_STAGE(PG8_SA(0, 1), cA + hstep, voffA);
        if (wr == 1) PG8_BAR;
        PG8_WAIT_V(2); PG8_BAR;
        PG8_STAGE(PG8_SB(1, 0), cB + kstep, voffB); PG8_STAGE(PG8_SA(1, 0), cA + kstep, voffA); PG8_STAGE(PG8_SB(1, 1), cB + hstep + kstep, voffB);
        PG8_WAIT_V(6); PG8_BAR;
    } else {
        PG8_STAGE(PG8_SB(0, 0), cB, voffB); PG8_STAGE(PG8_SA(0, 0), cA, voffA); PG8_STAGE(PG8_SB(0, 1), cB + hstep, voffB); PG8_STAGE(PG8_SA(0, 1), cA + hstep, voffA);
        if (wr == 1) PG8_BAR;
        PG8_WAIT_V(4); PG8_BAR;
        PG8_STAGE(PG8_SB(1, 0), cB + kstep, voffB); PG8_STAGE(PG8_SA(1, 0), cA + kstep, voffA); PG8_STAGE(PG8_SB(1, 1), cB + hstep + kstep, voffB);
        PG8_WAIT_V(6); PG8_BAR;
    }
    for (;;) {
        const bool has_next = S.next(ui + 1, nxt);
        const char* nA = has_next ? (const char*)g.A + (size_t)nxt.pm * tstep : cA; const char* nB = has_next ? (const char*)g.Bt + (size_t)nxt.pn * tstep : cB;
        for (int t = 0; t < nt; t += 2) {
            const bool last = (t == nt - 2);
            const char* a1 = cA + (size_t)(t + 1) * kstep;
            const char* a2 = last ? nA : cA + (size_t)(t + 2) * kstep; const char* b2 = last ? nB : cB + (size_t)(t + 2) * kstep;
            const char* a3 = a2 + kstep; const char* b3 = b2 + kstep;
            if (last && has_next) S.a_ready(nxt);
            if constexpr (SP2) {
            PG8_LDB(B0, 0, 0); PG8_LDB(B1, 0, 1); PG8_SCHED; PG8_LDA(At, 0, 0); PG8_STAGE(PG8_SA(1, 1), a1 + hstep, voffA);
            PG8_WAIT_V(8); PG8_WAIT_L(0); PG8_BAR; PG8_MMA(0, 0, At, B0); PG8_MMA(0, 1, At, B1); PG8_BAR; PG8_SCHED;
            PG8_LDA(At, 0, 1); PG8_STAGE(PG8_SB(0, 0), b2, voffB); PG8_STAGE(PG8_SB(0, 1), b2 + hstep, voffB); PG8_STAGE(PG8_SA(0, 0), a2, voffA);
            PG8_WAIT_V(8); PG8_WAIT_L(0); PG8_BAR; PG8_MMA(1, 0, At, B0); PG8_MMA(1, 1, At, B1); PG8_BAR; PG8_SCHED;
            PG8_LDB(B0, 1, 0); PG8_LDB(B1, 1, 1); PG8_SCHED; PG8_LDA(At, 1, 0); PG8_STAGE(PG8_SA(0, 1), a2 + hstep, voffA);
            PG8_WAIT_V(8); PG8_WAIT_L(0); PG8_BAR; PG8_MMA(0, 0, At, B0); PG8_MMA(0, 1, At, B1); PG8_BAR; PG8_SCHED;
            PG8_LDA(At, 1, 1); PG8_STAGE(PG8_SB(1, 0), b3, voffB); PG8_STAGE(PG8_SB(1, 1), b3 + hstep, voffB); PG8_STAGE(PG8_SA(1, 0), a3, voffA);
            PG8_WAIT_V(8); PG8_WAIT_L(0); PG8_BAR; PG8_MMA(1, 0, At, B0); PG8_MMA(1, 1, At, B1); PG8_BAR; PG8_SCHED;
            } else {
            PG8_LDB(B0, 0, 0); PG8_SCHED; PG8_LDA(At, 0, 0); PG8_STAGE(PG8_SA(1, 1), a1 + hstep, voffA);
            PG8_WAIT_L(8); PG8_BAR; PG8_WAIT_L(0); PG8_MMA(0, 0, At, B0); PG8_BAR; PG8_SCHED;
            PG8_LDB(B1, 0, 1); PG8_STAGE(PG8_SB(0, 0), b2, voffB);
            PG8_BAR; PG8_WAIT_L(0); PG8_MMA(0, 1, At, B1); PG8_BAR;
            PG8_LDA(At, 0, 1); PG8_STAGE(PG8_SA(0, 0), a2, voffA);
            PG8_BAR; PG8_WAIT_L(0); PG8_MMA(1, 0, At, B0); PG8_BAR; PG8_SCHED;
            PG8_STAGE(PG8_SB(0, 1), b2 + hstep, voffB);
            PG8_WAIT_V(6); PG8_BAR; PG8_MMA(1, 1, At, B1); PG8_BAR;
            PG8_LDB(B0, 1, 0); PG8_SCHED; PG8_LDA(At, 1, 0); PG8_STAGE(PG8_SA(0, 1), a2 + hstep, voffA);
            PG8_WAIT_L(8); PG8_BAR; PG8_WAIT_L(0); PG8_MMA(0, 0, At, B0); PG8_BAR; PG8_SCHED;
            PG8_LDB(B1, 1, 1); PG8_STAGE(PG8_SB(1, 0), b3, voffB);
            PG8_BAR; PG8_WAIT_L(0); PG8_MMA(0, 1, At, B1); PG8_BAR;
            PG8_LDA(At, 1, 1); PG8_STAGE(PG8_SA(1, 0), a3, voffA);
            PG8_BAR; PG8_WAIT_L(0); PG8_MMA(1, 0, At, B0); PG8_BAR; PG8_SCHED;
            PG8_STAGE(PG8_SB(1, 1), b3 + hstep, voffB);
            PG8_WAIT_V(6); PG8_BAR; PG8_MMA(1, 1, At, B1); PG8_BAR;
            }
        }
        if constexpr (ALIGN_EPI) { if (wr == 0) PG8_BAR; }
        if constexpr (!Epi::AFTER_DRAIN) { E(acc, cur, wr, wc, fr, fq); S.done(cur); }
        if (!has_next) break;
#pragma unroll
        for (int a = 0; a < 2; ++a)
#pragma unroll
            for (int b = 0; b < 2; ++b)
#pragma unroll
                for (int m = 0; m < 4; ++m)
#pragma unroll
                    for (int n = 0; n < 2; ++n) acc[a][b][m][n] = (f32x4){0.f, 0.f, 0.f, 0.f};
        cur = nxt; cA = nA; cB = nB; ++ui;
        if constexpr (ALIGN_EPI) { if (wr == 1) PG8_BAR; }
    }
    PG8_WAIT_V(0);
    if constexpr (!ALIGN_EPI) { if (wr == 0) PG8_BAR; }
    PG8_BAR;
    if constexpr (Epi::AFTER_DRAIN) { E.fused(acc, cur, wr, wc, fr, fq, lds, wid, lane); S.done(cur); }
#undef PG8_SA
#undef PG8_SB
#undef PG8_STAGE
#undef PG8_LDA
#undef PG8_LDB
#undef PG8_MMA
#undef PG8_WAIT_V
#undef PG8_WAIT_L
#undef PG8_BAR
#undef PG8_SCHED
}
}
#define GAS __attribute__((address_space(1)))
#define LAS __attribute__((address_space(3)))
typedef unsigned short bf16;
typedef unsigned v4u __attribute__((ext_vector_type(4)));
typedef unsigned v2u __attribute__((ext_vector_type(2)));
typedef float f32x4 __attribute__((ext_vector_type(4)));
typedef short bf16x8 __attribute__((ext_vector_type(8)));
#define LDS_WAIT() asm volatile("s_waitcnt lgkmcnt(0)" ::: "memory")
#define VM_WAIT() asm volatile("s_waitcnt vmcnt(0)" ::: "memory")

constexpr int DM = 2048, NB = 4, SEQ = 2048, NMETA = 16, MROWS = NB * SEQ, DPROJ = 6152, NPROJ = 6144;
constexpr int PADT = 2112, POS0 = 64, MPOS0 = 48;
constexpr float EPS = 1e-6f;
constexpr float LOG2E = 1.4426950408889634f;
constexpr float QSCALE = 0.08838834764831845f * LOG2E;
constexpr int NWAVES = 8, NTHR = 512;

constexpr size_t MiB = 1u << 20;
constexpr size_t WS_CTL = 0, CTL_ZERO_BYTES = 32 * 1024;
constexpr size_t WS_PM = 484 * MiB;
constexpr size_t WS_W1T = 2 * MiB, WS_W2T = 26 * MiB, WS_W3T = 34 * MiB, WS_XN = 42 * MiB;
constexpr size_t WS_Q = 74 * MiB, WS_KP = 90 * MiB, WS_VP = 107 * MiB, WS_MQ = 124 * MiB, WS_MK = 133 * MiB, WS_MV = 142 * MiB, WS_MO = 159 * MiB;
constexpr size_t WS_SMALL = 175 * MiB;
constexpr size_t WS_XM = WS_SMALL, WS_LI = WS_SMALL + 128 * 1024, WS_LF = WS_SMALL + 384 * 1024, WS_LAM = WS_SMALL + 640 * 1024;
constexpr size_t WS_PO = 176 * MiB, WS_ML = 304 * MiB, WS_HM = 305 * MiB, WS_A2 = 42 * MiB, WS_H1B = 74 * MiB, WS_SSQ = 106 * MiB, WS_S = 176 * MiB, WS_UB = 384 * MiB, WS_VB = 448 * MiB;
constexpr size_t WS_SCL = WS_SMALL + 704 * 1024;
constexpr size_t WS_VB8 = WS_UB + 32 * MiB;
constexpr size_t WS_DC = 305 * MiB, WS_CS = 448 * MiB, WS_DN = 482 * MiB, WS_NS = WS_DN + 512 * 1024, WS_GS = WS_DN + 1024 * 1024, WS_MS = WS_DN + 1152 * 1024;
constexpr size_t WS_EID = 240 * MiB, WS_EGT = 244 * MiB;
constexpr int CW_BAR = 4096;

constexpr int RING_OFF = 0, RING_BYTES = 131072;
constexpr int XCH_OFF = 131072;
constexpr int MISC_OFF = XCH_OFF + 8192;
constexpr int LDS_BYTES = 155648;

__device__ __forceinline__ unsigned f2bf(float f) { unsigned u = __builtin_bit_cast(unsigned, f); return (u + 0x7fffu + ((u >> 16) & 1u)) >> 16; }
__device__ __forceinline__ unsigned pk2(float lo, float hi) { return f2bf(lo) | (f2bf(hi) << 16); }
__device__ __forceinline__ float bf2f(unsigned short u) { return __builtin_bit_cast(float, (unsigned)u << 16); }
__device__ __forceinline__ float bflo(unsigned w) { return __builtin_bit_cast(float, w << 16); }
__device__ __forceinline__ float bfhi(unsigned w) { return __builtin_bit_cast(float, w & 0xffff0000u); }
__device__ __forceinline__ float wave_sum(float v) {
#pragma unroll
  for (int o = 1; o < 64; o <<= 1) v += __shfl_xor(v, o);
  return v;
}
__device__ __forceinline__ size_t kp_off(int bhm, int pos, int d) { const int j = pos >> 6, row = pos & 63, d0 = d >> 4, hi = (d >> 3) & 1;
  return ((size_t)(bhm * 33 + j) * 8 + d0) * 1024 + (size_t)((((row << 1) | hi) ^ ((row >> 3) & 1)) << 3) + (d & 7); }
__device__ __forceinline__ float wave_sum_dpp(float v) {
  v += __builtin_bit_cast(float, __builtin_amdgcn_update_dpp(0, __builtin_bit_cast(int, v), 0xB1, 0xF, 0xF, true));
  v += __builtin_bit_cast(float, __builtin_amdgcn_update_dpp(0, __builtin_bit_cast(int, v), 0x4E, 0xF, 0xF, true));
  v += __builtin_bit_cast(float, __builtin_amdgcn_update_dpp(0, __builtin_bit_cast(int, v), 0x141, 0xF, 0xF, true));
  v += __builtin_bit_cast(float, __builtin_amdgcn_update_dpp(0, __builtin_bit_cast(int, v), 0x140, 0xF, 0xF, true));
  const float r0 = __builtin_bit_cast(float, __builtin_amdgcn_readlane(__builtin_bit_cast(int, v), 0)), r1 = __builtin_bit_cast(float, __builtin_amdgcn_readlane(__builtin_bit_cast(int, v), 16));
  const float r2 = __builtin_bit_cast(float, __builtin_amdgcn_readlane(__builtin_bit_cast(int, v), 32)), r3 = __builtin_bit_cast(float, __builtin_amdgcn_readlane(__builtin_bit_cast(int, v), 48));
  return (r0 + r1) + (r2 + r3);
}
__device__ __forceinline__ float sigmoidf_(float x) { return 1.0f / (1.0f + __expf(-x)); }
#define XB_TMO      128
#define XB_XCNT(j)  (256  + 64 * (j))
#define XB_XSUB(j)  (1280 + 64 * (j))
#define XB_XGEN(j)  (2304 + 64 * (j))
#define XB_TOP      3328
#define XB_TOPGEN   3392
#define XCD_BAR_WORDS 3456
#define XB_SPIN_CAP (1u << 18)

__device__ __forceinline__ unsigned xb_ld(unsigned* p)              { return __hip_atomic_load(p, __ATOMIC_RELAXED, __HIP_MEMORY_SCOPE_AGENT); }
__device__ __forceinline__ unsigned xb_add(unsigned* p, unsigned v) { return __hip_atomic_fetch_add(p, v, __ATOMIC_RELAXED, __HIP_MEMORY_SCOPE_AGENT); }
__device__ __forceinline__ unsigned xb_xcc_id() { return (unsigned)__builtin_amdgcn_s_getreg((3 << 11) | 20) & 0xFu; }
#define XB_SPIN(cond, bar) do { unsigned _sp = 0; while (cond) { __builtin_amdgcn_s_sleep(1); \
    if ((++_sp & 255u) == 0u) { if (xb_ld(&(bar)[XB_TMO])) break; if (_sp > XB_SPIN_CAP) { atomicAdd(&(bar)[XB_TMO], 1u); break; } } } } while (0)

struct XcdBarrier {
    unsigned* bar; unsigned x;
    volatile LAS unsigned* st;
};

__device__ __forceinline__ XcdBarrier xcd_barrier_post(unsigned* bar, volatile LAS unsigned* st) {
    XcdBarrier b; b.bar = bar; b.x = xb_xcc_id(); b.st = st;
    if (threadIdx.x == 0) (void)xb_add(&bar[XB_XCNT(b.x)], 1u);
    return b;
}
__device__ __forceinline__ void xcd_barrier_complete(unsigned* bar, unsigned x, unsigned& nloc, unsigned& nx) {
    const unsigned G = gridDim.x * gridDim.y * gridDim.z;
    unsigned sum, cnt, mine, sp = 0u;
    for (;;) {
        sum = 0u; cnt = 0u; mine = 0u;
#pragma unroll
        for (unsigned j = 0; j < 16; ++j) { const unsigned c = xb_ld(&bar[XB_XCNT(j)]); sum += c; cnt += (c > 0u) ? 1u : 0u; mine = (j == x) ? c : mine; }
        if (sum == G) break;
        __builtin_amdgcn_s_sleep(1);
        if ((++sp & 255u) == 0u) { if (xb_ld(&bar[XB_TMO])) break; if (sp > XB_SPIN_CAP) { atomicAdd(&bar[XB_TMO], 1u); break; } }
    }
    nloc = mine > 0u ? mine : 1u; nx = cnt > 0u ? cnt : 1u;
}

__device__ __forceinline__ void xcd_barrier(const XcdBarrier& b) {
    asm volatile("s_waitcnt vmcnt(0)" ::: "memory");
    __syncthreads();
    if (threadIdx.x == 0) {
        unsigned* bar = b.bar;
        __builtin_amdgcn_s_waitcnt(0);
        unsigned nloc = b.st[0], nx = b.st[1];
        if (nloc == 0u) { xcd_barrier_complete(bar, b.x, nloc, nx); b.st[0] = nloc; b.st[1] = nx; }
        const unsigned old = xb_add(&bar[XB_XSUB(b.x)], 1u);
        const unsigned gen = old / nloc;
        if (old + 1u == (gen + 1u) * nloc) {
            __builtin_amdgcn_fence(__ATOMIC_RELEASE, "agent");
            asm volatile("s_waitcnt vmcnt(0)" ::: "memory");
            const unsigned og = xb_add(&bar[XB_TOP], 1u);
            const unsigned tg = og / nx;
            if (og + 1u == (tg + 1u) * nx) xb_add(&bar[XB_TOPGEN], 1u);
            else XB_SPIN(xb_ld(&bar[XB_TOPGEN]) == tg, bar);
            __builtin_amdgcn_fence(__ATOMIC_ACQUIRE, "agent");
            xb_add(&bar[XB_XGEN(b.x)], 1u);
            asm volatile("s_waitcnt vmcnt(0)" ::: "memory");
        } else {
            XB_SPIN(xb_ld(&bar[XB_XGEN(b.x)]) == gen, bar);
            __builtin_amdgcn_fence(__ATOMIC_ACQUIRE, "agent");
            asm volatile("s_waitcnt vmcnt(0)" ::: "memory");
        }
    }
    __syncthreads();
}

struct Args { const float* in[22]; float* out; unsigned char* ws; int ph_lo, ph_hi, na, pad; };
struct Frame {
  LAS unsigned char* lds; unsigned char* ws; int tid, lane, wave; const float* const* in;
};
#define IN_X 0
#define IN_META 1
#define IN_G1 2
#define IN_WIN 3
#define IN_CW 4
#define IN_CB 5
#define IN_IGB 6
#define IN_FGB 7
#define IN_LQ1 8
#define IN_LK1 9
#define IN_LQ2 10
#define IN_LK2 11
#define IN_QNG 12
#define IN_KNG 13
#define IN_SUBG 14
#define IN_OUTG 15
#define IN_WOUT 16
#define IN_G2 17
#define IN_WQ 18
#define IN_SUBK 19
#define IN_U 20
#define IN_V 21

__device__ __forceinline__ void p0_rows(const Frame& F, const Args& a) {
  const float* x = a.in[IN_X]; const float* meta = a.in[IN_META]; const float* g1 = a.in[IN_G1]; const float* w_in = a.in[IN_WIN];
  const float* igb = a.in[IN_IGB]; const float* fgb = a.in[IN_FGB];
  bf16* Xn = (bf16*)(F.ws + WS_XN); bf16* Xm = (bf16*)(F.ws + WS_XM); float* LI = (float*)(F.ws + WS_LI); float* LF = (float*)(F.ws + WS_LF);
  LAS f32x4* wgl = (LAS f32x4*)(F.lds);
  for (int e = F.tid; e < 4096; e += NTHR) {
    const int ln = e & 63, q = e >> 6, half = q & 1, j = (q >> 1) & 3, i = q >> 3;
    const int k = 4 * (i * 64 + ln) + j;
    wgl[e] = *(const f32x4*)(w_in + (size_t)k * DPROJ + NPROJ + 4 * half);
  }
  __syncthreads();
  const int gw = blockIdx.x * NWAVES + F.wave, NGW = gridDim.x * NWAVES, lane = F.lane;
  constexpr int NTASK = MROWS / 2 + NMETA / 2;
  f32x4 xnx[2][8];
  if (gw < NTASK) { const float* sn = (gw >= MROWS / 2 ? meta + (size_t)(gw - MROWS / 2) * 2 * DM : x + (size_t)gw * 2 * DM);
#pragma unroll
    for (int i = 0; i < 8; ++i) { xnx[0][i] = ((const f32x4*)sn)[i * 64 + lane]; xnx[1][i] = ((const f32x4*)(sn + DM))[i * 64 + lane]; } }
  for (int task = gw; task < NTASK; task += NGW) {
    const bool ismeta = task >= MROWS / 2;
    const int r0 = ismeta ? (task - MROWS / 2) * 2 : task * 2;
    f32x4 xv[2][8]; float rs[2];
    { float s0 = 0.f, s1 = 0.f;
#pragma unroll
      for (int i = 0; i < 8; ++i) { xv[0][i] = xnx[0][i]; xv[1][i] = xnx[1][i]; }
      { const int tn = task + NGW; if (tn < NTASK) { const float* sn = (tn >= MROWS / 2 ? meta + (size_t)(tn - MROWS / 2) * 2 * DM : x + (size_t)tn * 2 * DM);
#pragma unroll
          for (int i = 0; i < 8; ++i) { xnx[0][i] = ((const f32x4*)sn)[i * 64 + lane]; xnx[1][i] = ((const f32x4*)(sn + DM))[i * 64 + lane]; } } }
#pragma unroll
      for (int i = 0; i < 8; ++i) { const f32x4 a0 = xv[0][i], a1 = xv[1][i];
        s0 += (a0.x * a0.x + a0.y * a0.y) + (a0.z * a0.z + a0.w * a0.w); s1 += (a1.x * a1.x + a1.y * a1.y) + (a1.z * a1.z + a1.w * a1.w); }
      rs[0] = rsqrtf(wave_sum_dpp(s0) * (1.0f / DM) + EPS); rs[1] = rsqrtf(wave_sum_dpp(s1) * (1.0f / DM) + EPS); }
    float ga[2][8];
#pragma unroll
    for (int rr = 0; rr < 2; ++rr)
#pragma unroll
      for (int g = 0; g < 8; ++g) ga[rr][g] = 0.f;
    bf16* dst0 = (ismeta ? Xm : Xn) + (size_t)r0 * DM;
#pragma unroll
    for (int i = 0; i < 8; ++i) {
      const f32x4 g = ((const f32x4*)g1)[i * 64 + lane];
      f32x4 xn[2];
#pragma unroll
      for (int rr = 0; rr < 2; ++rr) { xn[rr] = xv[rr][i] * g * rs[rr];
        v2u o; o.x = pk2(xn[rr].x, xn[rr].y); o.y = pk2(xn[rr].z, xn[rr].w); ((v2u*)(dst0 + (size_t)rr * DM))[i * 64 + lane] = o; }
#pragma unroll
      for (int j = 0; j < 4; ++j) {
        const f32x4 w0 = wgl[((i * 4 + j) * 2 + 0) * 64 + lane], w1 = wgl[((i * 4 + j) * 2 + 1) * 64 + lane];
#pragma unroll
        for (int rr = 0; rr < 2; ++rr) { const float xs_ = xn[rr][j];
          ga[rr][0] += xs_ * w0.x; ga[rr][1] += xs_ * w0.y; ga[rr][2] += xs_ * w0.z; ga[rr][3] += xs_ * w0.w;
          ga[rr][4] += xs_ * w1.x; ga[rr][5] += xs_ * w1.y; ga[rr][6] += xs_ * w1.z; ga[rr][7] += xs_ * w1.w; }
      }
      __builtin_amdgcn_sched_barrier(0);
    }
#pragma unroll
    for (int rr = 0; rr < 2; ++rr)
#pragma unroll
      for (int g = 0; g < 8; ++g) ga[rr][g] = wave_sum_dpp(ga[rr][g]);
    if (lane < 8) {
      const int rr = lane >> 2, h = lane & 3;
      float gi = 0.f, gf = 0.f;
#pragma unroll
      for (int q = 0; q < 2; ++q)
#pragma unroll
        for (int hh = 0; hh < 4; ++hh) if (q == rr && hh == h) { gi = ga[q][hh]; gf = ga[q][4 + hh]; }
      const float li = gi + igb[h]; const float fx = gf + fgb[h];
      const float lf = fminf(fx, 0.f) - log1pf(__expf(-fabsf(fx)));
      const int R = r0 + rr;
      if (!ismeta) { const int b = R >> 11, t = R & 2047; LI[(b * 4 + h) * PADT + POS0 + t] = li; LF[(b * 4 + h) * PADT + POS0 + t] = lf; }
      else { for (int b = 0; b < NB; ++b) { LI[(b * 4 + h) * PADT + MPOS0 + R] = li; LF[(b * 4 + h) * PADT + MPOS0 + R] = lf; } }
    }
  }
  __syncthreads();
}
__device__ __forceinline__ void p0_metaproj(const Frame& F, const Args& a) {
  const float* meta = a.in[IN_META]; const float* g1 = a.in[IN_G1]; const float* w_in = a.in[IN_WIN];
  float* PM = (float*)(F.ws + WS_PM);
  LAS float* xs = (LAS float*)(F.lds);
  LAS float* part = (LAS float*)(F.lds + 16384);
  const int q = F.tid >> 7, c = F.tid & 127;
  for (int task = blockIdx.x; task < (NPROJ / 128) * 4; task += gridDim.x) {
    const int nb = task >> 2, kp = task & 3, n = nb * 128 + c;
    float acc[16];
#pragma unroll
    for (int m = 0; m < 16; ++m) acc[m] = 0.f;
#pragma unroll 1
    for (int kb = 0; kb < 2; ++kb) {
      __syncthreads();
#pragma unroll
      for (int i = 0; i < 8; ++i) { const int idx = F.tid + NTHR * i, qq = idx >> 10, kk = (idx >> 4) & 63, m = idx & 15; const int k = 512 * kp + 128 * qq + 64 * kb + kk;
        xs[idx] = meta[(size_t)m * DM + k] * g1[k]; }
      __syncthreads();
#pragma unroll 8
      for (int kk = 0; kk < 64; ++kk) {
        const float w = w_in[(size_t)(512 * kp + 128 * q + 64 * kb + kk) * DPROJ + n];
        const LAS f32x4* xp = (const LAS f32x4*)(xs + (q * 64 + kk) * 16);
#pragma unroll
        for (int t = 0; t < 4; ++t) { const f32x4 xv = xp[t]; acc[4 * t + 0] += xv.x * w; acc[4 * t + 1] += xv.y * w; acc[4 * t + 2] += xv.z * w; acc[4 * t + 3] += xv.w * w; }
      }
    }
#pragma unroll
    for (int m = 0; m < 16; ++m) part[(q * 16 + m) * 128 + c] = acc[m];
    __syncthreads();
    for (int e = F.tid; e < 16 * 128; e += NTHR) { const int m = e >> 7, cc = e & 127;
      PM[((size_t)kp * 16 + m) * NPROJ + nb * 128 + cc] = (part[(0 * 16 + m) * 128 + cc] + part[(1 * 16 + m) * 128 + cc]) + (part[(2 * 16 + m) * 128 + cc] + part[(3 * 16 + m) * 128 + cc]); }
  }
  __syncthreads();
}
__device__ __forceinline__ void p0_transpose(const Frame& F, const float* W, int ldw, int N, bf16* Wt) {
  LAS float* tl = (LAS float*)(F.lds);
  const int ntn = N / 64, ntask = ntn * 16;
  f32x4 wn[4];
  if ((int)blockIdx.x < ntask) { const int nb = blockIdx.x % ntn, kb = blockIdx.x / ntn;
#pragma unroll
    for (int i = 0; i < 4; ++i) { const int idx = F.tid + NTHR * i, kk = idx >> 4, c4 = idx & 15; wn[i] = *(const f32x4*)(W + (size_t)(kb * 128 + kk) * ldw + nb * 64 + 4 * c4); } }
  for (int task = blockIdx.x; task < ntask; task += gridDim.x) {
    const int nb = task % ntn, kb = task / ntn, n0 = nb * 64, k0 = kb * 128;
    __syncthreads();
#pragma unroll
    for (int i = 0; i < 4; ++i) { const int idx = F.tid + NTHR * i, kk = idx >> 4, c4 = idx & 15; const f32x4 w = wn[i];
      LAS float* d = tl + kk * 65 + 4 * c4; d[0] = w.x; d[1] = w.y; d[2] = w.z; d[3] = w.w; }
    { const int tn = task + gridDim.x; if (tn < ntask) { const int nb2 = tn % ntn, kb2 = tn / ntn;
#pragma unroll
        for (int i = 0; i < 4; ++i) { const int idx = F.tid + NTHR * i, kk = idx >> 4, c4 = idx & 15; wn[i] = *(const f32x4*)(W + (size_t)(kb2 * 128 + kk) * ldw + nb2 * 64 + 4 * c4); } } }
    __syncthreads();
    const int n = F.tid >> 3, kc = F.tid & 7;
    const LAS float* s = tl + (kc * 16) * 65 + n;
    v4u o0, o1;
    o0.x = pk2(s[0 * 65], s[1 * 65]); o0.y = pk2(s[2 * 65], s[3 * 65]); o0.z = pk2(s[4 * 65], s[5 * 65]); o0.w = pk2(s[6 * 65], s[7 * 65]);
    o1.x = pk2(s[8 * 65], s[9 * 65]); o1.y = pk2(s[10 * 65], s[11 * 65]); o1.z = pk2(s[12 * 65], s[13 * 65]); o1.w = pk2(s[14 * 65], s[15 * 65]);
    v4u* dp = (v4u*)(Wt + (size_t)(n0 + n) * DM + k0 + kc * 16);
    dp[0] = o0; dp[1] = o1;
  }
  __syncthreads();
}
__device__ __forceinline__ void p0_zero_vpad(const Frame& F) {
  bf16* Vp = (bf16*)(F.ws + WS_VP);
  const int per = MPOS0 * 256 / 8;
  for (int i = blockIdx.x * NTHR + F.tid; i < 16 * per; i += gridDim.x * NTHR) { const int bh = i / per, e = i % per;
    *(v4u*)(Vp + (size_t)bh * PADT * 256 + (size_t)e * 8) = (v4u){0u, 0u, 0u, 0u}; }
}
__device__ __forceinline__ void p0_lam(const Frame& F, const Args& a) {
  if (blockIdx.x == 0 && F.wave == 0) {
    const int l = F.lane;
    float s1 = a.in[IN_LQ1][l] * a.in[IN_LK1][l] + a.in[IN_LQ1][l + 64] * a.in[IN_LK1][l + 64];
    float s2 = a.in[IN_LQ2][l] * a.in[IN_LK2][l] + a.in[IN_LQ2][l + 64] * a.in[IN_LK2][l + 64];
    s1 = wave_sum(s1); s2 = wave_sum(s2);
    if (l == 0) *(float*)(F.ws + WS_LAM) = __expf(s1) - __expf(s2) + 0.2f;
  }
}

struct EpiProj {
  static constexpr bool PERM = true, AFTER_DRAIN = false;
  bf16 *Qb, *Kp, *Vp, *MQ, *MK, *MV, *MO; const float *qg, *kg; LAS float* xch;
  __device__ __forceinline__ void operator()(const pg8::f32x4 (&acc)[2][2][4][2], const pg8::Unit& u, int wr, int wc, int fr, int fq) const {
    const int pn = u.pn, b = u.pm >> 3, tb = (u.pm & 7) * 256 + wr * 64 + fr, d0 = wc * 32 + fq * 8;
    if (pn < 8) {
      const bool isk = pn >= 4; const int h = pn & 3;
      float ssq[2][4][2];
#pragma unroll
      for (int ai = 0; ai < 2; ++ai)
#pragma unroll
        for (int m = 0; m < 4; ++m)
#pragma unroll
          for (int bj = 0; bj < 2; ++bj) { float s = 0.f;
#pragma unroll
            for (int n = 0; n < 2; ++n) { const pg8::f32x4 x = acc[ai][bj][m][n]; s += (x[0] * x[0] + x[1] * x[1]) + (x[2] * x[2] + x[3] * x[3]); }
            s += __shfl_xor(s, 16); s += __shfl_xor(s, 32); ssq[ai][m][bj] = s;
            if (fq == 0) xch[((ai * 128 + wr * 64 + m * 16 + fr) * 2 + bj) * 4 + wc] = s; }
      asm volatile("s_waitcnt lgkmcnt(0)" ::: "memory"); __builtin_amdgcn_s_barrier(); asm volatile("" ::: "memory");
      const float* gp = (isk ? kg : qg) + d0; const f32x4 g0 = *(const f32x4*)gp, g1v = *(const f32x4*)(gp + 4);
      const float sc = isk ? 1.0f : QSCALE;
#pragma unroll
      for (int ai = 0; ai < 2; ++ai)
#pragma unroll
        for (int m = 0; m < 4; ++m)
#pragma unroll
          for (int bj = 0; bj < 2; ++bj) {
            const f32x4 p = *(const LAS f32x4*)(xch + ((ai * 128 + wr * 64 + m * 16 + fr) * 2 + bj) * 4);
            const float rs = rsqrtf(((p.x + p.y) + (p.z + p.w)) * (1.0f / 128.f) + EPS) * sc;
            const pg8::f32x4 v0 = acc[ai][bj][m][0], v1 = acc[ai][bj][m][1];
            v4u w; w.x = pk2(v0[0] * rs * g0.x, v0[1] * rs * g0.y); w.y = pk2(v0[2] * rs * g0.z, v0[3] * rs * g0.w);
            w.z = pk2(v1[0] * rs * g1v.x, v1[1] * rs * g1v.y); w.w = pk2(v1[2] * rs * g1v.z, v1[3] * rs * g1v.w);
            const int t = tb + ai * 128 + m * 16;
            bf16* dst = isk ? Kp + kp_off((b * 4 + h) * 2 + bj, POS0 + t, d0)
                            : Qb + ((size_t)((b * 4 + h) * 2 + bj) * SEQ + t) * 128 + d0;
            *(v4u*)dst = w; }
      return;
    }
#pragma unroll
    for (int ai = 0; ai < 2; ++ai)
#pragma unroll
      for (int m = 0; m < 4; ++m)
#pragma unroll
        for (int bj = 0; bj < 2; ++bj) {
          pg8::f32x4 v0 = acc[ai][bj][m][0], v1 = acc[ai][bj][m][1];
          const int t = tb + ai * 128 + m * 16;
          bf16* dst;
          if (pn < 12) { const int h = pn - 8; dst = Vp + ((size_t)(b * 4 + h) * PADT + POS0 + t) * 256 + bj * 128 + d0; }
          else if (pn < 16) { const int h = 2 * (pn & 1) + bj; dst = (pn >= 14 ? MK : MQ) + ((size_t)(b * 4 + h) * PADT + POS0 + t) * 128 + d0; }
          else if (pn < 20) { const int h = pn - 16; dst = MV + ((size_t)(b * 4 + h) * PADT + POS0 + t) * 256 + bj * 128 + d0; }
          else { dst = MO + (size_t)(b * SEQ + t) * 1024 + (pn - 20) * 256 + bj * 128 + d0;
#pragma unroll
            for (int j = 0; j < 4; ++j) { v0[j] = sigmoidf_(v0[j]); v1[j] = sigmoidf_(v1[j]); } }
          v4u w; w.x = pk2(v0[0], v0[1]); w.y = pk2(v0[2], v0[3]); w.z = pk2(v1[0], v1[1]); w.w = pk2(v1[2], v1[3]);
          *(v4u*)dst = w; }
  }
};
__device__ __forceinline__ void p1_meta_finalize(const Frame& F, const Args& a) {
  if (blockIdx.x >= NMETA) return;
  const int mrow = blockIdx.x, tid = F.tid, lane = F.lane, w = F.wave;
  const float* meta = a.in[IN_META] + (size_t)mrow * DM; const float* PM0 = (const float*)(F.ws + WS_PM) + (size_t)mrow * NPROJ;
#define PM_AT(i) ((PM0[(i)] + PM0[(size_t)16 * NPROJ + (i)]) + (PM0[(size_t)32 * NPROJ + (i)] + PM0[(size_t)48 * NPROJ + (i)]))
  LAS float* red = (LAS float*)(F.lds + XCH_OFF);
  const f32x4 mv = ((const f32x4*)meta)[tid];
  float s = wave_sum((mv.x * mv.x + mv.y * mv.y) + (mv.z * mv.z + mv.w * mv.w));
  if (lane == 0) red[w] = s;
  __syncthreads();
  float tot = 0.f;
#pragma unroll
  for (int i = 0; i < 8; ++i) tot += red[i];
  const float rs = rsqrtf(tot * (1.0f / DM) + EPS);
  bf16* Kp = (bf16*)(F.ws + WS_KP); bf16* Vp = (bf16*)(F.ws + WS_VP); bf16* MQ = (bf16*)(F.ws + WS_MQ); bf16* MK = (bf16*)(F.ws + WS_MK); bf16* MV = (bf16*)(F.ws + WS_MV);
  const int pos = MPOS0 + mrow;
  {
    const float v0 = PM_AT(1024 + w * 128 + lane) * rs, v1 = PM_AT(1024 + w * 128 + lane + 64) * rs;
    const float rk = rsqrtf(wave_sum(v0 * v0 + v1 * v1) * (1.0f / 128.f) + EPS);
    const float* kg = a.in[IN_KNG];
    const unsigned short o0 = (unsigned short)f2bf(v0 * rk * kg[lane]), o1 = (unsigned short)f2bf(v1 * rk * kg[lane + 64]);
    for (int b = 0; b < NB; ++b) { const int bhm = (b * 4 + (w >> 1)) * 2 + (w & 1); Kp[kp_off(bhm, pos, lane)] = o0; Kp[kp_off(bhm, pos, lane + 64)] = o1; }
  }
  { const int c = tid * 2;
    const unsigned o = pk2(PM_AT(2048 + c) * rs, PM_AT(2048 + c + 1) * rs); const int h = c >> 8, e = c & 255;
    for (int b = 0; b < NB; ++b) *(unsigned*)(Vp + ((size_t)(b * 4 + h) * PADT + pos) * 256 + e) = o;
    const unsigned o2 = pk2(PM_AT(3072 + c) * rs, PM_AT(3072 + c + 1) * rs); const bool isk = c >= 512; const int cc = c & 511, hq = cc >> 7, d = cc & 127;
    for (int b = 0; b < NB; ++b) *(unsigned*)((isk ? MK : MQ) + ((size_t)(b * 4 + hq) * PADT + pos) * 128 + d) = o2;
    const unsigned o3 = pk2(PM_AT(4096 + c) * rs, PM_AT(4096 + c + 1) * rs);
    for (int b = 0; b < NB; ++b) *(unsigned*)(MV + ((size_t)(b * 4 + h) * PADT + pos) * 256 + e) = o3;
  }
  __syncthreads();
}
#undef PM_AT

namespace att {
using f32x16 = __attribute__((ext_vector_type(16))) float;
using s16x4 = __attribute__((ext_vector_type(4))) short;
constexpr int STEPS_BHM = 152, NSTEPS = 32 * STEPS_BHM;
constexpr int SHM_V = 64 * 256 * 2, SHM_K = 64 * 128 * 2;
constexpr int LDS_V = 0, LDS_K = 2 * SHM_V, LDS_Q = LDS_K + SHM_K, LDS_WS = LDS_Q + 8 * 8192;
constexpr float THR2 = 8.0f;
#define KSWZ(row, colB) ((row) * 256 + ((colB) ^ (((row) & 7) << 4)))
#define SBAR() __builtin_amdgcn_sched_barrier(0)
__device__ __forceinline__ int crow(int r, int hi) { return (r & 3) + 8 * (r >> 2) + 4 * hi; }
__device__ __forceinline__ unsigned cvtpk(float lo, float hi) { unsigned r; asm volatile("v_cvt_pk_bf16_f32 %0, %1, %2" : "=v"(r) : "v"(lo), "v"(hi)); return r; }
__device__ __forceinline__ int qb_start(int qb) { return 2 * qb * qb + 3 * qb; }
__device__ __forceinline__ int chunk_of(int s, int NA) { return ((s + 1) * NA - 1) / NSTEPS; }

template <int OFF> __device__ __forceinline__ s16x4 tr_read(int vb) {
  s16x4 r; asm volatile("ds_read_b64_tr_b16 %0, %1 offset:%2" : "=&v"(r) : "v"(vb), "i"(OFF) : "memory"); return r;
}
constexpr int v_rd_off(int d0, int ks, int half) { return d0 * 512 + ks * 8192 + half * 4096; }
template <int D0> __device__ __forceinline__ void pv_one(f32x16& od, int vb, bf16x8 pa0, bf16x8 pa1, bf16x8 pa2, bf16x8 pa3) {
#define PK(L, H) (bf16x8){L[0], L[1], L[2], L[3], H[0], H[1], H[2], H[3]}
  { const s16x4 l0 = tr_read<v_rd_off(D0, 0, 0)>(vb), h0 = tr_read<v_rd_off(D0, 0, 1)>(vb), l1 = tr_read<v_rd_off(D0, 1, 0)>(vb), h1 = tr_read<v_rd_off(D0, 1, 1)>(vb);
    asm volatile("s_waitcnt lgkmcnt(0)" ::: "memory"); SBAR();
    od = __builtin_amdgcn_mfma_f32_32x32x16_bf16(pa0, PK(l0, h0), od, 0, 0, 0);
    od = __builtin_amdgcn_mfma_f32_32x32x16_bf16(pa1, PK(l1, h1), od, 0, 0, 0); }
  SBAR();
  { const s16x4 l2 = tr_read<v_rd_off(D0, 2, 0)>(vb), h2 = tr_read<v_rd_off(D0, 2, 1)>(vb), l3 = tr_read<v_rd_off(D0, 3, 0)>(vb), h3 = tr_read<v_rd_off(D0, 3, 1)>(vb);
    asm volatile("s_waitcnt lgkmcnt(0)" ::: "memory"); SBAR();
    od = __builtin_amdgcn_mfma_f32_32x32x16_bf16(pa2, PK(l2, h2), od, 0, 0, 0);
    od = __builtin_amdgcn_mfma_f32_32x32x16_bf16(pa3, PK(l3, h3), od, 0, 0, 0); }
#undef PK
}

__device__ __forceinline__ void segment(const Frame& F, int bhm, int qb, int j0, int j1, int slot) {
  const int tid = F.tid, wid = F.wave, lane = F.lane, r32 = lane & 31, hi = lane >> 5;
  const bf16* Qg = (const bf16*)(F.ws + WS_Q) + ((size_t)bhm * SEQ + qb * 256 + wid * 32 + r32) * 128 + hi * 8;
  const bf16* Kg = (const bf16*)(F.ws + WS_KP) + (size_t)bhm * 33 * 8192;
  const bf16* Vg = (const bf16*)(F.ws + WS_VP) + (size_t)(bhm >> 1) * PADT * 256;
  LAS unsigned char* lds = F.lds;
  LAS float* wsl = (LAS float*)(lds + LDS_WS) + wid * 64;
  const float slope2 = exp2f(-2.0f * (float)(((bhm >> 1) & 3) + 1)) * LOG2E;
  unsigned ksrc0, vsrc0;
  ksrc0 = (unsigned)tid * 16u;
  { const int a8 = tid >> 8, b = (tid >> 2) & 7, k = 8 * (b >> 2) + 4 * a8 + (b & 3), c = ((tid >> 5) & 7) * 32 + (tid & 3) * 8; vsrc0 = (unsigned)(k * 256 + c) * 2u; }
#define STAGE_K(j) do { const char* kt = (const char*)(Kg + (size_t)(j) * 8192); \
    _Pragma("unroll") for (int _i = 0; _i < 2; ++_i) __builtin_amdgcn_global_load_lds((const unsigned*)(kt + (ksrc0 + _i * 8192u)), (LAS unsigned*)(lds + LDS_K + _i * 8192 + wid * 1024), 16, 0, 0); } while (0)
#define STAGE_V(buf, j) do { const char* vt = (const char*)(Vg + (size_t)(j) * 64 * 256); \
    _Pragma("unroll") for (int _i = 0; _i < 4; ++_i) __builtin_amdgcn_global_load_lds((const unsigned*)(vt + (vsrc0 + _i * 8192u)), (LAS unsigned*)(lds + LDS_V + (buf) * SHM_V + _i * 8192 + wid * 1024), 16, 0, 0); } while (0)
  const int lt = (((r32 << 1) | hi) ^ ((r32 >> 3) & 1)) << 4;
  LAS unsigned char* Qs = lds + LDS_Q + wid * 8192;
#pragma unroll
  for (int d0 = 0; d0 < 8; ++d0) { const bf16x8 qv = *(const bf16x8*)(Qg + d0 * 16); *(LAS bf16x8*)(Qs + d0 * 1024 + lt) = qv; }
  f32x16 o[8];
#pragma unroll
  for (int d = 0; d < 8; ++d)
#pragma unroll
    for (int r = 0; r < 16; ++r) o[d][r] = 0.f;
  float m_reg = -1e30f, l_reg = 0.f;
  const int vb0 = (int)(uintptr_t)(lds + LDS_V) + (((lane & 3) << 3) | (((lane >> 2) & 3) << 6) | (((lane >> 4) & 1) << 5) | (((lane >> 5) & 1) << 8));
  STAGE_K(j0); STAGE_V(0, j0);
  VM_WAIT(); __syncthreads();
  for (int j = j0; j < j1; ++j) {
    const int cur = (j - j0) & 1;
    if (j + 1 < j1) STAGE_V(cur ^ 1, j + 1);
    SBAR();
    f32x16 p0 = {}, p1 = {};
    { const LAS unsigned char* Ks = lds + LDS_K;
#pragma unroll
      for (int d0 = 0; d0 < 8; ++d0) {
        const bf16x8 b0 = *(const LAS bf16x8*)(Ks + d0 * 2048 + lt);
        const bf16x8 b1 = *(const LAS bf16x8*)(Ks + d0 * 2048 + 1024 + lt);
        const bf16x8 qf = *(const LAS bf16x8*)(Qs + d0 * 1024 + lt);
        p0 = __builtin_amdgcn_mfma_f32_32x32x16_bf16(b0, qf, p0, 0, 0, 0);
        p1 = __builtin_amdgcn_mfma_f32_32x32x16_bf16(b1, qf, p1, 0, 0, 0); } }
    asm volatile("s_waitcnt lgkmcnt(0)" ::: "memory"); __builtin_amdgcn_s_barrier(); asm volatile("" ::: "memory");
    if (j + 1 < j1) STAGE_K(j + 1);
    SBAR();
    if (j == 0) {
#pragma unroll
      for (int r = 0; r < 16; ++r) p0[r] = -INFINITY;
#pragma unroll
      for (int r = 0; r < 8; ++r) p1[r] = -INFINITY;
    }
    int ln2 = threadIdx.x & 63; asm volatile("" : "+v"(ln2));
    const int hi2 = ln2 >> 5;
    const int jb = j - (4 * qb + 1);
    if (jb >= 0) {
      const int kb = 64 * jb + 4 * hi2, qrel = wid * 32 + (ln2 & 31);
#pragma unroll
      for (int r = 0; r < 16; ++r) { const int kv = kb + (r & 3) + 8 * (r >> 2); if (kv > qrel) p0[r] = -INFINITY; if (kv + 32 > qrel) p1[r] = -INFINITY; }
    }
    const float off0 = slope2 * (float)(64 * j + 4 * hi2), off1 = off0 + 32.0f * slope2;
#pragma unroll
    for (int r = 0; r < 16; ++r) { const float sb = slope2 * (float)((r & 3) + 8 * (r >> 2)); p0[r] += sb; p1[r] += sb; }
    float pm0 = p0[0], pm1 = p1[0];
#pragma unroll
    for (int r = 1; r < 16; ++r) { pm0 = fmaxf(pm0, p0[r]); pm1 = fmaxf(pm1, p1[r]); }
    float pmax = fmaxf(pm0 + off0, pm1 + off1);
    { auto rr = __builtin_amdgcn_permlane32_swap(__float_as_uint(pmax), __float_as_uint(pmax), false, false);
      pmax = fmaxf(__uint_as_float(rr[0]), __uint_as_float(rr[1])); }
    float mn, alpha;
    if (__builtin_expect(__all(pmax - m_reg <= THR2), 1)) { mn = m_reg; alpha = 1.f; }
    else { mn = fmaxf(m_reg, pmax); alpha = __builtin_amdgcn_exp2f(m_reg - mn); m_reg = mn; }
    const float c0 = off0 - mn, c1 = off1 - mn;
    float ps = 0.f;
#pragma unroll
    for (int r = 0; r < 16; ++r) { p0[r] = __builtin_amdgcn_exp2f(p0[r] + c0); p1[r] = __builtin_amdgcn_exp2f(p1[r] + c1); ps += p0[r] + p1[r]; }
    { auto rr = __builtin_amdgcn_permlane32_swap(__float_as_uint(ps), __float_as_uint(ps), false, false);
      ps = __uint_as_float(rr[0]) + __uint_as_float(rr[1]); }
    l_reg = l_reg * alpha + ps;
    if (__any(alpha < 1.f)) { if (hi == 0) wsl[r32] = alpha; asm volatile("s_waitcnt lgkmcnt(0)" ::: "memory");
#pragma unroll
      for (int rg = 0; rg < 4; ++rg) { const f32x4 al = *(const LAS f32x4*)(wsl + 8 * rg + 4 * hi);
#pragma unroll
        for (int d = 0; d < 8; ++d) { o[d][4 * rg + 0] *= al.x; o[d][4 * rg + 1] *= al.y; o[d][4 * rg + 2] *= al.z; o[d][4 * rg + 3] *= al.w; }
        SBAR(); } }
    bf16x8 pa0, pa1, pa2, pa3;
#define PK4(P, BASE, OUT) do { unsigned a0 = cvtpk(P[BASE + 0], P[BASE + 1]), a1 = cvtpk(P[BASE + 2], P[BASE + 3]);   \
    unsigned b0 = cvtpk(P[BASE + 4], P[BASE + 5]), b1 = cvtpk(P[BASE + 6], P[BASE + 7]);                              \
    auto r0 = __builtin_amdgcn_permlane32_swap(a0, b0, false, false); auto r1 = __builtin_amdgcn_permlane32_swap(a1, b1, false, false); \
    v4u w = {r0[0], r1[0], r0[1], r1[1]}; OUT = *reinterpret_cast<bf16x8*>(&w); } while (0)
    PK4(p0, 0, pa0); PK4(p0, 8, pa1); PK4(p1, 0, pa2); PK4(p1, 8, pa3);
#undef PK4
    SBAR();
    { const int vb = vb0 + cur * SHM_V;
      pv_one<0>(o[0], vb, pa0, pa1, pa2, pa3); pv_one<1>(o[1], vb, pa0, pa1, pa2, pa3); pv_one<2>(o[2], vb, pa0, pa1, pa2, pa3); pv_one<3>(o[3], vb, pa0, pa1, pa2, pa3);
      pv_one<4>(o[4], vb, pa0, pa1, pa2, pa3); pv_one<5>(o[5], vb, pa0, pa1, pa2, pa3); pv_one<6>(o[6], vb, pa0, pa1, pa2, pa3); pv_one<7>(o[7], vb, pa0, pa1, pa2, pa3); }
    VM_WAIT(); __syncthreads();
  }
  { int lane2 = threadIdx.x & 63, slot2 = slot; asm volatile("" : "+v"(lane2), "+s"(slot2));
    const int r32e = lane2 & 31, hie = lane2 >> 5;
    float* PO = (float*)(F.ws + WS_PO) + (size_t)slot2 * 256 * 256; float* ML = (float*)(F.ws + WS_ML) + (size_t)slot2 * 512;
    LAS float* wse = (LAS float*)(F.lds + LDS_WS) + wid * 64;
    if (hie == 0) { wse[r32e] = l_reg; ML[(wid * 32 + r32e) * 2] = m_reg; ML[(wid * 32 + r32e) * 2 + 1] = l_reg; }
    asm volatile("s_waitcnt lgkmcnt(0)" ::: "memory");
    char* Ob = (char*)(PO + (size_t)(wid * 32) * 256);
    const unsigned lo = (unsigned)(4 * hie * 256 + r32e) * 4u;
#pragma unroll
    for (int r = 0; r < 16; ++r) { const int rowc = (r & 3) + 8 * (r >> 2); const float lv = wse[rowc + 4 * hie]; const float rl = lv > 0.f ? __builtin_amdgcn_rcpf(lv) : 0.f;
#pragma unroll
      for (int d0 = 0; d0 < 8; ++d0) *(float*)(Ob + (lo + (unsigned)(rowc * 256 + d0 * 32) * 4u)) = o[d0][r] * rl;
      SBAR(); } }
  __syncthreads();
#undef STAGE_K
#undef STAGE_V
}

__device__ __forceinline__ void phase(const Frame& F, int ca, int NA) {
  int s0 = (int)(((long)ca * NSTEPS) / NA); const int s1 = (int)(((long)(ca + 1) * NSTEPS) / NA);
  while (s0 < s1) {
    const int bhm = s0 / STEPS_BHM, rem = s0 - bhm * STEPS_BHM;
    int qb = 0;
#pragma unroll 1
    for (int q = 1; q < 8; ++q) if (rem >= qb_start(q)) qb = q;
    const int j0 = rem - qb_start(qb), nst = 4 * qb + 5;
    const int j1 = (j0 + (s1 - s0) < nst) ? j0 + (s1 - s0) : nst;
    const int slot = bhm * 16 + qb + chunk_of(s0, NA) - chunk_of(bhm * STEPS_BHM, NA);
    segment(F, bhm, qb, j0, j1, slot);
    s0 += j1 - j0;
  }
}
#undef KSWZ
#undef SBAR
}
namespace ml {
constexpr int QST = 136, TST = 72;
constexpr int L_RQ = 0, L_RK = 17152, L_QS = 34304, L_QW = 51712, L_KS = 69120, L_KWT = 86528, L_VT = 104960  , L_SP = 0  , L_G = 141824, L_CW = 143872;
constexpr int L_HT = 0;
constexpr int G_A = 0, G_M = 64, G_WI = 128, G_EM = 192, G_DEN = 256, G_WG = 320, G_SC = 384, G_N = 0;
constexpr int L_NV = L_CW + 5120;
constexpr int L_SSQ = L_KWT;
__device__ __forceinline__ float shfl_up_f(float v, int d) { return __shfl_up(v, d); }

__device__ __forceinline__ void load_cw(const Frame& F, const Args& a, int h) {
  LAS float* CW = (LAS float*)(F.lds + L_CW);
  for (int e = F.tid; e < 2 * 5 * 128; e += NTHR) { const int qk = e / 640, j = (e / 128) % 5, d = e & 127; const int ch = qk * 512 + h * 128 + d;
    CW[e] = j < 4 ? a.in[IN_CW][j * 1024 + ch] : a.in[IN_CB][ch]; }
}
__device__ __forceinline__ void load_raw(const Frame& F, const bf16* g, int pos0, int lds_off) {
  for (int p = F.tid; p < 67 * 16; p += NTHR) { const int row = p >> 4, ch = p & 15, pos = pos0 - 3 + row;
    v4u v = {0u, 0u, 0u, 0u}; if (pos >= MPOS0) v = *(const v4u*)(g + (size_t)pos * 128 + ch * 8);
    *(LAS v4u*)(F.lds + lds_off + row * 256 + ch * 16) = v; }
}
__device__ __forceinline__ void conv16(const Frame& F, int qk, int lds_off, int t, int d0, float (&y)[16]) {
  const LAS float* CW = (const LAS float*)(F.lds + L_CW);
#pragma unroll
  for (int e = 0; e < 16; ++e) y[e] = CW[(qk * 5 + 4) * 128 + d0 + e];
#pragma unroll
  for (int j = 0; j < 4; ++j) { const LAS v4u* rp = (const LAS v4u*)(F.lds + lds_off + (t + j) * 256 + d0 * 2); const v4u r0 = rp[0], r1 = rp[1];
    const LAS float* cw = CW + (qk * 5 + j) * 128 + d0;
    y[0] += cw[0] * bflo(r0.x); y[1] += cw[1] * bfhi(r0.x); y[2] += cw[2] * bflo(r0.y); y[3] += cw[3] * bfhi(r0.y); y[4] += cw[4] * bflo(r0.z); y[5] += cw[5] * bfhi(r0.z); y[6] += cw[6] * bflo(r0.w); y[7] += cw[7] * bfhi(r0.w);
    y[8] += cw[8] * bflo(r1.x); y[9] += cw[9] * bfhi(r1.x); y[10] += cw[10] * bflo(r1.y); y[11] += cw[11] * bfhi(r1.y); y[12] += cw[12] * bflo(r1.z); y[13] += cw[13] * bfhi(r1.z); y[14] += cw[14] * bflo(r1.w); y[15] += cw[15] * bfhi(r1.w); }
#pragma unroll
  for (int e = 0; e < 16; ++e) y[e] = y[e] / (1.0f + __expf(-y[e]));
}
__device__ __forceinline__ void load_vt(const Frame& F, const bf16* MVg, int pos0) {
#pragma unroll
  for (int i = 0; i < 4; ++i) { const int p = F.tid + NTHR * i, row = p >> 5, ch = p & 31; v4u v4 = {0u, 0u, 0u, 0u};
    if (pos0 + row >= MPOS0) v4 = *(const v4u*)(MVg + (size_t)(pos0 + row) * 256 + ch * 8);
    LAS bf16* vt = (LAS bf16*)(F.lds + L_VT) + (ch * 8) * TST + row;
    vt[0 * TST] = (bf16)(v4.x & 0xffff); vt[1 * TST] = (bf16)(v4.x >> 16); vt[2 * TST] = (bf16)(v4.y & 0xffff); vt[3 * TST] = (bf16)(v4.y >> 16);
    vt[4 * TST] = (bf16)(v4.z & 0xffff); vt[5 * TST] = (bf16)(v4.z >> 16); vt[6 * TST] = (bf16)(v4.w & 0xffff); vt[7 * TST] = (bf16)(v4.w >> 16); }
}

__device__ __forceinline__ void taskA(const Frame& F, const Args& a, int task) {
  const int bh = task >> 5, c = task & 31, h = bh & 3, tid = F.tid, w = F.wave, lane = F.lane, fr = lane & 15, kq = lane >> 4, pos0 = 64 * c;
  LAS unsigned char* lds = F.lds; LAS float* G = (LAS float*)(lds + L_G);
  const bf16* MKg = (const bf16*)(F.ws + WS_MK) + (size_t)bh * PADT * 128; const bf16* MVg = (const bf16*)(F.ws + WS_MV) + (size_t)bh * PADT * 256;
  __syncthreads();
  load_cw(F, a, h); load_raw(F, MKg, pos0, L_RK); load_vt(F, MVg, pos0);
  if (w == 0) {
    const bool dead = pos0 + lane < MPOS0;
    const float li = dead ? -1e30f : ((const float*)(F.ws + WS_LI))[bh * PADT + pos0 + lane], lf = dead ? 0.f : ((const float*)(F.ws + WS_LF))[bh * PADT + pos0 + lane];
    float bs = lf;
#pragma unroll
    for (int d = 1; d < 64; d <<= 1) { const float o = shfl_up_f(bs, d); if (lane >= d) bs += o; }
    const float av = li - bs; float mx = av;
#pragma unroll
    for (int o = 1; o < 64; o <<= 1) mx = fmaxf(mx, __shfl_xor(mx, o));
    G[G_WG + lane] = __expf(av - mx);
    if (lane == 63) { float* gs = (float*)(F.ws + WS_GS) + (size_t)(bh * 33 + c) * 2; gs[0] = bs; gs[1] = mx; }
  }
  __syncthreads();
  { const int t = tid >> 3, d0 = (tid & 7) * 16; float y[16]; conv16(F, 1, L_RK, t, d0, y);
    const float sw = 0.08838834764831845f * G[G_WG + t]; LAS bf16* kt = (LAS bf16*)(lds + L_KWT) + d0 * TST + t;
#pragma unroll
    for (int e = 0; e < 16; ++e) kt[e * TST] = (bf16)f2bf(y[e] * sw); }
  __syncthreads();
  f32x4* DCg = (f32x4*)(F.ws + WS_DC) + ((size_t)(bh * 32 + c) * 128) * 64;
#pragma unroll
  for (int jj = 0; jj < 2; ++jj) { const int j = 2 * w + jj;
    const bf16x8 bv0 = *(const LAS bf16x8*)(lds + L_VT + ((16 * j + fr) * TST + 8 * kq) * 2), bv1 = *(const LAS bf16x8*)(lds + L_VT + ((16 * j + fr) * TST + 32 + 8 * kq) * 2);
#pragma unroll
    for (int i = 0; i < 8; ++i) { f32x4 acc = {0.f, 0.f, 0.f, 0.f};
      const bf16x8 k0 = *(const LAS bf16x8*)(lds + L_KWT + ((16 * i + fr) * TST + 8 * kq) * 2), k1 = *(const LAS bf16x8*)(lds + L_KWT + ((16 * i + fr) * TST + 32 + 8 * kq) * 2);
      acc = __builtin_amdgcn_mfma_f32_16x16x32_bf16(k0, bv0, acc, 0, 0, 0); acc = __builtin_amdgcn_mfma_f32_16x16x32_bf16(k1, bv1, acc, 0, 0, 0);
      DCg[(size_t)(i * 16 + j) * 64 + lane] = acc; } }
  if (tid < 128) { const LAS v4u* kr = (const LAS v4u*)(lds + L_KWT + tid * TST * 2); float s = 0.f;
#pragma unroll
    for (int q = 0; q < 8; ++q) { const v4u x = kr[q]; s += (bflo(x.x) + bfhi(x.x)) + (bflo(x.y) + bfhi(x.y)) + (bflo(x.z) + bfhi(x.z)) + (bflo(x.w) + bfhi(x.w)); }
    ((float*)(F.ws + WS_DN))[(size_t)(bh * 32 + c) * 128 + tid] = s; }
}

__device__ __forceinline__ void scanB(const Frame& F) {
  const float* GS = (const float*)(F.ws + WS_GS);
  LAS float* cf = (LAS float*)F.lds;
  for (int blk = blockIdx.x; blk < 16 * 8; blk += gridDim.x) { const int bh = blk >> 3, r = (blk & 7) * NTHR + F.tid, I = r >> 10, j = (r >> 6) & 15, ln = r & 63;
    __syncthreads();
    if (F.tid == 0) { float m = 0.f; for (int c = 0; c < 32; ++c) { const float bL = GS[(bh * 33 + c) * 2], ml = GS[(bh * 33 + c) * 2 + 1], me = fmaxf(m, ml);
        cf[2 * c] = __expf(m - me); cf[2 * c + 1] = __expf(ml - me); m = bL + me; } }
    __syncthreads();
    const f32x4* dc0 = (const f32x4*)(F.ws + WS_DC) + ((size_t)(bh * 32) * 128 + ((2 * I) * 16 + j)) * 64 + ln;
    const f32x4* dc1 = dc0 + 16 * 64;
    v4u* cs = (v4u*)(F.ws + WS_CS) + ((((size_t)bh * 33) * 4 + I) * 16 + j) * 64 + ln;
    f32x4 s0 = {0.f, 0.f, 0.f, 0.f}, s1 = {0.f, 0.f, 0.f, 0.f};
#pragma unroll 8
    for (int c = 0; c < 32; ++c) { const float fa = cf[2 * c], fb = cf[2 * c + 1];
      s0 = s0 * fa + dc0[(size_t)c * 128 * 64] * fb; s1 = s1 * fa + dc1[(size_t)c * 128 * 64] * fb;
      v4u o; o.x = pk2(s0.x, s0.y); o.y = pk2(s0.z, s0.w); o.z = pk2(s1.x, s1.y); o.w = pk2(s1.z, s1.w); cs[(size_t)(c + 1) * 4 * 16 * 64] = o; } }
  const int gt = blockIdx.x * NTHR + F.tid, NT = gridDim.x * NTHR;
  for (int g = gt; g < 16 * 128; g += NT) { const int bh = g >> 7, d = g & 127; float n = 0.f, m = 0.f;
    for (int c = 0; c < 32; ++c) { const float bL = GS[(bh * 33 + c) * 2], ml = GS[(bh * 33 + c) * 2 + 1], me = fmaxf(m, ml);
      n = n * __expf(m - me) + ((const float*)(F.ws + WS_DN))[(size_t)(bh * 32 + c) * 128 + d] * __expf(ml - me); m = bL + me;
      ((float*)(F.ws + WS_NS))[(size_t)(bh * 33 + c + 1) * 128 + d] = n; if (d == 0) ((float*)(F.ws + WS_MS))[bh * 33 + c + 1] = m; } }
}

__device__ __forceinline__ void taskC(const Frame& F, const Args& a, int task) {
  const int bh = task >> 5, c = (task & 31) + 1, b = bh >> 2, h = bh & 3, tid = F.tid, w = F.wave, lane = F.lane, fr = lane & 15, kq = lane >> 4, pos0 = 64 * c;
  LAS unsigned char* lds = F.lds; LAS float* G = (LAS float*)(lds + L_G); LAS float* NV = (LAS float*)(lds + L_NV);
  const bf16* MQg = (const bf16*)(F.ws + WS_MQ) + (size_t)bh * PADT * 128; const bf16* MKg = (const bf16*)(F.ws + WS_MK) + (size_t)bh * PADT * 128;
  const bf16* MVg = (const bf16*)(F.ws + WS_MV) + (size_t)bh * PADT * 256;
  const float m = ((const float*)(F.ws + WS_MS))[bh * 33 + c];
  __syncthreads();
  load_cw(F, a, h); load_raw(F, MQg, pos0, L_RQ); load_raw(F, MKg, pos0, L_RK); load_vt(F, MVg, pos0);
  if (tid < 128) NV[tid] = ((const float*)(F.ws + WS_NS))[(size_t)(bh * 33 + c) * 128 + tid];
  if (w == 0) {
    const float li = ((const float*)(F.ws + WS_LI))[bh * PADT + pos0 + lane], lf = ((const float*)(F.ws + WS_LF))[bh * PADT + pos0 + lane];
    float bs = lf;
#pragma unroll
    for (int d = 1; d < 64; d <<= 1) { const float o = shfl_up_f(bs, d); if (lane >= d) bs += o; }
    const float av = li - bs; float cm = av;
#pragma unroll
    for (int d = 1; d < 64; d <<= 1) { const float o = shfl_up_f(cm, d); if (lane >= d) cm = fmaxf(cm, o); }
    const float Mt = fmaxf(m, cm);
    G[G_A + lane] = av; G[G_M + lane] = Mt; G[G_WI + lane] = __expf(m - Mt); G[G_EM + lane] = __expf(-(bs + Mt));
  }
  __syncthreads();
  { const int t = tid >> 3, d0 = (tid & 7) * 16; const float wi = G[G_WI + t]; float y[16];
    conv16(F, 0, L_RQ, t, d0, y);
    { v4u o0, o1, w0, w1;
      o0.x = pk2(y[0], y[1]); o0.y = pk2(y[2], y[3]); o0.z = pk2(y[4], y[5]); o0.w = pk2(y[6], y[7]); o1.x = pk2(y[8], y[9]); o1.y = pk2(y[10], y[11]); o1.z = pk2(y[12], y[13]); o1.w = pk2(y[14], y[15]);
      w0.x = pk2(y[0] * wi, y[1] * wi); w0.y = pk2(y[2] * wi, y[3] * wi); w0.z = pk2(y[4] * wi, y[5] * wi); w0.w = pk2(y[6] * wi, y[7] * wi);
      w1.x = pk2(y[8] * wi, y[9] * wi); w1.y = pk2(y[10] * wi, y[11] * wi); w1.z = pk2(y[12] * wi, y[13] * wi); w1.w = pk2(y[14] * wi, y[15] * wi);
      LAS v4u* qs = (LAS v4u*)(lds + L_QS + (t * QST + d0) * 2); qs[0] = o0; qs[1] = o1;
      LAS v4u* qw = (LAS v4u*)(lds + L_QW + (t * QST + d0) * 2); qw[0] = w0; qw[1] = w1; }
    __builtin_amdgcn_sched_barrier(0);
    conv16(F, 1, L_RK, t, d0, y);
    { const float sc = 0.08838834764831845f; v4u o0, o1;
      o0.x = pk2(y[0] * sc, y[1] * sc); o0.y = pk2(y[2] * sc, y[3] * sc); o0.z = pk2(y[4] * sc, y[5] * sc); o0.w = pk2(y[6] * sc, y[7] * sc);
      o1.x = pk2(y[8] * sc, y[9] * sc); o1.y = pk2(y[10] * sc, y[11] * sc); o1.z = pk2(y[12] * sc, y[13] * sc); o1.w = pk2(y[14] * sc, y[15] * sc);
      LAS v4u* ks = (LAS v4u*)(lds + L_KS + (t * QST + d0) * 2); ks[0] = o0; ks[1] = o1; } }
  __syncthreads();
  v4u cb[4][2];
  { const v4u* cs = (const v4u*)(F.ws + WS_CS) + (((size_t)bh * 33 + c) * 4 * 16) * 64;
#pragma unroll
    for (int I = 0; I < 4; ++I)
#pragma unroll
      for (int jj = 0; jj < 2; ++jj) cb[I][jj] = cs[(size_t)(I * 16 + 2 * w + jj) * 64 + lane]; }
  { const int si = w >> 1; const f32x4 as = *(const LAS f32x4*)(G + G_A + 16 * si + 4 * kq);
#pragma unroll
    for (int tt = 0; tt < 2; ++tt) { const int ti = 2 * (w & 1) + tt; f32x4 acc = {0.f, 0.f, 0.f, 0.f};
#pragma unroll
      for (int ks = 0; ks < 4; ++ks) { const bf16x8 af = *(const LAS bf16x8*)(lds + L_KS + ((16 * si + fr) * QST + 32 * ks + 8 * kq) * 2);
        const bf16x8 bfr = *(const LAS bf16x8*)(lds + L_QS + ((16 * ti + fr) * QST + 32 * ks + 8 * kq) * 2);
        acc = __builtin_amdgcn_mfma_f32_16x16x32_bf16(af, bfr, acc, 0, 0, 0); }
      const int t = 16 * ti + fr, s0 = 16 * si + 4 * kq; const float Mt = G[G_M + t];
      const float v0 = (s0 + 0 <= t) ? acc.x * __expf(as.x - Mt) : 0.f, v1 = (s0 + 1 <= t) ? acc.y * __expf(as.y - Mt) : 0.f;
      const float v2 = (s0 + 2 <= t) ? acc.z * __expf(as.z - Mt) : 0.f, v3 = (s0 + 3 <= t) ? acc.w * __expf(as.w - Mt) : 0.f;
      v2u o; o.x = pk2(v0, v1); o.y = pk2(v2, v3);
      *(LAS v2u*)(lds + L_SP + (t * TST + s0) * 2) = o; } }
  __syncthreads();
  if (w == 0) { const int t = lane; float qn = 0.f, rsum = 0.f;
#pragma unroll 4
    for (int q = 0; q < 16; ++q) { const v4u x = *(const LAS v4u*)(lds + L_QS + (t * QST + q * 8) * 2); const f32x4 n0 = *(const LAS f32x4*)(NV + q * 8), n1 = *(const LAS f32x4*)(NV + q * 8 + 4);
      qn += bflo(x.x) * n0.x + bfhi(x.x) * n0.y + bflo(x.y) * n0.z + bfhi(x.y) * n0.w + bflo(x.z) * n1.x + bfhi(x.z) * n1.y + bflo(x.w) * n1.z + bfhi(x.w) * n1.w; }
#pragma unroll
    for (int q = 0; q < 8; ++q) { const v4u x = *(const LAS v4u*)(lds + L_SP + (t * TST + q * 8) * 2); rsum += (bflo(x.x) + bfhi(x.x)) + (bflo(x.y) + bfhi(x.y)) + (bflo(x.z) + bfhi(x.z)) + (bflo(x.w) + bfhi(x.w)); }
    const float den = G[G_WI + t] * qn + rsum; G[G_DEN + t] = fmaxf(fabsf(den), G[G_EM + t]); }
  f32x4 acc[2][4];
#pragma unroll
  for (int jj = 0; jj < 2; ++jj)
#pragma unroll
    for (int ti = 0; ti < 4; ++ti) acc[jj][ti] = (f32x4){0.f, 0.f, 0.f, 0.f};
#pragma unroll
  for (int I = 0; I < 4; ++I) {
#pragma unroll
    for (int ti = 0; ti < 4; ++ti) { const LAS unsigned char* qp = lds + L_QW + ((16 * ti + fr) * QST + 32 * I + 4 * kq) * 2;
      const v2u a0 = *(const LAS v2u*)qp, a1 = *(const LAS v2u*)(qp + 32); const v4u av = {a0.x, a0.y, a1.x, a1.y};
      acc[0][ti] = __builtin_amdgcn_mfma_f32_16x16x32_bf16(__builtin_bit_cast(bf16x8, av), __builtin_bit_cast(bf16x8, cb[I][0]), acc[0][ti], 0, 0, 0);
      acc[1][ti] = __builtin_amdgcn_mfma_f32_16x16x32_bf16(__builtin_bit_cast(bf16x8, av), __builtin_bit_cast(bf16x8, cb[I][1]), acc[1][ti], 0, 0, 0); }
    __builtin_amdgcn_sched_barrier(0); }
#pragma unroll
  for (int ks = 0; ks < 2; ++ks) { const bf16x8 bv0 = *(const LAS bf16x8*)(lds + L_VT + ((32 * w + fr) * TST + 32 * ks + 8 * kq) * 2), bv1 = *(const LAS bf16x8*)(lds + L_VT + ((32 * w + 16 + fr) * TST + 32 * ks + 8 * kq) * 2);
#pragma unroll
    for (int ti = 0; ti < 4; ++ti) { const bf16x8 sf = *(const LAS bf16x8*)(lds + L_SP + ((16 * ti + fr) * TST + 32 * ks + 8 * kq) * 2);
      acc[0][ti] = __builtin_amdgcn_mfma_f32_16x16x32_bf16(sf, bv0, acc[0][ti], 0, 0, 0); acc[1][ti] = __builtin_amdgcn_mfma_f32_16x16x32_bf16(sf, bv1, acc[1][ti], 0, 0, 0); } }
  __syncthreads();
  LAS float* SSQ = (LAS float*)(lds + L_SSQ);
#pragma unroll
  for (int ti = 0; ti < 4; ++ti) { const f32x4 dn = *(const LAS f32x4*)(G + G_DEN + 16 * ti + 4 * kq);
    f32x4 s4;
#pragma unroll
    for (int r = 0; r < 4; ++r) { const float h0 = acc[0][ti][r] / dn[r], h1 = acc[1][ti][r] / dn[r]; acc[0][ti][r] = h0; acc[1][ti][r] = h1; s4[r] = h0 * h0 + h1 * h1; }
#pragma unroll
    for (int o = 1; o < 16; o <<= 1) { s4.x += __shfl_xor(s4.x, o); s4.y += __shfl_xor(s4.y, o); s4.z += __shfl_xor(s4.z, o); s4.w += __shfl_xor(s4.w, o); }
    if (fr == 0) { SSQ[(16 * ti + 4 * kq + 0) * 8 + w] = s4.x; SSQ[(16 * ti + 4 * kq + 1) * 8 + w] = s4.y; SSQ[(16 * ti + 4 * kq + 2) * 8 + w] = s4.z; SSQ[(16 * ti + 4 * kq + 3) * 8 + w] = s4.w; } }
  __syncthreads();
  LAS bf16* HT = (LAS bf16*)(lds + L_HT);
#pragma unroll
  for (int ti = 0; ti < 4; ++ti)
#pragma unroll
    for (int r = 0; r < 4; ++r) { const int t = 16 * ti + 4 * kq + r; const f32x4 p0 = *(const LAS f32x4*)(SSQ + t * 8), p1 = *(const LAS f32x4*)(SSQ + t * 8 + 4);
      const float rh = rsqrtf(((p0.x + p0.y) + (p0.z + p0.w) + (p1.x + p1.y) + (p1.z + p1.w)) * (1.0f / 256.f) + EPS);
      HT[t * 264 + 32 * w + fr] = (bf16)f2bf(acc[0][ti][r] * rh); HT[t * 264 + 32 * w + 16 + fr] = (bf16)f2bf(acc[1][ti][r] * rh); }
  __syncthreads();
  { const int t = tid >> 3, c0 = (tid & 7) * 32; const size_t R = (size_t)b * SEQ + 64 * (c - 1) + t;
    const bf16* mo = (const bf16*)(F.ws + WS_MO) + R * 1024 + h * 256 + c0; const float* og = a.in[IN_OUTG] + h * 256 + c0; bf16* A2 = (bf16*)(F.ws + WS_A2) + R * DM + 1024 + h * 256 + c0;
#pragma unroll
    for (int q = 0; q < 4; ++q) { const v4u hv = *(const LAS v4u*)(HT + t * 264 + c0 + q * 8); const v4u mv = *(const v4u*)(mo + q * 8); const f32x4 g0 = *(const f32x4*)(og + q * 8), g1 = *(const f32x4*)(og + q * 8 + 4);
      v4u o; o.x = pk2(bflo(hv.x) * g0.x * bflo(mv.x), bfhi(hv.x) * g0.y * bfhi(mv.x)); o.y = pk2(bflo(hv.y) * g0.z * bflo(mv.y), bfhi(hv.y) * g0.w * bfhi(mv.y));
      o.z = pk2(bflo(hv.z) * g1.x * bflo(mv.z), bfhi(hv.z) * g1.y * bfhi(mv.z)); o.w = pk2(bflo(hv.w) * g1.z * bflo(mv.w), bfhi(hv.w) * g1.w * bfhi(mv.w));
      *(v4u*)(A2 + q * 8) = o; } }
}
}
__device__ __forceinline__ void p3_combine(const Frame& F, const Args& a, int NA) {
  const float* PO = (const float*)(F.ws + WS_PO); const float* ML = (const float*)(F.ws + WS_ML);
  bf16* A2 = (bf16*)(F.ws + WS_A2);
  const float lam = *(const float*)(F.ws + WS_LAM);
  const float* subg = a.in[IN_SUBG];
  const int gw = blockIdx.x * NWAVES + F.wave, NGW = gridDim.x * NWAVES, lane = F.lane;
  const f32x4 sg = ((const f32x4*)subg)[lane];
  for (int R = gw; R < MROWS; R += NGW) {
    const int b = R >> 11, t = R & 2047, qb = t >> 8, rq = t & 255;
#pragma unroll 2
    for (int h = 0; h < 4; ++h) {
      f32x4 om[2];
#pragma unroll
      for (int m = 0; m < 2; ++m) {
        const int bhm = (b * 4 + h) * 2 + m, first = bhm * att::STEPS_BHM + att::qb_start(qb), last = first + 4 * qb + 4;
        const int cf = att::chunk_of(first, NA), np = att::chunk_of(last, NA) - cf + 1, slot0 = bhm * 16 + qb + cf - att::chunk_of(bhm * att::STEPS_BHM, NA);
        float mp[3], lp[3]; f32x4 op[3];
#pragma unroll
        for (int p = 0; p < 3; ++p) { if (p < np) { const int slot = slot0 + p; mp[p] = ML[(size_t)slot * 512 + rq * 2]; lp[p] = ML[(size_t)slot * 512 + rq * 2 + 1];
            op[p] = ((const f32x4*)(PO + ((size_t)slot * 256 + rq) * 256))[lane]; } else { mp[p] = -1e30f; lp[p] = 0.f; op[p] = (f32x4){0.f, 0.f, 0.f, 0.f}; } }
        const float M = fmaxf(mp[0], fmaxf(mp[1], mp[2]));
        float wsum = 0.f; f32x4 acc = (f32x4){0.f, 0.f, 0.f, 0.f};
#pragma unroll
        for (int p = 0; p < 3; ++p) { const float w = lp[p] * exp2f(mp[p] - M); wsum += w; acc += op[p] * w; }
        om[m] = acc * (1.0f / wsum);
      }
      const f32x4 o = om[0] - om[1] * lam;
      const float rs = rsqrtf(wave_sum((o.x * o.x + o.y * o.y) + (o.z * o.z + o.w * o.w)) * (1.0f / 256.f) + EPS) * 0.8f;
      v2u w; w.x = pk2(o.x * rs * sg.x, o.y * rs * sg.y); w.y = pk2(o.z * rs * sg.z, o.w * rs * sg.w);
      ((v2u*)(A2 + (size_t)R * DM + h * 256))[lane] = w;
    }
  }
}
struct EpiRes {
  static constexpr bool PERM = true, AFTER_DRAIN = false;
  const float* x; float* out; bf16* H1b; float* SSQ;
  __device__ __forceinline__ void operator()(const pg8::f32x4 (&acc)[2][2][4][2], const pg8::Unit& u, int wr, int wc, int fr, int fq) const {
    const int row0 = u.pm * 256 + wr * 64 + fr, col0 = u.pn * 256 + wc * 32 + 8 * fq;
#pragma unroll
    for (int ai = 0; ai < 2; ++ai)
#pragma unroll
      for (int m = 0; m < 4; ++m) { const size_t R = (size_t)(row0 + ai * 128 + m * 16); float s = 0.f;
#pragma unroll
        for (int bj = 0; bj < 2; ++bj) { const size_t off = R * DM + col0 + bj * 128;
          const f32x4 x0 = *(const f32x4*)(x + off), x1 = *(const f32x4*)(x + off + 4);
          const f32x4 v0 = acc[ai][bj][m][0] + x0, v1 = acc[ai][bj][m][1] + x1;
          v4u w; w.x = pk2(v0.x, v0.y); w.y = pk2(v0.z, v0.w); w.z = pk2(v1.x, v1.y); w.w = pk2(v1.z, v1.w);
          *(v4u*)(H1b + off) = w;
          s += (v0.x * v0.x + v0.y * v0.y) + (v0.z * v0.z + v0.w * v0.w) + (v1.x * v1.x + v1.y * v1.y) + (v1.z * v1.z + v1.w * v1.w); }
        s += __shfl_xor(s, 16); s += __shfl_xor(s, 32);
        if (fq == 0) SSQ[R * 32 + u.pn * 4 + wc] = s; }
  }
};
#ifndef PEER_U_FP8
#define PEER_U_FP8 0
#endif
typedef __bf16 bfv2 __attribute__((ext_vector_type(2)));
__device__ __forceinline__ void split_hl(const f32x4 a, const f32x4 b, bf16x8& hi, bf16x8& lo) {
  float v[8] = {a.x, a.y, a.z, a.w, b.x, b.y, b.z, b.w}; unsigned h[8], l[8];
#pragma unroll
  for (int i = 0; i < 8; ++i) { h[i] = f2bf(v[i]); l[i] = f2bf(v[i] - __builtin_bit_cast(float, h[i] << 16)); }
  v4u hv = {h[0] | (h[1] << 16), h[2] | (h[3] << 16), h[4] | (h[5] << 16), h[6] | (h[7] << 16)};
  v4u lv = {l[0] | (l[1] << 16), l[2] | (l[3] << 16), l[4] | (l[5] << 16), l[6] | (l[7] << 16)};
  hi = __builtin_bit_cast(bf16x8, hv); lo = __builtin_bit_cast(bf16x8, lv);
}
__device__ __forceinline__ void p0_w3t(const Frame& F, const Args& a) {
  const float* wq = a.in[IN_WQ]; const float* sk = a.in[IN_SUBK]; const float* g2 = a.in[IN_G2];
  bf16* W3t = (bf16*)(F.ws + WS_W3T);
  const int gw = blockIdx.x * NWAVES + F.wave, NGW = gridDim.x * NWAVES, lane = F.lane, fr = lane & 15, fq = lane >> 4;
  for (int task = gw; task < 128 * 16; task += NGW) {
    const int kt = task >> 4, hh = task & 15;
    bf16x8 ahi[4], alo[4];
    const float* ap = wq + (size_t)(kt * 16 + fr) * DM + hh * 128 + fq * 8;
#pragma unroll
    for (int s = 0; s < 4; ++s) split_hl(*(const f32x4*)(ap + 32 * s), *(const f32x4*)(ap + 32 * s + 4), ahi[s], alo[s]);
    const f32x4 gk = *(const f32x4*)(g2 + kt * 16 + fq * 4);
#pragma unroll 1
    for (int t2 = 0; t2 < 8; ++t2) {
      const float* bp = sk + (size_t)(hh * 128 + t2 * 16 + fr) * 128 + fq * 8;
      f32x4 acc = {0.f, 0.f, 0.f, 0.f};
#pragma unroll
      for (int s = 0; s < 4; ++s) { bf16x8 bhi, blo; split_hl(*(const f32x4*)(bp + 32 * s), *(const f32x4*)(bp + 32 * s + 4), bhi, blo);
        acc = __builtin_amdgcn_mfma_f32_16x16x32_bf16(ahi[s], bhi, acc, 0, 0, 0);
        acc = __builtin_amdgcn_mfma_f32_16x16x32_bf16(ahi[s], blo, acc, 0, 0, 0);
        acc = __builtin_amdgcn_mfma_f32_16x16x32_bf16(alo[s], bhi, acc, 0, 0, 0); }
      v2u o; o.x = pk2(acc.x * gk.x, acc.y * gk.y); o.y = pk2(acc.z * gk.z, acc.w * gk.w);
      *(v2u*)(W3t + (size_t)(hh * 128 + t2 * 16 + fr) * DM + kt * 16 + fq * 4) = o;
    }
  }
}
typedef float f32x2v __attribute__((ext_vector_type(2)));
__device__ __forceinline__ void p0_tables(const Frame& F, const Args& a) {
  const float* g2 = a.in[IN_G2];
  float* SCL = (float*)(F.ws + WS_SCL);
  const int gw = blockIdx.x * NWAVES + F.wave, NGW = gridDim.x * NWAVES, lane = F.lane;
  f32x4 gl[8];
#pragma unroll
  for (int q = 0; q < 8; ++q) gl[q] = *(const f32x4*)(g2 + q * 256 + lane * 4);
  f32x4 xn[8];
  { const int row = gw; if (row < 2 * 16384) { const float* src = a.in[row >= 16384 ? IN_V : IN_U] + (size_t)(row & 16383) * DM + lane * 4;
#pragma unroll
      for (int q = 0; q < 8; ++q) xn[q] = *(const f32x4*)(src + q * 256); } }
  for (int row = gw; row < 2 * 16384; row += NGW) {
    const bool isv = row >= 16384; const int e = row & 16383;
    f32x4 x[8];
#pragma unroll
    for (int q = 0; q < 8; ++q) x[q] = xn[q];
    { const int rn = row + NGW; if (rn < 2 * 16384) { const float* src = a.in[rn >= 16384 ? IN_V : IN_U] + (size_t)(rn & 16383) * DM + lane * 4;
#pragma unroll
        for (int q = 0; q < 8; ++q) xn[q] = *(const f32x4*)(src + q * 256); } }
    float amax = 0.f;
#pragma unroll
    for (int q = 0; q < 8; ++q) { if (!isv) x[q] = x[q] * gl[q]; amax = fmaxf(amax, fmaxf(fmaxf(fabsf(x[q].x), fabsf(x[q].y)), fmaxf(fabsf(x[q].z), fabsf(x[q].w)))); }
#pragma unroll
    for (int o = 1; o < 64; o <<= 1) amax = fmaxf(amax, __shfl_xor(amax, o));
    const float sc = amax > 0.f ? 6.0f / amax : 1.0f;
    v4u w;
#pragma unroll
    for (int d = 0; d < 4; ++d) { unsigned pk = 0u;
      pk = __builtin_amdgcn_cvt_scalef32_pk_fp4_f32(pk, x[2 * d].x * sc, x[2 * d].y * sc, 1.0f, 0); pk = __builtin_amdgcn_cvt_scalef32_pk_fp4_f32(pk, x[2 * d].z * sc, x[2 * d].w * sc, 1.0f, 1);
      pk = __builtin_amdgcn_cvt_scalef32_pk_fp4_f32(pk, x[2 * d + 1].x * sc, x[2 * d + 1].y * sc, 1.0f, 2); pk = __builtin_amdgcn_cvt_scalef32_pk_fp4_f32(pk, x[2 * d + 1].z * sc, x[2 * d + 1].w * sc, 1.0f, 3);
      w[d] = pk; }
    *(v4u*)(F.ws + (isv ? WS_VB8 : WS_UB) + (size_t)e * 1024 + lane * 16) = w;
    if (lane == 0) SCL[row] = 1.0f / sc;
  }
}
struct EpiScore {
  static constexpr bool PERM = true, AFTER_DRAIN = false;
  float* S; const LAS float* rs;
  __device__ __forceinline__ void operator()(const pg8::f32x4 (&acc)[2][2][4][2], const pg8::Unit& u, int wr, int wc, int fr, int fq) const {
    const int rl0 = wr * 64 + fr, keyb = wc * 32 + 8 * fq;
#pragma unroll
    for (int ai = 0; ai < 2; ++ai)
#pragma unroll
      for (int m = 0; m < 4; ++m) { const int rl = rl0 + ai * 128 + m * 16; const float r = rs[rl]; const int row = u.pm * 256 + rl;
#pragma unroll
        for (int bj = 0; bj < 2; ++bj) { float* d = S + ((size_t)((row >> 5) * 16 + u.pn * 2 + bj) * 128 + keyb) * 32 + (row & 31);
          const pg8::f32x4 v0 = acc[ai][bj][m][0] * r, v1 = acc[ai][bj][m][1] * r;
          d[0] = v0[0]; d[32] = v0[1]; d[64] = v0[2]; d[96] = v0[3]; d[128] = v1[0]; d[160] = v1[1]; d[192] = v1[2]; d[224] = v1[3]; } }
  }
};

__device__ __forceinline__ unsigned fkey(float f) { const unsigned b = __builtin_bit_cast(unsigned, f); return b ^ ((b >> 31) ? 0xFFFFFFFFu : 0x80000000u); }
template <int NV, int K> __device__ __forceinline__ void wave_topk(const unsigned (&u)[NV], bool (&sel)[NV], int lane) {
  unsigned prefix = 0u; int cge = NV * 64;
#pragma unroll 1
  for (int bit = 31; bit >= 0 && cge != K; --bit) {
    const unsigned cand = prefix | (1u << bit); int c = 0;
#pragma unroll
    for (int i = 0; i < NV; ++i) c += __builtin_popcountll(__ballot(u[i] >= cand));
    if (c >= K) { prefix = cand; cge = c; }
  }
  int cgt = 0;
#pragma unroll
  for (int i = 0; i < NV; ++i) cgt += __builtin_popcountll(__ballot(u[i] > prefix));
  int need = K - cgt;
  const unsigned long long lm = (1ull << lane) - 1ull;
#pragma unroll
  for (int i = 0; i < NV; ++i) { const unsigned long long eq = __ballot(u[i] == prefix); const int before = __builtin_popcountll(eq & lm);
    sel[i] = (u[i] > prefix) || (u[i] == prefix && before < need); const int ne = __builtin_popcountll(eq); need = need > ne ? need - ne : 0; }
}
template <int NG, int NV, int K> __device__ __forceinline__ void wave_topk_multi(const unsigned (&u)[NG][NV], bool (&sel)[NG][NV], int lane) {
  unsigned prefix[NG]; int cge[NG];
#pragma unroll
  for (int g = 0; g < NG; ++g) { prefix[g] = 0u; cge[g] = NV * 64; }
#pragma unroll 1
  for (int bit = 31; bit >= 0; --bit) {
    bool done = true;
#pragma unroll
    for (int g = 0; g < NG; ++g) done = done && (cge[g] == K);
    if (done) break;
#pragma unroll
    for (int g = 0; g < NG; ++g) { const unsigned cand = prefix[g] | (1u << bit); int c = 0;
#pragma unroll
      for (int i = 0; i < NV; ++i) c += __builtin_popcountll(__ballot(u[g][i] >= cand));
      if (cge[g] != K && c >= K) { prefix[g] = cand; cge[g] = c; } }
  }
  const unsigned long long lm = (1ull << lane) - 1ull;
#pragma unroll
  for (int g = 0; g < NG; ++g) { int cgt = 0;
#pragma unroll
    for (int i = 0; i < NV; ++i) cgt += __builtin_popcountll(__ballot(u[g][i] > prefix[g]));
    int need = K - cgt;
#pragma unroll
    for (int i = 0; i < NV; ++i) { const unsigned long long eq = __ballot(u[g][i] == prefix[g]); const int before = __builtin_popcountll(eq & lm);
      sel[g][i] = (u[g][i] > prefix[g]) || (u[g][i] == prefix[g] && before < need); const int ne = __builtin_popcountll(eq); need = need > ne ? need - ne : 0; } }
}
__device__ __forceinline__ float gelu_erf(float v) {
  const float av = fabsf(v), t = __builtin_amdgcn_rcpf(1.0f + 0.2316418882f * av);
  float q = t * 0.5307027145f - 0.7265760135f; q = q * t + 0.7107068705f; q = q * t - 0.142248368f; q = q * t + 0.127414796f; q = q * t;
  const float tail = q * __builtin_amdgcn_exp2f(v * v * -0.72134752044f);
  return v < 0.f ? v * tail : v - v * tail;
}

#ifndef ROUTE_REPS
#define ROUTE_REPS 1
#endif
__device__ __forceinline__ void ins16(float (&t)[16], float x) {
#pragma unroll
  for (int i = 15; i >= 1; --i) t[i] = __builtin_amdgcn_fmed3f(t[i - 1], t[i], x);
  t[0] = fmaxf(t[0], x);
}
__device__ __forceinline__ void p6_peer(const Frame& F, const Args& a, float* dst_base) {
  const float* S2 = (const float*)(F.ws + WS_S); const float* SSQ = (const float*)(F.ws + WS_SSQ); const bf16* H1b = (const bf16*)(F.ws + WS_H1B);
  int lane = F.lane, wv = F.wave, tid = F.tid; asm volatile("" : "+v"(lane), "+s"(wv), "+v"(tid));
  int* EIDg = (int*)(F.ws + WS_EID); float* EGTg = (float*)(F.ws + WS_EGT);
  LAS int* eid = (LAS int*)(F.lds + wv * 1536); LAS float* egt = (LAS float*)(eid + 128); LAS float* esu = (LAS float*)(eid + 256);
  LAS unsigned char* RB = F.lds + 12288 + wv * 16384;
  LAS float* L1 = (LAS float*)(F.lds + 12288);
  for (int tb = blockIdx.x; tb < MROWS / 32; tb += gridDim.x) {
    __syncthreads();
    {
      const int g = tid >> 5, tl = tid & 31; const float* src = S2 + ((size_t)(tb * 16 + g) * 128) * 32 + tl;
      float t[16];
#pragma unroll
      for (int i = 0; i < 16; ++i) t[i] = -INFINITY;
#pragma unroll 32
      for (int k = 0; k < 128; ++k) { const float x = src[k * 32]; ins16(t, __builtin_bit_cast(float, (__builtin_bit_cast(unsigned, x) & ~0x7Fu) | (unsigned)(127 - k))); }
#pragma unroll
      for (int i = 0; i < 16; ++i) L1[(g * 16 + i) * 32 + tl] = t[i];
    }
    __syncthreads();
    if (tid < 256) {
      const int h8 = tid >> 5, tl = tid & 31; const LAS float* LA = L1 + ((2 * h8) * 16) * 32 + tl; const LAS float* LB = L1 + ((2 * h8 + 1) * 16) * 32 + tl;
      float A[16], B[16], t[16];
#pragma unroll
      for (int i = 0; i < 16; ++i) { A[i] = LA[i * 32]; B[i] = LB[i * 32]; t[i] = -INFINITY; }
#pragma unroll
      for (int i = 0; i < 16; ++i)
#pragma unroll
        for (int j = 0; j < 16; ++j) if ((i + 1) * (j + 1) <= 16) { const float c = A[i] + B[j];
            ins16(t, __builtin_bit_cast(float, (__builtin_bit_cast(unsigned, c) & ~0xFFu) | (unsigned)(255 - (i * 16 + j)))); }
      float ev[16], es = 0.f;
#pragma unroll
      for (int r = 0; r < 16; ++r) { ev[r] = __expf(t[r] - t[0]); es += ev[r]; }
      const float inv = 1.0f / es;
#pragma unroll
      for (int r = 0; r < 16; ++r) { const unsigned flat = 255u - (__builtin_bit_cast(unsigned, t[r]) & 0xFFu), ii = flat >> 4, jj = flat & 15u;
        const unsigned ka = 127u - (__builtin_bit_cast(unsigned, LA[ii * 32]) & 0x7Fu), kb = 127u - (__builtin_bit_cast(unsigned, LB[jj * 32]) & 0x7Fu);
        EIDg[(size_t)(tb * 32 + tl) * 128 + h8 * 16 + r] = (int)(ka * 128u + kb); EGTg[(size_t)(tb * 32 + tl) * 128 + h8 * 16 + r] = ev[r] * inv; }
    }
    asm volatile("s_waitcnt vmcnt(0)" ::: "memory"); __syncthreads();
#pragma unroll 1
    for (int tt = 0; tt < 4; ++tt) {
    const int tl = wv * 4 + tt, tok = tb * 32 + tl;
    const float rs = rsqrtf(wave_sum_dpp(lane < 32 ? SSQ[(size_t)tok * 32 + lane] : 0.f) * (1.0f / DM) + EPS);
    { const float* SCL = (const float*)(F.ws + WS_SCL);
#pragma unroll
      for (int i = 0; i < 2; ++i) { const int e = lane + 64 * i, idq = __builtin_nontemporal_load(EIDg + (size_t)tok * 128 + e); eid[e] = idq; esu[e] = SCL[idq]; egt[e] = __builtin_nontemporal_load(EGTg + (size_t)tok * 128 + e) * SCL[16384 + idq]; } }
    unsigned xw[16];
    { const bf16* xp = H1b + (size_t)tok * DM + (size_t)lane * 4;
#pragma unroll
      for (int q = 0; q < 8; ++q) { const v2u x0 = *(const v2u*)(xp + q * 256); xw[2 * q] = x0.x; xw[2 * q + 1] = x0.y; } }
    float y[32];
#pragma unroll
    for (int i = 0; i < 32; ++i) y[i] = 0.f;
    asm volatile("s_waitcnt vmcnt(0) lgkmcnt(0)" ::: "memory");
    const unsigned char* U8 = F.ws + WS_UB; const unsigned char* V8 = F.ws + WS_VB8;
#define PG_ISSUE(E) do { const int idq_ = __builtin_amdgcn_readfirstlane(eid[(E)]); LAS unsigned char* sl_ = RB + ((E) & 7) * 2048; \
      __builtin_amdgcn_global_load_lds((const unsigned*)(U8 + (size_t)idq_ * 1024 + lane * 16), (LAS unsigned*)sl_, 16, 0, 0); \
      __builtin_amdgcn_global_load_lds((const unsigned*)(V8 + (size_t)idq_ * 1024 + lane * 16), (LAS unsigned*)(sl_ + 1024), 16, 0, 0); } while (0)
#define PG_DOT(UW, DACC) do { float da_ = 0.f, db_ = 0.f; _Pragma("unroll") for (int dd = 0; dd < 4; ++dd) { const unsigned wa = UW[dd]; \
          da_ = __builtin_amdgcn_fdot2_f32_bf16(__builtin_bit_cast(bfv2, xw[4 * dd + 0]), __builtin_amdgcn_cvt_scalef32_pk_bf16_fp4(wa, 1.0f, 0), da_, false); \
          db_ = __builtin_amdgcn_fdot2_f32_bf16(__builtin_bit_cast(bfv2, xw[4 * dd + 1]), __builtin_amdgcn_cvt_scalef32_pk_bf16_fp4(wa, 1.0f, 1), db_, false); \
          da_ = __builtin_amdgcn_fdot2_f32_bf16(__builtin_bit_cast(bfv2, xw[4 * dd + 2]), __builtin_amdgcn_cvt_scalef32_pk_bf16_fp4(wa, 1.0f, 2), da_, false); \
          db_ = __builtin_amdgcn_fdot2_f32_bf16(__builtin_bit_cast(bfv2, xw[4 * dd + 3]), __builtin_amdgcn_cvt_scalef32_pk_bf16_fp4(wa, 1.0f, 3), db_, false); } DACC = da_ + db_; } while (0)
#define PG_AXPY(VW, CF) do { _Pragma("unroll") for (int dd = 0; dd < 4; ++dd) { const unsigned wa = VW[dd]; \
          { const f32x2v v2 = __builtin_amdgcn_cvt_scalef32_pk_f32_fp4(wa, 1.0f, 0); y[8 * dd + 0] += CF * v2.x; y[8 * dd + 1] += CF * v2.y; } \
          { const f32x2v v2 = __builtin_amdgcn_cvt_scalef32_pk_f32_fp4(wa, 1.0f, 1); y[8 * dd + 2] += CF * v2.x; y[8 * dd + 3] += CF * v2.y; } \
          { const f32x2v v2 = __builtin_amdgcn_cvt_scalef32_pk_f32_fp4(wa, 1.0f, 2); y[8 * dd + 4] += CF * v2.x; y[8 * dd + 5] += CF * v2.y; } \
          { const f32x2v v2 = __builtin_amdgcn_cvt_scalef32_pk_f32_fp4(wa, 1.0f, 3); y[8 * dd + 6] += CF * v2.x; y[8 * dd + 7] += CF * v2.y; } } } while (0)
#define PG_BATCH(E0, DOISSUE) do { v4u ub[NBT], vb[NBT]; float su_[NBT], gt_[NBT]; \
      _Pragma("unroll") for (int q = 0; q < NBT; ++q) { const LAS unsigned char* s0_ = RB + (((E0) + q) & 7) * 2048 + lane * 16; ub[q] = *(const LAS v4u*)s0_; vb[q] = *(const LAS v4u*)(s0_ + 1024); su_[q] = esu[(E0) + q]; gt_[q] = egt[(E0) + q]; } \
      asm volatile("s_waitcnt lgkmcnt(0)" ::: "memory"); \
      if (DOISSUE) { _Pragma("unroll") for (int q = 0; q < NBT; ++q) PG_ISSUE((E0) + 8 + q); } \
      float d_[NBT]; _Pragma("unroll") for (int q = 0; q < NBT; ++q) { d_[q] = 0.f; PG_DOT(ub[q], d_[q]); } \
      _Pragma("unroll") for (int q = 0; q < NBT; ++q) d_[q] = wave_sum_dpp(d_[q]); \
      _Pragma("unroll") for (int q = 0; q < NBT; ++q) { const float c_ = gelu_erf(d_[q] * (rs * su_[q])) * gt_[q]; PG_AXPY(vb[q], c_); __builtin_amdgcn_sched_barrier(0); } } while (0)
    constexpr int NBT = 2;
#pragma unroll
    for (int e = 0; e < 8; ++e) PG_ISSUE(e);
#pragma unroll 1
    for (int e = 0; e < 120; e += NBT) {
      asm volatile("s_waitcnt vmcnt(12)" ::: "memory");
      PG_BATCH(e, true);
      asm volatile("" ::: "memory");
    }
    asm volatile("s_waitcnt vmcnt(0)" ::: "memory");
#pragma unroll 1
    for (int e = 120; e < 128; e += NBT) PG_BATCH(e, false);
    asm volatile("s_waitcnt lgkmcnt(0)" ::: "memory");
#undef PG_ISSUE
#undef PG_DOT
#undef PG_AXPY
#undef PG_BATCH
    float* drow = dst_base + (size_t)tok * DM;
#pragma unroll
    for (int q = 0; q < 8; ++q) { const size_t off = (size_t)q * 256 + lane * 4; f32x4 hv;
      hv.x = bflo(xw[2 * q]) + y[4 * q]; hv.y = bfhi(xw[2 * q]) + y[4 * q + 1]; hv.z = bflo(xw[2 * q + 1]) + y[4 * q + 2]; hv.w = bfhi(xw[2 * q + 1]) + y[4 * q + 3]; *(f32x4*)(drow + off) = hv; }
    }
  }
}
constexpr int MISC_LDS = LDS_BYTES - 256;
__global__ void __launch_bounds__(NTHR, 2) mk_fwd(Args args) {
  extern __shared__ __attribute__((aligned(16))) unsigned char lds_raw[];
  Frame F; F.lds = (LAS unsigned char*)lds_raw; F.ws = args.ws; F.tid = threadIdx.x; F.lane = F.tid & 63; F.wave = __builtin_amdgcn_readfirstlane(F.tid >> 6);
  const int lo = args.ph_lo, hi = args.ph_hi, G = (int)gridDim.x, bx = (int)blockIdx.x;
  volatile LAS unsigned* misc = (volatile LAS unsigned*)(F.lds + MISC_LDS);
  if (F.tid < 16) misc[F.tid] = 0u;
  __syncthreads();
  XcdBarrier bar = xcd_barrier_post((unsigned*)(F.ws + WS_CTL) + CW_BAR, misc);
#define IN(k) (lo <= (k) && (k) < hi)
#define SEAM(k) do { if (IN(k) && IN((k) + 1)) xcd_barrier(bar); } while (0)
#define PHASE_FRAME(Fp) Frame Fp = F; asm volatile("" : "+v"(Fp.tid), "+v"(Fp.lane))
  const int NA = G;
  if (IN(0)) { PHASE_FRAME(F0);
    p0_lam(F0, args);
    p0_zero_vpad(F0);
    p0_metaproj(F0, args);
    p0_rows(F0, args);
    p0_transpose(F0, args.in[IN_WIN], DPROJ, NPROJ, (bf16*)(F.ws + WS_W1T));
    p0_transpose(F0, args.in[IN_WOUT], DM, DM, (bf16*)(F.ws + WS_W2T));
    p0_w3t(F0, args);
    p0_tables(F0, args);
  }
  SEAM(0);
  if (IN(1)) { PHASE_FRAME(F1);
    p1_meta_finalize(F1, args);
    pg8::Gemm g{(const pg8::bf16_t*)(F.ws + WS_XN), (const pg8::bf16_t*)(F.ws + WS_W1T), MROWS, NPROJ, DM};
    pg8::StaticOrder S; S.init(MROWS, NPROJ, G, bx);
    EpiProj E{(bf16*)(F.ws + WS_Q), (bf16*)(F.ws + WS_KP), (bf16*)(F.ws + WS_VP), (bf16*)(F.ws + WS_MQ), (bf16*)(F.ws + WS_MK), (bf16*)(F.ws + WS_MV), (bf16*)(F.ws + WS_MO),
              args.in[IN_QNG], args.in[IN_KNG], (LAS float*)(F.lds + XCH_OFF)};
    pg8::gemm_phase<EpiProj, pg8::StaticOrder, true, true>(F.lds + RING_OFF, g, S, E);
  }
  SEAM(1);
  if (IN(2)) {
    PHASE_FRAME(F2);
    att::phase(F2, (G % 8 == 0) ? (bx & 7) * (G >> 3) + (bx >> 3) : bx, NA);
    for (int task = bx; task < 512; task += G) ml::taskA(F2, args, task);
  }
  SEAM(2);
  if (IN(3)) { PHASE_FRAME(F3); ml::scanB(F3); p3_combine(F3, args, NA); }
  SEAM(3);
  if (IN(4)) {
    PHASE_FRAME(F4);
    for (int task = bx; task < 512; task += G) ml::taskC(F4, args, task);
  }
  SEAM(4);
  if (IN(5)) {
    pg8::Gemm g{(const pg8::bf16_t*)(F.ws + WS_A2), (const pg8::bf16_t*)(F.ws + WS_W2T), MROWS, DM, DM};
    pg8::StaticOrder S; S.init(MROWS, DM, G, bx);
    EpiRes E{args.in[IN_X], args.out, (bf16*)(F.ws + WS_H1B), (float*)(F.ws + WS_SSQ)};
    pg8::gemm_phase<EpiRes, pg8::StaticOrder, true, true>(F.lds + RING_OFF, g, S, E);
  }
  SEAM(5);
  if (IN(6)) {
    pg8::Gemm g{(const pg8::bf16_t*)(F.ws + WS_H1B), (const pg8::bf16_t*)(F.ws + WS_W3T), MROWS, DM, DM};
    pg8::StaticOrder S; S.init(MROWS, DM, G, bx);
    LAS float* rst = (LAS float*)(F.lds + XCH_OFF);
    { pg8::Unit u0; if (S.next(0, u0)) { if (F.tid < 256) { const float* sp = (const float*)(F.ws + WS_SSQ) + ((size_t)u0.pm * 256 + F.tid) * 32; float s = 0.f;
#pragma unroll
          for (int i = 0; i < 8; ++i) { const f32x4 v = ((const f32x4*)sp)[i]; s += (v.x + v.y) + (v.z + v.w); }
          rst[F.tid] = rsqrtf(s * (1.0f / DM) + EPS); } } }
    __syncthreads();
    EpiScore E{(float*)(F.ws + WS_S), rst};
    pg8::gemm_phase<EpiScore, pg8::StaticOrder, true, true>(F.lds + RING_OFF, g, S, E);
  }
  SEAM(6);
  if (IN(7)) { PHASE_FRAME(F7); p6_peer(F7, args, args.out); }
#undef IN
#undef SEAM
}
extern "C" void kernel_launch(void* const* d_in, const int* in_sizes, int n_in, void* d_out, int out_size, void* d_ws, size_t ws_size, hipStream_t stream) {
  static int grid = 0;
  if (grid == 0) {
    int dev = 0, cus = 0, per_cu = 0;
    if (hipGetDevice(&dev) != hipSuccess || hipDeviceGetAttribute(&cus, hipDeviceAttributeMultiprocessorCount, dev) != hipSuccess) { fprintf(stderr, "device query failed\n"); grid = -1; return; }
    if (hipFuncSetAttribute((const void*)mk_fwd, hipFuncAttributeMaxDynamicSharedMemorySize, LDS_BYTES) != hipSuccess) { fprintf(stderr, "hipFuncSetAttribute failed\n"); grid = -1; return; }
    if (hipOccupancyMaxActiveBlocksPerMultiprocessor(&per_cu, (const void*)mk_fwd, NTHR, LDS_BYTES) != hipSuccess || per_cu < 1) { fprintf(stderr, "occupancy query says %d workgroups per CU: not launching\n", per_cu); (void)hipGetLastError(); grid = -1; return; }
    (void)hipGetLastError();
    grid = cus;
    if (n_in != 22 || ws_size < (size_t)512 * MiB || out_size != MROWS * DM) { fprintf(stderr, "unexpected shapes: n_in %d out %d ws %zu\n", n_in, out_size, ws_size); grid = -1; return; }
  }
  if (grid < 0) return;
  unsigned char* ws = (unsigned char*)d_ws;
  if (hipMemsetAsync(ws + WS_CTL, 0, CTL_ZERO_BYTES, stream) != hipSuccess) { fprintf(stderr, "memset failed\n"); return; }
  Args a{};
  for (int i = 0; i < 22; ++i) a.in[i] = (const float*)d_in[i];
  a.out = (float*)d_out; a.ws = ws; a.na = 0; a.pad = 0;
  a.ph_lo = 0; a.ph_hi = 8;
  hipLaunchKernelGGL(mk_fwd, dim3(grid), dim3(NTHR), LDS_BYTES, stream, a);
}
```

```cpp
#include <hip/hip_runtime.h>
#include <cstdio>
#include <cstdint>
#include <math.h>
namespace pg8 {
#define PG8_LAS __attribute__((address_space(3)))
typedef unsigned short bf16_t;
typedef short bf16x8 __attribute__((ext_vector_type(8)));
typedef float f32x4 __attribute__((ext_vector_type(4)));
typedef unsigned u32x4 __attribute__((ext_vector_type(4)));
constexpr int BM = 256, BK = 64, HALF = 128, HTB = HALF * BK * 2  , STAGE_BYTES = 8 * HTB, NXCD = 8, WGM = 8;

__host__ __device__ __forceinline__ int lds_byte(int r, int c) { const int st = (r >> 4) * 2 + (c >> 5), rr = r & 15, cc = c & 31, ob = rr * 64 + cc * 2; return st * 1024 + (ob ^ (((ob >> 9) & 1) << 5)); }
__host__ __device__ __forceinline__ void stage_rc(int b, int& R, int& C) { const int st = b / 1024, sb = b % 1024, swz = sb ^ (((sb >> 9) & 1) << 5); R = (st >> 1) * 16 + swz / 64; C = (st & 1) * 32 + (swz % 64) / 2; }
__host__ __device__ __forceinline__ int perm32(int rho) { const int n = rho >> 4, i = rho & 15; return 8 * (i >> 2) + 4 * n + (i & 3); }

struct Unit { int pm, pn; };
struct Gemm { const bf16_t* A; const bf16_t* Bt; int M, N, K; };

struct StaticOrder {
    int nM, nN, nwg, G, c;
    __host__ __device__ void init(int M, int N, int G_, int c_) { nM = M / BM; nN = N / BM; nwg = nM * nN; G = G_; c = c_; }
    __host__ __device__ bool next(int i, Unit& u) const {
        const long L = (long)i * G + c; if (L >= nwg) return false;
        int wgid = (int)L; { const int q = nwg / NXCD, r = nwg % NXCD, xcd = wgid % NXCD, off = wgid / NXCD; wgid = (xcd < r ? xcd * (q + 1) : r * (q + 1) + (xcd - r) * q) + off; }
        const int nig = WGM * nN, gid = wgid / nig, fm = gid * WGM, gsz = (nM - fm) < WGM ? (nM - fm) : WGM;
        u.pm = fm + ((wgid % nig) % gsz); u.pn = (wgid % nig) / gsz; return true;
    }
    __device__ __forceinline__ void a_ready(const Unit&) const {}
    __device__ __forceinline__ void done(const Unit&) const {}
};

__device__ __forceinline__ unsigned cvt_pk_bf16(float lo, float hi) { unsigned r; asm volatile("v_cvt_pk_bf16_f32 %0, %1, %2" : "=v"(r) : "v"(lo), "v"(hi)); return r; }
typedef float f32x2 __attribute__((ext_vector_type(2)));
template <class Epi, class Sched, bool ALIGN_EPI = false, bool SP2 = false>
__device__ __forceinline__ void gemm_phase(PG8_LAS unsigned char* lds, const Gemm g, const Sched& S, const Epi& E) {
    int tid_ = threadIdx.x; asm volatile("" : "+v"(tid_));
    const int tid = tid_, wid = __builtin_amdgcn_readfirstlane(tid >> 6), lane = tid & 63, wr = wid >> 2, wc = wid & 3, fr = lane & 15, fq = lane >> 4;
    const int K = g.K, nt = K / BK;
    unsigned voffA[2], voffB[2];
#pragma unroll
    for (int i = 0; i < 2; ++i) { int R, C; stage_rc(tid * 16 + i * 8192, R, C); const int Rb = Epi::PERM ? ((R & ~31) + perm32(R & 31)) : R;
        voffA[i] = (unsigned)(R * K + C) * 2u; voffB[i] = (unsigned)(Rb * K + C) * 2u; }
    const size_t kstep = (size_t)(BK * 2);
    const size_t hstep = (size_t)HALF * K * 2;
    const size_t tstep = 2 * hstep;
    const unsigned ldsw = (unsigned)wid * 1024u;
    const int aoff = lds_byte(wr * 64 + fr, fq * 8), boff = lds_byte(wc * 32 + fr, fq * 8);
#define PG8_SA(b, h) (((b) * 2 + (h)) * HTB)
#define PG8_SB(b, h) ((4 + (b) * 2 + (h)) * HTB)
#define PG8_STAGE(bufoff, gbase, voff) do { _Pragma("unroll") for (int _i = 0; _i < 2; ++_i) \
        __builtin_amdgcn_global_load_lds((const unsigned*)((const char*)(gbase) + (voff)[_i]), (PG8_LAS unsigned*)(lds + (bufoff) + ldsw + _i * 8192), 16, 0, 0); } while (0)
#define PG8_LDA(dst, b, h) do { _Pragma("unroll") for (int m = 0; m < 4; ++m) _Pragma("unroll") for (int k = 0; k < 2; ++k) dst[m][k] = *(const PG8_LAS bf16x8*)(lds + PG8_SA(b, h) + aoff + m * 2048 + k * 1024); } while (0)
#define PG8_LDB(dst, b, h) do { _Pragma("unroll") for (int n = 0; n < 2; ++n) _Pragma("unroll") for (int k = 0; k < 2; ++k) dst[n][k] = *(const PG8_LAS bf16x8*)(lds + PG8_SB(b, h) + boff + n * 2048 + k * 1024); } while (0)
#define PG8_MMA(ai, bj, At, Bt) do { __builtin_amdgcn_s_setprio(1); _Pragma("unroll") for (int m = 0; m < 4; ++m) _Pragma("unroll") for (int n = 0; n < 2; ++n) _Pragma("unroll") for (int k = 0; k < 2; ++k) \
        acc[ai][bj][m][n] = __builtin_amdgcn_mfma_f32_16x16x32_bf16(Bt[n][k], At[m][k], acc[ai][bj][m][n], 0, 0, 0); __builtin_amdgcn_s_setprio(0); } while (0)
#define PG8_WAIT_V(n) asm volatile("s_waitcnt vmcnt(" #n ")" ::: "memory")
#define PG8_WAIT_L(n) asm volatile("s_waitcnt lgkmcnt(" #n ")" ::: "memory")
#define PG8_BAR __builtin_amdgcn_s_barrier()
#define PG8_SCHED __builtin_amdgcn_sched_barrier(0)
    Unit cur, nxt; int ui = 0;
    if (!S.next(0, cur)) return;
    f32x4 acc[2][2][4][2];
#pragma unroll
    for (int a = 0; a < 2; ++a)
#pragma unroll
        for (int b = 0; b < 2; ++b)
#pragma unroll
            for (int m = 0; m < 4; ++m)
#pragma unroll
                for (int n = 0; n < 2; ++n) acc[a][b][m][n] = (f32x4){0.f, 0.f, 0.f, 0.f};
    bf16x8 At[4][2], B0[2][2], B1[2][2];
    const char* cA = (const char*)g.A + (size_t)cur.pm * tstep; const char* cB = (const char*)g.Bt + (size_t)cur.pn * tstep;
    S.a_ready(cur);
    if constexpr (SP2) {
        PG8_STAGE(PG8_SB(0, 0), cB, voffB); PG8_STAGE(PG8_SB(0, 1), cB + hstep, voffB); PG8_STAGE(PG8_SA(0, 0), cA, voffA); PG8_STAGE(PG8_SA(0, 1), cA + hstep, voffA);
        if (wr == 1) PG8_BAR;
        PG8_WAIT_V(2); PG8_BAR;
        PG8_STAGE(PG8_SB(1, 0), cB + kstep, voffB); PG8_STAGE(PG8_SA(1, 0), cA + kstep, voffA); PG8_STAGE(PG8_SB(1, 1), cB + hstep + kstep, voffB);
        PG8_WAIT_V(6); PG8_BAR;
    } else {
        PG8_STAGE(PG8_SB(0, 0), cB, voffB); PG8_STAGE(PG8_SA(0, 0), cA, voffA); PG8_STAGE(PG8_SB(0, 1), cB + hstep, voffB); PG8_STAGE(PG8_SA(0, 1), cA + hstep, voffA);
        if (wr == 1) PG8_BAR;
        PG8_WAIT_V(4); PG8_BAR;
        PG8_STAGE(PG8_SB(1, 0), cB + kstep, voffB); PG8_STAGE(PG8_SA(1, 0), cA + kstep, voffA); PG8_STAGE(PG8_SB(1, 1), cB + hstep + kstep, voffB);
        PG8_WAIT_V(6); PG8_BAR;
    }
    for (;;) {
        const bool has_next = S.next(ui + 1, nxt);
        const char* nA = has_next ? (const char*)g.A + (size_t)nxt.pm * tstep : cA; const char* nB = has_next ? (const char*)g.Bt + (size_t)nxt.pn * tstep : cB;
        for (int t = 0; t < nt; t += 2) {
            const bool last = (t == nt - 2);
            const char* a1 = cA + (size_t)(t + 1) * kstep;
            const char* a2 = last ? nA : cA + (size_t)(t + 2) * kstep; const char* b2 = last ? nB : cB + (size_t)(t + 2) * kstep;
            const char* a3 = a2 + kstep; const char* b3 = b2 + kstep;
            if (last && has_next) S.a_ready(nxt);
            if constexpr (SP2) {
            PG8_LDB(B0, 0, 0); PG8_LDB(B1, 0, 1); PG8_SCHED; PG8_LDA(At, 0, 0); PG8_STAGE(PG8_SA(1, 1), a1 + hstep, voffA);
            PG8_WAIT_V(8); PG8_WAIT_L(0); PG8_BAR; PG8_MMA(0, 0, At, B0); PG8_MMA(0, 1, At, B1); PG8_BAR; PG8_SCHED;
            PG8_LDA(At, 0, 1); PG8_STAGE(PG8_SB(0, 0), b2, voffB); PG8_STAGE(PG8_SB(0, 1), b2 + hstep, voffB); PG8_STAGE(PG8_SA(0, 0), a2, voffA);
            PG8_WAIT_V(8); PG8_WAIT_L(0); PG8_BAR; PG8_MMA(1, 0, At, B0); PG8_MMA(1, 1, At, B1); PG8_BAR; PG8_SCHED;
            PG8_LDB(B0, 1, 0); PG8_LDB(B1, 1, 1); PG8_SCHED; PG8_LDA(At, 1, 0); PG8_STAGE(PG8_SA(0, 1), a2 + hstep, voffA);
            PG8_WAIT_V(8); PG8_WAIT_L(0); PG8_BAR; PG8_MMA(0, 0, At, B0); PG8_MMA(0, 1, At, B1); PG8_BAR; PG8_SCHED;
            PG8_LDA(At, 1, 1); PG8_STAGE(PG8_SB(1, 0), b3, voffB); PG8_STAGE(PG8_SB(1, 1), b3 + hstep, voffB); PG8_STAGE(PG8_SA(1, 0), a3, voffA);
            PG8_WAIT_V(8); PG8_WAIT_L(0); PG8_BAR; PG8_MMA(1, 0, At, B0); PG8_MMA(1, 1, At, B1); PG8_BAR; PG8_SCHED;
            } else {
            PG8_LDB(B0, 0, 0); PG8_SCHED; PG8_LDA(At, 0, 0); PG8_STAGE(PG8_SA(1, 1), a1 + hstep, voffA);
            PG8_WAIT_L(8); PG8_BAR; PG8_WAIT_L(0); PG8_MMA(0, 0, At, B0); PG8_BAR; PG8_SCHED;
            PG8_LDB(B1, 0, 1); PG8_STAGE(PG8_SB(0, 0), b2, voffB);
            PG8_BAR; PG8_WAIT_L(0); PG8_MMA(0, 1, At, B1); PG8_BAR;
            PG8_LDA(At, 0, 1); PG8_STAGE(PG8_SA(0, 0), a2, voffA);
            PG8_BAR; PG8_WAIT_L(0); PG8_MMA(1, 0, At, B0); PG8_BAR; PG8_SCHED;
            PG8_STAGE(PG8_SB(0, 1), b2 + hstep, voffB);
            PG8_WAIT_V(6); PG8_BAR; PG8_MMA(1, 1, At, B1); PG8_BAR;
            PG8_LDB(B0, 1, 0); PG8_SCHED; PG8_LDA(At, 1, 0); PG8_STAGE(PG8_SA(0, 1), a2 + hstep, voffA);
            PG8_WAIT_L(8); PG8_BAR; PG8_WAIT_L(0); PG8_MMA(0, 0, At, B0); PG8_BAR; PG8_SCHED;
            PG8_LDB(B1, 1, 1); PG8_STAGE(PG8_SB(1, 0), b3, voffB);
            PG8_BAR; PG8_WAIT_L(0); PG8_MMA(0, 1, At, B1); PG8_BAR;
            PG8_LDA(At, 1, 1); PG8_STAGE(PG8_SA(1, 0), a3, voffA);
            PG8_BAR; PG8_WAIT_L(0); PG8_MMA(1, 0, At, B0); PG8_BAR; PG8_SCHED;
            PG8_STAGE(PG8_SB(1, 1), b3 + hstep, voffB);
            PG8_WAIT_V(6); PG8_BAR; PG8_MMA(1, 1, At, B1); PG8_BAR;
            }
        }
        if constexpr (ALIGN_EPI) { if (wr == 0) PG8_BAR; }
        if constexpr (!Epi::AFTER_DRAIN) { E(acc, cur, wr, wc, fr, fq); S.done(cur); }
        if (!has_next) break;
#pragma unroll
        for (int a = 0; a < 2; ++a)
#pragma unroll
            for (int b = 0; b < 2; ++b)
#pragma unroll
                for (int m = 0; m < 4; ++m)
#pragma unroll
                    for (int n = 0; n < 2; ++n) acc[a][b][m][n] = (f32x4){0.f, 0.f, 0.f, 0.f};
        cur = nxt; cA = nA; cB = nB; ++ui;
        if constexpr (ALIGN_EPI) { if (wr == 1) PG8_BAR; }
    }
    PG8_WAIT_V(0);
    if constexpr (!ALIGN_EPI) { if (wr == 0) PG8_BAR; }
    PG8_BAR;
    if constexpr (Epi::AFTER_DRAIN) { E.fused(acc, cur, wr, wc, fr, fq, lds, wid, lane); S.done(cur); }
#undef PG8_SA
#undef PG8_SB
#undef PG8_STAGE
#undef PG8_LDA
#undef PG8_LDB
#undef PG8_MMA
#undef PG8_WAIT_V
#undef PG8_WAIT_L
#undef PG8_BAR
#undef PG8_SCHED
}
}
#define GAS __attribute__((address_space(1)))
#define LAS __attribute__((address_space(3)))
typedef unsigned short bf16;
typedef unsigned v4u __attribute__((ext_vector_type(4)));
typedef unsigned v2u __attribute__((ext_vector_type(2)));
typedef float f32x4 __attribute__((ext_vector_type(4)));
typedef short bf16x8 __attribute__((ext_vector_type(8)));
#define LDS_WAIT() asm volatile("s_waitcnt lgkmcnt(0)" ::: "memory")
#define VM_WAIT() asm volatile("s_waitcnt vmcnt(0)" ::: "memory")

constexpr int DM = 2048, NB = 4, SEQ = 2048, NMETA = 16, MROWS = NB * SEQ, DPROJ = 6152, NPROJ = 6144;
constexpr int PADT = 2112, POS0 = 64, MPOS0 = 48;
constexpr float EPS = 1e-6f;
constexpr float LOG2E = 1.4426950408889634f;
constexpr float QSCALE = 0.08838834764831845f * LOG2E;
constexpr int NWAVES = 8, NTHR = 512;

constexpr size_t MiB = 1u << 20;
constexpr size_t WS_CTL = 0, CTL_ZERO_BYTES = 32 * 1024;
constexpr size_t WS_PM = 484 * MiB;
constexpr size_t WS_W1T = 2 * MiB, WS_W2T = 26 * MiB, WS_W3T = 34 * MiB, WS_XN = 42 * MiB;
constexpr size_t WS_Q = 74 * MiB, WS_KP = 90 * MiB, WS_VP = 107 * MiB, WS_MQ = 124 * MiB, WS_MK = 133 * MiB, WS_MV = 142 * MiB, WS_MO = 159 * MiB;
constexpr size_t WS_SMALL = 175 * MiB;
constexpr size_t WS_XM = WS_SMALL, WS_LI = WS_SMALL + 128 * 1024, WS_LF = WS_SMALL + 384 * 1024, WS_LAM = WS_SMALL + 640 * 1024;
constexpr size_t WS_PO = 176 * MiB, WS_ML = 304 * MiB, WS_HM = 305 * MiB, WS_A2 = 42 * MiB, WS_H1B = 74 * MiB, WS_SSQ = 106 * MiB, WS_S = 176 * MiB, WS_UB = 384 * MiB, WS_VB = 448 * MiB;
constexpr size_t WS_SCL = WS_SMALL + 704 * 1024;
constexpr size_t WS_VB8 = WS_UB + 32 * MiB;
constexpr size_t WS_DC = 305 * MiB, WS_CS = 448 * MiB, WS_DN = 482 * MiB, WS_NS = WS_DN + 512 * 1024, WS_GS = WS_DN + 1024 * 1024, WS_MS = WS_DN + 1152 * 1024;
constexpr size_t WS_EID = 240 * MiB, WS_EGT = 244 * MiB;
constexpr int CW_BAR = 4096;

constexpr int RING_OFF = 0, RING_BYTES = 131072;
constexpr int XCH_OFF = 131072;
constexpr int MISC_OFF = XCH_OFF + 8192;
constexpr int LDS_BYTES = 155648;

__device__ __forceinline__ unsigned f2bf(float f) { unsigned u = __builtin_bit_cast(unsigned, f); return (u + 0x7fffu + ((u >> 16) & 1u)) >> 16; }
__device__ __forceinline__ unsigned pk2(float lo, float hi) { return f2bf(lo) | (f2bf(hi) << 16); }
__device__ __forceinline__ float bf2f(unsigned short u) { return __builtin_bit_cast(float, (unsigned)u << 16); }
__device__ __forceinline__ float bflo(unsigned w) { return __builtin_bit_cast(float, w << 16); }
__device__ __forceinline__ float bfhi(unsigned w) { return __builtin_bit_cast(float, w & 0xffff0000u); }
__device__ __forceinline__ float wave_sum(float v) {
#pragma unroll
  for (int o = 1; o < 64; o <<= 1) v += __shfl_xor(v, o);
  return v;
}
__device__ __forceinline__ size_t kp_off(int bhm, int pos, int d) { const int j = pos >> 6, row = pos & 63, d0 = d >> 4, hi = (d >> 3) & 1;
  return ((size_t)(bhm * 33 + j) * 8 + d0) * 1024 + (size_t)((((row << 1) | hi) ^ ((row >> 3) & 1)) << 3) + (d & 7); }
__device__ __forceinline__ float wave_sum_dpp(float v) {
  v += __builtin_bit_cast(float, __builtin_amdgcn_update_dpp(0, __builtin_bit_cast(int, v), 0xB1, 0xF, 0xF, true));
  v += __builtin_bit_cast(float, __builtin_amdgcn_update_dpp(0, __builtin_bit_cast(int, v), 0x4E, 0xF, 0xF, true));
  v += __builtin_bit_cast(float, __builtin_amdgcn_update_dpp(0, __builtin_bit_cast(int, v), 0x141, 0xF, 0xF, true));
  v += __builtin_bit_cast(float, __builtin_amdgcn_update_dpp(0, __builtin_bit_cast(int, v), 0x140, 0xF, 0xF, true));
  const float r0 = __builtin_bit_cast(float, __builtin_amdgcn_readlane(__builtin_bit_cast(int, v), 0)), r1 = __builtin_bit_cast(float, __builtin_amdgcn_readlane(__builtin_bit_cast(int, v), 16));
  const float r2 = __builtin_bit_cast(float, __builtin_amdgcn_readlane(__builtin_bit_cast(int, v), 32)), r3 = __builtin_bit_cast(float, __builtin_amdgcn_readlane(__builtin_bit_cast(int, v), 48));
  return (r0 + r1) + (r2 + r3);
}
__device__ __forceinline__ float sigmoidf_(float x) { return 1.0f / (1.0f + __expf(-x)); }
#define XB_TMO      128
#define XB_XCNT(j)  (256  + 64 * (j))
#define XB_XSUB(j)  (1280 + 64 * (j))
#define XB_XGEN(j)  (2304 + 64 * (j))
#define XB_TOP      3328
#define XB_TOPGEN   3392
#define XCD_BAR_WORDS 3456
#define XB_SPIN_CAP (1u << 18)

__device__ __forceinline__ unsigned xb_ld(unsigned* p)              { return __hip_atomic_load(p, __ATOMIC_RELAXED, __HIP_MEMORY_SCOPE_AGENT); }
__device__ __forceinline__ unsigned xb_add(unsigned* p, unsigned v) { return __hip_atomic_fetch_add(p, v, __ATOMIC_RELAXED, __HIP_MEMORY_SCOPE_AGENT); }
__device__ __forceinline__ unsigned xb_xcc_id() { return (unsigned)__builtin_amdgcn_s_getreg((3 << 11) | 20) & 0xFu; }
#define XB_SPIN(cond, bar) do { unsigned _sp = 0; while (cond) { __builtin_amdgcn_s_sleep(1); \
    if ((++_sp & 255u) == 0u) { if (xb_ld(&(bar)[XB_TMO])) break; if (_sp > XB_SPIN_CAP) { atomicAdd(&(bar)[XB_TMO], 1u); break; } } } } while (0)

struct XcdBarrier {
    unsigned* bar; unsigned x;
    volatile LAS unsigned* st;
};

__device__ __forceinline__ XcdBarrier xcd_barrier_post(unsigned* bar, volatile LAS unsigned* st) {
    XcdBarrier b; b.bar = bar; b.x = xb_xcc_id(); b.st = st;
    if (threadIdx.x == 0) (void)xb_add(&bar[XB_XCNT(b.x)], 1u);
    return b;
}
__device__ __forceinline__ void xcd_barrier_complete(unsigned* bar, unsigned x, unsigned& nloc, unsigned& nx) {
    const unsigned G = gridDim.x * gridDim.y * gridDim.z;
    unsigned sum, cnt, mine, sp = 0u;
    for (;;) {
        sum = 0u; cnt = 0u; mine = 0u;
#pragma unroll
        for (unsigned j = 0; j < 16; ++j) { const unsigned c = xb_ld(&bar[XB_XCNT(j)]); sum += c; cnt += (c > 0u) ? 1u : 0u; mine = (j == x) ? c : mine; }
        if (sum == G) break;
        __builtin_amdgcn_s_sleep(1);
        if ((++sp & 255u) == 0u) { if (xb_ld(&bar[XB_TMO])) break; if (sp > XB_SPIN_CAP) { atomicAdd(&bar[XB_TMO], 1u); break; } }
    }
    nloc = mine > 0u ? mine : 1u; nx = cnt > 0u ? cnt : 1u;
}

__device__ __forceinline__ void xcd_barrier(const XcdBarrier& b) {
    asm volatile("s_waitcnt vmcnt(0)" ::: "memory");
    __syncthreads();
    if (threadIdx.x == 0) {
        unsigned* bar = b.bar;
        __builtin_amdgcn_s_waitcnt(0);
        unsigned nloc = b.st[0], nx = b.st[1];
        if (nloc == 0u) { xcd_barrier_complete(bar, b.x, nloc, nx); b.st[0] = nloc; b.st[1] = nx; }
        const unsigned old = xb_add(&bar[XB_XSUB(b.x)], 1u);
        const unsigned gen = old / nloc;
        if (old + 1u == (gen + 1u) * nloc) {
            __builtin_amdgcn_fence(__ATOMIC_RELEASE, "agent");
            asm volatile("s_waitcnt vmcnt(0)" ::: "memory");
            const unsigned og = xb_add(&bar[XB_TOP], 1u);
            const unsigned tg = og / nx;
            if (og + 1u == (tg + 1u) * nx) xb_add(&bar[XB_TOPGEN], 1u);
            else XB_SPIN(xb_ld(&bar[XB_TOPGEN]) == tg, bar);
            __builtin_amdgcn_fence(__ATOMIC_ACQUIRE, "agent");
            xb_add(&bar[XB_XGEN(b.x)], 1u);
            asm volatile("s_waitcnt vmcnt(0)" ::: "memory");
        } else {
            XB_SPIN(xb_ld(&bar[XB_XGEN(b.x)]) == gen, bar);
            __builtin_amdgcn_fence(__ATOMIC_ACQUIRE, "agent");
            asm volatile("s_waitcnt vmcnt(0)" ::: "memory");
        }
    }
    __syncthreads();
}

struct Args { const float* in[22]; float* out; unsigned char* ws; int ph_lo, ph_hi, na, pad; };
struct Frame {
  LAS unsigned char* lds; unsigned char* ws; int tid, lane, wave; const float* const* in;
};
#define IN_X 0
#define IN_META 1
#define IN_G1 2
#define IN_WIN 3
#define IN_CW 4
#define IN_CB 5
#define IN_IGB 6
#define IN_FGB 7
#define IN_LQ1 8
#define IN_LK1 9
#define IN_LQ2 10
#define IN_LK2 11
#define IN_QNG 12
#define IN_KNG 13
#define IN_SUBG 14
#define IN_OUTG 15
#define IN_WOUT 16
#define IN_G2 17
#define IN_WQ 18
#define IN_SUBK 19
#define IN_U 20
#define IN_V 21

__device__ __forceinline__ void p0_rows(const Frame& F, const Args& a) {
  const float* x = a.in[IN_X]; const float* meta = a.in[IN_META]; const float* g1 = a.in[IN_G1]; const float* w_in = a.in[IN_WIN];
  const float* igb = a.in[IN_IGB]; const float* fgb = a.in[IN_FGB];
  bf16* Xn = (bf16*)(F.ws + WS_XN); bf16* Xm = (bf16*)(F.ws + WS_XM); float* LI = (float*)(F.ws + WS_LI); float* LF = (float*)(F.ws + WS_LF);
  LAS f32x4* wgl = (LAS f32x4*)(F.lds);
  for (int e = F.tid; e < 4096; e += NTHR) {
    const int ln = e & 63, q = e >> 6, half = q & 1, j = (q >> 1) & 3, i = q >> 3;
    const int k = 4 * (i * 64 + ln) + j;
    wgl[e] = *(const f32x4*)(w_in + (size_t)k * DPROJ + NPROJ + 4 * half);
  }
  __syncthreads();
  const int gw = blockIdx.x * NWAVES + F.wave, NGW = gridDim.x * NWAVES, lane = F.lane;
  constexpr int NTASK = MROWS / 2 + NMETA / 2;
  f32x4 xnx[2][8];
  if (gw < NTASK) { const float* sn = (gw >= MROWS / 2 ? meta + (size_t)(gw - MROWS / 2) * 2 * DM : x + (size_t)gw * 2 * DM);
#pragma unroll
    for (int i = 0; i < 8; ++i) { xnx[0][i] = ((const f32x4*)sn)[i * 64 + lane]; xnx[1][i] = ((const f32x4*)(sn + DM))[i * 64 + lane]; } }
  for (int task = gw; task < NTASK; task += NGW) {
    const bool ismeta = task >= MROWS / 2;
    const int r0 = ismeta ? (task - MROWS / 2) * 2 : task * 2;
    f32x4 xv[2][8]; float rs[2];
    { float s0 = 0.f, s1 = 0.f;
#pragma unroll
      for (int i = 0; i < 8; ++i) { xv[0][i] = xnx[0][i]; xv[1][i] = xnx[1][i]; }
      { const int tn = task + NGW; if (tn < NTASK) { const float* sn = (tn >= MROWS / 2 ? meta + (size_t)(tn - MROWS / 2) * 2 * DM : x + (size_t)tn * 2 * DM);
#pragma unroll
          for (int i = 0; i < 8; ++i) { xnx[0][i] = ((const f32x4*)sn)[i * 64 + lane]; xnx[1][i] = ((const f32x4*)(sn + DM))[i * 64 + lane]; } } }
#pragma unroll
      for (int i = 0; i < 8; ++i) { const f32x4 a0 = xv[0][i], a1 = xv[1][i];
        s0 += (a0.x * a0.x + a0.y * a0.y) + (a0.z * a0.z + a0.w * a0.w); s1 += (a1.x * a1.x + a1.y * a1.y) + (a1.z * a1.z + a1.w * a1.w); }
      rs[0] = rsqrtf(wave_sum_dpp(s0) * (1.0f / DM) + EPS); rs[1] = rsqrtf(wave_sum_dpp(s1) * (1.0f / DM) + EPS); }
    float ga[2][8];
#pragma unroll
    for (int rr = 0; rr < 2; ++rr)
#pragma unroll
      for (int g = 0; g < 8; ++g) ga[rr][g] = 0.f;
    bf16* dst0 = (ismeta ? Xm : Xn) + (size_t)r0 * DM;
#pragma unroll
    for (int i = 0; i < 8; ++i) {
      const f32x4 g = ((const f32x4*)g1)[i * 64 + lane];
      f32x4 xn[2];
#pragma unroll
      for (int rr = 0; rr < 2; ++rr) { xn[rr] = xv[rr][i] * g * rs[rr];
        v2u o; o.x = pk2(xn[rr].x, xn[rr].y); o.y = pk2(xn[rr].z, xn[rr].w); ((v2u*)(dst0 + (size_t)rr * DM))[i * 64 + lane] = o; }
#pragma unroll
      for (int j = 0; j < 4; ++j) {
        const f32x4 w0 = wgl[((i * 4 + j) * 2 + 0) * 64 + lane], w1 = wgl[((i * 4 + j) * 2 + 1) * 64 + lane];
#pragma unroll
        for (int rr = 0; rr < 2; ++rr) { const float xs_ = xn[rr][j];
          ga[rr][0] += xs_ * w0.x; ga[rr][1] += xs_ * w0.y; ga[rr][2] += xs_ * w0.z; ga[rr][3] += xs_ * w0.w;
          ga[rr][4] += xs_ * w1.x; ga[rr][5] += xs_ * w1.y; ga[rr][6] += xs_ * w1.z; ga[rr][7] += xs_ * w1.w; }
      }
      __builtin_amdgcn_sched_barrier(0);
    }
#pragma unroll
    for (int rr = 0; rr < 2; ++rr)
#pragma unroll
      for (int g = 0; g < 8; ++g) ga[rr][g] = wave_sum_dpp(ga[rr][g]);
    if (lane < 8) {
      const int rr = lane >> 2, h = lane & 3;
      float gi = 0.f, gf = 0.f;
#pragma unroll
      for (int q = 0; q < 2; ++q)
#pragma unroll
        for (int hh = 0; hh < 4; ++hh) if (q == rr && hh == h) { gi = ga[q][hh]; gf = ga[q][4 + hh]; }
      const float li = gi + igb[h]; const float fx = gf + fgb[h];
      const float lf = fminf(fx, 0.f) - log1pf(__expf(-fabsf(fx)));
      const int R = r0 + rr;
      if (!ismeta) { const int b = R >> 11, t = R & 2047; LI[(b * 4 + h) * PADT + POS0 + t] = li; LF[(b * 4 + h) * PADT + POS0 + t] = lf; }
      else { for (int b = 0; b < NB; ++b) { LI[(b * 4 + h) * PADT + MPOS0 + R] = li; LF[(b * 4 + h) * PADT + MPOS0 + R] = lf; } }
    }
  }
  __syncthreads();
}
template <bool META>
__device__ __forceinline__ void p0_transpose(const Frame& F, const Args& a, const float* W, int ldw, int N, bf16* Wt) {
  LAS float* tl = (LAS float*)(F.lds);
  LAS float* red = (LAS float*)(F.lds + 33792);
  float* PM = (float*)(F.ws + WS_PM);
  const float* meta = a.in[IN_META]; const float* g1 = a.in[IN_G1];
  const int ntn = N / 64, ntask = ntn * 16, fr = F.lane & 15, fq = F.lane >> 4, w = F.wave;
  f32x4 wn[4];
  float am[4], ag[4];
  if ((int)blockIdx.x < ntask) { const int nb = blockIdx.x % ntn, kb = blockIdx.x / ntn;
#pragma unroll
    for (int i = 0; i < 4; ++i) { const int idx = F.tid + NTHR * i, kk = idx >> 4, c4 = idx & 15; wn[i] = *(const f32x4*)(W + (size_t)(kb * 128 + kk) * ldw + nb * 64 + 4 * c4); }
    if (META) {
#pragma unroll
      for (int s_ = 0; s_ < 4; ++s_) { const int k = kb * 128 + 16 * w + 4 * s_ + fq; am[s_] = meta[(size_t)fr * DM + k]; ag[s_] = g1[k]; } } }
  for (int task = blockIdx.x; task < ntask; task += gridDim.x) {
    const int nb = task % ntn, kb = task / ntn, n0 = nb * 64, k0 = kb * 128;
    __syncthreads();
#pragma unroll
    for (int i = 0; i < 4; ++i) { const int idx = F.tid + NTHR * i, kk = idx >> 4, c4 = idx & 15; const f32x4 wv = wn[i];
      LAS float* d = tl + kk * 65 + 4 * c4; d[0] = wv.x; d[1] = wv.y; d[2] = wv.z; d[3] = wv.w; }
    float ac[4];
    if (META) {
#pragma unroll
      for (int s_ = 0; s_ < 4; ++s_) ac[s_] = am[s_] * ag[s_]; }
    { const int tn = task + gridDim.x; if (tn < ntask) { const int nb2 = tn % ntn, kb2 = tn / ntn;
#pragma unroll
        for (int i = 0; i < 4; ++i) { const int idx = F.tid + NTHR * i, kk = idx >> 4, c4 = idx & 15; wn[i] = *(const f32x4*)(W + (size_t)(kb2 * 128 + kk) * ldw + nb2 * 64 + 4 * c4); }
        if (META) {
#pragma unroll
          for (int s_ = 0; s_ < 4; ++s_) { const int k = kb2 * 128 + 16 * w + 4 * s_ + fq; am[s_] = meta[(size_t)fr * DM + k]; ag[s_] = g1[k]; } } } }
    __syncthreads();
    const int n = F.tid >> 3, kc = F.tid & 7;
    const LAS float* s = tl + (kc * 16) * 65 + n;
    v4u o0, o1;
    o0.x = pk2(s[0 * 65], s[1 * 65]); o0.y = pk2(s[2 * 65], s[3 * 65]); o0.z = pk2(s[4 * 65], s[5 * 65]); o0.w = pk2(s[6 * 65], s[7 * 65]);
    o1.x = pk2(s[8 * 65], s[9 * 65]); o1.y = pk2(s[10 * 65], s[11 * 65]); o1.z = pk2(s[12 * 65], s[13 * 65]); o1.w = pk2(s[14 * 65], s[15 * 65]);
    v4u* dp = (v4u*)(Wt + (size_t)(n0 + n) * DM + k0 + kc * 16);
    dp[0] = o0; dp[1] = o1;
    if (META && n0 >= 1024) {
      f32x4 acc[4];
#pragma unroll
      for (int nt = 0; nt < 4; ++nt) acc[nt] = (f32x4){0.f, 0.f, 0.f, 0.f};
#pragma unroll
      for (int s_ = 0; s_ < 4; ++s_)
#pragma unroll
        for (int nt = 0; nt < 4; ++nt) acc[nt] = __builtin_amdgcn_mfma_f32_16x16x4f32(ac[s_], tl[(16 * w + 4 * s_ + fq) * 65 + nt * 16 + fr], acc[nt], 0, 0, 0);
#pragma unroll
      for (int nt = 0; nt < 4; ++nt)
#pragma unroll
        for (int i = 0; i < 4; ++i) red[(w * 16 + 4 * fq + i) * 64 + nt * 16 + fr] = acc[nt][i];
      __syncthreads();
#pragma unroll
      for (int j = 0; j < 2; ++j) { const int idx = F.tid + NTHR * j, m = idx >> 6, nn = idx & 63; const LAS float* r = red + m * 64 + nn;
        PM[((size_t)kb * 16 + m) * NPROJ + n0 + nn] = ((r[0] + r[1024]) + (r[2048] + r[3072])) + ((r[4096] + r[5120]) + (r[6144] + r[7168])); }
    }
  }
  __syncthreads();
}
__device__ __forceinline__ void p0_zero_vpad(const Frame& F) {
  bf16* Vp = (bf16*)(F.ws + WS_VP);
  const int per = MPOS0 * 256 / 8;
  for (int i = blockIdx.x * NTHR + F.tid; i < 16 * per; i += gridDim.x * NTHR) { const int bh = i / per, e = i % per;
    *(v4u*)(Vp + (size_t)bh * PADT * 256 + (size_t)e * 8) = (v4u){0u, 0u, 0u, 0u}; }
}
__device__ __forceinline__ void p0_lam(const Frame& F, const Args& a) {
  if (blockIdx.x == 0 && F.wave == 0) {
    const int l = F.lane;
    float s1 = a.in[IN_LQ1][l] * a.in[IN_LK1][l] + a.in[IN_LQ1][l + 64] * a.in[IN_LK1][l + 64];
    float s2 = a.in[IN_LQ2][l] * a.in[IN_LK2][l] + a.in[IN_LQ2][l + 64] * a.in[IN_LK2][l + 64];
    s1 = wave_sum(s1); s2 = wave_sum(s2);
    if (l == 0) *(float*)(F.ws + WS_LAM) = __expf(s1) - __expf(s2) + 0.2f;
  }
}

struct EpiProj {
  static constexpr bool PERM = true, AFTER_DRAIN = false;
  bf16 *Qb, *Kp, *Vp, *MQ, *MK, *MV, *MO; const float *qg, *kg; LAS float* xch;
  __device__ __forceinline__ void operator()(const pg8::f32x4 (&acc)[2][2][4][2], const pg8::Unit& u, int wr, int wc, int fr, int fq) const {
    const int pn = u.pn, b = u.pm >> 3, tb = (u.pm & 7) * 256 + wr * 64 + fr, d0 = wc * 32 + fq * 8;
    if (pn < 8) {
      const bool isk = pn >= 4; const int h = pn & 3;
      float ssq[2][4][2];
#pragma unroll
      for (int ai = 0; ai < 2; ++ai)
#pragma unroll
        for (int m = 0; m < 4; ++m)
#pragma unroll
          for (int bj = 0; bj < 2; ++bj) { float s = 0.f;
#pragma unroll
            for (int n = 0; n < 2; ++n) { const pg8::f32x4 x = acc[ai][bj][m][n]; s += (x[0] * x[0] + x[1] * x[1]) + (x[2] * x[2] + x[3] * x[3]); }
            s += __shfl_xor(s, 16); s += __shfl_xor(s, 32); ssq[ai][m][bj] = s;
            if (fq == 0) xch[((ai * 128 + wr * 64 + m * 16 + fr) * 2 + bj) * 4 + wc] = s; }
      asm volatile("s_waitcnt lgkmcnt(0)" ::: "memory"); __builtin_amdgcn_s_barrier(); asm volatile("" ::: "memory");
      const float* gp = (isk ? kg : qg) + d0; const f32x4 g0 = *(const f32x4*)gp, g1v = *(const f32x4*)(gp + 4);
      const float sc = isk ? 1.0f : QSCALE;
#pragma unroll
      for (int ai = 0; ai < 2; ++ai)
#pragma unroll
        for (int m = 0; m < 4; ++m)
#pragma unroll
          for (int bj = 0; bj < 2; ++bj) {
            const f32x4 p = *(const LAS f32x4*)(xch + ((ai * 128 + wr * 64 + m * 16 + fr) * 2 + bj) * 4);
            const float rs = rsqrtf(((p.x + p.y) + (p.z + p.w)) * (1.0f / 128.f) + EPS) * sc;
            const pg8::f32x4 v0 = acc[ai][bj][m][0], v1 = acc[ai][bj][m][1];
            v4u w; w.x = pk2(v0[0] * rs * g0.x, v0[1] * rs * g0.y); w.y = pk2(v0[2] * rs * g0.z, v0[3] * rs * g0.w);
            w.z = pk2(v1[0] * rs * g1v.x, v1[1] * rs * g1v.y); w.w = pk2(v1[2] * rs * g1v.z, v1[3] * rs * g1v.w);
            const int t = tb + ai * 128 + m * 16;
            bf16* dst = isk ? Kp + kp_off((b * 4 + h) * 2 + bj, POS0 + t, d0)
                            : Qb + ((size_t)((b * 4 + h) * 2 + bj) * SEQ + t) * 128 + d0;
            *(v4u*)dst = w; }
      return;
    }
#pragma unroll
    for (int ai = 0; ai < 2; ++ai)
#pragma unroll
      for (int m = 0; m < 4; ++m)
#pragma unroll
        for (int bj = 0; bj < 2; ++bj) {
          pg8::f32x4 v0 = acc[ai][bj][m][0], v1 = acc[ai][bj][m][1];
          const int t = tb + ai * 128 + m * 16;
          bf16* dst;
          if (pn < 12) { const int h = pn - 8; dst = Vp + ((size_t)(b * 4 + h) * PADT + POS0 + t) * 256 + bj * 128 + d0; }
          else if (pn < 16) { const int h = 2 * (pn & 1) + bj; dst = (pn >= 14 ? MK : MQ) + ((size_t)(b * 4 + h) * PADT + POS0 + t) * 128 + d0; }
          else if (pn < 20) { const int h = pn - 16; dst = MV + ((size_t)(b * 4 + h) * PADT + POS0 + t) * 256 + bj * 128 + d0; }
          else { dst = MO + (size_t)(b * SEQ + t) * 1024 + (pn - 20) * 256 + bj * 128 + d0;
#pragma unroll
            for (int j = 0; j < 4; ++j) { v0[j] = sigmoidf_(v0[j]); v1[j] = sigmoidf_(v1[j]); } }
          v4u w; w.x = pk2(v0[0], v0[1]); w.y = pk2(v0[2], v0[3]); w.z = pk2(v1[0], v1[1]); w.w = pk2(v1[2], v1[3]);
          *(v4u*)dst = w; }
  }
};
__device__ __forceinline__ void p1_meta_finalize(const Frame& F, const Args& a) {
  if (blockIdx.x >= NMETA) return;
  const int mrow = blockIdx.x, tid = F.tid, lane = F.lane, w = F.wave;
  const float* meta = a.in[IN_META] + (size_t)mrow * DM; const float* PM0 = (const float*)(F.ws + WS_PM) + (size_t)mrow * NPROJ;
#define PM_P4(i, p) ((PM0[(size_t)(16 * (p)) * NPROJ + (i)] + PM0[(size_t)(16 * ((p) + 1)) * NPROJ + (i)]) + (PM0[(size_t)(16 * ((p) + 2)) * NPROJ + (i)] + PM0[(size_t)(16 * ((p) + 3)) * NPROJ + (i)]))
#define PM_AT(i) ((PM_P4(i, 0) + PM_P4(i, 4)) + (PM_P4(i, 8) + PM_P4(i, 12)))
  LAS float* red = (LAS float*)(F.lds + XCH_OFF);
  const f32x4 mv = ((const f32x4*)meta)[tid];
  float s = wave_sum((mv.x * mv.x + mv.y * mv.y) + (mv.z * mv.z + mv.w * mv.w));
  if (lane == 0) red[w] = s;
  __syncthreads();
  float tot = 0.f;
#pragma unroll
  for (int i = 0; i < 8; ++i) tot += red[i];
  const float rs = rsqrtf(tot * (1.0f / DM) + EPS);
  bf16* Kp = (bf16*)(F.ws + WS_KP); bf16* Vp = (bf16*)(F.ws + WS_VP); bf16* MQ = (bf16*)(F.ws + WS_MQ); bf16* MK = (bf16*)(F.ws + WS_MK); bf16* MV = (bf16*)(F.ws + WS_MV);
  const int pos = MPOS0 + mrow;
  {
    const float v0 = PM_AT(1024 + w * 128 + lane) * rs, v1 = PM_AT(1024 + w * 128 + lane + 64) * rs;
    const float rk = rsqrtf(wave_sum(v0 * v0 + v1 * v1) * (1.0f / 128.f) + EPS);
    const float* kg = a.in[IN_KNG];
    const unsigned short o0 = (unsigned short)f2bf(v0 * rk * kg[lane]), o1 = (unsigned short)f2bf(v1 * rk * kg[lane + 64]);
    for (int b = 0; b < NB; ++b) { const int bhm = (b * 4 + (w >> 1)) * 2 + (w & 1); Kp[kp_off(bhm, pos, lane)] = o0; Kp[kp_off(bhm, pos, lane + 64)] = o1; }
  }
  { const int c = tid * 2;
    const unsigned o = pk2(PM_AT(2048 + c) * rs, PM_AT(2048 + c + 1) * rs); const int h = c >> 8, e = c & 255;
    for (int b = 0; b < NB; ++b) *(unsigned*)(Vp + ((size_t)(b * 4 + h) * PADT + pos) * 256 + e) = o;
    const unsigned o2 = pk2(PM_AT(3072 + c) * rs, PM_AT(3072 + c + 1) * rs); const bool isk = c >= 512; const int cc = c & 511, hq = cc >> 7, d = cc & 127;
    for (int b = 0; b < NB; ++b) *(unsigned*)((isk ? MK : MQ) + ((size_t)(b * 4 + hq) * PADT + pos) * 128 + d) = o2;
    const unsigned o3 = pk2(PM_AT(4096 + c) * rs, PM_AT(4096 + c + 1) * rs);
    for (int b = 0; b < NB; ++b) *(unsigned*)(MV + ((size_t)(b * 4 + h) * PADT + pos) * 256 + e) = o3;
  }
  __syncthreads();
}
#undef PM_AT
#undef PM_P4

namespace att {
using f32x16 = __attribute__((ext_vector_type(16))) float;
using s16x4 = __attribute__((ext_vector_type(4))) short;
constexpr int STEPS_BHM = 152, NSTEPS = 32 * STEPS_BHM;
constexpr int SHM_V = 64 * 256 * 2, SHM_K = 64 * 128 * 2;
constexpr int LDS_V = 0, LDS_K = 2 * SHM_V, LDS_Q = LDS_K + SHM_K, LDS_WS = LDS_Q + 8 * 8192;
constexpr float THR2 = 8.0f;
#define KSWZ(row, colB) ((row) * 256 + ((colB) ^ (((row) & 7) << 4)))
#define SBAR() __builtin_amdgcn_sched_barrier(0)
__device__ __forceinline__ int crow(int r, int hi) { return (r & 3) + 8 * (r >> 2) + 4 * hi; }
__device__ __forceinline__ unsigned cvtpk(float lo, float hi) { unsigned r; asm volatile("v_cvt_pk_bf16_f32 %0, %1, %2" : "=v"(r) : "v"(lo), "v"(hi)); return r; }
__device__ __forceinline__ int qb_start(int qb) { return 2 * qb * qb + 3 * qb; }
__device__ __forceinline__ int chunk_of(int s, int NA) { return ((s + 1) * NA - 1) / NSTEPS; }

template <int OFF> __device__ __forceinline__ s16x4 tr_read(int vb) {
  s16x4 r; asm volatile("ds_read_b64_tr_b16 %0, %1 offset:%2" : "=&v"(r) : "v"(vb), "i"(OFF) : "memory"); return r;
}
constexpr int v_rd_off(int d0, int ks, int half) { return d0 * 512 + ks * 8192 + half * 4096; }
template <int D0> __device__ __forceinline__ void pv_one(f32x16& od, int vb, bf16x8 pa0, bf16x8 pa1, bf16x8 pa2, bf16x8 pa3) {
#define PK(L, H) (bf16x8){L[0], L[1], L[2], L[3], H[0], H[1], H[2], H[3]}
  { const s16x4 l0 = tr_read<v_rd_off(D0, 0, 0)>(vb), h0 = tr_read<v_rd_off(D0, 0, 1)>(vb), l1 = tr_read<v_rd_off(D0, 1, 0)>(vb), h1 = tr_read<v_rd_off(D0, 1, 1)>(vb);
    asm volatile("s_waitcnt lgkmcnt(0)" ::: "memory"); SBAR();
    od = __builtin_amdgcn_mfma_f32_32x32x16_bf16(pa0, PK(l0, h0), od, 0, 0, 0);
    od = __builtin_amdgcn_mfma_f32_32x32x16_bf16(pa1, PK(l1, h1), od, 0, 0, 0); }
  SBAR();
  { const s16x4 l2 = tr_read<v_rd_off(D0, 2, 0)>(vb), h2 = tr_read<v_rd_off(D0, 2, 1)>(vb), l3 = tr_read<v_rd_off(D0, 3, 0)>(vb), h3 = tr_read<v_rd_off(D0, 3, 1)>(vb);
    asm volatile("s_waitcnt lgkmcnt(0)" ::: "memory"); SBAR();
    od = __builtin_amdgcn_mfma_f32_32x32x16_bf16(pa2, PK(l2, h2), od, 0, 0, 0);
    od = __builtin_amdgcn_mfma_f32_32x32x16_bf16(pa3, PK(l3, h3), od, 0, 0, 0); }
#undef PK
}

__device__ __forceinline__ void segment(const Frame& F, int bhm, int qb, int j0, int j1, int slot) {
  const int tid = F.tid, wid = F.wave, lane = F.lane, r32 = lane & 31, hi = lane >> 5;
  const bf16* Qg = (const bf16*)(F.ws + WS_Q) + ((size_t)bhm * SEQ + qb * 256 + wid * 32 + r32) * 128 + hi * 8;
  const bf16* Kg = (const bf16*)(F.ws + WS_KP) + (size_t)bhm * 33 * 8192;
  const bf16* Vg = (const bf16*)(F.ws + WS_VP) + (size_t)(bhm >> 1) * PADT * 256;
  LAS unsigned char* lds = F.lds;
  LAS float* wsl = (LAS float*)(lds + LDS_WS) + wid * 64;
  const float slope2 = exp2f(-2.0f * (float)(((bhm >> 1) & 3) + 1)) * LOG2E;
  unsigned ksrc0, vsrc0;
  ksrc0 = (unsigned)tid * 16u;
  { const int a8 = tid >> 8, b = (tid >> 2) & 7, k = 8 * (b >> 2) + 4 * a8 + (b & 3), c = ((tid >> 5) & 7) * 32 + (tid & 3) * 8; vsrc0 = (unsigned)(k * 256 + c) * 2u; }
#define STAGE_K(j) do { const char* kt = (const char*)(Kg + (size_t)(j) * 8192); \
    _Pragma("unroll") for (int _i = 0; _i < 2; ++_i) __builtin_amdgcn_global_load_lds((const unsigned*)(kt + (ksrc0 + _i * 8192u)), (LAS unsigned*)(lds + LDS_K + _i * 8192 + wid * 1024), 16, 0, 0); } while (0)
#define STAGE_V(buf, j) do { const char* vt = (const char*)(Vg + (size_t)(j) * 64 * 256); \
    _Pragma("unroll") for (int _i = 0; _i < 4; ++_i) __builtin_amdgcn_global_load_lds((const unsigned*)(vt + (vsrc0 + _i * 8192u)), (LAS unsigned*)(lds + LDS_V + (buf) * SHM_V + _i * 8192 + wid * 1024), 16, 0, 0); } while (0)
  const int lt = (((r32 << 1) | hi) ^ ((r32 >> 3) & 1)) << 4;
  LAS unsigned char* Qs = lds + LDS_Q + wid * 8192;
#pragma unroll
  for (int d0 = 0; d0 < 8; ++d0) { const bf16x8 qv = *(const bf16x8*)(Qg + d0 * 16); *(LAS bf16x8*)(Qs + d0 * 1024 + lt) = qv; }
  f32x16 o[8];
#pragma unroll
  for (int d = 0; d < 8; ++d)
#pragma unroll
    for (int r = 0; r < 16; ++r) o[d][r] = 0.f;
  float m_reg = -1e30f, l_reg = 0.f;
  const int vb0 = (int)(uintptr_t)(lds + LDS_V) + (((lane & 3) << 3) | (((lane >> 2) & 3) << 6) | (((lane >> 4) & 1) << 5) | (((lane >> 5) & 1) << 8));
  STAGE_K(j0); STAGE_V(0, j0);
  VM_WAIT(); __syncthreads();
  for (int j = j0; j < j1; ++j) {
    const int cur = (j - j0) & 1;
    if (j + 1 < j1) STAGE_V(cur ^ 1, j + 1);
    SBAR();
    f32x16 p0 = {}, p1 = {};
    { const LAS unsigned char* Ks = lds + LDS_K;
#pragma unroll
      for (int d0 = 0; d0 < 8; ++d0) {
        const bf16x8 b0 = *(const LAS bf16x8*)(Ks + d0 * 2048 + lt);
        const bf16x8 b1 = *(const LAS bf16x8*)(Ks + d0 * 2048 + 1024 + lt);
        const bf16x8 qf = *(const LAS bf16x8*)(Qs + d0 * 1024 + lt);
        p0 = __builtin_amdgcn_mfma_f32_32x32x16_bf16(b0, qf, p0, 0, 0, 0);
        p1 = __builtin_amdgcn_mfma_f32_32x32x16_bf16(b1, qf, p1, 0, 0, 0); } }
    asm volatile("s_waitcnt lgkmcnt(0)" ::: "memory"); __builtin_amdgcn_s_barrier(); asm volatile("" ::: "memory");
    if (j + 1 < j1) STAGE_K(j + 1);
    SBAR();
    if (j == 0) {
#pragma unroll
      for (int r = 0; r < 16; ++r) p0[r] = -INFINITY;
#pragma unroll
      for (int r = 0; r < 8; ++r) p1[r] = -INFINITY;
    }
    int ln2 = threadIdx.x & 63; asm volatile("" : "+v"(ln2));
    const int hi2 = ln2 >> 5;
    const int jb = j - (4 * qb + 1);
    if (jb >= 0) {
      const int kb = 64 * jb + 4 * hi2, qrel = wid * 32 + (ln2 & 31);
#pragma unroll
      for (int r = 0; r < 16; ++r) { const int kv = kb + (r & 3) + 8 * (r >> 2); if (kv > qrel) p0[r] = -INFINITY; if (kv + 32 > qrel) p1[r] = -INFINITY; }
    }
    const float off0 = slope2 * (float)(64 * j + 4 * hi2), off1 = off0 + 32.0f * slope2;
#pragma unroll
    for (int r = 0; r < 16; ++r) { const float sb = slope2 * (float)((r & 3) + 8 * (r >> 2)); p0[r] += sb; p1[r] += sb; }
    float pm0 = p0[0], pm1 = p1[0];
#pragma unroll
    for (int r = 1; r < 16; ++r) { pm0 = fmaxf(pm0, p0[r]); pm1 = fmaxf(pm1, p1[r]); }
    float pmax = fmaxf(pm0 + off0, pm1 + off1);
    { auto rr = __builtin_amdgcn_permlane32_swap(__float_as_uint(pmax), __float_as_uint(pmax), false, false);
      pmax = fmaxf(__uint_as_float(rr[0]), __uint_as_float(rr[1])); }
    float mn, alpha;
    if (__builtin_expect(__all(pmax - m_reg <= THR2), 1)) { mn = m_reg; alpha = 1.f; }
    else { mn = fmaxf(m_reg, pmax); alpha = __builtin_amdgcn_exp2f(m_reg - mn); m_reg = mn; }
    const float c0 = off0 - mn, c1 = off1 - mn;
    float ps = 0.f;
#pragma unroll
    for (int r = 0; r < 16; ++r) { p0[r] = __builtin_amdgcn_exp2f(p0[r] + c0); p1[r] = __builtin_amdgcn_exp2f(p1[r] + c1); ps += p0[r] + p1[r]; }
    { auto rr = __builtin_amdgcn_permlane32_swap(__float_as_uint(ps), __float_as_uint(ps), false, false);
      ps = __uint_as_float(rr[0]) + __uint_as_float(rr[1]); }
    l_reg = l_reg * alpha + ps;
    if (__any(alpha < 1.f)) { if (hi == 0) wsl[r32] = alpha; asm volatile("s_waitcnt lgkmcnt(0)" ::: "memory");
#pragma unroll
      for (int rg = 0; rg < 4; ++rg) { const f32x4 al = *(const LAS f32x4*)(wsl + 8 * rg + 4 * hi);
#pragma unroll
        for (int d = 0; d < 8; ++d) { o[d][4 * rg + 0] *= al.x; o[d][4 * rg + 1] *= al.y; o[d][4 * rg + 2] *= al.z; o[d][4 * rg + 3] *= al.w; }
        SBAR(); } }
    bf16x8 pa0, pa1, pa2, pa3;
#define PK4(P, BASE, OUT) do { unsigned a0 = cvtpk(P[BASE + 0], P[BASE + 1]), a1 = cvtpk(P[BASE + 2], P[BASE + 3]);   \
    unsigned b0 = cvtpk(P[BASE + 4], P[BASE + 5]), b1 = cvtpk(P[BASE + 6], P[BASE + 7]);                              \
    auto r0 = __builtin_amdgcn_permlane32_swap(a0, b0, false, false); auto r1 = __builtin_amdgcn_permlane32_swap(a1, b1, false, false); \
    v4u w = {r0[0], r1[0], r0[1], r1[1]}; OUT = *reinterpret_cast<bf16x8*>(&w); } while (0)
    PK4(p0, 0, pa0); PK4(p0, 8, pa1); PK4(p1, 0, pa2); PK4(p1, 8, pa3);
#undef PK4
    SBAR();
    { const int vb = vb0 + cur * SHM_V;
      pv_one<0>(o[0], vb, pa0, pa1, pa2, pa3); pv_one<1>(o[1], vb, pa0, pa1, pa2, pa3); pv_one<2>(o[2], vb, pa0, pa1, pa2, pa3); pv_one<3>(o[3], vb, pa0, pa1, pa2, pa3);
      pv_one<4>(o[4], vb, pa0, pa1, pa2, pa3); pv_one<5>(o[5], vb, pa0, pa1, pa2, pa3); pv_one<6>(o[6], vb, pa0, pa1, pa2, pa3); pv_one<7>(o[7], vb, pa0, pa1, pa2, pa3); }
    VM_WAIT(); __syncthreads();
  }
  { int lane2 = threadIdx.x & 63, slot2 = slot; asm volatile("" : "+v"(lane2), "+s"(slot2));
    const int r32e = lane2 & 31, hie = lane2 >> 5;
    float* PO = (float*)(F.ws + WS_PO) + (size_t)slot2 * 256 * 256; float* ML = (float*)(F.ws + WS_ML) + (size_t)slot2 * 512;
    LAS float* wse = (LAS float*)(F.lds + LDS_WS) + wid * 64;
    if (hie == 0) { wse[r32e] = l_reg; ML[(wid * 32 + r32e) * 2] = m_reg; ML[(wid * 32 + r32e) * 2 + 1] = l_reg; }
    asm volatile("s_waitcnt lgkmcnt(0)" ::: "memory");
    char* Ob = (char*)(PO + (size_t)(wid * 32) * 256);
    const unsigned lo = (unsigned)(4 * hie * 256 + r32e) * 4u;
#pragma unroll
    for (int r = 0; r < 16; ++r) { const int rowc = (r & 3) + 8 * (r >> 2); const float lv = wse[rowc + 4 * hie]; const float rl = lv > 0.f ? __builtin_amdgcn_rcpf(lv) : 0.f;
#pragma unroll
      for (int d0 = 0; d0 < 8; ++d0) *(float*)(Ob + (lo + (unsigned)(rowc * 256 + d0 * 32) * 4u)) = o[d0][r] * rl;
      SBAR(); } }
  __syncthreads();
#undef STAGE_K
#undef STAGE_V
}

__device__ __forceinline__ void phase(const Frame& F, int ca, int NA) {
  int s0 = (int)(((long)ca * NSTEPS) / NA); const int s1 = (int)(((long)(ca + 1) * NSTEPS) / NA);
  while (s0 < s1) {
    const int bhm = s0 / STEPS_BHM, rem = s0 - bhm * STEPS_BHM;
    int qb = 0;
#pragma unroll 1
    for (int q = 1; q < 8; ++q) if (rem >= qb_start(q)) qb = q;
    const int j0 = rem - qb_start(qb), nst = 4 * qb + 5;
    const int j1 = (j0 + (s1 - s0) < nst) ? j0 + (s1 - s0) : nst;
    const int slot = bhm * 16 + qb + chunk_of(s0, NA) - chunk_of(bhm * STEPS_BHM, NA);
    segment(F, bhm, qb, j0, j1, slot);
    s0 += j1 - j0;
  }
}
#undef KSWZ
#undef SBAR
}
namespace ml {
constexpr int QST = 136, TST = 72;
constexpr int L_RQ = 0, L_RK = 17152, L_QS = 34304, L_QW = 51712, L_KS = 69120, L_KWT = 86528, L_VT = 104960  , L_SP = 0  , L_G = 141824, L_CW = 143872;
constexpr int L_HT = 0;
constexpr int G_A = 0, G_M = 64, G_WI = 128, G_EM = 192, G_DEN = 256, G_WG = 320, G_SC = 384, G_N = 0;
constexpr int L_NV = L_CW + 5120;
constexpr int L_SSQ = L_KWT;
__device__ __forceinline__ float shfl_up_f(float v, int d) { return __shfl_up(v, d); }

__device__ __forceinline__ void load_cw(const Frame& F, const Args& a, int h) {
  LAS float* CW = (LAS float*)(F.lds + L_CW);
  for (int e = F.tid; e < 2 * 5 * 128; e += NTHR) { const int qk = e / 640, j = (e / 128) % 5, d = e & 127; const int ch = qk * 512 + h * 128 + d;
    CW[e] = j < 4 ? a.in[IN_CW][j * 1024 + ch] : a.in[IN_CB][ch]; }
}
__device__ __forceinline__ void load_raw(const Frame& F, const bf16* g, int pos0, int lds_off) {
  for (int p = F.tid; p < 67 * 16; p += NTHR) { const int row = p >> 4, ch = p & 15, pos = pos0 - 3 + row;
    v4u v = {0u, 0u, 0u, 0u}; if (pos >= MPOS0) v = *(const v4u*)(g + (size_t)pos * 128 + ch * 8);
    *(LAS v4u*)(F.lds + lds_off + row * 256 + ch * 16) = v; }
}
__device__ __forceinline__ void conv16(const Frame& F, int qk, int lds_off, int t, int d0, float (&y)[16]) {
  const LAS float* CW = (const LAS float*)(F.lds + L_CW);
#pragma unroll
  for (int e = 0; e < 16; ++e) y[e] = CW[(qk * 5 + 4) * 128 + d0 + e];
#pragma unroll
  for (int j = 0; j < 4; ++j) { const LAS v4u* rp = (const LAS v4u*)(F.lds + lds_off + (t + j) * 256 + d0 * 2); const v4u r0 = rp[0], r1 = rp[1];
    const LAS float* cw = CW + (qk * 5 + j) * 128 + d0;
    y[0] += cw[0] * bflo(r0.x); y[1] += cw[1] * bfhi(r0.x); y[2] += cw[2] * bflo(r0.y); y[3] += cw[3] * bfhi(r0.y); y[4] += cw[4] * bflo(r0.z); y[5] += cw[5] * bfhi(r0.z); y[6] += cw[6] * bflo(r0.w); y[7] += cw[7] * bfhi(r0.w);
    y[8] += cw[8] * bflo(r1.x); y[9] += cw[9] * bfhi(r1.x); y[10] += cw[10] * bflo(r1.y); y[11] += cw[11] * bfhi(r1.y); y[12] += cw[12] * bflo(r1.z); y[13] += cw[13] * bfhi(r1.z); y[14] += cw[14] * bflo(r1.w); y[15] += cw[15] * bfhi(r1.w); }
#pragma unroll
  for (int e = 0; e < 16; ++e) y[e] = y[e] / (1.0f + __expf(-y[e]));
}
__device__ __forceinline__ void load_vt(const Frame& F, const bf16* MVg, int pos0) {
#pragma unroll
  for (int i = 0; i < 4; ++i) { const int p = F.tid + NTHR * i, row = p >> 5, ch = p & 31; v4u v4 = {0u, 0u, 0u, 0u};
    if (pos0 + row >= MPOS0) v4 = *(const v4u*)(MVg + (size_t)(pos0 + row) * 256 + ch * 8);
    LAS bf16* vt = (LAS bf16*)(F.lds + L_VT) + (ch * 8) * TST + row;
    vt[0 * TST] = (bf16)(v4.x & 0xffff); vt[1 * TST] = (bf16)(v4.x >> 16); vt[2 * TST] = (bf16)(v4.y & 0xffff); vt[3 * TST] = (bf16)(v4.y >> 16);
    vt[4 * TST] = (bf16)(v4.z & 0xffff); vt[5 * TST] = (bf16)(v4.z >> 16); vt[6 * TST] = (bf16)(v4.w & 0xffff); vt[7 * TST] = (bf16)(v4.w >> 16); }
}

__device__ __forceinline__ void taskA(const Frame& F, const Args& a, int task) {
  const int bh = task >> 5, c = task & 31, h = bh & 3, tid = F.tid, w = F.wave, lane = F.lane, fr = lane & 15, kq = lane >> 4, pos0 = 64 * c;
  LAS unsigned char* lds = F.lds; LAS float* G = (LAS float*)(lds + L_G);
  const bf16* MKg = (const bf16*)(F.ws + WS_MK) + (size_t)bh * PADT * 128; const bf16* MVg = (const bf16*)(F.ws + WS_MV) + (size_t)bh * PADT * 256;
  __syncthreads();
  load_cw(F, a, h); load_raw(F, MKg, pos0, L_RK); load_vt(F, MVg, pos0);
  if (w == 0) {
    const bool dead = pos0 + lane < MPOS0;
    const float li = dead ? -1e30f : ((const float*)(F.ws + WS_LI))[bh * PADT + pos0 + lane], lf = dead ? 0.f : ((const float*)(F.ws + WS_LF))[bh * PADT + pos0 + lane];
    float bs = lf;
#pragma unroll
    for (int d = 1; d < 64; d <<= 1) { const float o = shfl_up_f(bs, d); if (lane >= d) bs += o; }
    const float av = li - bs; float mx = av;
#pragma unroll
    for (int o = 1; o < 64; o <<= 1) mx = fmaxf(mx, __shfl_xor(mx, o));
    G[G_WG + lane] = __expf(av - mx);
    if (lane == 63) { float* gs = (float*)(F.ws + WS_GS) + (size_t)(bh * 33 + c) * 2; gs[0] = bs; gs[1] = mx; }
  }
  __syncthreads();
  { const int t = tid >> 3, d0 = (tid & 7) * 16; float y[16]; conv16(F, 1, L_RK, t, d0, y);
    const float sw = 0.08838834764831845f * G[G_WG + t]; LAS bf16* kt = (LAS bf16*)(lds + L_KWT) + d0 * TST + t;
#pragma unroll
    for (int e = 0; e < 16; ++e) kt[e * TST] = (bf16)f2bf(y[e] * sw); }
  __syncthreads();
  f32x4* DCg = (f32x4*)(F.ws + WS_DC) + ((size_t)(bh * 32 + c) * 128) * 64;
#pragma unroll
  for (int jj = 0; jj < 2; ++jj) { const int j = 2 * w + jj;
    const bf16x8 bv0 = *(const LAS bf16x8*)(lds + L_VT + ((16 * j + fr) * TST + 8 * kq) * 2), bv1 = *(const LAS bf16x8*)(lds + L_VT + ((16 * j + fr) * TST + 32 + 8 * kq) * 2);
#pragma unroll
    for (int i = 0; i < 8; ++i) { f32x4 acc = {0.f, 0.f, 0.f, 0.f};
      const bf16x8 k0 = *(const LAS bf16x8*)(lds + L_KWT + ((16 * i + fr) * TST + 8 * kq) * 2), k1 = *(const LAS bf16x8*)(lds + L_KWT + ((16 * i + fr) * TST + 32 + 8 * kq) * 2);
      acc = __builtin_amdgcn_mfma_f32_16x16x32_bf16(k0, bv0, acc, 0, 0, 0); acc = __builtin_amdgcn_mfma_f32_16x16x32_bf16(k1, bv1, acc, 0, 0, 0);
      DCg[(size_t)(i * 16 + j) * 64 + lane] = acc; } }
  if (tid < 128) { const LAS v4u* kr = (const LAS v4u*)(lds + L_KWT + tid * TST * 2); float s = 0.f;
#pragma unroll
    for (int q = 0; q < 8; ++q) { const v4u x = kr[q]; s += (bflo(x.x) + bfhi(x.x)) + (bflo(x.y) + bfhi(x.y)) + (bflo(x.z) + bfhi(x.z)) + (bflo(x.w) + bfhi(x.w)); }
    ((float*)(F.ws + WS_DN))[(size_t)(bh * 32 + c) * 128 + tid] = s; }
}

__device__ __forceinline__ void scanB(const Frame& F) {
  const float* GS = (const float*)(F.ws + WS_GS);
  LAS float* cf = (LAS float*)F.lds;
  for (int blk = blockIdx.x; blk < 16 * 8; blk += gridDim.x) { const int bh = blk >> 3, r = (blk & 7) * NTHR + F.tid, I = r >> 10, j = (r >> 6) & 15, ln = r & 63;
    __syncthreads();
    if (F.tid == 0) { float m = 0.f; for (int c = 0; c < 32; ++c) { const float bL = GS[(bh * 33 + c) * 2], ml = GS[(bh * 33 + c) * 2 + 1], me = fmaxf(m, ml);
        cf[2 * c] = __expf(m - me); cf[2 * c + 1] = __expf(ml - me); m = bL + me; } }
    __syncthreads();
    const f32x4* dc0 = (const f32x4*)(F.ws + WS_DC) + ((size_t)(bh * 32) * 128 + ((2 * I) * 16 + j)) * 64 + ln;
    const f32x4* dc1 = dc0 + 16 * 64;
    v4u* cs = (v4u*)(F.ws + WS_CS) + ((((size_t)bh * 33) * 4 + I) * 16 + j) * 64 + ln;
    f32x4 s0 = {0.f, 0.f, 0.f, 0.f}, s1 = {0.f, 0.f, 0.f, 0.f};
#pragma unroll 8
    for (int c = 0; c < 32; ++c) { const float fa = cf[2 * c], fb = cf[2 * c + 1];
      s0 = s0 * fa + dc0[(size_t)c * 128 * 64] * fb; s1 = s1 * fa + dc1[(size_t)c * 128 * 64] * fb;
      v4u o; o.x = pk2(s0.x, s0.y); o.y = pk2(s0.z, s0.w); o.z = pk2(s1.x, s1.y); o.w = pk2(s1.z, s1.w); cs[(size_t)(c + 1) * 4 * 16 * 64] = o; } }
  const int gt = blockIdx.x * NTHR + F.tid, NT = gridDim.x * NTHR;
  for (int g = gt; g < 16 * 128; g += NT) { const int bh = g >> 7, d = g & 127; float n = 0.f, m = 0.f;
    for (int c = 0; c < 32; ++c) { const float bL = GS[(bh * 33 + c) * 2], ml = GS[(bh * 33 + c) * 2 + 1], me = fmaxf(m, ml);
      n = n * __expf(m - me) + ((const float*)(F.ws + WS_DN))[(size_t)(bh * 32 + c) * 128 + d] * __expf(ml - me); m = bL + me;
      ((float*)(F.ws + WS_NS))[(size_t)(bh * 33 + c + 1) * 128 + d] = n; if (d == 0) ((float*)(F.ws + WS_MS))[bh * 33 + c + 1] = m; } }
}

__device__ __forceinline__ void taskC(const Frame& F, const Args& a, int task) {
  const int bh = task >> 5, c = (task & 31) + 1, b = bh >> 2, h = bh & 3, tid = F.tid, w = F.wave, lane = F.lane, fr = lane & 15, kq = lane >> 4, pos0 = 64 * c;
  LAS unsigned char* lds = F.lds; LAS float* G = (LAS float*)(lds + L_G); LAS float* NV = (LAS float*)(lds + L_NV);
  const bf16* MQg = (const bf16*)(F.ws + WS_MQ) + (size_t)bh * PADT * 128; const bf16* MKg = (const bf16*)(F.ws + WS_MK) + (size_t)bh * PADT * 128;
  const bf16* MVg = (const bf16*)(F.ws + WS_MV) + (size_t)bh * PADT * 256;
  const float m = ((const float*)(F.ws + WS_MS))[bh * 33 + c];
  __syncthreads();
  load_cw(F, a, h); load_raw(F, MQg, pos0, L_RQ); load_raw(F, MKg, pos0, L_RK); load_vt(F, MVg, pos0);
  if (tid < 128) NV[tid] = ((const float*)(F.ws + WS_NS))[(size_t)(bh * 33 + c) * 128 + tid];
  if (w == 0) {
    const float li = ((const float*)(F.ws + WS_LI))[bh * PADT + pos0 + lane], lf = ((const float*)(F.ws + WS_LF))[bh * PADT + pos0 + lane];
    float bs = lf;
#pragma unroll
    for (int d = 1; d < 64; d <<= 1) { const float o = shfl_up_f(bs, d); if (lane >= d) bs += o; }
    const float av = li - bs; float cm = av;
#pragma unroll
    for (int d = 1; d < 64; d <<= 1) { const float o = shfl_up_f(cm, d); if (lane >= d) cm = fmaxf(cm, o); }
    const float Mt = fmaxf(m, cm);
    G[G_A + lane] = av; G[G_M + lane] = Mt; G[G_WI + lane] = __expf(m - Mt); G[G_EM + lane] = __expf(-(bs + Mt));
  }
  __syncthreads();
  { const int t = tid >> 3, d0 = (tid & 7) * 16; const float wi = G[G_WI + t]; float y[16];
    conv16(F, 0, L_RQ, t, d0, y);
    { v4u o0, o1, w0, w1;
      o0.x = pk2(y[0], y[1]); o0.y = pk2(y[2], y[3]); o0.z = pk2(y[4], y[5]); o0.w = pk2(y[6], y[7]); o1.x = pk2(y[8], y[9]); o1.y = pk2(y[10], y[11]); o1.z = pk2(y[12], y[13]); o1.w = pk2(y[14], y[15]);
      w0.x = pk2(y[0] * wi, y[1] * wi); w0.y = pk2(y[2] * wi, y[3] * wi); w0.z = pk2(y[4] * wi, y[5] * wi); w0.w = pk2(y[6] * wi, y[7] * wi);
      w1.x = pk2(y[8] * wi, y[9] * wi); w1.y = pk2(y[10] * wi, y[11] * wi); w1.z = pk2(y[12] * wi, y[13] * wi); w1.w = pk2(y[14] * wi, y[15] * wi);
      LAS v4u* qs = (LAS v4u*)(lds + L_QS + (t * QST + d0) * 2); qs[0] = o0; qs[1] = o1;
      LAS v4u* qw = (LAS v4u*)(lds + L_QW + (t * QST + d0) * 2); qw[0] = w0; qw[1] = w1; }
    __builtin_amdgcn_sched_barrier(0);
    conv16(F, 1, L_RK, t, d0, y);
    { const float sc = 0.08838834764831845f; v4u o0, o1;
      o0.x = pk2(y[0] * sc, y[1] * sc); o0.y = pk2(y[2] * sc, y[3] * sc); o0.z = pk2(y[4] * sc, y[5] * sc); o0.w = pk2(y[6] * sc, y[7] * sc);
      o1.x = pk2(y[8] * sc, y[9] * sc); o1.y = pk2(y[10] * sc, y[11] * sc); o1.z = pk2(y[12] * sc, y[13] * sc); o1.w = pk2(y[14] * sc, y[15] * sc);
      LAS v4u* ks = (LAS v4u*)(lds + L_KS + (t * QST + d0) * 2); ks[0] = o0; ks[1] = o1; } }
  __syncthreads();
  v4u cb[4][2];
  { const v4u* cs = (const v4u*)(F.ws + WS_CS) + (((size_t)bh * 33 + c) * 4 * 16) * 64;
#pragma unroll
    for (int I = 0; I < 4; ++I)
#pragma unroll
      for (int jj = 0; jj < 2; ++jj) cb[I][jj] = cs[(size_t)(I * 16 + 2 * w + jj) * 64 + lane]; }
  { const int si = w >> 1; const f32x4 as = *(const LAS f32x4*)(G + G_A + 16 * si + 4 * kq);
#pragma unroll
    for (int tt = 0; tt < 2; ++tt) { const int ti = 2 * (w & 1) + tt; f32x4 acc = {0.f, 0.f, 0.f, 0.f};
#pragma unroll
      for (int ks = 0; ks < 4; ++ks) { const bf16x8 af = *(const LAS bf16x8*)(lds + L_KS + ((16 * si + fr) * QST + 32 * ks + 8 * kq) * 2);
        const bf16x8 bfr = *(const LAS bf16x8*)(lds + L_QS + ((16 * ti + fr) * QST + 32 * ks + 8 * kq) * 2);
        acc = __builtin_amdgcn_mfma_f32_16x16x32_bf16(af, bfr, acc, 0, 0, 0); }
      const int t = 16 * ti + fr, s0 = 16 * si + 4 * kq; const float Mt = G[G_M + t];
      const float v0 = (s0 + 0 <= t) ? acc.x * __expf(as.x - Mt) : 0.f, v1 = (s0 + 1 <= t) ? acc.y * __expf(as.y - Mt) : 0.f;
      const float v2 = (s0 + 2 <= t) ? acc.z * __expf(as.z - Mt) : 0.f, v3 = (s0 + 3 <= t) ? acc.w * __expf(as.w - Mt) : 0.f;
      v2u o; o.x = pk2(v0, v1); o.y = pk2(v2, v3);
      *(LAS v2u*)(lds + L_SP + (t * TST + s0) * 2) = o; } }
  __syncthreads();
  if (w == 0) { const int t = lane; float qn = 0.f, rsum = 0.f;
#pragma unroll 4
    for (int q = 0; q < 16; ++q) { const v4u x = *(const LAS v4u*)(lds + L_QS + (t * QST + q * 8) * 2); const f32x4 n0 = *(const LAS f32x4*)(NV + q * 8), n1 = *(const LAS f32x4*)(NV + q * 8 + 4);
      qn += bflo(x.x) * n0.x + bfhi(x.x) * n0.y + bflo(x.y) * n0.z + bfhi(x.y) * n0.w + bflo(x.z) * n1.x + bfhi(x.z) * n1.y + bflo(x.w) * n1.z + bfhi(x.w) * n1.w; }
#pragma unroll
    for (int q = 0; q < 8; ++q) { const v4u x = *(const LAS v4u*)(lds + L_SP + (t * TST + q * 8) * 2); rsum += (bflo(x.x) + bfhi(x.x)) + (bflo(x.y) + bfhi(x.y)) + (bflo(x.z) + bfhi(x.z)) + (bflo(x.w) + bfhi(x.w)); }
    const float den = G[G_WI + t] * qn + rsum; G[G_DEN + t] = fmaxf(fabsf(den), G[G_EM + t]); }
  f32x4 acc[2][4];
#pragma unroll
  for (int jj = 0; jj < 2; ++jj)
#pragma unroll
    for (int ti = 0; ti < 4; ++ti) acc[jj][ti] = (f32x4){0.f, 0.f, 0.f, 0.f};
#pragma unroll
  for (int I = 0; I < 4; ++I) {
#pragma unroll
    for (int ti = 0; ti < 4; ++ti) { const LAS unsigned char* qp = lds + L_QW + ((16 * ti + fr) * QST + 32 * I + 4 * kq) * 2;
      const v2u a0 = *(const LAS v2u*)qp, a1 = *(const LAS v2u*)(qp + 32); const v4u av = {a0.x, a0.y, a1.x, a1.y};
      acc[0][ti] = __builtin_amdgcn_mfma_f32_16x16x32_bf16(__builtin_bit_cast(bf16x8, av), __builtin_bit_cast(bf16x8, cb[I][0]), acc[0][ti], 0, 0, 0);
      acc[1][ti] = __builtin_amdgcn_mfma_f32_16x16x32_bf16(__builtin_bit_cast(bf16x8, av), __builtin_bit_cast(bf16x8, cb[I][1]), acc[1][ti], 0, 0, 0); }
    __builtin_amdgcn_sched_barrier(0); }
#pragma unroll
  for (int ks = 0; ks < 2; ++ks) { const bf16x8 bv0 = *(const LAS bf16x8*)(lds + L_VT + ((32 * w + fr) * TST + 32 * ks + 8 * kq) * 2), bv1 = *(const LAS bf16x8*)(lds + L_VT + ((32 * w + 16 + fr) * TST + 32 * ks + 8 * kq) * 2);
#pragma unroll
    for (int ti = 0; ti < 4; ++ti) { const bf16x8 sf = *(const LAS bf16x8*)(lds + L_SP + ((16 * ti + fr) * TST + 32 * ks + 8 * kq) * 2);
      acc[0][ti] = __builtin_amdgcn_mfma_f32_16x16x32_bf16(sf, bv0, acc[0][ti], 0, 0, 0); acc[1][ti] = __builtin_amdgcn_mfma_f32_16x16x32_bf16(sf, bv1, acc[1][ti], 0, 0, 0); } }
  __syncthreads();
  LAS float* SSQ = (LAS float*)(lds + L_SSQ);
#pragma unroll
  for (int ti = 0; ti < 4; ++ti) { const f32x4 dn = *(const LAS f32x4*)(G + G_DEN + 16 * ti + 4 * kq);
    f32x4 s4;
#pragma unroll
    for (int r = 0; r < 4; ++r) { const float h0 = acc[0][ti][r] / dn[r], h1 = acc[1][ti][r] / dn[r]; acc[0][ti][r] = h0; acc[1][ti][r] = h1; s4[r] = h0 * h0 + h1 * h1; }
#pragma unroll
    for (int o = 1; o < 16; o <<= 1) { s4.x += __shfl_xor(s4.x, o); s4.y += __shfl_xor(s4.y, o); s4.z += __shfl_xor(s4.z, o); s4.w += __shfl_xor(s4.w, o); }
    if (fr == 0) { SSQ[(16 * ti + 4 * kq + 0) * 8 + w] = s4.x; SSQ[(16 * ti + 4 * kq + 1) * 8 + w] = s4.y; SSQ[(16 * ti + 4 * kq + 2) * 8 + w] = s4.z; SSQ[(16 * ti + 4 * kq + 3) * 8 + w] = s4.w; } }
  __syncthreads();
  LAS bf16* HT = (LAS bf16*)(lds + L_HT);
#pragma unroll
  for (int ti = 0; ti < 4; ++ti)
#pragma unroll
    for (int r = 0; r < 4; ++r) { const int t = 16 * ti + 4 * kq + r; const f32x4 p0 = *(const LAS f32x4*)(SSQ + t * 8), p1 = *(const LAS f32x4*)(SSQ + t * 8 + 4);
      const float rh = rsqrtf(((p0.x + p0.y) + (p0.z + p0.w) + (p1.x + p1.y) + (p1.z + p1.w)) * (1.0f / 256.f) + EPS);
      HT[t * 264 + 32 * w + fr] = (bf16)f2bf(acc[0][ti][r] * rh); HT[t * 264 + 32 * w + 16 + fr] = (bf16)f2bf(acc[1][ti][r] * rh); }
  __syncthreads();
  { const int t = tid >> 3, c0 = (tid & 7) * 32; const size_t R = (size_t)b * SEQ + 64 * (c - 1) + t;
    const bf16* mo = (const bf16*)(F.ws + WS_MO) + R * 1024 + h * 256 + c0; const float* og = a.in[IN_OUTG] + h * 256 + c0; bf16* A2 = (bf16*)(F.ws + WS_A2) + R * DM + 1024 + h * 256 + c0;
#pragma unroll
    for (int q = 0; q < 4; ++q) { const v4u hv = *(const LAS v4u*)(HT + t * 264 + c0 + q * 8); const v4u mv = *(const v4u*)(mo + q * 8); const f32x4 g0 = *(const f32x4*)(og + q * 8), g1 = *(const f32x4*)(og + q * 8 + 4);
      v4u o; o.x = pk2(bflo(hv.x) * g0.x * bflo(mv.x), bfhi(hv.x) * g0.y * bfhi(mv.x)); o.y = pk2(bflo(hv.y) * g0.z * bflo(mv.y), bfhi(hv.y) * g0.w * bfhi(mv.y));
      o.z = pk2(bflo(hv.z) * g1.x * bflo(mv.z), bfhi(hv.z) * g1.y * bfhi(mv.z)); o.w = pk2(bflo(hv.w) * g1.z * bflo(mv.w), bfhi(hv.w) * g1.w * bfhi(mv.w));
      *(v4u*)(A2 + q * 8) = o; } }
}
}
__device__ __forceinline__ void p3_combine(const Frame& F, const Args& a, int NA) {
  const float* PO = (const float*)(F.ws + WS_PO); const float* ML = (const float*)(F.ws + WS_ML);
  bf16* A2 = (bf16*)(F.ws + WS_A2);
  const float lam = *(const float*)(F.ws + WS_LAM);
  const float* subg = a.in[IN_SUBG];
  const int gw = blockIdx.x * NWAVES + F.wave, NGW = gridDim.x * NWAVES, lane = F.lane;
  const f32x4 sg = ((const f32x4*)subg)[lane];
  for (int R = gw; R < MROWS; R += NGW) {
    const int b = R >> 11, t = R & 2047, qb = t >> 8, rq = t & 255;
#pragma unroll 2
    for (int h = 0; h < 4; ++h) {
      f32x4 om[2];
#pragma unroll
      for (int m = 0; m < 2; ++m) {
        const int bhm = (b * 4 + h) * 2 + m, first = bhm * att::STEPS_BHM + att::qb_start(qb), last = first + 4 * qb + 4;
        const int cf = att::chunk_of(first, NA), np = att::chunk_of(last, NA) - cf + 1, slot0 = bhm * 16 + qb + cf - att::chunk_of(bhm * att::STEPS_BHM, NA);
        float mp[3], lp[3]; f32x4 op[3];
#pragma unroll
        for (int p = 0; p < 3; ++p) { if (p < np) { const int slot = slot0 + p; mp[p] = ML[(size_t)slot * 512 + rq * 2]; lp[p] = ML[(size_t)slot * 512 + rq * 2 + 1];
            op[p] = ((const f32x4*)(PO + ((size_t)slot * 256 + rq) * 256))[lane]; } else { mp[p] = -1e30f; lp[p] = 0.f; op[p] = (f32x4){0.f, 0.f, 0.f, 0.f}; } }
        const float M = fmaxf(mp[0], fmaxf(mp[1], mp[2]));
        float wsum = 0.f; f32x4 acc = (f32x4){0.f, 0.f, 0.f, 0.f};
#pragma unroll
        for (int p = 0; p < 3; ++p) { const float w = lp[p] * exp2f(mp[p] - M); wsum += w; acc += op[p] * w; }
        om[m] = acc * (1.0f / wsum);
      }
      const f32x4 o = om[0] - om[1] * lam;
      const float rs = rsqrtf(wave_sum((o.x * o.x + o.y * o.y) + (o.z * o.z + o.w * o.w)) * (1.0f / 256.f) + EPS) * 0.8f;
      v2u w; w.x = pk2(o.x * rs * sg.x, o.y * rs * sg.y); w.y = pk2(o.z * rs * sg.z, o.w * rs * sg.w);
      ((v2u*)(A2 + (size_t)R * DM + h * 256))[lane] = w;
    }
  }
}
struct EpiRes {
  static constexpr bool PERM = true, AFTER_DRAIN = false;
  const float* x; float* out; bf16* H1b; float* SSQ;
  __device__ __forceinline__ void operator()(const pg8::f32x4 (&acc)[2][2][4][2], const pg8::Unit& u, int wr, int wc, int fr, int fq) const {
    const int row0 = u.pm * 256 + wr * 64 + fr, col0 = u.pn * 256 + wc * 32 + 8 * fq;
#pragma unroll
    for (int ai = 0; ai < 2; ++ai)
#pragma unroll
      for (int m = 0; m < 4; ++m) { const size_t R = (size_t)(row0 + ai * 128 + m * 16); float s = 0.f;
#pragma unroll
        for (int bj = 0; bj < 2; ++bj) { const size_t off = R * DM + col0 + bj * 128;
          const f32x4 x0 = *(const f32x4*)(x + off), x1 = *(const f32x4*)(x + off + 4);
          const f32x4 v0 = acc[ai][bj][m][0] + x0, v1 = acc[ai][bj][m][1] + x1;
          v4u w; w.x = pk2(v0.x, v0.y); w.y = pk2(v0.z, v0.w); w.z = pk2(v1.x, v1.y); w.w = pk2(v1.z, v1.w);
          *(v4u*)(H1b + off) = w;
          s += (v0.x * v0.x + v0.y * v0.y) + (v0.z * v0.z + v0.w * v0.w) + (v1.x * v1.x + v1.y * v1.y) + (v1.z * v1.z + v1.w * v1.w); }
        s += __shfl_xor(s, 16); s += __shfl_xor(s, 32);
        if (fq == 0) SSQ[R * 32 + u.pn * 4 + wc] = s; }
  }
};
#ifndef PEER_U_FP8
#define PEER_U_FP8 0
#endif
typedef __bf16 bfv2 __attribute__((ext_vector_type(2)));
__device__ __forceinline__ void split_hl(const f32x4 a, const f32x4 b, bf16x8& hi, bf16x8& lo) {
  float v[8] = {a.x, a.y, a.z, a.w, b.x, b.y, b.z, b.w}; unsigned h[8], l[8];
#pragma unroll
  for (int i = 0; i < 8; ++i) { h[i] = f2bf(v[i]); l[i] = f2bf(v[i] - __builtin_bit_cast(float, h[i] << 16)); }
  v4u hv = {h[0] | (h[1] << 16), h[2] | (h[3] << 16), h[4] | (h[5] << 16), h[6] | (h[7] << 16)};
  v4u lv = {l[0] | (l[1] << 16), l[2] | (l[3] << 16), l[4] | (l[5] << 16), l[6] | (l[7] << 16)};
  hi = __builtin_bit_cast(bf16x8, hv); lo = __builtin_bit_cast(bf16x8, lv);
}
__device__ __forceinline__ void p0_w3t(const Frame& F, const Args& a) {
  const float* wq = a.in[IN_WQ]; const float* sk = a.in[IN_SUBK]; const float* g2 = a.in[IN_G2];
  bf16* W3t = (bf16*)(F.ws + WS_W3T);
  const int lane = F.lane, fr = lane & 15, fq = lane >> 4;
  constexpr int SKS = 272;
  LAS unsigned char* shi = F.lds; LAS unsigned char* slo = F.lds + 128 * SKS;
  for (int bt = blockIdx.x; bt < 256; bt += gridDim.x) {
    const int hh = bt & 15, kt = (bt >> 4) * 8 + F.wave;
    const float* ap = wq + (size_t)(kt * 16 + fr) * DM + hh * 128 + fq * 8;
    f32x4 a0[4], a1[4];
#pragma unroll
    for (int s = 0; s < 4; ++s) { a0[s] = *(const f32x4*)(ap + 32 * s); a1[s] = *(const f32x4*)(ap + 32 * s + 4); }
    const f32x4 gk = *(const f32x4*)(g2 + kt * 16 + fq * 4);
    __syncthreads();
#pragma unroll
    for (int i = 0; i < 4; ++i) { const int idx = F.tid + NTHR * i, key = idx >> 4, c8 = idx & 15; const float* p = sk + (size_t)(hh * 128 + key) * 128 + c8 * 8;
      bf16x8 h, l; split_hl(*(const f32x4*)p, *(const f32x4*)(p + 4), h, l);
      *(LAS bf16x8*)(shi + key * SKS + c8 * 16) = h; *(LAS bf16x8*)(slo + key * SKS + c8 * 16) = l; }
    bf16x8 ahi[4], alo[4];
#pragma unroll
    for (int s = 0; s < 4; ++s) split_hl(a0[s], a1[s], ahi[s], alo[s]);
    __syncthreads();
#pragma unroll 2
    for (int t2 = 0; t2 < 8; ++t2) {
      const LAS unsigned char* bh = shi + (t2 * 16 + fr) * SKS + fq * 16; const LAS unsigned char* bl = slo + (t2 * 16 + fr) * SKS + fq * 16;
      f32x4 acc = {0.f, 0.f, 0.f, 0.f};
#pragma unroll
      for (int s = 0; s < 4; ++s) { const bf16x8 bhi = *(const LAS bf16x8*)(bh + 64 * s), blo = *(const LAS bf16x8*)(bl + 64 * s);
        acc = __builtin_amdgcn_mfma_f32_16x16x32_bf16(ahi[s], bhi, acc, 0, 0, 0);
        acc = __builtin_amdgcn_mfma_f32_16x16x32_bf16(ahi[s], blo, acc, 0, 0, 0);
        acc = __builtin_amdgcn_mfma_f32_16x16x32_bf16(alo[s], bhi, acc, 0, 0, 0); }
      v2u o; o.x = pk2(acc.x * gk.x, acc.y * gk.y); o.y = pk2(acc.z * gk.z, acc.w * gk.w);
      *(v2u*)(W3t + (size_t)(hh * 128 + t2 * 16 + fr) * DM + kt * 16 + fq * 4) = o;
    }
  }
  __syncthreads();
}
typedef float f32x2v __attribute__((ext_vector_type(2)));
__device__ __forceinline__ void p0_tables(const Frame& F, const Args& a) {
  const float* g2 = a.in[IN_G2];
  float* SCL = (float*)(F.ws + WS_SCL);
  const int gw = blockIdx.x * NWAVES + F.wave, NGW = gridDim.x * NWAVES, lane = F.lane;
  f32x4 gl[8];
#pragma unroll
  for (int q = 0; q < 8; ++q) gl[q] = *(const f32x4*)(g2 + q * 256 + lane * 4);
  f32x4 xn[8];
  { const int row = gw; if (row < 2 * 16384) { const float* src = a.in[row >= 16384 ? IN_V : IN_U] + (size_t)(row & 16383) * DM + lane * 4;
#pragma unroll
      for (int q = 0; q < 8; ++q) xn[q] = *(const f32x4*)(src + q * 256); } }
  for (int row = gw; row < 2 * 16384; row += NGW) {
    const bool isv = row >= 16384; const int e = row & 16383;
    f32x4 x[8];
#pragma unroll
    for (int q = 0; q < 8; ++q) x[q] = xn[q];
    { const int rn = row + NGW; if (rn < 2 * 16384) { const float* src = a.in[rn >= 16384 ? IN_V : IN_U] + (size_t)(rn & 16383) * DM + lane * 4;
#pragma unroll
        for (int q = 0; q < 8; ++q) xn[q] = *(const f32x4*)(src + q * 256); } }
    float amax = 0.f, ssq = 0.f;
#pragma unroll
    for (int q = 0; q < 8; ++q) { if (!isv) x[q] = x[q] * gl[q]; amax = fmaxf(amax, fmaxf(fmaxf(fabsf(x[q].x), fabsf(x[q].y)), fmaxf(fabsf(x[q].z), fabsf(x[q].w))));
      ssq += (x[q].x * x[q].x + x[q].y * x[q].y) + (x[q].z * x[q].z + x[q].w * x[q].w); }
#pragma unroll
    for (int o = 1; o < 64; o <<= 1) amax = fmaxf(amax, __shfl_xor(amax, o));
    v4u w;
    if (isv) {
      const float sc = amax > 0.f ? 6.0f / amax : 1.0f;
#pragma unroll
      for (int d = 0; d < 4; ++d) { unsigned pk = 0u;
        pk = __builtin_amdgcn_cvt_scalef32_pk_fp4_f32(pk, x[2 * d].x * sc, x[2 * d].y * sc, 1.0f, 0); pk = __builtin_amdgcn_cvt_scalef32_pk_fp4_f32(pk, x[2 * d].z * sc, x[2 * d].w * sc, 1.0f, 1);
        pk = __builtin_amdgcn_cvt_scalef32_pk_fp4_f32(pk, x[2 * d + 1].x * sc, x[2 * d + 1].y * sc, 1.0f, 2); pk = __builtin_amdgcn_cvt_scalef32_pk_fp4_f32(pk, x[2 * d + 1].z * sc, x[2 * d + 1].w * sc, 1.0f, 3);
        w[d] = pk; }
      if (lane == 0) SCL[row] = 1.0f / sc;
    } else {
      ssq = wave_sum_dpp(ssq);
      const float sA = amax > 0.f ? amax * (1.0f / 7.0f) : 1.0f, sB = fminf(sA, 0.36f * sqrtf(ssq * (1.0f / DM)) + 1e-30f);
      const float iA = 1.0f / sA, iB = 1.0f / sB;
      float eA = 0.f, eB = 0.f;
#pragma unroll
      for (int q = 0; q < 8; ++q)
#pragma unroll
        for (int j = 0; j < 4; ++j) { const float v = x[q][j];
          const float da = v - sA * __builtin_amdgcn_fmed3f(__builtin_rintf(v * iA), -7.0f, 7.0f), db = v - sB * __builtin_amdgcn_fmed3f(__builtin_rintf(v * iB), -7.0f, 7.0f);
          eA += da * da; eB += db * db; }
      eA = wave_sum_dpp(eA); eB = wave_sum_dpp(eB);
      const bool useB = eB < eA; const float st = useB ? sB : sA, is = useB ? iB : iA;
#pragma unroll
      for (int d = 0; d < 4; ++d) { unsigned pk = 0u;
#pragma unroll
        for (int p = 0; p < 8; ++p) { const float v = x[2 * d + (p >> 2)][p & 3]; const int qi = (int)__builtin_amdgcn_fmed3f(__builtin_rintf(v * is), -7.0f, 7.0f); pk |= ((unsigned)qi & 15u) << (4 * p); }
        w[d] = pk; }
      if (lane == 0) SCL[row] = st;
    }
    *(v4u*)(F.ws + (isv ? WS_VB8 : WS_UB) + (size_t)e * 1024 + lane * 16) = w;
  }
}
struct EpiScore {
  static constexpr bool PERM = true, AFTER_DRAIN = false;
  float* S; const LAS float* rs;
  __device__ __forceinline__ void operator()(const pg8::f32x4 (&acc)[2][2][4][2], const pg8::Unit& u, int wr, int wc, int fr, int fq) const {
    const int rl0 = wr * 64 + fr, keyb = wc * 32 + 8 * fq;
#pragma unroll
    for (int ai = 0; ai < 2; ++ai)
#pragma unroll
      for (int m = 0; m < 4; ++m) { const int rl = rl0 + ai * 128 + m * 16; const float r = rs[rl]; const int row = u.pm * 256 + rl;
#pragma unroll
        for (int bj = 0; bj < 2; ++bj) { float* d = S + ((size_t)((row >> 5) * 16 + u.pn * 2 + bj) * 128 + keyb) * 32 + (row & 31);
          const pg8::f32x4 v0 = acc[ai][bj][m][0] * r, v1 = acc[ai][bj][m][1] * r;
          d[0] = v0[0]; d[32] = v0[1]; d[64] = v0[2]; d[96] = v0[3]; d[128] = v1[0]; d[160] = v1[1]; d[192] = v1[2]; d[224] = v1[3]; } }
  }
};

__device__ __forceinline__ unsigned fkey(float f) { const unsigned b = __builtin_bit_cast(unsigned, f); return b ^ ((b >> 31) ? 0xFFFFFFFFu : 0x80000000u); }
template <int NV, int K> __device__ __forceinline__ void wave_topk(const unsigned (&u)[NV], bool (&sel)[NV], int lane) {
  unsigned prefix = 0u; int cge = NV * 64;
#pragma unroll 1
  for (int bit = 31; bit >= 0 && cge != K; --bit) {
    const unsigned cand = prefix | (1u << bit); int c = 0;
#pragma unroll
    for (int i = 0; i < NV; ++i) c += __builtin_popcountll(__ballot(u[i] >= cand));
    if (c >= K) { prefix = cand; cge = c; }
  }
  int cgt = 0;
#pragma unroll
  for (int i = 0; i < NV; ++i) cgt += __builtin_popcountll(__ballot(u[i] > prefix));
  int need = K - cgt;
  const unsigned long long lm = (1ull << lane) - 1ull;
#pragma unroll
  for (int i = 0; i < NV; ++i) { const unsigned long long eq = __ballot(u[i] == prefix); const int before = __builtin_popcountll(eq & lm);
    sel[i] = (u[i] > prefix) || (u[i] == prefix && before < need); const int ne = __builtin_popcountll(eq); need = need > ne ? need - ne : 0; }
}
template <int NG, int NV, int K> __device__ __forceinline__ void wave_topk_multi(const unsigned (&u)[NG][NV], bool (&sel)[NG][NV], int lane) {
  unsigned prefix[NG]; int cge[NG];
#pragma unroll
  for (int g = 0; g < NG; ++g) { prefix[g] = 0u; cge[g] = NV * 64; }
#pragma unroll 1
  for (int bit = 31; bit >= 0; --bit) {
    bool done = true;
#pragma unroll
    for (int g = 0; g < NG; ++g) done = done && (cge[g] == K);
    if (done) break;
#pragma unroll
    for (int g = 0; g < NG; ++g) { const unsigned cand = prefix[g] | (1u << bit); int c = 0;
#pragma unroll
      for (int i = 0; i < NV; ++i) c += __builtin_popcountll(__ballot(u[g][i] >= cand));
      if (cge[g] != K && c >= K) { prefix[g] = cand; cge[g] = c; } }
  }
  const unsigned long long lm = (1ull << lane) - 1ull;
#pragma unroll
  for (int g = 0; g < NG; ++g) { int cgt = 0;
#pragma unroll
    for (int i = 0; i < NV; ++i) cgt += __builtin_popcountll(__ballot(u[g][i] > prefix[g]));
    int need = K - cgt;
#pragma unroll
    for (int i = 0; i < NV; ++i) { const unsigned long long eq = __ballot(u[g][i] == prefix[g]); const int before = __builtin_popcountll(eq & lm);
      sel[g][i] = (u[g][i] > prefix[g]) || (u[g][i] == prefix[g] && before < need); const int ne = __builtin_popcountll(eq); need = need > ne ? need - ne : 0; } }
}
__device__ __forceinline__ float gelu_erf(float v) {
  const float av = fabsf(v), t = __builtin_amdgcn_rcpf(1.0f + 0.2316418882f * av);
  float q = t * 0.5307027145f - 0.7265760135f; q = q * t + 0.7107068705f; q = q * t - 0.142248368f; q = q * t + 0.127414796f; q = q * t;
  const float tail = q * __builtin_amdgcn_exp2f(v * v * -0.72134752044f);
  return v < 0.f ? v * tail : v - v * tail;
}

#ifndef ROUTE_REPS
#define ROUTE_REPS 1
#endif
__device__ __forceinline__ void ins16(float (&t)[16], float x) {
#pragma unroll
  for (int i = 15; i >= 1; --i) t[i] = __builtin_amdgcn_fmed3f(t[i - 1], t[i], x);
  t[0] = fmaxf(t[0], x);
}
__device__ __forceinline__ void p6_peer(const Frame& F, const Args& a, float* dst_base) {
  const float* S2 = (const float*)(F.ws + WS_S); const float* SSQ = (const float*)(F.ws + WS_SSQ); const bf16* H1b = (const bf16*)(F.ws + WS_H1B);
  int lane = F.lane, wv = F.wave, tid = F.tid; asm volatile("" : "+v"(lane), "+s"(wv), "+v"(tid));
  int* EIDg = (int*)(F.ws + WS_EID); float* EGTg = (float*)(F.ws + WS_EGT);
  LAS int* eid = (LAS int*)(F.lds + wv * 1536); LAS float* egt = (LAS float*)(eid + 128); LAS float* esu = (LAS float*)(eid + 256);
  LAS unsigned char* RB = F.lds + 12288 + wv * 16384;
  LAS float* L1 = (LAS float*)(F.lds + 12288);
  for (int tb = blockIdx.x; tb < MROWS / 32; tb += gridDim.x) {
    __syncthreads();
    {
      const int g = tid >> 5, tl = tid & 31; const float* src = S2 + ((size_t)(tb * 16 + g) * 128) * 32 + tl;
      float t[16];
#pragma unroll
      for (int i = 0; i < 16; ++i) t[i] = -INFINITY;
#pragma unroll 32
      for (int k = 0; k < 128; ++k) { const float x = src[k * 32]; ins16(t, __builtin_bit_cast(float, (__builtin_bit_cast(unsigned, x) & ~0x7Fu) | (unsigned)(127 - k))); }
#pragma unroll
      for (int i = 0; i < 16; ++i) L1[(g * 16 + i) * 32 + tl] = t[i];
    }
    __syncthreads();
    if (tid < 256) {
      const int h8 = tid >> 5, tl = tid & 31; const LAS float* LA = L1 + ((2 * h8) * 16) * 32 + tl; const LAS float* LB = L1 + ((2 * h8 + 1) * 16) * 32 + tl;
      float A[16], B[16], t[16];
#pragma unroll
      for (int i = 0; i < 16; ++i) { A[i] = LA[i * 32]; B[i] = LB[i * 32]; t[i] = -INFINITY; }
#pragma unroll
      for (int i = 0; i < 16; ++i)
#pragma unroll
        for (int j = 0; j < 16; ++j) if ((i + 1) * (j + 1) <= 16) { const float c = A[i] + B[j];
            ins16(t, __builtin_bit_cast(float, (__builtin_bit_cast(unsigned, c) & ~0xFFu) | (unsigned)(255 - (i * 16 + j)))); }
      float ev[16], es = 0.f;
#pragma unroll
      for (int r = 0; r < 16; ++r) { ev[r] = __expf(t[r] - t[0]); es += ev[r]; }
      const float inv = 1.0f / es;
#pragma unroll
      for (int r = 0; r < 16; ++r) { const unsigned flat = 255u - (__builtin_bit_cast(unsigned, t[r]) & 0xFFu), ii = flat >> 4, jj = flat & 15u;
        const unsigned ka = 127u - (__builtin_bit_cast(unsigned, LA[ii * 32]) & 0x7Fu), kb = 127u - (__builtin_bit_cast(unsigned, LB[jj * 32]) & 0x7Fu);
        EIDg[(size_t)(tb * 32 + tl) * 128 + h8 * 16 + r] = (int)(ka * 128u + kb); EGTg[(size_t)(tb * 32 + tl) * 128 + h8 * 16 + r] = ev[r] * inv; }
    }
    asm volatile("s_waitcnt vmcnt(0)" ::: "memory"); __syncthreads();
#pragma unroll 1
    for (int tt = 0; tt < 4; ++tt) {
    const int tl = wv * 4 + tt, tok = tb * 32 + tl;
    const float rs = rsqrtf(wave_sum_dpp(lane < 32 ? SSQ[(size_t)tok * 32 + lane] : 0.f) * (1.0f / DM) + EPS);
    { const float* SCL = (const float*)(F.ws + WS_SCL);
#pragma unroll
      for (int i = 0; i < 2; ++i) { const int e = lane + 64 * i, idq = __builtin_nontemporal_load(EIDg + (size_t)tok * 128 + e); eid[e] = idq; esu[e] = SCL[idq]; egt[e] = __builtin_nontemporal_load(EGTg + (size_t)tok * 128 + e) * SCL[16384 + idq]; } }
    unsigned xw[16];
    { const bf16* xp = H1b + (size_t)tok * DM + (size_t)lane * 4;
#pragma unroll
      for (int q = 0; q < 8; ++q) { const v2u x0 = *(const v2u*)(xp + q * 256); xw[2 * q] = x0.x; xw[2 * q + 1] = x0.y; } }
    int xl[4], xh[4]; float rsx;
    { float xa = 0.f;
#pragma unroll
      for (int i = 0; i < 16; ++i) xa = fmaxf(xa, fmaxf(fabsf(bflo(xw[i])), fabsf(bfhi(xw[i]))));
#pragma unroll
      for (int o = 1; o < 64; o <<= 1) xa = fmaxf(xa, __shfl_xor(xa, o));
      const float xinv = xa > 0.f ? 119.0f / xa : 0.f; rsx = rs * (xa > 0.f ? xa * (1.0f / 119.0f) : 0.f);
#pragma unroll
      for (int d = 0; d < 4; ++d) { unsigned pl = 0u, ph = 0u;
#pragma unroll
        for (int p = 0; p < 8; ++p) { const int i = 8 * d + p; const float v = (i & 1) ? bfhi(xw[i >> 1]) : bflo(xw[i >> 1]);
          const int xi = (int)__builtin_rintf(v * xinv), l = ((xi + 8) & 15) - 8, h = (xi - l) >> 4;
          pl |= ((unsigned)l & 15u) << (4 * p); ph |= ((unsigned)h & 15u) << (4 * p); }
        xl[d] = (int)pl; xh[d] = (int)ph; } }
    float y[32];
#pragma unroll
    for (int i = 0; i < 32; ++i) y[i] = 0.f;
    asm volatile("s_waitcnt vmcnt(0) lgkmcnt(0)" ::: "memory");
    const unsigned char* U8 = F.ws + WS_UB; const unsigned char* V8 = F.ws + WS_VB8;
#define PG_ISSUE(E) do { const int idq_ = __builtin_amdgcn_readfirstlane(eid[(E)]); LAS unsigned char* sl_ = RB + ((E) & 7) * 2048; \
      __builtin_amdgcn_global_load_lds((const unsigned*)(U8 + (size_t)idq_ * 1024 + lane * 16), (LAS unsigned*)sl_, 16, 0, 0); \
      __builtin_amdgcn_global_load_lds((const unsigned*)(V8 + (size_t)idq_ * 1024 + lane * 16), (LAS unsigned*)(sl_ + 1024), 16, 0, 0); } while (0)
#define PG_DOT(UW, DACC) do { int al_ = 0, ah_ = 0; _Pragma("unroll") for (int dd = 0; dd < 4; ++dd) { const int wa = (int)UW[dd]; \
          al_ = __builtin_amdgcn_sdot8(wa, xl[dd], al_, false); ah_ = __builtin_amdgcn_sdot8(wa, xh[dd], ah_, false); } DACC = (float)(ah_ * 16 + al_); } while (0)
#define PG_AXPY(VW, CF) do { _Pragma("unroll") for (int dd = 0; dd < 4; ++dd) { const unsigned wa = VW[dd]; \
          { const f32x2v v2 = __builtin_amdgcn_cvt_scalef32_pk_f32_fp4(wa, 1.0f, 0); y[8 * dd + 0] += CF * v2.x; y[8 * dd + 1] += CF * v2.y; } \
          { const f32x2v v2 = __builtin_amdgcn_cvt_scalef32_pk_f32_fp4(wa, 1.0f, 1); y[8 * dd + 2] += CF * v2.x; y[8 * dd + 3] += CF * v2.y; } \
          { const f32x2v v2 = __builtin_amdgcn_cvt_scalef32_pk_f32_fp4(wa, 1.0f, 2); y[8 * dd + 4] += CF * v2.x; y[8 * dd + 5] += CF * v2.y; } \
          { const f32x2v v2 = __builtin_amdgcn_cvt_scalef32_pk_f32_fp4(wa, 1.0f, 3); y[8 * dd + 6] += CF * v2.x; y[8 * dd + 7] += CF * v2.y; } } } while (0)
#define PG_BATCH(E0, DOISSUE) do { v4u ub[NBT], vb[NBT]; float su_[NBT], gt_[NBT]; \
      _Pragma("unroll") for (int q = 0; q < NBT; ++q) { const LAS unsigned char* s0_ = RB + (((E0) + q) & 7) * 2048 + lane * 16; ub[q] = *(const LAS v4u*)s0_; vb[q] = *(const LAS v4u*)(s0_ + 1024); su_[q] = esu[(E0) + q]; gt_[q] = egt[(E0) + q]; } \
      asm volatile("s_waitcnt lgkmcnt(0)" ::: "memory"); \
      if (DOISSUE) { _Pragma("unroll") for (int q = 0; q < NBT; ++q) PG_ISSUE((E0) + 8 + q); } \
      float d_[NBT]; _Pragma("unroll") for (int q = 0; q < NBT; ++q) { d_[q] = 0.f; PG_DOT(ub[q], d_[q]); } \
      PROBE_EXTRA \
      _Pragma("unroll") for (int q = 0; q < NBT; ++q) d_[q] = wave_sum_dpp(d_[q]); \
      _Pragma("unroll") for (int q = 0; q < NBT; ++q) { const float c_ = gelu_erf(d_[q] * (rsx * su_[q])) * gt_[q]; PG_AXPY(vb[q], c_); __builtin_amdgcn_sched_barrier(0); } } while (0)
#if defined(PROBE_CVT)
#define PROBE_EXTRA _Pragma("unroll") for (int q = 0; q < NBT; ++q) _Pragma("unroll") for (int dd = 0; dd < 4; ++dd) { const unsigned wz = ub[q][dd]; \
        const f32x2v r0 = __builtin_amdgcn_cvt_scalef32_pk_f32_fp4(wz, 1.0f, 0), r1 = __builtin_amdgcn_cvt_scalef32_pk_f32_fp4(wz, 1.0f, 1), r2 = __builtin_amdgcn_cvt_scalef32_pk_f32_fp4(wz, 1.0f, 2), r3 = __builtin_amdgcn_cvt_scalef32_pk_f32_fp4(wz, 1.0f, 3); \
        asm volatile("" :: "v"(r0), "v"(r1), "v"(r2), "v"(r3)); }
#elif defined(PROBE_DOT)
#define PROBE_EXTRA _Pragma("unroll") for (int q = 0; q < NBT; ++q) _Pragma("unroll") for (int dd = 0; dd < 16; ++dd) { \
        const float r0 = __builtin_amdgcn_fdot2_f32_bf16(__builtin_bit_cast(bfv2, xw[dd]), __builtin_bit_cast(bfv2, ub[q][dd & 3]), su_[q], false); asm volatile("" :: "v"(r0)); }
#elif defined(PROBE_FMA16)
#define PROBE_EXTRA _Pragma("unroll") for (int q = 0; q < NBT; ++q) _Pragma("unroll") for (int dd = 0; dd < 16; ++dd) { \
        unsigned r0 = ub[q][dd & 3]; asm volatile("v_pk_fma_f16 %0, %1, %1, %0" : "+v"(r0) : "v"(xw[dd])); asm volatile("" :: "v"(r0)); }
#elif defined(PROBE_DOTF16)
#define PROBE_EXTRA _Pragma("unroll") for (int q = 0; q < NBT; ++q) _Pragma("unroll") for (int dd = 0; dd < 16; ++dd) { \
        float r0 = su_[q]; asm volatile("v_dot2_f32_f16 %0, %1, %2, %0" : "+v"(r0) : "v"(xw[dd]), "v"(ub[q][dd & 3])); asm volatile("" :: "v"(r0)); }
#elif defined(PROBE_SDOT4)
#define PROBE_EXTRA _Pragma("unroll") for (int q = 0; q < NBT; ++q) _Pragma("unroll") for (int dd = 0; dd < 16; ++dd) { \
        int r0 = (int)ub[q][(dd + 1) & 3]; asm volatile("v_dot4_i32_i8 %0, %1, %2, %0" : "+v"(r0) : "v"(xw[dd]), "v"(ub[q][dd & 3])); asm volatile("" :: "v"(r0)); }
#elif defined(PROBE_SDOT8)
#define PROBE_EXTRA _Pragma("unroll") for (int q = 0; q < NBT; ++q) _Pragma("unroll") for (int dd = 0; dd < 16; ++dd) { \
        int r0 = (int)ub[q][(dd + 1) & 3]; asm volatile("v_dot8_i32_i4 %0, %1, %2, %0" : "+v"(r0) : "v"(xw[dd]), "v"(ub[q][dd & 3])); asm volatile("" :: "v"(r0)); }
#elif defined(PROBE_FMA)
#define PROBE_EXTRA _Pragma("unroll") for (int q = 0; q < NBT; ++q) _Pragma("unroll") for (int dd = 0; dd < 16; ++dd) { \
        f32x2v r0 = {su_[q], gt_[q]}; const f32x2v a_ = {y[2 * dd], y[2 * dd + 1]}; asm volatile("v_pk_fma_f32 %0, %1, %1, %0" : "+v"(r0) : "v"(a_)); asm volatile("" :: "v"(r0)); }
#else
#define PROBE_EXTRA
#endif
    constexpr int NBT = 2;
#pragma unroll
    for (int e = 0; e < 8; ++e) PG_ISSUE(e);
#pragma unroll 1
    for (int e = 0; e < 120; e += NBT) {
      asm volatile("s_waitcnt vmcnt(12)" ::: "memory");
      PG_BATCH(e, true);
      asm volatile("" ::: "memory");
    }
    asm volatile("s_waitcnt vmcnt(0)" ::: "memory");
#pragma unroll 1
    for (int e = 120; e < 128; e += NBT) PG_BATCH(e, false);
    asm volatile("s_waitcnt lgkmcnt(0)" ::: "memory");
#undef PG_ISSUE
#undef PG_DOT
#undef PG_AXPY
#undef PG_BATCH
#undef PROBE_EXTRA
    float* drow = dst_base + (size_t)tok * DM;
#pragma unroll
    for (int q = 0; q < 8; ++q) { const size_t off = (size_t)q * 256 + lane * 4; f32x4 hv;
      hv.x = bflo(xw[2 * q]) + y[4 * q]; hv.y = bfhi(xw[2 * q]) + y[4 * q + 1]; hv.z = bflo(xw[2 * q + 1]) + y[4 * q + 2]; hv.w = bfhi(xw[2 * q + 1]) + y[4 * q + 3]; *(f32x4*)(drow + off) = hv; }
    }
  }
}
constexpr int MISC_LDS = LDS_BYTES - 256;
__global__ void __launch_bounds__(NTHR, 2) mk_fwd(Args args) {
  extern __shared__ __attribute__((aligned(16))) unsigned char lds_raw[];
  Frame F; F.lds = (LAS unsigned char*)lds_raw; F.ws = args.ws; F.tid = threadIdx.x; F.lane = F.tid & 63; F.wave = __builtin_amdgcn_readfirstlane(F.tid >> 6);
  const int lo = args.ph_lo, hi = args.ph_hi, G = (int)gridDim.x, bx = (int)blockIdx.x;
  volatile LAS unsigned* misc = (volatile LAS unsigned*)(F.lds + MISC_LDS);
  if (F.tid < 16) misc[F.tid] = 0u;
  __syncthreads();
  XcdBarrier bar = xcd_barrier_post((unsigned*)(F.ws + WS_CTL) + CW_BAR, misc);
#define IN(k) (lo <= (k) && (k) < hi)
#define SEAM(k) do { if (IN(k) && IN((k) + 1)) xcd_barrier(bar); } while (0)
#define PHASE_FRAME(Fp) Frame Fp = F; asm volatile("" : "+v"(Fp.tid), "+v"(Fp.lane))
  const int NA = G;
  if (IN(0)) { PHASE_FRAME(F0);
#ifdef SLEEP_START
#pragma unroll 1
    for (int i_ = 0; i_ < SLEEP_START; ++i_) __builtin_amdgcn_s_sleep(127);
#endif
    p0_lam(F0, args);
    p0_zero_vpad(F0);
    p0_rows(F0, args);
    p0_transpose<true>(F0, args, args.in[IN_WIN], DPROJ, NPROJ, (bf16*)(F.ws + WS_W1T));
    p0_transpose<false>(F0, args, args.in[IN_WOUT], DM, DM, (bf16*)(F.ws + WS_W2T));
    p0_w3t(F0, args);
    p0_tables(F0, args);
#ifdef DUP_ROWS
    p0_rows(F0, args);
#endif
#ifdef DUP_TR
    p0_transpose<true>(F0, args, args.in[IN_WIN], DPROJ, NPROJ, (bf16*)(F.ws + WS_W1T));
    p0_transpose<false>(F0, args, args.in[IN_WOUT], DM, DM, (bf16*)(F.ws + WS_W2T));
#endif
#ifdef DUP_W3T
    p0_w3t(F0, args);
#endif
#ifdef DUP_TAB
    p0_tables(F0, args);
#endif
  }
  SEAM(0);
  if (IN(1)) { PHASE_FRAME(F1);
    p1_meta_finalize(F1, args);
    pg8::Gemm g{(const pg8::bf16_t*)(F.ws + WS_XN), (const pg8::bf16_t*)(F.ws + WS_W1T), MROWS, NPROJ, DM};
    pg8::StaticOrder S; S.init(MROWS, NPROJ, G, bx);
    EpiProj E{(bf16*)(F.ws + WS_Q), (bf16*)(F.ws + WS_KP), (bf16*)(F.ws + WS_VP), (bf16*)(F.ws + WS_MQ), (bf16*)(F.ws + WS_MK), (bf16*)(F.ws + WS_MV), (bf16*)(F.ws + WS_MO),
              args.in[IN_QNG], args.in[IN_KNG], (LAS float*)(F.lds + XCH_OFF)};
    pg8::gemm_phase<EpiProj, pg8::StaticOrder, true, true>(F.lds + RING_OFF, g, S, E);
  }
  SEAM(1);
  if (IN(2)) {
    PHASE_FRAME(F2);
    att::phase(F2, (G % 8 == 0) ? (bx & 7) * (G >> 3) + (bx >> 3) : bx, NA);
    for (int task = bx; task < 512; task += G) ml::taskA(F2, args, task);
  }
  SEAM(2);
  if (IN(3)) { PHASE_FRAME(F3); ml::scanB(F3); p3_combine(F3, args, NA); }
  SEAM(3);
  if (IN(4)) {
    PHASE_FRAME(F4);
    for (int task = bx; task < 512; task += G) ml::taskC(F4, args, task);
  }
  SEAM(4);
  if (IN(5)) {
    pg8::Gemm g{(const pg8::bf16_t*)(F.ws + WS_A2), (const pg8::bf16_t*)(F.ws + WS_W2T), MROWS, DM, DM};
    pg8::StaticOrder S; S.init(MROWS, DM, G, bx);
    EpiRes E{args.in[IN_X], args.out, (bf16*)(F.ws + WS_H1B), (float*)(F.ws + WS_SSQ)};
    pg8::gemm_phase<EpiRes, pg8::StaticOrder, true, true>(F.lds + RING_OFF, g, S, E);
  }
  SEAM(5);
  if (IN(6)) {
    pg8::Gemm g{(const pg8::bf16_t*)(F.ws + WS_H1B), (const pg8::bf16_t*)(F.ws + WS_W3T), MROWS, DM, DM};
    pg8::StaticOrder S; S.init(MROWS, DM, G, bx);
    LAS float* rst = (LAS float*)(F.lds + XCH_OFF);
    { pg8::Unit u0; if (S.next(0, u0)) { if (F.tid < 256) { const float* sp = (const float*)(F.ws + WS_SSQ) + ((size_t)u0.pm * 256 + F.tid) * 32; float s = 0.f;
#pragma unroll
          for (int i = 0; i < 8; ++i) { const f32x4 v = ((const f32x4*)sp)[i]; s += (v.x + v.y) + (v.z + v.w); }
          rst[F.tid] = rsqrtf(s * (1.0f / DM) + EPS); } } }
    __syncthreads();
    EpiScore E{(float*)(F.ws + WS_S), rst};
    pg8::gemm_phase<EpiScore, pg8::StaticOrder, true, true>(F.lds + RING_OFF, g, S, E);
  }
  SEAM(6);
  if (IN(7)) { PHASE_FRAME(F7); p6_peer(F7, args, args.out); }
#undef IN
#undef SEAM
}
extern "C" void kernel_launch(void* const* d_in, const int* in_sizes, int n_in, void* d_out, int out_size, void* d_ws, size_t ws_size, hipStream_t stream) {
  static int grid = 0;
  if (grid == 0) {
    int dev = 0, cus = 0, per_cu = 0;
    if (hipGetDevice(&dev) != hipSuccess || hipDeviceGetAttribute(&cus, hipDeviceAttributeMultiprocessorCount, dev) != hipSuccess) { fprintf(stderr, "device query failed\n"); grid = -1; return; }
    if (hipFuncSetAttribute((const void*)mk_fwd, hipFuncAttributeMaxDynamicSharedMemorySize, LDS_BYTES) != hipSuccess) { fprintf(stderr, "hipFuncSetAttribute failed\n"); grid = -1; return; }
    if (hipOccupancyMaxActiveBlocksPerMultiprocessor(&per_cu, (const void*)mk_fwd, NTHR, LDS_BYTES) != hipSuccess || per_cu < 1) { fprintf(stderr, "occupancy query says %d workgroups per CU: not launching\n", per_cu); (void)hipGetLastError(); grid = -1; return; }
    (void)hipGetLastError();
    grid = cus;
    if (n_in != 22 || ws_size < (size_t)512 * MiB || out_size != MROWS * DM) { fprintf(stderr, "unexpected shapes: n_in %d out %d ws %zu\n", n_in, out_size, ws_size); grid = -1; return; }
  }
  if (grid < 0) return;
  unsigned char* ws = (unsigned char*)d_ws;
  if (hipMemsetAsync(ws + WS_CTL, 0, CTL_ZERO_BYTES, stream) != hipSuccess) { fprintf(stderr, "memset failed\n"); return; }
  Args a{};
  for (int i = 0; i < 22; ++i) a.in[i] = (const float*)d_in[i];
  a.out = (float*)d_out; a.ws = ws; a.na = 0; a.pad = 0;
  a.ph_lo = 0; a.ph_hi = 8;
  hipLaunchKernelGGL(mk_fwd, dim3(grid), dim3(NTHR), LDS_BYTES, stream, a);
}
```

```cpp
#include <hip/hip_runtime.h>
#include <cstdio>
#include <cstdint>
#include <math.h>
namespace pg8 {
#define PG8_LAS __attribute__((address_space(3)))
typedef unsigned short bf16_t;
typedef short bf16x8 __attribute__((ext_vector_type(8)));
typedef float f32x4 __attribute__((ext_vector_type(4)));
typedef unsigned u32x4 __attribute__((ext_vector_type(4)));
constexpr int BM = 256, BK = 64, HALF = 128, HTB = HALF * BK * 2  , STAGE_BYTES = 8 * HTB, NXCD = 8, WGM = 8;

__host__ __device__ __forceinline__ int lds_byte(int r, int c) { const int st = (r >> 4) * 2 + (c >> 5), rr = r & 15, cc = c & 31, ob = rr * 64 + cc * 2; return st * 1024 + (ob ^ (((ob >> 9) & 1) << 5)); }
__host__ __device__ __forceinline__ void stage_rc(int b, int& R, int& C) { const int st = b / 1024, sb = b % 1024, swz = sb ^ (((sb >> 9) & 1) << 5); R = (st >> 1) * 16 + swz / 64; C = (st & 1) * 32 + (swz % 64) / 2; }
__host__ __device__ __forceinline__ int perm32(int rho) { const int n = rho >> 4, i = rho & 15; return 8 * (i >> 2) + 4 * n + (i & 3); }

struct Unit { int pm, pn; };
struct Gemm { const bf16_t* A; const bf16_t* Bt; int M, N, K; };

struct StaticOrder {
    int nM, nN, nwg, G, c;
    __host__ __device__ void init(int M, int N, int G_, int c_) { nM = M / BM; nN = N / BM; nwg = nM * nN; G = G_; c = c_; }
    __host__ __device__ bool next(int i, Unit& u) const {
        const long L = (long)i * G + c; if (L >= nwg) return false;
        int wgid = (int)L; { const int q = nwg / NXCD, r = nwg % NXCD, xcd = wgid % NXCD, off = wgid / NXCD; wgid = (xcd < r ? xcd * (q + 1) : r * (q + 1) + (xcd - r) * q) + off; }
        const int nig = WGM * nN, gid = wgid / nig, fm = gid * WGM, gsz = (nM - fm) < WGM ? (nM - fm) : WGM;
        u.pm = fm + ((wgid % nig) % gsz); u.pn = (wgid % nig) / gsz; return true;
    }
    __device__ __forceinline__ void a_ready(const Unit&) const {}
    __device__ __forceinline__ void done(const Unit&) const {}
};

__device__ __forceinline__ unsigned cvt_pk_bf16(float lo, float hi) { unsigned r; asm volatile("v_cvt_pk_bf16_f32 %0, %1, %2" : "=v"(r) : "v"(lo), "v"(hi)); return r; }
typedef float f32x2 __attribute__((ext_vector_type(2)));
template <class Epi, class Sched, bool ALIGN_EPI = false, bool SP2 = false>
__device__ __forceinline__ void gemm_phase(PG8_LAS unsigned char* lds, const Gemm g, const Sched& S, const Epi& E) {
    int tid_ = threadIdx.x; asm volatile("" : "+v"(tid_));
    const int tid = tid_, wid = __builtin_amdgcn_readfirstlane(tid >> 6), lane = tid & 63, wr = wid >> 2, wc = wid & 3, fr = lane & 15, fq = lane >> 4;
    const int K = g.K, nt = K / BK;
    unsigned voffA[2], voffB[2];
#pragma unroll
    for (int i = 0; i < 2; ++i) { int R, C; stage_rc(tid * 16 + i * 8192, R, C); const int Rb = Epi::PERM ? ((R & ~31) + perm32(R & 31)) : R;
        voffA[i] = (unsigned)(R * K + C) * 2u; voffB[i] = (unsigned)(Rb * K + C) * 2u; }
    const size_t kstep = (size_t)(BK * 2);
    const size_t hstep = (size_t)HALF * K * 2;
    const size_t tstep = 2 * hstep;
    const unsigned ldsw = (unsigned)wid * 1024u;
    const int aoff = lds_byte(wr * 64 + fr, fq * 8), boff = lds_byte(wc * 32 + fr, fq * 8);
#define PG8_SA(b, h) (((b) * 2 + (h)) * HTB)
#define PG8_SB(b, h) ((4 + (b) * 2 + (h)) * HTB)
#define PG8_STAGE(bufoff, gbase, voff) do { _Pragma("unroll") for (int _i = 0; _i < 2; ++_i) \
        __builtin_amdgcn_global_load_lds((const unsigned*)((const char*)(gbase) + (voff)[_i]), (PG8_LAS unsigned*)(lds + (bufoff) + ldsw + _i * 8192), 16, 0, 0); } while (0)
#define PG8_LDA(dst, b, h) do { _Pragma("unroll") for (int m = 0; m < 4; ++m) _Pragma("unroll") for (int k = 0; k < 2; ++k) dst[m][k] = *(const PG8_LAS bf16x8*)(lds + PG8_SA(b, h) + aoff + m * 2048 + k * 1024); } while (0)
#define PG8_LDB(dst, b, h) do { _Pragma("unroll") for (int n = 0; n < 2; ++n) _Pragma("unroll") for (int k = 0; k < 2; ++k) dst[n][k] = *(const PG8_LAS bf16x8*)(lds + PG8_SB(b, h) + boff + n * 2048 + k * 1024); } while (0)
#define PG8_MMA(ai, bj, At, Bt) do { __builtin_amdgcn_s_setprio(1); _Pragma("unroll") for (int m = 0; m < 4; ++m) _Pragma("unroll") for (int n = 0; n < 2; ++n) _Pragma("unroll") for (int k = 0; k < 2; ++k) \
        acc[ai][bj][m][n] = __builtin_amdgcn_mfma_f32_16x16x32_bf16(Bt[n][k], At[m][k], acc[ai][bj][m][n], 0, 0, 0); __builtin_amdgcn_s_setprio(0); } while (0)
#define PG8_WAIT_V(n) asm volatile("s_waitcnt vmcnt(" #n ")" ::: "memory")
#define PG8_WAIT_L(n) asm volatile("s_waitcnt lgkmcnt(" #n ")" ::: "memory")
#define PG8_BAR __builtin_amdgcn_s_barrier()
#define PG8_SCHED __builtin_amdgcn_sched_barrier(0)
    Unit cur, nxt; int ui = 0;
    if (!S.next(0, cur)) return;
    f32x4 acc[2][2][4][2];
#pragma unroll
    for (int a = 0; a < 2; ++a)
#pragma unroll
        for (int b = 0; b < 2; ++b)
#pragma unroll
            for (int m = 0; m < 4; ++m)
#pragma unroll
                for (int n = 0; n < 2; ++n) acc[a][b][m][n] = (f32x4){0.f, 0.f, 0.f, 0.f};
    bf16x8 At[4][2], B0[2][2], B1[2][2];
    const char* cA = (const char*)g.A + (size_t)cur.pm * tstep; const char* cB = (const char*)g.Bt + (size_t)cur.pn * tstep;
    S.a_ready(cur);
    if constexpr (SP2) {
        PG8_STAGE(PG8_SB(0, 0), cB, voffB); PG8_STAGE(PG8_SB(0, 1), cB + hstep, voffB); PG8_STAGE(PG8_SA(0, 0), cA, voffA); PG8_STAGE(PG8_SA(0, 1), cA + hstep, voffA);
        if (wr == 1) PG8_BAR;
        PG8_WAIT_V(2); PG8_BAR;
        PG8_STAGE(PG8_SB(1, 0), cB + kstep, voffB); PG8_STAGE(PG8_SA(1, 0), cA + kstep, voffA); PG8_STAGE(PG8_SB(1, 1), cB + hstep + kstep, voffB);
        PG8_WAIT_V(6); PG8_BAR;
    } else {
        PG8_STAGE(PG8_SB(0, 0), cB, voffB); PG8_STAGE(PG8_SA(0, 0), cA, voffA); PG8_STAGE(PG8_SB(0, 1), cB + hstep, voffB); PG8_STAGE(PG8_SA(0, 1), cA + hstep, voffA);
        if (wr == 1) PG8_BAR;
        PG8_WAIT_V(4); PG8_BAR;
        PG8_STAGE(PG8_SB(1, 0), cB + kstep, voffB); PG8_STAGE(PG8_SA(1, 0), cA + kstep, voffA); PG8_STAGE(PG8_SB(1, 1), cB + hstep + kstep, voffB);
        PG8_WAIT_V(6); PG8_BAR;
    }
    for (;;) {
        const bool has_next = S.next(ui + 1, nxt);
        const char* nA = has_next ? (const char*)g.A + (size_t)nxt.pm * tstep : cA; const char* nB = has_next ? (const char*)g.Bt + (size_t)nxt.pn * tstep : cB;
        for (int t = 0; t < nt; t += 2) {
            const bool last = (t == nt - 2);
            const char* a1 = cA + (size_t)(t + 1) * kstep;
            const char* a2 = last ? nA : cA + (size_t)(t + 2) * kstep; const char* b2 = last ? nB : cB + (size_t)(t + 2) * kstep;
            const char* a3 = a2 + kstep; const char* b3 = b2 + kstep;
            if (last && has_next) S.a_ready(nxt);
            if constexpr (SP2) {
            PG8_LDB(B0, 0, 0); PG8_LDB(B1, 0, 1); PG8_SCHED; PG8_LDA(At, 0, 0); PG8_STAGE(PG8_SA(1, 1), a1 + hstep, voffA);
            PG8_WAIT_V(8); PG8_WAIT_L(0); PG8_BAR; PG8_MMA(0, 0, At, B0); PG8_MMA(0, 1, At, B1); PG8_BAR; PG8_SCHED;
            PG8_LDA(At, 0, 1); PG8_STAGE(PG8_SB(0, 0), b2, voffB); PG8_STAGE(PG8_SB(0, 1), b2 + hstep, voffB); PG8_STAGE(PG8_SA(0, 0), a2, voffA);
            PG8_WAIT_V(8); PG8_WAIT_L(0); PG8_BAR; PG8_MMA(1, 0, At, B0); PG8_MMA(1, 1, At, B1); PG8_BAR; PG8_SCHED;
            PG8_LDB(B0, 1, 0); PG8_LDB(B1, 1, 1); PG8_SCHED; PG8_LDA(At, 1, 0); PG8_STAGE(PG8_SA(0, 1), a2 + hstep, voffA);
            PG8_WAIT_V(8); PG8_WAIT_L(0); PG8_BAR; PG8_MMA(0, 0, At, B0); PG8_MMA(0, 1, At, B1); PG8_BAR; PG8_SCHED;
            PG8_LDA(At, 1, 1); PG8_STAGE(PG8_SB(1, 0), b3, voffB); PG8_STAGE(PG8_SB(1, 1), b3 + hstep, voffB); PG8_STAGE(PG8_SA(1, 0), a3, voffA);
            PG8_WAIT_V(8); PG8_WAIT_L(0); PG8_BAR; PG8_MMA(1, 0, At, B0); PG8_MMA(1, 1, At, B1); PG8_BAR; PG8_SCHED;
            } else {
            PG8_LDB(B0, 0, 0); PG8_SCHED; PG8_LDA(At, 0, 0); PG8_STAGE(PG8_SA(1, 1), a1 + hstep, voffA);
            PG8_WAIT_L(8); PG8_BAR; PG8_WAIT_L(0); PG8_MMA(0, 0, At, B0); PG8_BAR; PG8_SCHED;
            PG8_LDB(B1, 0, 1); PG8_STAGE(PG8_SB(0, 0), b2, voffB);
            PG8_BAR; PG8_WAIT_L(0); PG8_MMA(0, 1, At, B1); PG8_BAR;
            PG8_LDA(At, 0, 1); PG8_STAGE(PG8_SA(0, 0), a2, voffA);
            PG8_BAR; PG8_WAIT_L(0); PG8_MMA(1, 0, At, B0); PG8_BAR; PG8_SCHED;
            PG8_STAGE(PG8_SB(0, 1), b2 + hstep, voffB);
            PG8_WAIT_V(6); PG8_BAR; PG8_MMA(1, 1, At, B1); PG8_BAR;
            PG8_LDB(B0, 1, 0); PG8_SCHED; PG8_LDA(At, 1, 0); PG8_STAGE(PG8_SA(0, 1), a2 + hstep, voffA);
            PG8_WAIT_L(8); PG8_BAR; PG8_WAIT_L(0); PG8_MMA(0, 0, At, B0); PG8_BAR; PG8_SCHED;
            PG8_LDB(B1, 1, 1); PG8_STAGE(PG8_SB(1, 0), b3, voffB);
            PG8_BAR; PG8_WAIT_L(0); PG8_MMA(0, 1, At, B1); PG8_BAR;
            PG8_LDA(At, 1, 1); PG8_STAGE(PG8_SA(1, 0), a3, voffA);
            PG8_BAR; PG8_WAIT_L(0); PG8_MMA(1, 0, At, B0); PG8_BAR; PG8_SCHED;
            PG8_STAGE(PG8_SB(1, 1), b3 + hstep, voffB);
            PG8_WAIT_V(6); PG8_BAR; PG8_MMA(1, 1, At, B1); PG8_BAR;
            }
        }
        if constexpr (ALIGN_EPI) { if (wr == 0) PG8_BAR; }
        if constexpr (!Epi::AFTER_DRAIN) { E(acc, cur, wr, wc, fr, fq); S.done(cur); }
        if (!has_next) break;
#pragma unroll
        for (int a = 0; a < 2; ++a)
#pragma unroll
            for (int b = 0; b < 2; ++b)
#pragma unroll
                for (int m = 0; m < 4; ++m)
#pragma unroll
                    for (int n = 0; n < 2; ++n) acc[a][b][m][n] = (f32x4){0.f, 0.f, 0.f, 0.f};
        cur = nxt; cA = nA; cB = nB; ++ui;
        if constexpr (ALIGN_EPI) { if (wr == 1) PG8_BAR; }
    }
    PG8_WAIT_V(0);
    if constexpr (!ALIGN_EPI) { if (wr == 0) PG8_BAR; }
    PG8_BAR;
    if constexpr (Epi::AFTER_DRAIN) { E.fused(acc, cur, wr, wc, fr, fq, lds, wid, lane); S.done(cur); }
#undef PG8_SA
#undef PG8_SB
#undef PG8_STAGE
#undef PG8_LDA
#undef PG8_LDB
#undef PG8_MMA
#undef PG8_WAIT_V
#undef PG8_WAIT_L
#undef PG8_BAR
#undef PG8_SCHED
}
}
#define GAS __attribute__((address_space(1)))
#define LAS __attribute__((address_space(3)))
typedef unsigned short bf16;
typedef unsigned v4u __attribute__((ext_vector_type(4)));
typedef unsigned v2u __attribute__((ext_vector_type(2)));
typedef float f32x4 __attribute__((ext_vector_type(4)));
typedef short bf16x8 __attribute__((ext_vector_type(8)));
#define LDS_WAIT() asm volatile("s_waitcnt lgkmcnt(0)" ::: "memory")
#define VM_WAIT() asm volatile("s_waitcnt vmcnt(0)" ::: "memory")

constexpr int DM = 2048, NB = 4, SEQ = 2048, NMETA = 16, MROWS = NB * SEQ, DPROJ = 6152, NPROJ = 6144;
constexpr int PADT = 2112, POS0 = 64, MPOS0 = 48;
constexpr float EPS = 1e-6f;
constexpr float LOG2E = 1.4426950408889634f;
constexpr float QSCALE = 0.08838834764831845f * LOG2E;
constexpr int NWAVES = 8, NTHR = 512;

constexpr size_t MiB = 1u << 20;
constexpr size_t WS_CTL = 0, CTL_ZERO_BYTES = 32 * 1024;
constexpr size_t WS_PM = 484 * MiB;
constexpr size_t WS_W1T = 2 * MiB, WS_W2T = 26 * MiB, WS_W3T = 34 * MiB, WS_XN = 42 * MiB;
constexpr size_t WS_Q = 74 * MiB, WS_KP = 90 * MiB, WS_VP = 107 * MiB, WS_MQ = 124 * MiB, WS_MK = 133 * MiB, WS_MV = 142 * MiB, WS_MO = 159 * MiB;
constexpr size_t WS_SMALL = 175 * MiB;
constexpr size_t WS_XM = WS_SMALL, WS_LI = WS_SMALL + 128 * 1024, WS_LF = WS_SMALL + 384 * 1024, WS_LAM = WS_SMALL + 640 * 1024;
constexpr size_t WS_PO = 176 * MiB, WS_ML = 304 * MiB, WS_HM = 305 * MiB, WS_A2 = 42 * MiB, WS_H1B = 74 * MiB, WS_SSQ = 106 * MiB, WS_S = 176 * MiB, WS_UB = 384 * MiB, WS_VB = 448 * MiB;
constexpr size_t WS_SCL = WS_SMALL + 704 * 1024;
constexpr size_t WS_VB8 = WS_UB + 32 * MiB;
constexpr size_t WS_DC = 305 * MiB, WS_CS = 448 * MiB, WS_DN = 482 * MiB, WS_NS = WS_DN + 512 * 1024, WS_GS = WS_DN + 1024 * 1024, WS_MS = WS_DN + 1152 * 1024;
constexpr size_t WS_EID = 240 * MiB, WS_EGT = 244 * MiB;
constexpr int CW_BAR = 4096;

constexpr int RING_OFF = 0, RING_BYTES = 131072;
constexpr int XCH_OFF = 131072;
constexpr int MISC_OFF = XCH_OFF + 8192;
constexpr int LDS_BYTES = 155648;

__device__ __forceinline__ unsigned f2bf(float f) { unsigned u = __builtin_bit_cast(unsigned, f); return (u + 0x7fffu + ((u >> 16) & 1u)) >> 16; }
__device__ __forceinline__ unsigned pk2(float lo, float hi) { return f2bf(lo) | (f2bf(hi) << 16); }
__device__ __forceinline__ float bf2f(unsigned short u) { return __builtin_bit_cast(float, (unsigned)u << 16); }
__device__ __forceinline__ float bflo(unsigned w) { return __builtin_bit_cast(float, w << 16); }
__device__ __forceinline__ float bfhi(unsigned w) { return __builtin_bit_cast(float, w & 0xffff0000u); }
__device__ __forceinline__ float wave_sum(float v) {
#pragma unroll
  for (int o = 1; o < 64; o <<= 1) v += __shfl_xor(v, o);
  return v;
}
__device__ __forceinline__ size_t kp_off(int bhm, int pos, int d) { const int j = pos >> 6, row = pos & 63, d0 = d >> 4, hi = (d >> 3) & 1;
  return ((size_t)(bhm * 33 + j) * 8 + d0) * 1024 + (size_t)((((row << 1) | hi) ^ ((row >> 3) & 1)) << 3) + (d & 7); }
__device__ __forceinline__ float wave_sum_dpp(float v) {
  v += __builtin_bit_cast(float, __builtin_amdgcn_update_dpp(0, __builtin_bit_cast(int, v), 0xB1, 0xF, 0xF, true));
  v += __builtin_bit_cast(float, __builtin_amdgcn_update_dpp(0, __builtin_bit_cast(int, v), 0x4E, 0xF, 0xF, true));
  v += __builtin_bit_cast(float, __builtin_amdgcn_update_dpp(0, __builtin_bit_cast(int, v), 0x141, 0xF, 0xF, true));
  v += __builtin_bit_cast(float, __builtin_amdgcn_update_dpp(0, __builtin_bit_cast(int, v), 0x140, 0xF, 0xF, true));
  const float r0 = __builtin_bit_cast(float, __builtin_amdgcn_readlane(__builtin_bit_cast(int, v), 0)), r1 = __builtin_bit_cast(float, __builtin_amdgcn_readlane(__builtin_bit_cast(int, v), 16));
  const float r2 = __builtin_bit_cast(float, __builtin_amdgcn_readlane(__builtin_bit_cast(int, v), 32)), r3 = __builtin_bit_cast(float, __builtin_amdgcn_readlane(__builtin_bit_cast(int, v), 48));
  return (r0 + r1) + (r2 + r3);
}
__device__ __forceinline__ float sigmoidf_(float x) { return 1.0f / (1.0f + __expf(-x)); }
#define XB_TMO      128
#define XB_XCNT(j)  (256  + 64 * (j))
#define XB_XSUB(j)  (1280 + 64 * (j))
#define XB_XGEN(j)  (2304 + 64 * (j))
#define XB_TOP      3328
#define XB_TOPGEN   3392
#define XCD_BAR_WORDS 3456
#define XB_SPIN_CAP (1u << 18)

__device__ __forceinline__ unsigned xb_ld(unsigned* p)              { return __hip_atomic_load(p, __ATOMIC_RELAXED, __HIP_MEMORY_SCOPE_AGENT); }
__device__ __forceinline__ unsigned xb_add(unsigned* p, unsigned v) { return __hip_atomic_fetch_add(p, v, __ATOMIC_RELAXED, __HIP_MEMORY_SCOPE_AGENT); }
__device__ __forceinline__ unsigned xb_xcc_id() { return (unsigned)__builtin_amdgcn_s_getreg((3 << 11) | 20) & 0xFu; }
#define XB_SPIN(cond, bar) do { unsigned _sp = 0; while (cond) { __builtin_amdgcn_s_sleep(1); \
    if ((++_sp & 255u) == 0u) { if (xb_ld(&(bar)[XB_TMO])) break; if (_sp > XB_SPIN_CAP) { atomicAdd(&(bar)[XB_TMO], 1u); break; } } } } while (0)

struct XcdBarrier {
    unsigned* bar; unsigned x;
    volatile LAS unsigned* st;
};

__device__ __forceinline__ XcdBarrier xcd_barrier_post(unsigned* bar, volatile LAS unsigned* st) {
    XcdBarrier b; b.bar = bar; b.x = xb_xcc_id(); b.st = st;
    if (threadIdx.x == 0) (void)xb_add(&bar[XB_XCNT(b.x)], 1u);
    return b;
}
__device__ __forceinline__ void xcd_barrier_complete(unsigned* bar, unsigned x, unsigned& nloc, unsigned& nx) {
    const unsigned G = gridDim.x * gridDim.y * gridDim.z;
    unsigned sum, cnt, mine, sp = 0u;
    for (;;) {
        sum = 0u; cnt = 0u; mine = 0u;
#pragma unroll
        for (unsigned j = 0; j < 16; ++j) { const unsigned c = xb_ld(&bar[XB_XCNT(j)]); sum += c; cnt += (c > 0u) ? 1u : 0u; mine = (j == x) ? c : mine; }
        if (sum == G) break;
        __builtin_amdgcn_s_sleep(1);
        if ((++sp & 255u) == 0u) { if (xb_ld(&bar[XB_TMO])) break; if (sp > XB_SPIN_CAP) { atomicAdd(&bar[XB_TMO], 1u); break; } }
    }
    nloc = mine > 0u ? mine : 1u; nx = cnt > 0u ? cnt : 1u;
}

__device__ __forceinline__ void xcd_barrier(const XcdBarrier& b) {
    asm volatile("s_waitcnt vmcnt(0)" ::: "memory");
    __syncthreads();
    if (threadIdx.x == 0) {
        unsigned* bar = b.bar;
        __builtin_amdgcn_s_waitcnt(0);
        unsigned nloc = b.st[0], nx = b.st[1];
        if (nloc == 0u) { xcd_barrier_complete(bar, b.x, nloc, nx); b.st[0] = nloc; b.st[1] = nx; }
        const unsigned old = xb_add(&bar[XB_XSUB(b.x)], 1u);
        const unsigned gen = old / nloc;
        if (old + 1u == (gen + 1u) * nloc) {
            __builtin_amdgcn_fence(__ATOMIC_RELEASE, "agent");
            asm volatile("s_waitcnt vmcnt(0)" ::: "memory");
            const unsigned og = xb_add(&bar[XB_TOP], 1u);
            const unsigned tg = og / nx;
            if (og + 1u == (tg + 1u) * nx) xb_add(&bar[XB_TOPGEN], 1u);
            else XB_SPIN(xb_ld(&bar[XB_TOPGEN]) == tg, bar);
            __builtin_amdgcn_fence(__ATOMIC_ACQUIRE, "agent");
            xb_add(&bar[XB_XGEN(b.x)], 1u);
            asm volatile("s_waitcnt vmcnt(0)" ::: "memory");
        } else {
            XB_SPIN(xb_ld(&bar[XB_XGEN(b.x)]) == gen, bar);
            __builtin_amdgcn_fence(__ATOMIC_ACQUIRE, "agent");
            asm volatile("s_waitcnt vmcnt(0)" ::: "memory");
        }
    }
    __syncthreads();
}

struct Args { const float* in[22]; float* out; unsigned char* ws; int ph_lo, ph_hi, na, pad; };
struct Frame {
  LAS unsigned char* lds; unsigned char* ws; int tid, lane, wave; const float* const* in;
};
#define IN_X 0
#define IN_META 1
#define IN_G1 2
#define IN_WIN 3
#define IN_CW 4
#define IN_CB 5
#define IN_IGB 6
#define IN_FGB 7
#define IN_LQ1 8
#define IN_LK1 9
#define IN_LQ2 10
#define IN_LK2 11
#define IN_QNG 12
#define IN_KNG 13
#define IN_SUBG 14
#define IN_OUTG 15
#define IN_WOUT 16
#define IN_G2 17
#define IN_WQ 18
#define IN_SUBK 19
#define IN_U 20
#define IN_V 21

__device__ __forceinline__ void p0_rows(const Frame& F, const Args& a) {
  const float* x = a.in[IN_X]; const float* meta = a.in[IN_META]; const float* g1 = a.in[IN_G1]; const float* w_in = a.in[IN_WIN];
  const float* igb = a.in[IN_IGB]; const float* fgb = a.in[IN_FGB];
  bf16* Xn = (bf16*)(F.ws + WS_XN); bf16* Xm = (bf16*)(F.ws + WS_XM); float* LI = (float*)(F.ws + WS_LI); float* LF = (float*)(F.ws + WS_LF);
  LAS f32x4* wgl = (LAS f32x4*)(F.lds);
  for (int e = F.tid; e < 4096; e += NTHR) {
    const int ln = e & 63, q = e >> 6, half = q & 1, j = (q >> 1) & 3, i = q >> 3;
    const int k = 4 * (i * 64 + ln) + j;
    wgl[e] = *(const f32x4*)(w_in + (size_t)k * DPROJ + NPROJ + 4 * half);
  }
  __syncthreads();
  const int gw = blockIdx.x * NWAVES + F.wave, NGW = gridDim.x * NWAVES, lane = F.lane;
  constexpr int NTASK = MROWS / 2 + NMETA / 2;
  f32x4 xnx[2][8];
  if (gw < NTASK) { const float* sn = (gw >= MROWS / 2 ? meta + (size_t)(gw - MROWS / 2) * 2 * DM : x + (size_t)gw * 2 * DM);
#pragma unroll
    for (int i = 0; i < 8; ++i) { xnx[0][i] = ((const f32x4*)sn)[i * 64 + lane]; xnx[1][i] = ((const f32x4*)(sn + DM))[i * 64 + lane]; } }
  for (int task = gw; task < NTASK; task += NGW) {
    const bool ismeta = task >= MROWS / 2;
    const int r0 = ismeta ? (task - MROWS / 2) * 2 : task * 2;
    f32x4 xv[2][8]; float rs[2];
    { float s0 = 0.f, s1 = 0.f;
#pragma unroll
      for (int i = 0; i < 8; ++i) { xv[0][i] = xnx[0][i]; xv[1][i] = xnx[1][i]; }
      { const int tn = task + NGW; if (tn < NTASK) { const float* sn = (tn >= MROWS / 2 ? meta + (size_t)(tn - MROWS / 2) * 2 * DM : x + (size_t)tn * 2 * DM);
#pragma unroll
          for (int i = 0; i < 8; ++i) { xnx[0][i] = ((const f32x4*)sn)[i * 64 + lane]; xnx[1][i] = ((const f32x4*)(sn + DM))[i * 64 + lane]; } } }
#pragma unroll
      for (int i = 0; i < 8; ++i) { const f32x4 a0 = xv[0][i], a1 = xv[1][i];
        s0 += (a0.x * a0.x + a0.y * a0.y) + (a0.z * a0.z + a0.w * a0.w); s1 += (a1.x * a1.x + a1.y * a1.y) + (a1.z * a1.z + a1.w * a1.w); }
      rs[0] = rsqrtf(wave_sum_dpp(s0) * (1.0f / DM) + EPS); rs[1] = rsqrtf(wave_sum_dpp(s1) * (1.0f / DM) + EPS); }
    float ga[2][8];
#pragma unroll
    for (int rr = 0; rr < 2; ++rr)
#pragma unroll
      for (int g = 0; g < 8; ++g) ga[rr][g] = 0.f;
    bf16* dst0 = (ismeta ? Xm : Xn) + (size_t)r0 * DM;
#pragma unroll
    for (int i = 0; i < 8; ++i) {
      const f32x4 g = ((const f32x4*)g1)[i * 64 + lane];
      f32x4 xn[2];
#pragma unroll
      for (int rr = 0; rr < 2; ++rr) { xn[rr] = xv[rr][i] * g * rs[rr];
        v2u o; o.x = pk2(xn[rr].x, xn[rr].y); o.y = pk2(xn[rr].z, xn[rr].w); ((v2u*)(dst0 + (size_t)rr * DM))[i * 64 + lane] = o; }
#pragma unroll
      for (int j = 0; j < 4; ++j) {
        const f32x4 w0 = wgl[((i * 4 + j) * 2 + 0) * 64 + lane], w1 = wgl[((i * 4 + j) * 2 + 1) * 64 + lane];
#pragma unroll
        for (int rr = 0; rr < 2; ++rr) { const float xs_ = xn[rr][j];
          ga[rr][0] += xs_ * w0.x; ga[rr][1] += xs_ * w0.y; ga[rr][2] += xs_ * w0.z; ga[rr][3] += xs_ * w0.w;
          ga[rr][4] += xs_ * w1.x; ga[rr][5] += xs_ * w1.y; ga[rr][6] += xs_ * w1.z; ga[rr][7] += xs_ * w1.w; }
      }
      __builtin_amdgcn_sched_barrier(0);
    }
#pragma unroll
    for (int rr = 0; rr < 2; ++rr)
#pragma unroll
      for (int g = 0; g < 8; ++g) ga[rr][g] = wave_sum_dpp(ga[rr][g]);
    if (lane < 8) {
      const int rr = lane >> 2, h = lane & 3;
      float gi = 0.f, gf = 0.f;
#pragma unroll
      for (int q = 0; q < 2; ++q)
#pragma unroll
        for (int hh = 0; hh < 4; ++hh) if (q == rr && hh == h) { gi = ga[q][hh]; gf = ga[q][4 + hh]; }
      const float li = gi + igb[h]; const float fx = gf + fgb[h];
      const float lf = fminf(fx, 0.f) - log1pf(__expf(-fabsf(fx)));
      const int R = r0 + rr;
      if (!ismeta) { const int b = R >> 11, t = R & 2047; LI[(b * 4 + h) * PADT + POS0 + t] = li; LF[(b * 4 + h) * PADT + POS0 + t] = lf; }
      else { for (int b = 0; b < NB; ++b) { LI[(b * 4 + h) * PADT + MPOS0 + R] = li; LF[(b * 4 + h) * PADT + MPOS0 + R] = lf; } }
    }
  }
  __syncthreads();
}
template <bool META>
__device__ __forceinline__ void p0_transpose(const Frame& F, const Args& a, const float* W, int ldw, int N, bf16* Wt) {
  LAS float* tl = (LAS float*)(F.lds);
  LAS float* red = (LAS float*)(F.lds + 33792);
  float* PM = (float*)(F.ws + WS_PM);
  const float* meta = a.in[IN_META]; const float* g1 = a.in[IN_G1];
  const int ntn = N / 64, ntask = ntn * 16, fr = F.lane & 15, fq = F.lane >> 4, w = F.wave;
  f32x4 wn[4];
  float am[4], ag[4];
  if ((int)blockIdx.x < ntask) { const int nb = blockIdx.x % ntn, kb = blockIdx.x / ntn;
#pragma unroll
    for (int i = 0; i < 4; ++i) { const int idx = F.tid + NTHR * i, kk = idx >> 4, c4 = idx & 15; wn[i] = *(const f32x4*)(W + (size_t)(kb * 128 + kk) * ldw + nb * 64 + 4 * c4); }
    if (META) {
#pragma unroll
      for (int s_ = 0; s_ < 4; ++s_) { const int k = kb * 128 + 16 * w + 4 * s_ + fq; am[s_] = meta[(size_t)fr * DM + k]; ag[s_] = g1[k]; } } }
  for (int task = blockIdx.x; task < ntask; task += gridDim.x) {
    const int nb = task % ntn, kb = task / ntn, n0 = nb * 64, k0 = kb * 128;
    __syncthreads();
#pragma unroll
    for (int i = 0; i < 4; ++i) { const int idx = F.tid + NTHR * i, kk = idx >> 4, c4 = idx & 15; const f32x4 wv = wn[i];
      LAS float* d = tl + kk * 65 + 4 * c4; d[0] = wv.x; d[1] = wv.y; d[2] = wv.z; d[3] = wv.w; }
    float ac[4];
    if (META) {
#pragma unroll
      for (int s_ = 0; s_ < 4; ++s_) ac[s_] = am[s_] * ag[s_]; }
    { const int tn = task + gridDim.x; if (tn < ntask) { const int nb2 = tn % ntn, kb2 = tn / ntn;
#pragma unroll
        for (int i = 0; i < 4; ++i) { const int idx = F.tid + NTHR * i, kk = idx >> 4, c4 = idx & 15; wn[i] = *(const f32x4*)(W + (size_t)(kb2 * 128 + kk) * ldw + nb2 * 64 + 4 * c4); }
        if (META) {
#pragma unroll
          for (int s_ = 0; s_ < 4; ++s_) { const int k = kb2 * 128 + 16 * w + 4 * s_ + fq; am[s_] = meta[(size_t)fr * DM + k]; ag[s_] = g1[k]; } } } }
    __syncthreads();
    const int n = F.tid >> 3, kc = F.tid & 7;
    const LAS float* s = tl + (kc * 16) * 65 + n;
    v4u o0, o1;
    o0.x = pk2(s[0 * 65], s[1 * 65]); o0.y = pk2(s[2 * 65], s[3 * 65]); o0.z = pk2(s[4 * 65], s[5 * 65]); o0.w = pk2(s[6 * 65], s[7 * 65]);
    o1.x = pk2(s[8 * 65], s[9 * 65]); o1.y = pk2(s[10 * 65], s[11 * 65]); o1.z = pk2(s[12 * 65], s[13 * 65]); o1.w = pk2(s[14 * 65], s[15 * 65]);
    v4u* dp = (v4u*)(Wt + (size_t)(n0 + n) * DM + k0 + kc * 16);
    dp[0] = o0; dp[1] = o1;
    if (META && n0 >= 1024) {
      f32x4 acc[4];
#pragma unroll
      for (int nt = 0; nt < 4; ++nt) acc[nt] = (f32x4){0.f, 0.f, 0.f, 0.f};
#pragma unroll
      for (int s_ = 0; s_ < 4; ++s_)
#pragma unroll
        for (int nt = 0; nt < 4; ++nt) acc[nt] = __builtin_amdgcn_mfma_f32_16x16x4f32(ac[s_], tl[(16 * w + 4 * s_ + fq) * 65 + nt * 16 + fr], acc[nt], 0, 0, 0);
#pragma unroll
      for (int nt = 0; nt < 4; ++nt)
#pragma unroll
        for (int i = 0; i < 4; ++i) red[(w * 16 + 4 * fq + i) * 64 + nt * 16 + fr] = acc[nt][i];
      __syncthreads();
#pragma unroll
      for (int j = 0; j < 2; ++j) { const int idx = F.tid + NTHR * j, m = idx >> 6, nn = idx & 63; const LAS float* r = red + m * 64 + nn;
        PM[((size_t)kb * 16 + m) * NPROJ + n0 + nn] = ((r[0] + r[1024]) + (r[2048] + r[3072])) + ((r[4096] + r[5120]) + (r[6144] + r[7168])); }
    }
  }
  __syncthreads();
}
__device__ __forceinline__ void p0_zero_vpad(const Frame& F) {
  bf16* Vp = (bf16*)(F.ws + WS_VP);
  const int per = MPOS0 * 256 / 8;
  for (int i = blockIdx.x * NTHR + F.tid; i < 16 * per; i += gridDim.x * NTHR) { const int bh = i / per, e = i % per;
    *(v4u*)(Vp + (size_t)bh * PADT * 256 + (size_t)e * 8) = (v4u){0u, 0u, 0u, 0u}; }
}
__device__ __forceinline__ void p0_lam(const Frame& F, const Args& a) {
  if (blockIdx.x == 0 && F.wave == 0) {
    const int l = F.lane;
    float s1 = a.in[IN_LQ1][l] * a.in[IN_LK1][l] + a.in[IN_LQ1][l + 64] * a.in[IN_LK1][l + 64];
    float s2 = a.in[IN_LQ2][l] * a.in[IN_LK2][l] + a.in[IN_LQ2][l + 64] * a.in[IN_LK2][l + 64];
    s1 = wave_sum(s1); s2 = wave_sum(s2);
    if (l == 0) *(float*)(F.ws + WS_LAM) = __expf(s1) - __expf(s2) + 0.2f;
  }
}

struct EpiProj {
  static constexpr bool PERM = true, AFTER_DRAIN = false;
  bf16 *Qb, *Kp, *Vp, *MQ, *MK, *MV, *MO; const float *qg, *kg; LAS float* xch;
  __device__ __forceinline__ void operator()(const pg8::f32x4 (&acc)[2][2][4][2], const pg8::Unit& u, int wr, int wc, int fr, int fq) const {
    const int pn = u.pn, b = u.pm >> 3, tb = (u.pm & 7) * 256 + wr * 64 + fr, d0 = wc * 32 + fq * 8;
    if (pn < 8) {
      const bool isk = pn >= 4; const int h = pn & 3;
      float ssq[2][4][2];
#pragma unroll
      for (int ai = 0; ai < 2; ++ai)
#pragma unroll
        for (int m = 0; m < 4; ++m)
#pragma unroll
          for (int bj = 0; bj < 2; ++bj) { float s = 0.f;
#pragma unroll
            for (int n = 0; n < 2; ++n) { const pg8::f32x4 x = acc[ai][bj][m][n]; s += (x[0] * x[0] + x[1] * x[1]) + (x[2] * x[2] + x[3] * x[3]); }
            s += __shfl_xor(s, 16); s += __shfl_xor(s, 32); ssq[ai][m][bj] = s;
            if (fq == 0) xch[((ai * 128 + wr * 64 + m * 16 + fr) * 2 + bj) * 4 + wc] = s; }
      asm volatile("s_waitcnt lgkmcnt(0)" ::: "memory"); __builtin_amdgcn_s_barrier(); asm volatile("" ::: "memory");
      const float* gp = (isk ? kg : qg) + d0; const f32x4 g0 = *(const f32x4*)gp, g1v = *(const f32x4*)(gp + 4);
      const float sc = isk ? 1.0f : QSCALE;
#pragma unroll
      for (int ai = 0; ai < 2; ++ai)
#pragma unroll
        for (int m = 0; m < 4; ++m)
#pragma unroll
          for (int bj = 0; bj < 2; ++bj) {
            const f32x4 p = *(const LAS f32x4*)(xch + ((ai * 128 + wr * 64 + m * 16 + fr) * 2 + bj) * 4);
            const float rs = rsqrtf(((p.x + p.y) + (p.z + p.w)) * (1.0f / 128.f) + EPS) * sc;
            const pg8::f32x4 v0 = acc[ai][bj][m][0], v1 = acc[ai][bj][m][1];
            v4u w; w.x = pk2(v0[0] * rs * g0.x, v0[1] * rs * g0.y); w.y = pk2(v0[2] * rs * g0.z, v0[3] * rs * g0.w);
            w.z = pk2(v1[0] * rs * g1v.x, v1[1] * rs * g1v.y); w.w = pk2(v1[2] * rs * g1v.z, v1[3] * rs * g1v.w);
            const int t = tb + ai * 128 + m * 16;
            bf16* dst = isk ? Kp + kp_off((b * 4 + h) * 2 + bj, POS0 + t, d0)
                            : Qb + ((size_t)((b * 4 + h) * 2 + bj) * SEQ + t) * 128 + d0;
            *(v4u*)dst = w; }
      return;
    }
#pragma unroll
    for (int ai = 0; ai < 2; ++ai)
#pragma unroll
      for (int m = 0; m < 4; ++m)
#pragma unroll
        for (int bj = 0; bj < 2; ++bj) {
          pg8::f32x4 v0 = acc[ai][bj][m][0], v1 = acc[ai][bj][m][1];
          const int t = tb + ai * 128 + m * 16;
          bf16* dst;
          if (pn < 12) { const int h = pn - 8; dst = Vp + ((size_t)(b * 4 + h) * PADT + POS0 + t) * 256 + bj * 128 + d0; }
          else if (pn < 16) { const int h = 2 * (pn & 1) + bj; dst = (pn >= 14 ? MK : MQ) + ((size_t)(b * 4 + h) * PADT + POS0 + t) * 128 + d0; }
          else if (pn < 20) { const int h = pn - 16; dst = MV + ((size_t)(b * 4 + h) * PADT + POS0 + t) * 256 + bj * 128 + d0; }
          else { dst = MO + (size_t)(b * SEQ + t) * 1024 + (pn - 20) * 256 + bj * 128 + d0;
#pragma unroll
            for (int j = 0; j < 4; ++j) { v0[j] = sigmoidf_(v0[j]); v1[j] = sigmoidf_(v1[j]); } }
          v4u w; w.x = pk2(v0[0], v0[1]); w.y = pk2(v0[2], v0[3]); w.z = pk2(v1[0], v1[1]); w.w = pk2(v1[2], v1[3]);
          *(v4u*)dst = w; }
  }
};
__device__ __forceinline__ void p1_meta_finalize(const Frame& F, const Args& a) {
  if (blockIdx.x >= NMETA) return;
  const int mrow = blockIdx.x, tid = F.tid, lane = F.lane, w = F.wave;
  const float* meta = a.in[IN_META] + (size_t)mrow * DM; const float* PM0 = (const float*)(F.ws + WS_PM) + (size_t)mrow * NPROJ;
#define PM_P4(i, p) ((PM0[(size_t)(16 * (p)) * NPROJ + (i)] + PM0[(size_t)(16 * ((p) + 1)) * NPROJ + (i)]) + (PM0[(size_t)(16 * ((p) + 2)) * NPROJ + (i)] + PM0[(size_t)(16 * ((p) + 3)) * NPROJ + (i)]))
#define PM_AT(i) ((PM_P4(i, 0) + PM_P4(i, 4)) + (PM_P4(i, 8) + PM_P4(i, 12)))
  LAS float* red = (LAS float*)(F.lds + XCH_OFF);
  const f32x4 mv = ((const f32x4*)meta)[tid];
  float s = wave_sum((mv.x * mv.x + mv.y * mv.y) + (mv.z * mv.z + mv.w * mv.w));
  if (lane == 0) red[w] = s;
  __syncthreads();
  float tot = 0.f;
#pragma unroll
  for (int i = 0; i < 8; ++i) tot += red[i];
  const float rs = rsqrtf(tot * (1.0f / DM) + EPS);
  bf16* Kp = (bf16*)(F.ws + WS_KP); bf16* Vp = (bf16*)(F.ws + WS_VP); bf16* MQ = (bf16*)(F.ws + WS_MQ); bf16* MK = (bf16*)(F.ws + WS_MK); bf16* MV = (bf16*)(F.ws + WS_MV);
  const int pos = MPOS0 + mrow;
  {
    const float v0 = PM_AT(1024 + w * 128 + lane) * rs, v1 = PM_AT(1024 + w * 128 + lane + 64) * rs;
    const float rk = rsqrtf(wave_sum(v0 * v0 + v1 * v1) * (1.0f / 128.f) + EPS);
    const float* kg = a.in[IN_KNG];
    const unsigned short o0 = (unsigned short)f2bf(v0 * rk * kg[lane]), o1 = (unsigned short)f2bf(v1 * rk * kg[lane + 64]);
    for (int b = 0; b < NB; ++b) { const int bhm = (b * 4 + (w >> 1)) * 2 + (w & 1); Kp[kp_off(bhm, pos, lane)] = o0; Kp[kp_off(bhm, pos, lane + 64)] = o1; }
  }
  { const int c = tid * 2;
    const unsigned o = pk2(PM_AT(2048 + c) * rs, PM_AT(2048 + c + 1) * rs); const int h = c >> 8, e = c & 255;
    for (int b = 0; b < NB; ++b) *(unsigned*)(Vp + ((size_t)(b * 4 + h) * PADT + pos) * 256 + e) = o;
    const unsigned o2 = pk2(PM_AT(3072 + c) * rs, PM_AT(3072 + c + 1) * rs); const bool isk = c >= 512; const int cc = c & 511, hq = cc >> 7, d = cc & 127;
    for (int b = 0; b < NB; ++b) *(unsigned*)((isk ? MK : MQ) + ((size_t)(b * 4 + hq) * PADT + pos) * 128 + d) = o2;
    const unsigned o3 = pk2(PM_AT(4096 + c) * rs, PM_AT(4096 + c + 1) * rs);
    for (int b = 0; b < NB; ++b) *(unsigned*)(MV + ((size_t)(b * 4 + h) * PADT + pos) * 256 + e) = o3;
  }
  __syncthreads();
}
#undef PM_AT
#undef PM_P4

namespace att {
using f32x16 = __attribute__((ext_vector_type(16))) float;
using s16x4 = __attribute__((ext_vector_type(4))) short;
constexpr int STEPS_BHM = 152, NSTEPS = 32 * STEPS_BHM;
constexpr int SHM_V = 64 * 256 * 2, SHM_K = 64 * 128 * 2;
constexpr int LDS_V = 0, LDS_K = 2 * SHM_V, LDS_Q = LDS_K + SHM_K, LDS_WS = LDS_Q + 8 * 8192;
constexpr float THR2 = 8.0f;
#define KSWZ(row, colB) ((row) * 256 + ((colB) ^ (((row) & 7) << 4)))
#define SBAR() __builtin_amdgcn_sched_barrier(0)
__device__ __forceinline__ int crow(int r, int hi) { return (r & 3) + 8 * (r >> 2) + 4 * hi; }
__device__ __forceinline__ unsigned cvtpk(float lo, float hi) { unsigned r; asm volatile("v_cvt_pk_bf16_f32 %0, %1, %2" : "=v"(r) : "v"(lo), "v"(hi)); return r; }
__device__ __forceinline__ int qb_start(int qb) { return 2 * qb * qb + 3 * qb; }
__device__ __forceinline__ int chunk_of(int s, int NA) { return ((s + 1) * NA - 1) / NSTEPS; }

template <int OFF> __device__ __forceinline__ s16x4 tr_read(int vb) {
  s16x4 r; asm volatile("ds_read_b64_tr_b16 %0, %1 offset:%2" : "=&v"(r) : "v"(vb), "i"(OFF) : "memory"); return r;
}
constexpr int v_rd_off(int d0, int ks, int half) { return d0 * 512 + ks * 8192 + half * 4096; }
template <int D0> __device__ __forceinline__ void pv_one(f32x16& od, int vb, bf16x8 pa0, bf16x8 pa1, bf16x8 pa2, bf16x8 pa3) {
#define PK(L, H) (bf16x8){L[0], L[1], L[2], L[3], H[0], H[1], H[2], H[3]}
  { const s16x4 l0 = tr_read<v_rd_off(D0, 0, 0)>(vb), h0 = tr_read<v_rd_off(D0, 0, 1)>(vb), l1 = tr_read<v_rd_off(D0, 1, 0)>(vb), h1 = tr_read<v_rd_off(D0, 1, 1)>(vb);
    asm volatile("s_waitcnt lgkmcnt(0)" ::: "memory"); SBAR();
    od = __builtin_amdgcn_mfma_f32_32x32x16_bf16(pa0, PK(l0, h0), od, 0, 0, 0);
    od = __builtin_amdgcn_mfma_f32_32x32x16_bf16(pa1, PK(l1, h1), od, 0, 0, 0); }
  SBAR();
  { const s16x4 l2 = tr_read<v_rd_off(D0, 2, 0)>(vb), h2 = tr_read<v_rd_off(D0, 2, 1)>(vb), l3 = tr_read<v_rd_off(D0, 3, 0)>(vb), h3 = tr_read<v_rd_off(D0, 3, 1)>(vb);
    asm volatile("s_waitcnt lgkmcnt(0)" ::: "memory"); SBAR();
    od = __builtin_amdgcn_mfma_f32_32x32x16_bf16(pa2, PK(l2, h2), od, 0, 0, 0);
    od = __builtin_amdgcn_mfma_f32_32x32x16_bf16(pa3, PK(l3, h3), od, 0, 0, 0); }
#undef PK
}

__device__ __forceinline__ void segment(const Frame& F, int bhm, int qb, int j0, int j1, int slot) {
  const int tid = F.tid, wid = F.wave, lane = F.lane, r32 = lane & 31, hi = lane >> 5;
  const bf16* Qg = (const bf16*)(F.ws + WS_Q) + ((size_t)bhm * SEQ + qb * 256 + wid * 32 + r32) * 128 + hi * 8;
  const bf16* Kg = (const bf16*)(F.ws + WS_KP) + (size_t)bhm * 33 * 8192;
  const bf16* Vg = (const bf16*)(F.ws + WS_VP) + (size_t)(bhm >> 1) * PADT * 256;
  LAS unsigned char* lds = F.lds;
  LAS float* wsl = (LAS float*)(lds + LDS_WS) + wid * 64;
  const float slope2 = exp2f(-2.0f * (float)(((bhm >> 1) & 3) + 1)) * LOG2E;
  unsigned ksrc0, vsrc0;
  ksrc0 = (unsigned)tid * 16u;
  { const int a8 = tid >> 8, b = (tid >> 2) & 7, k = 8 * (b >> 2) + 4 * a8 + (b & 3), c = ((tid >> 5) & 7) * 32 + (tid & 3) * 8; vsrc0 = (unsigned)(k * 256 + c) * 2u; }
#define STAGE_K(j) do { const char* kt = (const char*)(Kg + (size_t)(j) * 8192); \
    _Pragma("unroll") for (int _i = 0; _i < 2; ++_i) __builtin_amdgcn_global_load_lds((const unsigned*)(kt + (ksrc0 + _i * 8192u)), (LAS unsigned*)(lds + LDS_K + _i * 8192 + wid * 1024), 16, 0, 0); } while (0)
#define STAGE_V(buf, j) do { const char* vt = (const char*)(Vg + (size_t)(j) * 64 * 256); \
    _Pragma("unroll") for (int _i = 0; _i < 4; ++_i) __builtin_amdgcn_global_load_lds((const unsigned*)(vt + (vsrc0 + _i * 8192u)), (LAS unsigned*)(lds + LDS_V + (buf) * SHM_V + _i * 8192 + wid * 1024), 16, 0, 0); } while (0)
  const int lt = (((r32 << 1) | hi) ^ ((r32 >> 3) & 1)) << 4;
  LAS unsigned char* Qs = lds + LDS_Q + wid * 8192;
#pragma unroll
  for (int d0 = 0; d0 < 8; ++d0) { const bf16x8 qv = *(const bf16x8*)(Qg + d0 * 16); *(LAS bf16x8*)(Qs + d0 * 1024 + lt) = qv; }
  f32x16 o[8];
#pragma unroll
  for (int d = 0; d < 8; ++d)
#pragma unroll
    for (int r = 0; r < 16; ++r) o[d][r] = 0.f;
  float m_reg = -1e30f, l_reg = 0.f;
  const int vb0 = (int)(uintptr_t)(lds + LDS_V) + (((lane & 3) << 3) | (((lane >> 2) & 3) << 6) | (((lane >> 4) & 1) << 5) | (((lane >> 5) & 1) << 8));
  STAGE_K(j0); STAGE_V(0, j0);
  VM_WAIT(); __syncthreads();
  for (int j = j0; j < j1; ++j) {
    const int cur = (j - j0) & 1;
    if (j + 1 < j1) STAGE_V(cur ^ 1, j + 1);
    SBAR();
    f32x16 p0 = {}, p1 = {};
    { const LAS unsigned char* Ks = lds + LDS_K;
#pragma unroll
      for (int d0 = 0; d0 < 8; ++d0) {
        const bf16x8 b0 = *(const LAS bf16x8*)(Ks + d0 * 2048 + lt);
        const bf16x8 b1 = *(const LAS bf16x8*)(Ks + d0 * 2048 + 1024 + lt);
        const bf16x8 qf = *(const LAS bf16x8*)(Qs + d0 * 1024 + lt);
        p0 = __builtin_amdgcn_mfma_f32_32x32x16_bf16(b0, qf, p0, 0, 0, 0);
        p1 = __builtin_amdgcn_mfma_f32_32x32x16_bf16(b1, qf, p1, 0, 0, 0); } }
    asm volatile("s_waitcnt lgkmcnt(0)" ::: "memory"); __builtin_amdgcn_s_barrier(); asm volatile("" ::: "memory");
    if (j + 1 < j1) STAGE_K(j + 1);
    SBAR();
    if (j == 0) {
#pragma unroll
      for (int r = 0; r < 16; ++r) p0[r] = -INFINITY;
#pragma unroll
      for (int r = 0; r < 8; ++r) p1[r] = -INFINITY;
    }
    int ln2 = threadIdx.x & 63; asm volatile("" : "+v"(ln2));
    const int hi2 = ln2 >> 5;
    const int jb = j - (4 * qb + 1);
    if (jb >= 0) {
      const int kb = 64 * jb + 4 * hi2, qrel = wid * 32 + (ln2 & 31);
#pragma unroll
      for (int r = 0; r < 16; ++r) { const int kv = kb + (r & 3) + 8 * (r >> 2); if (kv > qrel) p0[r] = -INFINITY; if (kv + 32 > qrel) p1[r] = -INFINITY; }
    }
    const float off0 = slope2 * (float)(64 * j + 4 * hi2), off1 = off0 + 32.0f * slope2;
#pragma unroll
    for (int r = 0; r < 16; ++r) { const float sb = slope2 * (float)((r & 3) + 8 * (r >> 2)); p0[r] += sb; p1[r] += sb; }
    float pm0 = p0[0], pm1 = p1[0];
#pragma unroll
    for (int r = 1; r < 16; ++r) { pm0 = fmaxf(pm0, p0[r]); pm1 = fmaxf(pm1, p1[r]); }
    float pmax = fmaxf(pm0 + off0, pm1 + off1);
    { auto rr = __builtin_amdgcn_permlane32_swap(__float_as_uint(pmax), __float_as_uint(pmax), false, false);
      pmax = fmaxf(__uint_as_float(rr[0]), __uint_as_float(rr[1])); }
    float mn, alpha;
    if (__builtin_expect(__all(pmax - m_reg <= THR2), 1)) { mn = m_reg; alpha = 1.f; }
    else { mn = fmaxf(m_reg, pmax); alpha = __builtin_amdgcn_exp2f(m_reg - mn); m_reg = mn; }
    const float c0 = off0 - mn, c1 = off1 - mn;
    float ps = 0.f;
#pragma unroll
    for (int r = 0; r < 16; ++r) { p0[r] = __builtin_amdgcn_exp2f(p0[r] + c0); p1[r] = __builtin_amdgcn_exp2f(p1[r] + c1); ps += p0[r] + p1[r]; }
    { auto rr = __builtin_amdgcn_permlane32_swap(__float_as_uint(ps), __float_as_uint(ps), false, false);
      ps = __uint_as_float(rr[0]) + __uint_as_float(rr[1]); }
    l_reg = l_reg * alpha + ps;
    if (__any(alpha < 1.f)) { if (hi == 0) wsl[r32] = alpha; asm volatile("s_waitcnt lgkmcnt(0)" ::: "memory");
#pragma unroll
      for (int rg = 0; rg < 4; ++rg) { const f32x4 al = *(const LAS f32x4*)(wsl + 8 * rg + 4 * hi);
#pragma unroll
        for (int d = 0; d < 8; ++d) { o[d][4 * rg + 0] *= al.x; o[d][4 * rg + 1] *= al.y; o[d][4 * rg + 2] *= al.z; o[d][4 * rg + 3] *= al.w; }
        SBAR(); } }
    bf16x8 pa0, pa1, pa2, pa3;
#define PK4(P, BASE, OUT) do { unsigned a0 = cvtpk(P[BASE + 0], P[BASE + 1]), a1 = cvtpk(P[BASE + 2], P[BASE + 3]);   \
    unsigned b0 = cvtpk(P[BASE + 4], P[BASE + 5]), b1 = cvtpk(P[BASE + 6], P[BASE + 7]);                              \
    auto r0 = __builtin_amdgcn_permlane32_swap(a0, b0, false, false); auto r1 = __builtin_amdgcn_permlane32_swap(a1, b1, false, false); \
    v4u w = {r0[0], r1[0], r0[1], r1[1]}; OUT = *reinterpret_cast<bf16x8*>(&w); } while (0)
    PK4(p0, 0, pa0); PK4(p0, 8, pa1); PK4(p1, 0, pa2); PK4(p1, 8, pa3);
#undef PK4
    SBAR();
    { const int vb = vb0 + cur * SHM_V;
      pv_one<0>(o[0], vb, pa0, pa1, pa2, pa3); pv_one<1>(o[1], vb, pa0, pa1, pa2, pa3); pv_one<2>(o[2], vb, pa0, pa1, pa2, pa3); pv_one<3>(o[3], vb, pa0, pa1, pa2, pa3);
      pv_one<4>(o[4], vb, pa0, pa1, pa2, pa3); pv_one<5>(o[5], vb, pa0, pa1, pa2, pa3); pv_one<6>(o[6], vb, pa0, pa1, pa2, pa3); pv_one<7>(o[7], vb, pa0, pa1, pa2, pa3); }
    VM_WAIT(); __syncthreads();
  }
  { int lane2 = threadIdx.x & 63, slot2 = slot; asm volatile("" : "+v"(lane2), "+s"(slot2));
    const int r32e = lane2 & 31, hie = lane2 >> 5;
    bf16* PO = (bf16*)(F.ws + WS_PO) + (size_t)slot2 * 256 * 256; float* ML = (float*)(F.ws + WS_ML) + (size_t)slot2 * 512;
    LAS float* wse = (LAS float*)(F.lds + LDS_WS) + wid * 64;
    if (hie == 0) { wse[r32e] = l_reg; ML[(wid * 32 + r32e) * 2] = m_reg; ML[(wid * 32 + r32e) * 2 + 1] = l_reg; }
    asm volatile("s_waitcnt lgkmcnt(0)" ::: "memory");
    char* Ob = (char*)(PO + (size_t)(wid * 32) * 256);
    const bool odd = (r32e & 1) != 0;
    const unsigned lo = (unsigned)(4 * hie * 256 + (r32e & ~1) + (odd ? 32 : 0)) * 2u;
#pragma unroll
    for (int r = 0; r < 16; ++r) { const int rowc = (r & 3) + 8 * (r >> 2); const float lv = wse[rowc + 4 * hie]; const float rl = lv > 0.f ? __builtin_amdgcn_rcpf(lv) : 0.f;
#pragma unroll
      for (int dp = 0; dp < 4; ++dp) { const float va = o[2 * dp][r] * rl, vb = o[2 * dp + 1][r] * rl;
        const float send = odd ? va : vb, keep = odd ? vb : va;
        const float recv = __builtin_bit_cast(float, __builtin_amdgcn_update_dpp(0, __builtin_bit_cast(int, send), 0xB1, 0xF, 0xF, true));
        *(unsigned*)(Ob + (lo + (unsigned)(rowc * 256 + dp * 64) * 2u)) = odd ? pk2(recv, keep) : pk2(keep, recv); }
      SBAR(); } }
  __syncthreads();
#undef STAGE_K
#undef STAGE_V
}

__device__ __forceinline__ void phase(const Frame& F, int ca, int NA) {
  int s0 = (int)(((long)ca * NSTEPS) / NA); const int s1 = (int)(((long)(ca + 1) * NSTEPS) / NA);
  while (s0 < s1) {
    const int bhm = s0 / STEPS_BHM, rem = s0 - bhm * STEPS_BHM;
    int qb = 0;
#pragma unroll 1
    for (int q = 1; q < 8; ++q) if (rem >= qb_start(q)) qb = q;
    const int j0 = rem - qb_start(qb), nst = 4 * qb + 5;
    const int j1 = (j0 + (s1 - s0) < nst) ? j0 + (s1 - s0) : nst;
    const int slot = bhm * 16 + qb + chunk_of(s0, NA) - chunk_of(bhm * STEPS_BHM, NA);
    segment(F, bhm, qb, j0, j1, slot);
    s0 += j1 - j0;
  }
}
#undef KSWZ
#undef SBAR
}
namespace ml {
constexpr int QST = 136, TST = 72;
constexpr int L_RQ = 0, L_RK = 17152, L_QS = 34304, L_QW = 51712, L_KS = 69120, L_KWT = 86528, L_VT = 104960  , L_SP = 0  , L_G = 141824, L_CW = 143872;
constexpr int L_HT = 0;
constexpr int G_A = 0, G_M = 64, G_WI = 128, G_EM = 192, G_DEN = 256, G_WG = 320, G_SC = 384, G_N = 0;
constexpr int L_NV = L_CW + 5120;
constexpr int L_SSQ = L_KWT;
__device__ __forceinline__ float shfl_up_f(float v, int d) { return __shfl_up(v, d); }

__device__ __forceinline__ void load_cw(const Frame& F, const Args& a, int h) {
  LAS float* CW = (LAS float*)(F.lds + L_CW);
  for (int e = F.tid; e < 2 * 5 * 128; e += NTHR) { const int qk = e / 640, j = (e / 128) % 5, d = e & 127; const int ch = qk * 512 + h * 128 + d;
    CW[e] = j < 4 ? a.in[IN_CW][j * 1024 + ch] : a.in[IN_CB][ch]; }
}
__device__ __forceinline__ void load_raw(const Frame& F, const bf16* g, int pos0, int lds_off) {
  for (int p = F.tid; p < 67 * 16; p += NTHR) { const int row = p >> 4, ch = p & 15, pos = pos0 - 3 + row;
    v4u v = {0u, 0u, 0u, 0u}; if (pos >= MPOS0) v = *(const v4u*)(g + (size_t)pos * 128 + ch * 8);
    *(LAS v4u*)(F.lds + lds_off + row * 256 + ch * 16) = v; }
}
__device__ __forceinline__ void conv16(const Frame& F, int qk, int lds_off, int t, int d0, float (&y)[16]) {
  const LAS float* CW = (const LAS float*)(F.lds + L_CW);
#pragma unroll
  for (int e = 0; e < 16; ++e) y[e] = CW[(qk * 5 + 4) * 128 + d0 + e];
#pragma unroll
  for (int j = 0; j < 4; ++j) { const LAS v4u* rp = (const LAS v4u*)(F.lds + lds_off + (t + j) * 256 + d0 * 2); const v4u r0 = rp[0], r1 = rp[1];
    const LAS float* cw = CW + (qk * 5 + j) * 128 + d0;
    y[0] += cw[0] * bflo(r0.x); y[1] += cw[1] * bfhi(r0.x); y[2] += cw[2] * bflo(r0.y); y[3] += cw[3] * bfhi(r0.y); y[4] += cw[4] * bflo(r0.z); y[5] += cw[5] * bfhi(r0.z); y[6] += cw[6] * bflo(r0.w); y[7] += cw[7] * bfhi(r0.w);
    y[8] += cw[8] * bflo(r1.x); y[9] += cw[9] * bfhi(r1.x); y[10] += cw[10] * bflo(r1.y); y[11] += cw[11] * bfhi(r1.y); y[12] += cw[12] * bflo(r1.z); y[13] += cw[13] * bfhi(r1.z); y[14] += cw[14] * bflo(r1.w); y[15] += cw[15] * bfhi(r1.w); }
#pragma unroll
  for (int e = 0; e < 16; ++e) y[e] = y[e] / (1.0f + __expf(-y[e]));
}
__device__ __forceinline__ void load_vt(const Frame& F, const bf16* MVg, int pos0) {
#pragma unroll
  for (int i = 0; i < 4; ++i) { const int p = F.tid + NTHR * i, row = p >> 5, ch = p & 31; v4u v4 = {0u, 0u, 0u, 0u};
    if (pos0 + row >= MPOS0) v4 = *(const v4u*)(MVg + (size_t)(pos0 + row) * 256 + ch * 8);
    LAS bf16* vt = (LAS bf16*)(F.lds + L_VT) + (ch * 8) * TST + row;
    vt[0 * TST] = (bf16)(v4.x & 0xffff); vt[1 * TST] = (bf16)(v4.x >> 16); vt[2 * TST] = (bf16)(v4.y & 0xffff); vt[3 * TST] = (bf16)(v4.y >> 16);
    vt[4 * TST] = (bf16)(v4.z & 0xffff); vt[5 * TST] = (bf16)(v4.z >> 16); vt[6 * TST] = (bf16)(v4.w & 0xffff); vt[7 * TST] = (bf16)(v4.w >> 16); }
}

__device__ __forceinline__ void taskA(const Frame& F, const Args& a, int task) {
  const int bh = task >> 5, c = task & 31, h = bh & 3, tid = F.tid, w = F.wave, lane = F.lane, fr = lane & 15, kq = lane >> 4, pos0 = 64 * c;
  LAS unsigned char* lds = F.lds; LAS float* G = (LAS float*)(lds + L_G);
  const bf16* MKg = (const bf16*)(F.ws + WS_MK) + (size_t)bh * PADT * 128; const bf16* MVg = (const bf16*)(F.ws + WS_MV) + (size_t)bh * PADT * 256;
  __syncthreads();
  load_cw(F, a, h); load_raw(F, MKg, pos0, L_RK); load_vt(F, MVg, pos0);
  if (w == 0) {
    const bool dead = pos0 + lane < MPOS0;
    const float li = dead ? -1e30f : ((const float*)(F.ws + WS_LI))[bh * PADT + pos0 + lane], lf = dead ? 0.f : ((const float*)(F.ws + WS_LF))[bh * PADT + pos0 + lane];
    float bs = lf;
#pragma unroll
    for (int d = 1; d < 64; d <<= 1) { const float o = shfl_up_f(bs, d); if (lane >= d) bs += o; }
    const float av = li - bs; float mx = av;
#pragma unroll
    for (int o = 1; o < 64; o <<= 1) mx = fmaxf(mx, __shfl_xor(mx, o));
    G[G_WG + lane] = __expf(av - mx);
    if (lane == 63) { float* gs = (float*)(F.ws + WS_GS) + (size_t)(bh * 33 + c) * 2; gs[0] = bs; gs[1] = mx; }
  }
  __syncthreads();
  { const int t = tid >> 3, d0 = (tid & 7) * 16; float y[16]; conv16(F, 1, L_RK, t, d0, y);
    const float sw = 0.08838834764831845f * G[G_WG + t]; LAS bf16* kt = (LAS bf16*)(lds + L_KWT) + d0 * TST + t;
#pragma unroll
    for (int e = 0; e < 16; ++e) kt[e * TST] = (bf16)f2bf(y[e] * sw); }
  __syncthreads();
  f32x4* DCg = (f32x4*)(F.ws + WS_DC) + ((size_t)(bh * 32 + c) * 128) * 64;
#pragma unroll
  for (int jj = 0; jj < 2; ++jj) { const int j = 2 * w + jj;
    const bf16x8 bv0 = *(const LAS bf16x8*)(lds + L_VT + ((16 * j + fr) * TST + 8 * kq) * 2), bv1 = *(const LAS bf16x8*)(lds + L_VT + ((16 * j + fr) * TST + 32 + 8 * kq) * 2);
#pragma unroll
    for (int i = 0; i < 8; ++i) { f32x4 acc = {0.f, 0.f, 0.f, 0.f};
      const bf16x8 k0 = *(const LAS bf16x8*)(lds + L_KWT + ((16 * i + fr) * TST + 8 * kq) * 2), k1 = *(const LAS bf16x8*)(lds + L_KWT + ((16 * i + fr) * TST + 32 + 8 * kq) * 2);
      acc = __builtin_amdgcn_mfma_f32_16x16x32_bf16(k0, bv0, acc, 0, 0, 0); acc = __builtin_amdgcn_mfma_f32_16x16x32_bf16(k1, bv1, acc, 0, 0, 0);
      DCg[(size_t)(i * 16 + j) * 64 + lane] = acc; } }
  if (tid < 128) { const LAS v4u* kr = (const LAS v4u*)(lds + L_KWT + tid * TST * 2); float s = 0.f;
#pragma unroll
    for (int q = 0; q < 8; ++q) { const v4u x = kr[q]; s += (bflo(x.x) + bfhi(x.x)) + (bflo(x.y) + bfhi(x.y)) + (bflo(x.z) + bfhi(x.z)) + (bflo(x.w) + bfhi(x.w)); }
    ((float*)(F.ws + WS_DN))[(size_t)(bh * 32 + c) * 128 + tid] = s; }
}

__device__ __forceinline__ void scanB(const Frame& F) {
  const float* GS = (const float*)(F.ws + WS_GS);
  LAS float* cf = (LAS float*)F.lds;
  for (int blk = blockIdx.x; blk < 16 * 8; blk += gridDim.x) { const int bh = blk >> 3, r = (blk & 7) * NTHR + F.tid, I = r >> 10, j = (r >> 6) & 15, ln = r & 63;
    __syncthreads();
    if (F.tid == 0) { float m = 0.f; for (int c = 0; c < 32; ++c) { const float bL = GS[(bh * 33 + c) * 2], ml = GS[(bh * 33 + c) * 2 + 1], me = fmaxf(m, ml);
        cf[2 * c] = __expf(m - me); cf[2 * c + 1] = __expf(ml - me); m = bL + me; } }
    __syncthreads();
    const f32x4* dc0 = (const f32x4*)(F.ws + WS_DC) + ((size_t)(bh * 32) * 128 + ((2 * I) * 16 + j)) * 64 + ln;
    const f32x4* dc1 = dc0 + 16 * 64;
    v4u* cs = (v4u*)(F.ws + WS_CS) + ((((size_t)bh * 33) * 4 + I) * 16 + j) * 64 + ln;
    f32x4 s0 = {0.f, 0.f, 0.f, 0.f}, s1 = {0.f, 0.f, 0.f, 0.f};
#pragma unroll 16
    for (int c = 0; c < 32; ++c) { const float fa = cf[2 * c], fb = cf[2 * c + 1];
      s0 = s0 * fa + dc0[(size_t)c * 128 * 64] * fb; s1 = s1 * fa + dc1[(size_t)c * 128 * 64] * fb;
      v4u o; o.x = pk2(s0.x, s0.y); o.y = pk2(s0.z, s0.w); o.z = pk2(s1.x, s1.y); o.w = pk2(s1.z, s1.w); cs[(size_t)(c + 1) * 4 * 16 * 64] = o; } }
  const int gt = blockIdx.x * NTHR + F.tid, NT = gridDim.x * NTHR;
  for (int g = gt; g < 16 * 128; g += NT) { const int bh = g >> 7, d = g & 127; float n = 0.f, m = 0.f;
    for (int c = 0; c < 32; ++c) { const float bL = GS[(bh * 33 + c) * 2], ml = GS[(bh * 33 + c) * 2 + 1], me = fmaxf(m, ml);
      n = n * __expf(m - me) + ((const float*)(F.ws + WS_DN))[(size_t)(bh * 32 + c) * 128 + d] * __expf(ml - me); m = bL + me;
      ((float*)(F.ws + WS_NS))[(size_t)(bh * 33 + c + 1) * 128 + d] = n; if (d == 0) ((float*)(F.ws + WS_MS))[bh * 33 + c + 1] = m; } }
}

__device__ __forceinline__ void taskC(const Frame& F, const Args& a, int task) {
  const int bh = task >> 5, c = (task & 31) + 1, b = bh >> 2, h = bh & 3, tid = F.tid, w = F.wave, lane = F.lane, fr = lane & 15, kq = lane >> 4, pos0 = 64 * c;
  LAS unsigned char* lds = F.lds; LAS float* G = (LAS float*)(lds + L_G); LAS float* NV = (LAS float*)(lds + L_NV);
  const bf16* MQg = (const bf16*)(F.ws + WS_MQ) + (size_t)bh * PADT * 128; const bf16* MKg = (const bf16*)(F.ws + WS_MK) + (size_t)bh * PADT * 128;
  const bf16* MVg = (const bf16*)(F.ws + WS_MV) + (size_t)bh * PADT * 256;
  const float m = ((const float*)(F.ws + WS_MS))[bh * 33 + c];
  __syncthreads();
  load_cw(F, a, h); load_raw(F, MQg, pos0, L_RQ); load_raw(F, MKg, pos0, L_RK); load_vt(F, MVg, pos0);
  if (tid < 128) NV[tid] = ((const float*)(F.ws + WS_NS))[(size_t)(bh * 33 + c) * 128 + tid];
  if (w == 0) {
    const float li = ((const float*)(F.ws + WS_LI))[bh * PADT + pos0 + lane], lf = ((const float*)(F.ws + WS_LF))[bh * PADT + pos0 + lane];
    float bs = lf;
#pragma unroll
    for (int d = 1; d < 64; d <<= 1) { const float o = shfl_up_f(bs, d); if (lane >= d) bs += o; }
    const float av = li - bs; float cm = av;
#pragma unroll
    for (int d = 1; d < 64; d <<= 1) { const float o = shfl_up_f(cm, d); if (lane >= d) cm = fmaxf(cm, o); }
    const float Mt = fmaxf(m, cm);
    G[G_A + lane] = av; G[G_M + lane] = Mt; G[G_WI + lane] = __expf(m - Mt); G[G_EM + lane] = __expf(-(bs + Mt));
  }
  __syncthreads();
  { const int t = tid >> 3, d0 = (tid & 7) * 16; const float wi = G[G_WI + t]; float y[16];
    conv16(F, 0, L_RQ, t, d0, y);
    { v4u o0, o1, w0, w1;
      o0.x = pk2(y[0], y[1]); o0.y = pk2(y[2], y[3]); o0.z = pk2(y[4], y[5]); o0.w = pk2(y[6], y[7]); o1.x = pk2(y[8], y[9]); o1.y = pk2(y[10], y[11]); o1.z = pk2(y[12], y[13]); o1.w = pk2(y[14], y[15]);
      w0.x = pk2(y[0] * wi, y[1] * wi); w0.y = pk2(y[2] * wi, y[3] * wi); w0.z = pk2(y[4] * wi, y[5] * wi); w0.w = pk2(y[6] * wi, y[7] * wi);
      w1.x = pk2(y[8] * wi, y[9] * wi); w1.y = pk2(y[10] * wi, y[11] * wi); w1.z = pk2(y[12] * wi, y[13] * wi); w1.w = pk2(y[14] * wi, y[15] * wi);
      LAS v4u* qs = (LAS v4u*)(lds + L_QS + (t * QST + d0) * 2); qs[0] = o0; qs[1] = o1;
      LAS v4u* qw = (LAS v4u*)(lds + L_QW + (t * QST + d0) * 2); qw[0] = w0; qw[1] = w1; }
    __builtin_amdgcn_sched_barrier(0);
    conv16(F, 1, L_RK, t, d0, y);
    { const float sc = 0.08838834764831845f; v4u o0, o1;
      o0.x = pk2(y[0] * sc, y[1] * sc); o0.y = pk2(y[2] * sc, y[3] * sc); o0.z = pk2(y[4] * sc, y[5] * sc); o0.w = pk2(y[6] * sc, y[7] * sc);
      o1.x = pk2(y[8] * sc, y[9] * sc); o1.y = pk2(y[10] * sc, y[11] * sc); o1.z = pk2(y[12] * sc, y[13] * sc); o1.w = pk2(y[14] * sc, y[15] * sc);
      LAS v4u* ks = (LAS v4u*)(lds + L_KS + (t * QST + d0) * 2); ks[0] = o0; ks[1] = o1; } }
  __syncthreads();
  v4u cb[4][2];
  { const v4u* cs = (const v4u*)(F.ws + WS_CS) + (((size_t)bh * 33 + c) * 4 * 16) * 64;
#pragma unroll
    for (int I = 0; I < 4; ++I)
#pragma unroll
      for (int jj = 0; jj < 2; ++jj) cb[I][jj] = cs[(size_t)(I * 16 + 2 * w + jj) * 64 + lane]; }
  { const int si = w >> 1; const f32x4 as = *(const LAS f32x4*)(G + G_A + 16 * si + 4 * kq);
#pragma unroll
    for (int tt = 0; tt < 2; ++tt) { const int ti = 2 * (w & 1) + tt; f32x4 acc = {0.f, 0.f, 0.f, 0.f};
#pragma unroll
      for (int ks = 0; ks < 4; ++ks) { const bf16x8 af = *(const LAS bf16x8*)(lds + L_KS + ((16 * si + fr) * QST + 32 * ks + 8 * kq) * 2);
        const bf16x8 bfr = *(const LAS bf16x8*)(lds + L_QS + ((16 * ti + fr) * QST + 32 * ks + 8 * kq) * 2);
        acc = __builtin_amdgcn_mfma_f32_16x16x32_bf16(af, bfr, acc, 0, 0, 0); }
      const int t = 16 * ti + fr, s0 = 16 * si + 4 * kq; const float Mt = G[G_M + t];
      const float v0 = (s0 + 0 <= t) ? acc.x * __expf(as.x - Mt) : 0.f, v1 = (s0 + 1 <= t) ? acc.y * __expf(as.y - Mt) : 0.f;
      const float v2 = (s0 + 2 <= t) ? acc.z * __expf(as.z - Mt) : 0.f, v3 = (s0 + 3 <= t) ? acc.w * __expf(as.w - Mt) : 0.f;
      v2u o; o.x = pk2(v0, v1); o.y = pk2(v2, v3);
      *(LAS v2u*)(lds + L_SP + (t * TST + s0) * 2) = o; } }
  __syncthreads();
  if (w == 0) { const int t = lane; float qn = 0.f, rsum = 0.f;
#pragma unroll 4
    for (int q = 0; q < 16; ++q) { const v4u x = *(const LAS v4u*)(lds + L_QS + (t * QST + q * 8) * 2); const f32x4 n0 = *(const LAS f32x4*)(NV + q * 8), n1 = *(const LAS f32x4*)(NV + q * 8 + 4);
      qn += bflo(x.x) * n0.x + bfhi(x.x) * n0.y + bflo(x.y) * n0.z + bfhi(x.y) * n0.w + bflo(x.z) * n1.x + bfhi(x.z) * n1.y + bflo(x.w) * n1.z + bfhi(x.w) * n1.w; }
#pragma unroll
    for (int q = 0; q < 8; ++q) { const v4u x = *(const LAS v4u*)(lds + L_SP + (t * TST + q * 8) * 2); rsum += (bflo(x.x) + bfhi(x.x)) + (bflo(x.y) + bfhi(x.y)) + (bflo(x.z) + bfhi(x.z)) + (bflo(x.w) + bfhi(x.w)); }
    const float den = G[G_WI + t] * qn + rsum; G[G_DEN + t] = fmaxf(fabsf(den), G[G_EM + t]); }
  f32x4 acc[2][4];
#pragma unroll
  for (int jj = 0; jj < 2; ++jj)
#pragma unroll
    for (int ti = 0; ti < 4; ++ti) acc[jj][ti] = (f32x4){0.f, 0.f, 0.f, 0.f};
#pragma unroll
  for (int I = 0; I < 4; ++I) {
#pragma unroll
    for (int ti = 0; ti < 4; ++ti) { const LAS unsigned char* qp = lds + L_QW + ((16 * ti + fr) * QST + 32 * I + 4 * kq) * 2;
      const v2u a0 = *(const LAS v2u*)qp, a1 = *(const LAS v2u*)(qp + 32); const v4u av = {a0.x, a0.y, a1.x, a1.y};
      acc[0][ti] = __builtin_amdgcn_mfma_f32_16x16x32_bf16(__builtin_bit_cast(bf16x8, av), __builtin_bit_cast(bf16x8, cb[I][0]), acc[0][ti], 0, 0, 0);
      acc[1][ti] = __builtin_amdgcn_mfma_f32_16x16x32_bf16(__builtin_bit_cast(bf16x8, av), __builtin_bit_cast(bf16x8, cb[I][1]), acc[1][ti], 0, 0, 0); }
    __builtin_amdgcn_sched_barrier(0); }
#pragma unroll
  for (int ks = 0; ks < 2; ++ks) { const bf16x8 bv0 = *(const LAS bf16x8*)(lds + L_VT + ((32 * w + fr) * TST + 32 * ks + 8 * kq) * 2), bv1 = *(const LAS bf16x8*)(lds + L_VT + ((32 * w + 16 + fr) * TST + 32 * ks + 8 * kq) * 2);
#pragma unroll
    for (int ti = 0; ti < 4; ++ti) { const bf16x8 sf = *(const LAS bf16x8*)(lds + L_SP + ((16 * ti + fr) * TST + 32 * ks + 8 * kq) * 2);
      acc[0][ti] = __builtin_amdgcn_mfma_f32_16x16x32_bf16(sf, bv0, acc[0][ti], 0, 0, 0); acc[1][ti] = __builtin_amdgcn_mfma_f32_16x16x32_bf16(sf, bv1, acc[1][ti], 0, 0, 0); } }
  __syncthreads();
  LAS float* SSQ = (LAS float*)(lds + L_SSQ);
#pragma unroll
  for (int ti = 0; ti < 4; ++ti) { const f32x4 dn = *(const LAS f32x4*)(G + G_DEN + 16 * ti + 4 * kq);
    f32x4 s4;
#pragma unroll
    for (int r = 0; r < 4; ++r) { const float h0 = acc[0][ti][r] / dn[r], h1 = acc[1][ti][r] / dn[r]; acc[0][ti][r] = h0; acc[1][ti][r] = h1; s4[r] = h0 * h0 + h1 * h1; }
#pragma unroll
    for (int o = 1; o < 16; o <<= 1) { s4.x += __shfl_xor(s4.x, o); s4.y += __shfl_xor(s4.y, o); s4.z += __shfl_xor(s4.z, o); s4.w += __shfl_xor(s4.w, o); }
    if (fr == 0) { SSQ[(16 * ti + 4 * kq + 0) * 8 + w] = s4.x; SSQ[(16 * ti + 4 * kq + 1) * 8 + w] = s4.y; SSQ[(16 * ti + 4 * kq + 2) * 8 + w] = s4.z; SSQ[(16 * ti + 4 * kq + 3) * 8 + w] = s4.w; } }
  __syncthreads();
  LAS bf16* HT = (LAS bf16*)(lds + L_HT);
#pragma unroll
  for (int ti = 0; ti < 4; ++ti)
#pragma unroll
    for (int r = 0; r < 4; ++r) { const int t = 16 * ti + 4 * kq + r; const f32x4 p0 = *(const LAS f32x4*)(SSQ + t * 8), p1 = *(const LAS f32x4*)(SSQ + t * 8 + 4);
      const float rh = rsqrtf(((p0.x + p0.y) + (p0.z + p0.w) + (p1.x + p1.y) + (p1.z + p1.w)) * (1.0f / 256.f) + EPS);
      HT[t * 264 + 32 * w + fr] = (bf16)f2bf(acc[0][ti][r] * rh); HT[t * 264 + 32 * w + 16 + fr] = (bf16)f2bf(acc[1][ti][r] * rh); }
  __syncthreads();
  { const int t = tid >> 3, c0 = (tid & 7) * 32; const size_t R = (size_t)b * SEQ + 64 * (c - 1) + t;
    const bf16* mo = (const bf16*)(F.ws + WS_MO) + R * 1024 + h * 256 + c0; const float* og = a.in[IN_OUTG] + h * 256 + c0; bf16* A2 = (bf16*)(F.ws + WS_A2) + R * DM + 1024 + h * 256 + c0;
#pragma unroll
    for (int q = 0; q < 4; ++q) { const v4u hv = *(const LAS v4u*)(HT + t * 264 + c0 + q * 8); const v4u mv = *(const v4u*)(mo + q * 8); const f32x4 g0 = *(const f32x4*)(og + q * 8), g1 = *(const f32x4*)(og + q * 8 + 4);
      v4u o; o.x = pk2(bflo(hv.x) * g0.x * bflo(mv.x), bfhi(hv.x) * g0.y * bfhi(mv.x)); o.y = pk2(bflo(hv.y) * g0.z * bflo(mv.y), bfhi(hv.y) * g0.w * bfhi(mv.y));
      o.z = pk2(bflo(hv.z) * g1.x * bflo(mv.z), bfhi(hv.z) * g1.y * bfhi(mv.z)); o.w = pk2(bflo(hv.w) * g1.z * bflo(mv.w), bfhi(hv.w) * g1.w * bfhi(mv.w));
      *(v4u*)(A2 + q * 8) = o; } }
}
}
struct CombRow { float mp[8][3], lp[8][3]; v4u op[8][3]; };
__device__ __forceinline__ float half_sum_dpp(float v, bool hi) {
  v += __builtin_bit_cast(float, __builtin_amdgcn_update_dpp(0, __builtin_bit_cast(int, v), 0xB1, 0xF, 0xF, true));
  v += __builtin_bit_cast(float, __builtin_amdgcn_update_dpp(0, __builtin_bit_cast(int, v), 0x4E, 0xF, 0xF, true));
  v += __builtin_bit_cast(float, __builtin_amdgcn_update_dpp(0, __builtin_bit_cast(int, v), 0x141, 0xF, 0xF, true));
  v += __builtin_bit_cast(float, __builtin_amdgcn_update_dpp(0, __builtin_bit_cast(int, v), 0x140, 0xF, 0xF, true));
  const float r0 = __builtin_bit_cast(float, __builtin_amdgcn_readlane(__builtin_bit_cast(int, v), 0)), r1 = __builtin_bit_cast(float, __builtin_amdgcn_readlane(__builtin_bit_cast(int, v), 16));
  const float r2 = __builtin_bit_cast(float, __builtin_amdgcn_readlane(__builtin_bit_cast(int, v), 32)), r3 = __builtin_bit_cast(float, __builtin_amdgcn_readlane(__builtin_bit_cast(int, v), 48));
  return hi ? r2 + r3 : r0 + r1;
}
__device__ __forceinline__ void comb_load(const bf16* PO, const float* ML, int R0, int NA, int lane, CombRow& cr) {
  const int b = R0 >> 11, t = R0 & 2047, qb = t >> 8, rq = (t & 255) + (lane >> 5), l32 = lane & 31;
#pragma unroll
  for (int hm = 0; hm < 8; ++hm) {
    const int bhm = b * 8 + hm, first = bhm * att::STEPS_BHM + att::qb_start(qb), last = first + 4 * qb + 4;
    const int cf = att::chunk_of(first, NA), np = att::chunk_of(last, NA) - cf + 1, slot0 = bhm * 16 + qb + cf - att::chunk_of(bhm * att::STEPS_BHM, NA);
#pragma unroll
    for (int p = 0; p < 3; ++p) { if (p < np) { const int slot = slot0 + p; const v2u ml = *(const v2u*)(ML + (size_t)slot * 512 + rq * 2);
        const unsigned mx_ = ml.x, my_ = ml.y; cr.mp[hm][p] = __builtin_bit_cast(float, mx_); cr.lp[hm][p] = __builtin_bit_cast(float, my_);
        cr.op[hm][p] = ((const v4u*)(PO + ((size_t)slot * 256 + rq) * 256))[l32]; } else { cr.mp[hm][p] = -1e30f; cr.lp[hm][p] = 0.f; cr.op[hm][p] = (v4u){0u, 0u, 0u, 0u}; } }
  }
}
__device__ __forceinline__ void comb_finish(bf16* A2, int R0, int lane, float lam, const f32x4 sg0, const f32x4 sg1, const CombRow& cr) {
  const bool hi = lane >= 32; const int l32 = lane & 31;
#pragma unroll
  for (int h = 0; h < 4; ++h) {
    float om[2][8];
#pragma unroll
    for (int m = 0; m < 2; ++m) { const int hm = h * 2 + m;
      const float M = fmaxf(cr.mp[hm][0], fmaxf(cr.mp[hm][1], cr.mp[hm][2]));
      float wsum = 0.f, acc[8];
#pragma unroll
      for (int i = 0; i < 8; ++i) acc[i] = 0.f;
#pragma unroll
      for (int p = 0; p < 3; ++p) { const float w = cr.lp[hm][p] * exp2f(cr.mp[hm][p] - M); wsum += w; const v4u ow = cr.op[hm][p];
#pragma unroll
        for (int i = 0; i < 4; ++i) { const unsigned wd = ow[i]; acc[2 * i] += bflo(wd) * w; acc[2 * i + 1] += bfhi(wd) * w; } }
      const float iw = 1.0f / wsum;
#pragma unroll
      for (int i = 0; i < 8; ++i) om[m][i] = acc[i] * iw;
    }
    float o[8], ss = 0.f;
#pragma unroll
    for (int i = 0; i < 8; ++i) { o[i] = om[0][i] - om[1][i] * lam; ss += o[i] * o[i]; }
    const float rs = rsqrtf(half_sum_dpp(ss, hi) * (1.0f / 256.f) + EPS) * 0.8f;
    v4u w; w.x = pk2(o[0] * rs * sg0.x, o[1] * rs * sg0.y); w.y = pk2(o[2] * rs * sg0.z, o[3] * rs * sg0.w); w.z = pk2(o[4] * rs * sg1.x, o[5] * rs * sg1.y); w.w = pk2(o[6] * rs * sg1.z, o[7] * rs * sg1.w);
    ((v4u*)(A2 + (size_t)(R0 + (hi ? 1 : 0)) * DM + h * 256))[l32] = w;
  }
}
__device__ __forceinline__ void p3_combine(const Frame& F, const Args& a, int NA) {
  const bf16* PO = (const bf16*)(F.ws + WS_PO); const float* ML = (const float*)(F.ws + WS_ML);
  bf16* A2 = (bf16*)(F.ws + WS_A2);
  const float lam = *(const float*)(F.ws + WS_LAM);
  const int gw = blockIdx.x * NWAVES + F.wave, NGW = gridDim.x * NWAVES, lane = F.lane;
  const f32x4 sg0 = ((const f32x4*)a.in[IN_SUBG])[2 * (lane & 31)], sg1 = ((const f32x4*)a.in[IN_SUBG])[2 * (lane & 31) + 1];
  const int P0 = gw, P1 = MROWS / 2, PS = NGW;
  for (int P = P0; P < P1; P += PS) {
    CombRow r0;
    comb_load(PO, ML, 2 * P, NA, lane, r0);
    comb_finish(A2, 2 * P, lane, lam, sg0, sg1, r0);
  }
}
struct EpiRes {
  static constexpr bool PERM = true, AFTER_DRAIN = false;
  const float* x; float* out; bf16* H1b; float* SSQ;
  __device__ __forceinline__ void operator()(const pg8::f32x4 (&acc)[2][2][4][2], const pg8::Unit& u, int wr, int wc, int fr, int fq) const {
    const int row0 = u.pm * 256 + wr * 64 + fr, col0 = u.pn * 256 + wc * 32 + 8 * fq;
#pragma unroll
    for (int ai = 0; ai < 2; ++ai)
#pragma unroll
      for (int m = 0; m < 4; ++m) { const size_t R = (size_t)(row0 + ai * 128 + m * 16); float s = 0.f;
#pragma unroll
        for (int bj = 0; bj < 2; ++bj) { const size_t off = R * DM + col0 + bj * 128;
          const f32x4 x0 = *(const f32x4*)(x + off), x1 = *(const f32x4*)(x + off + 4);
          const f32x4 v0 = acc[ai][bj][m][0] + x0, v1 = acc[ai][bj][m][1] + x1;
          v4u w; w.x = pk2(v0.x, v0.y); w.y = pk2(v0.z, v0.w); w.z = pk2(v1.x, v1.y); w.w = pk2(v1.z, v1.w);
          *(v4u*)(H1b + off) = w;
          s += (v0.x * v0.x + v0.y * v0.y) + (v0.z * v0.z + v0.w * v0.w) + (v1.x * v1.x + v1.y * v1.y) + (v1.z * v1.z + v1.w * v1.w); }
        s += __shfl_xor(s, 16); s += __shfl_xor(s, 32);
        if (fq == 0) SSQ[R * 32 + u.pn * 4 + wc] = s; }
  }
};
#ifndef PEER_U_FP8
#define PEER_U_FP8 0
#endif
typedef __bf16 bfv2 __attribute__((ext_vector_type(2)));
__device__ __forceinline__ void split_hl(const f32x4 a, const f32x4 b, bf16x8& hi, bf16x8& lo) {
  float v[8] = {a.x, a.y, a.z, a.w, b.x, b.y, b.z, b.w}; unsigned h[8], l[8];
#pragma unroll
  for (int i = 0; i < 8; ++i) { h[i] = f2bf(v[i]); l[i] = f2bf(v[i] - __builtin_bit_cast(float, h[i] << 16)); }
  v4u hv = {h[0] | (h[1] << 16), h[2] | (h[3] << 16), h[4] | (h[5] << 16), h[6] | (h[7] << 16)};
  v4u lv = {l[0] | (l[1] << 16), l[2] | (l[3] << 16), l[4] | (l[5] << 16), l[6] | (l[7] << 16)};
  hi = __builtin_bit_cast(bf16x8, hv); lo = __builtin_bit_cast(bf16x8, lv);
}
__device__ __forceinline__ void p0_w3t(const Frame& F, const Args& a) {
  const float* wq = a.in[IN_WQ]; const float* sk = a.in[IN_SUBK]; const float* g2 = a.in[IN_G2];
  bf16* W3t = (bf16*)(F.ws + WS_W3T);
  const int lane = F.lane, fr = lane & 15, fq = lane >> 4;
  constexpr int SKS = 272;
  LAS unsigned char* shi = F.lds; LAS unsigned char* slo = F.lds + 128 * SKS;
  for (int bt = blockIdx.x; bt < 256; bt += gridDim.x) {
    const int hh = bt & 15, kt = (bt >> 4) * 8 + F.wave;
    const float* ap = wq + (size_t)(kt * 16 + fr) * DM + hh * 128 + fq * 8;
    f32x4 a0[4], a1[4];
#pragma unroll
    for (int s = 0; s < 4; ++s) { a0[s] = *(const f32x4*)(ap + 32 * s); a1[s] = *(const f32x4*)(ap + 32 * s + 4); }
    const f32x4 gk = *(const f32x4*)(g2 + kt * 16 + fq * 4);
    __syncthreads();
#pragma unroll
    for (int i = 0; i < 4; ++i) { const int idx = F.tid + NTHR * i, key = idx >> 4, c8 = idx & 15; const float* p = sk + (size_t)(hh * 128 + key) * 128 + c8 * 8;
      bf16x8 h, l; split_hl(*(const f32x4*)p, *(const f32x4*)(p + 4), h, l);
      *(LAS bf16x8*)(shi + key * SKS + c8 * 16) = h; *(LAS bf16x8*)(slo + key * SKS + c8 * 16) = l; }
    bf16x8 ahi[4], alo[4];
#pragma unroll
    for (int s = 0; s < 4; ++s) split_hl(a0[s], a1[s], ahi[s], alo[s]);
    __syncthreads();
#pragma unroll 2
    for (int t2 = 0; t2 < 8; ++t2) {
      const LAS unsigned char* bh = shi + (t2 * 16 + fr) * SKS + fq * 16; const LAS unsigned char* bl = slo + (t2 * 16 + fr) * SKS + fq * 16;
      f32x4 acc = {0.f, 0.f, 0.f, 0.f};
#pragma unroll
      for (int s = 0; s < 4; ++s) { const bf16x8 bhi = *(const LAS bf16x8*)(bh + 64 * s), blo = *(const LAS bf16x8*)(bl + 64 * s);
        acc = __builtin_amdgcn_mfma_f32_16x16x32_bf16(ahi[s], bhi, acc, 0, 0, 0);
        acc = __builtin_amdgcn_mfma_f32_16x16x32_bf16(ahi[s], blo, acc, 0, 0, 0);
        acc = __builtin_amdgcn_mfma_f32_16x16x32_bf16(alo[s], bhi, acc, 0, 0, 0); }
      v2u o; o.x = pk2(acc.x * gk.x, acc.y * gk.y); o.y = pk2(acc.z * gk.z, acc.w * gk.w);
      *(v2u*)(W3t + (size_t)(hh * 128 + t2 * 16 + fr) * DM + kt * 16 + fq * 4) = o;
    }
  }
  __syncthreads();
}
typedef float f32x2v __attribute__((ext_vector_type(2)));
__device__ __forceinline__ void p0_tables(const Frame& F, const Args& a) {
  const float* g2 = a.in[IN_G2];
  float* SCL = (float*)(F.ws + WS_SCL);
  const int gw = blockIdx.x * NWAVES + F.wave, NGW = gridDim.x * NWAVES, lane = F.lane;
  f32x4 gl[8];
#pragma unroll
  for (int q = 0; q < 8; ++q) gl[q] = *(const f32x4*)(g2 + q * 256 + lane * 4);
  f32x4 xn[8];
  { const int row = gw; if (row < 2 * 16384) { const float* src = a.in[row >= 16384 ? IN_V : IN_U] + (size_t)(row & 16383) * DM + lane * 4;
#pragma unroll
      for (int q = 0; q < 8; ++q) xn[q] = *(const f32x4*)(src + q * 256); } }
  for (int row = gw; row < 2 * 16384; row += NGW) {
    const bool isv = row >= 16384; const int e = row & 16383;
    f32x4 x[8];
#pragma unroll
    for (int q = 0; q < 8; ++q) x[q] = xn[q];
    { const int rn = row + NGW; if (rn < 2 * 16384) { const float* src = a.in[rn >= 16384 ? IN_V : IN_U] + (size_t)(rn & 16383) * DM + lane * 4;
#pragma unroll
        for (int q = 0; q < 8; ++q) xn[q] = *(const f32x4*)(src + q * 256); } }
    float amax = 0.f, ssq = 0.f;
#pragma unroll
    for (int q = 0; q < 8; ++q) { if (!isv) x[q] = x[q] * gl[q]; amax = fmaxf(amax, fmaxf(fmaxf(fabsf(x[q].x), fabsf(x[q].y)), fmaxf(fabsf(x[q].z), fabsf(x[q].w))));
      ssq += (x[q].x * x[q].x + x[q].y * x[q].y) + (x[q].z * x[q].z + x[q].w * x[q].w); }
#pragma unroll
    for (int o = 1; o < 64; o <<= 1) amax = fmaxf(amax, __shfl_xor(amax, o));
    v4u w;
    if (isv) {
      const float sc = amax > 0.f ? 6.0f / amax : 1.0f;
#pragma unroll
      for (int d = 0; d < 4; ++d) { unsigned pk = 0u;
        pk = __builtin_amdgcn_cvt_scalef32_pk_fp4_f32(pk, x[2 * d].x * sc, x[2 * d].y * sc, 1.0f, 0); pk = __builtin_amdgcn_cvt_scalef32_pk_fp4_f32(pk, x[2 * d].z * sc, x[2 * d].w * sc, 1.0f, 1);
        pk = __builtin_amdgcn_cvt_scalef32_pk_fp4_f32(pk, x[2 * d + 1].x * sc, x[2 * d + 1].y * sc, 1.0f, 2); pk = __builtin_amdgcn_cvt_scalef32_pk_fp4_f32(pk, x[2 * d + 1].z * sc, x[2 * d + 1].w * sc, 1.0f, 3);
        w[d] = pk; }
      if (lane == 0) SCL[row] = 1.0f / sc;
    } else {
      ssq = wave_sum_dpp(ssq);
      const float sA = amax > 0.f ? amax * (1.0f / 7.0f) : 1.0f, sB = fminf(sA, 0.36f * sqrtf(ssq * (1.0f / DM)) + 1e-30f);
      const float iA = 1.0f / sA, iB = 1.0f / sB;
      float eA = 0.f, eB = 0.f;
#pragma unroll
      for (int q = 0; q < 8; ++q)
#pragma unroll
        for (int j = 0; j < 4; ++j) { const float v = x[q][j];
          const float da = v - sA * __builtin_amdgcn_fmed3f(__builtin_rintf(v * iA), -7.0f, 7.0f), db = v - sB * __builtin_amdgcn_fmed3f(__builtin_rintf(v * iB), -7.0f, 7.0f);
          eA += da * da; eB += db * db; }
      eA = wave_sum_dpp(eA); eB = wave_sum_dpp(eB);
      const bool useB = eB < eA; const float st = useB ? sB : sA, is = useB ? iB : iA;
#pragma unroll
      for (int d = 0; d < 4; ++d) { unsigned pk = 0u;
#pragma unroll
        for (int p = 0; p < 8; ++p) { const float v = x[2 * d + (p >> 2)][p & 3]; const int qi = (int)__builtin_amdgcn_fmed3f(__builtin_rintf(v * is), -7.0f, 7.0f); pk |= ((unsigned)qi & 15u) << (4 * p); }
        w[d] = pk; }
      if (lane == 0) SCL[row] = st;
    }
    *(v4u*)(F.ws + (isv ? WS_VB8 : WS_UB) + (size_t)e * 1024 + lane * 16) = w;
  }
}
struct EpiScore {
  static constexpr bool PERM = true, AFTER_DRAIN = false;
  float* S; const LAS float* rs;
  __device__ __forceinline__ void operator()(const pg8::f32x4 (&acc)[2][2][4][2], const pg8::Unit& u, int wr, int wc, int fr, int fq) const {
    const int rl0 = wr * 64 + fr, keyb = wc * 32 + 8 * fq;
#pragma unroll
    for (int ai = 0; ai < 2; ++ai)
#pragma unroll
      for (int m = 0; m < 4; ++m) { const int rl = rl0 + ai * 128 + m * 16; const float r = rs[rl]; const int row = u.pm * 256 + rl;
#pragma unroll
        for (int bj = 0; bj < 2; ++bj) { float* d = S + ((size_t)((row >> 5) * 16 + u.pn * 2 + bj) * 128 + keyb) * 32 + (row & 31);
          const pg8::f32x4 v0 = acc[ai][bj][m][0] * r, v1 = acc[ai][bj][m][1] * r;
          d[0] = v0[0]; d[32] = v0[1]; d[64] = v0[2]; d[96] = v0[3]; d[128] = v1[0]; d[160] = v1[1]; d[192] = v1[2]; d[224] = v1[3]; } }
  }
};

__device__ __forceinline__ unsigned fkey(float f) { const unsigned b = __builtin_bit_cast(unsigned, f); return b ^ ((b >> 31) ? 0xFFFFFFFFu : 0x80000000u); }
template <int NV, int K> __device__ __forceinline__ void wave_topk(const unsigned (&u)[NV], bool (&sel)[NV], int lane) {
  unsigned prefix = 0u; int cge = NV * 64;
#pragma unroll 1
  for (int bit = 31; bit >= 0 && cge != K; --bit) {
    const unsigned cand = prefix | (1u << bit); int c = 0;
#pragma unroll
    for (int i = 0; i < NV; ++i) c += __builtin_popcountll(__ballot(u[i] >= cand));
    if (c >= K) { prefix = cand; cge = c; }
  }
  int cgt = 0;
#pragma unroll
  for (int i = 0; i < NV; ++i) cgt += __builtin_popcountll(__ballot(u[i] > prefix));
  int need = K - cgt;
  const unsigned long long lm = (1ull << lane) - 1ull;
#pragma unroll
  for (int i = 0; i < NV; ++i) { const unsigned long long eq = __ballot(u[i] == prefix); const int before = __builtin_popcountll(eq & lm);
    sel[i] = (u[i] > prefix) || (u[i] == prefix && before < need); const int ne = __builtin_popcountll(eq); need = need > ne ? need - ne : 0; }
}
template <int NG, int NV, int K> __device__ __forceinline__ void wave_topk_multi(const unsigned (&u)[NG][NV], bool (&sel)[NG][NV], int lane) {
  unsigned prefix[NG]; int cge[NG];
#pragma unroll
  for (int g = 0; g < NG; ++g) { prefix[g] = 0u; cge[g] = NV * 64; }
#pragma unroll 1
  for (int bit = 31; bit >= 0; --bit) {
    bool done = true;
#pragma unroll
    for (int g = 0; g < NG; ++g) done = done && (cge[g] == K);
    if (done) break;
#pragma unroll
    for (int g = 0; g < NG; ++g) { const unsigned cand = prefix[g] | (1u << bit); int c = 0;
#pragma unroll
      for (int i = 0; i < NV; ++i) c += __builtin_popcountll(__ballot(u[g][i] >= cand));
      if (cge[g] != K && c >= K) { prefix[g] = cand; cge[g] = c; } }
  }
  const unsigned long long lm = (1ull << lane) - 1ull;
#pragma unroll
  for (int g = 0; g < NG; ++g) { int cgt = 0;
#pragma unroll
    for (int i = 0; i < NV; ++i) cgt += __builtin_popcountll(__ballot(u[g][i] > prefix[g]));
    int need = K - cgt;
#pragma unroll
    for (int i = 0; i < NV; ++i) { const unsigned long long eq = __ballot(u[g][i] == prefix[g]); const int before = __builtin_popcountll(eq & lm);
      sel[g][i] = (u[g][i] > prefix[g]) || (u[g][i] == prefix[g] && before < need); const int ne = __builtin_popcountll(eq); need = need > ne ? need - ne : 0; } }
}
__device__ __forceinline__ float gelu_erf(float v) {
  const float av = fabsf(v), t = __builtin_amdgcn_rcpf(1.0f + 0.2316418882f * av);
  float q = t * 0.5307027145f - 0.7265760135f; q = q * t + 0.7107068705f; q = q * t - 0.142248368f; q = q * t + 0.127414796f; q = q * t;
  const float tail = q * __builtin_amdgcn_exp2f(v * v * -0.72134752044f);
  return v < 0.f ? v * tail : v - v * tail;
}

#ifndef ROUTE_REPS
#define ROUTE_REPS 1
#endif
__device__ __forceinline__ void ins16(float (&t)[16], float x) {
#pragma unroll
  for (int i = 15; i >= 1; --i) t[i] = __builtin_amdgcn_fmed3f(t[i - 1], t[i], x);
  t[0] = fmaxf(t[0], x);
}
__device__ __forceinline__ void p6_peer(const Frame& F, const Args& a, float* dst_base) {
  const float* S2 = (const float*)(F.ws + WS_S); const float* SSQ = (const float*)(F.ws + WS_SSQ); const bf16* H1b = (const bf16*)(F.ws + WS_H1B);
  int lane = F.lane, wv = F.wave, tid = F.tid; asm volatile("" : "+v"(lane), "+s"(wv), "+v"(tid));
  int* EIDg = (int*)(F.ws + WS_EID); float* EGTg = (float*)(F.ws + WS_EGT);
  LAS int* eid = (LAS int*)(F.lds + wv * 1536); LAS float* egt = (LAS float*)(eid + 128); LAS float* esu = (LAS float*)(eid + 256);
  LAS unsigned char* RB = F.lds + 12288 + wv * 16384;
  LAS float* L1 = (LAS float*)(F.lds + 12288);
  for (int tb = blockIdx.x; tb < MROWS / 32; tb += gridDim.x) {
    __syncthreads();
    {
      const int g = tid >> 5, tl = tid & 31; const float* src = S2 + ((size_t)(tb * 16 + g) * 128) * 32 + tl;
      float t[16];
#pragma unroll
      for (int i = 0; i < 16; ++i) t[i] = -INFINITY;
#pragma unroll 32
      for (int k = 0; k < 128; ++k) { const float x = src[k * 32]; ins16(t, __builtin_bit_cast(float, (__builtin_bit_cast(unsigned, x) & ~0x7Fu) | (unsigned)(127 - k))); }
#pragma unroll
      for (int i = 0; i < 16; ++i) L1[(g * 16 + i) * 32 + tl] = t[i];
    }
    __syncthreads();
    if (tid < 256) {
      const int h8 = tid >> 5, tl = tid & 31; const LAS float* LA = L1 + ((2 * h8) * 16) * 32 + tl; const LAS float* LB = L1 + ((2 * h8 + 1) * 16) * 32 + tl;
      float A[16], B[16], t[16];
#pragma unroll
      for (int i = 0; i < 16; ++i) { A[i] = LA[i * 32]; B[i] = LB[i * 32]; t[i] = -INFINITY; }
#pragma unroll
      for (int i = 0; i < 16; ++i)
#pragma unroll
        for (int j = 0; j < 16; ++j) if ((i + 1) * (j + 1) <= 16) { const float c = A[i] + B[j];
            ins16(t, __builtin_bit_cast(float, (__builtin_bit_cast(unsigned, c) & ~0xFFu) | (unsigned)(255 - (i * 16 + j)))); }
      float ev[16], es = 0.f;
#pragma unroll
      for (int r = 0; r < 16; ++r) { ev[r] = __expf(t[r] - t[0]); es += ev[r]; }
      const float inv = 1.0f / es;
#pragma unroll
      for (int r = 0; r < 16; ++r) { const unsigned flat = 255u - (__builtin_bit_cast(unsigned, t[r]) & 0xFFu), ii = flat >> 4, jj = flat & 15u;
        const unsigned ka = 127u - (__builtin_bit_cast(unsigned, LA[ii * 32]) & 0x7Fu), kb = 127u - (__builtin_bit_cast(unsigned, LB[jj * 32]) & 0x7Fu);
        EIDg[(size_t)(tb * 32 + tl) * 128 + h8 * 16 + r] = (int)(ka * 128u + kb); EGTg[(size_t)(tb * 32 + tl) * 128 + h8 * 16 + r] = ev[r] * inv; }
    }
    asm volatile("s_waitcnt vmcnt(0)" ::: "memory"); __syncthreads();
#pragma unroll 1
    for (int tt = 0; tt < 4; ++tt) {
    const int tl = wv * 4 + tt, tok = tb * 32 + tl;
    const float rs = rsqrtf(wave_sum_dpp(lane < 32 ? SSQ[(size_t)tok * 32 + lane] : 0.f) * (1.0f / DM) + EPS);
    { const float* SCL = (const float*)(F.ws + WS_SCL);
#pragma unroll
      for (int i = 0; i < 2; ++i) { const int e = lane + 64 * i, idq = __builtin_nontemporal_load(EIDg + (size_t)tok * 128 + e); eid[e] = idq; esu[e] = SCL[idq]; egt[e] = __builtin_nontemporal_load(EGTg + (size_t)tok * 128 + e) * SCL[16384 + idq]; } }
    unsigned xw[16];
    { const bf16* xp = H1b + (size_t)tok * DM + (size_t)lane * 4;
#pragma unroll
      for (int q = 0; q < 8; ++q) { const v2u x0 = *(const v2u*)(xp + q * 256); xw[2 * q] = x0.x; xw[2 * q + 1] = x0.y; } }
    int xl[4], xh[4]; float rsx;
    { float xa = 0.f;
#pragma unroll
      for (int i = 0; i < 16; ++i) xa = fmaxf(xa, fmaxf(fabsf(bflo(xw[i])), fabsf(bfhi(xw[i]))));
#pragma unroll
      for (int o = 1; o < 64; o <<= 1) xa = fmaxf(xa, __shfl_xor(xa, o));
      const float xinv = xa > 0.f ? 119.0f / xa : 0.f; rsx = rs * (xa > 0.f ? xa * (1.0f / 119.0f) : 0.f);
#pragma unroll
      for (int d = 0; d < 4; ++d) { unsigned pl = 0u, ph = 0u;
#pragma unroll
        for (int p = 0; p < 8; ++p) { const int i = 8 * d + p; const float v = (i & 1) ? bfhi(xw[i >> 1]) : bflo(xw[i >> 1]);
          const int xi = (int)__builtin_rintf(v * xinv), l = ((xi + 8) & 15) - 8, h = (xi - l) >> 4;
          pl |= ((unsigned)l & 15u) << (4 * p); ph |= ((unsigned)h & 15u) << (4 * p); }
        xl[d] = (int)pl; xh[d] = (int)ph; } }
    float y[32];
#pragma unroll
    for (int i = 0; i < 32; ++i) y[i] = 0.f;
    asm volatile("s_waitcnt vmcnt(0) lgkmcnt(0)" ::: "memory");
    const unsigned char* U8 = F.ws + WS_UB; const unsigned char* V8 = F.ws + WS_VB8;
#define PG_ISSUE(E) do { const int idq_ = __builtin_amdgcn_readfirstlane(eid[(E)]); LAS unsigned char* sl_ = RB + ((E) & 7) * 2048; \
      __builtin_amdgcn_global_load_lds((const unsigned*)(U8 + (size_t)idq_ * 1024 + lane * 16), (LAS unsigned*)sl_, 16, 0, 0); \
      __builtin_amdgcn_global_load_lds((const unsigned*)(V8 + (size_t)idq_ * 1024 + lane * 16), (LAS unsigned*)(sl_ + 1024), 16, 0, 0); } while (0)
#define PG_DOT(UW, DACC) do { int al_ = 0, ah_ = 0; _Pragma("unroll") for (int dd = 0; dd < 4; ++dd) { const int wa = (int)UW[dd]; \
          al_ = __builtin_amdgcn_sdot8(wa, xl[dd], al_, false); ah_ = __builtin_amdgcn_sdot8(wa, xh[dd], ah_, false); } DACC = (float)(ah_ * 16 + al_); } while (0)
#define PG_AXPY(VW, CF) do { _Pragma("unroll") for (int dd = 0; dd < 4; ++dd) { const unsigned wa = VW[dd]; \
          { const f32x2v v2 = __builtin_amdgcn_cvt_scalef32_pk_f32_fp4(wa, 1.0f, 0); y[8 * dd + 0] += CF * v2.x; y[8 * dd + 1] += CF * v2.y; } \
          { const f32x2v v2 = __builtin_amdgcn_cvt_scalef32_pk_f32_fp4(wa, 1.0f, 1); y[8 * dd + 2] += CF * v2.x; y[8 * dd + 3] += CF * v2.y; } \
          { const f32x2v v2 = __builtin_amdgcn_cvt_scalef32_pk_f32_fp4(wa, 1.0f, 2); y[8 * dd + 4] += CF * v2.x; y[8 * dd + 5] += CF * v2.y; } \
          { const f32x2v v2 = __builtin_amdgcn_cvt_scalef32_pk_f32_fp4(wa, 1.0f, 3); y[8 * dd + 6] += CF * v2.x; y[8 * dd + 7] += CF * v2.y; } } } while (0)
#define PG_BATCH(E0, DOISSUE) do { v4u ub[NBT], vb[NBT]; float su_[NBT], gt_[NBT]; \
      _Pragma("unroll") for (int q = 0; q < NBT; ++q) { const LAS unsigned char* s0_ = RB + (((E0) + q) & 7) * 2048 + lane * 16; ub[q] = *(const LAS v4u*)s0_; vb[q] = *(const LAS v4u*)(s0_ + 1024); su_[q] = esu[(E0) + q]; gt_[q] = egt[(E0) + q]; } \
      asm volatile("s_waitcnt lgkmcnt(0)" ::: "memory"); \
      if (DOISSUE) { _Pragma("unroll") for (int q = 0; q < NBT; ++q) PG_ISSUE((E0) + 8 + q); } \
      float d_[NBT]; _Pragma("unroll") for (int q = 0; q < NBT; ++q) { d_[q] = 0.f; PG_DOT(ub[q], d_[q]); } \
      PROBE_EXTRA \
      _Pragma("unroll") for (int q = 0; q < NBT; ++q) d_[q] = wave_sum_dpp(d_[q]); \
      _Pragma("unroll") for (int q = 0; q < NBT; ++q) { const float c_ = gelu_erf(d_[q] * (rsx * su_[q])) * gt_[q]; PG_AXPY(vb[q], c_); __builtin_amdgcn_sched_barrier(0); } } while (0)
#if defined(PROBE_CVT)
#define PROBE_EXTRA _Pragma("unroll") for (int q = 0; q < NBT; ++q) _Pragma("unroll") for (int dd = 0; dd < 4; ++dd) { const unsigned wz = ub[q][dd]; \
        const f32x2v r0 = __builtin_amdgcn_cvt_scalef32_pk_f32_fp4(wz, 1.0f, 0), r1 = __builtin_amdgcn_cvt_scalef32_pk_f32_fp4(wz, 1.0f, 1), r2 = __builtin_amdgcn_cvt_scalef32_pk_f32_fp4(wz, 1.0f, 2), r3 = __builtin_amdgcn_cvt_scalef32_pk_f32_fp4(wz, 1.0f, 3); \
        asm volatile("" :: "v"(r0), "v"(r1), "v"(r2), "v"(r3)); }
#elif defined(PROBE_DOT)
#define PROBE_EXTRA _Pragma("unroll") for (int q = 0; q < NBT; ++q) _Pragma("unroll") for (int dd = 0; dd < 16; ++dd) { \
        const float r0 = __builtin_amdgcn_fdot2_f32_bf16(__builtin_bit_cast(bfv2, xw[dd]), __builtin_bit_cast(bfv2, ub[q][dd & 3]), su_[q], false); asm volatile("" :: "v"(r0)); }
#elif defined(PROBE_FMA16)
#define PROBE_EXTRA _Pragma("unroll") for (int q = 0; q < NBT; ++q) _Pragma("unroll") for (int dd = 0; dd < 16; ++dd) { \
        unsigned r0 = ub[q][dd & 3]; asm volatile("v_pk_fma_f16 %0, %1, %1, %0" : "+v"(r0) : "v"(xw[dd])); asm volatile("" :: "v"(r0)); }
#elif defined(PROBE_DOTF16)
#define PROBE_EXTRA _Pragma("unroll") for (int q = 0; q < NBT; ++q) _Pragma("unroll") for (int dd = 0; dd < 16; ++dd) { \
        float r0 = su_[q]; asm volatile("v_dot2_f32_f16 %0, %1, %2, %0" : "+v"(r0) : "v"(xw[dd]), "v"(ub[q][dd & 3])); asm volatile("" :: "v"(r0)); }
#elif defined(PROBE_SDOT4)
#define PROBE_EXTRA _Pragma("unroll") for (int q = 0; q < NBT; ++q) _Pragma("unroll") for (int dd = 0; dd < 16; ++dd) { \
        int r0 = (int)ub[q][(dd + 1) & 3]; asm volatile("v_dot4_i32_i8 %0, %1, %2, %0" : "+v"(r0) : "v"(xw[dd]), "v"(ub[q][dd & 3])); asm volatile("" :: "v"(r0)); }
#elif defined(PROBE_SDOT8)
#define PROBE_EXTRA _Pragma("unroll") for (int q = 0; q < NBT; ++q) _Pragma("unroll") for (int dd = 0; dd < 16; ++dd) { \
        int r0 = (int)ub[q][(dd + 1) & 3]; asm volatile("v_dot8_i32_i4 %0, %1, %2, %0" : "+v"(r0) : "v"(xw[dd]), "v"(ub[q][dd & 3])); asm volatile("" :: "v"(r0)); }
#elif defined(PROBE_FMA)
#define PROBE_EXTRA _Pragma("unroll") for (int q = 0; q < NBT; ++q) _Pragma("unroll") for (int dd = 0; dd < 16; ++dd) { \
        f32x2v r0 = {su_[q], gt_[q]}; const f32x2v a_ = {y[2 * dd], y[2 * dd + 1]}; asm volatile("v_pk_fma_f32 %0, %1, %1, %0" : "+v"(r0) : "v"(a_)); asm volatile("" :: "v"(r0)); }
#else
#define PROBE_EXTRA
#endif
    constexpr int NBT = 2;
#pragma unroll
    for (int e = 0; e < 8; ++e) PG_ISSUE(e);
#pragma unroll 1
    for (int e = 0; e < 120; e += NBT) {
      asm volatile("s_waitcnt vmcnt(12)" ::: "memory");
      PG_BATCH(e, true);
      asm volatile("" ::: "memory");
    }
    asm volatile("s_waitcnt vmcnt(0)" ::: "memory");
#pragma unroll 1
    for (int e = 120; e < 128; e += NBT) PG_BATCH(e, false);
    asm volatile("s_waitcnt lgkmcnt(0)" ::: "memory");
#undef PG_ISSUE
#undef PG_DOT
#undef PG_AXPY
#undef PG_BATCH
#undef PROBE_EXTRA
    float* drow = dst_base + (size_t)tok * DM;
#pragma unroll
    for (int q = 0; q < 8; ++q) { const size_t off = (size_t)q * 256 + lane * 4; f32x4 hv;
      hv.x = bflo(xw[2 * q]) + y[4 * q]; hv.y = bfhi(xw[2 * q]) + y[4 * q + 1]; hv.z = bflo(xw[2 * q + 1]) + y[4 * q + 2]; hv.w = bfhi(xw[2 * q + 1]) + y[4 * q + 3]; *(f32x4*)(drow + off) = hv; }
    }
  }
}
constexpr int MISC_LDS = LDS_BYTES - 256;
__global__ void __launch_bounds__(NTHR, 2) mk_fwd(Args args) {
  extern __shared__ __attribute__((aligned(16))) unsigned char lds_raw[];
  Frame F; F.lds = (LAS unsigned char*)lds_raw; F.ws = args.ws; F.tid = threadIdx.x; F.lane = F.tid & 63; F.wave = __builtin_amdgcn_readfirstlane(F.tid >> 6);
  const int lo = args.ph_lo, hi = args.ph_hi, G = (int)gridDim.x, bx = (int)blockIdx.x;
  volatile LAS unsigned* misc = (volatile LAS unsigned*)(F.lds + MISC_LDS);
  if (F.tid < 16) misc[F.tid] = 0u;
  __syncthreads();
  XcdBarrier bar = xcd_barrier_post((unsigned*)(F.ws + WS_CTL) + CW_BAR, misc);
#define IN(k) (lo <= (k) && (k) < hi)
#define SEAM(k) do { if (IN(k) && IN((k) + 1)) xcd_barrier(bar); } while (0)
#define PHASE_FRAME(Fp) Frame Fp = F; asm volatile("" : "+v"(Fp.tid), "+v"(Fp.lane))
  const int NA = G;
  if (IN(0)) { PHASE_FRAME(F0);
#ifdef SLEEP_START
#pragma unroll 1
    for (int i_ = 0; i_ < SLEEP_START; ++i_) __builtin_amdgcn_s_sleep(127);
#endif
    p0_lam(F0, args);
    p0_zero_vpad(F0);
    p0_rows(F0, args);
    p0_transpose<true>(F0, args, args.in[IN_WIN], DPROJ, NPROJ, (bf16*)(F.ws + WS_W1T));
    p0_transpose<false>(F0, args, args.in[IN_WOUT], DM, DM, (bf16*)(F.ws + WS_W2T));
    p0_w3t(F0, args);
    p0_tables(F0, args);
#ifdef DUP_ROWS
    p0_rows(F0, args);
#endif
#ifdef DUP_TR
    p0_transpose<true>(F0, args, args.in[IN_WIN], DPROJ, NPROJ, (bf16*)(F.ws + WS_W1T));
    p0_transpose<false>(F0, args, args.in[IN_WOUT], DM, DM, (bf16*)(F.ws + WS_W2T));
#endif
#ifdef DUP_W3T
    p0_w3t(F0, args);
#endif
#ifdef DUP_TAB
    p0_tables(F0, args);
#endif
  }
  SEAM(0);
  if (IN(1)) { PHASE_FRAME(F1);
    p1_meta_finalize(F1, args);
    pg8::Gemm g{(const pg8::bf16_t*)(F.ws + WS_XN), (const pg8::bf16_t*)(F.ws + WS_W1T), MROWS, NPROJ, DM};
    pg8::StaticOrder S; S.init(MROWS, NPROJ, G, bx);
    EpiProj E{(bf16*)(F.ws + WS_Q), (bf16*)(F.ws + WS_KP), (bf16*)(F.ws + WS_VP), (bf16*)(F.ws + WS_MQ), (bf16*)(F.ws + WS_MK), (bf16*)(F.ws + WS_MV), (bf16*)(F.ws + WS_MO),
              args.in[IN_QNG], args.in[IN_KNG], (LAS float*)(F.lds + XCH_OFF)};
    pg8::gemm_phase<EpiProj, pg8::StaticOrder, true, true>(F.lds + RING_OFF, g, S, E);
  }
  SEAM(1);
  if (IN(2)) {
    PHASE_FRAME(F2);
    att::phase(F2, (G % 8 == 0) ? (bx & 7) * (G >> 3) + (bx >> 3) : bx, NA);
    for (int task = bx; task < 512; task += G) ml::taskA(F2, args, task);
  }
  SEAM(2);
  if (IN(3)) { PHASE_FRAME(F3); ml::scanB(F3); p3_combine(F3, args, NA);
#ifdef DUP_SCAN
    ml::scanB(F3);
#endif
#ifdef DUP_COMB
    p3_combine(F3, args, NA);
#endif
  }
  SEAM(3);
  if (IN(4)) {
    PHASE_FRAME(F4);
    for (int task = bx; task < 512; task += G) ml::taskC(F4, args, task);
  }
  SEAM(4);
  if (IN(5)) {
    pg8::Gemm g{(const pg8::bf16_t*)(F.ws + WS_A2), (const pg8::bf16_t*)(F.ws + WS_W2T), MROWS, DM, DM};
    pg8::StaticOrder S; S.init(MROWS, DM, G, bx);
    EpiRes E{args.in[IN_X], args.out, (bf16*)(F.ws + WS_H1B), (float*)(F.ws + WS_SSQ)};
    pg8::gemm_phase<EpiRes, pg8::StaticOrder, true, true>(F.lds + RING_OFF, g, S, E);
  }
  SEAM(5);
  if (IN(6)) {
    pg8::Gemm g{(const pg8::bf16_t*)(F.ws + WS_H1B), (const pg8::bf16_t*)(F.ws + WS_W3T), MROWS, DM, DM};
    pg8::StaticOrder S; S.init(MROWS, DM, G, bx);
    LAS float* rst = (LAS float*)(F.lds + XCH_OFF);
    { pg8::Unit u0; if (S.next(0, u0)) { if (F.tid < 256) { const float* sp = (const float*)(F.ws + WS_SSQ) + ((size_t)u0.pm * 256 + F.tid) * 32; float s = 0.f;
#pragma unroll
          for (int i = 0; i < 8; ++i) { const f32x4 v = ((const f32x4*)sp)[i]; s += (v.x + v.y) + (v.z + v.w); }
          rst[F.tid] = rsqrtf(s * (1.0f / DM) + EPS); } } }
    __syncthreads();
    EpiScore E{(float*)(F.ws + WS_S), rst};
    pg8::gemm_phase<EpiScore, pg8::StaticOrder, true, true>(F.lds + RING_OFF, g, S, E);
  }
  SEAM(6);
  if (IN(7)) { PHASE_FRAME(F7); p6_peer(F7, args, args.out); }
#undef IN
#undef SEAM
}
extern "C" void kernel_launch(void* const* d_in, const int* in_sizes, int n_in, void* d_out, int out_size, void* d_ws, size_t ws_size, hipStream_t stream) {
  static int grid = 0;
  if (grid == 0) {
    int dev = 0, cus = 0, per_cu = 0;
    if (hipGetDevice(&dev) != hipSuccess || hipDeviceGetAttribute(&cus, hipDeviceAttributeMultiprocessorCount, dev) != hipSuccess) { fprintf(stderr, "device query failed\n"); grid = -1; return; }
    if (hipFuncSetAttribute((const void*)mk_fwd, hipFuncAttributeMaxDynamicSharedMemorySize, LDS_BYTES) != hipSuccess) { fprintf(stderr, "hipFuncSetAttribute failed\n"); grid = -1; return; }
    if (hipOccupancyMaxActiveBlocksPerMultiprocessor(&per_cu, (const void*)mk_fwd, NTHR, LDS_BYTES) != hipSuccess || per_cu < 1) { fprintf(stderr, "occupancy query says %d workgroups per CU: not launching\n", per_cu); (void)hipGetLastError(); grid = -1; return; }
    (void)hipGetLastError();
    grid = cus;
    if (n_in != 22 || ws_size < (size_t)512 * MiB || out_size != MROWS * DM) { fprintf(stderr, "unexpected shapes: n_in %d out %d ws %zu\n", n_in, out_size, ws_size); grid = -1; return; }
  }
  if (grid < 0) return;
  unsigned char* ws = (unsigned char*)d_ws;
  if (hipMemsetAsync(ws + WS_CTL, 0, CTL_ZERO_BYTES, stream) != hipSuccess) { fprintf(stderr, "memset failed\n"); return; }
  Args a{};
  for (int i = 0; i < 22; ++i) a.in[i] = (const float*)d_in[i];
  a.out = (float*)d_out; a.ws = ws; a.na = 0; a.pad = 0;
  a.ph_lo = 0; a.ph_hi = 8;
  hipLaunchKernelGGL(mk_fwd, dim3(grid), dim3(NTHR), LDS_BYTES, stream, a);
}
```

```cpp
#include <hip/hip_runtime.h>
#include <cstdio>
#include <cstdint>
#include <math.h>
namespace pg8 {
#define PG8_LAS __attribute__((address_space(3)))
typedef unsigned short bf16_t;
typedef short bf16x8 __attribute__((ext_vector_type(8)));
typedef float f32x4 __attribute__((ext_vector_type(4)));
typedef unsigned u32x4 __attribute__((ext_vector_type(4)));
constexpr int BM = 256, BK = 64, HALF = 128, HTB = HALF * BK * 2  , STAGE_BYTES = 8 * HTB, NXCD = 8, WGM = 8;

__host__ __device__ __forceinline__ int lds_byte(int r, int c) { const int st = (r >> 4) * 2 + (c >> 5), rr = r & 15, cc = c & 31, ob = rr * 64 + cc * 2; return st * 1024 + (ob ^ (((ob >> 9) & 1) << 5)); }
__host__ __device__ __forceinline__ void stage_rc(int b, int& R, int& C) { const int st = b / 1024, sb = b % 1024, swz = sb ^ (((sb >> 9) & 1) << 5); R = (st >> 1) * 16 + swz / 64; C = (st & 1) * 32 + (swz % 64) / 2; }
__host__ __device__ __forceinline__ int perm32(int rho) { const int n = rho >> 4, i = rho & 15; return 8 * (i >> 2) + 4 * n + (i & 3); }

struct Unit { int pm, pn; };
struct Gemm { const bf16_t* A; const bf16_t* Bt; int M, N, K; };

struct StaticOrder {
    int nM, nN, nwg, G, c;
    __host__ __device__ void init(int M, int N, int G_, int c_) { nM = M / BM; nN = N / BM; nwg = nM * nN; G = G_; c = c_; }
    __host__ __device__ bool next(int i, Unit& u) const {
        const long L = (long)i * G + c; if (L >= nwg) return false;
        int wgid = (int)L; { const int q = nwg / NXCD, r = nwg % NXCD, xcd = wgid % NXCD, off = wgid / NXCD; wgid = (xcd < r ? xcd * (q + 1) : r * (q + 1) + (xcd - r) * q) + off; }
        const int nig = WGM * nN, gid = wgid / nig, fm = gid * WGM, gsz = (nM - fm) < WGM ? (nM - fm) : WGM;
        u.pm = fm + ((wgid % nig) % gsz); u.pn = (wgid % nig) / gsz; return true;
    }
    __device__ __forceinline__ void a_ready(const Unit&) const {}
    __device__ __forceinline__ void done(const Unit&) const {}
};

__device__ __forceinline__ unsigned cvt_pk_bf16(float lo, float hi) { unsigned r; asm volatile("v_cvt_pk_bf16_f32 %0, %1, %2" : "=v"(r) : "v"(lo), "v"(hi)); return r; }
typedef float f32x2 __attribute__((ext_vector_type(2)));
template <class Epi, class Sched, bool ALIGN_EPI = false, bool SP2 = false>
__device__ __forceinline__ void gemm_phase(PG8_LAS unsigned char* lds, const Gemm g, const Sched& S, const Epi& E) {
    int tid_ = threadIdx.x; asm volatile("" : "+v"(tid_));
    const int tid = tid_, wid = __builtin_amdgcn_readfirstlane(tid >> 6), lane = tid & 63, wr = wid >> 2, wc = wid & 3, fr = lane & 15, fq = lane >> 4;
    const int K = g.K, nt = K / BK;
    unsigned voffA[2], voffB[2];
#pragma unroll
    for (int i = 0; i < 2; ++i) { int R, C; stage_rc(tid * 16 + i * 8192, R, C); const int Rb = Epi::PERM ? ((R & ~31) + perm32(R & 31)) : R;
        voffA[i] = (unsigned)(R * K + C) * 2u; voffB[i] = (unsigned)(Rb * K + C) * 2u; }
    const size_t kstep = (size_t)(BK * 2);
    const size_t hstep = (size_t)HALF * K * 2;
    const size_t tstep = 2 * hstep;
    const unsigned ldsw = (unsigned)wid * 1024u;
    const int aoff = lds_byte(wr * 64 + fr, fq * 8), boff = lds_byte(wc * 32 + fr, fq * 8);
#define PG8_SA(b, h) (((b) * 2 + (h)) * HTB)
#define PG8_SB(b, h) ((4 + (b) * 2 + (h)) * HTB)
#define PG8_STAGE(bufoff, gbase, voff) do { _Pragma("unroll") for (int _i = 0; _i < 2; ++_i) \
        __builtin_amdgcn_global_load_lds((const unsigned*)((const char*)(gbase) + (voff)[_i]), (PG8_LAS unsigned*)(lds + (bufoff) + ldsw + _i * 8192), 16, 0, 0); } while (0)
#define PG8_LDA(dst, b, h) do { _Pragma("unroll") for (int m = 0; m < 4; ++m) _Pragma("unroll") for (int k = 0; k < 2; ++k) dst[m][k] = *(const PG8_LAS bf16x8*)(lds + PG8_SA(b, h) + aoff + m * 2048 + k * 1024); } while (0)
#define PG8_LDB(dst, b, h) do { _Pragma("unroll") for (int n = 0; n < 2; ++n) _Pragma("unroll") for (int k = 0; k < 2; ++k) dst[n][k] = *(const PG8_LAS bf16x8*)(lds + PG8_SB(b, h) + boff + n * 2048 + k * 1024); } while (0)
#define PG8_MMA(ai, bj, At, Bt) do { __builtin_amdgcn_s_setprio(1); _Pragma("unroll") for (int m = 0; m < 4; ++m) _Pragma("unroll") for (int n = 0; n < 2; ++n) _Pragma("unroll") for (int k = 0; k < 2; ++k) \
        acc[ai][bj][m][n] = __builtin_amdgcn_mfma_f32_16x16x32_bf16(Bt[n][k], At[m][k], acc[ai][bj][m][n], 0, 0, 0); __builtin_amdgcn_s_setprio(0); } while (0)
#define PG8_WAIT_V(n) asm volatile("s_waitcnt vmcnt(" #n ")" ::: "memory")
#define PG8_WAIT_L(n) asm volatile("s_waitcnt lgkmcnt(" #n ")" ::: "memory")
#define PG8_BAR __builtin_amdgcn_s_barrier()
#define PG8_SCHED __builtin_amdgcn_sched_barrier(0)
    Unit cur, nxt; int ui = 0;
    if (!S.next(0, cur)) return;
    f32x4 acc[2][2][4][2];
#pragma unroll
    for (int a = 0; a < 2; ++a)
#pragma unroll
        for (int b = 0; b < 2; ++b)
#pragma unroll
            for (int m = 0; m < 4; ++m)
#pragma unroll
                for (int n = 0; n < 2; ++n) acc[a][b][m][n] = (f32x4){0.f, 0.f, 0.f, 0.f};
    bf16x8 At[4][2], B0[2][2], B1[2][2];
    const char* cA = (const char*)g.A + (size_t)cur.pm * tstep; const char* cB = (const char*)g.Bt + (size_t)cur.pn * tstep;
    S.a_ready(cur);
    if constexpr (SP2) {
        PG8_STAGE(PG8_SB(0, 0), cB, voffB); PG8_STAGE(PG8_SB(0, 1), cB + hstep, voffB); PG8_STAGE(PG8_SA(0, 0), cA, voffA); PG8_STAGE(PG8_SA(0, 1), cA + hstep, voffA);
        if (wr == 1) PG8_BAR;
        PG8_WAIT_V(2); PG8_BAR;
        PG8_STAGE(PG8_SB(1, 0), cB + kstep, voffB); PG8_STAGE(PG8_SA(1, 0), cA + kstep, voffA); PG8_STAGE(PG8_SB(1, 1), cB + hstep + kstep, voffB);
        PG8_WAIT_V(6); PG8_BAR;
    } else {
        PG8_STAGE(PG8_SB(0, 0), cB, voffB); PG8_STAGE(PG8_SA(0, 0), cA, voffA); PG8_STAGE(PG8_SB(0, 1), cB + hstep, voffB); PG8_STAGE(PG8_SA(0, 1), cA + hstep, voffA);
        if (wr == 1) PG8_BAR;
        PG8_WAIT_V(4); PG8_BAR;
        PG8_STAGE(PG8_SB(1, 0), cB + kstep, voffB); PG8_STAGE(PG8_SA(1, 0), cA + kstep, voffA); PG8_STAGE(PG8_SB(1, 1), cB + hstep + kstep, voffB);
        PG8_WAIT_V(6); PG8_BAR;
    }
    for (;;) {
        const bool has_next = S.next(ui + 1, nxt);
        const char* nA = has_next ? (const char*)g.A + (size_t)nxt.pm * tstep : cA; const char* nB = has_next ? (const char*)g.Bt + (size_t)nxt.pn * tstep : cB;
        for (int t = 0; t < nt; t += 2) {
            const bool last = (t == nt - 2);
            const char* a1 = cA + (size_t)(t + 1) * kstep;
            const char* a2 = last ? nA : cA + (size_t)(t + 2) * kstep; const char* b2 = last ? nB : cB + (size_t)(t + 2) * kstep;
            const char* a3 = a2 + kstep; const char* b3 = b2 + kstep;
            if (last && has_next) S.a_ready(nxt);
            if constexpr (SP2) {
            PG8_LDB(B0, 0, 0); PG8_LDB(B1, 0, 1); PG8_SCHED; PG8_LDA(At, 0, 0); PG8_STAGE(PG8_SA(1, 1), a1 + hstep, voffA);
            PG8_WAIT_V(8); PG8_WAIT_L(0); PG8_BAR; PG8_MMA(0, 0, At, B0); PG8_MMA(0, 1, At, B1); PG8_BAR; PG8_SCHED;
            PG8_LDA(At, 0, 1); PG8_STAGE(PG8_SB(0, 0), b2, voffB); PG8_STAGE(PG8_SB(0, 1), b2 + hstep, voffB); PG8_STAGE(PG8_SA(0, 0), a2, voffA);
            PG8_WAIT_V(8); PG8_WAIT_L(0); PG8_BAR; PG8_MMA(1, 0, At, B0); PG8_MMA(1, 1, At, B1); PG8_BAR; PG8_SCHED;
            PG8_LDB(B0, 1, 0); PG8_LDB(B1, 1, 1); PG8_SCHED; PG8_LDA(At, 1, 0); PG8_STAGE(PG8_SA(0, 1), a2 + hstep, voffA);
            PG8_WAIT_V(8); PG8_WAIT_L(0); PG8_BAR; PG8_MMA(0, 0, At, B0); PG8_MMA(0, 1, At, B1); PG8_BAR; PG8_SCHED;
            PG8_LDA(At, 1, 1); PG8_STAGE(PG8_SB(1, 0), b3, voffB); PG8_STAGE(PG8_SB(1, 1), b3 + hstep, voffB); PG8_STAGE(PG8_SA(1, 0), a3, voffA);
            PG8_WAIT_V(8); PG8_WAIT_L(0); PG8_BAR; PG8_MMA(1, 0, At, B0); PG8_MMA(1, 1, At, B1); PG8_BAR; PG8_SCHED;
            } else {
            PG8_LDB(B0, 0, 0); PG8_SCHED; PG8_LDA(At, 0, 0); PG8_STAGE(PG8_SA(1, 1), a1 + hstep, voffA);
            PG8_WAIT_L(8); PG8_BAR; PG8_WAIT_L(0); PG8_MMA(0, 0, At, B0); PG8_BAR; PG8_SCHED;
            PG8_LDB(B1, 0, 1); PG8_STAGE(PG8_SB(0, 0), b2, voffB);
            PG8_BAR; PG8_WAIT_L(0); PG8_MMA(0, 1, At, B1); PG8_BAR;
            PG8_LDA(At, 0, 1); PG8_STAGE(PG8_SA(0, 0), a2, voffA);
            PG8_BAR; PG8_WAIT_L(0); PG8_MMA(1, 0, At, B0); PG8_BAR; PG8_SCHED;
            PG8_STAGE(PG8_SB(0, 1), b2 + hstep, voffB);
            PG8_WAIT_V(6); PG8_BAR; PG8_MMA(1, 1, At, B1); PG8_BAR;
            PG8_LDB(B0, 1, 0); PG8_SCHED; PG8_LDA(At, 1, 0); PG8_STAGE(PG8_SA(0, 1), a2 + hstep, voffA);
            PG8_WAIT_L(8); PG8_BAR; PG8_WAIT_L(0); PG8_MMA(0, 0, At, B0); PG8_BAR; PG8_SCHED;
            PG8_LDB(B1, 1, 1); PG8_STAGE(PG8_SB(1, 0), b3, voffB);
            PG8_BAR; PG8_WAIT_L(0); PG8_MMA(0, 1, At, B1); PG8_BAR;
            PG8_LDA(At, 1, 1); PG8_STAGE(PG8_SA(1, 0), a3, voffA);
            PG8_BAR; PG8_WAIT_L(0); PG8_MMA(1, 0, At, B0); PG8_BAR; PG8_SCHED;
            PG8_STAGE(PG8_SB(1, 1), b3 + hstep, voffB);
            PG8_WAIT_V(6); PG8_BAR; PG8_MMA(1, 1, At, B1); PG8_BAR;
            }
        }
        if constexpr (ALIGN_EPI) { if (wr == 0) PG8_BAR; }
        if constexpr (!Epi::AFTER_DRAIN) { E(acc, cur, wr, wc, fr, fq); S.done(cur); }
        if (!has_next) break;
#pragma unroll
        for (int a = 0; a < 2; ++a)
#pragma unroll
            for (int b = 0; b < 2; ++b)
#pragma unroll
                for (int m = 0; m < 4; ++m)
#pragma unroll
                    for (int n = 0; n < 2; ++n) acc[a][b][m][n] = (f32x4){0.f, 0.f, 0.f, 0.f};
        cur = nxt; cA = nA; cB = nB; ++ui;
        if constexpr (ALIGN_EPI) { if (wr == 1) PG8_BAR; }
    }
    PG8_WAIT_V(0);
    if constexpr (!ALIGN_EPI) { if (wr == 0) PG8_BAR; }
    PG8_BAR;
    if constexpr (Epi::AFTER_DRAIN) { E.fused(acc, cur, wr, wc, fr, fq, lds, wid, lane); S.done(cur); }
#undef PG8_SA
#undef PG8_SB
#undef PG8_STAGE
#undef PG8_LDA
#undef PG8_LDB
#undef PG8_MMA
#undef PG8_WAIT_V
#undef PG8_WAIT_L
#undef PG8_BAR
#undef PG8_SCHED
}
}
#define GAS __attribute__((address_space(1)))
#define LAS __attribute__((address_space(3)))
typedef unsigned short bf16;
typedef unsigned v4u __attribute__((ext_vector_type(4)));
typedef unsigned v2u __attribute__((ext_vector_type(2)));
typedef float f32x4 __attribute__((ext_vector_type(4)));
typedef short bf16x8 __attribute__((ext_vector_type(8)));
#define LDS_WAIT() asm volatile("s_waitcnt lgkmcnt(0)" ::: "memory")
#define VM_WAIT() asm volatile("s_waitcnt vmcnt(0)" ::: "memory")

constexpr int DM = 2048, NB = 4, SEQ = 2048, NMETA = 16, MROWS = NB * SEQ, DPROJ = 6152, NPROJ = 6144;
constexpr int PADT = 2112, POS0 = 64, MPOS0 = 48;
constexpr float EPS = 1e-6f;
constexpr float LOG2E = 1.4426950408889634f;
constexpr float QSCALE = 0.08838834764831845f * LOG2E;
constexpr int NWAVES = 8, NTHR = 512;

constexpr size_t MiB = 1u << 20;
constexpr size_t WS_CTL = 0, CTL_ZERO_BYTES = 32 * 1024;
constexpr size_t WS_PM = 484 * MiB;
constexpr size_t WS_W1T = 2 * MiB, WS_W2T = 26 * MiB, WS_W3T = 34 * MiB, WS_XN = 42 * MiB;
constexpr size_t WS_Q = 74 * MiB, WS_KP = 90 * MiB, WS_VP = 107 * MiB, WS_MQ = 124 * MiB, WS_MK = 133 * MiB, WS_MV = 142 * MiB, WS_MO = 159 * MiB;
constexpr size_t WS_SMALL = 175 * MiB;
constexpr size_t WS_XM = WS_SMALL, WS_LI = WS_SMALL + 128 * 1024, WS_LF = WS_SMALL + 384 * 1024, WS_LAM = WS_SMALL + 640 * 1024;
constexpr size_t WS_PO = 176 * MiB, WS_ML = 304 * MiB, WS_HM = 305 * MiB, WS_A2 = 42 * MiB, WS_H1B = 74 * MiB, WS_SSQ = 106 * MiB, WS_S = 176 * MiB, WS_UB = 384 * MiB, WS_VB = 448 * MiB;
constexpr size_t WS_SCL = WS_SMALL + 704 * 1024;
constexpr size_t WS_VB8 = WS_UB + 32 * MiB;
constexpr size_t WS_DC = 305 * MiB, WS_CS = 448 * MiB, WS_DN = 482 * MiB, WS_NS = WS_DN + 512 * 1024, WS_GS = WS_DN + 1024 * 1024, WS_MS = WS_DN + 1152 * 1024;
constexpr size_t WS_EID = 240 * MiB, WS_EGT = 244 * MiB;
constexpr int CW_BAR = 4096;

constexpr int RING_OFF = 0, RING_BYTES = 131072;
constexpr int XCH_OFF = 131072;
constexpr int MISC_OFF = XCH_OFF + 8192;
constexpr int LDS_BYTES = 155648;

__device__ __forceinline__ unsigned f2bf(float f) { unsigned u = __builtin_bit_cast(unsigned, f); return (u + 0x7fffu + ((u >> 16) & 1u)) >> 16; }
__device__ __forceinline__ unsigned pk2(float lo, float hi) { return f2bf(lo) | (f2bf(hi) << 16); }
__device__ __forceinline__ float bf2f(unsigned short u) { return __builtin_bit_cast(float, (unsigned)u << 16); }
__device__ __forceinline__ float bflo(unsigned w) { return __builtin_bit_cast(float, w << 16); }
__device__ __forceinline__ float bfhi(unsigned w) { return __builtin_bit_cast(float, w & 0xffff0000u); }
__device__ __forceinline__ float wave_sum(float v) {
#pragma unroll
  for (int o = 1; o < 64; o <<= 1) v += __shfl_xor(v, o);
  return v;
}
__device__ __forceinline__ size_t kp_off(int bhm, int pos, int d) { const int j = pos >> 6, row = pos & 63, d0 = d >> 4, hi = (d >> 3) & 1;
  return ((size_t)(bhm * 33 + j) * 8 + d0) * 1024 + (size_t)((((row << 1) | hi) ^ ((row >> 3) & 1)) << 3) + (d & 7); }
__device__ __forceinline__ float wave_sum_dpp(float v) {
  v += __builtin_bit_cast(float, __builtin_amdgcn_update_dpp(0, __builtin_bit_cast(int, v), 0xB1, 0xF, 0xF, true));
  v += __builtin_bit_cast(float, __builtin_amdgcn_update_dpp(0, __builtin_bit_cast(int, v), 0x4E, 0xF, 0xF, true));
  v += __builtin_bit_cast(float, __builtin_amdgcn_update_dpp(0, __builtin_bit_cast(int, v), 0x141, 0xF, 0xF, true));
  v += __builtin_bit_cast(float, __builtin_amdgcn_update_dpp(0, __builtin_bit_cast(int, v), 0x140, 0xF, 0xF, true));
  const float r0 = __builtin_bit_cast(float, __builtin_amdgcn_readlane(__builtin_bit_cast(int, v), 0)), r1 = __builtin_bit_cast(float, __builtin_amdgcn_readlane(__builtin_bit_cast(int, v), 16));
  const float r2 = __builtin_bit_cast(float, __builtin_amdgcn_readlane(__builtin_bit_cast(int, v), 32)), r3 = __builtin_bit_cast(float, __builtin_amdgcn_readlane(__builtin_bit_cast(int, v), 48));
  return (r0 + r1) + (r2 + r3);
}
__device__ __forceinline__ float sigmoidf_(float x) { return 1.0f / (1.0f + __expf(-x)); }

#ifdef TPROBE
#ifndef TP_BLOCK
#define TP_BLOCK 0
#endif
#ifndef TP_DIV
#define TP_DIV 1.0f
#endif
#define TP_BEGIN(id) unsigned long long tp_t0_##id = 0; do { if (TPROBE == (id)) tp_t0_##id = __builtin_amdgcn_s_memrealtime(); } while (0)
#define TP_END(id, WS) do { if (TPROBE == (id)) { const unsigned long long t1_ = __builtin_amdgcn_s_memrealtime(); if ((int)blockIdx.x == TP_BLOCK && threadIdx.x == 0) atomicAdd((unsigned*)((WS) + 64), (unsigned)(t1_ - tp_t0_##id)); } } while (0)
#else
#define TP_BEGIN(id)
#define TP_END(id, WS)
#endif
#define XB_TMO      128
#define XB_XCNT(j)  (256  + 64 * (j))
#define XB_XSUB(j)  (1280 + 64 * (j))
#define XB_XGEN(j)  (2304 + 64 * (j))
#define XB_TOP      3328
#define XB_TOPGEN   3392
#define XCD_BAR_WORDS 3456
#define XB_SPIN_CAP (1u << 18)

__device__ __forceinline__ unsigned xb_ld(unsigned* p)              { return __hip_atomic_load(p, __ATOMIC_RELAXED, __HIP_MEMORY_SCOPE_AGENT); }
__device__ __forceinline__ unsigned xb_add(unsigned* p, unsigned v) { return __hip_atomic_fetch_add(p, v, __ATOMIC_RELAXED, __HIP_MEMORY_SCOPE_AGENT); }
__device__ __forceinline__ unsigned xb_xcc_id() { return (unsigned)__builtin_amdgcn_s_getreg((3 << 11) | 20) & 0xFu; }
#define XB_SPIN(cond, bar) do { unsigned _sp = 0; while (cond) { __builtin_amdgcn_s_sleep(1); \
    if ((++_sp & 255u) == 0u) { if (xb_ld(&(bar)[XB_TMO])) break; if (_sp > XB_SPIN_CAP) { atomicAdd(&(bar)[XB_TMO], 1u); break; } } } } while (0)

struct XcdBarrier {
    unsigned* bar; unsigned x;
    volatile LAS unsigned* st;
};

__device__ __forceinline__ XcdBarrier xcd_barrier_post(unsigned* bar, volatile LAS unsigned* st) {
    XcdBarrier b; b.bar = bar; b.x = xb_xcc_id(); b.st = st;
    if (threadIdx.x == 0) (void)xb_add(&bar[XB_XCNT(b.x)], 1u);
    return b;
}
__device__ __forceinline__ void xcd_barrier_complete(unsigned* bar, unsigned x, unsigned& nloc, unsigned& nx) {
    const unsigned G = gridDim.x * gridDim.y * gridDim.z;
    unsigned sum, cnt, mine, sp = 0u;
    for (;;) {
        sum = 0u; cnt = 0u; mine = 0u;
#pragma unroll
        for (unsigned j = 0; j < 16; ++j) { const unsigned c = xb_ld(&bar[XB_XCNT(j)]); sum += c; cnt += (c > 0u) ? 1u : 0u; mine = (j == x) ? c : mine; }
        if (sum == G) break;
        __builtin_amdgcn_s_sleep(1);
        if ((++sp & 255u) == 0u) { if (xb_ld(&bar[XB_TMO])) break; if (sp > XB_SPIN_CAP) { atomicAdd(&bar[XB_TMO], 1u); break; } }
    }
    nloc = mine > 0u ? mine : 1u; nx = cnt > 0u ? cnt : 1u;
}

__device__ __forceinline__ void xcd_barrier(const XcdBarrier& b) {
    asm volatile("s_waitcnt vmcnt(0)" ::: "memory");
    __syncthreads();
    if (threadIdx.x == 0) {
        unsigned* bar = b.bar;
        __builtin_amdgcn_s_waitcnt(0);
        unsigned nloc = b.st[0], nx = b.st[1];
        if (nloc == 0u) { xcd_barrier_complete(bar, b.x, nloc, nx); b.st[0] = nloc; b.st[1] = nx; }
        const unsigned old = xb_add(&bar[XB_XSUB(b.x)], 1u);
        const unsigned gen = old / nloc;
        if (old + 1u == (gen + 1u) * nloc) {
            __builtin_amdgcn_fence(__ATOMIC_RELEASE, "agent");
            asm volatile("s_waitcnt vmcnt(0)" ::: "memory");
            const unsigned og = xb_add(&bar[XB_TOP], 1u);
            const unsigned tg = og / nx;
            if (og + 1u == (tg + 1u) * nx) xb_add(&bar[XB_TOPGEN], 1u);
            else XB_SPIN(xb_ld(&bar[XB_TOPGEN]) == tg, bar);
            __builtin_amdgcn_fence(__ATOMIC_ACQUIRE, "agent");
            xb_add(&bar[XB_XGEN(b.x)], 1u);
            asm volatile("s_waitcnt vmcnt(0)" ::: "memory");
        } else {
            XB_SPIN(xb_ld(&bar[XB_XGEN(b.x)]) == gen, bar);
            __builtin_amdgcn_fence(__ATOMIC_ACQUIRE, "agent");
            asm volatile("s_waitcnt vmcnt(0)" ::: "memory");
        }
    }
    __syncthreads();
}

struct Args { const float* in[22]; float* out; unsigned char* ws; int ph_lo, ph_hi, na, pad; };
struct Frame {
  LAS unsigned char* lds; unsigned char* ws; int tid, lane, wave; const float* const* in;
};
#define IN_X 0
#define IN_META 1
#define IN_G1 2
#define IN_WIN 3
#define IN_CW 4
#define IN_CB 5
#define IN_IGB 6
#define IN_FGB 7
#define IN_LQ1 8
#define IN_LK1 9
#define IN_LQ2 10
#define IN_LK2 11
#define IN_QNG 12
#define IN_KNG 13
#define IN_SUBG 14
#define IN_OUTG 15
#define IN_WOUT 16
#define IN_G2 17
#define IN_WQ 18
#define IN_SUBK 19
#define IN_U 20
#define IN_V 21

__device__ __forceinline__ void p0_rows(const Frame& F, const Args& a) {
  const float* x = a.in[IN_X]; const float* meta = a.in[IN_META]; const float* g1 = a.in[IN_G1]; const float* w_in = a.in[IN_WIN];
  const float* igb = a.in[IN_IGB]; const float* fgb = a.in[IN_FGB];
  bf16* Xn = (bf16*)(F.ws + WS_XN); bf16* Xm = (bf16*)(F.ws + WS_XM); float* LI = (float*)(F.ws + WS_LI); float* LF = (float*)(F.ws + WS_LF);
  LAS f32x4* wgl = (LAS f32x4*)(F.lds);
  for (int e = F.tid; e < 4096; e += NTHR) {
    const int ln = e & 63, q = e >> 6, half = q & 1, j = (q >> 1) & 3, i = q >> 3;
    const int k = 4 * (i * 64 + ln) + j;
    wgl[e] = *(const f32x4*)(w_in + (size_t)k * DPROJ + NPROJ + 4 * half);
  }
  __syncthreads();
  const int gw = blockIdx.x * NWAVES + F.wave, NGW = gridDim.x * NWAVES, lane = F.lane;
  constexpr int NTASK = MROWS / 2 + NMETA / 2;
  f32x4 xnx[2][8];
  if (gw < NTASK) { const float* sn = (gw >= MROWS / 2 ? meta + (size_t)(gw - MROWS / 2) * 2 * DM : x + (size_t)gw * 2 * DM);
#pragma unroll
    for (int i = 0; i < 8; ++i) { xnx[0][i] = ((const f32x4*)sn)[i * 64 + lane]; xnx[1][i] = ((const f32x4*)(sn + DM))[i * 64 + lane]; } }
  for (int task = gw; task < NTASK; task += NGW) {
    const bool ismeta = task >= MROWS / 2;
    const int r0 = ismeta ? (task - MROWS / 2) * 2 : task * 2;
    f32x4 xv[2][8]; float rs[2];
    { float s0 = 0.f, s1 = 0.f;
#pragma unroll
      for (int i = 0; i < 8; ++i) { xv[0][i] = xnx[0][i]; xv[1][i] = xnx[1][i]; }
      { const int tn = task + NGW; if (tn < NTASK) { const float* sn = (tn >= MROWS / 2 ? meta + (size_t)(tn - MROWS / 2) * 2 * DM : x + (size_t)tn * 2 * DM);
#pragma unroll
          for (int i = 0; i < 8; ++i) { xnx[0][i] = ((const f32x4*)sn)[i * 64 + lane]; xnx[1][i] = ((const f32x4*)(sn + DM))[i * 64 + lane]; } } }
#pragma unroll
      for (int i = 0; i < 8; ++i) { const f32x4 a0 = xv[0][i], a1 = xv[1][i];
        s0 += (a0.x * a0.x + a0.y * a0.y) + (a0.z * a0.z + a0.w * a0.w); s1 += (a1.x * a1.x + a1.y * a1.y) + (a1.z * a1.z + a1.w * a1.w); }
      rs[0] = rsqrtf(wave_sum_dpp(s0) * (1.0f / DM) + EPS); rs[1] = rsqrtf(wave_sum_dpp(s1) * (1.0f / DM) + EPS); }
    float ga[2][8];
#pragma unroll
    for (int rr = 0; rr < 2; ++rr)
#pragma unroll
      for (int g = 0; g < 8; ++g) ga[rr][g] = 0.f;
    bf16* dst0 = (ismeta ? Xm : Xn) + (size_t)r0 * DM;
#pragma unroll
    for (int i = 0; i < 8; ++i) {
      const f32x4 g = ((const f32x4*)g1)[i * 64 + lane];
      f32x4 xn[2];
#pragma unroll
      for (int rr = 0; rr < 2; ++rr) { xn[rr] = xv[rr][i] * g * rs[rr];
        v2u o; o.x = pk2(xn[rr].x, xn[rr].y); o.y = pk2(xn[rr].z, xn[rr].w); ((v2u*)(dst0 + (size_t)rr * DM))[i * 64 + lane] = o; }
#pragma unroll
      for (int j = 0; j < 4; ++j) {
        const f32x4 w0 = wgl[((i * 4 + j) * 2 + 0) * 64 + lane], w1 = wgl[((i * 4 + j) * 2 + 1) * 64 + lane];
#pragma unroll
        for (int rr = 0; rr < 2; ++rr) { const float xs_ = xn[rr][j];
          ga[rr][0] += xs_ * w0.x; ga[rr][1] += xs_ * w0.y; ga[rr][2] += xs_ * w0.z; ga[rr][3] += xs_ * w0.w;
          ga[rr][4] += xs_ * w1.x; ga[rr][5] += xs_ * w1.y; ga[rr][6] += xs_ * w1.z; ga[rr][7] += xs_ * w1.w; }
      }
      __builtin_amdgcn_sched_barrier(0);
    }
#pragma unroll
    for (int rr = 0; rr < 2; ++rr)
#pragma unroll
      for (int g = 0; g < 8; ++g) ga[rr][g] = wave_sum_dpp(ga[rr][g]);
    if (lane < 8) {
      const int rr = lane >> 2, h = lane & 3;
      float gi = 0.f, gf = 0.f;
#pragma unroll
      for (int q = 0; q < 2; ++q)
#pragma unroll
        for (int hh = 0; hh < 4; ++hh) if (q == rr && hh == h) { gi = ga[q][hh]; gf = ga[q][4 + hh]; }
      const float li = gi + igb[h]; const float fx = gf + fgb[h];
      const float lf = fminf(fx, 0.f) - log1pf(__expf(-fabsf(fx)));
      const int R = r0 + rr;
      if (!ismeta) { const int b = R >> 11, t = R & 2047; LI[(b * 4 + h) * PADT + POS0 + t] = li; LF[(b * 4 + h) * PADT + POS0 + t] = lf; }
      else { for (int b = 0; b < NB; ++b) { LI[(b * 4 + h) * PADT + MPOS0 + R] = li; LF[(b * 4 + h) * PADT + MPOS0 + R] = lf; } }
    }
  }
  __syncthreads();
}
template <bool META>
__device__ __forceinline__ void p0_transpose(const Frame& F, const Args& a, const float* W, int ldw, int N, bf16* Wt) {
  LAS float* tl = (LAS float*)(F.lds);
  LAS float* red = (LAS float*)(F.lds + 33792);
  float* PM = (float*)(F.ws + WS_PM);
  const float* meta = a.in[IN_META]; const float* g1 = a.in[IN_G1];
  const int ntn = N / 64, ntask = ntn * 16, fr = F.lane & 15, fq = F.lane >> 4, w = F.wave;
  f32x4 wn[4];
  float am[4], ag[4];
  if ((int)blockIdx.x < ntask) { const int nb = blockIdx.x % ntn, kb = blockIdx.x / ntn;
#pragma unroll
    for (int i = 0; i < 4; ++i) { const int idx = F.tid + NTHR * i, kk = idx >> 4, c4 = idx & 15; wn[i] = *(const f32x4*)(W + (size_t)(kb * 128 + kk) * ldw + nb * 64 + 4 * c4); }
    if (META) {
#pragma unroll
      for (int s_ = 0; s_ < 4; ++s_) { const int k = kb * 128 + 16 * w + 4 * s_ + fq; am[s_] = meta[(size_t)fr * DM + k]; ag[s_] = g1[k]; } } }
  for (int task = blockIdx.x; task < ntask; task += gridDim.x) {
    const int nb = task % ntn, kb = task / ntn, n0 = nb * 64, k0 = kb * 128;
    __syncthreads();
#pragma unroll
    for (int i = 0; i < 4; ++i) { const int idx = F.tid + NTHR * i, kk = idx >> 4, c4 = idx & 15; const f32x4 wv = wn[i];
      LAS float* d = tl + kk * 65 + 4 * c4; d[0] = wv.x; d[1] = wv.y; d[2] = wv.z; d[3] = wv.w; }
    float ac[4];
    if (META) {
#pragma unroll
      for (int s_ = 0; s_ < 4; ++s_) ac[s_] = am[s_] * ag[s_]; }
    { const int tn = task + gridDim.x; if (tn < ntask) { const int nb2 = tn % ntn, kb2 = tn / ntn;
#pragma unroll
        for (int i = 0; i < 4; ++i) { const int idx = F.tid + NTHR * i, kk = idx >> 4, c4 = idx & 15; wn[i] = *(const f32x4*)(W + (size_t)(kb2 * 128 + kk) * ldw + nb2 * 64 + 4 * c4); }
        if (META) {
#pragma unroll
          for (int s_ = 0; s_ < 4; ++s_) { const int k = kb2 * 128 + 16 * w + 4 * s_ + fq; am[s_] = meta[(size_t)fr * DM + k]; ag[s_] = g1[k]; } } } }
    __syncthreads();
    const int n = F.tid >> 3, kc = F.tid & 7;
    const LAS float* s = tl + (kc * 16) * 65 + n;
    v4u o0, o1;
    o0.x = pk2(s[0 * 65], s[1 * 65]); o0.y = pk2(s[2 * 65], s[3 * 65]); o0.z = pk2(s[4 * 65], s[5 * 65]); o0.w = pk2(s[6 * 65], s[7 * 65]);
    o1.x = pk2(s[8 * 65], s[9 * 65]); o1.y = pk2(s[10 * 65], s[11 * 65]); o1.z = pk2(s[12 * 65], s[13 * 65]); o1.w = pk2(s[14 * 65], s[15 * 65]);
    v4u* dp = (v4u*)(Wt + (size_t)(n0 + n) * DM + k0 + kc * 16);
    dp[0] = o0; dp[1] = o1;
    if (META && n0 >= 1024) {
      f32x4 acc[4];
#pragma unroll
      for (int nt = 0; nt < 4; ++nt) acc[nt] = (f32x4){0.f, 0.f, 0.f, 0.f};
#pragma unroll
      for (int s_ = 0; s_ < 4; ++s_)
#pragma unroll
        for (int nt = 0; nt < 4; ++nt) acc[nt] = __builtin_amdgcn_mfma_f32_16x16x4f32(ac[s_], tl[(16 * w + 4 * s_ + fq) * 65 + nt * 16 + fr], acc[nt], 0, 0, 0);
#pragma unroll
      for (int nt = 0; nt < 4; ++nt)
#pragma unroll
        for (int i = 0; i < 4; ++i) red[(w * 16 + 4 * fq + i) * 64 + nt * 16 + fr] = acc[nt][i];
      __syncthreads();
#pragma unroll
      for (int j = 0; j < 2; ++j) { const int idx = F.tid + NTHR * j, m = idx >> 6, nn = idx & 63; const LAS float* r = red + m * 64 + nn;
        PM[((size_t)kb * 16 + m) * NPROJ + n0 + nn] = ((r[0] + r[1024]) + (r[2048] + r[3072])) + ((r[4096] + r[5120]) + (r[6144] + r[7168])); }
    }
  }
  __syncthreads();
}
__device__ __forceinline__ void p0_zero_vpad(const Frame& F) {
  bf16* Vp = (bf16*)(F.ws + WS_VP);
  const int per = MPOS0 * 256 / 8;
  for (int i = blockIdx.x * NTHR + F.tid; i < 16 * per; i += gridDim.x * NTHR) { const int bh = i / per, e = i % per;
    *(v4u*)(Vp + (size_t)bh * PADT * 256 + (size_t)e * 8) = (v4u){0u, 0u, 0u, 0u}; }
}
__device__ __forceinline__ void p0_lam(const Frame& F, const Args& a) {
  if (blockIdx.x == 0 && F.wave == 0) {
    const int l = F.lane;
    float s1 = a.in[IN_LQ1][l] * a.in[IN_LK1][l] + a.in[IN_LQ1][l + 64] * a.in[IN_LK1][l + 64];
    float s2 = a.in[IN_LQ2][l] * a.in[IN_LK2][l] + a.in[IN_LQ2][l + 64] * a.in[IN_LK2][l + 64];
    s1 = wave_sum(s1); s2 = wave_sum(s2);
    if (l == 0) *(float*)(F.ws + WS_LAM) = __expf(s1) - __expf(s2) + 0.2f;
  }
}

struct EpiProj {
  static constexpr bool PERM = true, AFTER_DRAIN = false;
  bf16 *Qb, *Kp, *Vp, *MQ, *MK, *MV, *MO; const float *qg, *kg; LAS float* xch;
  __device__ __forceinline__ void operator()(const pg8::f32x4 (&acc)[2][2][4][2], const pg8::Unit& u, int wr, int wc, int fr, int fq) const {
    const int pn = u.pn, b = u.pm >> 3, tb = (u.pm & 7) * 256 + wr * 64 + fr, d0 = wc * 32 + fq * 8;
    if (pn < 8) {
      const bool isk = pn >= 4; const int h = pn & 3;
      float ssq[2][4][2];
#pragma unroll
      for (int ai = 0; ai < 2; ++ai)
#pragma unroll
        for (int m = 0; m < 4; ++m)
#pragma unroll
          for (int bj = 0; bj < 2; ++bj) { float s = 0.f;
#pragma unroll
            for (int n = 0; n < 2; ++n) { const pg8::f32x4 x = acc[ai][bj][m][n]; s += (x[0] * x[0] + x[1] * x[1]) + (x[2] * x[2] + x[3] * x[3]); }
            s += __shfl_xor(s, 16); s += __shfl_xor(s, 32); ssq[ai][m][bj] = s;
            if (fq == 0) xch[((ai * 128 + wr * 64 + m * 16 + fr) * 2 + bj) * 4 + wc] = s; }
      asm volatile("s_waitcnt lgkmcnt(0)" ::: "memory"); __builtin_amdgcn_s_barrier(); asm volatile("" ::: "memory");
      const float* gp = (isk ? kg : qg) + d0; const f32x4 g0 = *(const f32x4*)gp, g1v = *(const f32x4*)(gp + 4);
      const float sc = isk ? 1.0f : QSCALE;
#pragma unroll
      for (int ai = 0; ai < 2; ++ai)
#pragma unroll
        for (int m = 0; m < 4; ++m)
#pragma unroll
          for (int bj = 0; bj < 2; ++bj) {
            const f32x4 p = *(const LAS f32x4*)(xch + ((ai * 128 + wr * 64 + m * 16 + fr) * 2 + bj) * 4);
            const float rs = rsqrtf(((p.x + p.y) + (p.z + p.w)) * (1.0f / 128.f) + EPS) * sc;
            const pg8::f32x4 v0 = acc[ai][bj][m][0], v1 = acc[ai][bj][m][1];
            v4u w; w.x = pk2(v0[0] * rs * g0.x, v0[1] * rs * g0.y); w.y = pk2(v0[2] * rs * g0.z, v0[3] * rs * g0.w);
            w.z = pk2(v1[0] * rs * g1v.x, v1[1] * rs * g1v.y); w.w = pk2(v1[2] * rs * g1v.z, v1[3] * rs * g1v.w);
            const int t = tb + ai * 128 + m * 16;
            bf16* dst = isk ? Kp + kp_off((b * 4 + h) * 2 + bj, POS0 + t, d0)
                            : Qb + ((size_t)((b * 4 + h) * 2 + bj) * SEQ + t) * 128 + d0;
            *(v4u*)dst = w; }
      return;
    }
#pragma unroll
    for (int ai = 0; ai < 2; ++ai)
#pragma unroll
      for (int m = 0; m < 4; ++m)
#pragma unroll
        for (int bj = 0; bj < 2; ++bj) {
          pg8::f32x4 v0 = acc[ai][bj][m][0], v1 = acc[ai][bj][m][1];
          const int t = tb + ai * 128 + m * 16;
          bf16* dst;
          if (pn < 12) { const int h = pn - 8; dst = Vp + ((size_t)(b * 4 + h) * PADT + POS0 + t) * 256 + bj * 128 + d0; }
          else if (pn < 16) { const int h = 2 * (pn & 1) + bj; dst = (pn >= 14 ? MK : MQ) + ((size_t)(b * 4 + h) * PADT + POS0 + t) * 128 + d0; }
          else if (pn < 20) { const int h = pn - 16; dst = MV + ((size_t)(b * 4 + h) * PADT + POS0 + t) * 256 + bj * 128 + d0; }
          else { dst = MO + (size_t)(b * SEQ + t) * 1024 + (pn - 20) * 256 + bj * 128 + d0;
#pragma unroll
            for (int j = 0; j < 4; ++j) { v0[j] = sigmoidf_(v0[j]); v1[j] = sigmoidf_(v1[j]); } }
          v4u w; w.x = pk2(v0[0], v0[1]); w.y = pk2(v0[2], v0[3]); w.z = pk2(v1[0], v1[1]); w.w = pk2(v1[2], v1[3]);
          *(v4u*)dst = w; }
  }
};
__device__ __forceinline__ void p1_meta_finalize(const Frame& F, const Args& a) {
  if (blockIdx.x >= NMETA) return;
  const int mrow = blockIdx.x, tid = F.tid, lane = F.lane, w = F.wave;
  const float* meta = a.in[IN_META] + (size_t)mrow * DM; const float* PM0 = (const float*)(F.ws + WS_PM) + (size_t)mrow * NPROJ;
#define PM_P4(i, p) ((PM0[(size_t)(16 * (p)) * NPROJ + (i)] + PM0[(size_t)(16 * ((p) + 1)) * NPROJ + (i)]) + (PM0[(size_t)(16 * ((p) + 2)) * NPROJ + (i)] + PM0[(size_t)(16 * ((p) + 3)) * NPROJ + (i)]))
#define PM_AT(i) ((PM_P4(i, 0) + PM_P4(i, 4)) + (PM_P4(i, 8) + PM_P4(i, 12)))
  LAS float* red = (LAS float*)(F.lds + XCH_OFF);
  const f32x4 mv = ((const f32x4*)meta)[tid];
  float s = wave_sum((mv.x * mv.x + mv.y * mv.y) + (mv.z * mv.z + mv.w * mv.w));
  if (lane == 0) red[w] = s;
  __syncthreads();
  float tot = 0.f;
#pragma unroll
  for (int i = 0; i < 8; ++i) tot += red[i];
  const float rs = rsqrtf(tot * (1.0f / DM) + EPS);
  bf16* Kp = (bf16*)(F.ws + WS_KP); bf16* Vp = (bf16*)(F.ws + WS_VP); bf16* MQ = (bf16*)(F.ws + WS_MQ); bf16* MK = (bf16*)(F.ws + WS_MK); bf16* MV = (bf16*)(F.ws + WS_MV);
  const int pos = MPOS0 + mrow;
  {
    const float v0 = PM_AT(1024 + w * 128 + lane) * rs, v1 = PM_AT(1024 + w * 128 + lane + 64) * rs;
    const float rk = rsqrtf(wave_sum(v0 * v0 + v1 * v1) * (1.0f / 128.f) + EPS);
    const float* kg = a.in[IN_KNG];
    const unsigned short o0 = (unsigned short)f2bf(v0 * rk * kg[lane]), o1 = (unsigned short)f2bf(v1 * rk * kg[lane + 64]);
    for (int b = 0; b < NB; ++b) { const int bhm = (b * 4 + (w >> 1)) * 2 + (w & 1); Kp[kp_off(bhm, pos, lane)] = o0; Kp[kp_off(bhm, pos, lane + 64)] = o1; }
  }
  { const int c = tid * 2;
    const unsigned o = pk2(PM_AT(2048 + c) * rs, PM_AT(2048 + c + 1) * rs); const int h = c >> 8, e = c & 255;
    for (int b = 0; b < NB; ++b) *(unsigned*)(Vp + ((size_t)(b * 4 + h) * PADT + pos) * 256 + e) = o;
    const unsigned o2 = pk2(PM_AT(3072 + c) * rs, PM_AT(3072 + c + 1) * rs); const bool isk = c >= 512; const int cc = c & 511, hq = cc >> 7, d = cc & 127;
    for (int b = 0; b < NB; ++b) *(unsigned*)((isk ? MK : MQ) + ((size_t)(b * 4 + hq) * PADT + pos) * 128 + d) = o2;
    const unsigned o3 = pk2(PM_AT(4096 + c) * rs, PM_AT(4096 + c + 1) * rs);
    for (int b = 0; b < NB; ++b) *(unsigned*)(MV + ((size_t)(b * 4 + h) * PADT + pos) * 256 + e) = o3;
  }
  __syncthreads();
}
#undef PM_AT
#undef PM_P4

namespace att {
using f32x16 = __attribute__((ext_vector_type(16))) float;
using s16x4 = __attribute__((ext_vector_type(4))) short;
constexpr int STEPS_BHM = 152, NSTEPS = 32 * STEPS_BHM;
constexpr int SHM_V = 64 * 256 * 2, SHM_K = 64 * 128 * 2;
constexpr int LDS_V = 0, LDS_K = 2 * SHM_V, LDS_Q = LDS_K + SHM_K, LDS_WS = LDS_Q + 8 * 8192;
constexpr float THR2 = 8.0f;
#define KSWZ(row, colB) ((row) * 256 + ((colB) ^ (((row) & 7) << 4)))
#define SBAR() __builtin_amdgcn_sched_barrier(0)
__device__ __forceinline__ int crow(int r, int hi) { return (r & 3) + 8 * (r >> 2) + 4 * hi; }
__device__ __forceinline__ unsigned cvtpk(float lo, float hi) { unsigned r; asm volatile("v_cvt_pk_bf16_f32 %0, %1, %2" : "=v"(r) : "v"(lo), "v"(hi)); return r; }
__device__ __forceinline__ int qb_start(int qb) { return 2 * qb * qb + 3 * qb; }
__device__ __forceinline__ int chunk_of(int s, int NA) { return ((s + 1) * NA - 1) / NSTEPS; }

template <int OFF> __device__ __forceinline__ s16x4 tr_read(int vb) {
  s16x4 r; asm volatile("ds_read_b64_tr_b16 %0, %1 offset:%2" : "=&v"(r) : "v"(vb), "i"(OFF) : "memory"); return r;
}
constexpr int v_rd_off(int d0, int ks, int half) { return d0 * 512 + ks * 8192 + half * 4096; }
template <int D0> __device__ __forceinline__ void pv_one(f32x16& od, int vb, bf16x8 pa0, bf16x8 pa1, bf16x8 pa2, bf16x8 pa3) {
#define PK(L, H) (bf16x8){L[0], L[1], L[2], L[3], H[0], H[1], H[2], H[3]}
  { const s16x4 l0 = tr_read<v_rd_off(D0, 0, 0)>(vb), h0 = tr_read<v_rd_off(D0, 0, 1)>(vb), l1 = tr_read<v_rd_off(D0, 1, 0)>(vb), h1 = tr_read<v_rd_off(D0, 1, 1)>(vb);
    asm volatile("s_waitcnt lgkmcnt(0)" ::: "memory"); SBAR();
    od = __builtin_amdgcn_mfma_f32_32x32x16_bf16(pa0, PK(l0, h0), od, 0, 0, 0);
    od = __builtin_amdgcn_mfma_f32_32x32x16_bf16(pa1, PK(l1, h1), od, 0, 0, 0); }
  SBAR();
  { const s16x4 l2 = tr_read<v_rd_off(D0, 2, 0)>(vb), h2 = tr_read<v_rd_off(D0, 2, 1)>(vb), l3 = tr_read<v_rd_off(D0, 3, 0)>(vb), h3 = tr_read<v_rd_off(D0, 3, 1)>(vb);
    asm volatile("s_waitcnt lgkmcnt(0)" ::: "memory"); SBAR();
    od = __builtin_amdgcn_mfma_f32_32x32x16_bf16(pa2, PK(l2, h2), od, 0, 0, 0);
    od = __builtin_amdgcn_mfma_f32_32x32x16_bf16(pa3, PK(l3, h3), od, 0, 0, 0); }
#undef PK
}

__device__ __forceinline__ void segment(const Frame& F, int bhm, int qb, int j0, int j1, int slot) {
  const int tid = F.tid, wid = F.wave, lane = F.lane, r32 = lane & 31, hi = lane >> 5;
  const bf16* Qg = (const bf16*)(F.ws + WS_Q) + ((size_t)bhm * SEQ + qb * 256 + wid * 32 + r32) * 128 + hi * 8;
  const bf16* Kg = (const bf16*)(F.ws + WS_KP) + (size_t)bhm * 33 * 8192;
  const bf16* Vg = (const bf16*)(F.ws + WS_VP) + (size_t)(bhm >> 1) * PADT * 256;
  LAS unsigned char* lds = F.lds;
  LAS float* wsl = (LAS float*)(lds + LDS_WS) + wid * 64;
  const float slope2 = exp2f(-2.0f * (float)(((bhm >> 1) & 3) + 1)) * LOG2E;
  unsigned ksrc0, vsrc0;
  ksrc0 = (unsigned)tid * 16u;
  { const int a8 = tid >> 8, b = (tid >> 2) & 7, k = 8 * (b >> 2) + 4 * a8 + (b & 3), c = ((tid >> 5) & 7) * 32 + (tid & 3) * 8; vsrc0 = (unsigned)(k * 256 + c) * 2u; }
#define STAGE_K(j) do { const char* kt = (const char*)(Kg + (size_t)(j) * 8192); \
    _Pragma("unroll") for (int _i = 0; _i < 2; ++_i) __builtin_amdgcn_global_load_lds((const unsigned*)(kt + (ksrc0 + _i * 8192u)), (LAS unsigned*)(lds + LDS_K + _i * 8192 + wid * 1024), 16, 0, 0); } while (0)
#define STAGE_V(buf, j) do { const char* vt = (const char*)(Vg + (size_t)(j) * 64 * 256); \
    _Pragma("unroll") for (int _i = 0; _i < 4; ++_i) __builtin_amdgcn_global_load_lds((const unsigned*)(vt + (vsrc0 + _i * 8192u)), (LAS unsigned*)(lds + LDS_V + (buf) * SHM_V + _i * 8192 + wid * 1024), 16, 0, 0); } while (0)
  const int lt = (((r32 << 1) | hi) ^ ((r32 >> 3) & 1)) << 4;
  LAS unsigned char* Qs = lds + LDS_Q + wid * 8192;
#pragma unroll
  for (int d0 = 0; d0 < 8; ++d0) { const bf16x8 qv = *(const bf16x8*)(Qg + d0 * 16); *(LAS bf16x8*)(Qs + d0 * 1024 + lt) = qv; }
  f32x16 o[8];
#pragma unroll
  for (int d = 0; d < 8; ++d)
#pragma unroll
    for (int r = 0; r < 16; ++r) o[d][r] = 0.f;
  float m_reg = -1e30f, l_reg = 0.f;
  const int vb0 = (int)(uintptr_t)(lds + LDS_V) + (((lane & 3) << 3) | (((lane >> 2) & 3) << 6) | (((lane >> 4) & 1) << 5) | (((lane >> 5) & 1) << 8));
  STAGE_K(j0); STAGE_V(0, j0);
  VM_WAIT(); __syncthreads();
  for (int j = j0; j < j1; ++j) {
    const int cur = (j - j0) & 1;
    if (j + 1 < j1) STAGE_V(cur ^ 1, j + 1);
    SBAR();
    f32x16 p0 = {}, p1 = {};
    { const LAS unsigned char* Ks = lds + LDS_K;
#pragma unroll
      for (int d0 = 0; d0 < 8; ++d0) {
        const bf16x8 b0 = *(const LAS bf16x8*)(Ks + d0 * 2048 + lt);
        const bf16x8 b1 = *(const LAS bf16x8*)(Ks + d0 * 2048 + 1024 + lt);
        const bf16x8 qf = *(const LAS bf16x8*)(Qs + d0 * 1024 + lt);
        p0 = __builtin_amdgcn_mfma_f32_32x32x16_bf16(b0, qf, p0, 0, 0, 0);
        p1 = __builtin_amdgcn_mfma_f32_32x32x16_bf16(b1, qf, p1, 0, 0, 0); } }
    asm volatile("s_waitcnt lgkmcnt(0)" ::: "memory"); __builtin_amdgcn_s_barrier(); asm volatile("" ::: "memory");
    if (j + 1 < j1) STAGE_K(j + 1);
    SBAR();
    if (j == 0) {
#pragma unroll
      for (int r = 0; r < 16; ++r) p0[r] = -INFINITY;
#pragma unroll
      for (int r = 0; r < 8; ++r) p1[r] = -INFINITY;
    }
    int ln2 = threadIdx.x & 63; asm volatile("" : "+v"(ln2));
    const int hi2 = ln2 >> 5;
    const int jb = j - (4 * qb + 1);
    if (jb >= 0) {
      const int kb = 64 * jb + 4 * hi2, qrel = wid * 32 + (ln2 & 31);
#pragma unroll
      for (int r = 0; r < 16; ++r) { const int kv = kb + (r & 3) + 8 * (r >> 2); if (kv > qrel) p0[r] = -INFINITY; if (kv + 32 > qrel) p1[r] = -INFINITY; }
    }
    const float off0 = slope2 * (float)(64 * j + 4 * hi2), off1 = off0 + 32.0f * slope2;
#pragma unroll
    for (int r = 0; r < 16; ++r) { const float sb = slope2 * (float)((r & 3) + 8 * (r >> 2)); p0[r] += sb; p1[r] += sb; }
    float pm0 = p0[0], pm1 = p1[0];
#pragma unroll
    for (int r = 1; r < 16; ++r) { pm0 = fmaxf(pm0, p0[r]); pm1 = fmaxf(pm1, p1[r]); }
    float pmax = fmaxf(pm0 + off0, pm1 + off1);
    { auto rr = __builtin_amdgcn_permlane32_swap(__float_as_uint(pmax), __float_as_uint(pmax), false, false);
      pmax = fmaxf(__uint_as_float(rr[0]), __uint_as_float(rr[1])); }
    float mn, alpha;
    if (__builtin_expect(__all(pmax - m_reg <= THR2), 1)) { mn = m_reg; alpha = 1.f; }
    else { mn = fmaxf(m_reg, pmax); alpha = __builtin_amdgcn_exp2f(m_reg - mn); m_reg = mn; }
    const float c0 = off0 - mn, c1 = off1 - mn;
    float ps = 0.f;
#pragma unroll
    for (int r = 0; r < 16; ++r) { p0[r] = __builtin_amdgcn_exp2f(p0[r] + c0); p1[r] = __builtin_amdgcn_exp2f(p1[r] + c1); ps += p0[r] + p1[r]; }
    { auto rr = __builtin_amdgcn_permlane32_swap(__float_as_uint(ps), __float_as_uint(ps), false, false);
      ps = __uint_as_float(rr[0]) + __uint_as_float(rr[1]); }
    l_reg = l_reg * alpha + ps;
    if (__any(alpha < 1.f)) { if (hi == 0) wsl[r32] = alpha; asm volatile("s_waitcnt lgkmcnt(0)" ::: "memory");
#pragma unroll
      for (int rg = 0; rg < 4; ++rg) { const f32x4 al = *(const LAS f32x4*)(wsl + 8 * rg + 4 * hi);
#pragma unroll
        for (int d = 0; d < 8; ++d) { o[d][4 * rg + 0] *= al.x; o[d][4 * rg + 1] *= al.y; o[d][4 * rg + 2] *= al.z; o[d][4 * rg + 3] *= al.w; }
        SBAR(); } }
    bf16x8 pa0, pa1, pa2, pa3;
#define PK4(P, BASE, OUT) do { unsigned a0 = cvtpk(P[BASE + 0], P[BASE + 1]), a1 = cvtpk(P[BASE + 2], P[BASE + 3]);   \
    unsigned b0 = cvtpk(P[BASE + 4], P[BASE + 5]), b1 = cvtpk(P[BASE + 6], P[BASE + 7]);                              \
    auto r0 = __builtin_amdgcn_permlane32_swap(a0, b0, false, false); auto r1 = __builtin_amdgcn_permlane32_swap(a1, b1, false, false); \
    v4u w = {r0[0], r1[0], r0[1], r1[1]}; OUT = *reinterpret_cast<bf16x8*>(&w); } while (0)
    PK4(p0, 0, pa0); PK4(p0, 8, pa1); PK4(p1, 0, pa2); PK4(p1, 8, pa3);
#undef PK4
    SBAR();
    { const int vb = vb0 + cur * SHM_V;
      pv_one<0>(o[0], vb, pa0, pa1, pa2, pa3); pv_one<1>(o[1], vb, pa0, pa1, pa2, pa3); pv_one<2>(o[2], vb, pa0, pa1, pa2, pa3); pv_one<3>(o[3], vb, pa0, pa1, pa2, pa3);
      pv_one<4>(o[4], vb, pa0, pa1, pa2, pa3); pv_one<5>(o[5], vb, pa0, pa1, pa2, pa3); pv_one<6>(o[6], vb, pa0, pa1, pa2, pa3); pv_one<7>(o[7], vb, pa0, pa1, pa2, pa3); }
    VM_WAIT(); __syncthreads();
  }
  { int lane2 = threadIdx.x & 63, slot2 = slot; asm volatile("" : "+v"(lane2), "+s"(slot2));
    const int r32e = lane2 & 31, hie = lane2 >> 5;
    bf16* PO = (bf16*)(F.ws + WS_PO) + (size_t)slot2 * 256 * 256; float* ML = (float*)(F.ws + WS_ML) + (size_t)slot2 * 512;
    LAS float* wse = (LAS float*)(F.lds + LDS_WS) + wid * 64;
    if (hie == 0) { wse[r32e] = l_reg; ML[(wid * 32 + r32e) * 2] = m_reg; ML[(wid * 32 + r32e) * 2 + 1] = l_reg; }
    asm volatile("s_waitcnt lgkmcnt(0)" ::: "memory");
    char* Ob = (char*)(PO + (size_t)(wid * 32) * 256);
    const bool odd = (r32e & 1) != 0;
    const unsigned lo = (unsigned)(4 * hie * 256 + (r32e & ~1) + (odd ? 32 : 0)) * 2u;
#pragma unroll
    for (int r = 0; r < 16; ++r) { const int rowc = (r & 3) + 8 * (r >> 2); const float lv = wse[rowc + 4 * hie]; const float rl = lv > 0.f ? __builtin_amdgcn_rcpf(lv) : 0.f;
#pragma unroll
      for (int dp = 0; dp < 4; ++dp) { const float va = o[2 * dp][r] * rl, vb = o[2 * dp + 1][r] * rl;
        const float send = odd ? va : vb, keep = odd ? vb : va;
        const float recv = __builtin_bit_cast(float, __builtin_amdgcn_update_dpp(0, __builtin_bit_cast(int, send), 0xB1, 0xF, 0xF, true));
        *(unsigned*)(Ob + (lo + (unsigned)(rowc * 256 + dp * 64) * 2u)) = odd ? pk2(recv, keep) : pk2(keep, recv); }
      SBAR(); } }
  __syncthreads();
#undef STAGE_K
#undef STAGE_V
}

__device__ __forceinline__ void phase(const Frame& F, int ca, int NA) {
  int s0 = (int)(((long)ca * NSTEPS) / NA); const int s1 = (int)(((long)(ca + 1) * NSTEPS) / NA);
  while (s0 < s1) {
    const int bhm = s0 / STEPS_BHM, rem = s0 - bhm * STEPS_BHM;
    int qb = 0;
#pragma unroll 1
    for (int q = 1; q < 8; ++q) if (rem >= qb_start(q)) qb = q;
    const int j0 = rem - qb_start(qb), nst = 4 * qb + 5;
    const int j1 = (j0 + (s1 - s0) < nst) ? j0 + (s1 - s0) : nst;
    const int slot = bhm * 16 + qb + chunk_of(s0, NA) - chunk_of(bhm * STEPS_BHM, NA);
    segment(F, bhm, qb, j0, j1, slot);
    s0 += j1 - j0;
  }
}
#undef KSWZ
#undef SBAR
}
namespace ml {
constexpr int QST = 136, TST = 72;
constexpr int L_RQ = 0, L_RK = 17152, L_QS = 34304, L_QW = 51712, L_KS = 69120, L_KWT = 86528, L_VT = 104960  , L_SP = 0  , L_G = 141824, L_CW = 143872;
constexpr int L_HT = 0;
constexpr int G_A = 0, G_M = 64, G_WI = 128, G_EM = 192, G_DEN = 256, G_WG = 320, G_SC = 384, G_N = 0;
constexpr int L_NV = L_CW + 5120;
constexpr int L_SSQ = L_KWT;
__device__ __forceinline__ float shfl_up_f(float v, int d) { return __shfl_up(v, d); }

__device__ __forceinline__ void load_cw(const Frame& F, const Args& a, int h) {
  LAS float* CW = (LAS float*)(F.lds + L_CW);
  for (int e = F.tid; e < 2 * 5 * 128; e += NTHR) { const int qk = e / 640, j = (e / 128) % 5, d = e & 127; const int ch = qk * 512 + h * 128 + d;
    CW[e] = j < 4 ? a.in[IN_CW][j * 1024 + ch] : a.in[IN_CB][ch]; }
}
__device__ __forceinline__ void load_raw(const Frame& F, const bf16* g, int pos0, int lds_off) {
  for (int p = F.tid; p < 67 * 16; p += NTHR) { const int row = p >> 4, ch = p & 15, pos = pos0 - 3 + row;
    v4u v = {0u, 0u, 0u, 0u}; if (pos >= MPOS0) v = *(const v4u*)(g + (size_t)pos * 128 + ch * 8);
    *(LAS v4u*)(F.lds + lds_off + row * 256 + ch * 16) = v; }
}
__device__ __forceinline__ void conv16(const Frame& F, int qk, int lds_off, int t, int d0, float (&y)[16]) {
  const LAS float* CW = (const LAS float*)(F.lds + L_CW);
#pragma unroll
  for (int e = 0; e < 16; ++e) y[e] = CW[(qk * 5 + 4) * 128 + d0 + e];
#pragma unroll
  for (int j = 0; j < 4; ++j) { const LAS v4u* rp = (const LAS v4u*)(F.lds + lds_off + (t + j) * 256 + d0 * 2); const v4u r0 = rp[0], r1 = rp[1];
    const LAS float* cw = CW + (qk * 5 + j) * 128 + d0;
    y[0] += cw[0] * bflo(r0.x); y[1] += cw[1] * bfhi(r0.x); y[2] += cw[2] * bflo(r0.y); y[3] += cw[3] * bfhi(r0.y); y[4] += cw[4] * bflo(r0.z); y[5] += cw[5] * bfhi(r0.z); y[6] += cw[6] * bflo(r0.w); y[7] += cw[7] * bfhi(r0.w);
    y[8] += cw[8] * bflo(r1.x); y[9] += cw[9] * bfhi(r1.x); y[10] += cw[10] * bflo(r1.y); y[11] += cw[11] * bfhi(r1.y); y[12] += cw[12] * bflo(r1.z); y[13] += cw[13] * bfhi(r1.z); y[14] += cw[14] * bflo(r1.w); y[15] += cw[15] * bfhi(r1.w); }
#pragma unroll
  for (int e = 0; e < 16; ++e) y[e] = y[e] / (1.0f + __expf(-y[e]));
}
__device__ __forceinline__ void load_vt(const Frame& F, const bf16* MVg, int pos0) {
#pragma unroll
  for (int i = 0; i < 4; ++i) { const int p = F.tid + NTHR * i, row = p >> 5, ch = p & 31; v4u v4 = {0u, 0u, 0u, 0u};
    if (pos0 + row >= MPOS0) v4 = *(const v4u*)(MVg + (size_t)(pos0 + row) * 256 + ch * 8);
    LAS bf16* vt = (LAS bf16*)(F.lds + L_VT) + (ch * 8) * TST + row;
    vt[0 * TST] = (bf16)(v4.x & 0xffff); vt[1 * TST] = (bf16)(v4.x >> 16); vt[2 * TST] = (bf16)(v4.y & 0xffff); vt[3 * TST] = (bf16)(v4.y >> 16);
    vt[4 * TST] = (bf16)(v4.z & 0xffff); vt[5 * TST] = (bf16)(v4.z >> 16); vt[6 * TST] = (bf16)(v4.w & 0xffff); vt[7 * TST] = (bf16)(v4.w >> 16); }
}

__device__ __forceinline__ void taskA(const Frame& F, const Args& a, int task) {
  const int bh = task >> 5, c = task & 31, h = bh & 3, tid = F.tid, w = F.wave, lane = F.lane, fr = lane & 15, kq = lane >> 4, pos0 = 64 * c;
  LAS unsigned char* lds = F.lds; LAS float* G = (LAS float*)(lds + L_G);
  const bf16* MKg = (const bf16*)(F.ws + WS_MK) + (size_t)bh * PADT * 128; const bf16* MVg = (const bf16*)(F.ws + WS_MV) + (size_t)bh * PADT * 256;
  __syncthreads();
  load_cw(F, a, h); load_raw(F, MKg, pos0, L_RK); load_vt(F, MVg, pos0);
  if (w == 0) {
    const bool dead = pos0 + lane < MPOS0;
    const float li = dead ? -1e30f : ((const float*)(F.ws + WS_LI))[bh * PADT + pos0 + lane], lf = dead ? 0.f : ((const float*)(F.ws + WS_LF))[bh * PADT + pos0 + lane];
    float bs = lf;
#pragma unroll
    for (int d = 1; d < 64; d <<= 1) { const float o = shfl_up_f(bs, d); if (lane >= d) bs += o; }
    const float av = li - bs; float mx = av;
#pragma unroll
    for (int o = 1; o < 64; o <<= 1) mx = fmaxf(mx, __shfl_xor(mx, o));
    G[G_WG + lane] = __expf(av - mx);
    if (lane == 63) { float* gs = (float*)(F.ws + WS_GS) + (size_t)(bh * 33 + c) * 2; gs[0] = bs; gs[1] = mx; }
  }
  __syncthreads();
  { const int t = tid >> 3, d0 = (tid & 7) * 16; float y[16]; conv16(F, 1, L_RK, t, d0, y);
    const float sw = 0.08838834764831845f * G[G_WG + t]; LAS bf16* kt = (LAS bf16*)(lds + L_KWT) + d0 * TST + t;
#pragma unroll
    for (int e = 0; e < 16; ++e) kt[e * TST] = (bf16)f2bf(y[e] * sw); }
  __syncthreads();
  f32x4* DCg = (f32x4*)(F.ws + WS_DC) + ((size_t)(bh * 32 + c) * 128) * 64;
#pragma unroll
  for (int jj = 0; jj < 2; ++jj) { const int j = 2 * w + jj;
    const bf16x8 bv0 = *(const LAS bf16x8*)(lds + L_VT + ((16 * j + fr) * TST + 8 * kq) * 2), bv1 = *(const LAS bf16x8*)(lds + L_VT + ((16 * j + fr) * TST + 32 + 8 * kq) * 2);
#pragma unroll
    for (int i = 0; i < 8; ++i) { f32x4 acc = {0.f, 0.f, 0.f, 0.f};
      const bf16x8 k0 = *(const LAS bf16x8*)(lds + L_KWT + ((16 * i + fr) * TST + 8 * kq) * 2), k1 = *(const LAS bf16x8*)(lds + L_KWT + ((16 * i + fr) * TST + 32 + 8 * kq) * 2);
      acc = __builtin_amdgcn_mfma_f32_16x16x32_bf16(k0, bv0, acc, 0, 0, 0); acc = __builtin_amdgcn_mfma_f32_16x16x32_bf16(k1, bv1, acc, 0, 0, 0);
      DCg[(size_t)(i * 16 + j) * 64 + lane] = acc; } }
  if (tid < 128) { const LAS v4u* kr = (const LAS v4u*)(lds + L_KWT + tid * TST * 2); float s = 0.f;
#pragma unroll
    for (int q = 0; q < 8; ++q) { const v4u x = kr[q]; s += (bflo(x.x) + bfhi(x.x)) + (bflo(x.y) + bfhi(x.y)) + (bflo(x.z) + bfhi(x.z)) + (bflo(x.w) + bfhi(x.w)); }
    ((float*)(F.ws + WS_DN))[(size_t)(bh * 32 + c) * 128 + tid] = s; }
}

__device__ __forceinline__ void scanB(const Frame& F) {
  const float* GS = (const float*)(F.ws + WS_GS);
  LAS float* cf = (LAS float*)F.lds;
  for (int blk = blockIdx.x; blk < 16 * 16; blk += gridDim.x) { const int bh = blk >> 4, r = (blk & 15) * NTHR + F.tid, i = r >> 10, j = (r >> 6) & 15, ln = r & 63;
    __syncthreads();
    if (F.wave == 0) {
      const int c = F.lane & 31; const v2u gs = *(const v2u*)(GS + (size_t)(bh * 33 + c) * 2); const unsigned g0 = gs.x, g1 = gs.y;
      const float bL = __builtin_bit_cast(float, g0), ml = __builtin_bit_cast(float, g1);
      float mm = 0.f, fa = 0.f, fb = 0.f, mout = 0.f;
#pragma unroll
      for (int cc = 0; cc < 32; ++cc) { const float b_ = __builtin_bit_cast(float, __builtin_amdgcn_readlane(__builtin_bit_cast(int, bL), cc)), l_ = __builtin_bit_cast(float, __builtin_amdgcn_readlane(__builtin_bit_cast(int, ml), cc));
        const float me = fmaxf(mm, l_); if (c == cc) { fa = __expf(mm - me); fb = __expf(l_ - me); } mm = b_ + me; if (c == cc) mout = mm; }
      if (F.lane < 32) { cf[2 * c] = fa; cf[2 * c + 1] = fb; if ((blk & 15) == 0) ((float*)(F.ws + WS_MS))[bh * 33 + c + 1] = mout; }
    }
    __syncthreads();
    const f32x4* dc0 = (const f32x4*)(F.ws + WS_DC) + ((size_t)(bh * 32) * 128 + (i * 16 + j)) * 64 + ln;
    v2u* cs = (v2u*)(F.ws + WS_CS) + ((((size_t)bh * 33) * 8 + i) * 16 + j) * 64 + ln;
    f32x4 s0 = {0.f, 0.f, 0.f, 0.f}, dv[32];
#pragma unroll
    for (int c = 0; c < 32; ++c) dv[c] = dc0[(size_t)c * 128 * 64];
#pragma unroll
    for (int c = 0; c < 32; ++c) { const float fa = cf[2 * c], fb = cf[2 * c + 1];
      s0 = s0 * fa + dv[c] * fb;
      v2u o; o.x = pk2(s0.x, s0.y); o.y = pk2(s0.z, s0.w); cs[(size_t)(c + 1) * 8 * 16 * 64] = o; }
    if ((blk & 15) == 0 && F.tid < 128) {
      const float* dn = (const float*)(F.ws + WS_DN) + (size_t)(bh * 32) * 128 + F.tid; float* ns = (float*)(F.ws + WS_NS) + (size_t)(bh * 33) * 128 + F.tid; float n = 0.f;
      float dnv[32];
#pragma unroll
      for (int c = 0; c < 32; ++c) dnv[c] = dn[(size_t)c * 128];
#pragma unroll
      for (int c = 0; c < 32; ++c) { n = n * cf[2 * c] + dnv[c] * cf[2 * c + 1]; ns[(size_t)(c + 1) * 128] = n; }
    }
  }
}

__device__ __forceinline__ void taskC(const Frame& F, const Args& a, int task) {
  const int bh = task >> 5, c = (task & 31) + 1, b = bh >> 2, h = bh & 3, tid = F.tid, w = F.wave, lane = F.lane, fr = lane & 15, kq = lane >> 4, pos0 = 64 * c;
  LAS unsigned char* lds = F.lds; LAS float* G = (LAS float*)(lds + L_G); LAS float* NV = (LAS float*)(lds + L_NV);
  const bf16* MQg = (const bf16*)(F.ws + WS_MQ) + (size_t)bh * PADT * 128; const bf16* MKg = (const bf16*)(F.ws + WS_MK) + (size_t)bh * PADT * 128;
  const bf16* MVg = (const bf16*)(F.ws + WS_MV) + (size_t)bh * PADT * 256;
  const float m = ((const float*)(F.ws + WS_MS))[bh * 33 + c];
  __syncthreads();
  load_cw(F, a, h); load_raw(F, MQg, pos0, L_RQ); load_raw(F, MKg, pos0, L_RK); load_vt(F, MVg, pos0);
  if (tid < 128) NV[tid] = ((const float*)(F.ws + WS_NS))[(size_t)(bh * 33 + c) * 128 + tid];
  if (w == 0) {
    const float li = ((const float*)(F.ws + WS_LI))[bh * PADT + pos0 + lane], lf = ((const float*)(F.ws + WS_LF))[bh * PADT + pos0 + lane];
    float bs = lf;
#pragma unroll
    for (int d = 1; d < 64; d <<= 1) { const float o = shfl_up_f(bs, d); if (lane >= d) bs += o; }
    const float av = li - bs; float cm = av;
#pragma unroll
    for (int d = 1; d < 64; d <<= 1) { const float o = shfl_up_f(cm, d); if (lane >= d) cm = fmaxf(cm, o); }
    const float Mt = fmaxf(m, cm);
    G[G_A + lane] = av; G[G_M + lane] = Mt; G[G_WI + lane] = __expf(m - Mt); G[G_EM + lane] = __expf(-(bs + Mt));
  }
  __syncthreads();
  { const int t = tid >> 3, d0 = (tid & 7) * 16; const float wi = G[G_WI + t]; float y[16];
    conv16(F, 0, L_RQ, t, d0, y);
    { v4u o0, o1, w0, w1;
      o0.x = pk2(y[0], y[1]); o0.y = pk2(y[2], y[3]); o0.z = pk2(y[4], y[5]); o0.w = pk2(y[6], y[7]); o1.x = pk2(y[8], y[9]); o1.y = pk2(y[10], y[11]); o1.z = pk2(y[12], y[13]); o1.w = pk2(y[14], y[15]);
      w0.x = pk2(y[0] * wi, y[1] * wi); w0.y = pk2(y[2] * wi, y[3] * wi); w0.z = pk2(y[4] * wi, y[5] * wi); w0.w = pk2(y[6] * wi, y[7] * wi);
      w1.x = pk2(y[8] * wi, y[9] * wi); w1.y = pk2(y[10] * wi, y[11] * wi); w1.z = pk2(y[12] * wi, y[13] * wi); w1.w = pk2(y[14] * wi, y[15] * wi);
      LAS v4u* qs = (LAS v4u*)(lds + L_QS + (t * QST + d0) * 2); qs[0] = o0; qs[1] = o1;
      LAS v4u* qw = (LAS v4u*)(lds + L_QW + (t * QST + d0) * 2); qw[0] = w0; qw[1] = w1; }
    __builtin_amdgcn_sched_barrier(0);
    conv16(F, 1, L_RK, t, d0, y);
    { const float sc = 0.08838834764831845f; v4u o0, o1;
      o0.x = pk2(y[0] * sc, y[1] * sc); o0.y = pk2(y[2] * sc, y[3] * sc); o0.z = pk2(y[4] * sc, y[5] * sc); o0.w = pk2(y[6] * sc, y[7] * sc);
      o1.x = pk2(y[8] * sc, y[9] * sc); o1.y = pk2(y[10] * sc, y[11] * sc); o1.z = pk2(y[12] * sc, y[13] * sc); o1.w = pk2(y[14] * sc, y[15] * sc);
      LAS v4u* ks = (LAS v4u*)(lds + L_KS + (t * QST + d0) * 2); ks[0] = o0; ks[1] = o1; } }
  __syncthreads();
  v4u cb[4][2];
  { const v2u* cs = (const v2u*)(F.ws + WS_CS) + (((size_t)bh * 33 + c) * 8 * 16) * 64;
#pragma unroll
    for (int I = 0; I < 4; ++I)
#pragma unroll
      for (int jj = 0; jj < 2; ++jj) { const v2u lo_ = cs[(size_t)((2 * I) * 16 + 2 * w + jj) * 64 + lane], hi_ = cs[(size_t)((2 * I + 1) * 16 + 2 * w + jj) * 64 + lane]; cb[I][jj] = (v4u){lo_.x, lo_.y, hi_.x, hi_.y}; } }
  { const int si = w >> 1; const f32x4 as = *(const LAS f32x4*)(G + G_A + 16 * si + 4 * kq);
#pragma unroll
    for (int tt = 0; tt < 2; ++tt) { const int ti = 2 * (w & 1) + tt; f32x4 acc = {0.f, 0.f, 0.f, 0.f};
#pragma unroll
      for (int ks = 0; ks < 4; ++ks) { const bf16x8 af = *(const LAS bf16x8*)(lds + L_KS + ((16 * si + fr) * QST + 32 * ks + 8 * kq) * 2);
        const bf16x8 bfr = *(const LAS bf16x8*)(lds + L_QS + ((16 * ti + fr) * QST + 32 * ks + 8 * kq) * 2);
        acc = __builtin_amdgcn_mfma_f32_16x16x32_bf16(af, bfr, acc, 0, 0, 0); }
      const int t = 16 * ti + fr, s0 = 16 * si + 4 * kq; const float Mt = G[G_M + t];
      const float v0 = (s0 + 0 <= t) ? acc.x * __expf(as.x - Mt) : 0.f, v1 = (s0 + 1 <= t) ? acc.y * __expf(as.y - Mt) : 0.f;
      const float v2 = (s0 + 2 <= t) ? acc.z * __expf(as.z - Mt) : 0.f, v3 = (s0 + 3 <= t) ? acc.w * __expf(as.w - Mt) : 0.f;
      v2u o; o.x = pk2(v0, v1); o.y = pk2(v2, v3);
      *(LAS v2u*)(lds + L_SP + (t * TST + s0) * 2) = o; } }
  __syncthreads();
  if (w == 0) { const int t = lane; float qn = 0.f, rsum = 0.f;
#pragma unroll 4
    for (int q = 0; q < 16; ++q) { const v4u x = *(const LAS v4u*)(lds + L_QS + (t * QST + q * 8) * 2); const f32x4 n0 = *(const LAS f32x4*)(NV + q * 8), n1 = *(const LAS f32x4*)(NV + q * 8 + 4);
      qn += bflo(x.x) * n0.x + bfhi(x.x) * n0.y + bflo(x.y) * n0.z + bfhi(x.y) * n0.w + bflo(x.z) * n1.x + bfhi(x.z) * n1.y + bflo(x.w) * n1.z + bfhi(x.w) * n1.w; }
#pragma unroll
    for (int q = 0; q < 8; ++q) { const v4u x = *(const LAS v4u*)(lds + L_SP + (t * TST + q * 8) * 2); rsum += (bflo(x.x) + bfhi(x.x)) + (bflo(x.y) + bfhi(x.y)) + (bflo(x.z) + bfhi(x.z)) + (bflo(x.w) + bfhi(x.w)); }
    const float den = G[G_WI + t] * qn + rsum; G[G_DEN + t] = fmaxf(fabsf(den), G[G_EM + t]); }
  f32x4 acc[2][4];
#pragma unroll
  for (int jj = 0; jj < 2; ++jj)
#pragma unroll
    for (int ti = 0; ti < 4; ++ti) acc[jj][ti] = (f32x4){0.f, 0.f, 0.f, 0.f};
#pragma unroll
  for (int I = 0; I < 4; ++I) {
#pragma unroll
    for (int ti = 0; ti < 4; ++ti) { const LAS unsigned char* qp = lds + L_QW + ((16 * ti + fr) * QST + 32 * I + 4 * kq) * 2;
      const v2u a0 = *(const LAS v2u*)qp, a1 = *(const LAS v2u*)(qp + 32); const v4u av = {a0.x, a0.y, a1.x, a1.y};
      acc[0][ti] = __builtin_amdgcn_mfma_f32_16x16x32_bf16(__builtin_bit_cast(bf16x8, av), __builtin_bit_cast(bf16x8, cb[I][0]), acc[0][ti], 0, 0, 0);
      acc[1][ti] = __builtin_amdgcn_mfma_f32_16x16x32_bf16(__builtin_bit_cast(bf16x8, av), __builtin_bit_cast(bf16x8, cb[I][1]), acc[1][ti], 0, 0, 0); }
    __builtin_amdgcn_sched_barrier(0); }
#pragma unroll
  for (int ks = 0; ks < 2; ++ks) { const bf16x8 bv0 = *(const LAS bf16x8*)(lds + L_VT + ((32 * w + fr) * TST + 32 * ks + 8 * kq) * 2), bv1 = *(const LAS bf16x8*)(lds + L_VT + ((32 * w + 16 + fr) * TST + 32 * ks + 8 * kq) * 2);
#pragma unroll
    for (int ti = 0; ti < 4; ++ti) { const bf16x8 sf = *(const LAS bf16x8*)(lds + L_SP + ((16 * ti + fr) * TST + 32 * ks + 8 * kq) * 2);
      acc[0][ti] = __builtin_amdgcn_mfma_f32_16x16x32_bf16(sf, bv0, acc[0][ti], 0, 0, 0); acc[1][ti] = __builtin_amdgcn_mfma_f32_16x16x32_bf16(sf, bv1, acc[1][ti], 0, 0, 0); } }
  __syncthreads();
  LAS float* SSQ = (LAS float*)(lds + L_SSQ);
#pragma unroll
  for (int ti = 0; ti < 4; ++ti) { const f32x4 dn = *(const LAS f32x4*)(G + G_DEN + 16 * ti + 4 * kq);
    f32x4 s4;
#pragma unroll
    for (int r = 0; r < 4; ++r) { const float h0 = acc[0][ti][r] / dn[r], h1 = acc[1][ti][r] / dn[r]; acc[0][ti][r] = h0; acc[1][ti][r] = h1; s4[r] = h0 * h0 + h1 * h1; }
#pragma unroll
    for (int o = 1; o < 16; o <<= 1) { s4.x += __shfl_xor(s4.x, o); s4.y += __shfl_xor(s4.y, o); s4.z += __shfl_xor(s4.z, o); s4.w += __shfl_xor(s4.w, o); }
    if (fr == 0) { SSQ[(16 * ti + 4 * kq + 0) * 8 + w] = s4.x; SSQ[(16 * ti + 4 * kq + 1) * 8 + w] = s4.y; SSQ[(16 * ti + 4 * kq + 2) * 8 + w] = s4.z; SSQ[(16 * ti + 4 * kq + 3) * 8 + w] = s4.w; } }
  __syncthreads();
  LAS bf16* HT = (LAS bf16*)(lds + L_HT);
#pragma unroll
  for (int ti = 0; ti < 4; ++ti)
#pragma unroll
    for (int r = 0; r < 4; ++r) { const int t = 16 * ti + 4 * kq + r; const f32x4 p0 = *(const LAS f32x4*)(SSQ + t * 8), p1 = *(const LAS f32x4*)(SSQ + t * 8 + 4);
      const float rh = rsqrtf(((p0.x + p0.y) + (p0.z + p0.w) + (p1.x + p1.y) + (p1.z + p1.w)) * (1.0f / 256.f) + EPS);
      HT[t * 264 + 32 * w + fr] = (bf16)f2bf(acc[0][ti][r] * rh); HT[t * 264 + 32 * w + 16 + fr] = (bf16)f2bf(acc[1][ti][r] * rh); }
  __syncthreads();
  { const int t = tid >> 3, c0 = (tid & 7) * 32; const size_t R = (size_t)b * SEQ + 64 * (c - 1) + t;
    const bf16* mo = (const bf16*)(F.ws + WS_MO) + R * 1024 + h * 256 + c0; const float* og = a.in[IN_OUTG] + h * 256 + c0; bf16* A2 = (bf16*)(F.ws + WS_A2) + R * DM + 1024 + h * 256 + c0;
#pragma unroll
    for (int q = 0; q < 4; ++q) { const v4u hv = *(const LAS v4u*)(HT + t * 264 + c0 + q * 8); const v4u mv = *(const v4u*)(mo + q * 8); const f32x4 g0 = *(const f32x4*)(og + q * 8), g1 = *(const f32x4*)(og + q * 8 + 4);
      v4u o; o.x = pk2(bflo(hv.x) * g0.x * bflo(mv.x), bfhi(hv.x) * g0.y * bfhi(mv.x)); o.y = pk2(bflo(hv.y) * g0.z * bflo(mv.y), bfhi(hv.y) * g0.w * bfhi(mv.y));
      o.z = pk2(bflo(hv.z) * g1.x * bflo(mv.z), bfhi(hv.z) * g1.y * bfhi(mv.z)); o.w = pk2(bflo(hv.w) * g1.z * bflo(mv.w), bfhi(hv.w) * g1.w * bfhi(mv.w));
      *(v4u*)(A2 + q * 8) = o; } }
}
}
struct CombRow { float mp[8][3], lp[8][3]; v4u op[8][3]; };
__device__ __forceinline__ float half_sum_dpp(float v, bool hi) {
  v += __builtin_bit_cast(float, __builtin_amdgcn_update_dpp(0, __builtin_bit_cast(int, v), 0xB1, 0xF, 0xF, true));
  v += __builtin_bit_cast(float, __builtin_amdgcn_update_dpp(0, __builtin_bit_cast(int, v), 0x4E, 0xF, 0xF, true));
  v += __builtin_bit_cast(float, __builtin_amdgcn_update_dpp(0, __builtin_bit_cast(int, v), 0x141, 0xF, 0xF, true));
  v += __builtin_bit_cast(float, __builtin_amdgcn_update_dpp(0, __builtin_bit_cast(int, v), 0x140, 0xF, 0xF, true));
  const float r0 = __builtin_bit_cast(float, __builtin_amdgcn_readlane(__builtin_bit_cast(int, v), 0)), r1 = __builtin_bit_cast(float, __builtin_amdgcn_readlane(__builtin_bit_cast(int, v), 16));
  const float r2 = __builtin_bit_cast(float, __builtin_amdgcn_readlane(__builtin_bit_cast(int, v), 32)), r3 = __builtin_bit_cast(float, __builtin_amdgcn_readlane(__builtin_bit_cast(int, v), 48));
  return hi ? r2 + r3 : r0 + r1;
}
__device__ __forceinline__ void comb_load(const bf16* PO, const float* ML, int R0, int NA, int lane, CombRow& cr) {
  const int b = R0 >> 11, t = R0 & 2047, qb = t >> 8, rq = (t & 255) + (lane >> 5), l32 = lane & 31;
#pragma unroll
  for (int hm = 0; hm < 8; ++hm) {
    const int bhm = b * 8 + hm, first = bhm * att::STEPS_BHM + att::qb_start(qb), last = first + 4 * qb + 4;
    const int cf = att::chunk_of(first, NA), np = att::chunk_of(last, NA) - cf + 1, slot0 = bhm * 16 + qb + cf - att::chunk_of(bhm * att::STEPS_BHM, NA);
#pragma unroll
    for (int p = 0; p < 3; ++p) { if (p < np) { const int slot = slot0 + p; const v2u ml = *(const v2u*)(ML + (size_t)slot * 512 + rq * 2);
        const unsigned mx_ = ml.x, my_ = ml.y; cr.mp[hm][p] = __builtin_bit_cast(float, mx_); cr.lp[hm][p] = __builtin_bit_cast(float, my_);
        cr.op[hm][p] = ((const v4u*)(PO + ((size_t)slot * 256 + rq) * 256))[l32]; } else { cr.mp[hm][p] = -1e30f; cr.lp[hm][p] = 0.f; cr.op[hm][p] = (v4u){0u, 0u, 0u, 0u}; } }
  }
}
__device__ __forceinline__ void comb_finish(bf16* A2, int R0, int lane, float lam, const f32x4 sg0, const f32x4 sg1, const CombRow& cr) {
  const bool hi = lane >= 32; const int l32 = lane & 31;
#pragma unroll
  for (int h = 0; h < 4; ++h) {
    float om[2][8];
#pragma unroll
    for (int m = 0; m < 2; ++m) { const int hm = h * 2 + m;
      const float M = fmaxf(cr.mp[hm][0], fmaxf(cr.mp[hm][1], cr.mp[hm][2]));
      float wsum = 0.f, acc[8];
#pragma unroll
      for (int i = 0; i < 8; ++i) acc[i] = 0.f;
#pragma unroll
      for (int p = 0; p < 3; ++p) { const float w = cr.lp[hm][p] * exp2f(cr.mp[hm][p] - M); wsum += w; const v4u ow = cr.op[hm][p];
#pragma unroll
        for (int i = 0; i < 4; ++i) { const unsigned wd = ow[i]; acc[2 * i] += bflo(wd) * w; acc[2 * i + 1] += bfhi(wd) * w; } }
      const float iw = 1.0f / wsum;
#pragma unroll
      for (int i = 0; i < 8; ++i) om[m][i] = acc[i] * iw;
    }
    float o[8], ss = 0.f;
#pragma unroll
    for (int i = 0; i < 8; ++i) { o[i] = om[0][i] - om[1][i] * lam; ss += o[i] * o[i]; }
    const float rs = rsqrtf(half_sum_dpp(ss, hi) * (1.0f / 256.f) + EPS) * 0.8f;
    v4u w; w.x = pk2(o[0] * rs * sg0.x, o[1] * rs * sg0.y); w.y = pk2(o[2] * rs * sg0.z, o[3] * rs * sg0.w); w.z = pk2(o[4] * rs * sg1.x, o[5] * rs * sg1.y); w.w = pk2(o[6] * rs * sg1.z, o[7] * rs * sg1.w);
    ((v4u*)(A2 + (size_t)(R0 + (hi ? 1 : 0)) * DM + h * 256))[l32] = w;
  }
}
__device__ __forceinline__ void p3_combine(const Frame& F, const Args& a, int NA) {
  const bf16* PO = (const bf16*)(F.ws + WS_PO); const float* ML = (const float*)(F.ws + WS_ML);
  bf16* A2 = (bf16*)(F.ws + WS_A2);
  const float lam = *(const float*)(F.ws + WS_LAM);
  const int gw = blockIdx.x * NWAVES + F.wave, NGW = gridDim.x * NWAVES, lane = F.lane;
  const f32x4 sg0 = ((const f32x4*)a.in[IN_SUBG])[2 * (lane & 31)], sg1 = ((const f32x4*)a.in[IN_SUBG])[2 * (lane & 31) + 1];
  for (int k = gw; k < MROWS / 4; k += NGW) {
#pragma unroll 1
    for (int s = 0; s < 2; ++s) { const int P = s ? MROWS / 2 - 1 - k : k;
      CombRow r0;
      comb_load(PO, ML, 2 * P, NA, lane, r0);
      comb_finish(A2, 2 * P, lane, lam, sg0, sg1, r0); }
  }
}
struct EpiRes {
  static constexpr bool PERM = true, AFTER_DRAIN = false;
  const float* x; float* out; bf16* H1b; float* SSQ;
  __device__ __forceinline__ void operator()(const pg8::f32x4 (&acc)[2][2][4][2], const pg8::Unit& u, int wr, int wc, int fr, int fq) const {
    const int row0 = u.pm * 256 + wr * 64 + fr, col0 = u.pn * 256 + wc * 32 + 8 * fq;
#pragma unroll
    for (int ai = 0; ai < 2; ++ai)
#pragma unroll
      for (int m = 0; m < 4; ++m) { const size_t R = (size_t)(row0 + ai * 128 + m * 16); float s = 0.f;
#pragma unroll
        for (int bj = 0; bj < 2; ++bj) { const size_t off = R * DM + col0 + bj * 128;
          const f32x4 x0 = *(const f32x4*)(x + off), x1 = *(const f32x4*)(x + off + 4);
          const f32x4 v0 = acc[ai][bj][m][0] + x0, v1 = acc[ai][bj][m][1] + x1;
          v4u w; w.x = pk2(v0.x, v0.y); w.y = pk2(v0.z, v0.w); w.z = pk2(v1.x, v1.y); w.w = pk2(v1.z, v1.w);
          *(v4u*)(H1b + off) = w;
          s += (v0.x * v0.x + v0.y * v0.y) + (v0.z * v0.z + v0.w * v0.w) + (v1.x * v1.x + v1.y * v1.y) + (v1.z * v1.z + v1.w * v1.w); }
        s += __shfl_xor(s, 16); s += __shfl_xor(s, 32);
        if (fq == 0) SSQ[R * 32 + u.pn * 4 + wc] = s; }
  }
};
#ifndef PEER_U_FP8
#define PEER_U_FP8 0
#endif
typedef __bf16 bfv2 __attribute__((ext_vector_type(2)));
__device__ __forceinline__ void split_hl(const f32x4 a, const f32x4 b, bf16x8& hi, bf16x8& lo) {
  float v[8] = {a.x, a.y, a.z, a.w, b.x, b.y, b.z, b.w}; unsigned h[8], l[8];
#pragma unroll
  for (int i = 0; i < 8; ++i) { h[i] = f2bf(v[i]); l[i] = f2bf(v[i] - __builtin_bit_cast(float, h[i] << 16)); }
  v4u hv = {h[0] | (h[1] << 16), h[2] | (h[3] << 16), h[4] | (h[5] << 16), h[6] | (h[7] << 16)};
  v4u lv = {l[0] | (l[1] << 16), l[2] | (l[3] << 16), l[4] | (l[5] << 16), l[6] | (l[7] << 16)};
  hi = __builtin_bit_cast(bf16x8, hv); lo = __builtin_bit_cast(bf16x8, lv);
}
__device__ __forceinline__ void p0_w3t(const Frame& F, const Args& a) {
  const float* wq = a.in[IN_WQ]; const float* sk = a.in[IN_SUBK]; const float* g2 = a.in[IN_G2];
  bf16* W3t = (bf16*)(F.ws + WS_W3T);
  const int lane = F.lane, fr = lane & 15, fq = lane >> 4;
  constexpr int SKS = 272;
  LAS unsigned char* shi = F.lds; LAS unsigned char* slo = F.lds + 128 * SKS;
  for (int bt = blockIdx.x; bt < 256; bt += gridDim.x) {
    const int hh = bt & 15, kt = (bt >> 4) * 8 + F.wave;
    const float* ap = wq + (size_t)(kt * 16 + fr) * DM + hh * 128 + fq * 8;
    f32x4 a0[4], a1[4];
#pragma unroll
    for (int s = 0; s < 4; ++s) { a0[s] = *(const f32x4*)(ap + 32 * s); a1[s] = *(const f32x4*)(ap + 32 * s + 4); }
    const f32x4 gk = *(const f32x4*)(g2 + kt * 16 + fq * 4);
    __syncthreads();
#pragma unroll
    for (int i = 0; i < 4; ++i) { const int idx = F.tid + NTHR * i, key = idx >> 4, c8 = idx & 15; const float* p = sk + (size_t)(hh * 128 + key) * 128 + c8 * 8;
      bf16x8 h, l; split_hl(*(const f32x4*)p, *(const f32x4*)(p + 4), h, l);
      *(LAS bf16x8*)(shi + key * SKS + c8 * 16) = h; *(LAS bf16x8*)(slo + key * SKS + c8 * 16) = l; }
    bf16x8 ahi[4], alo[4];
#pragma unroll
    for (int s = 0; s < 4; ++s) split_hl(a0[s], a1[s], ahi[s], alo[s]);
    __syncthreads();
#pragma unroll 2
    for (int t2 = 0; t2 < 8; ++t2) {
      const LAS unsigned char* bh = shi + (t2 * 16 + fr) * SKS + fq * 16; const LAS unsigned char* bl = slo + (t2 * 16 + fr) * SKS + fq * 16;
      f32x4 acc = {0.f, 0.f, 0.f, 0.f};
#pragma unroll
      for (int s = 0; s < 4; ++s) { const bf16x8 bhi = *(const LAS bf16x8*)(bh + 64 * s), blo = *(const LAS bf16x8*)(bl + 64 * s);
        acc = __builtin_amdgcn_mfma_f32_16x16x32_bf16(ahi[s], bhi, acc, 0, 0, 0);
        acc = __builtin_amdgcn_mfma_f32_16x16x32_bf16(ahi[s], blo, acc, 0, 0, 0);
        acc = __builtin_amdgcn_mfma_f32_16x16x32_bf16(alo[s], bhi, acc, 0, 0, 0); }
      v2u o; o.x = pk2(acc.x * gk.x, acc.y * gk.y); o.y = pk2(acc.z * gk.z, acc.w * gk.w);
      *(v2u*)(W3t + (size_t)(hh * 128 + t2 * 16 + fr) * DM + kt * 16 + fq * 4) = o;
    }
  }
  __syncthreads();
}
typedef float f32x2v __attribute__((ext_vector_type(2)));
__device__ __forceinline__ void p0_tables(const Frame& F, const Args& a) {
  const float* g2 = a.in[IN_G2];
  float* SCL = (float*)(F.ws + WS_SCL);
  const int gw = blockIdx.x * NWAVES + F.wave, NGW = gridDim.x * NWAVES, lane = F.lane;
  f32x4 gl[8];
#pragma unroll
  for (int q = 0; q < 8; ++q) gl[q] = *(const f32x4*)(g2 + q * 256 + lane * 4);
  f32x4 xn[8];
  { const int row = gw; if (row < 2 * 16384) { const float* src = a.in[row >= 16384 ? IN_V : IN_U] + (size_t)(row & 16383) * DM + lane * 4;
#pragma unroll
      for (int q = 0; q < 8; ++q) xn[q] = *(const f32x4*)(src + q * 256); } }
  for (int row = gw; row < 2 * 16384; row += NGW) {
    const bool isv = row >= 16384; const int e = row & 16383;
    f32x4 x[8];
#pragma unroll
    for (int q = 0; q < 8; ++q) x[q] = xn[q];
    { const int rn = row + NGW; if (rn < 2 * 16384) { const float* src = a.in[rn >= 16384 ? IN_V : IN_U] + (size_t)(rn & 16383) * DM + lane * 4;
#pragma unroll
        for (int q = 0; q < 8; ++q) xn[q] = *(const f32x4*)(src + q * 256); } }
    float amax = 0.f, ssq = 0.f;
#pragma unroll
    for (int q = 0; q < 8; ++q) { if (!isv) x[q] = x[q] * gl[q]; amax = fmaxf(amax, fmaxf(fmaxf(fabsf(x[q].x), fabsf(x[q].y)), fmaxf(fabsf(x[q].z), fabsf(x[q].w))));
      ssq += (x[q].x * x[q].x + x[q].y * x[q].y) + (x[q].z * x[q].z + x[q].w * x[q].w); }
#pragma unroll
    for (int o = 1; o < 64; o <<= 1) amax = fmaxf(amax, __shfl_xor(amax, o));
    v4u w;
    if (isv) {
      const float sc = amax > 0.f ? 6.0f / amax : 1.0f;
#pragma unroll
      for (int d = 0; d < 4; ++d) { unsigned pk = 0u;
        pk = __builtin_amdgcn_cvt_scalef32_pk_fp4_f32(pk, x[2 * d].x * sc, x[2 * d].y * sc, 1.0f, 0); pk = __builtin_amdgcn_cvt_scalef32_pk_fp4_f32(pk, x[2 * d].z * sc, x[2 * d].w * sc, 1.0f, 1);
        pk = __builtin_amdgcn_cvt_scalef32_pk_fp4_f32(pk, x[2 * d + 1].x * sc, x[2 * d + 1].y * sc, 1.0f, 2); pk = __builtin_amdgcn_cvt_scalef32_pk_fp4_f32(pk, x[2 * d + 1].z * sc, x[2 * d + 1].w * sc, 1.0f, 3);
        w[d] = pk; }
      if (lane == 0) SCL[row] = 1.0f / sc;
    } else {
      ssq = wave_sum_dpp(ssq);
      const float sA = amax > 0.f ? amax * (1.0f / 7.0f) : 1.0f, sB = fminf(sA, 0.36f * sqrtf(ssq * (1.0f / DM)) + 1e-30f);
      const float iA = 1.0f / sA, iB = 1.0f / sB;
      float eA = 0.f, eB = 0.f;
#pragma unroll
      for (int q = 0; q < 8; ++q)
#pragma unroll
        for (int j = 0; j < 4; ++j) { const float v = x[q][j];
          const float da = v - sA * __builtin_amdgcn_fmed3f(__builtin_rintf(v * iA), -7.0f, 7.0f), db = v - sB * __builtin_amdgcn_fmed3f(__builtin_rintf(v * iB), -7.0f, 7.0f);
          eA += da * da; eB += db * db; }
      eA = wave_sum_dpp(eA); eB = wave_sum_dpp(eB);
      const bool useB = eB < eA; const float st = useB ? sB : sA, is = useB ? iB : iA;
#pragma unroll
      for (int d = 0; d < 4; ++d) { unsigned pk = 0u;
#pragma unroll
        for (int p = 0; p < 8; ++p) { const float v = x[2 * d + (p >> 2)][p & 3]; const int qi = (int)__builtin_amdgcn_fmed3f(__builtin_rintf(v * is), -7.0f, 7.0f); pk |= ((unsigned)qi & 15u) << (4 * p); }
        w[d] = pk; }
      if (lane == 0) SCL[row] = st;
    }
    *(v4u*)(F.ws + (isv ? WS_VB8 : WS_UB) + (size_t)e * 1024 + lane * 16) = w;
  }
}
struct EpiScore {
  static constexpr bool PERM = true, AFTER_DRAIN = false;
  float* S; const LAS float* rs;
  __device__ __forceinline__ void operator()(const pg8::f32x4 (&acc)[2][2][4][2], const pg8::Unit& u, int wr, int wc, int fr, int fq) const {
    const int rl0 = wr * 64 + fr, keyb = wc * 32 + 8 * fq;
#pragma unroll
    for (int ai = 0; ai < 2; ++ai)
#pragma unroll
      for (int m = 0; m < 4; ++m) { const int rl = rl0 + ai * 128 + m * 16; const float r = rs[rl]; const int row = u.pm * 256 + rl;
#pragma unroll
        for (int bj = 0; bj < 2; ++bj) { float* d = S + ((size_t)((row >> 5) * 16 + u.pn * 2 + bj) * 128 + keyb) * 32 + (row & 31);
          const pg8::f32x4 v0 = acc[ai][bj][m][0] * r, v1 = acc[ai][bj][m][1] * r;
          d[0] = v0[0]; d[32] = v0[1]; d[64] = v0[2]; d[96] = v0[3]; d[128] = v1[0]; d[160] = v1[1]; d[192] = v1[2]; d[224] = v1[3]; } }
  }
};

__device__ __forceinline__ unsigned fkey(float f) { const unsigned b = __builtin_bit_cast(unsigned, f); return b ^ ((b >> 31) ? 0xFFFFFFFFu : 0x80000000u); }
template <int NV, int K> __device__ __forceinline__ void wave_topk(const unsigned (&u)[NV], bool (&sel)[NV], int lane) {
  unsigned prefix = 0u; int cge = NV * 64;
#pragma unroll 1
  for (int bit = 31; bit >= 0 && cge != K; --bit) {
    const unsigned cand = prefix | (1u << bit); int c = 0;
#pragma unroll
    for (int i = 0; i < NV; ++i) c += __builtin_popcountll(__ballot(u[i] >= cand));
    if (c >= K) { prefix = cand; cge = c; }
  }
  int cgt = 0;
#pragma unroll
  for (int i = 0; i < NV; ++i) cgt += __builtin_popcountll(__ballot(u[i] > prefix));
  int need = K - cgt;
  const unsigned long long lm = (1ull << lane) - 1ull;
#pragma unroll
  for (int i = 0; i < NV; ++i) { const unsigned long long eq = __ballot(u[i] == prefix); const int before = __builtin_popcountll(eq & lm);
    sel[i] = (u[i] > prefix) || (u[i] == prefix && before < need); const int ne = __builtin_popcountll(eq); need = need > ne ? need - ne : 0; }
}
template <int NG, int NV, int K> __device__ __forceinline__ void wave_topk_multi(const unsigned (&u)[NG][NV], bool (&sel)[NG][NV], int lane) {
  unsigned prefix[NG]; int cge[NG];
#pragma unroll
  for (int g = 0; g < NG; ++g) { prefix[g] = 0u; cge[g] = NV * 64; }
#pragma unroll 1
  for (int bit = 31; bit >= 0; --bit) {
    bool done = true;
#pragma unroll
    for (int g = 0; g < NG; ++g) done = done && (cge[g] == K);
    if (done) break;
#pragma unroll
    for (int g = 0; g < NG; ++g) { const unsigned cand = prefix[g] | (1u << bit); int c = 0;
#pragma unroll
      for (int i = 0; i < NV; ++i) c += __builtin_popcountll(__ballot(u[g][i] >= cand));
      if (cge[g] != K && c >= K) { prefix[g] = cand; cge[g] = c; } }
  }
  const unsigned long long lm = (1ull << lane) - 1ull;
#pragma unroll
  for (int g = 0; g < NG; ++g) { int cgt = 0;
#pragma unroll
    for (int i = 0; i < NV; ++i) cgt += __builtin_popcountll(__ballot(u[g][i] > prefix[g]));
    int need = K - cgt;
#pragma unroll
    for (int i = 0; i < NV; ++i) { const unsigned long long eq = __ballot(u[g][i] == prefix[g]); const int before = __builtin_popcountll(eq & lm);
      sel[g][i] = (u[g][i] > prefix[g]) || (u[g][i] == prefix[g] && before < need); const int ne = __builtin_popcountll(eq); need = need > ne ? need - ne : 0; } }
}
__device__ __forceinline__ float gelu_erf(float v) {
  const float av = fabsf(v), t = __builtin_amdgcn_rcpf(1.0f + 0.2316418882f * av);
  float q = t * 0.5307027145f - 0.7265760135f; q = q * t + 0.7107068705f; q = q * t - 0.142248368f; q = q * t + 0.127414796f; q = q * t;
  const float tail = q * __builtin_amdgcn_exp2f(v * v * -0.72134752044f);
  return v < 0.f ? v * tail : v - v * tail;
}

#ifndef ROUTE_REPS
#define ROUTE_REPS 1
#endif
__device__ __forceinline__ void ins16(float (&t)[16], float x) {
#pragma unroll
  for (int i = 15; i >= 1; --i) t[i] = __builtin_amdgcn_fmed3f(t[i - 1], t[i], x);
  t[0] = fmaxf(t[0], x);
}
__device__ __forceinline__ void p6_peer(const Frame& F, const Args& a, float* dst_base) {
  const float* S2 = (const float*)(F.ws + WS_S); const float* SSQ = (const float*)(F.ws + WS_SSQ); const bf16* H1b = (const bf16*)(F.ws + WS_H1B);
  int lane = F.lane, wv = F.wave, tid = F.tid; asm volatile("" : "+v"(lane), "+s"(wv), "+v"(tid));
  int* EIDg = (int*)(F.ws + WS_EID); float* EGTg = (float*)(F.ws + WS_EGT);
  LAS int* eid = (LAS int*)(F.lds + wv * 1536); LAS float* egt = (LAS float*)(eid + 128); LAS float* esu = (LAS float*)(eid + 256);
  LAS unsigned char* RB = F.lds + 12288 + wv * 16384;
  LAS float* L1 = (LAS float*)(F.lds + 12288);
  for (int tb = blockIdx.x; tb < MROWS / 32; tb += gridDim.x) {
    __syncthreads();
    {
      const int g = tid >> 5, tl = tid & 31; const float* src = S2 + ((size_t)(tb * 16 + g) * 128) * 32 + tl;
      float t[16];
#pragma unroll
      for (int i = 0; i < 16; ++i) t[i] = -INFINITY;
#pragma unroll 32
      for (int k = 0; k < 128; ++k) { const float x = src[k * 32]; ins16(t, __builtin_bit_cast(float, (__builtin_bit_cast(unsigned, x) & ~0x7Fu) | (unsigned)(127 - k))); }
#pragma unroll
      for (int i = 0; i < 16; ++i) L1[(g * 16 + i) * 32 + tl] = t[i];
    }
    __syncthreads();
    if (tid < 256) {
      const int h8 = tid >> 5, tl = tid & 31; const LAS float* LA = L1 + ((2 * h8) * 16) * 32 + tl; const LAS float* LB = L1 + ((2 * h8 + 1) * 16) * 32 + tl;
      float A[16], B[16], t[16];
#pragma unroll
      for (int i = 0; i < 16; ++i) { A[i] = LA[i * 32]; B[i] = LB[i * 32]; t[i] = -INFINITY; }
#pragma unroll
      for (int i = 0; i < 16; ++i)
#pragma unroll
        for (int j = 0; j < 16; ++j) if ((i + 1) * (j + 1) <= 16) { const float c = A[i] + B[j];
            ins16(t, __builtin_bit_cast(float, (__builtin_bit_cast(unsigned, c) & ~0xFFu) | (unsigned)(255 - (i * 16 + j)))); }
      float ev[16], es = 0.f;
#pragma unroll
      for (int r = 0; r < 16; ++r) { ev[r] = __expf(t[r] - t[0]); es += ev[r]; }
      const float inv = 1.0f / es;
#pragma unroll
      for (int r = 0; r < 16; ++r) { const unsigned flat = 255u - (__builtin_bit_cast(unsigned, t[r]) & 0xFFu), ii = flat >> 4, jj = flat & 15u;
        const unsigned ka = 127u - (__builtin_bit_cast(unsigned, LA[ii * 32]) & 0x7Fu), kb = 127u - (__builtin_bit_cast(unsigned, LB[jj * 32]) & 0x7Fu);
        EIDg[(size_t)(tb * 32 + tl) * 128 + h8 * 16 + r] = (int)(ka * 128u + kb); EGTg[(size_t)(tb * 32 + tl) * 128 + h8 * 16 + r] = ev[r] * inv; }
    }
    asm volatile("s_waitcnt vmcnt(0)" ::: "memory"); __syncthreads();
#pragma unroll 1
    for (int tt = 0; tt < 4; ++tt) {
    const int tl = wv * 4 + tt, tok = tb * 32 + tl;
    const float rs = rsqrtf(wave_sum_dpp(lane < 32 ? SSQ[(size_t)tok * 32 + lane] : 0.f) * (1.0f / DM) + EPS);
    { const float* SCL = (const float*)(F.ws + WS_SCL);
#pragma unroll
      for (int i = 0; i < 2; ++i) { const int e = lane + 64 * i, idq = __builtin_nontemporal_load(EIDg + (size_t)tok * 128 + e); eid[e] = idq; esu[e] = SCL[idq]; egt[e] = __builtin_nontemporal_load(EGTg + (size_t)tok * 128 + e) * SCL[16384 + idq]; } }
    unsigned xw[16];
    { const bf16* xp = H1b + (size_t)tok * DM + (size_t)lane * 4;
#pragma unroll
      for (int q = 0; q < 8; ++q) { const v2u x0 = *(const v2u*)(xp + q * 256); xw[2 * q] = x0.x; xw[2 * q + 1] = x0.y; } }
    int xl[4], xh[4]; float rsx;
    { float xa = 0.f;
#pragma unroll
      for (int i = 0; i < 16; ++i) xa = fmaxf(xa, fmaxf(fabsf(bflo(xw[i])), fabsf(bfhi(xw[i]))));
#pragma unroll
      for (int o = 1; o < 64; o <<= 1) xa = fmaxf(xa, __shfl_xor(xa, o));
      const float xinv = xa > 0.f ? 119.0f / xa : 0.f; rsx = rs * (xa > 0.f ? xa * (1.0f / 119.0f) : 0.f);
#pragma unroll
      for (int d = 0; d < 4; ++d) { unsigned pl = 0u, ph = 0u;
#pragma unroll
        for (int p = 0; p < 8; ++p) { const int i = 8 * d + p; const float v = (i & 1) ? bfhi(xw[i >> 1]) : bflo(xw[i >> 1]);
          const int xi = (int)__builtin_rintf(v * xinv), l = ((xi + 8) & 15) - 8, h = (xi - l) >> 4;
          pl |= ((unsigned)l & 15u) << (4 * p); ph |= ((unsigned)h & 15u) << (4 * p); }
        xl[d] = (int)pl; xh[d] = (int)ph; } }
    float y[32];
#pragma unroll
    for (int i = 0; i < 32; ++i) y[i] = 0.f;
    asm volatile("s_waitcnt vmcnt(0) lgkmcnt(0)" ::: "memory");
    const unsigned char* U8 = F.ws + WS_UB; const unsigned char* V8 = F.ws + WS_VB8;
#define PG_ISSUE(E) do { const int idq_ = __builtin_amdgcn_readfirstlane(eid[(E)]); LAS unsigned char* sl_ = RB + ((E) & 7) * 2048; \
      __builtin_amdgcn_global_load_lds((const unsigned*)(U8 + (size_t)idq_ * 1024 + lane * 16), (LAS unsigned*)sl_, 16, 0, 0); \
      __builtin_amdgcn_global_load_lds((const unsigned*)(V8 + (size_t)idq_ * 1024 + lane * 16), (LAS unsigned*)(sl_ + 1024), 16, 0, 0); } while (0)
#define PG_DOT(UW, DACC) do { int al_ = 0, ah_ = 0; _Pragma("unroll") for (int dd = 0; dd < 4; ++dd) { const int wa = (int)UW[dd]; \
          al_ = __builtin_amdgcn_sdot8(wa, xl[dd], al_, false); ah_ = __builtin_amdgcn_sdot8(wa, xh[dd], ah_, false); } DACC = (float)(ah_ * 16 + al_); } while (0)
#define PG_AXPY(VW, CF) do { _Pragma("unroll") for (int dd = 0; dd < 4; ++dd) { const unsigned wa = VW[dd]; \
          { const f32x2v v2 = __builtin_amdgcn_cvt_scalef32_pk_f32_fp4(wa, 1.0f, 0); y[8 * dd + 0] += CF * v2.x; y[8 * dd + 1] += CF * v2.y; } \
          { const f32x2v v2 = __builtin_amdgcn_cvt_scalef32_pk_f32_fp4(wa, 1.0f, 1); y[8 * dd + 2] += CF * v2.x; y[8 * dd + 3] += CF * v2.y; } \
          { const f32x2v v2 = __builtin_amdgcn_cvt_scalef32_pk_f32_fp4(wa, 1.0f, 2); y[8 * dd + 4] += CF * v2.x; y[8 * dd + 5] += CF * v2.y; } \
          { const f32x2v v2 = __builtin_amdgcn_cvt_scalef32_pk_f32_fp4(wa, 1.0f, 3); y[8 * dd + 6] += CF * v2.x; y[8 * dd + 7] += CF * v2.y; } } } while (0)
#define PG_BATCH(E0, DOISSUE) do { v4u ub[NBT], vb[NBT]; float su_[NBT], gt_[NBT]; \
      _Pragma("unroll") for (int q = 0; q < NBT; ++q) { const LAS unsigned char* s0_ = RB + (((E0) + q) & 7) * 2048 + lane * 16; ub[q] = *(const LAS v4u*)s0_; vb[q] = *(const LAS v4u*)(s0_ + 1024); su_[q] = esu[(E0) + q]; gt_[q] = egt[(E0) + q]; } \
      asm volatile("s_waitcnt lgkmcnt(0)" ::: "memory"); \
      if (DOISSUE) { _Pragma("unroll") for (int q = 0; q < NBT; ++q) PG_ISSUE((E0) + 8 + q); } \
      float d_[NBT]; _Pragma("unroll") for (int q = 0; q < NBT; ++q) { d_[q] = 0.f; PG_DOT(ub[q], d_[q]); } \
      PROBE_EXTRA \
      _Pragma("unroll") for (int q = 0; q < NBT; ++q) d_[q] = wave_sum_dpp(d_[q]); \
      _Pragma("unroll") for (int q = 0; q < NBT; ++q) { const float c_ = gelu_erf(d_[q] * (rsx * su_[q])) * gt_[q]; PG_AXPY(vb[q], c_); __builtin_amdgcn_sched_barrier(0); } } while (0)
#if defined(PROBE_CVT)
#define PROBE_EXTRA _Pragma("unroll") for (int q = 0; q < NBT; ++q) _Pragma("unroll") for (int dd = 0; dd < 4; ++dd) { const unsigned wz = ub[q][dd]; \
        const f32x2v r0 = __builtin_amdgcn_cvt_scalef32_pk_f32_fp4(wz, 1.0f, 0), r1 = __builtin_amdgcn_cvt_scalef32_pk_f32_fp4(wz, 1.0f, 1), r2 = __builtin_amdgcn_cvt_scalef32_pk_f32_fp4(wz, 1.0f, 2), r3 = __builtin_amdgcn_cvt_scalef32_pk_f32_fp4(wz, 1.0f, 3); \
        asm volatile("" :: "v"(r0), "v"(r1), "v"(r2), "v"(r3)); }
#elif defined(PROBE_DOT)
#define PROBE_EXTRA _Pragma("unroll") for (int q = 0; q < NBT; ++q) _Pragma("unroll") for (int dd = 0; dd < 16; ++dd) { \
        const float r0 = __builtin_amdgcn_fdot2_f32_bf16(__builtin_bit_cast(bfv2, xw[dd]), __builtin_bit_cast(bfv2, ub[q][dd & 3]), su_[q], false); asm volatile("" :: "v"(r0)); }
#elif defined(PROBE_FMA16)
#define PROBE_EXTRA _Pragma("unroll") for (int q = 0; q < NBT; ++q) _Pragma("unroll") for (int dd = 0; dd < 16; ++dd) { \
        unsigned r0 = ub[q][dd & 3]; asm volatile("v_pk_fma_f16 %0, %1, %1, %0" : "+v"(r0) : "v"(xw[dd])); asm volatile("" :: "v"(r0)); }
#elif defined(PROBE_DOTF16)
#define PROBE_EXTRA _Pragma("unroll") for (int q = 0; q < NBT; ++q) _Pragma("unroll") for (int dd = 0; dd < 16; ++dd) { \
        float r0 = su_[q]; asm volatile("v_dot2_f32_f16 %0, %1, %2, %0" : "+v"(r0) : "v"(xw[dd]), "v"(ub[q][dd & 3])); asm volatile("" :: "v"(r0)); }
#elif defined(PROBE_SDOT4)
#define PROBE_EXTRA _Pragma("unroll") for (int q = 0; q < NBT; ++q) _Pragma("unroll") for (int dd = 0; dd < 16; ++dd) { \
        int r0 = (int)ub[q][(dd + 1) & 3]; asm volatile("v_dot4_i32_i8 %0, %1, %2, %0" : "+v"(r0) : "v"(xw[dd]), "v"(ub[q][dd & 3])); asm volatile("" :: "v"(r0)); }
#elif defined(PROBE_SDOT8)
#define PROBE_EXTRA _Pragma("unroll") for (int q = 0; q < NBT; ++q) _Pragma("unroll") for (int dd = 0; dd < 16; ++dd) { \
        int r0 = (int)ub[q][(dd + 1) & 3]; asm volatile("v_dot8_i32_i4 %0, %1, %2, %0" : "+v"(r0) : "v"(xw[dd]), "v"(ub[q][dd & 3])); asm volatile("" :: "v"(r0)); }
#elif defined(PROBE_FMA)
#define PROBE_EXTRA _Pragma("unroll") for (int q = 0; q < NBT; ++q) _Pragma("unroll") for (int dd = 0; dd < 16; ++dd) { \
        f32x2v r0 = {su_[q], gt_[q]}; const f32x2v a_ = {y[2 * dd], y[2 * dd + 1]}; asm volatile("v_pk_fma_f32 %0, %1, %1, %0" : "+v"(r0) : "v"(a_)); asm volatile("" :: "v"(r0)); }
#else
#define PROBE_EXTRA
#endif
    constexpr int NBT = 2;
#pragma unroll
    for (int e = 0; e < 8; ++e) PG_ISSUE(e);
#pragma unroll 1
    for (int e = 0; e < 120; e += NBT) {
      asm volatile("s_waitcnt vmcnt(12)" ::: "memory");
      PG_BATCH(e, true);
      asm volatile("" ::: "memory");
    }
    asm volatile("s_waitcnt vmcnt(0)" ::: "memory");
#pragma unroll 1
    for (int e = 120; e < 128; e += NBT) PG_BATCH(e, false);
    asm volatile("s_waitcnt lgkmcnt(0)" ::: "memory");
#undef PG_ISSUE
#undef PG_DOT
#undef PG_AXPY
#undef PG_BATCH
#undef PROBE_EXTRA
    float* drow = dst_base + (size_t)tok * DM;
#pragma unroll
    for (int q = 0; q < 8; ++q) { const size_t off = (size_t)q * 256 + lane * 4; f32x4 hv;
      hv.x = bflo(xw[2 * q]) + y[4 * q];
#ifdef TPROBE
      if (tok == 0 && lane == 0 && q == 0) hv.x += 10.0f + (float)(*(volatile unsigned*)(F.ws + 64)) * (0.01f / TP_DIV);
#endif
      hv.y = bfhi(xw[2 * q]) + y[4 * q + 1]; hv.z = bflo(xw[2 * q + 1]) + y[4 * q + 2]; hv.w = bfhi(xw[2 * q + 1]) + y[4 * q + 3]; *(f32x4*)(drow + off) = hv; }
    }
  }
}
constexpr int MISC_LDS = LDS_BYTES - 256;
__global__ void __launch_bounds__(NTHR, 2) mk_fwd(Args args) {
  extern __shared__ __attribute__((aligned(16))) unsigned char lds_raw[];
  Frame F; F.lds = (LAS unsigned char*)lds_raw; F.ws = args.ws; F.tid = threadIdx.x; F.lane = F.tid & 63; F.wave = __builtin_amdgcn_readfirstlane(F.tid >> 6);
  const int lo = args.ph_lo, hi = args.ph_hi, G = (int)gridDim.x, bx = (int)blockIdx.x;
  volatile LAS unsigned* misc = (volatile LAS unsigned*)(F.lds + MISC_LDS);
  if (F.tid < 16) misc[F.tid] = 0u;
  __syncthreads();
  XcdBarrier bar = xcd_barrier_post((unsigned*)(F.ws + WS_CTL) + CW_BAR, misc);
#define IN(k) (lo <= (k) && (k) < hi)
#ifdef TPROBE
#define SEAM(k) do { if (IN(k) && IN((k) + 1)) { const unsigned long long tq0_ = __builtin_amdgcn_s_memrealtime(); xcd_barrier(bar); const unsigned long long tq1_ = __builtin_amdgcn_s_memrealtime(); \
    if (TPROBE == 20 + (k) && (int)blockIdx.x == TP_BLOCK && threadIdx.x == 0) atomicAdd((unsigned*)(F.ws + 64), (unsigned)(tq1_ - tq0_)); } } while (0)
#else
#define SEAM(k) do { if (IN(k) && IN((k) + 1)) xcd_barrier(bar); } while (0)
#endif
#define PHASE_FRAME(Fp) Frame Fp = F; asm volatile("" : "+v"(Fp.tid), "+v"(Fp.lane))
  const int NA = G;
  if (IN(0)) { PHASE_FRAME(F0); TP_BEGIN(1);
#ifdef SLEEP_START
#pragma unroll 1
    for (int i_ = 0; i_ < SLEEP_START; ++i_) __builtin_amdgcn_s_sleep(127);
#endif
    p0_lam(F0, args);
    p0_zero_vpad(F0);
    p0_rows(F0, args);
    p0_transpose<true>(F0, args, args.in[IN_WIN], DPROJ, NPROJ, (bf16*)(F.ws + WS_W1T));
    p0_transpose<false>(F0, args, args.in[IN_WOUT], DM, DM, (bf16*)(F.ws + WS_W2T));
    p0_w3t(F0, args);
    p0_tables(F0, args);
#ifdef DUP_ROWS
    p0_rows(F0, args);
#endif
#ifdef DUP_TR
    p0_transpose<true>(F0, args, args.in[IN_WIN], DPROJ, NPROJ, (bf16*)(F.ws + WS_W1T));
    p0_transpose<false>(F0, args, args.in[IN_WOUT], DM, DM, (bf16*)(F.ws + WS_W2T));
#endif
#ifdef DUP_W3T
    p0_w3t(F0, args);
#endif
#ifdef DUP_TAB
    p0_tables(F0, args);
#endif
    TP_END(1, F.ws);
  }
  SEAM(0);
  if (IN(1)) { PHASE_FRAME(F1);
    p1_meta_finalize(F1, args);
    pg8::Gemm g{(const pg8::bf16_t*)(F.ws + WS_XN), (const pg8::bf16_t*)(F.ws + WS_W1T), MROWS, NPROJ, DM};
    pg8::StaticOrder S; S.init(MROWS, NPROJ, G, bx);
    EpiProj E{(bf16*)(F.ws + WS_Q), (bf16*)(F.ws + WS_KP), (bf16*)(F.ws + WS_VP), (bf16*)(F.ws + WS_MQ), (bf16*)(F.ws + WS_MK), (bf16*)(F.ws + WS_MV), (bf16*)(F.ws + WS_MO),
              args.in[IN_QNG], args.in[IN_KNG], (LAS float*)(F.lds + XCH_OFF)};
    pg8::gemm_phase<EpiProj, pg8::StaticOrder, true, true>(F.lds + RING_OFF, g, S, E);
  }
  SEAM(1);
  if (IN(2)) {
    PHASE_FRAME(F2);
    TP_BEGIN(3);
    att::phase(F2, (G % 8 == 0) ? (bx & 7) * (G >> 3) + (bx >> 3) : bx, NA);
    TP_END(3, F.ws); TP_BEGIN(4);
    for (int task = bx; task < 512; task += G) ml::taskA(F2, args, task);
    TP_END(4, F.ws);
  }
  SEAM(2);
  if (IN(3)) { PHASE_FRAME(F3); TP_BEGIN(5); ml::scanB(F3); TP_END(5, F.ws); TP_BEGIN(6); p3_combine(F3, args, NA); TP_END(6, F.ws);
#ifdef DUP_SCAN
    ml::scanB(F3);
#endif
#ifdef DUP_COMB
    p3_combine(F3, args, NA);
#endif
  }
  SEAM(3);
  if (IN(4)) {
    PHASE_FRAME(F4);
    TP_BEGIN(7);
    for (int task = bx; task < 512; task += G) ml::taskC(F4, args, task);
    TP_END(7, F.ws);
  }
  SEAM(4);
  if (IN(5)) {
    pg8::Gemm g{(const pg8::bf16_t*)(F.ws + WS_A2), (const pg8::bf16_t*)(F.ws + WS_W2T), MROWS, DM, DM};
    pg8::StaticOrder S; S.init(MROWS, DM, G, bx);
    EpiRes E{args.in[IN_X], args.out, (bf16*)(F.ws + WS_H1B), (float*)(F.ws + WS_SSQ)};
    pg8::gemm_phase<EpiRes, pg8::StaticOrder, true, true>(F.lds + RING_OFF, g, S, E);
  }
  SEAM(5);
  if (IN(6)) {
    pg8::Gemm g{(const pg8::bf16_t*)(F.ws + WS_H1B), (const pg8::bf16_t*)(F.ws + WS_W3T), MROWS, DM, DM};
    pg8::StaticOrder S; S.init(MROWS, DM, G, bx);
    LAS float* rst = (LAS float*)(F.lds + XCH_OFF);
    { pg8::Unit u0; if (S.next(0, u0)) { if (F.tid < 256) { const float* sp = (const float*)(F.ws + WS_SSQ) + ((size_t)u0.pm * 256 + F.tid) * 32; float s = 0.f;
#pragma unroll
          for (int i = 0; i < 8; ++i) { const f32x4 v = ((const f32x4*)sp)[i]; s += (v.x + v.y) + (v.z + v.w); }
          rst[F.tid] = rsqrtf(s * (1.0f / DM) + EPS); } } }
    __syncthreads();
    EpiScore E{(float*)(F.ws + WS_S), rst};
    pg8::gemm_phase<EpiScore, pg8::StaticOrder, true, true>(F.lds + RING_OFF, g, S, E);
  }
  SEAM(6);
  if (IN(7)) { PHASE_FRAME(F7); p6_peer(F7, args, args.out); }
#undef IN
#undef SEAM
}
extern "C" void kernel_launch(void* const* d_in, const int* in_sizes, int n_in, void* d_out, int out_size, void* d_ws, size_t ws_size, hipStream_t stream) {
  static int grid = 0;
  if (grid == 0) {
    int dev = 0, cus = 0, per_cu = 0;
    if (hipGetDevice(&dev) != hipSuccess || hipDeviceGetAttribute(&cus, hipDeviceAttributeMultiprocessorCount, dev) != hipSuccess) { fprintf(stderr, "device query failed\n"); grid = -1; return; }
    if (hipFuncSetAttribute((const void*)mk_fwd, hipFuncAttributeMaxDynamicSharedMemorySize, LDS_BYTES) != hipSuccess) { fprintf(stderr, "hipFuncSetAttribute failed\n"); grid = -1; return; }
    if (hipOccupancyMaxActiveBlocksPerMultiprocessor(&per_cu, (const void*)mk_fwd, NTHR, LDS_BYTES) != hipSuccess || per_cu < 1) { fprintf(stderr, "occupancy query says %d workgroups per CU: not launching\n", per_cu); (void)hipGetLastError(); grid = -1; return; }
    (void)hipGetLastError();
    grid = cus;
    if (n_in != 22 || ws_size < (size_t)512 * MiB || out_size != MROWS * DM) { fprintf(stderr, "unexpected shapes: n_in %d out %d ws %zu\n", n_in, out_size, ws_size); grid = -1; return; }
  }
  if (grid < 0) return;
  unsigned char* ws = (unsigned char*)d_ws;
  if (hipMemsetAsync(ws + WS_CTL, 0, CTL_ZERO_BYTES, stream) != hipSuccess) { fprintf(stderr, "memset failed\n"); return; }
  Args a{};
  for (int i = 0; i < 22; ++i) a.in[i] = (const float*)d_in[i];
  a.out = (float*)d_out; a.ws = ws; a.na = 0; a.pad = 0;
  a.ph_lo = 0; a.ph_hi = 8;
  hipLaunchKernelGGL(mk_fwd, dim3(grid), dim3(NTHR), LDS_BYTES, stream, a);
}
```

```cpp
#include <hip/hip_runtime.h>
#include <cstdio>
#include <cstdint>
#include <math.h>
namespace pg8 {
#define PG8_LAS __attribute__((address_space(3)))
typedef unsigned short bf16_t;
typedef short bf16x8 __attribute__((ext_vector_type(8)));
typedef float f32x4 __attribute__((ext_vector_type(4)));
typedef unsigned u32x4 __attribute__((ext_vector_type(4)));
constexpr int BM = 256, BK = 64, HALF = 128, HTB = HALF * BK * 2  , STAGE_BYTES = 8 * HTB, NXCD = 8, WGM = 8;

__host__ __device__ __forceinline__ int lds_byte(int r, int c) { const int st = (r >> 4) * 2 + (c >> 5), rr = r & 15, cc = c & 31, ob = rr * 64 + cc * 2; return st * 1024 + (ob ^ (((ob >> 9) & 1) << 5)); }
__host__ __device__ __forceinline__ void stage_rc(int b, int& R, int& C) { const int st = b / 1024, sb = b % 1024, swz = sb ^ (((sb >> 9) & 1) << 5); R = (st >> 1) * 16 + swz / 64; C = (st & 1) * 32 + (swz % 64) / 2; }
__host__ __device__ __forceinline__ int perm32(int rho) { const int n = rho >> 4, i = rho & 15; return 8 * (i >> 2) + 4 * n + (i & 3); }

struct Unit { int pm, pn; };
struct Gemm { const bf16_t* A; const bf16_t* Bt; int M, N, K; };

struct StaticOrder {
    int nM, nN, nwg, G, c;
    __host__ __device__ void init(int M, int N, int G_, int c_) { nM = M / BM; nN = N / BM; nwg = nM * nN; G = G_; c = c_; }
    __host__ __device__ bool next(int i, Unit& u) const {
        const long L = (long)i * G + c; if (L >= nwg) return false;
        int wgid = (int)L; { const int q = nwg / NXCD, r = nwg % NXCD, xcd = wgid % NXCD, off = wgid / NXCD; wgid = (xcd < r ? xcd * (q + 1) : r * (q + 1) + (xcd - r) * q) + off; }
        const int nig = WGM * nN, gid = wgid / nig, fm = gid * WGM, gsz = (nM - fm) < WGM ? (nM - fm) : WGM;
        u.pm = fm + ((wgid % nig) % gsz); u.pn = (wgid % nig) / gsz; return true;
    }
    __device__ __forceinline__ void a_ready(const Unit&) const {}
    __device__ __forceinline__ void done(const Unit&) const {}
};

__device__ __forceinline__ unsigned cvt_pk_bf16(float lo, float hi) { unsigned r; asm volatile("v_cvt_pk_bf16_f32 %0, %1, %2" : "=v"(r) : "v"(lo), "v"(hi)); return r; }
typedef float f32x2 __attribute__((ext_vector_type(2)));
template <class Epi, class Sched, bool ALIGN_EPI = false, bool SP2 = false>
__device__ __forceinline__ void gemm_phase(PG8_LAS unsigned char* lds, const Gemm g, const Sched& S, const Epi& E) {
    int tid_ = threadIdx.x; asm volatile("" : "+v"(tid_));
    const int tid = tid_, wid = __builtin_amdgcn_readfirstlane(tid >> 6), lane = tid & 63, wr = wid >> 2, wc = wid & 3, fr = lane & 15, fq = lane >> 4;
    const int K = g.K, nt = K / BK;
    unsigned voffA[2], voffB[2];
#pragma unroll
    for (int i = 0; i < 2; ++i) { int R, C; stage_rc(tid * 16 + i * 8192, R, C); const int Rb = Epi::PERM ? ((R & ~31) + perm32(R & 31)) : R;
        voffA[i] = (unsigned)(R * K + C) * 2u; voffB[i] = (unsigned)(Rb * K + C) * 2u; }
    const size_t kstep = (size_t)(BK * 2);
    const size_t hstep = (size_t)HALF * K * 2;
    const size_t tstep = 2 * hstep;
    const unsigned ldsw = (unsigned)wid * 1024u;
    const int aoff = lds_byte(wr * 64 + fr, fq * 8), boff = lds_byte(wc * 32 + fr, fq * 8);
#define PG8_SA(b, h) (((b) * 2 + (h)) * HTB)
#define PG8_SB(b, h) ((4 + (b) * 2 + (h)) * HTB)
#define PG8_STAGE(bufoff, gbase, voff) do { _Pragma("unroll") for (int _i = 0; _i < 2; ++_i) \
        __builtin_amdgcn_global_load_lds((const unsigned*)((const char*)(gbase) + (voff)[_i]), (PG8_LAS unsigned*)(lds + (bufoff) + ldsw + _i * 8192), 16, 0, 0); } while (0)
#define PG8_LDA(dst, b, h) do { _Pragma("unroll") for (int m = 0; m < 4; ++m) _Pragma("unroll") for (int k = 0; k < 2; ++k) dst[m][k] = *(const PG8_LAS bf16x8*)(lds + PG8_SA(b, h) + aoff + m * 2048 + k * 1024); } while (0)
#define PG8_LDB(dst, b, h) do { _Pragma("unroll") for (int n = 0; n < 2; ++n) _Pragma("unroll") for (int k = 0; k < 2; ++k) dst[n][k] = *(const PG8_LAS bf16x8*)(lds + PG8_SB(b, h) + boff + n * 2048 + k * 1024); } while (0)
#define PG8_MMA(ai, bj, At, Bt) do { __builtin_amdgcn_s_setprio(1); _Pragma("unroll") for (int m = 0; m < 4; ++m) _Pragma("unroll") for (int n = 0; n < 2; ++n) _Pragma("unroll") for (int k = 0; k < 2; ++k) \
        acc[ai][bj][m][n] = __builtin_amdgcn_mfma_f32_16x16x32_bf16(Bt[n][k], At[m][k], acc[ai][bj][m][n], 0, 0, 0); __builtin_amdgcn_s_setprio(0); } while (0)
#define PG8_WAIT_V(n) asm volatile("s_waitcnt vmcnt(" #n ")" ::: "memory")
#define PG8_WAIT_L(n) asm volatile("s_waitcnt lgkmcnt(" #n ")" ::: "memory")
#define PG8_BAR __builtin_amdgcn_s_barrier()
#define PG8_SCHED __builtin_amdgcn_sched_barrier(0)
    Unit cur, nxt; int ui = 0;
    if (!S.next(0, cur)) return;
    f32x4 acc[2][2][4][2];
#pragma unroll
    for (int a = 0; a < 2; ++a)
#pragma unroll
        for (int b = 0; b < 2; ++b)
#pragma unroll
            for (int m = 0; m < 4; ++m)
#pragma unroll
                for (int n = 0; n < 2; ++n) acc[a][b][m][n] = (f32x4){0.f, 0.f, 0.f, 0.f};
    bf16x8 At[4][2], B0[2][2], B1[2][2];
    const char* cA = (const char*)g.A + (size_t)cur.pm * tstep; const char* cB = (const char*)g.Bt + (size_t)cur.pn * tstep;
    S.a_ready(cur);
    if constexpr (SP2) {
        PG8_STAGE(PG8_SB(0, 0), cB, voffB); PG8_STAGE(PG8_SB(0, 1), cB + hstep, voffB); PG8_STAGE(PG8_SA(0, 0), cA, voffA); PG8_STAGE(PG8_SA(0, 1), cA + hstep, voffA);
        if (wr == 1) PG8_BAR;
        PG8_WAIT_V(2); PG8_BAR;
        PG8_STAGE(PG8_SB(1, 0), cB + kstep, voffB); PG8_STAGE(PG8_SA(1, 0), cA + kstep, voffA); PG8_STAGE(PG8_SB(1, 1), cB + hstep + kstep, voffB);
        PG8_WAIT_V(6); PG8_BAR;
    } else {
        PG8_STAGE(PG8_SB(0, 0), cB, voffB); PG8_STAGE(PG8_SA(0, 0), cA, voffA); PG8_STAGE(PG8_SB(0, 1), cB + hstep, voffB); PG8_STAGE(PG8_SA(0, 1), cA + hstep, voffA);
        if (wr == 1) PG8_BAR;
        PG8_WAIT_V(4); PG8_BAR;
        PG8_STAGE(PG8_SB(1, 0), cB + kstep, voffB); PG8_STAGE(PG8_SA(1, 0), cA + kstep, voffA); PG8_STAGE(PG8_SB(1, 1), cB + hstep + kstep, voffB);
        PG8_WAIT_V(6); PG8_BAR;
    }
    for (;;) {
        const bool has_next = S.next(ui + 1, nxt);
        const char* nA = has_next ? (const char*)g.A + (size_t)nxt.pm * tstep : cA; const char* nB = has_next ? (const char*)g.Bt + (size_t)nxt.pn * tstep : cB;
        for (int t = 0; t < nt; t += 2) {
            const bool last = (t == nt - 2);
            const char* a1 = cA + (size_t)(t + 1) * kstep;
            const char* a2 = last ? nA : cA + (size_t)(t + 2) * kstep; const char* b2 = last ? nB : cB + (size_t)(t + 2) * kstep;
            const char* a3 = a2 + kstep; const char* b3 = b2 + kstep;
            if (last && has_next) S.a_ready(nxt);
            if constexpr (SP2) {
            PG8_LDB(B0, 0, 0); PG8_LDB(B1, 0, 1); PG8_SCHED; PG8_LDA(At, 0, 0); PG8_STAGE(PG8_SA(1, 1), a1 + hstep, voffA);
            PG8_WAIT_V(8); PG8_WAIT_L(0); PG8_BAR; PG8_MMA(0, 0, At, B0); PG8_MMA(0, 1, At, B1); PG8_BAR; PG8_SCHED;
            PG8_LDA(At, 0, 1); PG8_STAGE(PG8_SB(0, 0), b2, voffB); PG8_STAGE(PG8_SB(0, 1), b2 + hstep, voffB); PG8_STAGE(PG8_SA(0, 0), a2, voffA);
            PG8_WAIT_V(8); PG8_WAIT_L(0); PG8_BAR; PG8_MMA(1, 0, At, B0); PG8_MMA(1, 1, At, B1); PG8_BAR; PG8_SCHED;
            PG8_LDB(B0, 1, 0); PG8_LDB(B1, 1, 1); PG8_SCHED; PG8_LDA(At, 1, 0); PG8_STAGE(PG8_SA(0, 1), a2 + hstep, voffA);
            PG8_WAIT_V(8); PG8_WAIT_L(0); PG8_BAR; PG8_MMA(0, 0, At, B0); PG8_MMA(0, 1, At, B1); PG8_BAR; PG8_SCHED;
            PG8_LDA(At, 1, 1); PG8_STAGE(PG8_SB(1, 0), b3, voffB); PG8_STAGE(PG8_SB(1, 1), b3 + hstep, voffB); PG8_STAGE(PG8_SA(1, 0), a3, voffA);
            PG8_WAIT_V(8); PG8_WAIT_L(0); PG8_BAR; PG8_MMA(1, 0, At, B0); PG8_MMA(1, 1, At, B1); PG8_BAR; PG8_SCHED;
            } else {
            PG8_LDB(B0, 0, 0); PG8_SCHED; PG8_LDA(At, 0, 0); PG8_STAGE(PG8_SA(1, 1), a1 + hstep, voffA);
            PG8_WAIT_L(8); PG8_BAR; PG8_WAIT_L(0); PG8_MMA(0, 0, At, B0); PG8_BAR; PG8_SCHED;
            PG8_LDB(B1, 0, 1); PG8_STAGE(PG8_SB(0, 0), b2, voffB);
            PG8_BAR; PG8_WAIT_L(0); PG8_MMA(0, 1, At, B1); PG8_BAR;
            PG8_LDA(At, 0, 1); PG8_STAGE(PG8_SA(0, 0), a2, voffA);
            PG8_BAR; PG8_WAIT_L(0); PG8_MMA(1, 0, At, B0); PG8_BAR; PG8_SCHED;
            PG8_STAGE(PG8_SB(0, 1), b2 + hstep, voffB);
            PG8_WAIT_V(6); PG8_BAR; PG8_MMA(1, 1, At, B1); PG8_BAR;
            PG8_LDB(B0, 1, 0); PG8_SCHED; PG8_LDA(At, 1, 0); PG8_STAGE(PG8_SA(0, 1), a2 + hstep, voffA);
            PG8_WAIT_L(8); PG8_BAR; PG8_WAIT_L(0); PG8_MMA(0, 0, At, B0); PG8_BAR; PG8_SCHED;
            PG8_LDB(B1, 1, 1); PG8_STAGE(PG8_SB(1, 0), b3, voffB);
            PG8_BAR; PG8_WAIT_L(0); PG8_MMA(0, 1, At, B1); PG8_BAR;
            PG8_LDA(At, 1, 1); PG8_STAGE(PG8_SA(1, 0), a3, voffA);
            PG8_BAR; PG8_WAIT_L(0); PG8_MMA(1, 0, At, B0); PG8_BAR; PG8_SCHED;
            PG8_STAGE(PG8_SB(1, 1), b3 + hstep, voffB);
            PG8_WAIT_V(6); PG8_BAR; PG8_MMA(1, 1, At, B1); PG8_BAR;
            }
        }
        if constexpr (ALIGN_EPI) { if (wr == 0) PG8_BAR; }
        if constexpr (!Epi::AFTER_DRAIN) { E(acc, cur, wr, wc, fr, fq); S.done(cur); }
        if (!has_next) break;
#pragma unroll
        for (int a = 0; a < 2; ++a)
#pragma unroll
            for (int b = 0; b < 2; ++b)
#pragma unroll
                for (int m = 0; m < 4; ++m)
#pragma unroll
                    for (int n = 0; n < 2; ++n) acc[a][b][m][n] = (f32x4){0.f, 0.f, 0.f, 0.f};
        cur = nxt; cA = nA; cB = nB; ++ui;
        if constexpr (ALIGN_EPI) { if (wr == 1) PG8_BAR; }
    }
    PG8_WAIT_V(0);
    if constexpr (!ALIGN_EPI) { if (wr == 0) PG8_BAR; }
    PG8_BAR;
    if constexpr (Epi::AFTER_DRAIN) { E.fused(acc, cur, wr, wc, fr, fq, lds, wid, lane); S.done(cur); }
#undef PG8_SA
#undef PG8_SB
#undef PG8_STAGE
#undef PG8_LDA
#undef PG8_LDB
#undef PG8_MMA
#undef PG8_WAIT_V
#undef PG8_WAIT_L
#undef PG8_BAR
#undef PG8_SCHED
}
}
#define GAS __attribute__((address_space(1)))
#define LAS __attribute__((address_space(3)))
typedef unsigned short bf16;
typedef unsigned v4u __attribute__((ext_vector_type(4)));
typedef unsigned v2u __attribute__((ext_vector_type(2)));
typedef float f32x4 __attribute__((ext_vector_type(4)));
typedef short bf16x8 __attribute__((ext_vector_type(8)));
#define LDS_WAIT() asm volatile("s_waitcnt lgkmcnt(0)" ::: "memory")
#define VM_WAIT() asm volatile("s_waitcnt vmcnt(0)" ::: "memory")

constexpr int DM = 2048, NB = 4, SEQ = 2048, NMETA = 16, MROWS = NB * SEQ, DPROJ = 6152, NPROJ = 6144;
constexpr int PADT = 2112, POS0 = 64, MPOS0 = 48;
constexpr float EPS = 1e-6f;
constexpr float LOG2E = 1.4426950408889634f;
constexpr float QSCALE = 0.08838834764831845f * LOG2E;
constexpr int NWAVES = 8, NTHR = 512;

constexpr size_t MiB = 1u << 20;
constexpr size_t WS_CTL = 0, CTL_ZERO_BYTES = 32 * 1024;
constexpr size_t WS_PM = 484 * MiB;
constexpr size_t WS_W1T = 2 * MiB, WS_W2T = 26 * MiB, WS_W3T = 34 * MiB, WS_XN = 42 * MiB;
constexpr size_t WS_Q = 74 * MiB, WS_KP = 90 * MiB, WS_VP = 107 * MiB, WS_MQ = 124 * MiB, WS_MK = 133 * MiB, WS_MV = 142 * MiB, WS_MO = 159 * MiB;
constexpr size_t WS_SMALL = 175 * MiB;
constexpr size_t WS_XM = WS_SMALL, WS_LI = WS_SMALL + 128 * 1024, WS_LF = WS_SMALL + 384 * 1024, WS_LAM = WS_SMALL + 640 * 1024;
constexpr size_t WS_PO = 176 * MiB, WS_ML = 304 * MiB, WS_HM = 305 * MiB, WS_A2 = 42 * MiB, WS_H1B = 74 * MiB, WS_SSQ = 106 * MiB, WS_S = 176 * MiB, WS_UB = 384 * MiB, WS_VB = 448 * MiB;
constexpr size_t WS_SCL = WS_SMALL + 704 * 1024;
constexpr size_t WS_VB8 = WS_UB + 32 * MiB;
constexpr size_t WS_DC = 305 * MiB, WS_CS = 448 * MiB, WS_DN = 482 * MiB, WS_NS = WS_DN + 512 * 1024, WS_GS = WS_DN + 1024 * 1024, WS_MS = WS_DN + 1152 * 1024;
constexpr size_t WS_EID = 240 * MiB, WS_EGT = 244 * MiB;
constexpr int CW_BAR = 4096;

constexpr int RING_OFF = 0, RING_BYTES = 131072;
constexpr int XCH_OFF = 131072;
constexpr int MISC_OFF = XCH_OFF + 8192;
constexpr int LDS_BYTES = 155648;

__device__ __forceinline__ unsigned f2bf(float f) { unsigned u = __builtin_bit_cast(unsigned, f); return (u + 0x7fffu + ((u >> 16) & 1u)) >> 16; }
__device__ __forceinline__ unsigned pk2(float lo, float hi) { return f2bf(lo) | (f2bf(hi) << 16); }
__device__ __forceinline__ float bf2f(unsigned short u) { return __builtin_bit_cast(float, (unsigned)u << 16); }
__device__ __forceinline__ float bflo(unsigned w) { return __builtin_bit_cast(float, w << 16); }
__device__ __forceinline__ float bfhi(unsigned w) { return __builtin_bit_cast(float, w & 0xffff0000u); }
__device__ __forceinline__ float wave_sum(float v) {
#pragma unroll
  for (int o = 1; o < 64; o <<= 1) v += __shfl_xor(v, o);
  return v;
}
__device__ __forceinline__ size_t kp_off(int bhm, int pos, int d) { const int j = pos >> 6, row = pos & 63, d0 = d >> 4, hi = (d >> 3) & 1;
  return ((size_t)(bhm * 33 + j) * 8 + d0) * 1024 + (size_t)((((row << 1) | hi) ^ ((row >> 3) & 1)) << 3) + (d & 7); }
__device__ __forceinline__ float wave_sum_dpp(float v) {
  v += __builtin_bit_cast(float, __builtin_amdgcn_update_dpp(0, __builtin_bit_cast(int, v), 0xB1, 0xF, 0xF, true));
  v += __builtin_bit_cast(float, __builtin_amdgcn_update_dpp(0, __builtin_bit_cast(int, v), 0x4E, 0xF, 0xF, true));
  v += __builtin_bit_cast(float, __builtin_amdgcn_update_dpp(0, __builtin_bit_cast(int, v), 0x141, 0xF, 0xF, true));
  v += __builtin_bit_cast(float, __builtin_amdgcn_update_dpp(0, __builtin_bit_cast(int, v), 0x140, 0xF, 0xF, true));
  const float r0 = __builtin_bit_cast(float, __builtin_amdgcn_readlane(__builtin_bit_cast(int, v), 0)), r1 = __builtin_bit_cast(float, __builtin_amdgcn_readlane(__builtin_bit_cast(int, v), 16));
  const float r2 = __builtin_bit_cast(float, __builtin_amdgcn_readlane(__builtin_bit_cast(int, v), 32)), r3 = __builtin_bit_cast(float, __builtin_amdgcn_readlane(__builtin_bit_cast(int, v), 48));
  return (r0 + r1) + (r2 + r3);
}
__device__ __forceinline__ float sigmoidf_(float x) { return 1.0f / (1.0f + __expf(-x)); }

#ifdef TPROBE
#ifndef TP_BLOCK
#define TP_BLOCK 0
#endif
#ifndef TP_DIV
#define TP_DIV 1.0f
#endif
#define TP_BEGIN(id) unsigned long long tp_t0_##id = 0; do { if (TPROBE == (id)) tp_t0_##id = __builtin_amdgcn_s_memrealtime(); } while (0)
#define TP_END(id, WS) do { if (TPROBE == (id)) { const unsigned long long t1_ = __builtin_amdgcn_s_memrealtime(); if ((int)blockIdx.x == TP_BLOCK && threadIdx.x == 0) atomicAdd((unsigned*)((WS) + 64), (unsigned)(t1_ - tp_t0_##id)); } } while (0)
#else
#define TP_BEGIN(id)
#define TP_END(id, WS)
#endif
#define XB_TMO      128
#define XB_XCNT(j)  (256  + 64 * (j))
#define XB_XSUB(j)  (1280 + 64 * (j))
#define XB_XGEN(j)  (2304 + 64 * (j))
#define XB_TOP      3328
#define XB_TOPGEN   3392
#define XCD_BAR_WORDS 3456
#define XB_SPIN_CAP (1u << 18)

__device__ __forceinline__ unsigned xb_ld(unsigned* p)              { return __hip_atomic_load(p, __ATOMIC_RELAXED, __HIP_MEMORY_SCOPE_AGENT); }
__device__ __forceinline__ unsigned xb_add(unsigned* p, unsigned v) { return __hip_atomic_fetch_add(p, v, __ATOMIC_RELAXED, __HIP_MEMORY_SCOPE_AGENT); }
__device__ __forceinline__ unsigned xb_xcc_id() { return (unsigned)__builtin_amdgcn_s_getreg((3 << 11) | 20) & 0xFu; }
#define XB_SPIN(cond, bar) do { unsigned _sp = 0; while (cond) { __builtin_amdgcn_s_sleep(1); \
    if ((++_sp & 255u) == 0u) { if (xb_ld(&(bar)[XB_TMO])) break; if (_sp > XB_SPIN_CAP) { atomicAdd(&(bar)[XB_TMO], 1u); break; } } } } while (0)

struct XcdBarrier {
    unsigned* bar; unsigned x;
    volatile LAS unsigned* st;
};

__device__ __forceinline__ XcdBarrier xcd_barrier_post(unsigned* bar, volatile LAS unsigned* st) {
    XcdBarrier b; b.bar = bar; b.x = xb_xcc_id(); b.st = st;
    if (threadIdx.x == 0) (void)xb_add(&bar[XB_XCNT(b.x)], 1u);
    return b;
}
__device__ __forceinline__ void xcd_barrier_complete(unsigned* bar, unsigned x, unsigned& nloc, unsigned& nx) {
    const unsigned G = gridDim.x * gridDim.y * gridDim.z;
    unsigned sum, cnt, mine, sp = 0u;
    for (;;) {
        sum = 0u; cnt = 0u; mine = 0u;
#pragma unroll
        for (unsigned j = 0; j < 16; ++j) { const unsigned c = xb_ld(&bar[XB_XCNT(j)]); sum += c; cnt += (c > 0u) ? 1u : 0u; mine = (j == x) ? c : mine; }
        if (sum == G) break;
        __builtin_amdgcn_s_sleep(1);
        if ((++sp & 255u) == 0u) { if (xb_ld(&bar[XB_TMO])) break; if (sp > XB_SPIN_CAP) { atomicAdd(&bar[XB_TMO], 1u); break; } }
    }
    nloc = mine > 0u ? mine : 1u; nx = cnt > 0u ? cnt : 1u;
}

__device__ __forceinline__ void xcd_barrier(const XcdBarrier& b) {
    asm volatile("s_waitcnt vmcnt(0)" ::: "memory");
    __syncthreads();
    if (threadIdx.x == 0) {
        unsigned* bar = b.bar;
        __builtin_amdgcn_s_waitcnt(0);
        unsigned nloc = b.st[0], nx = b.st[1];
        if (nloc == 0u) { xcd_barrier_complete(bar, b.x, nloc, nx); b.st[0] = nloc; b.st[1] = nx; }
        const unsigned old = xb_add(&bar[XB_XSUB(b.x)], 1u);
        const unsigned gen = old / nloc;
        if (old + 1u == (gen + 1u) * nloc) {
            __builtin_amdgcn_fence(__ATOMIC_RELEASE, "agent");
            asm volatile("s_waitcnt vmcnt(0)" ::: "memory");
            const unsigned og = xb_add(&bar[XB_TOP], 1u);
            const unsigned tg = og / nx;
            if (og + 1u == (tg + 1u) * nx) xb_add(&bar[XB_TOPGEN], 1u);
            else XB_SPIN(xb_ld(&bar[XB_TOPGEN]) == tg, bar);
            __builtin_amdgcn_fence(__ATOMIC_ACQUIRE, "agent");
            xb_add(&bar[XB_XGEN(b.x)], 1u);
            asm volatile("s_waitcnt vmcnt(0)" ::: "memory");
        } else {
            XB_SPIN(xb_ld(&bar[XB_XGEN(b.x)]) == gen, bar);
            __builtin_amdgcn_fence(__ATOMIC_ACQUIRE, "agent");
            asm volatile("s_waitcnt vmcnt(0)" ::: "memory");
        }
    }
    __syncthreads();
}

struct Args { const float* in[22]; float* out; unsigned char* ws; int ph_lo, ph_hi, na, pad; };
struct Frame {
  LAS unsigned char* lds; unsigned char* ws; int tid, lane, wave; const float* const* in;
};
#define IN_X 0
#define IN_META 1
#define IN_G1 2
#define IN_WIN 3
#define IN_CW 4
#define IN_CB 5
#define IN_IGB 6
#define IN_FGB 7
#define IN_LQ1 8
#define IN_LK1 9
#define IN_LQ2 10
#define IN_LK2 11
#define IN_QNG 12
#define IN_KNG 13
#define IN_SUBG 14
#define IN_OUTG 15
#define IN_WOUT 16
#define IN_G2 17
#define IN_WQ 18
#define IN_SUBK 19
#define IN_U 20
#define IN_V 21

__device__ __forceinline__ void p0_rows(const Frame& F, const Args& a) {
  const float* x = a.in[IN_X]; const float* meta = a.in[IN_META]; const float* g1 = a.in[IN_G1]; const float* w_in = a.in[IN_WIN];
  const float* igb = a.in[IN_IGB]; const float* fgb = a.in[IN_FGB];
  bf16* Xn = (bf16*)(F.ws + WS_XN); bf16* Xm = (bf16*)(F.ws + WS_XM); float* LI = (float*)(F.ws + WS_LI); float* LF = (float*)(F.ws + WS_LF);
  LAS f32x4* wgl = (LAS f32x4*)(F.lds);
  for (int e = F.tid; e < 4096; e += NTHR) {
    const int ln = e & 63, q = e >> 6, half = q & 1, j = (q >> 1) & 3, i = q >> 3;
    const int k = 4 * (i * 64 + ln) + j;
    wgl[e] = *(const f32x4*)(w_in + (size_t)k * DPROJ + NPROJ + 4 * half);
  }
  __syncthreads();
  const int gw = blockIdx.x * NWAVES + F.wave, NGW = gridDim.x * NWAVES, lane = F.lane;
  constexpr int NTASK = MROWS / 2 + NMETA / 2;
  f32x4 xnx[2][8];
  if (gw < NTASK) { const float* sn = (gw >= MROWS / 2 ? meta + (size_t)(gw - MROWS / 2) * 2 * DM : x + (size_t)gw * 2 * DM);
#pragma unroll
    for (int i = 0; i < 8; ++i) { xnx[0][i] = ((const f32x4*)sn)[i * 64 + lane]; xnx[1][i] = ((const f32x4*)(sn + DM))[i * 64 + lane]; } }
  for (int task = gw; task < NTASK; task += NGW) {
    const bool ismeta = task >= MROWS / 2;
    const int r0 = ismeta ? (task - MROWS / 2) * 2 : task * 2;
    f32x4 xv[2][8]; float rs[2];
    { float s0 = 0.f, s1 = 0.f;
#pragma unroll
      for (int i = 0; i < 8; ++i) { xv[0][i] = xnx[0][i]; xv[1][i] = xnx[1][i]; }
      { const int tn = task + NGW; if (tn < NTASK) { const float* sn = (tn >= MROWS / 2 ? meta + (size_t)(tn - MROWS / 2) * 2 * DM : x + (size_t)tn * 2 * DM);
#pragma unroll
          for (int i = 0; i < 8; ++i) { xnx[0][i] = ((const f32x4*)sn)[i * 64 + lane]; xnx[1][i] = ((const f32x4*)(sn + DM))[i * 64 + lane]; } } }
#pragma unroll
      for (int i = 0; i < 8; ++i) { const f32x4 a0 = xv[0][i], a1 = xv[1][i];
        s0 += (a0.x * a0.x + a0.y * a0.y) + (a0.z * a0.z + a0.w * a0.w); s1 += (a1.x * a1.x + a1.y * a1.y) + (a1.z * a1.z + a1.w * a1.w); }
      rs[0] = rsqrtf(wave_sum_dpp(s0) * (1.0f / DM) + EPS); rs[1] = rsqrtf(wave_sum_dpp(s1) * (1.0f / DM) + EPS); }
    float ga[2][8];
#pragma unroll
    for (int rr = 0; rr < 2; ++rr)
#pragma unroll
      for (int g = 0; g < 8; ++g) ga[rr][g] = 0.f;
    bf16* dst0 = (ismeta ? Xm : Xn) + (size_t)r0 * DM;
#pragma unroll
    for (int i = 0; i < 8; ++i) {
      const f32x4 g = ((const f32x4*)g1)[i * 64 + lane];
      f32x4 xn[2];
#pragma unroll
      for (int rr = 0; rr < 2; ++rr) { xn[rr] = xv[rr][i] * g * rs[rr];
        v2u o; o.x = pk2(xn[rr].x, xn[rr].y); o.y = pk2(xn[rr].z, xn[rr].w); ((v2u*)(dst0 + (size_t)rr * DM))[i * 64 + lane] = o; }
#pragma unroll
      for (int j = 0; j < 4; ++j) {
        const f32x4 w0 = wgl[((i * 4 + j) * 2 + 0) * 64 + lane], w1 = wgl[((i * 4 + j) * 2 + 1) * 64 + lane];
#pragma unroll
        for (int rr = 0; rr < 2; ++rr) { const float xs_ = xn[rr][j];
          ga[rr][0] += xs_ * w0.x; ga[rr][1] += xs_ * w0.y; ga[rr][2] += xs_ * w0.z; ga[rr][3] += xs_ * w0.w;
          ga[rr][4] += xs_ * w1.x; ga[rr][5] += xs_ * w1.y; ga[rr][6] += xs_ * w1.z; ga[rr][7] += xs_ * w1.w; }
      }
      __builtin_amdgcn_sched_barrier(0);
    }
#pragma unroll
    for (int rr = 0; rr < 2; ++rr)
#pragma unroll
      for (int g = 0; g < 8; ++g) ga[rr][g] = wave_sum_dpp(ga[rr][g]);
    if (lane < 8) {
      const int rr = lane >> 2, h = lane & 3;
      float gi = 0.f, gf = 0.f;
#pragma unroll
      for (int q = 0; q < 2; ++q)
#pragma unroll
        for (int hh = 0; hh < 4; ++hh) if (q == rr && hh == h) { gi = ga[q][hh]; gf = ga[q][4 + hh]; }
      const float li = gi + igb[h]; const float fx = gf + fgb[h];
      const float lf = fminf(fx, 0.f) - log1pf(__expf(-fabsf(fx)));
      const int R = r0 + rr;
      if (!ismeta) { const int b = R >> 11, t = R & 2047; LI[(b * 4 + h) * PADT + POS0 + t] = li; LF[(b * 4 + h) * PADT + POS0 + t] = lf; }
      else { for (int b = 0; b < NB; ++b) { LI[(b * 4 + h) * PADT + MPOS0 + R] = li; LF[(b * 4 + h) * PADT + MPOS0 + R] = lf; } }
    }
  }
  __syncthreads();
}
template <bool META>
__device__ __forceinline__ void p0_transpose(const Frame& F, const Args& a, const float* W, int ldw, int N, bf16* Wt) {
  LAS float* tl = (LAS float*)(F.lds);
  LAS float* red = (LAS float*)(F.lds + 33792);
  float* PM = (float*)(F.ws + WS_PM);
  const float* meta = a.in[IN_META]; const float* g1 = a.in[IN_G1];
  const int ntn = N / 64, ntask = ntn * 16, fr = F.lane & 15, fq = F.lane >> 4, w = F.wave;
  f32x4 wn[4];
  float am[4], ag[4];
  if ((int)blockIdx.x < ntask) { const int nb = blockIdx.x % ntn, kb = blockIdx.x / ntn;
#pragma unroll
    for (int i = 0; i < 4; ++i) { const int idx = F.tid + NTHR * i, kk = idx >> 4, c4 = idx & 15; wn[i] = *(const f32x4*)(W + (size_t)(kb * 128 + kk) * ldw + nb * 64 + 4 * c4); }
    if (META) {
#pragma unroll
      for (int s_ = 0; s_ < 4; ++s_) { const int k = kb * 128 + 16 * w + 4 * s_ + fq; am[s_] = meta[(size_t)fr * DM + k]; ag[s_] = g1[k]; } } }
  for (int task = blockIdx.x; task < ntask; task += gridDim.x) {
    const int nb = task % ntn, kb = task / ntn, n0 = nb * 64, k0 = kb * 128;
    __syncthreads();
#pragma unroll
    for (int i = 0; i < 4; ++i) { const int idx = F.tid + NTHR * i, kk = idx >> 4, c4 = idx & 15; const f32x4 wv = wn[i];
      LAS float* d = tl + kk * 65 + 4 * c4; d[0] = wv.x; d[1] = wv.y; d[2] = wv.z; d[3] = wv.w; }
    float ac[4];
    if (META) {
#pragma unroll
      for (int s_ = 0; s_ < 4; ++s_) ac[s_] = am[s_] * ag[s_]; }
    { const int tn = task + gridDim.x; if (tn < ntask) { const int nb2 = tn % ntn, kb2 = tn / ntn;
#pragma unroll
        for (int i = 0; i < 4; ++i) { const int idx = F.tid + NTHR * i, kk = idx >> 4, c4 = idx & 15; wn[i] = *(const f32x4*)(W + (size_t)(kb2 * 128 + kk) * ldw + nb2 * 64 + 4 * c4); }
        if (META) {
#pragma unroll
          for (int s_ = 0; s_ < 4; ++s_) { const int k = kb2 * 128 + 16 * w + 4 * s_ + fq; am[s_] = meta[(size_t)fr * DM + k]; ag[s_] = g1[k]; } } } }
    __syncthreads();
    const int n = F.tid >> 3, kc = F.tid & 7;
    const LAS float* s = tl + (kc * 16) * 65 + n;
    v4u o0, o1;
    o0.x = pk2(s[0 * 65], s[1 * 65]); o0.y = pk2(s[2 * 65], s[3 * 65]); o0.z = pk2(s[4 * 65], s[5 * 65]); o0.w = pk2(s[6 * 65], s[7 * 65]);
    o1.x = pk2(s[8 * 65], s[9 * 65]); o1.y = pk2(s[10 * 65], s[11 * 65]); o1.z = pk2(s[12 * 65], s[13 * 65]); o1.w = pk2(s[14 * 65], s[15 * 65]);
    v4u* dp = (v4u*)(Wt + (size_t)(n0 + n) * DM + k0 + kc * 16);
    dp[0] = o0; dp[1] = o1;
    if (META && n0 >= 1024) {
      f32x4 acc[4];
#pragma unroll
      for (int nt = 0; nt < 4; ++nt) acc[nt] = (f32x4){0.f, 0.f, 0.f, 0.f};
#pragma unroll
      for (int s_ = 0; s_ < 4; ++s_)
#pragma unroll
        for (int nt = 0; nt < 4; ++nt) acc[nt] = __builtin_amdgcn_mfma_f32_16x16x4f32(ac[s_], tl[(16 * w + 4 * s_ + fq) * 65 + nt * 16 + fr], acc[nt], 0, 0, 0);
#pragma unroll
      for (int nt = 0; nt < 4; ++nt)
#pragma unroll
        for (int i = 0; i < 4; ++i) red[(w * 16 + 4 * fq + i) * 64 + nt * 16 + fr] = acc[nt][i];
      __syncthreads();
#pragma unroll
      for (int j = 0; j < 2; ++j) { const int idx = F.tid + NTHR * j, m = idx >> 6, nn = idx & 63; const LAS float* r = red + m * 64 + nn;
        PM[((size_t)kb * 16 + m) * NPROJ + n0 + nn] = ((r[0] + r[1024]) + (r[2048] + r[3072])) + ((r[4096] + r[5120]) + (r[6144] + r[7168])); }
    }
  }
  __syncthreads();
}
__device__ __forceinline__ void p0_zero_vpad(const Frame& F) {
  bf16* Vp = (bf16*)(F.ws + WS_VP);
  const int per = MPOS0 * 256 / 8;
  for (int i = blockIdx.x * NTHR + F.tid; i < 16 * per; i += gridDim.x * NTHR) { const int bh = i / per, e = i % per;
    *(v4u*)(Vp + (size_t)bh * PADT * 256 + (size_t)e * 8) = (v4u){0u, 0u, 0u, 0u}; }
}
__device__ __forceinline__ void p0_lam(const Frame& F, const Args& a) {
  if (blockIdx.x == 0 && F.wave == 0) {
    const int l = F.lane;
    float s1 = a.in[IN_LQ1][l] * a.in[IN_LK1][l] + a.in[IN_LQ1][l + 64] * a.in[IN_LK1][l + 64];
    float s2 = a.in[IN_LQ2][l] * a.in[IN_LK2][l] + a.in[IN_LQ2][l + 64] * a.in[IN_LK2][l + 64];
    s1 = wave_sum(s1); s2 = wave_sum(s2);
    if (l == 0) *(float*)(F.ws + WS_LAM) = __expf(s1) - __expf(s2) + 0.2f;
  }
}

struct EpiProj {
  static constexpr bool PERM = true, AFTER_DRAIN = false;
  bf16 *Qb, *Kp, *Vp, *MQ, *MK, *MV, *MO; const float *qg, *kg; LAS float* xch;
  __device__ __forceinline__ void operator()(const pg8::f32x4 (&acc)[2][2][4][2], const pg8::Unit& u, int wr, int wc, int fr, int fq) const {
    const int pn = u.pn, b = u.pm >> 3, tb = (u.pm & 7) * 256 + wr * 64 + fr, d0 = wc * 32 + fq * 8;
    if (pn < 8) {
      const bool isk = pn >= 4; const int h = pn & 3;
      float ssq[2][4][2];
#pragma unroll
      for (int ai = 0; ai < 2; ++ai)
#pragma unroll
        for (int m = 0; m < 4; ++m)
#pragma unroll
          for (int bj = 0; bj < 2; ++bj) { float s = 0.f;
#pragma unroll
            for (int n = 0; n < 2; ++n) { const pg8::f32x4 x = acc[ai][bj][m][n]; s += (x[0] * x[0] + x[1] * x[1]) + (x[2] * x[2] + x[3] * x[3]); }
            s += __shfl_xor(s, 16); s += __shfl_xor(s, 32); ssq[ai][m][bj] = s;
            if (fq == 0) xch[((ai * 128 + wr * 64 + m * 16 + fr) * 2 + bj) * 4 + wc] = s; }
      asm volatile("s_waitcnt lgkmcnt(0)" ::: "memory"); __builtin_amdgcn_s_barrier(); asm volatile("" ::: "memory");
      const float* gp = (isk ? kg : qg) + d0; const f32x4 g0 = *(const f32x4*)gp, g1v = *(const f32x4*)(gp + 4);
      const float sc = isk ? 1.0f : QSCALE;
#pragma unroll
      for (int ai = 0; ai < 2; ++ai)
#pragma unroll
        for (int m = 0; m < 4; ++m)
#pragma unroll
          for (int bj = 0; bj < 2; ++bj) {
            const f32x4 p = *(const LAS f32x4*)(xch + ((ai * 128 + wr * 64 + m * 16 + fr) * 2 + bj) * 4);
            const float rs = rsqrtf(((p.x + p.y) + (p.z + p.w)) * (1.0f / 128.f) + EPS) * sc;
            const pg8::f32x4 v0 = acc[ai][bj][m][0], v1 = acc[ai][bj][m][1];
            v4u w; w.x = pk2(v0[0] * rs * g0.x, v0[1] * rs * g0.y); w.y = pk2(v0[2] * rs * g0.z, v0[3] * rs * g0.w);
            w.z = pk2(v1[0] * rs * g1v.x, v1[1] * rs * g1v.y); w.w = pk2(v1[2] * rs * g1v.z, v1[3] * rs * g1v.w);
            const int t = tb + ai * 128 + m * 16;
            bf16* dst = isk ? Kp + kp_off((b * 4 + h) * 2 + bj, POS0 + t, d0)
                            : Qb + ((size_t)((b * 4 + h) * 2 + bj) * SEQ + t) * 128 + d0;
            *(v4u*)dst = w; }
      return;
    }
#pragma unroll
    for (int ai = 0; ai < 2; ++ai)
#pragma unroll
      for (int m = 0; m < 4; ++m)
#pragma unroll
        for (int bj = 0; bj < 2; ++bj) {
          pg8::f32x4 v0 = acc[ai][bj][m][0], v1 = acc[ai][bj][m][1];
          const int t = tb + ai * 128 + m * 16;
          bf16* dst;
          if (pn < 12) { const int h = pn - 8; dst = Vp + ((size_t)(b * 4 + h) * PADT + POS0 + t) * 256 + bj * 128 + d0; }
          else if (pn < 16) { const int h = 2 * (pn & 1) + bj; dst = (pn >= 14 ? MK : MQ) + ((size_t)(b * 4 + h) * PADT + POS0 + t) * 128 + d0; }
          else if (pn < 20) { const int h = pn - 16; dst = MV + ((size_t)(b * 4 + h) * PADT + POS0 + t) * 256 + bj * 128 + d0; }
          else dst = MO + (size_t)(b * SEQ + t) * 1024 + (pn - 20) * 256 + bj * 128 + d0;
          v4u w; w.x = pk2(v0[0], v0[1]); w.y = pk2(v0[2], v0[3]); w.z = pk2(v1[0], v1[1]); w.w = pk2(v1[2], v1[3]);
          *(v4u*)dst = w; }
  }
};
__device__ __forceinline__ void p1_meta_finalize(const Frame& F, const Args& a) {
  if (blockIdx.x >= NMETA) return;
  const int mrow = blockIdx.x, tid = F.tid, lane = F.lane, w = F.wave;
  const float* meta = a.in[IN_META] + (size_t)mrow * DM; const float* PM0 = (const float*)(F.ws + WS_PM) + (size_t)mrow * NPROJ;
#define PM_P4(i, p) ((PM0[(size_t)(16 * (p)) * NPROJ + (i)] + PM0[(size_t)(16 * ((p) + 1)) * NPROJ + (i)]) + (PM0[(size_t)(16 * ((p) + 2)) * NPROJ + (i)] + PM0[(size_t)(16 * ((p) + 3)) * NPROJ + (i)]))
#define PM_AT(i) ((PM_P4(i, 0) + PM_P4(i, 4)) + (PM_P4(i, 8) + PM_P4(i, 12)))
  LAS float* red = (LAS float*)(F.lds + XCH_OFF);
  const f32x4 mv = ((const f32x4*)meta)[tid];
  float s = wave_sum((mv.x * mv.x + mv.y * mv.y) + (mv.z * mv.z + mv.w * mv.w));
  if (lane == 0) red[w] = s;
  __syncthreads();
  float tot = 0.f;
#pragma unroll
  for (int i = 0; i < 8; ++i) tot += red[i];
  const float rs = rsqrtf(tot * (1.0f / DM) + EPS);
  bf16* Kp = (bf16*)(F.ws + WS_KP); bf16* Vp = (bf16*)(F.ws + WS_VP); bf16* MQ = (bf16*)(F.ws + WS_MQ); bf16* MK = (bf16*)(F.ws + WS_MK); bf16* MV = (bf16*)(F.ws + WS_MV);
  const int pos = MPOS0 + mrow;
  {
    const float v0 = PM_AT(1024 + w * 128 + lane) * rs, v1 = PM_AT(1024 + w * 128 + lane + 64) * rs;
    const float rk = rsqrtf(wave_sum(v0 * v0 + v1 * v1) * (1.0f / 128.f) + EPS);
    const float* kg = a.in[IN_KNG];
    const unsigned short o0 = (unsigned short)f2bf(v0 * rk * kg[lane]), o1 = (unsigned short)f2bf(v1 * rk * kg[lane + 64]);
    for (int b = 0; b < NB; ++b) { const int bhm = (b * 4 + (w >> 1)) * 2 + (w & 1); Kp[kp_off(bhm, pos, lane)] = o0; Kp[kp_off(bhm, pos, lane + 64)] = o1; }
  }
  { const int c = tid * 2;
    const unsigned o = pk2(PM_AT(2048 + c) * rs, PM_AT(2048 + c + 1) * rs); const int h = c >> 8, e = c & 255;
    for (int b = 0; b < NB; ++b) *(unsigned*)(Vp + ((size_t)(b * 4 + h) * PADT + pos) * 256 + e) = o;
    const unsigned o2 = pk2(PM_AT(3072 + c) * rs, PM_AT(3072 + c + 1) * rs); const bool isk = c >= 512; const int cc = c & 511, hq = cc >> 7, d = cc & 127;
    for (int b = 0; b < NB; ++b) *(unsigned*)((isk ? MK : MQ) + ((size_t)(b * 4 + hq) * PADT + pos) * 128 + d) = o2;
    const unsigned o3 = pk2(PM_AT(4096 + c) * rs, PM_AT(4096 + c + 1) * rs);
    for (int b = 0; b < NB; ++b) *(unsigned*)(MV + ((size_t)(b * 4 + h) * PADT + pos) * 256 + e) = o3;
  }
  __syncthreads();
}
#undef PM_AT
#undef PM_P4

namespace att {
using f32x16 = __attribute__((ext_vector_type(16))) float;
using s16x4 = __attribute__((ext_vector_type(4))) short;
constexpr int STEPS_BHM = 152, NSTEPS = 32 * STEPS_BHM;
constexpr int SHM_V = 64 * 256 * 2, SHM_K = 64 * 128 * 2;
constexpr int LDS_V = 0, LDS_K = 2 * SHM_V, LDS_Q = LDS_K + SHM_K, LDS_WS = LDS_Q + 8 * 8192;
constexpr float THR2 = 8.0f;
#define KSWZ(row, colB) ((row) * 256 + ((colB) ^ (((row) & 7) << 4)))
#define SBAR() __builtin_amdgcn_sched_barrier(0)
__device__ __forceinline__ int crow(int r, int hi) { return (r & 3) + 8 * (r >> 2) + 4 * hi; }
__device__ __forceinline__ unsigned cvtpk(float lo, float hi) { unsigned r; asm volatile("v_cvt_pk_bf16_f32 %0, %1, %2" : "=v"(r) : "v"(lo), "v"(hi)); return r; }
__device__ __forceinline__ int qb_start(int qb) { return 2 * qb * qb + 3 * qb; }
__device__ __forceinline__ int chunk_of(int s, int NA) { return ((s + 1) * NA - 1) / NSTEPS; }

template <int OFF> __device__ __forceinline__ s16x4 tr_read(int vb) {
  s16x4 r; asm volatile("ds_read_b64_tr_b16 %0, %1 offset:%2" : "=&v"(r) : "v"(vb), "i"(OFF) : "memory"); return r;
}
constexpr int v_rd_off(int d0, int ks, int half) { return d0 * 512 + ks * 8192 + half * 4096; }
template <int D0> __device__ __forceinline__ void pv_one(f32x16& od, int vb, bf16x8 pa0, bf16x8 pa1, bf16x8 pa2, bf16x8 pa3) {
#define PK(L, H) (bf16x8){L[0], L[1], L[2], L[3], H[0], H[1], H[2], H[3]}
  { const s16x4 l0 = tr_read<v_rd_off(D0, 0, 0)>(vb), h0 = tr_read<v_rd_off(D0, 0, 1)>(vb), l1 = tr_read<v_rd_off(D0, 1, 0)>(vb), h1 = tr_read<v_rd_off(D0, 1, 1)>(vb);
    asm volatile("s_waitcnt lgkmcnt(0)" ::: "memory"); SBAR();
    od = __builtin_amdgcn_mfma_f32_32x32x16_bf16(pa0, PK(l0, h0), od, 0, 0, 0);
    od = __builtin_amdgcn_mfma_f32_32x32x16_bf16(pa1, PK(l1, h1), od, 0, 0, 0); }
  SBAR();
  { const s16x4 l2 = tr_read<v_rd_off(D0, 2, 0)>(vb), h2 = tr_read<v_rd_off(D0, 2, 1)>(vb), l3 = tr_read<v_rd_off(D0, 3, 0)>(vb), h3 = tr_read<v_rd_off(D0, 3, 1)>(vb);
    asm volatile("s_waitcnt lgkmcnt(0)" ::: "memory"); SBAR();
    od = __builtin_amdgcn_mfma_f32_32x32x16_bf16(pa2, PK(l2, h2), od, 0, 0, 0);
    od = __builtin_amdgcn_mfma_f32_32x32x16_bf16(pa3, PK(l3, h3), od, 0, 0, 0); }
#undef PK
}

__device__ __forceinline__ void segment(const Frame& F, int bhm, int qb, int j0, int j1, int slot) {
  const int tid = F.tid, wid = F.wave, lane = F.lane, r32 = lane & 31, hi = lane >> 5;
  const bf16* Qg = (const bf16*)(F.ws + WS_Q) + ((size_t)bhm * SEQ + qb * 256 + wid * 32 + r32) * 128 + hi * 8;
  const bf16* Kg = (const bf16*)(F.ws + WS_KP) + (size_t)bhm * 33 * 8192;
  const bf16* Vg = (const bf16*)(F.ws + WS_VP) + (size_t)(bhm >> 1) * PADT * 256;
  LAS unsigned char* lds = F.lds;
  LAS float* wsl = (LAS float*)(lds + LDS_WS) + wid * 64;
  const float slope2 = exp2f(-2.0f * (float)(((bhm >> 1) & 3) + 1)) * LOG2E;
  unsigned ksrc0, vsrc0;
  ksrc0 = (unsigned)tid * 16u;
  { const int a8 = tid >> 8, b = (tid >> 2) & 7, k = 8 * (b >> 2) + 4 * a8 + (b & 3), c = ((tid >> 5) & 7) * 32 + (tid & 3) * 8; vsrc0 = (unsigned)(k * 256 + c) * 2u; }
#define STAGE_K(j) do { const char* kt = (const char*)(Kg + (size_t)(j) * 8192); \
    _Pragma("unroll") for (int _i = 0; _i < 2; ++_i) __builtin_amdgcn_global_load_lds((const unsigned*)(kt + (ksrc0 + _i * 8192u)), (LAS unsigned*)(lds + LDS_K + _i * 8192 + wid * 1024), 16, 0, 0); } while (0)
#define STAGE_V(buf, j) do { const char* vt = (const char*)(Vg + (size_t)(j) * 64 * 256); \
    _Pragma("unroll") for (int _i = 0; _i < 4; ++_i) __builtin_amdgcn_global_load_lds((const unsigned*)(vt + (vsrc0 + _i * 8192u)), (LAS unsigned*)(lds + LDS_V + (buf) * SHM_V + _i * 8192 + wid * 1024), 16, 0, 0); } while (0)
  const int lt = (((r32 << 1) | hi) ^ ((r32 >> 3) & 1)) << 4;
  LAS unsigned char* Qs = lds + LDS_Q + wid * 8192;
#pragma unroll
  for (int d0 = 0; d0 < 8; ++d0) { const bf16x8 qv = *(const bf16x8*)(Qg + d0 * 16); *(LAS bf16x8*)(Qs + d0 * 1024 + lt) = qv; }
  f32x16 o[8];
#pragma unroll
  for (int d = 0; d < 8; ++d)
#pragma unroll
    for (int r = 0; r < 16; ++r) o[d][r] = 0.f;
  float m_reg = -1e30f, l_reg = 0.f;
  const int vb0 = (int)(uintptr_t)(lds + LDS_V) + (((lane & 3) << 3) | (((lane >> 2) & 3) << 6) | (((lane >> 4) & 1) << 5) | (((lane >> 5) & 1) << 8));
  STAGE_K(j0); STAGE_V(0, j0);
  VM_WAIT(); __syncthreads();
  for (int j = j0; j < j1; ++j) {
    const int cur = (j - j0) & 1;
    if (j + 1 < j1) STAGE_V(cur ^ 1, j + 1);
    SBAR();
    f32x16 p0 = {}, p1 = {};
    { const LAS unsigned char* Ks = lds + LDS_K;
#pragma unroll
      for (int d0 = 0; d0 < 8; ++d0) {
        const bf16x8 b0 = *(const LAS bf16x8*)(Ks + d0 * 2048 + lt);
        const bf16x8 b1 = *(const LAS bf16x8*)(Ks + d0 * 2048 + 1024 + lt);
        const bf16x8 qf = *(const LAS bf16x8*)(Qs + d0 * 1024 + lt);
        p0 = __builtin_amdgcn_mfma_f32_32x32x16_bf16(b0, qf, p0, 0, 0, 0);
        p1 = __builtin_amdgcn_mfma_f32_32x32x16_bf16(b1, qf, p1, 0, 0, 0); } }
    asm volatile("s_waitcnt lgkmcnt(0)" ::: "memory"); __builtin_amdgcn_s_barrier(); asm volatile("" ::: "memory");
    if (j + 1 < j1) STAGE_K(j + 1);
    SBAR();
    if (j == 0) {
#pragma unroll
      for (int r = 0; r < 16; ++r) p0[r] = -INFINITY;
#pragma unroll
      for (int r = 0; r < 8; ++r) p1[r] = -INFINITY;
    }
    int ln2 = threadIdx.x & 63; asm volatile("" : "+v"(ln2));
    const int hi2 = ln2 >> 5;
    const int jb = j - (4 * qb + 1);
    if (jb >= 0) {
      const int kb = 64 * jb + 4 * hi2, qrel = wid * 32 + (ln2 & 31);
#pragma unroll
      for (int r = 0; r < 16; ++r) { const int kv = kb + (r & 3) + 8 * (r >> 2); if (kv > qrel) p0[r] = -INFINITY; if (kv + 32 > qrel) p1[r] = -INFINITY; }
    }
    const float off0 = slope2 * (float)(64 * j + 4 * hi2), off1 = off0 + 32.0f * slope2;
#pragma unroll
    for (int r = 0; r < 16; ++r) { const float sb = slope2 * (float)((r & 3) + 8 * (r >> 2)); p0[r] += sb; p1[r] += sb; }
    float pm0 = p0[0], pm1 = p1[0];
#pragma unroll
    for (int r = 1; r < 16; ++r) { pm0 = fmaxf(pm0, p0[r]); pm1 = fmaxf(pm1, p1[r]); }
    float pmax = fmaxf(pm0 + off0, pm1 + off1);
    { auto rr = __builtin_amdgcn_permlane32_swap(__float_as_uint(pmax), __float_as_uint(pmax), false, false);
      pmax = fmaxf(__uint_as_float(rr[0]), __uint_as_float(rr[1])); }
    float mn, alpha;
    if (__builtin_expect(__all(pmax - m_reg <= THR2), 1)) { mn = m_reg; alpha = 1.f; }
    else { mn = fmaxf(m_reg, pmax); alpha = __builtin_amdgcn_exp2f(m_reg - mn); m_reg = mn; }
    const float c0 = off0 - mn, c1 = off1 - mn;
    float ps = 0.f;
#pragma unroll
    for (int r = 0; r < 16; ++r) { p0[r] = __builtin_amdgcn_exp2f(p0[r] + c0); p1[r] = __builtin_amdgcn_exp2f(p1[r] + c1); ps += p0[r] + p1[r]; }
    { auto rr = __builtin_amdgcn_permlane32_swap(__float_as_uint(ps), __float_as_uint(ps), false, false);
      ps = __uint_as_float(rr[0]) + __uint_as_float(rr[1]); }
    l_reg = l_reg * alpha + ps;
    if (__any(alpha < 1.f)) { if (hi == 0) wsl[r32] = alpha; asm volatile("s_waitcnt lgkmcnt(0)" ::: "memory");
#pragma unroll
      for (int rg = 0; rg < 4; ++rg) { const f32x4 al = *(const LAS f32x4*)(wsl + 8 * rg + 4 * hi);
#pragma unroll
        for (int d = 0; d < 8; ++d) { o[d][4 * rg + 0] *= al.x; o[d][4 * rg + 1] *= al.y; o[d][4 * rg + 2] *= al.z; o[d][4 * rg + 3] *= al.w; }
        SBAR(); } }
    bf16x8 pa0, pa1, pa2, pa3;
#define PK4(P, BASE, OUT) do { unsigned a0 = cvtpk(P[BASE + 0], P[BASE + 1]), a1 = cvtpk(P[BASE + 2], P[BASE + 3]);   \
    unsigned b0 = cvtpk(P[BASE + 4], P[BASE + 5]), b1 = cvtpk(P[BASE + 6], P[BASE + 7]);                              \
    auto r0 = __builtin_amdgcn_permlane32_swap(a0, b0, false, false); auto r1 = __builtin_amdgcn_permlane32_swap(a1, b1, false, false); \
    v4u w = {r0[0], r1[0], r0[1], r1[1]}; OUT = *reinterpret_cast<bf16x8*>(&w); } while (0)
    PK4(p0, 0, pa0); PK4(p0, 8, pa1); PK4(p1, 0, pa2); PK4(p1, 8, pa3);
#undef PK4
    SBAR();
    { const int vb = vb0 + cur * SHM_V;
      pv_one<0>(o[0], vb, pa0, pa1, pa2, pa3); pv_one<1>(o[1], vb, pa0, pa1, pa2, pa3); pv_one<2>(o[2], vb, pa0, pa1, pa2, pa3); pv_one<3>(o[3], vb, pa0, pa1, pa2, pa3);
      pv_one<4>(o[4], vb, pa0, pa1, pa2, pa3); pv_one<5>(o[5], vb, pa0, pa1, pa2, pa3); pv_one<6>(o[6], vb, pa0, pa1, pa2, pa3); pv_one<7>(o[7], vb, pa0, pa1, pa2, pa3); }
    VM_WAIT(); __syncthreads();
  }
  { int lane2 = threadIdx.x & 63, slot2 = slot; asm volatile("" : "+v"(lane2), "+s"(slot2));
    const int r32e = lane2 & 31, hie = lane2 >> 5;
    bf16* PO = (bf16*)(F.ws + WS_PO) + (size_t)slot2 * 256 * 256; float* ML = (float*)(F.ws + WS_ML) + (size_t)slot2 * 512;
    LAS float* wse = (LAS float*)(F.lds + LDS_WS) + wid * 64;
    if (hie == 0) { wse[r32e] = l_reg; ML[(wid * 32 + r32e) * 2] = m_reg; ML[(wid * 32 + r32e) * 2 + 1] = l_reg; }
    asm volatile("s_waitcnt lgkmcnt(0)" ::: "memory");
    char* Ob = (char*)(PO + (size_t)(wid * 32) * 256);
    const bool odd = (r32e & 1) != 0;
    const unsigned lo = (unsigned)(4 * hie * 256 + (r32e & ~1) + (odd ? 32 : 0)) * 2u;
#pragma unroll
    for (int r = 0; r < 16; ++r) { const int rowc = (r & 3) + 8 * (r >> 2); const float lv = wse[rowc + 4 * hie]; const float rl = lv > 0.f ? __builtin_amdgcn_rcpf(lv) : 0.f;
#pragma unroll
      for (int dp = 0; dp < 4; ++dp) { const float va = o[2 * dp][r] * rl, vb = o[2 * dp + 1][r] * rl;
        const float send = odd ? va : vb, keep = odd ? vb : va;
        const float recv = __builtin_bit_cast(float, __builtin_amdgcn_update_dpp(0, __builtin_bit_cast(int, send), 0xB1, 0xF, 0xF, true));
        *(unsigned*)(Ob + (lo + (unsigned)(rowc * 256 + dp * 64) * 2u)) = odd ? pk2(recv, keep) : pk2(keep, recv); }
      SBAR(); } }
  __syncthreads();
#undef STAGE_K
#undef STAGE_V
}

__device__ __forceinline__ void phase(const Frame& F, int ca, int NA) {
  int s0 = (int)(((long)ca * NSTEPS) / NA); const int s1 = (int)(((long)(ca + 1) * NSTEPS) / NA);
  while (s0 < s1) {
    const int bhm = s0 / STEPS_BHM, rem = s0 - bhm * STEPS_BHM;
    int qb = 0;
#pragma unroll 1
    for (int q = 1; q < 8; ++q) if (rem >= qb_start(q)) qb = q;
    const int j0 = rem - qb_start(qb), nst = 4 * qb + 5;
    const int j1 = (j0 + (s1 - s0) < nst) ? j0 + (s1 - s0) : nst;
    const int slot = bhm * 16 + qb + chunk_of(s0, NA) - chunk_of(bhm * STEPS_BHM, NA);
    segment(F, bhm, qb, j0, j1, slot);
    s0 += j1 - j0;
  }
}
#undef KSWZ
#undef SBAR
}
namespace ml {
constexpr int QST = 136, TST = 72;
constexpr int L_RQ = 0, L_RK = 17152, L_QS = 34304, L_QW = 51712, L_KS = 69120, L_KWT = 86528, L_VT = 104960  , L_SP = 0  , L_G = 141824, L_CW = 143872;
constexpr int L_HT = 0;
constexpr int G_A = 0, G_M = 64, G_WI = 128, G_EM = 192, G_DEN = 256, G_WG = 320, G_SC = 384, G_N = 0;
constexpr int L_NV = L_CW + 5120;
constexpr int L_SSQ = L_KWT;
__device__ __forceinline__ float shfl_up_f(float v, int d) { return __shfl_up(v, d); }

struct StageCW { float v[3]; };
__device__ __forceinline__ void issue_cw(const Frame& F, const Args& a, int h, StageCW& st) {
#pragma unroll
  for (int i = 0; i < 3; ++i) { const int e = F.tid + NTHR * i; st.v[i] = 0.f;
    if (e < 2 * 5 * 128) { const int qk = e / 640, j = (e / 128) % 5, d = e & 127; const int ch = qk * 512 + h * 128 + d; st.v[i] = j < 4 ? a.in[IN_CW][j * 1024 + ch] : a.in[IN_CB][ch]; } }
}
__device__ __forceinline__ void commit_cw(const Frame& F, const StageCW& st) {
  LAS float* CW = (LAS float*)(F.lds + L_CW);
#pragma unroll
  for (int i = 0; i < 3; ++i) { const int e = F.tid + NTHR * i; if (e < 2 * 5 * 128) CW[e] = st.v[i]; }
}
struct StageRaw { v4u v[3]; };
__device__ __forceinline__ void issue_raw(const Frame& F, const bf16* g, int pos0, StageRaw& st) {
#pragma unroll
  for (int i = 0; i < 3; ++i) { const int p = F.tid + NTHR * i, row = p >> 4, ch = p & 15, pos = pos0 - 3 + row;
    st.v[i] = (v4u){0u, 0u, 0u, 0u}; if (p < 67 * 16 && pos >= MPOS0) st.v[i] = *(const v4u*)(g + (size_t)pos * 128 + ch * 8); }
}
__device__ __forceinline__ void commit_raw(const Frame& F, int lds_off, const StageRaw& st) {
#pragma unroll
  for (int i = 0; i < 3; ++i) { const int p = F.tid + NTHR * i, row = p >> 4, ch = p & 15; if (p < 67 * 16) *(LAS v4u*)(F.lds + lds_off + row * 256 + ch * 16) = st.v[i]; }
}
__device__ __forceinline__ void conv16(const Frame& F, int qk, int lds_off, int t, int d0, float (&y)[16]) {
  const LAS float* CW = (const LAS float*)(F.lds + L_CW);
#pragma unroll
  for (int e = 0; e < 16; ++e) y[e] = CW[(qk * 5 + 4) * 128 + d0 + e];
#pragma unroll
  for (int j = 0; j < 4; ++j) { const LAS v4u* rp = (const LAS v4u*)(F.lds + lds_off + (t + j) * 256 + d0 * 2); const v4u r0 = rp[0], r1 = rp[1];
    const LAS float* cw = CW + (qk * 5 + j) * 128 + d0;
    y[0] += cw[0] * bflo(r0.x); y[1] += cw[1] * bfhi(r0.x); y[2] += cw[2] * bflo(r0.y); y[3] += cw[3] * bfhi(r0.y); y[4] += cw[4] * bflo(r0.z); y[5] += cw[5] * bfhi(r0.z); y[6] += cw[6] * bflo(r0.w); y[7] += cw[7] * bfhi(r0.w);
    y[8] += cw[8] * bflo(r1.x); y[9] += cw[9] * bfhi(r1.x); y[10] += cw[10] * bflo(r1.y); y[11] += cw[11] * bfhi(r1.y); y[12] += cw[12] * bflo(r1.z); y[13] += cw[13] * bfhi(r1.z); y[14] += cw[14] * bflo(r1.w); y[15] += cw[15] * bfhi(r1.w); }
#pragma unroll
  for (int e = 0; e < 16; ++e) y[e] = y[e] / (1.0f + __expf(-y[e]));
}
struct StageVT { v4u v[4]; };
__device__ __forceinline__ void issue_vt(const Frame& F, const bf16* MVg, int pos0, StageVT& st) {
#pragma unroll
  for (int i = 0; i < 4; ++i) { const int p = F.tid + NTHR * i, row = p >> 5, ch = p & 31; st.v[i] = (v4u){0u, 0u, 0u, 0u};
    if (pos0 + row >= MPOS0) st.v[i] = *(const v4u*)(MVg + (size_t)(pos0 + row) * 256 + ch * 8); }
}
__device__ __forceinline__ void commit_vt(const Frame& F, const StageVT& st) {
#pragma unroll
  for (int i = 0; i < 4; ++i) { const int p = F.tid + NTHR * i, row = p >> 5, ch = p & 31; const v4u v4 = st.v[i];
    LAS bf16* vt = (LAS bf16*)(F.lds + L_VT) + (ch * 8) * TST + row;
    vt[0 * TST] = (bf16)(v4.x & 0xffff); vt[1 * TST] = (bf16)(v4.x >> 16); vt[2 * TST] = (bf16)(v4.y & 0xffff); vt[3 * TST] = (bf16)(v4.y >> 16);
    vt[4 * TST] = (bf16)(v4.z & 0xffff); vt[5 * TST] = (bf16)(v4.z >> 16); vt[6 * TST] = (bf16)(v4.w & 0xffff); vt[7 * TST] = (bf16)(v4.w >> 16); }
}

__device__ __forceinline__ void taskA(const Frame& F, const Args& a, int task) {
  const int bh = task >> 5, c = task & 31, h = bh & 3, tid = F.tid, w = F.wave, lane = F.lane, fr = lane & 15, kq = lane >> 4, pos0 = 64 * c;
  LAS unsigned char* lds = F.lds; LAS float* G = (LAS float*)(lds + L_G);
  const bf16* MKg = (const bf16*)(F.ws + WS_MK) + (size_t)bh * PADT * 128; const bf16* MVg = (const bf16*)(F.ws + WS_MV) + (size_t)bh * PADT * 256;
  StageCW scw; StageRaw srk; StageVT svt; float li = -1e30f, lf = 0.f;
  issue_cw(F, a, h, scw); issue_raw(F, MKg, pos0, srk); issue_vt(F, MVg, pos0, svt);
  { const bool dead = pos0 + lane < MPOS0; if (w == 0 && !dead) { li = ((const float*)(F.ws + WS_LI))[bh * PADT + pos0 + lane]; lf = ((const float*)(F.ws + WS_LF))[bh * PADT + pos0 + lane]; } }
  __syncthreads();
  commit_cw(F, scw); commit_raw(F, L_RK, srk); commit_vt(F, svt);
  if (w == 0) {
    float bs = lf;
#pragma unroll
    for (int d = 1; d < 64; d <<= 1) { const float o = shfl_up_f(bs, d); if (lane >= d) bs += o; }
    const float av = li - bs; float mx = av;
#pragma unroll
    for (int o = 1; o < 64; o <<= 1) mx = fmaxf(mx, __shfl_xor(mx, o));
    G[G_WG + lane] = __expf(av - mx);
    if (lane == 63) { float* gs = (float*)(F.ws + WS_GS) + (size_t)(bh * 33 + c) * 2; gs[0] = bs; gs[1] = mx; }
  }
  __syncthreads();
  { const int t = tid >> 3, d0 = (tid & 7) * 16; float y[16]; conv16(F, 1, L_RK, t, d0, y);
    const float sw = 0.08838834764831845f * G[G_WG + t]; LAS bf16* kt = (LAS bf16*)(lds + L_KWT) + d0 * TST + t;
#pragma unroll
    for (int e = 0; e < 16; ++e) kt[e * TST] = (bf16)f2bf(y[e] * sw); }
  __syncthreads();
  f32x4* DCg = (f32x4*)(F.ws + WS_DC) + ((size_t)(bh * 32 + c) * 128) * 64;
#pragma unroll
  for (int jj = 0; jj < 2; ++jj) { const int j = 2 * w + jj;
    const bf16x8 bv0 = *(const LAS bf16x8*)(lds + L_VT + ((16 * j + fr) * TST + 8 * kq) * 2), bv1 = *(const LAS bf16x8*)(lds + L_VT + ((16 * j + fr) * TST + 32 + 8 * kq) * 2);
#pragma unroll
    for (int i = 0; i < 8; ++i) { f32x4 acc = {0.f, 0.f, 0.f, 0.f};
      const bf16x8 k0 = *(const LAS bf16x8*)(lds + L_KWT + ((16 * i + fr) * TST + 8 * kq) * 2), k1 = *(const LAS bf16x8*)(lds + L_KWT + ((16 * i + fr) * TST + 32 + 8 * kq) * 2);
      acc = __builtin_amdgcn_mfma_f32_16x16x32_bf16(k0, bv0, acc, 0, 0, 0); acc = __builtin_amdgcn_mfma_f32_16x16x32_bf16(k1, bv1, acc, 0, 0, 0);
      DCg[(size_t)(i * 16 + j) * 64 + lane] = acc; } }
  if (tid < 128) { const LAS v4u* kr = (const LAS v4u*)(lds + L_KWT + tid * TST * 2); float s = 0.f;
#pragma unroll
    for (int q = 0; q < 8; ++q) { const v4u x = kr[q]; s += (bflo(x.x) + bfhi(x.x)) + (bflo(x.y) + bfhi(x.y)) + (bflo(x.z) + bfhi(x.z)) + (bflo(x.w) + bfhi(x.w)); }
    ((float*)(F.ws + WS_DN))[(size_t)(bh * 32 + c) * 128 + tid] = s; }
}

__device__ __forceinline__ void scanB(const Frame& F) {
  const float* GS = (const float*)(F.ws + WS_GS);
  LAS float* cf = (LAS float*)F.lds;
  for (int blk = blockIdx.x; blk < 16 * 16; blk += gridDim.x) { const int bh = blk >> 4, r = (blk & 15) * NTHR + F.tid, i = r >> 10, j = (r >> 6) & 15, ln = r & 63;
    __syncthreads();
    if (F.wave == 0) {
      const int c = F.lane & 31; const v2u gs = *(const v2u*)(GS + (size_t)(bh * 33 + c) * 2); const unsigned g0 = gs.x, g1 = gs.y;
      const float bL = __builtin_bit_cast(float, g0), ml = __builtin_bit_cast(float, g1);
      float mm = 0.f, fa = 0.f, fb = 0.f, mout = 0.f;
#pragma unroll
      for (int cc = 0; cc < 32; ++cc) { const float b_ = __builtin_bit_cast(float, __builtin_amdgcn_readlane(__builtin_bit_cast(int, bL), cc)), l_ = __builtin_bit_cast(float, __builtin_amdgcn_readlane(__builtin_bit_cast(int, ml), cc));
        const float me = fmaxf(mm, l_); if (c == cc) { fa = __expf(mm - me); fb = __expf(l_ - me); } mm = b_ + me; if (c == cc) mout = mm; }
      if (F.lane < 32) { cf[2 * c] = fa; cf[2 * c + 1] = fb; if ((blk & 15) == 0) ((float*)(F.ws + WS_MS))[bh * 33 + c + 1] = mout; }
    }
    __syncthreads();
    const f32x4* dc0 = (const f32x4*)(F.ws + WS_DC) + ((size_t)(bh * 32) * 128 + (i * 16 + j)) * 64 + ln;
    v2u* cs = (v2u*)(F.ws + WS_CS) + ((((size_t)bh * 33) * 8 + i) * 16 + j) * 64 + ln;
    f32x4 s0 = {0.f, 0.f, 0.f, 0.f}, dv[32];
#pragma unroll
    for (int c = 0; c < 32; ++c) dv[c] = dc0[(size_t)c * 128 * 64];
#pragma unroll
    for (int c = 0; c < 32; ++c) { const float fa = cf[2 * c], fb = cf[2 * c + 1];
      s0 = s0 * fa + dv[c] * fb;
      v2u o; o.x = pk2(s0.x, s0.y); o.y = pk2(s0.z, s0.w); cs[(size_t)(c + 1) * 8 * 16 * 64] = o; }
    if ((blk & 15) == 0 && F.tid < 128) {
      const float* dn = (const float*)(F.ws + WS_DN) + (size_t)(bh * 32) * 128 + F.tid; float* ns = (float*)(F.ws + WS_NS) + (size_t)(bh * 33) * 128 + F.tid; float n = 0.f;
      float dnv[32];
#pragma unroll
      for (int c = 0; c < 32; ++c) dnv[c] = dn[(size_t)c * 128];
#pragma unroll
      for (int c = 0; c < 32; ++c) { n = n * cf[2 * c] + dnv[c] * cf[2 * c + 1]; ns[(size_t)(c + 1) * 128] = n; }
    }
  }
}

__device__ __forceinline__ void taskC(const Frame& F, const Args& a, int task) {
  TP_BEGIN(31);
  const int bh = task >> 5, c = (task & 31) + 1, b = bh >> 2, h = bh & 3, tid = F.tid, w = F.wave, lane = F.lane, fr = lane & 15, kq = lane >> 4, pos0 = 64 * c;
  LAS unsigned char* lds = F.lds; LAS float* G = (LAS float*)(lds + L_G); LAS float* NV = (LAS float*)(lds + L_NV);
  const bf16* MQg = (const bf16*)(F.ws + WS_MQ) + (size_t)bh * PADT * 128; const bf16* MKg = (const bf16*)(F.ws + WS_MK) + (size_t)bh * PADT * 128;
  const bf16* MVg = (const bf16*)(F.ws + WS_MV) + (size_t)bh * PADT * 256;
  const float m = ((const float*)(F.ws + WS_MS))[bh * 33 + c];
  StageCW scw; StageRaw srq, srk; StageVT svt; float nvv = 0.f, li = 0.f, lf = 0.f;
  issue_cw(F, a, h, scw); issue_raw(F, MQg, pos0, srq); issue_raw(F, MKg, pos0, srk); issue_vt(F, MVg, pos0, svt);
  if (tid < 128) nvv = ((const float*)(F.ws + WS_NS))[(size_t)(bh * 33 + c) * 128 + tid];
  if (w == 0) { li = ((const float*)(F.ws + WS_LI))[bh * PADT + pos0 + lane]; lf = ((const float*)(F.ws + WS_LF))[bh * PADT + pos0 + lane]; }
  __syncthreads();
  commit_cw(F, scw); commit_raw(F, L_RQ, srq); commit_raw(F, L_RK, srk); commit_vt(F, svt);
  if (tid < 128) NV[tid] = nvv;
  if (w == 0) {
    float bs = lf;
#pragma unroll
    for (int d = 1; d < 64; d <<= 1) { const float o = shfl_up_f(bs, d); if (lane >= d) bs += o; }
    const float av = li - bs; float cm = av;
#pragma unroll
    for (int d = 1; d < 64; d <<= 1) { const float o = shfl_up_f(cm, d); if (lane >= d) cm = fmaxf(cm, o); }
    const float Mt = fmaxf(m, cm);
    G[G_A + lane] = av; G[G_M + lane] = Mt; G[G_WI + lane] = __expf(m - Mt); G[G_EM + lane] = __expf(-(bs + Mt));
  }
  __syncthreads(); TP_END(31, F.ws); TP_BEGIN(32);
  { const int t = tid >> 3, d0 = (tid & 7) * 16; const float wi = G[G_WI + t]; float y[16];
    conv16(F, 0, L_RQ, t, d0, y);
    { v4u o0, o1, w0, w1;
      o0.x = pk2(y[0], y[1]); o0.y = pk2(y[2], y[3]); o0.z = pk2(y[4], y[5]); o0.w = pk2(y[6], y[7]); o1.x = pk2(y[8], y[9]); o1.y = pk2(y[10], y[11]); o1.z = pk2(y[12], y[13]); o1.w = pk2(y[14], y[15]);
      w0.x = pk2(y[0] * wi, y[1] * wi); w0.y = pk2(y[2] * wi, y[3] * wi); w0.z = pk2(y[4] * wi, y[5] * wi); w0.w = pk2(y[6] * wi, y[7] * wi);
      w1.x = pk2(y[8] * wi, y[9] * wi); w1.y = pk2(y[10] * wi, y[11] * wi); w1.z = pk2(y[12] * wi, y[13] * wi); w1.w = pk2(y[14] * wi, y[15] * wi);
      LAS v4u* qs = (LAS v4u*)(lds + L_QS + (t * QST + d0) * 2); qs[0] = o0; qs[1] = o1;
      LAS v4u* qw = (LAS v4u*)(lds + L_QW + (t * QST + d0) * 2); qw[0] = w0; qw[1] = w1; }
    __builtin_amdgcn_sched_barrier(0);
    conv16(F, 1, L_RK, t, d0, y);
    { const float sc = 0.08838834764831845f; v4u o0, o1;
      o0.x = pk2(y[0] * sc, y[1] * sc); o0.y = pk2(y[2] * sc, y[3] * sc); o0.z = pk2(y[4] * sc, y[5] * sc); o0.w = pk2(y[6] * sc, y[7] * sc);
      o1.x = pk2(y[8] * sc, y[9] * sc); o1.y = pk2(y[10] * sc, y[11] * sc); o1.z = pk2(y[12] * sc, y[13] * sc); o1.w = pk2(y[14] * sc, y[15] * sc);
      LAS v4u* ks = (LAS v4u*)(lds + L_KS + (t * QST + d0) * 2); ks[0] = o0; ks[1] = o1; } }
  __syncthreads(); TP_END(32, F.ws); TP_BEGIN(33);
  v4u cb[4][2];
  { const v2u* cs = (const v2u*)(F.ws + WS_CS) + (((size_t)bh * 33 + c) * 8 * 16) * 64;
#pragma unroll
    for (int I = 0; I < 4; ++I)
#pragma unroll
      for (int jj = 0; jj < 2; ++jj) { const v2u lo_ = cs[(size_t)((2 * I) * 16 + 2 * w + jj) * 64 + lane], hi_ = cs[(size_t)((2 * I + 1) * 16 + 2 * w + jj) * 64 + lane]; cb[I][jj] = (v4u){lo_.x, lo_.y, hi_.x, hi_.y}; } }
  { const int si = w >> 1; const f32x4 as = *(const LAS f32x4*)(G + G_A + 16 * si + 4 * kq);
#pragma unroll
    for (int tt = 0; tt < 2; ++tt) { const int ti = 2 * (w & 1) + tt; f32x4 acc = {0.f, 0.f, 0.f, 0.f};
#pragma unroll
      for (int ks = 0; ks < 4; ++ks) { const bf16x8 af = *(const LAS bf16x8*)(lds + L_KS + ((16 * si + fr) * QST + 32 * ks + 8 * kq) * 2);
        const bf16x8 bfr = *(const LAS bf16x8*)(lds + L_QS + ((16 * ti + fr) * QST + 32 * ks + 8 * kq) * 2);
        acc = __builtin_amdgcn_mfma_f32_16x16x32_bf16(af, bfr, acc, 0, 0, 0); }
      const int t = 16 * ti + fr, s0 = 16 * si + 4 * kq; const float Mt = G[G_M + t];
      const float v0 = (s0 + 0 <= t) ? acc.x * __expf(as.x - Mt) : 0.f, v1 = (s0 + 1 <= t) ? acc.y * __expf(as.y - Mt) : 0.f;
      const float v2 = (s0 + 2 <= t) ? acc.z * __expf(as.z - Mt) : 0.f, v3 = (s0 + 3 <= t) ? acc.w * __expf(as.w - Mt) : 0.f;
      v2u o; o.x = pk2(v0, v1); o.y = pk2(v2, v3);
      *(LAS v2u*)(lds + L_SP + (t * TST + s0) * 2) = o; } }
  __syncthreads(); TP_END(33, F.ws); TP_BEGIN(34);
  if (w == 0) { const int t = lane; float qn = 0.f, rsum = 0.f;
#pragma unroll 4
    for (int q = 0; q < 16; ++q) { const v4u x = *(const LAS v4u*)(lds + L_QS + (t * QST + q * 8) * 2); const f32x4 n0 = *(const LAS f32x4*)(NV + q * 8), n1 = *(const LAS f32x4*)(NV + q * 8 + 4);
      qn += bflo(x.x) * n0.x + bfhi(x.x) * n0.y + bflo(x.y) * n0.z + bfhi(x.y) * n0.w + bflo(x.z) * n1.x + bfhi(x.z) * n1.y + bflo(x.w) * n1.z + bfhi(x.w) * n1.w; }
#pragma unroll
    for (int q = 0; q < 8; ++q) { const v4u x = *(const LAS v4u*)(lds + L_SP + (t * TST + q * 8) * 2); rsum += (bflo(x.x) + bfhi(x.x)) + (bflo(x.y) + bfhi(x.y)) + (bflo(x.z) + bfhi(x.z)) + (bflo(x.w) + bfhi(x.w)); }
    const float den = G[G_WI + t] * qn + rsum; G[G_DEN + t] = fmaxf(fabsf(den), G[G_EM + t]); }
  f32x4 acc[2][4];
#pragma unroll
  for (int jj = 0; jj < 2; ++jj)
#pragma unroll
    for (int ti = 0; ti < 4; ++ti) acc[jj][ti] = (f32x4){0.f, 0.f, 0.f, 0.f};
#pragma unroll
  for (int I = 0; I < 4; ++I) {
#pragma unroll
    for (int ti = 0; ti < 4; ++ti) { const LAS unsigned char* qp = lds + L_QW + ((16 * ti + fr) * QST + 32 * I + 4 * kq) * 2;
      const v2u a0 = *(const LAS v2u*)qp, a1 = *(const LAS v2u*)(qp + 32); const v4u av = {a0.x, a0.y, a1.x, a1.y};
      acc[0][ti] = __builtin_amdgcn_mfma_f32_16x16x32_bf16(__builtin_bit_cast(bf16x8, av), __builtin_bit_cast(bf16x8, cb[I][0]), acc[0][ti], 0, 0, 0);
      acc[1][ti] = __builtin_amdgcn_mfma_f32_16x16x32_bf16(__builtin_bit_cast(bf16x8, av), __builtin_bit_cast(bf16x8, cb[I][1]), acc[1][ti], 0, 0, 0); }
    __builtin_amdgcn_sched_barrier(0); }
#pragma unroll
  for (int ks = 0; ks < 2; ++ks) { const bf16x8 bv0 = *(const LAS bf16x8*)(lds + L_VT + ((32 * w + fr) * TST + 32 * ks + 8 * kq) * 2), bv1 = *(const LAS bf16x8*)(lds + L_VT + ((32 * w + 16 + fr) * TST + 32 * ks + 8 * kq) * 2);
#pragma unroll
    for (int ti = 0; ti < 4; ++ti) { const bf16x8 sf = *(const LAS bf16x8*)(lds + L_SP + ((16 * ti + fr) * TST + 32 * ks + 8 * kq) * 2);
      acc[0][ti] = __builtin_amdgcn_mfma_f32_16x16x32_bf16(sf, bv0, acc[0][ti], 0, 0, 0); acc[1][ti] = __builtin_amdgcn_mfma_f32_16x16x32_bf16(sf, bv1, acc[1][ti], 0, 0, 0); } }
  __syncthreads(); TP_END(34, F.ws); TP_BEGIN(35);
  LAS float* SSQ = (LAS float*)(lds + L_SSQ);
#pragma unroll
  for (int ti = 0; ti < 4; ++ti) { const f32x4 dn = *(const LAS f32x4*)(G + G_DEN + 16 * ti + 4 * kq);
    f32x4 s4;
#pragma unroll
    for (int r = 0; r < 4; ++r) { const float h0 = acc[0][ti][r] / dn[r], h1 = acc[1][ti][r] / dn[r]; acc[0][ti][r] = h0; acc[1][ti][r] = h1; s4[r] = h0 * h0 + h1 * h1; }
#pragma unroll
    for (int o = 1; o < 16; o <<= 1) { s4.x += __shfl_xor(s4.x, o); s4.y += __shfl_xor(s4.y, o); s4.z += __shfl_xor(s4.z, o); s4.w += __shfl_xor(s4.w, o); }
    if (fr == 0) { SSQ[(16 * ti + 4 * kq + 0) * 8 + w] = s4.x; SSQ[(16 * ti + 4 * kq + 1) * 8 + w] = s4.y; SSQ[(16 * ti + 4 * kq + 2) * 8 + w] = s4.z; SSQ[(16 * ti + 4 * kq + 3) * 8 + w] = s4.w; } }
  __syncthreads();
  LAS bf16* HT = (LAS bf16*)(lds + L_HT);
#pragma unroll
  for (int ti = 0; ti < 4; ++ti)
#pragma unroll
    for (int r = 0; r < 4; ++r) { const int t = 16 * ti + 4 * kq + r; const f32x4 p0 = *(const LAS f32x4*)(SSQ + t * 8), p1 = *(const LAS f32x4*)(SSQ + t * 8 + 4);
      const float rh = rsqrtf(((p0.x + p0.y) + (p0.z + p0.w) + (p1.x + p1.y) + (p1.z + p1.w)) * (1.0f / 256.f) + EPS);
      HT[t * 264 + 32 * w + fr] = (bf16)f2bf(acc[0][ti][r] * rh); HT[t * 264 + 32 * w + 16 + fr] = (bf16)f2bf(acc[1][ti][r] * rh); }
  __syncthreads(); TP_END(35, F.ws); TP_BEGIN(36);
  { const int t = tid >> 3, c0 = (tid & 7) * 32; const size_t R = (size_t)b * SEQ + 64 * (c - 1) + t;
    const bf16* mo = (const bf16*)(F.ws + WS_MO) + R * 1024 + h * 256 + c0; const float* og = a.in[IN_OUTG] + h * 256 + c0; bf16* A2 = (bf16*)(F.ws + WS_A2) + R * DM + 1024 + h * 256 + c0;
#pragma unroll
    for (int q = 0; q < 4; ++q) { const v4u hv = *(const LAS v4u*)(HT + t * 264 + c0 + q * 8); const v4u mv = *(const v4u*)(mo + q * 8); const f32x4 g0 = *(const f32x4*)(og + q * 8), g1 = *(const f32x4*)(og + q * 8 + 4);
      v4u o; o.x = pk2(bflo(hv.x) * g0.x * sigmoidf_(bflo(mv.x)), bfhi(hv.x) * g0.y * sigmoidf_(bfhi(mv.x))); o.y = pk2(bflo(hv.y) * g0.z * sigmoidf_(bflo(mv.y)), bfhi(hv.y) * g0.w * sigmoidf_(bfhi(mv.y)));
      o.z = pk2(bflo(hv.z) * g1.x * sigmoidf_(bflo(mv.z)), bfhi(hv.z) * g1.y * sigmoidf_(bfhi(mv.z))); o.w = pk2(bflo(hv.w) * g1.z * sigmoidf_(bflo(mv.w)), bfhi(hv.w) * g1.w * sigmoidf_(bfhi(mv.w)));
      *(v4u*)(A2 + q * 8) = o; } }
  TP_END(36, F.ws);
}
}
struct CombRow { float mp[8][3], lp[8][3]; v4u op[8][3]; };
__device__ __forceinline__ float half_sum_dpp(float v, bool hi) {
  v += __builtin_bit_cast(float, __builtin_amdgcn_update_dpp(0, __builtin_bit_cast(int, v), 0xB1, 0xF, 0xF, true));
  v += __builtin_bit_cast(float, __builtin_amdgcn_update_dpp(0, __builtin_bit_cast(int, v), 0x4E, 0xF, 0xF, true));
  v += __builtin_bit_cast(float, __builtin_amdgcn_update_dpp(0, __builtin_bit_cast(int, v), 0x141, 0xF, 0xF, true));
  v += __builtin_bit_cast(float, __builtin_amdgcn_update_dpp(0, __builtin_bit_cast(int, v), 0x140, 0xF, 0xF, true));
  const float r0 = __builtin_bit_cast(float, __builtin_amdgcn_readlane(__builtin_bit_cast(int, v), 0)), r1 = __builtin_bit_cast(float, __builtin_amdgcn_readlane(__builtin_bit_cast(int, v), 16));
  const float r2 = __builtin_bit_cast(float, __builtin_amdgcn_readlane(__builtin_bit_cast(int, v), 32)), r3 = __builtin_bit_cast(float, __builtin_amdgcn_readlane(__builtin_bit_cast(int, v), 48));
  return hi ? r2 + r3 : r0 + r1;
}
__device__ __forceinline__ void comb_load(const bf16* PO, const float* ML, int R0, int NA, int lane, CombRow& cr) {
  const int b = R0 >> 11, t = R0 & 2047, qb = t >> 8, rq = (t & 255) + (lane >> 5), l32 = lane & 31;
#pragma unroll
  for (int hm = 0; hm < 8; ++hm) {
    const int bhm = b * 8 + hm, first = bhm * att::STEPS_BHM + att::qb_start(qb), last = first + 4 * qb + 4;
    const int cf = att::chunk_of(first, NA), np = att::chunk_of(last, NA) - cf + 1, slot0 = bhm * 16 + qb + cf - att::chunk_of(bhm * att::STEPS_BHM, NA);
#pragma unroll
    for (int p = 0; p < 3; ++p) { if (p < np) { const int slot = slot0 + p; const v2u ml = *(const v2u*)(ML + (size_t)slot * 512 + rq * 2);
        const unsigned mx_ = ml.x, my_ = ml.y; cr.mp[hm][p] = __builtin_bit_cast(float, mx_); cr.lp[hm][p] = __builtin_bit_cast(float, my_);
        cr.op[hm][p] = ((const v4u*)(PO + ((size_t)slot * 256 + rq) * 256))[l32]; } else { cr.mp[hm][p] = -1e30f; cr.lp[hm][p] = 0.f; cr.op[hm][p] = (v4u){0u, 0u, 0u, 0u}; } }
  }
}
__device__ __forceinline__ void comb_finish(bf16* A2, int R0, int lane, float lam, const f32x4 sg0, const f32x4 sg1, const CombRow& cr) {
  const bool hi = lane >= 32; const int l32 = lane & 31;
#pragma unroll
  for (int h = 0; h < 4; ++h) {
    float om[2][8];
#pragma unroll
    for (int m = 0; m < 2; ++m) { const int hm = h * 2 + m;
      const float M = fmaxf(cr.mp[hm][0], fmaxf(cr.mp[hm][1], cr.mp[hm][2]));
      float wsum = 0.f, acc[8];
#pragma unroll
      for (int i = 0; i < 8; ++i) acc[i] = 0.f;
#pragma unroll
      for (int p = 0; p < 3; ++p) { const float w = cr.lp[hm][p] * exp2f(cr.mp[hm][p] - M); wsum += w; const v4u ow = cr.op[hm][p];
#pragma unroll
        for (int i = 0; i < 4; ++i) { const unsigned wd = ow[i]; acc[2 * i] += bflo(wd) * w; acc[2 * i + 1] += bfhi(wd) * w; } }
      const float iw = 1.0f / wsum;
#pragma unroll
      for (int i = 0; i < 8; ++i) om[m][i] = acc[i] * iw;
    }
    float o[8], ss = 0.f;
#pragma unroll
    for (int i = 0; i < 8; ++i) { o[i] = om[0][i] - om[1][i] * lam; ss += o[i] * o[i]; }
    const float rs = rsqrtf(half_sum_dpp(ss, hi) * (1.0f / 256.f) + EPS) * 0.8f;
    v4u w; w.x = pk2(o[0] * rs * sg0.x, o[1] * rs * sg0.y); w.y = pk2(o[2] * rs * sg0.z, o[3] * rs * sg0.w); w.z = pk2(o[4] * rs * sg1.x, o[5] * rs * sg1.y); w.w = pk2(o[6] * rs * sg1.z, o[7] * rs * sg1.w);
    ((v4u*)(A2 + (size_t)(R0 + (hi ? 1 : 0)) * DM + h * 256))[l32] = w;
  }
}
__device__ __forceinline__ void p3_combine(const Frame& F, const Args& a, int NA) {
  const bf16* PO = (const bf16*)(F.ws + WS_PO); const float* ML = (const float*)(F.ws + WS_ML);
  bf16* A2 = (bf16*)(F.ws + WS_A2);
  const float lam = *(const float*)(F.ws + WS_LAM);
  const int gw = blockIdx.x * NWAVES + F.wave, NGW = gridDim.x * NWAVES, lane = F.lane;
  const f32x4 sg0 = ((const f32x4*)a.in[IN_SUBG])[2 * (lane & 31)], sg1 = ((const f32x4*)a.in[IN_SUBG])[2 * (lane & 31) + 1];
  for (int k = gw; k < MROWS / 4; k += NGW) {
#pragma unroll 1
    for (int s = 0; s < 2; ++s) { const int P = s ? MROWS / 2 - 1 - k : k;
      CombRow r0;
      comb_load(PO, ML, 2 * P, NA, lane, r0);
      comb_finish(A2, 2 * P, lane, lam, sg0, sg1, r0); }
  }
}
struct EpiRes {
  static constexpr bool PERM = true, AFTER_DRAIN = false;
  const float* x; float* out; bf16* H1b; float* SSQ;
  __device__ __forceinline__ void operator()(const pg8::f32x4 (&acc)[2][2][4][2], const pg8::Unit& u, int wr, int wc, int fr, int fq) const {
    const int row0 = u.pm * 256 + wr * 64 + fr, col0 = u.pn * 256 + wc * 32 + 8 * fq;
#pragma unroll
    for (int ai = 0; ai < 2; ++ai)
#pragma unroll
      for (int m = 0; m < 4; ++m) { const size_t R = (size_t)(row0 + ai * 128 + m * 16); float s = 0.f;
#pragma unroll
        for (int bj = 0; bj < 2; ++bj) { const size_t off = R * DM + col0 + bj * 128;
          const f32x4 x0 = *(const f32x4*)(x + off), x1 = *(const f32x4*)(x + off + 4);
          const f32x4 v0 = acc[ai][bj][m][0] + x0, v1 = acc[ai][bj][m][1] + x1;
          v4u w; w.x = pk2(v0.x, v0.y); w.y = pk2(v0.z, v0.w); w.z = pk2(v1.x, v1.y); w.w = pk2(v1.z, v1.w);
          *(v4u*)(H1b + off) = w;
          s += (v0.x * v0.x + v0.y * v0.y) + (v0.z * v0.z + v0.w * v0.w) + (v1.x * v1.x + v1.y * v1.y) + (v1.z * v1.z + v1.w * v1.w); }
        s += __shfl_xor(s, 16); s += __shfl_xor(s, 32);
        if (fq == 0) SSQ[R * 32 + u.pn * 4 + wc] = s; }
  }
};
#ifndef PEER_U_FP8
#define PEER_U_FP8 0
#endif
typedef __bf16 bfv2 __attribute__((ext_vector_type(2)));
__device__ __forceinline__ void split_hl(const f32x4 a, const f32x4 b, bf16x8& hi, bf16x8& lo) {
  float v[8] = {a.x, a.y, a.z, a.w, b.x, b.y, b.z, b.w}; unsigned h[8], l[8];
#pragma unroll
  for (int i = 0; i < 8; ++i) { h[i] = f2bf(v[i]); l[i] = f2bf(v[i] - __builtin_bit_cast(float, h[i] << 16)); }
  v4u hv = {h[0] | (h[1] << 16), h[2] | (h[3] << 16), h[4] | (h[5] << 16), h[6] | (h[7] << 16)};
  v4u lv = {l[0] | (l[1] << 16), l[2] | (l[3] << 16), l[4] | (l[5] << 16), l[6] | (l[7] << 16)};
  hi = __builtin_bit_cast(bf16x8, hv); lo = __builtin_bit_cast(bf16x8, lv);
}
__device__ __forceinline__ void p0_w3t(const Frame& F, const Args& a) {
  const float* wq = a.in[IN_WQ]; const float* sk = a.in[IN_SUBK]; const float* g2 = a.in[IN_G2];
  bf16* W3t = (bf16*)(F.ws + WS_W3T);
  const int lane = F.lane, fr = lane & 15, fq = lane >> 4;
  constexpr int SKS = 272;
  LAS unsigned char* shi = F.lds; LAS unsigned char* slo = F.lds + 128 * SKS;
  for (int bt = blockIdx.x; bt < 256; bt += gridDim.x) {
    const int hh = bt & 15, kt = (bt >> 4) * 8 + F.wave;
    const float* ap = wq + (size_t)(kt * 16 + fr) * DM + hh * 128 + fq * 8;
    f32x4 a0[4], a1[4];
#pragma unroll
    for (int s = 0; s < 4; ++s) { a0[s] = *(const f32x4*)(ap + 32 * s); a1[s] = *(const f32x4*)(ap + 32 * s + 4); }
    const f32x4 gk = *(const f32x4*)(g2 + kt * 16 + fq * 4);
    __syncthreads();
#pragma unroll
    for (int i = 0; i < 4; ++i) { const int idx = F.tid + NTHR * i, key = idx >> 4, c8 = idx & 15; const float* p = sk + (size_t)(hh * 128 + key) * 128 + c8 * 8;
      bf16x8 h, l; split_hl(*(const f32x4*)p, *(const f32x4*)(p + 4), h, l);
      *(LAS bf16x8*)(shi + key * SKS + c8 * 16) = h; *(LAS bf16x8*)(slo + key * SKS + c8 * 16) = l; }
    bf16x8 ahi[4], alo[4];
#pragma unroll
    for (int s = 0; s < 4; ++s) split_hl(a0[s], a1[s], ahi[s], alo[s]);
    __syncthreads();
#pragma unroll 2
    for (int t2 = 0; t2 < 8; ++t2) {
      const LAS unsigned char* bh = shi + (t2 * 16 + fr) * SKS + fq * 16; const LAS unsigned char* bl = slo + (t2 * 16 + fr) * SKS + fq * 16;
      f32x4 acc = {0.f, 0.f, 0.f, 0.f};
#pragma unroll
      for (int s = 0; s < 4; ++s) { const bf16x8 bhi = *(const LAS bf16x8*)(bh + 64 * s), blo = *(const LAS bf16x8*)(bl + 64 * s);
        acc = __builtin_amdgcn_mfma_f32_16x16x32_bf16(ahi[s], bhi, acc, 0, 0, 0);
        acc = __builtin_amdgcn_mfma_f32_16x16x32_bf16(ahi[s], blo, acc, 0, 0, 0);
        acc = __builtin_amdgcn_mfma_f32_16x16x32_bf16(alo[s], bhi, acc, 0, 0, 0); }
      v2u o; o.x = pk2(acc.x * gk.x, acc.y * gk.y); o.y = pk2(acc.z * gk.z, acc.w * gk.w);
      *(v2u*)(W3t + (size_t)(hh * 128 + t2 * 16 + fr) * DM + kt * 16 + fq * 4) = o;
    }
  }
  __syncthreads();
}
typedef float f32x2v __attribute__((ext_vector_type(2)));
__device__ __forceinline__ void p0_tables(const Frame& F, const Args& a) {
  const float* g2 = a.in[IN_G2];
  float* SCL = (float*)(F.ws + WS_SCL);
  const int gw = blockIdx.x * NWAVES + F.wave, NGW = gridDim.x * NWAVES, lane = F.lane;
  f32x4 gl[8];
#pragma unroll
  for (int q = 0; q < 8; ++q) gl[q] = *(const f32x4*)(g2 + q * 256 + lane * 4);
  f32x4 xn[8];
  { const int row = gw; if (row < 2 * 16384) { const float* src = a.in[row >= 16384 ? IN_V : IN_U] + (size_t)(row & 16383) * DM + lane * 4;
#pragma unroll
      for (int q = 0; q < 8; ++q) xn[q] = *(const f32x4*)(src + q * 256); } }
  for (int row = gw; row < 2 * 16384; row += NGW) {
    const bool isv = row >= 16384; const int e = row & 16383;
    f32x4 x[8];
#pragma unroll
    for (int q = 0; q < 8; ++q) x[q] = xn[q];
    { const int rn = row + NGW; if (rn < 2 * 16384) { const float* src = a.in[rn >= 16384 ? IN_V : IN_U] + (size_t)(rn & 16383) * DM + lane * 4;
#pragma unroll
        for (int q = 0; q < 8; ++q) xn[q] = *(const f32x4*)(src + q * 256); } }
    float amax = 0.f, ssq = 0.f;
#pragma unroll
    for (int q = 0; q < 8; ++q) { if (!isv) x[q] = x[q] * gl[q]; amax = fmaxf(amax, fmaxf(fmaxf(fabsf(x[q].x), fabsf(x[q].y)), fmaxf(fabsf(x[q].z), fabsf(x[q].w))));
      ssq += (x[q].x * x[q].x + x[q].y * x[q].y) + (x[q].z * x[q].z + x[q].w * x[q].w); }
#pragma unroll
    for (int o = 1; o < 64; o <<= 1) amax = fmaxf(amax, __shfl_xor(amax, o));
    v4u w;
    if (isv) {
      const float sc = amax > 0.f ? 6.0f / amax : 1.0f;
#pragma unroll
      for (int d = 0; d < 4; ++d) { unsigned pk = 0u;
        pk = __builtin_amdgcn_cvt_scalef32_pk_fp4_f32(pk, x[2 * d].x * sc, x[2 * d].y * sc, 1.0f, 0); pk = __builtin_amdgcn_cvt_scalef32_pk_fp4_f32(pk, x[2 * d].z * sc, x[2 * d].w * sc, 1.0f, 1);
        pk = __builtin_amdgcn_cvt_scalef32_pk_fp4_f32(pk, x[2 * d + 1].x * sc, x[2 * d + 1].y * sc, 1.0f, 2); pk = __builtin_amdgcn_cvt_scalef32_pk_fp4_f32(pk, x[2 * d + 1].z * sc, x[2 * d + 1].w * sc, 1.0f, 3);
        w[d] = pk; }
      if (lane == 0) SCL[row] = 1.0f / sc;
    } else {
      ssq = wave_sum_dpp(ssq);
      const float sA = amax > 0.f ? amax * (1.0f / 7.0f) : 1.0f, sB = fminf(sA, 0.36f * sqrtf(ssq * (1.0f / DM)) + 1e-30f);
      const float iA = 1.0f / sA, iB = 1.0f / sB;
      float eA = 0.f, eB = 0.f;
#pragma unroll
      for (int q = 0; q < 8; ++q)
#pragma unroll
        for (int j = 0; j < 4; ++j) { const float v = x[q][j];
          const float da = v - sA * __builtin_amdgcn_fmed3f(__builtin_rintf(v * iA), -7.0f, 7.0f), db = v - sB * __builtin_amdgcn_fmed3f(__builtin_rintf(v * iB), -7.0f, 7.0f);
          eA += da * da; eB += db * db; }
      eA = wave_sum_dpp(eA); eB = wave_sum_dpp(eB);
      const bool useB = eB < eA; const float st = useB ? sB : sA, is = useB ? iB : iA;
#pragma unroll
      for (int d = 0; d < 4; ++d) { unsigned pk = 0u;
#pragma unroll
        for (int p = 0; p < 8; ++p) { const float v = x[2 * d + (p >> 2)][p & 3]; const int qi = (int)__builtin_amdgcn_fmed3f(__builtin_rintf(v * is), -7.0f, 7.0f); pk |= ((unsigned)qi & 15u) << (4 * p); }
        w[d] = pk; }
      if (lane == 0) SCL[row] = st;
    }
    *(v4u*)(F.ws + (isv ? WS_VB8 : WS_UB) + (size_t)e * 1024 + lane * 16) = w;
  }
}
struct EpiScore {
  static constexpr bool PERM = true, AFTER_DRAIN = false;
  float* S; const LAS float* rs;
  __device__ __forceinline__ void operator()(const pg8::f32x4 (&acc)[2][2][4][2], const pg8::Unit& u, int wr, int wc, int fr, int fq) const {
    const int rl0 = wr * 64 + fr, keyb = wc * 32 + 8 * fq;
#pragma unroll
    for (int ai = 0; ai < 2; ++ai)
#pragma unroll
      for (int m = 0; m < 4; ++m) { const int rl = rl0 + ai * 128 + m * 16; const float r = rs[rl]; const int row = u.pm * 256 + rl;
#pragma unroll
        for (int bj = 0; bj < 2; ++bj) { float* d = S + ((size_t)((row >> 5) * 16 + u.pn * 2 + bj) * 128 + keyb) * 32 + (row & 31);
          const pg8::f32x4 v0 = acc[ai][bj][m][0] * r, v1 = acc[ai][bj][m][1] * r;
          d[0] = v0[0]; d[32] = v0[1]; d[64] = v0[2]; d[96] = v0[3]; d[128] = v1[0]; d[160] = v1[1]; d[192] = v1[2]; d[224] = v1[3]; } }
  }
};

__device__ __forceinline__ unsigned fkey(float f) { const unsigned b = __builtin_bit_cast(unsigned, f); return b ^ ((b >> 31) ? 0xFFFFFFFFu : 0x80000000u); }
template <int NV, int K> __device__ __forceinline__ void wave_topk(const unsigned (&u)[NV], bool (&sel)[NV], int lane) {
  unsigned prefix = 0u; int cge = NV * 64;
#pragma unroll 1
  for (int bit = 31; bit >= 0 && cge != K; --bit) {
    const unsigned cand = prefix | (1u << bit); int c = 0;
#pragma unroll
    for (int i = 0; i < NV; ++i) c += __builtin_popcountll(__ballot(u[i] >= cand));
    if (c >= K) { prefix = cand; cge = c; }
  }
  int cgt = 0;
#pragma unroll
  for (int i = 0; i < NV; ++i) cgt += __builtin_popcountll(__ballot(u[i] > prefix));
  int need = K - cgt;
  const unsigned long long lm = (1ull << lane) - 1ull;
#pragma unroll
  for (int i = 0; i < NV; ++i) { const unsigned long long eq = __ballot(u[i] == prefix); const int before = __builtin_popcountll(eq & lm);
    sel[i] = (u[i] > prefix) || (u[i] == prefix && before < need); const int ne = __builtin_popcountll(eq); need = need > ne ? need - ne : 0; }
}
template <int NG, int NV, int K> __device__ __forceinline__ void wave_topk_multi(const unsigned (&u)[NG][NV], bool (&sel)[NG][NV], int lane) {
  unsigned prefix[NG]; int cge[NG];
#pragma unroll
  for (int g = 0; g < NG; ++g) { prefix[g] = 0u; cge[g] = NV * 64; }
#pragma unroll 1
  for (int bit = 31; bit >= 0; --bit) {
    bool done = true;
#pragma unroll
    for (int g = 0; g < NG; ++g) done = done && (cge[g] == K);
    if (done) break;
#pragma unroll
    for (int g = 0; g < NG; ++g) { const unsigned cand = prefix[g] | (1u << bit); int c = 0;
#pragma unroll
      for (int i = 0; i < NV; ++i) c += __builtin_popcountll(__ballot(u[g][i] >= cand));
      if (cge[g] != K && c >= K) { prefix[g] = cand; cge[g] = c; } }
  }
  const unsigned long long lm = (1ull << lane) - 1ull;
#pragma unroll
  for (int g = 0; g < NG; ++g) { int cgt = 0;
#pragma unroll
    for (int i = 0; i < NV; ++i) cgt += __builtin_popcountll(__ballot(u[g][i] > prefix[g]));
    int need = K - cgt;
#pragma unroll
    for (int i = 0; i < NV; ++i) { const unsigned long long eq = __ballot(u[g][i] == prefix[g]); const int before = __builtin_popcountll(eq & lm);
      sel[g][i] = (u[g][i] > prefix[g]) || (u[g][i] == prefix[g] && before < need); const int ne = __builtin_popcountll(eq); need = need > ne ? need - ne : 0; } }
}
__device__ __forceinline__ float gelu_erf(float v) {
  const float av = fabsf(v), t = __builtin_amdgcn_rcpf(1.0f + 0.2316418882f * av);
  float q = t * 0.5307027145f - 0.7265760135f; q = q * t + 0.7107068705f; q = q * t - 0.142248368f; q = q * t + 0.127414796f; q = q * t;
  const float tail = q * __builtin_amdgcn_exp2f(v * v * -0.72134752044f);
  return v < 0.f ? v * tail : v - v * tail;
}

#ifndef ROUTE_REPS
#define ROUTE_REPS 1
#endif
__device__ __forceinline__ void ins16(float (&t)[16], float x) {
#pragma unroll
  for (int i = 15; i >= 1; --i) t[i] = __builtin_amdgcn_fmed3f(t[i - 1], t[i], x);
  t[0] = fmaxf(t[0], x);
}
__device__ __forceinline__ void p6_peer(const Frame& F, const Args& a, float* dst_base) {
  const float* S2 = (const float*)(F.ws + WS_S); const float* SSQ = (const float*)(F.ws + WS_SSQ); const bf16* H1b = (const bf16*)(F.ws + WS_H1B);
  int lane = F.lane, wv = F.wave, tid = F.tid; asm volatile("" : "+v"(lane), "+s"(wv), "+v"(tid));
  int* EIDg = (int*)(F.ws + WS_EID); float* EGTg = (float*)(F.ws + WS_EGT);
  LAS int* eid = (LAS int*)(F.lds + wv * 1536); LAS float* egt = (LAS float*)(eid + 128); LAS float* esu = (LAS float*)(eid + 256);
  LAS unsigned char* RB = F.lds + 12288 + wv * 16384;
  LAS float* L1 = (LAS float*)(F.lds + 12288);
  TP_BEGIN(11);
#ifdef TPROBE
  const unsigned long long tp_p7_ = __builtin_amdgcn_s_memrealtime();
#endif
  for (int tb = blockIdx.x; tb < MROWS / 32; tb += gridDim.x) {
    __syncthreads();
    {
      const int g = tid >> 5, tl = tid & 31; const float* src = S2 + ((size_t)(tb * 16 + g) * 128) * 32 + tl;
      float t[16];
#pragma unroll
      for (int i = 0; i < 16; ++i) t[i] = -INFINITY;
#pragma unroll 32
      for (int k = 0; k < 128; ++k) { const float x = src[k * 32]; ins16(t, __builtin_bit_cast(float, (__builtin_bit_cast(unsigned, x) & ~0x7Fu) | (unsigned)(127 - k))); }
#pragma unroll
      for (int i = 0; i < 16; ++i) L1[(g * 16 + i) * 32 + tl] = t[i];
    }
    __syncthreads();
    if (tid < 256) {
      const int h8 = tid >> 5, tl = tid & 31; const LAS float* LA = L1 + ((2 * h8) * 16) * 32 + tl; const LAS float* LB = L1 + ((2 * h8 + 1) * 16) * 32 + tl;
      float A[16], B[16], t[16];
#pragma unroll
      for (int i = 0; i < 16; ++i) { A[i] = LA[i * 32]; B[i] = LB[i * 32]; t[i] = -INFINITY; }
#pragma unroll
      for (int i = 0; i < 16; ++i)
#pragma unroll
        for (int j = 0; j < 16; ++j) if ((i + 1) * (j + 1) <= 16) { const float c = A[i] + B[j];
            ins16(t, __builtin_bit_cast(float, (__builtin_bit_cast(unsigned, c) & ~0xFFu) | (unsigned)(255 - (i * 16 + j)))); }
      float ev[16], es = 0.f;
#pragma unroll
      for (int r = 0; r < 16; ++r) { ev[r] = __expf(t[r] - t[0]); es += ev[r]; }
      const float inv = 1.0f / es;
#pragma unroll
      for (int r = 0; r < 16; ++r) { const unsigned flat = 255u - (__builtin_bit_cast(unsigned, t[r]) & 0xFFu), ii = flat >> 4, jj = flat & 15u;
        const unsigned ka = 127u - (__builtin_bit_cast(unsigned, LA[ii * 32]) & 0x7Fu), kb = 127u - (__builtin_bit_cast(unsigned, LB[jj * 32]) & 0x7Fu);
        EIDg[(size_t)(tb * 32 + tl) * 128 + h8 * 16 + r] = (int)(ka * 128u + kb); EGTg[(size_t)(tb * 32 + tl) * 128 + h8 * 16 + r] = ev[r] * inv; }
    }
    asm volatile("s_waitcnt vmcnt(0)" ::: "memory"); __syncthreads();
    TP_END(11, F.ws);
#pragma unroll 1
    for (int tt = 0; tt < 4; ++tt) {
    TP_BEGIN(12);
    const int tl = wv * 4 + tt, tok = tb * 32 + tl;
    const float rs = rsqrtf(wave_sum_dpp(lane < 32 ? SSQ[(size_t)tok * 32 + lane] : 0.f) * (1.0f / DM) + EPS);
    { const float* SCL = (const float*)(F.ws + WS_SCL);
#pragma unroll
      for (int i = 0; i < 2; ++i) { const int e = lane + 64 * i, idq = __builtin_nontemporal_load(EIDg + (size_t)tok * 128 + e); eid[e] = idq; esu[e] = SCL[idq]; egt[e] = __builtin_nontemporal_load(EGTg + (size_t)tok * 128 + e) * SCL[16384 + idq]; } }
    unsigned xw[16];
    { const bf16* xp = H1b + (size_t)tok * DM + (size_t)lane * 4;
#pragma unroll
      for (int q = 0; q < 8; ++q) { const v2u x0 = *(const v2u*)(xp + q * 256); xw[2 * q] = x0.x; xw[2 * q + 1] = x0.y; } }
    int xl[4], xh[4]; float rsx;
    { float xa = 0.f;
#pragma unroll
      for (int i = 0; i < 16; ++i) xa = fmaxf(xa, fmaxf(fabsf(bflo(xw[i])), fabsf(bfhi(xw[i]))));
#pragma unroll
      for (int o = 1; o < 64; o <<= 1) xa = fmaxf(xa, __shfl_xor(xa, o));
      const float xinv = xa > 0.f ? 119.0f / xa : 0.f; rsx = rs * (xa > 0.f ? xa * (1.0f / 119.0f) : 0.f);
#pragma unroll
      for (int d = 0; d < 4; ++d) { unsigned pl = 0u, ph = 0u;
#pragma unroll
        for (int p = 0; p < 8; ++p) { const int i = 8 * d + p; const float v = (i & 1) ? bfhi(xw[i >> 1]) : bflo(xw[i >> 1]);
          const int xi = (int)__builtin_rintf(v * xinv), l = ((xi + 8) & 15) - 8, h = (xi - l) >> 4;
          pl |= ((unsigned)l & 15u) << (4 * p); ph |= ((unsigned)h & 15u) << (4 * p); }
        xl[d] = (int)pl; xh[d] = (int)ph; } }
    float y[32];
#pragma unroll
    for (int i = 0; i < 32; ++i) y[i] = 0.f;
    asm volatile("s_waitcnt vmcnt(0) lgkmcnt(0)" ::: "memory");
    const unsigned char* U8 = F.ws + WS_UB; const unsigned char* V8 = F.ws + WS_VB8;
#define PG_ISSUE(E) do { const int idq_ = __builtin_amdgcn_readfirstlane(eid[(E)]); LAS unsigned char* sl_ = RB + ((E) & 7) * 2048; \
      __builtin_amdgcn_global_load_lds((const unsigned*)(U8 + (size_t)idq_ * 1024 + lane * 16), (LAS unsigned*)sl_, 16, 0, 0); \
      __builtin_amdgcn_global_load_lds((const unsigned*)(V8 + (size_t)idq_ * 1024 + lane * 16), (LAS unsigned*)(sl_ + 1024), 16, 0, 0); } while (0)
#define PG_DOT(UW, DACC) do { int al_ = 0, ah_ = 0; _Pragma("unroll") for (int dd = 0; dd < 4; ++dd) { const int wa = (int)UW[dd]; \
          al_ = __builtin_amdgcn_sdot8(wa, xl[dd], al_, false); ah_ = __builtin_amdgcn_sdot8(wa, xh[dd], ah_, false); } DACC = (float)(ah_ * 16 + al_); } while (0)
#define PG_AXPY(VW, CF) do { _Pragma("unroll") for (int dd = 0; dd < 4; ++dd) { const unsigned wa = VW[dd]; \
          { const f32x2v v2 = __builtin_amdgcn_cvt_scalef32_pk_f32_fp4(wa, 1.0f, 0); y[8 * dd + 0] += CF * v2.x; y[8 * dd + 1] += CF * v2.y; } \
          { const f32x2v v2 = __builtin_amdgcn_cvt_scalef32_pk_f32_fp4(wa, 1.0f, 1); y[8 * dd + 2] += CF * v2.x; y[8 * dd + 3] += CF * v2.y; } \
          { const f32x2v v2 = __builtin_amdgcn_cvt_scalef32_pk_f32_fp4(wa, 1.0f, 2); y[8 * dd + 4] += CF * v2.x; y[8 * dd + 5] += CF * v2.y; } \
          { const f32x2v v2 = __builtin_amdgcn_cvt_scalef32_pk_f32_fp4(wa, 1.0f, 3); y[8 * dd + 6] += CF * v2.x; y[8 * dd + 7] += CF * v2.y; } } } while (0)
#define PG_BATCH(E0, DOISSUE) do { v4u ub[NBT], vb[NBT]; float su_[NBT], gt_[NBT]; \
      _Pragma("unroll") for (int q = 0; q < NBT; ++q) { const LAS unsigned char* s0_ = RB + (((E0) + q) & 7) * 2048 + lane * 16; ub[q] = *(const LAS v4u*)s0_; vb[q] = *(const LAS v4u*)(s0_ + 1024); su_[q] = esu[(E0) + q]; gt_[q] = egt[(E0) + q]; } \
      asm volatile("s_waitcnt lgkmcnt(0)" ::: "memory"); \
      if (DOISSUE) { _Pragma("unroll") for (int q = 0; q < NBT; ++q) PG_ISSUE((E0) + 8 + q); } \
      float d_[NBT]; _Pragma("unroll") for (int q = 0; q < NBT; ++q) { d_[q] = 0.f; PG_DOT(ub[q], d_[q]); } \
      PROBE_EXTRA \
      _Pragma("unroll") for (int q = 0; q < NBT; ++q) d_[q] = wave_sum_dpp(d_[q]); \
      _Pragma("unroll") for (int q = 0; q < NBT; ++q) { const float c_ = gelu_erf(d_[q] * (rsx * su_[q])) * gt_[q]; PG_AXPY(vb[q], c_); __builtin_amdgcn_sched_barrier(0); } } while (0)
#if defined(PROBE_CVT)
#define PROBE_EXTRA _Pragma("unroll") for (int q = 0; q < NBT; ++q) _Pragma("unroll") for (int dd = 0; dd < 4; ++dd) { const unsigned wz = ub[q][dd]; \
        const f32x2v r0 = __builtin_amdgcn_cvt_scalef32_pk_f32_fp4(wz, 1.0f, 0), r1 = __builtin_amdgcn_cvt_scalef32_pk_f32_fp4(wz, 1.0f, 1), r2 = __builtin_amdgcn_cvt_scalef32_pk_f32_fp4(wz, 1.0f, 2), r3 = __builtin_amdgcn_cvt_scalef32_pk_f32_fp4(wz, 1.0f, 3); \
        asm volatile("" :: "v"(r0), "v"(r1), "v"(r2), "v"(r3)); }
#elif defined(PROBE_DOT)
#define PROBE_EXTRA _Pragma("unroll") for (int q = 0; q < NBT; ++q) _Pragma("unroll") for (int dd = 0; dd < 16; ++dd) { \
        const float r0 = __builtin_amdgcn_fdot2_f32_bf16(__builtin_bit_cast(bfv2, xw[dd]), __builtin_bit_cast(bfv2, ub[q][dd & 3]), su_[q], false); asm volatile("" :: "v"(r0)); }
#elif defined(PROBE_FMA16)
#define PROBE_EXTRA _Pragma("unroll") for (int q = 0; q < NBT; ++q) _Pragma("unroll") for (int dd = 0; dd < 16; ++dd) { \
        unsigned r0 = ub[q][dd & 3]; asm volatile("v_pk_fma_f16 %0, %1, %1, %0" : "+v"(r0) : "v"(xw[dd])); asm volatile("" :: "v"(r0)); }
#elif defined(PROBE_DOTF16)
#define PROBE_EXTRA _Pragma("unroll") for (int q = 0; q < NBT; ++q) _Pragma("unroll") for (int dd = 0; dd < 16; ++dd) { \
        float r0 = su_[q]; asm volatile("v_dot2_f32_f16 %0, %1, %2, %0" : "+v"(r0) : "v"(xw[dd]), "v"(ub[q][dd & 3])); asm volatile("" :: "v"(r0)); }
#elif defined(PROBE_SDOT4)
#define PROBE_EXTRA _Pragma("unroll") for (int q = 0; q < NBT; ++q) _Pragma("unroll") for (int dd = 0; dd < 16; ++dd) { \
        int r0 = (int)ub[q][(dd + 1) & 3]; asm volatile("v_dot4_i32_i8 %0, %1, %2, %0" : "+v"(r0) : "v"(xw[dd]), "v"(ub[q][dd & 3])); asm volatile("" :: "v"(r0)); }
#elif defined(PROBE_SDOT8)
#define PROBE_EXTRA _Pragma("unroll") for (int q = 0; q < NBT; ++q) _Pragma("unroll") for (int dd = 0; dd < 16; ++dd) { \
        int r0 = (int)ub[q][(dd + 1) & 3]; asm volatile("v_dot8_i32_i4 %0, %1, %2, %0" : "+v"(r0) : "v"(xw[dd]), "v"(ub[q][dd & 3])); asm volatile("" :: "v"(r0)); }
#elif defined(PROBE_FMA)
#define PROBE_EXTRA _Pragma("unroll") for (int q = 0; q < NBT; ++q) _Pragma("unroll") for (int dd = 0; dd < 16; ++dd) { \
        f32x2v r0 = {su_[q], gt_[q]}; const f32x2v a_ = {y[2 * dd], y[2 * dd + 1]}; asm volatile("v_pk_fma_f32 %0, %1, %1, %0" : "+v"(r0) : "v"(a_)); asm volatile("" :: "v"(r0)); }
#else
#define PROBE_EXTRA
#endif
    constexpr int NBT = 2;
#pragma unroll
    for (int e = 0; e < 8; ++e) PG_ISSUE(e);
#pragma unroll 1
    for (int e = 0; e < 120; e += NBT) {
      asm volatile("s_waitcnt vmcnt(12)" ::: "memory");
      PG_BATCH(e, true);
      asm volatile("" ::: "memory");
    }
    asm volatile("s_waitcnt vmcnt(0)" ::: "memory");
#pragma unroll 1
    for (int e = 120; e < 128; e += NBT) PG_BATCH(e, false);
    asm volatile("s_waitcnt lgkmcnt(0)" ::: "memory");
#undef PG_ISSUE
#undef PG_DOT
#undef PG_AXPY
#undef PG_BATCH
#undef PROBE_EXTRA
    TP_END(12, F.ws);
    float* drow = dst_base + (size_t)tok * DM;
#pragma unroll
    for (int q = 0; q < 8; ++q) { const size_t off = (size_t)q * 256 + lane * 4; f32x4 hv;
      hv.x = bflo(xw[2 * q]) + y[4 * q];
#ifdef TPROBE
      if (TPROBE != 13 && tok == 0 && lane == 0 && q == 0) hv.x += 10.0f + (float)(*(volatile unsigned*)(F.ws + 64)) * (0.01f / TP_DIV);
      if (TPROBE == 13 && (int)blockIdx.x == TP_BLOCK && wv == 7 && tt == 3 && lane == 0 && q == 0) hv.x += 10.0f + (float)(unsigned)(__builtin_amdgcn_s_memrealtime() - tp_p7_) * (0.01f / TP_DIV);
#endif
      hv.y = bfhi(xw[2 * q]) + y[4 * q + 1]; hv.z = bflo(xw[2 * q + 1]) + y[4 * q + 2]; hv.w = bfhi(xw[2 * q + 1]) + y[4 * q + 3]; *(f32x4*)(drow + off) = hv; }
    }
  }
}
constexpr int MISC_LDS = LDS_BYTES - 256;
__global__ void __launch_bounds__(NTHR, 2) mk_fwd(Args args) {
  extern __shared__ __attribute__((aligned(16))) unsigned char lds_raw[];
  Frame F; F.lds = (LAS unsigned char*)lds_raw; F.ws = args.ws; F.tid = threadIdx.x; F.lane = F.tid & 63; F.wave = __builtin_amdgcn_readfirstlane(F.tid >> 6);
  const int lo = args.ph_lo, hi = args.ph_hi, G = (int)gridDim.x, bx = (int)blockIdx.x;
  volatile LAS unsigned* misc = (volatile LAS unsigned*)(F.lds + MISC_LDS);
  if (F.tid < 16) misc[F.tid] = 0u;
  __syncthreads();
  XcdBarrier bar = xcd_barrier_post((unsigned*)(F.ws + WS_CTL) + CW_BAR, misc);
#define IN(k) (lo <= (k) && (k) < hi)
#ifdef TPROBE
#define SEAM(k) do { if (IN(k) && IN((k) + 1)) { const unsigned long long tq0_ = __builtin_amdgcn_s_memrealtime(); xcd_barrier(bar); const unsigned long long tq1_ = __builtin_amdgcn_s_memrealtime(); \
    if (TPROBE == 20 + (k) && (int)blockIdx.x == TP_BLOCK && threadIdx.x == 0) atomicAdd((unsigned*)(F.ws + 64), (unsigned)(tq1_ - tq0_)); } } while (0)
#else
#define SEAM(k) do { if (IN(k) && IN((k) + 1)) xcd_barrier(bar); } while (0)
#endif
#define PHASE_FRAME(Fp) Frame Fp = F; asm volatile("" : "+v"(Fp.tid), "+v"(Fp.lane))
  const int NA = G;
  if (IN(0)) { PHASE_FRAME(F0); TP_BEGIN(1);
#ifdef SLEEP_START
#pragma unroll 1
    for (int i_ = 0; i_ < SLEEP_START; ++i_) __builtin_amdgcn_s_sleep(127);
#endif
    p0_lam(F0, args);
    p0_zero_vpad(F0);
    p0_rows(F0, args);
    p0_transpose<true>(F0, args, args.in[IN_WIN], DPROJ, NPROJ, (bf16*)(F.ws + WS_W1T));
    p0_transpose<false>(F0, args, args.in[IN_WOUT], DM, DM, (bf16*)(F.ws + WS_W2T));
    p0_w3t(F0, args);
    p0_tables(F0, args);
#ifdef DUP_ROWS
    p0_rows(F0, args);
#endif
#ifdef DUP_TR
    p0_transpose<true>(F0, args, args.in[IN_WIN], DPROJ, NPROJ, (bf16*)(F.ws + WS_W1T));
    p0_transpose<false>(F0, args, args.in[IN_WOUT], DM, DM, (bf16*)(F.ws + WS_W2T));
#endif
#ifdef DUP_W3T
    p0_w3t(F0, args);
#endif
#ifdef DUP_TAB
    p0_tables(F0, args);
#endif
    TP_END(1, F.ws);
  }
  SEAM(0);
  if (IN(1)) { PHASE_FRAME(F1); TP_BEGIN(2);
    p1_meta_finalize(F1, args);
    pg8::Gemm g{(const pg8::bf16_t*)(F.ws + WS_XN), (const pg8::bf16_t*)(F.ws + WS_W1T), MROWS, NPROJ, DM};
    pg8::StaticOrder S; S.init(MROWS, NPROJ, G, bx);
    EpiProj E{(bf16*)(F.ws + WS_Q), (bf16*)(F.ws + WS_KP), (bf16*)(F.ws + WS_VP), (bf16*)(F.ws + WS_MQ), (bf16*)(F.ws + WS_MK), (bf16*)(F.ws + WS_MV), (bf16*)(F.ws + WS_MO),
              args.in[IN_QNG], args.in[IN_KNG], (LAS float*)(F.lds + XCH_OFF)};
    pg8::gemm_phase<EpiProj, pg8::StaticOrder, true, true>(F.lds + RING_OFF, g, S, E);
    TP_END(2, F.ws);
  }
  SEAM(1);
  if (IN(2)) {
    PHASE_FRAME(F2);
    TP_BEGIN(3);
    att::phase(F2, (G % 8 == 0) ? (bx & 7) * (G >> 3) + (bx >> 3) : bx, NA);
    TP_END(3, F.ws); TP_BEGIN(4);
    for (int task = bx; task < 512; task += G) ml::taskA(F2, args, task);
    TP_END(4, F.ws);
  }
  SEAM(2);
  if (IN(3)) { PHASE_FRAME(F3); TP_BEGIN(5); ml::scanB(F3); TP_END(5, F.ws); TP_BEGIN(6); p3_combine(F3, args, NA); TP_END(6, F.ws);
#ifdef DUP_SCAN
    ml::scanB(F3);
#endif
#ifdef DUP_COMB
    p3_combine(F3, args, NA);
#endif
  }
  SEAM(3);
  if (IN(4)) {
    PHASE_FRAME(F4);
    TP_BEGIN(7);
    for (int task = bx; task < 512; task += G) ml::taskC(F4, args, task);
    TP_END(7, F.ws);
  }
  SEAM(4);
  if (IN(5)) { TP_BEGIN(8);
    pg8::Gemm g{(const pg8::bf16_t*)(F.ws + WS_A2), (const pg8::bf16_t*)(F.ws + WS_W2T), MROWS, DM, DM};
    pg8::StaticOrder S; S.init(MROWS, DM, G, bx);
    EpiRes E{args.in[IN_X], args.out, (bf16*)(F.ws + WS_H1B), (float*)(F.ws + WS_SSQ)};
    pg8::gemm_phase<EpiRes, pg8::StaticOrder, true, true>(F.lds + RING_OFF, g, S, E);
    TP_END(8, F.ws);
  }
  SEAM(5);
  if (IN(6)) { TP_BEGIN(9);
    pg8::Gemm g{(const pg8::bf16_t*)(F.ws + WS_H1B), (const pg8::bf16_t*)(F.ws + WS_W3T), MROWS, DM, DM};
    pg8::StaticOrder S; S.init(MROWS, DM, G, bx);
    LAS float* rst = (LAS float*)(F.lds + XCH_OFF);
    { pg8::Unit u0; if (S.next(0, u0)) { if (F.tid < 256) { const float* sp = (const float*)(F.ws + WS_SSQ) + ((size_t)u0.pm * 256 + F.tid) * 32; float s = 0.f;
#pragma unroll
          for (int i = 0; i < 8; ++i) { const f32x4 v = ((const f32x4*)sp)[i]; s += (v.x + v.y) + (v.z + v.w); }
          rst[F.tid] = rsqrtf(s * (1.0f / DM) + EPS); } } }
    __syncthreads();
    EpiScore E{(float*)(F.ws + WS_S), rst};
    pg8::gemm_phase<EpiScore, pg8::StaticOrder, true, true>(F.lds + RING_OFF, g, S, E);
    TP_END(9, F.ws);
  }
  SEAM(6);
  if (IN(7)) { PHASE_FRAME(F7); TP_BEGIN(10); p6_peer(F7, args, args.out); TP_END(10, F.ws); }
#undef IN
#undef SEAM
}
extern "C" void kernel_launch(void* const* d_in, const int* in_sizes, int n_in, void* d_out, int out_size, void* d_ws, size_t ws_size, hipStream_t stream) {
  static int grid = 0;
  if (grid == 0) {
    int dev = 0, cus = 0, per_cu = 0;
    if (hipGetDevice(&dev) != hipSuccess || hipDeviceGetAttribute(&cus, hipDeviceAttributeMultiprocessorCount, dev) != hipSuccess) { fprintf(stderr, "device query failed\n"); grid = -1; return; }
    if (hipFuncSetAttribute((const void*)mk_fwd, hipFuncAttributeMaxDynamicSharedMemorySize, LDS_BYTES) != hipSuccess) { fprintf(stderr, "hipFuncSetAttribute failed\n"); grid = -1; return; }
    if (hipOccupancyMaxActiveBlocksPerMultiprocessor(&per_cu, (const void*)mk_fwd, NTHR, LDS_BYTES) != hipSuccess || per_cu < 1) { fprintf(stderr, "occupancy query says %d workgroups per CU: not launching\n", per_cu); (void)hipGetLastError(); grid = -1; return; }
    (void)hipGetLastError();
    grid = cus;
    if (n_in != 22 || ws_size < (size_t)512 * MiB || out_size != MROWS * DM) { fprintf(stderr, "unexpected shapes: n_in %d out %d ws %zu\n", n_in, out_size, ws_size); grid = -1; return; }
  }
  if (grid < 0) return;
  unsigned char* ws = (unsigned char*)d_ws;
  if (hipMemsetAsync(ws + WS_CTL, 0, CTL_ZERO_BYTES, stream) != hipSuccess) { fprintf(stderr, "memset failed\n"); return; }
  Args a{};
  for (int i = 0; i < 22; ++i) a.in[i] = (const float*)d_in[i];
  a.out = (float*)d_out; a.ws = ws; a.na = 0; a.pad = 0;
  a.ph_lo = 0; a.ph_hi = 8;
  hipLaunchKernelGGL(mk_fwd, dim3(grid), dim3(NTHR), LDS_BYTES, stream, a);
}
```

```cpp
#include <hip/hip_runtime.h>
#include <cstdio>
#include <cstdint>
#include <math.h>
namespace pg8 {
#define PG8_LAS __attribute__((address_space(3)))
typedef unsigned short bf16_t;
typedef short bf16x8 __attribute__((ext_vector_type(8)));
typedef float f32x4 __attribute__((ext_vector_type(4)));
typedef unsigned u32x4 __attribute__((ext_vector_type(4)));
constexpr int BM = 256, BK = 64, HALF = 128, HTB = HALF * BK * 2  , STAGE_BYTES = 8 * HTB, NXCD = 8, WGM = 8;

__host__ __device__ __forceinline__ int lds_byte(int r, int c) { const int st = (r >> 4) * 2 + (c >> 5), rr = r & 15, cc = c & 31, ob = rr * 64 + cc * 2; return st * 1024 + (ob ^ (((ob >> 9) & 1) << 5)); }
__host__ __device__ __forceinline__ void stage_rc(int b, int& R, int& C) { const int st = b / 1024, sb = b % 1024, swz = sb ^ (((sb >> 9) & 1) << 5); R = (st >> 1) * 16 + swz / 64; C = (st & 1) * 32 + (swz % 64) / 2; }
__host__ __device__ __forceinline__ int perm32(int rho) { const int n = rho >> 4, i = rho & 15; return 8 * (i >> 2) + 4 * n + (i & 3); }

struct Unit { int pm, pn; };
struct Gemm { const bf16_t* A; const bf16_t* Bt; int M, N, K; };

struct StaticOrder {
    int nM, nN, nwg, G, c;
    __host__ __device__ void init(int M, int N, int G_, int c_) { nM = M / BM; nN = N / BM; nwg = nM * nN; G = G_; c = c_; }
    __host__ __device__ bool next(int i, Unit& u) const {
        const long L = (long)i * G + c; if (L >= nwg) return false;
        int wgid = (int)L; { const int q = nwg / NXCD, r = nwg % NXCD, xcd = wgid % NXCD, off = wgid / NXCD; wgid = (xcd < r ? xcd * (q + 1) : r * (q + 1) + (xcd - r) * q) + off; }
        const int nig = WGM * nN, gid = wgid / nig, fm = gid * WGM, gsz = (nM - fm) < WGM ? (nM - fm) : WGM;
        u.pm = fm + ((wgid % nig) % gsz); u.pn = (wgid % nig) / gsz; return true;
    }
    __device__ __forceinline__ void a_ready(const Unit&) const {}
    __device__ __forceinline__ void done(const Unit&) const {}
};

__device__ __forceinline__ unsigned cvt_pk_bf16(float lo, float hi) { unsigned r; asm volatile("v_cvt_pk_bf16_f32 %0, %1, %2" : "=v"(r) : "v"(lo), "v"(hi)); return r; }
typedef float f32x2 __attribute__((ext_vector_type(2)));
template <class Epi, class Sched, bool ALIGN_EPI = false, bool SP2 = false>
__device__ __forceinline__ void gemm_phase(PG8_LAS unsigned char* lds, const Gemm g, const Sched& S, const Epi& E) {
    int tid_ = threadIdx.x; asm volatile("" : "+v"(tid_));
    const int tid = tid_, wid = __builtin_amdgcn_readfirstlane(tid >> 6), lane = tid & 63, wr = wid >> 2, wc = wid & 3, fr = lane & 15, fq = lane >> 4;
    const int K = g.K, nt = K / BK;
    unsigned voffA[2], voffB[2];
#pragma unroll
    for (int i = 0; i < 2; ++i) { int R, C; stage_rc(tid * 16 + i * 8192, R, C); const int Rb = Epi::PERM ? ((R & ~31) + perm32(R & 31)) : R;
        voffA[i] = (unsigned)(R * K + C) * 2u; voffB[i] = (unsigned)(Rb * K + C) * 2u; }
    const size_t kstep = (size_t)(BK * 2);
    const size_t hstep = (size_t)HALF * K * 2;
    const size_t tstep = 2 * hstep;
    const unsigned ldsw = (unsigned)wid * 1024u;
    const int aoff = lds_byte(wr * 64 + fr, fq * 8), boff = lds_byte(wc * 32 + fr, fq * 8);
#define PG8_SA(b, h) (((b) * 2 + (h)) * HTB)
#define PG8_SB(b, h) ((4 + (b) * 2 + (h)) * HTB)
#define PG8_STAGE(bufoff, gbase, voff) do { _Pragma("unroll") for (int _i = 0; _i < 2; ++_i) \
        __builtin_amdgcn_global_load_lds((const unsigned*)((const char*)(gbase) + (voff)[_i]), (PG8_LAS unsigned*)(lds + (bufoff) + ldsw + _i * 8192), 16, 0, 0); } while (0)
#define PG8_LDA(dst, b, h) do { _Pragma("unroll") for (int m = 0; m < 4; ++m) _Pragma("unroll") for (int k = 0; k < 2; ++k) dst[m][k] = *(const PG8_LAS bf16x8*)(lds + PG8_SA(b, h) + aoff + m * 2048 + k * 1024); } while (0)
#define PG8_LDB(dst, b, h) do { _Pragma("unroll") for (int n = 0; n < 2; ++n) _Pragma("unroll") for (int k = 0; k < 2; ++k) dst[n][k] = *(const PG8_LAS bf16x8*)(lds + PG8_SB(b, h) + boff + n * 2048 + k * 1024); } while (0)
#define PG8_MMA(ai, bj, At, Bt) do { __builtin_amdgcn_s_setprio(1); _Pragma("unroll") for (int m = 0; m < 4; ++m) _Pragma("unroll") for (int n = 0; n < 2; ++n) _Pragma("unroll") for (int k = 0; k < 2; ++k) \
        acc[ai][bj][m][n] = __builtin_amdgcn_mfma_f32_16x16x32_bf16(Bt[n][k], At[m][k], acc[ai][bj][m][n], 0, 0, 0); __builtin_amdgcn_s_setprio(0); } while (0)
#define PG8_WAIT_V(n) asm volatile("s_waitcnt vmcnt(" #n ")" ::: "memory")
#define PG8_WAIT_L(n) asm volatile("s_waitcnt lgkmcnt(" #n ")" ::: "memory")
#define PG8_BAR __builtin_amdgcn_s_barrier()
#define PG8_SCHED __builtin_amdgcn_sched_barrier(0)
    Unit cur, nxt; int ui = 0;
    if (!S.next(0, cur)) return;
    f32x4 acc[2][2][4][2];
#pragma unroll
    for (int a = 0; a < 2; ++a)
#pragma unroll
        for (int b = 0; b < 2; ++b)
#pragma unroll
            for (int m = 0; m < 4; ++m)
#pragma unroll
                for (int n = 0; n < 2; ++n) acc[a][b][m][n] = (f32x4){0.f, 0.f, 0.f, 0.f};
    bf16x8 At[4][2], B0[2][2], B1[2][2];
    const char* cA = (const char*)g.A + (size_t)cur.pm * tstep; const char* cB = (const char*)g.Bt + (size_t)cur.pn * tstep;
    S.a_ready(cur);
    if constexpr (SP2) {
        PG8_STAGE(PG8_SB(0, 0), cB, voffB); PG8_STAGE(PG8_SB(0, 1), cB + hstep, voffB); PG8_STAGE(PG8_SA(0, 0), cA, voffA); PG8_STAGE(PG8_SA(0, 1), cA + hstep, voffA);
        if (wr == 1) PG8_BAR;
        PG8_WAIT_V(2); PG8_BAR;
        PG8_STAGE(PG8_SB(1, 0), cB + kstep, voffB); PG8_STAGE(PG8_SA(1, 0), cA + kstep, voffA); PG8_STAGE(PG8_SB(1, 1), cB + hstep + kstep, voffB);
        PG8_WAIT_V(6); PG8_BAR;
    } else {
        PG8_STAGE(PG8_SB(0, 0), cB, voffB); PG8_STAGE(PG8_SA(0, 0), cA, voffA); PG8_STAGE(PG8_SB(0, 1), cB + hstep, voffB); PG8_STAGE(PG8_SA(0, 1), cA + hstep, voffA);
        if (wr == 1) PG8_BAR;
        PG8_WAIT_V(4); PG8_BAR;
        PG8_STAGE(PG8_SB(1, 0), cB + kstep, voffB); PG8_STAGE(PG8_SA(1, 0), cA + kstep, voffA); PG8_STAGE(PG8_SB(1, 1), cB + hstep + kstep, voffB);
        PG8_WAIT_V(6); PG8_BAR;
    }
    for (;;) {
        const bool has_next = S.next(ui + 1, nxt);
        const char* nA = has_next ? (const char*)g.A + (size_t)nxt.pm * tstep : cA; const char* nB = has_next ? (const char*)g.Bt + (size_t)nxt.pn * tstep : cB;
        for (int t = 0; t < nt; t += 2) {
            const bool last = (t == nt - 2);
            const char* a1 = cA + (size_t)(t + 1) * kstep;
            const char* a2 = last ? nA : cA + (size_t)(t + 2) * kstep; const char* b2 = last ? nB : cB + (size_t)(t + 2) * kstep;
            const char* a3 = a2 + kstep; const char* b3 = b2 + kstep;
            if (last && has_next) S.a_ready(nxt);
            if constexpr (SP2) {
            PG8_LDB(B0, 0, 0); PG8_LDB(B1, 0, 1); PG8_SCHED; PG8_LDA(At, 0, 0); PG8_STAGE(PG8_SA(1, 1), a1 + hstep, voffA);
            PG8_WAIT_V(8); PG8_WAIT_L(0); PG8_BAR; PG8_MMA(0, 0, At, B0); PG8_MMA(0, 1, At, B1); PG8_BAR; PG8_SCHED;
            PG8_LDA(At, 0, 1); PG8_STAGE(PG8_SB(0, 0), b2, voffB); PG8_STAGE(PG8_SB(0, 1), b2 + hstep, voffB); PG8_STAGE(PG8_SA(0, 0), a2, voffA);
            PG8_WAIT_V(8); PG8_WAIT_L(0); PG8_BAR; PG8_MMA(1, 0, At, B0); PG8_MMA(1, 1, At, B1); PG8_BAR; PG8_SCHED;
            PG8_LDB(B0, 1, 0); PG8_LDB(B1, 1, 1); PG8_SCHED; PG8_LDA(At, 1, 0); PG8_STAGE(PG8_SA(0, 1), a2 + hstep, voffA);
            PG8_WAIT_V(8); PG8_WAIT_L(0); PG8_BAR; PG8_MMA(0, 0, At, B0); PG8_MMA(0, 1, At, B1); PG8_BAR; PG8_SCHED;
            PG8_LDA(At, 1, 1); PG8_STAGE(PG8_SB(1, 0), b3, voffB); PG8_STAGE(PG8_SB(1, 1), b3 + hstep, voffB); PG8_STAGE(PG8_SA(1, 0), a3, voffA);
            PG8_WAIT_V(8); PG8_WAIT_L(0); PG8_BAR; PG8_MMA(1, 0, At, B0); PG8_MMA(1, 1, At, B1); PG8_BAR; PG8_SCHED;
            } else {
            PG8_LDB(B0, 0, 0); PG8_SCHED; PG8_LDA(At, 0, 0); PG8_STAGE(PG8_SA(1, 1), a1 + hstep, voffA);
            PG8_WAIT_L(8); PG8_BAR; PG8_WAIT_L(0); PG8_MMA(0, 0, At, B0); PG8_BAR; PG8_SCHED;
            PG8_LDB(B1, 0, 1); PG8_STAGE(PG8_SB(0, 0), b2, voffB);
            PG8_BAR; PG8_WAIT_L(0); PG8_MMA(0, 1, At, B1); PG8_BAR;
            PG8_LDA(At, 0, 1); PG8_STAGE(PG8_SA(0, 0), a2, voffA);
            PG8_BAR; PG8_WAIT_L(0); PG8_MMA(1, 0, At, B0); PG8_BAR; PG8_SCHED;
            PG8_STAGE(PG8_SB(0, 1), b2 + hstep, voffB);
            PG8_WAIT_V(6); PG8_BAR; PG8_MMA(1, 1, At, B1); PG8_BAR;
            PG8_LDB(B0, 1, 0); PG8_SCHED; PG8_LDA(At, 1, 0); PG8_STAGE(PG8_SA(0, 1), a2 + hstep, voffA);
            PG8_WAIT_L(8); PG8_BAR; PG8_WAIT_L(0); PG8_MMA(0, 0, At, B0); PG8_BAR; PG8_SCHED;
            PG8_LDB(B1, 1, 1); PG8_STAGE(PG8_SB(1, 0), b3, voffB);
            PG8_BAR; PG8_WAIT_L(0); PG8_MMA(0, 1, At, B1); PG8_BAR;
            PG8_LDA(At, 1, 1); PG8_STAGE(PG8_SA(1, 0), a3, voffA);
            PG8_BAR; PG8_WAIT_L(0); PG8_MMA(1, 0, At, B0); PG8_BAR; PG8_SCHED;
            PG8_STAGE(PG8_SB(1, 1), b3 + hstep, voffB);
            PG8_WAIT_V(6); PG8_BAR; PG8_MMA(1, 1, At, B1); PG8_BAR;
            }
        }
        if constexpr (ALIGN_EPI) { if (wr == 0) PG8_BAR; }
        if constexpr (!Epi::AFTER_DRAIN) { E(acc, cur, wr, wc, fr, fq); S.done(cur); }
        if (!has_next) break;
#pragma unroll
        for (int a = 0; a < 2; ++a)
#pragma unroll
            for (int b = 0; b < 2; ++b)
#pragma unroll
                for (int m = 0; m < 4; ++m)
#pragma unroll
                    for (int n = 0; n < 2; ++n) acc[a][b][m][n] = (f32x4){0.f, 0.f, 0.f, 0.f};
        cur = nxt; cA = nA; cB = nB; ++ui;
        if constexpr (ALIGN_EPI) { if (wr == 1) PG8_BAR; }
    }
    PG8_WAIT_V(0);
    if constexpr (!ALIGN_EPI) { if (wr == 0) PG8_BAR; }
    PG8_BAR;
    if constexpr (Epi::AFTER_DRAIN) { E.fused(acc, cur, wr, wc, fr, fq, lds, wid, lane); S.done(cur); }
#undef PG8_SA
#undef PG8_SB
#undef PG8_STAGE
#undef PG8_LDA
#undef PG8_LDB
#undef PG8_MMA
#undef PG8_WAIT_V
#undef PG8_WAIT_L
#undef PG8_BAR
#undef PG8_SCHED
}
}
#define GAS __attribute__((address_space(1)))
#define LAS __attribute__((address_space(3)))
typedef unsigned short bf16;
typedef unsigned v4u __attribute__((ext_vector_type(4)));
typedef unsigned v2u __attribute__((ext_vector_type(2)));
typedef float f32x4 __attribute__((ext_vector_type(4)));
typedef short bf16x8 __attribute__((ext_vector_type(8)));
#define LDS_WAIT() asm volatile("s_waitcnt lgkmcnt(0)" ::: "memory")
#define VM_WAIT() asm volatile("s_waitcnt vmcnt(0)" ::: "memory")

constexpr int DM = 2048, NB = 4, SEQ = 2048, NMETA = 16, MROWS = NB * SEQ, DPROJ = 6152, NPROJ = 6144;
constexpr int PADT = 2112, POS0 = 64, MPOS0 = 48;
constexpr float EPS = 1e-6f;
constexpr float LOG2E = 1.4426950408889634f;
constexpr float QSCALE = 0.08838834764831845f * LOG2E;
constexpr int NWAVES = 8, NTHR = 512;

constexpr size_t MiB = 1u << 20;
constexpr size_t WS_CTL = 0, CTL_ZERO_BYTES = 32 * 1024;
constexpr size_t WS_PM = 484 * MiB;
constexpr size_t WS_W1T = 2 * MiB, WS_W2T = 26 * MiB, WS_W3T = 34 * MiB, WS_XN = 42 * MiB;
constexpr size_t WS_Q = 74 * MiB, WS_KP = 90 * MiB, WS_VP = 107 * MiB, WS_MQ = 124 * MiB, WS_MK = 133 * MiB, WS_MV = 142 * MiB, WS_MO = 159 * MiB;
constexpr size_t WS_SMALL = 175 * MiB;
constexpr size_t WS_XM = WS_SMALL, WS_LI = WS_SMALL + 128 * 1024, WS_LF = WS_SMALL + 384 * 1024, WS_LAM = WS_SMALL + 640 * 1024;
constexpr size_t WS_PO = 176 * MiB, WS_ML = 304 * MiB, WS_HM = 305 * MiB, WS_A2 = 42 * MiB, WS_H1B = 74 * MiB, WS_SSQ = 106 * MiB, WS_S = 176 * MiB, WS_UB = 384 * MiB, WS_VB = 448 * MiB;
constexpr size_t WS_SCL = WS_SMALL + 704 * 1024;
constexpr size_t WS_VB8 = WS_UB + 32 * MiB;
constexpr size_t WS_DC = 305 * MiB, WS_CS = 448 * MiB, WS_DN = 482 * MiB, WS_NS = WS_DN + 512 * 1024, WS_GS = WS_DN + 1024 * 1024, WS_MS = WS_DN + 1152 * 1024;
constexpr size_t WS_EID = 240 * MiB, WS_EGT = 244 * MiB;
constexpr int CW_BAR = 4096;

constexpr int RING_OFF = 0, RING_BYTES = 131072;
constexpr int XCH_OFF = 131072;
constexpr int MISC_OFF = XCH_OFF + 8192;
constexpr int LDS_BYTES = 155648;

__device__ __forceinline__ unsigned f2bf(float f) { unsigned u = __builtin_bit_cast(unsigned, f); return (u + 0x7fffu + ((u >> 16) & 1u)) >> 16; }
__device__ __forceinline__ unsigned pk2(float lo, float hi) { return f2bf(lo) | (f2bf(hi) << 16); }
__device__ __forceinline__ float bf2f(unsigned short u) { return __builtin_bit_cast(float, (unsigned)u << 16); }
__device__ __forceinline__ float bflo(unsigned w) { return __builtin_bit_cast(float, w << 16); }
__device__ __forceinline__ float bfhi(unsigned w) { return __builtin_bit_cast(float, w & 0xffff0000u); }
__device__ __forceinline__ float wave_sum(float v) {
#pragma unroll
  for (int o = 1; o < 64; o <<= 1) v += __shfl_xor(v, o);
  return v;
}
__device__ __forceinline__ size_t kp_off(int bhm, int pos, int d) { const int j = pos >> 6, row = pos & 63, d0 = d >> 4, hi = (d >> 3) & 1;
  return ((size_t)(bhm * 33 + j) * 8 + d0) * 1024 + (size_t)((((row << 1) | hi) ^ ((row >> 3) & 1)) << 3) + (d & 7); }
__device__ __forceinline__ float wave_sum_dpp(float v) {
  v += __builtin_bit_cast(float, __builtin_amdgcn_update_dpp(0, __builtin_bit_cast(int, v), 0xB1, 0xF, 0xF, true));
  v += __builtin_bit_cast(float, __builtin_amdgcn_update_dpp(0, __builtin_bit_cast(int, v), 0x4E, 0xF, 0xF, true));
  v += __builtin_bit_cast(float, __builtin_amdgcn_update_dpp(0, __builtin_bit_cast(int, v), 0x141, 0xF, 0xF, true));
  v += __builtin_bit_cast(float, __builtin_amdgcn_update_dpp(0, __builtin_bit_cast(int, v), 0x140, 0xF, 0xF, true));
  const float r0 = __builtin_bit_cast(float, __builtin_amdgcn_readlane(__builtin_bit_cast(int, v), 0)), r1 = __builtin_bit_cast(float, __builtin_amdgcn_readlane(__builtin_bit_cast(int, v), 16));
  const float r2 = __builtin_bit_cast(float, __builtin_amdgcn_readlane(__builtin_bit_cast(int, v), 32)), r3 = __builtin_bit_cast(float, __builtin_amdgcn_readlane(__builtin_bit_cast(int, v), 48));
  return (r0 + r1) + (r2 + r3);
}
__device__ __forceinline__ float sigmoidf_(float x) { return 1.0f / (1.0f + __expf(-x)); }

#ifdef TPROBE
#ifndef TP_BLOCK
#define TP_BLOCK 0
#endif
#ifndef TP_DIV
#define TP_DIV 1.0f
#endif
#define TP_BEGIN(id) unsigned long long tp_t0_##id = 0; do { if (TPROBE == (id)) tp_t0_##id = __builtin_amdgcn_s_memrealtime(); } while (0)
#define TP_END(id, WS) do { if (TPROBE == (id)) { const unsigned long long t1_ = __builtin_amdgcn_s_memrealtime(); if ((int)blockIdx.x == TP_BLOCK && threadIdx.x == 0) atomicAdd((unsigned*)((WS) + 64), (unsigned)(t1_ - tp_t0_##id)); } } while (0)
#else
#define TP_BEGIN(id)
#define TP_END(id, WS)
#endif
#define XB_TMO      128
#define XB_XCNT(j)  (256  + 64 * (j))
#define XB_XSUB(j)  (1280 + 64 * (j))
#define XB_XGEN(j)  (2304 + 64 * (j))
#define XB_TOP      3328
#define XB_TOPGEN   3392
#define XCD_BAR_WORDS 3456
#define XB_SPIN_CAP (1u << 18)

__device__ __forceinline__ unsigned xb_ld(unsigned* p)              { return __hip_atomic_load(p, __ATOMIC_RELAXED, __HIP_MEMORY_SCOPE_AGENT); }
__device__ __forceinline__ unsigned xb_add(unsigned* p, unsigned v) { return __hip_atomic_fetch_add(p, v, __ATOMIC_RELAXED, __HIP_MEMORY_SCOPE_AGENT); }
__device__ __forceinline__ unsigned xb_xcc_id() { return (unsigned)__builtin_amdgcn_s_getreg((3 << 11) | 20) & 0xFu; }
#define XB_SPIN(cond, bar) do { unsigned _sp = 0; while (cond) { __builtin_amdgcn_s_sleep(1); \
    if ((++_sp & 255u) == 0u) { if (xb_ld(&(bar)[XB_TMO])) break; if (_sp > XB_SPIN_CAP) { atomicAdd(&(bar)[XB_TMO], 1u); break; } } } } while (0)

struct XcdBarrier {
    unsigned* bar; unsigned x;
    volatile LAS unsigned* st;
};

__device__ __forceinline__ XcdBarrier xcd_barrier_post(unsigned* bar, volatile LAS unsigned* st) {
    XcdBarrier b; b.bar = bar; b.x = xb_xcc_id(); b.st = st;
    if (threadIdx.x == 0) (void)xb_add(&bar[XB_XCNT(b.x)], 1u);
    return b;
}
__device__ __forceinline__ void xcd_barrier_complete(unsigned* bar, unsigned x, unsigned& nloc, unsigned& nx) {
    const unsigned G = gridDim.x * gridDim.y * gridDim.z;
    unsigned sum, cnt, mine, sp = 0u;
    for (;;) {
        sum = 0u; cnt = 0u; mine = 0u;
#pragma unroll
        for (unsigned j = 0; j < 16; ++j) { const unsigned c = xb_ld(&bar[XB_XCNT(j)]); sum += c; cnt += (c > 0u) ? 1u : 0u; mine = (j == x) ? c : mine; }
        if (sum == G) break;
        __builtin_amdgcn_s_sleep(1);
        if ((++sp & 255u) == 0u) { if (xb_ld(&bar[XB_TMO])) break; if (sp > XB_SPIN_CAP) { atomicAdd(&bar[XB_TMO], 1u); break; } }
    }
    nloc = mine > 0u ? mine : 1u; nx = cnt > 0u ? cnt : 1u;
}

__device__ __forceinline__ void xcd_barrier(const XcdBarrier& b) {
    asm volatile("s_waitcnt vmcnt(0)" ::: "memory");
    __syncthreads();
    if (threadIdx.x == 0) {
        unsigned* bar = b.bar;
        __builtin_amdgcn_s_waitcnt(0);
        unsigned nloc = b.st[0], nx = b.st[1];
        if (nloc == 0u) { xcd_barrier_complete(bar, b.x, nloc, nx); b.st[0] = nloc; b.st[1] = nx; }
        const unsigned old = xb_add(&bar[XB_XSUB(b.x)], 1u);
        const unsigned gen = old / nloc;
        if (old + 1u == (gen + 1u) * nloc) {
            __builtin_amdgcn_fence(__ATOMIC_RELEASE, "agent");
            asm volatile("s_waitcnt vmcnt(0)" ::: "memory");
            const unsigned og = xb_add(&bar[XB_TOP], 1u);
            const unsigned tg = og / nx;
            if (og + 1u == (tg + 1u) * nx) xb_add(&bar[XB_TOPGEN], 1u);
            else XB_SPIN(xb_ld(&bar[XB_TOPGEN]) == tg, bar);
            __builtin_amdgcn_fence(__ATOMIC_ACQUIRE, "agent");
            xb_add(&bar[XB_XGEN(b.x)], 1u);
            asm volatile("s_waitcnt vmcnt(0)" ::: "memory");
        } else {
            XB_SPIN(xb_ld(&bar[XB_XGEN(b.x)]) == gen, bar);
            __builtin_amdgcn_fence(__ATOMIC_ACQUIRE, "agent");
            asm volatile("s_waitcnt vmcnt(0)" ::: "memory");
        }
    }
    __syncthreads();
}

struct Args { const float* in[22]; float* out; unsigned char* ws; int ph_lo, ph_hi, na, pad; };
struct Frame {
  LAS unsigned char* lds; unsigned char* ws; int tid, lane, wave; const float* const* in;
};
#define IN_X 0
#define IN_META 1
#define IN_G1 2
#define IN_WIN 3
#define IN_CW 4
#define IN_CB 5
#define IN_IGB 6
#define IN_FGB 7
#define IN_LQ1 8
#define IN_LK1 9
#define IN_LQ2 10
#define IN_LK2 11
#define IN_QNG 12
#define IN_KNG 13
#define IN_SUBG 14
#define IN_OUTG 15
#define IN_WOUT 16
#define IN_G2 17
#define IN_WQ 18
#define IN_SUBK 19
#define IN_U 20
#define IN_V 21

__device__ __forceinline__ void p0_rows(const Frame& F, const Args& a) {
  const float* x = a.in[IN_X]; const float* meta = a.in[IN_META]; const float* g1 = a.in[IN_G1]; const float* w_in = a.in[IN_WIN];
  const float* igb = a.in[IN_IGB]; const float* fgb = a.in[IN_FGB];
  bf16* Xn = (bf16*)(F.ws + WS_XN); bf16* Xm = (bf16*)(F.ws + WS_XM); float* LI = (float*)(F.ws + WS_LI); float* LF = (float*)(F.ws + WS_LF);
  LAS f32x4* wgl = (LAS f32x4*)(F.lds);
  for (int e = F.tid; e < 4096; e += NTHR) {
    const int ln = e & 63, q = e >> 6, half = q & 1, j = (q >> 1) & 3, i = q >> 3;
    const int k = 4 * (i * 64 + ln) + j;
    wgl[e] = *(const f32x4*)(w_in + (size_t)k * DPROJ + NPROJ + 4 * half);
  }
  __syncthreads();
  const int gw = blockIdx.x * NWAVES + F.wave, NGW = gridDim.x * NWAVES, lane = F.lane;
  constexpr int NTASK = MROWS / 2 + NMETA / 2;
  f32x4 xnx[2][8];
  if (gw < NTASK) { const float* sn = (gw >= MROWS / 2 ? meta + (size_t)(gw - MROWS / 2) * 2 * DM : x + (size_t)gw * 2 * DM);
#pragma unroll
    for (int i = 0; i < 8; ++i) { xnx[0][i] = ((const f32x4*)sn)[i * 64 + lane]; xnx[1][i] = ((const f32x4*)(sn + DM))[i * 64 + lane]; } }
  for (int task = gw; task < NTASK; task += NGW) {
    const bool ismeta = task >= MROWS / 2;
    const int r0 = ismeta ? (task - MROWS / 2) * 2 : task * 2;
    f32x4 xv[2][8]; float rs[2];
    { float s0 = 0.f, s1 = 0.f;
#pragma unroll
      for (int i = 0; i < 8; ++i) { xv[0][i] = xnx[0][i]; xv[1][i] = xnx[1][i]; }
      { const int tn = task + NGW; if (tn < NTASK) { const float* sn = (tn >= MROWS / 2 ? meta + (size_t)(tn - MROWS / 2) * 2 * DM : x + (size_t)tn * 2 * DM);
#pragma unroll
          for (int i = 0; i < 8; ++i) { xnx[0][i] = ((const f32x4*)sn)[i * 64 + lane]; xnx[1][i] = ((const f32x4*)(sn + DM))[i * 64 + lane]; } } }
#pragma unroll
      for (int i = 0; i < 8; ++i) { const f32x4 a0 = xv[0][i], a1 = xv[1][i];
        s0 += (a0.x * a0.x + a0.y * a0.y) + (a0.z * a0.z + a0.w * a0.w); s1 += (a1.x * a1.x + a1.y * a1.y) + (a1.z * a1.z + a1.w * a1.w); }
      rs[0] = rsqrtf(wave_sum_dpp(s0) * (1.0f / DM) + EPS); rs[1] = rsqrtf(wave_sum_dpp(s1) * (1.0f / DM) + EPS); }
    float ga[2][8];
#pragma unroll
    for (int rr = 0; rr < 2; ++rr)
#pragma unroll
      for (int g = 0; g < 8; ++g) ga[rr][g] = 0.f;
    bf16* dst0 = (ismeta ? Xm : Xn) + (size_t)r0 * DM;
#pragma unroll
    for (int i = 0; i < 8; ++i) {
      const f32x4 g = ((const f32x4*)g1)[i * 64 + lane];
      f32x4 xn[2];
#pragma unroll
      for (int rr = 0; rr < 2; ++rr) { xn[rr] = xv[rr][i] * g * rs[rr];
        v2u o; o.x = pk2(xn[rr].x, xn[rr].y); o.y = pk2(xn[rr].z, xn[rr].w); ((v2u*)(dst0 + (size_t)rr * DM))[i * 64 + lane] = o; }
#pragma unroll
      for (int j = 0; j < 4; ++j) {
        const f32x4 w0 = wgl[((i * 4 + j) * 2 + 0) * 64 + lane], w1 = wgl[((i * 4 + j) * 2 + 1) * 64 + lane];
#pragma unroll
        for (int rr = 0; rr < 2; ++rr) { const float xs_ = xn[rr][j];
          ga[rr][0] += xs_ * w0.x; ga[rr][1] += xs_ * w0.y; ga[rr][2] += xs_ * w0.z; ga[rr][3] += xs_ * w0.w;
          ga[rr][4] += xs_ * w1.x; ga[rr][5] += xs_ * w1.y; ga[rr][6] += xs_ * w1.z; ga[rr][7] += xs_ * w1.w; }
      }
      __builtin_amdgcn_sched_barrier(0);
    }
#pragma unroll
    for (int rr = 0; rr < 2; ++rr)
#pragma unroll
      for (int g = 0; g < 8; ++g) ga[rr][g] = wave_sum_dpp(ga[rr][g]);
    if (lane < 8) {
      const int rr = lane >> 2, h = lane & 3;
      float gi = 0.f, gf = 0.f;
#pragma unroll
      for (int q = 0; q < 2; ++q)
#pragma unroll
        for (int hh = 0; hh < 4; ++hh) if (q == rr && hh == h) { gi = ga[q][hh]; gf = ga[q][4 + hh]; }
      const float li = gi + igb[h]; const float fx = gf + fgb[h];
      const float lf = fminf(fx, 0.f) - log1pf(__expf(-fabsf(fx)));
      const int R = r0 + rr;
      if (!ismeta) { const int b = R >> 11, t = R & 2047; LI[(b * 4 + h) * PADT + POS0 + t] = li; LF[(b * 4 + h) * PADT + POS0 + t] = lf; }
      else { for (int b = 0; b < NB; ++b) { LI[(b * 4 + h) * PADT + MPOS0 + R] = li; LF[(b * 4 + h) * PADT + MPOS0 + R] = lf; } }
    }
  }
  __syncthreads();
}
template <bool META>
__device__ __forceinline__ void p0_transpose(const Frame& F, const Args& a, const float* W, int ldw, int N, bf16* Wt) {
  LAS float* tl = (LAS float*)(F.lds);
  LAS float* red = (LAS float*)(F.lds + 33792);
  float* PM = (float*)(F.ws + WS_PM);
  const float* meta = a.in[IN_META]; const float* g1 = a.in[IN_G1];
  const int ntn = N / 64, ntask = ntn * 16, fr = F.lane & 15, fq = F.lane >> 4, w = F.wave;
  f32x4 wn[4];
  float am[4], ag[4];
  if ((int)blockIdx.x < ntask) { const int nb = blockIdx.x % ntn, kb = blockIdx.x / ntn;
#pragma unroll
    for (int i = 0; i < 4; ++i) { const int idx = F.tid + NTHR * i, kk = idx >> 4, c4 = idx & 15; wn[i] = *(const f32x4*)(W + (size_t)(kb * 128 + kk) * ldw + nb * 64 + 4 * c4); }
    if (META) {
#pragma unroll
      for (int s_ = 0; s_ < 4; ++s_) { const int k = kb * 128 + 16 * w + 4 * s_ + fq; am[s_] = meta[(size_t)fr * DM + k]; ag[s_] = g1[k]; } } }
  for (int task = blockIdx.x; task < ntask; task += gridDim.x) {
    const int nb = task % ntn, kb = task / ntn, n0 = nb * 64, k0 = kb * 128;
    __syncthreads();
#pragma unroll
    for (int i = 0; i < 4; ++i) { const int idx = F.tid + NTHR * i, kk = idx >> 4, c4 = idx & 15; const f32x4 wv = wn[i];
      LAS float* d = tl + kk * 65 + 4 * c4; d[0] = wv.x; d[1] = wv.y; d[2] = wv.z; d[3] = wv.w; }
    float ac[4];
    if (META) {
#pragma unroll
      for (int s_ = 0; s_ < 4; ++s_) ac[s_] = am[s_] * ag[s_]; }
    { const int tn = task + gridDim.x; if (tn < ntask) { const int nb2 = tn % ntn, kb2 = tn / ntn;
#pragma unroll
        for (int i = 0; i < 4; ++i) { const int idx = F.tid + NTHR * i, kk = idx >> 4, c4 = idx & 15; wn[i] = *(const f32x4*)(W + (size_t)(kb2 * 128 + kk) * ldw + nb2 * 64 + 4 * c4); }
        if (META) {
#pragma unroll
          for (int s_ = 0; s_ < 4; ++s_) { const int k = kb2 * 128 + 16 * w + 4 * s_ + fq; am[s_] = meta[(size_t)fr * DM + k]; ag[s_] = g1[k]; } } } }
    __syncthreads();
    const int n = F.tid >> 3, kc = F.tid & 7;
    const LAS float* s = tl + (kc * 16) * 65 + n;
    v4u o0, o1;
    o0.x = pk2(s[0 * 65], s[1 * 65]); o0.y = pk2(s[2 * 65], s[3 * 65]); o0.z = pk2(s[4 * 65], s[5 * 65]); o0.w = pk2(s[6 * 65], s[7 * 65]);
    o1.x = pk2(s[8 * 65], s[9 * 65]); o1.y = pk2(s[10 * 65], s[11 * 65]); o1.z = pk2(s[12 * 65], s[13 * 65]); o1.w = pk2(s[14 * 65], s[15 * 65]);
    v4u* dp = (v4u*)(Wt + (size_t)(n0 + n) * DM + k0 + kc * 16);
    dp[0] = o0; dp[1] = o1;
    if (META && n0 >= 1024) {
      f32x4 acc[4];
#pragma unroll
      for (int nt = 0; nt < 4; ++nt) acc[nt] = (f32x4){0.f, 0.f, 0.f, 0.f};
#pragma unroll
      for (int s_ = 0; s_ < 4; ++s_)
#pragma unroll
        for (int nt = 0; nt < 4; ++nt) acc[nt] = __builtin_amdgcn_mfma_f32_16x16x4f32(ac[s_], tl[(16 * w + 4 * s_ + fq) * 65 + nt * 16 + fr], acc[nt], 0, 0, 0);
#pragma unroll
      for (int nt = 0; nt < 4; ++nt)
#pragma unroll
        for (int i = 0; i < 4; ++i) red[(w * 16 + 4 * fq + i) * 64 + nt * 16 + fr] = acc[nt][i];
      __syncthreads();
#pragma unroll
      for (int j = 0; j < 2; ++j) { const int idx = F.tid + NTHR * j, m = idx >> 6, nn = idx & 63; const LAS float* r = red + m * 64 + nn;
        PM[((size_t)kb * 16 + m) * NPROJ + n0 + nn] = ((r[0] + r[1024]) + (r[2048] + r[3072])) + ((r[4096] + r[5120]) + (r[6144] + r[7168])); }
    }
  }
  __syncthreads();
}
__device__ __forceinline__ void p0_zero_vpad(const Frame& F) {
  bf16* Vp = (bf16*)(F.ws + WS_VP);
  const int per = MPOS0 * 256 / 8;
  for (int i = blockIdx.x * NTHR + F.tid; i < 16 * per; i += gridDim.x * NTHR) { const int bh = i / per, e = i % per;
    *(v4u*)(Vp + (size_t)bh * PADT * 256 + (size_t)e * 8) = (v4u){0u, 0u, 0u, 0u}; }
}
__device__ __forceinline__ void p0_lam(const Frame& F, const Args& a) {
  if (blockIdx.x == 0 && F.wave == 0) {
    const int l = F.lane;
    float s1 = a.in[IN_LQ1][l] * a.in[IN_LK1][l] + a.in[IN_LQ1][l + 64] * a.in[IN_LK1][l + 64];
    float s2 = a.in[IN_LQ2][l] * a.in[IN_LK2][l] + a.in[IN_LQ2][l + 64] * a.in[IN_LK2][l + 64];
    s1 = wave_sum(s1); s2 = wave_sum(s2);
    if (l == 0) *(float*)(F.ws + WS_LAM) = __expf(s1) - __expf(s2) + 0.2f;
  }
}

struct EpiProj {
  static constexpr bool PERM = true, AFTER_DRAIN = false;
  bf16 *Qb, *Kp, *Vp, *MQ, *MK, *MV, *MO; const float *qg, *kg; LAS float* xch;
  __device__ __forceinline__ void operator()(const pg8::f32x4 (&acc)[2][2][4][2], const pg8::Unit& u, int wr, int wc, int fr, int fq) const {
    const int pn = u.pn, b = u.pm >> 3, tb = (u.pm & 7) * 256 + wr * 64 + fr, d0 = wc * 32 + fq * 8;
    if (pn < 8) {
      const bool isk = pn >= 4; const int h = pn & 3;
      float ssq[2][4][2];
#pragma unroll
      for (int ai = 0; ai < 2; ++ai)
#pragma unroll
        for (int m = 0; m < 4; ++m)
#pragma unroll
          for (int bj = 0; bj < 2; ++bj) { float s = 0.f;
#pragma unroll
            for (int n = 0; n < 2; ++n) { const pg8::f32x4 x = acc[ai][bj][m][n]; s += (x[0] * x[0] + x[1] * x[1]) + (x[2] * x[2] + x[3] * x[3]); }
            s += __shfl_xor(s, 16); s += __shfl_xor(s, 32); ssq[ai][m][bj] = s;
            if (fq == 0) xch[((ai * 128 + wr * 64 + m * 16 + fr) * 2 + bj) * 4 + wc] = s; }
      asm volatile("s_waitcnt lgkmcnt(0)" ::: "memory"); __builtin_amdgcn_s_barrier(); asm volatile("" ::: "memory");
      const float* gp = (isk ? kg : qg) + d0; const f32x4 g0 = *(const f32x4*)gp, g1v = *(const f32x4*)(gp + 4);
      const float sc = isk ? 1.0f : QSCALE;
#pragma unroll
      for (int ai = 0; ai < 2; ++ai)
#pragma unroll
        for (int m = 0; m < 4; ++m)
#pragma unroll
          for (int bj = 0; bj < 2; ++bj) {
            const f32x4 p = *(const LAS f32x4*)(xch + ((ai * 128 + wr * 64 + m * 16 + fr) * 2 + bj) * 4);
            const float rs = rsqrtf(((p.x + p.y) + (p.z + p.w)) * (1.0f / 128.f) + EPS) * sc;
            const pg8::f32x4 v0 = acc[ai][bj][m][0], v1 = acc[ai][bj][m][1];
            v4u w; w.x = pk2(v0[0] * rs * g0.x, v0[1] * rs * g0.y); w.y = pk2(v0[2] * rs * g0.z, v0[3] * rs * g0.w);
            w.z = pk2(v1[0] * rs * g1v.x, v1[1] * rs * g1v.y); w.w = pk2(v1[2] * rs * g1v.z, v1[3] * rs * g1v.w);
            const int t = tb + ai * 128 + m * 16;
            bf16* dst = isk ? Kp + kp_off((b * 4 + h) * 2 + bj, POS0 + t, d0)
                            : Qb + ((size_t)((b * 4 + h) * 2 + bj) * SEQ + t) * 128 + d0;
            *(v4u*)dst = w; }
      return;
    }
#pragma unroll
    for (int ai = 0; ai < 2; ++ai)
#pragma unroll
      for (int m = 0; m < 4; ++m)
#pragma unroll
        for (int bj = 0; bj < 2; ++bj) {
          pg8::f32x4 v0 = acc[ai][bj][m][0], v1 = acc[ai][bj][m][1];
          const int t = tb + ai * 128 + m * 16;
          bf16* dst;
          if (pn < 12) { const int h = pn - 8; dst = Vp + ((size_t)(b * 4 + h) * PADT + POS0 + t) * 256 + bj * 128 + d0; }
          else if (pn < 16) { const int h = 2 * (pn & 1) + bj; dst = (pn >= 14 ? MK : MQ) + ((size_t)(b * 4 + h) * PADT + POS0 + t) * 128 + d0; }
          else if (pn < 20) { const int h = pn - 16; dst = MV + ((size_t)(b * 4 + h) * PADT + POS0 + t) * 256 + bj * 128 + d0; }
          else dst = MO + (size_t)(b * SEQ + t) * 1024 + (pn - 20) * 256 + bj * 128 + d0;
          v4u w; w.x = pk2(v0[0], v0[1]); w.y = pk2(v0[2], v0[3]); w.z = pk2(v1[0], v1[1]); w.w = pk2(v1[2], v1[3]);
          *(v4u*)dst = w; }
  }
};
__device__ __forceinline__ void p1_meta_finalize(const Frame& F, const Args& a) {
  if (blockIdx.x >= NMETA) return;
  const int mrow = blockIdx.x, tid = F.tid, lane = F.lane, w = F.wave;
  const float* meta = a.in[IN_META] + (size_t)mrow * DM; const float* PM0 = (const float*)(F.ws + WS_PM) + (size_t)mrow * NPROJ;
#define PM_P4(i, p) ((PM0[(size_t)(16 * (p)) * NPROJ + (i)] + PM0[(size_t)(16 * ((p) + 1)) * NPROJ + (i)]) + (PM0[(size_t)(16 * ((p) + 2)) * NPROJ + (i)] + PM0[(size_t)(16 * ((p) + 3)) * NPROJ + (i)]))
#define PM_AT(i) ((PM_P4(i, 0) + PM_P4(i, 4)) + (PM_P4(i, 8) + PM_P4(i, 12)))
  LAS float* red = (LAS float*)(F.lds + XCH_OFF);
  const f32x4 mv = ((const f32x4*)meta)[tid];
  float s = wave_sum((mv.x * mv.x + mv.y * mv.y) + (mv.z * mv.z + mv.w * mv.w));
  if (lane == 0) red[w] = s;
  __syncthreads();
  float tot = 0.f;
#pragma unroll
  for (int i = 0; i < 8; ++i) tot += red[i];
  const float rs = rsqrtf(tot * (1.0f / DM) + EPS);
  bf16* Kp = (bf16*)(F.ws + WS_KP); bf16* Vp = (bf16*)(F.ws + WS_VP); bf16* MQ = (bf16*)(F.ws + WS_MQ); bf16* MK = (bf16*)(F.ws + WS_MK); bf16* MV = (bf16*)(F.ws + WS_MV);
  const int pos = MPOS0 + mrow;
  {
    const float v0 = PM_AT(1024 + w * 128 + lane) * rs, v1 = PM_AT(1024 + w * 128 + lane + 64) * rs;
    const float rk = rsqrtf(wave_sum(v0 * v0 + v1 * v1) * (1.0f / 128.f) + EPS);
    const float* kg = a.in[IN_KNG];
    const unsigned short o0 = (unsigned short)f2bf(v0 * rk * kg[lane]), o1 = (unsigned short)f2bf(v1 * rk * kg[lane + 64]);
    for (int b = 0; b < NB; ++b) { const int bhm = (b * 4 + (w >> 1)) * 2 + (w & 1); Kp[kp_off(bhm, pos, lane)] = o0; Kp[kp_off(bhm, pos, lane + 64)] = o1; }
  }
  { const int c = tid * 2;
    const unsigned o = pk2(PM_AT(2048 + c) * rs, PM_AT(2048 + c + 1) * rs); const int h = c >> 8, e = c & 255;
    for (int b = 0; b < NB; ++b) *(unsigned*)(Vp + ((size_t)(b * 4 + h) * PADT + pos) * 256 + e) = o;
    const unsigned o2 = pk2(PM_AT(3072 + c) * rs, PM_AT(3072 + c + 1) * rs); const bool isk = c >= 512; const int cc = c & 511, hq = cc >> 7, d = cc & 127;
    for (int b = 0; b < NB; ++b) *(unsigned*)((isk ? MK : MQ) + ((size_t)(b * 4 + hq) * PADT + pos) * 128 + d) = o2;
    const unsigned o3 = pk2(PM_AT(4096 + c) * rs, PM_AT(4096 + c + 1) * rs);
    for (int b = 0; b < NB; ++b) *(unsigned*)(MV + ((size_t)(b * 4 + h) * PADT + pos) * 256 + e) = o3;
  }
  __syncthreads();
}
#undef PM_AT
#undef PM_P4

namespace att {
using f32x16 = __attribute__((ext_vector_type(16))) float;
using s16x4 = __attribute__((ext_vector_type(4))) short;
constexpr int STEPS_BHM = 152, NSTEPS = 32 * STEPS_BHM;
constexpr int SHM_V = 64 * 256 * 2, SHM_K = 64 * 128 * 2;
constexpr int LDS_V = 0, LDS_K = 2 * SHM_V, LDS_Q = LDS_K + SHM_K, LDS_WS = LDS_Q + 8 * 8192;
constexpr float THR2 = 8.0f;
#define KSWZ(row, colB) ((row) * 256 + ((colB) ^ (((row) & 7) << 4)))
#define SBAR() __builtin_amdgcn_sched_barrier(0)
__device__ __forceinline__ int crow(int r, int hi) { return (r & 3) + 8 * (r >> 2) + 4 * hi; }
__device__ __forceinline__ unsigned cvtpk(float lo, float hi) { unsigned r; asm volatile("v_cvt_pk_bf16_f32 %0, %1, %2" : "=v"(r) : "v"(lo), "v"(hi)); return r; }
__device__ __forceinline__ int qb_start(int qb) { return 2 * qb * qb + 3 * qb; }
__device__ __forceinline__ int chunk_of(int s, int NA) { return ((s + 1) * NA - 1) / NSTEPS; }

template <int OFF> __device__ __forceinline__ s16x4 tr_read(int vb) {
  s16x4 r; asm volatile("ds_read_b64_tr_b16 %0, %1 offset:%2" : "=&v"(r) : "v"(vb), "i"(OFF) : "memory"); return r;
}
constexpr int v_rd_off(int d0, int ks, int half) { return d0 * 512 + ks * 8192 + half * 4096; }
template <int D0> __device__ __forceinline__ void pv_one(f32x16& od, int vb, bf16x8 pa0, bf16x8 pa1, bf16x8 pa2, bf16x8 pa3) {
#define PK(L, H) (bf16x8){L[0], L[1], L[2], L[3], H[0], H[1], H[2], H[3]}
  { const s16x4 l0 = tr_read<v_rd_off(D0, 0, 0)>(vb), h0 = tr_read<v_rd_off(D0, 0, 1)>(vb), l1 = tr_read<v_rd_off(D0, 1, 0)>(vb), h1 = tr_read<v_rd_off(D0, 1, 1)>(vb);
    asm volatile("s_waitcnt lgkmcnt(0)" ::: "memory"); SBAR();
    od = __builtin_amdgcn_mfma_f32_32x32x16_bf16(pa0, PK(l0, h0), od, 0, 0, 0);
    od = __builtin_amdgcn_mfma_f32_32x32x16_bf16(pa1, PK(l1, h1), od, 0, 0, 0); }
  SBAR();
  { const s16x4 l2 = tr_read<v_rd_off(D0, 2, 0)>(vb), h2 = tr_read<v_rd_off(D0, 2, 1)>(vb), l3 = tr_read<v_rd_off(D0, 3, 0)>(vb), h3 = tr_read<v_rd_off(D0, 3, 1)>(vb);
    asm volatile("s_waitcnt lgkmcnt(0)" ::: "memory"); SBAR();
    od = __builtin_amdgcn_mfma_f32_32x32x16_bf16(pa2, PK(l2, h2), od, 0, 0, 0);
    od = __builtin_amdgcn_mfma_f32_32x32x16_bf16(pa3, PK(l3, h3), od, 0, 0, 0); }
#undef PK
}

__device__ __forceinline__ void segment(const Frame& F, int bhm, int qb, int j0, int j1, int slot) {
  const int tid = F.tid, wid = F.wave, lane = F.lane, r32 = lane & 31, hi = lane >> 5;
  const bf16* Qg = (const bf16*)(F.ws + WS_Q) + ((size_t)bhm * SEQ + qb * 256 + wid * 32 + r32) * 128 + hi * 8;
  const bf16* Kg = (const bf16*)(F.ws + WS_KP) + (size_t)bhm * 33 * 8192;
  const bf16* Vg = (const bf16*)(F.ws + WS_VP) + (size_t)(bhm >> 1) * PADT * 256;
  LAS unsigned char* lds = F.lds;
  LAS float* wsl = (LAS float*)(lds + LDS_WS) + wid * 64;
  const float slope2 = exp2f(-2.0f * (float)(((bhm >> 1) & 3) + 1)) * LOG2E;
  unsigned ksrc0, vsrc0;
  ksrc0 = (unsigned)tid * 16u;
  { const int a8 = tid >> 8, b = (tid >> 2) & 7, k = 8 * (b >> 2) + 4 * a8 + (b & 3), c = ((tid >> 5) & 7) * 32 + (tid & 3) * 8; vsrc0 = (unsigned)(k * 256 + c) * 2u; }
#define STAGE_K(j) do { const char* kt = (const char*)(Kg + (size_t)(j) * 8192); \
    _Pragma("unroll") for (int _i = 0; _i < 2; ++_i) __builtin_amdgcn_global_load_lds((const unsigned*)(kt + (ksrc0 + _i * 8192u)), (LAS unsigned*)(lds + LDS_K + _i * 8192 + wid * 1024), 16, 0, 0); } while (0)
#define STAGE_V(buf, j) do { const char* vt = (const char*)(Vg + (size_t)(j) * 64 * 256); \
    _Pragma("unroll") for (int _i = 0; _i < 4; ++_i) __builtin_amdgcn_global_load_lds((const unsigned*)(vt + (vsrc0 + _i * 8192u)), (LAS unsigned*)(lds + LDS_V + (buf) * SHM_V + _i * 8192 + wid * 1024), 16, 0, 0); } while (0)
  const int lt = (((r32 << 1) | hi) ^ ((r32 >> 3) & 1)) << 4;
  LAS unsigned char* Qs = lds + LDS_Q + wid * 8192;
#pragma unroll
  for (int d0 = 0; d0 < 8; ++d0) { const bf16x8 qv = *(const bf16x8*)(Qg + d0 * 16); *(LAS bf16x8*)(Qs + d0 * 1024 + lt) = qv; }
  f32x16 o[8];
#pragma unroll
  for (int d = 0; d < 8; ++d)
#pragma unroll
    for (int r = 0; r < 16; ++r) o[d][r] = 0.f;
  float m_reg = -1e30f, l_reg = 0.f;
  const int vb0 = (int)(uintptr_t)(lds + LDS_V) + (((lane & 3) << 3) | (((lane >> 2) & 3) << 6) | (((lane >> 4) & 1) << 5) | (((lane >> 5) & 1) << 8));
  STAGE_K(j0); STAGE_V(0, j0);
  VM_WAIT(); __syncthreads();
  for (int j = j0; j < j1; ++j) {
    const int cur = (j - j0) & 1;
    if (j + 1 < j1) STAGE_V(cur ^ 1, j + 1);
    SBAR();
    f32x16 p0 = {}, p1 = {};
    { const LAS unsigned char* Ks = lds + LDS_K;
#pragma unroll
      for (int d0 = 0; d0 < 8; ++d0) {
        const bf16x8 b0 = *(const LAS bf16x8*)(Ks + d0 * 2048 + lt);
        const bf16x8 b1 = *(const LAS bf16x8*)(Ks + d0 * 2048 + 1024 + lt);
        const bf16x8 qf = *(const LAS bf16x8*)(Qs + d0 * 1024 + lt);
        p0 = __builtin_amdgcn_mfma_f32_32x32x16_bf16(b0, qf, p0, 0, 0, 0);
        p1 = __builtin_amdgcn_mfma_f32_32x32x16_bf16(b1, qf, p1, 0, 0, 0); } }
    asm volatile("s_waitcnt lgkmcnt(0)" ::: "memory"); __builtin_amdgcn_s_barrier(); asm volatile("" ::: "memory");
    if (j + 1 < j1) STAGE_K(j + 1);
    SBAR();
    if (j == 0) {
#pragma unroll
      for (int r = 0; r < 16; ++r) p0[r] = -INFINITY;
#pragma unroll
      for (int r = 0; r < 8; ++r) p1[r] = -INFINITY;
    }
    int ln2 = threadIdx.x & 63; asm volatile("" : "+v"(ln2));
    const int hi2 = ln2 >> 5;
    const int jb = j - (4 * qb + 1);
    if (jb >= 0) {
      const int kb = 64 * jb + 4 * hi2, qrel = wid * 32 + (ln2 & 31);
#pragma unroll
      for (int r = 0; r < 16; ++r) { const int kv = kb + (r & 3) + 8 * (r >> 2); if (kv > qrel) p0[r] = -INFINITY; if (kv + 32 > qrel) p1[r] = -INFINITY; }
    }
    const float off0 = slope2 * (float)(64 * j + 4 * hi2), off1 = off0 + 32.0f * slope2;
#pragma unroll
    for (int r = 0; r < 16; ++r) { const float sb = slope2 * (float)((r & 3) + 8 * (r >> 2)); p0[r] += sb; p1[r] += sb; }
    float pm0 = p0[0], pm1 = p1[0];
#pragma unroll
    for (int r = 1; r < 16; ++r) { pm0 = fmaxf(pm0, p0[r]); pm1 = fmaxf(pm1, p1[r]); }
    float pmax = fmaxf(pm0 + off0, pm1 + off1);
    { auto rr = __builtin_amdgcn_permlane32_swap(__float_as_uint(pmax), __float_as_uint(pmax), false, false);
      pmax = fmaxf(__uint_as_float(rr[0]), __uint_as_float(rr[1])); }
    float mn, alpha;
    if (__builtin_expect(__all(pmax - m_reg <= THR2), 1)) { mn = m_reg; alpha = 1.f; }
    else { mn = fmaxf(m_reg, pmax); alpha = __builtin_amdgcn_exp2f(m_reg - mn); m_reg = mn; }
    const float c0 = off0 - mn, c1 = off1 - mn;
    float ps = 0.f;
#pragma unroll
    for (int r = 0; r < 16; ++r) { p0[r] = __builtin_amdgcn_exp2f(p0[r] + c0); p1[r] = __builtin_amdgcn_exp2f(p1[r] + c1); ps += p0[r] + p1[r]; }
    { auto rr = __builtin_amdgcn_permlane32_swap(__float_as_uint(ps), __float_as_uint(ps), false, false);
      ps = __uint_as_float(rr[0]) + __uint_as_float(rr[1]); }
    l_reg = l_reg * alpha + ps;
    if (__any(alpha < 1.f)) { if (hi == 0) wsl[r32] = alpha; asm volatile("s_waitcnt lgkmcnt(0)" ::: "memory");
#pragma unroll
      for (int rg = 0; rg < 4; ++rg) { const f32x4 al = *(const LAS f32x4*)(wsl + 8 * rg + 4 * hi);
#pragma unroll
        for (int d = 0; d < 8; ++d) { o[d][4 * rg + 0] *= al.x; o[d][4 * rg + 1] *= al.y; o[d][4 * rg + 2] *= al.z; o[d][4 * rg + 3] *= al.w; }
        SBAR(); } }
    bf16x8 pa0, pa1, pa2, pa3;
#define PK4(P, BASE, OUT) do { unsigned a0 = cvtpk(P[BASE + 0], P[BASE + 1]), a1 = cvtpk(P[BASE + 2], P[BASE + 3]);   \
    unsigned b0 = cvtpk(P[BASE + 4], P[BASE + 5]), b1 = cvtpk(P[BASE + 6], P[BASE + 7]);                              \
    auto r0 = __builtin_amdgcn_permlane32_swap(a0, b0, false, false); auto r1 = __builtin_amdgcn_permlane32_swap(a1, b1, false, false); \
    v4u w = {r0[0], r1[0], r0[1], r1[1]}; OUT = *reinterpret_cast<bf16x8*>(&w); } while (0)
    PK4(p0, 0, pa0); PK4(p0, 8, pa1); PK4(p1, 0, pa2); PK4(p1, 8, pa3);
#undef PK4
    SBAR();
    { const int vb = vb0 + cur * SHM_V;
      pv_one<0>(o[0], vb, pa0, pa1, pa2, pa3); pv_one<1>(o[1], vb, pa0, pa1, pa2, pa3); pv_one<2>(o[2], vb, pa0, pa1, pa2, pa3); pv_one<3>(o[3], vb, pa0, pa1, pa2, pa3);
      pv_one<4>(o[4], vb, pa0, pa1, pa2, pa3); pv_one<5>(o[5], vb, pa0, pa1, pa2, pa3); pv_one<6>(o[6], vb, pa0, pa1, pa2, pa3); pv_one<7>(o[7], vb, pa0, pa1, pa2, pa3); }
    VM_WAIT(); __syncthreads();
  }
  { int lane2 = threadIdx.x & 63, slot2 = slot; asm volatile("" : "+v"(lane2), "+s"(slot2));
    const int r32e = lane2 & 31, hie = lane2 >> 5;
    bf16* PO = (bf16*)(F.ws + WS_PO) + (size_t)slot2 * 256 * 256; float* ML = (float*)(F.ws + WS_ML) + (size_t)slot2 * 512;
    LAS float* wse = (LAS float*)(F.lds + LDS_WS) + wid * 64;
    if (hie == 0) { wse[r32e] = l_reg; ML[(wid * 32 + r32e) * 2] = m_reg; ML[(wid * 32 + r32e) * 2 + 1] = l_reg; }
    asm volatile("s_waitcnt lgkmcnt(0)" ::: "memory");
    char* Ob = (char*)(PO + (size_t)(wid * 32) * 256);
    const bool odd = (r32e & 1) != 0;
    const unsigned lo = (unsigned)(4 * hie * 256 + (r32e & ~1) + (odd ? 32 : 0)) * 2u;
#pragma unroll
    for (int r = 0; r < 16; ++r) { const int rowc = (r & 3) + 8 * (r >> 2); const float lv = wse[rowc + 4 * hie]; const float rl = lv > 0.f ? __builtin_amdgcn_rcpf(lv) : 0.f;
#pragma unroll
      for (int dp = 0; dp < 4; ++dp) { const float va = o[2 * dp][r] * rl, vb = o[2 * dp + 1][r] * rl;
        const float send = odd ? va : vb, keep = odd ? vb : va;
        const float recv = __builtin_bit_cast(float, __builtin_amdgcn_update_dpp(0, __builtin_bit_cast(int, send), 0xB1, 0xF, 0xF, true));
        *(unsigned*)(Ob + (lo + (unsigned)(rowc * 256 + dp * 64) * 2u)) = odd ? pk2(recv, keep) : pk2(keep, recv); }
      SBAR(); } }
  __syncthreads();
#undef STAGE_K
#undef STAGE_V
}

__device__ __forceinline__ void phase(const Frame& F, int ca, int NA) {
  int s0 = (int)(((long)ca * NSTEPS) / NA); const int s1 = (int)(((long)(ca + 1) * NSTEPS) / NA);
  while (s0 < s1) {
    const int bhm = s0 / STEPS_BHM, rem = s0 - bhm * STEPS_BHM;
    int qb = 0;
#pragma unroll 1
    for (int q = 1; q < 8; ++q) if (rem >= qb_start(q)) qb = q;
    const int j0 = rem - qb_start(qb), nst = 4 * qb + 5;
    const int j1 = (j0 + (s1 - s0) < nst) ? j0 + (s1 - s0) : nst;
    const int slot = bhm * 16 + qb + chunk_of(s0, NA) - chunk_of(bhm * STEPS_BHM, NA);
    segment(F, bhm, qb, j0, j1, slot);
    s0 += j1 - j0;
  }
}
#undef KSWZ
#undef SBAR
}
namespace ml {
constexpr int QST = 136, TST = 72;
constexpr int L_RQ = 0, L_RK = 17152, L_QS = 34304, L_QW = 51712, L_KS = 69120, L_KWT = 86528, L_VT = 104960  , L_SP = 0  , L_G = 141824, L_CW = 143872;
constexpr int L_HT = 0;
constexpr int G_A = 0, G_M = 64, G_WI = 128, G_EM = 192, G_DEN = 256, G_WG = 320, G_SC = 384, G_N = 0;
constexpr int L_NV = L_CW + 5120;
constexpr int L_SSQ = L_KWT;
__device__ __forceinline__ float shfl_up_f(float v, int d) { return __shfl_up(v, d); }

struct StageCW { float v[3]; };
__device__ __forceinline__ void issue_cw(const Frame& F, const Args& a, int h, StageCW& st) {
#pragma unroll
  for (int i = 0; i < 3; ++i) { const int e = F.tid + NTHR * i; st.v[i] = 0.f;
    if (e < 2 * 5 * 128) { const int qk = e / 640, j = (e / 128) % 5, d = e & 127; const int ch = qk * 512 + h * 128 + d; st.v[i] = j < 4 ? a.in[IN_CW][j * 1024 + ch] : a.in[IN_CB][ch]; } }
}
__device__ __forceinline__ void commit_cw(const Frame& F, const StageCW& st) {
  LAS float* CW = (LAS float*)(F.lds + L_CW);
#pragma unroll
  for (int i = 0; i < 3; ++i) { const int e = F.tid + NTHR * i; if (e < 2 * 5 * 128) CW[e] = st.v[i]; }
}
struct StageRaw { v4u v[3]; };
__device__ __forceinline__ void issue_raw(const Frame& F, const bf16* g, int pos0, StageRaw& st) {
#pragma unroll
  for (int i = 0; i < 3; ++i) { const int p = F.tid + NTHR * i, row = p >> 4, ch = p & 15, pos = pos0 - 3 + row;
    st.v[i] = (v4u){0u, 0u, 0u, 0u}; if (p < 67 * 16 && pos >= MPOS0) st.v[i] = *(const v4u*)(g + (size_t)pos * 128 + ch * 8); }
}
__device__ __forceinline__ void commit_raw(const Frame& F, int lds_off, const StageRaw& st) {
#pragma unroll
  for (int i = 0; i < 3; ++i) { const int p = F.tid + NTHR * i, row = p >> 4, ch = p & 15; if (p < 67 * 16) *(LAS v4u*)(F.lds + lds_off + row * 256 + ch * 16) = st.v[i]; }
}
__device__ __forceinline__ void conv16(const Frame& F, int qk, int lds_off, int t, int d0, float (&y)[16]) {
  const LAS float* CW = (const LAS float*)(F.lds + L_CW);
#pragma unroll
  for (int e = 0; e < 16; ++e) y[e] = CW[(qk * 5 + 4) * 128 + d0 + e];
#pragma unroll
  for (int j = 0; j < 4; ++j) { const LAS v4u* rp = (const LAS v4u*)(F.lds + lds_off + (t + j) * 256 + d0 * 2); const v4u r0 = rp[0], r1 = rp[1];
    const LAS float* cw = CW + (qk * 5 + j) * 128 + d0;
    y[0] += cw[0] * bflo(r0.x); y[1] += cw[1] * bfhi(r0.x); y[2] += cw[2] * bflo(r0.y); y[3] += cw[3] * bfhi(r0.y); y[4] += cw[4] * bflo(r0.z); y[5] += cw[5] * bfhi(r0.z); y[6] += cw[6] * bflo(r0.w); y[7] += cw[7] * bfhi(r0.w);
    y[8] += cw[8] * bflo(r1.x); y[9] += cw[9] * bfhi(r1.x); y[10] += cw[10] * bflo(r1.y); y[11] += cw[11] * bfhi(r1.y); y[12] += cw[12] * bflo(r1.z); y[13] += cw[13] * bfhi(r1.z); y[14] += cw[14] * bflo(r1.w); y[15] += cw[15] * bfhi(r1.w); }
#pragma unroll
  for (int e = 0; e < 16; ++e) y[e] = y[e] / (1.0f + __expf(-y[e]));
}
struct StageVT { v4u v[4]; };
__device__ __forceinline__ void issue_vt(const Frame& F, const bf16* MVg, int pos0, StageVT& st) {
#pragma unroll
  for (int i = 0; i < 4; ++i) { const int p = F.tid + NTHR * i, row = p >> 5, ch = p & 31; st.v[i] = (v4u){0u, 0u, 0u, 0u};
    if (pos0 + row >= MPOS0) st.v[i] = *(const v4u*)(MVg + (size_t)(pos0 + row) * 256 + ch * 8); }
}
__device__ __forceinline__ void commit_vt(const Frame& F, const StageVT& st) {
#pragma unroll
  for (int i = 0; i < 4; ++i) { const int p = F.tid + NTHR * i, row = p >> 5, ch = p & 31; const v4u v4 = st.v[i];
    LAS bf16* vt = (LAS bf16*)(F.lds + L_VT) + (ch * 8) * TST + row;
    vt[0 * TST] = (bf16)(v4.x & 0xffff); vt[1 * TST] = (bf16)(v4.x >> 16); vt[2 * TST] = (bf16)(v4.y & 0xffff); vt[3 * TST] = (bf16)(v4.y >> 16);
    vt[4 * TST] = (bf16)(v4.z & 0xffff); vt[5 * TST] = (bf16)(v4.z >> 16); vt[6 * TST] = (bf16)(v4.w & 0xffff); vt[7 * TST] = (bf16)(v4.w >> 16); }
}

__device__ __forceinline__ void taskA(const Frame& F, const Args& a, int task) {
  const int bh = task >> 5, c = task & 31, h = bh & 3, tid = F.tid, w = F.wave, lane = F.lane, fr = lane & 15, kq = lane >> 4, pos0 = 64 * c;
  LAS unsigned char* lds = F.lds; LAS float* G = (LAS float*)(lds + L_G);
  const bf16* MKg = (const bf16*)(F.ws + WS_MK) + (size_t)bh * PADT * 128; const bf16* MVg = (const bf16*)(F.ws + WS_MV) + (size_t)bh * PADT * 256;
  StageCW scw; StageRaw srk; StageVT svt; float li = -1e30f, lf = 0.f;
  issue_cw(F, a, h, scw); issue_raw(F, MKg, pos0, srk); issue_vt(F, MVg, pos0, svt);
  { const bool dead = pos0 + lane < MPOS0; if (w == 0 && !dead) { li = ((const float*)(F.ws + WS_LI))[bh * PADT + pos0 + lane]; lf = ((const float*)(F.ws + WS_LF))[bh * PADT + pos0 + lane]; } }
  __syncthreads();
  commit_cw(F, scw); commit_raw(F, L_RK, srk); commit_vt(F, svt);
  if (w == 0) {
    float bs = lf;
#pragma unroll
    for (int d = 1; d < 64; d <<= 1) { const float o = shfl_up_f(bs, d); if (lane >= d) bs += o; }
    const float av = li - bs; float mx = av;
#pragma unroll
    for (int o = 1; o < 64; o <<= 1) mx = fmaxf(mx, __shfl_xor(mx, o));
    G[G_WG + lane] = __expf(av - mx);
    if (lane == 63) { float* gs = (float*)(F.ws + WS_GS) + (size_t)(bh * 33 + c) * 2; gs[0] = bs; gs[1] = mx; }
  }
  __syncthreads();
  { const int t = tid >> 3, d0 = (tid & 7) * 16; float y[16]; conv16(F, 1, L_RK, t, d0, y);
    const float sw = 0.08838834764831845f * G[G_WG + t]; LAS bf16* kt = (LAS bf16*)(lds + L_KWT) + d0 * TST + t;
#pragma unroll
    for (int e = 0; e < 16; ++e) kt[e * TST] = (bf16)f2bf(y[e] * sw); }
  __syncthreads();
  f32x4* DCg = (f32x4*)(F.ws + WS_DC) + ((size_t)(bh * 32 + c) * 128) * 64;
#pragma unroll
  for (int jj = 0; jj < 2; ++jj) { const int j = 2 * w + jj;
    const bf16x8 bv0 = *(const LAS bf16x8*)(lds + L_VT + ((16 * j + fr) * TST + 8 * kq) * 2), bv1 = *(const LAS bf16x8*)(lds + L_VT + ((16 * j + fr) * TST + 32 + 8 * kq) * 2);
#pragma unroll
    for (int i = 0; i < 8; ++i) { f32x4 acc = {0.f, 0.f, 0.f, 0.f};
      const bf16x8 k0 = *(const LAS bf16x8*)(lds + L_KWT + ((16 * i + fr) * TST + 8 * kq) * 2), k1 = *(const LAS bf16x8*)(lds + L_KWT + ((16 * i + fr) * TST + 32 + 8 * kq) * 2);
      acc = __builtin_amdgcn_mfma_f32_16x16x32_bf16(k0, bv0, acc, 0, 0, 0); acc = __builtin_amdgcn_mfma_f32_16x16x32_bf16(k1, bv1, acc, 0, 0, 0);
      DCg[(size_t)(i * 16 + j) * 64 + lane] = acc; } }
  if (tid < 128) { const LAS v4u* kr = (const LAS v4u*)(lds + L_KWT + tid * TST * 2); float s = 0.f;
#pragma unroll
    for (int q = 0; q < 8; ++q) { const v4u x = kr[q]; s += (bflo(x.x) + bfhi(x.x)) + (bflo(x.y) + bfhi(x.y)) + (bflo(x.z) + bfhi(x.z)) + (bflo(x.w) + bfhi(x.w)); }
    ((float*)(F.ws + WS_DN))[(size_t)(bh * 32 + c) * 128 + tid] = s; }
}

__device__ __forceinline__ void scanB(const Frame& F) {
  const float* GS = (const float*)(F.ws + WS_GS);
  LAS float* cf = (LAS float*)F.lds;
  for (int blk = blockIdx.x; blk < 16 * 16; blk += gridDim.x) { const int bh = blk >> 4, r = (blk & 15) * NTHR + F.tid, i = r >> 10, j = (r >> 6) & 15, ln = r & 63;
    __syncthreads();
    if (F.wave == 0) {
      const int c = F.lane & 31; const v2u gs = *(const v2u*)(GS + (size_t)(bh * 33 + c) * 2); const unsigned g0 = gs.x, g1 = gs.y;
      const float bL = __builtin_bit_cast(float, g0), ml = __builtin_bit_cast(float, g1);
      float mm = 0.f, fa = 0.f, fb = 0.f, mout = 0.f;
#pragma unroll
      for (int cc = 0; cc < 32; ++cc) { const float b_ = __builtin_bit_cast(float, __builtin_amdgcn_readlane(__builtin_bit_cast(int, bL), cc)), l_ = __builtin_bit_cast(float, __builtin_amdgcn_readlane(__builtin_bit_cast(int, ml), cc));
        const float me = fmaxf(mm, l_); if (c == cc) { fa = __expf(mm - me); fb = __expf(l_ - me); } mm = b_ + me; if (c == cc) mout = mm; }
      if (F.lane < 32) { cf[2 * c] = fa; cf[2 * c + 1] = fb; if ((blk & 15) == 0) ((float*)(F.ws + WS_MS))[bh * 33 + c + 1] = mout; }
    }
    __syncthreads();
    const f32x4* dc0 = (const f32x4*)(F.ws + WS_DC) + ((size_t)(bh * 32) * 128 + (i * 16 + j)) * 64 + ln;
    v2u* cs = (v2u*)(F.ws + WS_CS) + ((((size_t)bh * 33) * 8 + i) * 16 + j) * 64 + ln;
    f32x4 s0 = {0.f, 0.f, 0.f, 0.f}, dv[32];
#pragma unroll
    for (int c = 0; c < 32; ++c) dv[c] = dc0[(size_t)c * 128 * 64];
#pragma unroll
    for (int c = 0; c < 32; ++c) { const float fa = cf[2 * c], fb = cf[2 * c + 1];
      s0 = s0 * fa + dv[c] * fb;
      v2u o; o.x = pk2(s0.x, s0.y); o.y = pk2(s0.z, s0.w); cs[(size_t)(c + 1) * 8 * 16 * 64] = o; }
    if ((blk & 15) == 0 && F.tid < 128) {
      const float* dn = (const float*)(F.ws + WS_DN) + (size_t)(bh * 32) * 128 + F.tid; float* ns = (float*)(F.ws + WS_NS) + (size_t)(bh * 33) * 128 + F.tid; float n = 0.f;
      float dnv[32];
#pragma unroll
      for (int c = 0; c < 32; ++c) dnv[c] = dn[(size_t)c * 128];
#pragma unroll
      for (int c = 0; c < 32; ++c) { n = n * cf[2 * c] + dnv[c] * cf[2 * c + 1]; ns[(size_t)(c + 1) * 128] = n; }
    }
  }
}

__device__ __forceinline__ void taskC(const Frame& F, const Args& a, int task) {
  TP_BEGIN(31);
  const int bh = task >> 5, c = (task & 31) + 1, b = bh >> 2, h = bh & 3, tid = F.tid, w = F.wave, lane = F.lane, fr = lane & 15, kq = lane >> 4, pos0 = 64 * c;
  LAS unsigned char* lds = F.lds; LAS float* G = (LAS float*)(lds + L_G); LAS float* NV = (LAS float*)(lds + L_NV);
  const bf16* MQg = (const bf16*)(F.ws + WS_MQ) + (size_t)bh * PADT * 128; const bf16* MKg = (const bf16*)(F.ws + WS_MK) + (size_t)bh * PADT * 128;
  const bf16* MVg = (const bf16*)(F.ws + WS_MV) + (size_t)bh * PADT * 256;
  const float m = ((const float*)(F.ws + WS_MS))[bh * 33 + c];
  StageCW scw; StageRaw srq, srk; StageVT svt; float nvv = 0.f, li = 0.f, lf = 0.f;
  issue_cw(F, a, h, scw); issue_raw(F, MQg, pos0, srq); issue_raw(F, MKg, pos0, srk); issue_vt(F, MVg, pos0, svt);
  if (tid < 128) nvv = ((const float*)(F.ws + WS_NS))[(size_t)(bh * 33 + c) * 128 + tid];
  if (w == 0) { li = ((const float*)(F.ws + WS_LI))[bh * PADT + pos0 + lane]; lf = ((const float*)(F.ws + WS_LF))[bh * PADT + pos0 + lane]; }
  __syncthreads();
  commit_cw(F, scw); commit_raw(F, L_RQ, srq); commit_raw(F, L_RK, srk); commit_vt(F, svt);
  if (tid < 128) NV[tid] = nvv;
  if (w == 0) {
    float bs = lf;
#pragma unroll
    for (int d = 1; d < 64; d <<= 1) { const float o = shfl_up_f(bs, d); if (lane >= d) bs += o; }
    const float av = li - bs; float cm = av;
#pragma unroll
    for (int d = 1; d < 64; d <<= 1) { const float o = shfl_up_f(cm, d); if (lane >= d) cm = fmaxf(cm, o); }
    const float Mt = fmaxf(m, cm);
    G[G_A + lane] = av; G[G_M + lane] = Mt; G[G_WI + lane] = __expf(m - Mt); G[G_EM + lane] = __expf(-(bs + Mt));
  }
  __syncthreads(); TP_END(31, F.ws); TP_BEGIN(32);
  { const int t = tid >> 3, d0 = (tid & 7) * 16; const float wi = G[G_WI + t]; float y[16];
    conv16(F, 0, L_RQ, t, d0, y);
    { v4u o0, o1, w0, w1;
      o0.x = pk2(y[0], y[1]); o0.y = pk2(y[2], y[3]); o0.z = pk2(y[4], y[5]); o0.w = pk2(y[6], y[7]); o1.x = pk2(y[8], y[9]); o1.y = pk2(y[10], y[11]); o1.z = pk2(y[12], y[13]); o1.w = pk2(y[14], y[15]);
      w0.x = pk2(y[0] * wi, y[1] * wi); w0.y = pk2(y[2] * wi, y[3] * wi); w0.z = pk2(y[4] * wi, y[5] * wi); w0.w = pk2(y[6] * wi, y[7] * wi);
      w1.x = pk2(y[8] * wi, y[9] * wi); w1.y = pk2(y[10] * wi, y[11] * wi); w1.z = pk2(y[12] * wi, y[13] * wi); w1.w = pk2(y[14] * wi, y[15] * wi);
      LAS v4u* qs = (LAS v4u*)(lds + L_QS + (t * QST + d0) * 2); qs[0] = o0; qs[1] = o1;
      LAS v4u* qw = (LAS v4u*)(lds + L_QW + (t * QST + d0) * 2); qw[0] = w0; qw[1] = w1; }
    __builtin_amdgcn_sched_barrier(0);
    conv16(F, 1, L_RK, t, d0, y);
    { const float sc = 0.08838834764831845f; v4u o0, o1;
      o0.x = pk2(y[0] * sc, y[1] * sc); o0.y = pk2(y[2] * sc, y[3] * sc); o0.z = pk2(y[4] * sc, y[5] * sc); o0.w = pk2(y[6] * sc, y[7] * sc);
      o1.x = pk2(y[8] * sc, y[9] * sc); o1.y = pk2(y[10] * sc, y[11] * sc); o1.z = pk2(y[12] * sc, y[13] * sc); o1.w = pk2(y[14] * sc, y[15] * sc);
      LAS v4u* ks = (LAS v4u*)(lds + L_KS + (t * QST + d0) * 2); ks[0] = o0; ks[1] = o1; } }
  __syncthreads(); TP_END(32, F.ws); TP_BEGIN(33);
  v4u cb[4][2];
  { const v2u* cs = (const v2u*)(F.ws + WS_CS) + (((size_t)bh * 33 + c) * 8 * 16) * 64;
#pragma unroll
    for (int I = 0; I < 4; ++I)
#pragma unroll
      for (int jj = 0; jj < 2; ++jj) { const v2u lo_ = cs[(size_t)((2 * I) * 16 + 2 * w + jj) * 64 + lane], hi_ = cs[(size_t)((2 * I + 1) * 16 + 2 * w + jj) * 64 + lane]; cb[I][jj] = (v4u){lo_.x, lo_.y, hi_.x, hi_.y}; } }
  { const int si = w >> 1; const f32x4 as = *(const LAS f32x4*)(G + G_A + 16 * si + 4 * kq);
#pragma unroll
    for (int tt = 0; tt < 2; ++tt) { const int ti = 2 * (w & 1) + tt; f32x4 acc = {0.f, 0.f, 0.f, 0.f};
#pragma unroll
      for (int ks = 0; ks < 4; ++ks) { const bf16x8 af = *(const LAS bf16x8*)(lds + L_KS + ((16 * si + fr) * QST + 32 * ks + 8 * kq) * 2);
        const bf16x8 bfr = *(const LAS bf16x8*)(lds + L_QS + ((16 * ti + fr) * QST + 32 * ks + 8 * kq) * 2);
        acc = __builtin_amdgcn_mfma_f32_16x16x32_bf16(af, bfr, acc, 0, 0, 0); }
      const int t = 16 * ti + fr, s0 = 16 * si + 4 * kq; const float Mt = G[G_M + t];
      const float v0 = (s0 + 0 <= t) ? acc.x * __expf(as.x - Mt) : 0.f, v1 = (s0 + 1 <= t) ? acc.y * __expf(as.y - Mt) : 0.f;
      const float v2 = (s0 + 2 <= t) ? acc.z * __expf(as.z - Mt) : 0.f, v3 = (s0 + 3 <= t) ? acc.w * __expf(as.w - Mt) : 0.f;
      v2u o; o.x = pk2(v0, v1); o.y = pk2(v2, v3);
      *(LAS v2u*)(lds + L_SP + (t * TST + s0) * 2) = o; } }
  __syncthreads(); TP_END(33, F.ws); TP_BEGIN(34);
  if (w == 0) { const int t = lane; float qn = 0.f, rsum = 0.f;
#pragma unroll 4
    for (int q = 0; q < 16; ++q) { const v4u x = *(const LAS v4u*)(lds + L_QS + (t * QST + q * 8) * 2); const f32x4 n0 = *(const LAS f32x4*)(NV + q * 8), n1 = *(const LAS f32x4*)(NV + q * 8 + 4);
      qn += bflo(x.x) * n0.x + bfhi(x.x) * n0.y + bflo(x.y) * n0.z + bfhi(x.y) * n0.w + bflo(x.z) * n1.x + bfhi(x.z) * n1.y + bflo(x.w) * n1.z + bfhi(x.w) * n1.w; }
#pragma unroll
    for (int q = 0; q < 8; ++q) { const v4u x = *(const LAS v4u*)(lds + L_SP + (t * TST + q * 8) * 2); rsum += (bflo(x.x) + bfhi(x.x)) + (bflo(x.y) + bfhi(x.y)) + (bflo(x.z) + bfhi(x.z)) + (bflo(x.w) + bfhi(x.w)); }
    const float den = G[G_WI + t] * qn + rsum; G[G_DEN + t] = fmaxf(fabsf(den), G[G_EM + t]); }
  f32x4 acc[2][4];
#pragma unroll
  for (int jj = 0; jj < 2; ++jj)
#pragma unroll
    for (int ti = 0; ti < 4; ++ti) acc[jj][ti] = (f32x4){0.f, 0.f, 0.f, 0.f};
#pragma unroll
  for (int I = 0; I < 4; ++I) {
#pragma unroll
    for (int ti = 0; ti < 4; ++ti) { const LAS unsigned char* qp = lds + L_QW + ((16 * ti + fr) * QST + 32 * I + 4 * kq) * 2;
      const v2u a0 = *(const LAS v2u*)qp, a1 = *(const LAS v2u*)(qp + 32); const v4u av = {a0.x, a0.y, a1.x, a1.y};
      acc[0][ti] = __builtin_amdgcn_mfma_f32_16x16x32_bf16(__builtin_bit_cast(bf16x8, av), __builtin_bit_cast(bf16x8, cb[I][0]), acc[0][ti], 0, 0, 0);
      acc[1][ti] = __builtin_amdgcn_mfma_f32_16x16x32_bf16(__builtin_bit_cast(bf16x8, av), __builtin_bit_cast(bf16x8, cb[I][1]), acc[1][ti], 0, 0, 0); }
    __builtin_amdgcn_sched_barrier(0); }
#pragma unroll
  for (int ks = 0; ks < 2; ++ks) { const bf16x8 bv0 = *(const LAS bf16x8*)(lds + L_VT + ((32 * w + fr) * TST + 32 * ks + 8 * kq) * 2), bv1 = *(const LAS bf16x8*)(lds + L_VT + ((32 * w + 16 + fr) * TST + 32 * ks + 8 * kq) * 2);
#pragma unroll
    for (int ti = 0; ti < 4; ++ti) { const bf16x8 sf = *(const LAS bf16x8*)(lds + L_SP + ((16 * ti + fr) * TST + 32 * ks + 8 * kq) * 2);
      acc[0][ti] = __builtin_amdgcn_mfma_f32_16x16x32_bf16(sf, bv0, acc[0][ti], 0, 0, 0); acc[1][ti] = __builtin_amdgcn_mfma_f32_16x16x32_bf16(sf, bv1, acc[1][ti], 0, 0, 0); } }
  __syncthreads(); TP_END(34, F.ws); TP_BEGIN(35);
  LAS float* SSQ = (LAS float*)(lds + L_SSQ);
#pragma unroll
  for (int ti = 0; ti < 4; ++ti) { const f32x4 dn = *(const LAS f32x4*)(G + G_DEN + 16 * ti + 4 * kq);
    f32x4 s4;
#pragma unroll
    for (int r = 0; r < 4; ++r) { const float h0 = acc[0][ti][r] / dn[r], h1 = acc[1][ti][r] / dn[r]; acc[0][ti][r] = h0; acc[1][ti][r] = h1; s4[r] = h0 * h0 + h1 * h1; }
#pragma unroll
    for (int o = 1; o < 16; o <<= 1) { s4.x += __shfl_xor(s4.x, o); s4.y += __shfl_xor(s4.y, o); s4.z += __shfl_xor(s4.z, o); s4.w += __shfl_xor(s4.w, o); }
    if (fr == 0) { SSQ[(16 * ti + 4 * kq + 0) * 8 + w] = s4.x; SSQ[(16 * ti + 4 * kq + 1) * 8 + w] = s4.y; SSQ[(16 * ti + 4 * kq + 2) * 8 + w] = s4.z; SSQ[(16 * ti + 4 * kq + 3) * 8 + w] = s4.w; } }
  __syncthreads();
  LAS bf16* HT = (LAS bf16*)(lds + L_HT);
#pragma unroll
  for (int ti = 0; ti < 4; ++ti)
#pragma unroll
    for (int r = 0; r < 4; ++r) { const int t = 16 * ti + 4 * kq + r; const f32x4 p0 = *(const LAS f32x4*)(SSQ + t * 8), p1 = *(const LAS f32x4*)(SSQ + t * 8 + 4);
      const float rh = rsqrtf(((p0.x + p0.y) + (p0.z + p0.w) + (p1.x + p1.y) + (p1.z + p1.w)) * (1.0f / 256.f) + EPS);
      HT[t * 264 + 32 * w + fr] = (bf16)f2bf(acc[0][ti][r] * rh); HT[t * 264 + 32 * w + 16 + fr] = (bf16)f2bf(acc[1][ti][r] * rh); }
  __syncthreads(); TP_END(35, F.ws); TP_BEGIN(36);
  { const int t = tid >> 3, c0 = (tid & 7) * 32; const size_t R = (size_t)b * SEQ + 64 * (c - 1) + t;
    const bf16* mo = (const bf16*)(F.ws + WS_MO) + R * 1024 + h * 256 + c0; const float* og = a.in[IN_OUTG] + h * 256 + c0; bf16* A2 = (bf16*)(F.ws + WS_A2) + R * DM + 1024 + h * 256 + c0;
#pragma unroll
    for (int q = 0; q < 4; ++q) { const v4u hv = *(const LAS v4u*)(HT + t * 264 + c0 + q * 8); const v4u mv = *(const v4u*)(mo + q * 8); const f32x4 g0 = *(const f32x4*)(og + q * 8), g1 = *(const f32x4*)(og + q * 8 + 4);
      v4u o; o.x = pk2(bflo(hv.x) * g0.x * sigmoidf_(bflo(mv.x)), bfhi(hv.x) * g0.y * sigmoidf_(bfhi(mv.x))); o.y = pk2(bflo(hv.y) * g0.z * sigmoidf_(bflo(mv.y)), bfhi(hv.y) * g0.w * sigmoidf_(bfhi(mv.y)));
      o.z = pk2(bflo(hv.z) * g1.x * sigmoidf_(bflo(mv.z)), bfhi(hv.z) * g1.y * sigmoidf_(bfhi(mv.z))); o.w = pk2(bflo(hv.w) * g1.z * sigmoidf_(bflo(mv.w)), bfhi(hv.w) * g1.w * sigmoidf_(bfhi(mv.w)));
      *(v4u*)(A2 + q * 8) = o; } }
  TP_END(36, F.ws);
}
}
struct CombRow { float mp[8][3], lp[8][3]; v4u op[8][3]; };
__device__ __forceinline__ float half_sum_dpp(float v, bool hi) {
  v += __builtin_bit_cast(float, __builtin_amdgcn_update_dpp(0, __builtin_bit_cast(int, v), 0xB1, 0xF, 0xF, true));
  v += __builtin_bit_cast(float, __builtin_amdgcn_update_dpp(0, __builtin_bit_cast(int, v), 0x4E, 0xF, 0xF, true));
  v += __builtin_bit_cast(float, __builtin_amdgcn_update_dpp(0, __builtin_bit_cast(int, v), 0x141, 0xF, 0xF, true));
  v += __builtin_bit_cast(float, __builtin_amdgcn_update_dpp(0, __builtin_bit_cast(int, v), 0x140, 0xF, 0xF, true));
  const float r0 = __builtin_bit_cast(float, __builtin_amdgcn_readlane(__builtin_bit_cast(int, v), 0)), r1 = __builtin_bit_cast(float, __builtin_amdgcn_readlane(__builtin_bit_cast(int, v), 16));
  const float r2 = __builtin_bit_cast(float, __builtin_amdgcn_readlane(__builtin_bit_cast(int, v), 32)), r3 = __builtin_bit_cast(float, __builtin_amdgcn_readlane(__builtin_bit_cast(int, v), 48));
  return hi ? r2 + r3 : r0 + r1;
}
__device__ __forceinline__ void comb_load(const bf16* PO, const float* ML, int R0, int NA, int lane, CombRow& cr) {
  const int b = R0 >> 11, t = R0 & 2047, qb = t >> 8, rq = (t & 255) + (lane >> 5), l32 = lane & 31;
#pragma unroll
  for (int hm = 0; hm < 8; ++hm) {
    const int bhm = b * 8 + hm, first = bhm * att::STEPS_BHM + att::qb_start(qb), last = first + 4 * qb + 4;
    const int cf = att::chunk_of(first, NA), np = att::chunk_of(last, NA) - cf + 1, slot0 = bhm * 16 + qb + cf - att::chunk_of(bhm * att::STEPS_BHM, NA);
#pragma unroll
    for (int p = 0; p < 3; ++p) { if (p < np) { const int slot = slot0 + p; const v2u ml = *(const v2u*)(ML + (size_t)slot * 512 + rq * 2);
        const unsigned mx_ = ml.x, my_ = ml.y; cr.mp[hm][p] = __builtin_bit_cast(float, mx_); cr.lp[hm][p] = __builtin_bit_cast(float, my_);
        cr.op[hm][p] = ((const v4u*)(PO + ((size_t)slot * 256 + rq) * 256))[l32]; } else { cr.mp[hm][p] = -1e30f; cr.lp[hm][p] = 0.f; cr.op[hm][p] = (v4u){0u, 0u, 0u, 0u}; } }
  }
}
__device__ __forceinline__ void comb_finish(bf16* A2, int R0, int lane, float lam, const f32x4 sg0, const f32x4 sg1, const CombRow& cr) {
  const bool hi = lane >= 32; const int l32 = lane & 31;
#pragma unroll
  for (int h = 0; h < 4; ++h) {
    float om[2][8];
#pragma unroll
    for (int m = 0; m < 2; ++m) { const int hm = h * 2 + m;
      const float M = fmaxf(cr.mp[hm][0], fmaxf(cr.mp[hm][1], cr.mp[hm][2]));
      float wsum = 0.f, acc[8];
#pragma unroll
      for (int i = 0; i < 8; ++i) acc[i] = 0.f;
#pragma unroll
      for (int p = 0; p < 3; ++p) { const float w = cr.lp[hm][p] * exp2f(cr.mp[hm][p] - M); wsum += w; const v4u ow = cr.op[hm][p];
#pragma unroll
        for (int i = 0; i < 4; ++i) { const unsigned wd = ow[i]; acc[2 * i] += bflo(wd) * w; acc[2 * i + 1] += bfhi(wd) * w; } }
      const float iw = 1.0f / wsum;
#pragma unroll
      for (int i = 0; i < 8; ++i) om[m][i] = acc[i] * iw;
    }
    float o[8], ss = 0.f;
#pragma unroll
    for (int i = 0; i < 8; ++i) { o[i] = om[0][i] - om[1][i] * lam; ss += o[i] * o[i]; }
    const float rs = rsqrtf(half_sum_dpp(ss, hi) * (1.0f / 256.f) + EPS) * 0.8f;
    v4u w; w.x = pk2(o[0] * rs * sg0.x, o[1] * rs * sg0.y); w.y = pk2(o[2] * rs * sg0.z, o[3] * rs * sg0.w); w.z = pk2(o[4] * rs * sg1.x, o[5] * rs * sg1.y); w.w = pk2(o[6] * rs * sg1.z, o[7] * rs * sg1.w);
    ((v4u*)(A2 + (size_t)(R0 + (hi ? 1 : 0)) * DM + h * 256))[l32] = w;
  }
}
__device__ __forceinline__ void p3_combine(const Frame& F, const Args& a, int NA) {
  const bf16* PO = (const bf16*)(F.ws + WS_PO); const float* ML = (const float*)(F.ws + WS_ML);
  bf16* A2 = (bf16*)(F.ws + WS_A2);
  const float lam = *(const float*)(F.ws + WS_LAM);
  const int gw = blockIdx.x * NWAVES + F.wave, NGW = gridDim.x * NWAVES, lane = F.lane;
  const f32x4 sg0 = ((const f32x4*)a.in[IN_SUBG])[2 * (lane & 31)], sg1 = ((const f32x4*)a.in[IN_SUBG])[2 * (lane & 31) + 1];
  for (int k = gw; k < MROWS / 4; k += NGW) {
#pragma unroll 1
    for (int s = 0; s < 2; ++s) { const int P = s ? MROWS / 2 - 1 - k : k;
      CombRow r0;
      comb_load(PO, ML, 2 * P, NA, lane, r0);
      comb_finish(A2, 2 * P, lane, lam, sg0, sg1, r0); }
  }
}
struct EpiRes {
  static constexpr bool PERM = true, AFTER_DRAIN = false;
  const float* x; float* out; bf16* H1b; float* SSQ;
  __device__ __forceinline__ void operator()(const pg8::f32x4 (&acc)[2][2][4][2], const pg8::Unit& u, int wr, int wc, int fr, int fq) const {
    const int row0 = u.pm * 256 + wr * 64 + fr, col0 = u.pn * 256 + wc * 32 + 8 * fq;
#pragma unroll
    for (int ai = 0; ai < 2; ++ai) {
      f32x4 xv[4][2][2];
#pragma unroll
      for (int m = 0; m < 4; ++m)
#pragma unroll
        for (int bj = 0; bj < 2; ++bj) { const size_t off = (size_t)(row0 + ai * 128 + m * 16) * DM + col0 + bj * 128; xv[m][bj][0] = *(const f32x4*)(x + off); xv[m][bj][1] = *(const f32x4*)(x + off + 4); }
#pragma unroll
      for (int m = 0; m < 4; ++m) { const size_t R = (size_t)(row0 + ai * 128 + m * 16); float s = 0.f;
#pragma unroll
        for (int bj = 0; bj < 2; ++bj) { const size_t off = R * DM + col0 + bj * 128;
          const f32x4 v0 = acc[ai][bj][m][0] + xv[m][bj][0], v1 = acc[ai][bj][m][1] + xv[m][bj][1];
          v4u w; w.x = pk2(v0.x, v0.y); w.y = pk2(v0.z, v0.w); w.z = pk2(v1.x, v1.y); w.w = pk2(v1.z, v1.w);
          *(v4u*)(H1b + off) = w;
          s += (v0.x * v0.x + v0.y * v0.y) + (v0.z * v0.z + v0.w * v0.w) + (v1.x * v1.x + v1.y * v1.y) + (v1.z * v1.z + v1.w * v1.w); }
        s += __shfl_xor(s, 16); s += __shfl_xor(s, 32);
        if (fq == 0) SSQ[R * 32 + u.pn * 4 + wc] = s; }
    }
  }
};
#ifndef PEER_U_FP8
#define PEER_U_FP8 0
#endif
typedef __bf16 bfv2 __attribute__((ext_vector_type(2)));
__device__ __forceinline__ void split_hl(const f32x4 a, const f32x4 b, bf16x8& hi, bf16x8& lo) {
  float v[8] = {a.x, a.y, a.z, a.w, b.x, b.y, b.z, b.w}; unsigned h[8], l[8];
#pragma unroll
  for (int i = 0; i < 8; ++i) { h[i] = f2bf(v[i]); l[i] = f2bf(v[i] - __builtin_bit_cast(float, h[i] << 16)); }
  v4u hv = {h[0] | (h[1] << 16), h[2] | (h[3] << 16), h[4] | (h[5] << 16), h[6] | (h[7] << 16)};
  v4u lv = {l[0] | (l[1] << 16), l[2] | (l[3] << 16), l[4] | (l[5] << 16), l[6] | (l[7] << 16)};
  hi = __builtin_bit_cast(bf16x8, hv); lo = __builtin_bit_cast(bf16x8, lv);
}
__device__ __forceinline__ void p0_w3t(const Frame& F, const Args& a) {
  const float* wq = a.in[IN_WQ]; const float* sk = a.in[IN_SUBK]; const float* g2 = a.in[IN_G2];
  bf16* W3t = (bf16*)(F.ws + WS_W3T);
  const int lane = F.lane, fr = lane & 15, fq = lane >> 4;
  constexpr int SKS = 272;
  LAS unsigned char* shi = F.lds; LAS unsigned char* slo = F.lds + 128 * SKS;
  for (int bt = blockIdx.x; bt < 256; bt += gridDim.x) {
    const int hh = bt & 15, kt = (bt >> 4) * 8 + F.wave;
    const float* ap = wq + (size_t)(kt * 16 + fr) * DM + hh * 128 + fq * 8;
    f32x4 a0[4], a1[4];
#pragma unroll
    for (int s = 0; s < 4; ++s) { a0[s] = *(const f32x4*)(ap + 32 * s); a1[s] = *(const f32x4*)(ap + 32 * s + 4); }
    const f32x4 gk = *(const f32x4*)(g2 + kt * 16 + fq * 4);
    __syncthreads();
#pragma unroll
    for (int i = 0; i < 4; ++i) { const int idx = F.tid + NTHR * i, key = idx >> 4, c8 = idx & 15; const float* p = sk + (size_t)(hh * 128 + key) * 128 + c8 * 8;
      bf16x8 h, l; split_hl(*(const f32x4*)p, *(const f32x4*)(p + 4), h, l);
      *(LAS bf16x8*)(shi + key * SKS + c8 * 16) = h; *(LAS bf16x8*)(slo + key * SKS + c8 * 16) = l; }
    bf16x8 ahi[4], alo[4];
#pragma unroll
    for (int s = 0; s < 4; ++s) split_hl(a0[s], a1[s], ahi[s], alo[s]);
    __syncthreads();
#pragma unroll 2
    for (int t2 = 0; t2 < 8; ++t2) {
      const LAS unsigned char* bh = shi + (t2 * 16 + fr) * SKS + fq * 16; const LAS unsigned char* bl = slo + (t2 * 16 + fr) * SKS + fq * 16;
      f32x4 acc = {0.f, 0.f, 0.f, 0.f};
#pragma unroll
      for (int s = 0; s < 4; ++s) { const bf16x8 bhi = *(const LAS bf16x8*)(bh + 64 * s), blo = *(const LAS bf16x8*)(bl + 64 * s);
        acc = __builtin_amdgcn_mfma_f32_16x16x32_bf16(ahi[s], bhi, acc, 0, 0, 0);
        acc = __builtin_amdgcn_mfma_f32_16x16x32_bf16(ahi[s], blo, acc, 0, 0, 0);
        acc = __builtin_amdgcn_mfma_f32_16x16x32_bf16(alo[s], bhi, acc, 0, 0, 0); }
      v2u o; o.x = pk2(acc.x * gk.x, acc.y * gk.y); o.y = pk2(acc.z * gk.z, acc.w * gk.w);
      *(v2u*)(W3t + (size_t)(hh * 128 + t2 * 16 + fr) * DM + kt * 16 + fq * 4) = o;
    }
  }
  __syncthreads();
}
typedef float f32x2v __attribute__((ext_vector_type(2)));
__device__ __forceinline__ void p0_tables(const Frame& F, const Args& a) {
  const float* g2 = a.in[IN_G2];
  float* SCL = (float*)(F.ws + WS_SCL);
  const int gw = blockIdx.x * NWAVES + F.wave, NGW = gridDim.x * NWAVES, lane = F.lane;
  f32x4 gl[8];
#pragma unroll
  for (int q = 0; q < 8; ++q) gl[q] = *(const f32x4*)(g2 + q * 256 + lane * 4);
  f32x4 xn[8];
  { const int row = gw; if (row < 2 * 16384) { const float* src = a.in[row >= 16384 ? IN_V : IN_U] + (size_t)(row & 16383) * DM + lane * 4;
#pragma unroll
      for (int q = 0; q < 8; ++q) xn[q] = *(const f32x4*)(src + q * 256); } }
  for (int row = gw; row < 2 * 16384; row += NGW) {
    const bool isv = row >= 16384; const int e = row & 16383;
    f32x4 x[8];
#pragma unroll
    for (int q = 0; q < 8; ++q) x[q] = xn[q];
    { const int rn = row + NGW; if (rn < 2 * 16384) { const float* src = a.in[rn >= 16384 ? IN_V : IN_U] + (size_t)(rn & 16383) * DM + lane * 4;
#pragma unroll
        for (int q = 0; q < 8; ++q) xn[q] = *(const f32x4*)(src + q * 256); } }
    float amax = 0.f, ssq = 0.f;
#pragma unroll
    for (int q = 0; q < 8; ++q) { if (!isv) x[q] = x[q] * gl[q]; amax = fmaxf(amax, fmaxf(fmaxf(fabsf(x[q].x), fabsf(x[q].y)), fmaxf(fabsf(x[q].z), fabsf(x[q].w))));
      ssq += (x[q].x * x[q].x + x[q].y * x[q].y) + (x[q].z * x[q].z + x[q].w * x[q].w); }
#pragma unroll
    for (int o = 1; o < 64; o <<= 1) amax = fmaxf(amax, __shfl_xor(amax, o));
    v4u w;
    if (isv) {
      const float sc = amax > 0.f ? 6.0f / amax : 1.0f;
#pragma unroll
      for (int d = 0; d < 4; ++d) { unsigned pk = 0u;
        pk = __builtin_amdgcn_cvt_scalef32_pk_fp4_f32(pk, x[2 * d].x * sc, x[2 * d].y * sc, 1.0f, 0); pk = __builtin_amdgcn_cvt_scalef32_pk_fp4_f32(pk, x[2 * d].z * sc, x[2 * d].w * sc, 1.0f, 1);
        pk = __builtin_amdgcn_cvt_scalef32_pk_fp4_f32(pk, x[2 * d + 1].x * sc, x[2 * d + 1].y * sc, 1.0f, 2); pk = __builtin_amdgcn_cvt_scalef32_pk_fp4_f32(pk, x[2 * d + 1].z * sc, x[2 * d + 1].w * sc, 1.0f, 3);
        w[d] = pk; }
      if (lane == 0) SCL[row] = 1.0f / sc;
    } else {
      ssq = wave_sum_dpp(ssq);
      const float sA = amax > 0.f ? amax * (1.0f / 7.0f) : 1.0f, sB = fminf(sA, 0.36f * sqrtf(ssq * (1.0f / DM)) + 1e-30f);
      const float iA = 1.0f / sA, iB = 1.0f / sB;
      float eA = 0.f, eB = 0.f;
#pragma unroll
      for (int q = 0; q < 8; ++q)
#pragma unroll
        for (int j = 0; j < 4; ++j) { const float v = x[q][j];
          const float da = v - sA * __builtin_amdgcn_fmed3f(__builtin_rintf(v * iA), -7.0f, 7.0f), db = v - sB * __builtin_amdgcn_fmed3f(__builtin_rintf(v * iB), -7.0f, 7.0f);
          eA += da * da; eB += db * db; }
      eA = wave_sum_dpp(eA); eB = wave_sum_dpp(eB);
      const bool useB = eB < eA; const float st = useB ? sB : sA, is = useB ? iB : iA;
#pragma unroll
      for (int d = 0; d < 4; ++d) { unsigned pk = 0u;
#pragma unroll
        for (int p = 0; p < 8; ++p) { const float v = x[2 * d + (p >> 2)][p & 3]; const int qi = (int)__builtin_amdgcn_fmed3f(__builtin_rintf(v * is), -7.0f, 7.0f); pk |= ((unsigned)qi & 15u) << (4 * p); }
        w[d] = pk; }
      if (lane == 0) SCL[row] = st;
    }
    *(v4u*)(F.ws + (isv ? WS_VB8 : WS_UB) + (size_t)e * 1024 + lane * 16) = w;
  }
}
struct EpiScore {
  static constexpr bool PERM = true, AFTER_DRAIN = false;
  float* S; const LAS float* rs;
  __device__ __forceinline__ void operator()(const pg8::f32x4 (&acc)[2][2][4][2], const pg8::Unit& u, int wr, int wc, int fr, int fq) const {
    const int rl0 = wr * 64 + fr, keyb = wc * 32 + 8 * fq;
#pragma unroll
    for (int ai = 0; ai < 2; ++ai)
#pragma unroll
      for (int m = 0; m < 4; ++m) { const int rl = rl0 + ai * 128 + m * 16; const float r = rs[rl]; const int row = u.pm * 256 + rl;
#pragma unroll
        for (int bj = 0; bj < 2; ++bj) { float* d = S + ((size_t)((row >> 5) * 16 + u.pn * 2 + bj) * 128 + keyb) * 32 + (row & 31);
          const pg8::f32x4 v0 = acc[ai][bj][m][0] * r, v1 = acc[ai][bj][m][1] * r;
          d[0] = v0[0]; d[32] = v0[1]; d[64] = v0[2]; d[96] = v0[3]; d[128] = v1[0]; d[160] = v1[1]; d[192] = v1[2]; d[224] = v1[3]; } }
  }
};

__device__ __forceinline__ unsigned fkey(float f) { const unsigned b = __builtin_bit_cast(unsigned, f); return b ^ ((b >> 31) ? 0xFFFFFFFFu : 0x80000000u); }
template <int NV, int K> __device__ __forceinline__ void wave_topk(const unsigned (&u)[NV], bool (&sel)[NV], int lane) {
  unsigned prefix = 0u; int cge = NV * 64;
#pragma unroll 1
  for (int bit = 31; bit >= 0 && cge != K; --bit) {
    const unsigned cand = prefix | (1u << bit); int c = 0;
#pragma unroll
    for (int i = 0; i < NV; ++i) c += __builtin_popcountll(__ballot(u[i] >= cand));
    if (c >= K) { prefix = cand; cge = c; }
  }
  int cgt = 0;
#pragma unroll
  for (int i = 0; i < NV; ++i) cgt += __builtin_popcountll(__ballot(u[i] > prefix));
  int need = K - cgt;
  const unsigned long long lm = (1ull << lane) - 1ull;
#pragma unroll
  for (int i = 0; i < NV; ++i) { const unsigned long long eq = __ballot(u[i] == prefix); const int before = __builtin_popcountll(eq & lm);
    sel[i] = (u[i] > prefix) || (u[i] == prefix && before < need); const int ne = __builtin_popcountll(eq); need = need > ne ? need - ne : 0; }
}
template <int NG, int NV, int K> __device__ __forceinline__ void wave_topk_multi(const unsigned (&u)[NG][NV], bool (&sel)[NG][NV], int lane) {
  unsigned prefix[NG]; int cge[NG];
#pragma unroll
  for (int g = 0; g < NG; ++g) { prefix[g] = 0u; cge[g] = NV * 64; }
#pragma unroll 1
  for (int bit = 31; bit >= 0; --bit) {
    bool done = true;
#pragma unroll
    for (int g = 0; g < NG; ++g) done = done && (cge[g] == K);
    if (done) break;
#pragma unroll
    for (int g = 0; g < NG; ++g) { const unsigned cand = prefix[g] | (1u << bit); int c = 0;
#pragma unroll
      for (int i = 0; i < NV; ++i) c += __builtin_popcountll(__ballot(u[g][i] >= cand));
      if (cge[g] != K && c >= K) { prefix[g] = cand; cge[g] = c; } }
  }
  const unsigned long long lm = (1ull << lane) - 1ull;
#pragma unroll
  for (int g = 0; g < NG; ++g) { int cgt = 0;
#pragma unroll
    for (int i = 0; i < NV; ++i) cgt += __builtin_popcountll(__ballot(u[g][i] > prefix[g]));
    int need = K - cgt;
#pragma unroll
    for (int i = 0; i < NV; ++i) { const unsigned long long eq = __ballot(u[g][i] == prefix[g]); const int before = __builtin_popcountll(eq & lm);
      sel[g][i] = (u[g][i] > prefix[g]) || (u[g][i] == prefix[g] && before < need); const int ne = __builtin_popcountll(eq); need = need > ne ? need - ne : 0; } }
}
__device__ __forceinline__ float gelu_erf(float v) {
  const float av = fabsf(v), t = __builtin_amdgcn_rcpf(1.0f + 0.2316418882f * av);
  float q = t * 0.5307027145f - 0.7265760135f; q = q * t + 0.7107068705f; q = q * t - 0.142248368f; q = q * t + 0.127414796f; q = q * t;
  const float tail = q * __builtin_amdgcn_exp2f(v * v * -0.72134752044f);
  return v < 0.f ? v * tail : v - v * tail;
}

#ifndef ROUTE_REPS
#define ROUTE_REPS 1
#endif
__device__ __forceinline__ void ins16(float (&t)[16], float x) {
#pragma unroll
  for (int i = 15; i >= 1; --i) t[i] = __builtin_amdgcn_fmed3f(t[i - 1], t[i], x);
  t[0] = fmaxf(t[0], x);
}
__device__ __forceinline__ void p6_peer(const Frame& F, const Args& a, float* dst_base) {
  const float* S2 = (const float*)(F.ws + WS_S); const float* SSQ = (const float*)(F.ws + WS_SSQ); const bf16* H1b = (const bf16*)(F.ws + WS_H1B);
  int lane = F.lane, wv = F.wave, tid = F.tid; asm volatile("" : "+v"(lane), "+s"(wv), "+v"(tid));
  int* EIDg = (int*)(F.ws + WS_EID); float* EGTg = (float*)(F.ws + WS_EGT);
  LAS int* eid = (LAS int*)(F.lds + wv * 4608); LAS float* cg = (LAS float*)(eid + 512); LAS float* esu = (LAS float*)(eid + 1024);
  LAS unsigned char* RB = F.lds + 36864 + wv * 8192;
  LAS float* L1 = (LAS float*)(F.lds + 36864);
  TP_BEGIN(11);
#ifdef TPROBE
  const unsigned long long tp_p7_ = __builtin_amdgcn_s_memrealtime();
#endif
  for (int tb = blockIdx.x; tb < MROWS / 32; tb += gridDim.x) {
    __syncthreads();
    {
      const int g = tid >> 5, tl = tid & 31; const float* src = S2 + ((size_t)(tb * 16 + g) * 128) * 32 + tl;
      float t[16];
#pragma unroll
      for (int i = 0; i < 16; ++i) t[i] = -INFINITY;
      float sv[128];
#pragma unroll
      for (int k = 0; k < 128; ++k) sv[k] = src[k * 32];
#pragma unroll
      for (int k = 0; k < 128; ++k) ins16(t, __builtin_bit_cast(float, (__builtin_bit_cast(unsigned, sv[k]) & ~0x7Fu) | (unsigned)(127 - k)));
#pragma unroll
      for (int i = 0; i < 16; ++i) L1[(g * 16 + i) * 32 + tl] = t[i];
    }
    __syncthreads();
    if (tid < 256) {
      const int h8 = tid >> 5, tl = tid & 31; const LAS float* LA = L1 + ((2 * h8) * 16) * 32 + tl; const LAS float* LB = L1 + ((2 * h8 + 1) * 16) * 32 + tl;
      float A[16], B[16], t[16];
#pragma unroll
      for (int i = 0; i < 16; ++i) { A[i] = LA[i * 32]; B[i] = LB[i * 32]; t[i] = -INFINITY; }
#pragma unroll
      for (int i = 0; i < 16; ++i)
#pragma unroll
        for (int j = 0; j < 16; ++j) if ((i + 1) * (j + 1) <= 16) { const float c = A[i] + B[j];
            ins16(t, __builtin_bit_cast(float, (__builtin_bit_cast(unsigned, c) & ~0xFFu) | (unsigned)(255 - (i * 16 + j)))); }
      float ev[16], es = 0.f;
#pragma unroll
      for (int r = 0; r < 16; ++r) { ev[r] = __expf(t[r] - t[0]); es += ev[r]; }
      const float inv = 1.0f / es;
#pragma unroll
      for (int r = 0; r < 16; ++r) { const unsigned flat = 255u - (__builtin_bit_cast(unsigned, t[r]) & 0xFFu), ii = flat >> 4, jj = flat & 15u;
        const unsigned ka = 127u - (__builtin_bit_cast(unsigned, LA[ii * 32]) & 0x7Fu), kb = 127u - (__builtin_bit_cast(unsigned, LB[jj * 32]) & 0x7Fu);
        EIDg[(size_t)(tb * 32 + tl) * 128 + h8 * 16 + r] = (int)(ka * 128u + kb); EGTg[(size_t)(tb * 32 + tl) * 128 + h8 * 16 + r] = ev[r] * inv; }
    }
    asm volatile("s_waitcnt vmcnt(0)" ::: "memory"); __syncthreads();
    TP_END(11, F.ws);
    const unsigned char* U8 = F.ws + WS_UB; const unsigned char* V8 = F.ws + WS_VB8;
    constexpr int NBT = 2;
#define PG_ISSUE(TAB, E) do { const int idq_ = __builtin_amdgcn_readfirstlane(eidt[(E)]); \
      __builtin_amdgcn_global_load_lds((const unsigned*)((TAB) + (size_t)idq_ * 1024 + lane * 16), (LAS unsigned*)(RB + ((E) & 7) * 1024), 16, 0, 0); } while (0)
#pragma unroll 1
    for (int tt = 0; tt < 4; ++tt) {
      const int tok = tb * 32 + wv * 4 + tt;
      LAS int* eidt = eid + tt * 128; LAS float* cgt = cg + tt * 128;
      const float rs = rsqrtf(wave_sum_dpp(lane < 32 ? SSQ[(size_t)tok * 32 + lane] : 0.f) * (1.0f / DM) + EPS);
      { const float* SCL = (const float*)(F.ws + WS_SCL);
#pragma unroll
        for (int i = 0; i < 2; ++i) { const int e = lane + 64 * i, idq = __builtin_nontemporal_load(EIDg + (size_t)tok * 128 + e);
          eidt[e] = idq; esu[e] = SCL[idq]; cgt[e] = __builtin_nontemporal_load(EGTg + (size_t)tok * 128 + e) * SCL[16384 + idq]; } }
      unsigned xw[16];
      { const bf16* xp = H1b + (size_t)tok * DM + (size_t)lane * 4;
#pragma unroll
        for (int q = 0; q < 8; ++q) { const v2u x0 = *(const v2u*)(xp + q * 256); xw[2 * q] = x0.x; xw[2 * q + 1] = x0.y; } }
      int xl[4], xh[4]; float rsx;
      { float xa = 0.f;
#pragma unroll
        for (int i = 0; i < 16; ++i) xa = fmaxf(xa, fmaxf(fabsf(bflo(xw[i])), fabsf(bfhi(xw[i]))));
#pragma unroll
        for (int o = 1; o < 64; o <<= 1) xa = fmaxf(xa, __shfl_xor(xa, o));
        const float xinv = xa > 0.f ? 119.0f / xa : 0.f; rsx = rs * (xa > 0.f ? xa * (1.0f / 119.0f) : 0.f);
#pragma unroll
        for (int d = 0; d < 4; ++d) { unsigned pl = 0u, ph = 0u;
#pragma unroll
          for (int p = 0; p < 8; ++p) { const int i = 8 * d + p; const float v = (i & 1) ? bfhi(xw[i >> 1]) : bflo(xw[i >> 1]);
            const int xi = (int)__builtin_rintf(v * xinv), l = ((xi + 8) & 15) - 8, h = (xi - l) >> 4;
            pl |= ((unsigned)l & 15u) << (4 * p); ph |= ((unsigned)h & 15u) << (4 * p); }
          xl[d] = (int)pl; xh[d] = (int)ph; } }
      asm volatile("s_waitcnt vmcnt(0) lgkmcnt(0)" ::: "memory");
#define PU_BATCH(E0, DOISSUE) do { v4u ub[NBT]; float su_[NBT], gt_[NBT]; \
        _Pragma("unroll") for (int q = 0; q < NBT; ++q) { ub[q] = *(const LAS v4u*)(RB + (((E0) + q) & 7) * 1024 + lane * 16); su_[q] = esu[(E0) + q]; gt_[q] = cgt[(E0) + q]; } \
        asm volatile("s_waitcnt lgkmcnt(0)" ::: "memory"); \
        if (DOISSUE) { _Pragma("unroll") for (int q = 0; q < NBT; ++q) PG_ISSUE(U8, (E0) + 8 + q); } \
        float d_[NBT]; _Pragma("unroll") for (int q = 0; q < NBT; ++q) { int al_ = 0, ah_ = 0; _Pragma("unroll") for (int dd = 0; dd < 4; ++dd) { const int wa = (int)ub[q][dd]; \
            al_ = __builtin_amdgcn_sdot8(wa, xl[dd], al_, false); ah_ = __builtin_amdgcn_sdot8(wa, xh[dd], ah_, false); } d_[q] = (float)(ah_ * 16 + al_); } \
        _Pragma("unroll") for (int q = 0; q < NBT; ++q) d_[q] = wave_sum_dpp(d_[q]); \
        _Pragma("unroll") for (int q = 0; q < NBT; ++q) { const float c_ = gelu_erf(d_[q] * (rsx * su_[q])) * gt_[q]; if (lane == 0) cgt[(E0) + q] = c_; } } while (0)
#pragma unroll
      for (int e = 0; e < 8; ++e) PG_ISSUE(U8, e);
#pragma unroll 1
      for (int e = 0; e < 120; e += NBT) {
        asm volatile("s_waitcnt vmcnt(6)" ::: "memory");
        PU_BATCH(e, true);
        asm volatile("" ::: "memory");
      }
      asm volatile("s_waitcnt vmcnt(0)" ::: "memory");
#pragma unroll 1
      for (int e = 120; e < 128; e += NBT) PU_BATCH(e, false);
      asm volatile("s_waitcnt lgkmcnt(0)" ::: "memory");
#undef PU_BATCH
    }
#pragma unroll 1
    for (int tt = 0; tt < 4; ++tt) {
      const int tok = tb * 32 + wv * 4 + tt;
      LAS int* eidt = eid + tt * 128; LAS float* cgt = cg + tt * 128;
      float y[32];
#pragma unroll
      for (int i = 0; i < 32; ++i) y[i] = 0.f;
#define PV_BATCH(E0, DOISSUE) do { v4u vb[NBT]; float c_[NBT]; \
        _Pragma("unroll") for (int q = 0; q < NBT; ++q) { vb[q] = *(const LAS v4u*)(RB + (((E0) + q) & 7) * 1024 + lane * 16); c_[q] = cgt[(E0) + q]; } \
        asm volatile("s_waitcnt lgkmcnt(0)" ::: "memory"); \
        if (DOISSUE) { _Pragma("unroll") for (int q = 0; q < NBT; ++q) PG_ISSUE(V8, (E0) + 8 + q); } \
        _Pragma("unroll") for (int q = 0; q < NBT; ++q) { _Pragma("unroll") for (int dd = 0; dd < 4; ++dd) { const unsigned wa = vb[q][dd]; \
            { const f32x2v v2 = __builtin_amdgcn_cvt_scalef32_pk_f32_fp4(wa, 1.0f, 0); y[8 * dd + 0] += c_[q] * v2.x; y[8 * dd + 1] += c_[q] * v2.y; } \
            { const f32x2v v2 = __builtin_amdgcn_cvt_scalef32_pk_f32_fp4(wa, 1.0f, 1); y[8 * dd + 2] += c_[q] * v2.x; y[8 * dd + 3] += c_[q] * v2.y; } \
            { const f32x2v v2 = __builtin_amdgcn_cvt_scalef32_pk_f32_fp4(wa, 1.0f, 2); y[8 * dd + 4] += c_[q] * v2.x; y[8 * dd + 5] += c_[q] * v2.y; } \
            { const f32x2v v2 = __builtin_amdgcn_cvt_scalef32_pk_f32_fp4(wa, 1.0f, 3); y[8 * dd + 6] += c_[q] * v2.x; y[8 * dd + 7] += c_[q] * v2.y; } } \
          __builtin_amdgcn_sched_barrier(0); } } while (0)
#pragma unroll
      for (int e = 0; e < 8; ++e) PG_ISSUE(V8, e);
#pragma unroll 1
      for (int e = 0; e < 120; e += NBT) {
        asm volatile("s_waitcnt vmcnt(6)" ::: "memory");
        PV_BATCH(e, true);
        asm volatile("" ::: "memory");
      }
      asm volatile("s_waitcnt vmcnt(0)" ::: "memory");
      unsigned xw[16];
      { const bf16* xp = H1b + (size_t)tok * DM + (size_t)lane * 4;
#pragma unroll
        for (int q = 0; q < 8; ++q) { const v2u x0 = *(const v2u*)(xp + q * 256); xw[2 * q] = x0.x; xw[2 * q + 1] = x0.y; } }
#pragma unroll 1
      for (int e = 120; e < 128; e += NBT) PV_BATCH(e, false);
      asm volatile("s_waitcnt lgkmcnt(0)" ::: "memory");
#undef PV_BATCH
      float* drow = dst_base + (size_t)tok * DM;
#pragma unroll
      for (int q = 0; q < 8; ++q) { const size_t off = (size_t)q * 256 + lane * 4; f32x4 hv;
        hv.x = bflo(xw[2 * q]) + y[4 * q];
#ifdef TPROBE
        if (TPROBE != 13 && tok == 0 && lane == 0 && q == 0) hv.x += 10.0f + (float)(*(volatile unsigned*)(F.ws + 64)) * (0.01f / TP_DIV);
        if (TPROBE == 13 && (int)blockIdx.x == TP_BLOCK && wv == 7 && tt == 3 && lane == 0 && q == 0) hv.x += 10.0f + (float)(unsigned)(__builtin_amdgcn_s_memrealtime() - tp_p7_) * (0.01f / TP_DIV);
#endif
        hv.y = bfhi(xw[2 * q]) + y[4 * q + 1]; hv.z = bflo(xw[2 * q + 1]) + y[4 * q + 2]; hv.w = bfhi(xw[2 * q + 1]) + y[4 * q + 3]; *(f32x4*)(drow + off) = hv; }
    }
#undef PG_ISSUE
  }
}
constexpr int MISC_LDS = LDS_BYTES - 256;
__global__ void __launch_bounds__(NTHR, 2) mk_fwd(Args args) {
  extern __shared__ __attribute__((aligned(16))) unsigned char lds_raw[];
  Frame F; F.lds = (LAS unsigned char*)lds_raw; F.ws = args.ws; F.tid = threadIdx.x; F.lane = F.tid & 63; F.wave = __builtin_amdgcn_readfirstlane(F.tid >> 6);
  const int lo = args.ph_lo, hi = args.ph_hi, G = (int)gridDim.x, bx = (int)blockIdx.x;
  volatile LAS unsigned* misc = (volatile LAS unsigned*)(F.lds + MISC_LDS);
  if (F.tid < 16) misc[F.tid] = 0u;
  __syncthreads();
  XcdBarrier bar = xcd_barrier_post((unsigned*)(F.ws + WS_CTL) + CW_BAR, misc);
#define IN(k) (lo <= (k) && (k) < hi)
#ifdef TPROBE
#define SEAM(k) do { if (IN(k) && IN((k) + 1)) { const unsigned long long tq0_ = __builtin_amdgcn_s_memrealtime(); xcd_barrier(bar); const unsigned long long tq1_ = __builtin_amdgcn_s_memrealtime(); \
    if (TPROBE == 20 + (k) && (int)blockIdx.x == TP_BLOCK && threadIdx.x == 0) atomicAdd((unsigned*)(F.ws + 64), (unsigned)(tq1_ - tq0_)); } } while (0)
#else
#define SEAM(k) do { if (IN(k) && IN((k) + 1)) xcd_barrier(bar); } while (0)
#endif
#define PHASE_FRAME(Fp) Frame Fp = F; asm volatile("" : "+v"(Fp.tid), "+v"(Fp.lane))
  const int NA = G;
  if (IN(0)) { PHASE_FRAME(F0); TP_BEGIN(1);
#ifdef SLEEP_START
#pragma unroll 1
    for (int i_ = 0; i_ < SLEEP_START; ++i_) __builtin_amdgcn_s_sleep(127);
#endif
    p0_lam(F0, args);
    p0_zero_vpad(F0);
    p0_rows(F0, args);
    p0_transpose<true>(F0, args, args.in[IN_WIN], DPROJ, NPROJ, (bf16*)(F.ws + WS_W1T));
    p0_transpose<false>(F0, args, args.in[IN_WOUT], DM, DM, (bf16*)(F.ws + WS_W2T));
    p0_w3t(F0, args);
    p0_tables(F0, args);
#ifdef DUP_ROWS
    p0_rows(F0, args);
#endif
#ifdef DUP_TR
    p0_transpose<true>(F0, args, args.in[IN_WIN], DPROJ, NPROJ, (bf16*)(F.ws + WS_W1T));
    p0_transpose<false>(F0, args, args.in[IN_WOUT], DM, DM, (bf16*)(F.ws + WS_W2T));
#endif
#ifdef DUP_W3T
    p0_w3t(F0, args);
#endif
#ifdef DUP_TAB
    p0_tables(F0, args);
#endif
    TP_END(1, F.ws);
  }
  SEAM(0);
  if (IN(1)) { PHASE_FRAME(F1); TP_BEGIN(2);
    p1_meta_finalize(F1, args);
    pg8::Gemm g{(const pg8::bf16_t*)(F.ws + WS_XN), (const pg8::bf16_t*)(F.ws + WS_W1T), MROWS, NPROJ, DM};
    pg8::StaticOrder S; S.init(MROWS, NPROJ, G, bx);
    EpiProj E{(bf16*)(F.ws + WS_Q), (bf16*)(F.ws + WS_KP), (bf16*)(F.ws + WS_VP), (bf16*)(F.ws + WS_MQ), (bf16*)(F.ws + WS_MK), (bf16*)(F.ws + WS_MV), (bf16*)(F.ws + WS_MO),
              args.in[IN_QNG], args.in[IN_KNG], (LAS float*)(F.lds + XCH_OFF)};
    pg8::gemm_phase<EpiProj, pg8::StaticOrder, true, true>(F.lds + RING_OFF, g, S, E);
    TP_END(2, F.ws);
  }
  SEAM(1);
  if (IN(2)) {
    PHASE_FRAME(F2);
    TP_BEGIN(3);
    att::phase(F2, (G % 8 == 0) ? (bx & 7) * (G >> 3) + (bx >> 3) : bx, NA);
    TP_END(3, F.ws); TP_BEGIN(4);
    for (int task = bx; task < 512; task += G) ml::taskA(F2, args, task);
    TP_END(4, F.ws);
  }
  SEAM(2);
  if (IN(3)) { PHASE_FRAME(F3); TP_BEGIN(5); ml::scanB(F3); TP_END(5, F.ws); TP_BEGIN(6); p3_combine(F3, args, NA); TP_END(6, F.ws);
#ifdef DUP_SCAN
    ml::scanB(F3);
#endif
#ifdef DUP_COMB
    p3_combine(F3, args, NA);
#endif
  }
  SEAM(3);
  if (IN(4)) {
    PHASE_FRAME(F4);
    TP_BEGIN(7);
    for (int task = bx; task < 512; task += G) ml::taskC(F4, args, task);
    TP_END(7, F.ws);
  }
  SEAM(4);
  if (IN(5)) { TP_BEGIN(8);
    pg8::Gemm g{(const pg8::bf16_t*)(F.ws + WS_A2), (const pg8::bf16_t*)(F.ws + WS_W2T), MROWS, DM, DM};
    pg8::StaticOrder S; S.init(MROWS, DM, G, bx);
    EpiRes E{args.in[IN_X], args.out, (bf16*)(F.ws + WS_H1B), (float*)(F.ws + WS_SSQ)};
    pg8::gemm_phase<EpiRes, pg8::StaticOrder, true, true>(F.lds + RING_OFF, g, S, E);
    TP_END(8, F.ws);
  }
  SEAM(5);
  if (IN(6)) { TP_BEGIN(9);
    pg8::Gemm g{(const pg8::bf16_t*)(F.ws + WS_H1B), (const pg8::bf16_t*)(F.ws + WS_W3T), MROWS, DM, DM};
    pg8::StaticOrder S; S.init(MROWS, DM, G, bx);
    LAS float* rst = (LAS float*)(F.lds + XCH_OFF);
    { pg8::Unit u0; if (S.next(0, u0)) { if (F.tid < 256) { const float* sp = (const float*)(F.ws + WS_SSQ) + ((size_t)u0.pm * 256 + F.tid) * 32; float s = 0.f;
#pragma unroll
          for (int i = 0; i < 8; ++i) { const f32x4 v = ((const f32x4*)sp)[i]; s += (v.x + v.y) + (v.z + v.w); }
          rst[F.tid] = rsqrtf(s * (1.0f / DM) + EPS); } } }
    __syncthreads();
    EpiScore E{(float*)(F.ws + WS_S), rst};
    pg8::gemm_phase<EpiScore, pg8::StaticOrder, true, true>(F.lds + RING_OFF, g, S, E);
    TP_END(9, F.ws);
  }
  SEAM(6);
  if (IN(7)) { PHASE_FRAME(F7); TP_BEGIN(10); p6_peer(F7, args, args.out); TP_END(10, F.ws); }
#undef IN
#undef SEAM
}
extern "C" void kernel_launch(void* const* d_in, const int* in_sizes, int n_in, void* d_out, int out_size, void* d_ws, size_t ws_size, hipStream_t stream) {
  static int grid = 0;
  if (grid == 0) {
    int dev = 0, cus = 0, per_cu = 0;
    if (hipGetDevice(&dev) != hipSuccess || hipDeviceGetAttribute(&cus, hipDeviceAttributeMultiprocessorCount, dev) != hipSuccess) { fprintf(stderr, "device query failed\n"); grid = -1; return; }
    if (hipFuncSetAttribute((const void*)mk_fwd, hipFuncAttributeMaxDynamicSharedMemorySize, LDS_BYTES) != hipSuccess) { fprintf(stderr, "hipFuncSetAttribute failed\n"); grid = -1; return; }
    if (hipOccupancyMaxActiveBlocksPerMultiprocessor(&per_cu, (const void*)mk_fwd, NTHR, LDS_BYTES) != hipSuccess || per_cu < 1) { fprintf(stderr, "occupancy query says %d workgroups per CU: not launching\n", per_cu); (void)hipGetLastError(); grid = -1; return; }
    (void)hipGetLastError();
    grid = cus;
    if (n_in != 22 || ws_size < (size_t)512 * MiB || out_size != MROWS * DM) { fprintf(stderr, "unexpected shapes: n_in %d out %d ws %zu\n", n_in, out_size, ws_size); grid = -1; return; }
  }
  if (grid < 0) return;
  unsigned char* ws = (unsigned char*)d_ws;
  if (hipMemsetAsync(ws + WS_CTL, 0, CTL_ZERO_BYTES, stream) != hipSuccess) { fprintf(stderr, "memset failed\n"); return; }
  Args a{};
  for (int i = 0; i < 22; ++i) a.in[i] = (const float*)d_in[i];
  a.out = (float*)d_out; a.ws = ws; a.na = 0; a.pad = 0;
  a.ph_lo = 0; a.ph_hi = 8;
  hipLaunchKernelGGL(mk_fwd, dim3(grid), dim3(NTHR), LDS_BYTES, stream, a);
}
```

```cpp
#include <hip/hip_runtime.h>
#include <cstdio>
#include <cstdint>
#include <math.h>
namespace pg8 {
#define PG8_LAS __attribute__((address_space(3)))
typedef unsigned short bf16_t;
typedef short bf16x8 __attribute__((ext_vector_type(8)));
typedef float f32x4 __attribute__((ext_vector_type(4)));
typedef unsigned u32x4 __attribute__((ext_vector_type(4)));
constexpr int BM = 256, BK = 64, HALF = 128, HTB = HALF * BK * 2  , STAGE_BYTES = 8 * HTB, NXCD = 8, WGM = 8;

__host__ __device__ __forceinline__ int lds_byte(int r, int c) { const int st = (r >> 4) * 2 + (c >> 5), rr = r & 15, cc = c & 31, ob = rr * 64 + cc * 2; return st * 1024 + (ob ^ (((ob >> 9) & 1) << 5)); }
__host__ __device__ __forceinline__ void stage_rc(int b, int& R, int& C) { const int st = b / 1024, sb = b % 1024, swz = sb ^ (((sb >> 9) & 1) << 5); R = (st >> 1) * 16 + swz / 64; C = (st & 1) * 32 + (swz % 64) / 2; }
__host__ __device__ __forceinline__ int perm32(int rho) { const int n = rho >> 4, i = rho & 15; return 8 * (i >> 2) + 4 * n + (i & 3); }

struct Unit { int pm, pn; };
struct Gemm { const bf16_t* A; const bf16_t* Bt; int M, N, K; };

struct StaticOrder {
    int nM, nN, nwg, G, c;
    __host__ __device__ void init(int M, int N, int G_, int c_) { nM = M / BM; nN = N / BM; nwg = nM * nN; G = G_; c = c_; }
    __host__ __device__ bool next(int i, Unit& u) const {
        const long L = (long)i * G + c; if (L >= nwg) return false;
        int wgid = (int)L; { const int q = nwg / NXCD, r = nwg % NXCD, xcd = wgid % NXCD, off = wgid / NXCD; wgid = (xcd < r ? xcd * (q + 1) : r * (q + 1) + (xcd - r) * q) + off; }
        const int nig = WGM * nN, gid = wgid / nig, fm = gid * WGM, gsz = (nM - fm) < WGM ? (nM - fm) : WGM;
        u.pm = fm + ((wgid % nig) % gsz); u.pn = (wgid % nig) / gsz; return true;
    }
    __device__ __forceinline__ void a_ready(const Unit&) const {}
    __device__ __forceinline__ void done(const Unit&) const {}
};

__device__ __forceinline__ unsigned cvt_pk_bf16(float lo, float hi) { unsigned r; asm volatile("v_cvt_pk_bf16_f32 %0, %1, %2" : "=v"(r) : "v"(lo), "v"(hi)); return r; }
typedef float f32x2 __attribute__((ext_vector_type(2)));
template <class Epi, class Sched, bool ALIGN_EPI = false, bool SP2 = false>
__device__ __forceinline__ void gemm_phase(PG8_LAS unsigned char* lds, const Gemm g, const Sched& S, const Epi& E) {
    int tid_ = threadIdx.x; asm volatile("" : "+v"(tid_));
    const int tid = tid_, wid = __builtin_amdgcn_readfirstlane(tid >> 6), lane = tid & 63, wr = wid >> 2, wc = wid & 3, fr = lane & 15, fq = lane >> 4;
    const int K = g.K, nt = K / BK;
    unsigned voffA[2], voffB[2];
#pragma unroll
    for (int i = 0; i < 2; ++i) { int R, C; stage_rc(tid * 16 + i * 8192, R, C); const int Rb = Epi::PERM ? ((R & ~31) + perm32(R & 31)) : R;
        voffA[i] = (unsigned)(R * K + C) * 2u; voffB[i] = (unsigned)(Rb * K + C) * 2u; }
    const size_t kstep = (size_t)(BK * 2);
    const size_t hstep = (size_t)HALF * K * 2;
    const size_t tstep = 2 * hstep;
    const unsigned ldsw = (unsigned)wid * 1024u;
    const int aoff = lds_byte(wr * 64 + fr, fq * 8), boff = lds_byte(wc * 32 + fr, fq * 8);
#define PG8_SA(b, h) (((b) * 2 + (h)) * HTB)
#define PG8_SB(b, h) ((4 + (b) * 2 + (h)) * HTB)
#define PG8_STAGE(bufoff, gbase, voff) do { _Pragma("unroll") for (int _i = 0; _i < 2; ++_i) \
        __builtin_amdgcn_global_load_lds((const unsigned*)((const char*)(gbase) + (voff)[_i]), (PG8_LAS unsigned*)(lds + (bufoff) + ldsw + _i * 8192), 16, 0, 0); } while (0)
#define PG8_LDA(dst, b, h) do { _Pragma("unroll") for (int m = 0; m < 4; ++m) _Pragma("unroll") for (int k = 0; k < 2; ++k) dst[m][k] = *(const PG8_LAS bf16x8*)(lds + PG8_SA(b, h) + aoff + m * 2048 + k * 1024); } while (0)
#define PG8_LDB(dst, b, h) do { _Pragma("unroll") for (int n = 0; n < 2; ++n) _Pragma("unroll") for (int k = 0; k < 2; ++k) dst[n][k] = *(const PG8_LAS bf16x8*)(lds + PG8_SB(b, h) + boff + n * 2048 + k * 1024); } while (0)
#define PG8_MMA(ai, bj, At, Bt) do { __builtin_amdgcn_s_setprio(1); _Pragma("unroll") for (int m = 0; m < 4; ++m) _Pragma("unroll") for (int n = 0; n < 2; ++n) _Pragma("unroll") for (int k = 0; k < 2; ++k) \
        acc[ai][bj][m][n] = __builtin_amdgcn_mfma_f32_16x16x32_bf16(Bt[n][k], At[m][k], acc[ai][bj][m][n], 0, 0, 0); __builtin_amdgcn_s_setprio(0); } while (0)
#define PG8_WAIT_V(n) asm volatile("s_waitcnt vmcnt(" #n ")" ::: "memory")
#define PG8_WAIT_L(n) asm volatile("s_waitcnt lgkmcnt(" #n ")" ::: "memory")
#define PG8_BAR __builtin_amdgcn_s_barrier()
#define PG8_SCHED __builtin_amdgcn_sched_barrier(0)
    Unit cur, nxt; int ui = 0;
    if (!S.next(0, cur)) return;
    f32x4 acc[2][2][4][2];
#pragma unroll
    for (int a = 0; a < 2; ++a)
#pragma unroll
        for (int b = 0; b < 2; ++b)
#pragma unroll
            for (int m = 0; m < 4; ++m)
#pragma unroll
                for (int n = 0; n < 2; ++n) acc[a][b][m][n] = (f32x4){0.f, 0.f, 0.f, 0.f};
    bf16x8 At[4][2], B0[2][2], B1[2][2];
    const char* cA = (const char*)g.A + (size_t)cur.pm * tstep; const char* cB = (const char*)g.Bt + (size_t)cur.pn * tstep;
    S.a_ready(cur);
    if constexpr (SP2) {
        PG8_STAGE(PG8_SB(0, 0), cB, voffB); PG8_STAGE(PG8_SB(0, 1), cB + hstep, voffB); PG8_STAGE(PG8_SA(0, 0), cA, voffA); PG8_STAGE(PG8_SA(0, 1), cA + hstep, voffA);
        if (wr == 1) PG8_BAR;
        PG8_WAIT_V(2); PG8_BAR;
        PG8_STAGE(PG8_SB(1, 0), cB + kstep, voffB); PG8_STAGE(PG8_SA(1, 0), cA + kstep, voffA); PG8_STAGE(PG8_SB(1, 1), cB + hstep + kstep, voffB);
        PG8_WAIT_V(6); PG8_BAR;
    } else {
        PG8_STAGE(PG8_SB(0, 0), cB, voffB); PG8_STAGE(PG8_SA(0, 0), cA, voffA); PG8_STAGE(PG8_SB(0, 1), cB + hstep, voffB); PG8_STAGE(PG8_SA(0, 1), cA + hstep, voffA);
        if (wr == 1) PG8_BAR;
        PG8_WAIT_V(4); PG8_BAR;
        PG8_STAGE(PG8_SB(1, 0), cB + kstep, voffB); PG8_STAGE(PG8_SA(1, 0), cA + kstep, voffA); PG8_STAGE(PG8_SB(1, 1), cB + hstep + kstep, voffB);
        PG8_WAIT_V(6); PG8_BAR;
    }
    for (;;) {
        const bool has_next = S.next(ui + 1, nxt);
        const char* nA = has_next ? (const char*)g.A + (size_t)nxt.pm * tstep : cA; const char* nB = has_next ? (const char*)g.Bt + (size_t)nxt.pn * tstep : cB;
        for (int t = 0; t < nt; t += 2) {
            const bool last = (t == nt - 2);
            const char* a1 = cA + (size_t)(t + 1) * kstep;
            const char* a2 = last ? nA : cA + (size_t)(t + 2) * kstep; const char* b2 = last ? nB : cB + (size_t)(t + 2) * kstep;
            const char* a3 = a2 + kstep; const char* b3 = b2 + kstep;
            if (last && has_next) S.a_ready(nxt);
            if constexpr (SP2) {
            PG8_LDB(B0, 0, 0); PG8_LDB(B1, 0, 1); PG8_SCHED; PG8_LDA(At, 0, 0); PG8_STAGE(PG8_SA(1, 1), a1 + hstep, voffA);
            PG8_WAIT_V(8); PG8_WAIT_L(0); PG8_BAR; PG8_MMA(0, 0, At, B0); PG8_MMA(0, 1, At, B1); PG8_BAR; PG8_SCHED;
            PG8_LDA(At, 0, 1); PG8_STAGE(PG8_SB(0, 0), b2, voffB); PG8_STAGE(PG8_SB(0, 1), b2 + hstep, voffB); PG8_STAGE(PG8_SA(0, 0), a2, voffA);
            PG8_WAIT_V(8); PG8_WAIT_L(0); PG8_BAR; PG8_MMA(1, 0, At, B0); PG8_MMA(1, 1, At, B1); PG8_BAR; PG8_SCHED;
            PG8_LDB(B0, 1, 0); PG8_LDB(B1, 1, 1); PG8_SCHED; PG8_LDA(At, 1, 0); PG8_STAGE(PG8_SA(0, 1), a2 + hstep, voffA);
            PG8_WAIT_V(8); PG8_WAIT_L(0); PG8_BAR; PG8_MMA(0, 0, At, B0); PG8_MMA(0, 1, At, B1); PG8_BAR; PG8_SCHED;
            PG8_LDA(At, 1, 1); PG8_STAGE(PG8_SB(1, 0), b3, voffB); PG8_STAGE(PG8_SB(1, 1), b3 + hstep, voffB); PG8_STAGE(PG8_SA(1, 0), a3, voffA);
            PG8_WAIT_V(8); PG8_WAIT_L(0); PG8_BAR; PG8_MMA(1, 0, At, B0); PG8_MMA(1, 1, At, B1); PG8_BAR; PG8_SCHED;
            } else {
            PG8_LDB(B0, 0, 0); PG8_SCHED; PG8_LDA(At, 0, 0); PG8_STAGE(PG8_SA(1, 1), a1 + hstep, voffA);
            PG8_WAIT_L(8); PG8_BAR; PG8_WAIT_L(0); PG8_MMA(0, 0, At, B0); PG8_BAR; PG8_SCHED;
            PG8_LDB(B1, 0, 1); PG8_STAGE(PG8_SB(0, 0), b2, voffB);
            PG8_BAR; PG8_WAIT_L(0); PG8_MMA(0, 1, At, B1); PG8_BAR;
            PG8_LDA(At, 0, 1); PG8_STAGE(PG8_SA(0, 0), a2, voffA);
            PG8_BAR; PG8_WAIT_L(0); PG8_MMA(1, 0, At, B0); PG8_BAR; PG8_SCHED;
            PG8_STAGE(PG8_SB(0, 1), b2 + hstep, voffB);
            PG8_WAIT_V(6); PG8_BAR; PG8_MMA(1, 1, At, B1); PG8_BAR;
            PG8_LDB(B0, 1, 0); PG8_SCHED; PG8_LDA(At, 1, 0); PG8_STAGE(PG8_SA(0, 1), a2 + hstep, voffA);
            PG8_WAIT_L(8); PG8_BAR; PG8_WAIT_L(0); PG8_MMA(0, 0, At, B0); PG8_BAR; PG8_SCHED;
            PG8_LDB(B1, 1, 1); PG8_STAGE(PG8_SB(1, 0), b3, voffB);
            PG8_BAR; PG8_WAIT_L(0); PG8_MMA(0, 1, At, B1); PG8_BAR;
            PG8_LDA(At, 1, 1); PG8_STAGE(PG8_SA(1, 0), a3, voffA);
            PG8_BAR; PG8_WAIT_L(0); PG8_MMA(1, 0, At, B0); PG8_BAR; PG8_SCHED;
            PG8_STAGE(PG8_SB(1, 1), b3 + hstep, voffB);
            PG8_WAIT_V(6); PG8_BAR; PG8_MMA(1, 1, At, B1); PG8_BAR;
            }
        }
        if constexpr (ALIGN_EPI) { if (wr == 0) PG8_BAR; }
        if constexpr (!Epi::AFTER_DRAIN) { E(acc, cur, wr, wc, fr, fq); S.done(cur); }
        if (!has_next) break;
#pragma unroll
        for (int a = 0; a < 2; ++a)
#pragma unroll
            for (int b = 0; b < 2; ++b)
#pragma unroll
                for (int m = 0; m < 4; ++m)
#pragma unroll
                    for (int n = 0; n < 2; ++n) acc[a][b][m][n] = (f32x4){0.f, 0.f, 0.f, 0.f};
        cur = nxt; cA = nA; cB = nB; ++ui;
        if constexpr (ALIGN_EPI) { if (wr == 1) PG8_BAR; }
    }
    PG8_WAIT_V(0);
    if constexpr (!ALIGN_EPI) { if (wr == 0) PG8_BAR; }
    PG8_BAR;
    if constexpr (Epi::AFTER_DRAIN) { E.fused(acc, cur, wr, wc, fr, fq, lds, wid, lane); S.done(cur); }
#undef PG8_SA
#undef PG8_SB
#undef PG8_STAGE
#undef PG8_LDA
#undef PG8_LDB
#undef PG8_MMA
#undef PG8_WAIT_V
#undef PG8_WAIT_L
#undef PG8_BAR
#undef PG8_SCHED
}
}
#define GAS __attribute__((address_space(1)))
#define LAS __attribute__((address_space(3)))
typedef unsigned short bf16;
typedef unsigned v4u __attribute__((ext_vector_type(4)));
typedef unsigned v2u __attribute__((ext_vector_type(2)));
typedef float f32x4 __attribute__((ext_vector_type(4)));
typedef short bf16x8 __attribute__((ext_vector_type(8)));
#define LDS_WAIT() asm volatile("s_waitcnt lgkmcnt(0)" ::: "memory")
#define VM_WAIT() asm volatile("s_waitcnt vmcnt(0)" ::: "memory")

constexpr int DM = 2048, NB = 4, SEQ = 2048, NMETA = 16, MROWS = NB * SEQ, DPROJ = 6152, NPROJ = 6144;
constexpr int PADT = 2112, POS0 = 64, MPOS0 = 48;
constexpr float EPS = 1e-6f;
constexpr float LOG2E = 1.4426950408889634f;
constexpr float QSCALE = 0.08838834764831845f * LOG2E;
constexpr int NWAVES = 8, NTHR = 512;

constexpr size_t MiB = 1u << 20;
constexpr size_t WS_CTL = 0, CTL_ZERO_BYTES = 32 * 1024;
constexpr size_t WS_PM = 484 * MiB;
constexpr size_t WS_W1T = 2 * MiB, WS_W2T = 26 * MiB, WS_W3T = 34 * MiB, WS_XN = 42 * MiB;
constexpr size_t WS_Q = 74 * MiB, WS_KP = 90 * MiB, WS_VP = 107 * MiB, WS_MQ = 124 * MiB, WS_MK = 133 * MiB, WS_MV = 142 * MiB, WS_MO = 159 * MiB;
constexpr size_t WS_SMALL = 175 * MiB;
constexpr size_t WS_XM = WS_SMALL, WS_LI = WS_SMALL + 128 * 1024, WS_LF = WS_SMALL + 384 * 1024, WS_LAM = WS_SMALL + 640 * 1024;
constexpr size_t WS_PO = 176 * MiB, WS_ML = 304 * MiB, WS_HM = 305 * MiB, WS_A2 = 42 * MiB, WS_H1B = 74 * MiB, WS_SSQ = 106 * MiB, WS_S = 176 * MiB, WS_UB = 384 * MiB, WS_VB = 448 * MiB;
constexpr size_t WS_SCL = WS_SMALL + 704 * 1024;
constexpr size_t WS_VB8 = WS_UB + 32 * MiB;
constexpr size_t WS_DC = 305 * MiB, WS_CS = 448 * MiB, WS_DN = 482 * MiB, WS_NS = WS_DN + 512 * 1024, WS_GS = WS_DN + 1024 * 1024, WS_MS = WS_DN + 1152 * 1024;
constexpr size_t WS_EID = 240 * MiB, WS_EGT = 244 * MiB;
constexpr int CW_BAR = 4096;

constexpr int RING_OFF = 0, RING_BYTES = 131072;
constexpr int XCH_OFF = 131072;
constexpr int MISC_OFF = XCH_OFF + 8192;
constexpr int LDS_BYTES = 155648;

__device__ __forceinline__ unsigned f2bf(float f) { unsigned u = __builtin_bit_cast(unsigned, f); return (u + 0x7fffu + ((u >> 16) & 1u)) >> 16; }
__device__ __forceinline__ unsigned pk2(float lo, float hi) { return f2bf(lo) | (f2bf(hi) << 16); }
__device__ __forceinline__ float bf2f(unsigned short u) { return __builtin_bit_cast(float, (unsigned)u << 16); }
__device__ __forceinline__ float bflo(unsigned w) { return __builtin_bit_cast(float, w << 16); }
__device__ __forceinline__ float bfhi(unsigned w) { return __builtin_bit_cast(float, w & 0xffff0000u); }
__device__ __forceinline__ float wave_sum(float v) {
#pragma unroll
  for (int o = 1; o < 64; o <<= 1) v += __shfl_xor(v, o);
  return v;
}
__device__ __forceinline__ size_t kp_off(int bhm, int pos, int d) { const int j = pos >> 6, row = pos & 63, d0 = d >> 4, hi = (d >> 3) & 1;
  return ((size_t)(bhm * 33 + j) * 8 + d0) * 1024 + (size_t)((((row << 1) | hi) ^ ((row >> 3) & 1)) << 3) + (d & 7); }
__device__ __forceinline__ float wave_sum_dpp(float v) {
  v += __builtin_bit_cast(float, __builtin_amdgcn_update_dpp(0, __builtin_bit_cast(int, v), 0xB1, 0xF, 0xF, true));
  v += __builtin_bit_cast(float, __builtin_amdgcn_update_dpp(0, __builtin_bit_cast(int, v), 0x4E, 0xF, 0xF, true));
  v += __builtin_bit_cast(float, __builtin_amdgcn_update_dpp(0, __builtin_bit_cast(int, v), 0x141, 0xF, 0xF, true));
  v += __builtin_bit_cast(float, __builtin_amdgcn_update_dpp(0, __builtin_bit_cast(int, v), 0x140, 0xF, 0xF, true));
  const float r0 = __builtin_bit_cast(float, __builtin_amdgcn_readlane(__builtin_bit_cast(int, v), 0)), r1 = __builtin_bit_cast(float, __builtin_amdgcn_readlane(__builtin_bit_cast(int, v), 16));
  const float r2 = __builtin_bit_cast(float, __builtin_amdgcn_readlane(__builtin_bit_cast(int, v), 32)), r3 = __builtin_bit_cast(float, __builtin_amdgcn_readlane(__builtin_bit_cast(int, v), 48));
  return (r0 + r1) + (r2 + r3);
}
__device__ __forceinline__ float sigmoidf_(float x) { return 1.0f / (1.0f + __expf(-x)); }

#ifdef TPROBE
#ifndef TP_BLOCK
#define TP_BLOCK 0
#endif
#ifndef TP_DIV
#define TP_DIV 1.0f
#endif
#define TP_BEGIN(id) unsigned long long tp_t0_##id = 0; do { if (TPROBE == (id)) tp_t0_##id = __builtin_amdgcn_s_memrealtime(); } while (0)
#define TP_END(id, WS) do { if (TPROBE == (id)) { const unsigned long long t1_ = __builtin_amdgcn_s_memrealtime(); if ((int)blockIdx.x == TP_BLOCK && threadIdx.x == 0) atomicAdd((unsigned*)((WS) + 64), (unsigned)(t1_ - tp_t0_##id)); } } while (0)
#else
#define TP_BEGIN(id)
#define TP_END(id, WS)
#endif
#define XB_TMO      128
#define XB_XCNT(j)  (256  + 64 * (j))
#define XB_XSUB(j)  (1280 + 64 * (j))
#define XB_XGEN(j)  (2304 + 64 * (j))
#define XB_TOP      3328
#define XB_TOPGEN   3392
#define XCD_BAR_WORDS 3456
#define XB_SPIN_CAP (1u << 18)

__device__ __forceinline__ unsigned xb_ld(unsigned* p)              { return __hip_atomic_load(p, __ATOMIC_RELAXED, __HIP_MEMORY_SCOPE_AGENT); }
__device__ __forceinline__ unsigned xb_add(unsigned* p, unsigned v) { return __hip_atomic_fetch_add(p, v, __ATOMIC_RELAXED, __HIP_MEMORY_SCOPE_AGENT); }
__device__ __forceinline__ unsigned xb_xcc_id() { return (unsigned)__builtin_amdgcn_s_getreg((3 << 11) | 20) & 0xFu; }
#define XB_SPIN(cond, bar) do { unsigned _sp = 0; while (cond) { __builtin_amdgcn_s_sleep(1); \
    if ((++_sp & 255u) == 0u) { if (xb_ld(&(bar)[XB_TMO])) break; if (_sp > XB_SPIN_CAP) { atomicAdd(&(bar)[XB_TMO], 1u); break; } } } } while (0)

struct XcdBarrier {
    unsigned* bar; unsigned x;
    volatile LAS unsigned* st;
};

__device__ __forceinline__ XcdBarrier xcd_barrier_post(unsigned* bar, volatile LAS unsigned* st) {
    XcdBarrier b; b.bar = bar; b.x = xb_xcc_id(); b.st = st;
    if (threadIdx.x == 0) (void)xb_add(&bar[XB_XCNT(b.x)], 1u);
    return b;
}
__device__ __forceinline__ void xcd_barrier_complete(unsigned* bar, unsigned x, unsigned& nloc, unsigned& nx) {
    const unsigned G = gridDim.x * gridDim.y * gridDim.z;
    unsigned sum, cnt, mine, sp = 0u;
    for (;;) {
        sum = 0u; cnt = 0u; mine = 0u;
#pragma unroll
        for (unsigned j = 0; j < 16; ++j) { const unsigned c = xb_ld(&bar[XB_XCNT(j)]); sum += c; cnt += (c > 0u) ? 1u : 0u; mine = (j == x) ? c : mine; }
        if (sum == G) break;
        __builtin_amdgcn_s_sleep(1);
        if ((++sp & 255u) == 0u) { if (xb_ld(&bar[XB_TMO])) break; if (sp > XB_SPIN_CAP) { atomicAdd(&bar[XB_TMO], 1u); break; } }
    }
    nloc = mine > 0u ? mine : 1u; nx = cnt > 0u ? cnt : 1u;
}

__device__ __forceinline__ void xcd_barrier(const XcdBarrier& b) {
    asm volatile("s_waitcnt vmcnt(0)" ::: "memory");
    __syncthreads();
    if (threadIdx.x == 0) {
        unsigned* bar = b.bar;
        __builtin_amdgcn_s_waitcnt(0);
        unsigned nloc = b.st[0], nx = b.st[1];
        if (nloc == 0u) { xcd_barrier_complete(bar, b.x, nloc, nx); b.st[0] = nloc; b.st[1] = nx; }
        const unsigned old = xb_add(&bar[XB_XSUB(b.x)], 1u);
        const unsigned gen = old / nloc;
        if (old + 1u == (gen + 1u) * nloc) {
            __builtin_amdgcn_fence(__ATOMIC_RELEASE, "agent");
            asm volatile("s_waitcnt vmcnt(0)" ::: "memory");
            const unsigned og = xb_add(&bar[XB_TOP], 1u);
            const unsigned tg = og / nx;
            if (og + 1u == (tg + 1u) * nx) xb_add(&bar[XB_TOPGEN], 1u);
            else XB_SPIN(xb_ld(&bar[XB_TOPGEN]) == tg, bar);
            __builtin_amdgcn_fence(__ATOMIC_ACQUIRE, "agent");
            xb_add(&bar[XB_XGEN(b.x)], 1u);
            asm volatile("s_waitcnt vmcnt(0)" ::: "memory");
        } else {
            XB_SPIN(xb_ld(&bar[XB_XGEN(b.x)]) == gen, bar);
            __builtin_amdgcn_fence(__ATOMIC_ACQUIRE, "agent");
            asm volatile("s_waitcnt vmcnt(0)" ::: "memory");
        }
    }
    __syncthreads();
}

struct Args { const float* in[22]; float* out; unsigned char* ws; int ph_lo, ph_hi, na, pad; };
struct Frame {
  LAS unsigned char* lds; unsigned char* ws; int tid, lane, wave; const float* const* in;
};
#define IN_X 0
#define IN_META 1
#define IN_G1 2
#define IN_WIN 3
#define IN_CW 4
#define IN_CB 5
#define IN_IGB 6
#define IN_FGB 7
#define IN_LQ1 8
#define IN_LK1 9
#define IN_LQ2 10
#define IN_LK2 11
#define IN_QNG 12
#define IN_KNG 13
#define IN_SUBG 14
#define IN_OUTG 15
#define IN_WOUT 16
#define IN_G2 17
#define IN_WQ 18
#define IN_SUBK 19
#define IN_U 20
#define IN_V 21

__device__ __forceinline__ void p0_rows(const Frame& F, const Args& a) {
  const float* x = a.in[IN_X]; const float* meta = a.in[IN_META]; const float* g1 = a.in[IN_G1]; const float* w_in = a.in[IN_WIN];
  const float* igb = a.in[IN_IGB]; const float* fgb = a.in[IN_FGB];
  bf16* Xn = (bf16*)(F.ws + WS_XN); bf16* Xm = (bf16*)(F.ws + WS_XM); float* LI = (float*)(F.ws + WS_LI); float* LF = (float*)(F.ws + WS_LF);
  LAS f32x4* wgl = (LAS f32x4*)(F.lds);
  for (int e = F.tid; e < 4096; e += NTHR) {
    const int ln = e & 63, q = e >> 6, half = q & 1, j = (q >> 1) & 3, i = q >> 3;
    const int k = 4 * (i * 64 + ln) + j;
    wgl[e] = *(const f32x4*)(w_in + (size_t)k * DPROJ + NPROJ + 4 * half);
  }
  __syncthreads();
  const int gw = blockIdx.x * NWAVES + F.wave, NGW = gridDim.x * NWAVES, lane = F.lane;
  constexpr int NTASK = MROWS / 2 + NMETA / 2;
  f32x4 xnx[2][8];
  if (gw < NTASK) { const float* sn = (gw >= MROWS / 2 ? meta + (size_t)(gw - MROWS / 2) * 2 * DM : x + (size_t)gw * 2 * DM);
#pragma unroll
    for (int i = 0; i < 8; ++i) { xnx[0][i] = ((const f32x4*)sn)[i * 64 + lane]; xnx[1][i] = ((const f32x4*)(sn + DM))[i * 64 + lane]; } }
  for (int task = gw; task < NTASK; task += NGW) {
    const bool ismeta = task >= MROWS / 2;
    const int r0 = ismeta ? (task - MROWS / 2) * 2 : task * 2;
    f32x4 xv[2][8]; float rs[2];
    { float s0 = 0.f, s1 = 0.f;
#pragma unroll
      for (int i = 0; i < 8; ++i) { xv[0][i] = xnx[0][i]; xv[1][i] = xnx[1][i]; }
      { const int tn = task + NGW; if (tn < NTASK) { const float* sn = (tn >= MROWS / 2 ? meta + (size_t)(tn - MROWS / 2) * 2 * DM : x + (size_t)tn * 2 * DM);
#pragma unroll
          for (int i = 0; i < 8; ++i) { xnx[0][i] = ((const f32x4*)sn)[i * 64 + lane]; xnx[1][i] = ((const f32x4*)(sn + DM))[i * 64 + lane]; } } }
#pragma unroll
      for (int i = 0; i < 8; ++i) { const f32x4 a0 = xv[0][i], a1 = xv[1][i];
        s0 += (a0.x * a0.x + a0.y * a0.y) + (a0.z * a0.z + a0.w * a0.w); s1 += (a1.x * a1.x + a1.y * a1.y) + (a1.z * a1.z + a1.w * a1.w); }
      rs[0] = rsqrtf(wave_sum_dpp(s0) * (1.0f / DM) + EPS); rs[1] = rsqrtf(wave_sum_dpp(s1) * (1.0f / DM) + EPS); }
    float ga[2][8];
#pragma unroll
    for (int rr = 0; rr < 2; ++rr)
#pragma unroll
      for (int g = 0; g < 8; ++g) ga[rr][g] = 0.f;
    bf16* dst0 = (ismeta ? Xm : Xn) + (size_t)r0 * DM;
#pragma unroll
    for (int i = 0; i < 8; ++i) {
      const f32x4 g = ((const f32x4*)g1)[i * 64 + lane];
      f32x4 xn[2];
#pragma unroll
      for (int rr = 0; rr < 2; ++rr) { xn[rr] = xv[rr][i] * g * rs[rr];
        v2u o; o.x = pk2(xn[rr].x, xn[rr].y); o.y = pk2(xn[rr].z, xn[rr].w); ((v2u*)(dst0 + (size_t)rr * DM))[i * 64 + lane] = o; }
#pragma unroll
      for (int j = 0; j < 4; ++j) {
        const f32x4 w0 = wgl[((i * 4 + j) * 2 + 0) * 64 + lane], w1 = wgl[((i * 4 + j) * 2 + 1) * 64 + lane];
#pragma unroll
        for (int rr = 0; rr < 2; ++rr) { const float xs_ = xn[rr][j];
          ga[rr][0] += xs_ * w0.x; ga[rr][1] += xs_ * w0.y; ga[rr][2] += xs_ * w0.z; ga[rr][3] += xs_ * w0.w;
          ga[rr][4] += xs_ * w1.x; ga[rr][5] += xs_ * w1.y; ga[rr][6] += xs_ * w1.z; ga[rr][7] += xs_ * w1.w; }
      }
      __builtin_amdgcn_sched_barrier(0);
    }
#pragma unroll
    for (int rr = 0; rr < 2; ++rr)
#pragma unroll
      for (int g = 0; g < 8; ++g) ga[rr][g] = wave_sum_dpp(ga[rr][g]);
    if (lane < 8) {
      const int rr = lane >> 2, h = lane & 3;
      float gi = 0.f, gf = 0.f;
#pragma unroll
      for (int q = 0; q < 2; ++q)
#pragma unroll
        for (int hh = 0; hh < 4; ++hh) if (q == rr && hh == h) { gi = ga[q][hh]; gf = ga[q][4 + hh]; }
      const float li = gi + igb[h]; const float fx = gf + fgb[h];
      const float lf = fminf(fx, 0.f) - log1pf(__expf(-fabsf(fx)));
      const int R = r0 + rr;
      if (!ismeta) { const int b = R >> 11, t = R & 2047; LI[(b * 4 + h) * PADT + POS0 + t] = li; LF[(b * 4 + h) * PADT + POS0 + t] = lf; }
      else { for (int b = 0; b < NB; ++b) { LI[(b * 4 + h) * PADT + MPOS0 + R] = li; LF[(b * 4 + h) * PADT + MPOS0 + R] = lf; } }
    }
  }
  __syncthreads();
}
template <bool META>
__device__ __forceinline__ void p0_transpose(const Frame& F, const Args& a, const float* W, int ldw, int N, bf16* Wt) {
  LAS float* tl = (LAS float*)(F.lds);
  LAS float* red = (LAS float*)(F.lds + 33792);
  float* PM = (float*)(F.ws + WS_PM);
  const float* meta = a.in[IN_META]; const float* g1 = a.in[IN_G1];
  const int ntn = N / 64, ntask = ntn * 16, fr = F.lane & 15, fq = F.lane >> 4, w = F.wave;
  f32x4 wn[4];
  float am[4], ag[4];
  if ((int)blockIdx.x < ntask) { const int nb = blockIdx.x % ntn, kb = blockIdx.x / ntn;
#pragma unroll
    for (int i = 0; i < 4; ++i) { const int idx = F.tid + NTHR * i, kk = idx >> 4, c4 = idx & 15; wn[i] = *(const f32x4*)(W + (size_t)(kb * 128 + kk) * ldw + nb * 64 + 4 * c4); }
    if (META) {
#pragma unroll
      for (int s_ = 0; s_ < 4; ++s_) { const int k = kb * 128 + 16 * w + 4 * s_ + fq; am[s_] = meta[(size_t)fr * DM + k]; ag[s_] = g1[k]; } } }
  for (int task = blockIdx.x; task < ntask; task += gridDim.x) {
    const int nb = task % ntn, kb = task / ntn, n0 = nb * 64, k0 = kb * 128;
    __syncthreads();
#pragma unroll
    for (int i = 0; i < 4; ++i) { const int idx = F.tid + NTHR * i, kk = idx >> 4, c4 = idx & 15; const f32x4 wv = wn[i];
      LAS float* d = tl + kk * 65 + 4 * c4; d[0] = wv.x; d[1] = wv.y; d[2] = wv.z; d[3] = wv.w; }
    float ac[4];
    if (META) {
#pragma unroll
      for (int s_ = 0; s_ < 4; ++s_) ac[s_] = am[s_] * ag[s_]; }
    { const int tn = task + gridDim.x; if (tn < ntask) { const int nb2 = tn % ntn, kb2 = tn / ntn;
#pragma unroll
        for (int i = 0; i < 4; ++i) { const int idx = F.tid + NTHR * i, kk = idx >> 4, c4 = idx & 15; wn[i] = *(const f32x4*)(W + (size_t)(kb2 * 128 + kk) * ldw + nb2 * 64 + 4 * c4); }
        if (META) {
#pragma unroll
          for (int s_ = 0; s_ < 4; ++s_) { const int k = kb2 * 128 + 16 * w + 4 * s_ + fq; am[s_] = meta[(size_t)fr * DM + k]; ag[s_] = g1[k]; } } } }
    __syncthreads();
    const int n = F.tid >> 3, kc = F.tid & 7;
    const LAS float* s = tl + (kc * 16) * 65 + n;
    v4u o0, o1;
    o0.x = pk2(s[0 * 65], s[1 * 65]); o0.y = pk2(s[2 * 65], s[3 * 65]); o0.z = pk2(s[4 * 65], s[5 * 65]); o0.w = pk2(s[6 * 65], s[7 * 65]);
    o1.x = pk2(s[8 * 65], s[9 * 65]); o1.y = pk2(s[10 * 65], s[11 * 65]); o1.z = pk2(s[12 * 65], s[13 * 65]); o1.w = pk2(s[14 * 65], s[15 * 65]);
    v4u* dp = (v4u*)(Wt + (size_t)(n0 + n) * DM + k0 + kc * 16);
    dp[0] = o0; dp[1] = o1;
    if (META && n0 >= 1024) {
      f32x4 acc[4];
#pragma unroll
      for (int nt = 0; nt < 4; ++nt) acc[nt] = (f32x4){0.f, 0.f, 0.f, 0.f};
#pragma unroll
      for (int s_ = 0; s_ < 4; ++s_)
#pragma unroll
        for (int nt = 0; nt < 4; ++nt) acc[nt] = __builtin_amdgcn_mfma_f32_16x16x4f32(ac[s_], tl[(16 * w + 4 * s_ + fq) * 65 + nt * 16 + fr], acc[nt], 0, 0, 0);
#pragma unroll
      for (int nt = 0; nt < 4; ++nt)
#pragma unroll
        for (int i = 0; i < 4; ++i) red[(w * 16 + 4 * fq + i) * 64 + nt * 16 + fr] = acc[nt][i];
      __syncthreads();
#pragma unroll
      for (int j = 0; j < 2; ++j) { const int idx = F.tid + NTHR * j, m = idx >> 6, nn = idx & 63; const LAS float* r = red + m * 64 + nn;
        PM[((size_t)kb * 16 + m) * NPROJ + n0 + nn] = ((r[0] + r[1024]) + (r[2048] + r[3072])) + ((r[4096] + r[5120]) + (r[6144] + r[7168])); }
    }
  }
  __syncthreads();
}
__device__ __forceinline__ void p0_zero_vpad(const Frame& F) {
  bf16* Vp = (bf16*)(F.ws + WS_VP);
  const int per = MPOS0 * 256 / 8;
  for (int i = blockIdx.x * NTHR + F.tid; i < 16 * per; i += gridDim.x * NTHR) { const int bh = i / per, e = i % per;
    *(v4u*)(Vp + (size_t)bh * PADT * 256 + (size_t)e * 8) = (v4u){0u, 0u, 0u, 0u}; }
}
__device__ __forceinline__ void p0_lam(const Frame& F, const Args& a) {
  if (blockIdx.x == 0 && F.wave == 0) {
    const int l = F.lane;
    float s1 = a.in[IN_LQ1][l] * a.in[IN_LK1][l] + a.in[IN_LQ1][l + 64] * a.in[IN_LK1][l + 64];
    float s2 = a.in[IN_LQ2][l] * a.in[IN_LK2][l] + a.in[IN_LQ2][l + 64] * a.in[IN_LK2][l + 64];
    s1 = wave_sum(s1); s2 = wave_sum(s2);
    if (l == 0) *(float*)(F.ws + WS_LAM) = __expf(s1) - __expf(s2) + 0.2f;
  }
}

struct EpiProj {
  static constexpr bool PERM = true, AFTER_DRAIN = false;
  bf16 *Qb, *Kp, *Vp, *MQ, *MK, *MV, *MO; const float *qg, *kg; LAS float* xch;
  __device__ __forceinline__ void operator()(const pg8::f32x4 (&acc)[2][2][4][2], const pg8::Unit& u, int wr, int wc, int fr, int fq) const {
    const int pn = u.pn, b = u.pm >> 3, tb = (u.pm & 7) * 256 + wr * 64 + fr, d0 = wc * 32 + fq * 8;
    if (pn < 8) {
      const bool isk = pn >= 4; const int h = pn & 3;
      float ssq[2][4][2];
#pragma unroll
      for (int ai = 0; ai < 2; ++ai)
#pragma unroll
        for (int m = 0; m < 4; ++m)
#pragma unroll
          for (int bj = 0; bj < 2; ++bj) { float s = 0.f;
#pragma unroll
            for (int n = 0; n < 2; ++n) { const pg8::f32x4 x = acc[ai][bj][m][n]; s += (x[0] * x[0] + x[1] * x[1]) + (x[2] * x[2] + x[3] * x[3]); }
            s += __shfl_xor(s, 16); s += __shfl_xor(s, 32); ssq[ai][m][bj] = s;
            if (fq == 0) xch[((ai * 128 + wr * 64 + m * 16 + fr) * 2 + bj) * 4 + wc] = s; }
      asm volatile("s_waitcnt lgkmcnt(0)" ::: "memory"); __builtin_amdgcn_s_barrier(); asm volatile("" ::: "memory");
      const float* gp = (isk ? kg : qg) + d0; const f32x4 g0 = *(const f32x4*)gp, g1v = *(const f32x4*)(gp + 4);
      const float sc = isk ? 1.0f : QSCALE;
#pragma unroll
      for (int ai = 0; ai < 2; ++ai)
#pragma unroll
        for (int m = 0; m < 4; ++m)
#pragma unroll
          for (int bj = 0; bj < 2; ++bj) {
            const f32x4 p = *(const LAS f32x4*)(xch + ((ai * 128 + wr * 64 + m * 16 + fr) * 2 + bj) * 4);
            const float rs = rsqrtf(((p.x + p.y) + (p.z + p.w)) * (1.0f / 128.f) + EPS) * sc;
            const pg8::f32x4 v0 = acc[ai][bj][m][0], v1 = acc[ai][bj][m][1];
            v4u w; w.x = pk2(v0[0] * rs * g0.x, v0[1] * rs * g0.y); w.y = pk2(v0[2] * rs * g0.z, v0[3] * rs * g0.w);
            w.z = pk2(v1[0] * rs * g1v.x, v1[1] * rs * g1v.y); w.w = pk2(v1[2] * rs * g1v.z, v1[3] * rs * g1v.w);
            const int t = tb + ai * 128 + m * 16;
            bf16* dst = isk ? Kp + kp_off((b * 4 + h) * 2 + bj, POS0 + t, d0)
                            : Qb + ((size_t)((b * 4 + h) * 2 + bj) * SEQ + t) * 128 + d0;
            *(v4u*)dst = w; }
      return;
    }
#pragma unroll
    for (int ai = 0; ai < 2; ++ai)
#pragma unroll
      for (int m = 0; m < 4; ++m)
#pragma unroll
        for (int bj = 0; bj < 2; ++bj) {
          pg8::f32x4 v0 = acc[ai][bj][m][0], v1 = acc[ai][bj][m][1];
          const int t = tb + ai * 128 + m * 16;
          bf16* dst;
          if (pn < 12) { const int h = pn - 8; dst = Vp + ((size_t)(b * 4 + h) * PADT + POS0 + t) * 256 + bj * 128 + d0; }
          else if (pn < 16) { const int h = 2 * (pn & 1) + bj; dst = (pn >= 14 ? MK : MQ) + ((size_t)(b * 4 + h) * PADT + POS0 + t) * 128 + d0; }
          else if (pn < 20) { const int h = pn - 16; dst = MV + ((size_t)(b * 4 + h) * PADT + POS0 + t) * 256 + bj * 128 + d0; }
          else dst = MO + (size_t)(b * SEQ + t) * 1024 + (pn - 20) * 256 + bj * 128 + d0;
          v4u w; w.x = pk2(v0[0], v0[1]); w.y = pk2(v0[2], v0[3]); w.z = pk2(v1[0], v1[1]); w.w = pk2(v1[2], v1[3]);
          *(v4u*)dst = w; }
  }
};
__device__ __forceinline__ void p1_meta_finalize(const Frame& F, const Args& a) {
  const bool spread = gridDim.x >= 2 * NMETA;
  if (spread ? ((blockIdx.x & 1) != 0 || blockIdx.x >= 2 * NMETA) : (blockIdx.x >= NMETA)) return;
  const int mrow = spread ? (int)(blockIdx.x >> 1) : (int)blockIdx.x, tid = F.tid, lane = F.lane, w = F.wave;
  const float* meta = a.in[IN_META] + (size_t)mrow * DM; const float* PM0 = (const float*)(F.ws + WS_PM) + (size_t)mrow * NPROJ;
#define PM_P4(i, p) ((PM0[(size_t)(16 * (p)) * NPROJ + (i)] + PM0[(size_t)(16 * ((p) + 1)) * NPROJ + (i)]) + (PM0[(size_t)(16 * ((p) + 2)) * NPROJ + (i)] + PM0[(size_t)(16 * ((p) + 3)) * NPROJ + (i)]))
#define PM_AT(i) ((PM_P4(i, 0) + PM_P4(i, 4)) + (PM_P4(i, 8) + PM_P4(i, 12)))
  LAS float* red = (LAS float*)(F.lds + XCH_OFF);
  const f32x4 mv = ((const f32x4*)meta)[tid];
  float s = wave_sum((mv.x * mv.x + mv.y * mv.y) + (mv.z * mv.z + mv.w * mv.w));
  if (lane == 0) red[w] = s;
  __syncthreads();
  float tot = 0.f;
#pragma unroll
  for (int i = 0; i < 8; ++i) tot += red[i];
  const float rs = rsqrtf(tot * (1.0f / DM) + EPS);
  bf16* Kp = (bf16*)(F.ws + WS_KP); bf16* Vp = (bf16*)(F.ws + WS_VP); bf16* MQ = (bf16*)(F.ws + WS_MQ); bf16* MK = (bf16*)(F.ws + WS_MK); bf16* MV = (bf16*)(F.ws + WS_MV);
  const int pos = MPOS0 + mrow;
  const int c = tid * 2;
  const float kv0 = PM_AT(1024 + w * 128 + lane), kv1 = PM_AT(1024 + w * 128 + lane + 64);
  const float a0 = PM_AT(2048 + c), a1 = PM_AT(2048 + c + 1), b0 = PM_AT(3072 + c), b1 = PM_AT(3072 + c + 1), c0 = PM_AT(4096 + c), c1 = PM_AT(4096 + c + 1);
  {
    const float v0 = kv0 * rs, v1 = kv1 * rs;
    const float rk = rsqrtf(wave_sum(v0 * v0 + v1 * v1) * (1.0f / 128.f) + EPS);
    const float* kg = a.in[IN_KNG];
    const unsigned short o0 = (unsigned short)f2bf(v0 * rk * kg[lane]), o1 = (unsigned short)f2bf(v1 * rk * kg[lane + 64]);
    for (int b = 0; b < NB; ++b) { const int bhm = (b * 4 + (w >> 1)) * 2 + (w & 1); Kp[kp_off(bhm, pos, lane)] = o0; Kp[kp_off(bhm, pos, lane + 64)] = o1; }
  }
  {
    const unsigned o = pk2(a0 * rs, a1 * rs); const int h = c >> 8, e = c & 255;
    for (int b = 0; b < NB; ++b) *(unsigned*)(Vp + ((size_t)(b * 4 + h) * PADT + pos) * 256 + e) = o;
    const unsigned o2 = pk2(b0 * rs, b1 * rs); const bool isk = c >= 512; const int cc = c & 511, hq = cc >> 7, d = cc & 127;
    for (int b = 0; b < NB; ++b) *(unsigned*)((isk ? MK : MQ) + ((size_t)(b * 4 + hq) * PADT + pos) * 128 + d) = o2;
    const unsigned o3 = pk2(c0 * rs, c1 * rs);
    for (int b = 0; b < NB; ++b) *(unsigned*)(MV + ((size_t)(b * 4 + h) * PADT + pos) * 256 + e) = o3;
  }
  __syncthreads();
}
#undef PM_AT
#undef PM_P4

namespace att {
using f32x16 = __attribute__((ext_vector_type(16))) float;
using s16x4 = __attribute__((ext_vector_type(4))) short;
constexpr int STEPS_BHM = 152, NSTEPS = 32 * STEPS_BHM;
constexpr int SHM_V = 64 * 256 * 2, SHM_K = 64 * 128 * 2;
constexpr int LDS_V = 0, LDS_K = 2 * SHM_V, LDS_Q = LDS_K + SHM_K, LDS_WS = LDS_Q + 8 * 8192;
constexpr float THR2 = 8.0f;
#define KSWZ(row, colB) ((row) * 256 + ((colB) ^ (((row) & 7) << 4)))
#define SBAR() __builtin_amdgcn_sched_barrier(0)
__device__ __forceinline__ int crow(int r, int hi) { return (r & 3) + 8 * (r >> 2) + 4 * hi; }
__device__ __forceinline__ unsigned cvtpk(float lo, float hi) { unsigned r; asm volatile("v_cvt_pk_bf16_f32 %0, %1, %2" : "=v"(r) : "v"(lo), "v"(hi)); return r; }
__device__ __forceinline__ int qb_start(int qb) { return 2 * qb * qb + 3 * qb; }
__device__ __forceinline__ int chunk_of(int s, int NA) { return ((s + 1) * NA - 1) / NSTEPS; }

template <int OFF> __device__ __forceinline__ s16x4 tr_read(int vb) {
  s16x4 r; asm volatile("ds_read_b64_tr_b16 %0, %1 offset:%2" : "=&v"(r) : "v"(vb), "i"(OFF) : "memory"); return r;
}
constexpr int v_rd_off(int d0, int ks, int half) { return d0 * 512 + ks * 8192 + half * 4096; }
template <int D0> __device__ __forceinline__ void pv_one(f32x16& od, int vb, bf16x8 pa0, bf16x8 pa1, bf16x8 pa2, bf16x8 pa3) {
#define PK(L, H) (bf16x8){L[0], L[1], L[2], L[3], H[0], H[1], H[2], H[3]}
  { const s16x4 l0 = tr_read<v_rd_off(D0, 0, 0)>(vb), h0 = tr_read<v_rd_off(D0, 0, 1)>(vb), l1 = tr_read<v_rd_off(D0, 1, 0)>(vb), h1 = tr_read<v_rd_off(D0, 1, 1)>(vb);
    asm volatile("s_waitcnt lgkmcnt(0)" ::: "memory"); SBAR();
    od = __builtin_amdgcn_mfma_f32_32x32x16_bf16(pa0, PK(l0, h0), od, 0, 0, 0);
    od = __builtin_amdgcn_mfma_f32_32x32x16_bf16(pa1, PK(l1, h1), od, 0, 0, 0); }
  SBAR();
  { const s16x4 l2 = tr_read<v_rd_off(D0, 2, 0)>(vb), h2 = tr_read<v_rd_off(D0, 2, 1)>(vb), l3 = tr_read<v_rd_off(D0, 3, 0)>(vb), h3 = tr_read<v_rd_off(D0, 3, 1)>(vb);
    asm volatile("s_waitcnt lgkmcnt(0)" ::: "memory"); SBAR();
    od = __builtin_amdgcn_mfma_f32_32x32x16_bf16(pa2, PK(l2, h2), od, 0, 0, 0);
    od = __builtin_amdgcn_mfma_f32_32x32x16_bf16(pa3, PK(l3, h3), od, 0, 0, 0); }
#undef PK
}

__device__ __forceinline__ void segment(const Frame& F, int bhm, int qb, int j0, int j1, int slot) {
  const int tid = F.tid, wid = F.wave, lane = F.lane, r32 = lane & 31, hi = lane >> 5;
  const bf16* Qg = (const bf16*)(F.ws + WS_Q) + ((size_t)bhm * SEQ + qb * 256 + wid * 32 + r32) * 128 + hi * 8;
  const bf16* Kg = (const bf16*)(F.ws + WS_KP) + (size_t)bhm * 33 * 8192;
  const bf16* Vg = (const bf16*)(F.ws + WS_VP) + (size_t)(bhm >> 1) * PADT * 256;
  LAS unsigned char* lds = F.lds;
  LAS float* wsl = (LAS float*)(lds + LDS_WS) + wid * 64;
  const float slope2 = exp2f(-2.0f * (float)(((bhm >> 1) & 3) + 1)) * LOG2E;
  unsigned ksrc0, vsrc0;
  ksrc0 = (unsigned)tid * 16u;
  { const int a8 = tid >> 8, b = (tid >> 2) & 7, k = 8 * (b >> 2) + 4 * a8 + (b & 3), c = ((tid >> 5) & 7) * 32 + (tid & 3) * 8; vsrc0 = (unsigned)(k * 256 + c) * 2u; }
#define STAGE_K(j) do { const char* kt = (const char*)(Kg + (size_t)(j) * 8192); \
    _Pragma("unroll") for (int _i = 0; _i < 2; ++_i) __builtin_amdgcn_global_load_lds((const unsigned*)(kt + (ksrc0 + _i * 8192u)), (LAS unsigned*)(lds + LDS_K + _i * 8192 + wid * 1024), 16, 0, 0); } while (0)
#define STAGE_V(buf, j) do { const char* vt = (const char*)(Vg + (size_t)(j) * 64 * 256); \
    _Pragma("unroll") for (int _i = 0; _i < 4; ++_i) __builtin_amdgcn_global_load_lds((const unsigned*)(vt + (vsrc0 + _i * 8192u)), (LAS unsigned*)(lds + LDS_V + (buf) * SHM_V + _i * 8192 + wid * 1024), 16, 0, 0); } while (0)
  const int lt = (((r32 << 1) | hi) ^ ((r32 >> 3) & 1)) << 4;
  LAS unsigned char* Qs = lds + LDS_Q + wid * 8192;
#pragma unroll
  for (int d0 = 0; d0 < 8; ++d0) { const bf16x8 qv = *(const bf16x8*)(Qg + d0 * 16); *(LAS bf16x8*)(Qs + d0 * 1024 + lt) = qv; }
  f32x16 o[8];
#pragma unroll
  for (int d = 0; d < 8; ++d)
#pragma unroll
    for (int r = 0; r < 16; ++r) o[d][r] = 0.f;
  float m_reg = -1e30f, l_reg = 0.f;
  const int vb0 = (int)(uintptr_t)(lds + LDS_V) + (((lane & 3) << 3) | (((lane >> 2) & 3) << 6) | (((lane >> 4) & 1) << 5) | (((lane >> 5) & 1) << 8));
  STAGE_K(j0); STAGE_V(0, j0);
  VM_WAIT(); __syncthreads();
  for (int j = j0; j < j1; ++j) {
    const int cur = (j - j0) & 1;
    if (j + 1 < j1) STAGE_V(cur ^ 1, j + 1);
    SBAR();
    f32x16 p0 = {}, p1 = {};
    { const LAS unsigned char* Ks = lds + LDS_K;
#pragma unroll
      for (int d0 = 0; d0 < 8; ++d0) {
        const bf16x8 b0 = *(const LAS bf16x8*)(Ks + d0 * 2048 + lt);
        const bf16x8 b1 = *(const LAS bf16x8*)(Ks + d0 * 2048 + 1024 + lt);
        const bf16x8 qf = *(const LAS bf16x8*)(Qs + d0 * 1024 + lt);
        p0 = __builtin_amdgcn_mfma_f32_32x32x16_bf16(b0, qf, p0, 0, 0, 0);
        p1 = __builtin_amdgcn_mfma_f32_32x32x16_bf16(b1, qf, p1, 0, 0, 0); } }
    asm volatile("s_waitcnt lgkmcnt(0)" ::: "memory"); __builtin_amdgcn_s_barrier(); asm volatile("" ::: "memory");
    if (j + 1 < j1) STAGE_K(j + 1);
    SBAR();
    if (j == 0) {
#pragma unroll
      for (int r = 0; r < 16; ++r) p0[r] = -INFINITY;
#pragma unroll
      for (int r = 0; r < 8; ++r) p1[r] = -INFINITY;
    }
    int ln2 = threadIdx.x & 63; asm volatile("" : "+v"(ln2));
    const int hi2 = ln2 >> 5;
    const int jb = j - (4 * qb + 1);
    if (jb >= 0) {
      const int kb = 64 * jb + 4 * hi2, qrel = wid * 32 + (ln2 & 31);
#pragma unroll
      for (int r = 0; r < 16; ++r) { const int kv = kb + (r & 3) + 8 * (r >> 2); if (kv > qrel) p0[r] = -INFINITY; if (kv + 32 > qrel) p1[r] = -INFINITY; }
    }
    const float off0 = slope2 * (float)(64 * j + 4 * hi2), off1 = off0 + 32.0f * slope2;
#pragma unroll
    for (int r = 0; r < 16; ++r) { const float sb = slope2 * (float)((r & 3) + 8 * (r >> 2)); p0[r] += sb; p1[r] += sb; }
    float pm0 = p0[0], pm1 = p1[0];
#pragma unroll
    for (int r = 1; r < 16; ++r) { pm0 = fmaxf(pm0, p0[r]); pm1 = fmaxf(pm1, p1[r]); }
    float pmax = fmaxf(pm0 + off0, pm1 + off1);
    { auto rr = __builtin_amdgcn_permlane32_swap(__float_as_uint(pmax), __float_as_uint(pmax), false, false);
      pmax = fmaxf(__uint_as_float(rr[0]), __uint_as_float(rr[1])); }
    float mn, alpha;
    if (__builtin_expect(__all(pmax - m_reg <= THR2), 1)) { mn = m_reg; alpha = 1.f; }
    else { mn = fmaxf(m_reg, pmax); alpha = __builtin_amdgcn_exp2f(m_reg - mn); m_reg = mn; }
    const float c0 = off0 - mn, c1 = off1 - mn;
    float ps = 0.f;
#pragma unroll
    for (int r = 0; r < 16; ++r) { p0[r] = __builtin_amdgcn_exp2f(p0[r] + c0); p1[r] = __builtin_amdgcn_exp2f(p1[r] + c1); ps += p0[r] + p1[r]; }
    { auto rr = __builtin_amdgcn_permlane32_swap(__float_as_uint(ps), __float_as_uint(ps), false, false);
      ps = __uint_as_float(rr[0]) + __uint_as_float(rr[1]); }
    l_reg = l_reg * alpha + ps;
    if (__any(alpha < 1.f)) { if (hi == 0) wsl[r32] = alpha; asm volatile("s_waitcnt lgkmcnt(0)" ::: "memory");
#pragma unroll
      for (int rg = 0; rg < 4; ++rg) { const f32x4 al = *(const LAS f32x4*)(wsl + 8 * rg + 4 * hi);
#pragma unroll
        for (int d = 0; d < 8; ++d) { o[d][4 * rg + 0] *= al.x; o[d][4 * rg + 1] *= al.y; o[d][4 * rg + 2] *= al.z; o[d][4 * rg + 3] *= al.w; }
        SBAR(); } }
    bf16x8 pa0, pa1, pa2, pa3;
#define PK4(P, BASE, OUT) do { unsigned a0 = cvtpk(P[BASE + 0], P[BASE + 1]), a1 = cvtpk(P[BASE + 2], P[BASE + 3]);   \
    unsigned b0 = cvtpk(P[BASE + 4], P[BASE + 5]), b1 = cvtpk(P[BASE + 6], P[BASE + 7]);                              \
    auto r0 = __builtin_amdgcn_permlane32_swap(a0, b0, false, false); auto r1 = __builtin_amdgcn_permlane32_swap(a1, b1, false, false); \
    v4u w = {r0[0], r1[0], r0[1], r1[1]}; OUT = *reinterpret_cast<bf16x8*>(&w); } while (0)
    PK4(p0, 0, pa0); PK4(p0, 8, pa1); PK4(p1, 0, pa2); PK4(p1, 8, pa3);
#undef PK4
    SBAR();
    { const int vb = vb0 + cur * SHM_V;
      pv_one<0>(o[0], vb, pa0, pa1, pa2, pa3); pv_one<1>(o[1], vb, pa0, pa1, pa2, pa3); pv_one<2>(o[2], vb, pa0, pa1, pa2, pa3); pv_one<3>(o[3], vb, pa0, pa1, pa2, pa3);
      pv_one<4>(o[4], vb, pa0, pa1, pa2, pa3); pv_one<5>(o[5], vb, pa0, pa1, pa2, pa3); pv_one<6>(o[6], vb, pa0, pa1, pa2, pa3); pv_one<7>(o[7], vb, pa0, pa1, pa2, pa3); }
    VM_WAIT(); __syncthreads();
  }
  { int lane2 = threadIdx.x & 63, slot2 = slot; asm volatile("" : "+v"(lane2), "+s"(slot2));
    const int r32e = lane2 & 31, hie = lane2 >> 5;
    bf16* PO = (bf16*)(F.ws + WS_PO) + (size_t)slot2 * 256 * 256; float* ML = (float*)(F.ws + WS_ML) + (size_t)slot2 * 512;
    LAS float* wse = (LAS float*)(F.lds + LDS_WS) + wid * 64;
    if (hie == 0) { wse[r32e] = l_reg; ML[(wid * 32 + r32e) * 2] = m_reg; ML[(wid * 32 + r32e) * 2 + 1] = l_reg; }
    asm volatile("s_waitcnt lgkmcnt(0)" ::: "memory");
    char* Ob = (char*)(PO + (size_t)(wid * 32) * 256);
    const bool odd = (r32e & 1) != 0;
    const unsigned lo = (unsigned)(4 * hie * 256 + (r32e & ~1) + (odd ? 32 : 0)) * 2u;
#pragma unroll
    for (int r = 0; r < 16; ++r) { const int rowc = (r & 3) + 8 * (r >> 2); const float lv = wse[rowc + 4 * hie]; const float rl = lv > 0.f ? __builtin_amdgcn_rcpf(lv) : 0.f;
#pragma unroll
      for (int dp = 0; dp < 4; ++dp) { const float va = o[2 * dp][r] * rl, vb = o[2 * dp + 1][r] * rl;
        const float send = odd ? va : vb, keep = odd ? vb : va;
        const float recv = __builtin_bit_cast(float, __builtin_amdgcn_update_dpp(0, __builtin_bit_cast(int, send), 0xB1, 0xF, 0xF, true));
        *(unsigned*)(Ob + (lo + (unsigned)(rowc * 256 + dp * 64) * 2u)) = odd ? pk2(recv, keep) : pk2(keep, recv); }
      SBAR(); } }
  __syncthreads();
#undef STAGE_K
#undef STAGE_V
}

__device__ __forceinline__ void phase(const Frame& F, int ca, int NA) {
  int s0 = (int)(((long)ca * NSTEPS) / NA); const int s1 = (int)(((long)(ca + 1) * NSTEPS) / NA);
  while (s0 < s1) {
    const int bhm = s0 / STEPS_BHM, rem = s0 - bhm * STEPS_BHM;
    int qb = 0;
#pragma unroll 1
    for (int q = 1; q < 8; ++q) if (rem >= qb_start(q)) qb = q;
    const int j0 = rem - qb_start(qb), nst = 4 * qb + 5;
    const int j1 = (j0 + (s1 - s0) < nst) ? j0 + (s1 - s0) : nst;
    const int slot = bhm * 16 + qb + chunk_of(s0, NA) - chunk_of(bhm * STEPS_BHM, NA);
    segment(F, bhm, qb, j0, j1, slot);
    s0 += j1 - j0;
  }
}
#undef KSWZ
#undef SBAR
}
namespace ml {
constexpr int QST = 136, TST = 72;
constexpr int L_RQ = 0, L_RK = 17152, L_QS = 34304, L_QW = 51712, L_KS = 69120, L_KWT = 86528, L_VT = 104960  , L_SP = 0  , L_G = 141824, L_CW = 143872;
constexpr int L_HT = 0;
constexpr int G_A = 0, G_M = 64, G_WI = 128, G_EM = 192, G_DEN = 256, G_WG = 320, G_SC = 384, G_N = 0;
constexpr int L_NV = L_CW + 5120;
constexpr int L_SSQ = L_KWT;
__device__ __forceinline__ float shfl_up_f(float v, int d) { return __shfl_up(v, d); }

struct StageCW { float v[3]; };
__device__ __forceinline__ void issue_cw(const Frame& F, const Args& a, int h, StageCW& st) {
#pragma unroll
  for (int i = 0; i < 3; ++i) { const int e = F.tid + NTHR * i; st.v[i] = 0.f;
    if (e < 2 * 5 * 128) { const int qk = e / 640, j = (e / 128) % 5, d = e & 127; const int ch = qk * 512 + h * 128 + d; st.v[i] = j < 4 ? a.in[IN_CW][j * 1024 + ch] : a.in[IN_CB][ch]; } }
}
__device__ __forceinline__ void commit_cw(const Frame& F, const StageCW& st) {
  LAS float* CW = (LAS float*)(F.lds + L_CW);
#pragma unroll
  for (int i = 0; i < 3; ++i) { const int e = F.tid + NTHR * i; if (e < 2 * 5 * 128) CW[e] = st.v[i]; }
}
struct StageRaw { v4u v[3]; };
__device__ __forceinline__ void issue_raw(const Frame& F, const bf16* g, int pos0, StageRaw& st) {
#pragma unroll
  for (int i = 0; i < 3; ++i) { const int p = F.tid + NTHR * i, row = p >> 4, ch = p & 15, pos = pos0 - 3 + row;
    st.v[i] = (v4u){0u, 0u, 0u, 0u}; if (p < 67 * 16 && pos >= MPOS0) st.v[i] = *(const v4u*)(g + (size_t)pos * 128 + ch * 8); }
}
__device__ __forceinline__ void commit_raw(const Frame& F, int lds_off, const StageRaw& st) {
#pragma unroll
  for (int i = 0; i < 3; ++i) { const int p = F.tid + NTHR * i, row = p >> 4, ch = p & 15; if (p < 67 * 16) *(LAS v4u*)(F.lds + lds_off + row * 256 + ch * 16) = st.v[i]; }
}
__device__ __forceinline__ void conv16(const Frame& F, int qk, int lds_off, int t, int d0, float (&y)[16]) {
  const LAS float* CW = (const LAS float*)(F.lds + L_CW);
#pragma unroll
  for (int e = 0; e < 16; ++e) y[e] = CW[(qk * 5 + 4) * 128 + d0 + e];
#pragma unroll
  for (int j = 0; j < 4; ++j) { const LAS v4u* rp = (const LAS v4u*)(F.lds + lds_off + (t + j) * 256 + d0 * 2); const v4u r0 = rp[0], r1 = rp[1];
    const LAS float* cw = CW + (qk * 5 + j) * 128 + d0;
    y[0] += cw[0] * bflo(r0.x); y[1] += cw[1] * bfhi(r0.x); y[2] += cw[2] * bflo(r0.y); y[3] += cw[3] * bfhi(r0.y); y[4] += cw[4] * bflo(r0.z); y[5] += cw[5] * bfhi(r0.z); y[6] += cw[6] * bflo(r0.w); y[7] += cw[7] * bfhi(r0.w);
    y[8] += cw[8] * bflo(r1.x); y[9] += cw[9] * bfhi(r1.x); y[10] += cw[10] * bflo(r1.y); y[11] += cw[11] * bfhi(r1.y); y[12] += cw[12] * bflo(r1.z); y[13] += cw[13] * bfhi(r1.z); y[14] += cw[14] * bflo(r1.w); y[15] += cw[15] * bfhi(r1.w); }
#pragma unroll
  for (int e = 0; e < 16; ++e) y[e] = y[e] / (1.0f + __expf(-y[e]));
}
struct StageVT { v4u v[4]; };
__device__ __forceinline__ void issue_vt(const Frame& F, const bf16* MVg, int pos0, StageVT& st) {
#pragma unroll
  for (int i = 0; i < 4; ++i) { const int p = F.tid + NTHR * i, row = p >> 5, ch = p & 31; st.v[i] = (v4u){0u, 0u, 0u, 0u};
    if (pos0 + row >= MPOS0) st.v[i] = *(const v4u*)(MVg + (size_t)(pos0 + row) * 256 + ch * 8); }
}
__device__ __forceinline__ void commit_vt(const Frame& F, const StageVT& st) {
#pragma unroll
  for (int i = 0; i < 4; ++i) { const int p = F.tid + NTHR * i, row = p >> 5, ch = p & 31; const v4u v4 = st.v[i];
    LAS bf16* vt = (LAS bf16*)(F.lds + L_VT) + (ch * 8) * TST + row;
    vt[0 * TST] = (bf16)(v4.x & 0xffff); vt[1 * TST] = (bf16)(v4.x >> 16); vt[2 * TST] = (bf16)(v4.y & 0xffff); vt[3 * TST] = (bf16)(v4.y >> 16);
    vt[4 * TST] = (bf16)(v4.z & 0xffff); vt[5 * TST] = (bf16)(v4.z >> 16); vt[6 * TST] = (bf16)(v4.w & 0xffff); vt[7 * TST] = (bf16)(v4.w >> 16); }
}

__device__ __forceinline__ void taskA(const Frame& F, const Args& a, int task) {
  const int bh = task >> 5, c = task & 31, h = bh & 3, tid = F.tid, w = F.wave, lane = F.lane, fr = lane & 15, kq = lane >> 4, pos0 = 64 * c;
  LAS unsigned char* lds = F.lds; LAS float* G = (LAS float*)(lds + L_G);
  const bf16* MKg = (const bf16*)(F.ws + WS_MK) + (size_t)bh * PADT * 128; const bf16* MVg = (const bf16*)(F.ws + WS_MV) + (size_t)bh * PADT * 256;
  StageCW scw; StageRaw srk; StageVT svt; float li = -1e30f, lf = 0.f;
  issue_cw(F, a, h, scw); issue_raw(F, MKg, pos0, srk); issue_vt(F, MVg, pos0, svt);
  { const bool dead = pos0 + lane < MPOS0; if (w == 0 && !dead) { li = ((const float*)(F.ws + WS_LI))[bh * PADT + pos0 + lane]; lf = ((const float*)(F.ws + WS_LF))[bh * PADT + pos0 + lane]; } }
  __syncthreads();
  commit_cw(F, scw); commit_raw(F, L_RK, srk); commit_vt(F, svt);
  if (w == 0) {
    float bs = lf;
#pragma unroll
    for (int d = 1; d < 64; d <<= 1) { const float o = shfl_up_f(bs, d); if (lane >= d) bs += o; }
    const float av = li - bs; float mx = av;
#pragma unroll
    for (int o = 1; o < 64; o <<= 1) mx = fmaxf(mx, __shfl_xor(mx, o));
    G[G_WG + lane] = __expf(av - mx);
    if (lane == 63) { float* gs = (float*)(F.ws + WS_GS) + (size_t)(bh * 33 + c) * 2; gs[0] = bs; gs[1] = mx; }
  }
  __syncthreads();
  { const int t = tid >> 3, d0 = (tid & 7) * 16; float y[16]; conv16(F, 1, L_RK, t, d0, y);
    const float sw = 0.08838834764831845f * G[G_WG + t]; LAS bf16* kt = (LAS bf16*)(lds + L_KWT) + d0 * TST + t;
#pragma unroll
    for (int e = 0; e < 16; ++e) kt[e * TST] = (bf16)f2bf(y[e] * sw); }
  __syncthreads();
  f32x4* DCg = (f32x4*)(F.ws + WS_DC) + ((size_t)(bh * 32 + c) * 128) * 64;
#pragma unroll
  for (int jj = 0; jj < 2; ++jj) { const int j = 2 * w + jj;
    const bf16x8 bv0 = *(const LAS bf16x8*)(lds + L_VT + ((16 * j + fr) * TST + 8 * kq) * 2), bv1 = *(const LAS bf16x8*)(lds + L_VT + ((16 * j + fr) * TST + 32 + 8 * kq) * 2);
#pragma unroll
    for (int i = 0; i < 8; ++i) { f32x4 acc = {0.f, 0.f, 0.f, 0.f};
      const bf16x8 k0 = *(const LAS bf16x8*)(lds + L_KWT + ((16 * i + fr) * TST + 8 * kq) * 2), k1 = *(const LAS bf16x8*)(lds + L_KWT + ((16 * i + fr) * TST + 32 + 8 * kq) * 2);
      acc = __builtin_amdgcn_mfma_f32_16x16x32_bf16(k0, bv0, acc, 0, 0, 0); acc = __builtin_amdgcn_mfma_f32_16x16x32_bf16(k1, bv1, acc, 0, 0, 0);
      DCg[(size_t)(i * 16 + j) * 64 + lane] = acc; } }
  if (tid < 128) { const LAS v4u* kr = (const LAS v4u*)(lds + L_KWT + tid * TST * 2); float s = 0.f;
#pragma unroll
    for (int q = 0; q < 8; ++q) { const v4u x = kr[q]; s += (bflo(x.x) + bfhi(x.x)) + (bflo(x.y) + bfhi(x.y)) + (bflo(x.z) + bfhi(x.z)) + (bflo(x.w) + bfhi(x.w)); }
    ((float*)(F.ws + WS_DN))[(size_t)(bh * 32 + c) * 128 + tid] = s; }
}

__device__ __forceinline__ void scanB(const Frame& F) {
  const float* GS = (const float*)(F.ws + WS_GS);
  LAS float* cf = (LAS float*)F.lds;
  for (int blk = blockIdx.x; blk < 16 * 16; blk += gridDim.x) { const int bh = blk >> 4, r = (blk & 15) * NTHR + F.tid, i = r >> 10, j = (r >> 6) & 15, ln = r & 63;
    __syncthreads();
    if (F.wave == 0) {
      const int c = F.lane & 31; const v2u gs = *(const v2u*)(GS + (size_t)(bh * 33 + c) * 2); const unsigned g0 = gs.x, g1 = gs.y;
      const float bL = __builtin_bit_cast(float, g0), ml = __builtin_bit_cast(float, g1);
      float mm = 0.f, fa = 0.f, fb = 0.f, mout = 0.f;
#pragma unroll
      for (int cc = 0; cc < 32; ++cc) { const float b_ = __builtin_bit_cast(float, __builtin_amdgcn_readlane(__builtin_bit_cast(int, bL), cc)), l_ = __builtin_bit_cast(float, __builtin_amdgcn_readlane(__builtin_bit_cast(int, ml), cc));
        const float me = fmaxf(mm, l_); if (c == cc) { fa = __expf(mm - me); fb = __expf(l_ - me); } mm = b_ + me; if (c == cc) mout = mm; }
      if (F.lane < 32) { cf[2 * c] = fa; cf[2 * c + 1] = fb; if ((blk & 15) == 0) ((float*)(F.ws + WS_MS))[bh * 33 + c + 1] = mout; }
    }
    __syncthreads();
    const f32x4* dc0 = (const f32x4*)(F.ws + WS_DC) + ((size_t)(bh * 32) * 128 + (i * 16 + j)) * 64 + ln;
    v2u* cs = (v2u*)(F.ws + WS_CS) + ((((size_t)bh * 33) * 8 + i) * 16 + j) * 64 + ln;
    f32x4 s0 = {0.f, 0.f, 0.f, 0.f}, dv[32];
#pragma unroll
    for (int c = 0; c < 32; ++c) dv[c] = dc0[(size_t)c * 128 * 64];
#pragma unroll
    for (int c = 0; c < 32; ++c) { const float fa = cf[2 * c], fb = cf[2 * c + 1];
      s0 = s0 * fa + dv[c] * fb;
      v2u o; o.x = pk2(s0.x, s0.y); o.y = pk2(s0.z, s0.w); cs[(size_t)(c + 1) * 8 * 16 * 64] = o; }
    if ((blk & 15) == 0 && F.tid < 128) {
      const float* dn = (const float*)(F.ws + WS_DN) + (size_t)(bh * 32) * 128 + F.tid; float* ns = (float*)(F.ws + WS_NS) + (size_t)(bh * 33) * 128 + F.tid; float n = 0.f;
      float dnv[32];
#pragma unroll
      for (int c = 0; c < 32; ++c) dnv[c] = dn[(size_t)c * 128];
#pragma unroll
      for (int c = 0; c < 32; ++c) { n = n * cf[2 * c] + dnv[c] * cf[2 * c + 1]; ns[(size_t)(c + 1) * 128] = n; }
    }
  }
}

__device__ __forceinline__ void taskC(const Frame& F, const Args& a, int task) {
  TP_BEGIN(31);
  const int bh = task >> 5, c = (task & 31) + 1, b = bh >> 2, h = bh & 3, tid = F.tid, w = F.wave, lane = F.lane, fr = lane & 15, kq = lane >> 4, pos0 = 64 * c;
  LAS unsigned char* lds = F.lds; LAS float* G = (LAS float*)(lds + L_G); LAS float* NV = (LAS float*)(lds + L_NV);
  const bf16* MQg = (const bf16*)(F.ws + WS_MQ) + (size_t)bh * PADT * 128; const bf16* MKg = (const bf16*)(F.ws + WS_MK) + (size_t)bh * PADT * 128;
  const bf16* MVg = (const bf16*)(F.ws + WS_MV) + (size_t)bh * PADT * 256;
  const float m = ((const float*)(F.ws + WS_MS))[bh * 33 + c];
  StageCW scw; StageRaw srq, srk; StageVT svt; float nvv = 0.f, li = 0.f, lf = 0.f;
  issue_cw(F, a, h, scw); issue_raw(F, MQg, pos0, srq); issue_raw(F, MKg, pos0, srk); issue_vt(F, MVg, pos0, svt);
  if (tid < 128) nvv = ((const float*)(F.ws + WS_NS))[(size_t)(bh * 33 + c) * 128 + tid];
  if (w == 0) { li = ((const float*)(F.ws + WS_LI))[bh * PADT + pos0 + lane]; lf = ((const float*)(F.ws + WS_LF))[bh * PADT + pos0 + lane]; }
  __syncthreads();
  commit_cw(F, scw); commit_raw(F, L_RQ, srq); commit_raw(F, L_RK, srk); commit_vt(F, svt);
  if (tid < 128) NV[tid] = nvv;
  if (w == 0) {
    float bs = lf;
#pragma unroll
    for (int d = 1; d < 64; d <<= 1) { const float o = shfl_up_f(bs, d); if (lane >= d) bs += o; }
    const float av = li - bs; float cm = av;
#pragma unroll
    for (int d = 1; d < 64; d <<= 1) { const float o = shfl_up_f(cm, d); if (lane >= d) cm = fmaxf(cm, o); }
    const float Mt = fmaxf(m, cm);
    G[G_A + lane] = av; G[G_M + lane] = Mt; G[G_WI + lane] = __expf(m - Mt); G[G_EM + lane] = __expf(-(bs + Mt));
  }
  __syncthreads(); TP_END(31, F.ws); TP_BEGIN(32);
  { const int t = tid >> 3, d0 = (tid & 7) * 16; const float wi = G[G_WI + t]; float y[16];
    conv16(F, 0, L_RQ, t, d0, y);
    { v4u o0, o1, w0, w1;
      o0.x = pk2(y[0], y[1]); o0.y = pk2(y[2], y[3]); o0.z = pk2(y[4], y[5]); o0.w = pk2(y[6], y[7]); o1.x = pk2(y[8], y[9]); o1.y = pk2(y[10], y[11]); o1.z = pk2(y[12], y[13]); o1.w = pk2(y[14], y[15]);
      w0.x = pk2(y[0] * wi, y[1] * wi); w0.y = pk2(y[2] * wi, y[3] * wi); w0.z = pk2(y[4] * wi, y[5] * wi); w0.w = pk2(y[6] * wi, y[7] * wi);
      w1.x = pk2(y[8] * wi, y[9] * wi); w1.y = pk2(y[10] * wi, y[11] * wi); w1.z = pk2(y[12] * wi, y[13] * wi); w1.w = pk2(y[14] * wi, y[15] * wi);
      LAS v4u* qs = (LAS v4u*)(lds + L_QS + (t * QST + d0) * 2); qs[0] = o0; qs[1] = o1;
      LAS v4u* qw = (LAS v4u*)(lds + L_QW + (t * QST + d0) * 2); qw[0] = w0; qw[1] = w1; }
    __builtin_amdgcn_sched_barrier(0);
    conv16(F, 1, L_RK, t, d0, y);
    { const float sc = 0.08838834764831845f; v4u o0, o1;
      o0.x = pk2(y[0] * sc, y[1] * sc); o0.y = pk2(y[2] * sc, y[3] * sc); o0.z = pk2(y[4] * sc, y[5] * sc); o0.w = pk2(y[6] * sc, y[7] * sc);
      o1.x = pk2(y[8] * sc, y[9] * sc); o1.y = pk2(y[10] * sc, y[11] * sc); o1.z = pk2(y[12] * sc, y[13] * sc); o1.w = pk2(y[14] * sc, y[15] * sc);
      LAS v4u* ks = (LAS v4u*)(lds + L_KS + (t * QST + d0) * 2); ks[0] = o0; ks[1] = o1; } }
  __syncthreads(); TP_END(32, F.ws); TP_BEGIN(33);
  v4u cb[4][2];
  { const v2u* cs = (const v2u*)(F.ws + WS_CS) + (((size_t)bh * 33 + c) * 8 * 16) * 64;
#pragma unroll
    for (int I = 0; I < 4; ++I)
#pragma unroll
      for (int jj = 0; jj < 2; ++jj) { const v2u lo_ = cs[(size_t)((2 * I) * 16 + 2 * w + jj) * 64 + lane], hi_ = cs[(size_t)((2 * I + 1) * 16 + 2 * w + jj) * 64 + lane]; cb[I][jj] = (v4u){lo_.x, lo_.y, hi_.x, hi_.y}; } }
  { const int si = w >> 1; const f32x4 as = *(const LAS f32x4*)(G + G_A + 16 * si + 4 * kq);
#pragma unroll
    for (int tt = 0; tt < 2; ++tt) { const int ti = 2 * (w & 1) + tt; f32x4 acc = {0.f, 0.f, 0.f, 0.f};
#pragma unroll
      for (int ks = 0; ks < 4; ++ks) { const bf16x8 af = *(const LAS bf16x8*)(lds + L_KS + ((16 * si + fr) * QST + 32 * ks + 8 * kq) * 2);
        const bf16x8 bfr = *(const LAS bf16x8*)(lds + L_QS + ((16 * ti + fr) * QST + 32 * ks + 8 * kq) * 2);
        acc = __builtin_amdgcn_mfma_f32_16x16x32_bf16(af, bfr, acc, 0, 0, 0); }
      const int t = 16 * ti + fr, s0 = 16 * si + 4 * kq; const float Mt = G[G_M + t];
      const float v0 = (s0 + 0 <= t) ? acc.x * __expf(as.x - Mt) : 0.f, v1 = (s0 + 1 <= t) ? acc.y * __expf(as.y - Mt) : 0.f;
      const float v2 = (s0 + 2 <= t) ? acc.z * __expf(as.z - Mt) : 0.f, v3 = (s0 + 3 <= t) ? acc.w * __expf(as.w - Mt) : 0.f;
      v2u o; o.x = pk2(v0, v1); o.y = pk2(v2, v3);
      *(LAS v2u*)(lds + L_SP + (t * TST + s0) * 2) = o; } }
  __syncthreads(); TP_END(33, F.ws); TP_BEGIN(34);
  if (w == 0) { const int t = lane; float qn = 0.f, rsum = 0.f;
#pragma unroll 4
    for (int q = 0; q < 16; ++q) { const v4u x = *(const LAS v4u*)(lds + L_QS + (t * QST + q * 8) * 2); const f32x4 n0 = *(const LAS f32x4*)(NV + q * 8), n1 = *(const LAS f32x4*)(NV + q * 8 + 4);
      qn += bflo(x.x) * n0.x + bfhi(x.x) * n0.y + bflo(x.y) * n0.z + bfhi(x.y) * n0.w + bflo(x.z) * n1.x + bfhi(x.z) * n1.y + bflo(x.w) * n1.z + bfhi(x.w) * n1.w; }
#pragma unroll
    for (int q = 0; q < 8; ++q) { const v4u x = *(const LAS v4u*)(lds + L_SP + (t * TST + q * 8) * 2); rsum += (bflo(x.x) + bfhi(x.x)) + (bflo(x.y) + bfhi(x.y)) + (bflo(x.z) + bfhi(x.z)) + (bflo(x.w) + bfhi(x.w)); }
    const float den = G[G_WI + t] * qn + rsum; G[G_DEN + t] = fmaxf(fabsf(den), G[G_EM + t]); }
  f32x4 acc[2][4];
#pragma unroll
  for (int jj = 0; jj < 2; ++jj)
#pragma unroll
    for (int ti = 0; ti < 4; ++ti) acc[jj][ti] = (f32x4){0.f, 0.f, 0.f, 0.f};
#pragma unroll
  for (int I = 0; I < 4; ++I) {
#pragma unroll
    for (int ti = 0; ti < 4; ++ti) { const LAS unsigned char* qp = lds + L_QW + ((16 * ti + fr) * QST + 32 * I + 4 * kq) * 2;
      const v2u a0 = *(const LAS v2u*)qp, a1 = *(const LAS v2u*)(qp + 32); const v4u av = {a0.x, a0.y, a1.x, a1.y};
      acc[0][ti] = __builtin_amdgcn_mfma_f32_16x16x32_bf16(__builtin_bit_cast(bf16x8, av), __builtin_bit_cast(bf16x8, cb[I][0]), acc[0][ti], 0, 0, 0);
      acc[1][ti] = __builtin_amdgcn_mfma_f32_16x16x32_bf16(__builtin_bit_cast(bf16x8, av), __builtin_bit_cast(bf16x8, cb[I][1]), acc[1][ti], 0, 0, 0); }
    __builtin_amdgcn_sched_barrier(0); }
#pragma unroll
  for (int ks = 0; ks < 2; ++ks) { const bf16x8 bv0 = *(const LAS bf16x8*)(lds + L_VT + ((32 * w + fr) * TST + 32 * ks + 8 * kq) * 2), bv1 = *(const LAS bf16x8*)(lds + L_VT + ((32 * w + 16 + fr) * TST + 32 * ks + 8 * kq) * 2);
#pragma unroll
    for (int ti = 0; ti < 4; ++ti) { const bf16x8 sf = *(const LAS bf16x8*)(lds + L_SP + ((16 * ti + fr) * TST + 32 * ks + 8 * kq) * 2);
      acc[0][ti] = __builtin_amdgcn_mfma_f32_16x16x32_bf16(sf, bv0, acc[0][ti], 0, 0, 0); acc[1][ti] = __builtin_amdgcn_mfma_f32_16x16x32_bf16(sf, bv1, acc[1][ti], 0, 0, 0); } }
  __syncthreads(); TP_END(34, F.ws); TP_BEGIN(35);
  LAS float* SSQ = (LAS float*)(lds + L_SSQ);
#pragma unroll
  for (int ti = 0; ti < 4; ++ti) { const f32x4 dn = *(const LAS f32x4*)(G + G_DEN + 16 * ti + 4 * kq);
    f32x4 s4;
#pragma unroll
    for (int r = 0; r < 4; ++r) { const float h0 = acc[0][ti][r] / dn[r], h1 = acc[1][ti][r] / dn[r]; acc[0][ti][r] = h0; acc[1][ti][r] = h1; s4[r] = h0 * h0 + h1 * h1; }
#pragma unroll
    for (int r = 0; r < 4; ++r) { float v = s4[r];
      v += __builtin_bit_cast(float, __builtin_amdgcn_update_dpp(0, __builtin_bit_cast(int, v), 0xB1, 0xF, 0xF, true)); v += __builtin_bit_cast(float, __builtin_amdgcn_update_dpp(0, __builtin_bit_cast(int, v), 0x4E, 0xF, 0xF, true));
      v += __builtin_bit_cast(float, __builtin_amdgcn_update_dpp(0, __builtin_bit_cast(int, v), 0x141, 0xF, 0xF, true)); v += __builtin_bit_cast(float, __builtin_amdgcn_update_dpp(0, __builtin_bit_cast(int, v), 0x140, 0xF, 0xF, true)); s4[r] = v; }
    if (fr == 0) { SSQ[(16 * ti + 4 * kq + 0) * 8 + w] = s4.x; SSQ[(16 * ti + 4 * kq + 1) * 8 + w] = s4.y; SSQ[(16 * ti + 4 * kq + 2) * 8 + w] = s4.z; SSQ[(16 * ti + 4 * kq + 3) * 8 + w] = s4.w; } }
  __syncthreads();
  LAS bf16* HT = (LAS bf16*)(lds + L_HT);
#pragma unroll
  for (int ti = 0; ti < 4; ++ti)
#pragma unroll
    for (int r = 0; r < 4; ++r) { const int t = 16 * ti + 4 * kq + r; const f32x4 p0 = *(const LAS f32x4*)(SSQ + t * 8), p1 = *(const LAS f32x4*)(SSQ + t * 8 + 4);
      const float rh = rsqrtf(((p0.x + p0.y) + (p0.z + p0.w) + (p1.x + p1.y) + (p1.z + p1.w)) * (1.0f / 256.f) + EPS);
      HT[t * 264 + 32 * w + fr] = (bf16)f2bf(acc[0][ti][r] * rh); HT[t * 264 + 32 * w + 16 + fr] = (bf16)f2bf(acc[1][ti][r] * rh); }
  __syncthreads(); TP_END(35, F.ws); TP_BEGIN(36);
  { const int t = tid >> 3, c0 = (tid & 7) * 32; const size_t R = (size_t)b * SEQ + 64 * (c - 1) + t;
    const bf16* mo = (const bf16*)(F.ws + WS_MO) + R * 1024 + h * 256 + c0; const float* og = a.in[IN_OUTG] + h * 256 + c0; bf16* A2 = (bf16*)(F.ws + WS_A2) + R * DM + 1024 + h * 256 + c0;
#pragma unroll
    for (int q = 0; q < 4; ++q) { const v4u hv = *(const LAS v4u*)(HT + t * 264 + c0 + q * 8); const v4u mv = *(const v4u*)(mo + q * 8); const f32x4 g0 = *(const f32x4*)(og + q * 8), g1 = *(const f32x4*)(og + q * 8 + 4);
      v4u o; o.x = pk2(bflo(hv.x) * g0.x * sigmoidf_(bflo(mv.x)), bfhi(hv.x) * g0.y * sigmoidf_(bfhi(mv.x))); o.y = pk2(bflo(hv.y) * g0.z * sigmoidf_(bflo(mv.y)), bfhi(hv.y) * g0.w * sigmoidf_(bfhi(mv.y)));
      o.z = pk2(bflo(hv.z) * g1.x * sigmoidf_(bflo(mv.z)), bfhi(hv.z) * g1.y * sigmoidf_(bfhi(mv.z))); o.w = pk2(bflo(hv.w) * g1.z * sigmoidf_(bflo(mv.w)), bfhi(hv.w) * g1.w * sigmoidf_(bfhi(mv.w)));
      *(v4u*)(A2 + q * 8) = o; } }
  TP_END(36, F.ws);
}
}
struct CombRow { float mp[8][3], lp[8][3]; v4u op[8][3]; };
__device__ __forceinline__ float half_sum_dpp(float v, bool hi) {
  v += __builtin_bit_cast(float, __builtin_amdgcn_update_dpp(0, __builtin_bit_cast(int, v), 0xB1, 0xF, 0xF, true));
  v += __builtin_bit_cast(float, __builtin_amdgcn_update_dpp(0, __builtin_bit_cast(int, v), 0x4E, 0xF, 0xF, true));
  v += __builtin_bit_cast(float, __builtin_amdgcn_update_dpp(0, __builtin_bit_cast(int, v), 0x141, 0xF, 0xF, true));
  v += __builtin_bit_cast(float, __builtin_amdgcn_update_dpp(0, __builtin_bit_cast(int, v), 0x140, 0xF, 0xF, true));
  const float r0 = __builtin_bit_cast(float, __builtin_amdgcn_readlane(__builtin_bit_cast(int, v), 0)), r1 = __builtin_bit_cast(float, __builtin_amdgcn_readlane(__builtin_bit_cast(int, v), 16));
  const float r2 = __builtin_bit_cast(float, __builtin_amdgcn_readlane(__builtin_bit_cast(int, v), 32)), r3 = __builtin_bit_cast(float, __builtin_amdgcn_readlane(__builtin_bit_cast(int, v), 48));
  return hi ? r2 + r3 : r0 + r1;
}
__device__ __forceinline__ void comb_load(const bf16* PO, const float* ML, int R0, int NA, int lane, CombRow& cr) {
  const int b = R0 >> 11, t = R0 & 2047, qb = t >> 8, rq = (t & 255) + (lane >> 5), l32 = lane & 31;
#pragma unroll
  for (int hm = 0; hm < 8; ++hm) {
    const int bhm = b * 8 + hm, first = bhm * att::STEPS_BHM + att::qb_start(qb), last = first + 4 * qb + 4;
    const int cf = att::chunk_of(first, NA), np = att::chunk_of(last, NA) - cf + 1, slot0 = bhm * 16 + qb + cf - att::chunk_of(bhm * att::STEPS_BHM, NA);
#pragma unroll
    for (int p = 0; p < 3; ++p) { if (p < np) { const int slot = slot0 + p; const v2u ml = *(const v2u*)(ML + (size_t)slot * 512 + rq * 2);
        const unsigned mx_ = ml.x, my_ = ml.y; cr.mp[hm][p] = __builtin_bit_cast(float, mx_); cr.lp[hm][p] = __builtin_bit_cast(float, my_);
        cr.op[hm][p] = ((const v4u*)(PO + ((size_t)slot * 256 + rq) * 256))[l32]; } else { cr.mp[hm][p] = -1e30f; cr.lp[hm][p] = 0.f; cr.op[hm][p] = (v4u){0u, 0u, 0u, 0u}; } }
  }
}
__device__ __forceinline__ void comb_finish(bf16* A2, int R0, int lane, float lam, const f32x4 sg0, const f32x4 sg1, const CombRow& cr) {
  const bool hi = lane >= 32; const int l32 = lane & 31;
#pragma unroll
  for (int h = 0; h < 4; ++h) {
    float om[2][8];
#pragma unroll
    for (int m = 0; m < 2; ++m) { const int hm = h * 2 + m;
      const float M = fmaxf(cr.mp[hm][0], fmaxf(cr.mp[hm][1], cr.mp[hm][2]));
      float wsum = 0.f, acc[8];
#pragma unroll
      for (int i = 0; i < 8; ++i) acc[i] = 0.f;
#pragma unroll
      for (int p = 0; p < 3; ++p) { const float w = cr.lp[hm][p] * exp2f(cr.mp[hm][p] - M); wsum += w; const v4u ow = cr.op[hm][p];
#pragma unroll
        for (int i = 0; i < 4; ++i) { const unsigned wd = ow[i]; acc[2 * i] += bflo(wd) * w; acc[2 * i + 1] += bfhi(wd) * w; } }
      const float iw = 1.0f / wsum;
#pragma unroll
      for (int i = 0; i < 8; ++i) om[m][i] = acc[i] * iw;
    }
    float o[8], ss = 0.f;
#pragma unroll
    for (int i = 0; i < 8; ++i) { o[i] = om[0][i] - om[1][i] * lam; ss += o[i] * o[i]; }
    const float rs = rsqrtf(half_sum_dpp(ss, hi) * (1.0f / 256.f) + EPS) * 0.8f;
    v4u w; w.x = pk2(o[0] * rs * sg0.x, o[1] * rs * sg0.y); w.y = pk2(o[2] * rs * sg0.z, o[3] * rs * sg0.w); w.z = pk2(o[4] * rs * sg1.x, o[5] * rs * sg1.y); w.w = pk2(o[6] * rs * sg1.z, o[7] * rs * sg1.w);
    ((v4u*)(A2 + (size_t)(R0 + (hi ? 1 : 0)) * DM + h * 256))[l32] = w;
  }
}
__device__ __forceinline__ void p3_combine(const Frame& F, const Args& a, int NA) {
  const bf16* PO = (const bf16*)(F.ws + WS_PO); const float* ML = (const float*)(F.ws + WS_ML);
  bf16* A2 = (bf16*)(F.ws + WS_A2);
  const float lam = *(const float*)(F.ws + WS_LAM);
  const int gw = blockIdx.x * NWAVES + F.wave, NGW = gridDim.x * NWAVES, lane = F.lane;
  const f32x4 sg0 = ((const f32x4*)a.in[IN_SUBG])[2 * (lane & 31)], sg1 = ((const f32x4*)a.in[IN_SUBG])[2 * (lane & 31) + 1];
  for (int k = gw; k < MROWS / 4; k += NGW) {
#pragma unroll 1
    for (int s = 0; s < 2; ++s) { const int P = s ? MROWS / 2 - 1 - k : k;
      CombRow r0;
      comb_load(PO, ML, 2 * P, NA, lane, r0);
      comb_finish(A2, 2 * P, lane, lam, sg0, sg1, r0); }
  }
}
struct EpiRes {
  static constexpr bool PERM = true, AFTER_DRAIN = false;
  const float* x; float* out; bf16* H1b; float* SSQ;
  __device__ __forceinline__ void operator()(const pg8::f32x4 (&acc)[2][2][4][2], const pg8::Unit& u, int wr, int wc, int fr, int fq) const {
    const int row0 = u.pm * 256 + wr * 64 + fr, col0 = u.pn * 256 + wc * 32 + 8 * fq;
#pragma unroll
    for (int ai = 0; ai < 2; ++ai) {
      f32x4 xv[4][2][2];
#pragma unroll
      for (int m = 0; m < 4; ++m)
#pragma unroll
        for (int bj = 0; bj < 2; ++bj) { const size_t off = (size_t)(row0 + ai * 128 + m * 16) * DM + col0 + bj * 128; xv[m][bj][0] = *(const f32x4*)(x + off); xv[m][bj][1] = *(const f32x4*)(x + off + 4); }
#pragma unroll
      for (int m = 0; m < 4; ++m) { const size_t R = (size_t)(row0 + ai * 128 + m * 16); float s = 0.f;
#pragma unroll
        for (int bj = 0; bj < 2; ++bj) { const size_t off = R * DM + col0 + bj * 128;
          const f32x4 v0 = acc[ai][bj][m][0] + xv[m][bj][0], v1 = acc[ai][bj][m][1] + xv[m][bj][1];
          v4u w; w.x = pk2(v0.x, v0.y); w.y = pk2(v0.z, v0.w); w.z = pk2(v1.x, v1.y); w.w = pk2(v1.z, v1.w);
          *(v4u*)(H1b + off) = w;
          s += (v0.x * v0.x + v0.y * v0.y) + (v0.z * v0.z + v0.w * v0.w) + (v1.x * v1.x + v1.y * v1.y) + (v1.z * v1.z + v1.w * v1.w); }
        s += __shfl_xor(s, 16); s += __shfl_xor(s, 32);
        if (fq == 0) SSQ[R * 32 + u.pn * 4 + wc] = s; }
    }
  }
};
#ifndef PEER_U_FP8
#define PEER_U_FP8 0
#endif
typedef __bf16 bfv2 __attribute__((ext_vector_type(2)));
__device__ __forceinline__ void split_hl(const f32x4 a, const f32x4 b, bf16x8& hi, bf16x8& lo) {
  float v[8] = {a.x, a.y, a.z, a.w, b.x, b.y, b.z, b.w}; unsigned h[8], l[8];
#pragma unroll
  for (int i = 0; i < 8; ++i) { h[i] = f2bf(v[i]); l[i] = f2bf(v[i] - __builtin_bit_cast(float, h[i] << 16)); }
  v4u hv = {h[0] | (h[1] << 16), h[2] | (h[3] << 16), h[4] | (h[5] << 16), h[6] | (h[7] << 16)};
  v4u lv = {l[0] | (l[1] << 16), l[2] | (l[3] << 16), l[4] | (l[5] << 16), l[6] | (l[7] << 16)};
  hi = __builtin_bit_cast(bf16x8, hv); lo = __builtin_bit_cast(bf16x8, lv);
}
__device__ __forceinline__ void p0_w3t(const Frame& F, const Args& a) {
  const float* wq = a.in[IN_WQ]; const float* sk = a.in[IN_SUBK]; const float* g2 = a.in[IN_G2];
  bf16* W3t = (bf16*)(F.ws + WS_W3T);
  const int lane = F.lane, fr = lane & 15, fq = lane >> 4;
  constexpr int SKS = 272;
  LAS unsigned char* shi = F.lds; LAS unsigned char* slo = F.lds + 128 * SKS;
  for (int bt = blockIdx.x; bt < 256; bt += gridDim.x) {
    const int hh = bt & 15, kt = (bt >> 4) * 8 + F.wave;
    const float* ap = wq + (size_t)(kt * 16 + fr) * DM + hh * 128 + fq * 8;
    f32x4 a0[4], a1[4];
#pragma unroll
    for (int s = 0; s < 4; ++s) { a0[s] = *(const f32x4*)(ap + 32 * s); a1[s] = *(const f32x4*)(ap + 32 * s + 4); }
    const f32x4 gk = *(const f32x4*)(g2 + kt * 16 + fq * 4);
    __syncthreads();
#pragma unroll
    for (int i = 0; i < 4; ++i) { const int idx = F.tid + NTHR * i, key = idx >> 4, c8 = idx & 15; const float* p = sk + (size_t)(hh * 128 + key) * 128 + c8 * 8;
      bf16x8 h, l; split_hl(*(const f32x4*)p, *(const f32x4*)(p + 4), h, l);
      *(LAS bf16x8*)(shi + key * SKS + c8 * 16) = h; *(LAS bf16x8*)(slo + key * SKS + c8 * 16) = l; }
    bf16x8 ahi[4], alo[4];
#pragma unroll
    for (int s = 0; s < 4; ++s) split_hl(a0[s], a1[s], ahi[s], alo[s]);
    __syncthreads();
#pragma unroll 2
    for (int t2 = 0; t2 < 8; ++t2) {
      const LAS unsigned char* bh = shi + (t2 * 16 + fr) * SKS + fq * 16; const LAS unsigned char* bl = slo + (t2 * 16 + fr) * SKS + fq * 16;
      f32x4 acc = {0.f, 0.f, 0.f, 0.f};
#pragma unroll
      for (int s = 0; s < 4; ++s) { const bf16x8 bhi = *(const LAS bf16x8*)(bh + 64 * s), blo = *(const LAS bf16x8*)(bl + 64 * s);
        acc = __builtin_amdgcn_mfma_f32_16x16x32_bf16(ahi[s], bhi, acc, 0, 0, 0);
        acc = __builtin_amdgcn_mfma_f32_16x16x32_bf16(ahi[s], blo, acc, 0, 0, 0);
        acc = __builtin_amdgcn_mfma_f32_16x16x32_bf16(alo[s], bhi, acc, 0, 0, 0); }
      v2u o; o.x = pk2(acc.x * gk.x, acc.y * gk.y); o.y = pk2(acc.z * gk.z, acc.w * gk.w);
      *(v2u*)(W3t + (size_t)(hh * 128 + t2 * 16 + fr) * DM + kt * 16 + fq * 4) = o;
    }
  }
  __syncthreads();
}
typedef float f32x2v __attribute__((ext_vector_type(2)));
__device__ __forceinline__ void p0_tables(const Frame& F, const Args& a) {
  const float* g2 = a.in[IN_G2];
  float* SCL = (float*)(F.ws + WS_SCL);
  const int gw = blockIdx.x * NWAVES + F.wave, NGW = gridDim.x * NWAVES, lane = F.lane;
  f32x4 gl[8];
#pragma unroll
  for (int q = 0; q < 8; ++q) gl[q] = *(const f32x4*)(g2 + q * 256 + lane * 4);
  f32x4 xn[8];
  { const int row = gw; if (row < 2 * 16384) { const float* src = a.in[row >= 16384 ? IN_V : IN_U] + (size_t)(row & 16383) * DM + lane * 4;
#pragma unroll
      for (int q = 0; q < 8; ++q) xn[q] = *(const f32x4*)(src + q * 256); } }
  for (int row = gw; row < 2 * 16384; row += NGW) {
    const bool isv = row >= 16384; const int e = row & 16383;
    f32x4 x[8];
#pragma unroll
    for (int q = 0; q < 8; ++q) x[q] = xn[q];
    { const int rn = row + NGW; if (rn < 2 * 16384) { const float* src = a.in[rn >= 16384 ? IN_V : IN_U] + (size_t)(rn & 16383) * DM + lane * 4;
#pragma unroll
        for (int q = 0; q < 8; ++q) xn[q] = *(const f32x4*)(src + q * 256); } }
    float amax = 0.f, ssq = 0.f;
#pragma unroll
    for (int q = 0; q < 8; ++q) { if (!isv) x[q] = x[q] * gl[q]; amax = fmaxf(amax, fmaxf(fmaxf(fabsf(x[q].x), fabsf(x[q].y)), fmaxf(fabsf(x[q].z), fabsf(x[q].w))));
      ssq += (x[q].x * x[q].x + x[q].y * x[q].y) + (x[q].z * x[q].z + x[q].w * x[q].w); }
#pragma unroll
    for (int o = 1; o < 64; o <<= 1) amax = fmaxf(amax, __shfl_xor(amax, o));
    v4u w;
    if (isv) {
      const float sc = amax > 0.f ? 6.0f / amax : 1.0f;
#pragma unroll
      for (int d = 0; d < 4; ++d) { unsigned pk = 0u;
        pk = __builtin_amdgcn_cvt_scalef32_pk_fp4_f32(pk, x[2 * d].x * sc, x[2 * d].y * sc, 1.0f, 0); pk = __builtin_amdgcn_cvt_scalef32_pk_fp4_f32(pk, x[2 * d].z * sc, x[2 * d].w * sc, 1.0f, 1);
        pk = __builtin_amdgcn_cvt_scalef32_pk_fp4_f32(pk, x[2 * d + 1].x * sc, x[2 * d + 1].y * sc, 1.0f, 2); pk = __builtin_amdgcn_cvt_scalef32_pk_fp4_f32(pk, x[2 * d + 1].z * sc, x[2 * d + 1].w * sc, 1.0f, 3);
        w[d] = pk; }
      if (lane == 0) SCL[row] = 1.0f / sc;
    } else {
      ssq = wave_sum_dpp(ssq);
      const float sA = amax > 0.f ? amax * (1.0f / 7.0f) : 1.0f, sB = fminf(sA, 0.36f * sqrtf(ssq * (1.0f / DM)) + 1e-30f);
      const float iA = 1.0f / sA, iB = 1.0f / sB;
      float eA = 0.f, eB = 0.f;
#pragma unroll
      for (int q = 0; q < 8; ++q)
#pragma unroll
        for (int j = 0; j < 4; ++j) { const float v = x[q][j];
          const float da = v - sA * __builtin_amdgcn_fmed3f(__builtin_rintf(v * iA), -7.0f, 7.0f), db = v - sB * __builtin_amdgcn_fmed3f(__builtin_rintf(v * iB), -7.0f, 7.0f);
          eA += da * da; eB += db * db; }
      eA = wave_sum_dpp(eA); eB = wave_sum_dpp(eB);
      const bool useB = eB < eA; const float st = useB ? sB : sA, is = useB ? iB : iA;
#pragma unroll
      for (int d = 0; d < 4; ++d) { unsigned pk = 0u;
#pragma unroll
        for (int p = 0; p < 8; ++p) { const float v = x[2 * d + (p >> 2)][p & 3]; const int qi = (int)__builtin_amdgcn_fmed3f(__builtin_rintf(v * is), -7.0f, 7.0f); pk |= ((unsigned)qi & 15u) << (4 * p); }
        w[d] = pk; }
      if (lane == 0) SCL[row] = st;
    }
    *(v4u*)(F.ws + (isv ? WS_VB8 : WS_UB) + (size_t)e * 1024 + lane * 16) = w;
  }
}
struct EpiScore {
  static constexpr bool PERM = true, AFTER_DRAIN = false;
  float* S; const LAS float* rs;
  __device__ __forceinline__ void operator()(const pg8::f32x4 (&acc)[2][2][4][2], const pg8::Unit& u, int wr, int wc, int fr, int fq) const {
    const int rl0 = wr * 64 + fr, keyb = wc * 32 + 8 * fq;
#pragma unroll
    for (int ai = 0; ai < 2; ++ai)
#pragma unroll
      for (int m = 0; m < 4; ++m) { const int rl = rl0 + ai * 128 + m * 16; const float r = rs[rl]; const int row = u.pm * 256 + rl;
#pragma unroll
        for (int bj = 0; bj < 2; ++bj) { float* d = S + ((size_t)((row >> 5) * 16 + u.pn * 2 + bj) * 128 + keyb) * 32 + (row & 31);
          const pg8::f32x4 v0 = acc[ai][bj][m][0] * r, v1 = acc[ai][bj][m][1] * r;
          d[0] = v0[0]; d[32] = v0[1]; d[64] = v0[2]; d[96] = v0[3]; d[128] = v1[0]; d[160] = v1[1]; d[192] = v1[2]; d[224] = v1[3]; } }
  }
};

__device__ __forceinline__ unsigned fkey(float f) { const unsigned b = __builtin_bit_cast(unsigned, f); return b ^ ((b >> 31) ? 0xFFFFFFFFu : 0x80000000u); }
template <int NV, int K> __device__ __forceinline__ void wave_topk(const unsigned (&u)[NV], bool (&sel)[NV], int lane) {
  unsigned prefix = 0u; int cge = NV * 64;
#pragma unroll 1
  for (int bit = 31; bit >= 0 && cge != K; --bit) {
    const unsigned cand = prefix | (1u << bit); int c = 0;
#pragma unroll
    for (int i = 0; i < NV; ++i) c += __builtin_popcountll(__ballot(u[i] >= cand));
    if (c >= K) { prefix = cand; cge = c; }
  }
  int cgt = 0;
#pragma unroll
  for (int i = 0; i < NV; ++i) cgt += __builtin_popcountll(__ballot(u[i] > prefix));
  int need = K - cgt;
  const unsigned long long lm = (1ull << lane) - 1ull;
#pragma unroll
  for (int i = 0; i < NV; ++i) { const unsigned long long eq = __ballot(u[i] == prefix); const int before = __builtin_popcountll(eq & lm);
    sel[i] = (u[i] > prefix) || (u[i] == prefix && before < need); const int ne = __builtin_popcountll(eq); need = need > ne ? need - ne : 0; }
}
template <int NG, int NV, int K> __device__ __forceinline__ void wave_topk_multi(const unsigned (&u)[NG][NV], bool (&sel)[NG][NV], int lane) {
  unsigned prefix[NG]; int cge[NG];
#pragma unroll
  for (int g = 0; g < NG; ++g) { prefix[g] = 0u; cge[g] = NV * 64; }
#pragma unroll 1
  for (int bit = 31; bit >= 0; --bit) {
    bool done = true;
#pragma unroll
    for (int g = 0; g < NG; ++g) done = done && (cge[g] == K);
    if (done) break;
#pragma unroll
    for (int g = 0; g < NG; ++g) { const unsigned cand = prefix[g] | (1u << bit); int c = 0;
#pragma unroll
      for (int i = 0; i < NV; ++i) c += __builtin_popcountll(__ballot(u[g][i] >= cand));
      if (cge[g] != K && c >= K) { prefix[g] = cand; cge[g] = c; } }
  }
  const unsigned long long lm = (1ull << lane) - 1ull;
#pragma unroll
  for (int g = 0; g < NG; ++g) { int cgt = 0;
#pragma unroll
    for (int i = 0; i < NV; ++i) cgt += __builtin_popcountll(__ballot(u[g][i] > prefix[g]));
    int need = K - cgt;
#pragma unroll
    for (int i = 0; i < NV; ++i) { const unsigned long long eq = __ballot(u[g][i] == prefix[g]); const int before = __builtin_popcountll(eq & lm);
      sel[g][i] = (u[g][i] > prefix[g]) || (u[g][i] == prefix[g] && before < need); const int ne = __builtin_popcountll(eq); need = need > ne ? need - ne : 0; } }
}
__device__ __forceinline__ float gelu_erf(float v) {
  const float av = fabsf(v), t = __builtin_amdgcn_rcpf(1.0f + 0.2316418882f * av);
  float q = t * 0.5307027145f - 0.7265760135f; q = q * t + 0.7107068705f; q = q * t - 0.142248368f; q = q * t + 0.127414796f; q = q * t;
  const float tail = q * __builtin_amdgcn_exp2f(v * v * -0.72134752044f);
  return v < 0.f ? v * tail : v - v * tail;
}

#ifndef ROUTE_REPS
#define ROUTE_REPS 1
#endif
__device__ __forceinline__ void ins16(float (&t)[16], float x) {
#pragma unroll
  for (int i = 15; i >= 1; --i) t[i] = __builtin_amdgcn_fmed3f(t[i - 1], t[i], x);
  t[0] = fmaxf(t[0], x);
}
__device__ __forceinline__ void p6_peer(const Frame& F, const Args& a, float* dst_base) {
  const float* S2 = (const float*)(F.ws + WS_S); const float* SSQ = (const float*)(F.ws + WS_SSQ); const bf16* H1b = (const bf16*)(F.ws + WS_H1B);
  int lane = F.lane, wv = F.wave, tid = F.tid; asm volatile("" : "+v"(lane), "+s"(wv), "+v"(tid));
  int* EIDg = (int*)(F.ws + WS_EID); float* EGTg = (float*)(F.ws + WS_EGT);
  LAS int* eid = (LAS int*)(F.lds + wv * 5120); LAS float* cg = (LAS float*)(eid + 512); LAS float* esu = (LAS float*)(eid + 1024); LAS float* dq = (LAS float*)(eid + 1152);
  LAS unsigned char* RB = F.lds + 40960 + wv * 8192;
  LAS float* L1 = (LAS float*)(F.lds + 40960);
  TP_BEGIN(11);
#ifdef TPROBE
  const unsigned long long tp_p7_ = __builtin_amdgcn_s_memrealtime();
#endif
  for (int tb = blockIdx.x; tb < MROWS / 32; tb += gridDim.x) {
    __syncthreads();
    {
      const int g = tid >> 5, tl = tid & 31; const float* src = S2 + ((size_t)(tb * 16 + g) * 128) * 32 + tl;
      float t[16];
#pragma unroll
      for (int i = 0; i < 16; ++i) t[i] = -INFINITY;
      float sv[128];
#pragma unroll
      for (int k = 0; k < 128; ++k) sv[k] = src[k * 32];
#pragma unroll
      for (int k = 0; k < 128; ++k) ins16(t, __builtin_bit_cast(float, (__builtin_bit_cast(unsigned, sv[k]) & ~0x7Fu) | (unsigned)(127 - k)));
#pragma unroll
      for (int i = 0; i < 16; ++i) L1[(g * 16 + i) * 32 + tl] = t[i];
    }
    __syncthreads();
    if (tid < 256) {
      const int h8 = tid >> 5, tl = tid & 31; const LAS float* LA = L1 + ((2 * h8) * 16) * 32 + tl; const LAS float* LB = L1 + ((2 * h8 + 1) * 16) * 32 + tl;
      float A[16], B[16], t[16];
#pragma unroll
      for (int i = 0; i < 16; ++i) { A[i] = LA[i * 32]; B[i] = LB[i * 32]; t[i] = -INFINITY; }
#pragma unroll
      for (int i = 0; i < 16; ++i)
#pragma unroll
        for (int j = 0; j < 16; ++j) if ((i + 1) * (j + 1) <= 16) { const float c = A[i] + B[j];
            ins16(t, __builtin_bit_cast(float, (__builtin_bit_cast(unsigned, c) & ~0xFFu) | (unsigned)(255 - (i * 16 + j)))); }
      float ev[16], es = 0.f;
#pragma unroll
      for (int r = 0; r < 16; ++r) { ev[r] = __expf(t[r] - t[0]); es += ev[r]; }
      const float inv = 1.0f / es;
#pragma unroll
      for (int r = 0; r < 16; ++r) { const unsigned flat = 255u - (__builtin_bit_cast(unsigned, t[r]) & 0xFFu), ii = flat >> 4, jj = flat & 15u;
        const unsigned ka = 127u - (__builtin_bit_cast(unsigned, LA[ii * 32]) & 0x7Fu), kb = 127u - (__builtin_bit_cast(unsigned, LB[jj * 32]) & 0x7Fu);
        EIDg[(size_t)(tb * 32 + tl) * 128 + h8 * 16 + r] = (int)(ka * 128u + kb); EGTg[(size_t)(tb * 32 + tl) * 128 + h8 * 16 + r] = ev[r] * inv; }
    }
    asm volatile("s_waitcnt vmcnt(0)" ::: "memory"); __syncthreads();
    TP_END(11, F.ws);
    const unsigned char* U8 = F.ws + WS_UB; const unsigned char* V8 = F.ws + WS_VB8;
    constexpr int NBT = 2;
#define PG_ISSUE(TAB, E) do { const int idq_ = __builtin_amdgcn_readfirstlane(eidt[(E)]); \
      __builtin_amdgcn_global_load_lds((const unsigned*)((TAB) + (size_t)idq_ * 1024 + lane * 16), (LAS unsigned*)(RB + ((E) & 7) * 1024), 16, 0, 0); } while (0)
#pragma unroll 1
    for (int tt = 0; tt < 4; ++tt) {
      const int tok = tb * 32 + wv * 4 + tt;
      LAS int* eidt = eid + tt * 128; LAS float* cgt = cg + tt * 128;
      const float rs = rsqrtf(wave_sum_dpp(lane < 32 ? SSQ[(size_t)tok * 32 + lane] : 0.f) * (1.0f / DM) + EPS);
      { const float* SCL = (const float*)(F.ws + WS_SCL);
#pragma unroll
        for (int i = 0; i < 2; ++i) { const int e = lane + 64 * i, idq = __builtin_nontemporal_load(EIDg + (size_t)tok * 128 + e);
          eidt[e] = idq; esu[e] = SCL[idq]; cgt[e] = __builtin_nontemporal_load(EGTg + (size_t)tok * 128 + e) * SCL[16384 + idq]; } }
      unsigned xw[16];
      { const bf16* xp = H1b + (size_t)tok * DM + (size_t)lane * 4;
#pragma unroll
        for (int q = 0; q < 8; ++q) { const v2u x0 = *(const v2u*)(xp + q * 256); xw[2 * q] = x0.x; xw[2 * q + 1] = x0.y; } }
      int xl[4], xh[4]; float rsx;
      { float xa = 0.f;
#pragma unroll
        for (int i = 0; i < 16; ++i) xa = fmaxf(xa, fmaxf(fabsf(bflo(xw[i])), fabsf(bfhi(xw[i]))));
#pragma unroll
        for (int o = 1; o < 64; o <<= 1) xa = fmaxf(xa, __shfl_xor(xa, o));
        const float xinv = xa > 0.f ? 119.0f / xa : 0.f; rsx = rs * (xa > 0.f ? xa * (1.0f / 119.0f) : 0.f);
#pragma unroll
        for (int d = 0; d < 4; ++d) { unsigned pl = 0u, ph = 0u;
#pragma unroll
          for (int p = 0; p < 8; ++p) { const int i = 8 * d + p; const float v = (i & 1) ? bfhi(xw[i >> 1]) : bflo(xw[i >> 1]);
            const int xi = (int)__builtin_rintf(v * xinv), l = ((xi + 8) & 15) - 8, h = (xi - l) >> 4;
            pl |= ((unsigned)l & 15u) << (4 * p); ph |= ((unsigned)h & 15u) << (4 * p); }
          xl[d] = (int)pl; xh[d] = (int)ph; } }
      asm volatile("s_waitcnt vmcnt(0) lgkmcnt(0)" ::: "memory");
#define DPPI(X, CTRL) __builtin_amdgcn_update_dpp(0, (X), (CTRL), 0xF, 0xF, true)
#define PU_BATCH(E0, DOISSUE) do { v4u ub[4]; \
        _Pragma("unroll") for (int q = 0; q < 4; ++q) ub[q] = *(const LAS v4u*)(RB + (((E0) + q) & 7) * 1024 + lane * 16); \
        asm volatile("s_waitcnt lgkmcnt(0)" ::: "memory"); \
        if (DOISSUE) { _Pragma("unroll") for (int q = 0; q < 4; ++q) PG_ISSUE(U8, (E0) + 8 + q); } \
        int a_[4]; _Pragma("unroll") for (int q = 0; q < 4; ++q) { int al_ = 0, ah_ = 0; _Pragma("unroll") for (int dd = 0; dd < 4; ++dd) { const int wa = (int)ub[q][dd]; \
            al_ = __builtin_amdgcn_sdot8(wa, xl[dd], al_, false); ah_ = __builtin_amdgcn_sdot8(wa, xh[dd], ah_, false); } a_[q] = ah_ * 16 + al_; } \
        const int r01_ = (o1 ? a_[1] : a_[0]) + DPPI(o1 ? a_[0] : a_[1], 0xB1), r23_ = (o1 ? a_[3] : a_[2]) + DPPI(o1 ? a_[2] : a_[3], 0xB1); \
        int r_ = (o2 ? r23_ : r01_) + DPPI(o2 ? r01_ : r23_, 0x4E); \
        r_ += DPPI(r_, 0x124); r_ += DPPI(r_, 0x128); \
        { auto s_ = __builtin_amdgcn_permlane16_swap((unsigned)r_, (unsigned)r_, false, false); const unsigned s0_ = s_[0], s1_ = s_[1]; r_ = (int)(s0_ + s1_); } \
        { auto s_ = __builtin_amdgcn_permlane32_swap((unsigned)r_, (unsigned)r_, false, false); const unsigned s0_ = s_[0], s1_ = s_[1]; r_ = (int)(s0_ + s1_); } \
        if (lane < 4) dqi[(E0) + lane] = r_; } while (0)
      const bool o1 = (lane & 1) != 0, o2 = (lane & 2) != 0; LAS int* dqi = (LAS int*)dq;
#pragma unroll
      for (int e = 0; e < 8; ++e) PG_ISSUE(U8, e);
#pragma unroll 1
      for (int e = 0; e < 120; e += 4) {
        asm volatile("s_waitcnt vmcnt(4)" ::: "memory");
        PU_BATCH(e, true);
        asm volatile("" ::: "memory");
      }
      asm volatile("s_waitcnt vmcnt(0)" ::: "memory");
#pragma unroll 1
      for (int e = 120; e < 128; e += 4) PU_BATCH(e, false);
      asm volatile("s_waitcnt lgkmcnt(0)" ::: "memory");
#pragma unroll
      for (int i = 0; i < 2; ++i) { const int e = lane + 64 * i; cgt[e] = gelu_erf((float)dqi[e] * (rsx * esu[e])) * cgt[e]; }
      asm volatile("s_waitcnt lgkmcnt(0)" ::: "memory");
#undef DPPI
#undef PU_BATCH
    }
#pragma unroll 1
    for (int tt = 0; tt < 4; ++tt) {
      const int tok = tb * 32 + wv * 4 + tt;
      LAS int* eidt = eid + tt * 128; LAS float* cgt = cg + tt * 128;
      float y[32];
#pragma unroll
      for (int i = 0; i < 32; ++i) y[i] = 0.f;
#define PV_BATCH(E0, DOISSUE) do { v4u vb[NBT]; float c_[NBT]; \
        _Pragma("unroll") for (int q = 0; q < NBT; ++q) { vb[q] = *(const LAS v4u*)(RB + (((E0) + q) & 7) * 1024 + lane * 16); c_[q] = cgt[(E0) + q]; } \
        asm volatile("s_waitcnt lgkmcnt(0)" ::: "memory"); \
        if (DOISSUE) { _Pragma("unroll") for (int q = 0; q < NBT; ++q) PG_ISSUE(V8, (E0) + 8 + q); } \
        _Pragma("unroll") for (int q = 0; q < NBT; ++q) { _Pragma("unroll") for (int dd = 0; dd < 4; ++dd) { const unsigned wa = vb[q][dd]; \
            { const f32x2v v2 = __builtin_amdgcn_cvt_scalef32_pk_f32_fp4(wa, 1.0f, 0); y[8 * dd + 0] += c_[q] * v2.x; y[8 * dd + 1] += c_[q] * v2.y; } \
            { const f32x2v v2 = __builtin_amdgcn_cvt_scalef32_pk_f32_fp4(wa, 1.0f, 1); y[8 * dd + 2] += c_[q] * v2.x; y[8 * dd + 3] += c_[q] * v2.y; } \
            { const f32x2v v2 = __builtin_amdgcn_cvt_scalef32_pk_f32_fp4(wa, 1.0f, 2); y[8 * dd + 4] += c_[q] * v2.x; y[8 * dd + 5] += c_[q] * v2.y; } \
            { const f32x2v v2 = __builtin_amdgcn_cvt_scalef32_pk_f32_fp4(wa, 1.0f, 3); y[8 * dd + 6] += c_[q] * v2.x; y[8 * dd + 7] += c_[q] * v2.y; } } \
          __builtin_amdgcn_sched_barrier(0); } } while (0)
#pragma unroll
      for (int e = 0; e < 8; ++e) PG_ISSUE(V8, e);
#pragma unroll 1
      for (int e = 0; e < 120; e += NBT) {
        asm volatile("s_waitcnt vmcnt(6)" ::: "memory");
        PV_BATCH(e, true);
        asm volatile("" ::: "memory");
      }
      asm volatile("s_waitcnt vmcnt(0)" ::: "memory");
      unsigned xw[16];
      { const bf16* xp = H1b + (size_t)tok * DM + (size_t)lane * 4;
#pragma unroll
        for (int q = 0; q < 8; ++q) { const v2u x0 = *(const v2u*)(xp + q * 256); xw[2 * q] = x0.x; xw[2 * q + 1] = x0.y; } }
#pragma unroll 1
      for (int e = 120; e < 128; e += NBT) PV_BATCH(e, false);
      asm volatile("s_waitcnt lgkmcnt(0)" ::: "memory");
#undef PV_BATCH
      float* drow = dst_base + (size_t)tok * DM;
#pragma unroll
      for (int q = 0; q < 8; ++q) { const size_t off = (size_t)q * 256 + lane * 4; f32x4 hv;
        hv.x = bflo(xw[2 * q]) + y[4 * q];
#ifdef TPROBE
        if (TPROBE != 13 && tok == 0 && lane == 0 && q == 0) hv.x += 10.0f + (float)(*(volatile unsigned*)(F.ws + 64)) * (0.01f / TP_DIV);
        if (TPROBE == 13 && (int)blockIdx.x == TP_BLOCK && wv == 7 && tt == 3 && lane == 0 && q == 0) hv.x += 10.0f + (float)(unsigned)(__builtin_amdgcn_s_memrealtime() - tp_p7_) * (0.01f / TP_DIV);
#endif
        hv.y = bfhi(xw[2 * q]) + y[4 * q + 1]; hv.z = bflo(xw[2 * q + 1]) + y[4 * q + 2]; hv.w = bfhi(xw[2 * q + 1]) + y[4 * q + 3]; *(f32x4*)(drow + off) = hv; }
    }
#undef PG_ISSUE
  }
}
constexpr int MISC_LDS = LDS_BYTES - 256;
__global__ void __launch_bounds__(NTHR, 2) mk_fwd(Args args) {
  extern __shared__ __attribute__((aligned(16))) unsigned char lds_raw[];
  Frame F; F.lds = (LAS unsigned char*)lds_raw; F.ws = args.ws; F.tid = threadIdx.x; F.lane = F.tid & 63; F.wave = __builtin_amdgcn_readfirstlane(F.tid >> 6);
  const int lo = args.ph_lo, hi = args.ph_hi, G = (int)gridDim.x, bx = (int)blockIdx.x;
  volatile LAS unsigned* misc = (volatile LAS unsigned*)(F.lds + MISC_LDS);
  if (F.tid < 16) misc[F.tid] = 0u;
  __syncthreads();
  XcdBarrier bar = xcd_barrier_post((unsigned*)(F.ws + WS_CTL) + CW_BAR, misc);
#define IN(k) (lo <= (k) && (k) < hi)
#ifdef TPROBE
#define SEAM(k) do { if (IN(k) && IN((k) + 1)) { const unsigned long long tq0_ = __builtin_amdgcn_s_memrealtime(); xcd_barrier(bar); const unsigned long long tq1_ = __builtin_amdgcn_s_memrealtime(); \
    if (TPROBE == 20 + (k) && (int)blockIdx.x == TP_BLOCK && threadIdx.x == 0) atomicAdd((unsigned*)(F.ws + 64), (unsigned)(tq1_ - tq0_)); } } while (0)
#else
#define SEAM(k) do { if (IN(k) && IN((k) + 1)) xcd_barrier(bar); } while (0)
#endif
#define PHASE_FRAME(Fp) Frame Fp = F; asm volatile("" : "+v"(Fp.tid), "+v"(Fp.lane))
  const int NA = G;
  if (IN(0)) { PHASE_FRAME(F0); TP_BEGIN(1);
#ifdef SLEEP_START
#pragma unroll 1
    for (int i_ = 0; i_ < SLEEP_START; ++i_) __builtin_amdgcn_s_sleep(127);
#endif
    p0_lam(F0, args);
    p0_zero_vpad(F0);
    p0_rows(F0, args);
    p0_transpose<true>(F0, args, args.in[IN_WIN], DPROJ, NPROJ, (bf16*)(F.ws + WS_W1T));
    p0_transpose<false>(F0, args, args.in[IN_WOUT], DM, DM, (bf16*)(F.ws + WS_W2T));
    p0_w3t(F0, args);
    p0_tables(F0, args);
#ifdef DUP_ROWS
    p0_rows(F0, args);
#endif
#ifdef DUP_TR
    p0_transpose<true>(F0, args, args.in[IN_WIN], DPROJ, NPROJ, (bf16*)(F.ws + WS_W1T));
    p0_transpose<false>(F0, args, args.in[IN_WOUT], DM, DM, (bf16*)(F.ws + WS_W2T));
#endif
#ifdef DUP_W3T
    p0_w3t(F0, args);
#endif
#ifdef DUP_TAB
    p0_tables(F0, args);
#endif
    TP_END(1, F.ws);
  }
  SEAM(0);
  if (IN(1)) { PHASE_FRAME(F1); TP_BEGIN(2);
    p1_meta_finalize(F1, args);
    pg8::Gemm g{(const pg8::bf16_t*)(F.ws + WS_XN), (const pg8::bf16_t*)(F.ws + WS_W1T), MROWS, NPROJ, DM};
    pg8::StaticOrder S; S.init(MROWS, NPROJ, G, bx);
    EpiProj E{(bf16*)(F.ws + WS_Q), (bf16*)(F.ws + WS_KP), (bf16*)(F.ws + WS_VP), (bf16*)(F.ws + WS_MQ), (bf16*)(F.ws + WS_MK), (bf16*)(F.ws + WS_MV), (bf16*)(F.ws + WS_MO),
              args.in[IN_QNG], args.in[IN_KNG], (LAS float*)(F.lds + XCH_OFF)};
    pg8::gemm_phase<EpiProj, pg8::StaticOrder, true, true>(F.lds + RING_OFF, g, S, E);
    TP_END(2, F.ws);
  }
  SEAM(1);
  if (IN(2)) {
    PHASE_FRAME(F2);
    TP_BEGIN(3);
    att::phase(F2, (G % 8 == 0) ? (bx & 7) * (G >> 3) + (bx >> 3) : bx, NA);
    TP_END(3, F.ws); TP_BEGIN(4);
    for (int task = bx; task < 512; task += G) ml::taskA(F2, args, task);
    TP_END(4, F.ws);
  }
  SEAM(2);
  if (IN(3)) { PHASE_FRAME(F3); TP_BEGIN(5); ml::scanB(F3); TP_END(5, F.ws); TP_BEGIN(6); p3_combine(F3, args, NA); TP_END(6, F.ws);
#ifdef DUP_SCAN
    ml::scanB(F3);
#endif
#ifdef DUP_COMB
    p3_combine(F3, args, NA);
#endif
  }
  SEAM(3);
  if (IN(4)) {
    PHASE_FRAME(F4);
    TP_BEGIN(7);
    for (int task = bx; task < 512; task += G) ml::taskC(F4, args, task);
    TP_END(7, F.ws);
  }
  SEAM(4);
  if (IN(5)) { TP_BEGIN(8);
    pg8::Gemm g{(const pg8::bf16_t*)(F.ws + WS_A2), (const pg8::bf16_t*)(F.ws + WS_W2T), MROWS, DM, DM};
    pg8::StaticOrder S; S.init(MROWS, DM, G, bx);
    EpiRes E{args.in[IN_X], args.out, (bf16*)(F.ws + WS_H1B), (float*)(F.ws + WS_SSQ)};
    pg8::gemm_phase<EpiRes, pg8::StaticOrder, true, true>(F.lds + RING_OFF, g, S, E);
    TP_END(8, F.ws);
  }
  SEAM(5);
  if (IN(6)) { TP_BEGIN(9);
    pg8::Gemm g{(const pg8::bf16_t*)(F.ws + WS_H1B), (const pg8::bf16_t*)(F.ws + WS_W3T), MROWS, DM, DM};
    pg8::StaticOrder S; S.init(MROWS, DM, G, bx);
    LAS float* rst = (LAS float*)(F.lds + XCH_OFF);
    { pg8::Unit u0; if (S.next(0, u0)) { if (F.tid < 256) { const float* sp = (const float*)(F.ws + WS_SSQ) + ((size_t)u0.pm * 256 + F.tid) * 32; float s = 0.f;
#pragma unroll
          for (int i = 0; i < 8; ++i) { const f32x4 v = ((const f32x4*)sp)[i]; s += (v.x + v.y) + (v.z + v.w); }
          rst[F.tid] = rsqrtf(s * (1.0f / DM) + EPS); } } }
    __syncthreads();
    EpiScore E{(float*)(F.ws + WS_S), rst};
    pg8::gemm_phase<EpiScore, pg8::StaticOrder, true, true>(F.lds + RING_OFF, g, S, E);
    TP_END(9, F.ws);
  }
  SEAM(6);
  if (IN(7)) { PHASE_FRAME(F7); TP_BEGIN(10); p6_peer(F7, args, args.out); TP_END(10, F.ws); }
#undef IN
#undef SEAM
}
extern "C" void kernel_launch(void* const* d_in, const int* in_sizes, int n_in, void* d_out, int out_size, void* d_ws, size_t ws_size, hipStream_t stream) {
  static int grid = 0;
  if (grid == 0) {
    int dev = 0, cus = 0, per_cu = 0;
    if (hipGetDevice(&dev) != hipSuccess || hipDeviceGetAttribute(&cus, hipDeviceAttributeMultiprocessorCount, dev) != hipSuccess) { fprintf(stderr, "device query failed\n"); grid = -1; return; }
    if (hipFuncSetAttribute((const void*)mk_fwd, hipFuncAttributeMaxDynamicSharedMemorySize, LDS_BYTES) != hipSuccess) { fprintf(stderr, "hipFuncSetAttribute failed\n"); grid = -1; return; }
    if (hipOccupancyMaxActiveBlocksPerMultiprocessor(&per_cu, (const void*)mk_fwd, NTHR, LDS_BYTES) != hipSuccess || per_cu < 1) { fprintf(stderr, "occupancy query says %d workgroups per CU: not launching\n", per_cu); (void)hipGetLastError(); grid = -1; return; }
    (void)hipGetLastError();
    grid = cus;
    if (n_in != 22 || ws_size < (size_t)512 * MiB || out_size != MROWS * DM) { fprintf(stderr, "unexpected shapes: n_in %d out %d ws %zu\n", n_in, out_size, ws_size); grid = -1; return; }
  }
  if (grid < 0) return;
  unsigned char* ws = (unsigned char*)d_ws;
  if (hipMemsetAsync(ws + WS_CTL, 0, CTL_ZERO_BYTES, stream) != hipSuccess) { fprintf(stderr, "memset failed\n"); return; }
  Args a{};
  for (int i = 0; i < 22; ++i) a.in[i] = (const float*)d_in[i];
  a.out = (float*)d_out; a.ws = ws; a.na = 0; a.pad = 0;
  a.ph_lo = 0; a.ph_hi = 8;
  hipLaunchKernelGGL(mk_fwd, dim3(grid), dim3(NTHR), LDS_BYTES, stream, a);
}
```

```cpp
#include <hip/hip_runtime.h>
#include <cstdio>
#include <cstdint>
#include <math.h>
namespace pg8 {
#define PG8_LAS __attribute__((address_space(3)))
typedef unsigned short bf16_t;
typedef short bf16x8 __attribute__((ext_vector_type(8)));
typedef float f32x4 __attribute__((ext_vector_type(4)));
typedef unsigned u32x4 __attribute__((ext_vector_type(4)));
constexpr int BM = 256, BK = 64, HALF = 128, HTB = HALF * BK * 2  , STAGE_BYTES = 8 * HTB, NXCD = 8, WGM = 8;

__host__ __device__ __forceinline__ int lds_byte(int r, int c) { const int st = (r >> 4) * 2 + (c >> 5), rr = r & 15, cc = c & 31, ob = rr * 64 + cc * 2; return st * 1024 + (ob ^ (((ob >> 9) & 1) << 5)); }
__host__ __device__ __forceinline__ void stage_rc(int b, int& R, int& C) { const int st = b / 1024, sb = b % 1024, swz = sb ^ (((sb >> 9) & 1) << 5); R = (st >> 1) * 16 + swz / 64; C = (st & 1) * 32 + (swz % 64) / 2; }
__host__ __device__ __forceinline__ int perm32(int rho) { const int n = rho >> 4, i = rho & 15; return 8 * (i >> 2) + 4 * n + (i & 3); }

struct Unit { int pm, pn; };
struct Gemm { const bf16_t* A; const bf16_t* Bt; int M, N, K; };

struct StaticOrder {
    int nM, nN, nwg, G, c;
    __host__ __device__ void init(int M, int N, int G_, int c_) { nM = M / BM; nN = N / BM; nwg = nM * nN; G = G_; c = c_; }
    __host__ __device__ bool next(int i, Unit& u) const {
        const long L = (long)i * G + c; if (L >= nwg) return false;
        int wgid = (int)L; { const int q = nwg / NXCD, r = nwg % NXCD, xcd = wgid % NXCD, off = wgid / NXCD; wgid = (xcd < r ? xcd * (q + 1) : r * (q + 1) + (xcd - r) * q) + off; }
        const int nig = WGM * nN, gid = wgid / nig, fm = gid * WGM, gsz = (nM - fm) < WGM ? (nM - fm) : WGM;
        u.pm = fm + ((wgid % nig) % gsz); u.pn = (wgid % nig) / gsz; return true;
    }
    __device__ __forceinline__ void a_ready(const Unit&) const {}
    __device__ __forceinline__ void done(const Unit&) const {}
};

__device__ __forceinline__ unsigned cvt_pk_bf16(float lo, float hi) { unsigned r; asm volatile("v_cvt_pk_bf16_f32 %0, %1, %2" : "=v"(r) : "v"(lo), "v"(hi)); return r; }
typedef float f32x2 __attribute__((ext_vector_type(2)));
template <class Epi, class Sched, bool ALIGN_EPI = false, bool SP2 = false>
__device__ __forceinline__ void gemm_phase(PG8_LAS unsigned char* lds, const Gemm g, const Sched& S, const Epi& E) {
    int tid_ = threadIdx.x; asm volatile("" : "+v"(tid_));
    const int tid = tid_, wid = __builtin_amdgcn_readfirstlane(tid >> 6), lane = tid & 63, wr = wid >> 2, wc = wid & 3, fr = lane & 15, fq = lane >> 4;
    const int K = g.K, nt = K / BK;
    unsigned voffA[2], voffB[2];
#pragma unroll
    for (int i = 0; i < 2; ++i) { int R, C; stage_rc(tid * 16 + i * 8192, R, C); const int Rb = Epi::PERM ? ((R & ~31) + perm32(R & 31)) : R;
        voffA[i] = (unsigned)(R * K + C) * 2u; voffB[i] = (unsigned)(Rb * K + C) * 2u; }
    const size_t kstep = (size_t)(BK * 2);
    const size_t hstep = (size_t)HALF * K * 2;
    const size_t tstep = 2 * hstep;
    const unsigned ldsw = (unsigned)wid * 1024u;
    const int aoff = lds_byte(wr * 64 + fr, fq * 8), boff = lds_byte(wc * 32 + fr, fq * 8);
#define PG8_SA(b, h) (((b) * 2 + (h)) * HTB)
#define PG8_SB(b, h) ((4 + (b) * 2 + (h)) * HTB)
#define PG8_STAGE(bufoff, gbase, voff) do { _Pragma("unroll") for (int _i = 0; _i < 2; ++_i) \
        __builtin_amdgcn_global_load_lds((const unsigned*)((const char*)(gbase) + (voff)[_i]), (PG8_LAS unsigned*)(lds + (bufoff) + ldsw + _i * 8192), 16, 0, 0); } while (0)
#define PG8_LDA(dst, b, h) do { _Pragma("unroll") for (int m = 0; m < 4; ++m) _Pragma("unroll") for (int k = 0; k < 2; ++k) dst[m][k] = *(const PG8_LAS bf16x8*)(lds + PG8_SA(b, h) + aoff + m * 2048 + k * 1024); } while (0)
#define PG8_LDB(dst, b, h) do { _Pragma("unroll") for (int n = 0; n < 2; ++n) _Pragma("unroll") for (int k = 0; k < 2; ++k) dst[n][k] = *(const PG8_LAS bf16x8*)(lds + PG8_SB(b, h) + boff + n * 2048 + k * 1024); } while (0)
#define PG8_MMA(ai, bj, At, Bt) do { __builtin_amdgcn_s_setprio(1); _Pragma("unroll") for (int m = 0; m < 4; ++m) _Pragma("unroll") for (int n = 0; n < 2; ++n) _Pragma("unroll") for (int k = 0; k < 2; ++k) \
        acc[ai][bj][m][n] = __builtin_amdgcn_mfma_f32_16x16x32_bf16(Bt[n][k], At[m][k], acc[ai][bj][m][n], 0, 0, 0); __builtin_amdgcn_s_setprio(0); } while (0)
#define PG8_WAIT_V(n) asm volatile("s_waitcnt vmcnt(" #n ")" ::: "memory")
#define PG8_WAIT_L(n) asm volatile("s_waitcnt lgkmcnt(" #n ")" ::: "memory")
#define PG8_BAR __builtin_amdgcn_s_barrier()
#define PG8_SCHED __builtin_amdgcn_sched_barrier(0)
    Unit cur, nxt; int ui = 0;
    if (!S.next(0, cur)) return;
    f32x4 acc[2][2][4][2];
#pragma unroll
    for (int a = 0; a < 2; ++a)
#pragma unroll
        for (int b = 0; b < 2; ++b)
#pragma unroll
            for (int m = 0; m < 4; ++m)
#pragma unroll
                for (int n = 0; n < 2; ++n) acc[a][b][m][n] = (f32x4){0.f, 0.f, 0.f, 0.f};
    bf16x8 At[4][2], B0[2][2], B1[2][2];
    const char* cA = (const char*)g.A + (size_t)cur.pm * tstep; const char* cB = (const char*)g.Bt + (size_t)cur.pn * tstep;
    S.a_ready(cur);
    if constexpr (SP2) {
        PG8_STAGE(PG8_SB(0, 0), cB, voffB); PG8_STAGE(PG8_SB(0, 1), cB + hstep, voffB); PG8_STAGE(PG8_SA(0, 0), cA, voffA); PG8_STAGE(PG8_SA(0, 1), cA + hstep, voffA);
        if (wr == 1) PG8_BAR;
        PG8_WAIT_V(2); PG8_BAR;
        PG8_STAGE(PG8_SB(1, 0), cB + kstep, voffB); PG8_STAGE(PG8_SA(1, 0), cA + kstep, voffA); PG8_STAGE(PG8_SB(1, 1), cB + hstep + kstep, voffB);
        PG8_WAIT_V(6); PG8_BAR;
    } else {
        PG8_STAGE(PG8_SB(0, 0), cB, voffB); PG8_STAGE(PG8_SA(0, 0), cA, voffA); PG8_STAGE(PG8_SB(0, 1), cB + hstep, voffB); PG8_STAGE(PG8_SA(0, 1), cA + hstep, voffA);
        if (wr == 1) PG8_BAR;
        PG8_WAIT_V(4); PG8_BAR;
        PG8_STAGE(PG8_SB(1, 0), cB + kstep, voffB); PG8_STAGE(PG8_SA(1, 0), cA + kstep, voffA); PG8_STAGE(PG8_SB(1, 1), cB + hstep + kstep, voffB);
        PG8_WAIT_V(6); PG8_BAR;
    }
    for (;;) {
        const bool has_next = S.next(ui + 1, nxt);
        const char* nA = has_next ? (const char*)g.A + (size_t)nxt.pm * tstep : cA; const char* nB = has_next ? (const char*)g.Bt + (size_t)nxt.pn * tstep : cB;
        for (int t = 0; t < nt; t += 2) {
            const bool last = (t == nt - 2);
            const char* a1 = cA + (size_t)(t + 1) * kstep;
            const char* a2 = last ? nA : cA + (size_t)(t + 2) * kstep; const char* b2 = last ? nB : cB + (size_t)(t + 2) * kstep;
            const char* a3 = a2 + kstep; const char* b3 = b2 + kstep;
            if (last && has_next) S.a_ready(nxt);
            if constexpr (SP2) {
            PG8_LDB(B0, 0, 0); PG8_LDB(B1, 0, 1); PG8_SCHED; PG8_LDA(At, 0, 0); PG8_STAGE(PG8_SA(1, 1), a1 + hstep, voffA);
            PG8_WAIT_V(8); PG8_WAIT_L(0); PG8_BAR; PG8_MMA(0, 0, At, B0); PG8_MMA(0, 1, At, B1); PG8_BAR; PG8_SCHED;
            PG8_LDA(At, 0, 1); PG8_STAGE(PG8_SB(0, 0), b2, voffB); PG8_STAGE(PG8_SB(0, 1), b2 + hstep, voffB); PG8_STAGE(PG8_SA(0, 0), a2, voffA);
            PG8_WAIT_V(8); PG8_WAIT_L(0); PG8_BAR; PG8_MMA(1, 0, At, B0); PG8_MMA(1, 1, At, B1); PG8_BAR; PG8_SCHED;
            PG8_LDB(B0, 1, 0); PG8_LDB(B1, 1, 1); PG8_SCHED; PG8_LDA(At, 1, 0); PG8_STAGE(PG8_SA(0, 1), a2 + hstep, voffA);
            PG8_WAIT_V(8); PG8_WAIT_L(0); PG8_BAR; PG8_MMA(0, 0, At, B0); PG8_MMA(0, 1, At, B1); PG8_BAR; PG8_SCHED;
            PG8_LDA(At, 1, 1); PG8_STAGE(PG8_SB(1, 0), b3, voffB); PG8_STAGE(PG8_SB(1, 1), b3 + hstep, voffB); PG8_STAGE(PG8_SA(1, 0), a3, voffA);
            PG8_WAIT_V(8); PG8_WAIT_L(0); PG8_BAR; PG8_MMA(1, 0, At, B0); PG8_MMA(1, 1, At, B1); PG8_BAR; PG8_SCHED;
            } else {
            PG8_LDB(B0, 0, 0); PG8_SCHED; PG8_LDA(At, 0, 0); PG8_STAGE(PG8_SA(1, 1), a1 + hstep, voffA);
            PG8_WAIT_L(8); PG8_BAR; PG8_WAIT_L(0); PG8_MMA(0, 0, At, B0); PG8_BAR; PG8_SCHED;
            PG8_LDB(B1, 0, 1); PG8_STAGE(PG8_SB(0, 0), b2, voffB);
            PG8_BAR; PG8_WAIT_L(0); PG8_MMA(0, 1, At, B1); PG8_BAR;
            PG8_LDA(At, 0, 1); PG8_STAGE(PG8_SA(0, 0), a2, voffA);
            PG8_BAR; PG8_WAIT_L(0); PG8_MMA(1, 0, At, B0); PG8_BAR; PG8_SCHED;
            PG8_STAGE(PG8_SB(0, 1), b2 + hstep, voffB);
            PG8_WAIT_V(6); PG8_BAR; PG8_MMA(1, 1, At, B1); PG8_BAR;
            PG8_LDB(B0, 1, 0); PG8_SCHED; PG8_LDA(At, 1, 0); PG8_STAGE(PG8_SA(0, 1), a2 + hstep, voffA);
            PG8_WAIT_L(8); PG8_BAR; PG8_WAIT_L(0); PG8_MMA(0, 0, At, B0); PG8_BAR; PG8_SCHED;
            PG8_LDB(B1, 1, 1); PG8_STAGE(PG8_SB(1, 0), b3, voffB);
            PG8_BAR; PG8_WAIT_L(0); PG8_MMA(0, 1, At, B1); PG8_BAR;
            PG8_LDA(At, 1, 1); PG8_STAGE(PG8_SA(1, 0), a3, voffA);
            PG8_BAR; PG8_WAIT_L(0); PG8_MMA(1, 0, At, B0); PG8_BAR; PG8_SCHED;
            PG8_STAGE(PG8_SB(1, 1), b3 + hstep, voffB);
            PG8_WAIT_V(6); PG8_BAR; PG8_MMA(1, 1, At, B1); PG8_BAR;
            }
        }
        if constexpr (ALIGN_EPI) { if (wr == 0) PG8_BAR; }
        if constexpr (!Epi::AFTER_DRAIN) { E(acc, cur, wr, wc, fr, fq); S.done(cur); }
        if (!has_next) break;
#pragma unroll
        for (int a = 0; a < 2; ++a)
#pragma unroll
            for (int b = 0; b < 2; ++b)
#pragma unroll
                for (int m = 0; m < 4; ++m)
#pragma unroll
                    for (int n = 0; n < 2; ++n) acc[a][b][m][n] = (f32x4){0.f, 0.f, 0.f, 0.f};
        cur = nxt; cA = nA; cB = nB; ++ui;
        if constexpr (ALIGN_EPI) { if (wr == 1) PG8_BAR; }
    }
    PG8_WAIT_V(0);
    if constexpr (!ALIGN_EPI) { if (wr == 0) PG8_BAR; }
    PG8_BAR;
    if constexpr (Epi::AFTER_DRAIN) { E.fused(acc, cur, wr, wc, fr, fq, lds, wid, lane); S.done(cur); }
#undef PG8_SA
#undef PG8_SB
#undef PG8_STAGE
#undef PG8_LDA
#undef PG8_LDB
#undef PG8_MMA
#undef PG8_WAIT_V
#undef PG8_WAIT_L
#undef PG8_BAR
#undef PG8_SCHED
}
}
#define GAS __attribute__((address_space(1)))
#define LAS __attribute__((address_space(3)))
typedef unsigned short bf16;
typedef unsigned v4u __attribute__((ext_vector_type(4)));
typedef unsigned v2u __attribute__((ext_vector_type(2)));
typedef float f32x4 __attribute__((ext_vector_type(4)));
typedef short bf16x8 __attribute__((ext_vector_type(8)));
#define LDS_WAIT() asm volatile("s_waitcnt lgkmcnt(0)" ::: "memory")
#define VM_WAIT() asm volatile("s_waitcnt vmcnt(0)" ::: "memory")

constexpr int DM = 2048, NB = 4, SEQ = 2048, NMETA = 16, MROWS = NB * SEQ, DPROJ = 6152, NPROJ = 6144;
constexpr int PADT = 2112, POS0 = 64, MPOS0 = 48;
constexpr float EPS = 1e-6f;
constexpr float LOG2E = 1.4426950408889634f;
constexpr float QSCALE = 0.08838834764831845f * LOG2E;
constexpr int NWAVES = 8, NTHR = 512;

constexpr size_t MiB = 1u << 20;
constexpr size_t WS_CTL = 0, CTL_ZERO_BYTES = 32 * 1024;
constexpr size_t WS_PM = 484 * MiB;
constexpr size_t WS_W1T = 2 * MiB, WS_W2T = 26 * MiB, WS_W3T = 34 * MiB, WS_XN = 42 * MiB;
constexpr size_t WS_Q = 74 * MiB, WS_KP = 90 * MiB, WS_VP = 107 * MiB, WS_MQ = 124 * MiB, WS_MK = 133 * MiB, WS_MV = 142 * MiB, WS_MO = 159 * MiB;
constexpr size_t WS_SMALL = 175 * MiB;
constexpr size_t WS_XM = WS_SMALL, WS_LI = WS_SMALL + 128 * 1024, WS_LF = WS_SMALL + 384 * 1024, WS_LAM = WS_SMALL + 640 * 1024;
constexpr size_t WS_PO = 176 * MiB, WS_ML = 304 * MiB, WS_HM = 305 * MiB, WS_A2 = 42 * MiB, WS_H1B = 74 * MiB, WS_SSQ = 106 * MiB, WS_S = 176 * MiB, WS_UB = 384 * MiB, WS_VB = 448 * MiB;
constexpr size_t WS_SCL = WS_SMALL + 704 * 1024;
constexpr size_t WS_VB8 = WS_UB + 32 * MiB;
constexpr size_t WS_DC = 305 * MiB, WS_CS = 448 * MiB, WS_DN = 482 * MiB, WS_NS = WS_DN + 512 * 1024, WS_GS = WS_DN + 1024 * 1024, WS_MS = WS_DN + 1152 * 1024;
constexpr size_t WS_EID = 240 * MiB, WS_EGT = 244 * MiB;
constexpr int CW_BAR = 4096;

constexpr int RING_OFF = 0, RING_BYTES = 131072;
constexpr int XCH_OFF = 131072;
constexpr int MISC_OFF = XCH_OFF + 8192;
constexpr int LDS_BYTES = 155648;

__device__ __forceinline__ unsigned f2bf(float f) { unsigned u = __builtin_bit_cast(unsigned, f); return (u + 0x7fffu + ((u >> 16) & 1u)) >> 16; }
__device__ __forceinline__ unsigned pk2(float lo, float hi) { return f2bf(lo) | (f2bf(hi) << 16); }
__device__ __forceinline__ float bf2f(unsigned short u) { return __builtin_bit_cast(float, (unsigned)u << 16); }
__device__ __forceinline__ float bflo(unsigned w) { return __builtin_bit_cast(float, w << 16); }
__device__ __forceinline__ float bfhi(unsigned w) { return __builtin_bit_cast(float, w & 0xffff0000u); }
__device__ __forceinline__ float wave_sum(float v) {
#pragma unroll
  for (int o = 1; o < 64; o <<= 1) v += __shfl_xor(v, o);
  return v;
}
__device__ __forceinline__ size_t kp_off(int bhm, int pos, int d) { const int j = pos >> 6, row = pos & 63, d0 = d >> 4, hi = (d >> 3) & 1;
  return ((size_t)(bhm * 33 + j) * 8 + d0) * 1024 + (size_t)((((row << 1) | hi) ^ ((row >> 3) & 1)) << 3) + (d & 7); }
__device__ __forceinline__ float wave_sum_dpp(float v) {
  v += __builtin_bit_cast(float, __builtin_amdgcn_update_dpp(0, __builtin_bit_cast(int, v), 0xB1, 0xF, 0xF, true));
  v += __builtin_bit_cast(float, __builtin_amdgcn_update_dpp(0, __builtin_bit_cast(int, v), 0x4E, 0xF, 0xF, true));
  v += __builtin_bit_cast(float, __builtin_amdgcn_update_dpp(0, __builtin_bit_cast(int, v), 0x141, 0xF, 0xF, true));
  v += __builtin_bit_cast(float, __builtin_amdgcn_update_dpp(0, __builtin_bit_cast(int, v), 0x140, 0xF, 0xF, true));
  const float r0 = __builtin_bit_cast(float, __builtin_amdgcn_readlane(__builtin_bit_cast(int, v), 0)), r1 = __builtin_bit_cast(float, __builtin_amdgcn_readlane(__builtin_bit_cast(int, v), 16));
  const float r2 = __builtin_bit_cast(float, __builtin_amdgcn_readlane(__builtin_bit_cast(int, v), 32)), r3 = __builtin_bit_cast(float, __builtin_amdgcn_readlane(__builtin_bit_cast(int, v), 48));
  return (r0 + r1) + (r2 + r3);
}
__device__ __forceinline__ float sigmoidf_(float x) { return 1.0f / (1.0f + __expf(-x)); }

#ifdef TPROBE
#ifndef TP_BLOCK
#define TP_BLOCK 0
#endif
#ifndef TP_DIV
#define TP_DIV 1.0f
#endif
#define TP_BEGIN(id) unsigned long long tp_t0_##id = 0; do { if (TPROBE == (id)) tp_t0_##id = __builtin_amdgcn_s_memrealtime(); } while (0)
#define TP_END(id, WS) do { if (TPROBE == (id)) { const unsigned long long t1_ = __builtin_amdgcn_s_memrealtime(); if ((int)blockIdx.x == TP_BLOCK && threadIdx.x == 0) atomicAdd((unsigned*)((WS) + 64), (unsigned)(t1_ - tp_t0_##id)); } } while (0)
#else
#define TP_BEGIN(id)
#define TP_END(id, WS)
#endif
#define XB_TMO      128
#define XB_XCNT(j)  (256  + 64 * (j))
#define XB_XSUB(j)  (1280 + 64 * (j))
#define XB_XGEN(j)  (2304 + 64 * (j))
#define XB_TOP      3328
#define XB_TOPGEN   3392
#define XCD_BAR_WORDS 3456
#define XB_SPIN_CAP (1u << 18)

__device__ __forceinline__ unsigned xb_ld(unsigned* p)              { return __hip_atomic_load(p, __ATOMIC_RELAXED, __HIP_MEMORY_SCOPE_AGENT); }
__device__ __forceinline__ unsigned xb_add(unsigned* p, unsigned v) { return __hip_atomic_fetch_add(p, v, __ATOMIC_RELAXED, __HIP_MEMORY_SCOPE_AGENT); }
__device__ __forceinline__ unsigned xb_xcc_id() { return (unsigned)__builtin_amdgcn_s_getreg((3 << 11) | 20) & 0xFu; }
#define XB_SPIN(cond, bar) do { unsigned _sp = 0; while (cond) { __builtin_amdgcn_s_sleep(1); \
    if ((++_sp & 255u) == 0u) { if (xb_ld(&(bar)[XB_TMO])) break; if (_sp > XB_SPIN_CAP) { atomicAdd(&(bar)[XB_TMO], 1u); break; } } } } while (0)

struct XcdBarrier {
    unsigned* bar; unsigned x;
    volatile LAS unsigned* st;
};

__device__ __forceinline__ XcdBarrier xcd_barrier_post(unsigned* bar, volatile LAS unsigned* st) {
    XcdBarrier b; b.bar = bar; b.x = xb_xcc_id(); b.st = st;
    if (threadIdx.x == 0) (void)xb_add(&bar[XB_XCNT(b.x)], 1u);
    return b;
}
__device__ __forceinline__ void xcd_barrier_complete(unsigned* bar, unsigned x, unsigned& nloc, unsigned& nx) {
    const unsigned G = gridDim.x * gridDim.y * gridDim.z;
    unsigned sum, cnt, mine, sp = 0u;
    for (;;) {
        sum = 0u; cnt = 0u; mine = 0u;
#pragma unroll
        for (unsigned j = 0; j < 16; ++j) { const unsigned c = xb_ld(&bar[XB_XCNT(j)]); sum += c; cnt += (c > 0u) ? 1u : 0u; mine = (j == x) ? c : mine; }
        if (sum == G) break;
        __builtin_amdgcn_s_sleep(1);
        if ((++sp & 255u) == 0u) { if (xb_ld(&bar[XB_TMO])) break; if (sp > XB_SPIN_CAP) { atomicAdd(&bar[XB_TMO], 1u); break; } }
    }
    nloc = mine > 0u ? mine : 1u; nx = cnt > 0u ? cnt : 1u;
}

__device__ __forceinline__ void xcd_barrier(const XcdBarrier& b) {
    asm volatile("s_waitcnt vmcnt(0)" ::: "memory");
    __syncthreads();
    if (threadIdx.x == 0) {
        unsigned* bar = b.bar;
        __builtin_amdgcn_s_waitcnt(0);
        unsigned nloc = b.st[0], nx = b.st[1];
        if (nloc == 0u) { xcd_barrier_complete(bar, b.x, nloc, nx); b.st[0] = nloc; b.st[1] = nx; }
        const unsigned old = xb_add(&bar[XB_XSUB(b.x)], 1u);
        const unsigned gen = old / nloc;
        if (old + 1u == (gen + 1u) * nloc) {
            __builtin_amdgcn_fence(__ATOMIC_RELEASE, "agent");
            asm volatile("s_waitcnt vmcnt(0)" ::: "memory");
            const unsigned og = xb_add(&bar[XB_TOP], 1u);
            const unsigned tg = og / nx;
            if (og + 1u == (tg + 1u) * nx) xb_add(&bar[XB_TOPGEN], 1u);
            else XB_SPIN(xb_ld(&bar[XB_TOPGEN]) == tg, bar);
            __builtin_amdgcn_fence(__ATOMIC_ACQUIRE, "agent");
            xb_add(&bar[XB_XGEN(b.x)], 1u);
            asm volatile("s_waitcnt vmcnt(0)" ::: "memory");
        } else {
            XB_SPIN(xb_ld(&bar[XB_XGEN(b.x)]) == gen, bar);
            __builtin_amdgcn_fence(__ATOMIC_ACQUIRE, "agent");
            asm volatile("s_waitcnt vmcnt(0)" ::: "memory");
        }
    }
    __syncthreads();
}

struct Args { const float* in[22]; float* out; unsigned char* ws; int ph_lo, ph_hi, na, pad; };
struct Frame {
  LAS unsigned char* lds; unsigned char* ws; int tid, lane, wave; const float* const* in;
};
#define IN_X 0
#define IN_META 1
#define IN_G1 2
#define IN_WIN 3
#define IN_CW 4
#define IN_CB 5
#define IN_IGB 6
#define IN_FGB 7
#define IN_LQ1 8
#define IN_LK1 9
#define IN_LQ2 10
#define IN_LK2 11
#define IN_QNG 12
#define IN_KNG 13
#define IN_SUBG 14
#define IN_OUTG 15
#define IN_WOUT 16
#define IN_G2 17
#define IN_WQ 18
#define IN_SUBK 19
#define IN_U 20
#define IN_V 21

__device__ __forceinline__ void p0_rows(const Frame& F, const Args& a) {
  const float* x = a.in[IN_X]; const float* meta = a.in[IN_META]; const float* g1 = a.in[IN_G1]; const float* w_in = a.in[IN_WIN];
  const float* igb = a.in[IN_IGB]; const float* fgb = a.in[IN_FGB];
  bf16* Xn = (bf16*)(F.ws + WS_XN); bf16* Xm = (bf16*)(F.ws + WS_XM); float* LI = (float*)(F.ws + WS_LI); float* LF = (float*)(F.ws + WS_LF);
  LAS f32x4* wgl = (LAS f32x4*)(F.lds);
  for (int e = F.tid; e < 4096; e += NTHR) {
    const int ln = e & 63, q = e >> 6, half = q & 1, j = (q >> 1) & 3, i = q >> 3;
    const int k = 4 * (i * 64 + ln) + j;
    wgl[e] = *(const f32x4*)(w_in + (size_t)k * DPROJ + NPROJ + 4 * half);
  }
  __syncthreads();
  const int gw = blockIdx.x * NWAVES + F.wave, NGW = gridDim.x * NWAVES, lane = F.lane;
  constexpr int NTASK = MROWS / 2 + NMETA / 2;
  f32x4 xnx[2][8];
  if (gw < NTASK) { const float* sn = (gw >= MROWS / 2 ? meta + (size_t)(gw - MROWS / 2) * 2 * DM : x + (size_t)gw * 2 * DM);
#pragma unroll
    for (int i = 0; i < 8; ++i) { xnx[0][i] = ((const f32x4*)sn)[i * 64 + lane]; xnx[1][i] = ((const f32x4*)(sn + DM))[i * 64 + lane]; } }
  f32x4 g1v[8];
#pragma unroll
  for (int i = 0; i < 8; ++i) g1v[i] = ((const f32x4*)g1)[i * 64 + lane];
  for (int task = gw; task < NTASK; task += NGW) {
    const bool ismeta = task >= MROWS / 2;
    const int r0 = ismeta ? (task - MROWS / 2) * 2 : task * 2;
    f32x4 xv[2][8]; float rs[2];
    { float s0 = 0.f, s1 = 0.f;
#pragma unroll
      for (int i = 0; i < 8; ++i) { xv[0][i] = xnx[0][i]; xv[1][i] = xnx[1][i]; }
      { const int tn = task + NGW; if (tn < NTASK) { const float* sn = (tn >= MROWS / 2 ? meta + (size_t)(tn - MROWS / 2) * 2 * DM : x + (size_t)tn * 2 * DM);
#pragma unroll
          for (int i = 0; i < 8; ++i) { xnx[0][i] = ((const f32x4*)sn)[i * 64 + lane]; xnx[1][i] = ((const f32x4*)(sn + DM))[i * 64 + lane]; } } }
#pragma unroll
      for (int i = 0; i < 8; ++i) { const f32x4 a0 = xv[0][i], a1 = xv[1][i];
        s0 += (a0.x * a0.x + a0.y * a0.y) + (a0.z * a0.z + a0.w * a0.w); s1 += (a1.x * a1.x + a1.y * a1.y) + (a1.z * a1.z + a1.w * a1.w); }
      rs[0] = rsqrtf(wave_sum_dpp(s0) * (1.0f / DM) + EPS); rs[1] = rsqrtf(wave_sum_dpp(s1) * (1.0f / DM) + EPS); }
    float ga[2][8];
#pragma unroll
    for (int rr = 0; rr < 2; ++rr)
#pragma unroll
      for (int g = 0; g < 8; ++g) ga[rr][g] = 0.f;
    bf16* dst0 = (ismeta ? Xm : Xn) + (size_t)r0 * DM;
#pragma unroll
    for (int i = 0; i < 8; ++i) {
      const f32x4 g = g1v[i];
      f32x4 xn[2];
#pragma unroll
      for (int rr = 0; rr < 2; ++rr) { xn[rr] = xv[rr][i] * g * rs[rr];
        v2u o; o.x = pk2(xn[rr].x, xn[rr].y); o.y = pk2(xn[rr].z, xn[rr].w); ((v2u*)(dst0 + (size_t)rr * DM))[i * 64 + lane] = o; }
#pragma unroll
      for (int j = 0; j < 4; ++j) {
        const f32x4 w0 = wgl[((i * 4 + j) * 2 + 0) * 64 + lane], w1 = wgl[((i * 4 + j) * 2 + 1) * 64 + lane];
#pragma unroll
        for (int rr = 0; rr < 2; ++rr) { const float xs_ = xn[rr][j];
          ga[rr][0] += xs_ * w0.x; ga[rr][1] += xs_ * w0.y; ga[rr][2] += xs_ * w0.z; ga[rr][3] += xs_ * w0.w;
          ga[rr][4] += xs_ * w1.x; ga[rr][5] += xs_ * w1.y; ga[rr][6] += xs_ * w1.z; ga[rr][7] += xs_ * w1.w; }
      }
      __builtin_amdgcn_sched_barrier(0);
    }
#pragma unroll
    for (int rr = 0; rr < 2; ++rr)
#pragma unroll
      for (int g = 0; g < 8; ++g) ga[rr][g] = wave_sum_dpp(ga[rr][g]);
    if (lane < 8) {
      const int rr = lane >> 2, h = lane & 3;
      float gi = 0.f, gf = 0.f;
#pragma unroll
      for (int q = 0; q < 2; ++q)
#pragma unroll
        for (int hh = 0; hh < 4; ++hh) if (q == rr && hh == h) { gi = ga[q][hh]; gf = ga[q][4 + hh]; }
      const float li = gi + igb[h]; const float fx = gf + fgb[h];
      const float lf = fminf(fx, 0.f) - log1pf(__expf(-fabsf(fx)));
      const int R = r0 + rr;
      if (!ismeta) { const int b = R >> 11, t = R & 2047; LI[(b * 4 + h) * PADT + POS0 + t] = li; LF[(b * 4 + h) * PADT + POS0 + t] = lf; }
      else { for (int b = 0; b < NB; ++b) { LI[(b * 4 + h) * PADT + MPOS0 + R] = li; LF[(b * 4 + h) * PADT + MPOS0 + R] = lf; } }
    }
  }
  __syncthreads();
}
template <bool META>
__device__ __forceinline__ void p0_transpose(const Frame& F, const Args& a, const float* W, int ldw, int N, bf16* Wt) {
  LAS float* tl = (LAS float*)(F.lds);
  LAS float* red = (LAS float*)(F.lds + 33792);
  float* PM = (float*)(F.ws + WS_PM);
  const float* meta = a.in[IN_META]; const float* g1 = a.in[IN_G1];
  const int ntn = N / 64, ntask = ntn * 16, fr = F.lane & 15, fq = F.lane >> 4, w = F.wave;
  f32x4 wn[4];
  float am[4], ag[4];
  if ((int)blockIdx.x < ntask) { const int nb = blockIdx.x % ntn, kb = blockIdx.x / ntn;
#pragma unroll
    for (int i = 0; i < 4; ++i) { const int idx = F.tid + NTHR * i, kk = idx >> 4, c4 = idx & 15; wn[i] = *(const f32x4*)(W + (size_t)(kb * 128 + kk) * ldw + nb * 64 + 4 * c4); }
    if (META) {
#pragma unroll
      for (int s_ = 0; s_ < 4; ++s_) { const int k = kb * 128 + 16 * w + 4 * s_ + fq; am[s_] = meta[(size_t)fr * DM + k]; ag[s_] = g1[k]; } } }
  for (int task = blockIdx.x; task < ntask; task += gridDim.x) {
    const int nb = task % ntn, kb = task / ntn, n0 = nb * 64, k0 = kb * 128;
    __syncthreads();
#pragma unroll
    for (int i = 0; i < 4; ++i) { const int idx = F.tid + NTHR * i, kk = idx >> 4, c4 = idx & 15; const f32x4 wv = wn[i];
      LAS float* d = tl + kk * 65 + 4 * c4; d[0] = wv.x; d[1] = wv.y; d[2] = wv.z; d[3] = wv.w; }
    float ac[4];
    if (META) {
#pragma unroll
      for (int s_ = 0; s_ < 4; ++s_) ac[s_] = am[s_] * ag[s_]; }
    { const int tn = task + gridDim.x; if (tn < ntask) { const int nb2 = tn % ntn, kb2 = tn / ntn;
#pragma unroll
        for (int i = 0; i < 4; ++i) { const int idx = F.tid + NTHR * i, kk = idx >> 4, c4 = idx & 15; wn[i] = *(const f32x4*)(W + (size_t)(kb2 * 128 + kk) * ldw + nb2 * 64 + 4 * c4); }
        if (META) {
#pragma unroll
          for (int s_ = 0; s_ < 4; ++s_) { const int k = kb2 * 128 + 16 * w + 4 * s_ + fq; am[s_] = meta[(size_t)fr * DM + k]; ag[s_] = g1[k]; } } } }
    __syncthreads();
    const int n = F.tid >> 3, kc = F.tid & 7;
    const LAS float* s = tl + (kc * 16) * 65 + n;
    v4u o0, o1;
    o0.x = pk2(s[0 * 65], s[1 * 65]); o0.y = pk2(s[2 * 65], s[3 * 65]); o0.z = pk2(s[4 * 65], s[5 * 65]); o0.w = pk2(s[6 * 65], s[7 * 65]);
    o1.x = pk2(s[8 * 65], s[9 * 65]); o1.y = pk2(s[10 * 65], s[11 * 65]); o1.z = pk2(s[12 * 65], s[13 * 65]); o1.w = pk2(s[14 * 65], s[15 * 65]);
    v4u* dp = (v4u*)(Wt + (size_t)(n0 + n) * DM + k0 + kc * 16);
    dp[0] = o0; dp[1] = o1;
    if (META && n0 >= 1024) {
      f32x4 acc[4];
#pragma unroll
      for (int nt = 0; nt < 4; ++nt) acc[nt] = (f32x4){0.f, 0.f, 0.f, 0.f};
#pragma unroll
      for (int s_ = 0; s_ < 4; ++s_)
#pragma unroll
        for (int nt = 0; nt < 4; ++nt) acc[nt] = __builtin_amdgcn_mfma_f32_16x16x4f32(ac[s_], tl[(16 * w + 4 * s_ + fq) * 65 + nt * 16 + fr], acc[nt], 0, 0, 0);
#pragma unroll
      for (int nt = 0; nt < 4; ++nt)
#pragma unroll
        for (int i = 0; i < 4; ++i) red[(w * 16 + 4 * fq + i) * 64 + nt * 16 + fr] = acc[nt][i];
      __syncthreads();
#pragma unroll
      for (int j = 0; j < 2; ++j) { const int idx = F.tid + NTHR * j, m = idx >> 6, nn = idx & 63; const LAS float* r = red + m * 64 + nn;
        PM[((size_t)kb * 16 + m) * NPROJ + n0 + nn] = ((r[0] + r[1024]) + (r[2048] + r[3072])) + ((r[4096] + r[5120]) + (r[6144] + r[7168])); }
    }
  }
  __syncthreads();
}
__device__ __forceinline__ void p0_zero_vpad(const Frame& F) {
  bf16* Vp = (bf16*)(F.ws + WS_VP);
  const int per = MPOS0 * 256 / 8;
  for (int i = blockIdx.x * NTHR + F.tid; i < 16 * per; i += gridDim.x * NTHR) { const int bh = i / per, e = i % per;
    *(v4u*)(Vp + (size_t)bh * PADT * 256 + (size_t)e * 8) = (v4u){0u, 0u, 0u, 0u}; }
}
__device__ __forceinline__ void p0_lam(const Frame& F, const Args& a) {
  if (blockIdx.x == 0 && F.wave == 0) {
    const int l = F.lane;
    float s1 = a.in[IN_LQ1][l] * a.in[IN_LK1][l] + a.in[IN_LQ1][l + 64] * a.in[IN_LK1][l + 64];
    float s2 = a.in[IN_LQ2][l] * a.in[IN_LK2][l] + a.in[IN_LQ2][l + 64] * a.in[IN_LK2][l + 64];
    s1 = wave_sum(s1); s2 = wave_sum(s2);
    if (l == 0) *(float*)(F.ws + WS_LAM) = __expf(s1) - __expf(s2) + 0.2f;
  }
}

struct EpiProj {
  static constexpr bool PERM = true, AFTER_DRAIN = false;
  bf16 *Qb, *Kp, *Vp, *MQ, *MK, *MV, *MO; const float *qg, *kg; LAS float* xch;
  __device__ __forceinline__ void operator()(const pg8::f32x4 (&acc)[2][2][4][2], const pg8::Unit& u, int wr, int wc, int fr, int fq) const {
    const int pn = u.pn, b = u.pm >> 3, tb = (u.pm & 7) * 256 + wr * 64 + fr, d0 = wc * 32 + fq * 8;
    if (pn < 8) {
      const bool isk = pn >= 4; const int h = pn & 3;
      float ssq[2][4][2];
#pragma unroll
      for (int ai = 0; ai < 2; ++ai)
#pragma unroll
        for (int m = 0; m < 4; ++m)
#pragma unroll
          for (int bj = 0; bj < 2; ++bj) { float s = 0.f;
#pragma unroll
            for (int n = 0; n < 2; ++n) { const pg8::f32x4 x = acc[ai][bj][m][n]; s += (x[0] * x[0] + x[1] * x[1]) + (x[2] * x[2] + x[3] * x[3]); }
            s += __shfl_xor(s, 16); s += __shfl_xor(s, 32); ssq[ai][m][bj] = s;
            if (fq == 0) xch[((ai * 128 + wr * 64 + m * 16 + fr) * 2 + bj) * 4 + wc] = s; }
      asm volatile("s_waitcnt lgkmcnt(0)" ::: "memory"); __builtin_amdgcn_s_barrier(); asm volatile("" ::: "memory");
      const float* gp = (isk ? kg : qg) + d0; const f32x4 g0 = *(const f32x4*)gp, g1v = *(const f32x4*)(gp + 4);
      const float sc = isk ? 1.0f : QSCALE;
#pragma unroll
      for (int ai = 0; ai < 2; ++ai)
#pragma unroll
        for (int m = 0; m < 4; ++m)
#pragma unroll
          for (int bj = 0; bj < 2; ++bj) {
            const f32x4 p = *(const LAS f32x4*)(xch + ((ai * 128 + wr * 64 + m * 16 + fr) * 2 + bj) * 4);
            const float rs = rsqrtf(((p.x + p.y) + (p.z + p.w)) * (1.0f / 128.f) + EPS) * sc;
            const pg8::f32x4 v0 = acc[ai][bj][m][0], v1 = acc[ai][bj][m][1];
            v4u w; w.x = pk2(v0[0] * rs * g0.x, v0[1] * rs * g0.y); w.y = pk2(v0[2] * rs * g0.z, v0[3] * rs * g0.w);
            w.z = pk2(v1[0] * rs * g1v.x, v1[1] * rs * g1v.y); w.w = pk2(v1[2] * rs * g1v.z, v1[3] * rs * g1v.w);
            const int t = tb + ai * 128 + m * 16;
            bf16* dst = isk ? Kp + kp_off((b * 4 + h) * 2 + bj, POS0 + t, d0)
                            : Qb + ((size_t)((b * 4 + h) * 2 + bj) * SEQ + t) * 128 + d0;
            *(v4u*)dst = w; }
      return;
    }
#pragma unroll
    for (int ai = 0; ai < 2; ++ai)
#pragma unroll
      for (int m = 0; m < 4; ++m)
#pragma unroll
        for (int bj = 0; bj < 2; ++bj) {
          pg8::f32x4 v0 = acc[ai][bj][m][0], v1 = acc[ai][bj][m][1];
          const int t = tb + ai * 128 + m * 16;
          bf16* dst;
          if (pn < 12) { const int h = pn - 8; dst = Vp + ((size_t)(b * 4 + h) * PADT + POS0 + t) * 256 + bj * 128 + d0; }
          else if (pn < 16) { const int h = 2 * (pn & 1) + bj; dst = (pn >= 14 ? MK : MQ) + ((size_t)(b * 4 + h) * PADT + POS0 + t) * 128 + d0; }
          else if (pn < 20) { const int h = pn - 16; dst = MV + ((size_t)(b * 4 + h) * PADT + POS0 + t) * 256 + bj * 128 + d0; }
          else dst = MO + (size_t)(b * SEQ + t) * 1024 + (pn - 20) * 256 + bj * 128 + d0;
          v4u w; w.x = pk2(v0[0], v0[1]); w.y = pk2(v0[2], v0[3]); w.z = pk2(v1[0], v1[1]); w.w = pk2(v1[2], v1[3]);
          *(v4u*)dst = w; }
  }
};
__device__ __forceinline__ void p1_meta_finalize(const Frame& F, const Args& a) {
  const bool spread = gridDim.x >= 2 * NMETA;
  if (spread ? ((blockIdx.x & 1) != 0 || blockIdx.x >= 2 * NMETA) : (blockIdx.x >= NMETA)) return;
  const int mrow = spread ? (int)(blockIdx.x >> 1) : (int)blockIdx.x, tid = F.tid, lane = F.lane, w = F.wave;
  const float* meta = a.in[IN_META] + (size_t)mrow * DM; const float* PM0 = (const float*)(F.ws + WS_PM) + (size_t)mrow * NPROJ;
#define PM_P4(i, p) ((PM0[(size_t)(16 * (p)) * NPROJ + (i)] + PM0[(size_t)(16 * ((p) + 1)) * NPROJ + (i)]) + (PM0[(size_t)(16 * ((p) + 2)) * NPROJ + (i)] + PM0[(size_t)(16 * ((p) + 3)) * NPROJ + (i)]))
#define PM_AT(i) ((PM_P4(i, 0) + PM_P4(i, 4)) + (PM_P4(i, 8) + PM_P4(i, 12)))
  LAS float* red = (LAS float*)(F.lds + XCH_OFF);
  const f32x4 mv = ((const f32x4*)meta)[tid];
  float s = wave_sum((mv.x * mv.x + mv.y * mv.y) + (mv.z * mv.z + mv.w * mv.w));
  if (lane == 0) red[w] = s;
  __syncthreads();
  float tot = 0.f;
#pragma unroll
  for (int i = 0; i < 8; ++i) tot += red[i];
  const float rs = rsqrtf(tot * (1.0f / DM) + EPS);
  bf16* Kp = (bf16*)(F.ws + WS_KP); bf16* Vp = (bf16*)(F.ws + WS_VP); bf16* MQ = (bf16*)(F.ws + WS_MQ); bf16* MK = (bf16*)(F.ws + WS_MK); bf16* MV = (bf16*)(F.ws + WS_MV);
  const int pos = MPOS0 + mrow;
  const int c = tid * 2;
  const float kv0 = PM_AT(1024 + w * 128 + lane), kv1 = PM_AT(1024 + w * 128 + lane + 64);
  const float a0 = PM_AT(2048 + c), a1 = PM_AT(2048 + c + 1), b0 = PM_AT(3072 + c), b1 = PM_AT(3072 + c + 1), c0 = PM_AT(4096 + c), c1 = PM_AT(4096 + c + 1);
  {
    const float v0 = kv0 * rs, v1 = kv1 * rs;
    const float rk = rsqrtf(wave_sum(v0 * v0 + v1 * v1) * (1.0f / 128.f) + EPS);
    const float* kg = a.in[IN_KNG];
    const unsigned short o0 = (unsigned short)f2bf(v0 * rk * kg[lane]), o1 = (unsigned short)f2bf(v1 * rk * kg[lane + 64]);
    for (int b = 0; b < NB; ++b) { const int bhm = (b * 4 + (w >> 1)) * 2 + (w & 1); Kp[kp_off(bhm, pos, lane)] = o0; Kp[kp_off(bhm, pos, lane + 64)] = o1; }
  }
  {
    const unsigned o = pk2(a0 * rs, a1 * rs); const int h = c >> 8, e = c & 255;
    for (int b = 0; b < NB; ++b) *(unsigned*)(Vp + ((size_t)(b * 4 + h) * PADT + pos) * 256 + e) = o;
    const unsigned o2 = pk2(b0 * rs, b1 * rs); const bool isk = c >= 512; const int cc = c & 511, hq = cc >> 7, d = cc & 127;
    for (int b = 0; b < NB; ++b) *(unsigned*)((isk ? MK : MQ) + ((size_t)(b * 4 + hq) * PADT + pos) * 128 + d) = o2;
    const unsigned o3 = pk2(c0 * rs, c1 * rs);
    for (int b = 0; b < NB; ++b) *(unsigned*)(MV + ((size_t)(b * 4 + h) * PADT + pos) * 256 + e) = o3;
  }
  __syncthreads();
}
#undef PM_AT
#undef PM_P4

namespace att {
using f32x16 = __attribute__((ext_vector_type(16))) float;
using s16x4 = __attribute__((ext_vector_type(4))) short;
constexpr int STEPS_BHM = 152, NSTEPS = 32 * STEPS_BHM;
constexpr int SHM_V = 64 * 256 * 2, SHM_K = 64 * 128 * 2;
constexpr int LDS_V = 0, LDS_K = 2 * SHM_V, LDS_Q = LDS_K + SHM_K, LDS_WS = LDS_Q + 8 * 8192;
constexpr float THR2 = 8.0f;
#define KSWZ(row, colB) ((row) * 256 + ((colB) ^ (((row) & 7) << 4)))
#define SBAR() __builtin_amdgcn_sched_barrier(0)
__device__ __forceinline__ int crow(int r, int hi) { return (r & 3) + 8 * (r >> 2) + 4 * hi; }
__device__ __forceinline__ unsigned cvtpk(float lo, float hi) { unsigned r; asm volatile("v_cvt_pk_bf16_f32 %0, %1, %2" : "=v"(r) : "v"(lo), "v"(hi)); return r; }
__device__ __forceinline__ int qb_start(int qb) { return 2 * qb * qb + 3 * qb; }
__device__ __forceinline__ int chunk_of(int s, int NA) { return ((s + 1) * NA - 1) / NSTEPS; }

template <int OFF> __device__ __forceinline__ s16x4 tr_read(int vb) {
  s16x4 r; asm volatile("ds_read_b64_tr_b16 %0, %1 offset:%2" : "=&v"(r) : "v"(vb), "i"(OFF) : "memory"); return r;
}
constexpr int v_rd_off(int d0, int ks, int half) { return d0 * 512 + ks * 8192 + half * 4096; }
template <int D0> __device__ __forceinline__ void pv_one(f32x16& od, int vb, bf16x8 pa0, bf16x8 pa1, bf16x8 pa2, bf16x8 pa3) {
#define PK(L, H) (bf16x8){L[0], L[1], L[2], L[3], H[0], H[1], H[2], H[3]}
  { const s16x4 l0 = tr_read<v_rd_off(D0, 0, 0)>(vb), h0 = tr_read<v_rd_off(D0, 0, 1)>(vb), l1 = tr_read<v_rd_off(D0, 1, 0)>(vb), h1 = tr_read<v_rd_off(D0, 1, 1)>(vb);
    asm volatile("s_waitcnt lgkmcnt(0)" ::: "memory"); SBAR();
    od = __builtin_amdgcn_mfma_f32_32x32x16_bf16(pa0, PK(l0, h0), od, 0, 0, 0);
    od = __builtin_amdgcn_mfma_f32_32x32x16_bf16(pa1, PK(l1, h1), od, 0, 0, 0); }
  SBAR();
  { const s16x4 l2 = tr_read<v_rd_off(D0, 2, 0)>(vb), h2 = tr_read<v_rd_off(D0, 2, 1)>(vb), l3 = tr_read<v_rd_off(D0, 3, 0)>(vb), h3 = tr_read<v_rd_off(D0, 3, 1)>(vb);
    asm volatile("s_waitcnt lgkmcnt(0)" ::: "memory"); SBAR();
    od = __builtin_amdgcn_mfma_f32_32x32x16_bf16(pa2, PK(l2, h2), od, 0, 0, 0);
    od = __builtin_amdgcn_mfma_f32_32x32x16_bf16(pa3, PK(l3, h3), od, 0, 0, 0); }
#undef PK
}

__device__ __forceinline__ void segment(const Frame& F, int bhm, int qb, int j0, int j1, int slot) {
  const int tid = F.tid, wid = F.wave, lane = F.lane, r32 = lane & 31, hi = lane >> 5;
  const bf16* Qg = (const bf16*)(F.ws + WS_Q) + ((size_t)bhm * SEQ + qb * 256 + wid * 32 + r32) * 128 + hi * 8;
  const bf16* Kg = (const bf16*)(F.ws + WS_KP) + (size_t)bhm * 33 * 8192;
  const bf16* Vg = (const bf16*)(F.ws + WS_VP) + (size_t)(bhm >> 1) * PADT * 256;
  LAS unsigned char* lds = F.lds;
  LAS float* wsl = (LAS float*)(lds + LDS_WS) + wid * 64;
  const float slope2 = exp2f(-2.0f * (float)(((bhm >> 1) & 3) + 1)) * LOG2E;
  unsigned ksrc0, vsrc0;
  ksrc0 = (unsigned)tid * 16u;
  { const int a8 = tid >> 8, b = (tid >> 2) & 7, k = 8 * (b >> 2) + 4 * a8 + (b & 3), c = ((tid >> 5) & 7) * 32 + (tid & 3) * 8; vsrc0 = (unsigned)(k * 256 + c) * 2u; }
#define STAGE_K(j) do { const char* kt = (const char*)(Kg + (size_t)(j) * 8192); \
    _Pragma("unroll") for (int _i = 0; _i < 2; ++_i) __builtin_amdgcn_global_load_lds((const unsigned*)(kt + (ksrc0 + _i * 8192u)), (LAS unsigned*)(lds + LDS_K + _i * 8192 + wid * 1024), 16, 0, 0); } while (0)
#define STAGE_V(buf, j) do { const char* vt = (const char*)(Vg + (size_t)(j) * 64 * 256); \
    _Pragma("unroll") for (int _i = 0; _i < 4; ++_i) __builtin_amdgcn_global_load_lds((const unsigned*)(vt + (vsrc0 + _i * 8192u)), (LAS unsigned*)(lds + LDS_V + (buf) * SHM_V + _i * 8192 + wid * 1024), 16, 0, 0); } while (0)
  const int lt = (((r32 << 1) | hi) ^ ((r32 >> 3) & 1)) << 4;
  LAS unsigned char* Qs = lds + LDS_Q + wid * 8192;
#pragma unroll
  for (int d0 = 0; d0 < 8; ++d0) { const bf16x8 qv = *(const bf16x8*)(Qg + d0 * 16); *(LAS bf16x8*)(Qs + d0 * 1024 + lt) = qv; }
  f32x16 o[8];
#pragma unroll
  for (int d = 0; d < 8; ++d)
#pragma unroll
    for (int r = 0; r < 16; ++r) o[d][r] = 0.f;
  float m_reg = -1e30f, l_reg = 0.f;
  const int vb0 = (int)(uintptr_t)(lds + LDS_V) + (((lane & 3) << 3) | (((lane >> 2) & 3) << 6) | (((lane >> 4) & 1) << 5) | (((lane >> 5) & 1) << 8));
  STAGE_K(j0); STAGE_V(0, j0);
  VM_WAIT(); __syncthreads();
  for (int j = j0; j < j1; ++j) {
    const int cur = (j - j0) & 1;
    if (j + 1 < j1) STAGE_V(cur ^ 1, j + 1);
    SBAR();
    f32x16 p0 = {}, p1 = {};
    { const LAS unsigned char* Ks = lds + LDS_K;
#pragma unroll
      for (int d0 = 0; d0 < 8; ++d0) {
        const bf16x8 b0 = *(const LAS bf16x8*)(Ks + d0 * 2048 + lt);
        const bf16x8 b1 = *(const LAS bf16x8*)(Ks + d0 * 2048 + 1024 + lt);
        const bf16x8 qf = *(const LAS bf16x8*)(Qs + d0 * 1024 + lt);
        p0 = __builtin_amdgcn_mfma_f32_32x32x16_bf16(b0, qf, p0, 0, 0, 0);
        p1 = __builtin_amdgcn_mfma_f32_32x32x16_bf16(b1, qf, p1, 0, 0, 0); } }
    asm volatile("s_waitcnt lgkmcnt(0)" ::: "memory"); __builtin_amdgcn_s_barrier(); asm volatile("" ::: "memory");
    if (j + 1 < j1) STAGE_K(j + 1);
    SBAR();
    if (j == 0) {
#pragma unroll
      for (int r = 0; r < 16; ++r) p0[r] = -INFINITY;
#pragma unroll
      for (int r = 0; r < 8; ++r) p1[r] = -INFINITY;
    }
    int ln2 = threadIdx.x & 63; asm volatile("" : "+v"(ln2));
    const int hi2 = ln2 >> 5;
    const int jb = j - (4 * qb + 1);
    if (jb >= 0) {
      const int kb = 64 * jb + 4 * hi2, qrel = wid * 32 + (ln2 & 31);
#pragma unroll
      for (int r = 0; r < 16; ++r) { const int kv = kb + (r & 3) + 8 * (r >> 2); if (kv > qrel) p0[r] = -INFINITY; if (kv + 32 > qrel) p1[r] = -INFINITY; }
    }
    const float off0 = slope2 * (float)(64 * j + 4 * hi2), off1 = off0 + 32.0f * slope2;
#pragma unroll
    for (int r = 0; r < 16; ++r) { const float sb = slope2 * (float)((r & 3) + 8 * (r >> 2)); p0[r] += sb; p1[r] += sb; }
    float pm0 = p0[0], pm1 = p1[0];
#pragma unroll
    for (int r = 1; r < 16; ++r) { pm0 = fmaxf(pm0, p0[r]); pm1 = fmaxf(pm1, p1[r]); }
    float pmax = fmaxf(pm0 + off0, pm1 + off1);
    { auto rr = __builtin_amdgcn_permlane32_swap(__float_as_uint(pmax), __float_as_uint(pmax), false, false);
      pmax = fmaxf(__uint_as_float(rr[0]), __uint_as_float(rr[1])); }
    float mn, alpha;
    if (__builtin_expect(__all(pmax - m_reg <= THR2), 1)) { mn = m_reg; alpha = 1.f; }
    else { mn = fmaxf(m_reg, pmax); alpha = __builtin_amdgcn_exp2f(m_reg - mn); m_reg = mn; }
    const float c0 = off0 - mn, c1 = off1 - mn;
    float ps = 0.f;
#pragma unroll
    for (int r = 0; r < 16; ++r) { p0[r] = __builtin_amdgcn_exp2f(p0[r] + c0); p1[r] = __builtin_amdgcn_exp2f(p1[r] + c1); ps += p0[r] + p1[r]; }
    { auto rr = __builtin_amdgcn_permlane32_swap(__float_as_uint(ps), __float_as_uint(ps), false, false);
      ps = __uint_as_float(rr[0]) + __uint_as_float(rr[1]); }
    l_reg = l_reg * alpha + ps;
    if (__any(alpha < 1.f)) { if (hi == 0) wsl[r32] = alpha; asm volatile("s_waitcnt lgkmcnt(0)" ::: "memory");
#pragma unroll
      for (int rg = 0; rg < 4; ++rg) { const f32x4 al = *(const LAS f32x4*)(wsl + 8 * rg + 4 * hi);
#pragma unroll
        for (int d = 0; d < 8; ++d) { o[d][4 * rg + 0] *= al.x; o[d][4 * rg + 1] *= al.y; o[d][4 * rg + 2] *= al.z; o[d][4 * rg + 3] *= al.w; }
        SBAR(); } }
    bf16x8 pa0, pa1, pa2, pa3;
#define PK4(P, BASE, OUT) do { unsigned a0 = cvtpk(P[BASE + 0], P[BASE + 1]), a1 = cvtpk(P[BASE + 2], P[BASE + 3]);   \
    unsigned b0 = cvtpk(P[BASE + 4], P[BASE + 5]), b1 = cvtpk(P[BASE + 6], P[BASE + 7]);                              \
    auto r0 = __builtin_amdgcn_permlane32_swap(a0, b0, false, false); auto r1 = __builtin_amdgcn_permlane32_swap(a1, b1, false, false); \
    v4u w = {r0[0], r1[0], r0[1], r1[1]}; OUT = *reinterpret_cast<bf16x8*>(&w); } while (0)
    PK4(p0, 0, pa0); PK4(p0, 8, pa1); PK4(p1, 0, pa2); PK4(p1, 8, pa3);
#undef PK4
    SBAR();
    { const int vb = vb0 + cur * SHM_V;
      pv_one<0>(o[0], vb, pa0, pa1, pa2, pa3); pv_one<1>(o[1], vb, pa0, pa1, pa2, pa3); pv_one<2>(o[2], vb, pa0, pa1, pa2, pa3); pv_one<3>(o[3], vb, pa0, pa1, pa2, pa3);
      pv_one<4>(o[4], vb, pa0, pa1, pa2, pa3); pv_one<5>(o[5], vb, pa0, pa1, pa2, pa3); pv_one<6>(o[6], vb, pa0, pa1, pa2, pa3); pv_one<7>(o[7], vb, pa0, pa1, pa2, pa3); }
    VM_WAIT(); __syncthreads();
  }
  { int lane2 = threadIdx.x & 63, slot2 = slot; asm volatile("" : "+v"(lane2), "+s"(slot2));
    const int r32e = lane2 & 31, hie = lane2 >> 5;
    bf16* PO = (bf16*)(F.ws + WS_PO) + (size_t)slot2 * 256 * 256; float* ML = (float*)(F.ws + WS_ML) + (size_t)slot2 * 512;
    LAS float* wse = (LAS float*)(F.lds + LDS_WS) + wid * 64;
    if (hie == 0) { wse[r32e] = l_reg; ML[(wid * 32 + r32e) * 2] = m_reg; ML[(wid * 32 + r32e) * 2 + 1] = l_reg; }
    asm volatile("s_waitcnt lgkmcnt(0)" ::: "memory");
    char* Ob = (char*)(PO + (size_t)(wid * 32) * 256);
    const bool odd = (r32e & 1) != 0;
    const unsigned lo = (unsigned)(4 * hie * 256 + (r32e & ~1) + (odd ? 32 : 0)) * 2u;
#pragma unroll
    for (int r = 0; r < 16; ++r) { const int rowc = (r & 3) + 8 * (r >> 2); const float lv = wse[rowc + 4 * hie]; const float rl = lv > 0.f ? __builtin_amdgcn_rcpf(lv) : 0.f;
#pragma unroll
      for (int dp = 0; dp < 4; ++dp) { const float va = o[2 * dp][r] * rl, vb = o[2 * dp + 1][r] * rl;
        const float send = odd ? va : vb, keep = odd ? vb : va;
        const float recv = __builtin_bit_cast(float, __builtin_amdgcn_update_dpp(0, __builtin_bit_cast(int, send), 0xB1, 0xF, 0xF, true));
        *(unsigned*)(Ob + (lo + (unsigned)(rowc * 256 + dp * 64) * 2u)) = odd ? pk2(recv, keep) : pk2(keep, recv); }
      SBAR(); } }
  __syncthreads();
#undef STAGE_K
#undef STAGE_V
}

__device__ __forceinline__ void phase(const Frame& F, int ca, int NA) {
  int s0 = (int)(((long)ca * NSTEPS) / NA); const int s1 = (int)(((long)(ca + 1) * NSTEPS) / NA);
  while (s0 < s1) {
    const int bhm = s0 / STEPS_BHM, rem = s0 - bhm * STEPS_BHM;
    int qb = 0;
#pragma unroll 1
    for (int q = 1; q < 8; ++q) if (rem >= qb_start(q)) qb = q;
    const int j0 = rem - qb_start(qb), nst = 4 * qb + 5;
    const int j1 = (j0 + (s1 - s0) < nst) ? j0 + (s1 - s0) : nst;
    const int slot = bhm * 16 + qb + chunk_of(s0, NA) - chunk_of(bhm * STEPS_BHM, NA);
    segment(F, bhm, qb, j0, j1, slot);
    s0 += j1 - j0;
  }
}
#undef KSWZ
#undef SBAR
}
namespace ml {
constexpr int QST = 136, TST = 72;
constexpr int L_RQ = 0, L_RK = 17152, L_QS = 34304, L_QW = 51712, L_KS = 69120, L_KWT = 86528, L_VT = 104960  , L_SP = 0  , L_G = 141824, L_CW = 143872;
constexpr int L_HT = 0;
constexpr int G_A = 0, G_M = 64, G_WI = 128, G_EM = 192, G_DEN = 256, G_WG = 320, G_SC = 384, G_N = 0;
constexpr int L_NV = L_CW + 5120;
constexpr int L_SSQ = L_KWT;
__device__ __forceinline__ float shfl_up_f(float v, int d) { return __shfl_up(v, d); }

struct StageCW { float v[3]; };
__device__ __forceinline__ void issue_cw(const Frame& F, const Args& a, int h, StageCW& st) {
#pragma unroll
  for (int i = 0; i < 3; ++i) { const int e = F.tid + NTHR * i; st.v[i] = 0.f;
    if (e < 2 * 5 * 128) { const int qk = e / 640, j = (e / 128) % 5, d = e & 127; const int ch = qk * 512 + h * 128 + d; st.v[i] = j < 4 ? a.in[IN_CW][j * 1024 + ch] : a.in[IN_CB][ch]; } }
}
__device__ __forceinline__ void commit_cw(const Frame& F, const StageCW& st) {
  LAS float* CW = (LAS float*)(F.lds + L_CW);
#pragma unroll
  for (int i = 0; i < 3; ++i) { const int e = F.tid + NTHR * i; if (e < 2 * 5 * 128) CW[e] = st.v[i]; }
}
struct StageRaw { v4u v[3]; };
__device__ __forceinline__ void issue_raw(const Frame& F, const bf16* g, int pos0, StageRaw& st) {
#pragma unroll
  for (int i = 0; i < 3; ++i) { const int p = F.tid + NTHR * i, row = p >> 4, ch = p & 15, pos = pos0 - 3 + row;
    st.v[i] = (v4u){0u, 0u, 0u, 0u}; if (p < 67 * 16 && pos >= MPOS0) st.v[i] = *(const v4u*)(g + (size_t)pos * 128 + ch * 8); }
}
__device__ __forceinline__ void commit_raw(const Frame& F, int lds_off, const StageRaw& st) {
#pragma unroll
  for (int i = 0; i < 3; ++i) { const int p = F.tid + NTHR * i, row = p >> 4, ch = p & 15; if (p < 67 * 16) *(LAS v4u*)(F.lds + lds_off + row * 256 + ch * 16) = st.v[i]; }
}
__device__ __forceinline__ void conv16(const Frame& F, int qk, int lds_off, int t, int d0, float (&y)[16]) {
  const LAS float* CW = (const LAS float*)(F.lds + L_CW);
#pragma unroll
  for (int e = 0; e < 16; ++e) y[e] = CW[(qk * 5 + 4) * 128 + d0 + e];
#pragma unroll
  for (int j = 0; j < 4; ++j) { const LAS v4u* rp = (const LAS v4u*)(F.lds + lds_off + (t + j) * 256 + d0 * 2); const v4u r0 = rp[0], r1 = rp[1];
    const LAS float* cw = CW + (qk * 5 + j) * 128 + d0;
    y[0] += cw[0] * bflo(r0.x); y[1] += cw[1] * bfhi(r0.x); y[2] += cw[2] * bflo(r0.y); y[3] += cw[3] * bfhi(r0.y); y[4] += cw[4] * bflo(r0.z); y[5] += cw[5] * bfhi(r0.z); y[6] += cw[6] * bflo(r0.w); y[7] += cw[7] * bfhi(r0.w);
    y[8] += cw[8] * bflo(r1.x); y[9] += cw[9] * bfhi(r1.x); y[10] += cw[10] * bflo(r1.y); y[11] += cw[11] * bfhi(r1.y); y[12] += cw[12] * bflo(r1.z); y[13] += cw[13] * bfhi(r1.z); y[14] += cw[14] * bflo(r1.w); y[15] += cw[15] * bfhi(r1.w); }
#pragma unroll
  for (int e = 0; e < 16; ++e) y[e] = y[e] / (1.0f + __expf(-y[e]));
}
struct StageVT { v4u v[4]; };
__device__ __forceinline__ void issue_vt(const Frame& F, const bf16* MVg, int pos0, StageVT& st) {
#pragma unroll
  for (int i = 0; i < 4; ++i) { const int p = F.tid + NTHR * i, row = p >> 5, ch = p & 31; st.v[i] = (v4u){0u, 0u, 0u, 0u};
    if (pos0 + row >= MPOS0) st.v[i] = *(const v4u*)(MVg + (size_t)(pos0 + row) * 256 + ch * 8); }
}
__device__ __forceinline__ void commit_vt(const Frame& F, const StageVT& st) {
#pragma unroll
  for (int i = 0; i < 4; ++i) { const int p = F.tid + NTHR * i, row = p >> 5, ch = p & 31; const v4u v4 = st.v[i];
    LAS bf16* vt = (LAS bf16*)(F.lds + L_VT) + (ch * 8) * TST + row;
    vt[0 * TST] = (bf16)(v4.x & 0xffff); vt[1 * TST] = (bf16)(v4.x >> 16); vt[2 * TST] = (bf16)(v4.y & 0xffff); vt[3 * TST] = (bf16)(v4.y >> 16);
    vt[4 * TST] = (bf16)(v4.z & 0xffff); vt[5 * TST] = (bf16)(v4.z >> 16); vt[6 * TST] = (bf16)(v4.w & 0xffff); vt[7 * TST] = (bf16)(v4.w >> 16); }
}

__device__ __forceinline__ void taskA(const Frame& F, const Args& a, int task) {
  const int bh = task >> 5, c = task & 31, h = bh & 3, tid = F.tid, w = F.wave, lane = F.lane, fr = lane & 15, kq = lane >> 4, pos0 = 64 * c;
  LAS unsigned char* lds = F.lds; LAS float* G = (LAS float*)(lds + L_G);
  const bf16* MKg = (const bf16*)(F.ws + WS_MK) + (size_t)bh * PADT * 128; const bf16* MVg = (const bf16*)(F.ws + WS_MV) + (size_t)bh * PADT * 256;
  StageCW scw; StageRaw srk; StageVT svt; float li = -1e30f, lf = 0.f;
  issue_cw(F, a, h, scw); issue_raw(F, MKg, pos0, srk); issue_vt(F, MVg, pos0, svt);
  { const bool dead = pos0 + lane < MPOS0; if (w == 0 && !dead) { li = ((const float*)(F.ws + WS_LI))[bh * PADT + pos0 + lane]; lf = ((const float*)(F.ws + WS_LF))[bh * PADT + pos0 + lane]; } }
  __syncthreads();
  commit_cw(F, scw); commit_raw(F, L_RK, srk); commit_vt(F, svt);
  if (w == 0) {
    float bs = lf;
#pragma unroll
    for (int d = 1; d < 64; d <<= 1) { const float o = shfl_up_f(bs, d); if (lane >= d) bs += o; }
    const float av = li - bs; float mx = av;
#pragma unroll
    for (int o = 1; o < 64; o <<= 1) mx = fmaxf(mx, __shfl_xor(mx, o));
    G[G_WG + lane] = __expf(av - mx);
    if (lane == 63) { float* gs = (float*)(F.ws + WS_GS) + (size_t)(bh * 33 + c) * 2; gs[0] = bs; gs[1] = mx; }
  }
  __syncthreads();
  { const int t = tid >> 3, d0 = (tid & 7) * 16; float y[16]; conv16(F, 1, L_RK, t, d0, y);
    const float sw = 0.08838834764831845f * G[G_WG + t]; LAS bf16* kt = (LAS bf16*)(lds + L_KWT) + d0 * TST + t;
#pragma unroll
    for (int e = 0; e < 16; ++e) kt[e * TST] = (bf16)f2bf(y[e] * sw); }
  __syncthreads();
  f32x4* DCg = (f32x4*)(F.ws + WS_DC) + ((size_t)(bh * 32 + c) * 128) * 64;
#pragma unroll
  for (int jj = 0; jj < 2; ++jj) { const int j = 2 * w + jj;
    const bf16x8 bv0 = *(const LAS bf16x8*)(lds + L_VT + ((16 * j + fr) * TST + 8 * kq) * 2), bv1 = *(const LAS bf16x8*)(lds + L_VT + ((16 * j + fr) * TST + 32 + 8 * kq) * 2);
#pragma unroll
    for (int i = 0; i < 8; ++i) { f32x4 acc = {0.f, 0.f, 0.f, 0.f};
      const bf16x8 k0 = *(const LAS bf16x8*)(lds + L_KWT + ((16 * i + fr) * TST + 8 * kq) * 2), k1 = *(const LAS bf16x8*)(lds + L_KWT + ((16 * i + fr) * TST + 32 + 8 * kq) * 2);
      acc = __builtin_amdgcn_mfma_f32_16x16x32_bf16(k0, bv0, acc, 0, 0, 0); acc = __builtin_amdgcn_mfma_f32_16x16x32_bf16(k1, bv1, acc, 0, 0, 0);
      DCg[(size_t)(i * 16 + j) * 64 + lane] = acc; } }
  if (tid < 128) { const LAS v4u* kr = (const LAS v4u*)(lds + L_KWT + tid * TST * 2); float s = 0.f;
#pragma unroll
    for (int q = 0; q < 8; ++q) { const v4u x = kr[q]; s += (bflo(x.x) + bfhi(x.x)) + (bflo(x.y) + bfhi(x.y)) + (bflo(x.z) + bfhi(x.z)) + (bflo(x.w) + bfhi(x.w)); }
    ((float*)(F.ws + WS_DN))[(size_t)(bh * 32 + c) * 128 + tid] = s; }
}

__device__ __forceinline__ void scanB(const Frame& F) {
  const float* GS = (const float*)(F.ws + WS_GS);
  LAS float* cf = (LAS float*)F.lds;
  for (int blk = blockIdx.x; blk < 16 * 16; blk += gridDim.x) { const int bh = blk >> 4, r = (blk & 15) * NTHR + F.tid, i = r >> 10, j = (r >> 6) & 15, ln = r & 63;
    __syncthreads();
    if (F.wave == 0) {
      const int c = F.lane & 31; const v2u gs = *(const v2u*)(GS + (size_t)(bh * 33 + c) * 2); const unsigned g0 = gs.x, g1 = gs.y;
      const float bL = __builtin_bit_cast(float, g0), ml = __builtin_bit_cast(float, g1);
      float mm = 0.f, fa = 0.f, fb = 0.f, mout = 0.f;
#pragma unroll
      for (int cc = 0; cc < 32; ++cc) { const float b_ = __builtin_bit_cast(float, __builtin_amdgcn_readlane(__builtin_bit_cast(int, bL), cc)), l_ = __builtin_bit_cast(float, __builtin_amdgcn_readlane(__builtin_bit_cast(int, ml), cc));
        const float me = fmaxf(mm, l_); if (c == cc) { fa = __expf(mm - me); fb = __expf(l_ - me); } mm = b_ + me; if (c == cc) mout = mm; }
      if (F.lane < 32) { cf[2 * c] = fa; cf[2 * c + 1] = fb; if ((blk & 15) == 0) ((float*)(F.ws + WS_MS))[bh * 33 + c + 1] = mout; }
    }
    __syncthreads();
    const f32x4* dc0 = (const f32x4*)(F.ws + WS_DC) + ((size_t)(bh * 32) * 128 + (i * 16 + j)) * 64 + ln;
    v2u* cs = (v2u*)(F.ws + WS_CS) + ((((size_t)bh * 33) * 8 + i) * 16 + j) * 64 + ln;
    f32x4 s0 = {0.f, 0.f, 0.f, 0.f}, dv[32];
#pragma unroll
    for (int c = 0; c < 32; ++c) dv[c] = dc0[(size_t)c * 128 * 64];
#pragma unroll
    for (int c = 0; c < 32; ++c) { const float fa = cf[2 * c], fb = cf[2 * c + 1];
      s0 = s0 * fa + dv[c] * fb;
      v2u o; o.x = pk2(s0.x, s0.y); o.y = pk2(s0.z, s0.w); cs[(size_t)(c + 1) * 8 * 16 * 64] = o; }
    if ((blk & 15) == 0 && F.tid < 128) {
      const float* dn = (const float*)(F.ws + WS_DN) + (size_t)(bh * 32) * 128 + F.tid; float* ns = (float*)(F.ws + WS_NS) + (size_t)(bh * 33) * 128 + F.tid; float n = 0.f;
      float dnv[32];
#pragma unroll
      for (int c = 0; c < 32; ++c) dnv[c] = dn[(size_t)c * 128];
#pragma unroll
      for (int c = 0; c < 32; ++c) { n = n * cf[2 * c] + dnv[c] * cf[2 * c + 1]; ns[(size_t)(c + 1) * 128] = n; }
    }
  }
}

__device__ __forceinline__ void taskC(const Frame& F, const Args& a, int task) {
  TP_BEGIN(31);
  const int bh = task >> 5, c = (task & 31) + 1, b = bh >> 2, h = bh & 3, tid = F.tid, w = F.wave, lane = F.lane, fr = lane & 15, kq = lane >> 4, pos0 = 64 * c;
  LAS unsigned char* lds = F.lds; LAS float* G = (LAS float*)(lds + L_G); LAS float* NV = (LAS float*)(lds + L_NV);
  const bf16* MQg = (const bf16*)(F.ws + WS_MQ) + (size_t)bh * PADT * 128; const bf16* MKg = (const bf16*)(F.ws + WS_MK) + (size_t)bh * PADT * 128;
  const bf16* MVg = (const bf16*)(F.ws + WS_MV) + (size_t)bh * PADT * 256;
  const float m = ((const float*)(F.ws + WS_MS))[bh * 33 + c];
  StageCW scw; StageRaw srq, srk; StageVT svt; float nvv = 0.f, li = 0.f, lf = 0.f;
  issue_cw(F, a, h, scw); issue_raw(F, MQg, pos0, srq); issue_raw(F, MKg, pos0, srk); issue_vt(F, MVg, pos0, svt);
  if (tid < 128) nvv = ((const float*)(F.ws + WS_NS))[(size_t)(bh * 33 + c) * 128 + tid];
  if (w == 0) { li = ((const float*)(F.ws + WS_LI))[bh * PADT + pos0 + lane]; lf = ((const float*)(F.ws + WS_LF))[bh * PADT + pos0 + lane]; }
  __syncthreads();
  commit_cw(F, scw); commit_raw(F, L_RQ, srq); commit_raw(F, L_RK, srk); commit_vt(F, svt);
  if (tid < 128) NV[tid] = nvv;
  if (w == 0) {
    float bs = lf;
#pragma unroll
    for (int d = 1; d < 64; d <<= 1) { const float o = shfl_up_f(bs, d); if (lane >= d) bs += o; }
    const float av = li - bs; float cm = av;
#pragma unroll
    for (int d = 1; d < 64; d <<= 1) { const float o = shfl_up_f(cm, d); if (lane >= d) cm = fmaxf(cm, o); }
    const float Mt = fmaxf(m, cm);
    G[G_A + lane] = av; G[G_M + lane] = Mt; G[G_WI + lane] = __expf(m - Mt); G[G_EM + lane] = __expf(-(bs + Mt));
  }
  __syncthreads(); TP_END(31, F.ws); TP_BEGIN(32);
  { const int t = tid >> 3, d0 = (tid & 7) * 16; const float wi = G[G_WI + t]; float y[16];
    conv16(F, 0, L_RQ, t, d0, y);
    { v4u o0, o1, w0, w1;
      o0.x = pk2(y[0], y[1]); o0.y = pk2(y[2], y[3]); o0.z = pk2(y[4], y[5]); o0.w = pk2(y[6], y[7]); o1.x = pk2(y[8], y[9]); o1.y = pk2(y[10], y[11]); o1.z = pk2(y[12], y[13]); o1.w = pk2(y[14], y[15]);
      w0.x = pk2(y[0] * wi, y[1] * wi); w0.y = pk2(y[2] * wi, y[3] * wi); w0.z = pk2(y[4] * wi, y[5] * wi); w0.w = pk2(y[6] * wi, y[7] * wi);
      w1.x = pk2(y[8] * wi, y[9] * wi); w1.y = pk2(y[10] * wi, y[11] * wi); w1.z = pk2(y[12] * wi, y[13] * wi); w1.w = pk2(y[14] * wi, y[15] * wi);
      LAS v4u* qs = (LAS v4u*)(lds + L_QS + (t * QST + d0) * 2); qs[0] = o0; qs[1] = o1;
      LAS v4u* qw = (LAS v4u*)(lds + L_QW + (t * QST + d0) * 2); qw[0] = w0; qw[1] = w1; }
    __builtin_amdgcn_sched_barrier(0);
    conv16(F, 1, L_RK, t, d0, y);
    { const float sc = 0.08838834764831845f; v4u o0, o1;
      o0.x = pk2(y[0] * sc, y[1] * sc); o0.y = pk2(y[2] * sc, y[3] * sc); o0.z = pk2(y[4] * sc, y[5] * sc); o0.w = pk2(y[6] * sc, y[7] * sc);
      o1.x = pk2(y[8] * sc, y[9] * sc); o1.y = pk2(y[10] * sc, y[11] * sc); o1.z = pk2(y[12] * sc, y[13] * sc); o1.w = pk2(y[14] * sc, y[15] * sc);
      LAS v4u* ks = (LAS v4u*)(lds + L_KS + (t * QST + d0) * 2); ks[0] = o0; ks[1] = o1; } }
  __syncthreads(); TP_END(32, F.ws); TP_BEGIN(33);
  v4u cb[4][2];
  { const v2u* cs = (const v2u*)(F.ws + WS_CS) + (((size_t)bh * 33 + c) * 8 * 16) * 64;
#pragma unroll
    for (int I = 0; I < 4; ++I)
#pragma unroll
      for (int jj = 0; jj < 2; ++jj) { const v2u lo_ = cs[(size_t)((2 * I) * 16 + 2 * w + jj) * 64 + lane], hi_ = cs[(size_t)((2 * I + 1) * 16 + 2 * w + jj) * 64 + lane]; cb[I][jj] = (v4u){lo_.x, lo_.y, hi_.x, hi_.y}; } }
  { const int si = w >> 1; const f32x4 as = *(const LAS f32x4*)(G + G_A + 16 * si + 4 * kq);
#pragma unroll
    for (int tt = 0; tt < 2; ++tt) { const int ti = 2 * (w & 1) + tt; f32x4 acc = {0.f, 0.f, 0.f, 0.f};
#pragma unroll
      for (int ks = 0; ks < 4; ++ks) { const bf16x8 af = *(const LAS bf16x8*)(lds + L_KS + ((16 * si + fr) * QST + 32 * ks + 8 * kq) * 2);
        const bf16x8 bfr = *(const LAS bf16x8*)(lds + L_QS + ((16 * ti + fr) * QST + 32 * ks + 8 * kq) * 2);
        acc = __builtin_amdgcn_mfma_f32_16x16x32_bf16(af, bfr, acc, 0, 0, 0); }
      const int t = 16 * ti + fr, s0 = 16 * si + 4 * kq; const float Mt = G[G_M + t];
      const float v0 = (s0 + 0 <= t) ? acc.x * __expf(as.x - Mt) : 0.f, v1 = (s0 + 1 <= t) ? acc.y * __expf(as.y - Mt) : 0.f;
      const float v2 = (s0 + 2 <= t) ? acc.z * __expf(as.z - Mt) : 0.f, v3 = (s0 + 3 <= t) ? acc.w * __expf(as.w - Mt) : 0.f;
      v2u o; o.x = pk2(v0, v1); o.y = pk2(v2, v3);
      *(LAS v2u*)(lds + L_SP + (t * TST + s0) * 2) = o; } }
  __syncthreads(); TP_END(33, F.ws); TP_BEGIN(34);
  if (w == 0) { const int t = lane; float qn = 0.f, rsum = 0.f;
#pragma unroll 4
    for (int q = 0; q < 16; ++q) { const v4u x = *(const LAS v4u*)(lds + L_QS + (t * QST + q * 8) * 2); const f32x4 n0 = *(const LAS f32x4*)(NV + q * 8), n1 = *(const LAS f32x4*)(NV + q * 8 + 4);
      qn += bflo(x.x) * n0.x + bfhi(x.x) * n0.y + bflo(x.y) * n0.z + bfhi(x.y) * n0.w + bflo(x.z) * n1.x + bfhi(x.z) * n1.y + bflo(x.w) * n1.z + bfhi(x.w) * n1.w; }
#pragma unroll
    for (int q = 0; q < 8; ++q) { const v4u x = *(const LAS v4u*)(lds + L_SP + (t * TST + q * 8) * 2); rsum += (bflo(x.x) + bfhi(x.x)) + (bflo(x.y) + bfhi(x.y)) + (bflo(x.z) + bfhi(x.z)) + (bflo(x.w) + bfhi(x.w)); }
    const float den = G[G_WI + t] * qn + rsum; G[G_DEN + t] = fmaxf(fabsf(den), G[G_EM + t]); }
  f32x4 acc[2][4];
#pragma unroll
  for (int jj = 0; jj < 2; ++jj)
#pragma unroll
    for (int ti = 0; ti < 4; ++ti) acc[jj][ti] = (f32x4){0.f, 0.f, 0.f, 0.f};
#pragma unroll
  for (int I = 0; I < 4; ++I) {
#pragma unroll
    for (int ti = 0; ti < 4; ++ti) { const LAS unsigned char* qp = lds + L_QW + ((16 * ti + fr) * QST + 32 * I + 4 * kq) * 2;
      const v2u a0 = *(const LAS v2u*)qp, a1 = *(const LAS v2u*)(qp + 32); const v4u av = {a0.x, a0.y, a1.x, a1.y};
      acc[0][ti] = __builtin_amdgcn_mfma_f32_16x16x32_bf16(__builtin_bit_cast(bf16x8, av), __builtin_bit_cast(bf16x8, cb[I][0]), acc[0][ti], 0, 0, 0);
      acc[1][ti] = __builtin_amdgcn_mfma_f32_16x16x32_bf16(__builtin_bit_cast(bf16x8, av), __builtin_bit_cast(bf16x8, cb[I][1]), acc[1][ti], 0, 0, 0); }
    __builtin_amdgcn_sched_barrier(0); }
#pragma unroll
  for (int ks = 0; ks < 2; ++ks) { const bf16x8 bv0 = *(const LAS bf16x8*)(lds + L_VT + ((32 * w + fr) * TST + 32 * ks + 8 * kq) * 2), bv1 = *(const LAS bf16x8*)(lds + L_VT + ((32 * w + 16 + fr) * TST + 32 * ks + 8 * kq) * 2);
#pragma unroll
    for (int ti = 0; ti < 4; ++ti) { const bf16x8 sf = *(const LAS bf16x8*)(lds + L_SP + ((16 * ti + fr) * TST + 32 * ks + 8 * kq) * 2);
      acc[0][ti] = __builtin_amdgcn_mfma_f32_16x16x32_bf16(sf, bv0, acc[0][ti], 0, 0, 0); acc[1][ti] = __builtin_amdgcn_mfma_f32_16x16x32_bf16(sf, bv1, acc[1][ti], 0, 0, 0); } }
  v4u mvp[4];
  { const int t_ = tid >> 3, c0_ = (tid & 7) * 32; const bf16* mo_ = (const bf16*)(F.ws + WS_MO) + ((size_t)b * SEQ + 64 * (c - 1) + t_) * 1024 + h * 256 + c0_;
#pragma unroll
    for (int q = 0; q < 4; ++q) mvp[q] = *(const v4u*)(mo_ + q * 8); }
  __syncthreads(); TP_END(34, F.ws); TP_BEGIN(35);
  LAS float* SSQ = (LAS float*)(lds + L_SSQ);
#pragma unroll
  for (int ti = 0; ti < 4; ++ti) { const f32x4 dn = *(const LAS f32x4*)(G + G_DEN + 16 * ti + 4 * kq);
    f32x4 s4;
#pragma unroll
    for (int r = 0; r < 4; ++r) { const float h0 = acc[0][ti][r] / dn[r], h1 = acc[1][ti][r] / dn[r]; acc[0][ti][r] = h0; acc[1][ti][r] = h1; s4[r] = h0 * h0 + h1 * h1; }
#pragma unroll
    for (int r = 0; r < 4; ++r) { float v = s4[r];
      v += __builtin_bit_cast(float, __builtin_amdgcn_update_dpp(0, __builtin_bit_cast(int, v), 0xB1, 0xF, 0xF, true)); v += __builtin_bit_cast(float, __builtin_amdgcn_update_dpp(0, __builtin_bit_cast(int, v), 0x4E, 0xF, 0xF, true));
      v += __builtin_bit_cast(float, __builtin_amdgcn_update_dpp(0, __builtin_bit_cast(int, v), 0x141, 0xF, 0xF, true)); v += __builtin_bit_cast(float, __builtin_amdgcn_update_dpp(0, __builtin_bit_cast(int, v), 0x140, 0xF, 0xF, true)); s4[r] = v; }
    if (fr == 0) { SSQ[(16 * ti + 4 * kq + 0) * 8 + w] = s4.x; SSQ[(16 * ti + 4 * kq + 1) * 8 + w] = s4.y; SSQ[(16 * ti + 4 * kq + 2) * 8 + w] = s4.z; SSQ[(16 * ti + 4 * kq + 3) * 8 + w] = s4.w; } }
  __syncthreads();
  LAS bf16* HT = (LAS bf16*)(lds + L_HT);
#pragma unroll
  for (int ti = 0; ti < 4; ++ti)
#pragma unroll
    for (int r = 0; r < 4; ++r) { const int t = 16 * ti + 4 * kq + r; const f32x4 p0 = *(const LAS f32x4*)(SSQ + t * 8), p1 = *(const LAS f32x4*)(SSQ + t * 8 + 4);
      const float rh = rsqrtf(((p0.x + p0.y) + (p0.z + p0.w) + (p1.x + p1.y) + (p1.z + p1.w)) * (1.0f / 256.f) + EPS);
      HT[t * 264 + 32 * w + fr] = (bf16)f2bf(acc[0][ti][r] * rh); HT[t * 264 + 32 * w + 16 + fr] = (bf16)f2bf(acc[1][ti][r] * rh); }
  __syncthreads(); TP_END(35, F.ws); TP_BEGIN(36);
  { const int t = tid >> 3, c0 = (tid & 7) * 32; const size_t R = (size_t)b * SEQ + 64 * (c - 1) + t;
    const float* og = a.in[IN_OUTG] + h * 256 + c0; bf16* A2 = (bf16*)(F.ws + WS_A2) + R * DM + 1024 + h * 256 + c0;
    f32x4 gg[8];
#pragma unroll
    for (int q = 0; q < 8; ++q) gg[q] = *(const f32x4*)(og + q * 4);
#pragma unroll
    for (int q = 0; q < 4; ++q) { const v4u hv = *(const LAS v4u*)(HT + t * 264 + c0 + q * 8); const v4u mv = mvp[q]; const f32x4 g0 = gg[2 * q], g1 = gg[2 * q + 1];
      v4u o; o.x = pk2(bflo(hv.x) * g0.x * sigmoidf_(bflo(mv.x)), bfhi(hv.x) * g0.y * sigmoidf_(bfhi(mv.x))); o.y = pk2(bflo(hv.y) * g0.z * sigmoidf_(bflo(mv.y)), bfhi(hv.y) * g0.w * sigmoidf_(bfhi(mv.y)));
      o.z = pk2(bflo(hv.z) * g1.x * sigmoidf_(bflo(mv.z)), bfhi(hv.z) * g1.y * sigmoidf_(bfhi(mv.z))); o.w = pk2(bflo(hv.w) * g1.z * sigmoidf_(bflo(mv.w)), bfhi(hv.w) * g1.w * sigmoidf_(bfhi(mv.w)));
      *(v4u*)(A2 + q * 8) = o; } }
  TP_END(36, F.ws);
}
}
struct CombRow { float mp[8][3], lp[8][3]; v4u op[8][3]; };
__device__ __forceinline__ float half_sum_dpp(float v, bool hi) {
  v += __builtin_bit_cast(float, __builtin_amdgcn_update_dpp(0, __builtin_bit_cast(int, v), 0xB1, 0xF, 0xF, true));
  v += __builtin_bit_cast(float, __builtin_amdgcn_update_dpp(0, __builtin_bit_cast(int, v), 0x4E, 0xF, 0xF, true));
  v += __builtin_bit_cast(float, __builtin_amdgcn_update_dpp(0, __builtin_bit_cast(int, v), 0x141, 0xF, 0xF, true));
  v += __builtin_bit_cast(float, __builtin_amdgcn_update_dpp(0, __builtin_bit_cast(int, v), 0x140, 0xF, 0xF, true));
  const float r0 = __builtin_bit_cast(float, __builtin_amdgcn_readlane(__builtin_bit_cast(int, v), 0)), r1 = __builtin_bit_cast(float, __builtin_amdgcn_readlane(__builtin_bit_cast(int, v), 16));
  const float r2 = __builtin_bit_cast(float, __builtin_amdgcn_readlane(__builtin_bit_cast(int, v), 32)), r3 = __builtin_bit_cast(float, __builtin_amdgcn_readlane(__builtin_bit_cast(int, v), 48));
  return hi ? r2 + r3 : r0 + r1;
}
__device__ __forceinline__ void comb_load(const bf16* PO, const float* ML, int R0, int NA, int lane, CombRow& cr) {
  const int b = R0 >> 11, t = R0 & 2047, qb = t >> 8, rq = (t & 255) + (lane >> 5), l32 = lane & 31;
#pragma unroll
  for (int hm = 0; hm < 8; ++hm) {
    const int bhm = b * 8 + hm, first = bhm * att::STEPS_BHM + att::qb_start(qb), last = first + 4 * qb + 4;
    const int cf = att::chunk_of(first, NA), np = att::chunk_of(last, NA) - cf + 1, slot0 = bhm * 16 + qb + cf - att::chunk_of(bhm * att::STEPS_BHM, NA);
#pragma unroll
    for (int p = 0; p < 3; ++p) { if (p < np) { const int slot = slot0 + p; const v2u ml = *(const v2u*)(ML + (size_t)slot * 512 + rq * 2);
        const unsigned mx_ = ml.x, my_ = ml.y; cr.mp[hm][p] = __builtin_bit_cast(float, mx_); cr.lp[hm][p] = __builtin_bit_cast(float, my_);
        cr.op[hm][p] = ((const v4u*)(PO + ((size_t)slot * 256 + rq) * 256))[l32]; } else { cr.mp[hm][p] = -1e30f; cr.lp[hm][p] = 0.f; cr.op[hm][p] = (v4u){0u, 0u, 0u, 0u}; } }
  }
}
__device__ __forceinline__ void comb_finish(bf16* A2, int R0, int lane, float lam, const f32x4 sg0, const f32x4 sg1, const CombRow& cr) {
  const bool hi = lane >= 32; const int l32 = lane & 31;
#pragma unroll
  for (int h = 0; h < 4; ++h) {
    float om[2][8];
#pragma unroll
    for (int m = 0; m < 2; ++m) { const int hm = h * 2 + m;
      const float M = fmaxf(cr.mp[hm][0], fmaxf(cr.mp[hm][1], cr.mp[hm][2]));
      float wsum = 0.f, acc[8];
#pragma unroll
      for (int i = 0; i < 8; ++i) acc[i] = 0.f;
#pragma unroll
      for (int p = 0; p < 3; ++p) { const float w = cr.lp[hm][p] * exp2f(cr.mp[hm][p] - M); wsum += w; const v4u ow = cr.op[hm][p];
#pragma unroll
        for (int i = 0; i < 4; ++i) { const unsigned wd = ow[i]; acc[2 * i] += bflo(wd) * w; acc[2 * i + 1] += bfhi(wd) * w; } }
      const float iw = 1.0f / wsum;
#pragma unroll
      for (int i = 0; i < 8; ++i) om[m][i] = acc[i] * iw;
    }
    float o[8], ss = 0.f;
#pragma unroll
    for (int i = 0; i < 8; ++i) { o[i] = om[0][i] - om[1][i] * lam; ss += o[i] * o[i]; }
    const float rs = rsqrtf(half_sum_dpp(ss, hi) * (1.0f / 256.f) + EPS) * 0.8f;
    v4u w; w.x = pk2(o[0] * rs * sg0.x, o[1] * rs * sg0.y); w.y = pk2(o[2] * rs * sg0.z, o[3] * rs * sg0.w); w.z = pk2(o[4] * rs * sg1.x, o[5] * rs * sg1.y); w.w = pk2(o[6] * rs * sg1.z, o[7] * rs * sg1.w);
    ((v4u*)(A2 + (size_t)(R0 + (hi ? 1 : 0)) * DM + h * 256))[l32] = w;
  }
}
__device__ __forceinline__ void p3_combine(const Frame& F, const Args& a, int NA) {
  const bf16* PO = (const bf16*)(F.ws + WS_PO); const float* ML = (const float*)(F.ws + WS_ML);
  bf16* A2 = (bf16*)(F.ws + WS_A2);
  const float lam = *(const float*)(F.ws + WS_LAM);
  const int gw = blockIdx.x * NWAVES + F.wave, NGW = gridDim.x * NWAVES, lane = F.lane;
  const f32x4 sg0 = ((const f32x4*)a.in[IN_SUBG])[2 * (lane & 31)], sg1 = ((const f32x4*)a.in[IN_SUBG])[2 * (lane & 31) + 1];
  for (int k = gw; k < MROWS / 4; k += NGW) {
#pragma unroll 1
    for (int s = 0; s < 2; ++s) { const int P = s ? MROWS / 2 - 1 - k : k;
      CombRow r0;
      comb_load(PO, ML, 2 * P, NA, lane, r0);
      comb_finish(A2, 2 * P, lane, lam, sg0, sg1, r0); }
  }
}
struct EpiRes {
  static constexpr bool PERM = true, AFTER_DRAIN = false;
  const float* x; float* out; bf16* H1b; float* SSQ;
  __device__ __forceinline__ void operator()(const pg8::f32x4 (&acc)[2][2][4][2], const pg8::Unit& u, int wr, int wc, int fr, int fq) const {
    const int row0 = u.pm * 256 + wr * 64 + fr, col0 = u.pn * 256 + wc * 32 + 8 * fq;
#pragma unroll
    for (int ai = 0; ai < 2; ++ai) {
      f32x4 xv[4][2][2];
#pragma unroll
      for (int m = 0; m < 4; ++m)
#pragma unroll
        for (int bj = 0; bj < 2; ++bj) { const size_t off = (size_t)(row0 + ai * 128 + m * 16) * DM + col0 + bj * 128; xv[m][bj][0] = *(const f32x4*)(x + off); xv[m][bj][1] = *(const f32x4*)(x + off + 4); }
#pragma unroll
      for (int m = 0; m < 4; ++m) { const size_t R = (size_t)(row0 + ai * 128 + m * 16); float s = 0.f;
#pragma unroll
        for (int bj = 0; bj < 2; ++bj) { const size_t off = R * DM + col0 + bj * 128;
          const f32x4 v0 = acc[ai][bj][m][0] + xv[m][bj][0], v1 = acc[ai][bj][m][1] + xv[m][bj][1];
          v4u w; w.x = pk2(v0.x, v0.y); w.y = pk2(v0.z, v0.w); w.z = pk2(v1.x, v1.y); w.w = pk2(v1.z, v1.w);
          *(v4u*)(H1b + off) = w;
          s += (v0.x * v0.x + v0.y * v0.y) + (v0.z * v0.z + v0.w * v0.w) + (v1.x * v1.x + v1.y * v1.y) + (v1.z * v1.z + v1.w * v1.w); }
        s += __shfl_xor(s, 16); s += __shfl_xor(s, 32);
        if (fq == 0) SSQ[R * 32 + u.pn * 4 + wc] = s; }
    }
  }
};
#ifndef PEER_U_FP8
#define PEER_U_FP8 0
#endif
typedef __bf16 bfv2 __attribute__((ext_vector_type(2)));
__device__ __forceinline__ void split_hl(const f32x4 a, const f32x4 b, bf16x8& hi, bf16x8& lo) {
  float v[8] = {a.x, a.y, a.z, a.w, b.x, b.y, b.z, b.w}; unsigned h[8], l[8];
#pragma unroll
  for (int i = 0; i < 8; ++i) { h[i] = f2bf(v[i]); l[i] = f2bf(v[i] - __builtin_bit_cast(float, h[i] << 16)); }
  v4u hv = {h[0] | (h[1] << 16), h[2] | (h[3] << 16), h[4] | (h[5] << 16), h[6] | (h[7] << 16)};
  v4u lv = {l[0] | (l[1] << 16), l[2] | (l[3] << 16), l[4] | (l[5] << 16), l[6] | (l[7] << 16)};
  hi = __builtin_bit_cast(bf16x8, hv); lo = __builtin_bit_cast(bf16x8, lv);
}
__device__ __forceinline__ void p0_w3t(const Frame& F, const Args& a) {
  const float* wq = a.in[IN_WQ]; const float* sk = a.in[IN_SUBK]; const float* g2 = a.in[IN_G2];
  bf16* W3t = (bf16*)(F.ws + WS_W3T);
  const int lane = F.lane, fr = lane & 15, fq = lane >> 4;
  constexpr int SKS = 272;
  LAS unsigned char* shi = F.lds; LAS unsigned char* slo = F.lds + 128 * SKS;
  for (int bt = blockIdx.x; bt < 256; bt += gridDim.x) {
    const int hh = bt & 15, kt = (bt >> 4) * 8 + F.wave;
    const float* ap = wq + (size_t)(kt * 16 + fr) * DM + hh * 128 + fq * 8;
    f32x4 a0[4], a1[4];
#pragma unroll
    for (int s = 0; s < 4; ++s) { a0[s] = *(const f32x4*)(ap + 32 * s); a1[s] = *(const f32x4*)(ap + 32 * s + 4); }
    const f32x4 gk = *(const f32x4*)(g2 + kt * 16 + fq * 4);
    __syncthreads();
#pragma unroll
    for (int i = 0; i < 4; ++i) { const int idx = F.tid + NTHR * i, key = idx >> 4, c8 = idx & 15; const float* p = sk + (size_t)(hh * 128 + key) * 128 + c8 * 8;
      bf16x8 h, l; split_hl(*(const f32x4*)p, *(const f32x4*)(p + 4), h, l);
      *(LAS bf16x8*)(shi + key * SKS + c8 * 16) = h; *(LAS bf16x8*)(slo + key * SKS + c8 * 16) = l; }
    bf16x8 ahi[4], alo[4];
#pragma unroll
    for (int s = 0; s < 4; ++s) split_hl(a0[s], a1[s], ahi[s], alo[s]);
    __syncthreads();
#pragma unroll 2
    for (int t2 = 0; t2 < 8; ++t2) {
      const LAS unsigned char* bh = shi + (t2 * 16 + fr) * SKS + fq * 16; const LAS unsigned char* bl = slo + (t2 * 16 + fr) * SKS + fq * 16;
      f32x4 acc = {0.f, 0.f, 0.f, 0.f};
#pragma unroll
      for (int s = 0; s < 4; ++s) { const bf16x8 bhi = *(const LAS bf16x8*)(bh + 64 * s), blo = *(const LAS bf16x8*)(bl + 64 * s);
        acc = __builtin_amdgcn_mfma_f32_16x16x32_bf16(ahi[s], bhi, acc, 0, 0, 0);
        acc = __builtin_amdgcn_mfma_f32_16x16x32_bf16(ahi[s], blo, acc, 0, 0, 0);
        acc = __builtin_amdgcn_mfma_f32_16x16x32_bf16(alo[s], bhi, acc, 0, 0, 0); }
      v2u o; o.x = pk2(acc.x * gk.x, acc.y * gk.y); o.y = pk2(acc.z * gk.z, acc.w * gk.w);
      *(v2u*)(W3t + (size_t)(hh * 128 + t2 * 16 + fr) * DM + kt * 16 + fq * 4) = o;
    }
  }
  __syncthreads();
}
typedef float f32x2v __attribute__((ext_vector_type(2)));
__device__ __forceinline__ void p0_tables(const Frame& F, const Args& a) {
  const float* g2 = a.in[IN_G2];
  float* SCL = (float*)(F.ws + WS_SCL);
  const int gw = blockIdx.x * NWAVES + F.wave, NGW = gridDim.x * NWAVES, lane = F.lane;
  f32x4 gl[8];
#pragma unroll
  for (int q = 0; q < 8; ++q) gl[q] = *(const f32x4*)(g2 + q * 256 + lane * 4);
  f32x4 xn[8];
  { const int row = gw; if (row < 2 * 16384) { const float* src = a.in[row >= 16384 ? IN_V : IN_U] + (size_t)(row & 16383) * DM + lane * 4;
#pragma unroll
      for (int q = 0; q < 8; ++q) xn[q] = *(const f32x4*)(src + q * 256); } }
  for (int row = gw; row < 2 * 16384; row += NGW) {
    const bool isv = row >= 16384; const int e = row & 16383;
    f32x4 x[8];
#pragma unroll
    for (int q = 0; q < 8; ++q) x[q] = xn[q];
    { const int rn = row + NGW; if (rn < 2 * 16384) { const float* src = a.in[rn >= 16384 ? IN_V : IN_U] + (size_t)(rn & 16383) * DM + lane * 4;
#pragma unroll
        for (int q = 0; q < 8; ++q) xn[q] = *(const f32x4*)(src + q * 256); } }
    float amax = 0.f, ssq = 0.f;
#pragma unroll
    for (int q = 0; q < 8; ++q) { if (!isv) x[q] = x[q] * gl[q]; amax = fmaxf(amax, fmaxf(fmaxf(fabsf(x[q].x), fabsf(x[q].y)), fmaxf(fabsf(x[q].z), fabsf(x[q].w))));
      ssq += (x[q].x * x[q].x + x[q].y * x[q].y) + (x[q].z * x[q].z + x[q].w * x[q].w); }
#pragma unroll
    for (int o = 1; o < 64; o <<= 1) amax = fmaxf(amax, __shfl_xor(amax, o));
    v4u w;
    if (isv) {
      const float sc = amax > 0.f ? 6.0f / amax : 1.0f;
#pragma unroll
      for (int d = 0; d < 4; ++d) { unsigned pk = 0u;
        pk = __builtin_amdgcn_cvt_scalef32_pk_fp4_f32(pk, x[2 * d].x * sc, x[2 * d].y * sc, 1.0f, 0); pk = __builtin_amdgcn_cvt_scalef32_pk_fp4_f32(pk, x[2 * d].z * sc, x[2 * d].w * sc, 1.0f, 1);
        pk = __builtin_amdgcn_cvt_scalef32_pk_fp4_f32(pk, x[2 * d + 1].x * sc, x[2 * d + 1].y * sc, 1.0f, 2); pk = __builtin_amdgcn_cvt_scalef32_pk_fp4_f32(pk, x[2 * d + 1].z * sc, x[2 * d + 1].w * sc, 1.0f, 3);
        w[d] = pk; }
      if (lane == 0) SCL[row] = 1.0f / sc;
    } else {
      ssq = wave_sum_dpp(ssq);
      const float sA = amax > 0.f ? amax * (1.0f / 7.0f) : 1.0f, sB = fminf(sA, 0.36f * sqrtf(ssq * (1.0f / DM)) + 1e-30f);
      const float iA = 1.0f / sA, iB = 1.0f / sB;
      float eA = 0.f, eB = 0.f;
#pragma unroll
      for (int q = 0; q < 8; ++q)
#pragma unroll
        for (int j = 0; j < 4; ++j) { const float v = x[q][j];
          const float da = v - sA * __builtin_amdgcn_fmed3f(__builtin_rintf(v * iA), -7.0f, 7.0f), db = v - sB * __builtin_amdgcn_fmed3f(__builtin_rintf(v * iB), -7.0f, 7.0f);
          eA += da * da; eB += db * db; }
      eA = wave_sum_dpp(eA); eB = wave_sum_dpp(eB);
      const bool useB = eB < eA; const float st = useB ? sB : sA, is = useB ? iB : iA;
#pragma unroll
      for (int d = 0; d < 4; ++d) { unsigned pk = 0u;
#pragma unroll
        for (int p = 0; p < 8; ++p) { const float v = x[2 * d + (p >> 2)][p & 3]; const int qi = (int)__builtin_amdgcn_fmed3f(__builtin_rintf(v * is), -7.0f, 7.0f); pk |= ((unsigned)qi & 15u) << (4 * p); }
        w[d] = pk; }
      if (lane == 0) SCL[row] = st;
    }
    *(v4u*)(F.ws + (isv ? WS_VB8 : WS_UB) + (size_t)e * 1024 + lane * 16) = w;
  }
}
struct EpiScore {
  static constexpr bool PERM = true, AFTER_DRAIN = false;
  float* S; const LAS float* rs;
  __device__ __forceinline__ void operator()(const pg8::f32x4 (&acc)[2][2][4][2], const pg8::Unit& u, int wr, int wc, int fr, int fq) const {
    const int rl0 = wr * 64 + fr, keyb = wc * 32 + 8 * fq;
#pragma unroll
    for (int ai = 0; ai < 2; ++ai)
#pragma unroll
      for (int m = 0; m < 4; ++m) { const int rl = rl0 + ai * 128 + m * 16; const float r = rs[rl]; const int row = u.pm * 256 + rl;
#pragma unroll
        for (int bj = 0; bj < 2; ++bj) { float* d = S + ((size_t)((row >> 5) * 16 + u.pn * 2 + bj) * 128 + keyb) * 32 + (row & 31);
          const pg8::f32x4 v0 = acc[ai][bj][m][0] * r, v1 = acc[ai][bj][m][1] * r;
          d[0] = v0[0]; d[32] = v0[1]; d[64] = v0[2]; d[96] = v0[3]; d[128] = v1[0]; d[160] = v1[1]; d[192] = v1[2]; d[224] = v1[3]; } }
  }
};

__device__ __forceinline__ unsigned fkey(float f) { const unsigned b = __builtin_bit_cast(unsigned, f); return b ^ ((b >> 31) ? 0xFFFFFFFFu : 0x80000000u); }
template <int NV, int K> __device__ __forceinline__ void wave_topk(const unsigned (&u)[NV], bool (&sel)[NV], int lane) {
  unsigned prefix = 0u; int cge = NV * 64;
#pragma unroll 1
  for (int bit = 31; bit >= 0 && cge != K; --bit) {
    const unsigned cand = prefix | (1u << bit); int c = 0;
#pragma unroll
    for (int i = 0; i < NV; ++i) c += __builtin_popcountll(__ballot(u[i] >= cand));
    if (c >= K) { prefix = cand; cge = c; }
  }
  int cgt = 0;
#pragma unroll
  for (int i = 0; i < NV; ++i) cgt += __builtin_popcountll(__ballot(u[i] > prefix));
  int need = K - cgt;
  const unsigned long long lm = (1ull << lane) - 1ull;
#pragma unroll
  for (int i = 0; i < NV; ++i) { const unsigned long long eq = __ballot(u[i] == prefix); const int before = __builtin_popcountll(eq & lm);
    sel[i] = (u[i] > prefix) || (u[i] == prefix && before < need); const int ne = __builtin_popcountll(eq); need = need > ne ? need - ne : 0; }
}
template <int NG, int NV, int K> __device__ __forceinline__ void wave_topk_multi(const unsigned (&u)[NG][NV], bool (&sel)[NG][NV], int lane) {
  unsigned prefix[NG]; int cge[NG];
#pragma unroll
  for (int g = 0; g < NG; ++g) { prefix[g] = 0u; cge[g] = NV * 64; }
#pragma unroll 1
  for (int bit = 31; bit >= 0; --bit) {
    bool done = true;
#pragma unroll
    for (int g = 0; g < NG; ++g) done = done && (cge[g] == K);
    if (done) break;
#pragma unroll
    for (int g = 0; g < NG; ++g) { const unsigned cand = prefix[g] | (1u << bit); int c = 0;
#pragma unroll
      for (int i = 0; i < NV; ++i) c += __builtin_popcountll(__ballot(u[g][i] >= cand));
      if (cge[g] != K && c >= K) { prefix[g] = cand; cge[g] = c; } }
  }
  const unsigned long long lm = (1ull << lane) - 1ull;
#pragma unroll
  for (int g = 0; g < NG; ++g) { int cgt = 0;
#pragma unroll
    for (int i = 0; i < NV; ++i) cgt += __builtin_popcountll(__ballot(u[g][i] > prefix[g]));
    int need = K - cgt;
#pragma unroll
    for (int i = 0; i < NV; ++i) { const unsigned long long eq = __ballot(u[g][i] == prefix[g]); const int before = __builtin_popcountll(eq & lm);
      sel[g][i] = (u[g][i] > prefix[g]) || (u[g][i] == prefix[g] && before < need); const int ne = __builtin_popcountll(eq); need = need > ne ? need - ne : 0; } }
}
__device__ __forceinline__ float gelu_erf(float v) {
  const float av = fabsf(v), t = __builtin_amdgcn_rcpf(1.0f + 0.2316418882f * av);
  float q = t * 0.5307027145f - 0.7265760135f; q = q * t + 0.7107068705f; q = q * t - 0.142248368f; q = q * t + 0.127414796f; q = q * t;
  const float tail = q * __builtin_amdgcn_exp2f(v * v * -0.72134752044f);
  return v < 0.f ? v * tail : v - v * tail;
}

#ifndef ROUTE_REPS
#define ROUTE_REPS 1
#endif
__device__ __forceinline__ void ins16(float (&t)[16], float x) {
#pragma unroll
  for (int i = 15; i >= 1; --i) t[i] = __builtin_amdgcn_fmed3f(t[i - 1], t[i], x);
  t[0] = fmaxf(t[0], x);
}
__device__ __forceinline__ void p6_peer(const Frame& F, const Args& a, float* dst_base) {
  const float* S2 = (const float*)(F.ws + WS_S); const float* SSQ = (const float*)(F.ws + WS_SSQ); const bf16* H1b = (const bf16*)(F.ws + WS_H1B);
  int lane = F.lane, wv = F.wave, tid = F.tid; asm volatile("" : "+v"(lane), "+s"(wv), "+v"(tid));
  int* EIDg = (int*)(F.ws + WS_EID); float* EGTg = (float*)(F.ws + WS_EGT);
  LAS int* eid = (LAS int*)(F.lds + wv * 5120); LAS float* cg = (LAS float*)(eid + 512); LAS float* esu = (LAS float*)(eid + 1024); LAS float* dq = (LAS float*)(eid + 1152);
  LAS unsigned char* RB = F.lds + 40960 + wv * 8192;
  LAS float* L1 = (LAS float*)(F.lds + 40960);
  TP_BEGIN(11);
#ifdef TPROBE
  const unsigned long long tp_p7_ = __builtin_amdgcn_s_memrealtime();
#endif
  for (int tb = blockIdx.x; tb < MROWS / 32; tb += gridDim.x) {
    __syncthreads();
    {
      const int g = tid >> 5, tl = tid & 31; const float* src = S2 + ((size_t)(tb * 16 + g) * 128) * 32 + tl;
      float t[16];
#pragma unroll
      for (int i = 0; i < 16; ++i) t[i] = -INFINITY;
      float sv[128];
#pragma unroll
      for (int k = 0; k < 128; ++k) sv[k] = src[k * 32];
#pragma unroll
      for (int k = 0; k < 128; ++k) ins16(t, __builtin_bit_cast(float, (__builtin_bit_cast(unsigned, sv[k]) & ~0x7Fu) | (unsigned)(127 - k)));
#pragma unroll
      for (int i = 0; i < 16; ++i) L1[(g * 16 + i) * 32 + tl] = t[i];
    }
    __syncthreads();
    if (tid < 256) {
      const int h8 = tid >> 5, tl = tid & 31; const LAS float* LA = L1 + ((2 * h8) * 16) * 32 + tl; const LAS float* LB = L1 + ((2 * h8 + 1) * 16) * 32 + tl;
      float A[16], B[16], t[16];
#pragma unroll
      for (int i = 0; i < 16; ++i) { A[i] = LA[i * 32]; B[i] = LB[i * 32]; t[i] = -INFINITY; }
#pragma unroll
      for (int i = 0; i < 16; ++i)
#pragma unroll
        for (int j = 0; j < 16; ++j) if ((i + 1) * (j + 1) <= 16) { const float c = A[i] + B[j];
            ins16(t, __builtin_bit_cast(float, (__builtin_bit_cast(unsigned, c) & ~0xFFu) | (unsigned)(255 - (i * 16 + j)))); }
      float ev[16], es = 0.f;
#pragma unroll
      for (int r = 0; r < 16; ++r) { ev[r] = __expf(t[r] - t[0]); es += ev[r]; }
      const float inv = 1.0f / es;
#pragma unroll
      for (int r = 0; r < 16; ++r) { const unsigned flat = 255u - (__builtin_bit_cast(unsigned, t[r]) & 0xFFu), ii = flat >> 4, jj = flat & 15u;
        const unsigned ka = 127u - (__builtin_bit_cast(unsigned, LA[ii * 32]) & 0x7Fu), kb = 127u - (__builtin_bit_cast(unsigned, LB[jj * 32]) & 0x7Fu);
        EIDg[(size_t)(tb * 32 + tl) * 128 + h8 * 16 + r] = (int)(ka * 128u + kb); EGTg[(size_t)(tb * 32 + tl) * 128 + h8 * 16 + r] = ev[r] * inv; }
    }
    asm volatile("s_waitcnt vmcnt(0)" ::: "memory"); __syncthreads();
    TP_END(11, F.ws);
    const unsigned char* U8 = F.ws + WS_UB; const unsigned char* V8 = F.ws + WS_VB8;
    constexpr int NBT = 2;
#define PG_ISSUE(TAB, E) do { const int idq_ = __builtin_amdgcn_readfirstlane(eidt[(E)]); \
      __builtin_amdgcn_global_load_lds((const unsigned*)((TAB) + (size_t)idq_ * 1024 + lane * 16), (LAS unsigned*)(RB + ((E) & 7) * 1024), 16, 0, 0); } while (0)
#pragma unroll 1
    for (int tt = 0; tt < 4; ++tt) {
      const int tok = tb * 32 + wv * 4 + tt;
      LAS int* eidt = eid + tt * 128; LAS float* cgt = cg + tt * 128;
      const float rs = rsqrtf(wave_sum_dpp(lane < 32 ? SSQ[(size_t)tok * 32 + lane] : 0.f) * (1.0f / DM) + EPS);
      { const float* SCL = (const float*)(F.ws + WS_SCL);
#pragma unroll
        for (int i = 0; i < 2; ++i) { const int e = lane + 64 * i, idq = __builtin_nontemporal_load(EIDg + (size_t)tok * 128 + e);
          eidt[e] = idq; esu[e] = SCL[idq]; cgt[e] = __builtin_nontemporal_load(EGTg + (size_t)tok * 128 + e) * SCL[16384 + idq]; } }
      unsigned xw[16];
      { const bf16* xp = H1b + (size_t)tok * DM + (size_t)lane * 4;
#pragma unroll
        for (int q = 0; q < 8; ++q) { const v2u x0 = *(const v2u*)(xp + q * 256); xw[2 * q] = x0.x; xw[2 * q + 1] = x0.y; } }
      int xl[4], xh[4]; float rsx;
      { float xa = 0.f;
#pragma unroll
        for (int i = 0; i < 16; ++i) xa = fmaxf(xa, fmaxf(fabsf(bflo(xw[i])), fabsf(bfhi(xw[i]))));
#pragma unroll
        for (int o = 1; o < 64; o <<= 1) xa = fmaxf(xa, __shfl_xor(xa, o));
        const float xinv = xa > 0.f ? 119.0f / xa : 0.f; rsx = rs * (xa > 0.f ? xa * (1.0f / 119.0f) : 0.f);
#pragma unroll
        for (int d = 0; d < 4; ++d) { unsigned pl = 0u, ph = 0u;
#pragma unroll
          for (int p = 0; p < 8; ++p) { const int i = 8 * d + p; const float v = (i & 1) ? bfhi(xw[i >> 1]) : bflo(xw[i >> 1]);
            const int xi = (int)__builtin_rintf(v * xinv), l = ((xi + 8) & 15) - 8, h = (xi - l) >> 4;
            pl |= ((unsigned)l & 15u) << (4 * p); ph |= ((unsigned)h & 15u) << (4 * p); }
          xl[d] = (int)pl; xh[d] = (int)ph; } }
      asm volatile("s_waitcnt vmcnt(0) lgkmcnt(0)" ::: "memory");
#define DPPI(X, CTRL) __builtin_amdgcn_update_dpp(0, (X), (CTRL), 0xF, 0xF, true)
#define PU_BATCH(E0, DOISSUE) do { v4u ub[4]; \
        _Pragma("unroll") for (int q = 0; q < 4; ++q) ub[q] = *(const LAS v4u*)(RB + (((E0) + q) & 7) * 1024 + lane * 16); \
        asm volatile("s_waitcnt lgkmcnt(0)" ::: "memory"); \
        if (DOISSUE) { _Pragma("unroll") for (int q = 0; q < 4; ++q) PG_ISSUE(U8, (E0) + 8 + q); } \
        int a_[4]; _Pragma("unroll") for (int q = 0; q < 4; ++q) { int al_ = 0, ah_ = 0; _Pragma("unroll") for (int dd = 0; dd < 4; ++dd) { const int wa = (int)ub[q][dd]; \
            al_ = __builtin_amdgcn_sdot8(wa, xl[dd], al_, false); ah_ = __builtin_amdgcn_sdot8(wa, xh[dd], ah_, false); } a_[q] = ah_ * 16 + al_; } \
        const int r01_ = (o1 ? a_[1] : a_[0]) + DPPI(o1 ? a_[0] : a_[1], 0xB1), r23_ = (o1 ? a_[3] : a_[2]) + DPPI(o1 ? a_[2] : a_[3], 0xB1); \
        int r_ = (o2 ? r23_ : r01_) + DPPI(o2 ? r01_ : r23_, 0x4E); \
        r_ += DPPI(r_, 0x124); r_ += DPPI(r_, 0x128); \
        { auto s_ = __builtin_amdgcn_permlane16_swap((unsigned)r_, (unsigned)r_, false, false); const unsigned s0_ = s_[0], s1_ = s_[1]; r_ = (int)(s0_ + s1_); } \
        { auto s_ = __builtin_amdgcn_permlane32_swap((unsigned)r_, (unsigned)r_, false, false); const unsigned s0_ = s_[0], s1_ = s_[1]; r_ = (int)(s0_ + s1_); } \
        if (lane < 4) dqi[(E0) + lane] = r_; } while (0)
      const bool o1 = (lane & 1) != 0, o2 = (lane & 2) != 0; LAS int* dqi = (LAS int*)dq;
#pragma unroll
      for (int e = 0; e < 8; ++e) PG_ISSUE(U8, e);
#pragma unroll 1
      for (int e = 0; e < 120; e += 4) {
        asm volatile("s_waitcnt vmcnt(4)" ::: "memory");
        PU_BATCH(e, true);
        asm volatile("" ::: "memory");
      }
      asm volatile("s_waitcnt vmcnt(0)" ::: "memory");
#pragma unroll 1
      for (int e = 120; e < 128; e += 4) PU_BATCH(e, false);
      asm volatile("s_waitcnt lgkmcnt(0)" ::: "memory");
#pragma unroll
      for (int i = 0; i < 2; ++i) { const int e = lane + 64 * i; cgt[e] = gelu_erf((float)dqi[e] * (rsx * esu[e])) * cgt[e]; }
      asm volatile("s_waitcnt lgkmcnt(0)" ::: "memory");
#undef DPPI
#undef PU_BATCH
    }
#pragma unroll 1
    for (int tt = 0; tt < 4; ++tt) {
      const int tok = tb * 32 + wv * 4 + tt;
      LAS int* eidt = eid + tt * 128; LAS float* cgt = cg + tt * 128;
      float y[32];
#pragma unroll
      for (int i = 0; i < 32; ++i) y[i] = 0.f;
#define PV_BATCH(E0, DOISSUE) do { v4u vb[NBT]; float c_[NBT]; \
        _Pragma("unroll") for (int q = 0; q < NBT; ++q) { vb[q] = *(const LAS v4u*)(RB + (((E0) + q) & 7) * 1024 + lane * 16); c_[q] = cgt[(E0) + q]; } \
        asm volatile("s_waitcnt lgkmcnt(0)" ::: "memory"); \
        if (DOISSUE) { _Pragma("unroll") for (int q = 0; q < NBT; ++q) PG_ISSUE(V8, (E0) + 8 + q); } \
        _Pragma("unroll") for (int q = 0; q < NBT; ++q) { _Pragma("unroll") for (int dd = 0; dd < 4; ++dd) { const unsigned wa = vb[q][dd]; \
            { const f32x2v v2 = __builtin_amdgcn_cvt_scalef32_pk_f32_fp4(wa, 1.0f, 0); y[8 * dd + 0] += c_[q] * v2.x; y[8 * dd + 1] += c_[q] * v2.y; } \
            { const f32x2v v2 = __builtin_amdgcn_cvt_scalef32_pk_f32_fp4(wa, 1.0f, 1); y[8 * dd + 2] += c_[q] * v2.x; y[8 * dd + 3] += c_[q] * v2.y; } \
            { const f32x2v v2 = __builtin_amdgcn_cvt_scalef32_pk_f32_fp4(wa, 1.0f, 2); y[8 * dd + 4] += c_[q] * v2.x; y[8 * dd + 5] += c_[q] * v2.y; } \
            { const f32x2v v2 = __builtin_amdgcn_cvt_scalef32_pk_f32_fp4(wa, 1.0f, 3); y[8 * dd + 6] += c_[q] * v2.x; y[8 * dd + 7] += c_[q] * v2.y; } } \
          __builtin_amdgcn_sched_barrier(0); } } while (0)
#pragma unroll
      for (int e = 0; e < 8; ++e) PG_ISSUE(V8, e);
#pragma unroll 1
      for (int e = 0; e < 120; e += NBT) {
        asm volatile("s_waitcnt vmcnt(6)" ::: "memory");
        PV_BATCH(e, true);
        asm volatile("" ::: "memory");
      }
      asm volatile("s_waitcnt vmcnt(0)" ::: "memory");
      unsigned xw[16];
      { const bf16* xp = H1b + (size_t)tok * DM + (size_t)lane * 4;
#pragma unroll
        for (int q = 0; q < 8; ++q) { const v2u x0 = *(const v2u*)(xp + q * 256); xw[2 * q] = x0.x; xw[2 * q + 1] = x0.y; } }
#pragma unroll 1
      for (int e = 120; e < 128; e += NBT) PV_BATCH(e, false);
      asm volatile("s_waitcnt lgkmcnt(0)" ::: "memory");
#undef PV_BATCH
      float* drow = dst_base + (size_t)tok * DM;
#pragma unroll
      for (int q = 0; q < 8; ++q) { const size_t off = (size_t)q * 256 + lane * 4; f32x4 hv;
        hv.x = bflo(xw[2 * q]) + y[4 * q];
#ifdef TPROBE
        if (TPROBE != 13 && tok == 0 && lane == 0 && q == 0) hv.x += 10.0f + (float)(*(volatile unsigned*)(F.ws + 64)) * (0.01f / TP_DIV);
        if (TPROBE == 13 && (int)blockIdx.x == TP_BLOCK && wv == 7 && tt == 3 && lane == 0 && q == 0) hv.x += 10.0f + (float)(unsigned)(__builtin_amdgcn_s_memrealtime() - tp_p7_) * (0.01f / TP_DIV);
#endif
        hv.y = bfhi(xw[2 * q]) + y[4 * q + 1]; hv.z = bflo(xw[2 * q + 1]) + y[4 * q + 2]; hv.w = bfhi(xw[2 * q + 1]) + y[4 * q + 3]; *(f32x4*)(drow + off) = hv; }
    }
#undef PG_ISSUE
  }
}
constexpr int MISC_LDS = LDS_BYTES - 256;
__global__ void __launch_bounds__(NTHR, 2) mk_fwd(Args args) {
  extern __shared__ __attribute__((aligned(16))) unsigned char lds_raw[];
  Frame F; F.lds = (LAS unsigned char*)lds_raw; F.ws = args.ws; F.tid = threadIdx.x; F.lane = F.tid & 63; F.wave = __builtin_amdgcn_readfirstlane(F.tid >> 6);
  const int lo = args.ph_lo, hi = args.ph_hi, G = (int)gridDim.x, bx = (int)blockIdx.x;
  volatile LAS unsigned* misc = (volatile LAS unsigned*)(F.lds + MISC_LDS);
  if (F.tid < 16) misc[F.tid] = 0u;
  __syncthreads();
  XcdBarrier bar = xcd_barrier_post((unsigned*)(F.ws + WS_CTL) + CW_BAR, misc);
#define IN(k) (lo <= (k) && (k) < hi)
#ifdef TPROBE
#define SEAM(k) do { if (IN(k) && IN((k) + 1)) { const unsigned long long tq0_ = __builtin_amdgcn_s_memrealtime(); xcd_barrier(bar); const unsigned long long tq1_ = __builtin_amdgcn_s_memrealtime(); \
    if (TPROBE == 20 + (k) && (int)blockIdx.x == TP_BLOCK && threadIdx.x == 0) atomicAdd((unsigned*)(F.ws + 64), (unsigned)(tq1_ - tq0_)); } } while (0)
#else
#define SEAM(k) do { if (IN(k) && IN((k) + 1)) xcd_barrier(bar); } while (0)
#endif
#define PHASE_FRAME(Fp) Frame Fp = F; asm volatile("" : "+v"(Fp.tid), "+v"(Fp.lane))
  const int NA = G;
  if (IN(0)) { PHASE_FRAME(F0); TP_BEGIN(1);
#ifdef SLEEP_START
#pragma unroll 1
    for (int i_ = 0; i_ < SLEEP_START; ++i_) __builtin_amdgcn_s_sleep(127);
#endif
    p0_lam(F0, args);
    p0_zero_vpad(F0);
    TP_BEGIN(41); p0_rows(F0, args); TP_END(41, F.ws);
    TP_BEGIN(42); p0_transpose<true>(F0, args, args.in[IN_WIN], DPROJ, NPROJ, (bf16*)(F.ws + WS_W1T));
    p0_transpose<false>(F0, args, args.in[IN_WOUT], DM, DM, (bf16*)(F.ws + WS_W2T)); TP_END(42, F.ws);
    TP_BEGIN(43); p0_w3t(F0, args); TP_END(43, F.ws);
    TP_BEGIN(44); p0_tables(F0, args); TP_END(44, F.ws);
#ifdef DUP_ROWS
    p0_rows(F0, args);
#endif
#ifdef DUP_TR
    p0_transpose<true>(F0, args, args.in[IN_WIN], DPROJ, NPROJ, (bf16*)(F.ws + WS_W1T));
    p0_transpose<false>(F0, args, args.in[IN_WOUT], DM, DM, (bf16*)(F.ws + WS_W2T));
#endif
#ifdef DUP_W3T
    p0_w3t(F0, args);
#endif
#ifdef DUP_TAB
    p0_tables(F0, args);
#endif
    TP_END(1, F.ws);
  }
  SEAM(0);
  if (IN(1)) { PHASE_FRAME(F1); TP_BEGIN(2);
    p1_meta_finalize(F1, args);
    pg8::Gemm g{(const pg8::bf16_t*)(F.ws + WS_XN), (const pg8::bf16_t*)(F.ws + WS_W1T), MROWS, NPROJ, DM};
    pg8::StaticOrder S; S.init(MROWS, NPROJ, G, bx);
    EpiProj E{(bf16*)(F.ws + WS_Q), (bf16*)(F.ws + WS_KP), (bf16*)(F.ws + WS_VP), (bf16*)(F.ws + WS_MQ), (bf16*)(F.ws + WS_MK), (bf16*)(F.ws + WS_MV), (bf16*)(F.ws + WS_MO),
              args.in[IN_QNG], args.in[IN_KNG], (LAS float*)(F.lds + XCH_OFF)};
    pg8::gemm_phase<EpiProj, pg8::StaticOrder, true, true>(F.lds + RING_OFF, g, S, E);
    TP_END(2, F.ws);
  }
  SEAM(1);
  if (IN(2)) {
    PHASE_FRAME(F2);
    TP_BEGIN(3);
    att::phase(F2, (G % 8 == 0) ? (bx & 7) * (G >> 3) + (bx >> 3) : bx, NA);
    TP_END(3, F.ws); TP_BEGIN(4);
    for (int task = bx; task < 512; task += G) ml::taskA(F2, args, task);
    TP_END(4, F.ws);
  }
  SEAM(2);
  if (IN(3)) { PHASE_FRAME(F3); TP_BEGIN(5); ml::scanB(F3); TP_END(5, F.ws); TP_BEGIN(6); p3_combine(F3, args, NA); TP_END(6, F.ws);
#ifdef DUP_SCAN
    ml::scanB(F3);
#endif
#ifdef DUP_COMB
    p3_combine(F3, args, NA);
#endif
  }
  SEAM(3);
#ifdef EXTRA_BARS
  for (int i_ = 0; i_ < EXTRA_BARS; ++i_) xcd_barrier(bar);
#endif
  if (IN(4)) {
    PHASE_FRAME(F4);
    TP_BEGIN(7);
    for (int task = bx; task < 512; task += G) ml::taskC(F4, args, task);
    TP_END(7, F.ws);
  }
  SEAM(4);
  if (IN(5)) { TP_BEGIN(8);
    pg8::Gemm g{(const pg8::bf16_t*)(F.ws + WS_A2), (const pg8::bf16_t*)(F.ws + WS_W2T), MROWS, DM, DM};
    pg8::StaticOrder S; S.init(MROWS, DM, G, bx);
    EpiRes E{args.in[IN_X], args.out, (bf16*)(F.ws + WS_H1B), (float*)(F.ws + WS_SSQ)};
    pg8::gemm_phase<EpiRes, pg8::StaticOrder, true, true>(F.lds + RING_OFF, g, S, E);
    TP_END(8, F.ws);
  }
  SEAM(5);
  if (IN(6)) { TP_BEGIN(9);
    pg8::Gemm g{(const pg8::bf16_t*)(F.ws + WS_H1B), (const pg8::bf16_t*)(F.ws + WS_W3T), MROWS, DM, DM};
    pg8::StaticOrder S; S.init(MROWS, DM, G, bx);
    LAS float* rst = (LAS float*)(F.lds + XCH_OFF);
    { pg8::Unit u0; if (S.next(0, u0)) { if (F.tid < 256) { const float* sp = (const float*)(F.ws + WS_SSQ) + ((size_t)u0.pm * 256 + F.tid) * 32; float s = 0.f;
#pragma unroll
          for (int i = 0; i < 8; ++i) { const f32x4 v = ((const f32x4*)sp)[i]; s += (v.x + v.y) + (v.z + v.w); }
          rst[F.tid] = rsqrtf(s * (1.0f / DM) + EPS); } } }
    __syncthreads();
    EpiScore E{(float*)(F.ws + WS_S), rst};
    pg8::gemm_phase<EpiScore, pg8::StaticOrder, true, true>(F.lds + RING_OFF, g, S, E);
    TP_END(9, F.ws);
  }
  SEAM(6);
  if (IN(7)) { PHASE_FRAME(F7); TP_BEGIN(10); p6_peer(F7, args, args.out); TP_END(10, F.ws); }
#undef IN
#undef SEAM
}
extern "C" void kernel_launch(void* const* d_in, const int* in_sizes, int n_in, void* d_out, int out_size, void* d_ws, size_t ws_size, hipStream_t stream) {
  static int grid = 0;
  if (grid == 0) {
    int dev = 0, cus = 0, per_cu = 0;
    if (hipGetDevice(&dev) != hipSuccess || hipDeviceGetAttribute(&cus, hipDeviceAttributeMultiprocessorCount, dev) != hipSuccess) { fprintf(stderr, "device query failed\n"); grid = -1; return; }
    if (hipFuncSetAttribute((const void*)mk_fwd, hipFuncAttributeMaxDynamicSharedMemorySize, LDS_BYTES) != hipSuccess) { fprintf(stderr, "hipFuncSetAttribute failed\n"); grid = -1; return; }
    if (hipOccupancyMaxActiveBlocksPerMultiprocessor(&per_cu, (const void*)mk_fwd, NTHR, LDS_BYTES) != hipSuccess || per_cu < 1) { fprintf(stderr, "occupancy query says %d workgroups per CU: not launching\n", per_cu); (void)hipGetLastError(); grid = -1; return; }
    (void)hipGetLastError();
    grid = cus;
    if (n_in != 22 || ws_size < (size_t)512 * MiB || out_size != MROWS * DM) { fprintf(stderr, "unexpected shapes: n_in %d out %d ws %zu\n", n_in, out_size, ws_size); grid = -1; return; }
  }
  if (grid < 0) return;
  unsigned char* ws = (unsigned char*)d_ws;
  if (hipMemsetAsync(ws + WS_CTL, 0, CTL_ZERO_BYTES, stream) != hipSuccess) { fprintf(stderr, "memset failed\n"); return; }
  Args a{};
  for (int i = 0; i < 22; ++i) a.in[i] = (const float*)d_in[i];
  a.out = (float*)d_out; a.ws = ws; a.na = 0; a.pad = 0;
  a.ph_lo = 0; a.ph_hi = 8;
  hipLaunchKernelGGL(mk_fwd, dim3(grid), dim3(NTHR), LDS_BYTES, stream, a);
}
```

```cpp
#include <hip/hip_runtime.h>
#include <cstdio>
#include <cstdint>
#include <math.h>
namespace pg8 {
#define PG8_LAS __attribute__((address_space(3)))
typedef unsigned short bf16_t;
typedef short bf16x8 __attribute__((ext_vector_type(8)));
typedef float f32x4 __attribute__((ext_vector_type(4)));
typedef unsigned u32x4 __attribute__((ext_vector_type(4)));
constexpr int BM = 256, BK = 64, HALF = 128, HTB = HALF * BK * 2  , STAGE_BYTES = 8 * HTB, NXCD = 8, WGM = 8;

__host__ __device__ __forceinline__ int lds_byte(int r, int c) { const int st = (r >> 4) * 2 + (c >> 5), rr = r & 15, cc = c & 31, ob = rr * 64 + cc * 2; return st * 1024 + (ob ^ (((ob >> 9) & 1) << 5)); }
__host__ __device__ __forceinline__ void stage_rc(int b, int& R, int& C) { const int st = b / 1024, sb = b % 1024, swz = sb ^ (((sb >> 9) & 1) << 5); R = (st >> 1) * 16 + swz / 64; C = (st & 1) * 32 + (swz % 64) / 2; }
__host__ __device__ __forceinline__ int perm32(int rho) { const int n = rho >> 4, i = rho & 15; return 8 * (i >> 2) + 4 * n + (i & 3); }

struct Unit { int pm, pn; };
struct Gemm { const bf16_t* A; const bf16_t* Bt; int M, N, K; };

struct StaticOrder {
    int nM, nN, nwg, G, c;
    __host__ __device__ void init(int M, int N, int G_, int c_) { nM = M / BM; nN = N / BM; nwg = nM * nN; G = G_; c = c_; }
    __host__ __device__ bool next(int i, Unit& u) const {
        const long L = (long)i * G + c; if (L >= nwg) return false;
        int wgid = (int)L; { const int q = nwg / NXCD, r = nwg % NXCD, xcd = wgid % NXCD, off = wgid / NXCD; wgid = (xcd < r ? xcd * (q + 1) : r * (q + 1) + (xcd - r) * q) + off; }
        const int nig = WGM * nN, gid = wgid / nig, fm = gid * WGM, gsz = (nM - fm) < WGM ? (nM - fm) : WGM;
        u.pm = fm + ((wgid % nig) % gsz); u.pn = (wgid % nig) / gsz; return true;
    }
    __device__ __forceinline__ void a_ready(const Unit&) const {}
    __device__ __forceinline__ void done(const Unit&) const {}
};

__device__ __forceinline__ unsigned cvt_pk_bf16(float lo, float hi) { unsigned r; asm volatile("v_cvt_pk_bf16_f32 %0, %1, %2" : "=v"(r) : "v"(lo), "v"(hi)); return r; }
typedef float f32x2 __attribute__((ext_vector_type(2)));
template <class Epi, class Sched, bool ALIGN_EPI = false, bool SP2 = false>
__device__ __forceinline__ void gemm_phase(PG8_LAS unsigned char* lds, const Gemm g, const Sched& S, const Epi& E) {
    int tid_ = threadIdx.x; asm volatile("" : "+v"(tid_));
    const int tid = tid_, wid = __builtin_amdgcn_readfirstlane(tid >> 6), lane = tid & 63, wr = wid >> 2, wc = wid & 3, fr = lane & 15, fq = lane >> 4;
    const int K = g.K, nt = K / BK;
    unsigned voffA[2], voffB[2];
#pragma unroll
    for (int i = 0; i < 2; ++i) { int R, C; stage_rc(tid * 16 + i * 8192, R, C); const int Rb = Epi::PERM ? ((R & ~31) + perm32(R & 31)) : R;
        voffA[i] = (unsigned)(R * K + C) * 2u; voffB[i] = (unsigned)(Rb * K + C) * 2u; }
    const size_t kstep = (size_t)(BK * 2);
    const size_t hstep = (size_t)HALF * K * 2;
    const size_t tstep = 2 * hstep;
    const unsigned ldsw = (unsigned)wid * 1024u;
    const int aoff = lds_byte(wr * 64 + fr, fq * 8), boff = lds_byte(wc * 32 + fr, fq * 8);
#define PG8_SA(b, h) (((b) * 2 + (h)) * HTB)
#define PG8_SB(b, h) ((4 + (b) * 2 + (h)) * HTB)
#define PG8_STAGE(bufoff, gbase, voff) do { _Pragma("unroll") for (int _i = 0; _i < 2; ++_i) \
        __builtin_amdgcn_global_load_lds((const unsigned*)((const char*)(gbase) + (voff)[_i]), (PG8_LAS unsigned*)(lds + (bufoff) + ldsw + _i * 8192), 16, 0, 0); } while (0)
#define PG8_LDA(dst, b, h) do { _Pragma("unroll") for (int m = 0; m < 4; ++m) _Pragma("unroll") for (int k = 0; k < 2; ++k) dst[m][k] = *(const PG8_LAS bf16x8*)(lds + PG8_SA(b, h) + aoff + m * 2048 + k * 1024); } while (0)
#define PG8_LDB(dst, b, h) do { _Pragma("unroll") for (int n = 0; n < 2; ++n) _Pragma("unroll") for (int k = 0; k < 2; ++k) dst[n][k] = *(const PG8_LAS bf16x8*)(lds + PG8_SB(b, h) + boff + n * 2048 + k * 1024); } while (0)
#define PG8_MMA(ai, bj, At, Bt) do { __builtin_amdgcn_s_setprio(1); _Pragma("unroll") for (int m = 0; m < 4; ++m) _Pragma("unroll") for (int n = 0; n < 2; ++n) _Pragma("unroll") for (int k = 0; k < 2; ++k) \
        acc[ai][bj][m][n] = __builtin_amdgcn_mfma_f32_16x16x32_bf16(Bt[n][k], At[m][k], acc[ai][bj][m][n], 0, 0, 0); __builtin_amdgcn_s_setprio(0); } while (0)
#define PG8_WAIT_V(n) asm volatile("s_waitcnt vmcnt(" #n ")" ::: "memory")
#define PG8_WAIT_L(n) asm volatile("s_waitcnt lgkmcnt(" #n ")" ::: "memory")
#define PG8_BAR __builtin_amdgcn_s_barrier()
#define PG8_SCHED __builtin_amdgcn_sched_barrier(0)
    Unit cur, nxt; int ui = 0;
    if (!S.next(0, cur)) return;
    f32x4 acc[2][2][4][2];
#pragma unroll
    for (int a = 0; a < 2; ++a)
#pragma unroll
        for (int b = 0; b < 2; ++b)
#pragma unroll
            for (int m = 0; m < 4; ++m)
#pragma unroll
                for (int n = 0; n < 2; ++n) acc[a][b][m][n] = (f32x4){0.f, 0.f, 0.f, 0.f};
    bf16x8 At[4][2], B0[2][2], B1[2][2];
    const char* cA = (const char*)g.A + (size_t)cur.pm * tstep; const char* cB = (const char*)g.Bt + (size_t)cur.pn * tstep;
    S.a_ready(cur);
    if constexpr (SP2) {
        PG8_STAGE(PG8_SB(0, 0), cB, voffB); PG8_STAGE(PG8_SB(0, 1), cB + hstep, voffB); PG8_STAGE(PG8_SA(0, 0), cA, voffA); PG8_STAGE(PG8_SA(0, 1), cA + hstep, voffA);
        if (wr == 1) PG8_BAR;
        PG8_WAIT_V(2); PG8_BAR;
        PG8_STAGE(PG8_SB(1, 0), cB + kstep, voffB); PG8_STAGE(PG8_SA(1, 0), cA + kstep, voffA); PG8_STAGE(PG8_SB(1, 1), cB + hstep + kstep, voffB);
        PG8_WAIT_V(6); PG8_BAR;
    } else {
        PG8_STAGE(PG8_SB(0, 0), cB, voffB); PG8_STAGE(PG8_SA(0, 0), cA, voffA); PG8_STAGE(PG8_SB(0, 1), cB + hstep, voffB); PG8_STAGE(PG8_SA(0, 1), cA + hstep, voffA);
        if (wr == 1) PG8_BAR;
        PG8_WAIT_V(4); PG8_BAR;
        PG8_STAGE(PG8_SB(1, 0), cB + kstep, voffB); PG8_STAGE(PG8_SA(1, 0), cA + kstep, voffA); PG8_STAGE(PG8_SB(1, 1), cB + hstep + kstep, voffB);
        PG8_WAIT_V(6); PG8_BAR;
    }
    for (;;) {
        const bool has_next = S.next(ui + 1, nxt);
        const char* nA = has_next ? (const char*)g.A + (size_t)nxt.pm * tstep : cA; const char* nB = has_next ? (const char*)g.Bt + (size_t)nxt.pn * tstep : cB;
        for (int t = 0; t < nt; t += 2) {
            const bool last = (t == nt - 2);
            const char* a1 = cA + (size_t)(t + 1) * kstep;
            const char* a2 = last ? nA : cA + (size_t)(t + 2) * kstep; const char* b2 = last ? nB : cB + (size_t)(t + 2) * kstep;
            const char* a3 = a2 + kstep; const char* b3 = b2 + kstep;
            if (last && has_next) S.a_ready(nxt);
            if constexpr (SP2) {
            PG8_LDB(B0, 0, 0); PG8_LDB(B1, 0, 1); PG8_SCHED; PG8_LDA(At, 0, 0); PG8_STAGE(PG8_SA(1, 1), a1 + hstep, voffA);
            PG8_WAIT_V(8); PG8_WAIT_L(0); PG8_BAR; PG8_MMA(0, 0, At, B0); PG8_MMA(0, 1, At, B1); PG8_BAR; PG8_SCHED;
            PG8_LDA(At, 0, 1); PG8_STAGE(PG8_SB(0, 0), b2, voffB); PG8_STAGE(PG8_SB(0, 1), b2 + hstep, voffB); PG8_STAGE(PG8_SA(0, 0), a2, voffA);
            PG8_WAIT_V(8); PG8_WAIT_L(0); PG8_BAR; PG8_MMA(1, 0, At, B0); PG8_MMA(1, 1, At, B1); PG8_BAR; PG8_SCHED;
            PG8_LDB(B0, 1, 0); PG8_LDB(B1, 1, 1); PG8_SCHED; PG8_LDA(At, 1, 0); PG8_STAGE(PG8_SA(0, 1), a2 + hstep, voffA);
            PG8_WAIT_V(8); PG8_WAIT_L(0); PG8_BAR; PG8_MMA(0, 0, At, B0); PG8_MMA(0, 1, At, B1); PG8_BAR; PG8_SCHED;
            PG8_LDA(At, 1, 1); PG8_STAGE(PG8_SB(1, 0), b3, voffB); PG8_STAGE(PG8_SB(1, 1), b3 + hstep, voffB); PG8_STAGE(PG8_SA(1, 0), a3, voffA);
            PG8_WAIT_V(8); PG8_WAIT_L(0); PG8_BAR; PG8_MMA(1, 0, At, B0); PG8_MMA(1, 1, At, B1); PG8_BAR; PG8_SCHED;
            } else {
            PG8_LDB(B0, 0, 0); PG8_SCHED; PG8_LDA(At, 0, 0); PG8_STAGE(PG8_SA(1, 1), a1 + hstep, voffA);
            PG8_WAIT_L(8); PG8_BAR; PG8_WAIT_L(0); PG8_MMA(0, 0, At, B0); PG8_BAR; PG8_SCHED;
            PG8_LDB(B1, 0, 1); PG8_STAGE(PG8_SB(0, 0), b2, voffB);
            PG8_BAR; PG8_WAIT_L(0); PG8_MMA(0, 1, At, B1); PG8_BAR;
            PG8_LDA(At, 0, 1); PG8_STAGE(PG8_SA(0, 0), a2, voffA);
            PG8_BAR; PG8_WAIT_L(0); PG8_MMA(1, 0, At, B0); PG8_BAR; PG8_SCHED;
            PG8_STAGE(PG8_SB(0, 1), b2 + hstep, voffB);
            PG8_WAIT_V(6); PG8_BAR; PG8_MMA(1, 1, At, B1); PG8_BAR;
            PG8_LDB(B0, 1, 0); PG8_SCHED; PG8_LDA(At, 1, 0); PG8_STAGE(PG8_SA(0, 1), a2 + hstep, voffA);
            PG8_WAIT_L(8); PG8_BAR; PG8_WAIT_L(0); PG8_MMA(0, 0, At, B0); PG8_BAR; PG8_SCHED;
            PG8_LDB(B1, 1, 1); PG8_STAGE(PG8_SB(1, 0), b3, voffB);
            PG8_BAR; PG8_WAIT_L(0); PG8_MMA(0, 1, At, B1); PG8_BAR;
            PG8_LDA(At, 1, 1); PG8_STAGE(PG8_SA(1, 0), a3, voffA);
            PG8_BAR; PG8_WAIT_L(0); PG8_MMA(1, 0, At, B0); PG8_BAR; PG8_SCHED;
            PG8_STAGE(PG8_SB(1, 1), b3 + hstep, voffB);
            PG8_WAIT_V(6); PG8_BAR; PG8_MMA(1, 1, At, B1); PG8_BAR;
            }
        }
        if constexpr (ALIGN_EPI) { if (wr == 0) PG8_BAR; }
        if constexpr (!Epi::AFTER_DRAIN) { E(acc, cur, wr, wc, fr, fq); S.done(cur); }
        if (!has_next) break;
#pragma unroll
        for (int a = 0; a < 2; ++a)
#pragma unroll
            for (int b = 0; b < 2; ++b)
#pragma unroll
                for (int m = 0; m < 4; ++m)
#pragma unroll
                    for (int n = 0; n < 2; ++n) acc[a][b][m][n] = (f32x4){0.f, 0.f, 0.f, 0.f};
        cur = nxt; cA = nA; cB = nB; ++ui;
        if constexpr (ALIGN_EPI) { if (wr == 1) PG8_BAR; }
    }
    PG8_WAIT_V(0);
    if constexpr (!ALIGN_EPI) { if (wr == 0) PG8_BAR; }
    PG8_BAR;
    if constexpr (Epi::AFTER_DRAIN) { E.fused(acc, cur, wr, wc, fr, fq, lds, wid, lane); S.done(cur); }
#undef PG8_SA
#undef PG8_SB
#undef PG8_STAGE
#undef PG8_LDA
#undef PG8_LDB
#undef PG8_MMA
#undef PG8_WAIT_V
#undef PG8_WAIT_L
#undef PG8_BAR
#undef PG8_SCHED
}
}
#define GAS __attribute__((address_space(1)))
#define LAS __attribute__((address_space(3)))
typedef unsigned short bf16;
typedef unsigned v4u __attribute__((ext_vector_type(4)));
typedef unsigned v2u __attribute__((ext_vector_type(2)));
typedef float f32x4 __attribute__((ext_vector_type(4)));
typedef short bf16x8 __attribute__((ext_vector_type(8)));
#define LDS_WAIT() asm volatile("s_waitcnt lgkmcnt(0)" ::: "memory")
#define VM_WAIT() asm volatile("s_waitcnt vmcnt(0)" ::: "memory")

constexpr int DM = 2048, NB = 4, SEQ = 2048, NMETA = 16, MROWS = NB * SEQ, DPROJ = 6152, NPROJ = 6144;
constexpr int PADT = 2112, POS0 = 64, MPOS0 = 48;
constexpr float EPS = 1e-6f;
constexpr float LOG2E = 1.4426950408889634f;
constexpr float QSCALE = 0.08838834764831845f * LOG2E;
constexpr int NWAVES = 8, NTHR = 512;

constexpr size_t MiB = 1u << 20;
constexpr size_t WS_CTL = 0, CTL_ZERO_BYTES = 32 * 1024;
constexpr size_t WS_PM = 484 * MiB;
constexpr size_t WS_W1T = 2 * MiB, WS_W2T = 26 * MiB, WS_W3T = 34 * MiB, WS_XN = 42 * MiB;
constexpr size_t WS_Q = 74 * MiB, WS_KP = 90 * MiB, WS_VP = 107 * MiB, WS_MQ = 124 * MiB, WS_MK = 133 * MiB, WS_MV = 142 * MiB, WS_MO = 159 * MiB;
constexpr size_t WS_SMALL = 175 * MiB;
constexpr size_t WS_XM = WS_SMALL, WS_LI = WS_SMALL + 128 * 1024, WS_LF = WS_SMALL + 384 * 1024, WS_LAM = WS_SMALL + 640 * 1024;
constexpr size_t WS_PO = 176 * MiB, WS_ML = 304 * MiB, WS_HM = 305 * MiB, WS_A2 = 42 * MiB, WS_H1B = 74 * MiB, WS_SSQ = 106 * MiB, WS_S = 176 * MiB, WS_UB = 384 * MiB, WS_VB = 448 * MiB;
constexpr size_t WS_SCL = WS_SMALL + 704 * 1024;
constexpr size_t WS_VB8 = WS_UB + 32 * MiB;
constexpr size_t WS_DC = 305 * MiB, WS_CS = 448 * MiB, WS_DN = 482 * MiB, WS_NS = WS_DN + 512 * 1024, WS_GS = WS_DN + 1024 * 1024, WS_MS = WS_DN + 1152 * 1024;
constexpr size_t WS_EID = 240 * MiB, WS_EGT = 244 * MiB;
constexpr int CW_BAR = 4096;

constexpr int RING_OFF = 0, RING_BYTES = 131072;
constexpr int XCH_OFF = 131072;
constexpr int MISC_OFF = XCH_OFF + 8192;
constexpr int LDS_BYTES = 155648;

__device__ __forceinline__ unsigned f2bf(float f) { unsigned u = __builtin_bit_cast(unsigned, f); return (u + 0x7fffu + ((u >> 16) & 1u)) >> 16; }
__device__ __forceinline__ unsigned pk2(float lo, float hi) { return f2bf(lo) | (f2bf(hi) << 16); }
__device__ __forceinline__ float bf2f(unsigned short u) { return __builtin_bit_cast(float, (unsigned)u << 16); }
__device__ __forceinline__ float bflo(unsigned w) { return __builtin_bit_cast(float, w << 16); }
__device__ __forceinline__ float bfhi(unsigned w) { return __builtin_bit_cast(float, w & 0xffff0000u); }
__device__ __forceinline__ float wave_sum(float v) {
#pragma unroll
  for (int o = 1; o < 64; o <<= 1) v += __shfl_xor(v, o);
  return v;
}
__device__ __forceinline__ size_t kp_off(int bhm, int pos, int d) { const int j = pos >> 6, row = pos & 63, d0 = d >> 4, hi = (d >> 3) & 1;
  return ((size_t)(bhm * 33 + j) * 8 + d0) * 1024 + (size_t)((((row << 1) | hi) ^ ((row >> 3) & 1)) << 3) + (d & 7); }
__device__ __forceinline__ float wave_sum_dpp(float v) {
  v += __builtin_bit_cast(float, __builtin_amdgcn_update_dpp(0, __builtin_bit_cast(int, v), 0xB1, 0xF, 0xF, true));
  v += __builtin_bit_cast(float, __builtin_amdgcn_update_dpp(0, __builtin_bit_cast(int, v), 0x4E, 0xF, 0xF, true));
  v += __builtin_bit_cast(float, __builtin_amdgcn_update_dpp(0, __builtin_bit_cast(int, v), 0x141, 0xF, 0xF, true));
  v += __builtin_bit_cast(float, __builtin_amdgcn_update_dpp(0, __builtin_bit_cast(int, v), 0x140, 0xF, 0xF, true));
  const float r0 = __builtin_bit_cast(float, __builtin_amdgcn_readlane(__builtin_bit_cast(int, v), 0)), r1 = __builtin_bit_cast(float, __builtin_amdgcn_readlane(__builtin_bit_cast(int, v), 16));
  const float r2 = __builtin_bit_cast(float, __builtin_amdgcn_readlane(__builtin_bit_cast(int, v), 32)), r3 = __builtin_bit_cast(float, __builtin_amdgcn_readlane(__builtin_bit_cast(int, v), 48));
  return (r0 + r1) + (r2 + r3);
}
__device__ __forceinline__ float sigmoidf_(float x) { return 1.0f / (1.0f + __expf(-x)); }

#ifdef TPROBE
#ifndef TP_BLOCK
#define TP_BLOCK 0
#endif
#ifndef TP_DIV
#define TP_DIV 1.0f
#endif
#define TP_BEGIN(id) unsigned long long tp_t0_##id = 0; do { if (TPROBE == (id)) tp_t0_##id = __builtin_amdgcn_s_memrealtime(); } while (0)
#define TP_END(id, WS) do { if (TPROBE == (id)) { const unsigned long long t1_ = __builtin_amdgcn_s_memrealtime(); if ((int)blockIdx.x == TP_BLOCK && threadIdx.x == 0) atomicAdd((unsigned*)((WS) + 64), (unsigned)(t1_ - tp_t0_##id)); } } while (0)
#else
#define TP_BEGIN(id)
#define TP_END(id, WS)
#endif
#define XB_TMO      128
#define XB_XCNT(j)  (256  + 64 * (j))
#define XB_XSUB(j)  (1280 + 64 * (j))
#define XB_XGEN(j)  (2304 + 64 * (j))
#define XB_TOP      3328
#define XB_TOPGEN   3392
#define XCD_BAR_WORDS 3456
#define XB_SPIN_CAP (1u << 18)

__device__ __forceinline__ unsigned xb_ld(unsigned* p)              { return __hip_atomic_load(p, __ATOMIC_RELAXED, __HIP_MEMORY_SCOPE_AGENT); }
__device__ __forceinline__ unsigned xb_add(unsigned* p, unsigned v) { return __hip_atomic_fetch_add(p, v, __ATOMIC_RELAXED, __HIP_MEMORY_SCOPE_AGENT); }
__device__ __forceinline__ unsigned xb_xcc_id() { return (unsigned)__builtin_amdgcn_s_getreg((3 << 11) | 20) & 0xFu; }
#define XB_SPIN(cond, bar) do { unsigned _sp = 0; while (cond) { __builtin_amdgcn_s_sleep(1); \
    if ((++_sp & 255u) == 0u) { if (xb_ld(&(bar)[XB_TMO])) break; if (_sp > XB_SPIN_CAP) { atomicAdd(&(bar)[XB_TMO], 1u); break; } } } } while (0)

struct XcdBarrier {
    unsigned* bar; unsigned x;
    volatile LAS unsigned* st;
};

__device__ __forceinline__ XcdBarrier xcd_barrier_post(unsigned* bar, volatile LAS unsigned* st) {
    XcdBarrier b; b.bar = bar; b.x = xb_xcc_id(); b.st = st;
    if (threadIdx.x == 0) (void)xb_add(&bar[XB_XCNT(b.x)], 1u);
    return b;
}
__device__ __forceinline__ void xcd_barrier_complete(unsigned* bar, unsigned x, unsigned& nloc, unsigned& nx) {
    const unsigned G = gridDim.x * gridDim.y * gridDim.z;
    unsigned sum, cnt, mine, sp = 0u;
    for (;;) {
        sum = 0u; cnt = 0u; mine = 0u;
#pragma unroll
        for (unsigned j = 0; j < 16; ++j) { const unsigned c = xb_ld(&bar[XB_XCNT(j)]); sum += c; cnt += (c > 0u) ? 1u : 0u; mine = (j == x) ? c : mine; }
        if (sum == G) break;
        __builtin_amdgcn_s_sleep(1);
        if ((++sp & 255u) == 0u) { if (xb_ld(&bar[XB_TMO])) break; if (sp > XB_SPIN_CAP) { atomicAdd(&bar[XB_TMO], 1u); break; } }
    }
    nloc = mine > 0u ? mine : 1u; nx = cnt > 0u ? cnt : 1u;
}

__device__ __forceinline__ void xcd_barrier(const XcdBarrier& b) {
    asm volatile("s_waitcnt vmcnt(0)" ::: "memory");
    __syncthreads();
    if (threadIdx.x == 0) {
        unsigned* bar = b.bar;
        __builtin_amdgcn_s_waitcnt(0);
        unsigned nloc = b.st[0], nx = b.st[1];
        if (nloc == 0u) { xcd_barrier_complete(bar, b.x, nloc, nx); b.st[0] = nloc; b.st[1] = nx; }
        const unsigned old = xb_add(&bar[XB_XSUB(b.x)], 1u);
        const unsigned gen = old / nloc;
        if (old + 1u == (gen + 1u) * nloc) {
            __builtin_amdgcn_fence(__ATOMIC_RELEASE, "agent");
            asm volatile("s_waitcnt vmcnt(0)" ::: "memory");
            const unsigned og = xb_add(&bar[XB_TOP], 1u);
            const unsigned tg = og / nx;
            if (og + 1u == (tg + 1u) * nx) xb_add(&bar[XB_TOPGEN], 1u);
            else XB_SPIN(xb_ld(&bar[XB_TOPGEN]) == tg, bar);
            __builtin_amdgcn_fence(__ATOMIC_ACQUIRE, "agent");
            xb_add(&bar[XB_XGEN(b.x)], 1u);
            asm volatile("s_waitcnt vmcnt(0)" ::: "memory");
        } else {
            XB_SPIN(xb_ld(&bar[XB_XGEN(b.x)]) == gen, bar);
            __builtin_amdgcn_fence(__ATOMIC_ACQUIRE, "agent");
            asm volatile("s_waitcnt vmcnt(0)" ::: "memory");
        }
    }
    __syncthreads();
}

struct Args { const float* in[22]; float* out; unsigned char* ws; int ph_lo, ph_hi, na, pad; };
struct Frame {
  LAS unsigned char* lds; unsigned char* ws; int tid, lane, wave; const float* const* in;
};
#define IN_X 0
#define IN_META 1
#define IN_G1 2
#define IN_WIN 3
#define IN_CW 4
#define IN_CB 5
#define IN_IGB 6
#define IN_FGB 7
#define IN_LQ1 8
#define IN_LK1 9
#define IN_LQ2 10
#define IN_LK2 11
#define IN_QNG 12
#define IN_KNG 13
#define IN_SUBG 14
#define IN_OUTG 15
#define IN_WOUT 16
#define IN_G2 17
#define IN_WQ 18
#define IN_SUBK 19
#define IN_U 20
#define IN_V 21

__device__ __forceinline__ void p0_rows(const Frame& F, const Args& a) {
  const float* x = a.in[IN_X]; const float* meta = a.in[IN_META]; const float* g1 = a.in[IN_G1]; const float* w_in = a.in[IN_WIN];
  const float* igb = a.in[IN_IGB]; const float* fgb = a.in[IN_FGB];
  bf16* Xn = (bf16*)(F.ws + WS_XN); bf16* Xm = (bf16*)(F.ws + WS_XM); float* LI = (float*)(F.ws + WS_LI); float* LF = (float*)(F.ws + WS_LF);
  LAS f32x4* wgl = (LAS f32x4*)(F.lds);
  for (int e = F.tid; e < 4096; e += NTHR) {
    const int ln = e & 63, q = e >> 6, half = q & 1, j = (q >> 1) & 3, i = q >> 3;
    const int k = 4 * (i * 64 + ln) + j;
    wgl[e] = *(const f32x4*)(w_in + (size_t)k * DPROJ + NPROJ + 4 * half);
  }
  __syncthreads();
  const int gw = blockIdx.x * NWAVES + F.wave, NGW = gridDim.x * NWAVES, lane = F.lane;
  constexpr int NTASK = MROWS / 2 + NMETA / 2;
  f32x4 xnx[2][8];
  if (gw < NTASK) { const float* sn = (gw >= MROWS / 2 ? meta + (size_t)(gw - MROWS / 2) * 2 * DM : x + (size_t)gw * 2 * DM);
#pragma unroll
    for (int i = 0; i < 8; ++i) { xnx[0][i] = ((const f32x4*)sn)[i * 64 + lane]; xnx[1][i] = ((const f32x4*)(sn + DM))[i * 64 + lane]; } }
  f32x4 g1v[8];
#pragma unroll
  for (int i = 0; i < 8; ++i) g1v[i] = ((const f32x4*)g1)[i * 64 + lane];
  for (int task = gw; task < NTASK; task += NGW) {
    const bool ismeta = task >= MROWS / 2;
    const int r0 = ismeta ? (task - MROWS / 2) * 2 : task * 2;
    f32x4 xv[2][8]; float rs[2];
    { float s0 = 0.f, s1 = 0.f;
#pragma unroll
      for (int i = 0; i < 8; ++i) { xv[0][i] = xnx[0][i]; xv[1][i] = xnx[1][i]; }
      { const int tn = task + NGW; if (tn < NTASK) { const float* sn = (tn >= MROWS / 2 ? meta + (size_t)(tn - MROWS / 2) * 2 * DM : x + (size_t)tn * 2 * DM);
#pragma unroll
          for (int i = 0; i < 8; ++i) { xnx[0][i] = ((const f32x4*)sn)[i * 64 + lane]; xnx[1][i] = ((const f32x4*)(sn + DM))[i * 64 + lane]; } } }
#pragma unroll
      for (int i = 0; i < 8; ++i) { const f32x4 a0 = xv[0][i], a1 = xv[1][i];
        s0 += (a0.x * a0.x + a0.y * a0.y) + (a0.z * a0.z + a0.w * a0.w); s1 += (a1.x * a1.x + a1.y * a1.y) + (a1.z * a1.z + a1.w * a1.w); }
      rs[0] = rsqrtf(wave_sum_dpp(s0) * (1.0f / DM) + EPS); rs[1] = rsqrtf(wave_sum_dpp(s1) * (1.0f / DM) + EPS); }
    float ga[2][8];
#pragma unroll
    for (int rr = 0; rr < 2; ++rr)
#pragma unroll
      for (int g = 0; g < 8; ++g) ga[rr][g] = 0.f;
    bf16* dst0 = (ismeta ? Xm : Xn) + (size_t)r0 * DM;
#pragma unroll
    for (int i = 0; i < 8; ++i) {
      const f32x4 g = g1v[i];
      f32x4 xn[2];
#pragma unroll
      for (int rr = 0; rr < 2; ++rr) { xn[rr] = xv[rr][i] * g * rs[rr];
        v2u o; o.x = pk2(xn[rr].x, xn[rr].y); o.y = pk2(xn[rr].z, xn[rr].w); ((v2u*)(dst0 + (size_t)rr * DM))[i * 64 + lane] = o; }
#pragma unroll
      for (int j = 0; j < 4; ++j) {
        const f32x4 w0 = wgl[((i * 4 + j) * 2 + 0) * 64 + lane], w1 = wgl[((i * 4 + j) * 2 + 1) * 64 + lane];
#pragma unroll
        for (int rr = 0; rr < 2; ++rr) { const float xs_ = xn[rr][j];
          ga[rr][0] += xs_ * w0.x; ga[rr][1] += xs_ * w0.y; ga[rr][2] += xs_ * w0.z; ga[rr][3] += xs_ * w0.w;
          ga[rr][4] += xs_ * w1.x; ga[rr][5] += xs_ * w1.y; ga[rr][6] += xs_ * w1.z; ga[rr][7] += xs_ * w1.w; }
      }
      __builtin_amdgcn_sched_barrier(0);
    }
#pragma unroll
    for (int rr = 0; rr < 2; ++rr)
#pragma unroll
      for (int g = 0; g < 8; ++g) ga[rr][g] = wave_sum_dpp(ga[rr][g]);
    if (lane < 8) {
      const int rr = lane >> 2, h = lane & 3;
      float gi = 0.f, gf = 0.f;
#pragma unroll
      for (int q = 0; q < 2; ++q)
#pragma unroll
        for (int hh = 0; hh < 4; ++hh) if (q == rr && hh == h) { gi = ga[q][hh]; gf = ga[q][4 + hh]; }
      const float li = gi + igb[h]; const float fx = gf + fgb[h];
      const float lf = fminf(fx, 0.f) - log1pf(__expf(-fabsf(fx)));
      const int R = r0 + rr;
      if (!ismeta) { const int b = R >> 11, t = R & 2047; LI[(b * 4 + h) * PADT + POS0 + t] = li; LF[(b * 4 + h) * PADT + POS0 + t] = lf; }
      else { for (int b = 0; b < NB; ++b) { LI[(b * 4 + h) * PADT + MPOS0 + R] = li; LF[(b * 4 + h) * PADT + MPOS0 + R] = lf; } }
    }
  }
  __syncthreads();
}
template <bool META>
__device__ __forceinline__ void p0_transpose(const Frame& F, const Args& a, const float* W, int ldw, int N, bf16* Wt) {
  LAS float* tl = (LAS float*)(F.lds);
  LAS float* red = (LAS float*)(F.lds + 33792);
  float* PM = (float*)(F.ws + WS_PM);
  const float* meta = a.in[IN_META]; const float* g1 = a.in[IN_G1];
  const int ntn = N / 64, ntask = ntn * 16, fr = F.lane & 15, fq = F.lane >> 4, w = F.wave;
  f32x4 wn[4];
  float am[4], ag[4];
  if ((int)blockIdx.x < ntask) { const int nb = blockIdx.x % ntn, kb = blockIdx.x / ntn;
#pragma unroll
    for (int i = 0; i < 4; ++i) { const int idx = F.tid + NTHR * i, kk = idx >> 4, c4 = idx & 15; wn[i] = *(const f32x4*)(W + (size_t)(kb * 128 + kk) * ldw + nb * 64 + 4 * c4); }
    if (META) {
#pragma unroll
      for (int s_ = 0; s_ < 4; ++s_) { const int k = kb * 128 + 16 * w + 4 * s_ + fq; am[s_] = meta[(size_t)fr * DM + k]; ag[s_] = g1[k]; } } }
  for (int task = blockIdx.x; task < ntask; task += gridDim.x) {
    const int nb = task % ntn, kb = task / ntn, n0 = nb * 64, k0 = kb * 128;
    __syncthreads();
#pragma unroll
    for (int i = 0; i < 4; ++i) { const int idx = F.tid + NTHR * i, kk = idx >> 4, c4 = idx & 15; const f32x4 wv = wn[i];
      LAS float* d = tl + kk * 65 + 4 * c4; d[0] = wv.x; d[1] = wv.y; d[2] = wv.z; d[3] = wv.w; }
    float ac[4];
    if (META) {
#pragma unroll
      for (int s_ = 0; s_ < 4; ++s_) ac[s_] = am[s_] * ag[s_]; }
    { const int tn = task + gridDim.x; if (tn < ntask) { const int nb2 = tn % ntn, kb2 = tn / ntn;
#pragma unroll
        for (int i = 0; i < 4; ++i) { const int idx = F.tid + NTHR * i, kk = idx >> 4, c4 = idx & 15; wn[i] = *(const f32x4*)(W + (size_t)(kb2 * 128 + kk) * ldw + nb2 * 64 + 4 * c4); }
        if (META) {
#pragma unroll
          for (int s_ = 0; s_ < 4; ++s_) { const int k = kb2 * 128 + 16 * w + 4 * s_ + fq; am[s_] = meta[(size_t)fr * DM + k]; ag[s_] = g1[k]; } } } }
    __syncthreads();
    const int n = F.tid >> 3, kc = F.tid & 7;
    const LAS float* s = tl + (kc * 16) * 65 + n;
    v4u o0, o1;
    o0.x = pk2(s[0 * 65], s[1 * 65]); o0.y = pk2(s[2 * 65], s[3 * 65]); o0.z = pk2(s[4 * 65], s[5 * 65]); o0.w = pk2(s[6 * 65], s[7 * 65]);
    o1.x = pk2(s[8 * 65], s[9 * 65]); o1.y = pk2(s[10 * 65], s[11 * 65]); o1.z = pk2(s[12 * 65], s[13 * 65]); o1.w = pk2(s[14 * 65], s[15 * 65]);
    v4u* dp = (v4u*)(Wt + (size_t)(n0 + n) * DM + k0 + kc * 16);
    dp[0] = o0; dp[1] = o1;
    if (META && n0 >= 1024) {
      f32x4 acc[4];
#pragma unroll
      for (int nt = 0; nt < 4; ++nt) acc[nt] = (f32x4){0.f, 0.f, 0.f, 0.f};
#pragma unroll
      for (int s_ = 0; s_ < 4; ++s_)
#pragma unroll
        for (int nt = 0; nt < 4; ++nt) acc[nt] = __builtin_amdgcn_mfma_f32_16x16x4f32(ac[s_], tl[(16 * w + 4 * s_ + fq) * 65 + nt * 16 + fr], acc[nt], 0, 0, 0);
#pragma unroll
      for (int nt = 0; nt < 4; ++nt)
#pragma unroll
        for (int i = 0; i < 4; ++i) red[(w * 16 + 4 * fq + i) * 64 + nt * 16 + fr] = acc[nt][i];
      __syncthreads();
#pragma unroll
      for (int j = 0; j < 2; ++j) { const int idx = F.tid + NTHR * j, m = idx >> 6, nn = idx & 63; const LAS float* r = red + m * 64 + nn;
        PM[((size_t)kb * 16 + m) * NPROJ + n0 + nn] = ((r[0] + r[1024]) + (r[2048] + r[3072])) + ((r[4096] + r[5120]) + (r[6144] + r[7168])); }
    }
  }
  __syncthreads();
}
__device__ __forceinline__ void p0_zero_vpad(const Frame& F) {
  bf16* Vp = (bf16*)(F.ws + WS_VP);
  const int per = MPOS0 * 256 / 8;
  for (int i = blockIdx.x * NTHR + F.tid; i < 16 * per; i += gridDim.x * NTHR) { const int bh = i / per, e = i % per;
    *(v4u*)(Vp + (size_t)bh * PADT * 256 + (size_t)e * 8) = (v4u){0u, 0u, 0u, 0u}; }
}
__device__ __forceinline__ void p0_lam(const Frame& F, const Args& a) {
  if (blockIdx.x == 0 && F.wave == 0) {
    const int l = F.lane;
    float s1 = a.in[IN_LQ1][l] * a.in[IN_LK1][l] + a.in[IN_LQ1][l + 64] * a.in[IN_LK1][l + 64];
    float s2 = a.in[IN_LQ2][l] * a.in[IN_LK2][l] + a.in[IN_LQ2][l + 64] * a.in[IN_LK2][l + 64];
    s1 = wave_sum(s1); s2 = wave_sum(s2);
    if (l == 0) *(float*)(F.ws + WS_LAM) = __expf(s1) - __expf(s2) + 0.2f;
  }
}

struct EpiProj {
  static constexpr bool PERM = true, AFTER_DRAIN = false;
  bf16 *Qb, *Kp, *Vp, *MQ, *MK, *MV, *MO; const float *qg, *kg; LAS float* xch;
  __device__ __forceinline__ void operator()(const pg8::f32x4 (&acc)[2][2][4][2], const pg8::Unit& u, int wr, int wc, int fr, int fq) const {
    const int pn = u.pn, b = u.pm >> 3, tb = (u.pm & 7) * 256 + wr * 64 + fr, d0 = wc * 32 + fq * 8;
    if (pn < 8) {
      const bool isk = pn >= 4; const int h = pn & 3;
      float ssq[2][4][2];
#pragma unroll
      for (int ai = 0; ai < 2; ++ai)
#pragma unroll
        for (int m = 0; m < 4; ++m)
#pragma unroll
          for (int bj = 0; bj < 2; ++bj) { float s = 0.f;
#pragma unroll
            for (int n = 0; n < 2; ++n) { const pg8::f32x4 x = acc[ai][bj][m][n]; s += (x[0] * x[0] + x[1] * x[1]) + (x[2] * x[2] + x[3] * x[3]); }
            s += __shfl_xor(s, 16); s += __shfl_xor(s, 32); ssq[ai][m][bj] = s;
            if (fq == 0) xch[((ai * 128 + wr * 64 + m * 16 + fr) * 2 + bj) * 4 + wc] = s; }
      asm volatile("s_waitcnt lgkmcnt(0)" ::: "memory"); __builtin_amdgcn_s_barrier(); asm volatile("" ::: "memory");
      const float* gp = (isk ? kg : qg) + d0; const f32x4 g0 = *(const f32x4*)gp, g1v = *(const f32x4*)(gp + 4);
      const float sc = isk ? 1.0f : QSCALE;
#pragma unroll
      for (int ai = 0; ai < 2; ++ai)
#pragma unroll
        for (int m = 0; m < 4; ++m)
#pragma unroll
          for (int bj = 0; bj < 2; ++bj) {
            const f32x4 p = *(const LAS f32x4*)(xch + ((ai * 128 + wr * 64 + m * 16 + fr) * 2 + bj) * 4);
            const float rs = rsqrtf(((p.x + p.y) + (p.z + p.w)) * (1.0f / 128.f) + EPS) * sc;
            const pg8::f32x4 v0 = acc[ai][bj][m][0], v1 = acc[ai][bj][m][1];
            v4u w; w.x = pk2(v0[0] * rs * g0.x, v0[1] * rs * g0.y); w.y = pk2(v0[2] * rs * g0.z, v0[3] * rs * g0.w);
            w.z = pk2(v1[0] * rs * g1v.x, v1[1] * rs * g1v.y); w.w = pk2(v1[2] * rs * g1v.z, v1[3] * rs * g1v.w);
            const int t = tb + ai * 128 + m * 16;
            bf16* dst = isk ? Kp + kp_off((b * 4 + h) * 2 + bj, POS0 + t, d0)
                            : Qb + ((size_t)((b * 4 + h) * 2 + bj) * SEQ + t) * 128 + d0;
            *(v4u*)dst = w; }
      return;
    }
#pragma unroll
    for (int ai = 0; ai < 2; ++ai)
#pragma unroll
      for (int m = 0; m < 4; ++m)
#pragma unroll
        for (int bj = 0; bj < 2; ++bj) {
          pg8::f32x4 v0 = acc[ai][bj][m][0], v1 = acc[ai][bj][m][1];
          const int t = tb + ai * 128 + m * 16;
          bf16* dst;
          if (pn < 12) { const int h = pn - 8; dst = Vp + ((size_t)(b * 4 + h) * PADT + POS0 + t) * 256 + bj * 128 + d0; }
          else if (pn < 16) { const int h = 2 * (pn & 1) + bj; dst = (pn >= 14 ? MK : MQ) + ((size_t)(b * 4 + h) * PADT + POS0 + t) * 128 + d0; }
          else if (pn < 20) { const int h = pn - 16; dst = MV + ((size_t)(b * 4 + h) * PADT + POS0 + t) * 256 + bj * 128 + d0; }
          else dst = MO + (size_t)(b * SEQ + t) * 1024 + (pn - 20) * 256 + bj * 128 + d0;
          v4u w; w.x = pk2(v0[0], v0[1]); w.y = pk2(v0[2], v0[3]); w.z = pk2(v1[0], v1[1]); w.w = pk2(v1[2], v1[3]);
          *(v4u*)dst = w; }
  }
};
__device__ __forceinline__ void p1_meta_finalize(const Frame& F, const Args& a) {
  const bool spread = gridDim.x >= 2 * NMETA;
  if (spread ? ((blockIdx.x & 1) != 0 || blockIdx.x >= 2 * NMETA) : (blockIdx.x >= NMETA)) return;
  const int mrow = spread ? (int)(blockIdx.x >> 1) : (int)blockIdx.x, tid = F.tid, lane = F.lane, w = F.wave;
  const float* meta = a.in[IN_META] + (size_t)mrow * DM; const float* PM0 = (const float*)(F.ws + WS_PM) + (size_t)mrow * NPROJ;
#define PM_P4(i, p) ((PM0[(size_t)(16 * (p)) * NPROJ + (i)] + PM0[(size_t)(16 * ((p) + 1)) * NPROJ + (i)]) + (PM0[(size_t)(16 * ((p) + 2)) * NPROJ + (i)] + PM0[(size_t)(16 * ((p) + 3)) * NPROJ + (i)]))
#define PM_AT(i) ((PM_P4(i, 0) + PM_P4(i, 4)) + (PM_P4(i, 8) + PM_P4(i, 12)))
  LAS float* red = (LAS float*)(F.lds + XCH_OFF);
  const f32x4 mv = ((const f32x4*)meta)[tid];
  float s = wave_sum((mv.x * mv.x + mv.y * mv.y) + (mv.z * mv.z + mv.w * mv.w));
  if (lane == 0) red[w] = s;
  __syncthreads();
  float tot = 0.f;
#pragma unroll
  for (int i = 0; i < 8; ++i) tot += red[i];
  const float rs = rsqrtf(tot * (1.0f / DM) + EPS);
  bf16* Kp = (bf16*)(F.ws + WS_KP); bf16* Vp = (bf16*)(F.ws + WS_VP); bf16* MQ = (bf16*)(F.ws + WS_MQ); bf16* MK = (bf16*)(F.ws + WS_MK); bf16* MV = (bf16*)(F.ws + WS_MV);
  const int pos = MPOS0 + mrow;
  const int c = tid * 2;
  const float kv0 = PM_AT(1024 + w * 128 + lane), kv1 = PM_AT(1024 + w * 128 + lane + 64);
  const float a0 = PM_AT(2048 + c), a1 = PM_AT(2048 + c + 1), b0 = PM_AT(3072 + c), b1 = PM_AT(3072 + c + 1), c0 = PM_AT(4096 + c), c1 = PM_AT(4096 + c + 1);
  {
    const float v0 = kv0 * rs, v1 = kv1 * rs;
    const float rk = rsqrtf(wave_sum(v0 * v0 + v1 * v1) * (1.0f / 128.f) + EPS);
    const float* kg = a.in[IN_KNG];
    const unsigned short o0 = (unsigned short)f2bf(v0 * rk * kg[lane]), o1 = (unsigned short)f2bf(v1 * rk * kg[lane + 64]);
    for (int b = 0; b < NB; ++b) { const int bhm = (b * 4 + (w >> 1)) * 2 + (w & 1); Kp[kp_off(bhm, pos, lane)] = o0; Kp[kp_off(bhm, pos, lane + 64)] = o1; }
  }
  {
    const unsigned o = pk2(a0 * rs, a1 * rs); const int h = c >> 8, e = c & 255;
    for (int b = 0; b < NB; ++b) *(unsigned*)(Vp + ((size_t)(b * 4 + h) * PADT + pos) * 256 + e) = o;
    const unsigned o2 = pk2(b0 * rs, b1 * rs); const bool isk = c >= 512; const int cc = c & 511, hq = cc >> 7, d = cc & 127;
    for (int b = 0; b < NB; ++b) *(unsigned*)((isk ? MK : MQ) + ((size_t)(b * 4 + hq) * PADT + pos) * 128 + d) = o2;
    const unsigned o3 = pk2(c0 * rs, c1 * rs);
    for (int b = 0; b < NB; ++b) *(unsigned*)(MV + ((size_t)(b * 4 + h) * PADT + pos) * 256 + e) = o3;
  }
  __syncthreads();
}
#undef PM_AT
#undef PM_P4

namespace att {
using f32x16 = __attribute__((ext_vector_type(16))) float;
using s16x4 = __attribute__((ext_vector_type(4))) short;
constexpr int STEPS_BHM = 152, NSTEPS = 32 * STEPS_BHM;
constexpr int SHM_V = 64 * 256 * 2, SHM_K = 64 * 128 * 2;
constexpr int LDS_V = 0, LDS_K = 2 * SHM_V, LDS_Q = LDS_K + SHM_K, LDS_WS = LDS_Q + 8 * 8192;
constexpr float THR2 = 8.0f;
#define KSWZ(row, colB) ((row) * 256 + ((colB) ^ (((row) & 7) << 4)))
#define SBAR() __builtin_amdgcn_sched_barrier(0)
__device__ __forceinline__ int crow(int r, int hi) { return (r & 3) + 8 * (r >> 2) + 4 * hi; }
__device__ __forceinline__ unsigned cvtpk(float lo, float hi) { unsigned r; asm volatile("v_cvt_pk_bf16_f32 %0, %1, %2" : "=v"(r) : "v"(lo), "v"(hi)); return r; }
__device__ __forceinline__ int qb_start(int qb) { return 2 * qb * qb + 3 * qb; }
__device__ __forceinline__ int chunk_of(int s, int NA) { return ((s + 1) * NA - 1) / NSTEPS; }

template <int OFF> __device__ __forceinline__ s16x4 tr_read(int vb) {
  s16x4 r; asm volatile("ds_read_b64_tr_b16 %0, %1 offset:%2" : "=&v"(r) : "v"(vb), "i"(OFF) : "memory"); return r;
}
constexpr int v_rd_off(int d0, int ks, int half) { return d0 * 512 + ks * 8192 + half * 4096; }
template <int D0> __device__ __forceinline__ void pv_one(f32x16& od, int vb, bf16x8 pa0, bf16x8 pa1, bf16x8 pa2, bf16x8 pa3) {
#define PK(L, H) (bf16x8){L[0], L[1], L[2], L[3], H[0], H[1], H[2], H[3]}
  { const s16x4 l0 = tr_read<v_rd_off(D0, 0, 0)>(vb), h0 = tr_read<v_rd_off(D0, 0, 1)>(vb), l1 = tr_read<v_rd_off(D0, 1, 0)>(vb), h1 = tr_read<v_rd_off(D0, 1, 1)>(vb);
    asm volatile("s_waitcnt lgkmcnt(0)" ::: "memory"); SBAR();
    od = __builtin_amdgcn_mfma_f32_32x32x16_bf16(pa0, PK(l0, h0), od, 0, 0, 0);
    od = __builtin_amdgcn_mfma_f32_32x32x16_bf16(pa1, PK(l1, h1), od, 0, 0, 0); }
  SBAR();
  { const s16x4 l2 = tr_read<v_rd_off(D0, 2, 0)>(vb), h2 = tr_read<v_rd_off(D0, 2, 1)>(vb), l3 = tr_read<v_rd_off(D0, 3, 0)>(vb), h3 = tr_read<v_rd_off(D0, 3, 1)>(vb);
    asm volatile("s_waitcnt lgkmcnt(0)" ::: "memory"); SBAR();
    od = __builtin_amdgcn_mfma_f32_32x32x16_bf16(pa2, PK(l2, h2), od, 0, 0, 0);
    od = __builtin_amdgcn_mfma_f32_32x32x16_bf16(pa3, PK(l3, h3), od, 0, 0, 0); }
#undef PK
}

__device__ __forceinline__ void segment(const Frame& F, int bhm, int qb, int j0, int j1, int slot) {
  const int tid = F.tid, wid = F.wave, lane = F.lane, r32 = lane & 31, hi = lane >> 5;
  const bf16* Qg = (const bf16*)(F.ws + WS_Q) + ((size_t)bhm * SEQ + qb * 256 + wid * 32 + r32) * 128 + hi * 8;
  const bf16* Kg = (const bf16*)(F.ws + WS_KP) + (size_t)bhm * 33 * 8192;
  const bf16* Vg = (const bf16*)(F.ws + WS_VP) + (size_t)(bhm >> 1) * PADT * 256;
  LAS unsigned char* lds = F.lds;
  LAS float* wsl = (LAS float*)(lds + LDS_WS) + wid * 64;
  const float slope2 = exp2f(-2.0f * (float)(((bhm >> 1) & 3) + 1)) * LOG2E;
  unsigned ksrc0, vsrc0;
  ksrc0 = (unsigned)tid * 16u;
  { const int a8 = tid >> 8, b = (tid >> 2) & 7, k = 8 * (b >> 2) + 4 * a8 + (b & 3), c = ((tid >> 5) & 7) * 32 + (tid & 3) * 8; vsrc0 = (unsigned)(k * 256 + c) * 2u; }
#define STAGE_K(j) do { const char* kt = (const char*)(Kg + (size_t)(j) * 8192); \
    _Pragma("unroll") for (int _i = 0; _i < 2; ++_i) __builtin_amdgcn_global_load_lds((const unsigned*)(kt + (ksrc0 + _i * 8192u)), (LAS unsigned*)(lds + LDS_K + _i * 8192 + wid * 1024), 16, 0, 0); } while (0)
#define STAGE_V(buf, j) do { const char* vt = (const char*)(Vg + (size_t)(j) * 64 * 256); \
    _Pragma("unroll") for (int _i = 0; _i < 4; ++_i) __builtin_amdgcn_global_load_lds((const unsigned*)(vt + (vsrc0 + _i * 8192u)), (LAS unsigned*)(lds + LDS_V + (buf) * SHM_V + _i * 8192 + wid * 1024), 16, 0, 0); } while (0)
  const int lt = (((r32 << 1) | hi) ^ ((r32 >> 3) & 1)) << 4;
  LAS unsigned char* Qs = lds + LDS_Q + wid * 8192;
#pragma unroll
  for (int d0 = 0; d0 < 8; ++d0) { const bf16x8 qv = *(const bf16x8*)(Qg + d0 * 16); *(LAS bf16x8*)(Qs + d0 * 1024 + lt) = qv; }
  f32x16 o[8];
#pragma unroll
  for (int d = 0; d < 8; ++d)
#pragma unroll
    for (int r = 0; r < 16; ++r) o[d][r] = 0.f;
  float m_reg = -1e30f, l_reg = 0.f;
  const int vb0 = (int)(uintptr_t)(lds + LDS_V) + (((lane & 3) << 3) | (((lane >> 2) & 3) << 6) | (((lane >> 4) & 1) << 5) | (((lane >> 5) & 1) << 8));
  STAGE_K(j0); STAGE_V(0, j0);
  VM_WAIT(); __syncthreads();
  for (int j = j0; j < j1; ++j) {
    const int cur = (j - j0) & 1;
    if (j + 1 < j1) STAGE_V(cur ^ 1, j + 1);
    SBAR();
    f32x16 p0 = {}, p1 = {};
    { const LAS unsigned char* Ks = lds + LDS_K;
#pragma unroll
      for (int d0 = 0; d0 < 8; ++d0) {
        const bf16x8 b0 = *(const LAS bf16x8*)(Ks + d0 * 2048 + lt);
        const bf16x8 b1 = *(const LAS bf16x8*)(Ks + d0 * 2048 + 1024 + lt);
        const bf16x8 qf = *(const LAS bf16x8*)(Qs + d0 * 1024 + lt);
        p0 = __builtin_amdgcn_mfma_f32_32x32x16_bf16(b0, qf, p0, 0, 0, 0);
        p1 = __builtin_amdgcn_mfma_f32_32x32x16_bf16(b1, qf, p1, 0, 0, 0); } }
    asm volatile("s_waitcnt lgkmcnt(0)" ::: "memory"); __builtin_amdgcn_s_barrier(); asm volatile("" ::: "memory");
    if (j + 1 < j1) STAGE_K(j + 1);
    SBAR();
    if (j == 0) {
#pragma unroll
      for (int r = 0; r < 16; ++r) p0[r] = -INFINITY;
#pragma unroll
      for (int r = 0; r < 8; ++r) p1[r] = -INFINITY;
    }
    int ln2 = threadIdx.x & 63; asm volatile("" : "+v"(ln2));
    const int hi2 = ln2 >> 5;
    const int jb = j - (4 * qb + 1);
    if (jb >= 0) {
      const int kb = 64 * jb + 4 * hi2, qrel = wid * 32 + (ln2 & 31);
#pragma unroll
      for (int r = 0; r < 16; ++r) { const int kv = kb + (r & 3) + 8 * (r >> 2); if (kv > qrel) p0[r] = -INFINITY; if (kv + 32 > qrel) p1[r] = -INFINITY; }
    }
    const float off0 = slope2 * (float)(64 * j + 4 * hi2), off1 = off0 + 32.0f * slope2;
#pragma unroll
    for (int r = 0; r < 16; ++r) { const float sb = slope2 * (float)((r & 3) + 8 * (r >> 2)); p0[r] += sb; p1[r] += sb; }
    float pm0 = p0[0], pm1 = p1[0];
#pragma unroll
    for (int r = 1; r < 16; ++r) { pm0 = fmaxf(pm0, p0[r]); pm1 = fmaxf(pm1, p1[r]); }
    float pmax = fmaxf(pm0 + off0, pm1 + off1);
    { auto rr = __builtin_amdgcn_permlane32_swap(__float_as_uint(pmax), __float_as_uint(pmax), false, false);
      pmax = fmaxf(__uint_as_float(rr[0]), __uint_as_float(rr[1])); }
    float mn, alpha;
    if (__builtin_expect(__all(pmax - m_reg <= THR2), 1)) { mn = m_reg; alpha = 1.f; }
    else { mn = fmaxf(m_reg, pmax); alpha = __builtin_amdgcn_exp2f(m_reg - mn); m_reg = mn; }
    const float c0 = off0 - mn, c1 = off1 - mn;
    float ps = 0.f;
#pragma unroll
    for (int r = 0; r < 16; ++r) { p0[r] = __builtin_amdgcn_exp2f(p0[r] + c0); p1[r] = __builtin_amdgcn_exp2f(p1[r] + c1); ps += p0[r] + p1[r]; }
    { auto rr = __builtin_amdgcn_permlane32_swap(__float_as_uint(ps), __float_as_uint(ps), false, false);
      ps = __uint_as_float(rr[0]) + __uint_as_float(rr[1]); }
    l_reg = l_reg * alpha + ps;
    if (__any(alpha < 1.f)) { if (hi == 0) wsl[r32] = alpha; asm volatile("s_waitcnt lgkmcnt(0)" ::: "memory");
#pragma unroll
      for (int rg = 0; rg < 4; ++rg) { const f32x4 al = *(const LAS f32x4*)(wsl + 8 * rg + 4 * hi);
#pragma unroll
        for (int d = 0; d < 8; ++d) { o[d][4 * rg + 0] *= al.x; o[d][4 * rg + 1] *= al.y; o[d][4 * rg + 2] *= al.z; o[d][4 * rg + 3] *= al.w; }
        SBAR(); } }
    bf16x8 pa0, pa1, pa2, pa3;
#define PK4(P, BASE, OUT) do { unsigned a0 = cvtpk(P[BASE + 0], P[BASE + 1]), a1 = cvtpk(P[BASE + 2], P[BASE + 3]);   \
    unsigned b0 = cvtpk(P[BASE + 4], P[BASE + 5]), b1 = cvtpk(P[BASE + 6], P[BASE + 7]);                              \
    auto r0 = __builtin_amdgcn_permlane32_swap(a0, b0, false, false); auto r1 = __builtin_amdgcn_permlane32_swap(a1, b1, false, false); \
    v4u w = {r0[0], r1[0], r0[1], r1[1]}; OUT = *reinterpret_cast<bf16x8*>(&w); } while (0)
    PK4(p0, 0, pa0); PK4(p0, 8, pa1); PK4(p1, 0, pa2); PK4(p1, 8, pa3);
#undef PK4
    SBAR();
    { const int vb = vb0 + cur * SHM_V;
      pv_one<0>(o[0], vb, pa0, pa1, pa2, pa3); pv_one<1>(o[1], vb, pa0, pa1, pa2, pa3); pv_one<2>(o[2], vb, pa0, pa1, pa2, pa3); pv_one<3>(o[3], vb, pa0, pa1, pa2, pa3);
      pv_one<4>(o[4], vb, pa0, pa1, pa2, pa3); pv_one<5>(o[5], vb, pa0, pa1, pa2, pa3); pv_one<6>(o[6], vb, pa0, pa1, pa2, pa3); pv_one<7>(o[7], vb, pa0, pa1, pa2, pa3); }
    VM_WAIT(); __syncthreads();
  }
  { int lane2 = threadIdx.x & 63, slot2 = slot; asm volatile("" : "+v"(lane2), "+s"(slot2));
    const int r32e = lane2 & 31, hie = lane2 >> 5;
    bf16* PO = (bf16*)(F.ws + WS_PO) + (size_t)slot2 * 256 * 256; float* ML = (float*)(F.ws + WS_ML) + (size_t)slot2 * 512;
    LAS float* wse = (LAS float*)(F.lds + LDS_WS) + wid * 64;
    if (hie == 0) { wse[r32e] = l_reg; ML[(wid * 32 + r32e) * 2] = m_reg; ML[(wid * 32 + r32e) * 2 + 1] = l_reg; }
    asm volatile("s_waitcnt lgkmcnt(0)" ::: "memory");
    char* Ob = (char*)(PO + (size_t)(wid * 32) * 256);
    const bool odd = (r32e & 1) != 0;
    const unsigned lo = (unsigned)(4 * hie * 256 + (r32e & ~1) + (odd ? 32 : 0)) * 2u;
#pragma unroll
    for (int r = 0; r < 16; ++r) { const int rowc = (r & 3) + 8 * (r >> 2); const float lv = wse[rowc + 4 * hie]; const float rl = lv > 0.f ? __builtin_amdgcn_rcpf(lv) : 0.f;
#pragma unroll
      for (int dp = 0; dp < 4; ++dp) { const float va = o[2 * dp][r] * rl, vb = o[2 * dp + 1][r] * rl;
        const float send = odd ? va : vb, keep = odd ? vb : va;
        const float recv = __builtin_bit_cast(float, __builtin_amdgcn_update_dpp(0, __builtin_bit_cast(int, send), 0xB1, 0xF, 0xF, true));
        *(unsigned*)(Ob + (lo + (unsigned)(rowc * 256 + dp * 64) * 2u)) = odd ? pk2(recv, keep) : pk2(keep, recv); }
      SBAR(); } }
  __syncthreads();
#undef STAGE_K
#undef STAGE_V
}

__device__ __forceinline__ void phase(const Frame& F, int ca, int NA) {
  int s0 = (int)(((long)ca * NSTEPS) / NA); const int s1 = (int)(((long)(ca + 1) * NSTEPS) / NA);
  while (s0 < s1) {
    const int bhm = s0 / STEPS_BHM, rem = s0 - bhm * STEPS_BHM;
    int qb = 0;
#pragma unroll 1
    for (int q = 1; q < 8; ++q) if (rem >= qb_start(q)) qb = q;
    const int j0 = rem - qb_start(qb), nst = 4 * qb + 5;
    const int j1 = (j0 + (s1 - s0) < nst) ? j0 + (s1 - s0) : nst;
    const int slot = bhm * 16 + qb + chunk_of(s0, NA) - chunk_of(bhm * STEPS_BHM, NA);
    segment(F, bhm, qb, j0, j1, slot);
    s0 += j1 - j0;
  }
}
#undef KSWZ
#undef SBAR
}
namespace ml {
constexpr int QST = 136, TST = 72;
constexpr int L_RQ = 0, L_RK = 17152, L_QS = 34304, L_QW = 51712, L_KS = 69120, L_KWT = 86528, L_VT = 104960  , L_SP = 0  , L_G = 141824, L_CW = 143872;
constexpr int L_HT = 0;
constexpr int G_A = 0, G_M = 64, G_WI = 128, G_EM = 192, G_DEN = 256, G_WG = 320, G_SC = 384, G_N = 0;
constexpr int L_NV = L_CW + 5120;
constexpr int L_SSQ = L_KWT;
__device__ __forceinline__ float shfl_up_f(float v, int d) { return __shfl_up(v, d); }

struct StageCW { float v[3]; };
__device__ __forceinline__ void issue_cw(const Frame& F, const Args& a, int h, StageCW& st) {
#pragma unroll
  for (int i = 0; i < 3; ++i) { const int e = F.tid + NTHR * i; st.v[i] = 0.f;
    if (e < 2 * 5 * 128) { const int qk = e / 640, j = (e / 128) % 5, d = e & 127; const int ch = qk * 512 + h * 128 + d; st.v[i] = j < 4 ? a.in[IN_CW][j * 1024 + ch] : a.in[IN_CB][ch]; } }
}
__device__ __forceinline__ void commit_cw(const Frame& F, const StageCW& st) {
  LAS float* CW = (LAS float*)(F.lds + L_CW);
#pragma unroll
  for (int i = 0; i < 3; ++i) { const int e = F.tid + NTHR * i; if (e < 2 * 5 * 128) CW[e] = st.v[i]; }
}
struct StageRaw { v4u v[3]; };
__device__ __forceinline__ void issue_raw(const Frame& F, const bf16* g, int pos0, StageRaw& st) {
#pragma unroll
  for (int i = 0; i < 3; ++i) { const int p = F.tid + NTHR * i, row = p >> 4, ch = p & 15, pos = pos0 - 3 + row;
    st.v[i] = (v4u){0u, 0u, 0u, 0u}; if (p < 67 * 16 && pos >= MPOS0) st.v[i] = *(const v4u*)(g + (size_t)pos * 128 + ch * 8); }
}
__device__ __forceinline__ void commit_raw(const Frame& F, int lds_off, const StageRaw& st) {
#pragma unroll
  for (int i = 0; i < 3; ++i) { const int p = F.tid + NTHR * i, row = p >> 4, ch = p & 15; if (p < 67 * 16) *(LAS v4u*)(F.lds + lds_off + row * 256 + ch * 16) = st.v[i]; }
}
__device__ __forceinline__ void conv16(const Frame& F, int qk, int lds_off, int t, int d0, float (&y)[16]) {
  const LAS float* CW = (const LAS float*)(F.lds + L_CW);
#pragma unroll
  for (int e = 0; e < 16; ++e) y[e] = CW[(qk * 5 + 4) * 128 + d0 + e];
#pragma unroll
  for (int j = 0; j < 4; ++j) { const LAS v4u* rp = (const LAS v4u*)(F.lds + lds_off + (t + j) * 256 + d0 * 2); const v4u r0 = rp[0], r1 = rp[1];
    const LAS float* cw = CW + (qk * 5 + j) * 128 + d0;
    y[0] += cw[0] * bflo(r0.x); y[1] += cw[1] * bfhi(r0.x); y[2] += cw[2] * bflo(r0.y); y[3] += cw[3] * bfhi(r0.y); y[4] += cw[4] * bflo(r0.z); y[5] += cw[5] * bfhi(r0.z); y[6] += cw[6] * bflo(r0.w); y[7] += cw[7] * bfhi(r0.w);
    y[8] += cw[8] * bflo(r1.x); y[9] += cw[9] * bfhi(r1.x); y[10] += cw[10] * bflo(r1.y); y[11] += cw[11] * bfhi(r1.y); y[12] += cw[12] * bflo(r1.z); y[13] += cw[13] * bfhi(r1.z); y[14] += cw[14] * bflo(r1.w); y[15] += cw[15] * bfhi(r1.w); }
#pragma unroll
  for (int e = 0; e < 16; ++e) y[e] = y[e] / (1.0f + __expf(-y[e]));
}
struct StageVT { v4u v[4]; };
__device__ __forceinline__ void issue_vt(const Frame& F, const bf16* MVg, int pos0, StageVT& st) {
#pragma unroll
  for (int i = 0; i < 4; ++i) { const int p = F.tid + NTHR * i, row = p >> 5, ch = p & 31; st.v[i] = (v4u){0u, 0u, 0u, 0u};
    if (pos0 + row >= MPOS0) st.v[i] = *(const v4u*)(MVg + (size_t)(pos0 + row) * 256 + ch * 8); }
}
__device__ __forceinline__ void commit_vt(const Frame& F, const StageVT& st) {
#pragma unroll
  for (int i = 0; i < 4; ++i) { const int p = F.tid + NTHR * i, row = p >> 5, ch = p & 31; const v4u v4 = st.v[i];
    LAS bf16* vt = (LAS bf16*)(F.lds + L_VT) + (ch * 8) * TST + row;
    vt[0 * TST] = (bf16)(v4.x & 0xffff); vt[1 * TST] = (bf16)(v4.x >> 16); vt[2 * TST] = (bf16)(v4.y & 0xffff); vt[3 * TST] = (bf16)(v4.y >> 16);
    vt[4 * TST] = (bf16)(v4.z & 0xffff); vt[5 * TST] = (bf16)(v4.z >> 16); vt[6 * TST] = (bf16)(v4.w & 0xffff); vt[7 * TST] = (bf16)(v4.w >> 16); }
}

__device__ __forceinline__ void taskA(const Frame& F, const Args& a, int task) {
  const int bh = task >> 5, c = task & 31, h = bh & 3, tid = F.tid, w = F.wave, lane = F.lane, fr = lane & 15, kq = lane >> 4, pos0 = 64 * c;
  LAS unsigned char* lds = F.lds; LAS float* G = (LAS float*)(lds + L_G);
  const bf16* MKg = (const bf16*)(F.ws + WS_MK) + (size_t)bh * PADT * 128; const bf16* MVg = (const bf16*)(F.ws + WS_MV) + (size_t)bh * PADT * 256;
  StageCW scw; StageRaw srk; StageVT svt; float li = -1e30f, lf = 0.f;
  issue_cw(F, a, h, scw); issue_raw(F, MKg, pos0, srk); issue_vt(F, MVg, pos0, svt);
  { const bool dead = pos0 + lane < MPOS0; if (w == 0 && !dead) { li = ((const float*)(F.ws + WS_LI))[bh * PADT + pos0 + lane]; lf = ((const float*)(F.ws + WS_LF))[bh * PADT + pos0 + lane]; } }
  __syncthreads();
  commit_cw(F, scw); commit_raw(F, L_RK, srk); commit_vt(F, svt);
  if (w == 0) {
    float bs = lf;
#pragma unroll
    for (int d = 1; d < 64; d <<= 1) { const float o = shfl_up_f(bs, d); if (lane >= d) bs += o; }
    const float av = li - bs; float mx = av;
#pragma unroll
    for (int o = 1; o < 64; o <<= 1) mx = fmaxf(mx, __shfl_xor(mx, o));
    G[G_WG + lane] = __expf(av - mx);
    if (lane == 63) { float* gs = (float*)(F.ws + WS_GS) + (size_t)(bh * 33 + c) * 2; gs[0] = bs; gs[1] = mx; }
  }
  __syncthreads();
  { const int t = tid >> 3, d0 = (tid & 7) * 16; float y[16]; conv16(F, 1, L_RK, t, d0, y);
    const float sw = 0.08838834764831845f * G[G_WG + t]; LAS bf16* kt = (LAS bf16*)(lds + L_KWT) + d0 * TST + t;
#pragma unroll
    for (int e = 0; e < 16; ++e) kt[e * TST] = (bf16)f2bf(y[e] * sw); }
  __syncthreads();
  f32x4* DCg = (f32x4*)(F.ws + WS_DC) + ((size_t)(bh * 32 + c) * 128) * 64;
#pragma unroll
  for (int jj = 0; jj < 2; ++jj) { const int j = 2 * w + jj;
    const bf16x8 bv0 = *(const LAS bf16x8*)(lds + L_VT + ((16 * j + fr) * TST + 8 * kq) * 2), bv1 = *(const LAS bf16x8*)(lds + L_VT + ((16 * j + fr) * TST + 32 + 8 * kq) * 2);
#pragma unroll
    for (int i = 0; i < 8; ++i) { f32x4 acc = {0.f, 0.f, 0.f, 0.f};
      const bf16x8 k0 = *(const LAS bf16x8*)(lds + L_KWT + ((16 * i + fr) * TST + 8 * kq) * 2), k1 = *(const LAS bf16x8*)(lds + L_KWT + ((16 * i + fr) * TST + 32 + 8 * kq) * 2);
      acc = __builtin_amdgcn_mfma_f32_16x16x32_bf16(k0, bv0, acc, 0, 0, 0); acc = __builtin_amdgcn_mfma_f32_16x16x32_bf16(k1, bv1, acc, 0, 0, 0);
      DCg[(size_t)(i * 16 + j) * 64 + lane] = acc; } }
  if (tid < 128) { const LAS v4u* kr = (const LAS v4u*)(lds + L_KWT + tid * TST * 2); float s = 0.f;
#pragma unroll
    for (int q = 0; q < 8; ++q) { const v4u x = kr[q]; s += (bflo(x.x) + bfhi(x.x)) + (bflo(x.y) + bfhi(x.y)) + (bflo(x.z) + bfhi(x.z)) + (bflo(x.w) + bfhi(x.w)); }
    ((float*)(F.ws + WS_DN))[(size_t)(bh * 32 + c) * 128 + tid] = s; }
}

__device__ __forceinline__ void scanB(const Frame& F) {
  const float* GS = (const float*)(F.ws + WS_GS);
  LAS float* cf = (LAS float*)F.lds;
  for (int blk = blockIdx.x; blk < 16 * 16; blk += gridDim.x) { const int bh = blk >> 4, r = (blk & 15) * NTHR + F.tid, i = r >> 10, j = (r >> 6) & 15, ln = r & 63;
    __syncthreads();
    if (F.wave == 0) {
      const int c = F.lane & 31; const v2u gs = *(const v2u*)(GS + (size_t)(bh * 33 + c) * 2); const unsigned g0 = gs.x, g1 = gs.y;
      const float bL = __builtin_bit_cast(float, g0), ml = __builtin_bit_cast(float, g1);
      float mm = 0.f, fa = 0.f, fb = 0.f, mout = 0.f;
#pragma unroll
      for (int cc = 0; cc < 32; ++cc) { const float b_ = __builtin_bit_cast(float, __builtin_amdgcn_readlane(__builtin_bit_cast(int, bL), cc)), l_ = __builtin_bit_cast(float, __builtin_amdgcn_readlane(__builtin_bit_cast(int, ml), cc));
        const float me = fmaxf(mm, l_); if (c == cc) { fa = __expf(mm - me); fb = __expf(l_ - me); } mm = b_ + me; if (c == cc) mout = mm; }
      if (F.lane < 32) { cf[2 * c] = fa; cf[2 * c + 1] = fb; if ((blk & 15) == 0) ((float*)(F.ws + WS_MS))[bh * 33 + c + 1] = mout; }
    }
    __syncthreads();
    const f32x4* dc0 = (const f32x4*)(F.ws + WS_DC) + ((size_t)(bh * 32) * 128 + (i * 16 + j)) * 64 + ln;
    v2u* cs = (v2u*)(F.ws + WS_CS) + ((((size_t)bh * 33) * 8 + i) * 16 + j) * 64 + ln;
    f32x4 s0 = {0.f, 0.f, 0.f, 0.f}, dv[32];
#pragma unroll
    for (int c = 0; c < 32; ++c) dv[c] = dc0[(size_t)c * 128 * 64];
#pragma unroll
    for (int c = 0; c < 32; ++c) { const float fa = cf[2 * c], fb = cf[2 * c + 1];
      s0 = s0 * fa + dv[c] * fb;
      v2u o; o.x = pk2(s0.x, s0.y); o.y = pk2(s0.z, s0.w); cs[(size_t)(c + 1) * 8 * 16 * 64] = o; }
    if ((blk & 15) == 0 && F.tid < 128) {
      const float* dn = (const float*)(F.ws + WS_DN) + (size_t)(bh * 32) * 128 + F.tid; float* ns = (float*)(F.ws + WS_NS) + (size_t)(bh * 33) * 128 + F.tid; float n = 0.f;
      float dnv[32];
#pragma unroll
      for (int c = 0; c < 32; ++c) dnv[c] = dn[(size_t)c * 128];
#pragma unroll
      for (int c = 0; c < 32; ++c) { n = n * cf[2 * c] + dnv[c] * cf[2 * c + 1]; ns[(size_t)(c + 1) * 128] = n; }
    }
  }
}

__device__ __forceinline__ void taskC(const Frame& F, const Args& a, int task) {
  TP_BEGIN(31);
  const int bh = task >> 5, c = (task & 31) + 1, b = bh >> 2, h = bh & 3, tid = F.tid, w = F.wave, lane = F.lane, fr = lane & 15, kq = lane >> 4, pos0 = 64 * c;
  LAS unsigned char* lds = F.lds; LAS float* G = (LAS float*)(lds + L_G); LAS float* NV = (LAS float*)(lds + L_NV);
  const bf16* MQg = (const bf16*)(F.ws + WS_MQ) + (size_t)bh * PADT * 128; const bf16* MKg = (const bf16*)(F.ws + WS_MK) + (size_t)bh * PADT * 128;
  const bf16* MVg = (const bf16*)(F.ws + WS_MV) + (size_t)bh * PADT * 256;
  const float m = ((const float*)(F.ws + WS_MS))[bh * 33 + c];
  StageCW scw; StageRaw srq, srk; StageVT svt; float nvv = 0.f, li = 0.f, lf = 0.f;
  issue_cw(F, a, h, scw); issue_raw(F, MQg, pos0, srq); issue_raw(F, MKg, pos0, srk); issue_vt(F, MVg, pos0, svt);
  if (tid < 128) nvv = ((const float*)(F.ws + WS_NS))[(size_t)(bh * 33 + c) * 128 + tid];
  if (w == 0) { li = ((const float*)(F.ws + WS_LI))[bh * PADT + pos0 + lane]; lf = ((const float*)(F.ws + WS_LF))[bh * PADT + pos0 + lane]; }
  __syncthreads();
  commit_cw(F, scw); commit_raw(F, L_RQ, srq); commit_raw(F, L_RK, srk); commit_vt(F, svt);
  if (tid < 128) NV[tid] = nvv;
  if (w == 0) {
    float bs = lf;
#pragma unroll
    for (int d = 1; d < 64; d <<= 1) { const float o = shfl_up_f(bs, d); if (lane >= d) bs += o; }
    const float av = li - bs; float cm = av;
#pragma unroll
    for (int d = 1; d < 64; d <<= 1) { const float o = shfl_up_f(cm, d); if (lane >= d) cm = fmaxf(cm, o); }
    const float Mt = fmaxf(m, cm);
    G[G_A + lane] = av; G[G_M + lane] = Mt; G[G_WI + lane] = __expf(m - Mt); G[G_EM + lane] = __expf(-(bs + Mt));
  }
  __syncthreads(); TP_END(31, F.ws); TP_BEGIN(32);
  { const int t = tid >> 3, d0 = (tid & 7) * 16; const float wi = G[G_WI + t]; float y[16];
    conv16(F, 0, L_RQ, t, d0, y);
    { v4u o0, o1, w0, w1;
      o0.x = pk2(y[0], y[1]); o0.y = pk2(y[2], y[3]); o0.z = pk2(y[4], y[5]); o0.w = pk2(y[6], y[7]); o1.x = pk2(y[8], y[9]); o1.y = pk2(y[10], y[11]); o1.z = pk2(y[12], y[13]); o1.w = pk2(y[14], y[15]);
      w0.x = pk2(y[0] * wi, y[1] * wi); w0.y = pk2(y[2] * wi, y[3] * wi); w0.z = pk2(y[4] * wi, y[5] * wi); w0.w = pk2(y[6] * wi, y[7] * wi);
      w1.x = pk2(y[8] * wi, y[9] * wi); w1.y = pk2(y[10] * wi, y[11] * wi); w1.z = pk2(y[12] * wi, y[13] * wi); w1.w = pk2(y[14] * wi, y[15] * wi);
      LAS v4u* qs = (LAS v4u*)(lds + L_QS + (t * QST + d0) * 2); qs[0] = o0; qs[1] = o1;
      LAS v4u* qw = (LAS v4u*)(lds + L_QW + (t * QST + d0) * 2); qw[0] = w0; qw[1] = w1; }
    __builtin_amdgcn_sched_barrier(0);
    conv16(F, 1, L_RK, t, d0, y);
    { const float sc = 0.08838834764831845f; v4u o0, o1;
      o0.x = pk2(y[0] * sc, y[1] * sc); o0.y = pk2(y[2] * sc, y[3] * sc); o0.z = pk2(y[4] * sc, y[5] * sc); o0.w = pk2(y[6] * sc, y[7] * sc);
      o1.x = pk2(y[8] * sc, y[9] * sc); o1.y = pk2(y[10] * sc, y[11] * sc); o1.z = pk2(y[12] * sc, y[13] * sc); o1.w = pk2(y[14] * sc, y[15] * sc);
      LAS v4u* ks = (LAS v4u*)(lds + L_KS + (t * QST + d0) * 2); ks[0] = o0; ks[1] = o1; } }
  __syncthreads(); TP_END(32, F.ws); TP_BEGIN(33);
  v4u cb[4][2];
  { const v2u* cs = (const v2u*)(F.ws + WS_CS) + (((size_t)bh * 33 + c) * 8 * 16) * 64;
#pragma unroll
    for (int I = 0; I < 4; ++I)
#pragma unroll
      for (int jj = 0; jj < 2; ++jj) { const v2u lo_ = cs[(size_t)((2 * I) * 16 + 2 * w + jj) * 64 + lane], hi_ = cs[(size_t)((2 * I + 1) * 16 + 2 * w + jj) * 64 + lane]; cb[I][jj] = (v4u){lo_.x, lo_.y, hi_.x, hi_.y}; } }
  { const int si = w >> 1; const f32x4 as = *(const LAS f32x4*)(G + G_A + 16 * si + 4 * kq);
#pragma unroll
    for (int tt = 0; tt < 2; ++tt) { const int ti = 2 * (w & 1) + tt; f32x4 acc = {0.f, 0.f, 0.f, 0.f};
#pragma unroll
      for (int ks = 0; ks < 4; ++ks) { const bf16x8 af = *(const LAS bf16x8*)(lds + L_KS + ((16 * si + fr) * QST + 32 * ks + 8 * kq) * 2);
        const bf16x8 bfr = *(const LAS bf16x8*)(lds + L_QS + ((16 * ti + fr) * QST + 32 * ks + 8 * kq) * 2);
        acc = __builtin_amdgcn_mfma_f32_16x16x32_bf16(af, bfr, acc, 0, 0, 0); }
      const int t = 16 * ti + fr, s0 = 16 * si + 4 * kq; const float Mt = G[G_M + t];
      const float v0 = (s0 + 0 <= t) ? acc.x * __expf(as.x - Mt) : 0.f, v1 = (s0 + 1 <= t) ? acc.y * __expf(as.y - Mt) : 0.f;
      const float v2 = (s0 + 2 <= t) ? acc.z * __expf(as.z - Mt) : 0.f, v3 = (s0 + 3 <= t) ? acc.w * __expf(as.w - Mt) : 0.f;
      v2u o; o.x = pk2(v0, v1); o.y = pk2(v2, v3);
      *(LAS v2u*)(lds + L_SP + (t * TST + s0) * 2) = o; } }
  __syncthreads(); TP_END(33, F.ws); TP_BEGIN(34);
  if (w == 0) { const int t = lane; float qn = 0.f, rsum = 0.f;
#pragma unroll 4
    for (int q = 0; q < 16; ++q) { const v4u x = *(const LAS v4u*)(lds + L_QS + (t * QST + q * 8) * 2); const f32x4 n0 = *(const LAS f32x4*)(NV + q * 8), n1 = *(const LAS f32x4*)(NV + q * 8 + 4);
      qn += bflo(x.x) * n0.x + bfhi(x.x) * n0.y + bflo(x.y) * n0.z + bfhi(x.y) * n0.w + bflo(x.z) * n1.x + bfhi(x.z) * n1.y + bflo(x.w) * n1.z + bfhi(x.w) * n1.w; }
#pragma unroll
    for (int q = 0; q < 8; ++q) { const v4u x = *(const LAS v4u*)(lds + L_SP + (t * TST + q * 8) * 2); rsum += (bflo(x.x) + bfhi(x.x)) + (bflo(x.y) + bfhi(x.y)) + (bflo(x.z) + bfhi(x.z)) + (bflo(x.w) + bfhi(x.w)); }
    const float den = G[G_WI + t] * qn + rsum; G[G_DEN + t] = fmaxf(fabsf(den), G[G_EM + t]); }
  f32x4 acc[2][4];
#pragma unroll
  for (int jj = 0; jj < 2; ++jj)
#pragma unroll
    for (int ti = 0; ti < 4; ++ti) acc[jj][ti] = (f32x4){0.f, 0.f, 0.f, 0.f};
#pragma unroll
  for (int I = 0; I < 4; ++I) {
#pragma unroll
    for (int ti = 0; ti < 4; ++ti) { const LAS unsigned char* qp = lds + L_QW + ((16 * ti + fr) * QST + 32 * I + 4 * kq) * 2;
      const v2u a0 = *(const LAS v2u*)qp, a1 = *(const LAS v2u*)(qp + 32); const v4u av = {a0.x, a0.y, a1.x, a1.y};
      acc[0][ti] = __builtin_amdgcn_mfma_f32_16x16x32_bf16(__builtin_bit_cast(bf16x8, av), __builtin_bit_cast(bf16x8, cb[I][0]), acc[0][ti], 0, 0, 0);
      acc[1][ti] = __builtin_amdgcn_mfma_f32_16x16x32_bf16(__builtin_bit_cast(bf16x8, av), __builtin_bit_cast(bf16x8, cb[I][1]), acc[1][ti], 0, 0, 0); }
    __builtin_amdgcn_sched_barrier(0); }
#pragma unroll
  for (int ks = 0; ks < 2; ++ks) { const bf16x8 bv0 = *(const LAS bf16x8*)(lds + L_VT + ((32 * w + fr) * TST + 32 * ks + 8 * kq) * 2), bv1 = *(const LAS bf16x8*)(lds + L_VT + ((32 * w + 16 + fr) * TST + 32 * ks + 8 * kq) * 2);
#pragma unroll
    for (int ti = 0; ti < 4; ++ti) { const bf16x8 sf = *(const LAS bf16x8*)(lds + L_SP + ((16 * ti + fr) * TST + 32 * ks + 8 * kq) * 2);
      acc[0][ti] = __builtin_amdgcn_mfma_f32_16x16x32_bf16(sf, bv0, acc[0][ti], 0, 0, 0); acc[1][ti] = __builtin_amdgcn_mfma_f32_16x16x32_bf16(sf, bv1, acc[1][ti], 0, 0, 0); } }
  v4u mvp[4];
  { const int t_ = tid >> 3, c0_ = (tid & 7) * 32; const bf16* mo_ = (const bf16*)(F.ws + WS_MO) + ((size_t)b * SEQ + 64 * (c - 1) + t_) * 1024 + h * 256 + c0_;
#pragma unroll
    for (int q = 0; q < 4; ++q) mvp[q] = *(const v4u*)(mo_ + q * 8); }
  __syncthreads(); TP_END(34, F.ws); TP_BEGIN(35);
  LAS float* SSQ = (LAS float*)(lds + L_SSQ);
#pragma unroll
  for (int ti = 0; ti < 4; ++ti) { const f32x4 dn = *(const LAS f32x4*)(G + G_DEN + 16 * ti + 4 * kq);
    f32x4 s4;
#pragma unroll
    for (int r = 0; r < 4; ++r) { const float h0 = acc[0][ti][r] / dn[r], h1 = acc[1][ti][r] / dn[r]; acc[0][ti][r] = h0; acc[1][ti][r] = h1; s4[r] = h0 * h0 + h1 * h1; }
#pragma unroll
    for (int r = 0; r < 4; ++r) { float v = s4[r];
      v += __builtin_bit_cast(float, __builtin_amdgcn_update_dpp(0, __builtin_bit_cast(int, v), 0xB1, 0xF, 0xF, true)); v += __builtin_bit_cast(float, __builtin_amdgcn_update_dpp(0, __builtin_bit_cast(int, v), 0x4E, 0xF, 0xF, true));
      v += __builtin_bit_cast(float, __builtin_amdgcn_update_dpp(0, __builtin_bit_cast(int, v), 0x141, 0xF, 0xF, true)); v += __builtin_bit_cast(float, __builtin_amdgcn_update_dpp(0, __builtin_bit_cast(int, v), 0x140, 0xF, 0xF, true)); s4[r] = v; }
    if (fr == 0) { SSQ[(16 * ti + 4 * kq + 0) * 8 + w] = s4.x; SSQ[(16 * ti + 4 * kq + 1) * 8 + w] = s4.y; SSQ[(16 * ti + 4 * kq + 2) * 8 + w] = s4.z; SSQ[(16 * ti + 4 * kq + 3) * 8 + w] = s4.w; } }
  __syncthreads();
  LAS bf16* HT = (LAS bf16*)(lds + L_HT);
#pragma unroll
  for (int ti = 0; ti < 4; ++ti)
#pragma unroll
    for (int r = 0; r < 4; ++r) { const int t = 16 * ti + 4 * kq + r; const f32x4 p0 = *(const LAS f32x4*)(SSQ + t * 8), p1 = *(const LAS f32x4*)(SSQ + t * 8 + 4);
      const float rh = rsqrtf(((p0.x + p0.y) + (p0.z + p0.w) + (p1.x + p1.y) + (p1.z + p1.w)) * (1.0f / 256.f) + EPS);
      HT[t * 264 + 32 * w + fr] = (bf16)f2bf(acc[0][ti][r] * rh); HT[t * 264 + 32 * w + 16 + fr] = (bf16)f2bf(acc[1][ti][r] * rh); }
  __syncthreads(); TP_END(35, F.ws); TP_BEGIN(36);
  { const int t = tid >> 3, c0 = (tid & 7) * 32; const size_t R = (size_t)b * SEQ + 64 * (c - 1) + t;
    const float* og = a.in[IN_OUTG] + h * 256 + c0; bf16* A2 = (bf16*)(F.ws + WS_A2) + R * DM + 1024 + h * 256 + c0;
    f32x4 gg[8];
#pragma unroll
    for (int q = 0; q < 8; ++q) gg[q] = *(const f32x4*)(og + q * 4);
#pragma unroll
    for (int q = 0; q < 4; ++q) { const v4u hv = *(const LAS v4u*)(HT + t * 264 + c0 + q * 8); const v4u mv = mvp[q]; const f32x4 g0 = gg[2 * q], g1 = gg[2 * q + 1];
      v4u o; o.x = pk2(bflo(hv.x) * g0.x * sigmoidf_(bflo(mv.x)), bfhi(hv.x) * g0.y * sigmoidf_(bfhi(mv.x))); o.y = pk2(bflo(hv.y) * g0.z * sigmoidf_(bflo(mv.y)), bfhi(hv.y) * g0.w * sigmoidf_(bfhi(mv.y)));
      o.z = pk2(bflo(hv.z) * g1.x * sigmoidf_(bflo(mv.z)), bfhi(hv.z) * g1.y * sigmoidf_(bfhi(mv.z))); o.w = pk2(bflo(hv.w) * g1.z * sigmoidf_(bflo(mv.w)), bfhi(hv.w) * g1.w * sigmoidf_(bfhi(mv.w)));
      *(v4u*)(A2 + q * 8) = o; } }
  TP_END(36, F.ws);
}
}
struct CombRow { float mp[8][3], lp[8][3]; v4u op[8][3]; };
__device__ __forceinline__ float half_sum_dpp(float v, bool hi) {
  v += __builtin_bit_cast(float, __builtin_amdgcn_update_dpp(0, __builtin_bit_cast(int, v), 0xB1, 0xF, 0xF, true));
  v += __builtin_bit_cast(float, __builtin_amdgcn_update_dpp(0, __builtin_bit_cast(int, v), 0x4E, 0xF, 0xF, true));
  v += __builtin_bit_cast(float, __builtin_amdgcn_update_dpp(0, __builtin_bit_cast(int, v), 0x141, 0xF, 0xF, true));
  v += __builtin_bit_cast(float, __builtin_amdgcn_update_dpp(0, __builtin_bit_cast(int, v), 0x140, 0xF, 0xF, true));
  const float r0 = __builtin_bit_cast(float, __builtin_amdgcn_readlane(__builtin_bit_cast(int, v), 0)), r1 = __builtin_bit_cast(float, __builtin_amdgcn_readlane(__builtin_bit_cast(int, v), 16));
  const float r2 = __builtin_bit_cast(float, __builtin_amdgcn_readlane(__builtin_bit_cast(int, v), 32)), r3 = __builtin_bit_cast(float, __builtin_amdgcn_readlane(__builtin_bit_cast(int, v), 48));
  return hi ? r2 + r3 : r0 + r1;
}
__device__ __forceinline__ void comb_load(const bf16* PO, const float* ML, int R0, int NA, int lane, CombRow& cr) {
  const int b = R0 >> 11, t = R0 & 2047, qb = t >> 8, rq = (t & 255) + (lane >> 5), l32 = lane & 31;
#pragma unroll
  for (int hm = 0; hm < 8; ++hm) {
    const int bhm = b * 8 + hm, first = bhm * att::STEPS_BHM + att::qb_start(qb), last = first + 4 * qb + 4;
    const int cf = att::chunk_of(first, NA), np = att::chunk_of(last, NA) - cf + 1, slot0 = bhm * 16 + qb + cf - att::chunk_of(bhm * att::STEPS_BHM, NA);
#pragma unroll
    for (int p = 0; p < 3; ++p) { if (p < np) { const int slot = slot0 + p; const v2u ml = *(const v2u*)(ML + (size_t)slot * 512 + rq * 2);
        const unsigned mx_ = ml.x, my_ = ml.y; cr.mp[hm][p] = __builtin_bit_cast(float, mx_); cr.lp[hm][p] = __builtin_bit_cast(float, my_);
        cr.op[hm][p] = ((const v4u*)(PO + ((size_t)slot * 256 + rq) * 256))[l32]; } else { cr.mp[hm][p] = -1e30f; cr.lp[hm][p] = 0.f; cr.op[hm][p] = (v4u){0u, 0u, 0u, 0u}; } }
  }
}
__device__ __forceinline__ void comb_finish(bf16* A2, int R0, int lane, float lam, const f32x4 sg0, const f32x4 sg1, const CombRow& cr) {
  const bool hi = lane >= 32; const int l32 = lane & 31;
#pragma unroll
  for (int h = 0; h < 4; ++h) {
    float om[2][8];
#pragma unroll
    for (int m = 0; m < 2; ++m) { const int hm = h * 2 + m;
      const float M = fmaxf(cr.mp[hm][0], fmaxf(cr.mp[hm][1], cr.mp[hm][2]));
      float wsum = 0.f, acc[8];
#pragma unroll
      for (int i = 0; i < 8; ++i) acc[i] = 0.f;
#pragma unroll
      for (int p = 0; p < 3; ++p) { const float w = cr.lp[hm][p] * exp2f(cr.mp[hm][p] - M); wsum += w; const v4u ow = cr.op[hm][p];
#pragma unroll
        for (int i = 0; i < 4; ++i) { const unsigned wd = ow[i]; acc[2 * i] += bflo(wd) * w; acc[2 * i + 1] += bfhi(wd) * w; } }
      const float iw = 1.0f / wsum;
#pragma unroll
      for (int i = 0; i < 8; ++i) om[m][i] = acc[i] * iw;
    }
    float o[8], ss = 0.f;
#pragma unroll
    for (int i = 0; i < 8; ++i) { o[i] = om[0][i] - om[1][i] * lam; ss += o[i] * o[i]; }
    const float rs = rsqrtf(half_sum_dpp(ss, hi) * (1.0f / 256.f) + EPS) * 0.8f;
    v4u w; w.x = pk2(o[0] * rs * sg0.x, o[1] * rs * sg0.y); w.y = pk2(o[2] * rs * sg0.z, o[3] * rs * sg0.w); w.z = pk2(o[4] * rs * sg1.x, o[5] * rs * sg1.y); w.w = pk2(o[6] * rs * sg1.z, o[7] * rs * sg1.w);
    ((v4u*)(A2 + (size_t)(R0 + (hi ? 1 : 0)) * DM + h * 256))[l32] = w;
  }
}
__device__ __forceinline__ void p3_combine(const Frame& F, const Args& a, int NA) {
  const bf16* PO = (const bf16*)(F.ws + WS_PO); const float* ML = (const float*)(F.ws + WS_ML);
  bf16* A2 = (bf16*)(F.ws + WS_A2);
  const float lam = *(const float*)(F.ws + WS_LAM);
  const int gw = blockIdx.x * NWAVES + F.wave, NGW = gridDim.x * NWAVES, lane = F.lane;
  const f32x4 sg0 = ((const f32x4*)a.in[IN_SUBG])[2 * (lane & 31)], sg1 = ((const f32x4*)a.in[IN_SUBG])[2 * (lane & 31) + 1];
  for (int k = gw; k < MROWS / 4; k += NGW) {
#pragma unroll 1
    for (int s = 0; s < 2; ++s) { const int P = s ? MROWS / 2 - 1 - k : k;
      CombRow r0;
      comb_load(PO, ML, 2 * P, NA, lane, r0);
      comb_finish(A2, 2 * P, lane, lam, sg0, sg1, r0); }
  }
}
struct EpiRes {
  static constexpr bool PERM = true, AFTER_DRAIN = false;
  const float* x; float* out; bf16* H1b; float* SSQ;
  __device__ __forceinline__ void operator()(const pg8::f32x4 (&acc)[2][2][4][2], const pg8::Unit& u, int wr, int wc, int fr, int fq) const {
    const int row0 = u.pm * 256 + wr * 64 + fr, col0 = u.pn * 256 + wc * 32 + 8 * fq;
#pragma unroll
    for (int ai = 0; ai < 2; ++ai) {
      f32x4 xv[4][2][2];
#pragma unroll
      for (int m = 0; m < 4; ++m)
#pragma unroll
        for (int bj = 0; bj < 2; ++bj) { const size_t off = (size_t)(row0 + ai * 128 + m * 16) * DM + col0 + bj * 128; xv[m][bj][0] = *(const f32x4*)(x + off); xv[m][bj][1] = *(const f32x4*)(x + off + 4); }
#pragma unroll
      for (int m = 0; m < 4; ++m) { const size_t R = (size_t)(row0 + ai * 128 + m * 16); float s = 0.f;
#pragma unroll
        for (int bj = 0; bj < 2; ++bj) { const size_t off = R * DM + col0 + bj * 128;
          const f32x4 v0 = acc[ai][bj][m][0] + xv[m][bj][0], v1 = acc[ai][bj][m][1] + xv[m][bj][1];
          v4u w; w.x = pk2(v0.x, v0.y); w.y = pk2(v0.z, v0.w); w.z = pk2(v1.x, v1.y); w.w = pk2(v1.z, v1.w);
          *(v4u*)(H1b + off) = w;
          s += (v0.x * v0.x + v0.y * v0.y) + (v0.z * v0.z + v0.w * v0.w) + (v1.x * v1.x + v1.y * v1.y) + (v1.z * v1.z + v1.w * v1.w); }
        s += __shfl_xor(s, 16); s += __shfl_xor(s, 32);
        if (fq == 0) SSQ[R * 32 + u.pn * 4 + wc] = s; }
    }
  }
};
#ifndef PEER_U_FP8
#define PEER_U_FP8 0
#endif
typedef __bf16 bfv2 __attribute__((ext_vector_type(2)));
__device__ __forceinline__ void split_hl(const f32x4 a, const f32x4 b, bf16x8& hi, bf16x8& lo) {
  float v[8] = {a.x, a.y, a.z, a.w, b.x, b.y, b.z, b.w}; unsigned h[8], l[8];
#pragma unroll
  for (int i = 0; i < 8; ++i) { h[i] = f2bf(v[i]); l[i] = f2bf(v[i] - __builtin_bit_cast(float, h[i] << 16)); }
  v4u hv = {h[0] | (h[1] << 16), h[2] | (h[3] << 16), h[4] | (h[5] << 16), h[6] | (h[7] << 16)};
  v4u lv = {l[0] | (l[1] << 16), l[2] | (l[3] << 16), l[4] | (l[5] << 16), l[6] | (l[7] << 16)};
  hi = __builtin_bit_cast(bf16x8, hv); lo = __builtin_bit_cast(bf16x8, lv);
}
__device__ __forceinline__ void p0_w3t(const Frame& F, const Args& a) {
  const float* wq = a.in[IN_WQ]; const float* sk = a.in[IN_SUBK]; const float* g2 = a.in[IN_G2];
  bf16* W3t = (bf16*)(F.ws + WS_W3T);
  const int lane = F.lane, fr = lane & 15, fq = lane >> 4;
  constexpr int SKS = 272;
  LAS unsigned char* shi = F.lds; LAS unsigned char* slo = F.lds + 128 * SKS;
  for (int bt = blockIdx.x; bt < 256; bt += gridDim.x) {
    const int hh = bt & 15, kt = (bt >> 4) * 8 + F.wave;
    const float* ap = wq + (size_t)(kt * 16 + fr) * DM + hh * 128 + fq * 8;
    f32x4 a0[4], a1[4];
#pragma unroll
    for (int s = 0; s < 4; ++s) { a0[s] = *(const f32x4*)(ap + 32 * s); a1[s] = *(const f32x4*)(ap + 32 * s + 4); }
    const f32x4 gk = *(const f32x4*)(g2 + kt * 16 + fq * 4);
    __syncthreads();
#pragma unroll
    for (int i = 0; i < 4; ++i) { const int idx = F.tid + NTHR * i, key = idx >> 4, c8 = idx & 15; const float* p = sk + (size_t)(hh * 128 + key) * 128 + c8 * 8;
      bf16x8 h, l; split_hl(*(const f32x4*)p, *(const f32x4*)(p + 4), h, l);
      *(LAS bf16x8*)(shi + key * SKS + c8 * 16) = h; *(LAS bf16x8*)(slo + key * SKS + c8 * 16) = l; }
    bf16x8 ahi[4], alo[4];
#pragma unroll
    for (int s = 0; s < 4; ++s) split_hl(a0[s], a1[s], ahi[s], alo[s]);
    __syncthreads();
#pragma unroll 2
    for (int t2 = 0; t2 < 8; ++t2) {
      const LAS unsigned char* bh = shi + (t2 * 16 + fr) * SKS + fq * 16; const LAS unsigned char* bl = slo + (t2 * 16 + fr) * SKS + fq * 16;
      f32x4 acc = {0.f, 0.f, 0.f, 0.f};
#pragma unroll
      for (int s = 0; s < 4; ++s) { const bf16x8 bhi = *(const LAS bf16x8*)(bh + 64 * s), blo = *(const LAS bf16x8*)(bl + 64 * s);
        acc = __builtin_amdgcn_mfma_f32_16x16x32_bf16(ahi[s], bhi, acc, 0, 0, 0);
        acc = __builtin_amdgcn_mfma_f32_16x16x32_bf16(ahi[s], blo, acc, 0, 0, 0);
        acc = __builtin_amdgcn_mfma_f32_16x16x32_bf16(alo[s], bhi, acc, 0, 0, 0); }
      v2u o; o.x = pk2(acc.x * gk.x, acc.y * gk.y); o.y = pk2(acc.z * gk.z, acc.w * gk.w);
      *(v2u*)(W3t + (size_t)(hh * 128 + t2 * 16 + fr) * DM + kt * 16 + fq * 4) = o;
    }
  }
  __syncthreads();
}
typedef float f32x2v __attribute__((ext_vector_type(2)));
__device__ __forceinline__ void p0_tables(const Frame& F, const Args& a) {
  const float* g2 = a.in[IN_G2];
  float* SCL = (float*)(F.ws + WS_SCL);
  const int gw = blockIdx.x * NWAVES + F.wave, NGW = gridDim.x * NWAVES, lane = F.lane;
  f32x4 gl[8];
#pragma unroll
  for (int q = 0; q < 8; ++q) gl[q] = *(const f32x4*)(g2 + q * 256 + lane * 4);
  f32x4 xn[8];
  { const int row = gw; if (row < 2 * 16384) { const float* src = a.in[row >= 16384 ? IN_V : IN_U] + (size_t)(row & 16383) * DM + lane * 4;
#pragma unroll
      for (int q = 0; q < 8; ++q) xn[q] = *(const f32x4*)(src + q * 256); } }
  for (int row = gw; row < 2 * 16384; row += NGW) {
    const bool isv = row >= 16384; const int e = row & 16383;
    f32x4 x[8];
#pragma unroll
    for (int q = 0; q < 8; ++q) x[q] = xn[q];
    { const int rn = row + NGW; if (rn < 2 * 16384) { const float* src = a.in[rn >= 16384 ? IN_V : IN_U] + (size_t)(rn & 16383) * DM + lane * 4;
#pragma unroll
        for (int q = 0; q < 8; ++q) xn[q] = *(const f32x4*)(src + q * 256); } }
    float amax = 0.f, ssq = 0.f;
#pragma unroll
    for (int q = 0; q < 8; ++q) { if (!isv) x[q] = x[q] * gl[q]; amax = fmaxf(amax, fmaxf(fmaxf(fabsf(x[q].x), fabsf(x[q].y)), fmaxf(fabsf(x[q].z), fabsf(x[q].w))));
      ssq += (x[q].x * x[q].x + x[q].y * x[q].y) + (x[q].z * x[q].z + x[q].w * x[q].w); }
#pragma unroll
    for (int o = 1; o < 64; o <<= 1) amax = fmaxf(amax, __shfl_xor(amax, o));
    v4u w;
    if (isv) {
      const float sc = amax > 0.f ? 6.0f / amax : 1.0f;
#pragma unroll
      for (int d = 0; d < 4; ++d) { unsigned pk = 0u;
        pk = __builtin_amdgcn_cvt_scalef32_pk_fp4_f32(pk, x[2 * d].x * sc, x[2 * d].y * sc, 1.0f, 0); pk = __builtin_amdgcn_cvt_scalef32_pk_fp4_f32(pk, x[2 * d].z * sc, x[2 * d].w * sc, 1.0f, 1);
        pk = __builtin_amdgcn_cvt_scalef32_pk_fp4_f32(pk, x[2 * d + 1].x * sc, x[2 * d + 1].y * sc, 1.0f, 2); pk = __builtin_amdgcn_cvt_scalef32_pk_fp4_f32(pk, x[2 * d + 1].z * sc, x[2 * d + 1].w * sc, 1.0f, 3);
        w[d] = pk; }
      if (lane == 0) SCL[row] = 1.0f / sc;
    } else {
      ssq = wave_sum_dpp(ssq);
      const float sA = amax > 0.f ? amax * (1.0f / 7.0f) : 1.0f, sB = fminf(sA, 0.36f * sqrtf(ssq * (1.0f / DM)) + 1e-30f);
      const float iA = 1.0f / sA, iB = 1.0f / sB;
      float eA = 0.f, eB = 0.f;
#pragma unroll
      for (int q = 0; q < 8; ++q)
#pragma unroll
        for (int j = 0; j < 4; ++j) { const float v = x[q][j];
          const float da = v - sA * __builtin_amdgcn_fmed3f(__builtin_rintf(v * iA), -7.0f, 7.0f), db = v - sB * __builtin_amdgcn_fmed3f(__builtin_rintf(v * iB), -7.0f, 7.0f);
          eA += da * da; eB += db * db; }
      eA = wave_sum_dpp(eA); eB = wave_sum_dpp(eB);
      const bool useB = eB < eA; const float st = useB ? sB : sA, is = useB ? iB : iA;
#pragma unroll
      for (int d = 0; d < 4; ++d) { unsigned pk = 0u;
#pragma unroll
        for (int p = 0; p < 8; ++p) { const float v = x[2 * d + (p >> 2)][p & 3]; const int qi = (int)__builtin_amdgcn_fmed3f(__builtin_rintf(v * is), -7.0f, 7.0f); pk |= ((unsigned)qi & 15u) << (4 * p); }
        w[d] = pk; }
      if (lane == 0) SCL[row] = st;
    }
    *(v4u*)(F.ws + (isv ? WS_VB8 : WS_UB) + (size_t)e * 1024 + lane * 16) = w;
  }
}
struct EpiScore {
  static constexpr bool PERM = true, AFTER_DRAIN = false;
  float* S; const LAS float* rs;
  __device__ __forceinline__ void operator()(const pg8::f32x4 (&acc)[2][2][4][2], const pg8::Unit& u, int wr, int wc, int fr, int fq) const {
    const int rl0 = wr * 64 + fr, keyb = wc * 32 + 8 * fq;
#pragma unroll
    for (int ai = 0; ai < 2; ++ai)
#pragma unroll
      for (int m = 0; m < 4; ++m) { const int rl = rl0 + ai * 128 + m * 16; const float r = rs[rl]; const int row = u.pm * 256 + rl;
#pragma unroll
        for (int bj = 0; bj < 2; ++bj) { float* d = S + ((size_t)((row >> 5) * 16 + u.pn * 2 + bj) * 128 + keyb) * 32 + (row & 31);
          const pg8::f32x4 v0 = acc[ai][bj][m][0] * r, v1 = acc[ai][bj][m][1] * r;
          d[0] = v0[0]; d[32] = v0[1]; d[64] = v0[2]; d[96] = v0[3]; d[128] = v1[0]; d[160] = v1[1]; d[192] = v1[2]; d[224] = v1[3]; } }
  }
};

__device__ __forceinline__ unsigned fkey(float f) { const unsigned b = __builtin_bit_cast(unsigned, f); return b ^ ((b >> 31) ? 0xFFFFFFFFu : 0x80000000u); }
template <int NV, int K> __device__ __forceinline__ void wave_topk(const unsigned (&u)[NV], bool (&sel)[NV], int lane) {
  unsigned prefix = 0u; int cge = NV * 64;
#pragma unroll 1
  for (int bit = 31; bit >= 0 && cge != K; --bit) {
    const unsigned cand = prefix | (1u << bit); int c = 0;
#pragma unroll
    for (int i = 0; i < NV; ++i) c += __builtin_popcountll(__ballot(u[i] >= cand));
    if (c >= K) { prefix = cand; cge = c; }
  }
  int cgt = 0;
#pragma unroll
  for (int i = 0; i < NV; ++i) cgt += __builtin_popcountll(__ballot(u[i] > prefix));
  int need = K - cgt;
  const unsigned long long lm = (1ull << lane) - 1ull;
#pragma unroll
  for (int i = 0; i < NV; ++i) { const unsigned long long eq = __ballot(u[i] == prefix); const int before = __builtin_popcountll(eq & lm);
    sel[i] = (u[i] > prefix) || (u[i] == prefix && before < need); const int ne = __builtin_popcountll(eq); need = need > ne ? need - ne : 0; }
}
template <int NG, int NV, int K> __device__ __forceinline__ void wave_topk_multi(const unsigned (&u)[NG][NV], bool (&sel)[NG][NV], int lane) {
  unsigned prefix[NG]; int cge[NG];
#pragma unroll
  for (int g = 0; g < NG; ++g) { prefix[g] = 0u; cge[g] = NV * 64; }
#pragma unroll 1
  for (int bit = 31; bit >= 0; --bit) {
    bool done = true;
#pragma unroll
    for (int g = 0; g < NG; ++g) done = done && (cge[g] == K);
    if (done) break;
#pragma unroll
    for (int g = 0; g < NG; ++g) { const unsigned cand = prefix[g] | (1u << bit); int c = 0;
#pragma unroll
      for (int i = 0; i < NV; ++i) c += __builtin_popcountll(__ballot(u[g][i] >= cand));
      if (cge[g] != K && c >= K) { prefix[g] = cand; cge[g] = c; } }
  }
  const unsigned long long lm = (1ull << lane) - 1ull;
#pragma unroll
  for (int g = 0; g < NG; ++g) { int cgt = 0;
#pragma unroll
    for (int i = 0; i < NV; ++i) cgt += __builtin_popcountll(__ballot(u[g][i] > prefix[g]));
    int need = K - cgt;
#pragma unroll
    for (int i = 0; i < NV; ++i) { const unsigned long long eq = __ballot(u[g][i] == prefix[g]); const int before = __builtin_popcountll(eq & lm);
      sel[g][i] = (u[g][i] > prefix[g]) || (u[g][i] == prefix[g] && before < need); const int ne = __builtin_popcountll(eq); need = need > ne ? need - ne : 0; } }
}
__device__ __forceinline__ float gelu_erf(float v) {
  const float av = fabsf(v), t = __builtin_amdgcn_rcpf(1.0f + 0.2316418882f * av);
  float q = t * 0.5307027145f - 0.7265760135f; q = q * t + 0.7107068705f; q = q * t - 0.142248368f; q = q * t + 0.127414796f; q = q * t;
  const float tail = q * __builtin_amdgcn_exp2f(v * v * -0.72134752044f);
  return v < 0.f ? v * tail : v - v * tail;
}

#ifndef ROUTE_REPS
#define ROUTE_REPS 1
#endif
__device__ __forceinline__ void ins16(float (&t)[16], float x) {
#pragma unroll
  for (int i = 15; i >= 1; --i) t[i] = __builtin_amdgcn_fmed3f(t[i - 1], t[i], x);
  t[0] = fmaxf(t[0], x);
}
__device__ __forceinline__ void p6_peer(const Frame& F, const Args& a, float* dst_base) {
  const float* S2 = (const float*)(F.ws + WS_S); const float* SSQ = (const float*)(F.ws + WS_SSQ); const bf16* H1b = (const bf16*)(F.ws + WS_H1B);
  int lane = F.lane, wv = F.wave, tid = F.tid; asm volatile("" : "+v"(lane), "+s"(wv), "+v"(tid));
  int* EIDg = (int*)(F.ws + WS_EID); float* EGTg = (float*)(F.ws + WS_EGT);
  LAS int* eid = (LAS int*)(F.lds + wv * 5120); LAS float* cg = (LAS float*)(eid + 512); LAS float* esu = (LAS float*)(eid + 1024); LAS float* dq = (LAS float*)(eid + 1152);
  LAS unsigned char* RB = F.lds + 40960 + wv * 8192;
  LAS float* L1 = (LAS float*)(F.lds + 40960);
  TP_BEGIN(11);
#ifdef TPROBE
  const unsigned long long tp_p7_ = __builtin_amdgcn_s_memrealtime();
#endif
  for (int tb = blockIdx.x; tb < MROWS / 32; tb += gridDim.x) {
    __syncthreads();
    {
      const int g = tid >> 5, tl = tid & 31; const float* src = S2 + ((size_t)(tb * 16 + g) * 128) * 32 + tl;
      float t[16];
#pragma unroll
      for (int i = 0; i < 16; ++i) t[i] = -INFINITY;
      float sv[128];
#pragma unroll
      for (int k = 0; k < 128; ++k) sv[k] = src[k * 32];
#pragma unroll
      for (int k = 0; k < 128; ++k) ins16(t, __builtin_bit_cast(float, (__builtin_bit_cast(unsigned, sv[k]) & ~0x7Fu) | (unsigned)(127 - k)));
#pragma unroll
      for (int i = 0; i < 16; ++i) L1[(g * 16 + i) * 32 + tl] = t[i];
    }
    __syncthreads();
    if (tid < 256) {
      const int h8 = tid >> 5, tl = tid & 31; const LAS float* LA = L1 + ((2 * h8) * 16) * 32 + tl; const LAS float* LB = L1 + ((2 * h8 + 1) * 16) * 32 + tl;
      float A[16], B[16], t[16];
#pragma unroll
      for (int i = 0; i < 16; ++i) { A[i] = LA[i * 32]; B[i] = LB[i * 32]; t[i] = -INFINITY; }
#pragma unroll
      for (int i = 0; i < 16; ++i)
#pragma unroll
        for (int j = 0; j < 16; ++j) if ((i + 1) * (j + 1) <= 16) { const float c = A[i] + B[j];
            ins16(t, __builtin_bit_cast(float, (__builtin_bit_cast(unsigned, c) & ~0xFFu) | (unsigned)(255 - (i * 16 + j)))); }
      float ev[16], es = 0.f;
#pragma unroll
      for (int r = 0; r < 16; ++r) { ev[r] = __expf(t[r] - t[0]); es += ev[r]; }
      const float inv = 1.0f / es;
#pragma unroll
      for (int r = 0; r < 16; ++r) { const unsigned flat = 255u - (__builtin_bit_cast(unsigned, t[r]) & 0xFFu), ii = flat >> 4, jj = flat & 15u;
        const unsigned ka = 127u - (__builtin_bit_cast(unsigned, LA[ii * 32]) & 0x7Fu), kb = 127u - (__builtin_bit_cast(unsigned, LB[jj * 32]) & 0x7Fu);
        EIDg[(size_t)(tb * 32 + tl) * 128 + h8 * 16 + r] = (int)(ka * 128u + kb); EGTg[(size_t)(tb * 32 + tl) * 128 + h8 * 16 + r] = ev[r] * inv; }
    }
    asm volatile("s_waitcnt vmcnt(0)" ::: "memory"); __syncthreads();
    TP_END(11, F.ws);
    const unsigned char* U8 = F.ws + WS_UB; const unsigned char* V8 = F.ws + WS_VB8;
    constexpr int NBT = 2;
#define PG_ISSUE(TAB, E) do { const int idq_ = __builtin_amdgcn_readfirstlane(eidt[(E)]); \
      __builtin_amdgcn_global_load_lds((const unsigned*)((TAB) + (size_t)idq_ * 1024 + lane * 16), (LAS unsigned*)(RB + ((E) & 7) * 1024), 16, 0, 0); } while (0)
#pragma unroll 1
    for (int tt = 0; tt < 4; ++tt) {
      const int tok = tb * 32 + wv * 4 + tt;
      LAS int* eidt = eid + tt * 128; LAS float* cgt = cg + tt * 128;
      const float rs = rsqrtf(wave_sum_dpp(lane < 32 ? SSQ[(size_t)tok * 32 + lane] : 0.f) * (1.0f / DM) + EPS);
      { const float* SCL = (const float*)(F.ws + WS_SCL);
#pragma unroll
        for (int i = 0; i < 2; ++i) { const int e = lane + 64 * i, idq = __builtin_nontemporal_load(EIDg + (size_t)tok * 128 + e);
          eidt[e] = idq; esu[e] = SCL[idq]; cgt[e] = __builtin_nontemporal_load(EGTg + (size_t)tok * 128 + e) * SCL[16384 + idq]; } }
      unsigned xw[16];
      { const bf16* xp = H1b + (size_t)tok * DM + (size_t)lane * 4;
#pragma unroll
        for (int q = 0; q < 8; ++q) { const v2u x0 = *(const v2u*)(xp + q * 256); xw[2 * q] = x0.x; xw[2 * q + 1] = x0.y; } }
      int xl[4], xh[4]; float rsx;
      { float xa = 0.f;
#pragma unroll
        for (int i = 0; i < 16; ++i) xa = fmaxf(xa, fmaxf(fabsf(bflo(xw[i])), fabsf(bfhi(xw[i]))));
#pragma unroll
        for (int o = 1; o < 64; o <<= 1) xa = fmaxf(xa, __shfl_xor(xa, o));
        const float xinv = xa > 0.f ? 119.0f / xa : 0.f; rsx = rs * (xa > 0.f ? xa * (1.0f / 119.0f) : 0.f);
#pragma unroll
        for (int d = 0; d < 4; ++d) { unsigned pl = 0u, ph = 0u;
#pragma unroll
          for (int p = 0; p < 8; ++p) { const int i = 8 * d + p; const float v = (i & 1) ? bfhi(xw[i >> 1]) : bflo(xw[i >> 1]);
            const int xi = (int)__builtin_rintf(v * xinv), l = ((xi + 8) & 15) - 8, h = (xi - l) >> 4;
            pl |= ((unsigned)l & 15u) << (4 * p); ph |= ((unsigned)h & 15u) << (4 * p); }
          xl[d] = (int)pl; xh[d] = (int)ph; } }
      asm volatile("s_waitcnt vmcnt(0) lgkmcnt(0)" ::: "memory");
#define DPPI(X, CTRL) __builtin_amdgcn_update_dpp(0, (X), (CTRL), 0xF, 0xF, true)
#define PU_BATCH(E0, DOISSUE) do { v4u ub[4]; \
        _Pragma("unroll") for (int q = 0; q < 4; ++q) ub[q] = *(const LAS v4u*)(RB + (((E0) + q) & 7) * 1024 + lane * 16); \
        asm volatile("s_waitcnt lgkmcnt(0)" ::: "memory"); \
        if (DOISSUE) { _Pragma("unroll") for (int q = 0; q < 4; ++q) PG_ISSUE(U8, (E0) + 8 + q); } \
        int a_[4]; _Pragma("unroll") for (int q = 0; q < 4; ++q) { int al_ = 0, ah_ = 0; _Pragma("unroll") for (int dd = 0; dd < 4; ++dd) { const int wa = (int)ub[q][dd]; \
            al_ = __builtin_amdgcn_sdot8(wa, xl[dd], al_, false); ah_ = __builtin_amdgcn_sdot8(wa, xh[dd], ah_, false); } a_[q] = ah_ * 16 + al_; } \
        const int r01_ = (o1 ? a_[1] : a_[0]) + DPPI(o1 ? a_[0] : a_[1], 0xB1), r23_ = (o1 ? a_[3] : a_[2]) + DPPI(o1 ? a_[2] : a_[3], 0xB1); \
        int r_ = (o2 ? r23_ : r01_) + DPPI(o2 ? r01_ : r23_, 0x4E); \
        r_ += DPPI(r_, 0x124); r_ += DPPI(r_, 0x128); \
        { auto s_ = __builtin_amdgcn_permlane16_swap((unsigned)r_, (unsigned)r_, false, false); const unsigned s0_ = s_[0], s1_ = s_[1]; r_ = (int)(s0_ + s1_); } \
        { auto s_ = __builtin_amdgcn_permlane32_swap((unsigned)r_, (unsigned)r_, false, false); const unsigned s0_ = s_[0], s1_ = s_[1]; r_ = (int)(s0_ + s1_); } \
        if (lane < 4) dqi[(E0) + lane] = r_; } while (0)
      const bool o1 = (lane & 1) != 0, o2 = (lane & 2) != 0; LAS int* dqi = (LAS int*)dq;
#pragma unroll
      for (int e = 0; e < 8; ++e) PG_ISSUE(U8, e);
#pragma unroll 1
      for (int e = 0; e < 120; e += 4) {
        asm volatile("s_waitcnt vmcnt(4)" ::: "memory");
        PU_BATCH(e, true);
        asm volatile("" ::: "memory");
      }
      asm volatile("s_waitcnt vmcnt(0)" ::: "memory");
#pragma unroll 1
      for (int e = 120; e < 128; e += 4) PU_BATCH(e, false);
      asm volatile("s_waitcnt lgkmcnt(0)" ::: "memory");
#pragma unroll
      for (int i = 0; i < 2; ++i) { const int e = lane + 64 * i; cgt[e] = gelu_erf((float)dqi[e] * (rsx * esu[e])) * cgt[e]; }
      asm volatile("s_waitcnt lgkmcnt(0)" ::: "memory");
#undef DPPI
#undef PU_BATCH
    }
#pragma unroll 1
    for (int tt = 0; tt < 4; ++tt) {
      const int tok = tb * 32 + wv * 4 + tt;
      LAS int* eidt = eid + tt * 128; LAS float* cgt = cg + tt * 128;
      float y[32];
#pragma unroll
      for (int i = 0; i < 32; ++i) y[i] = 0.f;
#define PV_BATCH(E0, DOISSUE) do { v4u vb[NBT]; float c_[NBT]; \
        _Pragma("unroll") for (int q = 0; q < NBT; ++q) { vb[q] = *(const LAS v4u*)(RB + (((E0) + q) & 7) * 1024 + lane * 16); c_[q] = cgt[(E0) + q]; } \
        asm volatile("s_waitcnt lgkmcnt(0)" ::: "memory"); \
        if (DOISSUE) { _Pragma("unroll") for (int q = 0; q < NBT; ++q) PG_ISSUE(V8, (E0) + 8 + q); } \
        _Pragma("unroll") for (int q = 0; q < NBT; ++q) { _Pragma("unroll") for (int dd = 0; dd < 4; ++dd) { const unsigned wa = vb[q][dd]; \
            { const f32x2v v2 = __builtin_amdgcn_cvt_scalef32_pk_f32_fp4(wa, 1.0f, 0); y[8 * dd + 0] += c_[q] * v2.x; y[8 * dd + 1] += c_[q] * v2.y; } \
            { const f32x2v v2 = __builtin_amdgcn_cvt_scalef32_pk_f32_fp4(wa, 1.0f, 1); y[8 * dd + 2] += c_[q] * v2.x; y[8 * dd + 3] += c_[q] * v2.y; } \
            { const f32x2v v2 = __builtin_amdgcn_cvt_scalef32_pk_f32_fp4(wa, 1.0f, 2); y[8 * dd + 4] += c_[q] * v2.x; y[8 * dd + 5] += c_[q] * v2.y; } \
            { const f32x2v v2 = __builtin_amdgcn_cvt_scalef32_pk_f32_fp4(wa, 1.0f, 3); y[8 * dd + 6] += c_[q] * v2.x; y[8 * dd + 7] += c_[q] * v2.y; } } \
          __builtin_amdgcn_sched_barrier(0); } } while (0)
#pragma unroll
      for (int e = 0; e < 8; ++e) PG_ISSUE(V8, e);
#pragma unroll 1
      for (int e = 0; e < 120; e += NBT) {
        asm volatile("s_waitcnt vmcnt(6)" ::: "memory");
        PV_BATCH(e, true);
        asm volatile("" ::: "memory");
      }
      asm volatile("s_waitcnt vmcnt(0)" ::: "memory");
      unsigned xw[16];
      { const bf16* xp = H1b + (size_t)tok * DM + (size_t)lane * 4;
#pragma unroll
        for (int q = 0; q < 8; ++q) { const v2u x0 = *(const v2u*)(xp + q * 256); xw[2 * q] = x0.x; xw[2 * q + 1] = x0.y; } }
#pragma unroll 1
      for (int e = 120; e < 128; e += NBT) PV_BATCH(e, false);
      asm volatile("s_waitcnt lgkmcnt(0)" ::: "memory");
#undef PV_BATCH
      float* drow = dst_base + (size_t)tok * DM;
#pragma unroll
      for (int q = 0; q < 8; ++q) { const size_t off = (size_t)q * 256 + lane * 4; f32x4 hv;
        hv.x = bflo(xw[2 * q]) + y[4 * q];
#ifdef TPROBE
        if (TPROBE != 13 && tok == 0 && lane == 0 && q == 0) hv.x += 10.0f + (float)(*(volatile unsigned*)(F.ws + 64)) * (0.01f / TP_DIV);
        if (TPROBE == 13 && (int)blockIdx.x == TP_BLOCK && wv == 7 && tt == 3 && lane == 0 && q == 0) hv.x += 10.0f + (float)(unsigned)(__builtin_amdgcn_s_memrealtime() - tp_p7_) * (0.01f / TP_DIV);
#endif
        hv.y = bfhi(xw[2 * q]) + y[4 * q + 1]; hv.z = bflo(xw[2 * q + 1]) + y[4 * q + 2]; hv.w = bfhi(xw[2 * q + 1]) + y[4 * q + 3]; __builtin_nontemporal_store(hv, (f32x4*)(drow + off)); }
    }
#undef PG_ISSUE
  }
}
constexpr int MISC_LDS = LDS_BYTES - 256;
__global__ void __launch_bounds__(NTHR, 2) mk_fwd(Args args) {
  extern __shared__ __attribute__((aligned(16))) unsigned char lds_raw[];
  Frame F; F.lds = (LAS unsigned char*)lds_raw; F.ws = args.ws; F.tid = threadIdx.x; F.lane = F.tid & 63; F.wave = __builtin_amdgcn_readfirstlane(F.tid >> 6);
  const int lo = args.ph_lo, hi = args.ph_hi, G = (int)gridDim.x, bx = (int)blockIdx.x;
  volatile LAS unsigned* misc = (volatile LAS unsigned*)(F.lds + MISC_LDS);
  if (F.tid < 16) misc[F.tid] = 0u;
  __syncthreads();
  XcdBarrier bar = xcd_barrier_post((unsigned*)(F.ws + WS_CTL) + CW_BAR, misc);
#define IN(k) (lo <= (k) && (k) < hi)
#ifdef TPROBE
#define SEAM(k) do { if (IN(k) && IN((k) + 1)) { const unsigned long long tq0_ = __builtin_amdgcn_s_memrealtime(); xcd_barrier(bar); const unsigned long long tq1_ = __builtin_amdgcn_s_memrealtime(); \
    if (TPROBE == 20 + (k) && (int)blockIdx.x == TP_BLOCK && threadIdx.x == 0) atomicAdd((unsigned*)(F.ws + 64), (unsigned)(tq1_ - tq0_)); } } while (0)
#else
#define SEAM(k) do { if (IN(k) && IN((k) + 1)) xcd_barrier(bar); } while (0)
#endif
#define PHASE_FRAME(Fp) Frame Fp = F; asm volatile("" : "+v"(Fp.tid), "+v"(Fp.lane))
  const int NA = G;
  if (IN(0)) { PHASE_FRAME(F0); TP_BEGIN(1);
#ifdef SLEEP_START
#pragma unroll 1
    for (int i_ = 0; i_ < SLEEP_START; ++i_) __builtin_amdgcn_s_sleep(127);
#endif
    p0_lam(F0, args);
    p0_zero_vpad(F0);
    TP_BEGIN(41); p0_rows(F0, args); TP_END(41, F.ws);
    TP_BEGIN(42); p0_transpose<true>(F0, args, args.in[IN_WIN], DPROJ, NPROJ, (bf16*)(F.ws + WS_W1T));
    p0_transpose<false>(F0, args, args.in[IN_WOUT], DM, DM, (bf16*)(F.ws + WS_W2T)); TP_END(42, F.ws);
    TP_BEGIN(43); p0_w3t(F0, args); TP_END(43, F.ws);
    TP_BEGIN(44); p0_tables(F0, args); TP_END(44, F.ws);
#ifdef DUP_ROWS
    p0_rows(F0, args);
#endif
#ifdef DUP_TR
    p0_transpose<true>(F0, args, args.in[IN_WIN], DPROJ, NPROJ, (bf16*)(F.ws + WS_W1T));
    p0_transpose<false>(F0, args, args.in[IN_WOUT], DM, DM, (bf16*)(F.ws + WS_W2T));
#endif
#ifdef DUP_W3T
    p0_w3t(F0, args);
#endif
#ifdef DUP_TAB
    p0_tables(F0, args);
#endif
    TP_END(1, F.ws);
  }
  SEAM(0);
  if (IN(1)) { PHASE_FRAME(F1); TP_BEGIN(2);
    p1_meta_finalize(F1, args);
    pg8::Gemm g{(const pg8::bf16_t*)(F.ws + WS_XN), (const pg8::bf16_t*)(F.ws + WS_W1T), MROWS, NPROJ, DM};
    pg8::StaticOrder S; S.init(MROWS, NPROJ, G, bx);
    EpiProj E{(bf16*)(F.ws + WS_Q), (bf16*)(F.ws + WS_KP), (bf16*)(F.ws + WS_VP), (bf16*)(F.ws + WS_MQ), (bf16*)(F.ws + WS_MK), (bf16*)(F.ws + WS_MV), (bf16*)(F.ws + WS_MO),
              args.in[IN_QNG], args.in[IN_KNG], (LAS float*)(F.lds + XCH_OFF)};
    pg8::gemm_phase<EpiProj, pg8::StaticOrder, true, true>(F.lds + RING_OFF, g, S, E);
    TP_END(2, F.ws);
  }
  SEAM(1);
  if (IN(2)) {
    PHASE_FRAME(F2);
    TP_BEGIN(3);
    att::phase(F2, (G % 8 == 0) ? (bx & 7) * (G >> 3) + (bx >> 3) : bx, NA);
    TP_END(3, F.ws); TP_BEGIN(4);
    for (int task = bx; task < 512; task += G) ml::taskA(F2, args, task);
    TP_END(4, F.ws);
  }
  SEAM(2);
  if (IN(3)) { PHASE_FRAME(F3); TP_BEGIN(5); ml::scanB(F3); TP_END(5, F.ws); TP_BEGIN(6); p3_combine(F3, args, NA); TP_END(6, F.ws);
#ifdef DUP_SCAN
    ml::scanB(F3);
#endif
#ifdef DUP_COMB
    p3_combine(F3, args, NA);
#endif
  }
  SEAM(3);
#ifdef EXTRA_BARS
  for (int i_ = 0; i_ < EXTRA_BARS; ++i_) xcd_barrier(bar);
#endif
  if (IN(4)) {
    PHASE_FRAME(F4);
    TP_BEGIN(7);
    for (int task = bx; task < 512; task += G) ml::taskC(F4, args, task);
    TP_END(7, F.ws);
  }
  SEAM(4);
  if (IN(5)) { TP_BEGIN(8);
    pg8::Gemm g{(const pg8::bf16_t*)(F.ws + WS_A2), (const pg8::bf16_t*)(F.ws + WS_W2T), MROWS, DM, DM};
    pg8::StaticOrder S; S.init(MROWS, DM, G, bx);
    EpiRes E{args.in[IN_X], args.out, (bf16*)(F.ws + WS_H1B), (float*)(F.ws + WS_SSQ)};
    pg8::gemm_phase<EpiRes, pg8::StaticOrder, true, true>(F.lds + RING_OFF, g, S, E);
    TP_END(8, F.ws);
  }
  SEAM(5);
  if (IN(6)) { TP_BEGIN(9);
    pg8::Gemm g{(const pg8::bf16_t*)(F.ws + WS_H1B), (const pg8::bf16_t*)(F.ws + WS_W3T), MROWS, DM, DM};
    pg8::StaticOrder S; S.init(MROWS, DM, G, bx);
    LAS float* rst = (LAS float*)(F.lds + XCH_OFF);
    { pg8::Unit u0; if (S.next(0, u0)) { if (F.tid < 256) { const float* sp = (const float*)(F.ws + WS_SSQ) + ((size_t)u0.pm * 256 + F.tid) * 32; float s = 0.f;
#pragma unroll
          for (int i = 0; i < 8; ++i) { const f32x4 v = ((const f32x4*)sp)[i]; s += (v.x + v.y) + (v.z + v.w); }
          rst[F.tid] = rsqrtf(s * (1.0f / DM) + EPS); } } }
    __syncthreads();
    EpiScore E{(float*)(F.ws + WS_S), rst};
    pg8::gemm_phase<EpiScore, pg8::StaticOrder, true, true>(F.lds + RING_OFF, g, S, E);
    TP_END(9, F.ws);
  }
  SEAM(6);
  if (IN(7)) { PHASE_FRAME(F7); TP_BEGIN(10); p6_peer(F7, args, args.out); TP_END(10, F.ws); }
#undef IN
#undef SEAM
}
extern "C" void kernel_launch(void* const* d_in, const int* in_sizes, int n_in, void* d_out, int out_size, void* d_ws, size_t ws_size, hipStream_t stream) {
  static int grid = 0;
  if (grid == 0) {
    int dev = 0, cus = 0, per_cu = 0;
    if (hipGetDevice(&dev) != hipSuccess || hipDeviceGetAttribute(&cus, hipDeviceAttributeMultiprocessorCount, dev) != hipSuccess) { fprintf(stderr, "device query failed\n"); grid = -1; return; }
    if (hipFuncSetAttribute((const void*)mk_fwd, hipFuncAttributeMaxDynamicSharedMemorySize, LDS_BYTES) != hipSuccess) { fprintf(stderr, "hipFuncSetAttribute failed\n"); grid = -1; return; }
    if (hipOccupancyMaxActiveBlocksPerMultiprocessor(&per_cu, (const void*)mk_fwd, NTHR, LDS_BYTES) != hipSuccess || per_cu < 1) { fprintf(stderr, "occupancy query says %d workgroups per CU: not launching\n", per_cu); (void)hipGetLastError(); grid = -1; return; }
    (void)hipGetLastError();
    grid = cus;
    if (n_in != 22 || ws_size < (size_t)512 * MiB || out_size != MROWS * DM) { fprintf(stderr, "unexpected shapes: n_in %d out %d ws %zu\n", n_in, out_size, ws_size); grid = -1; return; }
  }
  if (grid < 0) return;
  unsigned char* ws = (unsigned char*)d_ws;
  if (hipMemsetAsync(ws + WS_CTL, 0, CTL_ZERO_BYTES, stream) != hipSuccess) { fprintf(stderr, "memset failed\n"); return; }
  Args a{};
  for (int i = 0; i < 22; ++i) a.in[i] = (const float*)d_in[i];
  a.out = (float*)d_out; a.ws = ws; a.na = 0; a.pad = 0;
  a.ph_lo = 0; a.ph_hi = 8;
  hipLaunchKernelGGL(mk_fwd, dim3(grid), dim3(NTHR), LDS_BYTES, stream, a);
}
```

```cpp
#include <hip/hip_runtime.h>
#include <cstdio>
#include <cstdint>
#include <math.h>
namespace pg8 {
#define PG8_LAS __attribute__((address_space(3)))
typedef unsigned short bf16_t;
typedef short bf16x8 __attribute__((ext_vector_type(8)));
typedef float f32x4 __attribute__((ext_vector_type(4)));
typedef unsigned u32x4 __attribute__((ext_vector_type(4)));
constexpr int BM = 256, BK = 64, HALF = 128, HTB = HALF * BK * 2  , STAGE_BYTES = 8 * HTB, NXCD = 8, WGM = 8;

__host__ __device__ __forceinline__ int lds_byte(int r, int c) { const int st = (r >> 4) * 2 + (c >> 5), rr = r & 15, cc = c & 31, ob = rr * 64 + cc * 2; return st * 1024 + (ob ^ (((ob >> 9) & 1) << 5)); }
__host__ __device__ __forceinline__ void stage_rc(int b, int& R, int& C) { const int st = b / 1024, sb = b % 1024, swz = sb ^ (((sb >> 9) & 1) << 5); R = (st >> 1) * 16 + swz / 64; C = (st & 1) * 32 + (swz % 64) / 2; }
__host__ __device__ __forceinline__ int perm32(int rho) { const int n = rho >> 4, i = rho & 15; return 8 * (i >> 2) + 4 * n + (i & 3); }

struct Unit { int pm, pn; };
struct Gemm { const bf16_t* A; const bf16_t* Bt; int M, N, K; };

struct StaticOrder {
    int nM, nN, nwg, G, c;
    __host__ __device__ void init(int M, int N, int G_, int c_) { nM = M / BM; nN = N / BM; nwg = nM * nN; G = G_; c = c_; }
    __host__ __device__ bool next(int i, Unit& u) const {
        const long L = (long)i * G + c; if (L >= nwg) return false;
        int wgid = (int)L; { const int q = nwg / NXCD, r = nwg % NXCD, xcd = wgid % NXCD, off = wgid / NXCD; wgid = (xcd < r ? xcd * (q + 1) : r * (q + 1) + (xcd - r) * q) + off; }
        const int nig = WGM * nN, gid = wgid / nig, fm = gid * WGM, gsz = (nM - fm) < WGM ? (nM - fm) : WGM;
        u.pm = fm + ((wgid % nig) % gsz); u.pn = (wgid % nig) / gsz; return true;
    }
    __device__ __forceinline__ void a_ready(const Unit&) const {}
    __device__ __forceinline__ void done(const Unit&) const {}
};

__device__ __forceinline__ unsigned cvt_pk_bf16(float lo, float hi) { unsigned r; asm volatile("v_cvt_pk_bf16_f32 %0, %1, %2" : "=v"(r) : "v"(lo), "v"(hi)); return r; }
typedef float f32x2 __attribute__((ext_vector_type(2)));
template <class Epi, class Sched, bool ALIGN_EPI = false, bool SP2 = false>
__device__ __forceinline__ void gemm_phase(PG8_LAS unsigned char* lds, const Gemm g, const Sched& S, const Epi& E) {
    int tid_ = threadIdx.x; asm volatile("" : "+v"(tid_));
    const int tid = tid_, wid = __builtin_amdgcn_readfirstlane(tid >> 6), lane = tid & 63, wr = wid >> 2, wc = wid & 3, fr = lane & 15, fq = lane >> 4;
    const int K = g.K, nt = K / BK;
    unsigned voffA[2], voffB[2];
#pragma unroll
    for (int i = 0; i < 2; ++i) { int R, C; stage_rc(tid * 16 + i * 8192, R, C); const int Rb = Epi::PERM ? ((R & ~31) + perm32(R & 31)) : R;
        voffA[i] = (unsigned)(R * K + C) * 2u; voffB[i] = (unsigned)(Rb * K + C) * 2u; }
    const size_t kstep = (size_t)(BK * 2);
    const size_t hstep = (size_t)HALF * K * 2;
    const size_t tstep = 2 * hstep;
    const unsigned ldsw = (unsigned)wid * 1024u;
    const int aoff = lds_byte(wr * 64 + fr, fq * 8), boff = lds_byte(wc * 32 + fr, fq * 8);
#define PG8_SA(b, h) (((b) * 2 + (h)) * HTB)
#define PG8_SB(b, h) ((4 + (b) * 2 + (h)) * HTB)
#define PG8_STAGE(bufoff, gbase, voff) do { _Pragma("unroll") for (int _i = 0; _i < 2; ++_i) \
        __builtin_amdgcn_global_load_lds((const unsigned*)((const char*)(gbase) + (voff)[_i]), (PG8_LAS unsigned*)(lds + (bufoff) + ldsw + _i * 8192), 16, 0, 0); } while (0)
#define PG8_LDA(dst, b, h) do { _Pragma("unroll") for (int m = 0; m < 4; ++m) _Pragma("unroll") for (int k = 0; k < 2; ++k) dst[m][k] = *(const PG8_LAS bf16x8*)(lds + PG8_SA(b, h) + aoff + m * 2048 + k * 1024); } while (0)
#define PG8_LDB(dst, b, h) do { _Pragma("unroll") for (int n = 0; n < 2; ++n) _Pragma("unroll") for (int k = 0; k < 2; ++k) dst[n][k] = *(const PG8_LAS bf16x8*)(lds + PG8_SB(b, h) + boff + n * 2048 + k * 1024); } while (0)
#define PG8_MMA(ai, bj, At, Bt) do { __builtin_amdgcn_s_setprio(1); _Pragma("unroll") for (int m = 0; m < 4; ++m) _Pragma("unroll") for (int n = 0; n < 2; ++n) _Pragma("unroll") for (int k = 0; k < 2; ++k) \
        acc[ai][bj][m][n] = __builtin_amdgcn_mfma_f32_16x16x32_bf16(Bt[n][k], At[m][k], acc[ai][bj][m][n], 0, 0, 0); __builtin_amdgcn_s_setprio(0); } while (0)
#define PG8_WAIT_V(n) asm volatile("s_waitcnt vmcnt(" #n ")" ::: "memory")
#define PG8_WAIT_L(n) asm volatile("s_waitcnt lgkmcnt(" #n ")" ::: "memory")
#define PG8_BAR __builtin_amdgcn_s_barrier()
#define PG8_SCHED __builtin_amdgcn_sched_barrier(0)
    Unit cur, nxt; int ui = 0;
    if (!S.next(0, cur)) return;
    f32x4 acc[2][2][4][2];
#pragma unroll
    for (int a = 0; a < 2; ++a)
#pragma unroll
        for (int b = 0; b < 2; ++b)
#pragma unroll
            for (int m = 0; m < 4; ++m)
#pragma unroll
                for (int n = 0; n < 2; ++n) acc[a][b][m][n] = (f32x4){0.f, 0.f, 0.f, 0.f};
    bf16x8 At[4][2], B0[2][2], B1[2][2];
    const char* cA = (const char*)g.A + (size_t)cur.pm * tstep; const char* cB = (const char*)g.Bt + (size_t)cur.pn * tstep;
    S.a_ready(cur);
    if constexpr (SP2) {
        PG8_STAGE(PG8_SB(0, 0), cB, voffB); PG8_STAGE(PG8_SB(0, 1), cB + hstep, voffB); PG8_STAGE(PG8_SA(0, 0), cA, voffA); PG8_STAGE(PG8_SA(0, 1), cA + hstep, voffA);
        if (wr == 1) PG8_BAR;
        PG8_WAIT_V(2); PG8_BAR;
        PG8_STAGE(PG8_SB(1, 0), cB + kstep, voffB); PG8_STAGE(PG8_SA(1, 0), cA + kstep, voffA); PG8_STAGE(PG8_SB(1, 1), cB + hstep + kstep, voffB);
        PG8_WAIT_V(6); PG8_BAR;
    } else {
        PG8_STAGE(PG8_SB(0, 0), cB, voffB); PG8_STAGE(PG8_SA(0, 0), cA, voffA); PG8_STAGE(PG8_SB(0, 1), cB + hstep, voffB); PG8_STAGE(PG8_SA(0, 1), cA + hstep, voffA);
        if (wr == 1) PG8_BAR;
        PG8_WAIT_V(4); PG8_BAR;
        PG8_STAGE(PG8_SB(1, 0), cB + kstep, voffB); PG8_STAGE(PG8_SA(1, 0), cA + kstep, voffA); PG8_STAGE(PG8_SB(1, 1), cB + hstep + kstep, voffB);
        PG8_WAIT_V(6); PG8_BAR;
    }
    for (;;) {
        const bool has_next = S.next(ui + 1, nxt);
        const char* nA = has_next ? (const char*)g.A + (size_t)nxt.pm * tstep : cA; const char* nB = has_next ? (const char*)g.Bt + (size_t)nxt.pn * tstep : cB;
        for (int t = 0; t < nt; t += 2) {
            const bool last = (t == nt - 2);
            const char* a1 = cA + (size_t)(t + 1) * kstep;
            const char* a2 = last ? nA : cA + (size_t)(t + 2) * kstep; const char* b2 = last ? nB : cB + (size_t)(t + 2) * kstep;
            const char* a3 = a2 + kstep; const char* b3 = b2 + kstep;
            if (last && has_next) S.a_ready(nxt);
            if constexpr (SP2) {
            PG8_LDB(B0, 0, 0); PG8_LDB(B1, 0, 1); PG8_SCHED; PG8_LDA(At, 0, 0); PG8_STAGE(PG8_SA(1, 1), a1 + hstep, voffA);
            PG8_WAIT_V(8); PG8_WAIT_L(0); PG8_BAR; PG8_MMA(0, 0, At, B0); PG8_MMA(0, 1, At, B1); PG8_BAR; PG8_SCHED;
            PG8_LDA(At, 0, 1); PG8_STAGE(PG8_SB(0, 0), b2, voffB); PG8_STAGE(PG8_SB(0, 1), b2 + hstep, voffB); PG8_STAGE(PG8_SA(0, 0), a2, voffA);
            PG8_WAIT_V(8); PG8_WAIT_L(0); PG8_BAR; PG8_MMA(1, 0, At, B0); PG8_MMA(1, 1, At, B1); PG8_BAR; PG8_SCHED;
            PG8_LDB(B0, 1, 0); PG8_LDB(B1, 1, 1); PG8_SCHED; PG8_LDA(At, 1, 0); PG8_STAGE(PG8_SA(0, 1), a2 + hstep, voffA);
            PG8_WAIT_V(8); PG8_WAIT_L(0); PG8_BAR; PG8_MMA(0, 0, At, B0); PG8_MMA(0, 1, At, B1); PG8_BAR; PG8_SCHED;
            PG8_LDA(At, 1, 1); PG8_STAGE(PG8_SB(1, 0), b3, voffB); PG8_STAGE(PG8_SB(1, 1), b3 + hstep, voffB); PG8_STAGE(PG8_SA(1, 0), a3, voffA);
            PG8_WAIT_V(8); PG8_WAIT_L(0); PG8_BAR; PG8_MMA(1, 0, At, B0); PG8_MMA(1, 1, At, B1); PG8_BAR; PG8_SCHED;
            } else {
            PG8_LDB(B0, 0, 0); PG8_SCHED; PG8_LDA(At, 0, 0); PG8_STAGE(PG8_SA(1, 1), a1 + hstep, voffA);
            PG8_WAIT_L(8); PG8_BAR; PG8_WAIT_L(0); PG8_MMA(0, 0, At, B0); PG8_BAR; PG8_SCHED;
            PG8_LDB(B1, 0, 1); PG8_STAGE(PG8_SB(0, 0), b2, voffB);
            PG8_BAR; PG8_WAIT_L(0); PG8_MMA(0, 1, At, B1); PG8_BAR;
            PG8_LDA(At, 0, 1); PG8_STAGE(PG8_SA(0, 0), a2, voffA);
            PG8_BAR; PG8_WAIT_L(0); PG8_MMA(1, 0, At, B0); PG8_BAR; PG8_SCHED;
            PG8_STAGE(PG8_SB(0, 1), b2 + hstep, voffB);
            PG8_WAIT_V(6); PG8_BAR; PG8_MMA(1, 1, At, B1); PG8_BAR;
            PG8_LDB(B0, 1, 0); PG8_SCHED; PG8_LDA(At, 1, 0); PG8_STAGE(PG8_SA(0, 1), a2 + hstep, voffA);
            PG8_WAIT_L(8); PG8_BAR; PG8_WAIT_L(0); PG8_MMA(0, 0, At, B0); PG8_BAR; PG8_SCHED;
            PG8_LDB(B1, 1, 1); PG8_STAGE(PG8_SB(1, 0), b3, voffB);
            PG8_BAR; PG8_WAIT_L(0); PG8_MMA(0, 1, At, B1); PG8_BAR;
            PG8_LDA(At, 1, 1); PG8_STAGE(PG8_SA(1, 0), a3, voffA);
            PG8_BAR; PG8_WAIT_L(0); PG8_MMA(1, 0, At, B0); PG8_BAR; PG8_SCHED;
            PG8_STAGE(PG8_SB(1, 1), b3 + hstep, voffB);
            PG8_WAIT_V(6); PG8_BAR; PG8_MMA(1, 1, At, B1); PG8_BAR;
            }
        }
        if constexpr (ALIGN_EPI) { if (wr == 0) PG8_BAR; }
        if constexpr (!Epi::AFTER_DRAIN) { E(acc, cur, wr, wc, fr, fq); S.done(cur); }
        if (!has_next) break;
#pragma unroll
        for (int a = 0; a < 2; ++a)
#pragma unroll
            for (int b = 0; b < 2; ++b)
#pragma unroll
                for (int m = 0; m < 4; ++m)
#pragma unroll
                    for (int n = 0; n < 2; ++n) acc[a][b][m][n] = (f32x4){0.f, 0.f, 0.f, 0.f};
        cur = nxt; cA = nA; cB = nB; ++ui;
        if constexpr (ALIGN_EPI) { if (wr == 1) PG8_BAR; }
    }
    PG8_WAIT_V(0);
    if constexpr (!ALIGN_EPI) { if (wr == 0) PG8_BAR; }
    PG8_BAR;
    if constexpr (Epi::AFTER_DRAIN) { E.fused(acc, cur, wr, wc, fr, fq, lds, wid, lane); S.done(cur); }
#undef PG8_SA
#undef PG8_SB
#undef PG8_STAGE
#undef PG8_LDA
#undef PG8_LDB
#undef PG8_MMA
#undef PG8_WAIT_V
#undef PG8_WAIT_L
#undef PG8_BAR
#undef PG8_SCHED
}
}
#define GAS __attribute__((address_space(1)))
#define LAS __attribute__((address_space(3)))
typedef unsigned short bf16;
typedef unsigned v4u __attribute__((ext_vector_type(4)));
typedef unsigned v2u __attribute__((ext_vector_type(2)));
typedef float f32x4 __attribute__((ext_vector_type(4)));
typedef short bf16x8 __attribute__((ext_vector_type(8)));
#define LDS_WAIT() asm volatile("s_waitcnt lgkmcnt(0)" ::: "memory")
#define VM_WAIT() asm volatile("s_waitcnt vmcnt(0)" ::: "memory")

constexpr int DM = 2048, NB = 4, SEQ = 2048, NMETA = 16, MROWS = NB * SEQ, DPROJ = 6152, NPROJ = 6144;
constexpr int PADT = 2112, POS0 = 64, MPOS0 = 48;
constexpr float EPS = 1e-6f;
constexpr float LOG2E = 1.4426950408889634f;
constexpr float QSCALE = 0.08838834764831845f * LOG2E;
constexpr int NWAVES = 8, NTHR = 512;

constexpr size_t MiB = 1u << 20;
constexpr size_t WS_CTL = 0, CTL_ZERO_BYTES = 32 * 1024;
constexpr size_t WS_PM = 484 * MiB;
constexpr size_t WS_W1T = 2 * MiB, WS_W2T = 26 * MiB, WS_W3T = 34 * MiB, WS_XN = 42 * MiB;
constexpr size_t WS_Q = 74 * MiB, WS_KP = 90 * MiB, WS_VP = 107 * MiB, WS_MQ = 124 * MiB, WS_MK = 133 * MiB, WS_MV = 142 * MiB, WS_MO = 159 * MiB;
constexpr size_t WS_SMALL = 175 * MiB;
constexpr size_t WS_XM = WS_SMALL, WS_LI = WS_SMALL + 128 * 1024, WS_LF = WS_SMALL + 384 * 1024, WS_LAM = WS_SMALL + 640 * 1024;
constexpr size_t WS_PO = 176 * MiB, WS_ML = 304 * MiB, WS_HM = 305 * MiB, WS_A2 = 42 * MiB, WS_H1B = 74 * MiB, WS_SSQ = 106 * MiB, WS_S = 176 * MiB, WS_UB = 384 * MiB, WS_VB = 448 * MiB;
constexpr size_t WS_SCL = WS_SMALL + 704 * 1024;
constexpr size_t WS_VB8 = WS_UB + 32 * MiB;
constexpr size_t WS_DC = 305 * MiB, WS_CS = 448 * MiB, WS_DN = 482 * MiB, WS_NS = WS_DN + 512 * 1024, WS_GS = WS_DN + 1024 * 1024, WS_MS = WS_DN + 1152 * 1024;
constexpr size_t WS_EID = 240 * MiB, WS_EGT = 244 * MiB;
constexpr int CW_BAR = 4096;

constexpr int RING_OFF = 0, RING_BYTES = 131072;
constexpr int XCH_OFF = 131072;
constexpr int MISC_OFF = XCH_OFF + 8192;
constexpr int LDS_BYTES = 155648;

__device__ __forceinline__ unsigned f2bf(float f) { unsigned u = __builtin_bit_cast(unsigned, f); return (u + 0x7fffu + ((u >> 16) & 1u)) >> 16; }
__device__ __forceinline__ unsigned pk2(float lo, float hi) { return f2bf(lo) | (f2bf(hi) << 16); }
__device__ __forceinline__ float bf2f(unsigned short u) { return __builtin_bit_cast(float, (unsigned)u << 16); }
__device__ __forceinline__ float bflo(unsigned w) { return __builtin_bit_cast(float, w << 16); }
__device__ __forceinline__ float bfhi(unsigned w) { return __builtin_bit_cast(float, w & 0xffff0000u); }
__device__ __forceinline__ float wave_sum(float v) {
#pragma unroll
  for (int o = 1; o < 64; o <<= 1) v += __shfl_xor(v, o);
  return v;
}
__device__ __forceinline__ size_t kp_off(int bhm, int pos, int d) { const int j = pos >> 6, row = pos & 63, d0 = d >> 4, hi = (d >> 3) & 1;
  return ((size_t)(bhm * 33 + j) * 8 + d0) * 1024 + (size_t)((((row << 1) | hi) ^ ((row >> 3) & 1)) << 3) + (d & 7); }
__device__ __forceinline__ float wave_sum_dpp(float v) {
  v += __builtin_bit_cast(float, __builtin_amdgcn_update_dpp(0, __builtin_bit_cast(int, v), 0xB1, 0xF, 0xF, true));
  v += __builtin_bit_cast(float, __builtin_amdgcn_update_dpp(0, __builtin_bit_cast(int, v), 0x4E, 0xF, 0xF, true));
  v += __builtin_bit_cast(float, __builtin_amdgcn_update_dpp(0, __builtin_bit_cast(int, v), 0x141, 0xF, 0xF, true));
  v += __builtin_bit_cast(float, __builtin_amdgcn_update_dpp(0, __builtin_bit_cast(int, v), 0x140, 0xF, 0xF, true));
  const float r0 = __builtin_bit_cast(float, __builtin_amdgcn_readlane(__builtin_bit_cast(int, v), 0)), r1 = __builtin_bit_cast(float, __builtin_amdgcn_readlane(__builtin_bit_cast(int, v), 16));
  const float r2 = __builtin_bit_cast(float, __builtin_amdgcn_readlane(__builtin_bit_cast(int, v), 32)), r3 = __builtin_bit_cast(float, __builtin_amdgcn_readlane(__builtin_bit_cast(int, v), 48));
  return (r0 + r1) + (r2 + r3);
}
__device__ __forceinline__ float sigmoidf_(float x) { return 1.0f / (1.0f + __expf(-x)); }

#ifdef TPROBE
#ifndef TP_BLOCK
#define TP_BLOCK 0
#endif
#ifndef TP_DIV
#define TP_DIV 1.0f
#endif
#define TP_BEGIN(id) unsigned long long tp_t0_##id = 0; do { if (TPROBE == (id)) tp_t0_##id = __builtin_amdgcn_s_memrealtime(); } while (0)
#define TP_END(id, WS) do { if (TPROBE == (id)) { const unsigned long long t1_ = __builtin_amdgcn_s_memrealtime(); if ((int)blockIdx.x == TP_BLOCK && threadIdx.x == 0) atomicAdd((unsigned*)((WS) + 64), (unsigned)(t1_ - tp_t0_##id)); } } while (0)
#else
#define TP_BEGIN(id)
#define TP_END(id, WS)
#endif
#define XB_TMO      128
#define XB_XCNT(j)  (256  + 64 * (j))
#define XB_XSUB(j)  (1280 + 64 * (j))
#define XB_XGEN(j)  (2304 + 64 * (j))
#define XB_TOP      3328
#define XB_TOPGEN   3392
#define XCD_BAR_WORDS 3456
#define XB_SPIN_CAP (1u << 18)

__device__ __forceinline__ unsigned xb_ld(unsigned* p)              { return __hip_atomic_load(p, __ATOMIC_RELAXED, __HIP_MEMORY_SCOPE_AGENT); }
__device__ __forceinline__ unsigned xb_add(unsigned* p, unsigned v) { return __hip_atomic_fetch_add(p, v, __ATOMIC_RELAXED, __HIP_MEMORY_SCOPE_AGENT); }
__device__ __forceinline__ unsigned xb_xcc_id() { return (unsigned)__builtin_amdgcn_s_getreg((3 << 11) | 20) & 0xFu; }
#define XB_SPIN(cond, bar) do { unsigned _sp = 0; while (cond) { __builtin_amdgcn_s_sleep(1); \
    if ((++_sp & 255u) == 0u) { if (xb_ld(&(bar)[XB_TMO])) break; if (_sp > XB_SPIN_CAP) { atomicAdd(&(bar)[XB_TMO], 1u); break; } } } } while (0)

struct XcdBarrier {
    unsigned* bar; unsigned x;
    volatile LAS unsigned* st;
};

__device__ __forceinline__ XcdBarrier xcd_barrier_post(unsigned* bar, volatile LAS unsigned* st) {
    XcdBarrier b; b.bar = bar; b.x = xb_xcc_id(); b.st = st;
    if (threadIdx.x == 0) (void)xb_add(&bar[XB_XCNT(b.x)], 1u);
    return b;
}
__device__ __forceinline__ void xcd_barrier_complete(unsigned* bar, unsigned x, unsigned& nloc, unsigned& nx) {
    const unsigned G = gridDim.x * gridDim.y * gridDim.z;
    unsigned sum, cnt, mine, sp = 0u;
    for (;;) {
        sum = 0u; cnt = 0u; mine = 0u;
#pragma unroll
        for (unsigned j = 0; j < 16; ++j) { const unsigned c = xb_ld(&bar[XB_XCNT(j)]); sum += c; cnt += (c > 0u) ? 1u : 0u; mine = (j == x) ? c : mine; }
        if (sum == G) break;
        __builtin_amdgcn_s_sleep(1);
        if ((++sp & 255u) == 0u) { if (xb_ld(&bar[XB_TMO])) break; if (sp > XB_SPIN_CAP) { atomicAdd(&bar[XB_TMO], 1u); break; } }
    }
    nloc = mine > 0u ? mine : 1u; nx = cnt > 0u ? cnt : 1u;
}

__device__ __forceinline__ void xcd_barrier(const XcdBarrier& b) {
    asm volatile("s_waitcnt vmcnt(0)" ::: "memory");
    __syncthreads();
    if (threadIdx.x == 0) {
        unsigned* bar = b.bar;
        __builtin_amdgcn_s_waitcnt(0);
        unsigned nloc = b.st[0], nx = b.st[1];
        if (nloc == 0u) { xcd_barrier_complete(bar, b.x, nloc, nx); b.st[0] = nloc; b.st[1] = nx; }
        const unsigned old = xb_add(&bar[XB_XSUB(b.x)], 1u);
        const unsigned gen = old / nloc;
        if (old + 1u == (gen + 1u) * nloc) {
            __builtin_amdgcn_fence(__ATOMIC_RELEASE, "agent");
            asm volatile("s_waitcnt vmcnt(0)" ::: "memory");
            const unsigned og = xb_add(&bar[XB_TOP], 1u);
            const unsigned tg = og / nx;
            if (og + 1u == (tg + 1u) * nx) xb_add(&bar[XB_TOPGEN], 1u);
            else XB_SPIN(xb_ld(&bar[XB_TOPGEN]) == tg, bar);
            __builtin_amdgcn_fence(__ATOMIC_ACQUIRE, "agent");
            xb_add(&bar[XB_XGEN(b.x)], 1u);
            asm volatile("s_waitcnt vmcnt(0)" ::: "memory");
        } else {
            XB_SPIN(xb_ld(&bar[XB_XGEN(b.x)]) == gen, bar);
            __builtin_amdgcn_fence(__ATOMIC_ACQUIRE, "agent");
            asm volatile("s_waitcnt vmcnt(0)" ::: "memory");
        }
    }
    __syncthreads();
}

struct Args { const float* in[22]; float* out; unsigned char* ws; int ph_lo, ph_hi, na, pad; };
struct Frame {
  LAS unsigned char* lds; unsigned char* ws; int tid, lane, wave; const float* const* in;
};
#define IN_X 0
#define IN_META 1
#define IN_G1 2
#define IN_WIN 3
#define IN_CW 4
#define IN_CB 5
#define IN_IGB 6
#define IN_FGB 7
#define IN_LQ1 8
#define IN_LK1 9
#define IN_LQ2 10
#define IN_LK2 11
#define IN_QNG 12
#define IN_KNG 13
#define IN_SUBG 14
#define IN_OUTG 15
#define IN_WOUT 16
#define IN_G2 17
#define IN_WQ 18
#define IN_SUBK 19
#define IN_U 20
#define IN_V 21

__device__ __forceinline__ void p0_rows(const Frame& F, const Args& a) {
  const float* x = a.in[IN_X]; const float* meta = a.in[IN_META]; const float* g1 = a.in[IN_G1]; const float* w_in = a.in[IN_WIN];
  const float* igb = a.in[IN_IGB]; const float* fgb = a.in[IN_FGB];
  bf16* Xn = (bf16*)(F.ws + WS_XN); bf16* Xm = (bf16*)(F.ws + WS_XM); float* LI = (float*)(F.ws + WS_LI); float* LF = (float*)(F.ws + WS_LF);
  LAS f32x4* wgl = (LAS f32x4*)(F.lds);
  for (int e = F.tid; e < 4096; e += NTHR) {
    const int ln = e & 63, q = e >> 6, half = q & 1, j = (q >> 1) & 3, i = q >> 3;
    const int k = 4 * (i * 64 + ln) + j;
    wgl[e] = *(const f32x4*)(w_in + (size_t)k * DPROJ + NPROJ + 4 * half);
  }
  __syncthreads();
  const int gw = blockIdx.x * NWAVES + F.wave, NGW = gridDim.x * NWAVES, lane = F.lane;
  constexpr int NTASK = MROWS / 2 + NMETA / 2;
  f32x4 xnx[2][8];
  if (gw < NTASK) { const float* sn = (gw >= MROWS / 2 ? meta + (size_t)(gw - MROWS / 2) * 2 * DM : x + (size_t)gw * 2 * DM);
#pragma unroll
    for (int i = 0; i < 8; ++i) { xnx[0][i] = ((const f32x4*)sn)[i * 64 + lane]; xnx[1][i] = ((const f32x4*)(sn + DM))[i * 64 + lane]; } }
  f32x4 g1v[8];
#pragma unroll
  for (int i = 0; i < 8; ++i) g1v[i] = ((const f32x4*)g1)[i * 64 + lane];
  for (int task = gw; task < NTASK; task += NGW) {
    const bool ismeta = task >= MROWS / 2;
    const int r0 = ismeta ? (task - MROWS / 2) * 2 : task * 2;
    f32x4 xv[2][8]; float rs[2];
    { float s0 = 0.f, s1 = 0.f;
#pragma unroll
      for (int i = 0; i < 8; ++i) { xv[0][i] = xnx[0][i]; xv[1][i] = xnx[1][i]; }
      { const int tn = task + NGW; if (tn < NTASK) { const float* sn = (tn >= MROWS / 2 ? meta + (size_t)(tn - MROWS / 2) * 2 * DM : x + (size_t)tn * 2 * DM);
#pragma unroll
          for (int i = 0; i < 8; ++i) { xnx[0][i] = ((const f32x4*)sn)[i * 64 + lane]; xnx[1][i] = ((const f32x4*)(sn + DM))[i * 64 + lane]; } } }
#pragma unroll
      for (int i = 0; i < 8; ++i) { const f32x4 a0 = xv[0][i], a1 = xv[1][i];
        s0 += (a0.x * a0.x + a0.y * a0.y) + (a0.z * a0.z + a0.w * a0.w); s1 += (a1.x * a1.x + a1.y * a1.y) + (a1.z * a1.z + a1.w * a1.w); }
      rs[0] = rsqrtf(wave_sum_dpp(s0) * (1.0f / DM) + EPS); rs[1] = rsqrtf(wave_sum_dpp(s1) * (1.0f / DM) + EPS); }
    float ga[2][8];
#pragma unroll
    for (int rr = 0; rr < 2; ++rr)
#pragma unroll
      for (int g = 0; g < 8; ++g) ga[rr][g] = 0.f;
    bf16* dst0 = (ismeta ? Xm : Xn) + (size_t)r0 * DM;
#pragma unroll
    for (int i = 0; i < 8; ++i) {
      const f32x4 g = g1v[i];
      f32x4 xn[2];
#pragma unroll
      for (int rr = 0; rr < 2; ++rr) { xn[rr] = xv[rr][i] * g * rs[rr];
        v2u o; o.x = pk2(xn[rr].x, xn[rr].y); o.y = pk2(xn[rr].z, xn[rr].w); ((v2u*)(dst0 + (size_t)rr * DM))[i * 64 + lane] = o; }
#pragma unroll
      for (int j = 0; j < 4; ++j) {
        const f32x4 w0 = wgl[((i * 4 + j) * 2 + 0) * 64 + lane], w1 = wgl[((i * 4 + j) * 2 + 1) * 64 + lane];
#pragma unroll
        for (int rr = 0; rr < 2; ++rr) { const float xs_ = xn[rr][j];
          ga[rr][0] += xs_ * w0.x; ga[rr][1] += xs_ * w0.y; ga[rr][2] += xs_ * w0.z; ga[rr][3] += xs_ * w0.w;
          ga[rr][4] += xs_ * w1.x; ga[rr][5] += xs_ * w1.y; ga[rr][6] += xs_ * w1.z; ga[rr][7] += xs_ * w1.w; }
      }
      __builtin_amdgcn_sched_barrier(0);
    }
#pragma unroll
    for (int rr = 0; rr < 2; ++rr)
#pragma unroll
      for (int g = 0; g < 8; ++g) ga[rr][g] = wave_sum_dpp(ga[rr][g]);
    if (lane < 8) {
      const int rr = lane >> 2, h = lane & 3;
      float gi = 0.f, gf = 0.f;
#pragma unroll
      for (int q = 0; q < 2; ++q)
#pragma unroll
        for (int hh = 0; hh < 4; ++hh) if (q == rr && hh == h) { gi = ga[q][hh]; gf = ga[q][4 + hh]; }
      const float li = gi + igb[h]; const float fx = gf + fgb[h];
      const float lf = fminf(fx, 0.f) - log1pf(__expf(-fabsf(fx)));
      const int R = r0 + rr;
      if (!ismeta) { const int b = R >> 11, t = R & 2047; LI[(b * 4 + h) * PADT + POS0 + t] = li; LF[(b * 4 + h) * PADT + POS0 + t] = lf; }
      else { for (int b = 0; b < NB; ++b) { LI[(b * 4 + h) * PADT + MPOS0 + R] = li; LF[(b * 4 + h) * PADT + MPOS0 + R] = lf; } }
    }
  }
  __syncthreads();
}
template <bool META>
__device__ __forceinline__ void p0_transpose(const Frame& F, const Args& a, const float* W, int ldw, int N, bf16* Wt) {
  LAS float* tl = (LAS float*)(F.lds);
  LAS float* red = (LAS float*)(F.lds + 33792);
  float* PM = (float*)(F.ws + WS_PM);
  const float* meta = a.in[IN_META]; const float* g1 = a.in[IN_G1];
  const int ntn = N / 64, ntask = ntn * 16, fr = F.lane & 15, fq = F.lane >> 4, w = F.wave;
  f32x4 wn[4];
  float am[4], ag[4];
  if ((int)blockIdx.x < ntask) { const int nb = blockIdx.x % ntn, kb = blockIdx.x / ntn;
#pragma unroll
    for (int i = 0; i < 4; ++i) { const int idx = F.tid + NTHR * i, kk = idx >> 4, c4 = idx & 15; wn[i] = *(const f32x4*)(W + (size_t)(kb * 128 + kk) * ldw + nb * 64 + 4 * c4); }
    if (META) {
#pragma unroll
      for (int s_ = 0; s_ < 4; ++s_) { const int k = kb * 128 + 16 * w + 4 * s_ + fq; am[s_] = meta[(size_t)fr * DM + k]; ag[s_] = g1[k]; } } }
  for (int task = blockIdx.x; task < ntask; task += gridDim.x) {
    const int nb = task % ntn, kb = task / ntn, n0 = nb * 64, k0 = kb * 128;
    __syncthreads();
#pragma unroll
    for (int i = 0; i < 4; ++i) { const int idx = F.tid + NTHR * i, kk = idx >> 4, c4 = idx & 15; const f32x4 wv = wn[i];
      LAS float* d = tl + kk * 65 + 4 * c4; d[0] = wv.x; d[1] = wv.y; d[2] = wv.z; d[3] = wv.w; }
    float ac[4];
    if (META) {
#pragma unroll
      for (int s_ = 0; s_ < 4; ++s_) ac[s_] = am[s_] * ag[s_]; }
    { const int tn = task + gridDim.x; if (tn < ntask) { const int nb2 = tn % ntn, kb2 = tn / ntn;
#pragma unroll
        for (int i = 0; i < 4; ++i) { const int idx = F.tid + NTHR * i, kk = idx >> 4, c4 = idx & 15; wn[i] = *(const f32x4*)(W + (size_t)(kb2 * 128 + kk) * ldw + nb2 * 64 + 4 * c4); }
        if (META) {
#pragma unroll
          for (int s_ = 0; s_ < 4; ++s_) { const int k = kb2 * 128 + 16 * w + 4 * s_ + fq; am[s_] = meta[(size_t)fr * DM + k]; ag[s_] = g1[k]; } } } }
    __syncthreads();
    const int n = F.tid >> 3, kc = F.tid & 7;
    const LAS float* s = tl + (kc * 16) * 65 + n;
    v4u o0, o1;
    o0.x = pk2(s[0 * 65], s[1 * 65]); o0.y = pk2(s[2 * 65], s[3 * 65]); o0.z = pk2(s[4 * 65], s[5 * 65]); o0.w = pk2(s[6 * 65], s[7 * 65]);
    o1.x = pk2(s[8 * 65], s[9 * 65]); o1.y = pk2(s[10 * 65], s[11 * 65]); o1.z = pk2(s[12 * 65], s[13 * 65]); o1.w = pk2(s[14 * 65], s[15 * 65]);
    v4u* dp = (v4u*)(Wt + (size_t)(n0 + n) * DM + k0 + kc * 16);
    dp[0] = o0; dp[1] = o1;
    if (META && n0 >= 1024) {
      f32x4 acc[4];
#pragma unroll
      for (int nt = 0; nt < 4; ++nt) acc[nt] = (f32x4){0.f, 0.f, 0.f, 0.f};
#pragma unroll
      for (int s_ = 0; s_ < 4; ++s_)
#pragma unroll
        for (int nt = 0; nt < 4; ++nt) acc[nt] = __builtin_amdgcn_mfma_f32_16x16x4f32(ac[s_], tl[(16 * w + 4 * s_ + fq) * 65 + nt * 16 + fr], acc[nt], 0, 0, 0);
#pragma unroll
      for (int nt = 0; nt < 4; ++nt)
#pragma unroll
        for (int i = 0; i < 4; ++i) red[(w * 16 + 4 * fq + i) * 64 + nt * 16 + fr] = acc[nt][i];
      __syncthreads();
#pragma unroll
      for (int j = 0; j < 2; ++j) { const int idx = F.tid + NTHR * j, m = idx >> 6, nn = idx & 63; const LAS float* r = red + m * 64 + nn;
        PM[((size_t)kb * 16 + m) * NPROJ + n0 + nn] = ((r[0] + r[1024]) + (r[2048] + r[3072])) + ((r[4096] + r[5120]) + (r[6144] + r[7168])); }
    }
  }
  __syncthreads();
}
__device__ __forceinline__ void p0_zero_vpad(const Frame& F) {
  bf16* Vp = (bf16*)(F.ws + WS_VP);
  const int per = MPOS0 * 256 / 8;
  for (int i = blockIdx.x * NTHR + F.tid; i < 16 * per; i += gridDim.x * NTHR) { const int bh = i / per, e = i % per;
    *(v4u*)(Vp + (size_t)bh * PADT * 256 + (size_t)e * 8) = (v4u){0u, 0u, 0u, 0u}; }
}
__device__ __forceinline__ void p0_lam(const Frame& F, const Args& a) {
  if (blockIdx.x == 0 && F.wave == 0) {
    const int l = F.lane;
    float s1 = a.in[IN_LQ1][l] * a.in[IN_LK1][l] + a.in[IN_LQ1][l + 64] * a.in[IN_LK1][l + 64];
    float s2 = a.in[IN_LQ2][l] * a.in[IN_LK2][l] + a.in[IN_LQ2][l + 64] * a.in[IN_LK2][l + 64];
    s1 = wave_sum(s1); s2 = wave_sum(s2);
    if (l == 0) *(float*)(F.ws + WS_LAM) = __expf(s1) - __expf(s2) + 0.2f;
  }
}

struct EpiProj {
  static constexpr bool PERM = true, AFTER_DRAIN = false;
  bf16 *Qb, *Kp, *Vp, *MQ, *MK, *MV, *MO; const float *qg, *kg; LAS float* xch;
  __device__ __forceinline__ void operator()(const pg8::f32x4 (&acc)[2][2][4][2], const pg8::Unit& u, int wr, int wc, int fr, int fq) const {
    const int pn = u.pn, b = u.pm >> 3, tb = (u.pm & 7) * 256 + wr * 64 + fr, d0 = wc * 32 + fq * 8;
    if (pn < 8) {
      const bool isk = pn >= 4; const int h = pn & 3;
      float ssq[2][4][2];
#pragma unroll
      for (int ai = 0; ai < 2; ++ai)
#pragma unroll
        for (int m = 0; m < 4; ++m)
#pragma unroll
          for (int bj = 0; bj < 2; ++bj) { float s = 0.f;
#pragma unroll
            for (int n = 0; n < 2; ++n) { const pg8::f32x4 x = acc[ai][bj][m][n]; s += (x[0] * x[0] + x[1] * x[1]) + (x[2] * x[2] + x[3] * x[3]); }
            s += __shfl_xor(s, 16); s += __shfl_xor(s, 32); ssq[ai][m][bj] = s;
            if (fq == 0) xch[((ai * 128 + wr * 64 + m * 16 + fr) * 2 + bj) * 4 + wc] = s; }
      asm volatile("s_waitcnt lgkmcnt(0)" ::: "memory"); __builtin_amdgcn_s_barrier(); asm volatile("" ::: "memory");
      const float* gp = (isk ? kg : qg) + d0; const f32x4 g0 = *(const f32x4*)gp, g1v = *(const f32x4*)(gp + 4);
      const float sc = isk ? 1.0f : QSCALE;
#pragma unroll
      for (int ai = 0; ai < 2; ++ai)
#pragma unroll
        for (int m = 0; m < 4; ++m)
#pragma unroll
          for (int bj = 0; bj < 2; ++bj) {
            const f32x4 p = *(const LAS f32x4*)(xch + ((ai * 128 + wr * 64 + m * 16 + fr) * 2 + bj) * 4);
            const float rs = rsqrtf(((p.x + p.y) + (p.z + p.w)) * (1.0f / 128.f) + EPS) * sc;
            const pg8::f32x4 v0 = acc[ai][bj][m][0], v1 = acc[ai][bj][m][1];
            v4u w; w.x = pk2(v0[0] * rs * g0.x, v0[1] * rs * g0.y); w.y = pk2(v0[2] * rs * g0.z, v0[3] * rs * g0.w);
            w.z = pk2(v1[0] * rs * g1v.x, v1[1] * rs * g1v.y); w.w = pk2(v1[2] * rs * g1v.z, v1[3] * rs * g1v.w);
            const int t = tb + ai * 128 + m * 16;
            bf16* dst = isk ? Kp + kp_off((b * 4 + h) * 2 + bj, POS0 + t, d0)
                            : Qb + ((size_t)((b * 4 + h) * 2 + bj) * SEQ + t) * 128 + d0;
            *(v4u*)dst = w; }
      return;
    }
#pragma unroll
    for (int ai = 0; ai < 2; ++ai)
#pragma unroll
      for (int m = 0; m < 4; ++m)
#pragma unroll
        for (int bj = 0; bj < 2; ++bj) {
          pg8::f32x4 v0 = acc[ai][bj][m][0], v1 = acc[ai][bj][m][1];
          const int t = tb + ai * 128 + m * 16;
          bf16* dst;
          if (pn < 12) { const int h = pn - 8; dst = Vp + ((size_t)(b * 4 + h) * PADT + POS0 + t) * 256 + bj * 128 + d0; }
          else if (pn < 16) { const int h = 2 * (pn & 1) + bj; dst = (pn >= 14 ? MK : MQ) + ((size_t)(b * 4 + h) * PADT + POS0 + t) * 128 + d0; }
          else if (pn < 20) { const int h = pn - 16; dst = MV + ((size_t)(b * 4 + h) * PADT + POS0 + t) * 256 + bj * 128 + d0; }
          else dst = MO + (size_t)(b * SEQ + t) * 1024 + (pn - 20) * 256 + bj * 128 + d0;
          v4u w; w.x = pk2(v0[0], v0[1]); w.y = pk2(v0[2], v0[3]); w.z = pk2(v1[0], v1[1]); w.w = pk2(v1[2], v1[3]);
          *(v4u*)dst = w; }
  }
};
__device__ __forceinline__ void p1_meta_finalize(const Frame& F, const Args& a) {
  const bool spread = gridDim.x >= 2 * NMETA;
  if (spread ? ((blockIdx.x & 1) != 0 || blockIdx.x >= 2 * NMETA) : (blockIdx.x >= NMETA)) return;
  const int mrow = spread ? (int)(blockIdx.x >> 1) : (int)blockIdx.x, tid = F.tid, lane = F.lane, w = F.wave;
  const float* meta = a.in[IN_META] + (size_t)mrow * DM; const float* PM0 = (const float*)(F.ws + WS_PM) + (size_t)mrow * NPROJ;
#define PM_P4(i, p) ((PM0[(size_t)(16 * (p)) * NPROJ + (i)] + PM0[(size_t)(16 * ((p) + 1)) * NPROJ + (i)]) + (PM0[(size_t)(16 * ((p) + 2)) * NPROJ + (i)] + PM0[(size_t)(16 * ((p) + 3)) * NPROJ + (i)]))
#define PM_AT(i) ((PM_P4(i, 0) + PM_P4(i, 4)) + (PM_P4(i, 8) + PM_P4(i, 12)))
  LAS float* red = (LAS float*)(F.lds + XCH_OFF);
  const f32x4 mv = ((const f32x4*)meta)[tid];
  float s = wave_sum((mv.x * mv.x + mv.y * mv.y) + (mv.z * mv.z + mv.w * mv.w));
  if (lane == 0) red[w] = s;
  __syncthreads();
  float tot = 0.f;
#pragma unroll
  for (int i = 0; i < 8; ++i) tot += red[i];
  const float rs = rsqrtf(tot * (1.0f / DM) + EPS);
  bf16* Kp = (bf16*)(F.ws + WS_KP); bf16* Vp = (bf16*)(F.ws + WS_VP); bf16* MQ = (bf16*)(F.ws + WS_MQ); bf16* MK = (bf16*)(F.ws + WS_MK); bf16* MV = (bf16*)(F.ws + WS_MV);
  const int pos = MPOS0 + mrow;
  const int c = tid * 2;
  const float kv0 = PM_AT(1024 + w * 128 + lane), kv1 = PM_AT(1024 + w * 128 + lane + 64);
  const float a0 = PM_AT(2048 + c), a1 = PM_AT(2048 + c + 1), b0 = PM_AT(3072 + c), b1 = PM_AT(3072 + c + 1), c0 = PM_AT(4096 + c), c1 = PM_AT(4096 + c + 1);
  {
    const float v0 = kv0 * rs, v1 = kv1 * rs;
    const float rk = rsqrtf(wave_sum(v0 * v0 + v1 * v1) * (1.0f / 128.f) + EPS);
    const float* kg = a.in[IN_KNG];
    const unsigned short o0 = (unsigned short)f2bf(v0 * rk * kg[lane]), o1 = (unsigned short)f2bf(v1 * rk * kg[lane + 64]);
    for (int b = 0; b < NB; ++b) { const int bhm = (b * 4 + (w >> 1)) * 2 + (w & 1); Kp[kp_off(bhm, pos, lane)] = o0; Kp[kp_off(bhm, pos, lane + 64)] = o1; }
  }
  {
    const unsigned o = pk2(a0 * rs, a1 * rs); const int h = c >> 8, e = c & 255;
    for (int b = 0; b < NB; ++b) *(unsigned*)(Vp + ((size_t)(b * 4 + h) * PADT + pos) * 256 + e) = o;
    const unsigned o2 = pk2(b0 * rs, b1 * rs); const bool isk = c >= 512; const int cc = c & 511, hq = cc >> 7, d = cc & 127;
    for (int b = 0; b < NB; ++b) *(unsigned*)((isk ? MK : MQ) + ((size_t)(b * 4 + hq) * PADT + pos) * 128 + d) = o2;
    const unsigned o3 = pk2(c0 * rs, c1 * rs);
    for (int b = 0; b < NB; ++b) *(unsigned*)(MV + ((size_t)(b * 4 + h) * PADT + pos) * 256 + e) = o3;
  }
  __syncthreads();
}
#undef PM_AT
#undef PM_P4

namespace att {
using f32x16 = __attribute__((ext_vector_type(16))) float;
using s16x4 = __attribute__((ext_vector_type(4))) short;
constexpr int STEPS_BHM = 152, NSTEPS = 32 * STEPS_BHM;
constexpr int SHM_V = 64 * 256 * 2, SHM_K = 64 * 128 * 2;
constexpr int LDS_V = 0, LDS_K = 2 * SHM_V, LDS_Q = LDS_K + SHM_K, LDS_WS = LDS_Q + 8 * 8192;
constexpr float THR2 = 8.0f;
#define KSWZ(row, colB) ((row) * 256 + ((colB) ^ (((row) & 7) << 4)))
#define SBAR() __builtin_amdgcn_sched_barrier(0)
__device__ __forceinline__ int crow(int r, int hi) { return (r & 3) + 8 * (r >> 2) + 4 * hi; }
__device__ __forceinline__ unsigned cvtpk(float lo, float hi) { unsigned r; asm volatile("v_cvt_pk_bf16_f32 %0, %1, %2" : "=v"(r) : "v"(lo), "v"(hi)); return r; }
__device__ __forceinline__ int qb_start(int qb) { return 2 * qb * qb + 3 * qb; }
__device__ __forceinline__ int chunk_of(int s, int NA) { return ((s + 1) * NA - 1) / NSTEPS; }

template <int OFF> __device__ __forceinline__ s16x4 tr_read(int vb) {
  s16x4 r; asm volatile("ds_read_b64_tr_b16 %0, %1 offset:%2" : "=&v"(r) : "v"(vb), "i"(OFF) : "memory"); return r;
}
constexpr int v_rd_off(int d0, int ks, int half) { return d0 * 512 + ks * 8192 + half * 4096; }
template <int D0> __device__ __forceinline__ void pv_one(f32x16& od, int vb, bf16x8 pa0, bf16x8 pa1, bf16x8 pa2, bf16x8 pa3) {
#define PK(L, H) (bf16x8){L[0], L[1], L[2], L[3], H[0], H[1], H[2], H[3]}
  { const s16x4 l0 = tr_read<v_rd_off(D0, 0, 0)>(vb), h0 = tr_read<v_rd_off(D0, 0, 1)>(vb), l1 = tr_read<v_rd_off(D0, 1, 0)>(vb), h1 = tr_read<v_rd_off(D0, 1, 1)>(vb);
    asm volatile("s_waitcnt lgkmcnt(0)" ::: "memory"); SBAR();
    od = __builtin_amdgcn_mfma_f32_32x32x16_bf16(pa0, PK(l0, h0), od, 0, 0, 0);
    od = __builtin_amdgcn_mfma_f32_32x32x16_bf16(pa1, PK(l1, h1), od, 0, 0, 0); }
  SBAR();
  { const s16x4 l2 = tr_read<v_rd_off(D0, 2, 0)>(vb), h2 = tr_read<v_rd_off(D0, 2, 1)>(vb), l3 = tr_read<v_rd_off(D0, 3, 0)>(vb), h3 = tr_read<v_rd_off(D0, 3, 1)>(vb);
    asm volatile("s_waitcnt lgkmcnt(0)" ::: "memory"); SBAR();
    od = __builtin_amdgcn_mfma_f32_32x32x16_bf16(pa2, PK(l2, h2), od, 0, 0, 0);
    od = __builtin_amdgcn_mfma_f32_32x32x16_bf16(pa3, PK(l3, h3), od, 0, 0, 0); }
#undef PK
}

__device__ __forceinline__ void segment(const Frame& F, int bhm, int qb, int j0, int j1, int slot) {
  const int tid = F.tid, wid = F.wave, lane = F.lane, r32 = lane & 31, hi = lane >> 5;
  const bf16* Qg = (const bf16*)(F.ws + WS_Q) + ((size_t)bhm * SEQ + qb * 256 + wid * 32 + r32) * 128 + hi * 8;
  const bf16* Kg = (const bf16*)(F.ws + WS_KP) + (size_t)bhm * 33 * 8192;
  const bf16* Vg = (const bf16*)(F.ws + WS_VP) + (size_t)(bhm >> 1) * PADT * 256;
  LAS unsigned char* lds = F.lds;
  LAS float* wsl = (LAS float*)(lds + LDS_WS) + wid * 64;
  const float slope2 = exp2f(-2.0f * (float)(((bhm >> 1) & 3) + 1)) * LOG2E;
  unsigned ksrc0, vsrc0;
  ksrc0 = (unsigned)tid * 16u;
  { const int a8 = tid >> 8, b = (tid >> 2) & 7, k = 8 * (b >> 2) + 4 * a8 + (b & 3), c = ((tid >> 5) & 7) * 32 + (tid & 3) * 8; vsrc0 = (unsigned)(k * 256 + c) * 2u; }
#define STAGE_K(j) do { const char* kt = (const char*)(Kg + (size_t)(j) * 8192); \
    _Pragma("unroll") for (int _i = 0; _i < 2; ++_i) __builtin_amdgcn_global_load_lds((const unsigned*)(kt + (ksrc0 + _i * 8192u)), (LAS unsigned*)(lds + LDS_K + _i * 8192 + wid * 1024), 16, 0, 0); } while (0)
#define STAGE_V(buf, j) do { const char* vt = (const char*)(Vg + (size_t)(j) * 64 * 256); \
    _Pragma("unroll") for (int _i = 0; _i < 4; ++_i) __builtin_amdgcn_global_load_lds((const unsigned*)(vt + (vsrc0 + _i * 8192u)), (LAS unsigned*)(lds + LDS_V + (buf) * SHM_V + _i * 8192 + wid * 1024), 16, 0, 0); } while (0)
  const int lt = (((r32 << 1) | hi) ^ ((r32 >> 3) & 1)) << 4;
  LAS unsigned char* Qs = lds + LDS_Q + wid * 8192;
#pragma unroll
  for (int d0 = 0; d0 < 8; ++d0) { const bf16x8 qv = *(const bf16x8*)(Qg + d0 * 16); *(LAS bf16x8*)(Qs + d0 * 1024 + lt) = qv; }
  f32x16 o[8];
#pragma unroll
  for (int d = 0; d < 8; ++d)
#pragma unroll
    for (int r = 0; r < 16; ++r) o[d][r] = 0.f;
  float m_reg = -1e30f, l_reg = 0.f;
  const int vb0 = (int)(uintptr_t)(lds + LDS_V) + (((lane & 3) << 3) | (((lane >> 2) & 3) << 6) | (((lane >> 4) & 1) << 5) | (((lane >> 5) & 1) << 8));
  STAGE_K(j0); STAGE_V(0, j0);
  VM_WAIT(); __syncthreads();
  for (int j = j0; j < j1; ++j) {
    const int cur = (j - j0) & 1;
    if (j + 1 < j1) STAGE_V(cur ^ 1, j + 1);
    SBAR();
    f32x16 p0 = {}, p1 = {};
    { const LAS unsigned char* Ks = lds + LDS_K;
#pragma unroll
      for (int d0 = 0; d0 < 8; ++d0) {
        const bf16x8 b0 = *(const LAS bf16x8*)(Ks + d0 * 2048 + lt);
        const bf16x8 b1 = *(const LAS bf16x8*)(Ks + d0 * 2048 + 1024 + lt);
        const bf16x8 qf = *(const LAS bf16x8*)(Qs + d0 * 1024 + lt);
        p0 = __builtin_amdgcn_mfma_f32_32x32x16_bf16(b0, qf, p0, 0, 0, 0);
        p1 = __builtin_amdgcn_mfma_f32_32x32x16_bf16(b1, qf, p1, 0, 0, 0); } }
    asm volatile("s_waitcnt lgkmcnt(0)" ::: "memory"); __builtin_amdgcn_s_barrier(); asm volatile("" ::: "memory");
    if (j + 1 < j1) STAGE_K(j + 1);
    SBAR();
    if (j == 0) {
#pragma unroll
      for (int r = 0; r < 16; ++r) p0[r] = -INFINITY;
#pragma unroll
      for (int r = 0; r < 8; ++r) p1[r] = -INFINITY;
    }
    int ln2 = threadIdx.x & 63; asm volatile("" : "+v"(ln2));
    const int hi2 = ln2 >> 5;
    const int jb = j - (4 * qb + 1);
    if (jb >= 0) {
      const int kb = 64 * jb + 4 * hi2, qrel = wid * 32 + (ln2 & 31);
#pragma unroll
      for (int r = 0; r < 16; ++r) { const int kv = kb + (r & 3) + 8 * (r >> 2); if (kv > qrel) p0[r] = -INFINITY; if (kv + 32 > qrel) p1[r] = -INFINITY; }
    }
    const float off0 = slope2 * (float)(64 * j + 4 * hi2), off1 = off0 + 32.0f * slope2;
#pragma unroll
    for (int r = 0; r < 16; ++r) { const float sb = slope2 * (float)((r & 3) + 8 * (r >> 2)); p0[r] += sb; p1[r] += sb; }
    float pm0 = p0[0], pm1 = p1[0];
#pragma unroll
    for (int r = 1; r < 16; ++r) { pm0 = fmaxf(pm0, p0[r]); pm1 = fmaxf(pm1, p1[r]); }
    float pmax = fmaxf(pm0 + off0, pm1 + off1);
    { auto rr = __builtin_amdgcn_permlane32_swap(__float_as_uint(pmax), __float_as_uint(pmax), false, false);
      pmax = fmaxf(__uint_as_float(rr[0]), __uint_as_float(rr[1])); }
    float mn, alpha;
    if (__builtin_expect(__all(pmax - m_reg <= THR2), 1)) { mn = m_reg; alpha = 1.f; }
    else { mn = fmaxf(m_reg, pmax); alpha = __builtin_amdgcn_exp2f(m_reg - mn); m_reg = mn; }
    const float c0 = off0 - mn, c1 = off1 - mn;
    float ps = 0.f;
#pragma unroll
    for (int r = 0; r < 16; ++r) { p0[r] = __builtin_amdgcn_exp2f(p0[r] + c0); p1[r] = __builtin_amdgcn_exp2f(p1[r] + c1); ps += p0[r] + p1[r]; }
    { auto rr = __builtin_amdgcn_permlane32_swap(__float_as_uint(ps), __float_as_uint(ps), false, false);
      ps = __uint_as_float(rr[0]) + __uint_as_float(rr[1]); }
    l_reg = l_reg * alpha + ps;
    if (__any(alpha < 1.f)) { if (hi == 0) wsl[r32] = alpha; asm volatile("s_waitcnt lgkmcnt(0)" ::: "memory");
#pragma unroll
      for (int rg = 0; rg < 4; ++rg) { const f32x4 al = *(const LAS f32x4*)(wsl + 8 * rg + 4 * hi);
#pragma unroll
        for (int d = 0; d < 8; ++d) { o[d][4 * rg + 0] *= al.x; o[d][4 * rg + 1] *= al.y; o[d][4 * rg + 2] *= al.z; o[d][4 * rg + 3] *= al.w; }
        SBAR(); } }
    bf16x8 pa0, pa1, pa2, pa3;
#define PK4(P, BASE, OUT) do { unsigned a0 = cvtpk(P[BASE + 0], P[BASE + 1]), a1 = cvtpk(P[BASE + 2], P[BASE + 3]);   \
    unsigned b0 = cvtpk(P[BASE + 4], P[BASE + 5]), b1 = cvtpk(P[BASE + 6], P[BASE + 7]);                              \
    auto r0 = __builtin_amdgcn_permlane32_swap(a0, b0, false, false); auto r1 = __builtin_amdgcn_permlane32_swap(a1, b1, false, false); \
    v4u w = {r0[0], r1[0], r0[1], r1[1]}; OUT = *reinterpret_cast<bf16x8*>(&w); } while (0)
    PK4(p0, 0, pa0); PK4(p0, 8, pa1); PK4(p1, 0, pa2); PK4(p1, 8, pa3);
#undef PK4
    SBAR();
    { const int vb = vb0 + cur * SHM_V;
      pv_one<0>(o[0], vb, pa0, pa1, pa2, pa3); pv_one<1>(o[1], vb, pa0, pa1, pa2, pa3); pv_one<2>(o[2], vb, pa0, pa1, pa2, pa3); pv_one<3>(o[3], vb, pa0, pa1, pa2, pa3);
      pv_one<4>(o[4], vb, pa0, pa1, pa2, pa3); pv_one<5>(o[5], vb, pa0, pa1, pa2, pa3); pv_one<6>(o[6], vb, pa0, pa1, pa2, pa3); pv_one<7>(o[7], vb, pa0, pa1, pa2, pa3); }
    VM_WAIT(); __syncthreads();
  }
  { int lane2 = threadIdx.x & 63, slot2 = slot; asm volatile("" : "+v"(lane2), "+s"(slot2));
    const int r32e = lane2 & 31, hie = lane2 >> 5;
    bf16* PO = (bf16*)(F.ws + WS_PO) + (size_t)slot2 * 256 * 256; float* ML = (float*)(F.ws + WS_ML) + (size_t)slot2 * 512;
    LAS float* wse = (LAS float*)(F.lds + LDS_WS) + wid * 64;
    if (hie == 0) { wse[r32e] = l_reg; ML[(wid * 32 + r32e) * 2] = m_reg; ML[(wid * 32 + r32e) * 2 + 1] = l_reg; }
    asm volatile("s_waitcnt lgkmcnt(0)" ::: "memory");
    char* Ob = (char*)(PO + (size_t)(wid * 32) * 256);
    const bool odd = (r32e & 1) != 0;
    const unsigned lo = (unsigned)(4 * hie * 256 + (r32e & ~1) + (odd ? 32 : 0)) * 2u;
#pragma unroll
    for (int r = 0; r < 16; ++r) { const int rowc = (r & 3) + 8 * (r >> 2); const float lv = wse[rowc + 4 * hie]; const float rl = lv > 0.f ? __builtin_amdgcn_rcpf(lv) : 0.f;
#pragma unroll
      for (int dp = 0; dp < 4; ++dp) { const float va = o[2 * dp][r] * rl, vb = o[2 * dp + 1][r] * rl;
        const float send = odd ? va : vb, keep = odd ? vb : va;
        const float recv = __builtin_bit_cast(float, __builtin_amdgcn_update_dpp(0, __builtin_bit_cast(int, send), 0xB1, 0xF, 0xF, true));
        *(unsigned*)(Ob + (lo + (unsigned)(rowc * 256 + dp * 64) * 2u)) = odd ? pk2(recv, keep) : pk2(keep, recv); }
      SBAR(); } }
  __syncthreads();
#undef STAGE_K
#undef STAGE_V
}

__device__ __forceinline__ void phase(const Frame& F, int ca, int NA) {
  int s0 = (int)(((long)ca * NSTEPS) / NA); const int s1 = (int)(((long)(ca + 1) * NSTEPS) / NA);
  while (s0 < s1) {
    const int bhm = s0 / STEPS_BHM, rem = s0 - bhm * STEPS_BHM;
    int qb = 0;
#pragma unroll 1
    for (int q = 1; q < 8; ++q) if (rem >= qb_start(q)) qb = q;
    const int j0 = rem - qb_start(qb), nst = 4 * qb + 5;
    const int j1 = (j0 + (s1 - s0) < nst) ? j0 + (s1 - s0) : nst;
    const int slot = bhm * 16 + qb + chunk_of(s0, NA) - chunk_of(bhm * STEPS_BHM, NA);
    segment(F, bhm, qb, j0, j1, slot);
    s0 += j1 - j0;
  }
}
#undef KSWZ
#undef SBAR
}
namespace ml {
constexpr int QST = 136, TST = 72;
constexpr int L_RQ = 0, L_RK = 17152, L_QS = 34304, L_QW = 51712, L_KS = 69120, L_KWT = 86528, L_VT = 104960  , L_SP = 0  , L_G = 141824, L_CW = 143872;
constexpr int L_HT = 0;
constexpr int G_A = 0, G_M = 64, G_WI = 128, G_EM = 192, G_DEN = 256, G_WG = 320, G_SC = 384, G_N = 0;
constexpr int L_NV = L_CW + 5120;
constexpr int L_SSQ = L_KWT;
__device__ __forceinline__ float shfl_up_f(float v, int d) { return __shfl_up(v, d); }

struct StageCW { float v[3]; };
__device__ __forceinline__ void issue_cw(const Frame& F, const Args& a, int h, StageCW& st) {
#pragma unroll
  for (int i = 0; i < 3; ++i) { const int e = F.tid + NTHR * i; st.v[i] = 0.f;
    if (e < 2 * 5 * 128) { const int qk = e / 640, j = (e / 128) % 5, d = e & 127; const int ch = qk * 512 + h * 128 + d; st.v[i] = j < 4 ? a.in[IN_CW][j * 1024 + ch] : a.in[IN_CB][ch]; } }
}
__device__ __forceinline__ void commit_cw(const Frame& F, const StageCW& st) {
  LAS float* CW = (LAS float*)(F.lds + L_CW);
#pragma unroll
  for (int i = 0; i < 3; ++i) { const int e = F.tid + NTHR * i; if (e < 2 * 5 * 128) CW[e] = st.v[i]; }
}
struct StageRaw { v4u v[3]; };
__device__ __forceinline__ void issue_raw(const Frame& F, const bf16* g, int pos0, StageRaw& st) {
#pragma unroll
  for (int i = 0; i < 3; ++i) { const int p = F.tid + NTHR * i, row = p >> 4, ch = p & 15, pos = pos0 - 3 + row;
    st.v[i] = (v4u){0u, 0u, 0u, 0u}; if (p < 67 * 16 && pos >= MPOS0) st.v[i] = *(const v4u*)(g + (size_t)pos * 128 + ch * 8); }
}
__device__ __forceinline__ void commit_raw(const Frame& F, int lds_off, const StageRaw& st) {
#pragma unroll
  for (int i = 0; i < 3; ++i) { const int p = F.tid + NTHR * i, row = p >> 4, ch = p & 15; if (p < 67 * 16) *(LAS v4u*)(F.lds + lds_off + row * 256 + ch * 16) = st.v[i]; }
}
__device__ __forceinline__ void conv16(const Frame& F, int qk, int lds_off, int t, int d0, float (&y)[16]) {
  const LAS float* CW = (const LAS float*)(F.lds + L_CW);
#pragma unroll
  for (int e = 0; e < 16; ++e) y[e] = CW[(qk * 5 + 4) * 128 + d0 + e];
#pragma unroll
  for (int j = 0; j < 4; ++j) { const LAS v4u* rp = (const LAS v4u*)(F.lds + lds_off + (t + j) * 256 + d0 * 2); const v4u r0 = rp[0], r1 = rp[1];
    const LAS float* cw = CW + (qk * 5 + j) * 128 + d0;
    y[0] += cw[0] * bflo(r0.x); y[1] += cw[1] * bfhi(r0.x); y[2] += cw[2] * bflo(r0.y); y[3] += cw[3] * bfhi(r0.y); y[4] += cw[4] * bflo(r0.z); y[5] += cw[5] * bfhi(r0.z); y[6] += cw[6] * bflo(r0.w); y[7] += cw[7] * bfhi(r0.w);
    y[8] += cw[8] * bflo(r1.x); y[9] += cw[9] * bfhi(r1.x); y[10] += cw[10] * bflo(r1.y); y[11] += cw[11] * bfhi(r1.y); y[12] += cw[12] * bflo(r1.z); y[13] += cw[13] * bfhi(r1.z); y[14] += cw[14] * bflo(r1.w); y[15] += cw[15] * bfhi(r1.w); }
#pragma unroll
  for (int e = 0; e < 16; ++e) y[e] = y[e] / (1.0f + __expf(-y[e]));
}
struct StageVT { v4u v[4]; };
__device__ __forceinline__ void issue_vt(const Frame& F, const bf16* MVg, int pos0, StageVT& st) {
#pragma unroll
  for (int i = 0; i < 4; ++i) { const int p = F.tid + NTHR * i, row = p >> 5, ch = p & 31; st.v[i] = (v4u){0u, 0u, 0u, 0u};
    if (pos0 + row >= MPOS0) st.v[i] = *(const v4u*)(MVg + (size_t)(pos0 + row) * 256 + ch * 8); }
}
__device__ __forceinline__ void commit_vt(const Frame& F, const StageVT& st) {
#pragma unroll
  for (int i = 0; i < 4; ++i) { const int p = F.tid + NTHR * i, row = p >> 5, ch = p & 31; const v4u v4 = st.v[i];
    LAS bf16* vt = (LAS bf16*)(F.lds + L_VT) + (ch * 8) * TST + row;
    vt[0 * TST] = (bf16)(v4.x & 0xffff); vt[1 * TST] = (bf16)(v4.x >> 16); vt[2 * TST] = (bf16)(v4.y & 0xffff); vt[3 * TST] = (bf16)(v4.y >> 16);
    vt[4 * TST] = (bf16)(v4.z & 0xffff); vt[5 * TST] = (bf16)(v4.z >> 16); vt[6 * TST] = (bf16)(v4.w & 0xffff); vt[7 * TST] = (bf16)(v4.w >> 16); }
}

__device__ __forceinline__ void taskA(const Frame& F, const Args& a, int task) {
  const int bh = task >> 5, c = task & 31, h = bh & 3, tid = F.tid, w = F.wave, lane = F.lane, fr = lane & 15, kq = lane >> 4, pos0 = 64 * c;
  LAS unsigned char* lds = F.lds; LAS float* G = (LAS float*)(lds + L_G);
  const bf16* MKg = (const bf16*)(F.ws + WS_MK) + (size_t)bh * PADT * 128; const bf16* MVg = (const bf16*)(F.ws + WS_MV) + (size_t)bh * PADT * 256;
  StageCW scw; StageRaw srk; StageVT svt; float li = -1e30f, lf = 0.f;
  issue_cw(F, a, h, scw); issue_raw(F, MKg, pos0, srk); issue_vt(F, MVg, pos0, svt);
  { const bool dead = pos0 + lane < MPOS0; if (w == 0 && !dead) { li = ((const float*)(F.ws + WS_LI))[bh * PADT + pos0 + lane]; lf = ((const float*)(F.ws + WS_LF))[bh * PADT + pos0 + lane]; } }
  __syncthreads();
  commit_cw(F, scw); commit_raw(F, L_RK, srk); commit_vt(F, svt);
  if (w == 0) {
    float bs = lf;
#pragma unroll
    for (int d = 1; d < 64; d <<= 1) { const float o = shfl_up_f(bs, d); if (lane >= d) bs += o; }
    const float av = li - bs; float mx = av;
#pragma unroll
    for (int o = 1; o < 64; o <<= 1) mx = fmaxf(mx, __shfl_xor(mx, o));
    G[G_WG + lane] = __expf(av - mx);
    if (lane == 63) { float* gs = (float*)(F.ws + WS_GS) + (size_t)(bh * 33 + c) * 2; gs[0] = bs; gs[1] = mx; }
  }
  __syncthreads();
  { const int t = tid >> 3, d0 = (tid & 7) * 16; float y[16]; conv16(F, 1, L_RK, t, d0, y);
    const float sw = 0.08838834764831845f * G[G_WG + t]; LAS bf16* kt = (LAS bf16*)(lds + L_KWT) + d0 * TST + t;
#pragma unroll
    for (int e = 0; e < 16; ++e) kt[e * TST] = (bf16)f2bf(y[e] * sw); }
  __syncthreads();
  f32x4* DCg = (f32x4*)(F.ws + WS_DC) + ((size_t)(bh * 32 + c) * 128) * 64;
#pragma unroll
  for (int jj = 0; jj < 2; ++jj) { const int j = 2 * w + jj;
    const bf16x8 bv0 = *(const LAS bf16x8*)(lds + L_VT + ((16 * j + fr) * TST + 8 * kq) * 2), bv1 = *(const LAS bf16x8*)(lds + L_VT + ((16 * j + fr) * TST + 32 + 8 * kq) * 2);
#pragma unroll
    for (int i = 0; i < 8; ++i) { f32x4 acc = {0.f, 0.f, 0.f, 0.f};
      const bf16x8 k0 = *(const LAS bf16x8*)(lds + L_KWT + ((16 * i + fr) * TST + 8 * kq) * 2), k1 = *(const LAS bf16x8*)(lds + L_KWT + ((16 * i + fr) * TST + 32 + 8 * kq) * 2);
      acc = __builtin_amdgcn_mfma_f32_16x16x32_bf16(k0, bv0, acc, 0, 0, 0); acc = __builtin_amdgcn_mfma_f32_16x16x32_bf16(k1, bv1, acc, 0, 0, 0);
      DCg[(size_t)(i * 16 + j) * 64 + lane] = acc; } }
  if (tid < 128) { const LAS v4u* kr = (const LAS v4u*)(lds + L_KWT + tid * TST * 2); float s = 0.f;
#pragma unroll
    for (int q = 0; q < 8; ++q) { const v4u x = kr[q]; s += (bflo(x.x) + bfhi(x.x)) + (bflo(x.y) + bfhi(x.y)) + (bflo(x.z) + bfhi(x.z)) + (bflo(x.w) + bfhi(x.w)); }
    ((float*)(F.ws + WS_DN))[(size_t)(bh * 32 + c) * 128 + tid] = s; }
}

__device__ __forceinline__ void scanB(const Frame& F) {
  const float* GS = (const float*)(F.ws + WS_GS);
  LAS float* cf = (LAS float*)F.lds;
  for (int blk = blockIdx.x; blk < 16 * 16; blk += gridDim.x) { const int bh = blk >> 4, r = (blk & 15) * NTHR + F.tid, i = r >> 10, j = (r >> 6) & 15, ln = r & 63;
    __syncthreads();
    if (F.wave == 0) {
      const int c = F.lane & 31; const v2u gs = *(const v2u*)(GS + (size_t)(bh * 33 + c) * 2); const unsigned g0 = gs.x, g1 = gs.y;
      const float bL = __builtin_bit_cast(float, g0), ml = __builtin_bit_cast(float, g1);
      float mm = 0.f, fa = 0.f, fb = 0.f, mout = 0.f;
#pragma unroll
      for (int cc = 0; cc < 32; ++cc) { const float b_ = __builtin_bit_cast(float, __builtin_amdgcn_readlane(__builtin_bit_cast(int, bL), cc)), l_ = __builtin_bit_cast(float, __builtin_amdgcn_readlane(__builtin_bit_cast(int, ml), cc));
        const float me = fmaxf(mm, l_); if (c == cc) { fa = __expf(mm - me); fb = __expf(l_ - me); } mm = b_ + me; if (c == cc) mout = mm; }
      if (F.lane < 32) { cf[2 * c] = fa; cf[2 * c + 1] = fb; if ((blk & 15) == 0) ((float*)(F.ws + WS_MS))[bh * 33 + c + 1] = mout; }
    }
    __syncthreads();
    const f32x4* dc0 = (const f32x4*)(F.ws + WS_DC) + ((size_t)(bh * 32) * 128 + (i * 16 + j)) * 64 + ln;
    v2u* cs = (v2u*)(F.ws + WS_CS) + ((((size_t)bh * 33) * 8 + i) * 16 + j) * 64 + ln;
    f32x4 s0 = {0.f, 0.f, 0.f, 0.f}, dv[32];
#pragma unroll
    for (int c = 0; c < 32; ++c) dv[c] = dc0[(size_t)c * 128 * 64];
#pragma unroll
    for (int c = 0; c < 32; ++c) { const float fa = cf[2 * c], fb = cf[2 * c + 1];
      s0 = s0 * fa + dv[c] * fb;
      v2u o; o.x = pk2(s0.x, s0.y); o.y = pk2(s0.z, s0.w); cs[(size_t)(c + 1) * 8 * 16 * 64] = o; }
    if ((blk & 15) == 0 && F.tid < 128) {
      const float* dn = (const float*)(F.ws + WS_DN) + (size_t)(bh * 32) * 128 + F.tid; float* ns = (float*)(F.ws + WS_NS) + (size_t)(bh * 33) * 128 + F.tid; float n = 0.f;
      float dnv[32];
#pragma unroll
      for (int c = 0; c < 32; ++c) dnv[c] = dn[(size_t)c * 128];
#pragma unroll
      for (int c = 0; c < 32; ++c) { n = n * cf[2 * c] + dnv[c] * cf[2 * c + 1]; ns[(size_t)(c + 1) * 128] = n; }
    }
  }
}

__device__ __forceinline__ void taskC(const Frame& F, const Args& a, int task) {
  TP_BEGIN(31);
  const int bh = task >> 5, c = (task & 31) + 1, b = bh >> 2, h = bh & 3, tid = F.tid, w = F.wave, lane = F.lane, fr = lane & 15, kq = lane >> 4, pos0 = 64 * c;
  LAS unsigned char* lds = F.lds; LAS float* G = (LAS float*)(lds + L_G); LAS float* NV = (LAS float*)(lds + L_NV);
  const bf16* MQg = (const bf16*)(F.ws + WS_MQ) + (size_t)bh * PADT * 128; const bf16* MKg = (const bf16*)(F.ws + WS_MK) + (size_t)bh * PADT * 128;
  const bf16* MVg = (const bf16*)(F.ws + WS_MV) + (size_t)bh * PADT * 256;
  const float m = ((const float*)(F.ws + WS_MS))[bh * 33 + c];
  StageCW scw; StageRaw srq, srk; StageVT svt; float nvv = 0.f, li = 0.f, lf = 0.f;
  issue_cw(F, a, h, scw); issue_raw(F, MQg, pos0, srq); issue_raw(F, MKg, pos0, srk); issue_vt(F, MVg, pos0, svt);
  if (tid < 128) nvv = ((const float*)(F.ws + WS_NS))[(size_t)(bh * 33 + c) * 128 + tid];
  if (w == 0) { li = ((const float*)(F.ws + WS_LI))[bh * PADT + pos0 + lane]; lf = ((const float*)(F.ws + WS_LF))[bh * PADT + pos0 + lane]; }
  __syncthreads();
  commit_cw(F, scw); commit_raw(F, L_RQ, srq); commit_raw(F, L_RK, srk); commit_vt(F, svt);
  if (tid < 128) NV[tid] = nvv;
  if (w == 0) {
    float bs = lf;
#pragma unroll
    for (int d = 1; d < 64; d <<= 1) { const float o = shfl_up_f(bs, d); if (lane >= d) bs += o; }
    const float av = li - bs; float cm = av;
#pragma unroll
    for (int d = 1; d < 64; d <<= 1) { const float o = shfl_up_f(cm, d); if (lane >= d) cm = fmaxf(cm, o); }
    const float Mt = fmaxf(m, cm);
    G[G_A + lane] = av; G[G_M + lane] = Mt; G[G_WI + lane] = __expf(m - Mt); G[G_EM + lane] = __expf(-(bs + Mt));
  }
  __syncthreads(); TP_END(31, F.ws); TP_BEGIN(32);
  { const int t = tid >> 3, d0 = (tid & 7) * 16; const float wi = G[G_WI + t]; float y[16];
    conv16(F, 0, L_RQ, t, d0, y);
    { v4u o0, o1, w0, w1;
      o0.x = pk2(y[0], y[1]); o0.y = pk2(y[2], y[3]); o0.z = pk2(y[4], y[5]); o0.w = pk2(y[6], y[7]); o1.x = pk2(y[8], y[9]); o1.y = pk2(y[10], y[11]); o1.z = pk2(y[12], y[13]); o1.w = pk2(y[14], y[15]);
      w0.x = pk2(y[0] * wi, y[1] * wi); w0.y = pk2(y[2] * wi, y[3] * wi); w0.z = pk2(y[4] * wi, y[5] * wi); w0.w = pk2(y[6] * wi, y[7] * wi);
      w1.x = pk2(y[8] * wi, y[9] * wi); w1.y = pk2(y[10] * wi, y[11] * wi); w1.z = pk2(y[12] * wi, y[13] * wi); w1.w = pk2(y[14] * wi, y[15] * wi);
      LAS v4u* qs = (LAS v4u*)(lds + L_QS + (t * QST + d0) * 2); qs[0] = o0; qs[1] = o1;
      LAS v4u* qw = (LAS v4u*)(lds + L_QW + (t * QST + d0) * 2); qw[0] = w0; qw[1] = w1; }
    __builtin_amdgcn_sched_barrier(0);
    conv16(F, 1, L_RK, t, d0, y);
    { const float sc = 0.08838834764831845f; v4u o0, o1;
      o0.x = pk2(y[0] * sc, y[1] * sc); o0.y = pk2(y[2] * sc, y[3] * sc); o0.z = pk2(y[4] * sc, y[5] * sc); o0.w = pk2(y[6] * sc, y[7] * sc);
      o1.x = pk2(y[8] * sc, y[9] * sc); o1.y = pk2(y[10] * sc, y[11] * sc); o1.z = pk2(y[12] * sc, y[13] * sc); o1.w = pk2(y[14] * sc, y[15] * sc);
      LAS v4u* ks = (LAS v4u*)(lds + L_KS + (t * QST + d0) * 2); ks[0] = o0; ks[1] = o1; } }
  __syncthreads(); TP_END(32, F.ws); TP_BEGIN(33);
  v4u cb[4][2];
  { const v2u* cs = (const v2u*)(F.ws + WS_CS) + (((size_t)bh * 33 + c) * 8 * 16) * 64;
#pragma unroll
    for (int I = 0; I < 4; ++I)
#pragma unroll
      for (int jj = 0; jj < 2; ++jj) { const v2u lo_ = cs[(size_t)((2 * I) * 16 + 2 * w + jj) * 64 + lane], hi_ = cs[(size_t)((2 * I + 1) * 16 + 2 * w + jj) * 64 + lane]; cb[I][jj] = (v4u){lo_.x, lo_.y, hi_.x, hi_.y}; } }
  { const int si = w >> 1; const f32x4 as = *(const LAS f32x4*)(G + G_A + 16 * si + 4 * kq);
#pragma unroll
    for (int tt = 0; tt < 2; ++tt) { const int ti = 2 * (w & 1) + tt; f32x4 acc = {0.f, 0.f, 0.f, 0.f};
#pragma unroll
      for (int ks = 0; ks < 4; ++ks) { const bf16x8 af = *(const LAS bf16x8*)(lds + L_KS + ((16 * si + fr) * QST + 32 * ks + 8 * kq) * 2);
        const bf16x8 bfr = *(const LAS bf16x8*)(lds + L_QS + ((16 * ti + fr) * QST + 32 * ks + 8 * kq) * 2);
        acc = __builtin_amdgcn_mfma_f32_16x16x32_bf16(af, bfr, acc, 0, 0, 0); }
      const int t = 16 * ti + fr, s0 = 16 * si + 4 * kq; const float Mt = G[G_M + t];
      const float v0 = (s0 + 0 <= t) ? acc.x * __expf(as.x - Mt) : 0.f, v1 = (s0 + 1 <= t) ? acc.y * __expf(as.y - Mt) : 0.f;
      const float v2 = (s0 + 2 <= t) ? acc.z * __expf(as.z - Mt) : 0.f, v3 = (s0 + 3 <= t) ? acc.w * __expf(as.w - Mt) : 0.f;
      v2u o; o.x = pk2(v0, v1); o.y = pk2(v2, v3);
      *(LAS v2u*)(lds + L_SP + (t * TST + s0) * 2) = o; } }
  __syncthreads(); TP_END(33, F.ws); TP_BEGIN(34);
  if (w == 0) { const int t = lane; float qn = 0.f, rsum = 0.f;
#pragma unroll 4
    for (int q = 0; q < 16; ++q) { const v4u x = *(const LAS v4u*)(lds + L_QS + (t * QST + q * 8) * 2); const f32x4 n0 = *(const LAS f32x4*)(NV + q * 8), n1 = *(const LAS f32x4*)(NV + q * 8 + 4);
      qn += bflo(x.x) * n0.x + bfhi(x.x) * n0.y + bflo(x.y) * n0.z + bfhi(x.y) * n0.w + bflo(x.z) * n1.x + bfhi(x.z) * n1.y + bflo(x.w) * n1.z + bfhi(x.w) * n1.w; }
#pragma unroll
    for (int q = 0; q < 8; ++q) { const v4u x = *(const LAS v4u*)(lds + L_SP + (t * TST + q * 8) * 2); rsum += (bflo(x.x) + bfhi(x.x)) + (bflo(x.y) + bfhi(x.y)) + (bflo(x.z) + bfhi(x.z)) + (bflo(x.w) + bfhi(x.w)); }
    const float den = G[G_WI + t] * qn + rsum; G[G_DEN + t] = fmaxf(fabsf(den), G[G_EM + t]); }
  f32x4 acc[2][4];
#pragma unroll
  for (int jj = 0; jj < 2; ++jj)
#pragma unroll
    for (int ti = 0; ti < 4; ++ti) acc[jj][ti] = (f32x4){0.f, 0.f, 0.f, 0.f};
#pragma unroll
  for (int I = 0; I < 4; ++I) {
#pragma unroll
    for (int ti = 0; ti < 4; ++ti) { const LAS unsigned char* qp = lds + L_QW + ((16 * ti + fr) * QST + 32 * I + 4 * kq) * 2;
      const v2u a0 = *(const LAS v2u*)qp, a1 = *(const LAS v2u*)(qp + 32); const v4u av = {a0.x, a0.y, a1.x, a1.y};
      acc[0][ti] = __builtin_amdgcn_mfma_f32_16x16x32_bf16(__builtin_bit_cast(bf16x8, av), __builtin_bit_cast(bf16x8, cb[I][0]), acc[0][ti], 0, 0, 0);
      acc[1][ti] = __builtin_amdgcn_mfma_f32_16x16x32_bf16(__builtin_bit_cast(bf16x8, av), __builtin_bit_cast(bf16x8, cb[I][1]), acc[1][ti], 0, 0, 0); }
    __builtin_amdgcn_sched_barrier(0); }
#pragma unroll
  for (int ks = 0; ks < 2; ++ks) { const bf16x8 bv0 = *(const LAS bf16x8*)(lds + L_VT + ((32 * w + fr) * TST + 32 * ks + 8 * kq) * 2), bv1 = *(const LAS bf16x8*)(lds + L_VT + ((32 * w + 16 + fr) * TST + 32 * ks + 8 * kq) * 2);
#pragma unroll
    for (int ti = 0; ti < 4; ++ti) { const bf16x8 sf = *(const LAS bf16x8*)(lds + L_SP + ((16 * ti + fr) * TST + 32 * ks + 8 * kq) * 2);
      acc[0][ti] = __builtin_amdgcn_mfma_f32_16x16x32_bf16(sf, bv0, acc[0][ti], 0, 0, 0); acc[1][ti] = __builtin_amdgcn_mfma_f32_16x16x32_bf16(sf, bv1, acc[1][ti], 0, 0, 0); } }
  v4u mvp[4];
  { const int t_ = tid >> 3, c0_ = (tid & 7) * 32; const bf16* mo_ = (const bf16*)(F.ws + WS_MO) + ((size_t)b * SEQ + 64 * (c - 1) + t_) * 1024 + h * 256 + c0_;
#pragma unroll
    for (int q = 0; q < 4; ++q) mvp[q] = *(const v4u*)(mo_ + q * 8); }
  __syncthreads(); TP_END(34, F.ws); TP_BEGIN(35);
  LAS float* SSQ = (LAS float*)(lds + L_SSQ);
#pragma unroll
  for (int ti = 0; ti < 4; ++ti) { const f32x4 dn = *(const LAS f32x4*)(G + G_DEN + 16 * ti + 4 * kq);
    f32x4 s4;
#pragma unroll
    for (int r = 0; r < 4; ++r) { const float h0 = acc[0][ti][r] / dn[r], h1 = acc[1][ti][r] / dn[r]; acc[0][ti][r] = h0; acc[1][ti][r] = h1; s4[r] = h0 * h0 + h1 * h1; }
#pragma unroll
    for (int r = 0; r < 4; ++r) { float v = s4[r];
      v += __builtin_bit_cast(float, __builtin_amdgcn_update_dpp(0, __builtin_bit_cast(int, v), 0xB1, 0xF, 0xF, true)); v += __builtin_bit_cast(float, __builtin_amdgcn_update_dpp(0, __builtin_bit_cast(int, v), 0x4E, 0xF, 0xF, true));
      v += __builtin_bit_cast(float, __builtin_amdgcn_update_dpp(0, __builtin_bit_cast(int, v), 0x141, 0xF, 0xF, true)); v += __builtin_bit_cast(float, __builtin_amdgcn_update_dpp(0, __builtin_bit_cast(int, v), 0x140, 0xF, 0xF, true)); s4[r] = v; }
    if (fr == 0) { SSQ[(16 * ti + 4 * kq + 0) * 8 + w] = s4.x; SSQ[(16 * ti + 4 * kq + 1) * 8 + w] = s4.y; SSQ[(16 * ti + 4 * kq + 2) * 8 + w] = s4.z; SSQ[(16 * ti + 4 * kq + 3) * 8 + w] = s4.w; } }
  __syncthreads();
  LAS bf16* HT = (LAS bf16*)(lds + L_HT);
#pragma unroll
  for (int ti = 0; ti < 4; ++ti)
#pragma unroll
    for (int r = 0; r < 4; ++r) { const int t = 16 * ti + 4 * kq + r; const f32x4 p0 = *(const LAS f32x4*)(SSQ + t * 8), p1 = *(const LAS f32x4*)(SSQ + t * 8 + 4);
      const float rh = rsqrtf(((p0.x + p0.y) + (p0.z + p0.w) + (p1.x + p1.y) + (p1.z + p1.w)) * (1.0f / 256.f) + EPS);
      HT[t * 264 + 32 * w + fr] = (bf16)f2bf(acc[0][ti][r] * rh); HT[t * 264 + 32 * w + 16 + fr] = (bf16)f2bf(acc[1][ti][r] * rh); }
  __syncthreads(); TP_END(35, F.ws); TP_BEGIN(36);
  { const int t = tid >> 3, c0 = (tid & 7) * 32; const size_t R = (size_t)b * SEQ + 64 * (c - 1) + t;
    const float* og = a.in[IN_OUTG] + h * 256 + c0; bf16* A2 = (bf16*)(F.ws + WS_A2) + R * DM + 1024 + h * 256 + c0;
    f32x4 gg[8];
#pragma unroll
    for (int q = 0; q < 8; ++q) gg[q] = *(const f32x4*)(og + q * 4);
#pragma unroll
    for (int q = 0; q < 4; ++q) { const v4u hv = *(const LAS v4u*)(HT + t * 264 + c0 + q * 8); const v4u mv = mvp[q]; const f32x4 g0 = gg[2 * q], g1 = gg[2 * q + 1];
      v4u o; o.x = pk2(bflo(hv.x) * g0.x * sigmoidf_(bflo(mv.x)), bfhi(hv.x) * g0.y * sigmoidf_(bfhi(mv.x))); o.y = pk2(bflo(hv.y) * g0.z * sigmoidf_(bflo(mv.y)), bfhi(hv.y) * g0.w * sigmoidf_(bfhi(mv.y)));
      o.z = pk2(bflo(hv.z) * g1.x * sigmoidf_(bflo(mv.z)), bfhi(hv.z) * g1.y * sigmoidf_(bfhi(mv.z))); o.w = pk2(bflo(hv.w) * g1.z * sigmoidf_(bflo(mv.w)), bfhi(hv.w) * g1.w * sigmoidf_(bfhi(mv.w)));
      *(v4u*)(A2 + q * 8) = o; } }
  TP_END(36, F.ws);
}
}
struct CombRow { float mp[8][3], lp[8][3]; v4u op[8][3]; };
__device__ __forceinline__ float half_sum_dpp(float v, bool hi) {
  v += __builtin_bit_cast(float, __builtin_amdgcn_update_dpp(0, __builtin_bit_cast(int, v), 0xB1, 0xF, 0xF, true));
  v += __builtin_bit_cast(float, __builtin_amdgcn_update_dpp(0, __builtin_bit_cast(int, v), 0x4E, 0xF, 0xF, true));
  v += __builtin_bit_cast(float, __builtin_amdgcn_update_dpp(0, __builtin_bit_cast(int, v), 0x141, 0xF, 0xF, true));
  v += __builtin_bit_cast(float, __builtin_amdgcn_update_dpp(0, __builtin_bit_cast(int, v), 0x140, 0xF, 0xF, true));
  const float r0 = __builtin_bit_cast(float, __builtin_amdgcn_readlane(__builtin_bit_cast(int, v), 0)), r1 = __builtin_bit_cast(float, __builtin_amdgcn_readlane(__builtin_bit_cast(int, v), 16));
  const float r2 = __builtin_bit_cast(float, __builtin_amdgcn_readlane(__builtin_bit_cast(int, v), 32)), r3 = __builtin_bit_cast(float, __builtin_amdgcn_readlane(__builtin_bit_cast(int, v), 48));
  return hi ? r2 + r3 : r0 + r1;
}
__device__ __forceinline__ void comb_load(const bf16* PO, const float* ML, int R0, int NA, int lane, CombRow& cr) {
  const int b = R0 >> 11, t = R0 & 2047, qb = t >> 8, rq = (t & 255) + (lane >> 5), l32 = lane & 31;
#pragma unroll
  for (int hm = 0; hm < 8; ++hm) {
    const int bhm = b * 8 + hm, first = bhm * att::STEPS_BHM + att::qb_start(qb), last = first + 4 * qb + 4;
    const int cf = att::chunk_of(first, NA), np = att::chunk_of(last, NA) - cf + 1, slot0 = bhm * 16 + qb + cf - att::chunk_of(bhm * att::STEPS_BHM, NA);
#pragma unroll
    for (int p = 0; p < 3; ++p) { if (p < np) { const int slot = slot0 + p; const v2u ml = *(const v2u*)(ML + (size_t)slot * 512 + rq * 2);
        const unsigned mx_ = ml.x, my_ = ml.y; cr.mp[hm][p] = __builtin_bit_cast(float, mx_); cr.lp[hm][p] = __builtin_bit_cast(float, my_);
        cr.op[hm][p] = ((const v4u*)(PO + ((size_t)slot * 256 + rq) * 256))[l32]; } else { cr.mp[hm][p] = -1e30f; cr.lp[hm][p] = 0.f; cr.op[hm][p] = (v4u){0u, 0u, 0u, 0u}; } }
  }
}
__device__ __forceinline__ void comb_finish(bf16* A2, int R0, int lane, float lam, const f32x4 sg0, const f32x4 sg1, const CombRow& cr) {
  const bool hi = lane >= 32; const int l32 = lane & 31;
#pragma unroll
  for (int h = 0; h < 4; ++h) {
    float om[2][8];
#pragma unroll
    for (int m = 0; m < 2; ++m) { const int hm = h * 2 + m;
      const float M = fmaxf(cr.mp[hm][0], fmaxf(cr.mp[hm][1], cr.mp[hm][2]));
      float wsum = 0.f, acc[8];
#pragma unroll
      for (int i = 0; i < 8; ++i) acc[i] = 0.f;
#pragma unroll
      for (int p = 0; p < 3; ++p) { const float w = cr.lp[hm][p] * exp2f(cr.mp[hm][p] - M); wsum += w; const v4u ow = cr.op[hm][p];
#pragma unroll
        for (int i = 0; i < 4; ++i) { const unsigned wd = ow[i]; acc[2 * i] += bflo(wd) * w; acc[2 * i + 1] += bfhi(wd) * w; } }
      const float iw = 1.0f / wsum;
#pragma unroll
      for (int i = 0; i < 8; ++i) om[m][i] = acc[i] * iw;
    }
    float o[8], ss = 0.f;
#pragma unroll
    for (int i = 0; i < 8; ++i) { o[i] = om[0][i] - om[1][i] * lam; ss += o[i] * o[i]; }
    const float rs = rsqrtf(half_sum_dpp(ss, hi) * (1.0f / 256.f) + EPS) * 0.8f;
    v4u w; w.x = pk2(o[0] * rs * sg0.x, o[1] * rs * sg0.y); w.y = pk2(o[2] * rs * sg0.z, o[3] * rs * sg0.w); w.z = pk2(o[4] * rs * sg1.x, o[5] * rs * sg1.y); w.w = pk2(o[6] * rs * sg1.z, o[7] * rs * sg1.w);
    ((v4u*)(A2 + (size_t)(R0 + (hi ? 1 : 0)) * DM + h * 256))[l32] = w;
  }
}
__device__ __forceinline__ void p3_combine(const Frame& F, const Args& a, int NA) {
  const bf16* PO = (const bf16*)(F.ws + WS_PO); const float* ML = (const float*)(F.ws + WS_ML);
  bf16* A2 = (bf16*)(F.ws + WS_A2);
  const float lam = *(const float*)(F.ws + WS_LAM);
  const int gw = blockIdx.x * NWAVES + F.wave, NGW = gridDim.x * NWAVES, lane = F.lane;
  const f32x4 sg0 = ((const f32x4*)a.in[IN_SUBG])[2 * (lane & 31)], sg1 = ((const f32x4*)a.in[IN_SUBG])[2 * (lane & 31) + 1];
  for (int k = gw; k < MROWS / 4; k += NGW) {
#pragma unroll 1
    for (int s = 0; s < 2; ++s) { const int P = s ? MROWS / 2 - 1 - k : k;
      CombRow r0;
      comb_load(PO, ML, 2 * P, NA, lane, r0);
      comb_finish(A2, 2 * P, lane, lam, sg0, sg1, r0); }
  }
}
struct EpiRes {
  static constexpr bool PERM = true, AFTER_DRAIN = false;
  const float* x; float* out; bf16* H1b; float* SSQ;
  __device__ __forceinline__ void operator()(const pg8::f32x4 (&acc)[2][2][4][2], const pg8::Unit& u, int wr, int wc, int fr, int fq) const {
    const int row0 = u.pm * 256 + wr * 64 + fr, col0 = u.pn * 256 + wc * 32 + 8 * fq;
#pragma unroll
    for (int ai = 0; ai < 2; ++ai) {
      f32x4 xv[4][2][2];
#pragma unroll
      for (int m = 0; m < 4; ++m)
#pragma unroll
        for (int bj = 0; bj < 2; ++bj) { const size_t off = (size_t)(row0 + ai * 128 + m * 16) * DM + col0 + bj * 128; xv[m][bj][0] = *(const f32x4*)(x + off); xv[m][bj][1] = *(const f32x4*)(x + off + 4); }
#pragma unroll
      for (int m = 0; m < 4; ++m) { const size_t R = (size_t)(row0 + ai * 128 + m * 16); float s = 0.f;
#pragma unroll
        for (int bj = 0; bj < 2; ++bj) { const size_t off = R * DM + col0 + bj * 128;
          const f32x4 v0 = acc[ai][bj][m][0] + xv[m][bj][0], v1 = acc[ai][bj][m][1] + xv[m][bj][1];
          v4u w; w.x = pk2(v0.x, v0.y); w.y = pk2(v0.z, v0.w); w.z = pk2(v1.x, v1.y); w.w = pk2(v1.z, v1.w);
          *(v4u*)(H1b + off) = w;
          s += (v0.x * v0.x + v0.y * v0.y) + (v0.z * v0.z + v0.w * v0.w) + (v1.x * v1.x + v1.y * v1.y) + (v1.z * v1.z + v1.w * v1.w); }
        s += __shfl_xor(s, 16); s += __shfl_xor(s, 32);
        if (fq == 0) SSQ[R * 32 + u.pn * 4 + wc] = s; }
    }
  }
};
#ifndef PEER_U_FP8
#define PEER_U_FP8 0
#endif
typedef __bf16 bfv2 __attribute__((ext_vector_type(2)));
__device__ __forceinline__ void split_hl(const f32x4 a, const f32x4 b, bf16x8& hi, bf16x8& lo) {
  float v[8] = {a.x, a.y, a.z, a.w, b.x, b.y, b.z, b.w}; unsigned h[8], l[8];
#pragma unroll
  for (int i = 0; i < 8; ++i) { h[i] = f2bf(v[i]); l[i] = f2bf(v[i] - __builtin_bit_cast(float, h[i] << 16)); }
  v4u hv = {h[0] | (h[1] << 16), h[2] | (h[3] << 16), h[4] | (h[5] << 16), h[6] | (h[7] << 16)};
  v4u lv = {l[0] | (l[1] << 16), l[2] | (l[3] << 16), l[4] | (l[5] << 16), l[6] | (l[7] << 16)};
  hi = __builtin_bit_cast(bf16x8, hv); lo = __builtin_bit_cast(bf16x8, lv);
}
__device__ __forceinline__ void p0_w3t(const Frame& F, const Args& a) {
  const float* wq = a.in[IN_WQ]; const float* sk = a.in[IN_SUBK]; const float* g2 = a.in[IN_G2];
  bf16* W3t = (bf16*)(F.ws + WS_W3T);
  const int lane = F.lane, fr = lane & 15, fq = lane >> 4;
  constexpr int SKS = 272;
  LAS unsigned char* shi = F.lds; LAS unsigned char* slo = F.lds + 128 * SKS;
  for (int bt = blockIdx.x; bt < 256; bt += gridDim.x) {
    const int hh = bt & 15, kt = (bt >> 4) * 8 + F.wave;
    const float* ap = wq + (size_t)(kt * 16 + fr) * DM + hh * 128 + fq * 8;
    f32x4 a0[4], a1[4];
#pragma unroll
    for (int s = 0; s < 4; ++s) { a0[s] = *(const f32x4*)(ap + 32 * s); a1[s] = *(const f32x4*)(ap + 32 * s + 4); }
    const f32x4 gk = *(const f32x4*)(g2 + kt * 16 + fq * 4);
    __syncthreads();
#pragma unroll
    for (int i = 0; i < 4; ++i) { const int idx = F.tid + NTHR * i, key = idx >> 4, c8 = idx & 15; const float* p = sk + (size_t)(hh * 128 + key) * 128 + c8 * 8;
      bf16x8 h, l; split_hl(*(const f32x4*)p, *(const f32x4*)(p + 4), h, l);
      *(LAS bf16x8*)(shi + key * SKS + c8 * 16) = h; *(LAS bf16x8*)(slo + key * SKS + c8 * 16) = l; }
    bf16x8 ahi[4], alo[4];
#pragma unroll
    for (int s = 0; s < 4; ++s) split_hl(a0[s], a1[s], ahi[s], alo[s]);
    __syncthreads();
#pragma unroll 2
    for (int t2 = 0; t2 < 8; ++t2) {
      const LAS unsigned char* bh = shi + (t2 * 16 + fr) * SKS + fq * 16; const LAS unsigned char* bl = slo + (t2 * 16 + fr) * SKS + fq * 16;
      f32x4 acc = {0.f, 0.f, 0.f, 0.f};
#pragma unroll
      for (int s = 0; s < 4; ++s) { const bf16x8 bhi = *(const LAS bf16x8*)(bh + 64 * s), blo = *(const LAS bf16x8*)(bl + 64 * s);
        acc = __builtin_amdgcn_mfma_f32_16x16x32_bf16(ahi[s], bhi, acc, 0, 0, 0);
        acc = __builtin_amdgcn_mfma_f32_16x16x32_bf16(ahi[s], blo, acc, 0, 0, 0);
        acc = __builtin_amdgcn_mfma_f32_16x16x32_bf16(alo[s], bhi, acc, 0, 0, 0); }
      v2u o; o.x = pk2(acc.x * gk.x, acc.y * gk.y); o.y = pk2(acc.z * gk.z, acc.w * gk.w);
      *(v2u*)(W3t + (size_t)(hh * 128 + t2 * 16 + fr) * DM + kt * 16 + fq * 4) = o;
    }
  }
  __syncthreads();
}
typedef float f32x2v __attribute__((ext_vector_type(2)));
__device__ __forceinline__ void p0_tables(const Frame& F, const Args& a) {
  const float* g2 = a.in[IN_G2];
  float* SCL = (float*)(F.ws + WS_SCL);
  const int gw = blockIdx.x * NWAVES + F.wave, NGW = gridDim.x * NWAVES, lane = F.lane;
  f32x4 gl[8];
#pragma unroll
  for (int q = 0; q < 8; ++q) gl[q] = *(const f32x4*)(g2 + q * 256 + lane * 4);
  f32x4 xn[8];
  { const int row = gw; if (row < 2 * 16384) { const float* src = a.in[row >= 16384 ? IN_V : IN_U] + (size_t)(row & 16383) * DM + lane * 4;
#pragma unroll
      for (int q = 0; q < 8; ++q) xn[q] = *(const f32x4*)(src + q * 256); } }
  for (int row = gw; row < 2 * 16384; row += NGW) {
    const bool isv = row >= 16384; const int e = row & 16383;
    f32x4 x[8];
#pragma unroll
    for (int q = 0; q < 8; ++q) x[q] = xn[q];
    { const int rn = row + NGW; if (rn < 2 * 16384) { const float* src = a.in[rn >= 16384 ? IN_V : IN_U] + (size_t)(rn & 16383) * DM + lane * 4;
#pragma unroll
        for (int q = 0; q < 8; ++q) xn[q] = *(const f32x4*)(src + q * 256); } }
    float amax = 0.f, ssq = 0.f;
#pragma unroll
    for (int q = 0; q < 8; ++q) { if (!isv) x[q] = x[q] * gl[q]; amax = fmaxf(amax, fmaxf(fmaxf(fabsf(x[q].x), fabsf(x[q].y)), fmaxf(fabsf(x[q].z), fabsf(x[q].w))));
      ssq += (x[q].x * x[q].x + x[q].y * x[q].y) + (x[q].z * x[q].z + x[q].w * x[q].w); }
#pragma unroll
    for (int o = 1; o < 64; o <<= 1) amax = fmaxf(amax, __shfl_xor(amax, o));
    v4u w;
    if (isv) {
      const float sc = amax > 0.f ? 6.0f / amax : 1.0f;
#pragma unroll
      for (int d = 0; d < 4; ++d) { unsigned pk = 0u;
        pk = __builtin_amdgcn_cvt_scalef32_pk_fp4_f32(pk, x[2 * d].x * sc, x[2 * d].y * sc, 1.0f, 0); pk = __builtin_amdgcn_cvt_scalef32_pk_fp4_f32(pk, x[2 * d].z * sc, x[2 * d].w * sc, 1.0f, 1);
        pk = __builtin_amdgcn_cvt_scalef32_pk_fp4_f32(pk, x[2 * d + 1].x * sc, x[2 * d + 1].y * sc, 1.0f, 2); pk = __builtin_amdgcn_cvt_scalef32_pk_fp4_f32(pk, x[2 * d + 1].z * sc, x[2 * d + 1].w * sc, 1.0f, 3);
        w[d] = pk; }
      if (lane == 0) SCL[row] = 1.0f / sc;
    } else {
      ssq = wave_sum_dpp(ssq);
      const float sA = amax > 0.f ? amax * (1.0f / 7.0f) : 1.0f, sB = fminf(sA, 0.36f * sqrtf(ssq * (1.0f / DM)) + 1e-30f);
      const float iA = 1.0f / sA, iB = 1.0f / sB;
      float eA = 0.f, eB = 0.f;
#pragma unroll
      for (int q = 0; q < 8; ++q)
#pragma unroll
        for (int j = 0; j < 4; ++j) { const float v = x[q][j];
          const float da = v - sA * __builtin_amdgcn_fmed3f(__builtin_rintf(v * iA), -7.0f, 7.0f), db = v - sB * __builtin_amdgcn_fmed3f(__builtin_rintf(v * iB), -7.0f, 7.0f);
          eA += da * da; eB += db * db; }
      eA = wave_sum_dpp(eA); eB = wave_sum_dpp(eB);
      const bool useB = eB < eA; const float st = useB ? sB : sA, is = useB ? iB : iA;
#pragma unroll
      for (int d = 0; d < 4; ++d) { unsigned pk = 0u;
#pragma unroll
        for (int p = 0; p < 8; ++p) { const float v = x[2 * d + (p >> 2)][p & 3]; const int qi = (int)__builtin_amdgcn_fmed3f(__builtin_rintf(v * is), -7.0f, 7.0f); pk |= ((unsigned)qi & 15u) << (4 * p); }
        w[d] = pk; }
      if (lane == 0) SCL[row] = st;
    }
    *(v4u*)(F.ws + (isv ? WS_VB8 : WS_UB) + (size_t)e * 1024 + lane * 16) = w;
  }
}
struct EpiScore {
  static constexpr bool PERM = true, AFTER_DRAIN = false;
  float* S; const LAS float* rs;
  __device__ __forceinline__ void operator()(const pg8::f32x4 (&acc)[2][2][4][2], const pg8::Unit& u, int wr, int wc, int fr, int fq) const {
    const int rl0 = wr * 64 + fr, keyb = wc * 32 + 8 * fq;
#pragma unroll
    for (int ai = 0; ai < 2; ++ai)
#pragma unroll
      for (int m = 0; m < 4; ++m) { const int rl = rl0 + ai * 128 + m * 16; const float r = rs[rl]; const int row = u.pm * 256 + rl;
#pragma unroll
        for (int bj = 0; bj < 2; ++bj) { float* d = S + ((size_t)((row >> 5) * 16 + u.pn * 2 + bj) * 128 + keyb) * 32 + (row & 31);
          const pg8::f32x4 v0 = acc[ai][bj][m][0] * r, v1 = acc[ai][bj][m][1] * r;
          d[0] = v0[0]; d[32] = v0[1]; d[64] = v0[2]; d[96] = v0[3]; d[128] = v1[0]; d[160] = v1[1]; d[192] = v1[2]; d[224] = v1[3]; } }
  }
};

__device__ __forceinline__ unsigned fkey(float f) { const unsigned b = __builtin_bit_cast(unsigned, f); return b ^ ((b >> 31) ? 0xFFFFFFFFu : 0x80000000u); }
template <int NV, int K> __device__ __forceinline__ void wave_topk(const unsigned (&u)[NV], bool (&sel)[NV], int lane) {
  unsigned prefix = 0u; int cge = NV * 64;
#pragma unroll 1
  for (int bit = 31; bit >= 0 && cge != K; --bit) {
    const unsigned cand = prefix | (1u << bit); int c = 0;
#pragma unroll
    for (int i = 0; i < NV; ++i) c += __builtin_popcountll(__ballot(u[i] >= cand));
    if (c >= K) { prefix = cand; cge = c; }
  }
  int cgt = 0;
#pragma unroll
  for (int i = 0; i < NV; ++i) cgt += __builtin_popcountll(__ballot(u[i] > prefix));
  int need = K - cgt;
  const unsigned long long lm = (1ull << lane) - 1ull;
#pragma unroll
  for (int i = 0; i < NV; ++i) { const unsigned long long eq = __ballot(u[i] == prefix); const int before = __builtin_popcountll(eq & lm);
    sel[i] = (u[i] > prefix) || (u[i] == prefix && before < need); const int ne = __builtin_popcountll(eq); need = need > ne ? need - ne : 0; }
}
template <int NG, int NV, int K> __device__ __forceinline__ void wave_topk_multi(const unsigned (&u)[NG][NV], bool (&sel)[NG][NV], int lane) {
  unsigned prefix[NG]; int cge[NG];
#pragma unroll
  for (int g = 0; g < NG; ++g) { prefix[g] = 0u; cge[g] = NV * 64; }
#pragma unroll 1
  for (int bit = 31; bit >= 0; --bit) {
    bool done = true;
#pragma unroll
    for (int g = 0; g < NG; ++g) done = done && (cge[g] == K);
    if (done) break;
#pragma unroll
    for (int g = 0; g < NG; ++g) { const unsigned cand = prefix[g] | (1u << bit); int c = 0;
#pragma unroll
      for (int i = 0; i < NV; ++i) c += __builtin_popcountll(__ballot(u[g][i] >= cand));
      if (cge[g] != K && c >= K) { prefix[g] = cand; cge[g] = c; } }
  }
  const unsigned long long lm = (1ull << lane) - 1ull;
#pragma unroll
  for (int g = 0; g < NG; ++g) { int cgt = 0;
#pragma unroll
    for (int i = 0; i < NV; ++i) cgt += __builtin_popcountll(__ballot(u[g][i] > prefix[g]));
    int need = K - cgt;
#pragma unroll
    for (int i = 0; i < NV; ++i) { const unsigned long long eq = __ballot(u[g][i] == prefix[g]); const int before = __builtin_popcountll(eq & lm);
      sel[g][i] = (u[g][i] > prefix[g]) || (u[g][i] == prefix[g] && before < need); const int ne = __builtin_popcountll(eq); need = need > ne ? need - ne : 0; } }
}
__device__ __forceinline__ float gelu_erf(float v) {
  const float av = fabsf(v), t = __builtin_amdgcn_rcpf(1.0f + 0.2316418882f * av);
  float q = t * 0.5307027145f - 0.7265760135f; q = q * t + 0.7107068705f; q = q * t - 0.142248368f; q = q * t + 0.127414796f; q = q * t;
  const float tail = q * __builtin_amdgcn_exp2f(v * v * -0.72134752044f);
  return v < 0.f ? v * tail : v - v * tail;
}

#ifndef ROUTE_REPS
#define ROUTE_REPS 1
#endif
__device__ __forceinline__ void ins16(float (&t)[16], float x) {
#pragma unroll
  for (int i = 15; i >= 1; --i) t[i] = __builtin_amdgcn_fmed3f(t[i - 1], t[i], x);
  t[0] = fmaxf(t[0], x);
}
__device__ __forceinline__ void p6_peer(const Frame& F, const Args& a, float* dst_base) {
  const float* S2 = (const float*)(F.ws + WS_S); const float* SSQ = (const float*)(F.ws + WS_SSQ); const bf16* H1b = (const bf16*)(F.ws + WS_H1B);
  int lane = F.lane, wv = F.wave, tid = F.tid; asm volatile("" : "+v"(lane), "+s"(wv), "+v"(tid));
  int* EIDg = (int*)(F.ws + WS_EID); float* EGTg = (float*)(F.ws + WS_EGT);
  LAS int* eid = (LAS int*)(F.lds + wv * 8192); LAS float* cg = (LAS float*)(eid + 512); LAS float* esu = (LAS float*)(eid + 1024); LAS float* dq = (LAS float*)(eid + 1536);
  LAS unsigned char* RB = F.lds + 65536 + wv * 8192;
  LAS float* L1 = (LAS float*)(F.lds + 65536);
  TP_BEGIN(11);
#ifdef TPROBE
  const unsigned long long tp_p7_ = __builtin_amdgcn_s_memrealtime();
#endif
  for (int tb = blockIdx.x; tb < MROWS / 32; tb += gridDim.x) {
    __syncthreads();
    {
      const int g = tid >> 5, tl = tid & 31; const float* src = S2 + ((size_t)(tb * 16 + g) * 128) * 32 + tl;
      float t[16];
#pragma unroll
      for (int i = 0; i < 16; ++i) t[i] = -INFINITY;
      float sv[128];
#pragma unroll
      for (int k = 0; k < 128; ++k) sv[k] = src[k * 32];
#pragma unroll
      for (int k = 0; k < 128; ++k) ins16(t, __builtin_bit_cast(float, (__builtin_bit_cast(unsigned, sv[k]) & ~0x7Fu) | (unsigned)(127 - k)));
#pragma unroll
      for (int i = 0; i < 16; ++i) L1[(g * 16 + i) * 32 + tl] = t[i];
    }
    __syncthreads();
    if (tid < 256) {
      const int h8 = tid >> 5, tl = tid & 31; const LAS float* LA = L1 + ((2 * h8) * 16) * 32 + tl; const LAS float* LB = L1 + ((2 * h8 + 1) * 16) * 32 + tl;
      float A[16], B[16], t[16];
#pragma unroll
      for (int i = 0; i < 16; ++i) { A[i] = LA[i * 32]; B[i] = LB[i * 32]; t[i] = -INFINITY; }
#pragma unroll
      for (int i = 0; i < 16; ++i)
#pragma unroll
        for (int j = 0; j < 16; ++j) if ((i + 1) * (j + 1) <= 16) { const float c = A[i] + B[j];
            ins16(t, __builtin_bit_cast(float, (__builtin_bit_cast(unsigned, c) & ~0xFFu) | (unsigned)(255 - (i * 16 + j)))); }
      float ev[16], es = 0.f;
#pragma unroll
      for (int r = 0; r < 16; ++r) { ev[r] = __expf(t[r] - t[0]); es += ev[r]; }
      const float inv = 1.0f / es;
#pragma unroll
      for (int r = 0; r < 16; ++r) { const unsigned flat = 255u - (__builtin_bit_cast(unsigned, t[r]) & 0xFFu), ii = flat >> 4, jj = flat & 15u;
        const unsigned ka = 127u - (__builtin_bit_cast(unsigned, LA[ii * 32]) & 0x7Fu), kb = 127u - (__builtin_bit_cast(unsigned, LB[jj * 32]) & 0x7Fu);
        EIDg[(size_t)(tb * 32 + tl) * 128 + h8 * 16 + r] = (int)(ka * 128u + kb); EGTg[(size_t)(tb * 32 + tl) * 128 + h8 * 16 + r] = ev[r] * inv; }
    }
    asm volatile("s_waitcnt vmcnt(0)" ::: "memory"); __syncthreads();
    TP_END(11, F.ws);
    const unsigned char* U8 = F.ws + WS_UB; const unsigned char* V8 = F.ws + WS_VB8;
    constexpr int NBT = 2;
#define PG_ISSUE(TAB, E) do { const int idq_ = __builtin_amdgcn_readfirstlane(eidt[(E)]); \
      __builtin_amdgcn_global_load_lds((const unsigned*)((TAB) + (size_t)idq_ * 1024 + lane * 16), (LAS unsigned*)(RB + ((E) & 7) * 1024), 16, 0, 0); } while (0)
#pragma unroll 1
    for (int hh = 0; hh < 2; ++hh) {
#pragma unroll 1
    for (int tt = 0; tt < 4; ++tt) {
      const int tok = tb * 32 + wv * 4 + tt, e0 = 64 * hh;
      LAS int* eidt = eid + tt * 128; LAS float* cgt = cg + tt * 128; LAS float* esut = esu + tt * 128; LAS int* dqi = (LAS int*)dq + tt * 128;
      const float rs = rsqrtf(wave_sum_dpp(lane < 32 ? SSQ[(size_t)tok * 32 + lane] : 0.f) * (1.0f / DM) + EPS);
      if (hh == 0) {
        const float* SCL = (const float*)(F.ws + WS_SCL);
        const int id0 = __builtin_nontemporal_load(EIDg + (size_t)tok * 128 + lane), id1 = __builtin_nontemporal_load(EIDg + (size_t)tok * 128 + lane + 64);
        const float g0_ = __builtin_nontemporal_load(EGTg + (size_t)tok * 128 + lane), g1_ = __builtin_nontemporal_load(EGTg + (size_t)tok * 128 + lane + 64);
        const float su0 = SCL[id0], su1 = SCL[id1], sv0 = SCL[16384 + id0], sv1 = SCL[16384 + id1];
        const bool lo0 = id0 < 8192, lo1 = id1 < 8192;
        const unsigned long long m0 = __ballot(lo0), m1 = __ballot(lo1), lt = (1ull << lane) - 1ull;
        const int n0 = __builtin_popcountll(m0), nlo = n0 + __builtin_popcountll(m1);
        const int p0 = lo0 ? __builtin_popcountll(m0 & lt) : nlo + __builtin_popcountll(~m0 & lt);
        const int p1 = lo1 ? n0 + __builtin_popcountll(m1 & lt) : nlo + (64 - n0) + __builtin_popcountll(~m1 & lt);
        eidt[p0] = id0; esut[p0] = su0; cgt[p0] = g0_ * sv0; eidt[p1] = id1; esut[p1] = su1; cgt[p1] = g1_ * sv1; }
      unsigned xw[16];
      { const bf16* xp = H1b + (size_t)tok * DM + (size_t)lane * 4;
#pragma unroll
        for (int q = 0; q < 8; ++q) { const v2u x0 = *(const v2u*)(xp + q * 256); xw[2 * q] = x0.x; xw[2 * q + 1] = x0.y; } }
      int xl[4], xh[4]; float rsx;
      { float xa = 0.f;
#pragma unroll
        for (int i = 0; i < 16; ++i) xa = fmaxf(xa, fmaxf(fabsf(bflo(xw[i])), fabsf(bfhi(xw[i]))));
#pragma unroll
        for (int o = 1; o < 64; o <<= 1) xa = fmaxf(xa, __shfl_xor(xa, o));
        const float xinv = xa > 0.f ? 119.0f / xa : 0.f; rsx = rs * (xa > 0.f ? xa * (1.0f / 119.0f) : 0.f);
#pragma unroll
        for (int d = 0; d < 4; ++d) { unsigned pl = 0u, ph = 0u;
#pragma unroll
          for (int p = 0; p < 8; ++p) { const int i = 8 * d + p; const float v = (i & 1) ? bfhi(xw[i >> 1]) : bflo(xw[i >> 1]);
            const int xi = (int)__builtin_rintf(v * xinv), l = ((xi + 8) & 15) - 8, h = (xi - l) >> 4;
            pl |= ((unsigned)l & 15u) << (4 * p); ph |= ((unsigned)h & 15u) << (4 * p); }
          xl[d] = (int)pl; xh[d] = (int)ph; } }
      asm volatile("s_waitcnt vmcnt(0) lgkmcnt(0)" ::: "memory");
#define DPPI(X, CTRL) __builtin_amdgcn_update_dpp(0, (X), (CTRL), 0xF, 0xF, true)
#define PU_BATCH(E0, DOISSUE) do { v4u ub[4]; \
        _Pragma("unroll") for (int q = 0; q < 4; ++q) ub[q] = *(const LAS v4u*)(RB + (((E0) + q) & 7) * 1024 + lane * 16); \
        asm volatile("s_waitcnt lgkmcnt(0)" ::: "memory"); \
        if (DOISSUE) { _Pragma("unroll") for (int q = 0; q < 4; ++q) PG_ISSUE(U8, (E0) + 8 + q); } \
        int a_[4]; _Pragma("unroll") for (int q = 0; q < 4; ++q) { int al_ = 0, ah_ = 0; _Pragma("unroll") for (int dd = 0; dd < 4; ++dd) { const int wa = (int)ub[q][dd]; \
            al_ = __builtin_amdgcn_sdot8(wa, xl[dd], al_, false); ah_ = __builtin_amdgcn_sdot8(wa, xh[dd], ah_, false); } a_[q] = ah_ * 16 + al_; } \
        const int r01_ = (o1 ? a_[1] : a_[0]) + DPPI(o1 ? a_[0] : a_[1], 0xB1), r23_ = (o1 ? a_[3] : a_[2]) + DPPI(o1 ? a_[2] : a_[3], 0xB1); \
        int r_ = (o2 ? r23_ : r01_) + DPPI(o2 ? r01_ : r23_, 0x4E); \
        r_ += DPPI(r_, 0x124); r_ += DPPI(r_, 0x128); \
        { auto s_ = __builtin_amdgcn_permlane16_swap((unsigned)r_, (unsigned)r_, false, false); const unsigned s0_ = s_[0], s1_ = s_[1]; r_ = (int)(s0_ + s1_); } \
        { auto s_ = __builtin_amdgcn_permlane32_swap((unsigned)r_, (unsigned)r_, false, false); const unsigned s0_ = s_[0], s1_ = s_[1]; r_ = (int)(s0_ + s1_); } \
        if (lane < 4) dqi[(E0) + lane] = r_; } while (0)
      const bool o1 = (lane & 1) != 0, o2 = (lane & 2) != 0;
#pragma unroll
      for (int e = 0; e < 8; ++e) PG_ISSUE(U8, e0 + e);
#pragma unroll 1
      for (int e = e0; e < e0 + 56; e += 4) {
        asm volatile("s_waitcnt vmcnt(4)" ::: "memory");
        PU_BATCH(e, true);
        asm volatile("" ::: "memory");
      }
      asm volatile("s_waitcnt vmcnt(0)" ::: "memory");
#pragma unroll 1
      for (int e = e0 + 56; e < e0 + 64; e += 4) PU_BATCH(e, false);
      asm volatile("s_waitcnt lgkmcnt(0)" ::: "memory");
      if (hh == 1) {
#pragma unroll
        for (int i = 0; i < 2; ++i) { const int e = lane + 64 * i; cgt[e] = gelu_erf((float)dqi[e] * (rsx * esut[e])) * cgt[e]; } }
      asm volatile("s_waitcnt lgkmcnt(0)" ::: "memory");
#undef DPPI
#undef PU_BATCH
    }
    }
#pragma unroll 1
    for (int tt = 0; tt < 4; ++tt) {
      const int tok = tb * 32 + wv * 4 + tt;
      LAS int* eidt = eid + tt * 128; LAS float* cgt = cg + tt * 128;
      float y[32];
#pragma unroll
      for (int i = 0; i < 32; ++i) y[i] = 0.f;
#define PV_BATCH(E0, DOISSUE) do { v4u vb[NBT]; float c_[NBT]; \
        _Pragma("unroll") for (int q = 0; q < NBT; ++q) { vb[q] = *(const LAS v4u*)(RB + (((E0) + q) & 7) * 1024 + lane * 16); c_[q] = cgt[(E0) + q]; } \
        asm volatile("s_waitcnt lgkmcnt(0)" ::: "memory"); \
        if (DOISSUE) { _Pragma("unroll") for (int q = 0; q < NBT; ++q) PG_ISSUE(V8, (E0) + 8 + q); } \
        _Pragma("unroll") for (int q = 0; q < NBT; ++q) { _Pragma("unroll") for (int dd = 0; dd < 4; ++dd) { const unsigned wa = vb[q][dd]; \
            { const f32x2v v2 = __builtin_amdgcn_cvt_scalef32_pk_f32_fp4(wa, 1.0f, 0); y[8 * dd + 0] += c_[q] * v2.x; y[8 * dd + 1] += c_[q] * v2.y; } \
            { const f32x2v v2 = __builtin_amdgcn_cvt_scalef32_pk_f32_fp4(wa, 1.0f, 1); y[8 * dd + 2] += c_[q] * v2.x; y[8 * dd + 3] += c_[q] * v2.y; } \
            { const f32x2v v2 = __builtin_amdgcn_cvt_scalef32_pk_f32_fp4(wa, 1.0f, 2); y[8 * dd + 4] += c_[q] * v2.x; y[8 * dd + 5] += c_[q] * v2.y; } \
            { const f32x2v v2 = __builtin_amdgcn_cvt_scalef32_pk_f32_fp4(wa, 1.0f, 3); y[8 * dd + 6] += c_[q] * v2.x; y[8 * dd + 7] += c_[q] * v2.y; } } \
          __builtin_amdgcn_sched_barrier(0); } } while (0)
#pragma unroll
      for (int e = 0; e < 8; ++e) PG_ISSUE(V8, e);
#pragma unroll 1
      for (int e = 0; e < 120; e += NBT) {
        asm volatile("s_waitcnt vmcnt(6)" ::: "memory");
        PV_BATCH(e, true);
        asm volatile("" ::: "memory");
      }
      asm volatile("s_waitcnt vmcnt(0)" ::: "memory");
      unsigned xw[16];
      { const bf16* xp = H1b + (size_t)tok * DM + (size_t)lane * 4;
#pragma unroll
        for (int q = 0; q < 8; ++q) { const v2u x0 = *(const v2u*)(xp + q * 256); xw[2 * q] = x0.x; xw[2 * q + 1] = x0.y; } }
#pragma unroll 1
      for (int e = 120; e < 128; e += NBT) PV_BATCH(e, false);
      asm volatile("s_waitcnt lgkmcnt(0)" ::: "memory");
#undef PV_BATCH
      float* drow = dst_base + (size_t)tok * DM;
#pragma unroll
      for (int q = 0; q < 8; ++q) { const size_t off = (size_t)q * 256 + lane * 4; f32x4 hv;
        hv.x = bflo(xw[2 * q]) + y[4 * q];
#ifdef TPROBE
        if (TPROBE != 13 && tok == 0 && lane == 0 && q == 0) hv.x += 10.0f + (float)(*(volatile unsigned*)(F.ws + 64)) * (0.01f / TP_DIV);
        if (TPROBE == 13 && (int)blockIdx.x == TP_BLOCK && wv == 7 && tt == 3 && lane == 0 && q == 0) hv.x += 10.0f + (float)(unsigned)(__builtin_amdgcn_s_memrealtime() - tp_p7_) * (0.01f / TP_DIV);
#endif
        hv.y = bfhi(xw[2 * q]) + y[4 * q + 1]; hv.z = bflo(xw[2 * q + 1]) + y[4 * q + 2]; hv.w = bfhi(xw[2 * q + 1]) + y[4 * q + 3]; __builtin_nontemporal_store(hv, (f32x4*)(drow + off)); }
    }
#undef PG_ISSUE
  }
}
constexpr int MISC_LDS = LDS_BYTES - 256;
__global__ void __launch_bounds__(NTHR, 2) mk_fwd(Args args) {
  extern __shared__ __attribute__((aligned(16))) unsigned char lds_raw[];
  Frame F; F.lds = (LAS unsigned char*)lds_raw; F.ws = args.ws; F.tid = threadIdx.x; F.lane = F.tid & 63; F.wave = __builtin_amdgcn_readfirstlane(F.tid >> 6);
  const int lo = args.ph_lo, hi = args.ph_hi, G = (int)gridDim.x, bx = (int)blockIdx.x;
  volatile LAS unsigned* misc = (volatile LAS unsigned*)(F.lds + MISC_LDS);
  if (F.tid < 16) misc[F.tid] = 0u;
  __syncthreads();
  XcdBarrier bar = xcd_barrier_post((unsigned*)(F.ws + WS_CTL) + CW_BAR, misc);
#define IN(k) (lo <= (k) && (k) < hi)
#ifdef TPROBE
#define SEAM(k) do { if (IN(k) && IN((k) + 1)) { const unsigned long long tq0_ = __builtin_amdgcn_s_memrealtime(); xcd_barrier(bar); const unsigned long long tq1_ = __builtin_amdgcn_s_memrealtime(); \
    if (TPROBE == 20 + (k) && (int)blockIdx.x == TP_BLOCK && threadIdx.x == 0) atomicAdd((unsigned*)(F.ws + 64), (unsigned)(tq1_ - tq0_)); } } while (0)
#else
#define SEAM(k) do { if (IN(k) && IN((k) + 1)) xcd_barrier(bar); } while (0)
#endif
#define PHASE_FRAME(Fp) Frame Fp = F; asm volatile("" : "+v"(Fp.tid), "+v"(Fp.lane))
  const int NA = G;
  if (IN(0)) { PHASE_FRAME(F0); TP_BEGIN(1);
#ifdef SLEEP_START
#pragma unroll 1
    for (int i_ = 0; i_ < SLEEP_START; ++i_) __builtin_amdgcn_s_sleep(127);
#endif
    p0_lam(F0, args);
    p0_zero_vpad(F0);
    TP_BEGIN(41); p0_rows(F0, args); TP_END(41, F.ws);
    TP_BEGIN(42); p0_transpose<true>(F0, args, args.in[IN_WIN], DPROJ, NPROJ, (bf16*)(F.ws + WS_W1T));
    p0_transpose<false>(F0, args, args.in[IN_WOUT], DM, DM, (bf16*)(F.ws + WS_W2T)); TP_END(42, F.ws);
    TP_BEGIN(43); p0_w3t(F0, args); TP_END(43, F.ws);
    TP_BEGIN(44); p0_tables(F0, args); TP_END(44, F.ws);
#ifdef DUP_ROWS
    p0_rows(F0, args);
#endif
#ifdef DUP_TR
    p0_transpose<true>(F0, args, args.in[IN_WIN], DPROJ, NPROJ, (bf16*)(F.ws + WS_W1T));
    p0_transpose<false>(F0, args, args.in[IN_WOUT], DM, DM, (bf16*)(F.ws + WS_W2T));
#endif
#ifdef DUP_W3T
    p0_w3t(F0, args);
#endif
#ifdef DUP_TAB
    p0_tables(F0, args);
#endif
    TP_END(1, F.ws);
  }
  SEAM(0);
  if (IN(1)) { PHASE_FRAME(F1); TP_BEGIN(2);
    p1_meta_finalize(F1, args);
    pg8::Gemm g{(const pg8::bf16_t*)(F.ws + WS_XN), (const pg8::bf16_t*)(F.ws + WS_W1T), MROWS, NPROJ, DM};
    pg8::StaticOrder S; S.init(MROWS, NPROJ, G, bx);
    EpiProj E{(bf16*)(F.ws + WS_Q), (bf16*)(F.ws + WS_KP), (bf16*)(F.ws + WS_VP), (bf16*)(F.ws + WS_MQ), (bf16*)(F.ws + WS_MK), (bf16*)(F.ws + WS_MV), (bf16*)(F.ws + WS_MO),
              args.in[IN_QNG], args.in[IN_KNG], (LAS float*)(F.lds + XCH_OFF)};
    pg8::gemm_phase<EpiProj, pg8::StaticOrder, true, true>(F.lds + RING_OFF, g, S, E);
    TP_END(2, F.ws);
  }
  SEAM(1);
  if (IN(2)) {
    PHASE_FRAME(F2);
    TP_BEGIN(3);
    att::phase(F2, (G % 8 == 0) ? (bx & 7) * (G >> 3) + (bx >> 3) : bx, NA);
    TP_END(3, F.ws); TP_BEGIN(4);
    for (int task = bx; task < 512; task += G) ml::taskA(F2, args, task);
    TP_END(4, F.ws);
  }
  SEAM(2);
  if (IN(3)) { PHASE_FRAME(F3); TP_BEGIN(5); ml::scanB(F3); TP_END(5, F.ws); TP_BEGIN(6); p3_combine(F3, args, NA); TP_END(6, F.ws);
#ifdef DUP_SCAN
    ml::scanB(F3);
#endif
#ifdef DUP_COMB
    p3_combine(F3, args, NA);
#endif
  }
  SEAM(3);
#ifdef EXTRA_BARS
  for (int i_ = 0; i_ < EXTRA_BARS; ++i_) xcd_barrier(bar);
#endif
  if (IN(4)) {
    PHASE_FRAME(F4);
    TP_BEGIN(7);
    for (int task = bx; task < 512; task += G) ml::taskC(F4, args, task);
    TP_END(7, F.ws);
  }
  SEAM(4);
  if (IN(5)) { TP_BEGIN(8);
    pg8::Gemm g{(const pg8::bf16_t*)(F.ws + WS_A2), (const pg8::bf16_t*)(F.ws + WS_W2T), MROWS, DM, DM};
    pg8::StaticOrder S; S.init(MROWS, DM, G, bx);
    EpiRes E{args.in[IN_X], args.out, (bf16*)(F.ws + WS_H1B), (float*)(F.ws + WS_SSQ)};
    pg8::gemm_phase<EpiRes, pg8::StaticOrder, true, true>(F.lds + RING_OFF, g, S, E);
    TP_END(8, F.ws);
  }
  SEAM(5);
  if (IN(6)) { TP_BEGIN(9);
    pg8::Gemm g{(const pg8::bf16_t*)(F.ws + WS_H1B), (const pg8::bf16_t*)(F.ws + WS_W3T), MROWS, DM, DM};
    pg8::StaticOrder S; S.init(MROWS, DM, G, bx);
    LAS float* rst = (LAS float*)(F.lds + XCH_OFF);
    { pg8::Unit u0; if (S.next(0, u0)) { if (F.tid < 256) { const float* sp = (const float*)(F.ws + WS_SSQ) + ((size_t)u0.pm * 256 + F.tid) * 32; float s = 0.f;
#pragma unroll
          for (int i = 0; i < 8; ++i) { const f32x4 v = ((const f32x4*)sp)[i]; s += (v.x + v.y) + (v.z + v.w); }
          rst[F.tid] = rsqrtf(s * (1.0f / DM) + EPS); } } }
    __syncthreads();
    EpiScore E{(float*)(F.ws + WS_S), rst};
    pg8::gemm_phase<EpiScore, pg8::StaticOrder, true, true>(F.lds + RING_OFF, g, S, E);
    TP_END(9, F.ws);
  }
  SEAM(6);
  if (IN(7)) { PHASE_FRAME(F7); TP_BEGIN(10); p6_peer(F7, args, args.out); TP_END(10, F.ws); }
#undef IN
#undef SEAM
}
extern "C" void kernel_launch(void* const* d_in, const int* in_sizes, int n_in, void* d_out, int out_size, void* d_ws, size_t ws_size, hipStream_t stream) {
  static int grid = 0;
  if (grid == 0) {
    int dev = 0, cus = 0, per_cu = 0;
    if (hipGetDevice(&dev) != hipSuccess || hipDeviceGetAttribute(&cus, hipDeviceAttributeMultiprocessorCount, dev) != hipSuccess) { fprintf(stderr, "device query failed\n"); grid = -1; return; }
    if (hipFuncSetAttribute((const void*)mk_fwd, hipFuncAttributeMaxDynamicSharedMemorySize, LDS_BYTES) != hipSuccess) { fprintf(stderr, "hipFuncSetAttribute failed\n"); grid = -1; return; }
    if (hipOccupancyMaxActiveBlocksPerMultiprocessor(&per_cu, (const void*)mk_fwd, NTHR, LDS_BYTES) != hipSuccess || per_cu < 1) { fprintf(stderr, "occupancy query says %d workgroups per CU: not launching\n", per_cu); (void)hipGetLastError(); grid = -1; return; }
    (void)hipGetLastError();
    grid = cus;
    if (n_in != 22 || ws_size < (size_t)512 * MiB || out_size != MROWS * DM) { fprintf(stderr, "unexpected shapes: n_in %d out %d ws %zu\n", n_in, out_size, ws_size); grid = -1; return; }
  }
  if (grid < 0) return;
  unsigned char* ws = (unsigned char*)d_ws;
  if (hipMemsetAsync(ws + WS_CTL, 0, CTL_ZERO_BYTES, stream) != hipSuccess) { fprintf(stderr, "memset failed\n"); return; }
  Args a{};
  for (int i = 0; i < 22; ++i) a.in[i] = (const float*)d_in[i];
  a.out = (float*)d_out; a.ws = ws; a.na = 0; a.pad = 0;
  a.ph_lo = 0; a.ph_hi = 8;
  hipLaunchKernelGGL(mk_fwd, dim3(grid), dim3(NTHR), LDS_BYTES, stream, a);
}
```

```cpp
#include <hip/hip_runtime.h>
#include <cstdio>
#include <cstdint>
#include <math.h>
namespace pg8 {
#define PG8_LAS __attribute__((address_space(3)))
typedef unsigned short bf16_t;
typedef short bf16x8 __attribute__((ext_vector_type(8)));
typedef float f32x4 __attribute__((ext_vector_type(4)));
typedef unsigned u32x4 __attribute__((ext_vector_type(4)));
constexpr int BM = 256, BK = 64, HALF = 128, HTB = HALF * BK * 2  , STAGE_BYTES = 8 * HTB, NXCD = 8, WGM = 8;

__host__ __device__ __forceinline__ int lds_byte(int r, int c) { const int st = (r >> 4) * 2 + (c >> 5), rr = r & 15, cc = c & 31, ob = rr * 64 + cc * 2; return st * 1024 + (ob ^ (((ob >> 9) & 1) << 5)); }
__host__ __device__ __forceinline__ void stage_rc(int b, int& R, int& C) { const int st = b / 1024, sb = b % 1024, swz = sb ^ (((sb >> 9) & 1) << 5); R = (st >> 1) * 16 + swz / 64; C = (st & 1) * 32 + (swz % 64) / 2; }
__host__ __device__ __forceinline__ int perm32(int rho) { const int n = rho >> 4, i = rho & 15; return 8 * (i >> 2) + 4 * n + (i & 3); }

struct Unit { int pm, pn; };
struct Gemm { const bf16_t* A; const bf16_t* Bt; int M, N, K; };

struct StaticOrder {
    int nM, nN, nwg, G, c;
    __host__ __device__ void init(int M, int N, int G_, int c_) { nM = M / BM; nN = N / BM; nwg = nM * nN; G = G_; c = c_; }
    __host__ __device__ bool next(int i, Unit& u) const {
        const long L = (long)i * G + c; if (L >= nwg) return false;
        int wgid = (int)L; { const int q = nwg / NXCD, r = nwg % NXCD, xcd = wgid % NXCD, off = wgid / NXCD; wgid = (xcd < r ? xcd * (q + 1) : r * (q + 1) + (xcd - r) * q) + off; }
        const int nig = WGM * nN, gid = wgid / nig, fm = gid * WGM, gsz = (nM - fm) < WGM ? (nM - fm) : WGM;
        u.pm = fm + ((wgid % nig) % gsz); u.pn = (wgid % nig) / gsz; return true;
    }
    __device__ __forceinline__ void a_ready(const Unit&) const {}
    __device__ __forceinline__ void done(const Unit&) const {}
};

__device__ __forceinline__ unsigned cvt_pk_bf16(float lo, float hi) { unsigned r; asm volatile("v_cvt_pk_bf16_f32 %0, %1, %2" : "=v"(r) : "v"(lo), "v"(hi)); return r; }
typedef float f32x2 __attribute__((ext_vector_type(2)));
template <class Epi, class Sched, bool ALIGN_EPI = false, bool SP2 = false>
__device__ __forceinline__ void gemm_phase(PG8_LAS unsigned char* lds, const Gemm g, const Sched& S, const Epi& E) {
    int tid_ = threadIdx.x; asm volatile("" : "+v"(tid_));
    const int tid = tid_, wid = __builtin_amdgcn_readfirstlane(tid >> 6), lane = tid & 63, wr = wid >> 2, wc = wid & 3, fr = lane & 15, fq = lane >> 4;
    const int K = g.K, nt = K / BK;
    unsigned voffA[2], voffB[2];
#pragma unroll
    for (int i = 0; i < 2; ++i) { int R, C; stage_rc(tid * 16 + i * 8192, R, C); const int Rb = Epi::PERM ? ((R & ~31) + perm32(R & 31)) : R;
        voffA[i] = (unsigned)(R * K + C) * 2u; voffB[i] = (unsigned)(Rb * K + C) * 2u; }
    const size_t kstep = (size_t)(BK * 2);
    const size_t hstep = (size_t)HALF * K * 2;
    const size_t tstep = 2 * hstep;
    const unsigned ldsw = (unsigned)wid * 1024u;
    const int aoff = lds_byte(wr * 64 + fr, fq * 8), boff = lds_byte(wc * 32 + fr, fq * 8);
#define PG8_SA(b, h) (((b) * 2 + (h)) * HTB)
#define PG8_SB(b, h) ((4 + (b) * 2 + (h)) * HTB)
#define PG8_STAGE(bufoff, gbase, voff) do { _Pragma("unroll") for (int _i = 0; _i < 2; ++_i) \
        __builtin_amdgcn_global_load_lds((const unsigned*)((const char*)(gbase) + (voff)[_i]), (PG8_LAS unsigned*)(lds + (bufoff) + ldsw + _i * 8192), 16, 0, 0); } while (0)
#define PG8_LDA(dst, b, h) do { _Pragma("unroll") for (int m = 0; m < 4; ++m) _Pragma("unroll") for (int k = 0; k < 2; ++k) dst[m][k] = *(const PG8_LAS bf16x8*)(lds + PG8_SA(b, h) + aoff + m * 2048 + k * 1024); } while (0)
#define PG8_LDB(dst, b, h) do { _Pragma("unroll") for (int n = 0; n < 2; ++n) _Pragma("unroll") for (int k = 0; k < 2; ++k) dst[n][k] = *(const PG8_LAS bf16x8*)(lds + PG8_SB(b, h) + boff + n * 2048 + k * 1024); } while (0)
#define PG8_MMA(ai, bj, At, Bt) do { __builtin_amdgcn_s_setprio(1); _Pragma("unroll") for (int m = 0; m < 4; ++m) _Pragma("unroll") for (int n = 0; n < 2; ++n) _Pragma("unroll") for (int k = 0; k < 2; ++k) \
        acc[ai][bj][m][n] = __builtin_amdgcn_mfma_f32_16x16x32_bf16(Bt[n][k], At[m][k], acc[ai][bj][m][n], 0, 0, 0); __builtin_amdgcn_s_setprio(0); } while (0)
#define PG8_WAIT_V(n) asm volatile("s_waitcnt vmcnt(" #n ")" ::: "memory")
#define PG8_WAIT_L(n) asm volatile("s_waitcnt lgkmcnt(" #n ")" ::: "memory")
#define PG8_BAR __builtin_amdgcn_s_barrier()
#define PG8_SCHED __builtin_amdgcn_sched_barrier(0)
    Unit cur, nxt; int ui = 0;
    if (!S.next(0, cur)) return;
    f32x4 acc[2][2][4][2];
#pragma unroll
    for (int a = 0; a < 2; ++a)
#pragma unroll
        for (int b = 0; b < 2; ++b)
#pragma unroll
            for (int m = 0; m < 4; ++m)
#pragma unroll
                for (int n = 0; n < 2; ++n) acc[a][b][m][n] = (f32x4){0.f, 0.f, 0.f, 0.f};
    bf16x8 At[4][2], B0[2][2], B1[2][2];
    const char* cA = (const char*)g.A + (size_t)cur.pm * tstep; const char* cB = (const char*)g.Bt + (size_t)cur.pn * tstep;
    S.a_ready(cur);
    if constexpr (SP2) {
        PG8_STAGE(PG8_SB(0, 0), cB, voffB); PG8_STAGE(PG8_SB(0, 1), cB + hstep, voffB); PG8_STAGE(PG8_SA(0, 0), cA, voffA); PG8_STAGE(PG8_SA(0, 1), cA + hstep, voffA);
        if (wr == 1) PG8_BAR;
        PG8_WAIT_V(2); PG8_BAR;
        PG8_STAGE(PG8_SB(1, 0), cB + kstep, voffB); PG8_STAGE(PG8_SA(1, 0), cA + kstep, voffA); PG8_STAGE(PG8_SB(1, 1), cB + hstep + kstep, voffB);
        PG8_WAIT_V(6); PG8_BAR;
    } else {
        PG8_STAGE(PG8_SB(0, 0), cB, voffB); PG8_STAGE(PG8_SA(0, 0), cA, voffA); PG8_STAGE(PG8_SB(0, 1), cB + hstep, voffB); PG8_STAGE(PG8_SA(0, 1), cA + hstep, voffA);
        if (wr == 1) PG8_BAR;
        PG8_WAIT_V(4); PG8_BAR;
        PG8_STAGE(PG8_SB(1, 0), cB + kstep, voffB); PG8_STAGE(PG8_SA(1, 0), cA + kstep, voffA); PG8_STAGE(PG8_SB(1, 1), cB + hstep + kstep, voffB);
        PG8_WAIT_V(6); PG8_BAR;
    }
    for (;;) {
        const bool has_next = S.next(ui + 1, nxt);
        const char* nA = has_next ? (const char*)g.A + (size_t)nxt.pm * tstep : cA; const char* nB = has_next ? (const char*)g.Bt + (size_t)nxt.pn * tstep : cB;
        for (int t = 0; t < nt; t += 2) {
            const bool last = (t == nt - 2);
            const char* a1 = cA + (size_t)(t + 1) * kstep;
            const char* a2 = last ? nA : cA + (size_t)(t + 2) * kstep; const char* b2 = last ? nB : cB + (size_t)(t + 2) * kstep;
            const char* a3 = a2 + kstep; const char* b3 = b2 + kstep;
            if (last && has_next) S.a_ready(nxt);
            if constexpr (SP2) {
            PG8_LDB(B0, 0, 0); PG8_LDB(B1, 0, 1); PG8_SCHED; PG8_LDA(At, 0, 0); PG8_STAGE(PG8_SA(1, 1), a1 + hstep, voffA);
            PG8_WAIT_V(8); PG8_WAIT_L(0); PG8_BAR; PG8_MMA(0, 0, At, B0); PG8_MMA(0, 1, At, B1); PG8_BAR; PG8_SCHED;
            PG8_LDA(At, 0, 1); PG8_STAGE(PG8_SB(0, 0), b2, voffB); PG8_STAGE(PG8_SB(0, 1), b2 + hstep, voffB); PG8_STAGE(PG8_SA(0, 0), a2, voffA);
            PG8_WAIT_V(8); PG8_WAIT_L(0); PG8_BAR; PG8_MMA(1, 0, At, B0); PG8_MMA(1, 1, At, B1); PG8_BAR; PG8_SCHED;
            PG8_LDB(B0, 1, 0); PG8_LDB(B1, 1, 1); PG8_SCHED; PG8_LDA(At, 1, 0); PG8_STAGE(PG8_SA(0, 1), a2 + hstep, voffA);
            PG8_WAIT_V(8); PG8_WAIT_L(0); PG8_BAR; PG8_MMA(0, 0, At, B0); PG8_MMA(0, 1, At, B1); PG8_BAR; PG8_SCHED;
            PG8_LDA(At, 1, 1); PG8_STAGE(PG8_SB(1, 0), b3, voffB); PG8_STAGE(PG8_SB(1, 1), b3 + hstep, voffB); PG8_STAGE(PG8_SA(1, 0), a3, voffA);
            PG8_WAIT_V(8); PG8_WAIT_L(0); PG8_BAR; PG8_MMA(1, 0, At, B0); PG8_MMA(1, 1, At, B1); PG8_BAR; PG8_SCHED;
            } else {
            PG8_LDB(B0, 0, 0); PG8_SCHED; PG8_LDA(At, 0, 0); PG8_STAGE(PG8_SA(1, 1), a1 + hstep, voffA);
            PG8_WAIT_L(8); PG8_BAR; PG8_WAIT_L(0); PG8_MMA(0, 0, At, B0); PG8_BAR; PG8_SCHED;
            PG8_LDB(B1, 0, 1); PG8_STAGE(PG8_SB(0, 0), b2, voffB);
            PG8_BAR; PG8_WAIT_L(0); PG8_MMA(0, 1, At, B1); PG8_BAR;
            PG8_LDA(At, 0, 1); PG8_STAGE(PG8_SA(0, 0), a2, voffA);
            PG8_BAR; PG8_WAIT_L(0); PG8_MMA(1, 0, At, B0); PG8_BAR; PG8_SCHED;
            PG8_STAGE(PG8_SB(0, 1), b2 + hstep, voffB);
            PG8_WAIT_V(6); PG8_BAR; PG8_MMA(1, 1, At, B1); PG8_BAR;
            PG8_LDB(B0, 1, 0); PG8_SCHED; PG8_LDA(At, 1, 0); PG8_STAGE(PG8_SA(0, 1), a2 + hstep, voffA);
            PG8_WAIT_L(8); PG8_BAR; PG8_WAIT_L(0); PG8_MMA(0, 0, At, B0); PG8_BAR; PG8_SCHED;
            PG8_LDB(B1, 1, 1); PG8_STAGE(PG8_SB(1, 0), b3, voffB);
            PG8_BAR; PG8_WAIT_L(0); PG8_MMA(0, 1, At, B1); PG8_BAR;
            PG8_LDA(At, 1, 1); PG8_STAGE(PG8_SA(1, 0), a3, voffA);
            PG8_BAR; PG8_WAIT_L(0); PG8_MMA(1, 0, At, B0); PG8_BAR; PG8_SCHED;
            PG8_STAGE(PG8_SB(1, 1), b3 + hstep, voffB);
            PG8_WAIT_V(6); PG8_BAR; PG8_MMA(1, 1, At, B1); PG8_BAR;
            }
        }
        if constexpr (ALIGN_EPI) { if (wr == 0) PG8_BAR; }
        if constexpr (!Epi::AFTER_DRAIN) { E(acc, cur, wr, wc, fr, fq); S.done(cur); }
        if (!has_next) break;
#pragma unroll
        for (int a = 0; a < 2; ++a)
#pragma unroll
            for (int b = 0; b < 2; ++b)
#pragma unroll
                for (int m = 0; m < 4; ++m)
#pragma unroll
                    for (int n = 0; n < 2; ++n) acc[a][b][m][n] = (f32x4){0.f, 0.f, 0.f, 0.f};
        cur = nxt; cA = nA; cB = nB; ++ui;
        if constexpr (ALIGN_EPI) { if (wr == 1) PG8_BAR; }
    }
    PG8_WAIT_V(0);
    if constexpr (!ALIGN_EPI) { if (wr == 0) PG8_BAR; }
    PG8_BAR;
    if constexpr (Epi::AFTER_DRAIN) { E.fused(acc, cur, wr, wc, fr, fq, lds, wid, lane); S.done(cur); }
#undef PG8_SA
#undef PG8_SB
#undef PG8_STAGE
#undef PG8_LDA
#undef PG8_LDB
#undef PG8_MMA
#undef PG8_WAIT_V
#undef PG8_WAIT_L
#undef PG8_BAR
#undef PG8_SCHED
}
}
#define GAS __attribute__((address_space(1)))
#define LAS __attribute__((address_space(3)))
typedef unsigned short bf16;
typedef unsigned v4u __attribute__((ext_vector_type(4)));
typedef unsigned v2u __attribute__((ext_vector_type(2)));
typedef float f32x4 __attribute__((ext_vector_type(4)));
typedef short bf16x8 __attribute__((ext_vector_type(8)));
#define LDS_WAIT() asm volatile("s_waitcnt lgkmcnt(0)" ::: "memory")
#define VM_WAIT() asm volatile("s_waitcnt vmcnt(0)" ::: "memory")

constexpr int DM = 2048, NB = 4, SEQ = 2048, NMETA = 16, MROWS = NB * SEQ, DPROJ = 6152, NPROJ = 6144;
constexpr int PADT = 2112, POS0 = 64, MPOS0 = 48;
constexpr float EPS = 1e-6f;
constexpr float LOG2E = 1.4426950408889634f;
constexpr float QSCALE = 0.08838834764831845f * LOG2E;
constexpr int NWAVES = 8, NTHR = 512;

constexpr size_t MiB = 1u << 20;
constexpr size_t WS_CTL = 0, CTL_ZERO_BYTES = 32 * 1024;
constexpr size_t WS_PM = 484 * MiB;
constexpr size_t WS_W1T = 2 * MiB, WS_W2T = 26 * MiB, WS_W3T = 34 * MiB, WS_XN = 42 * MiB;
constexpr size_t WS_Q = 74 * MiB, WS_KP = 90 * MiB, WS_VP = 107 * MiB, WS_MQ = 124 * MiB, WS_MK = 133 * MiB, WS_MV = 142 * MiB, WS_MO = 159 * MiB;
constexpr size_t WS_SMALL = 175 * MiB;
constexpr size_t WS_XM = WS_SMALL, WS_LI = WS_SMALL + 128 * 1024, WS_LF = WS_SMALL + 384 * 1024, WS_LAM = WS_SMALL + 640 * 1024;
constexpr size_t WS_PO = 176 * MiB, WS_ML = 304 * MiB, WS_HM = 305 * MiB, WS_A2 = 42 * MiB, WS_H1B = 74 * MiB, WS_SSQ = 106 * MiB, WS_S = 176 * MiB, WS_UB = 384 * MiB, WS_VB = 448 * MiB;
constexpr size_t WS_SCL = WS_SMALL + 704 * 1024;
constexpr size_t WS_VB8 = WS_UB + 32 * MiB;
constexpr size_t WS_DC = 305 * MiB, WS_CS = 448 * MiB, WS_DN = 482 * MiB, WS_NS = WS_DN + 512 * 1024, WS_GS = WS_DN + 1024 * 1024, WS_MS = WS_DN + 1152 * 1024;
constexpr size_t WS_EID = 240 * MiB, WS_EGT = 244 * MiB;
constexpr int CW_BAR = 4096;

constexpr int RING_OFF = 0, RING_BYTES = 131072;
constexpr int XCH_OFF = 131072;
constexpr int MISC_OFF = XCH_OFF + 8192;
constexpr int LDS_BYTES = 155648;

__device__ __forceinline__ unsigned f2bf(float f) { unsigned u = __builtin_bit_cast(unsigned, f); return (u + 0x7fffu + ((u >> 16) & 1u)) >> 16; }
__device__ __forceinline__ unsigned pk2(float lo, float hi) { return f2bf(lo) | (f2bf(hi) << 16); }
__device__ __forceinline__ float bf2f(unsigned short u) { return __builtin_bit_cast(float, (unsigned)u << 16); }
__device__ __forceinline__ float bflo(unsigned w) { return __builtin_bit_cast(float, w << 16); }
__device__ __forceinline__ float bfhi(unsigned w) { return __builtin_bit_cast(float, w & 0xffff0000u); }
__device__ __forceinline__ float wave_sum(float v) {
#pragma unroll
  for (int o = 1; o < 64; o <<= 1) v += __shfl_xor(v, o);
  return v;
}
__device__ __forceinline__ size_t kp_off(int bhm, int pos, int d) { const int j = pos >> 6, row = pos & 63, d0 = d >> 4, hi = (d >> 3) & 1;
  return ((size_t)(bhm * 33 + j) * 8 + d0) * 1024 + (size_t)((((row << 1) | hi) ^ ((row >> 3) & 1)) << 3) + (d & 7); }
__device__ __forceinline__ float wave_sum_dpp(float v) {
  v += __builtin_bit_cast(float, __builtin_amdgcn_update_dpp(0, __builtin_bit_cast(int, v), 0xB1, 0xF, 0xF, true));
  v += __builtin_bit_cast(float, __builtin_amdgcn_update_dpp(0, __builtin_bit_cast(int, v), 0x4E, 0xF, 0xF, true));
  v += __builtin_bit_cast(float, __builtin_amdgcn_update_dpp(0, __builtin_bit_cast(int, v), 0x141, 0xF, 0xF, true));
  v += __builtin_bit_cast(float, __builtin_amdgcn_update_dpp(0, __builtin_bit_cast(int, v), 0x140, 0xF, 0xF, true));
  const float r0 = __builtin_bit_cast(float, __builtin_amdgcn_readlane(__builtin_bit_cast(int, v), 0)), r1 = __builtin_bit_cast(float, __builtin_amdgcn_readlane(__builtin_bit_cast(int, v), 16));
  const float r2 = __builtin_bit_cast(float, __builtin_amdgcn_readlane(__builtin_bit_cast(int, v), 32)), r3 = __builtin_bit_cast(float, __builtin_amdgcn_readlane(__builtin_bit_cast(int, v), 48));
  return (r0 + r1) + (r2 + r3);
}
__device__ __forceinline__ float sigmoidf_(float x) { return 1.0f / (1.0f + __expf(-x)); }

#ifdef TPROBE
#ifndef TP_BLOCK
#define TP_BLOCK 0
#endif
#ifndef TP_DIV
#define TP_DIV 1.0f
#endif
#define TP_BEGIN(id) unsigned long long tp_t0_##id = 0; do { if (TPROBE == (id)) tp_t0_##id = __builtin_amdgcn_s_memrealtime(); } while (0)
#define TP_END(id, WS) do { if (TPROBE == (id)) { const unsigned long long t1_ = __builtin_amdgcn_s_memrealtime(); if ((int)blockIdx.x == TP_BLOCK && threadIdx.x == 0) atomicAdd((unsigned*)((WS) + 64), (unsigned)(t1_ - tp_t0_##id)); } } while (0)
#else
#define TP_BEGIN(id)
#define TP_END(id, WS)
#endif
#define XB_TMO      128
#define XB_XCNT(j)  (256  + 64 * (j))
#define XB_XSUB(j)  (1280 + 64 * (j))
#define XB_XGEN(j)  (2304 + 64 * (j))
#define XB_TOP      3328
#define XB_TOPGEN   3392
#define XCD_BAR_WORDS 3456
#define XB_SPIN_CAP (1u << 18)

__device__ __forceinline__ unsigned xb_ld(unsigned* p)              { return __hip_atomic_load(p, __ATOMIC_RELAXED, __HIP_MEMORY_SCOPE_AGENT); }
__device__ __forceinline__ unsigned xb_add(unsigned* p, unsigned v) { return __hip_atomic_fetch_add(p, v, __ATOMIC_RELAXED, __HIP_MEMORY_SCOPE_AGENT); }
__device__ __forceinline__ unsigned xb_xcc_id() { return (unsigned)__builtin_amdgcn_s_getreg((3 << 11) | 20) & 0xFu; }
#define XB_SPIN(cond, bar) do { unsigned _sp = 0; while (cond) { __builtin_amdgcn_s_sleep(1); \
    if ((++_sp & 255u) == 0u) { if (xb_ld(&(bar)[XB_TMO])) break; if (_sp > XB_SPIN_CAP) { atomicAdd(&(bar)[XB_TMO], 1u); break; } } } } while (0)

struct XcdBarrier {
    unsigned* bar; unsigned x;
    volatile LAS unsigned* st;
};

__device__ __forceinline__ XcdBarrier xcd_barrier_post(unsigned* bar, volatile LAS unsigned* st) {
    XcdBarrier b; b.bar = bar; b.x = xb_xcc_id(); b.st = st;
    if (threadIdx.x == 0) (void)xb_add(&bar[XB_XCNT(b.x)], 1u);
    return b;
}
__device__ __forceinline__ void xcd_barrier_complete(unsigned* bar, unsigned x, unsigned& nloc, unsigned& nx) {
    const unsigned G = gridDim.x * gridDim.y * gridDim.z;
    unsigned sum, cnt, mine, sp = 0u;
    for (;;) {
        sum = 0u; cnt = 0u; mine = 0u;
#pragma unroll
        for (unsigned j = 0; j < 16; ++j) { const unsigned c = xb_ld(&bar[XB_XCNT(j)]); sum += c; cnt += (c > 0u) ? 1u : 0u; mine = (j == x) ? c : mine; }
        if (sum == G) break;
        __builtin_amdgcn_s_sleep(1);
        if ((++sp & 255u) == 0u) { if (xb_ld(&bar[XB_TMO])) break; if (sp > XB_SPIN_CAP) { atomicAdd(&bar[XB_TMO], 1u); break; } }
    }
    nloc = mine > 0u ? mine : 1u; nx = cnt > 0u ? cnt : 1u;
}

__device__ __forceinline__ void xcd_barrier(const XcdBarrier& b) {
    asm volatile("s_waitcnt vmcnt(0)" ::: "memory");
    __syncthreads();
    if (threadIdx.x == 0) {
        unsigned* bar = b.bar;
        __builtin_amdgcn_s_waitcnt(0);
        unsigned nloc = b.st[0], nx = b.st[1];
        if (nloc == 0u) { xcd_barrier_complete(bar, b.x, nloc, nx); b.st[0] = nloc; b.st[1] = nx; }
        const unsigned old = xb_add(&bar[XB_XSUB(b.x)], 1u);
        const unsigned gen = old / nloc;
        if (old + 1u == (gen + 1u) * nloc) {
            __builtin_amdgcn_fence(__ATOMIC_RELEASE, "agent");
            asm volatile("s_waitcnt vmcnt(0)" ::: "memory");
            const unsigned og = xb_add(&bar[XB_TOP], 1u);
            const unsigned tg = og / nx;
            if (og + 1u == (tg + 1u) * nx) xb_add(&bar[XB_TOPGEN], 1u);
            else XB_SPIN(xb_ld(&bar[XB_TOPGEN]) == tg, bar);
            __builtin_amdgcn_fence(__ATOMIC_ACQUIRE, "agent");
            xb_add(&bar[XB_XGEN(b.x)], 1u);
            asm volatile("s_waitcnt vmcnt(0)" ::: "memory");
        } else {
            XB_SPIN(xb_ld(&bar[XB_XGEN(b.x)]) == gen, bar);
            __builtin_amdgcn_fence(__ATOMIC_ACQUIRE, "agent");
            asm volatile("s_waitcnt vmcnt(0)" ::: "memory");
        }
    }
    __syncthreads();
}

struct Args { const float* in[22]; float* out; unsigned char* ws; int ph_lo, ph_hi, na, pad; };
struct Frame {
  LAS unsigned char* lds; unsigned char* ws; int tid, lane, wave; const float* const* in;
};
#define IN_X 0
#define IN_META 1
#define IN_G1 2
#define IN_WIN 3
#define IN_CW 4
#define IN_CB 5
#define IN_IGB 6
#define IN_FGB 7
#define IN_LQ1 8
#define IN_LK1 9
#define IN_LQ2 10
#define IN_LK2 11
#define IN_QNG 12
#define IN_KNG 13
#define IN_SUBG 14
#define IN_OUTG 15
#define IN_WOUT 16
#define IN_G2 17
#define IN_WQ 18
#define IN_SUBK 19
#define IN_U 20
#define IN_V 21

__device__ __forceinline__ void p0_rows(const Frame& F, const Args& a) {
  const float* x = a.in[IN_X]; const float* meta = a.in[IN_META]; const float* g1 = a.in[IN_G1]; const float* w_in = a.in[IN_WIN];
  const float* igb = a.in[IN_IGB]; const float* fgb = a.in[IN_FGB];
  bf16* Xn = (bf16*)(F.ws + WS_XN); bf16* Xm = (bf16*)(F.ws + WS_XM); float* LI = (float*)(F.ws + WS_LI); float* LF = (float*)(F.ws + WS_LF);
  LAS f32x4* wgl = (LAS f32x4*)(F.lds);
  for (int e = F.tid; e < 4096; e += NTHR) {
    const int ln = e & 63, q = e >> 6, half = q & 1, j = (q >> 1) & 3, i = q >> 3;
    const int k = 4 * (i * 64 + ln) + j;
    wgl[e] = *(const f32x4*)(w_in + (size_t)k * DPROJ + NPROJ + 4 * half);
  }
  __syncthreads();
  const int gw = blockIdx.x * NWAVES + F.wave, NGW = gridDim.x * NWAVES, lane = F.lane;
  constexpr int NTASK = MROWS / 2 + NMETA / 2;
  f32x4 xnx[2][8];
  if (gw < NTASK) { const float* sn = (gw >= MROWS / 2 ? meta + (size_t)(gw - MROWS / 2) * 2 * DM : x + (size_t)gw * 2 * DM);
#pragma unroll
    for (int i = 0; i < 8; ++i) { xnx[0][i] = ((const f32x4*)sn)[i * 64 + lane]; xnx[1][i] = ((const f32x4*)(sn + DM))[i * 64 + lane]; } }
  f32x4 g1v[8];
#pragma unroll
  for (int i = 0; i < 8; ++i) g1v[i] = ((const f32x4*)g1)[i * 64 + lane];
  for (int task = gw; task < NTASK; task += NGW) {
    const bool ismeta = task >= MROWS / 2;
    const int r0 = ismeta ? (task - MROWS / 2) * 2 : task * 2;
    f32x4 xv[2][8]; float rs[2];
    { float s0 = 0.f, s1 = 0.f;
#pragma unroll
      for (int i = 0; i < 8; ++i) { xv[0][i] = xnx[0][i]; xv[1][i] = xnx[1][i]; }
      { const int tn = task + NGW; if (tn < NTASK) { const float* sn = (tn >= MROWS / 2 ? meta + (size_t)(tn - MROWS / 2) * 2 * DM : x + (size_t)tn * 2 * DM);
#pragma unroll
          for (int i = 0; i < 8; ++i) { xnx[0][i] = ((const f32x4*)sn)[i * 64 + lane]; xnx[1][i] = ((const f32x4*)(sn + DM))[i * 64 + lane]; } } }
#pragma unroll
      for (int i = 0; i < 8; ++i) { const f32x4 a0 = xv[0][i], a1 = xv[1][i];
        s0 += (a0.x * a0.x + a0.y * a0.y) + (a0.z * a0.z + a0.w * a0.w); s1 += (a1.x * a1.x + a1.y * a1.y) + (a1.z * a1.z + a1.w * a1.w); }
      rs[0] = rsqrtf(wave_sum_dpp(s0) * (1.0f / DM) + EPS); rs[1] = rsqrtf(wave_sum_dpp(s1) * (1.0f / DM) + EPS); }
    float ga[2][8];
#pragma unroll
    for (int rr = 0; rr < 2; ++rr)
#pragma unroll
      for (int g = 0; g < 8; ++g) ga[rr][g] = 0.f;
    bf16* dst0 = (ismeta ? Xm : Xn) + (size_t)r0 * DM;
#pragma unroll
    for (int i = 0; i < 8; ++i) {
      const f32x4 g = g1v[i];
      f32x4 xn[2];
#pragma unroll
      for (int rr = 0; rr < 2; ++rr) { xn[rr] = xv[rr][i] * g * rs[rr];
        v2u o; o.x = pk2(xn[rr].x, xn[rr].y); o.y = pk2(xn[rr].z, xn[rr].w); ((v2u*)(dst0 + (size_t)rr * DM))[i * 64 + lane] = o; }
#pragma unroll
      for (int j = 0; j < 4; ++j) {
        const f32x4 w0 = wgl[((i * 4 + j) * 2 + 0) * 64 + lane], w1 = wgl[((i * 4 + j) * 2 + 1) * 64 + lane];
#pragma unroll
        for (int rr = 0; rr < 2; ++rr) { const float xs_ = xn[rr][j];
          ga[rr][0] += xs_ * w0.x; ga[rr][1] += xs_ * w0.y; ga[rr][2] += xs_ * w0.z; ga[rr][3] += xs_ * w0.w;
          ga[rr][4] += xs_ * w1.x; ga[rr][5] += xs_ * w1.y; ga[rr][6] += xs_ * w1.z; ga[rr][7] += xs_ * w1.w; }
      }
      __builtin_amdgcn_sched_barrier(0);
    }
#pragma unroll
    for (int rr = 0; rr < 2; ++rr)
#pragma unroll
      for (int g = 0; g < 8; ++g) ga[rr][g] = wave_sum_dpp(ga[rr][g]);
    if (lane < 8) {
      const int rr = lane >> 2, h = lane & 3;
      float gi = 0.f, gf = 0.f;
#pragma unroll
      for (int q = 0; q < 2; ++q)
#pragma unroll
        for (int hh = 0; hh < 4; ++hh) if (q == rr && hh == h) { gi = ga[q][hh]; gf = ga[q][4 + hh]; }
      const float li = gi + igb[h]; const float fx = gf + fgb[h];
      const float lf = fminf(fx, 0.f) - log1pf(__expf(-fabsf(fx)));
      const int R = r0 + rr;
      if (!ismeta) { const int b = R >> 11, t = R & 2047; LI[(b * 4 + h) * PADT + POS0 + t] = li; LF[(b * 4 + h) * PADT + POS0 + t] = lf; }
      else { for (int b = 0; b < NB; ++b) { LI[(b * 4 + h) * PADT + MPOS0 + R] = li; LF[(b * 4 + h) * PADT + MPOS0 + R] = lf; } }
    }
  }
  __syncthreads();
}
template <bool META>
__device__ __forceinline__ void p0_transpose(const Frame& F, const Args& a, const float* W, int ldw, int N, bf16* Wt) {
  LAS float* tl = (LAS float*)(F.lds);
  LAS float* red = (LAS float*)(F.lds + 33792);
  float* PM = (float*)(F.ws + WS_PM);
  const float* meta = a.in[IN_META]; const float* g1 = a.in[IN_G1];
  const int ntn = N / 64, ntask = ntn * 16, fr = F.lane & 15, fq = F.lane >> 4, w = F.wave;
  f32x4 wn[4];
  float am[4], ag[4];
  if ((int)blockIdx.x < ntask) { const int nb = blockIdx.x % ntn, kb = blockIdx.x / ntn;
#pragma unroll
    for (int i = 0; i < 4; ++i) { const int idx = F.tid + NTHR * i, kk = idx >> 4, c4 = idx & 15; wn[i] = *(const f32x4*)(W + (size_t)(kb * 128 + kk) * ldw + nb * 64 + 4 * c4); }
    if (META) {
#pragma unroll
      for (int s_ = 0; s_ < 4; ++s_) { const int k = kb * 128 + 16 * w + 4 * s_ + fq; am[s_] = meta[(size_t)fr * DM + k]; ag[s_] = g1[k]; } } }
  for (int task = blockIdx.x; task < ntask; task += gridDim.x) {
    const int nb = task % ntn, kb = task / ntn, n0 = nb * 64, k0 = kb * 128;
    __syncthreads();
#pragma unroll
    for (int i = 0; i < 4; ++i) { const int idx = F.tid + NTHR * i, kk = idx >> 4, c4 = idx & 15; const f32x4 wv = wn[i];
      LAS float* d = tl + kk * 65 + 4 * c4; d[0] = wv.x; d[1] = wv.y; d[2] = wv.z; d[3] = wv.w; }
    float ac[4];
    if (META) {
#pragma unroll
      for (int s_ = 0; s_ < 4; ++s_) ac[s_] = am[s_] * ag[s_]; }
    { const int tn = task + gridDim.x; if (tn < ntask) { const int nb2 = tn % ntn, kb2 = tn / ntn;
#pragma unroll
        for (int i = 0; i < 4; ++i) { const int idx = F.tid + NTHR * i, kk = idx >> 4, c4 = idx & 15; wn[i] = *(const f32x4*)(W + (size_t)(kb2 * 128 + kk) * ldw + nb2 * 64 + 4 * c4); }
        if (META) {
#pragma unroll
          for (int s_ = 0; s_ < 4; ++s_) { const int k = kb2 * 128 + 16 * w + 4 * s_ + fq; am[s_] = meta[(size_t)fr * DM + k]; ag[s_] = g1[k]; } } } }
    __syncthreads();
    const int n = F.tid >> 3, kc = F.tid & 7;
    const LAS float* s = tl + (kc * 16) * 65 + n;
    v4u o0, o1;
    o0.x = pk2(s[0 * 65], s[1 * 65]); o0.y = pk2(s[2 * 65], s[3 * 65]); o0.z = pk2(s[4 * 65], s[5 * 65]); o0.w = pk2(s[6 * 65], s[7 * 65]);
    o1.x = pk2(s[8 * 65], s[9 * 65]); o1.y = pk2(s[10 * 65], s[11 * 65]); o1.z = pk2(s[12 * 65], s[13 * 65]); o1.w = pk2(s[14 * 65], s[15 * 65]);
    v4u* dp = (v4u*)(Wt + (size_t)(n0 + n) * DM + k0 + kc * 16);
    dp[0] = o0; dp[1] = o1;
    if (META && n0 >= 1024) {
      f32x4 acc[4];
#pragma unroll
      for (int nt = 0; nt < 4; ++nt) acc[nt] = (f32x4){0.f, 0.f, 0.f, 0.f};
#pragma unroll
      for (int s_ = 0; s_ < 4; ++s_)
#pragma unroll
        for (int nt = 0; nt < 4; ++nt) acc[nt] = __builtin_amdgcn_mfma_f32_16x16x4f32(ac[s_], tl[(16 * w + 4 * s_ + fq) * 65 + nt * 16 + fr], acc[nt], 0, 0, 0);
#pragma unroll
      for (int nt = 0; nt < 4; ++nt)
#pragma unroll
        for (int i = 0; i < 4; ++i) red[(w * 16 + 4 * fq + i) * 64 + nt * 16 + fr] = acc[nt][i];
      __syncthreads();
#pragma unroll
      for (int j = 0; j < 2; ++j) { const int idx = F.tid + NTHR * j, m = idx >> 6, nn = idx & 63; const LAS float* r = red + m * 64 + nn;
        PM[((size_t)kb * 16 + m) * NPROJ + n0 + nn] = ((r[0] + r[1024]) + (r[2048] + r[3072])) + ((r[4096] + r[5120]) + (r[6144] + r[7168])); }
    }
  }
  __syncthreads();
}
__device__ __forceinline__ void p0_zero_vpad(const Frame& F) {
  bf16* Vp = (bf16*)(F.ws + WS_VP);
  const int per = MPOS0 * 256 / 8;
  for (int i = blockIdx.x * NTHR + F.tid; i < 16 * per; i += gridDim.x * NTHR) { const int bh = i / per, e = i % per;
    *(v4u*)(Vp + (size_t)bh * PADT * 256 + (size_t)e * 8) = (v4u){0u, 0u, 0u, 0u}; }
}
__device__ __forceinline__ void p0_lam(const Frame& F, const Args& a) {
  if (blockIdx.x == 0 && F.wave == 0) {
    const int l = F.lane;
    float s1 = a.in[IN_LQ1][l] * a.in[IN_LK1][l] + a.in[IN_LQ1][l + 64] * a.in[IN_LK1][l + 64];
    float s2 = a.in[IN_LQ2][l] * a.in[IN_LK2][l] + a.in[IN_LQ2][l + 64] * a.in[IN_LK2][l + 64];
    s1 = wave_sum(s1); s2 = wave_sum(s2);
    if (l == 0) *(float*)(F.ws + WS_LAM) = __expf(s1) - __expf(s2) + 0.2f;
  }
}

struct EpiProj {
  static constexpr bool PERM = true, AFTER_DRAIN = false;
  bf16 *Qb, *Kp, *Vp, *MQ, *MK, *MV, *MO; const float *qg, *kg; LAS float* xch;
  __device__ __forceinline__ void operator()(const pg8::f32x4 (&acc)[2][2][4][2], const pg8::Unit& u, int wr, int wc, int fr, int fq) const {
    const int pn = u.pn, b = u.pm >> 3, tb = (u.pm & 7) * 256 + wr * 64 + fr, d0 = wc * 32 + fq * 8;
    if (pn < 8) {
      const bool isk = pn >= 4; const int h = pn & 3;
      float ssq[2][4][2];
#pragma unroll
      for (int ai = 0; ai < 2; ++ai)
#pragma unroll
        for (int m = 0; m < 4; ++m)
#pragma unroll
          for (int bj = 0; bj < 2; ++bj) { float s = 0.f;
#pragma unroll
            for (int n = 0; n < 2; ++n) { const pg8::f32x4 x = acc[ai][bj][m][n]; s += (x[0] * x[0] + x[1] * x[1]) + (x[2] * x[2] + x[3] * x[3]); }
            s += __shfl_xor(s, 16); s += __shfl_xor(s, 32); ssq[ai][m][bj] = s;
            if (fq == 0) xch[((ai * 128 + wr * 64 + m * 16 + fr) * 2 + bj) * 4 + wc] = s; }
      asm volatile("s_waitcnt lgkmcnt(0)" ::: "memory"); __builtin_amdgcn_s_barrier(); asm volatile("" ::: "memory");
      const float* gp = (isk ? kg : qg) + d0; const f32x4 g0 = *(const f32x4*)gp, g1v = *(const f32x4*)(gp + 4);
      const float sc = isk ? 1.0f : QSCALE;
#pragma unroll
      for (int ai = 0; ai < 2; ++ai)
#pragma unroll
        for (int m = 0; m < 4; ++m)
#pragma unroll
          for (int bj = 0; bj < 2; ++bj) {
            const f32x4 p = *(const LAS f32x4*)(xch + ((ai * 128 + wr * 64 + m * 16 + fr) * 2 + bj) * 4);
            const float rs = rsqrtf(((p.x + p.y) + (p.z + p.w)) * (1.0f / 128.f) + EPS) * sc;
            const pg8::f32x4 v0 = acc[ai][bj][m][0], v1 = acc[ai][bj][m][1];
            v4u w; w.x = pk2(v0[0] * rs * g0.x, v0[1] * rs * g0.y); w.y = pk2(v0[2] * rs * g0.z, v0[3] * rs * g0.w);
            w.z = pk2(v1[0] * rs * g1v.x, v1[1] * rs * g1v.y); w.w = pk2(v1[2] * rs * g1v.z, v1[3] * rs * g1v.w);
            const int t = tb + ai * 128 + m * 16;
            bf16* dst = isk ? Kp + kp_off((b * 4 + h) * 2 + bj, POS0 + t, d0)
                            : Qb + ((size_t)((b * 4 + h) * 2 + bj) * SEQ + t) * 128 + d0;
            *(v4u*)dst = w; }
      return;
    }
#pragma unroll
    for (int ai = 0; ai < 2; ++ai)
#pragma unroll
      for (int m = 0; m < 4; ++m)
#pragma unroll
        for (int bj = 0; bj < 2; ++bj) {
          pg8::f32x4 v0 = acc[ai][bj][m][0], v1 = acc[ai][bj][m][1];
          const int t = tb + ai * 128 + m * 16;
          bf16* dst;
          if (pn < 12) { const int h = pn - 8; dst = Vp + ((size_t)(b * 4 + h) * PADT + POS0 + t) * 256 + bj * 128 + d0; }
          else if (pn < 16) { const int h = 2 * (pn & 1) + bj; dst = (pn >= 14 ? MK : MQ) + ((size_t)(b * 4 + h) * PADT + POS0 + t) * 128 + d0; }
          else if (pn < 20) { const int h = pn - 16; dst = MV + ((size_t)(b * 4 + h) * PADT + POS0 + t) * 256 + bj * 128 + d0; }
          else dst = MO + (size_t)(b * SEQ + t) * 1024 + (pn - 20) * 256 + bj * 128 + d0;
          v4u w; w.x = pk2(v0[0], v0[1]); w.y = pk2(v0[2], v0[3]); w.z = pk2(v1[0], v1[1]); w.w = pk2(v1[2], v1[3]);
          *(v4u*)dst = w; }
  }
};
__device__ __forceinline__ void p1_meta_finalize(const Frame& F, const Args& a) {
  const bool spread = gridDim.x >= 2 * NMETA;
  if (spread ? ((blockIdx.x & 1) != 0 || blockIdx.x >= 2 * NMETA) : (blockIdx.x >= NMETA)) return;
  const int mrow = spread ? (int)(blockIdx.x >> 1) : (int)blockIdx.x, tid = F.tid, lane = F.lane, w = F.wave;
  const float* meta = a.in[IN_META] + (size_t)mrow * DM; const float* PM0 = (const float*)(F.ws + WS_PM) + (size_t)mrow * NPROJ;
#define PM_P4(i, p) ((PM0[(size_t)(16 * (p)) * NPROJ + (i)] + PM0[(size_t)(16 * ((p) + 1)) * NPROJ + (i)]) + (PM0[(size_t)(16 * ((p) + 2)) * NPROJ + (i)] + PM0[(size_t)(16 * ((p) + 3)) * NPROJ + (i)]))
#define PM_AT(i) ((PM_P4(i, 0) + PM_P4(i, 4)) + (PM_P4(i, 8) + PM_P4(i, 12)))
  LAS float* red = (LAS float*)(F.lds + XCH_OFF);
  const f32x4 mv = ((const f32x4*)meta)[tid];
  float s = wave_sum((mv.x * mv.x + mv.y * mv.y) + (mv.z * mv.z + mv.w * mv.w));
  if (lane == 0) red[w] = s;
  __syncthreads();
  float tot = 0.f;
#pragma unroll
  for (int i = 0; i < 8; ++i) tot += red[i];
  const float rs = rsqrtf(tot * (1.0f / DM) + EPS);
  bf16* Kp = (bf16*)(F.ws + WS_KP); bf16* Vp = (bf16*)(F.ws + WS_VP); bf16* MQ = (bf16*)(F.ws + WS_MQ); bf16* MK = (bf16*)(F.ws + WS_MK); bf16* MV = (bf16*)(F.ws + WS_MV);
  const int pos = MPOS0 + mrow;
  const int c = tid * 2;
  const float kv0 = PM_AT(1024 + w * 128 + lane), kv1 = PM_AT(1024 + w * 128 + lane + 64);
  const float a0 = PM_AT(2048 + c), a1 = PM_AT(2048 + c + 1), b0 = PM_AT(3072 + c), b1 = PM_AT(3072 + c + 1), c0 = PM_AT(4096 + c), c1 = PM_AT(4096 + c + 1);
  {
    const float v0 = kv0 * rs, v1 = kv1 * rs;
    const float rk = rsqrtf(wave_sum(v0 * v0 + v1 * v1) * (1.0f / 128.f) + EPS);
    const float* kg = a.in[IN_KNG];
    const unsigned short o0 = (unsigned short)f2bf(v0 * rk * kg[lane]), o1 = (unsigned short)f2bf(v1 * rk * kg[lane + 64]);
    for (int b = 0; b < NB; ++b) { const int bhm = (b * 4 + (w >> 1)) * 2 + (w & 1); Kp[kp_off(bhm, pos, lane)] = o0; Kp[kp_off(bhm, pos, lane + 64)] = o1; }
  }
  {
    const unsigned o = pk2(a0 * rs, a1 * rs); const int h = c >> 8, e = c & 255;
    for (int b = 0; b < NB; ++b) *(unsigned*)(Vp + ((size_t)(b * 4 + h) * PADT + pos) * 256 + e) = o;
    const unsigned o2 = pk2(b0 * rs, b1 * rs); const bool isk = c >= 512; const int cc = c & 511, hq = cc >> 7, d = cc & 127;
    for (int b = 0; b < NB; ++b) *(unsigned*)((isk ? MK : MQ) + ((size_t)(b * 4 + hq) * PADT + pos) * 128 + d) = o2;
    const unsigned o3 = pk2(c0 * rs, c1 * rs);
    for (int b = 0; b < NB; ++b) *(unsigned*)(MV + ((size_t)(b * 4 + h) * PADT + pos) * 256 + e) = o3;
  }
  __syncthreads();
}
#undef PM_AT
#undef PM_P4

namespace att {
using f32x16 = __attribute__((ext_vector_type(16))) float;
using s16x4 = __attribute__((ext_vector_type(4))) short;
constexpr int STEPS_BHM = 152, NSTEPS = 32 * STEPS_BHM;
constexpr int SHM_V = 64 * 256 * 2, SHM_K = 64 * 128 * 2;
constexpr int LDS_V = 0, LDS_K = 2 * SHM_V, LDS_Q = LDS_K + SHM_K, LDS_WS = LDS_Q + 8 * 8192;
constexpr float THR2 = 8.0f;
#define KSWZ(row, colB) ((row) * 256 + ((colB) ^ (((row) & 7) << 4)))
#define SBAR() __builtin_amdgcn_sched_barrier(0)
__device__ __forceinline__ int crow(int r, int hi) { return (r & 3) + 8 * (r >> 2) + 4 * hi; }
__device__ __forceinline__ unsigned cvtpk(float lo, float hi) { unsigned r; asm volatile("v_cvt_pk_bf16_f32 %0, %1, %2" : "=v"(r) : "v"(lo), "v"(hi)); return r; }
__device__ __forceinline__ int qb_start(int qb) { return 2 * qb * qb + 3 * qb; }
__device__ __forceinline__ int chunk_of(int s, int NA) { return ((s + 1) * NA - 1) / NSTEPS; }

template <int OFF> __device__ __forceinline__ s16x4 tr_read(int vb) {
  s16x4 r; asm volatile("ds_read_b64_tr_b16 %0, %1 offset:%2" : "=&v"(r) : "v"(vb), "i"(OFF) : "memory"); return r;
}
constexpr int v_rd_off(int d0, int ks, int half) { return d0 * 512 + ks * 8192 + half * 4096; }
template <int D0> __device__ __forceinline__ void pv_one(f32x16& od, int vb, bf16x8 pa0, bf16x8 pa1, bf16x8 pa2, bf16x8 pa3) {
#define PK(L, H) (bf16x8){L[0], L[1], L[2], L[3], H[0], H[1], H[2], H[3]}
  { const s16x4 l0 = tr_read<v_rd_off(D0, 0, 0)>(vb), h0 = tr_read<v_rd_off(D0, 0, 1)>(vb), l1 = tr_read<v_rd_off(D0, 1, 0)>(vb), h1 = tr_read<v_rd_off(D0, 1, 1)>(vb);
    asm volatile("s_waitcnt lgkmcnt(0)" ::: "memory"); SBAR();
    od = __builtin_amdgcn_mfma_f32_32x32x16_bf16(pa0, PK(l0, h0), od, 0, 0, 0);
    od = __builtin_amdgcn_mfma_f32_32x32x16_bf16(pa1, PK(l1, h1), od, 0, 0, 0); }
  SBAR();
  { const s16x4 l2 = tr_read<v_rd_off(D0, 2, 0)>(vb), h2 = tr_read<v_rd_off(D0, 2, 1)>(vb), l3 = tr_read<v_rd_off(D0, 3, 0)>(vb), h3 = tr_read<v_rd_off(D0, 3, 1)>(vb);
    asm volatile("s_waitcnt lgkmcnt(0)" ::: "memory"); SBAR();
    od = __builtin_amdgcn_mfma_f32_32x32x16_bf16(pa2, PK(l2, h2), od, 0, 0, 0);
    od = __builtin_amdgcn_mfma_f32_32x32x16_bf16(pa3, PK(l3, h3), od, 0, 0, 0); }
#undef PK
}

__device__ __forceinline__ void segment(const Frame& F, int bhm, int qb, int j0, int j1, int slot) {
  const int tid = F.tid, wid = F.wave, lane = F.lane, r32 = lane & 31, hi = lane >> 5;
  const bf16* Qg = (const bf16*)(F.ws + WS_Q) + ((size_t)bhm * SEQ + qb * 256 + wid * 32 + r32) * 128 + hi * 8;
  const bf16* Kg = (const bf16*)(F.ws + WS_KP) + (size_t)bhm * 33 * 8192;
  const bf16* Vg = (const bf16*)(F.ws + WS_VP) + (size_t)(bhm >> 1) * PADT * 256;
  LAS unsigned char* lds = F.lds;
  LAS float* wsl = (LAS float*)(lds + LDS_WS) + wid * 64;
  const float slope2 = exp2f(-2.0f * (float)(((bhm >> 1) & 3) + 1)) * LOG2E;
  unsigned ksrc0, vsrc0;
  ksrc0 = (unsigned)tid * 16u;
  { const int a8 = tid >> 8, b = (tid >> 2) & 7, k = 8 * (b >> 2) + 4 * a8 + (b & 3), c = ((tid >> 5) & 7) * 32 + (tid & 3) * 8; vsrc0 = (unsigned)(k * 256 + c) * 2u; }
#define STAGE_K(j) do { const char* kt = (const char*)(Kg + (size_t)(j) * 8192); \
    _Pragma("unroll") for (int _i = 0; _i < 2; ++_i) __builtin_amdgcn_global_load_lds((const unsigned*)(kt + (ksrc0 + _i * 8192u)), (LAS unsigned*)(lds + LDS_K + _i * 8192 + wid * 1024), 16, 0, 0); } while (0)
#define STAGE_V(buf, j) do { const char* vt = (const char*)(Vg + (size_t)(j) * 64 * 256); \
    _Pragma("unroll") for (int _i = 0; _i < 4; ++_i) __builtin_amdgcn_global_load_lds((const unsigned*)(vt + (vsrc0 + _i * 8192u)), (LAS unsigned*)(lds + LDS_V + (buf) * SHM_V + _i * 8192 + wid * 1024), 16, 0, 0); } while (0)
  const int lt = (((r32 << 1) | hi) ^ ((r32 >> 3) & 1)) << 4;
  LAS unsigned char* Qs = lds + LDS_Q + wid * 8192;
#pragma unroll
  for (int d0 = 0; d0 < 8; ++d0) { const bf16x8 qv = *(const bf16x8*)(Qg + d0 * 16); *(LAS bf16x8*)(Qs + d0 * 1024 + lt) = qv; }
  f32x16 o[8];
#pragma unroll
  for (int d = 0; d < 8; ++d)
#pragma unroll
    for (int r = 0; r < 16; ++r) o[d][r] = 0.f;
  float m_reg = -1e30f, l_reg = 0.f;
  const int vb0 = (int)(uintptr_t)(lds + LDS_V) + (((lane & 3) << 3) | (((lane >> 2) & 3) << 6) | (((lane >> 4) & 1) << 5) | (((lane >> 5) & 1) << 8));
  STAGE_K(j0); STAGE_V(0, j0);
  VM_WAIT(); __syncthreads();
  for (int j = j0; j < j1; ++j) {
    const int cur = (j - j0) & 1;
    if (j + 1 < j1) STAGE_V(cur ^ 1, j + 1);
    SBAR();
    f32x16 p0 = {}, p1 = {};
    { const LAS unsigned char* Ks = lds + LDS_K;
#pragma unroll
      for (int d0 = 0; d0 < 8; ++d0) {
        const bf16x8 b0 = *(const LAS bf16x8*)(Ks + d0 * 2048 + lt);
        const bf16x8 b1 = *(const LAS bf16x8*)(Ks + d0 * 2048 + 1024 + lt);
        const bf16x8 qf = *(const LAS bf16x8*)(Qs + d0 * 1024 + lt);
        p0 = __builtin_amdgcn_mfma_f32_32x32x16_bf16(b0, qf, p0, 0, 0, 0);
        p1 = __builtin_amdgcn_mfma_f32_32x32x16_bf16(b1, qf, p1, 0, 0, 0); } }
    asm volatile("s_waitcnt lgkmcnt(0)" ::: "memory"); __builtin_amdgcn_s_barrier(); asm volatile("" ::: "memory");
    if (j + 1 < j1) STAGE_K(j + 1);
    SBAR();
    if (j == 0) {
#pragma unroll
      for (int r = 0; r < 16; ++r) p0[r] = -INFINITY;
#pragma unroll
      for (int r = 0; r < 8; ++r) p1[r] = -INFINITY;
    }
    int ln2 = threadIdx.x & 63; asm volatile("" : "+v"(ln2));
    const int hi2 = ln2 >> 5;
    const int jb = j - (4 * qb + 1);
    if (jb >= 0) {
      const int kb = 64 * jb + 4 * hi2, qrel = wid * 32 + (ln2 & 31);
#pragma unroll
      for (int r = 0; r < 16; ++r) { const int kv = kb + (r & 3) + 8 * (r >> 2); if (kv > qrel) p0[r] = -INFINITY; if (kv + 32 > qrel) p1[r] = -INFINITY; }
    }
    const float off0 = slope2 * (float)(64 * j + 4 * hi2), off1 = off0 + 32.0f * slope2;
#pragma unroll
    for (int r = 0; r < 16; ++r) { const float sb = slope2 * (float)((r & 3) + 8 * (r >> 2)); p0[r] += sb; p1[r] += sb; }
    float pm0 = p0[0], pm1 = p1[0];
#pragma unroll
    for (int r = 1; r < 16; ++r) { pm0 = fmaxf(pm0, p0[r]); pm1 = fmaxf(pm1, p1[r]); }
    float pmax = fmaxf(pm0 + off0, pm1 + off1);
    { auto rr = __builtin_amdgcn_permlane32_swap(__float_as_uint(pmax), __float_as_uint(pmax), false, false);
      pmax = fmaxf(__uint_as_float(rr[0]), __uint_as_float(rr[1])); }
    float mn, alpha;
    if (__builtin_expect(__all(pmax - m_reg <= THR2), 1)) { mn = m_reg; alpha = 1.f; }
    else { mn = fmaxf(m_reg, pmax); alpha = __builtin_amdgcn_exp2f(m_reg - mn); m_reg = mn; }
    const float c0 = off0 - mn, c1 = off1 - mn;
    float ps = 0.f;
#pragma unroll
    for (int r = 0; r < 16; ++r) { p0[r] = __builtin_amdgcn_exp2f(p0[r] + c0); p1[r] = __builtin_amdgcn_exp2f(p1[r] + c1); ps += p0[r] + p1[r]; }
    { auto rr = __builtin_amdgcn_permlane32_swap(__float_as_uint(ps), __float_as_uint(ps), false, false);
      ps = __uint_as_float(rr[0]) + __uint_as_float(rr[1]); }
    l_reg = l_reg * alpha + ps;
    if (__any(alpha < 1.f)) { if (hi == 0) wsl[r32] = alpha; asm volatile("s_waitcnt lgkmcnt(0)" ::: "memory");
#pragma unroll
      for (int rg = 0; rg < 4; ++rg) { const f32x4 al = *(const LAS f32x4*)(wsl + 8 * rg + 4 * hi);
#pragma unroll
        for (int d = 0; d < 8; ++d) { o[d][4 * rg + 0] *= al.x; o[d][4 * rg + 1] *= al.y; o[d][4 * rg + 2] *= al.z; o[d][4 * rg + 3] *= al.w; }
        SBAR(); } }
    bf16x8 pa0, pa1, pa2, pa3;
#define PK4(P, BASE, OUT) do { unsigned a0 = cvtpk(P[BASE + 0], P[BASE + 1]), a1 = cvtpk(P[BASE + 2], P[BASE + 3]);   \
    unsigned b0 = cvtpk(P[BASE + 4], P[BASE + 5]), b1 = cvtpk(P[BASE + 6], P[BASE + 7]);                              \
    auto r0 = __builtin_amdgcn_permlane32_swap(a0, b0, false, false); auto r1 = __builtin_amdgcn_permlane32_swap(a1, b1, false, false); \
    v4u w = {r0[0], r1[0], r0[1], r1[1]}; OUT = *reinterpret_cast<bf16x8*>(&w); } while (0)
    PK4(p0, 0, pa0); PK4(p0, 8, pa1); PK4(p1, 0, pa2); PK4(p1, 8, pa3);
#undef PK4
    SBAR();
    { const int vb = vb0 + cur * SHM_V;
      pv_one<0>(o[0], vb, pa0, pa1, pa2, pa3); pv_one<1>(o[1], vb, pa0, pa1, pa2, pa3); pv_one<2>(o[2], vb, pa0, pa1, pa2, pa3); pv_one<3>(o[3], vb, pa0, pa1, pa2, pa3);
      pv_one<4>(o[4], vb, pa0, pa1, pa2, pa3); pv_one<5>(o[5], vb, pa0, pa1, pa2, pa3); pv_one<6>(o[6], vb, pa0, pa1, pa2, pa3); pv_one<7>(o[7], vb, pa0, pa1, pa2, pa3); }
    VM_WAIT(); __syncthreads();
  }
  { int lane2 = threadIdx.x & 63, slot2 = slot; asm volatile("" : "+v"(lane2), "+s"(slot2));
    const int r32e = lane2 & 31, hie = lane2 >> 5;
    bf16* PO = (bf16*)(F.ws + WS_PO) + (size_t)slot2 * 256 * 256; float* ML = (float*)(F.ws + WS_ML) + (size_t)slot2 * 512;
    LAS float* wse = (LAS float*)(F.lds + LDS_WS) + wid * 64;
    if (hie == 0) { wse[r32e] = l_reg; ML[(wid * 32 + r32e) * 2] = m_reg; ML[(wid * 32 + r32e) * 2 + 1] = l_reg; }
    asm volatile("s_waitcnt lgkmcnt(0)" ::: "memory");
    char* Ob = (char*)(PO + (size_t)(wid * 32) * 256);
    const bool odd = (r32e & 1) != 0;
    const unsigned lo = (unsigned)(4 * hie * 256 + (r32e & ~1) + (odd ? 32 : 0)) * 2u;
#pragma unroll
    for (int r = 0; r < 16; ++r) { const int rowc = (r & 3) + 8 * (r >> 2); const float lv = wse[rowc + 4 * hie]; const float rl = lv > 0.f ? __builtin_amdgcn_rcpf(lv) : 0.f;
#pragma unroll
      for (int dp = 0; dp < 4; ++dp) { const float va = o[2 * dp][r] * rl, vb = o[2 * dp + 1][r] * rl;
        const float send = odd ? va : vb, keep = odd ? vb : va;
        const float recv = __builtin_bit_cast(float, __builtin_amdgcn_update_dpp(0, __builtin_bit_cast(int, send), 0xB1, 0xF, 0xF, true));
        *(unsigned*)(Ob + (lo + (unsigned)(rowc * 256 + dp * 64) * 2u)) = odd ? pk2(recv, keep) : pk2(keep, recv); }
      SBAR(); } }
  __syncthreads();
#undef STAGE_K
#undef STAGE_V
}

__device__ __forceinline__ void phase(const Frame& F, int ca, int NA) {
  int s0 = (int)(((long)ca * NSTEPS) / NA); const int s1 = (int)(((long)(ca + 1) * NSTEPS) / NA);
  while (s0 < s1) {
    const int bhm = s0 / STEPS_BHM, rem = s0 - bhm * STEPS_BHM;
    int qb = 0;
#pragma unroll 1
    for (int q = 1; q < 8; ++q) if (rem >= qb_start(q)) qb = q;
    const int j0 = rem - qb_start(qb), nst = 4 * qb + 5;
    const int j1 = (j0 + (s1 - s0) < nst) ? j0 + (s1 - s0) : nst;
    const int slot = bhm * 16 + qb + chunk_of(s0, NA) - chunk_of(bhm * STEPS_BHM, NA);
    segment(F, bhm, qb, j0, j1, slot);
    s0 += j1 - j0;
  }
}
#undef KSWZ
#undef SBAR
}
namespace ml {
constexpr int QST = 136, TST = 72;
constexpr int L_RQ = 0, L_RK = 17152, L_QS = 34304, L_QW = 51712, L_KS = 69120, L_KWT = 86528, L_VT = 104960  , L_SP = 0  , L_G = 141824, L_CW = 143872;
constexpr int L_HT = 0;
constexpr int G_A = 0, G_M = 64, G_WI = 128, G_EM = 192, G_DEN = 256, G_WG = 320, G_SC = 384, G_N = 0;
constexpr int L_NV = L_CW + 5120;
constexpr int L_SSQ = L_KWT;
__device__ __forceinline__ float shfl_up_f(float v, int d) { return __shfl_up(v, d); }

struct StageCW { float v[3]; };
__device__ __forceinline__ void issue_cw(const Frame& F, const Args& a, int h, StageCW& st) {
#pragma unroll
  for (int i = 0; i < 3; ++i) { const int e = F.tid + NTHR * i; st.v[i] = 0.f;
    if (e < 2 * 5 * 128) { const int qk = e / 640, j = (e / 128) % 5, d = e & 127; const int ch = qk * 512 + h * 128 + d; st.v[i] = j < 4 ? a.in[IN_CW][j * 1024 + ch] : a.in[IN_CB][ch]; } }
}
__device__ __forceinline__ void commit_cw(const Frame& F, const StageCW& st) {
  LAS float* CW = (LAS float*)(F.lds + L_CW);
#pragma unroll
  for (int i = 0; i < 3; ++i) { const int e = F.tid + NTHR * i; if (e < 2 * 5 * 128) CW[e] = st.v[i]; }
}
struct StageRaw { v4u v[3]; };
__device__ __forceinline__ void issue_raw(const Frame& F, const bf16* g, int pos0, StageRaw& st) {
#pragma unroll
  for (int i = 0; i < 3; ++i) { const int p = F.tid + NTHR * i, row = p >> 4, ch = p & 15, pos = pos0 - 3 + row;
    st.v[i] = (v4u){0u, 0u, 0u, 0u}; if (p < 67 * 16 && pos >= MPOS0) st.v[i] = *(const v4u*)(g + (size_t)pos * 128 + ch * 8); }
}
__device__ __forceinline__ void commit_raw(const Frame& F, int lds_off, const StageRaw& st) {
#pragma unroll
  for (int i = 0; i < 3; ++i) { const int p = F.tid + NTHR * i, row = p >> 4, ch = p & 15; if (p < 67 * 16) *(LAS v4u*)(F.lds + lds_off + row * 256 + ch * 16) = st.v[i]; }
}
__device__ __forceinline__ void conv16(const Frame& F, int qk, int lds_off, int t, int d0, float (&y)[16]) {
  const LAS float* CW = (const LAS float*)(F.lds + L_CW);
#pragma unroll
  for (int e = 0; e < 16; ++e) y[e] = CW[(qk * 5 + 4) * 128 + d0 + e];
#pragma unroll
  for (int j = 0; j < 4; ++j) { const LAS v4u* rp = (const LAS v4u*)(F.lds + lds_off + (t + j) * 256 + d0 * 2); const v4u r0 = rp[0], r1 = rp[1];
    const LAS float* cw = CW + (qk * 5 + j) * 128 + d0;
    y[0] += cw[0] * bflo(r0.x); y[1] += cw[1] * bfhi(r0.x); y[2] += cw[2] * bflo(r0.y); y[3] += cw[3] * bfhi(r0.y); y[4] += cw[4] * bflo(r0.z); y[5] += cw[5] * bfhi(r0.z); y[6] += cw[6] * bflo(r0.w); y[7] += cw[7] * bfhi(r0.w);
    y[8] += cw[8] * bflo(r1.x); y[9] += cw[9] * bfhi(r1.x); y[10] += cw[10] * bflo(r1.y); y[11] += cw[11] * bfhi(r1.y); y[12] += cw[12] * bflo(r1.z); y[13] += cw[13] * bfhi(r1.z); y[14] += cw[14] * bflo(r1.w); y[15] += cw[15] * bfhi(r1.w); }
#pragma unroll
  for (int e = 0; e < 16; ++e) y[e] = y[e] / (1.0f + __expf(-y[e]));
}
struct StageVT { v4u v[4]; };
__device__ __forceinline__ void issue_vt(const Frame& F, const bf16* MVg, int pos0, StageVT& st) {
#pragma unroll
  for (int i = 0; i < 4; ++i) { const int p = F.tid + NTHR * i, row = p >> 5, ch = p & 31; st.v[i] = (v4u){0u, 0u, 0u, 0u};
    if (pos0 + row >= MPOS0) st.v[i] = *(const v4u*)(MVg + (size_t)(pos0 + row) * 256 + ch * 8); }
}
__device__ __forceinline__ void commit_vt(const Frame& F, const StageVT& st) {
#pragma unroll
  for (int i = 0; i < 4; ++i) { const int p = F.tid + NTHR * i, row = p >> 5, ch = p & 31; const v4u v4 = st.v[i];
    LAS bf16* vt = (LAS bf16*)(F.lds + L_VT) + (ch * 8) * TST + row;
    vt[0 * TST] = (bf16)(v4.x & 0xffff); vt[1 * TST] = (bf16)(v4.x >> 16); vt[2 * TST] = (bf16)(v4.y & 0xffff); vt[3 * TST] = (bf16)(v4.y >> 16);
    vt[4 * TST] = (bf16)(v4.z & 0xffff); vt[5 * TST] = (bf16)(v4.z >> 16); vt[6 * TST] = (bf16)(v4.w & 0xffff); vt[7 * TST] = (bf16)(v4.w >> 16); }
}

__device__ __forceinline__ void taskA(const Frame& F, const Args& a, int task) {
  const int bh = task >> 5, c = task & 31, h = bh & 3, tid = F.tid, w = F.wave, lane = F.lane, fr = lane & 15, kq = lane >> 4, pos0 = 64 * c;
  LAS unsigned char* lds = F.lds; LAS float* G = (LAS float*)(lds + L_G);
  const bf16* MKg = (const bf16*)(F.ws + WS_MK) + (size_t)bh * PADT * 128; const bf16* MVg = (const bf16*)(F.ws + WS_MV) + (size_t)bh * PADT * 256;
  StageCW scw; StageRaw srk; StageVT svt; float li = -1e30f, lf = 0.f;
  issue_cw(F, a, h, scw); issue_raw(F, MKg, pos0, srk); issue_vt(F, MVg, pos0, svt);
  { const bool dead = pos0 + lane < MPOS0; if (w == 0 && !dead) { li = ((const float*)(F.ws + WS_LI))[bh * PADT + pos0 + lane]; lf = ((const float*)(F.ws + WS_LF))[bh * PADT + pos0 + lane]; } }
  __syncthreads();
  commit_cw(F, scw); commit_raw(F, L_RK, srk); commit_vt(F, svt);
  if (w == 0) {
    float bs = lf;
#pragma unroll
    for (int d = 1; d < 64; d <<= 1) { const float o = shfl_up_f(bs, d); if (lane >= d) bs += o; }
    const float av = li - bs; float mx = av;
#pragma unroll
    for (int o = 1; o < 64; o <<= 1) mx = fmaxf(mx, __shfl_xor(mx, o));
    G[G_WG + lane] = __expf(av - mx);
    if (lane == 63) { float* gs = (float*)(F.ws + WS_GS) + (size_t)(bh * 33 + c) * 2; gs[0] = bs; gs[1] = mx; }
  }
  __syncthreads();
  { const int t = tid >> 3, d0 = (tid & 7) * 16; float y[16]; conv16(F, 1, L_RK, t, d0, y);
    const float sw = 0.08838834764831845f * G[G_WG + t]; LAS bf16* kt = (LAS bf16*)(lds + L_KWT) + d0 * TST + t;
#pragma unroll
    for (int e = 0; e < 16; ++e) kt[e * TST] = (bf16)f2bf(y[e] * sw); }
  __syncthreads();
  f32x4* DCg = (f32x4*)(F.ws + WS_DC) + ((size_t)(bh * 32 + c) * 128) * 64;
#pragma unroll
  for (int jj = 0; jj < 2; ++jj) { const int j = 2 * w + jj;
    const bf16x8 bv0 = *(const LAS bf16x8*)(lds + L_VT + ((16 * j + fr) * TST + 8 * kq) * 2), bv1 = *(const LAS bf16x8*)(lds + L_VT + ((16 * j + fr) * TST + 32 + 8 * kq) * 2);
#pragma unroll
    for (int i = 0; i < 8; ++i) { f32x4 acc = {0.f, 0.f, 0.f, 0.f};
      const bf16x8 k0 = *(const LAS bf16x8*)(lds + L_KWT + ((16 * i + fr) * TST + 8 * kq) * 2), k1 = *(const LAS bf16x8*)(lds + L_KWT + ((16 * i + fr) * TST + 32 + 8 * kq) * 2);
      acc = __builtin_amdgcn_mfma_f32_16x16x32_bf16(k0, bv0, acc, 0, 0, 0); acc = __builtin_amdgcn_mfma_f32_16x16x32_bf16(k1, bv1, acc, 0, 0, 0);
      DCg[(size_t)(i * 16 + j) * 64 + lane] = acc; } }
  if (tid < 128) { const LAS v4u* kr = (const LAS v4u*)(lds + L_KWT + tid * TST * 2); float s = 0.f;
#pragma unroll
    for (int q = 0; q < 8; ++q) { const v4u x = kr[q]; s += (bflo(x.x) + bfhi(x.x)) + (bflo(x.y) + bfhi(x.y)) + (bflo(x.z) + bfhi(x.z)) + (bflo(x.w) + bfhi(x.w)); }
    ((float*)(F.ws + WS_DN))[(size_t)(bh * 32 + c) * 128 + tid] = s; }
}

__device__ __forceinline__ void scanB(const Frame& F) {
  const float* GS = (const float*)(F.ws + WS_GS);
  LAS float* cf = (LAS float*)F.lds;
  for (int blk = blockIdx.x; blk < 16 * 16; blk += gridDim.x) { const int bh = blk >> 4, r = (blk & 15) * NTHR + F.tid, i = r >> 10, j = (r >> 6) & 15, ln = r & 63;
    __syncthreads();
    if (F.wave == 0) {
      const int c = F.lane & 31; const v2u gs = *(const v2u*)(GS + (size_t)(bh * 33 + c) * 2); const unsigned g0 = gs.x, g1 = gs.y;
      const float bL = __builtin_bit_cast(float, g0), ml = __builtin_bit_cast(float, g1);
      float mm = 0.f, fa = 0.f, fb = 0.f, mout = 0.f;
#pragma unroll
      for (int cc = 0; cc < 32; ++cc) { const float b_ = __builtin_bit_cast(float, __builtin_amdgcn_readlane(__builtin_bit_cast(int, bL), cc)), l_ = __builtin_bit_cast(float, __builtin_amdgcn_readlane(__builtin_bit_cast(int, ml), cc));
        const float me = fmaxf(mm, l_); if (c == cc) { fa = __expf(mm - me); fb = __expf(l_ - me); } mm = b_ + me; if (c == cc) mout = mm; }
      if (F.lane < 32) { cf[2 * c] = fa; cf[2 * c + 1] = fb; if ((blk & 15) == 0) ((float*)(F.ws + WS_MS))[bh * 33 + c + 1] = mout; }
    }
    __syncthreads();
    const f32x4* dc0 = (const f32x4*)(F.ws + WS_DC) + ((size_t)(bh * 32) * 128 + (i * 16 + j)) * 64 + ln;
    v2u* cs = (v2u*)(F.ws + WS_CS) + ((((size_t)bh * 33) * 8 + i) * 16 + j) * 64 + ln;
    f32x4 s0 = {0.f, 0.f, 0.f, 0.f}, dv[32];
#pragma unroll
    for (int c = 0; c < 32; ++c) dv[c] = dc0[(size_t)c * 128 * 64];
#pragma unroll
    for (int c = 0; c < 32; ++c) { const float fa = cf[2 * c], fb = cf[2 * c + 1];
      s0 = s0 * fa + dv[c] * fb;
      v2u o; o.x = pk2(s0.x, s0.y); o.y = pk2(s0.z, s0.w); cs[(size_t)(c + 1) * 8 * 16 * 64] = o; }
    if ((blk & 15) == 0 && F.tid < 128) {
      const float* dn = (const float*)(F.ws + WS_DN) + (size_t)(bh * 32) * 128 + F.tid; float* ns = (float*)(F.ws + WS_NS) + (size_t)(bh * 33) * 128 + F.tid; float n = 0.f;
      float dnv[32];
#pragma unroll
      for (int c = 0; c < 32; ++c) dnv[c] = dn[(size_t)c * 128];
#pragma unroll
      for (int c = 0; c < 32; ++c) { n = n * cf[2 * c] + dnv[c] * cf[2 * c + 1]; ns[(size_t)(c + 1) * 128] = n; }
    }
  }
}

__device__ __forceinline__ void taskC(const Frame& F, const Args& a, int task) {
  TP_BEGIN(31);
  const int bh = task >> 5, c = (task & 31) + 1, b = bh >> 2, h = bh & 3, tid = F.tid, w = F.wave, lane = F.lane, fr = lane & 15, kq = lane >> 4, pos0 = 64 * c;
  LAS unsigned char* lds = F.lds; LAS float* G = (LAS float*)(lds + L_G); LAS float* NV = (LAS float*)(lds + L_NV);
  const bf16* MQg = (const bf16*)(F.ws + WS_MQ) + (size_t)bh * PADT * 128; const bf16* MKg = (const bf16*)(F.ws + WS_MK) + (size_t)bh * PADT * 128;
  const bf16* MVg = (const bf16*)(F.ws + WS_MV) + (size_t)bh * PADT * 256;
  const float m = ((const float*)(F.ws + WS_MS))[bh * 33 + c];
  StageCW scw; StageRaw srq, srk; StageVT svt; float nvv = 0.f, li = 0.f, lf = 0.f;
  issue_cw(F, a, h, scw); issue_raw(F, MQg, pos0, srq); issue_raw(F, MKg, pos0, srk); issue_vt(F, MVg, pos0, svt);
  if (tid < 128) nvv = ((const float*)(F.ws + WS_NS))[(size_t)(bh * 33 + c) * 128 + tid];
  if (w == 0) { li = ((const float*)(F.ws + WS_LI))[bh * PADT + pos0 + lane]; lf = ((const float*)(F.ws + WS_LF))[bh * PADT + pos0 + lane]; }
  __syncthreads();
  commit_cw(F, scw); commit_raw(F, L_RQ, srq); commit_raw(F, L_RK, srk); commit_vt(F, svt);
  if (tid < 128) NV[tid] = nvv;
  if (w == 0) {
    float bs = lf;
#pragma unroll
    for (int d = 1; d < 64; d <<= 1) { const float o = shfl_up_f(bs, d); if (lane >= d) bs += o; }
    const float av = li - bs; float cm = av;
#pragma unroll
    for (int d = 1; d < 64; d <<= 1) { const float o = shfl_up_f(cm, d); if (lane >= d) cm = fmaxf(cm, o); }
    const float Mt = fmaxf(m, cm);
    G[G_A + lane] = av; G[G_M + lane] = Mt; G[G_WI + lane] = __expf(m - Mt); G[G_EM + lane] = __expf(-(bs + Mt));
  }
  __syncthreads(); TP_END(31, F.ws); TP_BEGIN(32);
  { const int t = tid >> 3, d0 = (tid & 7) * 16; const float wi = G[G_WI + t]; float y[16];
    conv16(F, 0, L_RQ, t, d0, y);
    { v4u o0, o1, w0, w1;
      o0.x = pk2(y[0], y[1]); o0.y = pk2(y[2], y[3]); o0.z = pk2(y[4], y[5]); o0.w = pk2(y[6], y[7]); o1.x = pk2(y[8], y[9]); o1.y = pk2(y[10], y[11]); o1.z = pk2(y[12], y[13]); o1.w = pk2(y[14], y[15]);
      w0.x = pk2(y[0] * wi, y[1] * wi); w0.y = pk2(y[2] * wi, y[3] * wi); w0.z = pk2(y[4] * wi, y[5] * wi); w0.w = pk2(y[6] * wi, y[7] * wi);
      w1.x = pk2(y[8] * wi, y[9] * wi); w1.y = pk2(y[10] * wi, y[11] * wi); w1.z = pk2(y[12] * wi, y[13] * wi); w1.w = pk2(y[14] * wi, y[15] * wi);
      LAS v4u* qs = (LAS v4u*)(lds + L_QS + (t * QST + d0) * 2); qs[0] = o0; qs[1] = o1;
      LAS v4u* qw = (LAS v4u*)(lds + L_QW + (t * QST + d0) * 2); qw[0] = w0; qw[1] = w1; }
    __builtin_amdgcn_sched_barrier(0);
    conv16(F, 1, L_RK, t, d0, y);
    { const float sc = 0.08838834764831845f; v4u o0, o1;
      o0.x = pk2(y[0] * sc, y[1] * sc); o0.y = pk2(y[2] * sc, y[3] * sc); o0.z = pk2(y[4] * sc, y[5] * sc); o0.w = pk2(y[6] * sc, y[7] * sc);
      o1.x = pk2(y[8] * sc, y[9] * sc); o1.y = pk2(y[10] * sc, y[11] * sc); o1.z = pk2(y[12] * sc, y[13] * sc); o1.w = pk2(y[14] * sc, y[15] * sc);
      LAS v4u* ks = (LAS v4u*)(lds + L_KS + (t * QST + d0) * 2); ks[0] = o0; ks[1] = o1; } }
  __syncthreads(); TP_END(32, F.ws); TP_BEGIN(33);
  v4u cb[4][2];
  { const v2u* cs = (const v2u*)(F.ws + WS_CS) + (((size_t)bh * 33 + c) * 8 * 16) * 64;
#pragma unroll
    for (int I = 0; I < 4; ++I)
#pragma unroll
      for (int jj = 0; jj < 2; ++jj) { const v2u lo_ = cs[(size_t)((2 * I) * 16 + 2 * w + jj) * 64 + lane], hi_ = cs[(size_t)((2 * I + 1) * 16 + 2 * w + jj) * 64 + lane]; cb[I][jj] = (v4u){lo_.x, lo_.y, hi_.x, hi_.y}; } }
  { const int si = w >> 1; const f32x4 as = *(const LAS f32x4*)(G + G_A + 16 * si + 4 * kq);
#pragma unroll
    for (int tt = 0; tt < 2; ++tt) { const int ti = 2 * (w & 1) + tt; f32x4 acc = {0.f, 0.f, 0.f, 0.f};
#pragma unroll
      for (int ks = 0; ks < 4; ++ks) { const bf16x8 af = *(const LAS bf16x8*)(lds + L_KS + ((16 * si + fr) * QST + 32 * ks + 8 * kq) * 2);
        const bf16x8 bfr = *(const LAS bf16x8*)(lds + L_QS + ((16 * ti + fr) * QST + 32 * ks + 8 * kq) * 2);
        acc = __builtin_amdgcn_mfma_f32_16x16x32_bf16(af, bfr, acc, 0, 0, 0); }
      const int t = 16 * ti + fr, s0 = 16 * si + 4 * kq; const float Mt = G[G_M + t];
      const float v0 = (s0 + 0 <= t) ? acc.x * __expf(as.x - Mt) : 0.f, v1 = (s0 + 1 <= t) ? acc.y * __expf(as.y - Mt) : 0.f;
      const float v2 = (s0 + 2 <= t) ? acc.z * __expf(as.z - Mt) : 0.f, v3 = (s0 + 3 <= t) ? acc.w * __expf(as.w - Mt) : 0.f;
      v2u o; o.x = pk2(v0, v1); o.y = pk2(v2, v3);
      *(LAS v2u*)(lds + L_SP + (t * TST + s0) * 2) = o; } }
  __syncthreads(); TP_END(33, F.ws); TP_BEGIN(34);
  if (w == 0) { const int t = lane; float qn = 0.f, rsum = 0.f;
#pragma unroll 4
    for (int q = 0; q < 16; ++q) { const v4u x = *(const LAS v4u*)(lds + L_QS + (t * QST + q * 8) * 2); const f32x4 n0 = *(const LAS f32x4*)(NV + q * 8), n1 = *(const LAS f32x4*)(NV + q * 8 + 4);
      qn += bflo(x.x) * n0.x + bfhi(x.x) * n0.y + bflo(x.y) * n0.z + bfhi(x.y) * n0.w + bflo(x.z) * n1.x + bfhi(x.z) * n1.y + bflo(x.w) * n1.z + bfhi(x.w) * n1.w; }
#pragma unroll
    for (int q = 0; q < 8; ++q) { const v4u x = *(const LAS v4u*)(lds + L_SP + (t * TST + q * 8) * 2); rsum += (bflo(x.x) + bfhi(x.x)) + (bflo(x.y) + bfhi(x.y)) + (bflo(x.z) + bfhi(x.z)) + (bflo(x.w) + bfhi(x.w)); }
    const float den = G[G_WI + t] * qn + rsum; G[G_DEN + t] = fmaxf(fabsf(den), G[G_EM + t]); }
  f32x4 acc[2][4];
#pragma unroll
  for (int jj = 0; jj < 2; ++jj)
#pragma unroll
    for (int ti = 0; ti < 4; ++ti) acc[jj][ti] = (f32x4){0.f, 0.f, 0.f, 0.f};
#pragma unroll
  for (int I = 0; I < 4; ++I) {
#pragma unroll
    for (int ti = 0; ti < 4; ++ti) { const LAS unsigned char* qp = lds + L_QW + ((16 * ti + fr) * QST + 32 * I + 4 * kq) * 2;
      const v2u a0 = *(const LAS v2u*)qp, a1 = *(const LAS v2u*)(qp + 32); const v4u av = {a0.x, a0.y, a1.x, a1.y};
      acc[0][ti] = __builtin_amdgcn_mfma_f32_16x16x32_bf16(__builtin_bit_cast(bf16x8, av), __builtin_bit_cast(bf16x8, cb[I][0]), acc[0][ti], 0, 0, 0);
      acc[1][ti] = __builtin_amdgcn_mfma_f32_16x16x32_bf16(__builtin_bit_cast(bf16x8, av), __builtin_bit_cast(bf16x8, cb[I][1]), acc[1][ti], 0, 0, 0); }
    __builtin_amdgcn_sched_barrier(0); }
#pragma unroll
  for (int ks = 0; ks < 2; ++ks) { const bf16x8 bv0 = *(const LAS bf16x8*)(lds + L_VT + ((32 * w + fr) * TST + 32 * ks + 8 * kq) * 2), bv1 = *(const LAS bf16x8*)(lds + L_VT + ((32 * w + 16 + fr) * TST + 32 * ks + 8 * kq) * 2);
#pragma unroll
    for (int ti = 0; ti < 4; ++ti) { const bf16x8 sf = *(const LAS bf16x8*)(lds + L_SP + ((16 * ti + fr) * TST + 32 * ks + 8 * kq) * 2);
      acc[0][ti] = __builtin_amdgcn_mfma_f32_16x16x32_bf16(sf, bv0, acc[0][ti], 0, 0, 0); acc[1][ti] = __builtin_amdgcn_mfma_f32_16x16x32_bf16(sf, bv1, acc[1][ti], 0, 0, 0); } }
  v4u mvp[4];
  { const int t_ = tid >> 3, c0_ = (tid & 7) * 32; const bf16* mo_ = (const bf16*)(F.ws + WS_MO) + ((size_t)b * SEQ + 64 * (c - 1) + t_) * 1024 + h * 256 + c0_;
#pragma unroll
    for (int q = 0; q < 4; ++q) mvp[q] = *(const v4u*)(mo_ + q * 8); }
  __syncthreads(); TP_END(34, F.ws); TP_BEGIN(35);
  LAS float* SSQ = (LAS float*)(lds + L_SSQ);
#pragma unroll
  for (int ti = 0; ti < 4; ++ti) { const f32x4 dn = *(const LAS f32x4*)(G + G_DEN + 16 * ti + 4 * kq);
    f32x4 s4;
#pragma unroll
    for (int r = 0; r < 4; ++r) { const float h0 = acc[0][ti][r] / dn[r], h1 = acc[1][ti][r] / dn[r]; acc[0][ti][r] = h0; acc[1][ti][r] = h1; s4[r] = h0 * h0 + h1 * h1; }
#pragma unroll
    for (int r = 0; r < 4; ++r) { float v = s4[r];
      v += __builtin_bit_cast(float, __builtin_amdgcn_update_dpp(0, __builtin_bit_cast(int, v), 0xB1, 0xF, 0xF, true)); v += __builtin_bit_cast(float, __builtin_amdgcn_update_dpp(0, __builtin_bit_cast(int, v), 0x4E, 0xF, 0xF, true));
      v += __builtin_bit_cast(float, __builtin_amdgcn_update_dpp(0, __builtin_bit_cast(int, v), 0x141, 0xF, 0xF, true)); v += __builtin_bit_cast(float, __builtin_amdgcn_update_dpp(0, __builtin_bit_cast(int, v), 0x140, 0xF, 0xF, true)); s4[r] = v; }
    if (fr == 0) { SSQ[(16 * ti + 4 * kq + 0) * 8 + w] = s4.x; SSQ[(16 * ti + 4 * kq + 1) * 8 + w] = s4.y; SSQ[(16 * ti + 4 * kq + 2) * 8 + w] = s4.z; SSQ[(16 * ti + 4 * kq + 3) * 8 + w] = s4.w; } }
  __syncthreads();
  LAS bf16* HT = (LAS bf16*)(lds + L_HT);
#pragma unroll
  for (int ti = 0; ti < 4; ++ti)
#pragma unroll
    for (int r = 0; r < 4; ++r) { const int t = 16 * ti + 4 * kq + r; const f32x4 p0 = *(const LAS f32x4*)(SSQ + t * 8), p1 = *(const LAS f32x4*)(SSQ + t * 8 + 4);
      const float rh = rsqrtf(((p0.x + p0.y) + (p0.z + p0.w) + (p1.x + p1.y) + (p1.z + p1.w)) * (1.0f / 256.f) + EPS);
      HT[t * 264 + 32 * w + fr] = (bf16)f2bf(acc[0][ti][r] * rh); HT[t * 264 + 32 * w + 16 + fr] = (bf16)f2bf(acc[1][ti][r] * rh); }
  __syncthreads(); TP_END(35, F.ws); TP_BEGIN(36);
  { const int t = tid >> 3, c0 = (tid & 7) * 32; const size_t R = (size_t)b * SEQ + 64 * (c - 1) + t;
    const float* og = a.in[IN_OUTG] + h * 256 + c0; bf16* A2 = (bf16*)(F.ws + WS_A2) + R * DM + 1024 + h * 256 + c0;
    f32x4 gg[8];
#pragma unroll
    for (int q = 0; q < 8; ++q) gg[q] = *(const f32x4*)(og + q * 4);
#pragma unroll
    for (int q = 0; q < 4; ++q) { const v4u hv = *(const LAS v4u*)(HT + t * 264 + c0 + q * 8); const v4u mv = mvp[q]; const f32x4 g0 = gg[2 * q], g1 = gg[2 * q + 1];
      v4u o; o.x = pk2(bflo(hv.x) * g0.x * sigmoidf_(bflo(mv.x)), bfhi(hv.x) * g0.y * sigmoidf_(bfhi(mv.x))); o.y = pk2(bflo(hv.y) * g0.z * sigmoidf_(bflo(mv.y)), bfhi(hv.y) * g0.w * sigmoidf_(bfhi(mv.y)));
      o.z = pk2(bflo(hv.z) * g1.x * sigmoidf_(bflo(mv.z)), bfhi(hv.z) * g1.y * sigmoidf_(bfhi(mv.z))); o.w = pk2(bflo(hv.w) * g1.z * sigmoidf_(bflo(mv.w)), bfhi(hv.w) * g1.w * sigmoidf_(bfhi(mv.w)));
      *(v4u*)(A2 + q * 8) = o; } }
  TP_END(36, F.ws);
}
}
struct CombRow { float mp[8][3], lp[8][3]; v4u op[8][3]; };
__device__ __forceinline__ float half_sum_dpp(float v, bool hi) {
  v += __builtin_bit_cast(float, __builtin_amdgcn_update_dpp(0, __builtin_bit_cast(int, v), 0xB1, 0xF, 0xF, true));
  v += __builtin_bit_cast(float, __builtin_amdgcn_update_dpp(0, __builtin_bit_cast(int, v), 0x4E, 0xF, 0xF, true));
  v += __builtin_bit_cast(float, __builtin_amdgcn_update_dpp(0, __builtin_bit_cast(int, v), 0x141, 0xF, 0xF, true));
  v += __builtin_bit_cast(float, __builtin_amdgcn_update_dpp(0, __builtin_bit_cast(int, v), 0x140, 0xF, 0xF, true));
  const float r0 = __builtin_bit_cast(float, __builtin_amdgcn_readlane(__builtin_bit_cast(int, v), 0)), r1 = __builtin_bit_cast(float, __builtin_amdgcn_readlane(__builtin_bit_cast(int, v), 16));
  const float r2 = __builtin_bit_cast(float, __builtin_amdgcn_readlane(__builtin_bit_cast(int, v), 32)), r3 = __builtin_bit_cast(float, __builtin_amdgcn_readlane(__builtin_bit_cast(int, v), 48));
  return hi ? r2 + r3 : r0 + r1;
}
__device__ __forceinline__ void comb_load(const bf16* PO, const float* ML, int R0, int NA, int lane, CombRow& cr) {
  const int b = R0 >> 11, t = R0 & 2047, qb = t >> 8, rq = (t & 255) + (lane >> 5), l32 = lane & 31;
#pragma unroll
  for (int hm = 0; hm < 8; ++hm) {
    const int bhm = b * 8 + hm, first = bhm * att::STEPS_BHM + att::qb_start(qb), last = first + 4 * qb + 4;
    const int cf = att::chunk_of(first, NA), np = att::chunk_of(last, NA) - cf + 1, slot0 = bhm * 16 + qb + cf - att::chunk_of(bhm * att::STEPS_BHM, NA);
#pragma unroll
    for (int p = 0; p < 3; ++p) { if (p < np) { const int slot = slot0 + p; const v2u ml = *(const v2u*)(ML + (size_t)slot * 512 + rq * 2);
        const unsigned mx_ = ml.x, my_ = ml.y; cr.mp[hm][p] = __builtin_bit_cast(float, mx_); cr.lp[hm][p] = __builtin_bit_cast(float, my_);
        cr.op[hm][p] = ((const v4u*)(PO + ((size_t)slot * 256 + rq) * 256))[l32]; } else { cr.mp[hm][p] = -1e30f; cr.lp[hm][p] = 0.f; cr.op[hm][p] = (v4u){0u, 0u, 0u, 0u}; } }
  }
}
__device__ __forceinline__ void comb_finish(bf16* A2, int R0, int lane, float lam, const f32x4 sg0, const f32x4 sg1, const CombRow& cr) {
  const bool hi = lane >= 32; const int l32 = lane & 31;
#pragma unroll
  for (int h = 0; h < 4; ++h) {
    float om[2][8];
#pragma unroll
    for (int m = 0; m < 2; ++m) { const int hm = h * 2 + m;
      const float M = fmaxf(cr.mp[hm][0], fmaxf(cr.mp[hm][1], cr.mp[hm][2]));
      float wsum = 0.f, acc[8];
#pragma unroll
      for (int i = 0; i < 8; ++i) acc[i] = 0.f;
#pragma unroll
      for (int p = 0; p < 3; ++p) { const float w = cr.lp[hm][p] * exp2f(cr.mp[hm][p] - M); wsum += w; const v4u ow = cr.op[hm][p];
#pragma unroll
        for (int i = 0; i < 4; ++i) { const unsigned wd = ow[i]; acc[2 * i] += bflo(wd) * w; acc[2 * i + 1] += bfhi(wd) * w; } }
      const float iw = 1.0f / wsum;
#pragma unroll
      for (int i = 0; i < 8; ++i) om[m][i] = acc[i] * iw;
    }
    float o[8], ss = 0.f;
#pragma unroll
    for (int i = 0; i < 8; ++i) { o[i] = om[0][i] - om[1][i] * lam; ss += o[i] * o[i]; }
    const float rs = rsqrtf(half_sum_dpp(ss, hi) * (1.0f / 256.f) + EPS) * 0.8f;
    v4u w; w.x = pk2(o[0] * rs * sg0.x, o[1] * rs * sg0.y); w.y = pk2(o[2] * rs * sg0.z, o[3] * rs * sg0.w); w.z = pk2(o[4] * rs * sg1.x, o[5] * rs * sg1.y); w.w = pk2(o[6] * rs * sg1.z, o[7] * rs * sg1.w);
    ((v4u*)(A2 + (size_t)(R0 + (hi ? 1 : 0)) * DM + h * 256))[l32] = w;
  }
}
__device__ __forceinline__ void p3_combine(const Frame& F, const Args& a, int NA) {
  const bf16* PO = (const bf16*)(F.ws + WS_PO); const float* ML = (const float*)(F.ws + WS_ML);
  bf16* A2 = (bf16*)(F.ws + WS_A2);
  const float lam = *(const float*)(F.ws + WS_LAM);
  const int gw = blockIdx.x * NWAVES + F.wave, NGW = gridDim.x * NWAVES, lane = F.lane;
  const f32x4 sg0 = ((const f32x4*)a.in[IN_SUBG])[2 * (lane & 31)], sg1 = ((const f32x4*)a.in[IN_SUBG])[2 * (lane & 31) + 1];
  for (int k = gw; k < MROWS / 4; k += NGW) {
#pragma unroll 1
    for (int s = 0; s < 2; ++s) { const int P = s ? MROWS / 2 - 1 - k : k;
      CombRow r0;
      comb_load(PO, ML, 2 * P, NA, lane, r0);
      comb_finish(A2, 2 * P, lane, lam, sg0, sg1, r0); }
  }
}
struct EpiRes {
  static constexpr bool PERM = true, AFTER_DRAIN = false;
  const float* x; float* out; bf16* H1b; float* SSQ;
  __device__ __forceinline__ void operator()(const pg8::f32x4 (&acc)[2][2][4][2], const pg8::Unit& u, int wr, int wc, int fr, int fq) const {
    const int row0 = u.pm * 256 + wr * 64 + fr, col0 = u.pn * 256 + wc * 32 + 8 * fq;
#pragma unroll
    for (int ai = 0; ai < 2; ++ai) {
      f32x4 xv[4][2][2];
#pragma unroll
      for (int m = 0; m < 4; ++m)
#pragma unroll
        for (int bj = 0; bj < 2; ++bj) { const size_t off = (size_t)(row0 + ai * 128 + m * 16) * DM + col0 + bj * 128; xv[m][bj][0] = *(const f32x4*)(x + off); xv[m][bj][1] = *(const f32x4*)(x + off + 4); }
#pragma unroll
      for (int m = 0; m < 4; ++m) { const size_t R = (size_t)(row0 + ai * 128 + m * 16); float s = 0.f;
#pragma unroll
        for (int bj = 0; bj < 2; ++bj) { const size_t off = R * DM + col0 + bj * 128;
          const f32x4 v0 = acc[ai][bj][m][0] + xv[m][bj][0], v1 = acc[ai][bj][m][1] + xv[m][bj][1];
          v4u w; w.x = pk2(v0.x, v0.y); w.y = pk2(v0.z, v0.w); w.z = pk2(v1.x, v1.y); w.w = pk2(v1.z, v1.w);
          *(v4u*)(H1b + off) = w;
          s += (v0.x * v0.x + v0.y * v0.y) + (v0.z * v0.z + v0.w * v0.w) + (v1.x * v1.x + v1.y * v1.y) + (v1.z * v1.z + v1.w * v1.w); }
        s += __shfl_xor(s, 16); s += __shfl_xor(s, 32);
        if (fq == 0) SSQ[R * 32 + u.pn * 4 + wc] = s; }
    }
  }
};
#ifndef PEER_U_FP8
#define PEER_U_FP8 0
#endif
typedef __bf16 bfv2 __attribute__((ext_vector_type(2)));
__device__ __forceinline__ void split_hl(const f32x4 a, const f32x4 b, bf16x8& hi, bf16x8& lo) {
  float v[8] = {a.x, a.y, a.z, a.w, b.x, b.y, b.z, b.w}; unsigned h[8], l[8];
#pragma unroll
  for (int i = 0; i < 8; ++i) { h[i] = f2bf(v[i]); l[i] = f2bf(v[i] - __builtin_bit_cast(float, h[i] << 16)); }
  v4u hv = {h[0] | (h[1] << 16), h[2] | (h[3] << 16), h[4] | (h[5] << 16), h[6] | (h[7] << 16)};
  v4u lv = {l[0] | (l[1] << 16), l[2] | (l[3] << 16), l[4] | (l[5] << 16), l[6] | (l[7] << 16)};
  hi = __builtin_bit_cast(bf16x8, hv); lo = __builtin_bit_cast(bf16x8, lv);
}
__device__ __forceinline__ void p0_w3t(const Frame& F, const Args& a) {
  const float* wq = a.in[IN_WQ]; const float* sk = a.in[IN_SUBK]; const float* g2 = a.in[IN_G2];
  bf16* W3t = (bf16*)(F.ws + WS_W3T);
  const int lane = F.lane, fr = lane & 15, fq = lane >> 4;
  constexpr int SKS = 272;
  LAS unsigned char* shi = F.lds; LAS unsigned char* slo = F.lds + 128 * SKS;
  for (int bt = blockIdx.x; bt < 256; bt += gridDim.x) {
    const int hh = bt & 15, kt = (bt >> 4) * 8 + F.wave;
    const float* ap = wq + (size_t)(kt * 16 + fr) * DM + hh * 128 + fq * 8;
    f32x4 a0[4], a1[4];
#pragma unroll
    for (int s = 0; s < 4; ++s) { a0[s] = *(const f32x4*)(ap + 32 * s); a1[s] = *(const f32x4*)(ap + 32 * s + 4); }
    const f32x4 gk = *(const f32x4*)(g2 + kt * 16 + fq * 4);
    __syncthreads();
#pragma unroll
    for (int i = 0; i < 4; ++i) { const int idx = F.tid + NTHR * i, key = idx >> 4, c8 = idx & 15; const float* p = sk + (size_t)(hh * 128 + key) * 128 + c8 * 8;
      bf16x8 h, l; split_hl(*(const f32x4*)p, *(const f32x4*)(p + 4), h, l);
      *(LAS bf16x8*)(shi + key * SKS + c8 * 16) = h; *(LAS bf16x8*)(slo + key * SKS + c8 * 16) = l; }
    bf16x8 ahi[4], alo[4];
#pragma unroll
    for (int s = 0; s < 4; ++s) split_hl(a0[s], a1[s], ahi[s], alo[s]);
    __syncthreads();
#pragma unroll 2
    for (int t2 = 0; t2 < 8; ++t2) {
      const LAS unsigned char* bh = shi + (t2 * 16 + fr) * SKS + fq * 16; const LAS unsigned char* bl = slo + (t2 * 16 + fr) * SKS + fq * 16;
      f32x4 acc = {0.f, 0.f, 0.f, 0.f};
#pragma unroll
      for (int s = 0; s < 4; ++s) { const bf16x8 bhi = *(const LAS bf16x8*)(bh + 64 * s), blo = *(const LAS bf16x8*)(bl + 64 * s);
        acc = __builtin_amdgcn_mfma_f32_16x16x32_bf16(ahi[s], bhi, acc, 0, 0, 0);
        acc = __builtin_amdgcn_mfma_f32_16x16x32_bf16(ahi[s], blo, acc, 0, 0, 0);
        acc = __builtin_amdgcn_mfma_f32_16x16x32_bf16(alo[s], bhi, acc, 0, 0, 0); }
      v2u o; o.x = pk2(acc.x * gk.x, acc.y * gk.y); o.y = pk2(acc.z * gk.z, acc.w * gk.w);
      *(v2u*)(W3t + (size_t)(hh * 128 + t2 * 16 + fr) * DM + kt * 16 + fq * 4) = o;
    }
  }
  __syncthreads();
}
typedef float f32x2v __attribute__((ext_vector_type(2)));
__device__ __forceinline__ void p0_tables(const Frame& F, const Args& a) {
  const float* g2 = a.in[IN_G2];
  float* SCL = (float*)(F.ws + WS_SCL);
  const int gw = blockIdx.x * NWAVES + F.wave, NGW = gridDim.x * NWAVES, lane = F.lane;
  f32x4 gl[8];
#pragma unroll
  for (int q = 0; q < 8; ++q) gl[q] = *(const f32x4*)(g2 + q * 256 + lane * 4);
  f32x4 xn[8];
  { const int row = gw; if (row < 2 * 16384) { const float* src = a.in[row >= 16384 ? IN_V : IN_U] + (size_t)(row & 16383) * DM + lane * 4;
#pragma unroll
      for (int q = 0; q < 8; ++q) xn[q] = *(const f32x4*)(src + q * 256); } }
  for (int row = gw; row < 2 * 16384; row += NGW) {
    const bool isv = row >= 16384; const int e = row & 16383;
    f32x4 x[8];
#pragma unroll
    for (int q = 0; q < 8; ++q) x[q] = xn[q];
    { const int rn = row + NGW; if (rn < 2 * 16384) { const float* src = a.in[rn >= 16384 ? IN_V : IN_U] + (size_t)(rn & 16383) * DM + lane * 4;
#pragma unroll
        for (int q = 0; q < 8; ++q) xn[q] = *(const f32x4*)(src + q * 256); } }
    float amax = 0.f, ssq = 0.f;
#pragma unroll
    for (int q = 0; q < 8; ++q) { if (!isv) x[q] = x[q] * gl[q]; amax = fmaxf(amax, fmaxf(fmaxf(fabsf(x[q].x), fabsf(x[q].y)), fmaxf(fabsf(x[q].z), fabsf(x[q].w))));
      ssq += (x[q].x * x[q].x + x[q].y * x[q].y) + (x[q].z * x[q].z + x[q].w * x[q].w); }
#pragma unroll
    for (int o = 1; o < 64; o <<= 1) amax = fmaxf(amax, __shfl_xor(amax, o));
    v4u w;
    if (isv) {
      const float sc = amax > 0.f ? 6.0f / amax : 1.0f;
#pragma unroll
      for (int d = 0; d < 4; ++d) { unsigned pk = 0u;
        pk = __builtin_amdgcn_cvt_scalef32_pk_fp4_f32(pk, x[2 * d].x * sc, x[2 * d].y * sc, 1.0f, 0); pk = __builtin_amdgcn_cvt_scalef32_pk_fp4_f32(pk, x[2 * d].z * sc, x[2 * d].w * sc, 1.0f, 1);
        pk = __builtin_amdgcn_cvt_scalef32_pk_fp4_f32(pk, x[2 * d + 1].x * sc, x[2 * d + 1].y * sc, 1.0f, 2); pk = __builtin_amdgcn_cvt_scalef32_pk_fp4_f32(pk, x[2 * d + 1].z * sc, x[2 * d + 1].w * sc, 1.0f, 3);
        w[d] = pk; }
      if (lane == 0) SCL[row] = 1.0f / sc;
    } else {
      ssq = wave_sum_dpp(ssq);
      const float sA = amax > 0.f ? amax * (1.0f / 7.0f) : 1.0f, sB = fminf(sA, 0.36f * sqrtf(ssq * (1.0f / DM)) + 1e-30f);
      const float iA = 1.0f / sA, iB = 1.0f / sB;
      float eA = 0.f, eB = 0.f;
#pragma unroll
      for (int q = 0; q < 8; ++q)
#pragma unroll
        for (int j = 0; j < 4; ++j) { const float v = x[q][j];
          const float da = v - sA * __builtin_amdgcn_fmed3f(__builtin_rintf(v * iA), -7.0f, 7.0f), db = v - sB * __builtin_amdgcn_fmed3f(__builtin_rintf(v * iB), -7.0f, 7.0f);
          eA += da * da; eB += db * db; }
      eA = wave_sum_dpp(eA); eB = wave_sum_dpp(eB);
      const bool useB = eB < eA; const float st = useB ? sB : sA, is = useB ? iB : iA;
#pragma unroll
      for (int d = 0; d < 4; ++d) { unsigned pk = 0u;
#pragma unroll
        for (int p = 0; p < 8; ++p) { const float v = x[2 * d + (p >> 2)][p & 3]; const int qi = (int)__builtin_amdgcn_fmed3f(__builtin_rintf(v * is), -7.0f, 7.0f); pk |= ((unsigned)qi & 15u) << (4 * p); }
        w[d] = pk; }
      if (lane == 0) SCL[row] = st;
    }
    *(v4u*)(F.ws + (isv ? WS_VB8 : WS_UB) + (size_t)e * 1024 + lane * 16) = w;
  }
}
struct EpiScore {
  static constexpr bool PERM = true, AFTER_DRAIN = false;
  float* S; const LAS float* rs;
  __device__ __forceinline__ void operator()(const pg8::f32x4 (&acc)[2][2][4][2], const pg8::Unit& u, int wr, int wc, int fr, int fq) const {
    const int rl0 = wr * 64 + fr, keyb = wc * 32 + 8 * fq;
#pragma unroll
    for (int ai = 0; ai < 2; ++ai)
#pragma unroll
      for (int m = 0; m < 4; ++m) { const int rl = rl0 + ai * 128 + m * 16; const float r = rs[rl]; const int row = u.pm * 256 + rl;
#pragma unroll
        for (int bj = 0; bj < 2; ++bj) { float* d = S + ((size_t)((row >> 5) * 16 + u.pn * 2 + bj) * 128 + keyb) * 32 + (row & 31);
          const pg8::f32x4 v0 = acc[ai][bj][m][0] * r, v1 = acc[ai][bj][m][1] * r;
          d[0] = v0[0]; d[32] = v0[1]; d[64] = v0[2]; d[96] = v0[3]; d[128] = v1[0]; d[160] = v1[1]; d[192] = v1[2]; d[224] = v1[3]; } }
  }
};

__device__ __forceinline__ unsigned fkey(float f) { const unsigned b = __builtin_bit_cast(unsigned, f); return b ^ ((b >> 31) ? 0xFFFFFFFFu : 0x80000000u); }
template <int NV, int K> __device__ __forceinline__ void wave_topk(const unsigned (&u)[NV], bool (&sel)[NV], int lane) {
  unsigned prefix = 0u; int cge = NV * 64;
#pragma unroll 1
  for (int bit = 31; bit >= 0 && cge != K; --bit) {
    const unsigned cand = prefix | (1u << bit); int c = 0;
#pragma unroll
    for (int i = 0; i < NV; ++i) c += __builtin_popcountll(__ballot(u[i] >= cand));
    if (c >= K) { prefix = cand; cge = c; }
  }
  int cgt = 0;
#pragma unroll
  for (int i = 0; i < NV; ++i) cgt += __builtin_popcountll(__ballot(u[i] > prefix));
  int need = K - cgt;
  const unsigned long long lm = (1ull << lane) - 1ull;
#pragma unroll
  for (int i = 0; i < NV; ++i) { const unsigned long long eq = __ballot(u[i] == prefix); const int before = __builtin_popcountll(eq & lm);
    sel[i] = (u[i] > prefix) || (u[i] == prefix && before < need); const int ne = __builtin_popcountll(eq); need = need > ne ? need - ne : 0; }
}
template <int NG, int NV, int K> __device__ __forceinline__ void wave_topk_multi(const unsigned (&u)[NG][NV], bool (&sel)[NG][NV], int lane) {
  unsigned prefix[NG]; int cge[NG];
#pragma unroll
  for (int g = 0; g < NG; ++g) { prefix[g] = 0u; cge[g] = NV * 64; }
#pragma unroll 1
  for (int bit = 31; bit >= 0; --bit) {
    bool done = true;
#pragma unroll
    for (int g = 0; g < NG; ++g) done = done && (cge[g] == K);
    if (done) break;
#pragma unroll
    for (int g = 0; g < NG; ++g) { const unsigned cand = prefix[g] | (1u << bit); int c = 0;
#pragma unroll
      for (int i = 0; i < NV; ++i) c += __builtin_popcountll(__ballot(u[g][i] >= cand));
      if (cge[g] != K && c >= K) { prefix[g] = cand; cge[g] = c; } }
  }
  const unsigned long long lm = (1ull << lane) - 1ull;
#pragma unroll
  for (int g = 0; g < NG; ++g) { int cgt = 0;
#pragma unroll
    for (int i = 0; i < NV; ++i) cgt += __builtin_popcountll(__ballot(u[g][i] > prefix[g]));
    int need = K - cgt;
#pragma unroll
    for (int i = 0; i < NV; ++i) { const unsigned long long eq = __ballot(u[g][i] == prefix[g]); const int before = __builtin_popcountll(eq & lm);
      sel[g][i] = (u[g][i] > prefix[g]) || (u[g][i] == prefix[g] && before < need); const int ne = __builtin_popcountll(eq); need = need > ne ? need - ne : 0; } }
}
__device__ __forceinline__ float gelu_erf(float v) {
  const float av = fabsf(v), t = __builtin_amdgcn_rcpf(1.0f + 0.2316418882f * av);
  float q = t * 0.5307027145f - 0.7265760135f; q = q * t + 0.7107068705f; q = q * t - 0.142248368f; q = q * t + 0.127414796f; q = q * t;
  const float tail = q * __builtin_amdgcn_exp2f(v * v * -0.72134752044f);
  return v < 0.f ? v * tail : v - v * tail;
}

#ifndef ROUTE_REPS
#define ROUTE_REPS 1
#endif
__device__ __forceinline__ void ins16(float (&t)[16], float x) {
#pragma unroll
  for (int i = 15; i >= 1; --i) t[i] = __builtin_amdgcn_fmed3f(t[i - 1], t[i], x);
  t[0] = fmaxf(t[0], x);
}
__device__ __forceinline__ void p6_peer(const Frame& F, const Args& a, float* dst_base) {
  const float* S2 = (const float*)(F.ws + WS_S); const float* SSQ = (const float*)(F.ws + WS_SSQ); const bf16* H1b = (const bf16*)(F.ws + WS_H1B);
  int lane = F.lane, wv = F.wave, tid = F.tid; asm volatile("" : "+v"(lane), "+s"(wv), "+v"(tid));
  int* EIDg = (int*)(F.ws + WS_EID); float* EGTg = (float*)(F.ws + WS_EGT);
  LAS int* eid = (LAS int*)(F.lds + wv * 8192); LAS float* cg = (LAS float*)(eid + 512); LAS float* esu = (LAS float*)(eid + 1024); LAS float* dq = (LAS float*)(eid + 1536);
  LAS unsigned char* RB = F.lds + 65536 + wv * 8192;
  LAS float* L1 = (LAS float*)(F.lds + 65536);
  TP_BEGIN(11);
#ifdef TPROBE
  const unsigned long long tp_p7_ = __builtin_amdgcn_s_memrealtime();
#endif
  for (int tb = blockIdx.x; tb < MROWS / 32; tb += gridDim.x) {
    __syncthreads();
    {
      const int g = tid >> 5, tl = tid & 31; const float* src = S2 + ((size_t)(tb * 16 + g) * 128) * 32 + tl;
      float t[16];
#pragma unroll
      for (int i = 0; i < 16; ++i) t[i] = -INFINITY;
      float sv[128];
#pragma unroll
      for (int k = 0; k < 128; ++k) sv[k] = src[k * 32];
#pragma unroll
      for (int k = 0; k < 128; ++k) ins16(t, __builtin_bit_cast(float, (__builtin_bit_cast(unsigned, sv[k]) & ~0x7Fu) | (unsigned)(127 - k)));
#pragma unroll
      for (int i = 0; i < 16; ++i) L1[(g * 16 + i) * 32 + tl] = t[i];
    }
    __syncthreads();
    if (tid < 256) {
      const int h8 = tid >> 5, tl = tid & 31; const LAS float* LA = L1 + ((2 * h8) * 16) * 32 + tl; const LAS float* LB = L1 + ((2 * h8 + 1) * 16) * 32 + tl;
      float A[16], B[16], t[16];
#pragma unroll
      for (int i = 0; i < 16; ++i) { A[i] = LA[i * 32]; B[i] = LB[i * 32]; t[i] = -INFINITY; }
#pragma unroll
      for (int i = 0; i < 16; ++i)
#pragma unroll
        for (int j = 0; j < 16; ++j) if ((i + 1) * (j + 1) <= 16) { const float c = A[i] + B[j];
            ins16(t, __builtin_bit_cast(float, (__builtin_bit_cast(unsigned, c) & ~0xFFu) | (unsigned)(255 - (i * 16 + j)))); }
      float ev[16], es = 0.f;
#pragma unroll
      for (int r = 0; r < 16; ++r) { ev[r] = __expf(t[r] - t[0]); es += ev[r]; }
      const float inv = 1.0f / es;
#pragma unroll
      for (int r = 0; r < 16; ++r) { const unsigned flat = 255u - (__builtin_bit_cast(unsigned, t[r]) & 0xFFu), ii = flat >> 4, jj = flat & 15u;
        const unsigned ka = 127u - (__builtin_bit_cast(unsigned, LA[ii * 32]) & 0x7Fu), kb = 127u - (__builtin_bit_cast(unsigned, LB[jj * 32]) & 0x7Fu);
        EIDg[(size_t)(tb * 32 + tl) * 128 + h8 * 16 + r] = (int)(ka * 128u + kb); EGTg[(size_t)(tb * 32 + tl) * 128 + h8 * 16 + r] = ev[r] * inv; }
    }
    asm volatile("s_waitcnt vmcnt(0)" ::: "memory"); __syncthreads();
    TP_END(11, F.ws);
    const unsigned char* U8 = F.ws + WS_UB; const unsigned char* V8 = F.ws + WS_VB8;
    constexpr int NBT = 2;
#define PG_ISSUE(TAB, E) do { const int idq_ = __builtin_amdgcn_readfirstlane(eidt[(E)]); \
      __builtin_amdgcn_global_load_lds((const unsigned*)((TAB) + (size_t)idq_ * 1024 + lane * 16), (LAS unsigned*)(RB + ((E) & 7) * 1024), 16, 0, 0); } while (0)
    constexpr int NSPL_LOG = 1, NSPL = 1 << NSPL_LOG, ESPL = 128 / NSPL;
#pragma unroll 1
    for (int hh = 0; hh < NSPL; ++hh) {
#pragma unroll 1
    for (int tt = 0; tt < 4; ++tt) {
      const int tok = tb * 32 + wv * 4 + tt, e0 = ESPL * hh;
      LAS int* eidt = eid + tt * 128; LAS float* cgt = cg + tt * 128; LAS float* esut = esu + tt * 128; LAS int* dqi = (LAS int*)dq + tt * 128;
      const float rs = rsqrtf(wave_sum_dpp(lane < 32 ? SSQ[(size_t)tok * 32 + lane] : 0.f) * (1.0f / DM) + EPS);
      if (hh == 0) {
        const float* SCL = (const float*)(F.ws + WS_SCL);
        const int id0 = __builtin_nontemporal_load(EIDg + (size_t)tok * 128 + lane), id1 = __builtin_nontemporal_load(EIDg + (size_t)tok * 128 + lane + 64);
        const float g0_ = __builtin_nontemporal_load(EGTg + (size_t)tok * 128 + lane), g1_ = __builtin_nontemporal_load(EGTg + (size_t)tok * 128 + lane + 64);
        const float su0 = SCL[id0], su1 = SCL[id1], sv0 = SCL[16384 + id0], sv1 = SCL[16384 + id1];
        const int b0 = id0 >> (14 - NSPL_LOG), b1 = id1 >> (14 - NSPL_LOG); const unsigned long long lt = (1ull << lane) - 1ull;
        int p0 = 0, p1 = 0, base = 0;
#pragma unroll
        for (int b = 0; b < (1 << NSPL_LOG); ++b) { const unsigned long long k0 = __ballot(b0 == b), k1 = __ballot(b1 == b); const int c0_ = __builtin_popcountll(k0);
          if (b0 == b) p0 = base + __builtin_popcountll(k0 & lt); if (b1 == b) p1 = base + c0_ + __builtin_popcountll(k1 & lt); base += c0_ + __builtin_popcountll(k1); }
        eidt[p0] = id0; esut[p0] = su0; cgt[p0] = g0_ * sv0; eidt[p1] = id1; esut[p1] = su1; cgt[p1] = g1_ * sv1; }
      unsigned xw[16];
      { const bf16* xp = H1b + (size_t)tok * DM + (size_t)lane * 4;
#pragma unroll
        for (int q = 0; q < 8; ++q) { const v2u x0 = *(const v2u*)(xp + q * 256); xw[2 * q] = x0.x; xw[2 * q + 1] = x0.y; } }
      int xl[4], xh[4]; float rsx;
      { float xa = 0.f;
#pragma unroll
        for (int i = 0; i < 16; ++i) xa = fmaxf(xa, fmaxf(fabsf(bflo(xw[i])), fabsf(bfhi(xw[i]))));
#pragma unroll
        for (int o = 1; o < 64; o <<= 1) xa = fmaxf(xa, __shfl_xor(xa, o));
        const float xinv = xa > 0.f ? 119.0f / xa : 0.f; rsx = rs * (xa > 0.f ? xa * (1.0f / 119.0f) : 0.f);
#pragma unroll
        for (int d = 0; d < 4; ++d) { unsigned pl = 0u, ph = 0u;
#pragma unroll
          for (int p = 0; p < 8; ++p) { const int i = 8 * d + p; const float v = (i & 1) ? bfhi(xw[i >> 1]) : bflo(xw[i >> 1]);
            const int xi = (int)__builtin_rintf(v * xinv), l = ((xi + 8) & 15) - 8, h = (xi - l) >> 4;
            pl |= ((unsigned)l & 15u) << (4 * p); ph |= ((unsigned)h & 15u) << (4 * p); }
          xl[d] = (int)pl; xh[d] = (int)ph; } }
      asm volatile("s_waitcnt vmcnt(0) lgkmcnt(0)" ::: "memory");
#define DPPI(X, CTRL) __builtin_amdgcn_update_dpp(0, (X), (CTRL), 0xF, 0xF, true)
#define PU_BATCH(E0, DOISSUE) do { v4u ub[4]; \
        _Pragma("unroll") for (int q = 0; q < 4; ++q) ub[q] = *(const LAS v4u*)(RB + (((E0) + q) & 7) * 1024 + lane * 16); \
        asm volatile("s_waitcnt lgkmcnt(0)" ::: "memory"); \
        if (DOISSUE) { _Pragma("unroll") for (int q = 0; q < 4; ++q) PG_ISSUE(U8, (E0) + 8 + q); } \
        int a_[4]; _Pragma("unroll") for (int q = 0; q < 4; ++q) { int al_ = 0, ah_ = 0; _Pragma("unroll") for (int dd = 0; dd < 4; ++dd) { const int wa = (int)ub[q][dd]; \
            al_ = __builtin_amdgcn_sdot8(wa, xl[dd], al_, false); ah_ = __builtin_amdgcn_sdot8(wa, xh[dd], ah_, false); } a_[q] = ah_ * 16 + al_; } \
        const int r01_ = (o1 ? a_[1] : a_[0]) + DPPI(o1 ? a_[0] : a_[1], 0xB1), r23_ = (o1 ? a_[3] : a_[2]) + DPPI(o1 ? a_[2] : a_[3], 0xB1); \
        int r_ = (o2 ? r23_ : r01_) + DPPI(o2 ? r01_ : r23_, 0x4E); \
        r_ += DPPI(r_, 0x124); r_ += DPPI(r_, 0x128); \
        { auto s_ = __builtin_amdgcn_permlane16_swap((unsigned)r_, (unsigned)r_, false, false); const unsigned s0_ = s_[0], s1_ = s_[1]; r_ = (int)(s0_ + s1_); } \
        { auto s_ = __builtin_amdgcn_permlane32_swap((unsigned)r_, (unsigned)r_, false, false); const unsigned s0_ = s_[0], s1_ = s_[1]; r_ = (int)(s0_ + s1_); } \
        if (lane < 4) dqi[(E0) + lane] = r_; } while (0)
      const bool o1 = (lane & 1) != 0, o2 = (lane & 2) != 0;
#pragma unroll
      for (int e = 0; e < 8; ++e) PG_ISSUE(U8, e0 + e);
#pragma unroll 1
      for (int e = e0; e < e0 + ESPL - 8; e += 4) {
        asm volatile("s_waitcnt vmcnt(4)" ::: "memory");
        PU_BATCH(e, true);
        asm volatile("" ::: "memory");
      }
      asm volatile("s_waitcnt vmcnt(0)" ::: "memory");
#pragma unroll 1
      for (int e = e0 + ESPL - 8; e < e0 + ESPL; e += 4) PU_BATCH(e, false);
      asm volatile("s_waitcnt lgkmcnt(0)" ::: "memory");
      if (hh == NSPL - 1) {
#pragma unroll
        for (int i = 0; i < 2; ++i) { const int e = lane + 64 * i; cgt[e] = gelu_erf((float)dqi[e] * (rsx * esut[e])) * cgt[e]; } }
      asm volatile("s_waitcnt lgkmcnt(0)" ::: "memory");
#undef DPPI
#undef PU_BATCH
    }
    }
    float y[4][32];
#pragma unroll
    for (int t_ = 0; t_ < 4; ++t_)
#pragma unroll
      for (int i = 0; i < 32; ++i) y[t_][i] = 0.f;
#define PV_BATCH(TT, E0, DOISSUE) do { v4u vb[NBT]; float c_[NBT]; \
        _Pragma("unroll") for (int q = 0; q < NBT; ++q) { vb[q] = *(const LAS v4u*)(RB + (((E0) + q) & 7) * 1024 + lane * 16); c_[q] = cgt[(E0) + q]; } \
        asm volatile("s_waitcnt lgkmcnt(0)" ::: "memory"); \
        if (DOISSUE) { _Pragma("unroll") for (int q = 0; q < NBT; ++q) PG_ISSUE(V8, (E0) + 8 + q); } \
        _Pragma("unroll") for (int q = 0; q < NBT; ++q) { _Pragma("unroll") for (int dd = 0; dd < 4; ++dd) { const unsigned wa = vb[q][dd]; \
            { const f32x2v v2 = __builtin_amdgcn_cvt_scalef32_pk_f32_fp4(wa, 1.0f, 0); y[TT][8 * dd + 0] += c_[q] * v2.x; y[TT][8 * dd + 1] += c_[q] * v2.y; } \
            { const f32x2v v2 = __builtin_amdgcn_cvt_scalef32_pk_f32_fp4(wa, 1.0f, 1); y[TT][8 * dd + 2] += c_[q] * v2.x; y[TT][8 * dd + 3] += c_[q] * v2.y; } \
            { const f32x2v v2 = __builtin_amdgcn_cvt_scalef32_pk_f32_fp4(wa, 1.0f, 2); y[TT][8 * dd + 4] += c_[q] * v2.x; y[TT][8 * dd + 5] += c_[q] * v2.y; } \
            { const f32x2v v2 = __builtin_amdgcn_cvt_scalef32_pk_f32_fp4(wa, 1.0f, 3); y[TT][8 * dd + 6] += c_[q] * v2.x; y[TT][8 * dd + 7] += c_[q] * v2.y; } } \
          __builtin_amdgcn_sched_barrier(0); } } while (0)
#define PV_VISIT(TT, HH) do { LAS int* eidt = eid + (TT) * 128; LAS float* cgt = cg + (TT) * 128; \
      _Pragma("unroll") for (int e = 0; e < 8; ++e) PG_ISSUE(V8, 64 * (HH) + e); \
      _Pragma("unroll 1") for (int e = 64 * (HH); e < 64 * (HH) + 56; e += NBT) { asm volatile("s_waitcnt vmcnt(6)" ::: "memory"); PV_BATCH(TT, e, true); asm volatile("" ::: "memory"); } \
      asm volatile("s_waitcnt vmcnt(0)" ::: "memory"); \
      _Pragma("unroll 1") for (int e = 64 * (HH) + 56; e < 64 * (HH) + 64; e += NBT) PV_BATCH(TT, e, false); \
      asm volatile("s_waitcnt lgkmcnt(0)" ::: "memory"); } while (0)
    PV_VISIT(0, 0); PV_VISIT(1, 0); PV_VISIT(2, 0); PV_VISIT(3, 0);
    PV_VISIT(0, 1); PV_VISIT(1, 1); PV_VISIT(2, 1); PV_VISIT(3, 1);
#undef PV_VISIT
#undef PV_BATCH
#pragma unroll
    for (int tt = 0; tt < 4; ++tt) {
      const int tok = tb * 32 + wv * 4 + tt;
      unsigned xw[16];
      { const bf16* xp = H1b + (size_t)tok * DM + (size_t)lane * 4;
#pragma unroll
        for (int q = 0; q < 8; ++q) { const v2u x0 = *(const v2u*)(xp + q * 256); xw[2 * q] = x0.x; xw[2 * q + 1] = x0.y; } }
      float* drow = dst_base + (size_t)tok * DM;
#pragma unroll
      for (int q = 0; q < 8; ++q) { const size_t off = (size_t)q * 256 + lane * 4; f32x4 hv;
        hv.x = bflo(xw[2 * q]) + y[tt][4 * q];
#ifdef TPROBE
        if (TPROBE != 13 && tok == 0 && lane == 0 && q == 0) hv.x += 10.0f + (float)(*(volatile unsigned*)(F.ws + 64)) * (0.01f / TP_DIV);
        if (TPROBE == 13 && (int)blockIdx.x == TP_BLOCK && wv == 7 && tt == 3 && lane == 0 && q == 0) hv.x += 10.0f + (float)(unsigned)(__builtin_amdgcn_s_memrealtime() - tp_p7_) * (0.01f / TP_DIV);
#endif
        hv.y = bfhi(xw[2 * q]) + y[tt][4 * q + 1]; hv.z = bflo(xw[2 * q + 1]) + y[tt][4 * q + 2]; hv.w = bfhi(xw[2 * q + 1]) + y[tt][4 * q + 3]; __builtin_nontemporal_store(hv, (f32x4*)(drow + off)); }
    }
#undef PG_ISSUE
  }
}
constexpr int MISC_LDS = LDS_BYTES - 256;
__global__ void __launch_bounds__(NTHR, 2) mk_fwd(Args args) {
  extern __shared__ __attribute__((aligned(16))) unsigned char lds_raw[];
  Frame F; F.lds = (LAS unsigned char*)lds_raw; F.ws = args.ws; F.tid = threadIdx.x; F.lane = F.tid & 63; F.wave = __builtin_amdgcn_readfirstlane(F.tid >> 6);
  const int lo = args.ph_lo, hi = args.ph_hi, G = (int)gridDim.x, bx = (int)blockIdx.x;
  volatile LAS unsigned* misc = (volatile LAS unsigned*)(F.lds + MISC_LDS);
  if (F.tid < 16) misc[F.tid] = 0u;
  __syncthreads();
  XcdBarrier bar = xcd_barrier_post((unsigned*)(F.ws + WS_CTL) + CW_BAR, misc);
#define IN(k) (lo <= (k) && (k) < hi)
#ifdef TPROBE
#define SEAM(k) do { if (IN(k) && IN((k) + 1)) { const unsigned long long tq0_ = __builtin_amdgcn_s_memrealtime(); xcd_barrier(bar); const unsigned long long tq1_ = __builtin_amdgcn_s_memrealtime(); \
    if (TPROBE == 20 + (k) && (int)blockIdx.x == TP_BLOCK && threadIdx.x == 0) atomicAdd((unsigned*)(F.ws + 64), (unsigned)(tq1_ - tq0_)); } } while (0)
#else
#define SEAM(k) do { if (IN(k) && IN((k) + 1)) xcd_barrier(bar); } while (0)
#endif
#define PHASE_FRAME(Fp) Frame Fp = F; asm volatile("" : "+v"(Fp.tid), "+v"(Fp.lane))
  const int NA = G;
  if (IN(0)) { PHASE_FRAME(F0); TP_BEGIN(1);
#ifdef SLEEP_START
#pragma unroll 1
    for (int i_ = 0; i_ < SLEEP_START; ++i_) __builtin_amdgcn_s_sleep(127);
#endif
    p0_lam(F0, args);
    p0_zero_vpad(F0);
    TP_BEGIN(41); p0_rows(F0, args); TP_END(41, F.ws);
    TP_BEGIN(42); p0_transpose<true>(F0, args, args.in[IN_WIN], DPROJ, NPROJ, (bf16*)(F.ws + WS_W1T));
    p0_transpose<false>(F0, args, args.in[IN_WOUT], DM, DM, (bf16*)(F.ws + WS_W2T)); TP_END(42, F.ws);
    TP_BEGIN(43); p0_w3t(F0, args); TP_END(43, F.ws);
    TP_BEGIN(44); p0_tables(F0, args); TP_END(44, F.ws);
#ifdef DUP_ROWS
    p0_rows(F0, args);
#endif
#ifdef DUP_TR
    p0_transpose<true>(F0, args, args.in[IN_WIN], DPROJ, NPROJ, (bf16*)(F.ws + WS_W1T));
    p0_transpose<false>(F0, args, args.in[IN_WOUT], DM, DM, (bf16*)(F.ws + WS_W2T));
#endif
#ifdef DUP_W3T
    p0_w3t(F0, args);
#endif
#ifdef DUP_TAB
    p0_tables(F0, args);
#endif
    TP_END(1, F.ws);
  }
  SEAM(0);
  if (IN(1)) { PHASE_FRAME(F1); TP_BEGIN(2);
    p1_meta_finalize(F1, args);
    pg8::Gemm g{(const pg8::bf16_t*)(F.ws + WS_XN), (const pg8::bf16_t*)(F.ws + WS_W1T), MROWS, NPROJ, DM};
    pg8::StaticOrder S; S.init(MROWS, NPROJ, G, bx);
    EpiProj E{(bf16*)(F.ws + WS_Q), (bf16*)(F.ws + WS_KP), (bf16*)(F.ws + WS_VP), (bf16*)(F.ws + WS_MQ), (bf16*)(F.ws + WS_MK), (bf16*)(F.ws + WS_MV), (bf16*)(F.ws + WS_MO),
              args.in[IN_QNG], args.in[IN_KNG], (LAS float*)(F.lds + XCH_OFF)};
    pg8::gemm_phase<EpiProj, pg8::StaticOrder, true, true>(F.lds + RING_OFF, g, S, E);
    TP_END(2, F.ws);
  }
  SEAM(1);
  if (IN(2)) {
    PHASE_FRAME(F2);
    TP_BEGIN(3);
    att::phase(F2, (G % 8 == 0) ? (bx & 7) * (G >> 3) + (bx >> 3) : bx, NA);
    TP_END(3, F.ws); TP_BEGIN(4);
    for (int task = bx; task < 512; task += G) ml::taskA(F2, args, task);
    TP_END(4, F.ws);
  }
  SEAM(2);
  if (IN(3)) { PHASE_FRAME(F3); TP_BEGIN(5); ml::scanB(F3); TP_END(5, F.ws); TP_BEGIN(6); p3_combine(F3, args, NA); TP_END(6, F.ws);
#ifdef DUP_SCAN
    ml::scanB(F3);
#endif
#ifdef DUP_COMB
    p3_combine(F3, args, NA);
#endif
  }
  SEAM(3);
#ifdef EXTRA_BARS
  for (int i_ = 0; i_ < EXTRA_BARS; ++i_) xcd_barrier(bar);
#endif
  if (IN(4)) {
    PHASE_FRAME(F4);
    TP_BEGIN(7);
    for (int task = bx; task < 512; task += G) ml::taskC(F4, args, task);
    TP_END(7, F.ws);
  }
  SEAM(4);
  if (IN(5)) { TP_BEGIN(8);
    pg8::Gemm g{(const pg8::bf16_t*)(F.ws + WS_A2), (const pg8::bf16_t*)(F.ws + WS_W2T), MROWS, DM, DM};
    pg8::StaticOrder S; S.init(MROWS, DM, G, bx);
    EpiRes E{args.in[IN_X], args.out, (bf16*)(F.ws + WS_H1B), (float*)(F.ws + WS_SSQ)};
    pg8::gemm_phase<EpiRes, pg8::StaticOrder, true, true>(F.lds + RING_OFF, g, S, E);
    TP_END(8, F.ws);
  }
  SEAM(5);
  if (IN(6)) { TP_BEGIN(9);
    pg8::Gemm g{(const pg8::bf16_t*)(F.ws + WS_H1B), (const pg8::bf16_t*)(F.ws + WS_W3T), MROWS, DM, DM};
    pg8::StaticOrder S; S.init(MROWS, DM, G, bx);
    LAS float* rst = (LAS float*)(F.lds + XCH_OFF);
    { pg8::Unit u0; if (S.next(0, u0)) { if (F.tid < 256) { const float* sp = (const float*)(F.ws + WS_SSQ) + ((size_t)u0.pm * 256 + F.tid) * 32; float s = 0.f;
#pragma unroll
          for (int i = 0; i < 8; ++i) { const f32x4 v = ((const f32x4*)sp)[i]; s += (v.x + v.y) + (v.z + v.w); }
          rst[F.tid] = rsqrtf(s * (1.0f / DM) + EPS); } } }
    __syncthreads();
    EpiScore E{(float*)(F.ws + WS_S), rst};
    pg8::gemm_phase<EpiScore, pg8::StaticOrder, true, true>(F.lds + RING_OFF, g, S, E);
    TP_END(9, F.ws);
  }
  SEAM(6);
  if (IN(7)) { PHASE_FRAME(F7); TP_BEGIN(10); p6_peer(F7, args, args.out); TP_END(10, F.ws); }
#undef IN
#undef SEAM
}
extern "C" void kernel_launch(void* const* d_in, const int* in_sizes, int n_in, void* d_out, int out_size, void* d_ws, size_t ws_size, hipStream_t stream) {
  static int grid = 0;
  if (grid == 0) {
    int dev = 0, cus = 0, per_cu = 0;
    if (hipGetDevice(&dev) != hipSuccess || hipDeviceGetAttribute(&cus, hipDeviceAttributeMultiprocessorCount, dev) != hipSuccess) { fprintf(stderr, "device query failed\n"); grid = -1; return; }
    if (hipFuncSetAttribute((const void*)mk_fwd, hipFuncAttributeMaxDynamicSharedMemorySize, LDS_BYTES) != hipSuccess) { fprintf(stderr, "hipFuncSetAttribute failed\n"); grid = -1; return; }
    if (hipOccupancyMaxActiveBlocksPerMultiprocessor(&per_cu, (const void*)mk_fwd, NTHR, LDS_BYTES) != hipSuccess || per_cu < 1) { fprintf(stderr, "occupancy query says %d workgroups per CU: not launching\n", per_cu); (void)hipGetLastError(); grid = -1; return; }
    (void)hipGetLastError();
    grid = cus;
    if (n_in != 22 || ws_size < (size_t)512 * MiB || out_size != MROWS * DM) { fprintf(stderr, "unexpected shapes: n_in %d out %d ws %zu\n", n_in, out_size, ws_size); grid = -1; return; }
  }
  if (grid < 0) return;
  unsigned char* ws = (unsigned char*)d_ws;
  if (hipMemsetAsync(ws + WS_CTL, 0, CTL_ZERO_BYTES, stream) != hipSuccess) { fprintf(stderr, "memset failed\n"); return; }
  Args a{};
  for (int i = 0; i < 22; ++i) a.in[i] = (const float*)d_in[i];
  a.out = (float*)d_out; a.ws = ws; a.na = 0; a.pad = 0;
  a.ph_lo = 0; a.ph_hi = 8;
  hipLaunchKernelGGL(mk_fwd, dim3(grid), dim3(NTHR), LDS_BYTES, stream, a);
}
```

```cpp
#include <hip/hip_runtime.h>
#include <cstdio>
#include <cstdint>
#include <math.h>
namespace pg8 {
#define PG8_LAS __attribute__((address_space(3)))
typedef unsigned short bf16_t;
typedef short bf16x8 __attribute__((ext_vector_type(8)));
typedef float f32x4 __attribute__((ext_vector_type(4)));
typedef unsigned u32x4 __attribute__((ext_vector_type(4)));
constexpr int BM = 256, BK = 64, HALF = 128, HTB = HALF * BK * 2  , STAGE_BYTES = 8 * HTB, NXCD = 8, WGM = 8;

__host__ __device__ __forceinline__ int lds_byte(int r, int c) { const int st = (r >> 4) * 2 + (c >> 5), rr = r & 15, cc = c & 31, ob = rr * 64 + cc * 2; return st * 1024 + (ob ^ (((ob >> 9) & 1) << 5)); }
__host__ __device__ __forceinline__ void stage_rc(int b, int& R, int& C) { const int st = b / 1024, sb = b % 1024, swz = sb ^ (((sb >> 9) & 1) << 5); R = (st >> 1) * 16 + swz / 64; C = (st & 1) * 32 + (swz % 64) / 2; }
__host__ __device__ __forceinline__ int perm32(int rho) { const int n = rho >> 4, i = rho & 15; return 8 * (i >> 2) + 4 * n + (i & 3); }

struct Unit { int pm, pn; };
struct Gemm { const bf16_t* A; const bf16_t* Bt; int M, N, K; };

struct StaticOrder {
    int nM, nN, nwg, G, c;
    __host__ __device__ void init(int M, int N, int G_, int c_) { nM = M / BM; nN = N / BM; nwg = nM * nN; G = G_; c = c_; }
    __host__ __device__ bool next(int i, Unit& u) const {
        const long L = (long)i * G + c; if (L >= nwg) return false;
        int wgid = (int)L; { const int q = nwg / NXCD, r = nwg % NXCD, xcd = wgid % NXCD, off = wgid / NXCD; wgid = (xcd < r ? xcd * (q + 1) : r * (q + 1) + (xcd - r) * q) + off; }
        const int nig = WGM * nN, gid = wgid / nig, fm = gid * WGM, gsz = (nM - fm) < WGM ? (nM - fm) : WGM;
        u.pm = fm + ((wgid % nig) % gsz); u.pn = (wgid % nig) / gsz; return true;
    }
    __device__ __forceinline__ void a_ready(const Unit&) const {}
    __device__ __forceinline__ void done(const Unit&) const {}
};

__device__ __forceinline__ unsigned cvt_pk_bf16(float lo, float hi) { unsigned r; asm volatile("v_cvt_pk_bf16_f32 %0, %1, %2" : "=v"(r) : "v"(lo), "v"(hi)); return r; }
typedef float f32x2 __attribute__((ext_vector_type(2)));
template <class Epi, class Sched, bool ALIGN_EPI = false, bool SP2 = false>
__device__ __forceinline__ void gemm_phase(PG8_LAS unsigned char* lds, const Gemm g, const Sched& S, const Epi& E) {
    int tid_ = threadIdx.x; asm volatile("" : "+v"(tid_));
    const int tid = tid_, wid = __builtin_amdgcn_readfirstlane(tid >> 6), lane = tid & 63, wr = wid >> 2, wc = wid & 3, fr = lane & 15, fq = lane >> 4;
    const int K = g.K, nt = K / BK;
    unsigned voffA[2], voffB[2];
#pragma unroll
    for (int i = 0; i < 2; ++i) { int R, C; stage_rc(tid * 16 + i * 8192, R, C); const int Rb = Epi::PERM ? ((R & ~31) + perm32(R & 31)) : R;
        voffA[i] = (unsigned)(R * K + C) * 2u; voffB[i] = (unsigned)(Rb * K + C) * 2u; }
    const size_t kstep = (size_t)(BK * 2);
    const size_t hstep = (size_t)HALF * K * 2;
    const size_t tstep = 2 * hstep;
    const unsigned ldsw = (unsigned)wid * 1024u;
    const int aoff = lds_byte(wr * 64 + fr, fq * 8), boff = lds_byte(wc * 32 + fr, fq * 8);
#define PG8_SA(b, h) (((b) * 2 + (h)) * HTB)
#define PG8_SB(b, h) ((4 + (b) * 2 + (h)) * HTB)
#define PG8_STAGE(bufoff, gbase, voff) do { _Pragma("unroll") for (int _i = 0; _i < 2; ++_i) \
        __builtin_amdgcn_global_load_lds((const unsigned*)((const char*)(gbase) + (voff)[_i]), (PG8_LAS unsigned*)(lds + (bufoff) + ldsw + _i * 8192), 16, 0, 0); } while (0)
#define PG8_LDA(dst, b, h) do { _Pragma("unroll") for (int m = 0; m < 4; ++m) _Pragma("unroll") for (int k = 0; k < 2; ++k) dst[m][k] = *(const PG8_LAS bf16x8*)(lds + PG8_SA(b, h) + aoff + m * 2048 + k * 1024); } while (0)
#define PG8_LDB(dst, b, h) do { _Pragma("unroll") for (int n = 0; n < 2; ++n) _Pragma("unroll") for (int k = 0; k < 2; ++k) dst[n][k] = *(const PG8_LAS bf16x8*)(lds + PG8_SB(b, h) + boff + n * 2048 + k * 1024); } while (0)
#define PG8_MMA(ai, bj, At, Bt) do { __builtin_amdgcn_s_setprio(1); _Pragma("unroll") for (int m = 0; m < 4; ++m) _Pragma("unroll") for (int n = 0; n < 2; ++n) _Pragma("unroll") for (int k = 0; k < 2; ++k) \
        acc[ai][bj][m][n] = __builtin_amdgcn_mfma_f32_16x16x32_bf16(Bt[n][k], At[m][k], acc[ai][bj][m][n], 0, 0, 0); __builtin_amdgcn_s_setprio(0); } while (0)
#define PG8_WAIT_V(n) asm volatile("s_waitcnt vmcnt(" #n ")" ::: "memory")
#define PG8_WAIT_L(n) asm volatile("s_waitcnt lgkmcnt(" #n ")" ::: "memory")
#define PG8_BAR __builtin_amdgcn_s_barrier()
#define PG8_SCHED __builtin_amdgcn_sched_barrier(0)
    Unit cur, nxt; int ui = 0;
    if (!S.next(0, cur)) return;
    f32x4 acc[2][2][4][2];
#pragma unroll
    for (int a = 0; a < 2; ++a)
#pragma unroll
        for (int b = 0; b < 2; ++b)
#pragma unroll
            for (int m = 0; m < 4; ++m)
#pragma unroll
                for (int n = 0; n < 2; ++n) acc[a][b][m][n] = (f32x4){0.f, 0.f, 0.f, 0.f};
    bf16x8 At[4][2], B0[2][2], B1[2][2];
    const char* cA = (const char*)g.A + (size_t)cur.pm * tstep; const char* cB = (const char*)g.Bt + (size_t)cur.pn * tstep;
    S.a_ready(cur);
    if constexpr (SP2) {
        PG8_STAGE(PG8_SB(0, 0), cB, voffB); PG8_STAGE(PG8_SB(0, 1), cB + hstep, voffB); PG8_STAGE(PG8_SA(0, 0), cA, voffA); PG8_STAGE(PG8_SA(0, 1), cA + hstep, voffA);
        if (wr == 1) PG8_BAR;
        PG8_WAIT_V(2); PG8_BAR;
        PG8_STAGE(PG8_SB(1, 0), cB + kstep, voffB); PG8_STAGE(PG8_SA(1, 0), cA + kstep, voffA); PG8_STAGE(PG8_SB(1, 1), cB + hstep + kstep, voffB);
        PG8_WAIT_V(6); PG8_BAR;
    } else {
        PG8_STAGE(PG8_SB(0, 0), cB, voffB); PG8_STAGE(PG8_SA(0, 0), cA, voffA); PG8_STAGE(PG8_SB(0, 1), cB + hstep, voffB); PG8_STAGE(PG8_SA(0, 1), cA + hstep, voffA);
        if (wr == 1) PG8_BAR;
        PG8_WAIT_V(4); PG8_BAR;
        PG8_STAGE(PG8_SB(1, 0), cB + kstep, voffB); PG8_STAGE(PG8_SA(1, 0), cA + kstep, voffA); PG8_STAGE(PG8_SB(1, 1), cB + hstep + kstep, voffB);
        PG8_WAIT_V(6); PG8_BAR;
    }
    for (;;) {
        const bool has_next = S.next(ui + 1, nxt);
        const char* nA = has_next ? (const char*)g.A + (size_t)nxt.pm * tstep : cA; const char* nB = has_next ? (const char*)g.Bt + (size_t)nxt.pn * tstep : cB;
        for (int t = 0; t < nt; t += 2) {
            const bool last = (t == nt - 2);
            const char* a1 = cA + (size_t)(t + 1) * kstep;
            const char* a2 = last ? nA : cA + (size_t)(t + 2) * kstep; const char* b2 = last ? nB : cB + (size_t)(t + 2) * kstep;
            const char* a3 = a2 + kstep; const char* b3 = b2 + kstep;
            if (last && has_next) S.a_ready(nxt);
            if constexpr (SP2) {
            PG8_LDB(B0, 0, 0); PG8_LDB(B1, 0, 1); PG8_SCHED; PG8_LDA(At, 0, 0); PG8_STAGE(PG8_SA(1, 1), a1 + hstep, voffA);
            PG8_WAIT_V(8); PG8_WAIT_L(0); PG8_BAR; PG8_MMA(0, 0, At, B0); PG8_MMA(0, 1, At, B1); PG8_BAR; PG8_SCHED;
            PG8_LDA(At, 0, 1); PG8_STAGE(PG8_SB(0, 0), b2, voffB); PG8_STAGE(PG8_SB(0, 1), b2 + hstep, voffB); PG8_STAGE(PG8_SA(0, 0), a2, voffA);
            PG8_WAIT_V(8); PG8_WAIT_L(0); PG8_BAR; PG8_MMA(1, 0, At, B0); PG8_MMA(1, 1, At, B1); PG8_BAR; PG8_SCHED;
            PG8_LDB(B0, 1, 0); PG8_LDB(B1, 1, 1); PG8_SCHED; PG8_LDA(At, 1, 0); PG8_STAGE(PG8_SA(0, 1), a2 + hstep, voffA);
            PG8_WAIT_V(8); PG8_WAIT_L(0); PG8_BAR; PG8_MMA(0, 0, At, B0); PG8_MMA(0, 1, At, B1); PG8_BAR; PG8_SCHED;
            PG8_LDA(At, 1, 1); PG8_STAGE(PG8_SB(1, 0), b3, voffB); PG8_STAGE(PG8_SB(1, 1), b3 + hstep, voffB); PG8_STAGE(PG8_SA(1, 0), a3, voffA);
            PG8_WAIT_V(8); PG8_WAIT_L(0); PG8_BAR; PG8_MMA(1, 0, At, B0); PG8_MMA(1, 1, At, B1); PG8_BAR; PG8_SCHED;
            } else {
            PG8_LDB(B0, 0, 0); PG8_SCHED; PG8_LDA(At, 0, 0); PG8_STAGE(PG8_SA(1, 1), a1 + hstep, voffA);
            PG8_WAIT_L(8); PG8_BAR; PG8_WAIT_L(0); PG8_MMA(0, 0, At, B0); PG8_BAR; PG8_SCHED;
            PG8_LDB(B1, 0, 1); PG8_STAGE(PG8_SB(0, 0), b2, voffB);
            PG8_BAR; PG8_WAIT_L(0); PG8_MMA(0, 1, At, B1); PG8_BAR;
            PG8_LDA(At, 0, 1); PG8_STAGE(PG8_SA(0, 0), a2, voffA);
            PG8_BAR; PG8_WAIT_L(0); PG8_MMA(1, 0, At, B0); PG8_BAR; PG8_SCHED;
            PG8_STAGE(PG8_SB(0, 1), b2 + hstep, voffB);
            PG8_WAIT_V(6); PG8_BAR; PG8_MMA(1, 1, At, B1); PG8_BAR;
            PG8_LDB(B0, 1, 0); PG8_SCHED; PG8_LDA(At, 1, 0); PG8_STAGE(PG8_SA(0, 1), a2 + hstep, voffA);
            PG8_WAIT_L(8); PG8_BAR; PG8_WAIT_L(0); PG8_MMA(0, 0, At, B0); PG8_BAR; PG8_SCHED;
            PG8_LDB(B1, 1, 1); PG8_STAGE(PG8_SB(1, 0), b3, voffB);
            PG8_BAR; PG8_WAIT_L(0); PG8_MMA(0, 1, At, B1); PG8_BAR;
            PG8_LDA(At, 1, 1); PG8_STAGE(PG8_SA(1, 0), a3, voffA);
            PG8_BAR; PG8_WAIT_L(0); PG8_MMA(1, 0, At, B0); PG8_BAR; PG8_SCHED;
            PG8_STAGE(PG8_SB(1, 1), b3 + hstep, voffB);
            PG8_WAIT_V(6); PG8_BAR; PG8_MMA(1, 1, At, B1); PG8_BAR;
            }
        }
        if constexpr (ALIGN_EPI) { if (wr == 0) PG8_BAR; }
        if constexpr (!Epi::AFTER_DRAIN) { E(acc, cur, wr, wc, fr, fq); S.done(cur); }
        if (!has_next) break;
#pragma unroll
        for (int a = 0; a < 2; ++a)
#pragma unroll
            for (int b = 0; b < 2; ++b)
#pragma unroll
                for (int m = 0; m < 4; ++m)
#pragma unroll
                    for (int n = 0; n < 2; ++n) acc[a][b][m][n] = (f32x4){0.f, 0.f, 0.f, 0.f};
        cur = nxt; cA = nA; cB = nB; ++ui;
        if constexpr (ALIGN_EPI) { if (wr == 1) PG8_BAR; }
    }
    PG8_WAIT_V(0);
    if constexpr (!ALIGN_EPI) { if (wr == 0) PG8_BAR; }
    PG8_BAR;
    if constexpr (Epi::AFTER_DRAIN) { E.fused(acc, cur, wr, wc, fr, fq, lds, wid, lane); S.done(cur); }
#undef PG8_SA
#undef PG8_SB
#undef PG8_STAGE
#undef PG8_LDA
#undef PG8_LDB
#undef PG8_MMA
#undef PG8_WAIT_V
#undef PG8_WAIT_L
#undef PG8_BAR
#undef PG8_SCHED
}
}
#define GAS __attribute__((address_space(1)))
#define LAS __attribute__((address_space(3)))
typedef unsigned short bf16;
typedef unsigned v4u __attribute__((ext_vector_type(4)));
typedef unsigned v2u __attribute__((ext_vector_type(2)));
typedef float f32x4 __attribute__((ext_vector_type(4)));
typedef short bf16x8 __attribute__((ext_vector_type(8)));
#define LDS_WAIT() asm volatile("s_waitcnt lgkmcnt(0)" ::: "memory")
#define VM_WAIT() asm volatile("s_waitcnt vmcnt(0)" ::: "memory")

constexpr int DM = 2048, NB = 4, SEQ = 2048, NMETA = 16, MROWS = NB * SEQ, DPROJ = 6152, NPROJ = 6144;
constexpr int PADT = 2112, POS0 = 64, MPOS0 = 48;
constexpr float EPS = 1e-6f;
constexpr float LOG2E = 1.4426950408889634f;
constexpr float QSCALE = 0.08838834764831845f * LOG2E;
constexpr int NWAVES = 8, NTHR = 512;

constexpr size_t MiB = 1u << 20;
constexpr size_t WS_CTL = 0, CTL_ZERO_BYTES = 32 * 1024;
constexpr size_t WS_PM = 484 * MiB;
constexpr size_t WS_W1T = 2 * MiB, WS_W2T = 26 * MiB, WS_W3T = 34 * MiB, WS_XN = 42 * MiB;
constexpr size_t WS_Q = 74 * MiB, WS_KP = 90 * MiB, WS_VP = 107 * MiB, WS_MQ = 124 * MiB, WS_MK = 133 * MiB, WS_MV = 142 * MiB, WS_MO = 159 * MiB;
constexpr size_t WS_SMALL = 175 * MiB;
constexpr size_t WS_XM = WS_SMALL, WS_LI = WS_SMALL + 128 * 1024, WS_LF = WS_SMALL + 384 * 1024, WS_LAM = WS_SMALL + 640 * 1024;
constexpr size_t WS_PO = 176 * MiB, WS_ML = 304 * MiB, WS_HM = 305 * MiB, WS_A2 = 42 * MiB, WS_H1B = 74 * MiB, WS_SSQ = 106 * MiB, WS_S = 176 * MiB, WS_UB = 384 * MiB, WS_VB = 448 * MiB;
constexpr size_t WS_SCL = WS_SMALL + 704 * 1024;
constexpr size_t WS_VB8 = WS_UB + 32 * MiB;
constexpr size_t WS_DC = 305 * MiB, WS_CS = 448 * MiB, WS_DN = 482 * MiB, WS_NS = WS_DN + 512 * 1024, WS_GS = WS_DN + 1024 * 1024, WS_MS = WS_DN + 1152 * 1024;
constexpr size_t WS_EID = 240 * MiB, WS_EGT = 244 * MiB;
constexpr int CW_BAR = 4096;

constexpr int RING_OFF = 0, RING_BYTES = 131072;
constexpr int XCH_OFF = 131072;
constexpr int MISC_OFF = XCH_OFF + 8192;
constexpr int LDS_BYTES = 155648;

__device__ __forceinline__ unsigned f2bf(float f) { unsigned u = __builtin_bit_cast(unsigned, f); return (u + 0x7fffu + ((u >> 16) & 1u)) >> 16; }
__device__ __forceinline__ unsigned pk2(float lo, float hi) { return f2bf(lo) | (f2bf(hi) << 16); }
__device__ __forceinline__ float bf2f(unsigned short u) { return __builtin_bit_cast(float, (unsigned)u << 16); }
__device__ __forceinline__ float bflo(unsigned w) { return __builtin_bit_cast(float, w << 16); }
__device__ __forceinline__ float bfhi(unsigned w) { return __builtin_bit_cast(float, w & 0xffff0000u); }
__device__ __forceinline__ float wave_sum(float v) {
#pragma unroll
  for (int o = 1; o < 64; o <<= 1) v += __shfl_xor(v, o);
  return v;
}
__device__ __forceinline__ size_t kp_off(int bhm, int pos, int d) { const int j = pos >> 6, row = pos & 63, d0 = d >> 4, hi = (d >> 3) & 1;
  return ((size_t)(bhm * 33 + j) * 8 + d0) * 1024 + (size_t)((((row << 1) | hi) ^ ((row >> 3) & 1)) << 3) + (d & 7); }
__device__ __forceinline__ float wave_sum_dpp(float v) {
  v += __builtin_bit_cast(float, __builtin_amdgcn_update_dpp(0, __builtin_bit_cast(int, v), 0xB1, 0xF, 0xF, true));
  v += __builtin_bit_cast(float, __builtin_amdgcn_update_dpp(0, __builtin_bit_cast(int, v), 0x4E, 0xF, 0xF, true));
  v += __builtin_bit_cast(float, __builtin_amdgcn_update_dpp(0, __builtin_bit_cast(int, v), 0x141, 0xF, 0xF, true));
  v += __builtin_bit_cast(float, __builtin_amdgcn_update_dpp(0, __builtin_bit_cast(int, v), 0x140, 0xF, 0xF, true));
  const float r0 = __builtin_bit_cast(float, __builtin_amdgcn_readlane(__builtin_bit_cast(int, v), 0)), r1 = __builtin_bit_cast(float, __builtin_amdgcn_readlane(__builtin_bit_cast(int, v), 16));
  const float r2 = __builtin_bit_cast(float, __builtin_amdgcn_readlane(__builtin_bit_cast(int, v), 32)), r3 = __builtin_bit_cast(float, __builtin_amdgcn_readlane(__builtin_bit_cast(int, v), 48));
  return (r0 + r1) + (r2 + r3);
}
__device__ __forceinline__ float sigmoidf_(float x) { return __builtin_amdgcn_rcpf(1.0f + __expf(-x)); }

#ifdef TPROBE
#ifndef TP_BLOCK
#define TP_BLOCK 0
#endif
#ifndef TP_DIV
#define TP_DIV 1.0f
#endif
#define TP_BEGIN(id) unsigned long long tp_t0_##id = 0; do { if (TPROBE == (id)) tp_t0_##id = __builtin_amdgcn_s_memrealtime(); } while (0)
#define TP_END(id, WS) do { if (TPROBE == (id)) { const unsigned long long t1_ = __builtin_amdgcn_s_memrealtime(); if ((int)blockIdx.x == TP_BLOCK && threadIdx.x == 0) atomicAdd((unsigned*)((WS) + 64), (unsigned)(t1_ - tp_t0_##id)); } } while (0)
#else
#define TP_BEGIN(id)
#define TP_END(id, WS)
#endif
#define XB_TMO      128
#define XB_XCNT(j)  (256  + 64 * (j))
#define XB_XSUB(j)  (1280 + 64 * (j))
#define XB_XGEN(j)  (2304 + 64 * (j))
#define XB_TOP      3328
#define XB_TOPGEN   3392
#define XCD_BAR_WORDS 3456
#define XB_SPIN_CAP (1u << 18)

__device__ __forceinline__ unsigned xb_ld(unsigned* p)              { return __hip_atomic_load(p, __ATOMIC_RELAXED, __HIP_MEMORY_SCOPE_AGENT); }
__device__ __forceinline__ unsigned xb_add(unsigned* p, unsigned v) { return __hip_atomic_fetch_add(p, v, __ATOMIC_RELAXED, __HIP_MEMORY_SCOPE_AGENT); }
__device__ __forceinline__ unsigned xb_xcc_id() { return (unsigned)__builtin_amdgcn_s_getreg((3 << 11) | 20) & 0xFu; }
#define XB_SPIN(cond, bar) do { unsigned _sp = 0; while (cond) { __builtin_amdgcn_s_sleep(1); \
    if ((++_sp & 255u) == 0u) { if (xb_ld(&(bar)[XB_TMO])) break; if (_sp > XB_SPIN_CAP) { atomicAdd(&(bar)[XB_TMO], 1u); break; } } } } while (0)

struct XcdBarrier {
    unsigned* bar; unsigned x;
    volatile LAS unsigned* st;
};

__device__ __forceinline__ XcdBarrier xcd_barrier_post(unsigned* bar, volatile LAS unsigned* st) {
    XcdBarrier b; b.bar = bar; b.x = xb_xcc_id(); b.st = st;
    if (threadIdx.x == 0) (void)xb_add(&bar[XB_XCNT(b.x)], 1u);
    return b;
}
__device__ __forceinline__ void xcd_barrier_complete(unsigned* bar, unsigned x, unsigned& nloc, unsigned& nx) {
    const unsigned G = gridDim.x * gridDim.y * gridDim.z;
    unsigned sum, cnt, mine, sp = 0u;
    for (;;) {
        sum = 0u; cnt = 0u; mine = 0u;
#pragma unroll
        for (unsigned j = 0; j < 16; ++j) { const unsigned c = xb_ld(&bar[XB_XCNT(j)]); sum += c; cnt += (c > 0u) ? 1u : 0u; mine = (j == x) ? c : mine; }
        if (sum == G) break;
        __builtin_amdgcn_s_sleep(1);
        if ((++sp & 255u) == 0u) { if (xb_ld(&bar[XB_TMO])) break; if (sp > XB_SPIN_CAP) { atomicAdd(&bar[XB_TMO], 1u); break; } }
    }
    nloc = mine > 0u ? mine : 1u; nx = cnt > 0u ? cnt : 1u;
}

__device__ __forceinline__ void xcd_barrier(const XcdBarrier& b) {
    asm volatile("s_waitcnt vmcnt(0)" ::: "memory");
    __syncthreads();
    if (threadIdx.x == 0) {
        unsigned* bar = b.bar;
        __builtin_amdgcn_s_waitcnt(0);
        unsigned nloc = b.st[0], nx = b.st[1];
        if (nloc == 0u) { xcd_barrier_complete(bar, b.x, nloc, nx); b.st[0] = nloc; b.st[1] = nx; }
        const unsigned old = xb_add(&bar[XB_XSUB(b.x)], 1u);
        const unsigned gen = old / nloc;
        if (old + 1u == (gen + 1u) * nloc) {
            __builtin_amdgcn_fence(__ATOMIC_RELEASE, "agent");
            asm volatile("s_waitcnt vmcnt(0)" ::: "memory");
            const unsigned og = xb_add(&bar[XB_TOP], 1u);
            const unsigned tg = og / nx;
            if (og + 1u == (tg + 1u) * nx) xb_add(&bar[XB_TOPGEN], 1u);
            else XB_SPIN(xb_ld(&bar[XB_TOPGEN]) == tg, bar);
            __builtin_amdgcn_fence(__ATOMIC_ACQUIRE, "agent");
            xb_add(&bar[XB_XGEN(b.x)], 1u);
            asm volatile("s_waitcnt vmcnt(0)" ::: "memory");
        } else {
            XB_SPIN(xb_ld(&bar[XB_XGEN(b.x)]) == gen, bar);
            __builtin_amdgcn_fence(__ATOMIC_ACQUIRE, "agent");
            asm volatile("s_waitcnt vmcnt(0)" ::: "memory");
        }
    }
    __syncthreads();
}

struct Args { const float* in[22]; float* out; unsigned char* ws; int ph_lo, ph_hi, na, pad; };
struct Frame {
  LAS unsigned char* lds; unsigned char* ws; int tid, lane, wave; const float* const* in;
};
#define IN_X 0
#define IN_META 1
#define IN_G1 2
#define IN_WIN 3
#define IN_CW 4
#define IN_CB 5
#define IN_IGB 6
#define IN_FGB 7
#define IN_LQ1 8
#define IN_LK1 9
#define IN_LQ2 10
#define IN_LK2 11
#define IN_QNG 12
#define IN_KNG 13
#define IN_SUBG 14
#define IN_OUTG 15
#define IN_WOUT 16
#define IN_G2 17
#define IN_WQ 18
#define IN_SUBK 19
#define IN_U 20
#define IN_V 21

__device__ __forceinline__ void p0_rows(const Frame& F, const Args& a) {
  const float* x = a.in[IN_X]; const float* meta = a.in[IN_META]; const float* g1 = a.in[IN_G1]; const float* w_in = a.in[IN_WIN];
  const float* igb = a.in[IN_IGB]; const float* fgb = a.in[IN_FGB];
  bf16* Xn = (bf16*)(F.ws + WS_XN); bf16* Xm = (bf16*)(F.ws + WS_XM); float* LI = (float*)(F.ws + WS_LI); float* LF = (float*)(F.ws + WS_LF);
  LAS f32x4* wgl = (LAS f32x4*)(F.lds);
  const int gw = blockIdx.x * NWAVES + F.wave, NGW = gridDim.x * NWAVES, lane = F.lane;
  constexpr int NTASK = MROWS / 2 + NMETA / 2;
  f32x4 xnx[2][8];
  if (gw < NTASK) { const float* sn = (gw >= MROWS / 2 ? meta + (size_t)(gw - MROWS / 2) * 2 * DM : x + (size_t)gw * 2 * DM);
#pragma unroll
    for (int i = 0; i < 8; ++i) { xnx[0][i] = __builtin_nontemporal_load((const f32x4*)sn + i * 64 + lane); xnx[1][i] = __builtin_nontemporal_load((const f32x4*)(sn + DM) + i * 64 + lane); } }
  f32x4 g1v[8];
#pragma unroll
  for (int i = 0; i < 8; ++i) g1v[i] = ((const f32x4*)g1)[i * 64 + lane];
  for (int e = F.tid; e < 4096; e += NTHR) {
    const int ln = e & 63, q = e >> 6, half = q & 1, j = (q >> 1) & 3, i = q >> 3;
    const int k = 4 * (i * 64 + ln) + j;
    wgl[e] = *(const f32x4*)(w_in + (size_t)k * DPROJ + NPROJ + 4 * half);
  }
  __syncthreads();
  for (int task = gw; task < NTASK; task += NGW) {
    const bool ismeta = task >= MROWS / 2;
    const int r0 = ismeta ? (task - MROWS / 2) * 2 : task * 2;
    f32x4 xv[2][8]; float rs[2];
    { float s0 = 0.f, s1 = 0.f;
#pragma unroll
      for (int i = 0; i < 8; ++i) { xv[0][i] = xnx[0][i]; xv[1][i] = xnx[1][i]; }
      { const int tn = task + NGW; if (tn < NTASK) { const float* sn = (tn >= MROWS / 2 ? meta + (size_t)(tn - MROWS / 2) * 2 * DM : x + (size_t)tn * 2 * DM);
#pragma unroll
          for (int i = 0; i < 8; ++i) { xnx[0][i] = __builtin_nontemporal_load((const f32x4*)sn + i * 64 + lane); xnx[1][i] = __builtin_nontemporal_load((const f32x4*)(sn + DM) + i * 64 + lane); } } }
#pragma unroll
      for (int i = 0; i < 8; ++i) { const f32x4 a0 = xv[0][i], a1 = xv[1][i];
        s0 += (a0.x * a0.x + a0.y * a0.y) + (a0.z * a0.z + a0.w * a0.w); s1 += (a1.x * a1.x + a1.y * a1.y) + (a1.z * a1.z + a1.w * a1.w); }
      rs[0] = rsqrtf(wave_sum_dpp(s0) * (1.0f / DM) + EPS); rs[1] = rsqrtf(wave_sum_dpp(s1) * (1.0f / DM) + EPS); }
    float ga[2][8];
#pragma unroll
    for (int rr = 0; rr < 2; ++rr)
#pragma unroll
      for (int g = 0; g < 8; ++g) ga[rr][g] = 0.f;
    bf16* dst0 = (ismeta ? Xm : Xn) + (size_t)r0 * DM;
#pragma unroll
    for (int i = 0; i < 8; ++i) {
      const f32x4 g = g1v[i];
      f32x4 xn[2];
#pragma unroll
      for (int rr = 0; rr < 2; ++rr) { xn[rr] = xv[rr][i] * g * rs[rr];
        v2u o; o.x = pk2(xn[rr].x, xn[rr].y); o.y = pk2(xn[rr].z, xn[rr].w); ((v2u*)(dst0 + (size_t)rr * DM))[i * 64 + lane] = o; }
#pragma unroll
      for (int j = 0; j < 4; ++j) {
        const f32x4 w0 = wgl[((i * 4 + j) * 2 + 0) * 64 + lane], w1 = wgl[((i * 4 + j) * 2 + 1) * 64 + lane];
#pragma unroll
        for (int rr = 0; rr < 2; ++rr) { const float xs_ = xn[rr][j];
          ga[rr][0] += xs_ * w0.x; ga[rr][1] += xs_ * w0.y; ga[rr][2] += xs_ * w0.z; ga[rr][3] += xs_ * w0.w;
          ga[rr][4] += xs_ * w1.x; ga[rr][5] += xs_ * w1.y; ga[rr][6] += xs_ * w1.z; ga[rr][7] += xs_ * w1.w; }
      }
      __builtin_amdgcn_sched_barrier(0);
    }
#pragma unroll
    for (int rr = 0; rr < 2; ++rr)
#pragma unroll
      for (int g = 0; g < 8; ++g) ga[rr][g] = wave_sum_dpp(ga[rr][g]);
    if (lane < 8) {
      const int rr = lane >> 2, h = lane & 3;
      float gi = 0.f, gf = 0.f;
#pragma unroll
      for (int q = 0; q < 2; ++q)
#pragma unroll
        for (int hh = 0; hh < 4; ++hh) if (q == rr && hh == h) { gi = ga[q][hh]; gf = ga[q][4 + hh]; }
      const float li = gi + igb[h]; const float fx = gf + fgb[h];
      const float lf = fminf(fx, 0.f) - log1pf(__expf(-fabsf(fx)));
      const int R = r0 + rr;
      if (!ismeta) { const int b = R >> 11, t = R & 2047; LI[(b * 4 + h) * PADT + POS0 + t] = li; LF[(b * 4 + h) * PADT + POS0 + t] = lf; }
      else { for (int b = 0; b < NB; ++b) { LI[(b * 4 + h) * PADT + MPOS0 + R] = li; LF[(b * 4 + h) * PADT + MPOS0 + R] = lf; } }
    }
  }
  __syncthreads();
}
template <bool META>
__device__ __forceinline__ void p0_transpose(const Frame& F, const Args& a, const float* W, int ldw, int N, bf16* Wt) {
  LAS float* tl = (LAS float*)(F.lds);
  LAS float* red = (LAS float*)(F.lds + 33792);
  float* PM = (float*)(F.ws + WS_PM);
  const float* meta = a.in[IN_META]; const float* g1 = a.in[IN_G1];
  const int ntn = N / 64, ntask = ntn * 16, fr = F.lane & 15, fq = F.lane >> 4, w = F.wave;
  f32x4 wn[4];
  float am[4], ag[4];
  if ((int)blockIdx.x < ntask) { const int nb = blockIdx.x % ntn, kb = blockIdx.x / ntn;
#pragma unroll
    for (int i = 0; i < 4; ++i) { const int idx = F.tid + NTHR * i, kk = idx >> 4, c4 = idx & 15; wn[i] = __builtin_nontemporal_load((const f32x4*)(W + (size_t)(kb * 128 + kk) * ldw + nb * 64 + 4 * c4)); }
    if (META) {
#pragma unroll
      for (int s_ = 0; s_ < 4; ++s_) { const int k = kb * 128 + 16 * w + 4 * s_ + fq; am[s_] = meta[(size_t)fr * DM + k]; ag[s_] = g1[k]; } } }
  for (int task = blockIdx.x; task < ntask; task += gridDim.x) {
    const int nb = task % ntn, kb = task / ntn, n0 = nb * 64, k0 = kb * 128;
    __syncthreads();
#pragma unroll
    for (int i = 0; i < 4; ++i) { const int idx = F.tid + NTHR * i, kk = idx >> 4, c4 = idx & 15; const f32x4 wv = wn[i];
      LAS float* d = tl + kk * 65 + 4 * c4; d[0] = wv.x; d[1] = wv.y; d[2] = wv.z; d[3] = wv.w; }
    float ac[4];
    if (META) {
#pragma unroll
      for (int s_ = 0; s_ < 4; ++s_) ac[s_] = am[s_] * ag[s_]; }
    { const int tn = task + gridDim.x; if (tn < ntask) { const int nb2 = tn % ntn, kb2 = tn / ntn;
#pragma unroll
        for (int i = 0; i < 4; ++i) { const int idx = F.tid + NTHR * i, kk = idx >> 4, c4 = idx & 15; wn[i] = __builtin_nontemporal_load((const f32x4*)(W + (size_t)(kb2 * 128 + kk) * ldw + nb2 * 64 + 4 * c4)); }
        if (META) {
#pragma unroll
          for (int s_ = 0; s_ < 4; ++s_) { const int k = kb2 * 128 + 16 * w + 4 * s_ + fq; am[s_] = meta[(size_t)fr * DM + k]; ag[s_] = g1[k]; } } } }
    __syncthreads();
    const int n = F.tid >> 3, kc = F.tid & 7;
    const LAS float* s = tl + (kc * 16) * 65 + n;
    v4u o0, o1;
    o0.x = pk2(s[0 * 65], s[1 * 65]); o0.y = pk2(s[2 * 65], s[3 * 65]); o0.z = pk2(s[4 * 65], s[5 * 65]); o0.w = pk2(s[6 * 65], s[7 * 65]);
    o1.x = pk2(s[8 * 65], s[9 * 65]); o1.y = pk2(s[10 * 65], s[11 * 65]); o1.z = pk2(s[12 * 65], s[13 * 65]); o1.w = pk2(s[14 * 65], s[15 * 65]);
    v4u* dp = (v4u*)(Wt + (size_t)(n0 + n) * DM + k0 + kc * 16);
    dp[0] = o0; dp[1] = o1;
    if (META && n0 >= 1024) {
      f32x4 acc[4];
#pragma unroll
      for (int nt = 0; nt < 4; ++nt) acc[nt] = (f32x4){0.f, 0.f, 0.f, 0.f};
#pragma unroll
      for (int s_ = 0; s_ < 4; ++s_)
#pragma unroll
        for (int nt = 0; nt < 4; ++nt) acc[nt] = __builtin_amdgcn_mfma_f32_16x16x4f32(ac[s_], tl[(16 * w + 4 * s_ + fq) * 65 + nt * 16 + fr], acc[nt], 0, 0, 0);
#pragma unroll
      for (int nt = 0; nt < 4; ++nt)
#pragma unroll
        for (int i = 0; i < 4; ++i) red[(w * 16 + 4 * fq + i) * 64 + nt * 16 + fr] = acc[nt][i];
      __syncthreads();
#pragma unroll
      for (int j = 0; j < 2; ++j) { const int idx = F.tid + NTHR * j, m = idx >> 6, nn = idx & 63; const LAS float* r = red + m * 64 + nn;
        PM[((size_t)kb * 16 + m) * NPROJ + n0 + nn] = ((r[0] + r[1024]) + (r[2048] + r[3072])) + ((r[4096] + r[5120]) + (r[6144] + r[7168])); }
    }
  }
  __syncthreads();
}
__device__ __forceinline__ void p0_zero_vpad(const Frame& F) {
  bf16* Vp = (bf16*)(F.ws + WS_VP);
  const int per = MPOS0 * 256 / 8;
  for (int i = blockIdx.x * NTHR + F.tid; i < 16 * per; i += gridDim.x * NTHR) { const int bh = i / per, e = i % per;
    *(v4u*)(Vp + (size_t)bh * PADT * 256 + (size_t)e * 8) = (v4u){0u, 0u, 0u, 0u}; }
}
__device__ __forceinline__ void p0_lam(const Frame& F, const Args& a) {
  if (blockIdx.x == 0 && F.wave == 0) {
    const int l = F.lane;
    float s1 = a.in[IN_LQ1][l] * a.in[IN_LK1][l] + a.in[IN_LQ1][l + 64] * a.in[IN_LK1][l + 64];
    float s2 = a.in[IN_LQ2][l] * a.in[IN_LK2][l] + a.in[IN_LQ2][l + 64] * a.in[IN_LK2][l + 64];
    s1 = wave_sum(s1); s2 = wave_sum(s2);
    if (l == 0) *(float*)(F.ws + WS_LAM) = __expf(s1) - __expf(s2) + 0.2f;
  }
}

struct EpiProj {
  static constexpr bool PERM = true, AFTER_DRAIN = false;
  bf16 *Qb, *Kp, *Vp, *MQ, *MK, *MV, *MO; const float *qg, *kg; LAS float* xch;
  __device__ __forceinline__ void operator()(const pg8::f32x4 (&acc)[2][2][4][2], const pg8::Unit& u, int wr, int wc, int fr, int fq) const {
    const int pn = u.pn, b = u.pm >> 3, tb = (u.pm & 7) * 256 + wr * 64 + fr, d0 = wc * 32 + fq * 8;
    if (pn < 8) {
      const bool isk = pn >= 4; const int h = pn & 3;
      float ssq[2][4][2];
#pragma unroll
      for (int ai = 0; ai < 2; ++ai)
#pragma unroll
        for (int m = 0; m < 4; ++m)
#pragma unroll
          for (int bj = 0; bj < 2; ++bj) { float s = 0.f;
#pragma unroll
            for (int n = 0; n < 2; ++n) { const pg8::f32x4 x = acc[ai][bj][m][n]; s += (x[0] * x[0] + x[1] * x[1]) + (x[2] * x[2] + x[3] * x[3]); }
            s += __shfl_xor(s, 16); s += __shfl_xor(s, 32); ssq[ai][m][bj] = s;
            if (fq == 0) xch[((ai * 128 + wr * 64 + m * 16 + fr) * 2 + bj) * 4 + wc] = s; }
      asm volatile("s_waitcnt lgkmcnt(0)" ::: "memory"); __builtin_amdgcn_s_barrier(); asm volatile("" ::: "memory");
      const float* gp = (isk ? kg : qg) + d0; const f32x4 g0 = *(const f32x4*)gp, g1v = *(const f32x4*)(gp + 4);
      const float sc = isk ? 1.0f : QSCALE;
#pragma unroll
      for (int ai = 0; ai < 2; ++ai)
#pragma unroll
        for (int m = 0; m < 4; ++m)
#pragma unroll
          for (int bj = 0; bj < 2; ++bj) {
            const f32x4 p = *(const LAS f32x4*)(xch + ((ai * 128 + wr * 64 + m * 16 + fr) * 2 + bj) * 4);
            const float rs = rsqrtf(((p.x + p.y) + (p.z + p.w)) * (1.0f / 128.f) + EPS) * sc;
            const pg8::f32x4 v0 = acc[ai][bj][m][0], v1 = acc[ai][bj][m][1];
            v4u w; w.x = pk2(v0[0] * rs * g0.x, v0[1] * rs * g0.y); w.y = pk2(v0[2] * rs * g0.z, v0[3] * rs * g0.w);
            w.z = pk2(v1[0] * rs * g1v.x, v1[1] * rs * g1v.y); w.w = pk2(v1[2] * rs * g1v.z, v1[3] * rs * g1v.w);
            const int t = tb + ai * 128 + m * 16;
            bf16* dst = isk ? Kp + kp_off((b * 4 + h) * 2 + bj, POS0 + t, d0)
                            : Qb + ((size_t)((b * 4 + h) * 2 + bj) * SEQ + t) * 128 + d0;
            *(v4u*)dst = w; }
      return;
    }
#pragma unroll
    for (int ai = 0; ai < 2; ++ai)
#pragma unroll
      for (int m = 0; m < 4; ++m)
#pragma unroll
        for (int bj = 0; bj < 2; ++bj) {
          pg8::f32x4 v0 = acc[ai][bj][m][0], v1 = acc[ai][bj][m][1];
          const int t = tb + ai * 128 + m * 16;
          bf16* dst;
          if (pn < 12) { const int h = pn - 8; dst = Vp + ((size_t)(b * 4 + h) * PADT + POS0 + t) * 256 + bj * 128 + d0; }
          else if (pn < 16) { const int h = 2 * (pn & 1) + bj; dst = (pn >= 14 ? MK : MQ) + ((size_t)(b * 4 + h) * PADT + POS0 + t) * 128 + d0; }
          else if (pn < 20) { const int h = pn - 16; dst = MV + ((size_t)(b * 4 + h) * PADT + POS0 + t) * 256 + bj * 128 + d0; }
          else dst = MO + (size_t)(b * SEQ + t) * 1024 + (pn - 20) * 256 + bj * 128 + d0;
          v4u w; w.x = pk2(v0[0], v0[1]); w.y = pk2(v0[2], v0[3]); w.z = pk2(v1[0], v1[1]); w.w = pk2(v1[2], v1[3]);
          *(v4u*)dst = w; }
  }
};
__device__ __forceinline__ void p1_meta_finalize(const Frame& F, const Args& a) {
  const bool spread = gridDim.x >= 2 * NMETA;
  if (spread ? ((blockIdx.x & 1) != 0 || blockIdx.x >= 2 * NMETA) : (blockIdx.x >= NMETA)) return;
  const int mrow = spread ? (int)(blockIdx.x >> 1) : (int)blockIdx.x, tid = F.tid, lane = F.lane, w = F.wave;
  const float* meta = a.in[IN_META] + (size_t)mrow * DM; const float* PM0 = (const float*)(F.ws + WS_PM) + (size_t)mrow * NPROJ;
#define PM_P4(i, p) ((PM0[(size_t)(16 * (p)) * NPROJ + (i)] + PM0[(size_t)(16 * ((p) + 1)) * NPROJ + (i)]) + (PM0[(size_t)(16 * ((p) + 2)) * NPROJ + (i)] + PM0[(size_t)(16 * ((p) + 3)) * NPROJ + (i)]))
#define PM_AT(i) ((PM_P4(i, 0) + PM_P4(i, 4)) + (PM_P4(i, 8) + PM_P4(i, 12)))
  LAS float* red = (LAS float*)(F.lds + XCH_OFF);
  const f32x4 mv = ((const f32x4*)meta)[tid];
  float s = wave_sum((mv.x * mv.x + mv.y * mv.y) + (mv.z * mv.z + mv.w * mv.w));
  if (lane == 0) red[w] = s;
  __syncthreads();
  float tot = 0.f;
#pragma unroll
  for (int i = 0; i < 8; ++i) tot += red[i];
  const float rs = rsqrtf(tot * (1.0f / DM) + EPS);
  bf16* Kp = (bf16*)(F.ws + WS_KP); bf16* Vp = (bf16*)(F.ws + WS_VP); bf16* MQ = (bf16*)(F.ws + WS_MQ); bf16* MK = (bf16*)(F.ws + WS_MK); bf16* MV = (bf16*)(F.ws + WS_MV);
  const int pos = MPOS0 + mrow;
  const int c = tid * 2;
  const float kv0 = PM_AT(1024 + w * 128 + lane), kv1 = PM_AT(1024 + w * 128 + lane + 64);
  const float a0 = PM_AT(2048 + c), a1 = PM_AT(2048 + c + 1), b0 = PM_AT(3072 + c), b1 = PM_AT(3072 + c + 1), c0 = PM_AT(4096 + c), c1 = PM_AT(4096 + c + 1);
  {
    const float v0 = kv0 * rs, v1 = kv1 * rs;
    const float rk = rsqrtf(wave_sum(v0 * v0 + v1 * v1) * (1.0f / 128.f) + EPS);
    const float* kg = a.in[IN_KNG];
    const unsigned short o0 = (unsigned short)f2bf(v0 * rk * kg[lane]), o1 = (unsigned short)f2bf(v1 * rk * kg[lane + 64]);
    for (int b = 0; b < NB; ++b) { const int bhm = (b * 4 + (w >> 1)) * 2 + (w & 1); Kp[kp_off(bhm, pos, lane)] = o0; Kp[kp_off(bhm, pos, lane + 64)] = o1; }
  }
  {
    const unsigned o = pk2(a0 * rs, a1 * rs); const int h = c >> 8, e = c & 255;
    for (int b = 0; b < NB; ++b) *(unsigned*)(Vp + ((size_t)(b * 4 + h) * PADT + pos) * 256 + e) = o;
    const unsigned o2 = pk2(b0 * rs, b1 * rs); const bool isk = c >= 512; const int cc = c & 511, hq = cc >> 7, d = cc & 127;
    for (int b = 0; b < NB; ++b) *(unsigned*)((isk ? MK : MQ) + ((size_t)(b * 4 + hq) * PADT + pos) * 128 + d) = o2;
    const unsigned o3 = pk2(c0 * rs, c1 * rs);
    for (int b = 0; b < NB; ++b) *(unsigned*)(MV + ((size_t)(b * 4 + h) * PADT + pos) * 256 + e) = o3;
  }
  __syncthreads();
}
#undef PM_AT
#undef PM_P4

namespace att {
using f32x16 = __attribute__((ext_vector_type(16))) float;
using s16x4 = __attribute__((ext_vector_type(4))) short;
constexpr int STEPS_BHM = 152, NSTEPS = 32 * STEPS_BHM;
constexpr int SHM_V = 64 * 256 * 2, SHM_K = 64 * 128 * 2;
constexpr int LDS_V = 0, LDS_K = 2 * SHM_V, LDS_Q = LDS_K + SHM_K, LDS_WS = LDS_Q + 8 * 8192;
constexpr float THR2 = 8.0f;
#define KSWZ(row, colB) ((row) * 256 + ((colB) ^ (((row) & 7) << 4)))
#define SBAR() __builtin_amdgcn_sched_barrier(0)
__device__ __forceinline__ int crow(int r, int hi) { return (r & 3) + 8 * (r >> 2) + 4 * hi; }
__device__ __forceinline__ unsigned cvtpk(float lo, float hi) { unsigned r; asm volatile("v_cvt_pk_bf16_f32 %0, %1, %2" : "=v"(r) : "v"(lo), "v"(hi)); return r; }
__device__ __forceinline__ int qb_start(int qb) { return 2 * qb * qb + 3 * qb; }
__device__ __forceinline__ int chunk_of(int s, int NA) { return ((s + 1) * NA - 1) / NSTEPS; }

template <int OFF> __device__ __forceinline__ s16x4 tr_read(int vb) {
  s16x4 r; asm volatile("ds_read_b64_tr_b16 %0, %1 offset:%2" : "=&v"(r) : "v"(vb), "i"(OFF) : "memory"); return r;
}
constexpr int v_rd_off(int d0, int ks, int half) { return d0 * 512 + ks * 8192 + half * 4096; }
template <int D0> __device__ __forceinline__ void pv_one(f32x16& od, int vb, bf16x8 pa0, bf16x8 pa1, bf16x8 pa2, bf16x8 pa3) {
#define PK(L, H) (bf16x8){L[0], L[1], L[2], L[3], H[0], H[1], H[2], H[3]}
  { const s16x4 l0 = tr_read<v_rd_off(D0, 0, 0)>(vb), h0 = tr_read<v_rd_off(D0, 0, 1)>(vb), l1 = tr_read<v_rd_off(D0, 1, 0)>(vb), h1 = tr_read<v_rd_off(D0, 1, 1)>(vb);
    asm volatile("s_waitcnt lgkmcnt(0)" ::: "memory"); SBAR();
    od = __builtin_amdgcn_mfma_f32_32x32x16_bf16(pa0, PK(l0, h0), od, 0, 0, 0);
    od = __builtin_amdgcn_mfma_f32_32x32x16_bf16(pa1, PK(l1, h1), od, 0, 0, 0); }
  SBAR();
  { const s16x4 l2 = tr_read<v_rd_off(D0, 2, 0)>(vb), h2 = tr_read<v_rd_off(D0, 2, 1)>(vb), l3 = tr_read<v_rd_off(D0, 3, 0)>(vb), h3 = tr_read<v_rd_off(D0, 3, 1)>(vb);
    asm volatile("s_waitcnt lgkmcnt(0)" ::: "memory"); SBAR();
    od = __builtin_amdgcn_mfma_f32_32x32x16_bf16(pa2, PK(l2, h2), od, 0, 0, 0);
    od = __builtin_amdgcn_mfma_f32_32x32x16_bf16(pa3, PK(l3, h3), od, 0, 0, 0); }
#undef PK
}

__device__ __forceinline__ void segment(const Frame& F, int bhm, int qb, int j0, int j1, int slot) {
  const int tid = F.tid, wid = F.wave, lane = F.lane, r32 = lane & 31, hi = lane >> 5;
  const bf16* Qg = (const bf16*)(F.ws + WS_Q) + ((size_t)bhm * SEQ + qb * 256 + wid * 32 + r32) * 128 + hi * 8;
  const bf16* Kg = (const bf16*)(F.ws + WS_KP) + (size_t)bhm * 33 * 8192;
  const bf16* Vg = (const bf16*)(F.ws + WS_VP) + (size_t)(bhm >> 1) * PADT * 256;
  LAS unsigned char* lds = F.lds;
  LAS float* wsl = (LAS float*)(lds + LDS_WS) + wid * 64;
  const float slope2 = exp2f(-2.0f * (float)(((bhm >> 1) & 3) + 1)) * LOG2E;
  unsigned ksrc0, vsrc0;
  ksrc0 = (unsigned)tid * 16u;
  { const int a8 = tid >> 8, b = (tid >> 2) & 7, k = 8 * (b >> 2) + 4 * a8 + (b & 3), c = ((tid >> 5) & 7) * 32 + (tid & 3) * 8; vsrc0 = (unsigned)(k * 256 + c) * 2u; }
#define STAGE_K(j) do { const char* kt = (const char*)(Kg + (size_t)(j) * 8192); \
    _Pragma("unroll") for (int _i = 0; _i < 2; ++_i) __builtin_amdgcn_global_load_lds((const unsigned*)(kt + (ksrc0 + _i * 8192u)), (LAS unsigned*)(lds + LDS_K + _i * 8192 + wid * 1024), 16, 0, 0); } while (0)
#define STAGE_V(buf, j) do { const char* vt = (const char*)(Vg + (size_t)(j) * 64 * 256); \
    _Pragma("unroll") for (int _i = 0; _i < 4; ++_i) __builtin_amdgcn_global_load_lds((const unsigned*)(vt + (vsrc0 + _i * 8192u)), (LAS unsigned*)(lds + LDS_V + (buf) * SHM_V + _i * 8192 + wid * 1024), 16, 0, 0); } while (0)
  const int lt = (((r32 << 1) | hi) ^ ((r32 >> 3) & 1)) << 4;
  LAS unsigned char* Qs = lds + LDS_Q + wid * 8192;
#pragma unroll
  for (int d0 = 0; d0 < 8; ++d0) { const bf16x8 qv = *(const bf16x8*)(Qg + d0 * 16); *(LAS bf16x8*)(Qs + d0 * 1024 + lt) = qv; }
  f32x16 o[8];
#pragma unroll
  for (int d = 0; d < 8; ++d)
#pragma unroll
    for (int r = 0; r < 16; ++r) o[d][r] = 0.f;
  float m_reg = -1e30f, l_reg = 0.f;
  const int vb0 = (int)(uintptr_t)(lds + LDS_V) + (((lane & 3) << 3) | (((lane >> 2) & 3) << 6) | (((lane >> 4) & 1) << 5) | (((lane >> 5) & 1) << 8));
  STAGE_K(j0); STAGE_V(0, j0);
  VM_WAIT(); __syncthreads();
  for (int j = j0; j < j1; ++j) {
    const int cur = (j - j0) & 1;
    if (j + 1 < j1) STAGE_V(cur ^ 1, j + 1);
    SBAR();
    f32x16 p0 = {}, p1 = {};
    { const LAS unsigned char* Ks = lds + LDS_K;
#pragma unroll
      for (int d0 = 0; d0 < 8; ++d0) {
        const bf16x8 b0 = *(const LAS bf16x8*)(Ks + d0 * 2048 + lt);
        const bf16x8 b1 = *(const LAS bf16x8*)(Ks + d0 * 2048 + 1024 + lt);
        const bf16x8 qf = *(const LAS bf16x8*)(Qs + d0 * 1024 + lt);
        p0 = __builtin_amdgcn_mfma_f32_32x32x16_bf16(b0, qf, p0, 0, 0, 0);
        p1 = __builtin_amdgcn_mfma_f32_32x32x16_bf16(b1, qf, p1, 0, 0, 0); } }
    asm volatile("s_waitcnt lgkmcnt(0)" ::: "memory"); __builtin_amdgcn_s_barrier(); asm volatile("" ::: "memory");
    if (j + 1 < j1) STAGE_K(j + 1);
    SBAR();
    if (j == 0) {
#pragma unroll
      for (int r = 0; r < 16; ++r) p0[r] = -INFINITY;
#pragma unroll
      for (int r = 0; r < 8; ++r) p1[r] = -INFINITY;
    }
    int ln2 = threadIdx.x & 63; asm volatile("" : "+v"(ln2));
    const int hi2 = ln2 >> 5;
    const int jb = j - (4 * qb + 1);
    if (jb >= 0) {
      const int kb = 64 * jb + 4 * hi2, qrel = wid * 32 + (ln2 & 31);
#pragma unroll
      for (int r = 0; r < 16; ++r) { const int kv = kb + (r & 3) + 8 * (r >> 2); if (kv > qrel) p0[r] = -INFINITY; if (kv + 32 > qrel) p1[r] = -INFINITY; }
    }
    const float off0 = slope2 * (float)(64 * j + 4 * hi2), off1 = off0 + 32.0f * slope2;
#pragma unroll
    for (int r = 0; r < 16; ++r) { const float sb = slope2 * (float)((r & 3) + 8 * (r >> 2)); p0[r] += sb; p1[r] += sb; }
    float pm0 = p0[0], pm1 = p1[0];
#pragma unroll
    for (int r = 1; r < 16; ++r) { pm0 = fmaxf(pm0, p0[r]); pm1 = fmaxf(pm1, p1[r]); }
    float pmax = fmaxf(pm0 + off0, pm1 + off1);
    { auto rr = __builtin_amdgcn_permlane32_swap(__float_as_uint(pmax), __float_as_uint(pmax), false, false);
      pmax = fmaxf(__uint_as_float(rr[0]), __uint_as_float(rr[1])); }
    float mn, alpha;
    if (__builtin_expect(__all(pmax - m_reg <= THR2), 1)) { mn = m_reg; alpha = 1.f; }
    else { mn = fmaxf(m_reg, pmax); alpha = __builtin_amdgcn_exp2f(m_reg - mn); m_reg = mn; }
    const float c0 = off0 - mn, c1 = off1 - mn;
    float ps = 0.f;
#pragma unroll
    for (int r = 0; r < 16; ++r) { p0[r] = __builtin_amdgcn_exp2f(p0[r] + c0); p1[r] = __builtin_amdgcn_exp2f(p1[r] + c1); ps += p0[r] + p1[r]; }
    { auto rr = __builtin_amdgcn_permlane32_swap(__float_as_uint(ps), __float_as_uint(ps), false, false);
      ps = __uint_as_float(rr[0]) + __uint_as_float(rr[1]); }
    l_reg = l_reg * alpha + ps;
    if (__any(alpha < 1.f)) { if (hi == 0) wsl[r32] = alpha; asm volatile("s_waitcnt lgkmcnt(0)" ::: "memory");
#pragma unroll
      for (int rg = 0; rg < 4; ++rg) { const f32x4 al = *(const LAS f32x4*)(wsl + 8 * rg + 4 * hi);
#pragma unroll
        for (int d = 0; d < 8; ++d) { o[d][4 * rg + 0] *= al.x; o[d][4 * rg + 1] *= al.y; o[d][4 * rg + 2] *= al.z; o[d][4 * rg + 3] *= al.w; }
        SBAR(); } }
    bf16x8 pa0, pa1, pa2, pa3;
#define PK4(P, BASE, OUT) do { unsigned a0 = cvtpk(P[BASE + 0], P[BASE + 1]), a1 = cvtpk(P[BASE + 2], P[BASE + 3]);   \
    unsigned b0 = cvtpk(P[BASE + 4], P[BASE + 5]), b1 = cvtpk(P[BASE + 6], P[BASE + 7]);                              \
    auto r0 = __builtin_amdgcn_permlane32_swap(a0, b0, false, false); auto r1 = __builtin_amdgcn_permlane32_swap(a1, b1, false, false); \
    v4u w = {r0[0], r1[0], r0[1], r1[1]}; OUT = *reinterpret_cast<bf16x8*>(&w); } while (0)
    PK4(p0, 0, pa0); PK4(p0, 8, pa1); PK4(p1, 0, pa2); PK4(p1, 8, pa3);
#undef PK4
    SBAR();
    { const int vb = vb0 + cur * SHM_V;
      pv_one<0>(o[0], vb, pa0, pa1, pa2, pa3); pv_one<1>(o[1], vb, pa0, pa1, pa2, pa3); pv_one<2>(o[2], vb, pa0, pa1, pa2, pa3); pv_one<3>(o[3], vb, pa0, pa1, pa2, pa3);
      pv_one<4>(o[4], vb, pa0, pa1, pa2, pa3); pv_one<5>(o[5], vb, pa0, pa1, pa2, pa3); pv_one<6>(o[6], vb, pa0, pa1, pa2, pa3); pv_one<7>(o[7], vb, pa0, pa1, pa2, pa3); }
    VM_WAIT(); __syncthreads();
  }
  { int lane2 = threadIdx.x & 63, slot2 = slot; asm volatile("" : "+v"(lane2), "+s"(slot2));
    const int r32e = lane2 & 31, hie = lane2 >> 5;
    bf16* PO = (bf16*)(F.ws + WS_PO) + (size_t)slot2 * 256 * 256; float* ML = (float*)(F.ws + WS_ML) + (size_t)slot2 * 512;
    LAS float* wse = (LAS float*)(F.lds + LDS_WS) + wid * 64;
    if (hie == 0) { wse[r32e] = l_reg; ML[(wid * 32 + r32e) * 2] = m_reg; ML[(wid * 32 + r32e) * 2 + 1] = l_reg; }
    asm volatile("s_waitcnt lgkmcnt(0)" ::: "memory");
    char* Ob = (char*)(PO + (size_t)(wid * 32) * 256);
    const bool odd = (r32e & 1) != 0;
    const unsigned lo = (unsigned)(4 * hie * 256 + (r32e & ~1) + (odd ? 32 : 0)) * 2u;
#pragma unroll
    for (int r = 0; r < 16; ++r) { const int rowc = (r & 3) + 8 * (r >> 2); const float lv = wse[rowc + 4 * hie]; const float rl = lv > 0.f ? __builtin_amdgcn_rcpf(lv) : 0.f;
#pragma unroll
      for (int dp = 0; dp < 4; ++dp) { const float va = o[2 * dp][r] * rl, vb = o[2 * dp + 1][r] * rl;
        const float send = odd ? va : vb, keep = odd ? vb : va;
        const float recv = __builtin_bit_cast(float, __builtin_amdgcn_update_dpp(0, __builtin_bit_cast(int, send), 0xB1, 0xF, 0xF, true));
        *(unsigned*)(Ob + (lo + (unsigned)(rowc * 256 + dp * 64) * 2u)) = odd ? pk2(recv, keep) : pk2(keep, recv); }
      SBAR(); } }
  __syncthreads();
#undef STAGE_K
#undef STAGE_V
}

__device__ __forceinline__ void phase(const Frame& F, int ca, int NA) {
  int s0 = (int)(((long)ca * NSTEPS) / NA); const int s1 = (int)(((long)(ca + 1) * NSTEPS) / NA);
  while (s0 < s1) {
    const int bhm = s0 / STEPS_BHM, rem = s0 - bhm * STEPS_BHM;
    int qb = 0;
#pragma unroll 1
    for (int q = 1; q < 8; ++q) if (rem >= qb_start(q)) qb = q;
    const int j0 = rem - qb_start(qb), nst = 4 * qb + 5;
    const int j1 = (j0 + (s1 - s0) < nst) ? j0 + (s1 - s0) : nst;
    const int slot = bhm * 16 + qb + chunk_of(s0, NA) - chunk_of(bhm * STEPS_BHM, NA);
    segment(F, bhm, qb, j0, j1, slot);
    s0 += j1 - j0;
  }
}
#undef KSWZ
#undef SBAR
}
namespace ml {
constexpr int QST = 136, TST = 72;
constexpr int L_RQ = 0, L_RK = 17152, L_QS = 34304, L_QW = 51712, L_KS = 69120, L_KWT = 86528, L_VT = 104960  , L_SP = 0  , L_G = 141824, L_CW = 143872;
constexpr int L_HT = 0;
constexpr int G_A = 0, G_M = 64, G_WI = 128, G_EM = 192, G_DEN = 256, G_WG = 320, G_SC = 384, G_N = 0;
constexpr int L_NV = L_CW + 5120;
constexpr int L_SSQ = L_KWT;
__device__ __forceinline__ float shfl_up_f(float v, int d) { return __shfl_up(v, d); }

struct StageCW { float v[3]; };
__device__ __forceinline__ void issue_cw(const Frame& F, const Args& a, int h, StageCW& st) {
#pragma unroll
  for (int i = 0; i < 3; ++i) { const int e = F.tid + NTHR * i; st.v[i] = 0.f;
    if (e < 2 * 5 * 128) { const int qk = e / 640, j = (e / 128) % 5, d = e & 127; const int ch = qk * 512 + h * 128 + d; st.v[i] = j < 4 ? a.in[IN_CW][j * 1024 + ch] : a.in[IN_CB][ch]; } }
}
__device__ __forceinline__ void commit_cw(const Frame& F, const StageCW& st) {
  LAS float* CW = (LAS float*)(F.lds + L_CW);
#pragma unroll
  for (int i = 0; i < 3; ++i) { const int e = F.tid + NTHR * i; if (e < 2 * 5 * 128) CW[e] = st.v[i]; }
}
struct StageRaw { v4u v[3]; };
__device__ __forceinline__ void issue_raw(const Frame& F, const bf16* g, int pos0, StageRaw& st) {
#pragma unroll
  for (int i = 0; i < 3; ++i) { const int p = F.tid + NTHR * i, row = p >> 4, ch = p & 15, pos = pos0 - 3 + row;
    st.v[i] = (v4u){0u, 0u, 0u, 0u}; if (p < 67 * 16 && pos >= MPOS0) st.v[i] = *(const v4u*)(g + (size_t)pos * 128 + ch * 8); }
}
__device__ __forceinline__ void commit_raw(const Frame& F, int lds_off, const StageRaw& st) {
#pragma unroll
  for (int i = 0; i < 3; ++i) { const int p = F.tid + NTHR * i, row = p >> 4, ch = p & 15; if (p < 67 * 16) *(LAS v4u*)(F.lds + lds_off + row * 256 + ch * 16) = st.v[i]; }
}
__device__ __forceinline__ void conv16(const Frame& F, int qk, int lds_off, int t, int d0, float (&y)[16]) {
  const LAS float* CW = (const LAS float*)(F.lds + L_CW);
#pragma unroll
  for (int e = 0; e < 16; ++e) y[e] = CW[(qk * 5 + 4) * 128 + d0 + e];
#pragma unroll
  for (int j = 0; j < 4; ++j) { const LAS v4u* rp = (const LAS v4u*)(F.lds + lds_off + (t + j) * 256 + d0 * 2); const v4u r0 = rp[0], r1 = rp[1];
    const LAS float* cw = CW + (qk * 5 + j) * 128 + d0;
    y[0] += cw[0] * bflo(r0.x); y[1] += cw[1] * bfhi(r0.x); y[2] += cw[2] * bflo(r0.y); y[3] += cw[3] * bfhi(r0.y); y[4] += cw[4] * bflo(r0.z); y[5] += cw[5] * bfhi(r0.z); y[6] += cw[6] * bflo(r0.w); y[7] += cw[7] * bfhi(r0.w);
    y[8] += cw[8] * bflo(r1.x); y[9] += cw[9] * bfhi(r1.x); y[10] += cw[10] * bflo(r1.y); y[11] += cw[11] * bfhi(r1.y); y[12] += cw[12] * bflo(r1.z); y[13] += cw[13] * bfhi(r1.z); y[14] += cw[14] * bflo(r1.w); y[15] += cw[15] * bfhi(r1.w); }
#pragma unroll
  for (int e = 0; e < 16; ++e) y[e] = y[e] * __builtin_amdgcn_rcpf(1.0f + __expf(-y[e]));
}
struct StageVT { v4u v[4]; };
__device__ __forceinline__ void issue_vt(const Frame& F, const bf16* MVg, int pos0, StageVT& st) {
#pragma unroll
  for (int i = 0; i < 4; ++i) { const int p = F.tid + NTHR * i, row = p >> 5, ch = p & 31; st.v[i] = (v4u){0u, 0u, 0u, 0u};
    if (pos0 + row >= MPOS0) st.v[i] = *(const v4u*)(MVg + (size_t)(pos0 + row) * 256 + ch * 8); }
}
__device__ __forceinline__ void commit_vt(const Frame& F, const StageVT& st) {
#pragma unroll
  for (int i = 0; i < 4; ++i) { const int p = F.tid + NTHR * i, row = p >> 5, ch = p & 31; const v4u v4 = st.v[i];
    LAS bf16* vt = (LAS bf16*)(F.lds + L_VT) + (ch * 8) * TST + row;
    vt[0 * TST] = (bf16)(v4.x & 0xffff); vt[1 * TST] = (bf16)(v4.x >> 16); vt[2 * TST] = (bf16)(v4.y & 0xffff); vt[3 * TST] = (bf16)(v4.y >> 16);
    vt[4 * TST] = (bf16)(v4.z & 0xffff); vt[5 * TST] = (bf16)(v4.z >> 16); vt[6 * TST] = (bf16)(v4.w & 0xffff); vt[7 * TST] = (bf16)(v4.w >> 16); }
}

__device__ __forceinline__ void taskA(const Frame& F, const Args& a, int task) {
  const int bh = task >> 5, c = task & 31, h = bh & 3, tid = F.tid, w = F.wave, lane = F.lane, fr = lane & 15, kq = lane >> 4, pos0 = 64 * c;
  LAS unsigned char* lds = F.lds; LAS float* G = (LAS float*)(lds + L_G);
  const bf16* MKg = (const bf16*)(F.ws + WS_MK) + (size_t)bh * PADT * 128; const bf16* MVg = (const bf16*)(F.ws + WS_MV) + (size_t)bh * PADT * 256;
  StageCW scw; StageRaw srk; StageVT svt; float li = -1e30f, lf = 0.f;
  issue_cw(F, a, h, scw); issue_raw(F, MKg, pos0, srk); issue_vt(F, MVg, pos0, svt);
  { const bool dead = pos0 + lane < MPOS0; if (w == 0 && !dead) { li = ((const float*)(F.ws + WS_LI))[bh * PADT + pos0 + lane]; lf = ((const float*)(F.ws + WS_LF))[bh * PADT + pos0 + lane]; } }
  __syncthreads();
  commit_cw(F, scw); commit_raw(F, L_RK, srk); commit_vt(F, svt);
  if (w == 0) {
    float bs = lf;
#pragma unroll
    for (int d = 1; d < 64; d <<= 1) { const float o = shfl_up_f(bs, d); if (lane >= d) bs += o; }
    const float av = li - bs; float mx = av;
#pragma unroll
    for (int o = 1; o < 64; o <<= 1) mx = fmaxf(mx, __shfl_xor(mx, o));
    G[G_WG + lane] = __expf(av - mx);
    if (lane == 63) { float* gs = (float*)(F.ws + WS_GS) + (size_t)(bh * 33 + c) * 2; gs[0] = bs; gs[1] = mx; }
  }
  __syncthreads();
  { const int t = tid >> 3, d0 = (tid & 7) * 16; float y[16]; conv16(F, 1, L_RK, t, d0, y);
    const float sw = 0.08838834764831845f * G[G_WG + t]; LAS bf16* kt = (LAS bf16*)(lds + L_KWT) + d0 * TST + t;
#pragma unroll
    for (int e = 0; e < 16; ++e) kt[e * TST] = (bf16)f2bf(y[e] * sw); }
  __syncthreads();
  v2u* DCg = (v2u*)(F.ws + WS_DC) + ((size_t)(bh * 32 + c) * 128) * 64;
#pragma unroll
  for (int jj = 0; jj < 2; ++jj) { const int j = 2 * w + jj;
    const bf16x8 bv0 = *(const LAS bf16x8*)(lds + L_VT + ((16 * j + fr) * TST + 8 * kq) * 2), bv1 = *(const LAS bf16x8*)(lds + L_VT + ((16 * j + fr) * TST + 32 + 8 * kq) * 2);
#pragma unroll
    for (int i = 0; i < 8; ++i) { f32x4 acc = {0.f, 0.f, 0.f, 0.f};
      const bf16x8 k0 = *(const LAS bf16x8*)(lds + L_KWT + ((16 * i + fr) * TST + 8 * kq) * 2), k1 = *(const LAS bf16x8*)(lds + L_KWT + ((16 * i + fr) * TST + 32 + 8 * kq) * 2);
      acc = __builtin_amdgcn_mfma_f32_16x16x32_bf16(k0, bv0, acc, 0, 0, 0); acc = __builtin_amdgcn_mfma_f32_16x16x32_bf16(k1, bv1, acc, 0, 0, 0);
      { v2u o_; o_.x = pk2(acc.x, acc.y); o_.y = pk2(acc.z, acc.w); DCg[(size_t)(i * 16 + j) * 64 + lane] = o_; } } }
  if (tid < 128) { const LAS v4u* kr = (const LAS v4u*)(lds + L_KWT + tid * TST * 2); float s = 0.f;
#pragma unroll
    for (int q = 0; q < 8; ++q) { const v4u x = kr[q]; s += (bflo(x.x) + bfhi(x.x)) + (bflo(x.y) + bfhi(x.y)) + (bflo(x.z) + bfhi(x.z)) + (bflo(x.w) + bfhi(x.w)); }
    ((float*)(F.ws + WS_DN))[(size_t)(bh * 32 + c) * 128 + tid] = s; }
}

__device__ __forceinline__ void scanB(const Frame& F) {
  const float* GS = (const float*)(F.ws + WS_GS);
  LAS float* cf = (LAS float*)F.lds;
  for (int blk = blockIdx.x; blk < 16 * 16; blk += gridDim.x) { const int bh = blk >> 4, r = (blk & 15) * NTHR + F.tid, i = r >> 10, j = (r >> 6) & 15, ln = r & 63;
    __syncthreads();
    if (F.wave == 0) {
      const int c = F.lane & 31; const v2u gs = *(const v2u*)(GS + (size_t)(bh * 33 + c) * 2); const unsigned g0 = gs.x, g1 = gs.y;
      const float bL = __builtin_bit_cast(float, g0), ml = __builtin_bit_cast(float, g1);
      float mm = 0.f, fa = 0.f, fb = 0.f, mout = 0.f;
#pragma unroll
      for (int cc = 0; cc < 32; ++cc) { const float b_ = __builtin_bit_cast(float, __builtin_amdgcn_readlane(__builtin_bit_cast(int, bL), cc)), l_ = __builtin_bit_cast(float, __builtin_amdgcn_readlane(__builtin_bit_cast(int, ml), cc));
        const float me = fmaxf(mm, l_); if (c == cc) { fa = __expf(mm - me); fb = __expf(l_ - me); } mm = b_ + me; if (c == cc) mout = mm; }
      if (F.lane < 32) { cf[2 * c] = fa; cf[2 * c + 1] = fb; if ((blk & 15) == 0) ((float*)(F.ws + WS_MS))[bh * 33 + c + 1] = mout; }
    }
    __syncthreads();
    const v2u* dc0 = (const v2u*)(F.ws + WS_DC) + ((size_t)(bh * 32) * 128 + (i * 16 + j)) * 64 + ln;
    v2u* cs = (v2u*)(F.ws + WS_CS) + ((((size_t)bh * 33) * 8 + i) * 16 + j) * 64 + ln;
    f32x4 s0 = {0.f, 0.f, 0.f, 0.f}; v2u dv[32];
#pragma unroll
    for (int c = 0; c < 32; ++c) dv[c] = dc0[(size_t)c * 128 * 64];
#pragma unroll
    for (int c = 0; c < 32; ++c) { const float fa = cf[2 * c], fb = cf[2 * c + 1];
      { const unsigned d0_ = dv[c].x, d1_ = dv[c].y; s0 = s0 * fa + (f32x4){bflo(d0_), bfhi(d0_), bflo(d1_), bfhi(d1_)} * fb; }
      v2u o; o.x = pk2(s0.x, s0.y); o.y = pk2(s0.z, s0.w); cs[(size_t)(c + 1) * 8 * 16 * 64] = o; }
    if ((blk & 15) == 0 && F.tid < 128) {
      const float* dn = (const float*)(F.ws + WS_DN) + (size_t)(bh * 32) * 128 + F.tid; float* ns = (float*)(F.ws + WS_NS) + (size_t)(bh * 33) * 128 + F.tid; float n = 0.f;
      float dnv[32];
#pragma unroll
      for (int c = 0; c < 32; ++c) dnv[c] = dn[(size_t)c * 128];
#pragma unroll
      for (int c = 0; c < 32; ++c) { n = n * cf[2 * c] + dnv[c] * cf[2 * c + 1]; ns[(size_t)(c + 1) * 128] = n; }
    }
  }
}

__device__ __forceinline__ void taskC(const Frame& F, const Args& a, int task) {
  TP_BEGIN(31);
  const int bh = task >> 5, c = (task & 31) + 1, b = bh >> 2, h = bh & 3, tid = F.tid, w = F.wave, lane = F.lane, fr = lane & 15, kq = lane >> 4, pos0 = 64 * c;
  LAS unsigned char* lds = F.lds; LAS float* G = (LAS float*)(lds + L_G); LAS float* NV = (LAS float*)(lds + L_NV);
  const bf16* MQg = (const bf16*)(F.ws + WS_MQ) + (size_t)bh * PADT * 128; const bf16* MKg = (const bf16*)(F.ws + WS_MK) + (size_t)bh * PADT * 128;
  const bf16* MVg = (const bf16*)(F.ws + WS_MV) + (size_t)bh * PADT * 256;
  const float m = ((const float*)(F.ws + WS_MS))[bh * 33 + c];
  StageCW scw; StageRaw srq, srk; StageVT svt; float nvv = 0.f, li = 0.f, lf = 0.f;
  issue_cw(F, a, h, scw); issue_raw(F, MQg, pos0, srq); issue_raw(F, MKg, pos0, srk); issue_vt(F, MVg, pos0, svt);
  if (tid < 128) nvv = ((const float*)(F.ws + WS_NS))[(size_t)(bh * 33 + c) * 128 + tid];
  if (w == 0) { li = ((const float*)(F.ws + WS_LI))[bh * PADT + pos0 + lane]; lf = ((const float*)(F.ws + WS_LF))[bh * PADT + pos0 + lane]; }
  __syncthreads();
  commit_cw(F, scw); commit_raw(F, L_RQ, srq); commit_raw(F, L_RK, srk); commit_vt(F, svt);
  if (tid < 128) NV[tid] = nvv;
  if (w == 0) {
    float bs = lf;
#pragma unroll
    for (int d = 1; d < 64; d <<= 1) { const float o = shfl_up_f(bs, d); if (lane >= d) bs += o; }
    const float av = li - bs; float cm = av;
#pragma unroll
    for (int d = 1; d < 64; d <<= 1) { const float o = shfl_up_f(cm, d); if (lane >= d) cm = fmaxf(cm, o); }
    const float Mt = fmaxf(m, cm);
    G[G_A + lane] = av; G[G_M + lane] = Mt; G[G_WI + lane] = __expf(m - Mt); G[G_EM + lane] = __expf(-(bs + Mt));
  }
  __syncthreads(); TP_END(31, F.ws); TP_BEGIN(32);
  { const int t = tid >> 3, d0 = (tid & 7) * 16; const float wi = G[G_WI + t]; float y[16];
    conv16(F, 0, L_RQ, t, d0, y);
    { v4u o0, o1, w0, w1;
      o0.x = pk2(y[0], y[1]); o0.y = pk2(y[2], y[3]); o0.z = pk2(y[4], y[5]); o0.w = pk2(y[6], y[7]); o1.x = pk2(y[8], y[9]); o1.y = pk2(y[10], y[11]); o1.z = pk2(y[12], y[13]); o1.w = pk2(y[14], y[15]);
      w0.x = pk2(y[0] * wi, y[1] * wi); w0.y = pk2(y[2] * wi, y[3] * wi); w0.z = pk2(y[4] * wi, y[5] * wi); w0.w = pk2(y[6] * wi, y[7] * wi);
      w1.x = pk2(y[8] * wi, y[9] * wi); w1.y = pk2(y[10] * wi, y[11] * wi); w1.z = pk2(y[12] * wi, y[13] * wi); w1.w = pk2(y[14] * wi, y[15] * wi);
      LAS v4u* qs = (LAS v4u*)(lds + L_QS + (t * QST + d0) * 2); qs[0] = o0; qs[1] = o1;
      LAS v4u* qw = (LAS v4u*)(lds + L_QW + (t * QST + d0) * 2); qw[0] = w0; qw[1] = w1; }
    __builtin_amdgcn_sched_barrier(0);
    conv16(F, 1, L_RK, t, d0, y);
    { const float sc = 0.08838834764831845f; v4u o0, o1;
      o0.x = pk2(y[0] * sc, y[1] * sc); o0.y = pk2(y[2] * sc, y[3] * sc); o0.z = pk2(y[4] * sc, y[5] * sc); o0.w = pk2(y[6] * sc, y[7] * sc);
      o1.x = pk2(y[8] * sc, y[9] * sc); o1.y = pk2(y[10] * sc, y[11] * sc); o1.z = pk2(y[12] * sc, y[13] * sc); o1.w = pk2(y[14] * sc, y[15] * sc);
      LAS v4u* ks = (LAS v4u*)(lds + L_KS + (t * QST + d0) * 2); ks[0] = o0; ks[1] = o1; } }
  __syncthreads(); TP_END(32, F.ws); TP_BEGIN(33);
  v4u cb[4][2];
  { const v2u* cs = (const v2u*)(F.ws + WS_CS) + (((size_t)bh * 33 + c) * 8 * 16) * 64;
#pragma unroll
    for (int I = 0; I < 4; ++I)
#pragma unroll
      for (int jj = 0; jj < 2; ++jj) { const v2u lo_ = cs[(size_t)((2 * I) * 16 + 2 * w + jj) * 64 + lane], hi_ = cs[(size_t)((2 * I + 1) * 16 + 2 * w + jj) * 64 + lane]; cb[I][jj] = (v4u){lo_.x, lo_.y, hi_.x, hi_.y}; } }
  { const int si = w >> 1; const f32x4 as = *(const LAS f32x4*)(G + G_A + 16 * si + 4 * kq);
#pragma unroll
    for (int tt = 0; tt < 2; ++tt) { const int ti = 2 * (w & 1) + tt; f32x4 acc = {0.f, 0.f, 0.f, 0.f};
#pragma unroll
      for (int ks = 0; ks < 4; ++ks) { const bf16x8 af = *(const LAS bf16x8*)(lds + L_KS + ((16 * si + fr) * QST + 32 * ks + 8 * kq) * 2);
        const bf16x8 bfr = *(const LAS bf16x8*)(lds + L_QS + ((16 * ti + fr) * QST + 32 * ks + 8 * kq) * 2);
        acc = __builtin_amdgcn_mfma_f32_16x16x32_bf16(af, bfr, acc, 0, 0, 0); }
      const int t = 16 * ti + fr, s0 = 16 * si + 4 * kq; const float Mt = G[G_M + t];
      const float v0 = (s0 + 0 <= t) ? acc.x * __expf(as.x - Mt) : 0.f, v1 = (s0 + 1 <= t) ? acc.y * __expf(as.y - Mt) : 0.f;
      const float v2 = (s0 + 2 <= t) ? acc.z * __expf(as.z - Mt) : 0.f, v3 = (s0 + 3 <= t) ? acc.w * __expf(as.w - Mt) : 0.f;
      v2u o; o.x = pk2(v0, v1); o.y = pk2(v2, v3);
      *(LAS v2u*)(lds + L_SP + (t * TST + s0) * 2) = o; } }
  __syncthreads(); TP_END(33, F.ws); TP_BEGIN(34);
  if (w == 0) { const int t = lane; float qn = 0.f, rsum = 0.f;
#pragma unroll 4
    for (int q = 0; q < 16; ++q) { const v4u x = *(const LAS v4u*)(lds + L_QS + (t * QST + q * 8) * 2); const f32x4 n0 = *(const LAS f32x4*)(NV + q * 8), n1 = *(const LAS f32x4*)(NV + q * 8 + 4);
      qn += bflo(x.x) * n0.x + bfhi(x.x) * n0.y + bflo(x.y) * n0.z + bfhi(x.y) * n0.w + bflo(x.z) * n1.x + bfhi(x.z) * n1.y + bflo(x.w) * n1.z + bfhi(x.w) * n1.w; }
#pragma unroll
    for (int q = 0; q < 8; ++q) { const v4u x = *(const LAS v4u*)(lds + L_SP + (t * TST + q * 8) * 2); rsum += (bflo(x.x) + bfhi(x.x)) + (bflo(x.y) + bfhi(x.y)) + (bflo(x.z) + bfhi(x.z)) + (bflo(x.w) + bfhi(x.w)); }
    const float den = G[G_WI + t] * qn + rsum; G[G_DEN + t] = fmaxf(fabsf(den), G[G_EM + t]); }
  f32x4 acc[2][4];
#pragma unroll
  for (int jj = 0; jj < 2; ++jj)
#pragma unroll
    for (int ti = 0; ti < 4; ++ti) acc[jj][ti] = (f32x4){0.f, 0.f, 0.f, 0.f};
#pragma unroll
  for (int I = 0; I < 4; ++I) {
#pragma unroll
    for (int ti = 0; ti < 4; ++ti) { const LAS unsigned char* qp = lds + L_QW + ((16 * ti + fr) * QST + 32 * I + 4 * kq) * 2;
      const v2u a0 = *(const LAS v2u*)qp, a1 = *(const LAS v2u*)(qp + 32); const v4u av = {a0.x, a0.y, a1.x, a1.y};
      acc[0][ti] = __builtin_amdgcn_mfma_f32_16x16x32_bf16(__builtin_bit_cast(bf16x8, av), __builtin_bit_cast(bf16x8, cb[I][0]), acc[0][ti], 0, 0, 0);
      acc[1][ti] = __builtin_amdgcn_mfma_f32_16x16x32_bf16(__builtin_bit_cast(bf16x8, av), __builtin_bit_cast(bf16x8, cb[I][1]), acc[1][ti], 0, 0, 0); }
    __builtin_amdgcn_sched_barrier(0); }
#pragma unroll
  for (int ks = 0; ks < 2; ++ks) { const bf16x8 bv0 = *(const LAS bf16x8*)(lds + L_VT + ((32 * w + fr) * TST + 32 * ks + 8 * kq) * 2), bv1 = *(const LAS bf16x8*)(lds + L_VT + ((32 * w + 16 + fr) * TST + 32 * ks + 8 * kq) * 2);
#pragma unroll
    for (int ti = 0; ti < 4; ++ti) { const bf16x8 sf = *(const LAS bf16x8*)(lds + L_SP + ((16 * ti + fr) * TST + 32 * ks + 8 * kq) * 2);
      acc[0][ti] = __builtin_amdgcn_mfma_f32_16x16x32_bf16(sf, bv0, acc[0][ti], 0, 0, 0); acc[1][ti] = __builtin_amdgcn_mfma_f32_16x16x32_bf16(sf, bv1, acc[1][ti], 0, 0, 0); } }
  v4u mvp[4];
  { const int t_ = tid >> 3, c0_ = (tid & 7) * 32; const bf16* mo_ = (const bf16*)(F.ws + WS_MO) + ((size_t)b * SEQ + 64 * (c - 1) + t_) * 1024 + h * 256 + c0_;
#pragma unroll
    for (int q = 0; q < 4; ++q) mvp[q] = *(const v4u*)(mo_ + q * 8); }
  __syncthreads(); TP_END(34, F.ws); TP_BEGIN(35);
  LAS float* SSQ = (LAS float*)(lds + L_SSQ);
#pragma unroll
  for (int ti = 0; ti < 4; ++ti) { const f32x4 dn = *(const LAS f32x4*)(G + G_DEN + 16 * ti + 4 * kq);
    f32x4 s4;
#pragma unroll
    for (int r = 0; r < 4; ++r) { const float id_ = __builtin_amdgcn_rcpf(dn[r]); const float h0 = acc[0][ti][r] * id_, h1 = acc[1][ti][r] * id_; acc[0][ti][r] = h0; acc[1][ti][r] = h1; s4[r] = h0 * h0 + h1 * h1; }
#pragma unroll
    for (int r = 0; r < 4; ++r) { float v = s4[r];
      v += __builtin_bit_cast(float, __builtin_amdgcn_update_dpp(0, __builtin_bit_cast(int, v), 0xB1, 0xF, 0xF, true)); v += __builtin_bit_cast(float, __builtin_amdgcn_update_dpp(0, __builtin_bit_cast(int, v), 0x4E, 0xF, 0xF, true));
      v += __builtin_bit_cast(float, __builtin_amdgcn_update_dpp(0, __builtin_bit_cast(int, v), 0x141, 0xF, 0xF, true)); v += __builtin_bit_cast(float, __builtin_amdgcn_update_dpp(0, __builtin_bit_cast(int, v), 0x140, 0xF, 0xF, true)); s4[r] = v; }
    if (fr == 0) { SSQ[(16 * ti + 4 * kq + 0) * 8 + w] = s4.x; SSQ[(16 * ti + 4 * kq + 1) * 8 + w] = s4.y; SSQ[(16 * ti + 4 * kq + 2) * 8 + w] = s4.z; SSQ[(16 * ti + 4 * kq + 3) * 8 + w] = s4.w; } }
  __syncthreads();
  LAS bf16* HT = (LAS bf16*)(lds + L_HT);
#pragma unroll
  for (int ti = 0; ti < 4; ++ti)
#pragma unroll
    for (int r = 0; r < 4; ++r) { const int t = 16 * ti + 4 * kq + r; const f32x4 p0 = *(const LAS f32x4*)(SSQ + t * 8), p1 = *(const LAS f32x4*)(SSQ + t * 8 + 4);
      const float rh = rsqrtf(((p0.x + p0.y) + (p0.z + p0.w) + (p1.x + p1.y) + (p1.z + p1.w)) * (1.0f / 256.f) + EPS);
      HT[t * 264 + 32 * w + fr] = (bf16)f2bf(acc[0][ti][r] * rh); HT[t * 264 + 32 * w + 16 + fr] = (bf16)f2bf(acc[1][ti][r] * rh); }
  __syncthreads(); TP_END(35, F.ws); TP_BEGIN(36);
  { const int t = tid >> 3, c0 = (tid & 7) * 32; const size_t R = (size_t)b * SEQ + 64 * (c - 1) + t;
    const float* og = a.in[IN_OUTG] + h * 256 + c0; bf16* A2 = (bf16*)(F.ws + WS_A2) + R * DM + 1024 + h * 256 + c0;
    f32x4 gg[8];
#pragma unroll
    for (int q = 0; q < 8; ++q) gg[q] = *(const f32x4*)(og + q * 4);
#pragma unroll
    for (int q = 0; q < 4; ++q) { const v4u hv = *(const LAS v4u*)(HT + t * 264 + c0 + q * 8); const v4u mv = mvp[q]; const f32x4 g0 = gg[2 * q], g1 = gg[2 * q + 1];
      v4u o; o.x = pk2(bflo(hv.x) * g0.x * sigmoidf_(bflo(mv.x)), bfhi(hv.x) * g0.y * sigmoidf_(bfhi(mv.x))); o.y = pk2(bflo(hv.y) * g0.z * sigmoidf_(bflo(mv.y)), bfhi(hv.y) * g0.w * sigmoidf_(bfhi(mv.y)));
      o.z = pk2(bflo(hv.z) * g1.x * sigmoidf_(bflo(mv.z)), bfhi(hv.z) * g1.y * sigmoidf_(bfhi(mv.z))); o.w = pk2(bflo(hv.w) * g1.z * sigmoidf_(bflo(mv.w)), bfhi(hv.w) * g1.w * sigmoidf_(bfhi(mv.w)));
      *(v4u*)(A2 + q * 8) = o; } }
  TP_END(36, F.ws);
}
}
struct CombRow { float mp[8][3], lp[8][3]; v4u op[8][3]; };
__device__ __forceinline__ float half_sum_dpp(float v, bool hi) {
  v += __builtin_bit_cast(float, __builtin_amdgcn_update_dpp(0, __builtin_bit_cast(int, v), 0xB1, 0xF, 0xF, true));
  v += __builtin_bit_cast(float, __builtin_amdgcn_update_dpp(0, __builtin_bit_cast(int, v), 0x4E, 0xF, 0xF, true));
  v += __builtin_bit_cast(float, __builtin_amdgcn_update_dpp(0, __builtin_bit_cast(int, v), 0x141, 0xF, 0xF, true));
  v += __builtin_bit_cast(float, __builtin_amdgcn_update_dpp(0, __builtin_bit_cast(int, v), 0x140, 0xF, 0xF, true));
  const float r0 = __builtin_bit_cast(float, __builtin_amdgcn_readlane(__builtin_bit_cast(int, v), 0)), r1 = __builtin_bit_cast(float, __builtin_amdgcn_readlane(__builtin_bit_cast(int, v), 16));
  const float r2 = __builtin_bit_cast(float, __builtin_amdgcn_readlane(__builtin_bit_cast(int, v), 32)), r3 = __builtin_bit_cast(float, __builtin_amdgcn_readlane(__builtin_bit_cast(int, v), 48));
  return hi ? r2 + r3 : r0 + r1;
}
__device__ __forceinline__ void comb_load(const bf16* PO, const float* ML, int R0, int NA, int lane, CombRow& cr) {
  const int b = R0 >> 11, t = R0 & 2047, qb = t >> 8, rq = (t & 255) + (lane >> 5), l32 = lane & 31;
#pragma unroll
  for (int hm = 0; hm < 8; ++hm) {
    const int bhm = b * 8 + hm, first = bhm * att::STEPS_BHM + att::qb_start(qb), last = first + 4 * qb + 4;
    const int cf = att::chunk_of(first, NA), np = att::chunk_of(last, NA) - cf + 1, slot0 = bhm * 16 + qb + cf - att::chunk_of(bhm * att::STEPS_BHM, NA);
#pragma unroll
    for (int p = 0; p < 3; ++p) { if (p < np) { const int slot = slot0 + p; const v2u ml = *(const v2u*)(ML + (size_t)slot * 512 + rq * 2);
        const unsigned mx_ = ml.x, my_ = ml.y; cr.mp[hm][p] = __builtin_bit_cast(float, mx_); cr.lp[hm][p] = __builtin_bit_cast(float, my_);
        cr.op[hm][p] = ((const v4u*)(PO + ((size_t)slot * 256 + rq) * 256))[l32]; } else { cr.mp[hm][p] = -1e30f; cr.lp[hm][p] = 0.f; cr.op[hm][p] = (v4u){0u, 0u, 0u, 0u}; } }
  }
}
__device__ __forceinline__ void comb_finish(bf16* A2, int R0, int lane, float lam, const f32x4 sg0, const f32x4 sg1, const CombRow& cr) {
  const bool hi = lane >= 32; const int l32 = lane & 31;
#pragma unroll
  for (int h = 0; h < 4; ++h) {
    float om[2][8];
#pragma unroll
    for (int m = 0; m < 2; ++m) { const int hm = h * 2 + m;
      const float M = fmaxf(cr.mp[hm][0], fmaxf(cr.mp[hm][1], cr.mp[hm][2]));
      float wsum = 0.f, acc[8];
#pragma unroll
      for (int i = 0; i < 8; ++i) acc[i] = 0.f;
#pragma unroll
      for (int p = 0; p < 3; ++p) { const float w = cr.lp[hm][p] * exp2f(cr.mp[hm][p] - M); wsum += w; const v4u ow = cr.op[hm][p];
#pragma unroll
        for (int i = 0; i < 4; ++i) { const unsigned wd = ow[i]; acc[2 * i] += bflo(wd) * w; acc[2 * i + 1] += bfhi(wd) * w; } }
      const float iw = 1.0f / wsum;
#pragma unroll
      for (int i = 0; i < 8; ++i) om[m][i] = acc[i] * iw;
    }
    float o[8], ss = 0.f;
#pragma unroll
    for (int i = 0; i < 8; ++i) { o[i] = om[0][i] - om[1][i] * lam; ss += o[i] * o[i]; }
    const float rs = rsqrtf(half_sum_dpp(ss, hi) * (1.0f / 256.f) + EPS) * 0.8f;
    v4u w; w.x = pk2(o[0] * rs * sg0.x, o[1] * rs * sg0.y); w.y = pk2(o[2] * rs * sg0.z, o[3] * rs * sg0.w); w.z = pk2(o[4] * rs * sg1.x, o[5] * rs * sg1.y); w.w = pk2(o[6] * rs * sg1.z, o[7] * rs * sg1.w);
    ((v4u*)(A2 + (size_t)(R0 + (hi ? 1 : 0)) * DM + h * 256))[l32] = w;
  }
}
__device__ __forceinline__ void p3_combine(const Frame& F, const Args& a, int NA) {
  const bf16* PO = (const bf16*)(F.ws + WS_PO); const float* ML = (const float*)(F.ws + WS_ML);
  bf16* A2 = (bf16*)(F.ws + WS_A2);
  const float lam = *(const float*)(F.ws + WS_LAM);
  const int gw = blockIdx.x * NWAVES + F.wave, NGW = gridDim.x * NWAVES, lane = F.lane;
  const f32x4 sg0 = ((const f32x4*)a.in[IN_SUBG])[2 * (lane & 31)], sg1 = ((const f32x4*)a.in[IN_SUBG])[2 * (lane & 31) + 1];
  for (int k = gw; k < MROWS / 4; k += NGW) {
#pragma unroll 1
    for (int s = 0; s < 2; ++s) { const int P = s ? MROWS / 2 - 1 - k : k;
      CombRow r0;
      comb_load(PO, ML, 2 * P, NA, lane, r0);
      comb_finish(A2, 2 * P, lane, lam, sg0, sg1, r0); }
  }
}
struct EpiRes {
  static constexpr bool PERM = true, AFTER_DRAIN = false;
  const float* x; float* out; bf16* H1b; float* SSQ;
  __device__ __forceinline__ void operator()(const pg8::f32x4 (&acc)[2][2][4][2], const pg8::Unit& u, int wr, int wc, int fr, int fq) const {
    const int row0 = u.pm * 256 + wr * 64 + fr, col0 = u.pn * 256 + wc * 32 + 8 * fq;
#pragma unroll
    for (int ai = 0; ai < 2; ++ai) {
      f32x4 xv[4][2][2];
#pragma unroll
      for (int m = 0; m < 4; ++m)
#pragma unroll
        for (int bj = 0; bj < 2; ++bj) { const size_t off = (size_t)(row0 + ai * 128 + m * 16) * DM + col0 + bj * 128; xv[m][bj][0] = __builtin_nontemporal_load((const f32x4*)(x + off)); xv[m][bj][1] = __builtin_nontemporal_load((const f32x4*)(x + off + 4)); }
#pragma unroll
      for (int m = 0; m < 4; ++m) { const size_t R = (size_t)(row0 + ai * 128 + m * 16); float s = 0.f;
#pragma unroll
        for (int bj = 0; bj < 2; ++bj) { const size_t off = R * DM + col0 + bj * 128;
          const f32x4 v0 = acc[ai][bj][m][0] + xv[m][bj][0], v1 = acc[ai][bj][m][1] + xv[m][bj][1];
          v4u w; w.x = pk2(v0.x, v0.y); w.y = pk2(v0.z, v0.w); w.z = pk2(v1.x, v1.y); w.w = pk2(v1.z, v1.w);
          *(v4u*)(H1b + off) = w;
          s += (v0.x * v0.x + v0.y * v0.y) + (v0.z * v0.z + v0.w * v0.w) + (v1.x * v1.x + v1.y * v1.y) + (v1.z * v1.z + v1.w * v1.w); }
        s += __shfl_xor(s, 16); s += __shfl_xor(s, 32);
        if (fq == 0) SSQ[R * 32 + u.pn * 4 + wc] = s; }
    }
  }
};
#ifndef PEER_U_FP8
#define PEER_U_FP8 0
#endif
typedef __bf16 bfv2 __attribute__((ext_vector_type(2)));
__device__ __forceinline__ void split_hl(const f32x4 a, const f32x4 b, bf16x8& hi, bf16x8& lo) {
  float v[8] = {a.x, a.y, a.z, a.w, b.x, b.y, b.z, b.w}; unsigned h[8], l[8];
#pragma unroll
  for (int i = 0; i < 8; ++i) { h[i] = f2bf(v[i]); l[i] = f2bf(v[i] - __builtin_bit_cast(float, h[i] << 16)); }
  v4u hv = {h[0] | (h[1] << 16), h[2] | (h[3] << 16), h[4] | (h[5] << 16), h[6] | (h[7] << 16)};
  v4u lv = {l[0] | (l[1] << 16), l[2] | (l[3] << 16), l[4] | (l[5] << 16), l[6] | (l[7] << 16)};
  hi = __builtin_bit_cast(bf16x8, hv); lo = __builtin_bit_cast(bf16x8, lv);
}
__device__ __forceinline__ void p0_w3t(const Frame& F, const Args& a) {
  const float* wq = a.in[IN_WQ]; const float* sk = a.in[IN_SUBK]; const float* g2 = a.in[IN_G2];
  bf16* W3t = (bf16*)(F.ws + WS_W3T);
  const int lane = F.lane, fr = lane & 15, fq = lane >> 4;
  constexpr int SKS = 272;
  LAS unsigned char* shi = F.lds; LAS unsigned char* slo = F.lds + 128 * SKS;
  for (int bt = blockIdx.x; bt < 256; bt += gridDim.x) {
    const int hh = bt & 15, kt = (bt >> 4) * 8 + F.wave;
    const float* ap = wq + (size_t)(kt * 16 + fr) * DM + hh * 128 + fq * 8;
    f32x4 a0[4], a1[4];
#pragma unroll
    for (int s = 0; s < 4; ++s) { a0[s] = __builtin_nontemporal_load((const f32x4*)(ap + 32 * s)); a1[s] = __builtin_nontemporal_load((const f32x4*)(ap + 32 * s + 4)); }
    const f32x4 gk = *(const f32x4*)(g2 + kt * 16 + fq * 4);
    __syncthreads();
#pragma unroll
    for (int i = 0; i < 4; ++i) { const int idx = F.tid + NTHR * i, key = idx >> 4, c8 = idx & 15; const float* p = sk + (size_t)(hh * 128 + key) * 128 + c8 * 8;
      bf16x8 h, l; split_hl(*(const f32x4*)p, *(const f32x4*)(p + 4), h, l);
      *(LAS bf16x8*)(shi + key * SKS + c8 * 16) = h; *(LAS bf16x8*)(slo + key * SKS + c8 * 16) = l; }
    bf16x8 ahi[4], alo[4];
#pragma unroll
    for (int s = 0; s < 4; ++s) split_hl(a0[s], a1[s], ahi[s], alo[s]);
    __syncthreads();
#pragma unroll 2
    for (int t2 = 0; t2 < 8; ++t2) {
      const LAS unsigned char* bh = shi + (t2 * 16 + fr) * SKS + fq * 16; const LAS unsigned char* bl = slo + (t2 * 16 + fr) * SKS + fq * 16;
      f32x4 acc = {0.f, 0.f, 0.f, 0.f};
#pragma unroll
      for (int s = 0; s < 4; ++s) { const bf16x8 bhi = *(const LAS bf16x8*)(bh + 64 * s), blo = *(const LAS bf16x8*)(bl + 64 * s);
        acc = __builtin_amdgcn_mfma_f32_16x16x32_bf16(ahi[s], bhi, acc, 0, 0, 0);
        acc = __builtin_amdgcn_mfma_f32_16x16x32_bf16(ahi[s], blo, acc, 0, 0, 0);
        acc = __builtin_amdgcn_mfma_f32_16x16x32_bf16(alo[s], bhi, acc, 0, 0, 0); }
      v2u o; o.x = pk2(acc.x * gk.x, acc.y * gk.y); o.y = pk2(acc.z * gk.z, acc.w * gk.w);
      *(v2u*)(W3t + (size_t)(hh * 128 + t2 * 16 + fr) * DM + kt * 16 + fq * 4) = o;
    }
  }
  __syncthreads();
}
typedef float f32x2v __attribute__((ext_vector_type(2)));
typedef _Float16 h16x2 __attribute__((ext_vector_type(2)));
__device__ __forceinline__ void p0_tables(const Frame& F, const Args& a) {
  const float* g2 = a.in[IN_G2];
  float* SCL = (float*)(F.ws + WS_SCL);
  const int gw = blockIdx.x * NWAVES + F.wave, NGW = gridDim.x * NWAVES, lane = F.lane;
  f32x4 gl[8];
#pragma unroll
  for (int q = 0; q < 8; ++q) gl[q] = *(const f32x4*)(g2 + q * 256 + lane * 4);
  f32x4 xa[8], xb[8];
#define TAB_LOAD(BUF, ROW) do { const int r_ = (ROW); if (r_ < 2 * 16384) { const float* src = a.in[r_ >= 16384 ? IN_V : IN_U] + (size_t)(r_ & 16383) * DM + lane * 4; \
      _Pragma("unroll") for (int q = 0; q < 8; ++q) BUF[q] = __builtin_nontemporal_load((const f32x4*)(src + q * 256)); } } while (0)
  TAB_LOAD(xa, gw); TAB_LOAD(xb, gw + NGW);
  for (int row0 = gw; row0 < 2 * 16384; row0 += 2 * NGW) {
#pragma unroll
   for (int half = 0; half < 2; ++half) { const int row = row0 + half * NGW; if (row < 2 * 16384) {
    const bool isv = row >= 16384; const int e = row & 16383;
    f32x4 x[8];
    if (half == 0) {
#pragma unroll
      for (int q = 0; q < 8; ++q) x[q] = xa[q];
      TAB_LOAD(xa, row + 2 * NGW); }
    else {
#pragma unroll
      for (int q = 0; q < 8; ++q) x[q] = xb[q];
      TAB_LOAD(xb, row + 2 * NGW); }
    float amax = 0.f, ssq = 0.f;
#pragma unroll
    for (int q = 0; q < 8; ++q) { if (!isv) x[q] = x[q] * gl[q]; amax = fmaxf(amax, fmaxf(fmaxf(fabsf(x[q].x), fabsf(x[q].y)), fmaxf(fabsf(x[q].z), fabsf(x[q].w))));
      ssq += (x[q].x * x[q].x + x[q].y * x[q].y) + (x[q].z * x[q].z + x[q].w * x[q].w); }
#pragma unroll
    for (int o = 1; o < 64; o <<= 1) amax = fmaxf(amax, __shfl_xor(amax, o));
    v4u w;
    if (isv) {
      const float sc = amax > 0.f ? 6.0f / amax : 1.0f;
#pragma unroll
      for (int d = 0; d < 4; ++d) { unsigned pk = 0u;
        pk = __builtin_amdgcn_cvt_scalef32_pk_fp4_f32(pk, x[2 * d].x * sc, x[2 * d].y * sc, 1.0f, 0); pk = __builtin_amdgcn_cvt_scalef32_pk_fp4_f32(pk, x[2 * d].z * sc, x[2 * d].w * sc, 1.0f, 1);
        pk = __builtin_amdgcn_cvt_scalef32_pk_fp4_f32(pk, x[2 * d + 1].x * sc, x[2 * d + 1].y * sc, 1.0f, 2); pk = __builtin_amdgcn_cvt_scalef32_pk_fp4_f32(pk, x[2 * d + 1].z * sc, x[2 * d + 1].w * sc, 1.0f, 3);
        w[d] = pk; }
      if (lane == 0) SCL[row] = 1.0f / sc;
    } else {
      ssq = wave_sum_dpp(ssq);
      const float sA = amax > 0.f ? amax * (1.0f / 7.0f) : 1.0f, sB = fminf(sA, 0.36f * sqrtf(ssq * (1.0f / DM)) + 1e-30f);
      const float iA = 1.0f / sA, iB = 1.0f / sB;
      float eA = 0.f, eB = 0.f;
#pragma unroll
      for (int q = 0; q < 8; ++q)
#pragma unroll
        for (int j = 0; j < 4; ++j) { const float v = x[q][j];
          const float da = v - sA * __builtin_amdgcn_fmed3f(__builtin_rintf(v * iA), -7.0f, 7.0f), db = v - sB * __builtin_amdgcn_fmed3f(__builtin_rintf(v * iB), -7.0f, 7.0f);
          eA += da * da; eB += db * db; }
      eA = wave_sum_dpp(eA); eB = wave_sum_dpp(eB);
      const bool useB = eB < eA; const float st = useB ? sB : sA, is = useB ? iB : iA;
#pragma unroll
      for (int d = 0; d < 4; ++d) { unsigned pk = 0u;
#pragma unroll
        for (int p = 0; p < 8; ++p) { const float v = x[2 * d + (p >> 2)][p & 3]; const int qi = (int)__builtin_amdgcn_fmed3f(__builtin_rintf(v * is), -7.0f, 7.0f); pk |= ((unsigned)qi & 15u) << (4 * p); }
        w[d] = pk; }
      if (lane == 0) SCL[row] = st;
    }
    *(v4u*)(F.ws + (isv ? WS_VB8 : WS_UB) + (size_t)e * 1024 + lane * 16) = w;
   } }
  }
#undef TAB_LOAD
}
struct EpiScore {
  static constexpr bool PERM = true, AFTER_DRAIN = false;
  _Float16* S; const LAS float* rs;
  __device__ __forceinline__ void operator()(const pg8::f32x4 (&acc)[2][2][4][2], const pg8::Unit& u, int wr, int wc, int fr, int fq) const {
    const int rl0 = wr * 64 + fr, keyb = wc * 32 + 8 * fq;
#pragma unroll
    for (int ai = 0; ai < 2; ++ai)
#pragma unroll
      for (int m = 0; m < 4; ++m) { const int rl = rl0 + ai * 128 + m * 16; const float r = rs[rl]; const int row = u.pm * 256 + rl;
#pragma unroll
        for (int bj = 0; bj < 2; ++bj) { _Float16* d = S + ((size_t)(((row >> 5) * 16 + u.pn * 2 + bj) * 32 + (row & 31))) * 128 + keyb;
          pg8::f32x4 v0 = acc[ai][bj][m][0] * r, v1 = acc[ai][bj][m][1] * r;
#pragma unroll
          for (int j = 0; j < 4; ++j) { v0[j] = __builtin_amdgcn_fmed3f(v0[j], -65000.0f, 65000.0f); v1[j] = __builtin_amdgcn_fmed3f(v1[j], -65000.0f, 65000.0f); }
          const h16x2 h0 = {(_Float16)v0[0], (_Float16)v0[1]}, h1 = {(_Float16)v0[2], (_Float16)v0[3]}, h2 = {(_Float16)v1[0], (_Float16)v1[1]}, h3 = {(_Float16)v1[2], (_Float16)v1[3]};
          v4u w; w.x = __builtin_bit_cast(unsigned, h0); w.y = __builtin_bit_cast(unsigned, h1); w.z = __builtin_bit_cast(unsigned, h2); w.w = __builtin_bit_cast(unsigned, h3);
          *(v4u*)d = w; } }
  }
};

__device__ __forceinline__ unsigned fkey(float f) { const unsigned b = __builtin_bit_cast(unsigned, f); return b ^ ((b >> 31) ? 0xFFFFFFFFu : 0x80000000u); }
template <int NV, int K> __device__ __forceinline__ void wave_topk(const unsigned (&u)[NV], bool (&sel)[NV], int lane) {
  unsigned prefix = 0u; int cge = NV * 64;
#pragma unroll 1
  for (int bit = 31; bit >= 0 && cge != K; --bit) {
    const unsigned cand = prefix | (1u << bit); int c = 0;
#pragma unroll
    for (int i = 0; i < NV; ++i) c += __builtin_popcountll(__ballot(u[i] >= cand));
    if (c >= K) { prefix = cand; cge = c; }
  }
  int cgt = 0;
#pragma unroll
  for (int i = 0; i < NV; ++i) cgt += __builtin_popcountll(__ballot(u[i] > prefix));
  int need = K - cgt;
  const unsigned long long lm = (1ull << lane) - 1ull;
#pragma unroll
  for (int i = 0; i < NV; ++i) { const unsigned long long eq = __ballot(u[i] == prefix); const int before = __builtin_popcountll(eq & lm);
    sel[i] = (u[i] > prefix) || (u[i] == prefix && before < need); const int ne = __builtin_popcountll(eq); need = need > ne ? need - ne : 0; }
}
template <int NG, int NV, int K> __device__ __forceinline__ void wave_topk_multi(const unsigned (&u)[NG][NV], bool (&sel)[NG][NV], int lane) {
  unsigned prefix[NG]; int cge[NG];
#pragma unroll
  for (int g = 0; g < NG; ++g) { prefix[g] = 0u; cge[g] = NV * 64; }
#pragma unroll 1
  for (int bit = 31; bit >= 0; --bit) {
    bool done = true;
#pragma unroll
    for (int g = 0; g < NG; ++g) done = done && (cge[g] == K);
    if (done) break;
#pragma unroll
    for (int g = 0; g < NG; ++g) { const unsigned cand = prefix[g] | (1u << bit); int c = 0;
#pragma unroll
      for (int i = 0; i < NV; ++i) c += __builtin_popcountll(__ballot(u[g][i] >= cand));
      if (cge[g] != K && c >= K) { prefix[g] = cand; cge[g] = c; } }
  }
  const unsigned long long lm = (1ull << lane) - 1ull;
#pragma unroll
  for (int g = 0; g < NG; ++g) { int cgt = 0;
#pragma unroll
    for (int i = 0; i < NV; ++i) cgt += __builtin_popcountll(__ballot(u[g][i] > prefix[g]));
    int need = K - cgt;
#pragma unroll
    for (int i = 0; i < NV; ++i) { const unsigned long long eq = __ballot(u[g][i] == prefix[g]); const int before = __builtin_popcountll(eq & lm);
      sel[g][i] = (u[g][i] > prefix[g]) || (u[g][i] == prefix[g] && before < need); const int ne = __builtin_popcountll(eq); need = need > ne ? need - ne : 0; } }
}
__device__ __forceinline__ float gelu_erf(float v) {
  const float av = fabsf(v), t = __builtin_amdgcn_rcpf(1.0f + 0.2316418882f * av);
  float q = t * 0.5307027145f - 0.7265760135f; q = q * t + 0.7107068705f; q = q * t - 0.142248368f; q = q * t + 0.127414796f; q = q * t;
  const float tail = q * __builtin_amdgcn_exp2f(v * v * -0.72134752044f);
  return v < 0.f ? v * tail : v - v * tail;
}

#ifndef ROUTE_REPS
#define ROUTE_REPS 1
#endif
__device__ __forceinline__ void ins16(float (&t)[16], float x) {
#pragma unroll
  for (int i = 15; i >= 1; --i) t[i] = __builtin_amdgcn_fmed3f(t[i - 1], t[i], x);
  t[0] = fmaxf(t[0], x);
}
__device__ __forceinline__ void p6_peer(const Frame& F, const Args& a, float* dst_base) {
  const float* S2 = (const float*)(F.ws + WS_S); const float* SSQ = (const float*)(F.ws + WS_SSQ); const bf16* H1b = (const bf16*)(F.ws + WS_H1B);
  int lane = F.lane, wv = F.wave, tid = F.tid; asm volatile("" : "+v"(lane), "+s"(wv), "+v"(tid));
  int* EIDg = (int*)(F.ws + WS_EID); float* EGTg = (float*)(F.ws + WS_EGT);
  LAS int* eid = (LAS int*)(F.lds + wv * 8192); LAS float* cg = (LAS float*)(eid + 512); LAS float* esu = (LAS float*)(eid + 1024); LAS float* dq = (LAS float*)(eid + 1536);
  LAS unsigned char* RB = F.lds + 65536 + wv * 8192;
  LAS float* L1 = (LAS float*)(F.lds + 65536);
  TP_BEGIN(11);
#ifdef TPROBE
  const unsigned long long tp_p7_ = __builtin_amdgcn_s_memrealtime();
#endif
  for (int tb = blockIdx.x; tb < MROWS / 32; tb += gridDim.x) {
    __syncthreads();
    {
      const int g = tid >> 5, tl = tid & 31; const v4u* src = (const v4u*)((const _Float16*)S2 + ((size_t)((tb * 16 + g) * 32 + tl)) * 128);
      float t[16];
#pragma unroll
      for (int i = 0; i < 16; ++i) t[i] = -INFINITY;
      v4u sv[16];
#pragma unroll
      for (int k8 = 0; k8 < 16; ++k8) sv[k8] = src[k8];
#pragma unroll
      for (int k8 = 0; k8 < 16; ++k8)
#pragma unroll
        for (int q = 0; q < 4; ++q) { const unsigned wq_ = sv[k8][q]; const h16x2 hq_ = __builtin_bit_cast(h16x2, wq_); const int k = 8 * k8 + 2 * q;
          ins16(t, __builtin_bit_cast(float, (__builtin_bit_cast(unsigned, (float)hq_.x) & ~0x7Fu) | (unsigned)(127 - k)));
          ins16(t, __builtin_bit_cast(float, (__builtin_bit_cast(unsigned, (float)hq_.y) & ~0x7Fu) | (unsigned)(126 - k))); }
#pragma unroll
      for (int i = 0; i < 16; ++i) L1[(g * 16 + i) * 32 + tl] = t[i];
    }
    __syncthreads();
    if (tid < 256) {
      const int h8 = tid >> 5, tl = tid & 31; const LAS float* LA = L1 + ((2 * h8) * 16) * 32 + tl; const LAS float* LB = L1 + ((2 * h8 + 1) * 16) * 32 + tl;
      float A[16], B[16], t[16];
#pragma unroll
      for (int i = 0; i < 16; ++i) { A[i] = LA[i * 32]; B[i] = LB[i * 32]; t[i] = -INFINITY; }
#pragma unroll
      for (int i = 0; i < 16; ++i)
#pragma unroll
        for (int j = 0; j < 16; ++j) if ((i + 1) * (j + 1) <= 16) { const float c = A[i] + B[j];
            ins16(t, __builtin_bit_cast(float, (__builtin_bit_cast(unsigned, c) & ~0xFFu) | (unsigned)(255 - (i * 16 + j)))); }
      float ev[16], es = 0.f;
#pragma unroll
      for (int r = 0; r < 16; ++r) { ev[r] = __expf(t[r] - t[0]); es += ev[r]; }
      const float inv = 1.0f / es;
#pragma unroll
      for (int r = 0; r < 16; ++r) { const unsigned flat = 255u - (__builtin_bit_cast(unsigned, t[r]) & 0xFFu), ii = flat >> 4, jj = flat & 15u;
        const unsigned ka = 127u - (__builtin_bit_cast(unsigned, LA[ii * 32]) & 0x7Fu), kb = 127u - (__builtin_bit_cast(unsigned, LB[jj * 32]) & 0x7Fu);
        EIDg[(size_t)(tb * 32 + tl) * 128 + h8 * 16 + r] = (int)(ka * 128u + kb); EGTg[(size_t)(tb * 32 + tl) * 128 + h8 * 16 + r] = ev[r] * inv; }
    }
    asm volatile("s_waitcnt vmcnt(0)" ::: "memory"); __syncthreads();
    TP_END(11, F.ws);
    const unsigned char* U8 = F.ws + WS_UB; const unsigned char* V8 = F.ws + WS_VB8;
    constexpr int NSPL_LOG = 4, NSPL = 1 << NSPL_LOG, ESPL = 128 / NSPL, NBT = 4;
#define S_IDX(S) ((((S) / ESPL) & 3) * 128 + ((S) / (4 * ESPL)) * ESPL + ((S) & (ESPL - 1)))
#define PG_ISSUE(TAB, S) do { const int idq_ = __builtin_amdgcn_readfirstlane(eid[S_IDX(S)]); \
      __builtin_amdgcn_global_load_lds((const unsigned*)((TAB) + (size_t)idq_ * 1024 + lane * 16), (LAS unsigned*)(RB + ((S) & 7) * 1024), 16, 0, 0); } while (0)
#define PG_ISSUE_ID(TAB, S, ID) do { const int idq_ = __builtin_amdgcn_readfirstlane(ID); \
      __builtin_amdgcn_global_load_lds((const unsigned*)((TAB) + (size_t)idq_ * 1024 + lane * 16), (LAS unsigned*)(RB + ((S) & 7) * 1024), 16, 0, 0); } while (0)
    int xl[4][4], xh[4][4]; float rsxv[4];
    { const float* SCL = (const float*)(F.ws + WS_SCL); const int tok0 = tb * 32 + wv * 4;
      int id0[4], id1[4]; float g0_[4], g1_[4], sq[4]; unsigned xw[4][16];
#pragma unroll
      for (int tt = 0; tt < 4; ++tt) {
        id0[tt] = __builtin_nontemporal_load(EIDg + (size_t)(tok0 + tt) * 128 + lane); id1[tt] = __builtin_nontemporal_load(EIDg + (size_t)(tok0 + tt) * 128 + lane + 64);
        g0_[tt] = __builtin_nontemporal_load(EGTg + (size_t)(tok0 + tt) * 128 + lane); g1_[tt] = __builtin_nontemporal_load(EGTg + (size_t)(tok0 + tt) * 128 + lane + 64);
        sq[tt] = lane < 32 ? SSQ[(size_t)(tok0 + tt) * 32 + lane] : 0.f;
        const bf16* xp = H1b + (size_t)(tok0 + tt) * DM + (size_t)lane * 4;
#pragma unroll
        for (int q = 0; q < 8; ++q) { const v2u x0 = *(const v2u*)(xp + q * 256); xw[tt][2 * q] = x0.x; xw[tt][2 * q + 1] = x0.y; } }
#pragma unroll
      for (int tt = 0; tt < 4; ++tt) {
        const float su0 = SCL[id0[tt]], su1 = SCL[id1[tt]], sv0 = SCL[16384 + id0[tt]], sv1 = SCL[16384 + id1[tt]];
        const int b0 = id0[tt] >> (14 - NSPL_LOG), b1 = id1[tt] >> (14 - NSPL_LOG); const unsigned long long lt = (1ull << lane) - 1ull;
        int p0 = 0, p1 = 0, base = 0;
#pragma unroll
        for (int b = 0; b < NSPL; ++b) { const unsigned long long k0 = __ballot(b0 == b), k1 = __ballot(b1 == b); const int c0_ = __builtin_popcountll(k0);
          if (b0 == b) p0 = base + __builtin_popcountll(k0 & lt); if (b1 == b) p1 = base + c0_ + __builtin_popcountll(k1 & lt); base += c0_ + __builtin_popcountll(k1); }
        eid[tt * 128 + p0] = id0[tt]; esu[tt * 128 + p0] = su0; cg[tt * 128 + p0] = g0_[tt] * sv0; eid[tt * 128 + p1] = id1[tt]; esu[tt * 128 + p1] = su1; cg[tt * 128 + p1] = g1_[tt] * sv1; }
#pragma unroll
      for (int tt = 0; tt < 4; ++tt) { const float rs = rsqrtf(wave_sum_dpp(sq[tt]) * (1.0f / DM) + EPS); float xa = 0.f;
#pragma unroll
        for (int i = 0; i < 16; ++i) xa = fmaxf(xa, fmaxf(fabsf(bflo(xw[tt][i])), fabsf(bfhi(xw[tt][i]))));
#pragma unroll
        for (int o = 1; o < 64; o <<= 1) xa = fmaxf(xa, __shfl_xor(xa, o));
        const float xinv = xa > 0.f ? 119.0f / xa : 0.f; rsxv[tt] = rs * (xa > 0.f ? xa * (1.0f / 119.0f) : 0.f);
#pragma unroll
        for (int d = 0; d < 4; ++d) { unsigned pl = 0u, ph = 0u;
#pragma unroll
          for (int p_ = 0; p_ < 8; ++p_) { const int i = 8 * d + p_; const float v = (i & 1) ? bfhi(xw[tt][i >> 1]) : bflo(xw[tt][i >> 1]);
            const int xi = (int)__builtin_rintf(v * xinv), l = ((xi + 8) & 15) - 8, h = (xi - l) >> 4;
            pl |= ((unsigned)l & 15u) << (4 * p_); ph |= ((unsigned)h & 15u) << (4 * p_); }
          xl[tt][d] = (int)pl; xh[tt][d] = (int)ph; } }
    }
    asm volatile("s_waitcnt vmcnt(0) lgkmcnt(0)" ::: "memory");
    {
      LAS int* dqi = (LAS int*)dq; const bool o1 = (lane & 1) != 0, o2 = (lane & 2) != 0;
#define DPPI(X, CTRL) __builtin_amdgcn_update_dpp(0, (X), (CTRL), 0xF, 0xF, true)
#define PU_LOAD(R, NI, S) do { const int nb_ = (S) + 8 < 512 ? S_IDX((S) + 8) : 0; \
        _Pragma("unroll") for (int q = 0; q < 4; ++q) { R[q] = *(const LAS v4u*)(RB + (((S) + q) & 7) * 1024 + lane * 16); NI[q] = eid[nb_ + q]; } } while (0)
#define PU_STEP(TT, S, R, NI, R2, NI2) do { \
        asm volatile("s_waitcnt lgkmcnt(0)" ::: "memory");                                      \
        if ((S) + 8 < 512) { _Pragma("unroll") for (int q = 0; q < 4; ++q) PG_ISSUE_ID(U8, (S) + 8 + q, NI[q]); } \
        if ((S) + 4 < 512) { if ((S) + 8 < 512) asm volatile("s_waitcnt vmcnt(4)" ::: "memory"); else asm volatile("s_waitcnt vmcnt(0)" ::: "memory");     \
          PU_LOAD(R2, NI2, (S) + 4); } \
        int a_[4]; _Pragma("unroll") for (int q = 0; q < 4; ++q) { int al_ = 0, ah_ = 0; _Pragma("unroll") for (int dd = 0; dd < 4; ++dd) { const int wa = (int)R[q][dd]; \
            al_ = __builtin_amdgcn_sdot8(wa, xl[TT][dd], al_, false); ah_ = __builtin_amdgcn_sdot8(wa, xh[TT][dd], ah_, false); } a_[q] = ah_ * 16 + al_; } \
        const int r01_ = (o1 ? a_[1] : a_[0]) + DPPI(o1 ? a_[0] : a_[1], 0xB1), r23_ = (o1 ? a_[3] : a_[2]) + DPPI(o1 ? a_[2] : a_[3], 0xB1); \
        int r_ = (o2 ? r23_ : r01_) + DPPI(o2 ? r01_ : r23_, 0x4E); \
        r_ += DPPI(r_, 0x124); r_ += DPPI(r_, 0x128); \
        { auto s_ = __builtin_amdgcn_permlane16_swap((unsigned)r_, (unsigned)r_, false, false); const unsigned s0_ = s_[0], s1_ = s_[1]; r_ = (int)(s0_ + s1_); } \
        { auto s_ = __builtin_amdgcn_permlane32_swap((unsigned)r_, (unsigned)r_, false, false); const unsigned s0_ = s_[0], s1_ = s_[1]; r_ = (int)(s0_ + s1_); } \
        if (lane < 4) dqi[S_IDX(S) + lane] = r_; \
        asm volatile("" ::: "memory"); } while (0)
#define PU_TOK(TT) { const int S = (hh * 4 + (TT)) * ESPL; PU_STEP(TT, S, ra, na, rb, nb); PU_STEP(TT, S + 4, rb, nb, ra, na); }
      static_assert(ESPL == 8, "the pipelined gather assumes two batches of four rows per visit");
      v4u ra[4], rb[4]; int na[4], nb[4];
#pragma unroll
      for (int s = 0; s < 8; ++s) PG_ISSUE(U8, s);
      asm volatile("s_waitcnt vmcnt(4)" ::: "memory");
      PU_LOAD(ra, na, 0);
#pragma unroll 1
      for (int hh = 0; hh < NSPL; ++hh) { PU_TOK(0) PU_TOK(1) PU_TOK(2) PU_TOK(3) }
      asm volatile("s_waitcnt lgkmcnt(0)" ::: "memory");
#undef PU_LOAD
#undef PU_STEP
#undef PU_TOK
#undef DPPI
#pragma unroll
      for (int tt = 0; tt < 4; ++tt)
#pragma unroll
        for (int i = 0; i < 2; ++i) { const int e = tt * 128 + lane + 64 * i; cg[e] = gelu_erf((float)dqi[e] * (rsxv[tt] * esu[e])) * cg[e]; }
      asm volatile("s_waitcnt lgkmcnt(0)" ::: "memory");
    }
    h16x2 y[4][16];
#pragma unroll
    for (int t_ = 0; t_ < 4; ++t_)
#pragma unroll
      for (int i = 0; i < 16; ++i) y[t_][i] = (h16x2){(_Float16)0.f, (_Float16)0.f};
#define PV_LOAD(R, CC, NI, S) do { const int li_ = S_IDX(S), nb_ = (S) + 8 < 512 ? S_IDX((S) + 8) : 0; \
        _Pragma("unroll") for (int q = 0; q < 4; ++q) { R[q] = *(const LAS v4u*)(RB + (((S) + q) & 7) * 1024 + lane * 16); CC[q] = cg[li_ + q]; NI[q] = eid[nb_ + q]; } } while (0)
#define PV_STEP(TT, S, R, CC, NI, R2, CC2, NI2) do { \
        asm volatile("s_waitcnt lgkmcnt(0)" ::: "memory"); \
        if ((S) + 8 < 512) { _Pragma("unroll") for (int q = 0; q < 4; ++q) PG_ISSUE_ID(V8, (S) + 8 + q, NI[q]); } \
        if ((S) + 4 < 512) { if ((S) + 8 < 512) asm volatile("s_waitcnt vmcnt(4)" ::: "memory"); else asm volatile("s_waitcnt vmcnt(0)" ::: "memory"); \
          PV_LOAD(R2, CC2, NI2, (S) + 4); } \
        _Pragma("unroll") for (int q = 0; q < 4; ++q) { const _Float16 ch_ = (_Float16)CC[q]; const h16x2 c2_ = {ch_, ch_}; \
          _Pragma("unroll") for (int dd = 0; dd < 4; ++dd) { const unsigned wa = R[q][dd]; \
            y[TT][4 * dd + 0] += c2_ * __builtin_amdgcn_cvt_scalef32_pk_f16_fp4(wa, 1.0f, 0); y[TT][4 * dd + 1] += c2_ * __builtin_amdgcn_cvt_scalef32_pk_f16_fp4(wa, 1.0f, 1); \
            y[TT][4 * dd + 2] += c2_ * __builtin_amdgcn_cvt_scalef32_pk_f16_fp4(wa, 1.0f, 2); y[TT][4 * dd + 3] += c2_ * __builtin_amdgcn_cvt_scalef32_pk_f16_fp4(wa, 1.0f, 3); } \
          __builtin_amdgcn_sched_barrier(0); } \
        asm volatile("" ::: "memory"); } while (0)
#define PV_STEPU(TT, S, R, CC, NI, R2, CC2, NI2) do {       \
        asm volatile("s_waitcnt lgkmcnt(0)" ::: "memory"); \
        _Pragma("unroll") for (int q = 0; q < 4; ++q) PG_ISSUE_ID(V8, (S) + 8 + q, NI[q]); \
        asm volatile("s_waitcnt vmcnt(4)" ::: "memory"); \
        PV_LOAD(R2, CC2, NI2, (S) + 4); \
        _Pragma("unroll") for (int q = 0; q < 4; ++q) { const _Float16 ch_ = (_Float16)CC[q]; const h16x2 c2_ = {ch_, ch_}; \
          _Pragma("unroll") for (int dd = 0; dd < 4; ++dd) { const unsigned wa = R[q][dd]; \
            y[TT][4 * dd + 0] += c2_ * __builtin_amdgcn_cvt_scalef32_pk_f16_fp4(wa, 1.0f, 0); y[TT][4 * dd + 1] += c2_ * __builtin_amdgcn_cvt_scalef32_pk_f16_fp4(wa, 1.0f, 1); \
            y[TT][4 * dd + 2] += c2_ * __builtin_amdgcn_cvt_scalef32_pk_f16_fp4(wa, 1.0f, 2); y[TT][4 * dd + 3] += c2_ * __builtin_amdgcn_cvt_scalef32_pk_f16_fp4(wa, 1.0f, 3); } \
          __builtin_amdgcn_sched_barrier(0); } \
        asm volatile("" ::: "memory"); } while (0)
#define PV_TOKU(TT) { const int S = (hh * 4 + (TT)) * ESPL; PV_STEPU(TT, S, va, ca, ia, vb2, cb2, ib2); PV_STEPU(TT, S + 4, vb2, cb2, ib2, va, ca, ia); }
#define PV_TOK(TT) { const int S = (hh * 4 + (TT)) * ESPL; PV_STEP(TT, S, va, ca, ia, vb2, cb2, ib2); PV_STEP(TT, S + 4, vb2, cb2, ib2, va, ca, ia); }
    v4u va[4], vb2[4]; float ca[4], cb2[4]; int ia[4], ib2[4];
#pragma unroll
    for (int s = 0; s < 8; ++s) PG_ISSUE(V8, s);
    asm volatile("s_waitcnt vmcnt(4)" ::: "memory");
    PV_LOAD(va, ca, ia, 0);
#pragma unroll 1
    for (int hh = 0; hh < NSPL - 1; ++hh) { PV_TOKU(0) PV_TOKU(1) PV_TOKU(2) PV_TOKU(3) }
    { constexpr int hh = NSPL - 1; PV_TOKU(0) PV_TOKU(1) PV_TOKU(2) PV_TOK(3) }
    asm volatile("s_waitcnt lgkmcnt(0)" ::: "memory");
#undef PV_LOAD
#undef PV_STEP
#undef PV_TOK
#undef PV_TOKU
#undef PV_STEPU
#undef S_IDX
#pragma unroll
    for (int tt = 0; tt < 4; ++tt) {
      const int tok = tb * 32 + wv * 4 + tt;
      unsigned xw[16];
      { const bf16* xp = H1b + (size_t)tok * DM + (size_t)lane * 4;
#pragma unroll
        for (int q = 0; q < 8; ++q) { const v2u x0 = *(const v2u*)(xp + q * 256); xw[2 * q] = x0.x; xw[2 * q + 1] = x0.y; } }
      float* drow = dst_base + (size_t)tok * DM;
#pragma unroll
      for (int q = 0; q < 8; ++q) { const size_t off = (size_t)q * 256 + lane * 4; f32x4 hv;
        const h16x2 ya_ = y[tt][2 * q], yb_ = y[tt][2 * q + 1];
        hv.x = bflo(xw[2 * q]) + (float)ya_.x;
#ifdef TPROBE
        if (TPROBE != 13 && tok == 0 && lane == 0 && q == 0) hv.x += 10.0f + (float)(*(volatile unsigned*)(F.ws + 64)) * (0.01f / TP_DIV);
        if (TPROBE == 13 && (int)blockIdx.x == TP_BLOCK && wv == 7 && tt == 3 && lane == 0 && q == 0) hv.x += 10.0f + (float)(unsigned)(__builtin_amdgcn_s_memrealtime() - tp_p7_) * (0.01f / TP_DIV);
#endif
        hv.y = bfhi(xw[2 * q]) + (float)ya_.y; hv.z = bflo(xw[2 * q + 1]) + (float)yb_.x; hv.w = bfhi(xw[2 * q + 1]) + (float)yb_.y; __builtin_nontemporal_store(hv, (f32x4*)(drow + off)); }
    }
#undef PG_ISSUE
#undef PG_ISSUE_ID
  }
}
constexpr int MISC_LDS = LDS_BYTES - 256;
__global__ void __launch_bounds__(NTHR, 2) mk_fwd(Args args) {
  extern __shared__ __attribute__((aligned(16))) unsigned char lds_raw[];
  Frame F; F.lds = (LAS unsigned char*)lds_raw; F.ws = args.ws; F.tid = threadIdx.x; F.lane = F.tid & 63; F.wave = __builtin_amdgcn_readfirstlane(F.tid >> 6);
  const int lo = args.ph_lo, hi = args.ph_hi, G = (int)gridDim.x, bx = (int)blockIdx.x;
  volatile LAS unsigned* misc = (volatile LAS unsigned*)(F.lds + MISC_LDS);
  if (F.tid < 16) misc[F.tid] = 0u;
  __syncthreads();
  XcdBarrier bar = xcd_barrier_post((unsigned*)(F.ws + WS_CTL) + CW_BAR, misc);
#define IN(k) (lo <= (k) && (k) < hi)
#ifdef TPROBE
#define SEAM(k) do { if (IN(k) && IN((k) + 1)) { const unsigned long long tq0_ = __builtin_amdgcn_s_memrealtime(); xcd_barrier(bar); const unsigned long long tq1_ = __builtin_amdgcn_s_memrealtime(); \
    if (TPROBE == 20 + (k) && (int)blockIdx.x == TP_BLOCK && threadIdx.x == 0) atomicAdd((unsigned*)(F.ws + 64), (unsigned)(tq1_ - tq0_)); } } while (0)
#else
#define SEAM(k) do { if (IN(k) && IN((k) + 1)) xcd_barrier(bar); } while (0)
#endif
#define PHASE_FRAME(Fp) Frame Fp = F; asm volatile("" : "+v"(Fp.tid), "+v"(Fp.lane))
  const int NA = G;
  if (IN(0)) { PHASE_FRAME(F0); TP_BEGIN(1);
#ifdef SLEEP_START
#pragma unroll 1
    for (int i_ = 0; i_ < SLEEP_START; ++i_) __builtin_amdgcn_s_sleep(127);
#endif
    p0_lam(F0, args);
    p0_zero_vpad(F0);
    TP_BEGIN(41); p0_rows(F0, args); TP_END(41, F.ws);
    TP_BEGIN(42); p0_transpose<true>(F0, args, args.in[IN_WIN], DPROJ, NPROJ, (bf16*)(F.ws + WS_W1T));
    p0_transpose<false>(F0, args, args.in[IN_WOUT], DM, DM, (bf16*)(F.ws + WS_W2T)); TP_END(42, F.ws);
    TP_BEGIN(43); p0_w3t(F0, args); TP_END(43, F.ws);
    TP_BEGIN(44); p0_tables(F0, args); TP_END(44, F.ws);
#ifdef DUP_ROWS
    p0_rows(F0, args);
#endif
#ifdef DUP_TR
    p0_transpose<true>(F0, args, args.in[IN_WIN], DPROJ, NPROJ, (bf16*)(F.ws + WS_W1T));
    p0_transpose<false>(F0, args, args.in[IN_WOUT], DM, DM, (bf16*)(F.ws + WS_W2T));
#endif
#ifdef DUP_W3T
    p0_w3t(F0, args);
#endif
#ifdef DUP_TAB
    p0_tables(F0, args);
#endif
    TP_END(1, F.ws);
  }
  SEAM(0);
  if (IN(1)) { PHASE_FRAME(F1); TP_BEGIN(2);
    p1_meta_finalize(F1, args);
    pg8::Gemm g{(const pg8::bf16_t*)(F.ws + WS_XN), (const pg8::bf16_t*)(F.ws + WS_W1T), MROWS, NPROJ, DM};
    pg8::StaticOrder S; S.init(MROWS, NPROJ, G, bx);
    EpiProj E{(bf16*)(F.ws + WS_Q), (bf16*)(F.ws + WS_KP), (bf16*)(F.ws + WS_VP), (bf16*)(F.ws + WS_MQ), (bf16*)(F.ws + WS_MK), (bf16*)(F.ws + WS_MV), (bf16*)(F.ws + WS_MO),
              args.in[IN_QNG], args.in[IN_KNG], (LAS float*)(F.lds + XCH_OFF)};
    pg8::gemm_phase<EpiProj, pg8::StaticOrder, true, true>(F.lds + RING_OFF, g, S, E);
    TP_END(2, F.ws);
  }
  SEAM(1);
  if (IN(2)) {
    PHASE_FRAME(F2);
    TP_BEGIN(3);
    att::phase(F2, (G % 8 == 0) ? (bx & 7) * (G >> 3) + (bx >> 3) : bx, NA);
    TP_END(3, F.ws); TP_BEGIN(4);
    for (int task = bx; task < 512; task += G) ml::taskA(F2, args, task);
    TP_END(4, F.ws);
  }
  SEAM(2);
  if (IN(3)) { PHASE_FRAME(F3); TP_BEGIN(5); ml::scanB(F3); TP_END(5, F.ws); TP_BEGIN(6); p3_combine(F3, args, NA); TP_END(6, F.ws);
#ifdef DUP_SCAN
    ml::scanB(F3);
#endif
#ifdef DUP_COMB
    p3_combine(F3, args, NA);
#endif
  }
  SEAM(3);
#ifdef EXTRA_BARS
  for (int i_ = 0; i_ < EXTRA_BARS; ++i_) xcd_barrier(bar);
#endif
  if (IN(4)) {
    PHASE_FRAME(F4);
    TP_BEGIN(7);
    for (int task = bx; task < 512; task += G) ml::taskC(F4, args, task);
    TP_END(7, F.ws);
  }
  SEAM(4);
  if (IN(5)) { TP_BEGIN(8);
    pg8::Gemm g{(const pg8::bf16_t*)(F.ws + WS_A2), (const pg8::bf16_t*)(F.ws + WS_W2T), MROWS, DM, DM};
    pg8::StaticOrder S; S.init(MROWS, DM, G, bx);
    EpiRes E{args.in[IN_X], args.out, (bf16*)(F.ws + WS_H1B), (float*)(F.ws + WS_SSQ)};
    pg8::gemm_phase<EpiRes, pg8::StaticOrder, true, true>(F.lds + RING_OFF, g, S, E);
    TP_END(8, F.ws);
  }
  SEAM(5);
  if (IN(6)) { TP_BEGIN(9);
    pg8::Gemm g{(const pg8::bf16_t*)(F.ws + WS_H1B), (const pg8::bf16_t*)(F.ws + WS_W3T), MROWS, DM, DM};
    pg8::StaticOrder S; S.init(MROWS, DM, G, bx);
    LAS float* rst = (LAS float*)(F.lds + XCH_OFF);
    { pg8::Unit u0; if (S.next(0, u0)) { if (F.tid < 256) { const float* sp = (const float*)(F.ws + WS_SSQ) + ((size_t)u0.pm * 256 + F.tid) * 32; float s = 0.f;
#pragma unroll
          for (int i = 0; i < 8; ++i) { const f32x4 v = ((const f32x4*)sp)[i]; s += (v.x + v.y) + (v.z + v.w); }
          rst[F.tid] = rsqrtf(s * (1.0f / DM) + EPS); } } }
    __syncthreads();
    EpiScore E{(_Float16*)(F.ws + WS_S), rst};
    pg8::gemm_phase<EpiScore, pg8::StaticOrder, true, true>(F.lds + RING_OFF, g, S, E);
    TP_END(9, F.ws);
  }
  SEAM(6);
  if (IN(7)) { PHASE_FRAME(F7); TP_BEGIN(10); p6_peer(F7, args, args.out); TP_END(10, F.ws); }
#undef IN
#undef SEAM
}
extern "C" void kernel_launch(void* const* d_in, const int* in_sizes, int n_in, void* d_out, int out_size, void* d_ws, size_t ws_size, hipStream_t stream) {
  static int grid = 0;
  if (grid == 0) {
    int dev = 0, cus = 0, per_cu = 0;
    if (hipGetDevice(&dev) != hipSuccess || hipDeviceGetAttribute(&cus, hipDeviceAttributeMultiprocessorCount, dev) != hipSuccess) { fprintf(stderr, "device query failed\n"); grid = -1; return; }
    if (hipFuncSetAttribute((const void*)mk_fwd, hipFuncAttributeMaxDynamicSharedMemorySize, LDS_BYTES) != hipSuccess) { fprintf(stderr, "hipFuncSetAttribute failed\n"); grid = -1; return; }
    if (hipOccupancyMaxActiveBlocksPerMultiprocessor(&per_cu, (const void*)mk_fwd, NTHR, LDS_BYTES) != hipSuccess || per_cu < 1) { fprintf(stderr, "occupancy query says %d workgroups per CU: not launching\n", per_cu); (void)hipGetLastError(); grid = -1; return; }
    (void)hipGetLastError();
    grid = cus;
    if (n_in != 22 || ws_size < (size_t)512 * MiB || out_size != MROWS * DM) { fprintf(stderr, "unexpected shapes: n_in %d out %d ws %zu\n", n_in, out_size, ws_size); grid = -1; return; }
  }
  if (grid < 0) return;
  unsigned char* ws = (unsigned char*)d_ws;
  if (hipMemsetAsync(ws + WS_CTL, 0, CTL_ZERO_BYTES, stream) != hipSuccess) { fprintf(stderr, "memset failed\n"); return; }
  Args a{};
  for (int i = 0; i < 22; ++i) a.in[i] = (const float*)d_in[i];
  a.out = (float*)d_out; a.ws = ws; a.na = 0; a.pad = 0;
  a.ph_lo = 0; a.ph_hi = 8;
  hipLaunchKernelGGL(mk_fwd, dim3(grid), dim3(NTHR), LDS_BYTES, stream, a);
}
```
